# Optimizing an MI355X kernel written in HIP

```python
import math
import jax, jax.numpy as jnp
from jax import lax
import numpy as np

D_MODEL = 4096
BATCH = 4
SEQ = 2048
DEPTH = 2

PLE_DIM = 256
N_BRANCHES = 3
BRANCH_WIDTH = D_MODEL // 2
GMLP_CHUNK = 128
GMLP_GROUPS = 8
SWA_HEAD_DIM = 64
SWA_Q_HEADS = BRANCH_WIDTH // SWA_HEAD_DIM
SWA_KV_HEADS = 4
SWA_WINDOW = 128
SWA_BLOCK = 128
ROT_DIM = SWA_HEAD_DIM // 4
ROPE_THETA = 500000.0
MLSTM_HEADS = 4
MLSTM_V_DIM = BRANCH_WIDTH // MLSTM_HEADS
MLSTM_QK_DIM = MLSTM_V_DIM // 2
MLSTM_CHUNK = 64
GATE_SOFTCAP = 15.0
NORM_EPS = 1e-6
NEG_INF = -1e30

SPLIT_SIZES = (
    BRANCH_WIDTH, BRANCH_WIDTH, BRANCH_WIDTH,
    SWA_Q_HEADS * SWA_HEAD_DIM, SWA_KV_HEADS * SWA_HEAD_DIM,
    SWA_KV_HEADS * SWA_HEAD_DIM, BRANCH_WIDTH,
    MLSTM_HEADS * MLSTM_QK_DIM, MLSTM_HEADS * MLSTM_QK_DIM,
    MLSTM_HEADS * MLSTM_V_DIM, MLSTM_HEADS, MLSTM_HEADS,
    BRANCH_WIDTH, BRANCH_WIDTH,
    N_BRANCHES * D_MODEL,
)
N_IN = sum(SPLIT_SIZES)

kernel_name = 'hybrid_gmlp_swa_mlstm_block'


def rms_norm(x, g):
    xf = x.astype(jnp.float32)
    y = xf * lax.rsqrt(jnp.mean(xf * xf, axis=-1, keepdims=True) + NORM_EPS)
    return (y * g.astype(jnp.float32)).astype(x.dtype)


def layer_norm(x, g, b):
    xf = x.astype(jnp.float32)
    mu = jnp.mean(xf, axis=-1, keepdims=True)
    var = jnp.mean(jnp.square(xf - mu), axis=-1, keepdims=True)
    y = (xf - mu) * lax.rsqrt(var + NORM_EPS)
    return (y * g.astype(jnp.float32) + b.astype(jnp.float32)).astype(x.dtype)


def softcap(z):
    return GATE_SOFTCAP * jnp.tanh(z / GATE_SOFTCAP)


def apply_partial_rope(t, cos, sin):
    half = ROT_DIM // 2
    t1 = t[..., :half].astype(jnp.float32)
    t2 = t[..., half:ROT_DIM].astype(jnp.float32)
    rot = jnp.concatenate([t1 * cos - t2 * sin, t2 * cos + t1 * sin], axis=-1).astype(t.dtype)
    return jnp.concatenate([rot, t[..., ROT_DIM:]], axis=-1)


def gmlp_branch(u, v, ln_g, ln_b, ws, bs):
    B, S, W = v.shape
    nc = S // GMLP_CHUNK
    u = jax.nn.gelu(u, approximate=False)
    v = layer_norm(jax.nn.gelu(v, approximate=False), ln_g, ln_b)
    vg = v.reshape(B, nc, GMLP_CHUNK, GMLP_GROUPS, W // GMLP_GROUPS)
    w_causal = jnp.tril(ws)
    mixed = jnp.einsum('gts,bnsgc->bntgc', w_causal, vg) + bs.T[None, None, :, :, None]
    return u * mixed.reshape(B, S, W)


def swa_branch(q, k, v, sinks, cos, sin):
    B, S, _ = q.shape
    G = SWA_Q_HEADS // SWA_KV_HEADS
    nb = S // SWA_BLOCK
    q = apply_partial_rope(q.reshape(B, S, SWA_Q_HEADS, SWA_HEAD_DIM), cos, sin)
    k = apply_partial_rope(k.reshape(B, S, SWA_KV_HEADS, SWA_HEAD_DIM), cos, sin)
    v = v.reshape(B, S, SWA_KV_HEADS, SWA_HEAD_DIM)
    qb = q.reshape(B, nb, SWA_BLOCK, SWA_KV_HEADS, G, SWA_HEAD_DIM)

    def band(t):
        tp = jnp.pad(t, ((0, 0), (SWA_BLOCK, 0), (0, 0), (0, 0)))
        tp = tp.reshape(B, nb + 1, SWA_BLOCK, SWA_KV_HEADS, SWA_HEAD_DIM)
        return jnp.concatenate([tp[:, :-1], tp[:, 1:]], axis=2)

    kb, vb = band(k), band(v)
    s = jnp.einsum('bnqhgd,bnkhd->bnhgqk', qb, kb).astype(jnp.float32) * (SWA_HEAD_DIM ** -0.5)
    qi = jnp.arange(SWA_BLOCK)[:, None]
    kj = jnp.arange(2 * SWA_BLOCK)[None, :]
    diff = qi + SWA_BLOCK - kj
    local = (diff >= 0) & (diff < SWA_WINDOW)
    not_pad = (jnp.arange(nb)[:, None, None] > 0) | (kj >= SWA_BLOCK)[None]
    mask = local[None] & not_pad
    s = jnp.where(mask[None, :, None, None], s, NEG_INF)
    sink = sinks.astype(jnp.float32).reshape(SWA_KV_HEADS, G)[None, None, :, :, None, None]
    sink = jnp.broadcast_to(sink, s.shape[:-1] + (1,))
    probs = jax.nn.softmax(jnp.concatenate([s, sink], axis=-1), axis=-1)[..., :-1]
    o = jnp.einsum('bnhgqk,bnkhd->bnqhgd', probs.astype(v.dtype), vb)
    return o.reshape(B, S, SWA_Q_HEADS * SWA_HEAD_DIM)


def mlstm_chunkwise(q, k, v, ig, lf):
    B, S, H, dk = q.shape
    dv = v.shape[-1]
    L = MLSTM_CHUNK
    nc = S // L

    def to_chunks(t):
        if t.ndim == 4:
            return t.reshape(B, nc, L, H, t.shape[-1]).transpose(1, 0, 3, 2, 4)
        return t.reshape(B, nc, L, H).transpose(1, 0, 3, 2)

    causal = jnp.tril(jnp.ones((L, L), dtype=bool))

    def step(carry, xs):
        C, n, m = carry
        qc, kc, vc, ic, fc = xs
        b = jnp.cumsum(fc, axis=-1)
        log_d = b[..., :, None] - b[..., None, :] + ic[..., None, :]
        log_d = jnp.where(causal, log_d, NEG_INF)
        m_inter = b + m[..., None]
        m_t = jnp.maximum(m_inter, jnp.max(log_d, axis=-1))
        s = jnp.einsum('bhqd,bhkd->bhqk', qc, kc) * jnp.exp(log_d - m_t[..., None])
        a = jnp.exp(m_inter - m_t)
        num = jnp.einsum('bhqk,bhkv->bhqv', s, vc) + a[..., None] * jnp.einsum('bhqd,bhdv->bhqv', qc, C)
        den = jnp.sum(s, axis=-1) + a * jnp.einsum('bhqd,bhd->bhq', qc, n)
        h = num / jnp.maximum(jnp.abs(den), jnp.exp(-m_t))[..., None]
        g = b[..., -1]
        w_log = g[..., None] - b + ic
        m_new = jnp.maximum(g + m, jnp.max(w_log, axis=-1))
        w = jnp.exp(w_log - m_new[..., None])
        decay = jnp.exp(g + m - m_new)
        C = decay[..., None, None] * C + jnp.einsum('bhl,bhld,bhlv->bhdv', w, kc, vc)
        n = decay[..., None] * n + jnp.einsum('bhl,bhld->bhd', w, kc)
        return (C, n, m_new), h

    init = (jnp.zeros((B, H, dk, dv), jnp.float32), jnp.zeros((B, H, dk), jnp.float32),
            jnp.zeros((B, H), jnp.float32))
    _, hs = lax.scan(step, init, (to_chunks(q), to_chunks(k), to_chunks(v), to_chunks(ig), to_chunks(lf)))
    return hs.transpose(1, 0, 3, 2, 4).reshape(B, S, H, dv)


def mlstm_branch(q, k, v, i_pre, f_pre, o_pre, ib, fb, norm_g):
    B, S, _ = q.shape
    qf = q.reshape(B, S, MLSTM_HEADS, MLSTM_QK_DIM).astype(jnp.float32) * (MLSTM_QK_DIM ** -0.5)
    kf = k.reshape(B, S, MLSTM_HEADS, MLSTM_QK_DIM).astype(jnp.float32)
    vf = v.reshape(B, S, MLSTM_HEADS, MLSTM_V_DIM).astype(jnp.float32)
    ig = softcap(i_pre.astype(jnp.float32) + ib.astype(jnp.float32))
    lf = jax.nn.log_sigmoid(softcap(f_pre.astype(jnp.float32) + fb.astype(jnp.float32)))
    h = mlstm_chunkwise(qf, kf, vf, ig, lf)
    h = h * lax.rsqrt(jnp.mean(h * h, axis=-1, keepdims=True) + NORM_EPS)
    h = h.reshape(B, S, MLSTM_HEADS * MLSTM_V_DIM) * norm_g.astype(jnp.float32)
    return h.astype(o_pre.dtype) * jax.nn.sigmoid(o_pre)


def split_columns(proj):
    idx, acc = [], 0
    for sz in SPLIT_SIZES[:-1]:
        acc += sz
        idx.append(acc)
    return jnp.split(proj, idx, axis=-1)


def hybrid_layer(x, p_l, cos, sin, norm_pre, w_in, gmlp_ln_g, gmlp_ln_b, gmlp_ws, gmlp_bs,
                 attn_sinks, mlstm_ib, mlstm_fb, mlstm_norm_g, w_branch, w_out, norm_post,
                 ple_proj, ple_norm, ple_gate):
    B, S, D = x.shape
    h = rms_norm(x, norm_pre)
    proj = jnp.einsum('bsd,dn->bsn', h, w_in)
    (a_u, a_v, a_z, b_q, b_k, b_v, b_z,
     c_q, c_k, c_v, c_i, c_f, c_o, c_z, gates) = split_columns(proj)
    y_a = gmlp_branch(a_u, a_v, gmlp_ln_g, gmlp_ln_b, gmlp_ws, gmlp_bs) * jax.nn.silu(a_z)
    y_b = swa_branch(b_q, b_k, b_v, attn_sinks, cos, sin) * jax.nn.silu(b_z)
    y_c = mlstm_branch(c_q, c_k, c_v, c_i, c_f, c_o, mlstm_ib, mlstm_fb, mlstm_norm_g) * jax.nn.silu(c_z)
    ys = jnp.stack([y_a, y_b, y_c], axis=2)
    br = jnp.einsum('bsjc,jcd->bsjd', ys, w_branch)
    g = jax.nn.sigmoid(gates.reshape(B, S, N_BRANCHES, D))
    mixed = jnp.sum(g * br, axis=2)
    x = x + rms_norm(jnp.einsum('bsd,de->bse', mixed, w_out), norm_post)
    e = rms_norm(jnp.einsum('bsp,pd->bsd', p_l, ple_proj), ple_norm)
    x = x + jax.nn.sigmoid(jnp.einsum('bsd,de->bse', x, ple_gate)) * e
    return x


def setup_inputs(seed: int = 0) -> dict:
    key = jax.random.key(seed)
    ks = jax.random.split(key, 20)

    def nrm(k, shape, scale):
        return jax.random.normal(k, shape, jnp.float32) * scale

    x = nrm(ks[0], (BATCH, SEQ, D_MODEL), 1.0)
    p = nrm(ks[1], (DEPTH, BATCH, SEQ, PLE_DIM), 1.0)
    start = jax.random.randint(ks[2], (BATCH, 1), 0, 4096, dtype=jnp.int32)
    positions = start + jnp.arange(SEQ, dtype=jnp.int32)[None, :]
    norm_pre = 1.0 + nrm(ks[3], (DEPTH, D_MODEL), 0.05)
    w_in = nrm(ks[4], (DEPTH, D_MODEL, N_IN), D_MODEL ** -0.5)
    gmlp_ln_g = 1.0 + nrm(ks[5], (DEPTH, BRANCH_WIDTH), 0.05)
    gmlp_ln_b = nrm(ks[6], (DEPTH, BRANCH_WIDTH), 0.02)
    gmlp_ws = nrm(ks[7], (DEPTH, GMLP_GROUPS, GMLP_CHUNK, GMLP_CHUNK), GMLP_CHUNK ** -0.5)
    gmlp_bs = 1.0 + nrm(ks[8], (DEPTH, GMLP_GROUPS, GMLP_CHUNK), 0.05)
    attn_sinks = nrm(ks[9], (DEPTH, SWA_Q_HEADS), 0.5)
    mlstm_ib = nrm(ks[10], (DEPTH, MLSTM_HEADS), 0.1)
    mlstm_fb = jnp.linspace(3.0, 6.0, MLSTM_HEADS, dtype=jnp.float32)[None, :] + nrm(ks[11], (DEPTH, MLSTM_HEADS), 0.1)
    mlstm_norm_g = 1.0 + nrm(ks[12], (DEPTH, BRANCH_WIDTH), 0.05)
    w_branch = nrm(ks[13], (DEPTH, N_BRANCHES, BRANCH_WIDTH, D_MODEL), BRANCH_WIDTH ** -0.5)
    w_out = nrm(ks[14], (DEPTH, D_MODEL, D_MODEL), D_MODEL ** -0.5)
    norm_post = 1.0 + nrm(ks[15], (DEPTH, D_MODEL), 0.05)
    ple_proj = nrm(ks[16], (DEPTH, PLE_DIM, D_MODEL), PLE_DIM ** -0.5)
    ple_norm = 1.0 + nrm(ks[17], (DEPTH, D_MODEL), 0.05)
    ple_gate = nrm(ks[18], (DEPTH, D_MODEL, D_MODEL), D_MODEL ** -0.5)
    return {'x': x, 'p': p, 'positions': positions, 'norm_pre': norm_pre, 'w_in': w_in,
            'gmlp_ln_g': gmlp_ln_g, 'gmlp_ln_b': gmlp_ln_b, 'gmlp_ws': gmlp_ws, 'gmlp_bs': gmlp_bs,
            'attn_sinks': attn_sinks, 'mlstm_ib': mlstm_ib, 'mlstm_fb': mlstm_fb,
            'mlstm_norm_g': mlstm_norm_g, 'w_branch': w_branch, 'w_out': w_out,
            'norm_post': norm_post, 'ple_proj': ple_proj, 'ple_norm': ple_norm, 'ple_gate': ple_gate}


def reference(x, p, positions, norm_pre, w_in, gmlp_ln_g, gmlp_ln_b, gmlp_ws, gmlp_bs,
              attn_sinks, mlstm_ib, mlstm_fb, mlstm_norm_g, w_branch, w_out, norm_post,
              ple_proj, ple_norm, ple_gate):
    inv_freq = ROPE_THETA ** (-jnp.arange(0, ROT_DIM, 2, dtype=jnp.float32) / ROT_DIM)
    ang = positions.astype(jnp.float32)[..., None] * inv_freq
    cos = jnp.cos(ang)[:, :, None, :]
    sin = jnp.sin(ang)[:, :, None, :]
    for i in range(DEPTH):
        x = hybrid_layer(x, p[i], cos, sin, norm_pre[i], w_in[i], gmlp_ln_g[i], gmlp_ln_b[i],
                         gmlp_ws[i], gmlp_bs[i], attn_sinks[i], mlstm_ib[i], mlstm_fb[i],
                         mlstm_norm_g[i], w_branch[i], w_out[i], norm_post[i],
                         ple_proj[i], ple_norm[i], ple_gate[i])
    return x
```

```cpp
#include <hip/hip_runtime.h>
#include <cstdio>
#include <cstdint>

#define LAS __attribute__((address_space(3)))
#define GAS __attribute__((address_space(1)))
typedef unsigned short bf16_t;
typedef short bf16x8 __attribute__((ext_vector_type(8)));
typedef float f32x4 __attribute__((ext_vector_type(4)));
typedef float f32x2 __attribute__((ext_vector_type(2)));
typedef unsigned u32x4 __attribute__((ext_vector_type(4)));
typedef unsigned u32x2 __attribute__((ext_vector_type(2)));

constexpr int M_ROWS = 8192, SEQ = 2048, DM = 4096, BW = 2048, NLAYER = 2;
constexpr int N_IN = 31240, IF_COL = 14848;
constexpr int NT_IN = 123;
constexpr int N_IN_T = NT_IN * 256;
constexpr float NORM_EPS = 1e-6f;

__device__ __forceinline__ unsigned cvt_pk_bf16(float lo, float hi) { unsigned r; asm("v_cvt_pk_bf16_f32 %0, %1, %2" : "=v"(r) : "v"(lo), "v"(hi)); return r; }
__device__ __forceinline__ float bf_lo(unsigned w) { return __uint_as_float(w << 16); }
__device__ __forceinline__ float bf_hi(unsigned w) { return __uint_as_float(w & 0xffff0000u); }
__device__ __forceinline__ float bf1(bf16_t b) { return __uint_as_float(((unsigned)b) << 16); }
__device__ __forceinline__ float fsigmoid(float x) { return __builtin_amdgcn_rcpf(1.0f + __expf(-x)); }
__device__ __forceinline__ float wave_sum(float v) {
#pragma unroll
    for (int o = 1; o < 64; o <<= 1) v += __shfl_xor(v, o);
    return v;
}
__device__ __forceinline__ f32x2 gelu_pk(f32x2 v) {
    const f32x2 av = __builtin_elementwise_abs(v), d = av * 0.2316418882f + 1.0f;
    f32x2 t; t.x = __builtin_amdgcn_rcpf(d.x); t.y = __builtin_amdgcn_rcpf(d.y);
    f32x2 q = t * 0.5307027145f + (-0.7265760135f); q = q * t + 0.7107068705f; q = q * t + (-0.142248368f); q = q * t + 0.127414796f; q = q * t;
    const f32x2 s = (v * v) * (-0.72134752044f);
    f32x2 e; e.x = __builtin_amdgcn_exp2f(s.x); e.y = __builtin_amdgcn_exp2f(s.y);
    const f32x2 m = v * (q * e), r = v - m;
    f32x2 o; o.x = v.x < 0.f ? m.x : r.x; o.y = v.y < 0.f ? m.y : r.y; return o;
}
#define LAUNDER_V(x) asm volatile("" : "+v"(x))
#define LAUNDER_S(x) asm volatile("" : "+s"(x))
#define LDS_WAIT() asm volatile("s_waitcnt lgkmcnt(0)" ::: "memory")
#define VM_WAIT() asm volatile("s_waitcnt vmcnt(0)" ::: "memory")
#define MFMA16(a, b, c) __builtin_amdgcn_mfma_f32_16x16x32_bf16((a), (b), (c), 0, 0, 0)

#define XB_TMO      128
#define XB_XCNT(j)  (256  + 64 * (j))
#define XB_XSUB(j)  (1280 + 64 * (j))
#define XB_XGEN(j)  (2304 + 64 * (j))
#define XB_TOP      3328
#define XB_TOPGEN   3392
#define XCD_BAR_WORDS 3456
#define XB_SPIN_CAP (1u << 18)
__device__ __forceinline__ unsigned xb_ld(unsigned* p)              { return __hip_atomic_load(p, __ATOMIC_RELAXED, __HIP_MEMORY_SCOPE_AGENT); }
__device__ __forceinline__ unsigned xb_add(unsigned* p, unsigned v) { return __hip_atomic_fetch_add(p, v, __ATOMIC_RELAXED, __HIP_MEMORY_SCOPE_AGENT); }
__device__ __forceinline__ unsigned xb_xcc_id() { return (unsigned)__builtin_amdgcn_s_getreg((3 << 11) | 20) & 0xFu; }
#define XB_SPIN(cond, bar) do { unsigned _sp = 0; while (cond) { __builtin_amdgcn_s_sleep(1); \
    if ((++_sp & 255u) == 0u) { if (xb_ld(&(bar)[XB_TMO])) break; if (_sp > XB_SPIN_CAP) { atomicAdd(&(bar)[XB_TMO], 1u); break; } } } } while (0)
struct XcdBarrier { unsigned* bar; unsigned x; volatile LAS unsigned* st; };
__device__ __forceinline__ XcdBarrier xcd_barrier_post(unsigned* bar, volatile LAS unsigned* st) {
    XcdBarrier b; b.bar = bar; b.x = xb_xcc_id(); b.st = st;
    if (threadIdx.x == 0) (void)xb_add(&bar[XB_XCNT(b.x)], 1u);
    return b;
}
__device__ __forceinline__ void xcd_barrier_complete(unsigned* bar, unsigned x, unsigned& nloc, unsigned& nx) {
    const unsigned G = gridDim.x * gridDim.y * gridDim.z;
    unsigned sum, cnt, mine, sp = 0u;
    for (;;) {
        sum = 0u; cnt = 0u; mine = 0u;
#pragma unroll
        for (unsigned j = 0; j < 16; ++j) { const unsigned c = xb_ld(&bar[XB_XCNT(j)]); sum += c; cnt += (c > 0u) ? 1u : 0u; mine = (j == x) ? c : mine; }
        if (sum == G) break;
        __builtin_amdgcn_s_sleep(1);
        if ((++sp & 255u) == 0u) { if (xb_ld(&bar[XB_TMO])) break; if (sp > XB_SPIN_CAP) { atomicAdd(&bar[XB_TMO], 1u); break; } }
    }
    nloc = mine > 0u ? mine : 1u; nx = cnt > 0u ? cnt : 1u;
}
__device__ __forceinline__ void xcd_barrier(const XcdBarrier& b) {
    asm volatile("s_waitcnt vmcnt(0)" ::: "memory");
    __syncthreads();
    if (threadIdx.x == 0) {
        unsigned* bar = b.bar;
        __builtin_amdgcn_s_waitcnt(0);
        unsigned nloc = b.st[0], nx = b.st[1];
        if (nloc == 0u) { xcd_barrier_complete(bar, b.x, nloc, nx); b.st[0] = nloc; b.st[1] = nx; }
        const unsigned old = xb_add(&bar[XB_XSUB(b.x)], 1u);
        const unsigned gen = old / nloc;
        if (old + 1u == (gen + 1u) * nloc) {
            __builtin_amdgcn_fence(__ATOMIC_RELEASE, "agent");
            asm volatile("s_waitcnt vmcnt(0)" ::: "memory");
            const unsigned og = xb_add(&bar[XB_TOP], 1u);
            const unsigned tg = og / nx;
            if (og + 1u == (tg + 1u) * nx) xb_add(&bar[XB_TOPGEN], 1u);
            else XB_SPIN(xb_ld(&bar[XB_TOPGEN]) == tg, bar);
            __builtin_amdgcn_fence(__ATOMIC_ACQUIRE, "agent");
            xb_add(&bar[XB_XGEN(b.x)], 1u);
            asm volatile("s_waitcnt vmcnt(0)" ::: "memory");
        } else {
            XB_SPIN(xb_ld(&bar[XB_XGEN(b.x)]) == gen, bar);
            __builtin_amdgcn_fence(__ATOMIC_ACQUIRE, "agent");
            asm volatile("s_waitcnt vmcnt(0)" ::: "memory");
        }
    }
    __syncthreads();
}

namespace pg8 {
constexpr int BM = 256, BK = 64, HALF = 128, HTB = HALF * BK * 2, STAGE_BYTES = 8 * HTB, NXCD = 8, WGM = 8;
__host__ __device__ __forceinline__ int lds_byte(int r, int c) { const int st = (r >> 4) * 2 + (c >> 5), rr = r & 15, cc = c & 31, ob = rr * 64 + cc * 2; return st * 1024 + (ob ^ (((ob >> 9) & 1) << 5)); }
__host__ __device__ __forceinline__ void stage_rc(int b, int& R, int& C) { const int st = b / 1024, sb = b % 1024, swz = sb ^ (((sb >> 9) & 1) << 5); R = (st >> 1) * 16 + swz / 64; C = (st & 1) * 32 + (swz % 64) / 2; }
__host__ __device__ __forceinline__ int perm32(int rho) { const int n = rho >> 4, i = rho & 15; return 8 * (i >> 2) + 4 * n + (i & 3); }

struct Unit { int pm, pn, seg; };

struct TileOrder {
    int nM, nN, nwg, G, c;
    __device__ __forceinline__ void init(int nM_, int nN_, int G_, int c_) { nM = nM_; nN = nN_; nwg = nM * nN; G = G_; c = c_; }
    __device__ __forceinline__ bool tile(int i, int& pm, int& pn) const {
        const long L = (long)i * G + c; if (L >= nwg) return false;
        int wgid = (int)L; { const int q = nwg / NXCD, r = nwg % NXCD, xcd = wgid % NXCD, off = wgid / NXCD; wgid = (xcd < r ? xcd * (q + 1) : r * (q + 1) + (xcd - r) * q) + off; }
        const int nig = WGM * nN, gid = wgid / nig, fm = gid * WGM, gsz = (nM - fm) < WGM ? (nM - fm) : WGM;
        pm = fm + ((wgid % nig) % gsz); pn = (wgid % nig) / gsz; return true;
    }
};
struct SchedPlain {
    TileOrder T; const char* A; const char* B; size_t astep, bstep;
    __device__ __forceinline__ bool next(int i, Unit& u) const { u.seg = 0; return T.tile(i, u.pm, u.pn); }
    __device__ __forceinline__ const char* a_ptr(const Unit& u) const { return A + (size_t)u.pm * astep; }
    __device__ __forceinline__ const char* b_ptr(const Unit& u) const { return B + (size_t)u.pn * bstep; }
};
struct SchedBranch {
    TileOrder T; const char* A; const char* B; size_t astep, bstep, aseg, bseg;
    __device__ __forceinline__ bool next(int i, Unit& u) const { const int t = i / 3; u.seg = i - 3 * t; return T.tile(t, u.pm, u.pn); }
    __device__ __forceinline__ const char* a_ptr(const Unit& u) const { return A + (size_t)u.seg * aseg + (size_t)u.pm * astep; }
    __device__ __forceinline__ const char* b_ptr(const Unit& u) const { return B + (size_t)u.seg * bseg + (size_t)u.pn * bstep; }
};

template <class Epi, class Sched>
__device__ __forceinline__ void gemm_phase(LAS unsigned char* lds, const int K, const int lda, const int ldb, const Sched& S, const Epi& E) {
    int tid = threadIdx.x; LAUNDER_V(tid);
    const int wid = __builtin_amdgcn_readfirstlane(tid >> 6), lane = tid & 63, wr = wid >> 2, wc = wid & 3, fr = lane & 15, fq = lane >> 4;
    const int nt = K / BK;
    unsigned voffA[2], voffB[2];
#pragma unroll
    for (int i = 0; i < 2; ++i) { int R, C; stage_rc(tid * 16 + i * 8192, R, C); const int Rb = Epi::PERM ? ((R & ~31) + perm32(R & 31)) : R;
        voffA[i] = (unsigned)(R * lda + C) * 2u; voffB[i] = (unsigned)(Rb * ldb + C) * 2u; }
    const size_t kstep = (size_t)(BK * 2);
    const size_t hstepA = (size_t)HALF * lda * 2, hstepB = (size_t)HALF * ldb * 2;
    const unsigned ldsw = (unsigned)wid * 1024u;
    const int aoff = lds_byte(wr * 64 + fr, fq * 8), boff = lds_byte(wc * 32 + fr, fq * 8);
#define PG8_SA(b, h) (((b) * 2 + (h)) * HTB)
#define PG8_SB(b, h) ((4 + (b) * 2 + (h)) * HTB)
#define PG8_STAGE(bufoff, gbase, voff) do { _Pragma("unroll") for (int _i = 0; _i < 2; ++_i) \
        __builtin_amdgcn_global_load_lds((const unsigned*)((const char*)(gbase) + (voff)[_i]), (LAS unsigned*)(lds + (bufoff) + ldsw + _i * 8192), 16, 0, 0); } while (0)
#define PG8_LDA(dst, b, h) do { _Pragma("unroll") for (int m = 0; m < 4; ++m) _Pragma("unroll") for (int k = 0; k < 2; ++k) dst[m][k] = *(const LAS bf16x8*)(lds + PG8_SA(b, h) + aoff + m * 2048 + k * 1024); } while (0)
#define PG8_LDB(dst, b, h) do { _Pragma("unroll") for (int n = 0; n < 2; ++n) _Pragma("unroll") for (int k = 0; k < 2; ++k) dst[n][k] = *(const LAS bf16x8*)(lds + PG8_SB(b, h) + boff + n * 2048 + k * 1024); } while (0)
#define PG8_MMA(ai, bj, At, Bt) do { __builtin_amdgcn_s_setprio(1); _Pragma("unroll") for (int m = 0; m < 4; ++m) _Pragma("unroll") for (int n = 0; n < 2; ++n) _Pragma("unroll") for (int k = 0; k < 2; ++k) \
        acc[ai][bj][m][n] = __builtin_amdgcn_mfma_f32_16x16x32_bf16(Bt[n][k], At[m][k], acc[ai][bj][m][n], 0, 0, 0); __builtin_amdgcn_s_setprio(0); } while (0)
#define PG8_WAIT_V(n) asm volatile("s_waitcnt vmcnt(" #n ")" ::: "memory")
#define PG8_WAIT_L(n) asm volatile("s_waitcnt lgkmcnt(" #n ")" ::: "memory")
#define PG8_BAR __builtin_amdgcn_s_barrier()
#define PG8_SCHED __builtin_amdgcn_sched_barrier(0)
    Unit cur, nxt; int ui = 0;
    if (!S.next(0, cur)) return;
    f32x4 acc[2][2][4][2];
#pragma unroll
    for (int a = 0; a < 2; ++a)
#pragma unroll
        for (int b = 0; b < 2; ++b)
#pragma unroll
            for (int m = 0; m < 4; ++m)
#pragma unroll
                for (int n = 0; n < 2; ++n) acc[a][b][m][n] = (f32x4){0.f, 0.f, 0.f, 0.f};
    bf16x8 At[4][2], B0[2][2], B1[2][2];
    const char* cA = S.a_ptr(cur); const char* cB = S.b_ptr(cur);
    PG8_STAGE(PG8_SB(0, 0), cB, voffB); PG8_STAGE(PG8_SB(0, 1), cB + hstepB, voffB); PG8_STAGE(PG8_SA(0, 0), cA, voffA); PG8_STAGE(PG8_SA(0, 1), cA + hstepA, voffA);
    if (wr == 1) PG8_BAR;
    PG8_WAIT_V(2); PG8_BAR;
    PG8_STAGE(PG8_SB(1, 0), cB + kstep, voffB); PG8_STAGE(PG8_SA(1, 0), cA + kstep, voffA); PG8_STAGE(PG8_SB(1, 1), cB + hstepB + kstep, voffB);
    PG8_WAIT_V(6); PG8_BAR;
    for (;;) {
        const bool has_next = S.next(ui + 1, nxt);
        const char* nA = has_next ? S.a_ptr(nxt) : cA; const char* nB = has_next ? S.b_ptr(nxt) : cB;
        for (int t = 0; t < nt; t += 2) {
            const bool last = (t == nt - 2);
            const char* a1 = cA + (size_t)(t + 1) * kstep;
            const char* a2 = last ? nA : cA + (size_t)(t + 2) * kstep; const char* b2 = last ? nB : cB + (size_t)(t + 2) * kstep;
            const char* a3 = a2 + kstep; const char* b3 = b2 + kstep;
            PG8_LDB(B0, 0, 0); PG8_LDB(B1, 0, 1); PG8_SCHED; PG8_LDA(At, 0, 0); PG8_STAGE(PG8_SA(1, 1), a1 + hstepA, voffA);
            PG8_WAIT_V(8); PG8_WAIT_L(0); PG8_BAR; PG8_MMA(0, 0, At, B0); PG8_MMA(0, 1, At, B1); PG8_BAR; PG8_SCHED;
            PG8_LDA(At, 0, 1); PG8_STAGE(PG8_SB(0, 0), b2, voffB); PG8_STAGE(PG8_SB(0, 1), b2 + hstepB, voffB); PG8_STAGE(PG8_SA(0, 0), a2, voffA);
            PG8_WAIT_V(8); PG8_WAIT_L(0); PG8_BAR; PG8_MMA(1, 0, At, B0); PG8_MMA(1, 1, At, B1); PG8_BAR; PG8_SCHED;
            PG8_LDB(B0, 1, 0); PG8_LDB(B1, 1, 1); PG8_SCHED; PG8_LDA(At, 1, 0); PG8_STAGE(PG8_SA(0, 1), a2 + hstepA, voffA);
            PG8_WAIT_V(8); PG8_WAIT_L(0); PG8_BAR; PG8_MMA(0, 0, At, B0); PG8_MMA(0, 1, At, B1); PG8_BAR; PG8_SCHED;
            PG8_LDA(At, 1, 1); PG8_STAGE(PG8_SB(1, 0), b3, voffB); PG8_STAGE(PG8_SB(1, 1), b3 + hstepB, voffB); PG8_STAGE(PG8_SA(1, 0), a3, voffA);
            PG8_WAIT_V(8); PG8_WAIT_L(0); PG8_BAR; PG8_MMA(1, 0, At, B0); PG8_MMA(1, 1, At, B1); PG8_BAR; PG8_SCHED;
        }
        if (wr == 0) PG8_BAR;
        E(acc, cur, wr, wc, fr, fq);
        if (!has_next) break;
        if (!E.keep(cur)) {
#pragma unroll
            for (int a = 0; a < 2; ++a)
#pragma unroll
                for (int b = 0; b < 2; ++b)
#pragma unroll
                    for (int m = 0; m < 4; ++m)
#pragma unroll
                        for (int n = 0; n < 2; ++n) acc[a][b][m][n] = (f32x4){0.f, 0.f, 0.f, 0.f};
        }
        cur = nxt; cA = nA; cB = nB; ++ui;
        if (wr == 1) PG8_BAR;
    }
    PG8_WAIT_V(0);
    PG8_BAR;
#undef PG8_SA
#undef PG8_SB
#undef PG8_STAGE
#undef PG8_LDA
#undef PG8_LDB
#undef PG8_MMA
#undef PG8_WAIT_V
#undef PG8_WAIT_L
#undef PG8_BAR
#undef PG8_SCHED
}
}

constexpr size_t MiB = 1u << 20;
constexpr size_t WS_CTL = 0, CTL_ZERO_BYTES = 1 * MiB;
constexpr int CW_BAR = 4096;
constexpr size_t CTL_SSQ1 = 256 * 1024;
constexpr size_t SZ_WIN = (size_t)N_IN_T * DM * 2, SZ_WBR = (size_t)3 * DM * BW * 2, SZ_WSQ = (size_t)DM * DM * 2, SZ_WPP = (size_t)DM * 256 * 2;
constexpr size_t WS_WIN = 2 * MiB;
constexpr size_t WS_WBR = WS_WIN + 2 * SZ_WIN;
constexpr size_t WS_WOUT = WS_WBR + 2 * SZ_WBR;
constexpr size_t WS_WPG = WS_WOUT + 2 * SZ_WSQ;
constexpr size_t WS_WPP = WS_WPG + 2 * SZ_WSQ;
constexpr size_t SZ_ROWS_BW = (size_t)M_ROWS * BW * 2, SZ_ROWS_D = (size_t)M_ROWS * DM * 2;
constexpr size_t WS_XB = WS_WPP + 2 * SZ_WPP;
constexpr size_t WS_PB = WS_XB + SZ_ROWS_D;
constexpr size_t WS_CS = WS_PB + (size_t)2 * M_ROWS * 256 * 2;
constexpr size_t WS_SSQ0 = WS_CS + (size_t)M_ROWS * 16 * 4;
constexpr size_t WS_AU = WS_SSQ0 + (size_t)M_ROWS * 4;
constexpr size_t WS_AV = WS_AU + SZ_ROWS_BW, WS_AZ = WS_AV + SZ_ROWS_BW, WS_BQ = WS_AZ + SZ_ROWS_BW;
constexpr size_t WS_BK = WS_BQ + SZ_ROWS_BW;
constexpr size_t WS_BV = WS_BK + (size_t)M_ROWS * 256 * 2;
constexpr size_t WS_BZ = WS_BV + (size_t)M_ROWS * 256 * 2;
constexpr size_t WS_CQ = WS_BZ + SZ_ROWS_BW;
constexpr size_t WS_CK = WS_CQ + (size_t)M_ROWS * 1024 * 2;
constexpr size_t WS_CV = WS_CK + (size_t)M_ROWS * 1024 * 2;
constexpr size_t WS_CO = WS_CV + SZ_ROWS_BW, WS_CZ = WS_CO + SZ_ROWS_BW;
constexpr size_t WS_G = WS_CZ + SZ_ROWS_BW;
constexpr size_t WS_IF = WS_G + (size_t)M_ROWS * 12288 * 2;
constexpr size_t WS_LNP = WS_IF + (size_t)M_ROWS * 8 * 4;
constexpr size_t WS_YA = WS_LNP + (size_t)M_ROWS * 32 * 8;
constexpr size_t WS_NUM = WS_YA + 3 * SZ_ROWS_BW;
constexpr size_t WS_SSQC = WS_NUM + SZ_ROWS_BW;
constexpr size_t WS_DN = WS_SSQC + (size_t)M_ROWS * 64 * 4;
constexpr size_t WS_MIX = WS_DN + (size_t)M_ROWS * 4 * 4;
constexpr size_t WS_OUT = WS_MIX + SZ_ROWS_D;
constexpr size_t WS_OUTP = WS_OUT + SZ_ROWS_D;
constexpr size_t WS_ERAW = WS_OUTP + (size_t)M_ROWS * 64 * 4;
constexpr size_t WS_ERP = WS_ERAW + SZ_ROWS_D;
constexpr size_t WS_RSO = WS_ERP + (size_t)M_ROWS * 64 * 4;
constexpr size_t WS_RSE = WS_RSO + (size_t)M_ROWS * 4;
constexpr size_t WS_X1B = WS_RSE + (size_t)M_ROWS * 4;
constexpr size_t WS_END = WS_X1B + SZ_ROWS_D;
static_assert(WS_WIN % 256 == 0 && WS_XB % 256 == 0 && WS_AU % 256 == 0 && WS_G % 256 == 0 && WS_YA % 256 == 0 && WS_MIX % 256 == 0 && WS_X1B % 256 == 0, "alignment");

namespace pg8 {
struct EpiIn {
    static constexpr bool PERM = true;
    const float* ssq; unsigned char* ws;
    __device__ __forceinline__ bool keep(const Unit&) const { return false; }
    __device__ __forceinline__ void operator()(f32x4 (&acc)[2][2][4][2], const Unit& u, int wr, int wc, int fr, int fq) const {
        const int pn = u.pn; const int row0 = u.pm * BM + wr * 64 + fr;
        size_t off; int ldc, t0, act; float sc = 1.f;
        if (pn < 8)        { off = WS_AU; ldc = 2048; t0 = 0; act = 1; }
        else if (pn < 16)  { off = WS_AV; ldc = 2048; t0 = 8; act = 5; }
        else if (pn < 24)  { off = WS_AZ; ldc = 2048; t0 = 16; act = 2; }
        else if (pn < 32)  { off = WS_BQ; ldc = 2048; t0 = 24; act = 0; }
        else if (pn < 33)  { off = WS_BK; ldc = 256; t0 = 32; act = 0; }
        else if (pn < 34)  { off = WS_BV; ldc = 256; t0 = 33; act = 0; }
        else if (pn < 42)  { off = WS_BZ; ldc = 2048; t0 = 34; act = 2; }
        else if (pn < 46)  { off = WS_CQ; ldc = 1024; t0 = 42; act = 0; sc = 0.0625f; }
        else if (pn < 50)  { off = WS_CK; ldc = 1024; t0 = 46; act = 0; }
        else if (pn < 58)  { off = WS_CV; ldc = 2048; t0 = 50; act = 0; }
        else if (pn < 66)  { off = WS_CO; ldc = 2048; t0 = 58; act = 3; }
        else if (pn < 74)  { off = WS_CZ; ldc = 2048; t0 = 66; act = 2; }
        else if (pn < 122) { off = WS_G; ldc = 12288; t0 = 74; act = 3; }
        else               { off = WS_IF; ldc = 8; t0 = 122; act = 4; }
        const int col0 = (pn - t0) * BM + wc * 32 + 8 * fq;
        if (act == 4) {
            if (wc == 0 && fq == 0) {
                float* dst = (float*)(ws + off);
#pragma unroll
                for (int ai = 0; ai < 2; ++ai)
#pragma unroll
                    for (int m = 0; m < 4; ++m) { const int row = row0 + ai * HALF + m * 16; const float rs = rsqrtf(ssq[row] * (1.0f / DM) + NORM_EPS);
                        *(f32x4*)(dst + (size_t)row * 8) = acc[ai][0][m][0] * rs; *(f32x4*)(dst + (size_t)row * 8 + 4) = acc[ai][0][m][1] * rs; }
            }
            return;
        }
        bf16_t* base = (bf16_t*)(ws + off);
#pragma unroll
        for (int ai = 0; ai < 2; ++ai)
#pragma unroll
            for (int m = 0; m < 4; ++m) {
                const int row = row0 + ai * HALF + m * 16; const float rs = rsqrtf(ssq[row] * (1.0f / DM) + NORM_EPS) * sc;
                bf16_t* rowp = base + (size_t)row * ldc + col0; float ls = 0.f, lq = 0.f;
#pragma unroll
                for (int bj = 0; bj < 2; ++bj) {
                    f32x4 v0 = acc[ai][bj][m][0] * rs, v1 = acc[ai][bj][m][1] * rs;
                    if (act == 1 || act == 5) {
                        f32x2 a = gelu_pk((f32x2){v0[0], v0[1]}), b = gelu_pk((f32x2){v0[2], v0[3]}), c = gelu_pk((f32x2){v1[0], v1[1]}), d = gelu_pk((f32x2){v1[2], v1[3]});
                        v0 = (f32x4){a.x, a.y, b.x, b.y}; v1 = (f32x4){c.x, c.y, d.x, d.y};
                        if (act == 5) { ls += (v0[0] + v0[1]) + (v0[2] + v0[3]) + (v1[0] + v1[1]) + (v1[2] + v1[3]);
                            lq += (v0[0] * v0[0] + v0[1] * v0[1]) + (v0[2] * v0[2] + v0[3] * v0[3]) + (v1[0] * v1[0] + v1[1] * v1[1]) + (v1[2] * v1[2] + v1[3] * v1[3]); }
                    } else if (act == 2) {
#pragma unroll
                        for (int j = 0; j < 4; ++j) { v0[j] = v0[j] * fsigmoid(v0[j]); v1[j] = v1[j] * fsigmoid(v1[j]); }
                    } else if (act == 3) {
#pragma unroll
                        for (int j = 0; j < 4; ++j) { v0[j] = fsigmoid(v0[j]); v1[j] = fsigmoid(v1[j]); }
                    }
                    u32x4 w; w.x = cvt_pk_bf16(v0[0], v0[1]); w.y = cvt_pk_bf16(v0[2], v0[3]); w.z = cvt_pk_bf16(v1[0], v1[1]); w.w = cvt_pk_bf16(v1[2], v1[3]);
                    *(u32x4*)(rowp + bj * HALF) = w;
                }
                if (act == 5) {
                    ls += __shfl_xor(ls, 16); ls += __shfl_xor(ls, 32); lq += __shfl_xor(lq, 16); lq += __shfl_xor(lq, 32);
                    if (fq == 0) *(f32x2*)(ws + WS_LNP + ((size_t)row * 32 + (pn - 8) * 4 + wc) * 8) = (f32x2){ls, lq};
                }
            }
    }
};
struct EpiBranch {
    static constexpr bool PERM = true;
    const bf16_t* G; bf16_t* MIX;
    __device__ __forceinline__ bool keep(const Unit& u) const { return u.seg != 2; }
    __device__ __forceinline__ void operator()(f32x4 (&acc)[2][2][4][2], const Unit& u, int wr, int wc, int fr, int fq) const {
        const int row0 = u.pm * BM + wr * 64 + fr, col0 = u.pn * BM + wc * 32 + 8 * fq; const int seg = u.seg;
#pragma unroll
        for (int ai = 0; ai < 2; ++ai)
#pragma unroll
            for (int m = 0; m < 4; ++m) {
                const int row = row0 + ai * HALF + m * 16; const bf16_t* gp = G + (size_t)row * 12288 + seg * DM + col0;
#pragma unroll
                for (int bj = 0; bj < 2; ++bj) {
                    const u32x4 ga = *(const u32x4*)(gp + bj * HALF);
                    float f[8] = {bf_lo(ga.x), bf_hi(ga.x), bf_lo(ga.y), bf_hi(ga.y), bf_lo(ga.z), bf_hi(ga.z), bf_lo(ga.w), bf_hi(ga.w)};
#pragma unroll
                    for (int j = 0; j < 8; ++j) f[j] = fmaxf(f[j], 1e-20f);
                    if (seg != 2) {
                        const u32x4 gb = *(const u32x4*)(gp + DM + bj * HALF);
                        const float h[8] = {bf_lo(gb.x), bf_hi(gb.x), bf_lo(gb.y), bf_hi(gb.y), bf_lo(gb.z), bf_hi(gb.z), bf_lo(gb.w), bf_hi(gb.w)};
#pragma unroll
                        for (int j = 0; j < 8; ++j) f[j] = f[j] * __builtin_amdgcn_rcpf(fmaxf(h[j], 1e-20f));
                    }
                    f32x4 v0 = acc[ai][bj][m][0], v1 = acc[ai][bj][m][1];
                    v0 = v0 * (f32x4){f[0], f[1], f[2], f[3]}; v1 = v1 * (f32x4){f[4], f[5], f[6], f[7]};
                    if (seg != 2) { acc[ai][bj][m][0] = v0; acc[ai][bj][m][1] = v1; }
                    else { u32x4 w; w.x = cvt_pk_bf16(v0[0], v0[1]); w.y = cvt_pk_bf16(v0[2], v0[3]); w.z = cvt_pk_bf16(v1[0], v1[1]); w.w = cvt_pk_bf16(v1[2], v1[3]);
                        *(u32x4*)(MIX + (size_t)row * DM + col0 + bj * HALF) = w; }
                }
                asm volatile("" ::: "memory");
            }
    }
};
struct EpiSq {
    static constexpr bool PERM = true;
    bf16_t* O; float* P;
    __device__ __forceinline__ bool keep(const Unit&) const { return false; }
    __device__ __forceinline__ void operator()(f32x4 (&acc)[2][2][4][2], const Unit& u, int wr, int wc, int fr, int fq) const {
        const int row0 = u.pm * BM + wr * 64 + fr, col0 = u.pn * BM + wc * 32 + 8 * fq;
#pragma unroll
        for (int ai = 0; ai < 2; ++ai)
#pragma unroll
            for (int m = 0; m < 4; ++m) {
                const int row = row0 + ai * HALF + m * 16; float q = 0.f;
#pragma unroll
                for (int bj = 0; bj < 2; ++bj) {
                    const f32x4 v0 = acc[ai][bj][m][0], v1 = acc[ai][bj][m][1];
                    q += (v0[0] * v0[0] + v0[1] * v0[1]) + (v0[2] * v0[2] + v0[3] * v0[3]) + (v1[0] * v1[0] + v1[1] * v1[1]) + (v1[2] * v1[2] + v1[3] * v1[3]);
                    u32x4 w; w.x = cvt_pk_bf16(v0[0], v0[1]); w.y = cvt_pk_bf16(v0[2], v0[3]); w.z = cvt_pk_bf16(v1[0], v1[1]); w.w = cvt_pk_bf16(v1[2], v1[3]);
                    *(u32x4*)(O + (size_t)row * DM + col0 + bj * HALF) = w;
                }
                q += __shfl_xor(q, 16); q += __shfl_xor(q, 32);
                if (fq == 0) P[(size_t)row * 64 + u.pn * 4 + wc] = q;
            }
    }
};
struct EpiPle {
    static constexpr bool PERM = false;
    const float* XIN; float* XOUT; bf16_t* XB; const bf16_t* OUT; const bf16_t* ERAW; const float* RSO; const float* RSE; const float* npost; const float* pnorm; float* SSQN; int last;
    __device__ __forceinline__ bool keep(const Unit&) const { return false; }
    __device__ __forceinline__ void operator()(f32x4 (&acc)[2][2][4][2], const Unit& u, int wr, int wc, int fr, int fq) const {
        const int row0 = u.pm * BM + wr * 64 + fr, col0 = u.pn * BM + wc * 32 + 4 * fq;
#pragma unroll
        for (int ai = 0; ai < 2; ++ai)
#pragma unroll
            for (int m = 0; m < 4; ++m) {
                const int row = row0 + ai * HALF + m * 16; const float rso = RSO[row], rse = RSE[row]; float q = 0.f; const size_t ro = (size_t)row * DM;
#pragma unroll
                for (int bj = 0; bj < 2; ++bj)
#pragma unroll
                    for (int n = 0; n < 2; ++n) {
                        const int col = col0 + bj * HALF + n * 16;
                        const f32x4 x = *(const f32x4*)(XIN + ro + col); const u32x2 ob = *(const u32x2*)(OUT + ro + col), eb = *(const u32x2*)(ERAW + ro + col);
                        const f32x4 np = *(const f32x4*)(npost + col), pn = *(const f32x4*)(pnorm + col);
                        const f32x4 o = {bf_lo(ob.x), bf_hi(ob.x), bf_lo(ob.y), bf_hi(ob.y)}, e = {bf_lo(eb.x), bf_hi(eb.x), bf_lo(eb.y), bf_hi(eb.y)};
                        const f32x4 a = acc[ai][bj][m][n]; f32x4 r;
#pragma unroll
                        for (int j = 0; j < 4; ++j) { const float x1 = x[j] + o[j] * rso * np[j]; r[j] = x1 + fsigmoid(a[j]) * (e[j] * rse * pn[j]); q += r[j] * r[j]; }
                        *(f32x4*)(XOUT + ro + col) = r;
                        if (!last) { u32x2 w; w.x = cvt_pk_bf16(r[0], r[1]); w.y = cvt_pk_bf16(r[2], r[3]); *(u32x2*)(XB + ro + col) = w; }
                    }
                if (!last) { q += __shfl_xor(q, 16); q += __shfl_xor(q, 32); if (fq == 0) atomicAdd(SSQN + row, q); }
                asm volatile("" ::: "memory");
            }
    }
};
}

constexpr int LDS_BYTES = 147456;
constexpr int MISC_OFF = LDS_BYTES - 128;
constexpr int ARGS_OFF = LDS_BYTES - 512;
constexpr int NWAVES = 8, NTHREADS = 512;

struct Ctx {
    LAS unsigned char* lds; int tid, lane, wave, vcu, G;
};

struct TrTile { const float* W; const float* kscale; bf16_t* WT; int ldw, K; };
constexpr int TR_PER_LAYER = 7808 + 1536 + 1024 + 1024 + 64;
__device__ __forceinline__ TrTile tr_decode(int it, const float* w_in, const float* norm_pre, const float* w_branch, const float* w_out, const float* ple_gate, const float* ple_proj, unsigned char* ws) {
    const int l = it / TR_PER_LAYER; int r = it - l * TR_PER_LAYER; TrTile t; int kt, ntile;
    if (r < 7808) { kt = r / 244; ntile = r - kt * 244; const int src = ntile < 116 ? ntile * 128 : ntile * 128 + 8;
        t.ldw = N_IN; t.K = DM; t.W = w_in + (size_t)l * DM * N_IN + (size_t)kt * 128 * N_IN + src; t.kscale = norm_pre + l * DM + kt * 128;
        t.WT = (bf16_t*)(ws + WS_WIN + (size_t)l * SZ_WIN) + (size_t)ntile * 128 * DM + kt * 128; return t; }
    r -= 7808; t.kscale = nullptr; t.ldw = DM;
    if (r < 1536) { const int j = r / 512; const int rr = r - j * 512; kt = rr / 32; ntile = rr - kt * 32; t.K = BW;
        t.W = w_branch + ((size_t)(l * 3 + j) * BW + (size_t)kt * 128) * DM + ntile * 128;
        t.WT = (bf16_t*)(ws + WS_WBR + (size_t)l * SZ_WBR) + (size_t)j * DM * BW + (size_t)ntile * 128 * BW + kt * 128; return t; }
    r -= 1536;
    if (r < 2048) { const int which = r / 1024; const int rr = r - which * 1024; kt = rr / 32; ntile = rr - kt * 32; t.K = DM;
        t.W = (which ? ple_gate : w_out) + ((size_t)l * DM + (size_t)kt * 128) * DM + ntile * 128;
        t.WT = (bf16_t*)(ws + (which ? WS_WPG : WS_WOUT) + (size_t)l * SZ_WSQ) + (size_t)ntile * 128 * DM + kt * 128; return t; }
    r -= 2048; kt = r / 32; ntile = r - kt * 32; t.K = 256;
    t.W = ple_proj + ((size_t)l * 256 + (size_t)kt * 128) * DM + ntile * 128;
    t.WT = (bf16_t*)(ws + WS_WPP + (size_t)l * SZ_WPP) + (size_t)ntile * 128 * 256 + kt * 128; return t;
}
__device__ __forceinline__ void p0_prologue(const Ctx& F, const float* x, const float* p, const int* positions, const float* norm_pre, const float* w_in, const float* w_branch,
                                            const float* w_out, const float* ple_gate, const float* ple_proj, unsigned char* ws) {
    int tid = F.tid; LAUNDER_V(tid);
    {
        constexpr int NIT = NLAYER * TR_PER_LAYER, RS = 264;
        int it = F.vcu; bool have = it < NIT; TrTile cur; f32x4 v[8]; float ks[8];
        const int c4 = tid & 31, kr = tid >> 5;
        if (have) { cur = tr_decode(it, w_in, norm_pre, w_branch, w_out, ple_gate, ple_proj, ws);
#pragma unroll
            for (int i = 0; i < 8; ++i) { v[i] = *(const f32x4*)(cur.W + (size_t)(i * 16 + kr) * cur.ldw + 4 * c4); ks[i] = cur.kscale ? cur.kscale[i * 16 + kr] : 1.0f; } }
        while (have) {
#pragma unroll
            for (int i = 0; i < 8; ++i) { const f32x4 a = v[i] * ks[i]; u32x2 w; w.x = cvt_pk_bf16(a[0], a[1]); w.y = cvt_pk_bf16(a[2], a[3]);
                *(LAS u32x2*)(F.lds + (i * 16 + kr) * RS + c4 * 8) = w; }
            __syncthreads();
            const int nx = it + F.G; const bool hn = nx < NIT; TrTile nt = cur;
            if (hn) { nt = tr_decode(nx, w_in, norm_pre, w_branch, w_out, ple_gate, ple_proj, ws);
#pragma unroll
                for (int i = 0; i < 8; ++i) { v[i] = *(const f32x4*)(nt.W + (size_t)(i * 16 + kr) * nt.ldw + 4 * c4); ks[i] = nt.kscale ? nt.kscale[i * 16 + kr] : 1.0f; } }
            const int kc = tid & 15;
#pragma unroll
            for (int q = 0; q < 4; ++q) { const int n = 32 * q + (tid >> 4); const LAS bf16_t* s = (const LAS bf16_t*)(F.lds + (8 * kc) * RS + 2 * n);
                unsigned e[8];
#pragma unroll
                for (int j = 0; j < 8; ++j) e[j] = s[j * (RS / 2)];
                u32x4 o; o.x = e[0] | (e[1] << 16); o.y = e[2] | (e[3] << 16); o.z = e[4] | (e[5] << 16); o.w = e[6] | (e[7] << 16);
                *(u32x4*)(cur.WT + (size_t)n * cur.K + 8 * kc) = o; }
            __syncthreads();
            cur = nt; it = nx; have = hn;
        }
    }
    const int gt = F.vcu * NTHREADS + tid, NGT = F.G * NTHREADS;
    for (int i = gt; i < NLAYER * 256 * DM; i += NGT) { const int l = i / (256 * DM), rr = (i / DM) & 255, k = i & (DM - 1);
        float val = 0.f; if (rr < 8) val = w_in[(size_t)l * DM * N_IN + (size_t)k * N_IN + IF_COL + rr] * norm_pre[l * DM + k];
        ((bf16_t*)(ws + WS_WIN + (size_t)l * SZ_WIN))[(size_t)(122 * 256 + rr) * DM + k] = (bf16_t)(cvt_pk_bf16(val, 0.f) & 0xffffu); }
    for (int i = gt; i < NLAYER * M_ROWS * 256 / 4; i += NGT) { const f32x4 a = ((const f32x4*)p)[i]; u32x2 w; w.x = cvt_pk_bf16(a[0], a[1]); w.y = cvt_pk_bf16(a[2], a[3]); ((u32x2*)(ws + WS_PB))[i] = w; }
    for (int i = gt; i < M_ROWS * 8; i += NGT) { const int row = i >> 3, j = i & 7; const float inv = powf(500000.0f, -(float)j * 0.125f); const float ang = (float)positions[row] * inv;
        float* cs = (float*)(ws + WS_CS) + (size_t)row * 16; cs[j] = cosf(ang); cs[8 + j] = sinf(ang); }
    { const int gw = F.vcu * NWAVES + F.wave, NGW = F.G * NWAVES;
      for (int m = gw; m < M_ROWS; m += NGW) { const f32x4* xr = (const f32x4*)(x + (size_t)m * DM) + F.lane; u32x2* o = (u32x2*)(ws + WS_XB + (size_t)m * DM * 2) + F.lane; float s = 0.f;
#pragma unroll
          for (int j = 0; j < 16; ++j) { const f32x4 a = xr[64 * j]; s += (a[0] * a[0] + a[1] * a[1]) + (a[2] * a[2] + a[3] * a[3]); u32x2 w; w.x = cvt_pk_bf16(a[0], a[1]); w.y = cvt_pk_bf16(a[2], a[3]); o[64 * j] = w; }
          s = wave_sum(s); if (F.lane == 0) ((float*)(ws + WS_SSQ0))[m] = s; } }
}

__device__ __forceinline__ u32x2 pack4(const f32x4 v) { u32x2 w; w.x = cvt_pk_bf16(v[0], v[1]); w.y = cvt_pk_bf16(v[2], v[3]); return w; }
__device__ __forceinline__ bf16x8 mk_frag(const u32x2 lo, const u32x2 hi) { const u32x4 t = {lo.x, lo.y, hi.x, hi.y}; return __builtin_bit_cast(bf16x8, t); }
__device__ __forceinline__ bf16x8 frag_const(unsigned w) { const u32x4 t = {w, w, w, w}; return __builtin_bit_cast(bf16x8, t); }

constexpr int GM_WL = 0, GM_VT = 34816, GM_ST = 104448, GM_RS = 272;
__device__ __forceinline__ void gmlp_unit(const Ctx& F, int b, int n, int g, unsigned char* ws, const float* ln_g, const float* ln_b, const float* wsp, const float* bsp) {
    int tid = F.tid; LAUNDER_V(tid); const int lane = tid & 63, w = F.wave, r16 = lane & 15, q4 = lane >> 4;
    const int row0 = b * SEQ + n * 128, c0 = g * 256;
    const bf16_t* AU = (const bf16_t*)(ws + WS_AU); const bf16_t* AV = (const bf16_t*)(ws + WS_AV); const bf16_t* AZ = (const bf16_t*)(ws + WS_AZ); bf16_t* YA = (bf16_t*)(ws + WS_YA);
    if (tid < 128) { const f32x2* pp = (const f32x2*)(ws + WS_LNP) + (size_t)(row0 + tid) * 32; float s = 0.f, q = 0.f;
#pragma unroll 8
        for (int j = 0; j < 32; ++j) { const f32x2 t = pp[j]; s += t.x; q += t.y; }
        const float mu = s * (1.0f / BW); const float var = fmaxf(q * (1.0f / BW) - mu * mu, 0.f);
        *(LAS f32x2*)(F.lds + GM_ST + tid * 8) = (f32x2){mu, rsqrtf(var + NORM_EPS)}; }
#pragma unroll
    for (int k = 0; k < 8; ++k) { const int item = tid + 512 * k, t = item >> 5, ch = item & 31;
        f32x4 a = *(const f32x4*)(wsp + ((size_t)(g * 128 + t)) * 128 + 4 * ch);
#pragma unroll
        for (int e = 0; e < 4; ++e) if (4 * ch + e > t) a[e] = 0.f;
        *(LAS u32x2*)(F.lds + GM_WL + t * GM_RS + ch * 8) = pack4(a); }
    __syncthreads();
#pragma unroll
    for (int k = 0; k < 8; ++k) { const int item = tid + 512 * k, s = item & 127, ch = item >> 7;
        const u32x4 raw = *(const u32x4*)(AV + (size_t)(row0 + s) * BW + c0 + 8 * ch);
        const f32x4 g0 = *(const f32x4*)(ln_g + c0 + 8 * ch), g1 = *(const f32x4*)(ln_g + c0 + 8 * ch + 4), b0 = *(const f32x4*)(ln_b + c0 + 8 * ch), b1 = *(const f32x4*)(ln_b + c0 + 8 * ch + 4);
        const f32x2 st = *(const LAS f32x2*)(F.lds + GM_ST + s * 8);
        const float xv[8] = {bf_lo(raw.x), bf_hi(raw.x), bf_lo(raw.y), bf_hi(raw.y), bf_lo(raw.z), bf_hi(raw.z), bf_lo(raw.w), bf_hi(raw.w)};
        const float gg[8] = {g0[0], g0[1], g0[2], g0[3], g1[0], g1[1], g1[2], g1[3]}, bb[8] = {b0[0], b0[1], b0[2], b0[3], b1[0], b1[1], b1[2], b1[3]};
#pragma unroll
        for (int i = 0; i < 8; ++i) { const float y = (xv[i] - st.x) * st.y * gg[i] + bb[i];
            *(LAS bf16_t*)(F.lds + GM_VT + (8 * ch + i) * GM_RS + 2 * s) = (bf16_t)(cvt_pk_bf16(y, 0.f) & 0xffffu); } }
    __syncthreads();
    f32x4 acc[2][8];
#pragma unroll
    for (int m = 0; m < 2; ++m)
#pragma unroll
        for (int n8 = 0; n8 < 8; ++n8) acc[m][n8] = (f32x4){0.f, 0.f, 0.f, 0.f};
    bf16x8 af[2][4];
#pragma unroll
    for (int m = 0; m < 2; ++m)
#pragma unroll
        for (int ks = 0; ks < 4; ++ks) af[m][ks] = *(const LAS bf16x8*)(F.lds + GM_VT + (32 * w + 16 * m + r16) * GM_RS + ks * 64 + q4 * 16);
#pragma unroll
    for (int n8 = 0; n8 < 8; ++n8)
#pragma unroll
        for (int ks = 0; ks < 4; ++ks) if (ks <= n8 / 2) {
            const bf16x8 bfr = *(const LAS bf16x8*)(F.lds + GM_WL + (16 * n8 + r16) * GM_RS + ks * 64 + q4 * 16);
#pragma unroll
            for (int m = 0; m < 2; ++m) acc[m][n8] = MFMA16(af[m][ks], bfr, acc[m][n8]); }
#pragma unroll
    for (int n8 = 0; n8 < 8; ++n8) { const int t = 16 * n8 + r16; const float bsv = bsp[g * 128 + t]; const size_t ro = (size_t)(row0 + t) * BW + c0 + 32 * w + 4 * q4;
#pragma unroll
        for (int m = 0; m < 2; ++m) { const u32x2 ub = *(const u32x2*)(AU + ro + 16 * m), zb = *(const u32x2*)(AZ + ro + 16 * m);
            const f32x4 a = acc[m][n8] + bsv; f32x4 y;
            y[0] = a[0] * bf_lo(ub.x) * bf_lo(zb.x); y[1] = a[1] * bf_hi(ub.x) * bf_hi(zb.x); y[2] = a[2] * bf_lo(ub.y) * bf_lo(zb.y); y[3] = a[3] * bf_hi(ub.y) * bf_hi(zb.y);
            *(u32x2*)(YA + ro + 16 * m) = pack4(y); } }
    __syncthreads();
}

constexpr int SW_KL = 0, SW_VT = 36864, SW_QL = 70656, SW_RS = 144, SW_VS = 528;
__device__ __forceinline__ void rope8(const u32x4 a, const u32x4 bq, const float* cs, float scale, u32x4& o1, u32x4& o2) {
    const f32x4 c0 = *(const f32x4*)cs, c1 = *(const f32x4*)(cs + 4), s0 = *(const f32x4*)(cs + 8), s1 = *(const f32x4*)(cs + 12);
    const float t1[8] = {bf_lo(a.x), bf_hi(a.x), bf_lo(a.y), bf_hi(a.y), bf_lo(a.z), bf_hi(a.z), bf_lo(a.w), bf_hi(a.w)};
    const float t2[8] = {bf_lo(bq.x), bf_hi(bq.x), bf_lo(bq.y), bf_hi(bq.y), bf_lo(bq.z), bf_hi(bq.z), bf_lo(bq.w), bf_hi(bq.w)};
    const float cc[8] = {c0[0], c0[1], c0[2], c0[3], c1[0], c1[1], c1[2], c1[3]}, ss[8] = {s0[0], s0[1], s0[2], s0[3], s1[0], s1[1], s1[2], s1[3]};
    float r1[8], r2[8];
#pragma unroll
    for (int i = 0; i < 8; ++i) { r1[i] = (t1[i] * cc[i] - t2[i] * ss[i]) * scale; r2[i] = (t2[i] * cc[i] + t1[i] * ss[i]) * scale; }
    o1 = (u32x4){cvt_pk_bf16(r1[0], r1[1]), cvt_pk_bf16(r1[2], r1[3]), cvt_pk_bf16(r1[4], r1[5]), cvt_pk_bf16(r1[6], r1[7])};
    o2 = (u32x4){cvt_pk_bf16(r2[0], r2[1]), cvt_pk_bf16(r2[2], r2[3]), cvt_pk_bf16(r2[4], r2[5]), cvt_pk_bf16(r2[6], r2[7])};
}
__device__ __forceinline__ u32x4 scale8(const u32x4 a, float sc) {
    return (u32x4){cvt_pk_bf16(bf_lo(a.x) * sc, bf_hi(a.x) * sc), cvt_pk_bf16(bf_lo(a.y) * sc, bf_hi(a.y) * sc), cvt_pk_bf16(bf_lo(a.z) * sc, bf_hi(a.z) * sc), cvt_pk_bf16(bf_lo(a.w) * sc, bf_hi(a.w) * sc)};
}
__device__ __forceinline__ void swa_unit(const Ctx& F, int b, int n, int hk, unsigned char* ws, const float* sinks) {
    int tid = F.tid; LAUNDER_V(tid); const int lane = tid & 63, w = F.wave, r16 = lane & 15, q4 = lane >> 4;
    const int r0 = b * SEQ + n * 128, kr0 = r0 - 128;
    const bf16_t* BQ = (const bf16_t*)(ws + WS_BQ); const bf16_t* BK = (const bf16_t*)(ws + WS_BK); const bf16_t* BV = (const bf16_t*)(ws + WS_BV); const bf16_t* BZ = (const bf16_t*)(ws + WS_BZ);
    bf16_t* YB = (bf16_t*)(ws + WS_YA) + (size_t)M_ROWS * BW; const float* CS = (const float*)(ws + WS_CS);
#pragma unroll
    for (int k = 0; k < 4; ++k) { const int item = tid + 512 * k, key = item >> 3, ch = item & 7; const bool pad = (n == 0 && key < 128);
        if (ch == 1) continue;
        const bf16_t* src = BK + (size_t)(kr0 + key) * 256 + hk * 64;
        LAS unsigned char* dst = F.lds + SW_KL + key * SW_RS;
        if (pad) { *(LAS u32x4*)(dst + ch * 16) = (u32x4){0u, 0u, 0u, 0u}; if (ch == 0) *(LAS u32x4*)(dst + 16) = (u32x4){0u, 0u, 0u, 0u}; }
        else if (ch == 0) { u32x4 o1, o2; rope8(*(const u32x4*)src, *(const u32x4*)(src + 8), CS + (size_t)(kr0 + key) * 16, 1.0f, o1, o2); *(LAS u32x4*)dst = o1; *(LAS u32x4*)(dst + 16) = o2; }
        else *(LAS u32x4*)(dst + ch * 16) = *(const u32x4*)(src + 8 * ch); }
#pragma unroll
    for (int k = 0; k < 4; ++k) { const int item = tid + 512 * k, key = item & 255, ch = item >> 8; const bool pad = (n == 0 && key < 128);
        u32x4 raw = {0u, 0u, 0u, 0u}; if (!pad) raw = *(const u32x4*)(BV + (size_t)(kr0 + key) * 256 + hk * 64 + 8 * ch);
        const unsigned e[4] = {raw.x, raw.y, raw.z, raw.w};
#pragma unroll
        for (int i = 0; i < 8; ++i) *(LAS bf16_t*)(F.lds + SW_VT + (8 * ch + i) * SW_VS + 2 * key) = (bf16_t)((e[i >> 1] >> ((i & 1) * 16)) & 0xffffu); }
    for (int hi = 0; hi < 8; ++hi) {
        const int hq = hk * 8 + hi;
#pragma unroll
        for (int k = 0; k < 2; ++k) { const int item = tid + 512 * k, qr = item >> 3, ch = item & 7;
            if (ch == 1) continue;
            const bf16_t* src = BQ + (size_t)(r0 + qr) * BW + hq * 64; LAS unsigned char* dst = F.lds + SW_QL + qr * SW_RS;
            if (ch == 0) { u32x4 o1, o2; rope8(*(const u32x4*)src, *(const u32x4*)(src + 8), CS + (size_t)(r0 + qr) * 16, 0.125f, o1, o2); *(LAS u32x4*)dst = o1; *(LAS u32x4*)(dst + 16) = o2; }
            else *(LAS u32x4*)(dst + ch * 16) = scale8(*(const u32x4*)(src + 8 * ch), 0.125f); }
        __syncthreads();
        bf16x8 bq[2];
#pragma unroll
        for (int ks = 0; ks < 2; ++ks) bq[ks] = *(const LAS bf16x8*)(F.lds + SW_QL + (16 * w + r16) * SW_RS + ks * 64 + q4 * 16);
        f32x4 s[16];
#pragma unroll
        for (int kt = 0; kt < 16; ++kt) { s[kt] = (f32x4){0.f, 0.f, 0.f, 0.f};
#pragma unroll
            for (int ks = 0; ks < 2; ++ks) { const bf16x8 a = *(const LAS bf16x8*)(F.lds + SW_KL + (16 * kt + r16) * SW_RS + ks * 64 + q4 * 16); s[kt] = MFMA16(a, bq[ks], s[kt]); } }
        const int qi = 16 * w + r16; const float sink = sinks[hq]; float mx = sink;
#pragma unroll
        for (int kt = 0; kt < 16; ++kt)
#pragma unroll
            for (int e = 0; e < 4; ++e) { const int kj = 16 * kt + 4 * q4 + e; const bool valid = (kj > qi) && (kj <= qi + 128) && (n > 0 || kj >= 128);
                s[kt][e] = valid ? s[kt][e] : -1e30f; mx = fmaxf(mx, s[kt][e]); }
        mx = fmaxf(mx, __shfl_xor(mx, 16)); mx = fmaxf(mx, __shfl_xor(mx, 32));
        float sum = 0.f;
#pragma unroll
        for (int kt = 0; kt < 16; ++kt)
#pragma unroll
            for (int e = 0; e < 4; ++e) { const float pv = (s[kt][e] > -1e29f) ? __expf(s[kt][e] - mx) : 0.f; s[kt][e] = pv; sum += pv; }
        sum += __shfl_xor(sum, 16); sum += __shfl_xor(sum, 32); sum += __expf(sink - mx);
        const float inv = 1.0f / sum;
        f32x4 o[4];
#pragma unroll
        for (int dt = 0; dt < 4; ++dt) o[dt] = (f32x4){0.f, 0.f, 0.f, 0.f};
#pragma unroll
        for (int kk = 0; kk < 8; ++kk) { const bf16x8 pf = mk_frag(pack4(s[2 * kk]), pack4(s[2 * kk + 1]));
#pragma unroll
            for (int dt = 0; dt < 4; ++dt) { const LAS unsigned char* vp = F.lds + SW_VT + (16 * dt + r16) * SW_VS + (32 * kk + 4 * q4) * 2;
                const bf16x8 a = mk_frag(*(const LAS u32x2*)vp, *(const LAS u32x2*)(vp + 32)); o[dt] = MFMA16(a, pf, o[dt]); } }
        const size_t ro = (size_t)(r0 + qi) * BW + hq * 64 + 4 * q4;
#pragma unroll
        for (int dt = 0; dt < 4; ++dt) { const u32x2 zb = *(const u32x2*)(BZ + ro + 16 * dt); f32x4 y;
            y[0] = o[dt][0] * inv * bf_lo(zb.x); y[1] = o[dt][1] * inv * bf_hi(zb.x); y[2] = o[dt][2] * inv * bf_lo(zb.y); y[3] = o[dt][3] * inv * bf_hi(zb.y);
            *(u32x2*)(YB + ro + 16 * dt) = pack4(y); }
        __syncthreads();
    }
}

constexpr int ML_QL = 0, ML_KL = 33792, ML_KWT = 67584, ML_VT = 104448, ML_CT = 109056, ML_X = 126480, ML_GATE = 135696, ML_GSZ = 1344, ML_RS = 528, ML_TS = 144;
static_assert(ML_GATE + 2 * ML_GSZ <= ARGS_OFF, "mLSTM LDS map");
__device__ __forceinline__ float wave_scan_add(float v, int lane) {
#pragma unroll
    for (int d = 1; d < 64; d <<= 1) { const float t = __shfl_up(v, d); if (lane >= d) v += t; }
    return v;
}
__device__ __forceinline__ float wave_scan_max(float v, int lane) {
#pragma unroll
    for (int d = 1; d < 64; d <<= 1) { const float t = __shfl_up(v, d); if (lane >= d) v = fmaxf(v, t); }
    return v;
}
__device__ __forceinline__ float softcap15(float z) { const float e = __expf(z * (2.0f / 15.0f)); return 15.0f * (1.0f - 2.0f * __builtin_amdgcn_rcpf(e + 1.0f)); }
__device__ __forceinline__ void mlstm_unit(const Ctx& F, int b, int h, int sl, unsigned char* ws, const float* ibp, const float* fbp) {
    int tid = F.tid; LAUNDER_V(tid); const int lane = tid & 63, w = F.wave, r16 = lane & 15, q4 = lane >> 4;
    const bf16_t* CQ = (const bf16_t*)(ws + WS_CQ) + h * 256; const bf16_t* CK = (const bf16_t*)(ws + WS_CK) + h * 256; const bf16_t* CV = (const bf16_t*)(ws + WS_CV) + h * 512 + sl * 32;
    const float* IFB = (const float*)(ws + WS_IF);
    bf16_t* NUM = (bf16_t*)(ws + WS_NUM) + h * 512 + sl * 32; float* SSQC = (float*)(ws + WS_SSQC); float* DNB = (float*)(ws + WS_DN);
    const int rowb = b * SEQ;
    const bf16x8 ones = frag_const(0x3f803f80u), zeros = frag_const(0u);
    for (int i = tid; i < 33 * ML_RS / 16; i += NTHREADS) *(LAS u32x4*)(F.lds + ML_CT + i * 16) = (u32x4){0u, 0u, 0u, 0u};
    f32x4 st[2][3];
#pragma unroll
    for (int i = 0; i < 2; ++i)
#pragma unroll
        for (int dt = 0; dt < 3; ++dt) st[i][dt] = (f32x4){0.f, 0.f, 0.f, 0.f};
    float m_prev = 0.f;
    const float ibv = ibp[h], fbv = fbp[h];
    u32x4 qreg[4], kreg[4], vreg; float gi = 0.f, gf = 0.f;
#define ML_LOAD(c) do { const int rc_ = rowb + (c) * 64; _Pragma("unroll") for (int k_ = 0; k_ < 4; ++k_) { const int it_ = tid + 512 * k_, s_ = it_ >> 5, ch_ = it_ & 31; \
        qreg[k_] = *(const u32x4*)(CQ + (size_t)(rc_ + s_) * 1024 + 8 * ch_); kreg[k_] = *(const u32x4*)(CK + (size_t)(rc_ + s_) * 1024 + 8 * ch_); } \
        if (tid < 256) vreg = *(const u32x4*)(CV + (size_t)(rc_ + (tid >> 2)) * BW + 8 * (tid & 3)); } while (0)
#define ML_GLOAD(c) do { if (w == 7) { const int r_ = rowb + (c) * 64 + lane; gi = IFB[(size_t)r_ * 8 + h]; gf = IFB[(size_t)r_ * 8 + 4 + h]; } } while (0)
#define ML_GPREP(par) do { if (w == 7) { const float ig_ = softcap15(gi + ibv); const float z_ = softcap15(gf + fbv); \
        const float lf_ = -(fmaxf(-z_, 0.f) + log1pf(__expf(-fabsf(z_)))); const float bc_ = wave_scan_add(lf_, lane); const float u_ = ig_ - bc_; const float pm_ = wave_scan_max(u_, lane); \
        const float Mv_ = fmaxf(m_prev, pm_); const float M63_ = __shfl(Mv_, 63); const float g_ = __shfl(bc_, 63); \
        LAS float* gp_ = (LAS float*)(F.lds + ML_GATE + (par) * ML_GSZ); gp_[lane] = u_; gp_[64 + lane] = Mv_; gp_[128 + lane] = __expf(m_prev - Mv_); gp_[192 + lane] = __expf(-(bc_ + Mv_)); \
        gp_[256 + lane] = __expf(u_ - M63_); if (lane == 0) gp_[320] = __expf(m_prev - M63_); m_prev = g_ + M63_; } } while (0)
#define ML_WRITE() do { _Pragma("unroll") for (int k_ = 0; k_ < 4; ++k_) { const int it_ = tid + 512 * k_, s_ = it_ >> 5, ch_ = it_ & 31; \
        *(LAS u32x4*)(F.lds + ML_QL + s_ * ML_RS + ch_ * 16) = qreg[k_]; *(LAS u32x4*)(F.lds + ML_KL + s_ * ML_RS + ch_ * 16) = kreg[k_]; } \
        if (tid < 256) { const int s_ = tid >> 2, ch_ = tid & 3; const unsigned e_[4] = {vreg.x, vreg.y, vreg.z, vreg.w}; \
            _Pragma("unroll") for (int i_ = 0; i_ < 8; ++i_) *(LAS bf16_t*)(F.lds + ML_VT + (8 * ch_ + i_) * ML_TS + 2 * s_) = (bf16_t)((e_[i_ >> 1] >> ((i_ & 1) * 16)) & 0xffffu); } } while (0)
    ML_LOAD(0); ML_GLOAD(0);
    ML_GPREP(0);
    ML_GLOAD(1);
    ML_WRITE();
    __syncthreads();
    for (int c = 0; c < 32; ++c) {
        const int par = c & 1; const LAS float* gp = (const LAS float*)(F.lds + ML_GATE + par * ML_GSZ);
        const int rowc = rowb + c * 64;
        if (c + 1 < 32) { ML_LOAD(c + 1); ML_GPREP(par ^ 1); if (c + 2 < 32) ML_GLOAD(c + 2); }
#pragma unroll
        for (int k = 0; k < 4; ++k) { const int item = tid + 512 * k, dk = item & 255, so = item >> 8;
            const f32x4 w0 = *(const LAS f32x4*)(gp + 256 + 8 * so), w1 = *(const LAS f32x4*)(gp + 256 + 8 * so + 4); const float wv[8] = {w0[0], w0[1], w0[2], w0[3], w1[0], w1[1], w1[2], w1[3]};
            float kv[8];
#pragma unroll
            for (int j = 0; j < 8; ++j) kv[j] = bf1(*(const LAS bf16_t*)(F.lds + ML_KL + (8 * so + j) * ML_RS + 2 * dk)) * wv[j];
            *(LAS u32x4*)(F.lds + ML_KWT + dk * ML_TS + so * 16) = (u32x4){cvt_pk_bf16(kv[0], kv[1]), cvt_pk_bf16(kv[2], kv[3]), cvt_pk_bf16(kv[4], kv[5]), cvt_pk_bf16(kv[6], kv[7])}; }
        f32x4 oacc[3];
#pragma unroll
        for (int dt = 0; dt < 3; ++dt) oacc[dt] = (f32x4){0.f, 0.f, 0.f, 0.f};
        if (w < 4) {
            const int T = w;
            bf16x8 bq[8];
#pragma unroll
            for (int ks = 0; ks < 8; ++ks) bq[ks] = *(const LAS bf16x8*)(F.lds + ML_QL + (16 * T + r16) * ML_RS + ks * 64 + q4 * 16);
            f32x4 sa[4];
#pragma unroll
            for (int s4 = 0; s4 < 4; ++s4) { sa[s4] = (f32x4){0.f, 0.f, 0.f, 0.f};
                if (s4 <= T) {
#pragma unroll
                    for (int ks = 0; ks < 8; ++ks) { const bf16x8 a = *(const LAS bf16x8*)(F.lds + ML_KL + (16 * s4 + r16) * ML_RS + ks * 64 + q4 * 16); sa[s4] = MFMA16(a, bq[ks], sa[s4]); } } }
            const int tl = 16 * T + r16; const float Mt = gp[64 + tl];
#pragma unroll
            for (int s4 = 0; s4 < 4; ++s4) { const f32x4 uu = *(const LAS f32x4*)(gp + 16 * s4 + 4 * q4);
#pragma unroll
                for (int e = 0; e < 4; ++e) { const int sl_ = 16 * s4 + 4 * q4 + e; sa[s4][e] = (sl_ <= tl) ? sa[s4][e] * __expf(uu[e] - Mt) : 0.f; } }
#pragma unroll
            for (int kk = 0; kk < 2; ++kk) { const bf16x8 pf = mk_frag(pack4(sa[2 * kk]), pack4(sa[2 * kk + 1]));
#pragma unroll
                for (int dt = 0; dt < 3; ++dt) { bf16x8 a;
                    if (dt < 2) { const LAS unsigned char* vp = F.lds + ML_VT + (16 * dt + r16) * ML_TS + (32 * kk + 4 * q4) * 2; a = mk_frag(*(const LAS u32x2*)vp, *(const LAS u32x2*)(vp + 32)); }
                    else a = (r16 == 0) ? ones : zeros;
                    oacc[dt] = MFMA16(a, pf, oacc[dt]); } }
        } else {
            const int T = w - 4; f32x4 ia[3];
#pragma unroll
            for (int dt = 0; dt < 3; ++dt) ia[dt] = (f32x4){0.f, 0.f, 0.f, 0.f};
#pragma unroll
            for (int ks = 0; ks < 8; ++ks) { const bf16x8 bqv = *(const LAS bf16x8*)(F.lds + ML_QL + (16 * T + r16) * ML_RS + ks * 64 + q4 * 16);
#pragma unroll
                for (int dt = 0; dt < 3; ++dt) { bf16x8 a;
                    if (dt < 2) a = *(const LAS bf16x8*)(F.lds + ML_CT + (16 * dt + r16) * ML_RS + ks * 64 + q4 * 16);
                    else { a = *(const LAS bf16x8*)(F.lds + ML_CT + 32 * ML_RS + ks * 64 + q4 * 16); if (r16 != 0) a = zeros; }
                    ia[dt] = MFMA16(a, bqv, ia[dt]); } }
            const int tl = 16 * T + r16;
            *(LAS f32x4*)(F.lds + ML_X + tl * 144 + (4 * q4) * 4) = ia[0]; *(LAS f32x4*)(F.lds + ML_X + tl * 144 + (16 + 4 * q4) * 4) = ia[1];
            if (q4 == 0) *(LAS f32x4*)(F.lds + ML_X + tl * 144 + 32 * 4) = ia[2];
        }
        __syncthreads();
        if (w < 4) {
            const int tl = 16 * w + r16; const float at = gp[128 + tl], en = gp[192 + tl];
            const f32x4 x0 = *(const LAS f32x4*)(F.lds + ML_X + tl * 144 + (4 * q4) * 4), x1 = *(const LAS f32x4*)(F.lds + ML_X + tl * 144 + (16 + 4 * q4) * 4);
            const float xd = *(const LAS float*)(F.lds + ML_X + tl * 144 + 32 * 4);
            const f32x4 n0 = oacc[0] + x0 * at, n1 = oacc[1] + x1 * at;
            float den = oacc[2][0] + xd * at; den = __shfl(den, r16);
            float sq = (n0[0] * n0[0] + n0[1] * n0[1]) + (n0[2] * n0[2] + n0[3] * n0[3]) + (n1[0] * n1[0] + n1[1] * n1[1]) + (n1[2] * n1[2] + n1[3] * n1[3]);
            sq += __shfl_xor(sq, 16); sq += __shfl_xor(sq, 32);
            const size_t ro = (size_t)(rowc + tl) * BW + 4 * q4;
            *(u32x2*)(NUM + ro) = pack4(n0); *(u32x2*)(NUM + ro + 16) = pack4(n1);
            if (q4 == 0) { SSQC[(size_t)(rowc + tl) * 64 + h * 16 + sl] = sq; if (sl == 0) DNB[(size_t)(rowc + tl) * 4 + h] = fmaxf(fabsf(den), en); }
        }
        { const float dec = gp[320];
#pragma unroll
          for (int i = 0; i < 2; ++i)
#pragma unroll
              for (int dt = 0; dt < 3; ++dt) st[i][dt] = st[i][dt] * dec;
#pragma unroll
          for (int kk = 0; kk < 2; ++kk) { bf16x8 a[2], bv[3];
#pragma unroll
              for (int i = 0; i < 2; ++i) a[i] = *(const LAS bf16x8*)(F.lds + ML_KWT + (32 * w + 16 * i + r16) * ML_TS + kk * 64 + q4 * 16);
#pragma unroll
              for (int dt = 0; dt < 2; ++dt) bv[dt] = *(const LAS bf16x8*)(F.lds + ML_VT + (16 * dt + r16) * ML_TS + kk * 64 + q4 * 16);
              bv[2] = (r16 == 0) ? ones : zeros;
#pragma unroll
              for (int i = 0; i < 2; ++i)
#pragma unroll
                  for (int dt = 0; dt < 3; ++dt) st[i][dt] = MFMA16(a[i], bv[dt], st[i][dt]); }
#pragma unroll
          for (int i = 0; i < 2; ++i) {
#pragma unroll
              for (int dt = 0; dt < 2; ++dt) *(LAS u32x2*)(F.lds + ML_CT + (16 * dt + r16) * ML_RS + (32 * w + 16 * i + 4 * q4) * 2) = pack4(st[i][dt]);
              if (r16 == 0) *(LAS u32x2*)(F.lds + ML_CT + 32 * ML_RS + (32 * w + 16 * i + 4 * q4) * 2) = pack4(st[i][2]); } }
        __syncthreads();
        if (c + 1 < 32) ML_WRITE();
        __syncthreads();
    }
#undef ML_LOAD
#undef ML_GLOAD
#undef ML_GPREP
#undef ML_WRITE
}

__device__ __forceinline__ void p2b_finalize(const Ctx& F, unsigned char* ws, const float* norm_g) {
    int lane = F.lane; LAUNDER_V(lane); const int gw = F.vcu * NWAVES + F.wave, NGW = F.G * NWAVES;
    const bf16_t* NUM = (const bf16_t*)(ws + WS_NUM); const bf16_t* CO = (const bf16_t*)(ws + WS_CO); const bf16_t* CZ = (const bf16_t*)(ws + WS_CZ);
    bf16_t* YC = (bf16_t*)(ws + WS_YA) + (size_t)2 * M_ROWS * BW;
    for (int m = gw; m < M_ROWS; m += NGW) {
        float s = ((const float*)(ws + WS_SSQC))[(size_t)m * 64 + lane];
        s += __shfl_xor(s, 1); s += __shfl_xor(s, 2); s += __shfl_xor(s, 4); s += __shfl_xor(s, 8);
        const float dn = ((const float*)(ws + WS_DN))[(size_t)m * 4 + (lane >> 4)];
        const float inv = 1.0f / dn; const float sc = inv * rsqrtf(s * (1.0f / 512.0f) * inv * inv + NORM_EPS);
#pragma unroll
        for (int it = 0; it < 4; ++it) { const float f = __shfl(sc, 16 * it); const size_t o = (size_t)m * BW + (size_t)(it * 64 + lane) * 8;
            const u32x4 nb = *(const u32x4*)(NUM + o), ob = *(const u32x4*)(CO + o), zb = *(const u32x4*)(CZ + o);
            const f32x4 g0 = *(const f32x4*)(norm_g + (it * 64 + lane) * 8), g1 = *(const f32x4*)(norm_g + (it * 64 + lane) * 8 + 4);
            u32x4 y;
            y.x = cvt_pk_bf16(bf_lo(nb.x) * f * g0[0] * bf_lo(ob.x) * bf_lo(zb.x), bf_hi(nb.x) * f * g0[1] * bf_hi(ob.x) * bf_hi(zb.x));
            y.y = cvt_pk_bf16(bf_lo(nb.y) * f * g0[2] * bf_lo(ob.y) * bf_lo(zb.y), bf_hi(nb.y) * f * g0[3] * bf_hi(ob.y) * bf_hi(zb.y));
            y.z = cvt_pk_bf16(bf_lo(nb.z) * f * g1[0] * bf_lo(ob.z) * bf_lo(zb.z), bf_hi(nb.z) * f * g1[1] * bf_hi(ob.z) * bf_hi(zb.z));
            y.w = cvt_pk_bf16(bf_lo(nb.w) * f * g1[2] * bf_lo(ob.w) * bf_lo(zb.w), bf_hi(nb.w) * f * g1[3] * bf_hi(ob.w) * bf_hi(zb.w));
            *(u32x4*)(YC + o) = y; }
    }
}
__device__ __forceinline__ void p4b_x1(const Ctx& F, unsigned char* ws, const float* xin, const float* npost) {
    int lane = F.lane; LAUNDER_V(lane); const int gw = F.vcu * NWAVES + F.wave, NGW = F.G * NWAVES;
    const bf16_t* OUT = (const bf16_t*)(ws + WS_OUT); bf16_t* X1B = (bf16_t*)(ws + WS_X1B);
    for (int m = gw; m < M_ROWS; m += NGW) {
        const float so = wave_sum(((const float*)(ws + WS_OUTP))[(size_t)m * 64 + lane]), se = wave_sum(((const float*)(ws + WS_ERP))[(size_t)m * 64 + lane]);
        const float rso = rsqrtf(so * (1.0f / DM) + NORM_EPS), rse = rsqrtf(se * (1.0f / DM) + NORM_EPS);
        if (lane == 0) { ((float*)(ws + WS_RSO))[m] = rso; ((float*)(ws + WS_RSE))[m] = rse; }
#pragma unroll
        for (int it = 0; it < 8; ++it) { const int c = (it * 64 + lane) * 8; const size_t o = (size_t)m * DM + c;
            const f32x4 x0 = *(const f32x4*)(xin + o), x1 = *(const f32x4*)(xin + o + 4), n0 = *(const f32x4*)(npost + c), n1 = *(const f32x4*)(npost + c + 4);
            const u32x4 ob = *(const u32x4*)(OUT + o); u32x4 y;
            y.x = cvt_pk_bf16(x0[0] + bf_lo(ob.x) * rso * n0[0], x0[1] + bf_hi(ob.x) * rso * n0[1]);
            y.y = cvt_pk_bf16(x0[2] + bf_lo(ob.y) * rso * n0[2], x0[3] + bf_hi(ob.y) * rso * n0[3]);
            y.z = cvt_pk_bf16(x1[0] + bf_lo(ob.z) * rso * n1[0], x1[1] + bf_hi(ob.z) * rso * n1[1]);
            y.w = cvt_pk_bf16(x1[2] + bf_lo(ob.w) * rso * n1[2], x1[3] + bf_hi(ob.w) * rso * n1[3]);
            *(u32x4*)(X1B + o) = y; }
    }
}

struct Args { const void* in[19]; float* out; unsigned char* ws; };
static_assert(sizeof(Args) == 21 * 8, "no padding in Args");

__global__ void __launch_bounds__(NTHREADS, 2) fwd_kernel(Args args) {
    extern __shared__ __attribute__((aligned(16))) unsigned char lds_raw[];
    Ctx F; F.lds = (LAS unsigned char*)lds_raw; F.tid = threadIdx.x; F.lane = F.tid & 63; F.wave = __builtin_amdgcn_readfirstlane(F.tid >> 6);
    F.G = gridDim.x; { const int bx = blockIdx.x; F.vcu = (F.G % 8 == 0) ? (bx % 8) * (F.G / 8) + bx / 8 : bx; }
    unsigned char* ws0 = args.ws;
#define WSL() ({ unsigned char* w_ = ws0; LAUNDER_S(w_); w_; })
    volatile LAS unsigned* MISC = (volatile LAS unsigned*)(F.lds + MISC_OFF);
    if (F.tid < 32) MISC[F.tid] = 0u;
    __syncthreads();
    const XcdBarrier bar = xcd_barrier_post((unsigned*)(ws0 + WS_CTL) + CW_BAR, MISC);

    if (F.tid < 19) ((LAS unsigned long long*)(F.lds + ARGS_OFF))[F.tid] = (unsigned long long)args.in[F.tid];
    if (F.tid == 19) ((LAS unsigned long long*)(F.lds + ARGS_OFF))[19] = (unsigned long long)args.out;
    __syncthreads();
#define ARGP(T, i) ((T)(((unsigned long long)__builtin_amdgcn_readfirstlane((int)(((volatile LAS unsigned*)(F.lds + ARGS_OFF))[2 * (i) + 1])) << 32) | (unsigned)__builtin_amdgcn_readfirstlane((int)(((volatile LAS unsigned*)(F.lds + ARGS_OFF))[2 * (i)]))))

#ifndef SKIP_P0
    { unsigned char* ws = WSL(); p0_prologue(F, ARGP(const float*, 0), ARGP(const float*, 1), ARGP(const int*, 2), ARGP(const float*, 3), ARGP(const float*, 4), ARGP(const float*, 13), ARGP(const float*, 14), ARGP(const float*, 18), ARGP(const float*, 16), ws); }
#endif
    xcd_barrier(bar);

    for (int l = 0; l < NLAYER; ++l) {
        const float* xin = l == 0 ? ARGP(const float*, 0) : (const float*)ARGP(float*, 19);
#ifndef SKIP_P1
        { unsigned char* ws = WSL(); const float* ssq = l == 0 ? (const float*)(ws + WS_SSQ0) : (const float*)(ws + WS_CTL + CTL_SSQ1); pg8::SchedPlain S; S.T.init(M_ROWS / 256, NT_IN, F.G, (int)blockIdx.x); S.A = (const char*)(ws + WS_XB); S.B = (const char*)(ws + WS_WIN + (size_t)l * SZ_WIN);
          S.astep = (size_t)256 * DM * 2; S.bstep = (size_t)256 * DM * 2;
          pg8::EpiIn E{ssq, ws};
          pg8::gemm_phase<pg8::EpiIn, pg8::SchedPlain>(F.lds, DM, DM, DM, S, E); }
#endif
        xcd_barrier(bar);
#ifndef SKIP_ML
        { unsigned char* ws = WSL(); for (int u = F.vcu; u < 256; u += F.G) mlstm_unit(F, u >> 6, (u >> 4) & 3, u & 15, ws, ARGP(const float*, 10) + l * 4, ARGP(const float*, 11) + l * 4); }
#endif
#ifndef SKIP_SW
        { unsigned char* ws = WSL(); for (int u = F.vcu; u < 256; u += F.G) swa_unit(F, u >> 6, (u >> 2) & 15, u & 3, ws, ARGP(const float*, 9) + l * 32); }
#endif
#ifndef SKIP_GM
        { unsigned char* ws = WSL(); for (int u = F.vcu; u < 512; u += F.G) gmlp_unit(F, u >> 7, (u >> 3) & 15, u & 7, ws, ARGP(const float*, 5) + l * BW, ARGP(const float*, 6) + l * BW, ARGP(const float*, 7) + (size_t)l * 8 * 128 * 128, ARGP(const float*, 8) + l * 8 * 128); }
#endif
        xcd_barrier(bar);
#ifndef SKIP_P2B
        p2b_finalize(F, WSL(), ARGP(const float*, 12) + l * BW);
#endif
        xcd_barrier(bar);
#ifndef SKIP_P3
        { unsigned char* ws = WSL(); pg8::SchedBranch S; S.T.init(M_ROWS / 256, DM / 256, F.G, (int)blockIdx.x); S.A = (const char*)(ws + WS_YA); S.B = (const char*)(ws + WS_WBR + (size_t)l * SZ_WBR);
          S.astep = (size_t)256 * BW * 2; S.bstep = (size_t)256 * BW * 2; S.aseg = SZ_ROWS_BW; S.bseg = (size_t)DM * BW * 2;
          pg8::EpiBranch E{(const bf16_t*)(ws + WS_G), (bf16_t*)(ws + WS_MIX)};
          pg8::gemm_phase<pg8::EpiBranch, pg8::SchedBranch>(F.lds, BW, BW, BW, S, E); }
#endif
        xcd_barrier(bar);
#ifndef SKIP_P4
        { unsigned char* ws = WSL(); pg8::SchedPlain S; S.T.init(M_ROWS / 256, DM / 256, F.G, (int)blockIdx.x); S.A = (const char*)(ws + WS_MIX); S.B = (const char*)(ws + WS_WOUT + (size_t)l * SZ_WSQ);
          S.astep = (size_t)256 * DM * 2; S.bstep = (size_t)256 * DM * 2;
          pg8::EpiSq E{(bf16_t*)(ws + WS_OUT), (float*)(ws + WS_OUTP)};
          pg8::gemm_phase<pg8::EpiSq, pg8::SchedPlain>(F.lds, DM, DM, DM, S, E); }
        { unsigned char* ws = WSL(); pg8::SchedPlain S; S.T.init(M_ROWS / 256, DM / 256, F.G, (int)blockIdx.x); S.A = (const char*)(ws + WS_PB + (size_t)l * M_ROWS * 256 * 2); S.B = (const char*)(ws + WS_WPP + (size_t)l * SZ_WPP);
          S.astep = (size_t)256 * 256 * 2; S.bstep = (size_t)256 * 256 * 2;
          pg8::EpiSq E{(bf16_t*)(ws + WS_ERAW), (float*)(ws + WS_ERP)};
          pg8::gemm_phase<pg8::EpiSq, pg8::SchedPlain>(F.lds, 256, 256, 256, S, E); }
#endif
        xcd_barrier(bar);
#ifndef SKIP_P4B
        p4b_x1(F, WSL(), xin, ARGP(const float*, 15) + l * DM);
#endif
        xcd_barrier(bar);
#ifndef SKIP_P5
        { unsigned char* ws = WSL(); pg8::SchedPlain S; S.T.init(M_ROWS / 256, DM / 256, F.G, (int)blockIdx.x); S.A = (const char*)(ws + WS_X1B); S.B = (const char*)(ws + WS_WPG + (size_t)l * SZ_WSQ);
          S.astep = (size_t)256 * DM * 2; S.bstep = (size_t)256 * DM * 2;
          pg8::EpiPle E{xin, ARGP(float*, 19), (bf16_t*)(ws + WS_XB), (const bf16_t*)(ws + WS_OUT), (const bf16_t*)(ws + WS_ERAW), (const float*)(ws + WS_RSO), (const float*)(ws + WS_RSE),
                        ARGP(const float*, 15) + l * DM, ARGP(const float*, 17) + l * DM, (float*)(ws + WS_CTL + CTL_SSQ1), l == NLAYER - 1 ? 1 : 0};
          pg8::gemm_phase<pg8::EpiPle, pg8::SchedPlain>(F.lds, DM, DM, DM, S, E); }
#endif
        if (l + 1 < NLAYER) xcd_barrier(bar);
    }
}

extern "C" void kernel_launch(void* const* d_in, const int* in_sizes, int n_in, void* d_out, int out_size, void* d_ws, size_t ws_size, hipStream_t stream) {
    static int grid = 0;
    if (grid == 0) {
        if (n_in != 19 || out_size != M_ROWS * DM || ws_size < WS_END) { fprintf(stderr, "kernel_launch: unexpected problem (n_in %d, out %d, ws %zu, need %zu)\n", n_in, out_size, ws_size, (size_t)WS_END); grid = -1; return; }
        int dev = 0, cus = 0;
        if (hipGetDevice(&dev) != hipSuccess || hipDeviceGetAttribute(&cus, hipDeviceAttributeMultiprocessorCount, dev) != hipSuccess) { grid = -1; return; }
        if (hipFuncSetAttribute((const void*)fwd_kernel, hipFuncAttributeMaxDynamicSharedMemorySize, LDS_BYTES) != hipSuccess) { fprintf(stderr, "kernel_launch: hipFuncSetAttribute failed\n"); grid = -1; return; }
        int per_cu = 0; (void)hipOccupancyMaxActiveBlocksPerMultiprocessor(&per_cu, (const void*)fwd_kernel, NTHREADS, LDS_BYTES); (void)hipGetLastError();
        if (per_cu < 1) fprintf(stderr, "kernel_launch: occupancy query reports %d blocks per CU\n", per_cu);
        grid = cus > 256 ? 256 : cus;
    }
    if (grid < 0) return;
    (void)hipMemsetAsync((char*)d_ws + WS_CTL, 0, CTL_ZERO_BYTES, stream);
    Args a{};
    for (int i = 0; i < 19; ++i) a.in[i] = d_in[i];
    a.out = (float*)d_out; a.ws = (unsigned char*)d_ws;
    hipLaunchKernelGGL(fwd_kernel, dim3(grid), dim3(NTHREADS), LDS_BYTES, stream, a);
    const hipError_t le = hipPeekAtLastError();
    if (le != hipSuccess) fprintf(stderr, "kernel_launch: launch failed: %s\n", hipGetErrorName(le));
}
```

```cpp
#include <hip/hip_runtime.h>
#include <cstdio>
#include <cstdint>

#define LAS __attribute__((address_space(3)))
#define GAS __attribute__((address_space(1)))
typedef unsigned short bf16_t;
typedef short bf16x8 __attribute__((ext_vector_type(8)));
typedef float f32x4 __attribute__((ext_vector_type(4)));
typedef float f32x2 __attribute__((ext_vector_type(2)));
typedef unsigned u32x4 __attribute__((ext_vector_type(4)));
typedef unsigned u32x2 __attribute__((ext_vector_type(2)));

constexpr int M_ROWS = 8192, SEQ = 2048, DM = 4096, BW = 2048, NLAYER = 2;
constexpr int N_IN = 31240, IF_COL = 14848;
constexpr int NT_IN = 123;
constexpr int N_IN_T = NT_IN * 256;
constexpr float NORM_EPS = 1e-6f;

__device__ __forceinline__ unsigned cvt_pk_bf16(float lo, float hi) { unsigned r; asm("v_cvt_pk_bf16_f32 %0, %1, %2" : "=v"(r) : "v"(lo), "v"(hi)); return r; }
__device__ __forceinline__ float bf_lo(unsigned w) { return __uint_as_float(w << 16); }
__device__ __forceinline__ float bf_hi(unsigned w) { return __uint_as_float(w & 0xffff0000u); }
__device__ __forceinline__ float bf1(bf16_t b) { return __uint_as_float(((unsigned)b) << 16); }
__device__ __forceinline__ float fsigmoid(float x) { return __builtin_amdgcn_rcpf(1.0f + __expf(-x)); }
__device__ __forceinline__ float wave_sum(float v) {
#pragma unroll
    for (int o = 1; o < 64; o <<= 1) v += __shfl_xor(v, o);
    return v;
}
__device__ __forceinline__ f32x2 gelu_pk(f32x2 v) {
    const f32x2 av = __builtin_elementwise_abs(v), d = av * 0.2316418882f + 1.0f;
    f32x2 t; t.x = __builtin_amdgcn_rcpf(d.x); t.y = __builtin_amdgcn_rcpf(d.y);
    f32x2 q = t * 0.5307027145f + (-0.7265760135f); q = q * t + 0.7107068705f; q = q * t + (-0.142248368f); q = q * t + 0.127414796f; q = q * t;
    const f32x2 s = (v * v) * (-0.72134752044f);
    f32x2 e; e.x = __builtin_amdgcn_exp2f(s.x); e.y = __builtin_amdgcn_exp2f(s.y);
    const f32x2 m = v * (q * e), r = v - m;
    f32x2 o; o.x = v.x < 0.f ? m.x : r.x; o.y = v.y < 0.f ? m.y : r.y; return o;
}
#define LAUNDER_V(x) asm volatile("" : "+v"(x))
#define LAUNDER_S(x) asm volatile("" : "+s"(x))
#define LDS_WAIT() asm volatile("s_waitcnt lgkmcnt(0)" ::: "memory")
#define VM_WAIT() asm volatile("s_waitcnt vmcnt(0)" ::: "memory")
#define MFMA16(a, b, c) __builtin_amdgcn_mfma_f32_16x16x32_bf16((a), (b), (c), 0, 0, 0)

#define XB_TMO      128
#define XB_XCNT(j)  (256  + 64 * (j))
#define XB_XSUB(j)  (1280 + 64 * (j))
#define XB_XGEN(j)  (2304 + 64 * (j))
#define XB_TOP      3328
#define XB_TOPGEN   3392
#define XCD_BAR_WORDS 3456
#define XB_SPIN_CAP (1u << 18)
__device__ __forceinline__ unsigned xb_ld(unsigned* p)              { return __hip_atomic_load(p, __ATOMIC_RELAXED, __HIP_MEMORY_SCOPE_AGENT); }
__device__ __forceinline__ unsigned xb_add(unsigned* p, unsigned v) { return __hip_atomic_fetch_add(p, v, __ATOMIC_RELAXED, __HIP_MEMORY_SCOPE_AGENT); }
__device__ __forceinline__ unsigned xb_xcc_id() { return (unsigned)__builtin_amdgcn_s_getreg((3 << 11) | 20) & 0xFu; }
#define XB_SPIN(cond, bar) do { unsigned _sp = 0; while (cond) { __builtin_amdgcn_s_sleep(1); \
    if ((++_sp & 255u) == 0u) { if (xb_ld(&(bar)[XB_TMO])) break; if (_sp > XB_SPIN_CAP) { atomicAdd(&(bar)[XB_TMO], 1u); break; } } } } while (0)
struct XcdBarrier { unsigned* bar; unsigned x; volatile LAS unsigned* st; };
__device__ __forceinline__ XcdBarrier xcd_barrier_post(unsigned* bar, volatile LAS unsigned* st) {
    XcdBarrier b; b.bar = bar; b.x = xb_xcc_id(); b.st = st;
    if (threadIdx.x == 0) (void)xb_add(&bar[XB_XCNT(b.x)], 1u);
    return b;
}
__device__ __forceinline__ void xcd_barrier_complete(unsigned* bar, unsigned x, unsigned& nloc, unsigned& nx) {
    const unsigned G = gridDim.x * gridDim.y * gridDim.z;
    unsigned sum, cnt, mine, sp = 0u;
    for (;;) {
        sum = 0u; cnt = 0u; mine = 0u;
#pragma unroll
        for (unsigned j = 0; j < 16; ++j) { const unsigned c = xb_ld(&bar[XB_XCNT(j)]); sum += c; cnt += (c > 0u) ? 1u : 0u; mine = (j == x) ? c : mine; }
        if (sum == G) break;
        __builtin_amdgcn_s_sleep(1);
        if ((++sp & 255u) == 0u) { if (xb_ld(&bar[XB_TMO])) break; if (sp > XB_SPIN_CAP) { atomicAdd(&bar[XB_TMO], 1u); break; } }
    }
    nloc = mine > 0u ? mine : 1u; nx = cnt > 0u ? cnt : 1u;
}
__device__ __forceinline__ void xcd_barrier(const XcdBarrier& b) {
    asm volatile("s_waitcnt vmcnt(0)" ::: "memory");
    __syncthreads();
    if (threadIdx.x == 0) {
        unsigned* bar = b.bar;
        __builtin_amdgcn_s_waitcnt(0);
        unsigned nloc = b.st[0], nx = b.st[1];
        if (nloc == 0u) { xcd_barrier_complete(bar, b.x, nloc, nx); b.st[0] = nloc; b.st[1] = nx; }
        const unsigned old = xb_add(&bar[XB_XSUB(b.x)], 1u);
        const unsigned gen = old / nloc;
        if (old + 1u == (gen + 1u) * nloc) {
            __builtin_amdgcn_fence(__ATOMIC_RELEASE, "agent");
            asm volatile("s_waitcnt vmcnt(0)" ::: "memory");
            const unsigned og = xb_add(&bar[XB_TOP], 1u);
            const unsigned tg = og / nx;
            if (og + 1u == (tg + 1u) * nx) xb_add(&bar[XB_TOPGEN], 1u);
            else XB_SPIN(xb_ld(&bar[XB_TOPGEN]) == tg, bar);
            __builtin_amdgcn_fence(__ATOMIC_ACQUIRE, "agent");
            xb_add(&bar[XB_XGEN(b.x)], 1u);
            asm volatile("s_waitcnt vmcnt(0)" ::: "memory");
        } else {
            XB_SPIN(xb_ld(&bar[XB_XGEN(b.x)]) == gen, bar);
            __builtin_amdgcn_fence(__ATOMIC_ACQUIRE, "agent");
            asm volatile("s_waitcnt vmcnt(0)" ::: "memory");
        }
    }
    __syncthreads();
}

namespace pg8 {
constexpr int BM = 256, BK = 64, HALF = 128, HTB = HALF * BK * 2, STAGE_BYTES = 8 * HTB, NXCD = 8, WGM = 8;
__host__ __device__ __forceinline__ int lds_byte(int r, int c) { const int st = (r >> 4) * 2 + (c >> 5), rr = r & 15, cc = c & 31, ob = rr * 64 + cc * 2; return st * 1024 + (ob ^ (((ob >> 9) & 1) << 5)); }
__host__ __device__ __forceinline__ void stage_rc(int b, int& R, int& C) { const int st = b / 1024, sb = b % 1024, swz = sb ^ (((sb >> 9) & 1) << 5); R = (st >> 1) * 16 + swz / 64; C = (st & 1) * 32 + (swz % 64) / 2; }
__host__ __device__ __forceinline__ int perm32(int rho) { const int n = rho >> 4, i = rho & 15; return 8 * (i >> 2) + 4 * n + (i & 3); }

struct Unit { int pm, pn, seg; };

struct TileOrder {
    int nM, nN, nwg, G, c;
    __device__ __forceinline__ void init(int nM_, int nN_, int G_, int c_) { nM = nM_; nN = nN_; nwg = nM * nN; G = G_; c = c_; }
    __device__ __forceinline__ bool tile(int i, int& pm, int& pn) const {
        const long L = (long)i * G + c; if (L >= nwg) return false;
        int wgid = (int)L; { const int q = nwg / NXCD, r = nwg % NXCD, xcd = wgid % NXCD, off = wgid / NXCD; wgid = (xcd < r ? xcd * (q + 1) : r * (q + 1) + (xcd - r) * q) + off; }
        const int nig = WGM * nN, gid = wgid / nig, fm = gid * WGM, gsz = (nM - fm) < WGM ? (nM - fm) : WGM;
        pm = fm + ((wgid % nig) % gsz); pn = (wgid % nig) / gsz; return true;
    }
};
struct SchedPlain {
    TileOrder T; const char* A; const char* B; size_t astep, bstep;
    __device__ __forceinline__ bool next(int i, Unit& u) const { u.seg = 0; return T.tile(i, u.pm, u.pn); }
    __device__ __forceinline__ const char* a_ptr(const Unit& u) const { return A + (size_t)u.pm * astep; }
    __device__ __forceinline__ const char* b_ptr(const Unit& u) const { return B + (size_t)u.pn * bstep; }
};
struct SchedBranch {
    TileOrder T; const char* A; const char* B; size_t astep, bstep, aseg, bseg;
    __device__ __forceinline__ bool next(int i, Unit& u) const { const int t = i / 3; u.seg = i - 3 * t; return T.tile(t, u.pm, u.pn); }
    __device__ __forceinline__ const char* a_ptr(const Unit& u) const { return A + (size_t)u.seg * aseg + (size_t)u.pm * astep; }
    __device__ __forceinline__ const char* b_ptr(const Unit& u) const { return B + (size_t)u.seg * bseg + (size_t)u.pn * bstep; }
};

template <class Epi, class Sched>
__device__ __forceinline__ void gemm_phase(LAS unsigned char* lds, const int K, const int lda, const int ldb, const Sched& S, const Epi& E) {
    int tid = threadIdx.x; LAUNDER_V(tid);
    const int wid = __builtin_amdgcn_readfirstlane(tid >> 6), lane = tid & 63, wr = wid >> 2, wc = wid & 3, fr = lane & 15, fq = lane >> 4;
    const int nt = K / BK;
    unsigned voffA[2], voffB[2];
#pragma unroll
    for (int i = 0; i < 2; ++i) { int R, C; stage_rc(tid * 16 + i * 8192, R, C); const int Rb = Epi::PERM ? ((R & ~31) + perm32(R & 31)) : R;
        voffA[i] = (unsigned)(R * lda + C) * 2u; voffB[i] = (unsigned)(Rb * ldb + C) * 2u; }
    const size_t kstep = (size_t)(BK * 2);
    const size_t hstepA = (size_t)HALF * lda * 2, hstepB = (size_t)HALF * ldb * 2;
    const unsigned ldsw = (unsigned)wid * 1024u;
    const int aoff = lds_byte(wr * 64 + fr, fq * 8), boff = lds_byte(wc * 32 + fr, fq * 8);
#define PG8_SA(b, h) (((b) * 2 + (h)) * HTB)
#define PG8_SB(b, h) ((4 + (b) * 2 + (h)) * HTB)
#define PG8_STAGE(bufoff, gbase, voff) do { _Pragma("unroll") for (int _i = 0; _i < 2; ++_i) \
        __builtin_amdgcn_global_load_lds((const unsigned*)((const char*)(gbase) + (voff)[_i]), (LAS unsigned*)(lds + (bufoff) + ldsw + _i * 8192), 16, 0, 0); } while (0)
#define PG8_LDA(dst, b, h) do { _Pragma("unroll") for (int m = 0; m < 4; ++m) _Pragma("unroll") for (int k = 0; k < 2; ++k) dst[m][k] = *(const LAS bf16x8*)(lds + PG8_SA(b, h) + aoff + m * 2048 + k * 1024); } while (0)
#define PG8_LDB(dst, b, h) do { _Pragma("unroll") for (int n = 0; n < 2; ++n) _Pragma("unroll") for (int k = 0; k < 2; ++k) dst[n][k] = *(const LAS bf16x8*)(lds + PG8_SB(b, h) + boff + n * 2048 + k * 1024); } while (0)
#define PG8_MMA(ai, bj, At, Bt) do { __builtin_amdgcn_s_setprio(1); _Pragma("unroll") for (int m = 0; m < 4; ++m) _Pragma("unroll") for (int n = 0; n < 2; ++n) _Pragma("unroll") for (int k = 0; k < 2; ++k) \
        acc[ai][bj][m][n] = __builtin_amdgcn_mfma_f32_16x16x32_bf16(Bt[n][k], At[m][k], acc[ai][bj][m][n], 0, 0, 0); __builtin_amdgcn_s_setprio(0); } while (0)
#define PG8_WAIT_V(n) asm volatile("s_waitcnt vmcnt(" #n ")" ::: "memory")
#define PG8_WAIT_L(n) asm volatile("s_waitcnt lgkmcnt(" #n ")" ::: "memory")
#define PG8_BAR __builtin_amdgcn_s_barrier()
#define PG8_SCHED __builtin_amdgcn_sched_barrier(0)
    Unit cur, nxt; int ui = 0;
    if (!S.next(0, cur)) return;
    f32x4 acc[2][2][4][2];
#pragma unroll
    for (int a = 0; a < 2; ++a)
#pragma unroll
        for (int b = 0; b < 2; ++b)
#pragma unroll
            for (int m = 0; m < 4; ++m)
#pragma unroll
                for (int n = 0; n < 2; ++n) acc[a][b][m][n] = (f32x4){0.f, 0.f, 0.f, 0.f};
    bf16x8 At[4][2], B0[2][2], B1[2][2];
    const char* cA = S.a_ptr(cur); const char* cB = S.b_ptr(cur);
    PG8_STAGE(PG8_SB(0, 0), cB, voffB); PG8_STAGE(PG8_SB(0, 1), cB + hstepB, voffB); PG8_STAGE(PG8_SA(0, 0), cA, voffA); PG8_STAGE(PG8_SA(0, 1), cA + hstepA, voffA);
    if (wr == 1) PG8_BAR;
    PG8_WAIT_V(2); PG8_BAR;
    PG8_STAGE(PG8_SB(1, 0), cB + kstep, voffB); PG8_STAGE(PG8_SA(1, 0), cA + kstep, voffA); PG8_STAGE(PG8_SB(1, 1), cB + hstepB + kstep, voffB);
    PG8_WAIT_V(6); PG8_BAR;
    for (;;) {
        const bool has_next = S.next(ui + 1, nxt);
        const char* nA = has_next ? S.a_ptr(nxt) : cA; const char* nB = has_next ? S.b_ptr(nxt) : cB;
        for (int t = 0; t < nt; t += 2) {
            const bool last = (t == nt - 2);
            const char* a1 = cA + (size_t)(t + 1) * kstep;
            const char* a2 = last ? nA : cA + (size_t)(t + 2) * kstep; const char* b2 = last ? nB : cB + (size_t)(t + 2) * kstep;
            const char* a3 = a2 + kstep; const char* b3 = b2 + kstep;
            PG8_LDB(B0, 0, 0); PG8_LDB(B1, 0, 1); PG8_SCHED; PG8_LDA(At, 0, 0); PG8_STAGE(PG8_SA(1, 1), a1 + hstepA, voffA);
            PG8_WAIT_V(8); PG8_WAIT_L(0); PG8_BAR; PG8_MMA(0, 0, At, B0); PG8_MMA(0, 1, At, B1); PG8_BAR; PG8_SCHED;
            PG8_LDA(At, 0, 1); PG8_STAGE(PG8_SB(0, 0), b2, voffB); PG8_STAGE(PG8_SB(0, 1), b2 + hstepB, voffB); PG8_STAGE(PG8_SA(0, 0), a2, voffA);
            PG8_WAIT_V(8); PG8_WAIT_L(0); PG8_BAR; PG8_MMA(1, 0, At, B0); PG8_MMA(1, 1, At, B1); PG8_BAR; PG8_SCHED;
            PG8_LDB(B0, 1, 0); PG8_LDB(B1, 1, 1); PG8_SCHED; PG8_LDA(At, 1, 0); PG8_STAGE(PG8_SA(0, 1), a2 + hstepA, voffA);
            PG8_WAIT_V(8); PG8_WAIT_L(0); PG8_BAR; PG8_MMA(0, 0, At, B0); PG8_MMA(0, 1, At, B1); PG8_BAR; PG8_SCHED;
            PG8_LDA(At, 1, 1); PG8_STAGE(PG8_SB(1, 0), b3, voffB); PG8_STAGE(PG8_SB(1, 1), b3 + hstepB, voffB); PG8_STAGE(PG8_SA(1, 0), a3, voffA);
            PG8_WAIT_V(8); PG8_WAIT_L(0); PG8_BAR; PG8_MMA(1, 0, At, B0); PG8_MMA(1, 1, At, B1); PG8_BAR; PG8_SCHED;
        }
        if (wr == 0) PG8_BAR;
        E(acc, cur, wr, wc, fr, fq);
        if (!has_next) break;
        if (!E.keep(cur)) {
#pragma unroll
            for (int a = 0; a < 2; ++a)
#pragma unroll
                for (int b = 0; b < 2; ++b)
#pragma unroll
                    for (int m = 0; m < 4; ++m)
#pragma unroll
                        for (int n = 0; n < 2; ++n) acc[a][b][m][n] = (f32x4){0.f, 0.f, 0.f, 0.f};
        }
        cur = nxt; cA = nA; cB = nB; ++ui;
        if (wr == 1) PG8_BAR;
    }
    PG8_WAIT_V(0);
    PG8_BAR;
#undef PG8_SA
#undef PG8_SB
#undef PG8_STAGE
#undef PG8_LDA
#undef PG8_LDB
#undef PG8_MMA
#undef PG8_WAIT_V
#undef PG8_WAIT_L
#undef PG8_BAR
#undef PG8_SCHED
}
}

constexpr size_t MiB = 1u << 20;
constexpr size_t WS_CTL = 0, CTL_ZERO_BYTES = 1 * MiB;
constexpr int CW_BAR = 4096;
constexpr size_t CTL_SSQ1 = 256 * 1024;
constexpr size_t SZ_WIN = (size_t)N_IN_T * DM * 2, SZ_WBR = (size_t)3 * DM * BW * 2, SZ_WSQ = (size_t)DM * DM * 2, SZ_WPP = (size_t)DM * 256 * 2;
constexpr size_t WS_WIN = 2 * MiB;
constexpr size_t WS_WBR = WS_WIN + 2 * SZ_WIN;
constexpr size_t WS_WOUT = WS_WBR + 2 * SZ_WBR;
constexpr size_t WS_WPG = WS_WOUT + 2 * SZ_WSQ;
constexpr size_t WS_WPP = WS_WPG + 2 * SZ_WSQ;
constexpr size_t SZ_ROWS_BW = (size_t)M_ROWS * BW * 2, SZ_ROWS_D = (size_t)M_ROWS * DM * 2;
constexpr size_t WS_XB = WS_WPP + 2 * SZ_WPP;
constexpr size_t WS_PB = WS_XB + SZ_ROWS_D;
constexpr size_t WS_CS = WS_PB + (size_t)2 * M_ROWS * 256 * 2;
constexpr size_t WS_SSQ0 = WS_CS + (size_t)M_ROWS * 16 * 4;
constexpr size_t WS_AU = WS_SSQ0 + (size_t)M_ROWS * 4;
constexpr size_t WS_AV = WS_AU + SZ_ROWS_BW, WS_AZ = WS_AV + SZ_ROWS_BW, WS_BQ = WS_AZ + SZ_ROWS_BW;
constexpr size_t WS_BK = WS_BQ + SZ_ROWS_BW;
constexpr size_t WS_BV = WS_BK + (size_t)M_ROWS * 256 * 2;
constexpr size_t WS_BZ = WS_BV + (size_t)M_ROWS * 256 * 2;
constexpr size_t WS_CQ = WS_BZ + SZ_ROWS_BW;
constexpr size_t WS_CK = WS_CQ + (size_t)M_ROWS * 1024 * 2;
constexpr size_t WS_CV = WS_CK + (size_t)M_ROWS * 1024 * 2;
constexpr size_t WS_CO = WS_CV + SZ_ROWS_BW, WS_CZ = WS_CO + SZ_ROWS_BW;
constexpr size_t WS_G = WS_CZ + SZ_ROWS_BW;
constexpr size_t WS_IF = WS_G + (size_t)M_ROWS * 12288 * 2;
constexpr size_t WS_LNP = WS_IF + (size_t)M_ROWS * 8 * 4;
constexpr size_t WS_YA = WS_LNP + (size_t)M_ROWS * 32 * 8;
constexpr size_t WS_NUM = WS_YA + 3 * SZ_ROWS_BW;
constexpr size_t WS_SSQC = WS_NUM + SZ_ROWS_BW;
constexpr size_t WS_DN = WS_SSQC + (size_t)M_ROWS * 64 * 4;
constexpr size_t WS_MIX = WS_DN + (size_t)M_ROWS * 4 * 4;
constexpr size_t WS_OUT = WS_MIX + SZ_ROWS_D;
constexpr size_t WS_OUTP = WS_OUT + SZ_ROWS_D;
constexpr size_t WS_ERAW = WS_OUTP + (size_t)M_ROWS * 64 * 4;
constexpr size_t WS_ERP = WS_ERAW + SZ_ROWS_D;
constexpr size_t WS_RSO = WS_ERP + (size_t)M_ROWS * 64 * 4;
constexpr size_t WS_RSE = WS_RSO + (size_t)M_ROWS * 4;
constexpr size_t WS_X1B = WS_RSE + (size_t)M_ROWS * 4;
constexpr size_t WS_END = WS_X1B + SZ_ROWS_D;
static_assert(WS_WIN % 256 == 0 && WS_XB % 256 == 0 && WS_AU % 256 == 0 && WS_G % 256 == 0 && WS_YA % 256 == 0 && WS_MIX % 256 == 0 && WS_X1B % 256 == 0, "alignment");

namespace pg8 {
struct EpiIn {
    static constexpr bool PERM = true;
    const float* ssq; unsigned char* ws;
    __device__ __forceinline__ bool keep(const Unit&) const { return false; }
    __device__ __forceinline__ void operator()(f32x4 (&acc)[2][2][4][2], const Unit& u, int wr, int wc, int fr, int fq) const {
        const int pn = u.pn; const int row0 = u.pm * BM + wr * 64 + fr;
        size_t off; int ldc, t0, act; float sc = 1.f;
        if (pn < 8)        { off = WS_AU; ldc = 2048; t0 = 0; act = 1; }
        else if (pn < 16)  { off = WS_AV; ldc = 2048; t0 = 8; act = 5; }
        else if (pn < 24)  { off = WS_AZ; ldc = 2048; t0 = 16; act = 2; }
        else if (pn < 32)  { off = WS_BQ; ldc = 2048; t0 = 24; act = 0; }
        else if (pn < 33)  { off = WS_BK; ldc = 256; t0 = 32; act = 0; }
        else if (pn < 34)  { off = WS_BV; ldc = 256; t0 = 33; act = 0; }
        else if (pn < 42)  { off = WS_BZ; ldc = 2048; t0 = 34; act = 2; }
        else if (pn < 46)  { off = WS_CQ; ldc = 1024; t0 = 42; act = 0; sc = 0.0625f; }
        else if (pn < 50)  { off = WS_CK; ldc = 1024; t0 = 46; act = 0; }
        else if (pn < 58)  { off = WS_CV; ldc = 2048; t0 = 50; act = 0; }
        else if (pn < 66)  { off = WS_CO; ldc = 2048; t0 = 58; act = 3; }
        else if (pn < 74)  { off = WS_CZ; ldc = 2048; t0 = 66; act = 2; }
        else if (pn < 122) { off = WS_G; ldc = 12288; t0 = 74; act = 3; }
        else               { off = WS_IF; ldc = 8; t0 = 122; act = 4; }
        const int col0 = (pn - t0) * BM + wc * 32 + 8 * fq;
        if (act == 4) {
            if (wc == 0 && fq == 0) {
                float* dst = (float*)(ws + off);
#pragma unroll
                for (int ai = 0; ai < 2; ++ai)
#pragma unroll
                    for (int m = 0; m < 4; ++m) { const int row = row0 + ai * HALF + m * 16; const float rs = rsqrtf(ssq[row] * (1.0f / DM) + NORM_EPS);
                        *(f32x4*)(dst + (size_t)row * 8) = acc[ai][0][m][0] * rs; *(f32x4*)(dst + (size_t)row * 8 + 4) = acc[ai][0][m][1] * rs; }
            }
            return;
        }
        bf16_t* base = (bf16_t*)(ws + off);
#pragma unroll
        for (int ai = 0; ai < 2; ++ai)
#pragma unroll
            for (int m = 0; m < 4; ++m) {
                const int row = row0 + ai * HALF + m * 16; const float rs = rsqrtf(ssq[row] * (1.0f / DM) + NORM_EPS) * sc;
                bf16_t* rowp = base + (size_t)row * ldc + col0; float ls = 0.f, lq = 0.f;
#pragma unroll
                for (int bj = 0; bj < 2; ++bj) {
                    f32x4 v0 = acc[ai][bj][m][0] * rs, v1 = acc[ai][bj][m][1] * rs;
                    if (act == 1 || act == 5) {
                        f32x2 a = gelu_pk((f32x2){v0[0], v0[1]}), b = gelu_pk((f32x2){v0[2], v0[3]}), c = gelu_pk((f32x2){v1[0], v1[1]}), d = gelu_pk((f32x2){v1[2], v1[3]});
                        v0 = (f32x4){a.x, a.y, b.x, b.y}; v1 = (f32x4){c.x, c.y, d.x, d.y};
                        if (act == 5) { ls += (v0[0] + v0[1]) + (v0[2] + v0[3]) + (v1[0] + v1[1]) + (v1[2] + v1[3]);
                            lq += (v0[0] * v0[0] + v0[1] * v0[1]) + (v0[2] * v0[2] + v0[3] * v0[3]) + (v1[0] * v1[0] + v1[1] * v1[1]) + (v1[2] * v1[2] + v1[3] * v1[3]); }
                    } else if (act == 2) {
#pragma unroll
                        for (int j = 0; j < 4; ++j) { v0[j] = v0[j] * fsigmoid(v0[j]); v1[j] = v1[j] * fsigmoid(v1[j]); }
                    } else if (act == 3) {
#pragma unroll
                        for (int j = 0; j < 4; ++j) { v0[j] = fsigmoid(v0[j]); v1[j] = fsigmoid(v1[j]); }
                    }
                    u32x4 w; w.x = cvt_pk_bf16(v0[0], v0[1]); w.y = cvt_pk_bf16(v0[2], v0[3]); w.z = cvt_pk_bf16(v1[0], v1[1]); w.w = cvt_pk_bf16(v1[2], v1[3]);
                    *(u32x4*)(rowp + bj * HALF) = w;
                }
                if (act == 5) {
                    ls += __shfl_xor(ls, 16); ls += __shfl_xor(ls, 32); lq += __shfl_xor(lq, 16); lq += __shfl_xor(lq, 32);
                    if (fq == 0) *(f32x2*)(ws + WS_LNP + ((size_t)row * 32 + (pn - 8) * 4 + wc) * 8) = (f32x2){ls, lq};
                }
            }
    }
};
struct EpiBranch {
    static constexpr bool PERM = true;
    const bf16_t* G; bf16_t* MIX;
    __device__ __forceinline__ bool keep(const Unit& u) const { return u.seg != 2; }
    __device__ __forceinline__ void operator()(f32x4 (&acc)[2][2][4][2], const Unit& u, int wr, int wc, int fr, int fq) const {
        const int row0 = u.pm * BM + wr * 64 + fr, col0 = u.pn * BM + wc * 32 + 8 * fq; const int seg = u.seg;
#pragma unroll
        for (int ai = 0; ai < 2; ++ai)
#pragma unroll
            for (int m = 0; m < 4; ++m) {
                const int row = row0 + ai * HALF + m * 16; const bf16_t* gp = G + (size_t)row * 12288 + seg * DM + col0;
#pragma unroll
                for (int bj = 0; bj < 2; ++bj) {
                    const u32x4 ga = *(const u32x4*)(gp + bj * HALF);
                    float f[8] = {bf_lo(ga.x), bf_hi(ga.x), bf_lo(ga.y), bf_hi(ga.y), bf_lo(ga.z), bf_hi(ga.z), bf_lo(ga.w), bf_hi(ga.w)};
#pragma unroll
                    for (int j = 0; j < 8; ++j) f[j] = fmaxf(f[j], 1e-20f);
                    if (seg != 2) {
                        const u32x4 gb = *(const u32x4*)(gp + DM + bj * HALF);
                        const float h[8] = {bf_lo(gb.x), bf_hi(gb.x), bf_lo(gb.y), bf_hi(gb.y), bf_lo(gb.z), bf_hi(gb.z), bf_lo(gb.w), bf_hi(gb.w)};
#pragma unroll
                        for (int j = 0; j < 8; ++j) f[j] = f[j] * __builtin_amdgcn_rcpf(fmaxf(h[j], 1e-20f));
                    }
                    f32x4 v0 = acc[ai][bj][m][0], v1 = acc[ai][bj][m][1];
                    v0 = v0 * (f32x4){f[0], f[1], f[2], f[3]}; v1 = v1 * (f32x4){f[4], f[5], f[6], f[7]};
                    if (seg != 2) { acc[ai][bj][m][0] = v0; acc[ai][bj][m][1] = v1; }
                    else { u32x4 w; w.x = cvt_pk_bf16(v0[0], v0[1]); w.y = cvt_pk_bf16(v0[2], v0[3]); w.z = cvt_pk_bf16(v1[0], v1[1]); w.w = cvt_pk_bf16(v1[2], v1[3]);
                        *(u32x4*)(MIX + (size_t)row * DM + col0 + bj * HALF) = w; }
                }
                if (m == 3) asm volatile("" ::: "memory");
            }
    }
};
struct EpiSq {
    static constexpr bool PERM = true;
    bf16_t* O; float* P;
    __device__ __forceinline__ bool keep(const Unit&) const { return false; }
    __device__ __forceinline__ void operator()(f32x4 (&acc)[2][2][4][2], const Unit& u, int wr, int wc, int fr, int fq) const {
        const int row0 = u.pm * BM + wr * 64 + fr, col0 = u.pn * BM + wc * 32 + 8 * fq;
#pragma unroll
        for (int ai = 0; ai < 2; ++ai)
#pragma unroll
            for (int m = 0; m < 4; ++m) {
                const int row = row0 + ai * HALF + m * 16; float q = 0.f;
#pragma unroll
                for (int bj = 0; bj < 2; ++bj) {
                    const f32x4 v0 = acc[ai][bj][m][0], v1 = acc[ai][bj][m][1];
                    q += (v0[0] * v0[0] + v0[1] * v0[1]) + (v0[2] * v0[2] + v0[3] * v0[3]) + (v1[0] * v1[0] + v1[1] * v1[1]) + (v1[2] * v1[2] + v1[3] * v1[3]);
                    u32x4 w; w.x = cvt_pk_bf16(v0[0], v0[1]); w.y = cvt_pk_bf16(v0[2], v0[3]); w.z = cvt_pk_bf16(v1[0], v1[1]); w.w = cvt_pk_bf16(v1[2], v1[3]);
                    *(u32x4*)(O + (size_t)row * DM + col0 + bj * HALF) = w;
                }
                q += __shfl_xor(q, 16); q += __shfl_xor(q, 32);
                if (fq == 0) P[(size_t)row * 64 + u.pn * 4 + wc] = q;
            }
    }
};
struct EpiPle {
    static constexpr bool PERM = false;
    const float* XIN; float* XOUT; bf16_t* XB; const bf16_t* OUT; const bf16_t* ERAW; const float* RSO; const float* RSE; const float* npost; const float* pnorm; float* SSQN; int last;
    __device__ __forceinline__ bool keep(const Unit&) const { return false; }
    __device__ __forceinline__ void operator()(f32x4 (&acc)[2][2][4][2], const Unit& u, int wr, int wc, int fr, int fq) const {
        const int row0 = u.pm * BM + wr * 64 + fr, col0 = u.pn * BM + wc * 32 + 4 * fq;
#pragma unroll
        for (int ai = 0; ai < 2; ++ai)
#pragma unroll
            for (int m = 0; m < 4; ++m) {
                const int row = row0 + ai * HALF + m * 16; const float rso = RSO[row], rse = RSE[row]; float q = 0.f; const size_t ro = (size_t)row * DM;
#pragma unroll
                for (int bj = 0; bj < 2; ++bj)
#pragma unroll
                    for (int n = 0; n < 2; ++n) {
                        const int col = col0 + bj * HALF + n * 16;
                        const f32x4 x = *(const f32x4*)(XIN + ro + col); const u32x2 ob = *(const u32x2*)(OUT + ro + col), eb = *(const u32x2*)(ERAW + ro + col);
                        const f32x4 np = *(const f32x4*)(npost + col), pn = *(const f32x4*)(pnorm + col);
                        const f32x4 o = {bf_lo(ob.x), bf_hi(ob.x), bf_lo(ob.y), bf_hi(ob.y)}, e = {bf_lo(eb.x), bf_hi(eb.x), bf_lo(eb.y), bf_hi(eb.y)};
                        const f32x4 a = acc[ai][bj][m][n]; f32x4 r;
#pragma unroll
                        for (int j = 0; j < 4; ++j) { const float x1 = x[j] + o[j] * rso * np[j]; r[j] = x1 + fsigmoid(a[j]) * (e[j] * rse * pn[j]); q += r[j] * r[j]; }
                        *(f32x4*)(XOUT + ro + col) = r;
                        if (!last) { u32x2 w; w.x = cvt_pk_bf16(r[0], r[1]); w.y = cvt_pk_bf16(r[2], r[3]); *(u32x2*)(XB + ro + col) = w; }
                    }
                if (!last) { q += __shfl_xor(q, 16); q += __shfl_xor(q, 32); if (fq == 0) atomicAdd(SSQN + row, q); }
                if (m & 1) asm volatile("" ::: "memory");
            }
    }
};
}

constexpr int LDS_BYTES = 147456;
constexpr int MISC_OFF = LDS_BYTES - 128;
constexpr int ARGS_OFF = LDS_BYTES - 512;
constexpr int NWAVES = 8, NTHREADS = 512;

struct Ctx {
    LAS unsigned char* lds; int tid, lane, wave, vcu, G;
};

struct TrTile { const float* W; const float* kscale; bf16_t* WT; int ldw, K; };
constexpr int TR_PER_LAYER = 7808 + 1536 + 1024 + 1024 + 64;
__device__ __forceinline__ TrTile tr_decode(int it, const float* w_in, const float* norm_pre, const float* w_branch, const float* w_out, const float* ple_gate, const float* ple_proj, unsigned char* ws) {
    const int l = it / TR_PER_LAYER; int r = it - l * TR_PER_LAYER; TrTile t; int kt, ntile;
    if (r < 7808) { kt = r / 244; ntile = r - kt * 244; const int src = ntile < 116 ? ntile * 128 : ntile * 128 + 8;
        t.ldw = N_IN; t.K = DM; t.W = w_in + (size_t)l * DM * N_IN + (size_t)kt * 128 * N_IN + src; t.kscale = norm_pre + l * DM + kt * 128;
        t.WT = (bf16_t*)(ws + WS_WIN + (size_t)l * SZ_WIN) + (size_t)ntile * 128 * DM + kt * 128; return t; }
    r -= 7808; t.kscale = nullptr; t.ldw = DM;
    if (r < 1536) { const int j = r / 512; const int rr = r - j * 512; kt = rr / 32; ntile = rr - kt * 32; t.K = BW;
        t.W = w_branch + ((size_t)(l * 3 + j) * BW + (size_t)kt * 128) * DM + ntile * 128;
        t.WT = (bf16_t*)(ws + WS_WBR + (size_t)l * SZ_WBR) + (size_t)j * DM * BW + (size_t)ntile * 128 * BW + kt * 128; return t; }
    r -= 1536;
    if (r < 2048) { const int which = r / 1024; const int rr = r - which * 1024; kt = rr / 32; ntile = rr - kt * 32; t.K = DM;
        t.W = (which ? ple_gate : w_out) + ((size_t)l * DM + (size_t)kt * 128) * DM + ntile * 128;
        t.WT = (bf16_t*)(ws + (which ? WS_WPG : WS_WOUT) + (size_t)l * SZ_WSQ) + (size_t)ntile * 128 * DM + kt * 128; return t; }
    r -= 2048; kt = r / 32; ntile = r - kt * 32; t.K = 256;
    t.W = ple_proj + ((size_t)l * 256 + (size_t)kt * 128) * DM + ntile * 128;
    t.WT = (bf16_t*)(ws + WS_WPP + (size_t)l * SZ_WPP) + (size_t)ntile * 128 * 256 + kt * 128; return t;
}
__device__ __forceinline__ void tr_run(const Ctx& F, int it0, int it1, int sk0, int sk1, int me, int nw, const float* w_in, const float* norm_pre, const float* w_branch,
                                       const float* w_out, const float* ple_gate, const float* ple_proj, unsigned char* ws) {
    int tid = F.tid; LAUNDER_V(tid);
    {
        constexpr int RS = 264; const int NIT = it1 - it0 - (sk1 - sk0);
        const int c4 = tid & 31, kr = tid >> 5, kc = tid & 15;
        f32x4 va[8], vb[8]; float ka[8], kb[8]; TrTile ta, tb;
#define TR_LOAD(T_, V_, K_, IT_) do { T_ = tr_decode(it0 + (IT_) + (((it0 + (IT_)) >= sk0) ? (sk1 - sk0) : 0), w_in, norm_pre, w_branch, w_out, ple_gate, ple_proj, ws); \
        _Pragma("unroll") for (int i = 0; i < 8; ++i) { V_[i] = *(const f32x4*)(T_.W + (size_t)(i * 16 + kr) * T_.ldw + 4 * c4); K_[i] = T_.kscale ? T_.kscale[i * 16 + kr] : 1.0f; } } while (0)
#define TR_PUT(V_, K_) do { _Pragma("unroll") for (int i = 0; i < 8; ++i) { const f32x4 a = V_[i] * K_[i]; u32x2 w; w.x = cvt_pk_bf16(a[0], a[1]); w.y = cvt_pk_bf16(a[2], a[3]); \
        *(LAS u32x2*)(F.lds + (i * 16 + kr) * RS + c4 * 8) = w; } } while (0)
#define TR_GET(WT_, K_) do { _Pragma("unroll") for (int q = 0; q < 4; ++q) { const int n = 32 * q + (tid >> 4); const LAS bf16_t* s = (const LAS bf16_t*)(F.lds + (8 * kc) * RS + 2 * n); unsigned e[8]; \
        _Pragma("unroll") for (int j = 0; j < 8; ++j) e[j] = s[j * (RS / 2)]; \
        u32x4 o; o.x = e[0] | (e[1] << 16); o.y = e[2] | (e[3] << 16); o.z = e[4] | (e[5] << 16); o.w = e[6] | (e[7] << 16); \
        *(u32x4*)(WT_ + (size_t)n * K_ + 8 * kc) = o; } } while (0)
        int it = me;
        if (it < NIT) TR_LOAD(ta, va, ka, it);
        if (it + nw < NIT) TR_LOAD(tb, vb, kb, it + nw);
        while (it < NIT) {
            { TR_PUT(va, ka); __syncthreads(); bf16_t* wt = ta.WT; const int kk = ta.K;
              if (it + 2 * nw < NIT) TR_LOAD(ta, va, ka, it + 2 * nw);
              TR_GET(wt, kk); __syncthreads(); }
            it += nw; if (it >= NIT) break;
            { TR_PUT(vb, kb); __syncthreads(); bf16_t* wt = tb.WT; const int kk = tb.K;
              if (it + 2 * nw < NIT) TR_LOAD(tb, vb, kb, it + 2 * nw);
              TR_GET(wt, kk); __syncthreads(); }
            it += nw;
        }
#undef TR_LOAD
#undef TR_PUT
#undef TR_GET
    }
}
constexpr int TR_DEFER0 = TR_PER_LAYER + 7808 + 1536, TR_DEFER1 = TR_DEFER0 + 2048;
__device__ __forceinline__ void p0_prologue(const Ctx& F, const float* x, const float* p, const int* positions, const float* norm_pre, const float* w_in, const float* w_branch,
                                            const float* w_out, const float* ple_gate, const float* ple_proj, unsigned char* ws) {
    int tid = F.tid; LAUNDER_V(tid);
    tr_run(F, 0, NLAYER * TR_PER_LAYER, TR_DEFER0, TR_DEFER1, F.vcu, F.G, w_in, norm_pre, w_branch, w_out, ple_gate, ple_proj, ws);
    const int gt = F.vcu * NTHREADS + tid, NGT = F.G * NTHREADS;
    for (int i = gt; i < NLAYER * 256 * DM; i += NGT) { const int l = i / (256 * DM), rr = (i / DM) & 255, k = i & (DM - 1);
        float val = 0.f; if (rr < 8) val = w_in[(size_t)l * DM * N_IN + (size_t)k * N_IN + IF_COL + rr] * norm_pre[l * DM + k];
        ((bf16_t*)(ws + WS_WIN + (size_t)l * SZ_WIN))[(size_t)(122 * 256 + rr) * DM + k] = (bf16_t)(cvt_pk_bf16(val, 0.f) & 0xffffu); }
    for (int i = gt; i < NLAYER * M_ROWS * 256 / 4; i += NGT) { const f32x4 a = ((const f32x4*)p)[i]; u32x2 w; w.x = cvt_pk_bf16(a[0], a[1]); w.y = cvt_pk_bf16(a[2], a[3]); ((u32x2*)(ws + WS_PB))[i] = w; }
    for (int i = gt; i < M_ROWS * 8; i += NGT) { const int row = i >> 3, j = i & 7; const float inv = powf(500000.0f, -(float)j * 0.125f); const float ang = (float)positions[row] * inv;
        float* cs = (float*)(ws + WS_CS) + (size_t)row * 16; cs[j] = cosf(ang); cs[8 + j] = sinf(ang); }
    { const int gw = F.vcu * NWAVES + F.wave, NGW = F.G * NWAVES;
      for (int m = gw; m < M_ROWS; m += NGW) { const f32x4* xr = (const f32x4*)(x + (size_t)m * DM) + F.lane; u32x2* o = (u32x2*)(ws + WS_XB + (size_t)m * DM * 2) + F.lane; float s = 0.f;
#pragma unroll
          for (int j = 0; j < 16; ++j) { const f32x4 a = xr[64 * j]; s += (a[0] * a[0] + a[1] * a[1]) + (a[2] * a[2] + a[3] * a[3]); u32x2 w; w.x = cvt_pk_bf16(a[0], a[1]); w.y = cvt_pk_bf16(a[2], a[3]); o[64 * j] = w; }
          s = wave_sum(s); if (F.lane == 0) ((float*)(ws + WS_SSQ0))[m] = s; } }
}

__device__ __forceinline__ u32x2 pack4(const f32x4 v) { u32x2 w; w.x = cvt_pk_bf16(v[0], v[1]); w.y = cvt_pk_bf16(v[2], v[3]); return w; }
__device__ __forceinline__ bf16x8 mk_frag(const u32x2 lo, const u32x2 hi) { const u32x4 t = {lo.x, lo.y, hi.x, hi.y}; return __builtin_bit_cast(bf16x8, t); }
__device__ __forceinline__ bf16x8 frag_const(unsigned w) { const u32x4 t = {w, w, w, w}; return __builtin_bit_cast(bf16x8, t); }

constexpr int GM_WL = 0, GM_VT = 34816, GM_ST = 104448, GM_RS = 272;
__device__ __forceinline__ void gmlp_unit(const Ctx& F, int b, int n, int g, unsigned char* ws, const float* ln_g, const float* ln_b, const float* wsp, const float* bsp) {
    int tid = F.tid; LAUNDER_V(tid); const int lane = tid & 63, w = F.wave, r16 = lane & 15, q4 = lane >> 4;
    const int row0 = b * SEQ + n * 128, c0 = g * 256;
    const bf16_t* AU = (const bf16_t*)(ws + WS_AU); const bf16_t* AV = (const bf16_t*)(ws + WS_AV); const bf16_t* AZ = (const bf16_t*)(ws + WS_AZ); bf16_t* YA = (bf16_t*)(ws + WS_YA);
    if (tid < 128) { const f32x2* pp = (const f32x2*)(ws + WS_LNP) + (size_t)(row0 + tid) * 32; float s = 0.f, q = 0.f;
#pragma unroll 8
        for (int j = 0; j < 32; ++j) { const f32x2 t = pp[j]; s += t.x; q += t.y; }
        const float mu = s * (1.0f / BW); const float var = fmaxf(q * (1.0f / BW) - mu * mu, 0.f);
        *(LAS f32x2*)(F.lds + GM_ST + tid * 8) = (f32x2){mu, rsqrtf(var + NORM_EPS)}; }
#pragma unroll
    for (int k = 0; k < 8; ++k) { const int item = tid + 512 * k, t = item >> 5, ch = item & 31;
        f32x4 a = *(const f32x4*)(wsp + ((size_t)(g * 128 + t)) * 128 + 4 * ch);
#pragma unroll
        for (int e = 0; e < 4; ++e) if (4 * ch + e > t) a[e] = 0.f;
        *(LAS u32x2*)(F.lds + GM_WL + t * GM_RS + ch * 8) = pack4(a); }
    __syncthreads();
#pragma unroll
    for (int k = 0; k < 8; ++k) { const int item = tid + 512 * k, s = item & 127, ch = item >> 7;
        const u32x4 raw = *(const u32x4*)(AV + (size_t)(row0 + s) * BW + c0 + 8 * ch);
        const f32x4 g0 = *(const f32x4*)(ln_g + c0 + 8 * ch), g1 = *(const f32x4*)(ln_g + c0 + 8 * ch + 4), b0 = *(const f32x4*)(ln_b + c0 + 8 * ch), b1 = *(const f32x4*)(ln_b + c0 + 8 * ch + 4);
        const f32x2 st = *(const LAS f32x2*)(F.lds + GM_ST + s * 8);
        const float xv[8] = {bf_lo(raw.x), bf_hi(raw.x), bf_lo(raw.y), bf_hi(raw.y), bf_lo(raw.z), bf_hi(raw.z), bf_lo(raw.w), bf_hi(raw.w)};
        const float gg[8] = {g0[0], g0[1], g0[2], g0[3], g1[0], g1[1], g1[2], g1[3]}, bb[8] = {b0[0], b0[1], b0[2], b0[3], b1[0], b1[1], b1[2], b1[3]};
#pragma unroll
        for (int i = 0; i < 8; ++i) { const float y = (xv[i] - st.x) * st.y * gg[i] + bb[i];
            *(LAS bf16_t*)(F.lds + GM_VT + (8 * ch + i) * GM_RS + 2 * s) = (bf16_t)(cvt_pk_bf16(y, 0.f) & 0xffffu); } }
    __syncthreads();
    f32x4 acc[2][8];
#pragma unroll
    for (int m = 0; m < 2; ++m)
#pragma unroll
        for (int n8 = 0; n8 < 8; ++n8) acc[m][n8] = (f32x4){0.f, 0.f, 0.f, 0.f};
    bf16x8 af[2][4];
#pragma unroll
    for (int m = 0; m < 2; ++m)
#pragma unroll
        for (int ks = 0; ks < 4; ++ks) af[m][ks] = *(const LAS bf16x8*)(F.lds + GM_VT + (32 * w + 16 * m + r16) * GM_RS + ks * 64 + q4 * 16);
#pragma unroll
    for (int n8 = 0; n8 < 8; ++n8)
#pragma unroll
        for (int ks = 0; ks < 4; ++ks) if (ks <= n8 / 2) {
            const bf16x8 bfr = *(const LAS bf16x8*)(F.lds + GM_WL + (16 * n8 + r16) * GM_RS + ks * 64 + q4 * 16);
#pragma unroll
            for (int m = 0; m < 2; ++m) acc[m][n8] = MFMA16(af[m][ks], bfr, acc[m][n8]); }
#pragma unroll
    for (int n8 = 0; n8 < 8; ++n8) { const int t = 16 * n8 + r16; const float bsv = bsp[g * 128 + t]; const size_t ro = (size_t)(row0 + t) * BW + c0 + 32 * w + 4 * q4;
#pragma unroll
        for (int m = 0; m < 2; ++m) { const u32x2 ub = *(const u32x2*)(AU + ro + 16 * m), zb = *(const u32x2*)(AZ + ro + 16 * m);
            const f32x4 a = acc[m][n8] + bsv; f32x4 y;
            y[0] = a[0] * bf_lo(ub.x) * bf_lo(zb.x); y[1] = a[1] * bf_hi(ub.x) * bf_hi(zb.x); y[2] = a[2] * bf_lo(ub.y) * bf_lo(zb.y); y[3] = a[3] * bf_hi(ub.y) * bf_hi(zb.y);
            *(u32x2*)(YA + ro + 16 * m) = pack4(y); } }
    __syncthreads();
}

constexpr int SW_KL = 0, SW_VT = 36864, SW_QL = 70656, SW_RS = 144, SW_VS = 528;
__device__ __forceinline__ void rope8(const u32x4 a, const u32x4 bq, const float* cs, float scale, u32x4& o1, u32x4& o2) {
    const f32x4 c0 = *(const f32x4*)cs, c1 = *(const f32x4*)(cs + 4), s0 = *(const f32x4*)(cs + 8), s1 = *(const f32x4*)(cs + 12);
    const float t1[8] = {bf_lo(a.x), bf_hi(a.x), bf_lo(a.y), bf_hi(a.y), bf_lo(a.z), bf_hi(a.z), bf_lo(a.w), bf_hi(a.w)};
    const float t2[8] = {bf_lo(bq.x), bf_hi(bq.x), bf_lo(bq.y), bf_hi(bq.y), bf_lo(bq.z), bf_hi(bq.z), bf_lo(bq.w), bf_hi(bq.w)};
    const float cc[8] = {c0[0], c0[1], c0[2], c0[3], c1[0], c1[1], c1[2], c1[3]}, ss[8] = {s0[0], s0[1], s0[2], s0[3], s1[0], s1[1], s1[2], s1[3]};
    float r1[8], r2[8];
#pragma unroll
    for (int i = 0; i < 8; ++i) { r1[i] = (t1[i] * cc[i] - t2[i] * ss[i]) * scale; r2[i] = (t2[i] * cc[i] + t1[i] * ss[i]) * scale; }
    o1 = (u32x4){cvt_pk_bf16(r1[0], r1[1]), cvt_pk_bf16(r1[2], r1[3]), cvt_pk_bf16(r1[4], r1[5]), cvt_pk_bf16(r1[6], r1[7])};
    o2 = (u32x4){cvt_pk_bf16(r2[0], r2[1]), cvt_pk_bf16(r2[2], r2[3]), cvt_pk_bf16(r2[4], r2[5]), cvt_pk_bf16(r2[6], r2[7])};
}
__device__ __forceinline__ u32x4 scale8(const u32x4 a, float sc) {
    return (u32x4){cvt_pk_bf16(bf_lo(a.x) * sc, bf_hi(a.x) * sc), cvt_pk_bf16(bf_lo(a.y) * sc, bf_hi(a.y) * sc), cvt_pk_bf16(bf_lo(a.z) * sc, bf_hi(a.z) * sc), cvt_pk_bf16(bf_lo(a.w) * sc, bf_hi(a.w) * sc)};
}
__device__ __forceinline__ void swa_unit(const Ctx& F, int b, int n, int hk, unsigned char* ws, const float* sinks) {
    int tid = F.tid; LAUNDER_V(tid); const int lane = tid & 63, w = F.wave, r16 = lane & 15, q4 = lane >> 4;
    const int r0 = b * SEQ + n * 128, kr0 = r0 - 128;
    const bf16_t* BQ = (const bf16_t*)(ws + WS_BQ); const bf16_t* BK = (const bf16_t*)(ws + WS_BK); const bf16_t* BV = (const bf16_t*)(ws + WS_BV); const bf16_t* BZ = (const bf16_t*)(ws + WS_BZ);
    bf16_t* YB = (bf16_t*)(ws + WS_YA) + (size_t)M_ROWS * BW; const float* CS = (const float*)(ws + WS_CS);
#pragma unroll
    for (int k = 0; k < 4; ++k) { const int item = tid + 512 * k, key = item >> 3, ch = item & 7; const bool pad = (n == 0 && key < 128);
        if (ch == 1) continue;
        const bf16_t* src = BK + (size_t)(kr0 + key) * 256 + hk * 64;
        LAS unsigned char* dst = F.lds + SW_KL + key * SW_RS;
        if (pad) { *(LAS u32x4*)(dst + ch * 16) = (u32x4){0u, 0u, 0u, 0u}; if (ch == 0) *(LAS u32x4*)(dst + 16) = (u32x4){0u, 0u, 0u, 0u}; }
        else if (ch == 0) { u32x4 o1, o2; rope8(*(const u32x4*)src, *(const u32x4*)(src + 8), CS + (size_t)(kr0 + key) * 16, 1.0f, o1, o2); *(LAS u32x4*)dst = o1; *(LAS u32x4*)(dst + 16) = o2; }
        else *(LAS u32x4*)(dst + ch * 16) = *(const u32x4*)(src + 8 * ch); }
#pragma unroll
    for (int k = 0; k < 4; ++k) { const int item = tid + 512 * k, key = item & 255, ch = item >> 8; const bool pad = (n == 0 && key < 128);
        u32x4 raw = {0u, 0u, 0u, 0u}; if (!pad) raw = *(const u32x4*)(BV + (size_t)(kr0 + key) * 256 + hk * 64 + 8 * ch);
        const unsigned e[4] = {raw.x, raw.y, raw.z, raw.w};
#pragma unroll
        for (int i = 0; i < 8; ++i) *(LAS bf16_t*)(F.lds + SW_VT + (8 * ch + i) * SW_VS + 2 * key) = (bf16_t)((e[i >> 1] >> ((i & 1) * 16)) & 0xffffu); }
    for (int hi = 0; hi < 8; ++hi) {
        const int hq = hk * 8 + hi;
#pragma unroll
        for (int k = 0; k < 2; ++k) { const int item = tid + 512 * k, qr = item >> 3, ch = item & 7;
            if (ch == 1) continue;
            const bf16_t* src = BQ + (size_t)(r0 + qr) * BW + hq * 64; LAS unsigned char* dst = F.lds + SW_QL + qr * SW_RS;
            if (ch == 0) { u32x4 o1, o2; rope8(*(const u32x4*)src, *(const u32x4*)(src + 8), CS + (size_t)(r0 + qr) * 16, 0.125f, o1, o2); *(LAS u32x4*)dst = o1; *(LAS u32x4*)(dst + 16) = o2; }
            else *(LAS u32x4*)(dst + ch * 16) = scale8(*(const u32x4*)(src + 8 * ch), 0.125f); }
        __syncthreads();
        bf16x8 bq[2];
#pragma unroll
        for (int ks = 0; ks < 2; ++ks) bq[ks] = *(const LAS bf16x8*)(F.lds + SW_QL + (16 * w + r16) * SW_RS + ks * 64 + q4 * 16);
        f32x4 s[16];
#pragma unroll
        for (int kt = 0; kt < 16; ++kt) { s[kt] = (f32x4){0.f, 0.f, 0.f, 0.f};
#pragma unroll
            for (int ks = 0; ks < 2; ++ks) { const bf16x8 a = *(const LAS bf16x8*)(F.lds + SW_KL + (16 * kt + r16) * SW_RS + ks * 64 + q4 * 16); s[kt] = MFMA16(a, bq[ks], s[kt]); } }
        const int qi = 16 * w + r16; const float sink = sinks[hq]; float mx = sink;
#pragma unroll
        for (int kt = 0; kt < 16; ++kt)
#pragma unroll
            for (int e = 0; e < 4; ++e) { const int kj = 16 * kt + 4 * q4 + e; const bool valid = (kj > qi) && (kj <= qi + 128) && (n > 0 || kj >= 128);
                s[kt][e] = valid ? s[kt][e] : -1e30f; mx = fmaxf(mx, s[kt][e]); }
        mx = fmaxf(mx, __shfl_xor(mx, 16)); mx = fmaxf(mx, __shfl_xor(mx, 32));
        float sum = 0.f;
#pragma unroll
        for (int kt = 0; kt < 16; ++kt)
#pragma unroll
            for (int e = 0; e < 4; ++e) { const float pv = (s[kt][e] > -1e29f) ? __expf(s[kt][e] - mx) : 0.f; s[kt][e] = pv; sum += pv; }
        sum += __shfl_xor(sum, 16); sum += __shfl_xor(sum, 32); sum += __expf(sink - mx);
        const float inv = 1.0f / sum;
        f32x4 o[4];
#pragma unroll
        for (int dt = 0; dt < 4; ++dt) o[dt] = (f32x4){0.f, 0.f, 0.f, 0.f};
#pragma unroll
        for (int kk = 0; kk < 8; ++kk) { const bf16x8 pf = mk_frag(pack4(s[2 * kk]), pack4(s[2 * kk + 1]));
#pragma unroll
            for (int dt = 0; dt < 4; ++dt) { const LAS unsigned char* vp = F.lds + SW_VT + (16 * dt + r16) * SW_VS + (32 * kk + 4 * q4) * 2;
                const bf16x8 a = mk_frag(*(const LAS u32x2*)vp, *(const LAS u32x2*)(vp + 32)); o[dt] = MFMA16(a, pf, o[dt]); } }
        const size_t ro = (size_t)(r0 + qi) * BW + hq * 64 + 4 * q4;
#pragma unroll
        for (int dt = 0; dt < 4; ++dt) { const u32x2 zb = *(const u32x2*)(BZ + ro + 16 * dt); f32x4 y;
            y[0] = o[dt][0] * inv * bf_lo(zb.x); y[1] = o[dt][1] * inv * bf_hi(zb.x); y[2] = o[dt][2] * inv * bf_lo(zb.y); y[3] = o[dt][3] * inv * bf_hi(zb.y);
            *(u32x2*)(YB + ro + 16 * dt) = pack4(y); }
        __syncthreads();
    }
}

constexpr int ML_QL = 0, ML_KL = 33792, ML_KWT = 67584, ML_VT = 104448, ML_CT = 109056, ML_X = 126480, ML_GATE = 135696, ML_GSZ = 1344, ML_RS = 528, ML_TS = 144;
static_assert(ML_GATE + 2 * ML_GSZ <= ARGS_OFF, "mLSTM LDS map");
__device__ __forceinline__ float wave_scan_add(float v, int lane) {
#pragma unroll
    for (int d = 1; d < 64; d <<= 1) { const float t = __shfl_up(v, d); if (lane >= d) v += t; }
    return v;
}
__device__ __forceinline__ float wave_scan_max(float v, int lane) {
#pragma unroll
    for (int d = 1; d < 64; d <<= 1) { const float t = __shfl_up(v, d); if (lane >= d) v = fmaxf(v, t); }
    return v;
}
__device__ __forceinline__ float softcap15(float z) { const float e = __expf(z * (2.0f / 15.0f)); return 15.0f * (1.0f - 2.0f * __builtin_amdgcn_rcpf(e + 1.0f)); }
__device__ __forceinline__ void mlstm_unit(const Ctx& F, int b, int h, int sl, unsigned char* ws, const float* ibp, const float* fbp) {
    int tid = F.tid; LAUNDER_V(tid); const int lane = tid & 63, w = F.wave, r16 = lane & 15, q4 = lane >> 4;
    const bf16_t* CQ = (const bf16_t*)(ws + WS_CQ) + h * 256; const bf16_t* CK = (const bf16_t*)(ws + WS_CK) + h * 256; const bf16_t* CV = (const bf16_t*)(ws + WS_CV) + h * 512 + sl * 32;
    const float* IFB = (const float*)(ws + WS_IF);
    bf16_t* NUM = (bf16_t*)(ws + WS_NUM) + h * 512 + sl * 32; float* SSQC = (float*)(ws + WS_SSQC); float* DNB = (float*)(ws + WS_DN);
    const int rowb = b * SEQ;
    const bf16x8 ones = frag_const(0x3f803f80u), zeros = frag_const(0u);
    for (int i = tid; i < 33 * ML_RS / 16; i += NTHREADS) *(LAS u32x4*)(F.lds + ML_CT + i * 16) = (u32x4){0u, 0u, 0u, 0u};
    f32x4 st[2][3];
#pragma unroll
    for (int i = 0; i < 2; ++i)
#pragma unroll
        for (int dt = 0; dt < 3; ++dt) st[i][dt] = (f32x4){0.f, 0.f, 0.f, 0.f};
    float m_prev = 0.f;
    const float ibv = ibp[h], fbv = fbp[h];
    u32x4 qreg[4], kreg[4], vreg; float gi = 0.f, gf = 0.f;
#define ML_LOAD(c) do { const int rc_ = rowb + (c) * 64; _Pragma("unroll") for (int k_ = 0; k_ < 4; ++k_) { const int it_ = tid + 512 * k_, s_ = it_ >> 5, ch_ = it_ & 31; \
        qreg[k_] = *(const u32x4*)(CQ + (size_t)(rc_ + s_) * 1024 + 8 * ch_); kreg[k_] = *(const u32x4*)(CK + (size_t)(rc_ + s_) * 1024 + 8 * ch_); } \
        if (tid < 256) vreg = *(const u32x4*)(CV + (size_t)(rc_ + (tid >> 2)) * BW + 8 * (tid & 3)); } while (0)
#define ML_GLOAD(c) do { if (w == 7) { const int r_ = rowb + (c) * 64 + lane; gi = IFB[(size_t)r_ * 8 + h]; gf = IFB[(size_t)r_ * 8 + 4 + h]; } } while (0)
#define ML_GPREP(par) do { if (w == 7) { const float ig_ = softcap15(gi + ibv); const float z_ = softcap15(gf + fbv); \
        const float lf_ = -(fmaxf(-z_, 0.f) + log1pf(__expf(-fabsf(z_)))); const float bc_ = wave_scan_add(lf_, lane); const float u_ = ig_ - bc_; const float pm_ = wave_scan_max(u_, lane); \
        const float Mv_ = fmaxf(m_prev, pm_); const float M63_ = __shfl(Mv_, 63); const float g_ = __shfl(bc_, 63); \
        LAS float* gp_ = (LAS float*)(F.lds + ML_GATE + (par) * ML_GSZ); gp_[lane] = u_; gp_[64 + lane] = Mv_; gp_[128 + lane] = __expf(m_prev - Mv_); gp_[192 + lane] = __expf(-(bc_ + Mv_)); \
        gp_[256 + lane] = __expf(u_ - M63_); if (lane == 0) gp_[320] = __expf(m_prev - M63_); m_prev = g_ + M63_; } } while (0)
#define ML_WRITE() do { _Pragma("unroll") for (int k_ = 0; k_ < 4; ++k_) { const int it_ = tid + 512 * k_, s_ = it_ >> 5, ch_ = it_ & 31; \
        *(LAS u32x4*)(F.lds + ML_QL + s_ * ML_RS + ch_ * 16) = qreg[k_]; *(LAS u32x4*)(F.lds + ML_KL + s_ * ML_RS + ch_ * 16) = kreg[k_]; } \
        if (tid < 256) { const int s_ = tid >> 2, ch_ = tid & 3; const unsigned e_[4] = {vreg.x, vreg.y, vreg.z, vreg.w}; \
            _Pragma("unroll") for (int i_ = 0; i_ < 8; ++i_) *(LAS bf16_t*)(F.lds + ML_VT + (8 * ch_ + i_) * ML_TS + 2 * s_) = (bf16_t)((e_[i_ >> 1] >> ((i_ & 1) * 16)) & 0xffffu); } } while (0)
    ML_LOAD(0); ML_GLOAD(0);
    ML_GPREP(0);
    ML_GLOAD(1);
    ML_WRITE();
    __syncthreads();
    for (int c = 0; c < 32; ++c) {
        const int par = c & 1; const LAS float* gp = (const LAS float*)(F.lds + ML_GATE + par * ML_GSZ);
        const int rowc = rowb + c * 64;
        if (c + 1 < 32) { ML_LOAD(c + 1); ML_GPREP(par ^ 1); if (c + 2 < 32) ML_GLOAD(c + 2); }
#pragma unroll
        for (int k = 0; k < 4; ++k) { const int item = tid + 512 * k, dk = item & 255, so = item >> 8;
            const f32x4 w0 = *(const LAS f32x4*)(gp + 256 + 8 * so), w1 = *(const LAS f32x4*)(gp + 256 + 8 * so + 4); const float wv[8] = {w0[0], w0[1], w0[2], w0[3], w1[0], w1[1], w1[2], w1[3]};
            float kv[8];
#pragma unroll
            for (int j = 0; j < 8; ++j) kv[j] = bf1(*(const LAS bf16_t*)(F.lds + ML_KL + (8 * so + j) * ML_RS + 2 * dk)) * wv[j];
            *(LAS u32x4*)(F.lds + ML_KWT + dk * ML_TS + so * 16) = (u32x4){cvt_pk_bf16(kv[0], kv[1]), cvt_pk_bf16(kv[2], kv[3]), cvt_pk_bf16(kv[4], kv[5]), cvt_pk_bf16(kv[6], kv[7])}; }
        f32x4 oacc[3];
#pragma unroll
        for (int dt = 0; dt < 3; ++dt) oacc[dt] = (f32x4){0.f, 0.f, 0.f, 0.f};
        if (w < 4) {
            const int T = w;
            bf16x8 bq[8];
#pragma unroll
            for (int ks = 0; ks < 8; ++ks) bq[ks] = *(const LAS bf16x8*)(F.lds + ML_QL + (16 * T + r16) * ML_RS + ks * 64 + q4 * 16);
            f32x4 sa[4];
#pragma unroll
            for (int s4 = 0; s4 < 4; ++s4) { sa[s4] = (f32x4){0.f, 0.f, 0.f, 0.f};
                if (s4 <= T) {
#pragma unroll
                    for (int ks = 0; ks < 8; ++ks) { const bf16x8 a = *(const LAS bf16x8*)(F.lds + ML_KL + (16 * s4 + r16) * ML_RS + ks * 64 + q4 * 16); sa[s4] = MFMA16(a, bq[ks], sa[s4]); } } }
            const int tl = 16 * T + r16; const float Mt = gp[64 + tl];
#pragma unroll
            for (int s4 = 0; s4 < 4; ++s4) { const f32x4 uu = *(const LAS f32x4*)(gp + 16 * s4 + 4 * q4);
#pragma unroll
                for (int e = 0; e < 4; ++e) { const int sl_ = 16 * s4 + 4 * q4 + e; sa[s4][e] = (sl_ <= tl) ? sa[s4][e] * __expf(uu[e] - Mt) : 0.f; } }
#pragma unroll
            for (int kk = 0; kk < 2; ++kk) { const bf16x8 pf = mk_frag(pack4(sa[2 * kk]), pack4(sa[2 * kk + 1]));
#pragma unroll
                for (int dt = 0; dt < 3; ++dt) { bf16x8 a;
                    if (dt < 2) { const LAS unsigned char* vp = F.lds + ML_VT + (16 * dt + r16) * ML_TS + (32 * kk + 4 * q4) * 2; a = mk_frag(*(const LAS u32x2*)vp, *(const LAS u32x2*)(vp + 32)); }
                    else a = (r16 == 0) ? ones : zeros;
                    oacc[dt] = MFMA16(a, pf, oacc[dt]); } }
        } else {
            const int T = w - 4; f32x4 ia[3];
#pragma unroll
            for (int dt = 0; dt < 3; ++dt) ia[dt] = (f32x4){0.f, 0.f, 0.f, 0.f};
#pragma unroll
            for (int ks = 0; ks < 8; ++ks) { const bf16x8 bqv = *(const LAS bf16x8*)(F.lds + ML_QL + (16 * T + r16) * ML_RS + ks * 64 + q4 * 16);
#pragma unroll
                for (int dt = 0; dt < 3; ++dt) { bf16x8 a;
                    if (dt < 2) a = *(const LAS bf16x8*)(F.lds + ML_CT + (16 * dt + r16) * ML_RS + ks * 64 + q4 * 16);
                    else { a = *(const LAS bf16x8*)(F.lds + ML_CT + 32 * ML_RS + ks * 64 + q4 * 16); if (r16 != 0) a = zeros; }
                    ia[dt] = MFMA16(a, bqv, ia[dt]); } }
            const int tl = 16 * T + r16;
            *(LAS f32x4*)(F.lds + ML_X + tl * 144 + (4 * q4) * 4) = ia[0]; *(LAS f32x4*)(F.lds + ML_X + tl * 144 + (16 + 4 * q4) * 4) = ia[1];
            if (q4 == 0) *(LAS f32x4*)(F.lds + ML_X + tl * 144 + 32 * 4) = ia[2];
        }
        __syncthreads();
        if (w < 4) {
            const int tl = 16 * w + r16; const float at = gp[128 + tl], en = gp[192 + tl];
            const f32x4 x0 = *(const LAS f32x4*)(F.lds + ML_X + tl * 144 + (4 * q4) * 4), x1 = *(const LAS f32x4*)(F.lds + ML_X + tl * 144 + (16 + 4 * q4) * 4);
            const float xd = *(const LAS float*)(F.lds + ML_X + tl * 144 + 32 * 4);
            const f32x4 n0 = oacc[0] + x0 * at, n1 = oacc[1] + x1 * at;
            float den = oacc[2][0] + xd * at; den = __shfl(den, r16);
            float sq = (n0[0] * n0[0] + n0[1] * n0[1]) + (n0[2] * n0[2] + n0[3] * n0[3]) + (n1[0] * n1[0] + n1[1] * n1[1]) + (n1[2] * n1[2] + n1[3] * n1[3]);
            sq += __shfl_xor(sq, 16); sq += __shfl_xor(sq, 32);
            const size_t ro = (size_t)(rowc + tl) * BW + 4 * q4;
            *(u32x2*)(NUM + ro) = pack4(n0); *(u32x2*)(NUM + ro + 16) = pack4(n1);
            if (q4 == 0) { SSQC[(size_t)(rowc + tl) * 64 + h * 16 + sl] = sq; if (sl == 0) DNB[(size_t)(rowc + tl) * 4 + h] = fmaxf(fabsf(den), en); }
        }
        { const float dec = gp[320];
#pragma unroll
          for (int i = 0; i < 2; ++i)
#pragma unroll
              for (int dt = 0; dt < 3; ++dt) st[i][dt] = st[i][dt] * dec;
#pragma unroll
          for (int kk = 0; kk < 2; ++kk) { bf16x8 a[2], bv[3];
#pragma unroll
              for (int i = 0; i < 2; ++i) a[i] = *(const LAS bf16x8*)(F.lds + ML_KWT + (32 * w + 16 * i + r16) * ML_TS + kk * 64 + q4 * 16);
#pragma unroll
              for (int dt = 0; dt < 2; ++dt) bv[dt] = *(const LAS bf16x8*)(F.lds + ML_VT + (16 * dt + r16) * ML_TS + kk * 64 + q4 * 16);
              bv[2] = (r16 == 0) ? ones : zeros;
#pragma unroll
              for (int i = 0; i < 2; ++i)
#pragma unroll
                  for (int dt = 0; dt < 3; ++dt) st[i][dt] = MFMA16(a[i], bv[dt], st[i][dt]); }
#pragma unroll
          for (int i = 0; i < 2; ++i) {
#pragma unroll
              for (int dt = 0; dt < 2; ++dt) *(LAS u32x2*)(F.lds + ML_CT + (16 * dt + r16) * ML_RS + (32 * w + 16 * i + 4 * q4) * 2) = pack4(st[i][dt]);
              if (r16 == 0) *(LAS u32x2*)(F.lds + ML_CT + 32 * ML_RS + (32 * w + 16 * i + 4 * q4) * 2) = pack4(st[i][2]); } }
        __syncthreads();
        if (c + 1 < 32) ML_WRITE();
        __syncthreads();
    }
#undef ML_LOAD
#undef ML_GLOAD
#undef ML_GPREP
#undef ML_WRITE
}

__device__ __forceinline__ void p2b_finalize(const Ctx& F, unsigned char* ws, const float* norm_g) {
    int lane = F.lane; LAUNDER_V(lane); const int gw = F.vcu * NWAVES + F.wave, NGW = F.G * NWAVES;
    const bf16_t* NUM = (const bf16_t*)(ws + WS_NUM); const bf16_t* CO = (const bf16_t*)(ws + WS_CO); const bf16_t* CZ = (const bf16_t*)(ws + WS_CZ);
    bf16_t* YC = (bf16_t*)(ws + WS_YA) + (size_t)2 * M_ROWS * BW;
    for (int m = gw; m < M_ROWS; m += NGW) {
        float s = ((const float*)(ws + WS_SSQC))[(size_t)m * 64 + lane];
        s += __shfl_xor(s, 1); s += __shfl_xor(s, 2); s += __shfl_xor(s, 4); s += __shfl_xor(s, 8);
        const float dn = ((const float*)(ws + WS_DN))[(size_t)m * 4 + (lane >> 4)];
        const float inv = 1.0f / dn; const float sc = inv * rsqrtf(s * (1.0f / 512.0f) * inv * inv + NORM_EPS);
#pragma unroll
        for (int it = 0; it < 4; ++it) { const float f = __shfl(sc, 16 * it); const size_t o = (size_t)m * BW + (size_t)(it * 64 + lane) * 8;
            const u32x4 nb = *(const u32x4*)(NUM + o), ob = *(const u32x4*)(CO + o), zb = *(const u32x4*)(CZ + o);
            const f32x4 g0 = *(const f32x4*)(norm_g + (it * 64 + lane) * 8), g1 = *(const f32x4*)(norm_g + (it * 64 + lane) * 8 + 4);
            u32x4 y;
            y.x = cvt_pk_bf16(bf_lo(nb.x) * f * g0[0] * bf_lo(ob.x) * bf_lo(zb.x), bf_hi(nb.x) * f * g0[1] * bf_hi(ob.x) * bf_hi(zb.x));
            y.y = cvt_pk_bf16(bf_lo(nb.y) * f * g0[2] * bf_lo(ob.y) * bf_lo(zb.y), bf_hi(nb.y) * f * g0[3] * bf_hi(ob.y) * bf_hi(zb.y));
            y.z = cvt_pk_bf16(bf_lo(nb.z) * f * g1[0] * bf_lo(ob.z) * bf_lo(zb.z), bf_hi(nb.z) * f * g1[1] * bf_hi(ob.z) * bf_hi(zb.z));
            y.w = cvt_pk_bf16(bf_lo(nb.w) * f * g1[2] * bf_lo(ob.w) * bf_lo(zb.w), bf_hi(nb.w) * f * g1[3] * bf_hi(ob.w) * bf_hi(zb.w));
            *(u32x4*)(YC + o) = y; }
    }
}
__device__ __forceinline__ void p4b_x1(const Ctx& F, unsigned char* ws, const float* xin, const float* npost) {
    int lane = F.lane; LAUNDER_V(lane); const int gw = F.vcu * NWAVES + F.wave, NGW = F.G * NWAVES;
    const bf16_t* OUT = (const bf16_t*)(ws + WS_OUT); bf16_t* X1B = (bf16_t*)(ws + WS_X1B);
    for (int m = gw; m < M_ROWS; m += NGW) {
        const float so = wave_sum(((const float*)(ws + WS_OUTP))[(size_t)m * 64 + lane]), se = wave_sum(((const float*)(ws + WS_ERP))[(size_t)m * 64 + lane]);
        const float rso = rsqrtf(so * (1.0f / DM) + NORM_EPS), rse = rsqrtf(se * (1.0f / DM) + NORM_EPS);
        if (lane == 0) { ((float*)(ws + WS_RSO))[m] = rso; ((float*)(ws + WS_RSE))[m] = rse; }
#pragma unroll
        for (int it = 0; it < 8; ++it) { const int c = (it * 64 + lane) * 8; const size_t o = (size_t)m * DM + c;
            const f32x4 x0 = *(const f32x4*)(xin + o), x1 = *(const f32x4*)(xin + o + 4), n0 = *(const f32x4*)(npost + c), n1 = *(const f32x4*)(npost + c + 4);
            const u32x4 ob = *(const u32x4*)(OUT + o); u32x4 y;
            y.x = cvt_pk_bf16(x0[0] + bf_lo(ob.x) * rso * n0[0], x0[1] + bf_hi(ob.x) * rso * n0[1]);
            y.y = cvt_pk_bf16(x0[2] + bf_lo(ob.y) * rso * n0[2], x0[3] + bf_hi(ob.y) * rso * n0[3]);
            y.z = cvt_pk_bf16(x1[0] + bf_lo(ob.z) * rso * n1[0], x1[1] + bf_hi(ob.z) * rso * n1[1]);
            y.w = cvt_pk_bf16(x1[2] + bf_lo(ob.w) * rso * n1[2], x1[3] + bf_hi(ob.w) * rso * n1[3]);
            *(u32x4*)(X1B + o) = y; }
    }
}

#ifndef REP_P0
#define REP_P0 1
#endif
#ifndef REP_P1
#define REP_P1 1
#endif
#ifndef REP_ML
#define REP_ML 1
#endif
#ifndef REP_SW
#define REP_SW 1
#endif
#ifndef REP_GM
#define REP_GM 1
#endif
#ifndef REP_P3
#define REP_P3 1
#endif
#ifndef REP_THIN
#define REP_THIN 1
#endif
#ifndef REP_BAR
#define REP_BAR 1
#endif
#ifndef REP_P4
#define REP_P4 1
#endif
struct Args { const void* in[19]; float* out; unsigned char* ws; };
static_assert(sizeof(Args) == 21 * 8, "no padding in Args");

__global__ void __launch_bounds__(NTHREADS, 2) fwd_kernel(Args args) {
    extern __shared__ __attribute__((aligned(16))) unsigned char lds_raw[];
    Ctx F; F.lds = (LAS unsigned char*)lds_raw; F.tid = threadIdx.x; F.lane = F.tid & 63; F.wave = __builtin_amdgcn_readfirstlane(F.tid >> 6);
    F.G = gridDim.x; { const int bx = blockIdx.x; F.vcu = (F.G % 8 == 0) ? (bx % 8) * (F.G / 8) + bx / 8 : bx; }
    unsigned char* ws0 = args.ws;
#define WSL() ({ unsigned char* w_ = ws0; LAUNDER_S(w_); w_; })
    volatile LAS unsigned* MISC = (volatile LAS unsigned*)(F.lds + MISC_OFF);
    if (F.tid < 32) MISC[F.tid] = 0u;
    __syncthreads();
    const XcdBarrier bar = xcd_barrier_post((unsigned*)(ws0 + WS_CTL) + CW_BAR, MISC);

    if (F.tid < 19) ((LAS unsigned long long*)(F.lds + ARGS_OFF))[F.tid] = (unsigned long long)args.in[F.tid];
    if (F.tid == 19) ((LAS unsigned long long*)(F.lds + ARGS_OFF))[19] = (unsigned long long)args.out;
    __syncthreads();
#define ARGP(T, i) ((T)(((unsigned long long)__builtin_amdgcn_readfirstlane((int)(((volatile LAS unsigned*)(F.lds + ARGS_OFF))[2 * (i) + 1])) << 32) | (unsigned)__builtin_amdgcn_readfirstlane((int)(((volatile LAS unsigned*)(F.lds + ARGS_OFF))[2 * (i)]))))

#ifndef SKIP_P0
    for (int rep_ = 0; rep_ < REP_P0; ++rep_) { unsigned char* ws = WSL(); p0_prologue(F, ARGP(const float*, 0), ARGP(const float*, 1), ARGP(const int*, 2), ARGP(const float*, 3), ARGP(const float*, 4), ARGP(const float*, 13), ARGP(const float*, 14), ARGP(const float*, 18), ARGP(const float*, 16), ws); }
#endif
    for (int rb_ = 0; rb_ < REP_BAR; ++rb_) xcd_barrier(bar);

    for (int l = 0; l < NLAYER; ++l) {
        const float* xin = l == 0 ? ARGP(const float*, 0) : (const float*)ARGP(float*, 19);
#ifndef SKIP_P1
        for (int rep_ = 0; rep_ < REP_P1; ++rep_) { unsigned char* ws = WSL(); const float* ssq = l == 0 ? (const float*)(ws + WS_SSQ0) : (const float*)(ws + WS_CTL + CTL_SSQ1); pg8::SchedPlain S; S.T.init(M_ROWS / 256, NT_IN, F.G, (int)blockIdx.x); S.A = (const char*)(ws + WS_XB); S.B = (const char*)(ws + WS_WIN + (size_t)l * SZ_WIN);
          S.astep = (size_t)256 * DM * 2; S.bstep = (size_t)256 * DM * 2;
          pg8::EpiIn E{ssq, ws};
          pg8::gemm_phase<pg8::EpiIn, pg8::SchedPlain>(F.lds, DM, DM, DM, S, E); }
        { const int nwg_ = (M_ROWS / 256) * NT_IN, rem_ = nwg_ % F.G;
          if (rem_ == 0 || (int)blockIdx.x >= rem_) { const int me = rem_ ? (int)blockIdx.x - rem_ : (int)blockIdx.x, nw = rem_ ? F.G - rem_ : F.G;
            { unsigned char* ws = WSL(); pg8::SchedPlain S; S.T.init(M_ROWS / 256, DM / 256, nw, me); S.A = (const char*)(ws + WS_PB + (size_t)l * M_ROWS * 256 * 2); S.B = (const char*)(ws + WS_WPP + (size_t)l * SZ_WPP);
              S.astep = (size_t)256 * 256 * 2; S.bstep = (size_t)256 * 256 * 2;
              pg8::EpiSq E{(bf16_t*)(ws + WS_ERAW), (float*)(ws + WS_ERP)};
              pg8::gemm_phase<pg8::EpiSq, pg8::SchedPlain>(F.lds, 256, 256, 256, S, E); }
            if (l == 0) tr_run(F, TR_DEFER0, TR_DEFER1, 0x7fffffff, 0x7fffffff, me, nw, ARGP(const float*, 4), ARGP(const float*, 3), ARGP(const float*, 13), ARGP(const float*, 14), ARGP(const float*, 18), ARGP(const float*, 16), WSL()); } }
#endif
        for (int rb_ = 0; rb_ < REP_BAR; ++rb_) xcd_barrier(bar);
#ifndef SKIP_ML
        for (int rep_ = 0; rep_ < REP_ML; ++rep_) { unsigned char* ws = WSL(); for (int u = F.vcu; u < 256; u += F.G) mlstm_unit(F, u >> 6, (u >> 4) & 3, u & 15, ws, ARGP(const float*, 10) + l * 4, ARGP(const float*, 11) + l * 4); }
#endif
#ifndef SKIP_SW
        for (int rep_ = 0; rep_ < REP_SW; ++rep_) { unsigned char* ws = WSL(); for (int u = F.vcu; u < 256; u += F.G) swa_unit(F, u >> 6, (u >> 2) & 15, u & 3, ws, ARGP(const float*, 9) + l * 32); }
#endif
#ifndef SKIP_GM
        for (int rep_ = 0; rep_ < REP_GM; ++rep_) { unsigned char* ws = WSL(); for (int u = F.vcu; u < 512; u += F.G) gmlp_unit(F, u >> 7, (u >> 3) & 15, u & 7, ws, ARGP(const float*, 5) + l * BW, ARGP(const float*, 6) + l * BW, ARGP(const float*, 7) + (size_t)l * 8 * 128 * 128, ARGP(const float*, 8) + l * 8 * 128); }
#endif
        for (int rb_ = 0; rb_ < REP_BAR; ++rb_) xcd_barrier(bar);
#ifndef SKIP_P2B
        for (int rep_ = 0; rep_ < REP_THIN; ++rep_) p2b_finalize(F, WSL(), ARGP(const float*, 12) + l * BW);
#endif
        for (int rb_ = 0; rb_ < REP_BAR; ++rb_) xcd_barrier(bar);
#ifndef SKIP_P3
        for (int rep_ = 0; rep_ < REP_P3; ++rep_) { unsigned char* ws = WSL(); pg8::SchedBranch S; S.T.init(M_ROWS / 256, DM / 256, F.G, (int)blockIdx.x); S.A = (const char*)(ws + WS_YA); S.B = (const char*)(ws + WS_WBR + (size_t)l * SZ_WBR);
          S.astep = (size_t)256 * BW * 2; S.bstep = (size_t)256 * BW * 2; S.aseg = SZ_ROWS_BW; S.bseg = (size_t)DM * BW * 2;
          pg8::EpiBranch E{(const bf16_t*)(ws + WS_G), (bf16_t*)(ws + WS_MIX)};
          pg8::gemm_phase<pg8::EpiBranch, pg8::SchedBranch>(F.lds, BW, BW, BW, S, E); }
#endif
        for (int rb_ = 0; rb_ < REP_BAR; ++rb_) xcd_barrier(bar);
#ifndef SKIP_P4
        for (int rep_ = 0; rep_ < REP_P4; ++rep_) { unsigned char* ws = WSL(); pg8::SchedPlain S; S.T.init(M_ROWS / 256, DM / 256, F.G, (int)blockIdx.x); S.A = (const char*)(ws + WS_MIX); S.B = (const char*)(ws + WS_WOUT + (size_t)l * SZ_WSQ);
          S.astep = (size_t)256 * DM * 2; S.bstep = (size_t)256 * DM * 2;
          pg8::EpiSq E{(bf16_t*)(ws + WS_OUT), (float*)(ws + WS_OUTP)};
          pg8::gemm_phase<pg8::EpiSq, pg8::SchedPlain>(F.lds, DM, DM, DM, S, E); }
#endif
        for (int rb_ = 0; rb_ < REP_BAR; ++rb_) xcd_barrier(bar);
#ifndef SKIP_P4B
        for (int rep_ = 0; rep_ < REP_THIN; ++rep_) p4b_x1(F, WSL(), xin, ARGP(const float*, 15) + l * DM);
#endif
        for (int rb_ = 0; rb_ < REP_BAR; ++rb_) xcd_barrier(bar);
#ifndef SKIP_P5
        { unsigned char* ws = WSL(); pg8::SchedPlain S; S.T.init(M_ROWS / 256, DM / 256, F.G, (int)blockIdx.x); S.A = (const char*)(ws + WS_X1B); S.B = (const char*)(ws + WS_WPG + (size_t)l * SZ_WSQ);
          S.astep = (size_t)256 * DM * 2; S.bstep = (size_t)256 * DM * 2;
          pg8::EpiPle E{xin, ARGP(float*, 19), (bf16_t*)(ws + WS_XB), (const bf16_t*)(ws + WS_OUT), (const bf16_t*)(ws + WS_ERAW), (const float*)(ws + WS_RSO), (const float*)(ws + WS_RSE),
                        ARGP(const float*, 15) + l * DM, ARGP(const float*, 17) + l * DM, (float*)(ws + WS_CTL + CTL_SSQ1), l == NLAYER - 1 ? 1 : 0};
          pg8::gemm_phase<pg8::EpiPle, pg8::SchedPlain>(F.lds, DM, DM, DM, S, E); }
#endif
        if (l + 1 < NLAYER) for (int rb_ = 0; rb_ < REP_BAR; ++rb_) xcd_barrier(bar);
    }
}

extern "C" void kernel_launch(void* const* d_in, const int* in_sizes, int n_in, void* d_out, int out_size, void* d_ws, size_t ws_size, hipStream_t stream) {
    static int grid = 0;
    if (grid == 0) {
        if (n_in != 19 || out_size != M_ROWS * DM || ws_size < WS_END) { fprintf(stderr, "kernel_launch: unexpected problem (n_in %d, out %d, ws %zu, need %zu)\n", n_in, out_size, ws_size, (size_t)WS_END); grid = -1; return; }
        int dev = 0, cus = 0;
        if (hipGetDevice(&dev) != hipSuccess || hipDeviceGetAttribute(&cus, hipDeviceAttributeMultiprocessorCount, dev) != hipSuccess) { grid = -1; return; }
        if (hipFuncSetAttribute((const void*)fwd_kernel, hipFuncAttributeMaxDynamicSharedMemorySize, LDS_BYTES) != hipSuccess) { fprintf(stderr, "kernel_launch: hipFuncSetAttribute failed\n"); grid = -1; return; }
        int per_cu = 0; (void)hipOccupancyMaxActiveBlocksPerMultiprocessor(&per_cu, (const void*)fwd_kernel, NTHREADS, LDS_BYTES); (void)hipGetLastError();
        if (per_cu < 1) fprintf(stderr, "kernel_launch: occupancy query reports %d blocks per CU\n", per_cu);
        grid = cus > 256 ? 256 : cus;
    }
    if (grid < 0) return;
    (void)hipMemsetAsync((char*)d_ws + WS_CTL, 0, CTL_ZERO_BYTES, stream);
    Args a{};
    for (int i = 0; i < 19; ++i) a.in[i] = d_in[i];
    a.out = (float*)d_out; a.ws = (unsigned char*)d_ws;
    hipLaunchKernelGGL(fwd_kernel, dim3(grid), dim3(NTHREADS), LDS_BYTES, stream, a);
    const hipError_t le = hipPeekAtLastError();
    if (le != hipSuccess) fprintf(stderr, "kernel_launch: launch failed: %s\n", hipGetErrorName(le));
}
```

```cpp
#include <hip/hip_runtime.h>
#include <cstdio>
#include <cstdint>

#define LAS __attribute__((address_space(3)))
#define GAS __attribute__((address_space(1)))
typedef unsigned short bf16_t;
typedef short bf16x8 __attribute__((ext_vector_type(8)));
typedef float f32x4 __attribute__((ext_vector_type(4)));
typedef float f32x2 __attribute__((ext_vector_type(2)));
typedef unsigned u32x4 __attribute__((ext_vector_type(4)));
typedef unsigned u32x2 __attribute__((ext_vector_type(2)));

typedef GAS float gfloat; typedef GAS bf16_t gbf16; typedef GAS int gint; typedef GAS char gchar; typedef GAS unsigned char guchar; typedef GAS unsigned gunsigned;
typedef GAS f32x4 gf32x4; typedef GAS f32x2 gf32x2; typedef GAS u32x4 gu32x4; typedef GAS u32x2 gu32x2;
constexpr int M_ROWS = 8192, SEQ = 2048, DM = 4096, BW = 2048, NLAYER = 2;
constexpr int N_IN = 31240, IF_COL = 14848;
constexpr int NT_IN = 123;
constexpr int N_IN_T = NT_IN * 256;
constexpr float NORM_EPS = 1e-6f;

__device__ __forceinline__ unsigned cvt_pk_bf16(float lo, float hi) { unsigned r; asm("v_cvt_pk_bf16_f32 %0, %1, %2" : "=v"(r) : "v"(lo), "v"(hi)); return r; }
__device__ __forceinline__ float bf_lo(unsigned w) { return __uint_as_float(w << 16); }
__device__ __forceinline__ float bf_hi(unsigned w) { return __uint_as_float(w & 0xffff0000u); }
__device__ __forceinline__ float bf1(bf16_t b) { return __uint_as_float(((unsigned)b) << 16); }
__device__ __forceinline__ float fsigmoid(float x) { return __builtin_amdgcn_rcpf(1.0f + __expf(-x)); }
__device__ __forceinline__ float wave_sum(float v) {
#pragma unroll
    for (int o = 1; o < 64; o <<= 1) v += __shfl_xor(v, o);
    return v;
}
__device__ __forceinline__ f32x2 gelu_pk(f32x2 v) {
    const f32x2 av = __builtin_elementwise_abs(v), d = av * 0.2316418882f + 1.0f;
    f32x2 t; t.x = __builtin_amdgcn_rcpf(d.x); t.y = __builtin_amdgcn_rcpf(d.y);
    f32x2 q = t * 0.5307027145f + (-0.7265760135f); q = q * t + 0.7107068705f; q = q * t + (-0.142248368f); q = q * t + 0.127414796f; q = q * t;
    const f32x2 s = (v * v) * (-0.72134752044f);
    f32x2 e; e.x = __builtin_amdgcn_exp2f(s.x); e.y = __builtin_amdgcn_exp2f(s.y);
    const f32x2 m = v * (q * e), r = v - m;
    f32x2 o; o.x = v.x < 0.f ? m.x : r.x; o.y = v.y < 0.f ? m.y : r.y; return o;
}
#define LAUNDER_V(x) asm volatile("" : "+v"(x))
#define LAUNDER_S(x) asm volatile("" : "+s"(x))
#define LDS_WAIT() asm volatile("s_waitcnt lgkmcnt(0)" ::: "memory")
#define VM_WAIT() asm volatile("s_waitcnt vmcnt(0)" ::: "memory")
#define MFMA16(a, b, c) __builtin_amdgcn_mfma_f32_16x16x32_bf16((a), (b), (c), 0, 0, 0)

#define XB_TMO      128
#define XB_XCNT(j)  (256  + 64 * (j))
#define XB_XSUB(j)  (1280 + 64 * (j))
#define XB_XGEN(j)  (2304 + 64 * (j))
#define XB_TOP      3328
#define XB_TOPGEN   3392
#define XCD_BAR_WORDS 3456
#define XB_SPIN_CAP (1u << 18)
__device__ __forceinline__ unsigned xb_ld(unsigned* p)              { return __hip_atomic_load(p, __ATOMIC_RELAXED, __HIP_MEMORY_SCOPE_AGENT); }
__device__ __forceinline__ unsigned xb_add(unsigned* p, unsigned v) { return __hip_atomic_fetch_add(p, v, __ATOMIC_RELAXED, __HIP_MEMORY_SCOPE_AGENT); }
__device__ __forceinline__ unsigned xb_xcc_id() { return (unsigned)__builtin_amdgcn_s_getreg((3 << 11) | 20) & 0xFu; }
#define XB_SPIN(cond, bar) do { unsigned _sp = 0; while (cond) { __builtin_amdgcn_s_sleep(1); \
    if ((++_sp & 255u) == 0u) { if (xb_ld(&(bar)[XB_TMO])) break; if (_sp > XB_SPIN_CAP) { atomicAdd(&(bar)[XB_TMO], 1u); break; } } } } while (0)
struct XcdBarrier { unsigned* bar; unsigned x; volatile LAS unsigned* st; };
__device__ __forceinline__ XcdBarrier xcd_barrier_post(unsigned* bar, volatile LAS unsigned* st) {
    XcdBarrier b; b.bar = bar; b.x = xb_xcc_id(); b.st = st;
    if (threadIdx.x == 0) (void)xb_add(&bar[XB_XCNT(b.x)], 1u);
    return b;
}
__device__ __forceinline__ void xcd_barrier_complete(unsigned* bar, unsigned x, unsigned& nloc, unsigned& nx) {
    const unsigned G = gridDim.x * gridDim.y * gridDim.z;
    unsigned sum, cnt, mine, sp = 0u;
    for (;;) {
        sum = 0u; cnt = 0u; mine = 0u;
#pragma unroll
        for (unsigned j = 0; j < 16; ++j) { const unsigned c = xb_ld(&bar[XB_XCNT(j)]); sum += c; cnt += (c > 0u) ? 1u : 0u; mine = (j == x) ? c : mine; }
        if (sum == G) break;
        __builtin_amdgcn_s_sleep(1);
        if ((++sp & 255u) == 0u) { if (xb_ld(&bar[XB_TMO])) break; if (sp > XB_SPIN_CAP) { atomicAdd(&bar[XB_TMO], 1u); break; } }
    }
    nloc = mine > 0u ? mine : 1u; nx = cnt > 0u ? cnt : 1u;
}
__device__ __forceinline__ void xcd_barrier(const XcdBarrier& b) {
    asm volatile("s_waitcnt vmcnt(0)" ::: "memory");
    __syncthreads();
    if (threadIdx.x == 0) {
        unsigned* bar = b.bar;
        __builtin_amdgcn_s_waitcnt(0);
        unsigned nloc = b.st[0], nx = b.st[1];
        if (nloc == 0u) { xcd_barrier_complete(bar, b.x, nloc, nx); b.st[0] = nloc; b.st[1] = nx; }
        const unsigned old = xb_add(&bar[XB_XSUB(b.x)], 1u);
        const unsigned gen = old / nloc;
        if (old + 1u == (gen + 1u) * nloc) {
            __builtin_amdgcn_fence(__ATOMIC_RELEASE, "agent");
            asm volatile("s_waitcnt vmcnt(0)" ::: "memory");
            const unsigned og = xb_add(&bar[XB_TOP], 1u);
            const unsigned tg = og / nx;
            if (og + 1u == (tg + 1u) * nx) xb_add(&bar[XB_TOPGEN], 1u);
            else XB_SPIN(xb_ld(&bar[XB_TOPGEN]) == tg, bar);
            __builtin_amdgcn_fence(__ATOMIC_ACQUIRE, "agent");
            xb_add(&bar[XB_XGEN(b.x)], 1u);
            asm volatile("s_waitcnt vmcnt(0)" ::: "memory");
        } else {
            XB_SPIN(xb_ld(&bar[XB_XGEN(b.x)]) == gen, bar);
            __builtin_amdgcn_fence(__ATOMIC_ACQUIRE, "agent");
            asm volatile("s_waitcnt vmcnt(0)" ::: "memory");
        }
    }
    __syncthreads();
}
#define EPIIN_NS 0
#define EPI_NS16 0
#define EPI_NS32 0

namespace pg8 {
constexpr int BM = 256, BK = 64, HALF = 128, HTB = HALF * BK * 2, STAGE_BYTES = 8 * HTB, NXCD = 8, WGM = 8;
__host__ __device__ __forceinline__ int lds_byte(int r, int c) { const int st = (r >> 4) * 2 + (c >> 5), rr = r & 15, cc = c & 31, ob = rr * 64 + cc * 2; return st * 1024 + (ob ^ (((ob >> 9) & 1) << 5)); }
__host__ __device__ __forceinline__ void stage_rc(int b, int& R, int& C) { const int st = b / 1024, sb = b % 1024, swz = sb ^ (((sb >> 9) & 1) << 5); R = (st >> 1) * 16 + swz / 64; C = (st & 1) * 32 + (swz % 64) / 2; }
__host__ __device__ __forceinline__ int perm32(int rho) { const int n = rho >> 4, i = rho & 15; return 8 * (i >> 2) + 4 * n + (i & 3); }

struct Unit { int pm, pn, seg; };

struct TileOrder {
    int nM, nN, nwg, G, c;
    __device__ __forceinline__ void init(int nM_, int nN_, int G_, int c_) { nM = nM_; nN = nN_; nwg = nM * nN; G = G_; c = c_; }
    __device__ __forceinline__ bool tile(int i, int& pm, int& pn) const {
        const long L = (long)i * G + c; if (L >= nwg) return false;
        int wgid = (int)L; { const int q = nwg / NXCD, r = nwg % NXCD, xcd = wgid % NXCD, off = wgid / NXCD; wgid = (xcd < r ? xcd * (q + 1) : r * (q + 1) + (xcd - r) * q) + off; }
        const int nig = WGM * nN, gid = wgid / nig, fm = gid * WGM, gsz = (nM - fm) < WGM ? (nM - fm) : WGM;
        pm = fm + ((wgid % nig) % gsz); pn = (wgid % nig) / gsz; return true;
    }
};
struct SchedPlain {
    TileOrder T; const gchar* A; const gchar* B; size_t astep, bstep;
    __device__ __forceinline__ bool next(int i, Unit& u) const { u.seg = 0; return T.tile(i, u.pm, u.pn); }
    __device__ __forceinline__ const gchar* a_ptr(const Unit& u) const { return A + (size_t)u.pm * astep; }
    __device__ __forceinline__ const gchar* b_ptr(const Unit& u) const { return B + (size_t)u.pn * bstep; }
};
struct SchedBranch {
    TileOrder T; const gchar* A; const gchar* B; size_t astep, bstep, aseg, bseg;
    __device__ __forceinline__ bool next(int i, Unit& u) const { const int t = i / 3; u.seg = i - 3 * t; return T.tile(t, u.pm, u.pn); }
    __device__ __forceinline__ const gchar* a_ptr(const Unit& u) const { return A + (size_t)u.seg * aseg + (size_t)u.pm * astep; }
    __device__ __forceinline__ const gchar* b_ptr(const Unit& u) const { return B + (size_t)u.seg * bseg + (size_t)u.pn * bstep; }
};

template <class Epi, class Sched>
__device__ __forceinline__ void gemm_phase(LAS unsigned char* lds, const int K, const int lda, const int ldb, const Sched& S, const Epi& E) {
    int tid = threadIdx.x; LAUNDER_V(tid);
    const int wid = __builtin_amdgcn_readfirstlane(tid >> 6), lane = tid & 63, wr = wid >> 2, wc = wid & 3, fr = lane & 15, fq = lane >> 4;
    const int nt = K / BK;
    unsigned voffA, voffB;
    { int R, C; stage_rc(tid * 16, R, C); const int Rb = Epi::PERM ? ((R & ~31) + perm32(R & 31)) : R;
      voffA = (unsigned)(R * lda + C) * 2u; voffB = (unsigned)(Rb * ldb + C) * 2u; }
    const unsigned qstepA = 64u * (unsigned)lda * 2u, qstepB = 64u * (unsigned)ldb * 2u;
    const size_t kstep = (size_t)(BK * 2);
    const size_t hstepA = (size_t)HALF * lda * 2, hstepB = (size_t)HALF * ldb * 2;
    const unsigned ldsw = (unsigned)wid * 1024u;
    const int aoff = lds_byte(wr * 64 + fr, fq * 8), boff = lds_byte(wc * 32 + fr, fq * 8);
#define PG8_SA(b, h) (((b) * 2 + (h)) * HTB)
#define PG8_SB(b, h) ((4 + (b) * 2 + (h)) * HTB)
#define PG8_STAGE(bufoff, gbase, voff) do { _Pragma("unroll") for (int _i = 0; _i < 2; ++_i) \
        __builtin_amdgcn_global_load_lds((const gunsigned*)((const gchar*)(gbase) + (size_t)_i * q##voff + (voff)), (LAS unsigned*)(lds + (bufoff) + ldsw + _i * 8192), 16, 0, 0); } while (0)
#define qvoffA qstepA
#define qvoffB qstepB
#define PG8_LDA(dst, b, h) do { _Pragma("unroll") for (int m = 0; m < 4; ++m) _Pragma("unroll") for (int k = 0; k < 2; ++k) dst[m][k] = *(const LAS bf16x8*)(lds + PG8_SA(b, h) + aoff + m * 2048 + k * 1024); } while (0)
#define PG8_LDB(dst, b, h) do { _Pragma("unroll") for (int n = 0; n < 2; ++n) _Pragma("unroll") for (int k = 0; k < 2; ++k) dst[n][k] = *(const LAS bf16x8*)(lds + PG8_SB(b, h) + boff + n * 2048 + k * 1024); } while (0)
#define PG8_MMA(ai, bj, At, Bt) do { __builtin_amdgcn_s_setprio(1); _Pragma("unroll") for (int m = 0; m < 4; ++m) _Pragma("unroll") for (int n = 0; n < 2; ++n) _Pragma("unroll") for (int k = 0; k < 2; ++k) \
        acc[ai][bj][m][n] = __builtin_amdgcn_mfma_f32_16x16x32_bf16(Bt[n][k], At[m][k], acc[ai][bj][m][n], 0, 0, 0); __builtin_amdgcn_s_setprio(0); } while (0)
#define PG8_WAIT_V(n) asm volatile("s_waitcnt vmcnt(" #n ")" ::: "memory")
#define PG8_WAIT_VR() do { if constexpr (Epi::NS == 16) asm volatile("s_waitcnt vmcnt(24)" ::: "memory"); else if constexpr (Epi::NS == 32) asm volatile("s_waitcnt vmcnt(40)" ::: "memory"); else asm volatile("s_waitcnt vmcnt(8)" ::: "memory"); } while (0)
#define PG8_WAIT_L(n) asm volatile("s_waitcnt lgkmcnt(" #n ")" ::: "memory")
#define PG8_BAR __builtin_amdgcn_s_barrier()
#define PG8_SCHED __builtin_amdgcn_sched_barrier(0)
    Unit cur, nxt; int ui = 0; bool relax_next = false;
    if (!S.next(0, cur)) return;
    f32x4 acc[2][2][4][2];
#pragma unroll
    for (int a = 0; a < 2; ++a)
#pragma unroll
        for (int b = 0; b < 2; ++b)
#pragma unroll
            for (int m = 0; m < 4; ++m)
#pragma unroll
                for (int n = 0; n < 2; ++n) acc[a][b][m][n] = (f32x4){0.f, 0.f, 0.f, 0.f};
    bf16x8 At[4][2], B0[2][2], B1[2][2];
    const gchar* cA = S.a_ptr(cur); const gchar* cB = S.b_ptr(cur);
    PG8_STAGE(PG8_SB(0, 0), cB, voffB); PG8_STAGE(PG8_SB(0, 1), cB + hstepB, voffB); PG8_STAGE(PG8_SA(0, 0), cA, voffA); PG8_STAGE(PG8_SA(0, 1), cA + hstepA, voffA);
    if (wr == 1) PG8_BAR;
    PG8_WAIT_V(2); PG8_BAR;
    PG8_STAGE(PG8_SB(1, 0), cB + kstep, voffB); PG8_STAGE(PG8_SA(1, 0), cA + kstep, voffA); PG8_STAGE(PG8_SB(1, 1), cB + hstepB + kstep, voffB);
    PG8_WAIT_V(6); PG8_BAR;
    for (;;) {
        const bool has_next = S.next(ui + 1, nxt);
        const gchar* nA = has_next ? S.a_ptr(nxt) : cA; const gchar* nB = has_next ? S.b_ptr(nxt) : cB;
        for (int t = 0; t < nt; t += 2) {
            const bool last = (t == nt - 2); const bool relax = Epi::NS > 0 && (t == 0) && relax_next;
            const gchar* a1 = cA + (size_t)(t + 1) * kstep;
            const gchar* a2 = last ? nA : cA + (size_t)(t + 2) * kstep; const gchar* b2 = last ? nB : cB + (size_t)(t + 2) * kstep;
            const gchar* a3 = a2 + kstep; const gchar* b3 = b2 + kstep;
            PG8_LDB(B0, 0, 0); PG8_LDB(B1, 0, 1); PG8_SCHED; PG8_LDA(At, 0, 0); PG8_STAGE(PG8_SA(1, 1), a1 + hstepA, voffA);
            if (relax) PG8_WAIT_VR(); else PG8_WAIT_V(8); PG8_WAIT_L(0); PG8_BAR; PG8_MMA(0, 0, At, B0); PG8_MMA(0, 1, At, B1); PG8_BAR; PG8_SCHED;
            PG8_LDA(At, 0, 1); PG8_STAGE(PG8_SB(0, 0), b2, voffB); PG8_STAGE(PG8_SB(0, 1), b2 + hstepB, voffB); PG8_STAGE(PG8_SA(0, 0), a2, voffA);
            if (relax) PG8_WAIT_VR(); else PG8_WAIT_V(8); PG8_WAIT_L(0); PG8_BAR; PG8_MMA(1, 0, At, B0); PG8_MMA(1, 1, At, B1); PG8_BAR; PG8_SCHED;
            PG8_LDB(B0, 1, 0); PG8_LDB(B1, 1, 1); PG8_SCHED; PG8_LDA(At, 1, 0); PG8_STAGE(PG8_SA(0, 1), a2 + hstepA, voffA);
            PG8_WAIT_V(8); PG8_WAIT_L(0); PG8_BAR; PG8_MMA(0, 0, At, B0); PG8_MMA(0, 1, At, B1); PG8_BAR; PG8_SCHED;
            PG8_LDA(At, 1, 1); PG8_STAGE(PG8_SB(1, 0), b3, voffB); PG8_STAGE(PG8_SB(1, 1), b3 + hstepB, voffB); PG8_STAGE(PG8_SA(1, 0), a3, voffA);
            PG8_WAIT_V(8); PG8_WAIT_L(0); PG8_BAR; PG8_MMA(1, 0, At, B0); PG8_MMA(1, 1, At, B1); PG8_BAR; PG8_SCHED;
        }
        if (wr == 0) PG8_BAR;
        { const int ln_ = (int)__builtin_amdgcn_mbcnt_hi(~0u, __builtin_amdgcn_mbcnt_lo(~0u, 0u)); E(acc, cur, wr, wc, ln_ & 15, ln_ >> 4); } relax_next = E.relax(cur);
        if (!has_next) break;
        if (!E.keep(cur)) {
#pragma unroll
            for (int a = 0; a < 2; ++a)
#pragma unroll
                for (int b = 0; b < 2; ++b)
#pragma unroll
                    for (int m = 0; m < 4; ++m)
#pragma unroll
                        for (int n = 0; n < 2; ++n) acc[a][b][m][n] = (f32x4){0.f, 0.f, 0.f, 0.f};
        }
        cur = nxt; cA = nA; cB = nB; ++ui;
        if (wr == 1) PG8_BAR;
    }
    PG8_WAIT_V(0);
    PG8_BAR;
#undef PG8_SA
#undef PG8_SB
#undef PG8_STAGE
#undef qvoffA
#undef qvoffB
#undef PG8_LDA
#undef PG8_LDB
#undef PG8_MMA
#undef PG8_WAIT_V
#undef PG8_WAIT_VR
#undef PG8_WAIT_L
#undef PG8_BAR
#undef PG8_SCHED
}
}

constexpr size_t MiB = 1u << 20;
constexpr size_t WS_CTL = 0, CTL_ZERO_BYTES = 1 * MiB;
constexpr int CW_BAR = 4096;
constexpr size_t CTL_SSQ1 = 256 * 1024;
constexpr size_t SZ_WIN = (size_t)N_IN_T * DM * 2, SZ_WBR = (size_t)3 * DM * BW * 2, SZ_WSQ = (size_t)DM * DM * 2, SZ_WPP = (size_t)DM * 256 * 2;
constexpr size_t WS_WIN = 2 * MiB;
constexpr size_t WS_WBR = WS_WIN + 2 * SZ_WIN;
constexpr size_t WS_WOUT = WS_WBR + 2 * SZ_WBR;
constexpr size_t WS_WPG = WS_WOUT + 2 * SZ_WSQ;
constexpr size_t WS_WPP = WS_WPG + 2 * SZ_WSQ;
constexpr size_t SZ_ROWS_BW = (size_t)M_ROWS * BW * 2, SZ_ROWS_D = (size_t)M_ROWS * DM * 2;
constexpr size_t WS_XB = WS_WPP + 2 * SZ_WPP;
constexpr size_t WS_PB = WS_XB + SZ_ROWS_D;
constexpr size_t WS_CS = WS_PB + (size_t)2 * M_ROWS * 256 * 2;
constexpr size_t WS_SSQ0 = WS_CS + (size_t)M_ROWS * 16 * 4;
constexpr size_t WS_AU = WS_SSQ0 + (size_t)M_ROWS * 4;
constexpr size_t WS_AV = WS_AU + SZ_ROWS_BW, WS_AZ = WS_AV + SZ_ROWS_BW, WS_BQ = WS_AZ + SZ_ROWS_BW;
constexpr size_t WS_BK = WS_BQ + SZ_ROWS_BW;
constexpr size_t WS_BV = WS_BK + (size_t)M_ROWS * 256 * 2;
constexpr size_t WS_BZ = WS_BV + (size_t)M_ROWS * 256 * 2;
constexpr size_t WS_CQ = WS_BZ + SZ_ROWS_BW;
constexpr size_t WS_CK = WS_CQ + (size_t)M_ROWS * 1024 * 2;
constexpr size_t WS_CV = WS_CK + (size_t)M_ROWS * 1024 * 2;
constexpr size_t WS_CO = WS_CV + SZ_ROWS_BW, WS_CZ = WS_CO + SZ_ROWS_BW;
constexpr size_t WS_G = WS_CZ + SZ_ROWS_BW;
constexpr size_t WS_IF = WS_G + (size_t)M_ROWS * 12288 * 2;
constexpr size_t WS_LNP = WS_IF + (size_t)M_ROWS * 8 * 4;
constexpr size_t WS_YA = WS_LNP + (size_t)M_ROWS * 32 * 8;
constexpr size_t WS_NUM = WS_YA + 3 * SZ_ROWS_BW;
constexpr size_t WS_SSQC = WS_NUM + SZ_ROWS_BW;
constexpr size_t WS_DN = WS_SSQC + (size_t)M_ROWS * 64 * 4;
constexpr size_t WS_MIX = WS_DN + (size_t)M_ROWS * 4 * 4;
constexpr size_t WS_OUT = WS_MIX + SZ_ROWS_D;
constexpr size_t WS_OUTP = WS_OUT + SZ_ROWS_D;
constexpr size_t WS_ERAW = WS_OUTP + (size_t)M_ROWS * 64 * 4;
constexpr size_t WS_ERP = WS_ERAW + SZ_ROWS_D;
constexpr size_t WS_RSO = WS_ERP + (size_t)M_ROWS * 64 * 4;
constexpr size_t WS_RSE = WS_RSO + (size_t)M_ROWS * 4;
constexpr size_t WS_X1B = WS_RSE + (size_t)M_ROWS * 4;
constexpr size_t WS_END = WS_X1B + SZ_ROWS_D;
static_assert(WS_WIN % 256 == 0 && WS_XB % 256 == 0 && WS_AU % 256 == 0 && WS_G % 256 == 0 && WS_YA % 256 == 0 && WS_MIX % 256 == 0 && WS_X1B % 256 == 0, "alignment");

#ifndef EPIIN_NT
#define EPIIN_NT 0
#endif
#if EPIIN_NT
#define EPIIN_STORE(v, p) __builtin_nontemporal_store((v), (p))
#else
#define EPIIN_STORE(v, p) (*(p) = (v))
#endif
#ifndef EPI_NS16
#define EPI_NS16 16
#endif
#ifndef EPI_NS32
#define EPI_NS32 32
#endif
#ifndef EPIIN_NS
#define EPIIN_NS 16
#endif
namespace pg8 {
struct EpiIn {
    static constexpr bool PERM = true; static constexpr int NS = EPIIN_NS;
    __device__ __forceinline__ bool relax(const Unit& u) const { return u.pn < 122; }
    const gfloat* ssq; guchar* ws;
    __device__ __forceinline__ bool keep(const Unit&) const { return false; }
    __device__ __forceinline__ void operator()(f32x4 (&acc)[2][2][4][2], const Unit& u, int wr, int wc, int fr, int fq) const {
        const int pn = u.pn; const int row0 = u.pm * BM + wr * 64 + fr;
        size_t off; int ldc, t0, act; float sc = 1.f;
        if (pn < 8)        { off = WS_AU; ldc = 2048; t0 = 0; act = 1; }
        else if (pn < 16)  { off = WS_AV; ldc = 2048; t0 = 8; act = 5; }
        else if (pn < 24)  { off = WS_AZ; ldc = 2048; t0 = 16; act = 2; }
        else if (pn < 32)  { off = WS_BQ; ldc = 2048; t0 = 24; act = 0; }
        else if (pn < 33)  { off = WS_BK; ldc = 256; t0 = 32; act = 0; }
        else if (pn < 34)  { off = WS_BV; ldc = 256; t0 = 33; act = 0; }
        else if (pn < 42)  { off = WS_BZ; ldc = 2048; t0 = 34; act = 2; }
        else if (pn < 46)  { off = WS_CQ; ldc = 1024; t0 = 42; act = 0; sc = 0.0625f; }
        else if (pn < 50)  { off = WS_CK; ldc = 1024; t0 = 46; act = 0; }
        else if (pn < 58)  { off = WS_CV; ldc = 2048; t0 = 50; act = 0; }
        else if (pn < 66)  { off = WS_CO; ldc = 2048; t0 = 58; act = 3; }
        else if (pn < 74)  { off = WS_CZ; ldc = 2048; t0 = 66; act = 2; }
        else if (pn < 122) { off = WS_G; ldc = 12288; t0 = 74; act = 3; }
        else               { off = WS_IF; ldc = 8; t0 = 122; act = 4; }
        const int col0 = (pn - t0) * BM + wc * 32 + 8 * fq;
        if (act == 4) {
            if (wc == 0 && fq == 0) {
                gfloat* dst = (gfloat*)(ws + off);
#pragma unroll
                for (int ai = 0; ai < 2; ++ai)
#pragma unroll
                    for (int m = 0; m < 4; ++m) { const int row = row0 + ai * HALF + m * 16; const float rs = rsqrtf(ssq[row] * (1.0f / DM) + NORM_EPS);
                        *(gf32x4*)(dst + (size_t)row * 8) = acc[ai][0][m][0] * rs; *(gf32x4*)(dst + (size_t)row * 8 + 4) = acc[ai][0][m][1] * rs; }
            }
            return;
        }
        gbf16* base = (gbf16*)(ws + off);
#pragma unroll
        for (int ai = 0; ai < 2; ++ai)
#pragma unroll
            for (int m = 0; m < 4; ++m) {
                const int row = row0 + ai * HALF + m * 16; const float rs = rsqrtf(ssq[row] * (1.0f / DM) + NORM_EPS) * sc;
                gbf16* rowp = base + (size_t)row * ldc + col0; float ls = 0.f, lq = 0.f;
#pragma unroll
                for (int bj = 0; bj < 2; ++bj) {
                    f32x4 v0 = acc[ai][bj][m][0] * rs, v1 = acc[ai][bj][m][1] * rs;
                    if (act == 1 || act == 5) {
                        f32x2 a = gelu_pk((f32x2){v0[0], v0[1]}), b = gelu_pk((f32x2){v0[2], v0[3]}), c = gelu_pk((f32x2){v1[0], v1[1]}), d = gelu_pk((f32x2){v1[2], v1[3]});
                        v0 = (f32x4){a.x, a.y, b.x, b.y}; v1 = (f32x4){c.x, c.y, d.x, d.y};
                        if (act == 5) { ls += (v0[0] + v0[1]) + (v0[2] + v0[3]) + (v1[0] + v1[1]) + (v1[2] + v1[3]);
                            lq += (v0[0] * v0[0] + v0[1] * v0[1]) + (v0[2] * v0[2] + v0[3] * v0[3]) + (v1[0] * v1[0] + v1[1] * v1[1]) + (v1[2] * v1[2] + v1[3] * v1[3]); }
                    } else if (act == 2) {
#pragma unroll
                        for (int j = 0; j < 4; ++j) { v0[j] = v0[j] * fsigmoid(v0[j]); v1[j] = v1[j] * fsigmoid(v1[j]); }
                    } else if (act == 3) {
#pragma unroll
                        for (int j = 0; j < 4; ++j) { v0[j] = fsigmoid(v0[j]); v1[j] = fsigmoid(v1[j]); }
                    }
                    u32x4 w; w.x = cvt_pk_bf16(v0[0], v0[1]); w.y = cvt_pk_bf16(v0[2], v0[3]); w.z = cvt_pk_bf16(v1[0], v1[1]); w.w = cvt_pk_bf16(v1[2], v1[3]);
                    EPIIN_STORE(w, (gu32x4*)(rowp + bj * HALF));
                }
                if (act == 5) {
                    ls += __shfl_xor(ls, 16); ls += __shfl_xor(ls, 32); lq += __shfl_xor(lq, 16); lq += __shfl_xor(lq, 32);
                    if (fq == 0) *(gf32x2*)(ws + WS_LNP + ((size_t)row * 32 + (pn - 8) * 4 + wc) * 8) = (f32x2){ls, lq};
                }
            }
    }
};
struct EpiBranch {
    static constexpr bool PERM = true; static constexpr int NS = EPI_NS16;
    __device__ __forceinline__ bool relax(const Unit& u) const { return u.seg == 2; }
    const gbf16* G; gbf16* MIX;
    __device__ __forceinline__ bool keep(const Unit& u) const { return u.seg != 2; }
    __device__ __forceinline__ void operator()(f32x4 (&acc)[2][2][4][2], const Unit& u, int wr, int wc, int fr, int fq) const {
        const int row0 = u.pm * BM + wr * 64 + fr, col0 = u.pn * BM + wc * 32 + 8 * fq; const int seg = u.seg;
#pragma unroll
        for (int ai = 0; ai < 2; ++ai)
#pragma unroll
            for (int m = 0; m < 4; ++m) {
                const int row = row0 + ai * HALF + m * 16; const gbf16* gp = G + (size_t)row * 12288 + seg * DM + col0;
#pragma unroll
                for (int bj = 0; bj < 2; ++bj) {
                    const u32x4 ga = *(const gu32x4*)(gp + bj * HALF);
                    float f[8] = {bf_lo(ga.x), bf_hi(ga.x), bf_lo(ga.y), bf_hi(ga.y), bf_lo(ga.z), bf_hi(ga.z), bf_lo(ga.w), bf_hi(ga.w)};
#pragma unroll
                    for (int j = 0; j < 8; ++j) f[j] = fmaxf(f[j], 1e-20f);
                    if (seg != 2) {
                        const u32x4 gb = *(const gu32x4*)(gp + DM + bj * HALF);
                        const float h[8] = {bf_lo(gb.x), bf_hi(gb.x), bf_lo(gb.y), bf_hi(gb.y), bf_lo(gb.z), bf_hi(gb.z), bf_lo(gb.w), bf_hi(gb.w)};
#pragma unroll
                        for (int j = 0; j < 8; ++j) f[j] = f[j] * __builtin_amdgcn_rcpf(fmaxf(h[j], 1e-20f));
                    }
                    f32x4 v0 = acc[ai][bj][m][0], v1 = acc[ai][bj][m][1];
                    v0 = v0 * (f32x4){f[0], f[1], f[2], f[3]}; v1 = v1 * (f32x4){f[4], f[5], f[6], f[7]};
                    if (seg != 2) { acc[ai][bj][m][0] = v0; acc[ai][bj][m][1] = v1; }
                    else { u32x4 w; w.x = cvt_pk_bf16(v0[0], v0[1]); w.y = cvt_pk_bf16(v0[2], v0[3]); w.z = cvt_pk_bf16(v1[0], v1[1]); w.w = cvt_pk_bf16(v1[2], v1[3]);
                        *(gu32x4*)(MIX + (size_t)row * DM + col0 + bj * HALF) = w; }
                }
                if (m == 3) asm volatile("" ::: "memory");
            }
    }
};
struct EpiSq {
    static constexpr bool PERM = true; static constexpr int NS = EPI_NS16;
    __device__ __forceinline__ bool relax(const Unit&) const { return true; }
    gbf16* O; gfloat* P;
    __device__ __forceinline__ bool keep(const Unit&) const { return false; }
    __device__ __forceinline__ void operator()(f32x4 (&acc)[2][2][4][2], const Unit& u, int wr, int wc, int fr, int fq) const {
        const int row0 = u.pm * BM + wr * 64 + fr, col0 = u.pn * BM + wc * 32 + 8 * fq;
#pragma unroll
        for (int ai = 0; ai < 2; ++ai)
#pragma unroll
            for (int m = 0; m < 4; ++m) {
                const int row = row0 + ai * HALF + m * 16; float q = 0.f;
#pragma unroll
                for (int bj = 0; bj < 2; ++bj) {
                    const f32x4 v0 = acc[ai][bj][m][0], v1 = acc[ai][bj][m][1];
                    q += (v0[0] * v0[0] + v0[1] * v0[1]) + (v0[2] * v0[2] + v0[3] * v0[3]) + (v1[0] * v1[0] + v1[1] * v1[1]) + (v1[2] * v1[2] + v1[3] * v1[3]);
                    u32x4 w; w.x = cvt_pk_bf16(v0[0], v0[1]); w.y = cvt_pk_bf16(v0[2], v0[3]); w.z = cvt_pk_bf16(v1[0], v1[1]); w.w = cvt_pk_bf16(v1[2], v1[3]);
                    if (O) *(gu32x4*)(O + (size_t)row * DM + col0 + bj * HALF) = w; else asm volatile("" :: "v"(w));
                }
                q += __shfl_xor(q, 16); q += __shfl_xor(q, 32);
                if (fq == 0) P[(size_t)row * 64 + u.pn * 4 + wc] = q;
            }
    }
};
struct EpiPle {
    static constexpr bool PERM = false; static constexpr int NS = EPI_NS32;
    __device__ __forceinline__ bool relax(const Unit&) const { return true; }
    const gfloat* XIN; gfloat* XOUT; gbf16* XB; const gbf16* OUT; const gbf16* ERAW; const gfloat* RSO; const gfloat* RSE; const gfloat* npost; const gfloat* pnorm; gfloat* SSQN; int last;
    __device__ __forceinline__ bool keep(const Unit&) const { return false; }
    __device__ __forceinline__ void operator()(f32x4 (&acc)[2][2][4][2], const Unit& u, int wr, int wc, int fr, int fq) const {
        const int row0 = u.pm * BM + wr * 64 + fr, col0 = u.pn * BM + wc * 32 + 4 * fq;
#pragma unroll
        for (int ai = 0; ai < 2; ++ai)
#pragma unroll
            for (int m = 0; m < 4; ++m) {
                const int row = row0 + ai * HALF + m * 16; const float rso = RSO[row], rse = RSE[row]; float q = 0.f; const size_t ro = (size_t)row * DM;
#pragma unroll
                for (int bj = 0; bj < 2; ++bj)
#pragma unroll
                    for (int n = 0; n < 2; ++n) {
                        const int col = col0 + bj * HALF + n * 16;
                        const f32x4 x = *(const gf32x4*)(XIN + ro + col); const u32x2 ob = *(const gu32x2*)(OUT + ro + col), eb = *(const gu32x2*)(ERAW + ro + col);
                        const f32x4 np = *(const gf32x4*)(npost + col), pn = *(const gf32x4*)(pnorm + col);
                        const f32x4 o = {bf_lo(ob.x), bf_hi(ob.x), bf_lo(ob.y), bf_hi(ob.y)}, e = {bf_lo(eb.x), bf_hi(eb.x), bf_lo(eb.y), bf_hi(eb.y)};
                        const f32x4 a = acc[ai][bj][m][n]; f32x4 r;
#pragma unroll
                        for (int j = 0; j < 4; ++j) { const float x1 = x[j] + o[j] * rso * np[j]; r[j] = x1 + fsigmoid(a[j]) * (e[j] * rse * pn[j]); q += r[j] * r[j]; }
                        *(gf32x4*)(XOUT + ro + col) = r;
                        if (!last) { u32x2 w; w.x = cvt_pk_bf16(r[0], r[1]); w.y = cvt_pk_bf16(r[2], r[3]); *(gu32x2*)(XB + ro + col) = w; }
                    }
                if (!last) { q += __shfl_xor(q, 16); q += __shfl_xor(q, 32); if (fq == 0) (void)__hip_atomic_fetch_add(SSQN + row, q, __ATOMIC_RELAXED, __HIP_MEMORY_SCOPE_AGENT); }
                if (m & 1) asm volatile("" ::: "memory");
            }
    }
};
}

constexpr int LDS_BYTES = 147456;
constexpr int MISC_OFF = LDS_BYTES - 128;
constexpr int ARGS_OFF = LDS_BYTES - 512;
constexpr int NWAVES = 8, NTHREADS = 512;

struct Ctx {
    LAS unsigned char* lds; int tid, lane, wave, vcu, G, bx;
};

struct TrTile { const gfloat* W; const gfloat* kscale; gbf16* WT; int ldw, K; };
constexpr int TR_PER_LAYER = 7808 + 1536 + 1024 + 1024 + 64;
__device__ __forceinline__ TrTile tr_decode(int it, const gfloat* w_in, const gfloat* norm_pre, const gfloat* w_branch, const gfloat* w_out, const gfloat* ple_gate, const gfloat* ple_proj, guchar* ws) {
    const int l = it / TR_PER_LAYER; int r = it - l * TR_PER_LAYER; TrTile t; int kt, ntile;
    if (r < 7808) { kt = r / 244; ntile = r - kt * 244; const int src = ntile < 116 ? ntile * 128 : ntile * 128 + 8;
        t.ldw = N_IN; t.K = DM; t.W = w_in + (size_t)l * DM * N_IN + (size_t)kt * 128 * N_IN + src; t.kscale = norm_pre + l * DM + kt * 128;
        t.WT = (gbf16*)(ws + WS_WIN + (size_t)l * SZ_WIN) + (size_t)ntile * 128 * DM + kt * 128; return t; }
    r -= 7808; t.kscale = nullptr; t.ldw = DM;
    if (r < 1536) { const int j = r / 512; const int rr = r - j * 512; kt = rr / 32; ntile = rr - kt * 32; t.K = BW;
        t.W = w_branch + ((size_t)(l * 3 + j) * BW + (size_t)kt * 128) * DM + ntile * 128;
        t.WT = (gbf16*)(ws + WS_WBR + (size_t)l * SZ_WBR) + (size_t)j * DM * BW + (size_t)ntile * 128 * BW + kt * 128; return t; }
    r -= 1536;
    if (r < 2048) { const int which = r / 1024; const int rr = r - which * 1024; kt = rr / 32; ntile = rr - kt * 32; t.K = DM;
        t.W = (which ? ple_gate : w_out) + ((size_t)l * DM + (size_t)kt * 128) * DM + ntile * 128;
        t.WT = (gbf16*)(ws + (which ? WS_WPG : WS_WOUT) + (size_t)l * SZ_WSQ) + (size_t)ntile * 128 * DM + kt * 128; return t; }
    r -= 2048; kt = r / 32; ntile = r - kt * 32; t.K = 256;
    t.W = ple_proj + ((size_t)l * 256 + (size_t)kt * 128) * DM + ntile * 128;
    t.WT = (gbf16*)(ws + WS_WPP + (size_t)l * SZ_WPP) + (size_t)ntile * 128 * 256 + kt * 128; return t;
}
__device__ __forceinline__ void tr_run(const Ctx& F, int it0, int it1, int sk0, int sk1, int me, int nw, const gfloat* w_in, const gfloat* norm_pre, const gfloat* w_branch,
                                       const gfloat* w_out, const gfloat* ple_gate, const gfloat* ple_proj, guchar* ws) {
    int tid = F.tid; LAUNDER_V(tid);
    {
        constexpr int RS = 264; const int NIT = it1 - it0 - (sk1 - sk0);
        const int c4 = tid & 31, kr = tid >> 5, kc = tid & 15;
        f32x4 va[8], vb[8]; float ka[8], kb[8]; TrTile ta, tb;
#define TR_LOAD(T_, V_, K_, IT_) do { T_ = tr_decode(it0 + (IT_) + (((it0 + (IT_)) >= sk0) ? (sk1 - sk0) : 0), w_in, norm_pre, w_branch, w_out, ple_gate, ple_proj, ws); \
        _Pragma("unroll") for (int i = 0; i < 8; ++i) { V_[i] = *(const gf32x4*)(T_.W + (size_t)(i * 16 + kr) * T_.ldw + 4 * c4); K_[i] = T_.kscale ? T_.kscale[i * 16 + kr] : 1.0f; } } while (0)
#define TR_PUT(V_, K_) do { _Pragma("unroll") for (int i = 0; i < 8; ++i) { const f32x4 a = V_[i] * K_[i]; u32x2 w; w.x = cvt_pk_bf16(a[0], a[1]); w.y = cvt_pk_bf16(a[2], a[3]); \
        *(LAS u32x2*)(F.lds + (i * 16 + kr) * RS + c4 * 8) = w; } } while (0)
#define TR_GET(WT_, K_) do { _Pragma("unroll") for (int q = 0; q < 4; ++q) { const int n = 32 * q + (tid >> 4); const LAS bf16_t* s = (const LAS bf16_t*)(F.lds + (8 * kc) * RS + 2 * n); unsigned e[8]; \
        _Pragma("unroll") for (int j = 0; j < 8; ++j) e[j] = s[j * (RS / 2)]; \
        u32x4 o; o.x = e[0] | (e[1] << 16); o.y = e[2] | (e[3] << 16); o.z = e[4] | (e[5] << 16); o.w = e[6] | (e[7] << 16); \
        *(gu32x4*)(WT_ + (size_t)n * K_ + 8 * kc) = o; } } while (0)
        int it = me;
        if (it < NIT) TR_LOAD(ta, va, ka, it);
        if (it + nw < NIT) TR_LOAD(tb, vb, kb, it + nw);
        while (it < NIT) {
            { TR_PUT(va, ka); __syncthreads(); gbf16* wt = ta.WT; const int kk = ta.K;
              if (it + 2 * nw < NIT) TR_LOAD(ta, va, ka, it + 2 * nw);
              TR_GET(wt, kk); __syncthreads(); }
            it += nw; if (it >= NIT) break;
            { TR_PUT(vb, kb); __syncthreads(); gbf16* wt = tb.WT; const int kk = tb.K;
              if (it + 2 * nw < NIT) TR_LOAD(tb, vb, kb, it + 2 * nw);
              TR_GET(wt, kk); __syncthreads(); }
            it += nw;
        }
#undef TR_LOAD
#undef TR_PUT
#undef TR_GET
    }
}
constexpr int TR_DEFER0 = TR_PER_LAYER + 7808 + 1536, TR_DEFER1 = TR_DEFER0 + 2048;
__device__ __forceinline__ void p0_prologue(const Ctx& F, const gfloat* x, const gfloat* p, const gint* positions, const gfloat* norm_pre, const gfloat* w_in, const gfloat* w_branch,
                                            const gfloat* w_out, const gfloat* ple_gate, const gfloat* ple_proj, guchar* ws) {
    int tid = F.tid; LAUNDER_V(tid);
    tr_run(F, 0, NLAYER * TR_PER_LAYER, TR_DEFER0, TR_DEFER1, F.vcu, F.G, w_in, norm_pre, w_branch, w_out, ple_gate, ple_proj, ws);
    const int gt = F.vcu * NTHREADS + tid, NGT = F.G * NTHREADS;
    for (int i = gt; i < NLAYER * 256 * DM; i += NGT) { const int l = i / (256 * DM), rr = (i / DM) & 255, k = i & (DM - 1);
        float val = 0.f; if (rr < 8) val = w_in[(size_t)l * DM * N_IN + (size_t)k * N_IN + IF_COL + rr] * norm_pre[l * DM + k];
        ((gbf16*)(ws + WS_WIN + (size_t)l * SZ_WIN))[(size_t)(122 * 256 + rr) * DM + k] = (bf16_t)(cvt_pk_bf16(val, 0.f) & 0xffffu); }
    for (int i = gt; i < NLAYER * M_ROWS * 256 / 4; i += NGT) { const f32x4 a = ((const gf32x4*)p)[i]; u32x2 w; w.x = cvt_pk_bf16(a[0], a[1]); w.y = cvt_pk_bf16(a[2], a[3]); ((gu32x2*)(ws + WS_PB))[i] = w; }
    for (int i = gt; i < M_ROWS * 8; i += NGT) { const int row = i >> 3, j = i & 7; const float inv = powf(500000.0f, -(float)j * 0.125f); const float ang = (float)positions[row] * inv;
        gfloat* cs = (gfloat*)(ws + WS_CS) + (size_t)row * 16; cs[j] = cosf(ang); cs[8 + j] = sinf(ang); }
    { const int gw = F.vcu * NWAVES + F.wave, NGW = F.G * NWAVES;
      for (int m = gw; m < M_ROWS; m += NGW) { const gf32x4* xr = (const gf32x4*)(x + (size_t)m * DM) + F.lane; gu32x2* o = (gu32x2*)(ws + WS_XB + (size_t)m * DM * 2) + F.lane; float s = 0.f;
#pragma unroll
          for (int j = 0; j < 16; ++j) { const f32x4 a = xr[64 * j]; s += (a[0] * a[0] + a[1] * a[1]) + (a[2] * a[2] + a[3] * a[3]); u32x2 w; w.x = cvt_pk_bf16(a[0], a[1]); w.y = cvt_pk_bf16(a[2], a[3]); o[64 * j] = w; }
          s = wave_sum(s); if (F.lane == 0) ((gfloat*)(ws + WS_SSQ0))[m] = s; } }
}

__device__ __forceinline__ u32x2 pack4(const f32x4 v) { u32x2 w; w.x = cvt_pk_bf16(v[0], v[1]); w.y = cvt_pk_bf16(v[2], v[3]); return w; }
__device__ __forceinline__ bf16x8 mk_frag(const u32x2 lo, const u32x2 hi) { const u32x4 t = {lo.x, lo.y, hi.x, hi.y}; return __builtin_bit_cast(bf16x8, t); }
__device__ __forceinline__ bf16x8 frag_const(unsigned w) { const u32x4 t = {w, w, w, w}; return __builtin_bit_cast(bf16x8, t); }

constexpr int GM_WL = 0, GM_VT = 34816, GM_ST = 104448, GM_RS = 272;
__device__ __forceinline__ void gmlp_unit(const Ctx& F, int b, int n, int g, guchar* ws, const gfloat* ln_g, const gfloat* ln_b, const gfloat* wsp, const gfloat* bsp) {
    int tid = F.tid; LAUNDER_V(tid); const int lane = tid & 63, w = F.wave, r16 = lane & 15, q4 = lane >> 4;
    const int row0 = b * SEQ + n * 128, c0 = g * 256;
    const gbf16* AU = (const gbf16*)(ws + WS_AU); const gbf16* AV = (const gbf16*)(ws + WS_AV); const gbf16* AZ = (const gbf16*)(ws + WS_AZ); gbf16* YA = (gbf16*)(ws + WS_YA);
    if (tid < 128) { const gf32x2* pp = (const gf32x2*)(ws + WS_LNP) + (size_t)(row0 + tid) * 32; float s = 0.f, q = 0.f;
#pragma unroll 8
        for (int j = 0; j < 32; ++j) { const f32x2 t = pp[j]; s += t.x; q += t.y; }
        const float mu = s * (1.0f / BW); const float var = fmaxf(q * (1.0f / BW) - mu * mu, 0.f);
        *(LAS f32x2*)(F.lds + GM_ST + tid * 8) = (f32x2){mu, rsqrtf(var + NORM_EPS)}; }
#pragma unroll
    for (int k = 0; k < 8; ++k) { const int item = tid + 512 * k, t = item >> 5, ch = item & 31;
        f32x4 a = *(const gf32x4*)(wsp + ((size_t)(g * 128 + t)) * 128 + 4 * ch);
#pragma unroll
        for (int e = 0; e < 4; ++e) if (4 * ch + e > t) a[e] = 0.f;
        *(LAS u32x2*)(F.lds + GM_WL + t * GM_RS + ch * 8) = pack4(a); }
    __syncthreads();
#pragma unroll
    for (int k = 0; k < 8; ++k) { const int item = tid + 512 * k, s = item & 127, ch = item >> 7;
        const u32x4 raw = *(const gu32x4*)(AV + (size_t)(row0 + s) * BW + c0 + 8 * ch);
        const f32x4 g0 = *(const gf32x4*)(ln_g + c0 + 8 * ch), g1 = *(const gf32x4*)(ln_g + c0 + 8 * ch + 4), b0 = *(const gf32x4*)(ln_b + c0 + 8 * ch), b1 = *(const gf32x4*)(ln_b + c0 + 8 * ch + 4);
        const f32x2 st = *(const LAS f32x2*)(F.lds + GM_ST + s * 8);
        const float xv[8] = {bf_lo(raw.x), bf_hi(raw.x), bf_lo(raw.y), bf_hi(raw.y), bf_lo(raw.z), bf_hi(raw.z), bf_lo(raw.w), bf_hi(raw.w)};
        const float gg[8] = {g0[0], g0[1], g0[2], g0[3], g1[0], g1[1], g1[2], g1[3]}, bb[8] = {b0[0], b0[1], b0[2], b0[3], b1[0], b1[1], b1[2], b1[3]};
#pragma unroll
        for (int i = 0; i < 8; ++i) { const float y = (xv[i] - st.x) * st.y * gg[i] + bb[i];
            *(LAS bf16_t*)(F.lds + GM_VT + (8 * ch + i) * GM_RS + 2 * s) = (bf16_t)(cvt_pk_bf16(y, 0.f) & 0xffffu); } }
    __syncthreads();
    f32x4 acc[2][8];
#pragma unroll
    for (int m = 0; m < 2; ++m)
#pragma unroll
        for (int n8 = 0; n8 < 8; ++n8) acc[m][n8] = (f32x4){0.f, 0.f, 0.f, 0.f};
    bf16x8 af[2][4];
#pragma unroll
    for (int m = 0; m < 2; ++m)
#pragma unroll
        for (int ks = 0; ks < 4; ++ks) af[m][ks] = *(const LAS bf16x8*)(F.lds + GM_VT + (32 * w + 16 * m + r16) * GM_RS + ks * 64 + q4 * 16);
#pragma unroll
    for (int n8 = 0; n8 < 8; ++n8)
#pragma unroll
        for (int ks = 0; ks < 4; ++ks) if (ks <= n8 / 2) {
            const bf16x8 bfr = *(const LAS bf16x8*)(F.lds + GM_WL + (16 * n8 + r16) * GM_RS + ks * 64 + q4 * 16);
#pragma unroll
            for (int m = 0; m < 2; ++m) acc[m][n8] = MFMA16(af[m][ks], bfr, acc[m][n8]); }
#pragma unroll
    for (int n8 = 0; n8 < 8; ++n8) { const int t = 16 * n8 + r16; const float bsv = bsp[g * 128 + t]; const size_t ro = (size_t)(row0 + t) * BW + c0 + 32 * w + 4 * q4;
#pragma unroll
        for (int m = 0; m < 2; ++m) { const u32x2 ub = *(const gu32x2*)(AU + ro + 16 * m), zb = *(const gu32x2*)(AZ + ro + 16 * m);
            const f32x4 a = acc[m][n8] + bsv; f32x4 y;
            y[0] = a[0] * bf_lo(ub.x) * bf_lo(zb.x); y[1] = a[1] * bf_hi(ub.x) * bf_hi(zb.x); y[2] = a[2] * bf_lo(ub.y) * bf_lo(zb.y); y[3] = a[3] * bf_hi(ub.y) * bf_hi(zb.y);
            *(gu32x2*)(YA + ro + 16 * m) = pack4(y); } }
    __syncthreads();
}

constexpr int SW_KL = 0, SW_VT = 36864, SW_QL = 70656, SW_RS = 144, SW_VS = 528;
__device__ __forceinline__ void rope8(const u32x4 a, const u32x4 bq, const gfloat* cs, float scale, u32x4& o1, u32x4& o2) {
    const f32x4 c0 = *(const gf32x4*)cs, c1 = *(const gf32x4*)(cs + 4), s0 = *(const gf32x4*)(cs + 8), s1 = *(const gf32x4*)(cs + 12);
    const float t1[8] = {bf_lo(a.x), bf_hi(a.x), bf_lo(a.y), bf_hi(a.y), bf_lo(a.z), bf_hi(a.z), bf_lo(a.w), bf_hi(a.w)};
    const float t2[8] = {bf_lo(bq.x), bf_hi(bq.x), bf_lo(bq.y), bf_hi(bq.y), bf_lo(bq.z), bf_hi(bq.z), bf_lo(bq.w), bf_hi(bq.w)};
    const float cc[8] = {c0[0], c0[1], c0[2], c0[3], c1[0], c1[1], c1[2], c1[3]}, ss[8] = {s0[0], s0[1], s0[2], s0[3], s1[0], s1[1], s1[2], s1[3]};
    float r1[8], r2[8];
#pragma unroll
    for (int i = 0; i < 8; ++i) { r1[i] = (t1[i] * cc[i] - t2[i] * ss[i]) * scale; r2[i] = (t2[i] * cc[i] + t1[i] * ss[i]) * scale; }
    o1 = (u32x4){cvt_pk_bf16(r1[0], r1[1]), cvt_pk_bf16(r1[2], r1[3]), cvt_pk_bf16(r1[4], r1[5]), cvt_pk_bf16(r1[6], r1[7])};
    o2 = (u32x4){cvt_pk_bf16(r2[0], r2[1]), cvt_pk_bf16(r2[2], r2[3]), cvt_pk_bf16(r2[4], r2[5]), cvt_pk_bf16(r2[6], r2[7])};
}
__device__ __forceinline__ u32x4 scale8(const u32x4 a, float sc) {
    return (u32x4){cvt_pk_bf16(bf_lo(a.x) * sc, bf_hi(a.x) * sc), cvt_pk_bf16(bf_lo(a.y) * sc, bf_hi(a.y) * sc), cvt_pk_bf16(bf_lo(a.z) * sc, bf_hi(a.z) * sc), cvt_pk_bf16(bf_lo(a.w) * sc, bf_hi(a.w) * sc)};
}
__device__ __forceinline__ void swa_unit(const Ctx& F, int b, int n, int hk, guchar* ws, const gfloat* sinks) {
    int tid = F.tid; LAUNDER_V(tid); const int lane = tid & 63, w = F.wave, r16 = lane & 15, q4 = lane >> 4;
    const int r0 = b * SEQ + n * 128, kr0 = r0 - 128;
    const gbf16* BQ = (const gbf16*)(ws + WS_BQ); const gbf16* BK = (const gbf16*)(ws + WS_BK); const gbf16* BV = (const gbf16*)(ws + WS_BV); const gbf16* BZ = (const gbf16*)(ws + WS_BZ);
    gbf16* YB = (gbf16*)(ws + WS_YA) + (size_t)M_ROWS * BW; const gfloat* CS = (const gfloat*)(ws + WS_CS);
#pragma unroll
    for (int k = 0; k < 4; ++k) { const int item = tid + 512 * k, key = item >> 3, ch = item & 7; const bool pad = (n == 0 && key < 128);
        if (ch == 1) continue;
        const gbf16* src = BK + (size_t)(kr0 + key) * 256 + hk * 64;
        LAS unsigned char* dst = F.lds + SW_KL + key * SW_RS;
        if (pad) { *(LAS u32x4*)(dst + ch * 16) = (u32x4){0u, 0u, 0u, 0u}; if (ch == 0) *(LAS u32x4*)(dst + 16) = (u32x4){0u, 0u, 0u, 0u}; }
        else if (ch == 0) { u32x4 o1, o2; rope8(*(const gu32x4*)src, *(const gu32x4*)(src + 8), CS + (size_t)(kr0 + key) * 16, 1.0f, o1, o2); *(LAS u32x4*)dst = o1; *(LAS u32x4*)(dst + 16) = o2; }
        else *(LAS u32x4*)(dst + ch * 16) = *(const gu32x4*)(src + 8 * ch); }
#pragma unroll
    for (int k = 0; k < 4; ++k) { const int item = tid + 512 * k, key = item & 255, ch = item >> 8; const bool pad = (n == 0 && key < 128);
        u32x4 raw = {0u, 0u, 0u, 0u}; if (!pad) raw = *(const gu32x4*)(BV + (size_t)(kr0 + key) * 256 + hk * 64 + 8 * ch);
        const unsigned e[4] = {raw.x, raw.y, raw.z, raw.w};
#pragma unroll
        for (int i = 0; i < 8; ++i) *(LAS bf16_t*)(F.lds + SW_VT + (8 * ch + i) * SW_VS + 2 * key) = (bf16_t)((e[i >> 1] >> ((i & 1) * 16)) & 0xffffu); }
    for (int hi = 0; hi < 8; ++hi) {
        const int hq = hk * 8 + hi;
#pragma unroll
        for (int k = 0; k < 2; ++k) { const int item = tid + 512 * k, qr = item >> 3, ch = item & 7;
            if (ch == 1) continue;
            const gbf16* src = BQ + (size_t)(r0 + qr) * BW + hq * 64; LAS unsigned char* dst = F.lds + SW_QL + qr * SW_RS;
            if (ch == 0) { u32x4 o1, o2; rope8(*(const gu32x4*)src, *(const gu32x4*)(src + 8), CS + (size_t)(r0 + qr) * 16, 0.125f, o1, o2); *(LAS u32x4*)dst = o1; *(LAS u32x4*)(dst + 16) = o2; }
            else *(LAS u32x4*)(dst + ch * 16) = scale8(*(const gu32x4*)(src + 8 * ch), 0.125f); }
        __syncthreads();
        bf16x8 bq[2];
#pragma unroll
        for (int ks = 0; ks < 2; ++ks) bq[ks] = *(const LAS bf16x8*)(F.lds + SW_QL + (16 * w + r16) * SW_RS + ks * 64 + q4 * 16);
        f32x4 s[16];
#pragma unroll
        for (int kt = 0; kt < 16; ++kt) { s[kt] = (f32x4){0.f, 0.f, 0.f, 0.f};
#pragma unroll
            for (int ks = 0; ks < 2; ++ks) { const bf16x8 a = *(const LAS bf16x8*)(F.lds + SW_KL + (16 * kt + r16) * SW_RS + ks * 64 + q4 * 16); s[kt] = MFMA16(a, bq[ks], s[kt]); } }
        const int qi = 16 * w + r16; const float sink = sinks[hq]; float mx = sink;
#pragma unroll
        for (int kt = 0; kt < 16; ++kt)
#pragma unroll
            for (int e = 0; e < 4; ++e) { const int kj = 16 * kt + 4 * q4 + e; const bool valid = (kj > qi) && (kj <= qi + 128) && (n > 0 || kj >= 128);
                s[kt][e] = valid ? s[kt][e] : -1e30f; mx = fmaxf(mx, s[kt][e]); }
        mx = fmaxf(mx, __shfl_xor(mx, 16)); mx = fmaxf(mx, __shfl_xor(mx, 32));
        float sum = 0.f;
#pragma unroll
        for (int kt = 0; kt < 16; ++kt)
#pragma unroll
            for (int e = 0; e < 4; ++e) { const float pv = (s[kt][e] > -1e29f) ? __expf(s[kt][e] - mx) : 0.f; s[kt][e] = pv; sum += pv; }
        sum += __shfl_xor(sum, 16); sum += __shfl_xor(sum, 32); sum += __expf(sink - mx);
        const float inv = 1.0f / sum;
        f32x4 o[4];
#pragma unroll
        for (int dt = 0; dt < 4; ++dt) o[dt] = (f32x4){0.f, 0.f, 0.f, 0.f};
#pragma unroll
        for (int kk = 0; kk < 8; ++kk) { const bf16x8 pf = mk_frag(pack4(s[2 * kk]), pack4(s[2 * kk + 1]));
#pragma unroll
            for (int dt = 0; dt < 4; ++dt) { const LAS unsigned char* vp = F.lds + SW_VT + (16 * dt + r16) * SW_VS + (32 * kk + 4 * q4) * 2;
                const bf16x8 a = mk_frag(*(const LAS u32x2*)vp, *(const LAS u32x2*)(vp + 32)); o[dt] = MFMA16(a, pf, o[dt]); } }
        const size_t ro = (size_t)(r0 + qi) * BW + hq * 64 + 4 * q4;
#pragma unroll
        for (int dt = 0; dt < 4; ++dt) { const u32x2 zb = *(const gu32x2*)(BZ + ro + 16 * dt); f32x4 y;
            y[0] = o[dt][0] * inv * bf_lo(zb.x); y[1] = o[dt][1] * inv * bf_hi(zb.x); y[2] = o[dt][2] * inv * bf_lo(zb.y); y[3] = o[dt][3] * inv * bf_hi(zb.y);
            *(gu32x2*)(YB + ro + 16 * dt) = pack4(y); }
        __syncthreads();
    }
}

constexpr int ML_QL = 0, ML_KL = 33792, ML_KWT = 67584, ML_VT = 104448, ML_CT = 109056, ML_X = 126480, ML_GATE = 135696, ML_GSZ = 1344, ML_RS = 528, ML_TS = 144;
static_assert(ML_GATE + 2 * ML_GSZ <= ARGS_OFF, "mLSTM LDS map");
__device__ __forceinline__ float wave_scan_add(float v, int lane) {
#pragma unroll
    for (int d = 1; d < 64; d <<= 1) { const float t = __shfl_up(v, d); if (lane >= d) v += t; }
    return v;
}
__device__ __forceinline__ float wave_scan_max(float v, int lane) {
#pragma unroll
    for (int d = 1; d < 64; d <<= 1) { const float t = __shfl_up(v, d); if (lane >= d) v = fmaxf(v, t); }
    return v;
}
__device__ __forceinline__ float softcap15(float z) { const float e = __expf(z * (2.0f / 15.0f)); return 15.0f * (1.0f - 2.0f * __builtin_amdgcn_rcpf(e + 1.0f)); }
__device__ __forceinline__ void mlstm_unit(const Ctx& F, int b, int h, int sl, guchar* ws, const gfloat* ibp, const gfloat* fbp) {
    int tid = F.tid; LAUNDER_V(tid); const int lane = tid & 63, w = F.wave, r16 = lane & 15, q4 = lane >> 4;
    const gbf16* CQ = (const gbf16*)(ws + WS_CQ) + h * 256; const gbf16* CK = (const gbf16*)(ws + WS_CK) + h * 256; const gbf16* CV = (const gbf16*)(ws + WS_CV) + h * 512 + sl * 32;
    const gfloat* IFB = (const gfloat*)(ws + WS_IF);
    gbf16* NUM = (gbf16*)(ws + WS_NUM) + h * 512 + sl * 32; gfloat* SSQC = (gfloat*)(ws + WS_SSQC); gfloat* DNB = (gfloat*)(ws + WS_DN);
    const int rowb = b * SEQ;
    const bf16x8 ones = frag_const(0x3f803f80u), zeros = frag_const(0u);
    for (int i = tid; i < 33 * ML_RS / 16; i += NTHREADS) *(LAS u32x4*)(F.lds + ML_CT + i * 16) = (u32x4){0u, 0u, 0u, 0u};
    f32x4 st[2][3];
#pragma unroll
    for (int i = 0; i < 2; ++i)
#pragma unroll
        for (int dt = 0; dt < 3; ++dt) st[i][dt] = (f32x4){0.f, 0.f, 0.f, 0.f};
    float m_prev = 0.f;
    const float ibv = ibp[h], fbv = fbp[h];
    u32x4 qreg[4], kreg[4], vreg; float gi = 0.f, gf = 0.f;
#define ML_LOAD(c) do { const int rc_ = rowb + (c) * 64; _Pragma("unroll") for (int k_ = 0; k_ < 4; ++k_) { const int it_ = tid + 512 * k_, s_ = it_ >> 5, ch_ = it_ & 31; \
        qreg[k_] = *(const gu32x4*)(CQ + (size_t)(rc_ + s_) * 1024 + 8 * ch_); kreg[k_] = *(const gu32x4*)(CK + (size_t)(rc_ + s_) * 1024 + 8 * ch_); } \
        if (tid < 256) vreg = *(const gu32x4*)(CV + (size_t)(rc_ + (tid >> 2)) * BW + 8 * (tid & 3)); } while (0)
#define ML_GLOAD(c) do { if (w == 7) { const int r_ = rowb + (c) * 64 + lane; gi = IFB[(size_t)r_ * 8 + h]; gf = IFB[(size_t)r_ * 8 + 4 + h]; } } while (0)
#define ML_GPREP(par) do { if (w == 7) { const float ig_ = softcap15(gi + ibv); const float z_ = softcap15(gf + fbv); \
        const float lf_ = -(fmaxf(-z_, 0.f) + log1pf(__expf(-fabsf(z_)))); const float bc_ = wave_scan_add(lf_, lane); const float u_ = ig_ - bc_; const float pm_ = wave_scan_max(u_, lane); \
        const float Mv_ = fmaxf(m_prev, pm_); const float M63_ = __shfl(Mv_, 63); const float g_ = __shfl(bc_, 63); \
        LAS float* gp_ = (LAS float*)(F.lds + ML_GATE + (par) * ML_GSZ); gp_[lane] = u_; gp_[64 + lane] = Mv_; gp_[128 + lane] = __expf(m_prev - Mv_); gp_[192 + lane] = __expf(-(bc_ + Mv_)); \
        gp_[256 + lane] = __expf(u_ - M63_); if (lane == 0) gp_[320] = __expf(m_prev - M63_); m_prev = g_ + M63_; } } while (0)
#define ML_WRITE() do { _Pragma("unroll") for (int k_ = 0; k_ < 4; ++k_) { const int it_ = tid + 512 * k_, s_ = it_ >> 5, ch_ = it_ & 31; \
        *(LAS u32x4*)(F.lds + ML_QL + s_ * ML_RS + ch_ * 16) = qreg[k_]; *(LAS u32x4*)(F.lds + ML_KL + s_ * ML_RS + ch_ * 16) = kreg[k_]; } \
        if (tid < 256) { const int s_ = tid >> 2, ch_ = tid & 3; const unsigned e_[4] = {vreg.x, vreg.y, vreg.z, vreg.w}; \
            _Pragma("unroll") for (int i_ = 0; i_ < 8; ++i_) *(LAS bf16_t*)(F.lds + ML_VT + (8 * ch_ + i_) * ML_TS + 2 * s_) = (bf16_t)((e_[i_ >> 1] >> ((i_ & 1) * 16)) & 0xffffu); } } while (0)
    ML_LOAD(0); ML_GLOAD(0);
    ML_GPREP(0);
    ML_GLOAD(1);
    ML_WRITE();
    __syncthreads();
    for (int c = 0; c < 32; ++c) {
        const int par = c & 1; const LAS float* gp = (const LAS float*)(F.lds + ML_GATE + par * ML_GSZ);
        const int rowc = rowb + c * 64;
        if (c + 1 < 32) { ML_LOAD(c + 1); ML_GPREP(par ^ 1); if (c + 2 < 32) ML_GLOAD(c + 2); }
#pragma unroll
        for (int k = 0; k < 4; ++k) { const int item = tid + 512 * k, dk = item & 255, so = item >> 8;
            const f32x4 w0 = *(const LAS f32x4*)(gp + 256 + 8 * so), w1 = *(const LAS f32x4*)(gp + 256 + 8 * so + 4); const float wv[8] = {w0[0], w0[1], w0[2], w0[3], w1[0], w1[1], w1[2], w1[3]};
            float kv[8];
#pragma unroll
            for (int j = 0; j < 8; ++j) kv[j] = bf1(*(const LAS bf16_t*)(F.lds + ML_KL + (8 * so + j) * ML_RS + 2 * dk)) * wv[j];
            *(LAS u32x4*)(F.lds + ML_KWT + dk * ML_TS + so * 16) = (u32x4){cvt_pk_bf16(kv[0], kv[1]), cvt_pk_bf16(kv[2], kv[3]), cvt_pk_bf16(kv[4], kv[5]), cvt_pk_bf16(kv[6], kv[7])}; }
        f32x4 oacc[3];
#pragma unroll
        for (int dt = 0; dt < 3; ++dt) oacc[dt] = (f32x4){0.f, 0.f, 0.f, 0.f};
        if (w < 4) {
            const int T = w;
            bf16x8 bq[8];
#pragma unroll
            for (int ks = 0; ks < 8; ++ks) bq[ks] = *(const LAS bf16x8*)(F.lds + ML_QL + (16 * T + r16) * ML_RS + ks * 64 + q4 * 16);
            f32x4 sa[4];
#pragma unroll
            for (int s4 = 0; s4 < 4; ++s4) { sa[s4] = (f32x4){0.f, 0.f, 0.f, 0.f};
                if (s4 <= T) {
#pragma unroll
                    for (int ks = 0; ks < 8; ++ks) { const bf16x8 a = *(const LAS bf16x8*)(F.lds + ML_KL + (16 * s4 + r16) * ML_RS + ks * 64 + q4 * 16); sa[s4] = MFMA16(a, bq[ks], sa[s4]); } } }
            const int tl = 16 * T + r16; const float Mt = gp[64 + tl];
#pragma unroll
            for (int s4 = 0; s4 < 4; ++s4) { const f32x4 uu = *(const LAS f32x4*)(gp + 16 * s4 + 4 * q4);
#pragma unroll
                for (int e = 0; e < 4; ++e) { const int sl_ = 16 * s4 + 4 * q4 + e; sa[s4][e] = (sl_ <= tl) ? sa[s4][e] * __expf(uu[e] - Mt) : 0.f; } }
#pragma unroll
            for (int kk = 0; kk < 2; ++kk) { const bf16x8 pf = mk_frag(pack4(sa[2 * kk]), pack4(sa[2 * kk + 1]));
#pragma unroll
                for (int dt = 0; dt < 3; ++dt) { bf16x8 a;
                    if (dt < 2) { const LAS unsigned char* vp = F.lds + ML_VT + (16 * dt + r16) * ML_TS + (32 * kk + 4 * q4) * 2; a = mk_frag(*(const LAS u32x2*)vp, *(const LAS u32x2*)(vp + 32)); }
                    else a = (r16 == 0) ? ones : zeros;
                    oacc[dt] = MFMA16(a, pf, oacc[dt]); } }
        } else {
            const int T = w - 4; f32x4 ia[3];
#pragma unroll
            for (int dt = 0; dt < 3; ++dt) ia[dt] = (f32x4){0.f, 0.f, 0.f, 0.f};
#pragma unroll
            for (int ks = 0; ks < 8; ++ks) { const bf16x8 bqv = *(const LAS bf16x8*)(F.lds + ML_QL + (16 * T + r16) * ML_RS + ks * 64 + q4 * 16);
#pragma unroll
                for (int dt = 0; dt < 3; ++dt) { bf16x8 a;
                    if (dt < 2) a = *(const LAS bf16x8*)(F.lds + ML_CT + (16 * dt + r16) * ML_RS + ks * 64 + q4 * 16);
                    else { a = *(const LAS bf16x8*)(F.lds + ML_CT + 32 * ML_RS + ks * 64 + q4 * 16); if (r16 != 0) a = zeros; }
                    ia[dt] = MFMA16(a, bqv, ia[dt]); } }
            const int tl = 16 * T + r16;
            *(LAS f32x4*)(F.lds + ML_X + tl * 144 + (4 * q4) * 4) = ia[0]; *(LAS f32x4*)(F.lds + ML_X + tl * 144 + (16 + 4 * q4) * 4) = ia[1];
            if (q4 == 0) *(LAS f32x4*)(F.lds + ML_X + tl * 144 + 32 * 4) = ia[2];
        }
        __syncthreads();
        if (w < 4) {
            const int tl = 16 * w + r16; const float at = gp[128 + tl], en = gp[192 + tl];
            const f32x4 x0 = *(const LAS f32x4*)(F.lds + ML_X + tl * 144 + (4 * q4) * 4), x1 = *(const LAS f32x4*)(F.lds + ML_X + tl * 144 + (16 + 4 * q4) * 4);
            const float xd = *(const LAS float*)(F.lds + ML_X + tl * 144 + 32 * 4);
            const f32x4 n0 = oacc[0] + x0 * at, n1 = oacc[1] + x1 * at;
            float den = oacc[2][0] + xd * at; den = __shfl(den, r16);
            float sq = (n0[0] * n0[0] + n0[1] * n0[1]) + (n0[2] * n0[2] + n0[3] * n0[3]) + (n1[0] * n1[0] + n1[1] * n1[1]) + (n1[2] * n1[2] + n1[3] * n1[3]);
            sq += __shfl_xor(sq, 16); sq += __shfl_xor(sq, 32);
            const size_t ro = (size_t)(rowc + tl) * BW + 4 * q4;
            *(gu32x2*)(NUM + ro) = pack4(n0); *(gu32x2*)(NUM + ro + 16) = pack4(n1);
            if (q4 == 0) { SSQC[(size_t)(rowc + tl) * 64 + h * 16 + sl] = sq; if (sl == 0) DNB[(size_t)(rowc + tl) * 4 + h] = fmaxf(fabsf(den), en); }
        }
        { const float dec = gp[320];
#pragma unroll
          for (int i = 0; i < 2; ++i)
#pragma unroll
              for (int dt = 0; dt < 3; ++dt) st[i][dt] = st[i][dt] * dec;
#pragma unroll
          for (int kk = 0; kk < 2; ++kk) { bf16x8 a[2], bv[3];
#pragma unroll
              for (int i = 0; i < 2; ++i) a[i] = *(const LAS bf16x8*)(F.lds + ML_KWT + (32 * w + 16 * i + r16) * ML_TS + kk * 64 + q4 * 16);
#pragma unroll
              for (int dt = 0; dt < 2; ++dt) bv[dt] = *(const LAS bf16x8*)(F.lds + ML_VT + (16 * dt + r16) * ML_TS + kk * 64 + q4 * 16);
              bv[2] = (r16 == 0) ? ones : zeros;
#pragma unroll
              for (int i = 0; i < 2; ++i)
#pragma unroll
                  for (int dt = 0; dt < 3; ++dt) st[i][dt] = MFMA16(a[i], bv[dt], st[i][dt]); }
#pragma unroll
          for (int i = 0; i < 2; ++i) {
#pragma unroll
              for (int dt = 0; dt < 2; ++dt) *(LAS u32x2*)(F.lds + ML_CT + (16 * dt + r16) * ML_RS + (32 * w + 16 * i + 4 * q4) * 2) = pack4(st[i][dt]);
              if (r16 == 0) *(LAS u32x2*)(F.lds + ML_CT + 32 * ML_RS + (32 * w + 16 * i + 4 * q4) * 2) = pack4(st[i][2]); } }
        __syncthreads();
        if (c + 1 < 32) ML_WRITE();
        __syncthreads();
    }
#undef ML_LOAD
#undef ML_GLOAD
#undef ML_GPREP
#undef ML_WRITE
}

__device__ __forceinline__ void p2b_finalize(const Ctx& F, guchar* ws, const gfloat* norm_g) {
    int lane = F.lane; LAUNDER_V(lane); const int gw = F.vcu * NWAVES + F.wave, NGW = F.G * NWAVES;
    const gbf16* NUM = (const gbf16*)(ws + WS_NUM); const gbf16* CO = (const gbf16*)(ws + WS_CO); const gbf16* CZ = (const gbf16*)(ws + WS_CZ);
    gbf16* YC = (gbf16*)(ws + WS_YA) + (size_t)2 * M_ROWS * BW;
    for (int m = gw; m < M_ROWS; m += NGW) {
        float s = ((const gfloat*)(ws + WS_SSQC))[(size_t)m * 64 + lane];
        s += __shfl_xor(s, 1); s += __shfl_xor(s, 2); s += __shfl_xor(s, 4); s += __shfl_xor(s, 8);
        const float dn = ((const gfloat*)(ws + WS_DN))[(size_t)m * 4 + (lane >> 4)];
        const float inv = 1.0f / dn; const float sc = inv * rsqrtf(s * (1.0f / 512.0f) * inv * inv + NORM_EPS);
#pragma unroll
        for (int it = 0; it < 4; ++it) { const float f = __shfl(sc, 16 * it); const size_t o = (size_t)m * BW + (size_t)(it * 64 + lane) * 8;
            const u32x4 nb = *(const gu32x4*)(NUM + o), ob = *(const gu32x4*)(CO + o), zb = *(const gu32x4*)(CZ + o);
            const f32x4 g0 = *(const gf32x4*)(norm_g + (it * 64 + lane) * 8), g1 = *(const gf32x4*)(norm_g + (it * 64 + lane) * 8 + 4);
            u32x4 y;
            y.x = cvt_pk_bf16(bf_lo(nb.x) * f * g0[0] * bf_lo(ob.x) * bf_lo(zb.x), bf_hi(nb.x) * f * g0[1] * bf_hi(ob.x) * bf_hi(zb.x));
            y.y = cvt_pk_bf16(bf_lo(nb.y) * f * g0[2] * bf_lo(ob.y) * bf_lo(zb.y), bf_hi(nb.y) * f * g0[3] * bf_hi(ob.y) * bf_hi(zb.y));
            y.z = cvt_pk_bf16(bf_lo(nb.z) * f * g1[0] * bf_lo(ob.z) * bf_lo(zb.z), bf_hi(nb.z) * f * g1[1] * bf_hi(ob.z) * bf_hi(zb.z));
            y.w = cvt_pk_bf16(bf_lo(nb.w) * f * g1[2] * bf_lo(ob.w) * bf_lo(zb.w), bf_hi(nb.w) * f * g1[3] * bf_hi(ob.w) * bf_hi(zb.w));
            *(gu32x4*)(YC + o) = y; }
    }
}
__device__ __forceinline__ void p4b_x1(const Ctx& F, guchar* ws, const gfloat* xin, const gfloat* npost) {
    int lane = F.lane; LAUNDER_V(lane); const int gw = F.vcu * NWAVES + F.wave, NGW = F.G * NWAVES;
    const gbf16* OUT = (const gbf16*)(ws + WS_OUT); gbf16* X1B = (gbf16*)(ws + WS_X1B);
    for (int m = gw; m < M_ROWS; m += NGW) {
        const float so = wave_sum(((const gfloat*)(ws + WS_OUTP))[(size_t)m * 64 + lane]), se = wave_sum(((const gfloat*)(ws + WS_ERP))[(size_t)m * 64 + lane]);
        const float rso = rsqrtf(so * (1.0f / DM) + NORM_EPS), rse = rsqrtf(se * (1.0f / DM) + NORM_EPS);
        if (lane == 0) { ((gfloat*)(ws + WS_RSO))[m] = rso; ((gfloat*)(ws + WS_RSE))[m] = rse; }
#pragma unroll
        for (int it = 0; it < 8; ++it) { const int c = (it * 64 + lane) * 8; const size_t o = (size_t)m * DM + c;
            const f32x4 x0 = *(const gf32x4*)(xin + o), x1 = *(const gf32x4*)(xin + o + 4), n0 = *(const gf32x4*)(npost + c), n1 = *(const gf32x4*)(npost + c + 4);
            const u32x4 ob = *(const gu32x4*)(OUT + o); u32x4 y;
            y.x = cvt_pk_bf16(x0[0] + bf_lo(ob.x) * rso * n0[0], x0[1] + bf_hi(ob.x) * rso * n0[1]);
            y.y = cvt_pk_bf16(x0[2] + bf_lo(ob.y) * rso * n0[2], x0[3] + bf_hi(ob.y) * rso * n0[3]);
            y.z = cvt_pk_bf16(x1[0] + bf_lo(ob.z) * rso * n1[0], x1[1] + bf_hi(ob.z) * rso * n1[1]);
            y.w = cvt_pk_bf16(x1[2] + bf_lo(ob.w) * rso * n1[2], x1[3] + bf_hi(ob.w) * rso * n1[3]);
            *(gu32x4*)(X1B + o) = y; }
    }
}

#ifndef REP_P0
#define REP_P0 1
#endif
#ifndef REP_P1
#define REP_P1 1
#endif
#ifndef REP_ML
#define REP_ML 1
#endif
#ifndef REP_SW
#define REP_SW 1
#endif
#ifndef REP_GM
#define REP_GM 1
#endif
#ifndef REP_P3
#define REP_P3 1
#endif
#ifndef REP_THIN
#define REP_THIN 1
#endif
#ifndef REP_BAR
#define REP_BAR 1
#endif
#ifndef REP_P4
#define REP_P4 1
#endif
__device__ __forceinline__ unsigned long long arg_ld(LAS unsigned char* lds, int i) {
    unsigned a = (unsigned)(ARGS_OFF + 8 * i); asm volatile("" : "+v"(a));
    const volatile LAS unsigned* q = (const volatile LAS unsigned*)(lds + a);
    const unsigned lo = q[0], hi = q[1];
    return ((unsigned long long)(unsigned)__builtin_amdgcn_readfirstlane((int)hi) << 32) | (unsigned)__builtin_amdgcn_readfirstlane((int)lo);
}
struct Args { const void* in[19]; float* out; unsigned char* ws; };
static_assert(sizeof(Args) == 21 * 8, "no padding in Args");

__global__ void __launch_bounds__(NTHREADS, 2) fwd_kernel(Args args) {
    extern __shared__ __attribute__((aligned(16))) unsigned char lds_raw[];
    Ctx F; F.lds = (LAS unsigned char*)lds_raw; F.tid = threadIdx.x; F.lane = F.tid & 63; F.wave = __builtin_amdgcn_readfirstlane(F.tid >> 6);
    F.G = gridDim.x; F.bx = blockIdx.x; { const int bx = blockIdx.x; F.vcu = (F.G % 8 == 0) ? (bx % 8) * (F.G / 8) + bx / 8 : bx; }
    guchar* ws0 = (guchar*)args.ws;
#define WSL() ({ guchar* w_ = ws0; LAUNDER_S(w_); w_; })
    volatile LAS unsigned* MISC = (volatile LAS unsigned*)(F.lds + MISC_OFF);
    if (F.tid < 32) MISC[F.tid] = 0u;
    __syncthreads();
    const XcdBarrier bar = xcd_barrier_post((unsigned*)(ws0 + WS_CTL) + CW_BAR, MISC);

    if (F.tid < 19) ((LAS unsigned long long*)(F.lds + ARGS_OFF))[F.tid] = (unsigned long long)args.in[F.tid];
    if (F.tid == 19) ((LAS unsigned long long*)(F.lds + ARGS_OFF))[19] = (unsigned long long)args.out;
    __syncthreads();
#define ARGP(T, i) ((T)arg_ld(F.lds, (i)))

#define FL() ({ Ctx f_ = F; LAUNDER_S(f_.lds); LAUNDER_S(f_.wave); LAUNDER_S(f_.vcu); LAUNDER_S(f_.G); LAUNDER_S(f_.bx); f_; })
#ifndef SKIP_P0
    for (int rep_ = 0; rep_ < REP_P0; ++rep_) { const Ctx Fp = FL(); guchar* ws = WSL(); p0_prologue(FL(), ARGP(const gfloat*, 0), ARGP(const gfloat*, 1), ARGP(const gint*, 2), ARGP(const gfloat*, 3), ARGP(const gfloat*, 4), ARGP(const gfloat*, 13), ARGP(const gfloat*, 14), ARGP(const gfloat*, 18), ARGP(const gfloat*, 16), ws); }
#endif
    for (int rb_ = 0; rb_ < REP_BAR; ++rb_) xcd_barrier(bar);

    for (int l = 0; l < NLAYER; ++l) {
        const gfloat* xin = l == 0 ? ARGP(const gfloat*, 0) : (const gfloat*)ARGP(gfloat*, 19);
#ifndef SKIP_P1
        for (int rep_ = 0; rep_ < REP_P1; ++rep_) { const Ctx Fp = FL(); guchar* ws = WSL(); const gfloat* ssq = l == 0 ? (const gfloat*)(ws + WS_SSQ0) : (const gfloat*)(ws + WS_CTL + CTL_SSQ1); pg8::SchedPlain S; S.T.init(M_ROWS / 256, NT_IN, Fp.G, Fp.bx); S.A = (const gchar*)(ws + WS_XB); S.B = (const gchar*)(ws + WS_WIN + (size_t)l * SZ_WIN);
          S.astep = (size_t)256 * DM * 2; S.bstep = (size_t)256 * DM * 2;
          pg8::EpiIn E{ssq, ws};
          pg8::gemm_phase<pg8::EpiIn, pg8::SchedPlain>(FL().lds, DM, DM, DM, S, E); }
#ifdef PROBE_P1CHEAP
        { const Ctx Fp = FL(); guchar* ws = WSL(); pg8::SchedPlain S; S.T.init(M_ROWS / 256, NT_IN, Fp.G, Fp.bx); S.A = (const gchar*)(ws + WS_XB); S.B = (const gchar*)(ws + WS_WIN + (size_t)l * SZ_WIN);
          S.astep = (size_t)256 * DM * 2; S.bstep = (size_t)256 * DM * 2;
          pg8::EpiSq E{(gbf16*)(ws + WS_END), (gfloat*)(ws + WS_END + (size_t)M_ROWS * 31488 * 2)};
          pg8::gemm_phase<pg8::EpiSq, pg8::SchedPlain>(FL().lds, DM, DM, DM, S, E); }
#endif
        { const Ctx Fq = FL(); const int nwg_ = (M_ROWS / 256) * NT_IN, rem_ = nwg_ % Fq.G;
          if (rem_ == 0 || Fq.bx >= rem_) { const int me = rem_ ? Fq.bx - rem_ : Fq.bx, nw = rem_ ? Fq.G - rem_ : Fq.G;
            { const Ctx Fp = FL(); guchar* ws = WSL(); pg8::SchedPlain S; S.T.init(M_ROWS / 256, DM / 256, nw, me); S.A = (const gchar*)(ws + WS_PB + (size_t)l * M_ROWS * 256 * 2); S.B = (const gchar*)(ws + WS_WPP + (size_t)l * SZ_WPP);
              S.astep = (size_t)256 * 256 * 2; S.bstep = (size_t)256 * 256 * 2;
              pg8::EpiSq E{(gbf16*)(ws + WS_ERAW), (gfloat*)(ws + WS_ERP)};
              pg8::gemm_phase<pg8::EpiSq, pg8::SchedPlain>(FL().lds, 256, 256, 256, S, E); }
            if (l == 0) tr_run(FL(), TR_DEFER0, TR_DEFER1, 0x7fffffff, 0x7fffffff, me, nw, ARGP(const gfloat*, 4), ARGP(const gfloat*, 3), ARGP(const gfloat*, 13), ARGP(const gfloat*, 14), ARGP(const gfloat*, 18), ARGP(const gfloat*, 16), WSL()); } }
#endif
        for (int rb_ = 0; rb_ < REP_BAR; ++rb_) xcd_barrier(bar);
#ifndef SKIP_ML
        for (int rep_ = 0; rep_ < REP_ML; ++rep_) { const Ctx Fp = FL(); guchar* ws = WSL(); for (int u = Fp.vcu; u < 256; u += Fp.G) mlstm_unit(Fp, u >> 6, (u >> 4) & 3, u & 15, ws, ARGP(const gfloat*, 10) + l * 4, ARGP(const gfloat*, 11) + l * 4); }
#endif
#ifndef SKIP_SW
        for (int rep_ = 0; rep_ < REP_SW; ++rep_) { const Ctx Fp = FL(); guchar* ws = WSL(); for (int u = Fp.vcu; u < 256; u += Fp.G) swa_unit(Fp, u >> 6, (u >> 2) & 15, u & 3, ws, ARGP(const gfloat*, 9) + l * 32); }
#endif
#ifndef SKIP_GM
        for (int rep_ = 0; rep_ < REP_GM; ++rep_) { const Ctx Fp = FL(); guchar* ws = WSL(); for (int u = Fp.vcu; u < 512; u += Fp.G) gmlp_unit(Fp, u >> 7, (u >> 3) & 15, u & 7, ws, ARGP(const gfloat*, 5) + l * BW, ARGP(const gfloat*, 6) + l * BW, ARGP(const gfloat*, 7) + (size_t)l * 8 * 128 * 128, ARGP(const gfloat*, 8) + l * 8 * 128); }
#endif
        for (int rb_ = 0; rb_ < REP_BAR; ++rb_) xcd_barrier(bar);
#ifndef SKIP_P2B
        for (int rep_ = 0; rep_ < REP_THIN; ++rep_) p2b_finalize(FL(), WSL(), ARGP(const gfloat*, 12) + l * BW);
#endif
        for (int rb_ = 0; rb_ < REP_BAR; ++rb_) xcd_barrier(bar);
#ifndef PROBE_NOSTORE
#define PROBE_NOSTORE 0
#endif
#ifdef PROBE_K1024
        for (int rep_ = 0; rep_ < 4; ++rep_) { const Ctx Fp = FL(); guchar* ws = WSL(); pg8::SchedPlain S; S.T.init(M_ROWS / 256, DM / 256, Fp.G, Fp.bx); S.A = (const gchar*)(ws + WS_YA); S.B = (const gchar*)(ws + WS_WOUT + (size_t)l * SZ_WSQ);
          S.astep = (size_t)256 * DM * 2; S.bstep = (size_t)256 * DM * 2;
          pg8::EpiSq E{PROBE_NOSTORE ? (gbf16*)nullptr : (gbf16*)(ws + WS_END), (gfloat*)(ws + WS_END + (size_t)M_ROWS * 31488 * 2)};
          pg8::gemm_phase<pg8::EpiSq, pg8::SchedPlain>(FL().lds, 1024, DM, DM, S, E); }
#endif
#ifdef PROBE_P3CHEAP
        { const Ctx Fp = FL(); guchar* ws = WSL(); pg8::SchedBranch S; S.T.init(M_ROWS / 256, DM / 256, Fp.G, Fp.bx); S.A = (const gchar*)(ws + WS_YA); S.B = (const gchar*)(ws + WS_WBR + (size_t)l * SZ_WBR);
          S.astep = (size_t)256 * BW * 2; S.bstep = (size_t)256 * BW * 2; S.aseg = SZ_ROWS_BW; S.bseg = (size_t)DM * BW * 2;
          pg8::EpiSq E{(gbf16*)(ws + WS_END), (gfloat*)(ws + WS_END + (size_t)M_ROWS * 31488 * 2)};
          pg8::gemm_phase<pg8::EpiSq, pg8::SchedBranch>(FL().lds, BW, BW, BW, S, E); }
#endif
#ifndef SKIP_P3
        for (int rep_ = 0; rep_ < REP_P3; ++rep_) { const Ctx Fp = FL(); guchar* ws = WSL(); pg8::SchedBranch S; S.T.init(M_ROWS / 256, DM / 256, Fp.G, Fp.bx); S.A = (const gchar*)(ws + WS_YA); S.B = (const gchar*)(ws + WS_WBR + (size_t)l * SZ_WBR);
          S.astep = (size_t)256 * BW * 2; S.bstep = (size_t)256 * BW * 2; S.aseg = SZ_ROWS_BW; S.bseg = (size_t)DM * BW * 2;
          pg8::EpiBranch E{(const gbf16*)(ws + WS_G), (gbf16*)(ws + WS_MIX)};
          pg8::gemm_phase<pg8::EpiBranch, pg8::SchedBranch>(FL().lds, BW, BW, BW, S, E); }
#endif
        for (int rb_ = 0; rb_ < REP_BAR; ++rb_) xcd_barrier(bar);
#ifndef SKIP_P4
        for (int rep_ = 0; rep_ < REP_P4; ++rep_) { const Ctx Fp = FL(); guchar* ws = WSL(); pg8::SchedPlain S; S.T.init(M_ROWS / 256, DM / 256, Fp.G, Fp.bx); S.A = (const gchar*)(ws + WS_MIX); S.B = (const gchar*)(ws + WS_WOUT + (size_t)l * SZ_WSQ);
          S.astep = (size_t)256 * DM * 2; S.bstep = (size_t)256 * DM * 2;
          pg8::EpiSq E{(gbf16*)(ws + WS_OUT), (gfloat*)(ws + WS_OUTP)};
          pg8::gemm_phase<pg8::EpiSq, pg8::SchedPlain>(FL().lds, DM, DM, DM, S, E); }
#endif
        for (int rb_ = 0; rb_ < REP_BAR; ++rb_) xcd_barrier(bar);
#ifndef SKIP_P4B
        for (int rep_ = 0; rep_ < REP_THIN; ++rep_) p4b_x1(FL(), WSL(), xin, ARGP(const gfloat*, 15) + l * DM);
#endif
        for (int rb_ = 0; rb_ < REP_BAR; ++rb_) xcd_barrier(bar);
#ifndef SKIP_P5
        { const Ctx Fp = FL(); guchar* ws = WSL(); pg8::SchedPlain S; S.T.init(M_ROWS / 256, DM / 256, Fp.G, Fp.bx); S.A = (const gchar*)(ws + WS_X1B); S.B = (const gchar*)(ws + WS_WPG + (size_t)l * SZ_WSQ);
          S.astep = (size_t)256 * DM * 2; S.bstep = (size_t)256 * DM * 2;
          pg8::EpiPle E{xin, ARGP(gfloat*, 19), (gbf16*)(ws + WS_XB), (const gbf16*)(ws + WS_OUT), (const gbf16*)(ws + WS_ERAW), (const gfloat*)(ws + WS_RSO), (const gfloat*)(ws + WS_RSE),
                        ARGP(const gfloat*, 15) + l * DM, ARGP(const gfloat*, 17) + l * DM, (gfloat*)(ws + WS_CTL + CTL_SSQ1), l == NLAYER - 1 ? 1 : 0};
          pg8::gemm_phase<pg8::EpiPle, pg8::SchedPlain>(FL().lds, DM, DM, DM, S, E); }
#endif
        if (l + 1 < NLAYER) for (int rb_ = 0; rb_ < REP_BAR; ++rb_) xcd_barrier(bar);
    }
}

extern "C" void kernel_launch(void* const* d_in, const int* in_sizes, int n_in, void* d_out, int out_size, void* d_ws, size_t ws_size, hipStream_t stream) {
    static int grid = 0;
    if (grid == 0) {
        if (n_in != 19 || out_size != M_ROWS * DM || ws_size < WS_END) { fprintf(stderr, "kernel_launch: unexpected problem (n_in %d, out %d, ws %zu, need %zu)\n", n_in, out_size, ws_size, (size_t)WS_END); grid = -1; return; }
        int dev = 0, cus = 0;
        if (hipGetDevice(&dev) != hipSuccess || hipDeviceGetAttribute(&cus, hipDeviceAttributeMultiprocessorCount, dev) != hipSuccess) { grid = -1; return; }
        if (hipFuncSetAttribute((const void*)fwd_kernel, hipFuncAttributeMaxDynamicSharedMemorySize, LDS_BYTES) != hipSuccess) { fprintf(stderr, "kernel_launch: hipFuncSetAttribute failed\n"); grid = -1; return; }
        int per_cu = 0; (void)hipOccupancyMaxActiveBlocksPerMultiprocessor(&per_cu, (const void*)fwd_kernel, NTHREADS, LDS_BYTES); (void)hipGetLastError();
        if (per_cu < 1) fprintf(stderr, "kernel_launch: occupancy query reports %d blocks per CU\n", per_cu);
        grid = cus > 256 ? 256 : cus;
    }
    if (grid < 0) return;
    (void)hipMemsetAsync((char*)d_ws + WS_CTL, 0, CTL_ZERO_BYTES, stream);
    Args a{};
    for (int i = 0; i < 19; ++i) a.in[i] = d_in[i];
    a.out = (float*)d_out; a.ws = (unsigned char*)d_ws;
    hipLaunchKernelGGL(fwd_kernel, dim3(grid), dim3(NTHREADS), LDS_BYTES, stream, a);
    const hipError_t le = hipPeekAtLastError();
    if (le != hipSuccess) fprintf(stderr, "kernel_launch: launch failed: %s\n", hipGetErrorName(le));
}
```

```cpp
#include <hip/hip_runtime.h>
#include <cstdio>
#include <cstdint>

#define LAS __attribute__((address_space(3)))
#define GAS __attribute__((address_space(1)))
typedef unsigned short bf16_t;
typedef short bf16x8 __attribute__((ext_vector_type(8)));
typedef float f32x4 __attribute__((ext_vector_type(4)));
typedef float f32x2 __attribute__((ext_vector_type(2)));
typedef unsigned u32x4 __attribute__((ext_vector_type(4)));
typedef unsigned u32x2 __attribute__((ext_vector_type(2)));

typedef GAS float gfloat; typedef GAS bf16_t gbf16; typedef GAS int gint; typedef GAS char gchar; typedef GAS unsigned char guchar; typedef GAS unsigned gunsigned;
typedef GAS f32x4 gf32x4; typedef GAS f32x2 gf32x2; typedef GAS u32x4 gu32x4; typedef GAS u32x2 gu32x2;
constexpr int M_ROWS = 8192, SEQ = 2048, DM = 4096, BW = 2048, NLAYER = 2;
constexpr int N_IN = 31240, IF_COL = 14848;
constexpr int NT_IN = 123;
constexpr int N_IN_T = NT_IN * 256;
constexpr float NORM_EPS = 1e-6f;

__device__ __forceinline__ unsigned cvt_pk_bf16(float lo, float hi) { unsigned r; asm("v_cvt_pk_bf16_f32 %0, %1, %2" : "=v"(r) : "v"(lo), "v"(hi)); return r; }
__device__ __forceinline__ float bf_lo(unsigned w) { return __uint_as_float(w << 16); }
__device__ __forceinline__ float bf_hi(unsigned w) { return __uint_as_float(w & 0xffff0000u); }
__device__ __forceinline__ float bf1(bf16_t b) { return __uint_as_float(((unsigned)b) << 16); }
__device__ __forceinline__ float fsigmoid(float x) { return __builtin_amdgcn_rcpf(1.0f + __expf(-x)); }
__device__ __forceinline__ float wave_sum(float v) {
#pragma unroll
    for (int o = 1; o < 64; o <<= 1) v += __shfl_xor(v, o);
    return v;
}
__device__ __forceinline__ f32x2 gelu_pk(f32x2 v) {
    const f32x2 av = __builtin_elementwise_abs(v), d = av * 0.2316418882f + 1.0f;
    f32x2 t; t.x = __builtin_amdgcn_rcpf(d.x); t.y = __builtin_amdgcn_rcpf(d.y);
    f32x2 q = t * 0.5307027145f + (-0.7265760135f); q = q * t + 0.7107068705f; q = q * t + (-0.142248368f); q = q * t + 0.127414796f; q = q * t;
    const f32x2 s = (v * v) * (-0.72134752044f);
    f32x2 e; e.x = __builtin_amdgcn_exp2f(s.x); e.y = __builtin_amdgcn_exp2f(s.y);
    const f32x2 m = v * (q * e), r = v - m;
    f32x2 o; o.x = v.x < 0.f ? m.x : r.x; o.y = v.y < 0.f ? m.y : r.y; return o;
}
#define LAUNDER_V(x) asm volatile("" : "+v"(x))
#define LAUNDER_S(x) asm volatile("" : "+s"(x))
#define LDS_WAIT() asm volatile("s_waitcnt lgkmcnt(0)" ::: "memory")
#define VM_WAIT() asm volatile("s_waitcnt vmcnt(0)" ::: "memory")
#define MFMA16(a, b, c) __builtin_amdgcn_mfma_f32_16x16x32_bf16((a), (b), (c), 0, 0, 0)

#define XB_TMO      128
#define XB_XCNT(j)  (256  + 64 * (j))
#define XB_XSUB(j)  (1280 + 64 * (j))
#define XB_XGEN(j)  (2304 + 64 * (j))
#define XB_TOP      3328
#define XB_TOPGEN   3392
#define XCD_BAR_WORDS 3456
#define XB_SPIN_CAP (1u << 18)
__device__ __forceinline__ unsigned xb_ld(unsigned* p)              { return __hip_atomic_load(p, __ATOMIC_RELAXED, __HIP_MEMORY_SCOPE_AGENT); }
__device__ __forceinline__ unsigned xb_add(unsigned* p, unsigned v) { return __hip_atomic_fetch_add(p, v, __ATOMIC_RELAXED, __HIP_MEMORY_SCOPE_AGENT); }
__device__ __forceinline__ unsigned xb_xcc_id() { return (unsigned)__builtin_amdgcn_s_getreg((3 << 11) | 20) & 0xFu; }
#define XB_SPIN(cond, bar) do { unsigned _sp = 0; while (cond) { __builtin_amdgcn_s_sleep(1); \
    if ((++_sp & 255u) == 0u) { if (xb_ld(&(bar)[XB_TMO])) break; if (_sp > XB_SPIN_CAP) { atomicAdd(&(bar)[XB_TMO], 1u); break; } } } } while (0)
struct XcdBarrier { unsigned* bar; unsigned x; volatile LAS unsigned* st; };
__device__ __forceinline__ XcdBarrier xcd_barrier_post(unsigned* bar, volatile LAS unsigned* st) {
    XcdBarrier b; b.bar = bar; b.x = xb_xcc_id(); b.st = st;
    if (threadIdx.x == 0) (void)xb_add(&bar[XB_XCNT(b.x)], 1u);
    return b;
}
__device__ __forceinline__ void xcd_barrier_complete(unsigned* bar, unsigned x, unsigned& nloc, unsigned& nx) {
    const unsigned G = gridDim.x * gridDim.y * gridDim.z;
    unsigned sum, cnt, mine, sp = 0u;
    for (;;) {
        sum = 0u; cnt = 0u; mine = 0u;
#pragma unroll
        for (unsigned j = 0; j < 16; ++j) { const unsigned c = xb_ld(&bar[XB_XCNT(j)]); sum += c; cnt += (c > 0u) ? 1u : 0u; mine = (j == x) ? c : mine; }
        if (sum == G) break;
        __builtin_amdgcn_s_sleep(1);
        if ((++sp & 255u) == 0u) { if (xb_ld(&bar[XB_TMO])) break; if (sp > XB_SPIN_CAP) { atomicAdd(&bar[XB_TMO], 1u); break; } }
    }
    nloc = mine > 0u ? mine : 1u; nx = cnt > 0u ? cnt : 1u;
}
__device__ __forceinline__ void xcd_barrier(const XcdBarrier& b) {
    asm volatile("s_waitcnt vmcnt(0)" ::: "memory");
    __syncthreads();
    if (threadIdx.x == 0) {
        unsigned* bar = b.bar;
        __builtin_amdgcn_s_waitcnt(0);
        unsigned nloc = b.st[0], nx = b.st[1];
        if (nloc == 0u) { xcd_barrier_complete(bar, b.x, nloc, nx); b.st[0] = nloc; b.st[1] = nx; }
        const unsigned old = xb_add(&bar[XB_XSUB(b.x)], 1u);
        const unsigned gen = old / nloc;
        if (old + 1u == (gen + 1u) * nloc) {
            __builtin_amdgcn_fence(__ATOMIC_RELEASE, "agent");
            asm volatile("s_waitcnt vmcnt(0)" ::: "memory");
            const unsigned og = xb_add(&bar[XB_TOP], 1u);
            const unsigned tg = og / nx;
            if (og + 1u == (tg + 1u) * nx) xb_add(&bar[XB_TOPGEN], 1u);
            else XB_SPIN(xb_ld(&bar[XB_TOPGEN]) == tg, bar);
            __builtin_amdgcn_fence(__ATOMIC_ACQUIRE, "agent");
            xb_add(&bar[XB_XGEN(b.x)], 1u);
            asm volatile("s_waitcnt vmcnt(0)" ::: "memory");
        } else {
            XB_SPIN(xb_ld(&bar[XB_XGEN(b.x)]) == gen, bar);
            __builtin_amdgcn_fence(__ATOMIC_ACQUIRE, "agent");
            asm volatile("s_waitcnt vmcnt(0)" ::: "memory");
        }
    }
    __syncthreads();
}
#define EPIIN_NS 0
#define EPI_NS16 0
#define EPI_NS32 0

namespace pg8 {
constexpr int BM = 256, BK = 64, HALF = 128, HTB = HALF * BK * 2, STAGE_BYTES = 8 * HTB, NXCD = 8, WGM = 8;
__host__ __device__ __forceinline__ int lds_byte(int r, int c) { const int st = (r >> 4) * 2 + (c >> 5), rr = r & 15, cc = c & 31, ob = rr * 64 + cc * 2; return st * 1024 + (ob ^ (((ob >> 9) & 1) << 5)); }
__host__ __device__ __forceinline__ void stage_rc(int b, int& R, int& C) { const int st = b / 1024, sb = b % 1024, swz = sb ^ (((sb >> 9) & 1) << 5); R = (st >> 1) * 16 + swz / 64; C = (st & 1) * 32 + (swz % 64) / 2; }
__host__ __device__ __forceinline__ int perm32(int rho) { const int n = rho >> 4, i = rho & 15; return 8 * (i >> 2) + 4 * n + (i & 3); }

struct Unit { int pm, pn, seg; };

struct TileOrder {
    int nM, nN, nwg, G, c;
    __device__ __forceinline__ void init(int nM_, int nN_, int G_, int c_) { nM = nM_; nN = nN_; nwg = nM * nN; G = G_; c = c_; }
    __device__ __forceinline__ bool tile(int i, int& pm, int& pn) const {
        const long L = (long)i * G + c; if (L >= nwg) return false;
        int wgid = (int)L; { const int q = nwg / NXCD, r = nwg % NXCD, xcd = wgid % NXCD, off = wgid / NXCD; wgid = (xcd < r ? xcd * (q + 1) : r * (q + 1) + (xcd - r) * q) + off; }
        const int nig = WGM * nN, gid = wgid / nig, fm = gid * WGM, gsz = (nM - fm) < WGM ? (nM - fm) : WGM;
        pm = fm + ((wgid % nig) % gsz); pn = (wgid % nig) / gsz; return true;
    }
};
struct SchedPlain {
    TileOrder T; const gchar* A; const gchar* B; size_t astep, bstep;
    __device__ __forceinline__ bool next(int i, Unit& u) const { u.seg = 0; return T.tile(i, u.pm, u.pn); }
    __device__ __forceinline__ const gchar* a_ptr(const Unit& u) const { return A + (size_t)u.pm * astep; }
    __device__ __forceinline__ const gchar* b_ptr(const Unit& u) const { return B + (size_t)u.pn * bstep; }
};
struct SchedBranch {
    TileOrder T; const gchar* A; const gchar* B; size_t astep, bstep, aseg, bseg;
    __device__ __forceinline__ bool next(int i, Unit& u) const { const int t = i / 3; u.seg = i - 3 * t; return T.tile(t, u.pm, u.pn); }
    __device__ __forceinline__ const gchar* a_ptr(const Unit& u) const { return A + (size_t)u.seg * aseg + (size_t)u.pm * astep; }
    __device__ __forceinline__ const gchar* b_ptr(const Unit& u) const { return B + (size_t)u.seg * bseg + (size_t)u.pn * bstep; }
};

template <class Epi, class Sched>
__device__ __forceinline__ void gemm_phase(LAS unsigned char* lds, const int K, const int lda, const int ldb, const Sched& S, const Epi& E) {
    int tid = threadIdx.x; LAUNDER_V(tid);
    const int wid = __builtin_amdgcn_readfirstlane(tid >> 6), lane = tid & 63, wr = wid >> 2, wc = wid & 3, fr = lane & 15, fq = lane >> 4;
    const int nt = K / BK;
    unsigned voffA, voffB;
    { int R, C; stage_rc(tid * 16, R, C); const int Rb = Epi::PERM ? ((R & ~31) + perm32(R & 31)) : R;
      voffA = (unsigned)(R * lda + C) * 2u; voffB = (unsigned)(Rb * ldb + C) * 2u; }
    const unsigned qstepA = 64u * (unsigned)lda * 2u, qstepB = 64u * (unsigned)ldb * 2u;
    const size_t kstep = (size_t)(BK * 2);
    const size_t hstepA = (size_t)HALF * lda * 2, hstepB = (size_t)HALF * ldb * 2;
    const unsigned ldsw = (unsigned)wid * 1024u;
    const int aoff = lds_byte(wr * 64 + fr, fq * 8), boff = lds_byte(wc * 32 + fr, fq * 8);
#define PG8_SA(b, h) (((b) * 2 + (h)) * HTB)
#define PG8_SB(b, h) ((4 + (b) * 2 + (h)) * HTB)
#define PG8_STAGE(bufoff, gbase, voff) do { _Pragma("unroll") for (int _i = 0; _i < 2; ++_i) \
        __builtin_amdgcn_global_load_lds((const gunsigned*)((const gchar*)(gbase) + (size_t)_i * q##voff + (voff)), (LAS unsigned*)(lds + (bufoff) + ldsw + _i * 8192), 16, 0, 0); } while (0)
#define qvoffA qstepA
#define qvoffB qstepB
#define PG8_LDA(dst, b, h) do { _Pragma("unroll") for (int m = 0; m < 4; ++m) _Pragma("unroll") for (int k = 0; k < 2; ++k) dst[m][k] = *(const LAS bf16x8*)(lds + PG8_SA(b, h) + aoff + m * 2048 + k * 1024); } while (0)
#define PG8_LDB(dst, b, h) do { _Pragma("unroll") for (int n = 0; n < 2; ++n) _Pragma("unroll") for (int k = 0; k < 2; ++k) dst[n][k] = *(const LAS bf16x8*)(lds + PG8_SB(b, h) + boff + n * 2048 + k * 1024); } while (0)
#define PG8_MMA(ai, bj, At, Bt) do { __builtin_amdgcn_s_setprio(1); _Pragma("unroll") for (int m = 0; m < 4; ++m) _Pragma("unroll") for (int n = 0; n < 2; ++n) _Pragma("unroll") for (int k = 0; k < 2; ++k) \
        acc[ai][bj][m][n] = __builtin_amdgcn_mfma_f32_16x16x32_bf16(Bt[n][k], At[m][k], acc[ai][bj][m][n], 0, 0, 0); __builtin_amdgcn_s_setprio(0); } while (0)
#define PG8_WAIT_V(n) asm volatile("s_waitcnt vmcnt(" #n ")" ::: "memory")
#define PG8_WAIT_VR() do { if constexpr (Epi::NS == 16) asm volatile("s_waitcnt vmcnt(24)" ::: "memory"); else if constexpr (Epi::NS == 32) asm volatile("s_waitcnt vmcnt(40)" ::: "memory"); else asm volatile("s_waitcnt vmcnt(8)" ::: "memory"); } while (0)
#define PG8_WAIT_L(n) asm volatile("s_waitcnt lgkmcnt(" #n ")" ::: "memory")
#define PG8_BAR __builtin_amdgcn_s_barrier()
#define PG8_SCHED __builtin_amdgcn_sched_barrier(0)
    Unit cur, nxt; int ui = 0; bool relax_next = false;
    if (!S.next(0, cur)) return;
    f32x4 acc[2][2][4][2];
#pragma unroll
    for (int a = 0; a < 2; ++a)
#pragma unroll
        for (int b = 0; b < 2; ++b)
#pragma unroll
            for (int m = 0; m < 4; ++m)
#pragma unroll
                for (int n = 0; n < 2; ++n) acc[a][b][m][n] = (f32x4){0.f, 0.f, 0.f, 0.f};
    bf16x8 At[4][2], B0[2][2], B1[2][2];
    const gchar* cA = S.a_ptr(cur); const gchar* cB = S.b_ptr(cur);
    PG8_STAGE(PG8_SB(0, 0), cB, voffB); PG8_STAGE(PG8_SB(0, 1), cB + hstepB, voffB); PG8_STAGE(PG8_SA(0, 0), cA, voffA); PG8_STAGE(PG8_SA(0, 1), cA + hstepA, voffA);
    if (wr == 1) PG8_BAR;
    PG8_WAIT_V(2); PG8_BAR;
    PG8_STAGE(PG8_SB(1, 0), cB + kstep, voffB); PG8_STAGE(PG8_SA(1, 0), cA + kstep, voffA); PG8_STAGE(PG8_SB(1, 1), cB + hstepB + kstep, voffB);
    PG8_WAIT_V(6); PG8_BAR;
    for (;;) {
        const bool has_next = S.next(ui + 1, nxt);
        const gchar* nA = has_next ? S.a_ptr(nxt) : cA; const gchar* nB = has_next ? S.b_ptr(nxt) : cB;
        for (int t = 0; t < nt; t += 2) {
            const bool last = (t == nt - 2); const bool relax = Epi::NS > 0 && (t == 0) && relax_next;
            const gchar* a1 = cA + (size_t)(t + 1) * kstep;
            const gchar* a2 = last ? nA : cA + (size_t)(t + 2) * kstep; const gchar* b2 = last ? nB : cB + (size_t)(t + 2) * kstep;
            const gchar* a3 = a2 + kstep; const gchar* b3 = b2 + kstep;
            PG8_LDB(B0, 0, 0); PG8_LDB(B1, 0, 1); PG8_SCHED; PG8_LDA(At, 0, 0); PG8_STAGE(PG8_SA(1, 1), a1 + hstepA, voffA);
            if (relax) PG8_WAIT_VR(); else PG8_WAIT_V(8); PG8_WAIT_L(0); PG8_BAR; PG8_MMA(0, 0, At, B0); PG8_MMA(0, 1, At, B1); PG8_BAR; PG8_SCHED;
            PG8_LDA(At, 0, 1); PG8_STAGE(PG8_SB(0, 0), b2, voffB); PG8_STAGE(PG8_SB(0, 1), b2 + hstepB, voffB); PG8_STAGE(PG8_SA(0, 0), a2, voffA);
            if (relax) PG8_WAIT_VR(); else PG8_WAIT_V(8); PG8_WAIT_L(0); PG8_BAR; PG8_MMA(1, 0, At, B0); PG8_MMA(1, 1, At, B1); PG8_BAR; PG8_SCHED;
            PG8_LDB(B0, 1, 0); PG8_LDB(B1, 1, 1); PG8_SCHED; PG8_LDA(At, 1, 0); PG8_STAGE(PG8_SA(0, 1), a2 + hstepA, voffA);
            PG8_WAIT_V(8); PG8_WAIT_L(0); PG8_BAR; PG8_MMA(0, 0, At, B0); PG8_MMA(0, 1, At, B1); PG8_BAR; PG8_SCHED;
            PG8_LDA(At, 1, 1); PG8_STAGE(PG8_SB(1, 0), b3, voffB); PG8_STAGE(PG8_SB(1, 1), b3 + hstepB, voffB); PG8_STAGE(PG8_SA(1, 0), a3, voffA);
            PG8_WAIT_V(8); PG8_WAIT_L(0); PG8_BAR; PG8_MMA(1, 0, At, B0); PG8_MMA(1, 1, At, B1); PG8_BAR; PG8_SCHED;
        }
        if (wr == 0) PG8_BAR;
        { const int ln_ = (int)__builtin_amdgcn_mbcnt_hi(~0u, __builtin_amdgcn_mbcnt_lo(~0u, 0u)); E(acc, cur, wr, wc, ln_ & 15, ln_ >> 4); } relax_next = E.relax(cur);
        if (!has_next) break;
        if (!E.keep(cur)) {
#pragma unroll
            for (int a = 0; a < 2; ++a)
#pragma unroll
                for (int b = 0; b < 2; ++b)
#pragma unroll
                    for (int m = 0; m < 4; ++m)
#pragma unroll
                        for (int n = 0; n < 2; ++n) acc[a][b][m][n] = (f32x4){0.f, 0.f, 0.f, 0.f};
        }
        cur = nxt; cA = nA; cB = nB; ++ui;
        if (wr == 1) PG8_BAR;
    }
    PG8_WAIT_V(0);
    PG8_BAR;
#undef PG8_SA
#undef PG8_SB
#undef PG8_STAGE
#undef qvoffA
#undef qvoffB
#undef PG8_LDA
#undef PG8_LDB
#undef PG8_MMA
#undef PG8_WAIT_V
#undef PG8_WAIT_VR
#undef PG8_WAIT_L
#undef PG8_BAR
#undef PG8_SCHED
}
}

constexpr size_t MiB = 1u << 20;
constexpr size_t WS_CTL = 0, CTL_ZERO_BYTES = 1 * MiB;
constexpr int CW_BAR = 4096;
constexpr size_t CTL_SSQ1 = 256 * 1024;
constexpr size_t SZ_WIN = (size_t)N_IN_T * DM * 2, SZ_WBR = (size_t)3 * DM * BW * 2, SZ_WSQ = (size_t)DM * DM * 2, SZ_WPP = (size_t)DM * 256 * 2;
constexpr size_t WS_WIN = 2 * MiB;
constexpr size_t WS_WBR = WS_WIN + 2 * SZ_WIN;
constexpr size_t WS_WOUT = WS_WBR + 2 * SZ_WBR;
constexpr size_t WS_WPG = WS_WOUT + 2 * SZ_WSQ;
constexpr size_t WS_WPP = WS_WPG + 2 * SZ_WSQ;
constexpr size_t SZ_ROWS_BW = (size_t)M_ROWS * BW * 2, SZ_ROWS_D = (size_t)M_ROWS * DM * 2;
constexpr size_t WS_XB = WS_WPP + 2 * SZ_WPP;
constexpr size_t WS_PB = WS_XB + SZ_ROWS_D;
constexpr size_t WS_CS = WS_PB + (size_t)2 * M_ROWS * 256 * 2;
constexpr size_t WS_SSQ0 = WS_CS + (size_t)M_ROWS * 16 * 4;
constexpr size_t WS_AU = WS_SSQ0 + (size_t)M_ROWS * 4;
constexpr size_t WS_AV = WS_AU + SZ_ROWS_BW, WS_AZ = WS_AV + SZ_ROWS_BW, WS_BQ = WS_AZ + SZ_ROWS_BW;
constexpr size_t WS_BK = WS_BQ + SZ_ROWS_BW;
constexpr size_t WS_BV = WS_BK + (size_t)M_ROWS * 256 * 2;
constexpr size_t WS_BZ = WS_BV + (size_t)M_ROWS * 256 * 2;
constexpr size_t WS_CQ = WS_BZ + SZ_ROWS_BW;
constexpr size_t WS_CK = WS_CQ + (size_t)M_ROWS * 1024 * 2;
constexpr size_t WS_CV = WS_CK + (size_t)M_ROWS * 1024 * 2;
constexpr size_t WS_CO = WS_CV + SZ_ROWS_BW, WS_CZ = WS_CO + SZ_ROWS_BW;
constexpr size_t WS_G = WS_CZ + SZ_ROWS_BW;
constexpr size_t WS_IF = WS_G + (size_t)M_ROWS * 12288 * 2;
constexpr size_t WS_LNP = WS_IF + (size_t)M_ROWS * 8 * 4;
constexpr size_t WS_YA = WS_LNP + (size_t)M_ROWS * 32 * 8;
constexpr size_t WS_NUM = WS_YA + 3 * SZ_ROWS_BW;
constexpr size_t WS_SSQC = WS_NUM + SZ_ROWS_BW;
constexpr size_t WS_DN = WS_SSQC + (size_t)M_ROWS * 64 * 4;
constexpr size_t WS_MIX = WS_DN + (size_t)M_ROWS * 4 * 4;
constexpr size_t WS_OUT = WS_MIX + SZ_ROWS_D;
constexpr size_t WS_OUTP = WS_OUT + SZ_ROWS_D;
constexpr size_t WS_ERAW = WS_OUTP + (size_t)M_ROWS * 64 * 4;
constexpr size_t WS_ERP = WS_ERAW + SZ_ROWS_D;
constexpr size_t WS_RSO = WS_ERP + (size_t)M_ROWS * 64 * 4;
constexpr size_t WS_RSE = WS_RSO + (size_t)M_ROWS * 4;
constexpr size_t WS_X1B = WS_RSE + (size_t)M_ROWS * 4;
constexpr size_t WS_END = WS_X1B + SZ_ROWS_D;
static_assert(WS_WIN % 256 == 0 && WS_XB % 256 == 0 && WS_AU % 256 == 0 && WS_G % 256 == 0 && WS_YA % 256 == 0 && WS_MIX % 256 == 0 && WS_X1B % 256 == 0, "alignment");

#ifndef EPIIN_NT
#define EPIIN_NT 0
#endif
#if EPIIN_NT
#define EPIIN_STORE(v, p) __builtin_nontemporal_store((v), (p))
#else
#define EPIIN_STORE(v, p) (*(p) = (v))
#endif
#ifndef EPI_NS16
#define EPI_NS16 16
#endif
#ifndef EPI_NS32
#define EPI_NS32 32
#endif
#ifndef EPIIN_NS
#define EPIIN_NS 16
#endif
namespace pg8 {
struct EpiIn {
    static constexpr bool PERM = true; static constexpr int NS = EPIIN_NS;
    __device__ __forceinline__ bool relax(const Unit& u) const { return u.pn < 122; }
    const gfloat* ssq; guchar* ws;
    __device__ __forceinline__ bool keep(const Unit&) const { return false; }
    __device__ __forceinline__ void operator()(f32x4 (&acc)[2][2][4][2], const Unit& u, int wr, int wc, int fr, int fq) const {
        const int pn = u.pn; const int row0 = u.pm * BM + wr * 64 + fr;
        size_t off; int ldc, t0, act; float sc = 1.f;
        if (pn < 8)        { off = WS_AU; ldc = 2048; t0 = 0; act = 1; }
        else if (pn < 16)  { off = WS_AV; ldc = 2048; t0 = 8; act = 5; }
        else if (pn < 24)  { off = WS_AZ; ldc = 2048; t0 = 16; act = 2; }
        else if (pn < 32)  { off = WS_BQ; ldc = 2048; t0 = 24; act = 0; }
        else if (pn < 33)  { off = WS_BK; ldc = 256; t0 = 32; act = 0; }
        else if (pn < 34)  { off = WS_BV; ldc = 256; t0 = 33; act = 0; }
        else if (pn < 42)  { off = WS_BZ; ldc = 2048; t0 = 34; act = 2; }
        else if (pn < 46)  { off = WS_CQ; ldc = 1024; t0 = 42; act = 0; sc = 0.0625f; }
        else if (pn < 50)  { off = WS_CK; ldc = 1024; t0 = 46; act = 0; }
        else if (pn < 58)  { off = WS_CV; ldc = 2048; t0 = 50; act = 0; }
        else if (pn < 66)  { off = WS_CO; ldc = 2048; t0 = 58; act = 3; }
        else if (pn < 74)  { off = WS_CZ; ldc = 2048; t0 = 66; act = 2; }
        else if (pn < 122) { off = WS_G; ldc = 12288; t0 = 74; act = 3; }
        else               { off = WS_IF; ldc = 8; t0 = 122; act = 4; }
        const int col0 = (pn - t0) * BM + wc * 32 + 8 * fq;
        if (act == 4) {
            if (wc == 0 && fq == 0) {
                gfloat* dst = (gfloat*)(ws + off);
#pragma unroll
                for (int ai = 0; ai < 2; ++ai)
#pragma unroll
                    for (int m = 0; m < 4; ++m) { const int row = row0 + ai * HALF + m * 16; const float rs = rsqrtf(ssq[row] * (1.0f / DM) + NORM_EPS);
                        *(gf32x4*)(dst + (size_t)row * 8) = acc[ai][0][m][0] * rs; *(gf32x4*)(dst + (size_t)row * 8 + 4) = acc[ai][0][m][1] * rs; }
            }
            return;
        }
        gbf16* base = (gbf16*)(ws + off);
#pragma unroll
        for (int ai = 0; ai < 2; ++ai)
#pragma unroll
            for (int m = 0; m < 4; ++m) {
                const int row = row0 + ai * HALF + m * 16; const float rs = rsqrtf(ssq[row] * (1.0f / DM) + NORM_EPS) * sc;
                gbf16* rowp = base + (size_t)row * ldc + col0; float ls = 0.f, lq = 0.f;
#pragma unroll
                for (int bj = 0; bj < 2; ++bj) {
                    f32x4 v0 = acc[ai][bj][m][0] * rs, v1 = acc[ai][bj][m][1] * rs;
                    if (act == 1 || act == 5) {
                        f32x2 a = gelu_pk((f32x2){v0[0], v0[1]}), b = gelu_pk((f32x2){v0[2], v0[3]}), c = gelu_pk((f32x2){v1[0], v1[1]}), d = gelu_pk((f32x2){v1[2], v1[3]});
                        v0 = (f32x4){a.x, a.y, b.x, b.y}; v1 = (f32x4){c.x, c.y, d.x, d.y};
                        if (act == 5) { ls += (v0[0] + v0[1]) + (v0[2] + v0[3]) + (v1[0] + v1[1]) + (v1[2] + v1[3]);
                            lq += (v0[0] * v0[0] + v0[1] * v0[1]) + (v0[2] * v0[2] + v0[3] * v0[3]) + (v1[0] * v1[0] + v1[1] * v1[1]) + (v1[2] * v1[2] + v1[3] * v1[3]); }
                    } else if (act == 2) {
#pragma unroll
                        for (int j = 0; j < 4; ++j) { v0[j] = v0[j] * fsigmoid(v0[j]); v1[j] = v1[j] * fsigmoid(v1[j]); }
                    } else if (act == 3) {
#pragma unroll
                        for (int j = 0; j < 4; ++j) { v0[j] = fsigmoid(v0[j]); v1[j] = fsigmoid(v1[j]); }
                    }
                    u32x4 w; w.x = cvt_pk_bf16(v0[0], v0[1]); w.y = cvt_pk_bf16(v0[2], v0[3]); w.z = cvt_pk_bf16(v1[0], v1[1]); w.w = cvt_pk_bf16(v1[2], v1[3]);
                    EPIIN_STORE(w, (gu32x4*)(rowp + bj * HALF));
                }
                if (act == 5) {
                    ls += __shfl_xor(ls, 16); ls += __shfl_xor(ls, 32); lq += __shfl_xor(lq, 16); lq += __shfl_xor(lq, 32);
                    if (fq == 0) *(gf32x2*)(ws + WS_LNP + ((size_t)row * 32 + (pn - 8) * 4 + wc) * 8) = (f32x2){ls, lq};
                }
            }
    }
};
struct EpiBranch {
    static constexpr bool PERM = true; static constexpr int NS = EPI_NS16;
    __device__ __forceinline__ bool relax(const Unit& u) const { return u.seg == 2; }
    const gbf16* G; gbf16* MIX;
    __device__ __forceinline__ bool keep(const Unit& u) const { return u.seg != 2; }
    __device__ __forceinline__ void operator()(f32x4 (&acc)[2][2][4][2], const Unit& u, int wr, int wc, int fr, int fq) const {
        const int row0 = u.pm * BM + wr * 64 + fr, col0 = u.pn * BM + wc * 32 + 8 * fq; const int seg = u.seg;
#pragma unroll
        for (int ai = 0; ai < 2; ++ai)
#pragma unroll
            for (int m = 0; m < 4; ++m) {
                const int row = row0 + ai * HALF + m * 16; const gbf16* gp = G + (size_t)row * 12288 + seg * DM + col0;
#pragma unroll
                for (int bj = 0; bj < 2; ++bj) {
                    const u32x4 ga = *(const gu32x4*)(gp + bj * HALF);
                    float f[8] = {bf_lo(ga.x), bf_hi(ga.x), bf_lo(ga.y), bf_hi(ga.y), bf_lo(ga.z), bf_hi(ga.z), bf_lo(ga.w), bf_hi(ga.w)};
#pragma unroll
                    for (int j = 0; j < 8; ++j) f[j] = fmaxf(f[j], 1e-20f);
                    if (seg != 2) {
                        const u32x4 gb = *(const gu32x4*)(gp + DM + bj * HALF);
                        const float h[8] = {bf_lo(gb.x), bf_hi(gb.x), bf_lo(gb.y), bf_hi(gb.y), bf_lo(gb.z), bf_hi(gb.z), bf_lo(gb.w), bf_hi(gb.w)};
#pragma unroll
                        for (int j = 0; j < 8; ++j) f[j] = f[j] * __builtin_amdgcn_rcpf(fmaxf(h[j], 1e-20f));
                    }
                    f32x4 v0 = acc[ai][bj][m][0], v1 = acc[ai][bj][m][1];
                    v0 = v0 * (f32x4){f[0], f[1], f[2], f[3]}; v1 = v1 * (f32x4){f[4], f[5], f[6], f[7]};
                    if (seg != 2) { acc[ai][bj][m][0] = v0; acc[ai][bj][m][1] = v1; }
                    else { u32x4 w; w.x = cvt_pk_bf16(v0[0], v0[1]); w.y = cvt_pk_bf16(v0[2], v0[3]); w.z = cvt_pk_bf16(v1[0], v1[1]); w.w = cvt_pk_bf16(v1[2], v1[3]);
                        *(gu32x4*)(MIX + (size_t)row * DM + col0 + bj * HALF) = w; }
                }
                if (m == 3) asm volatile("" ::: "memory");
            }
    }
};
struct EpiSq {
    static constexpr bool PERM = true; static constexpr int NS = EPI_NS16;
    __device__ __forceinline__ bool relax(const Unit&) const { return true; }
    gbf16* O; gfloat* P;
    __device__ __forceinline__ bool keep(const Unit&) const { return false; }
    __device__ __forceinline__ void operator()(f32x4 (&acc)[2][2][4][2], const Unit& u, int wr, int wc, int fr, int fq) const {
        const int row0 = u.pm * BM + wr * 64 + fr, col0 = u.pn * BM + wc * 32 + 8 * fq;
#pragma unroll
        for (int ai = 0; ai < 2; ++ai)
#pragma unroll
            for (int m = 0; m < 4; ++m) {
                const int row = row0 + ai * HALF + m * 16; float q = 0.f;
#pragma unroll
                for (int bj = 0; bj < 2; ++bj) {
                    const f32x4 v0 = acc[ai][bj][m][0], v1 = acc[ai][bj][m][1];
                    q += (v0[0] * v0[0] + v0[1] * v0[1]) + (v0[2] * v0[2] + v0[3] * v0[3]) + (v1[0] * v1[0] + v1[1] * v1[1]) + (v1[2] * v1[2] + v1[3] * v1[3]);
                    u32x4 w; w.x = cvt_pk_bf16(v0[0], v0[1]); w.y = cvt_pk_bf16(v0[2], v0[3]); w.z = cvt_pk_bf16(v1[0], v1[1]); w.w = cvt_pk_bf16(v1[2], v1[3]);
                    if (O) *(gu32x4*)(O + (size_t)row * DM + col0 + bj * HALF) = w; else asm volatile("" :: "v"(w));
                }
                q += __shfl_xor(q, 16); q += __shfl_xor(q, 32);
                if (fq == 0) P[(size_t)row * 64 + u.pn * 4 + wc] = q;
            }
    }
};
struct EpiPle {
    static constexpr bool PERM = false; static constexpr int NS = EPI_NS32;
    __device__ __forceinline__ bool relax(const Unit&) const { return true; }
    const gfloat* XIN; gfloat* XOUT; gbf16* XB; const gbf16* OUT; const gbf16* ERAW; const gfloat* RSO; const gfloat* RSE; const gfloat* npost; const gfloat* pnorm; gfloat* SSQN; int last;
    __device__ __forceinline__ bool keep(const Unit&) const { return false; }
    __device__ __forceinline__ void operator()(f32x4 (&acc)[2][2][4][2], const Unit& u, int wr, int wc, int fr, int fq) const {
        const int row0 = u.pm * BM + wr * 64 + fr, col0 = u.pn * BM + wc * 32 + 4 * fq;
#pragma unroll
        for (int ai = 0; ai < 2; ++ai)
#pragma unroll
            for (int m = 0; m < 4; ++m) {
                const int row = row0 + ai * HALF + m * 16; const float rso = RSO[row], rse = RSE[row]; float q = 0.f; const size_t ro = (size_t)row * DM;
#pragma unroll
                for (int bj = 0; bj < 2; ++bj)
#pragma unroll
                    for (int n = 0; n < 2; ++n) {
                        const int col = col0 + bj * HALF + n * 16;
                        const f32x4 x = *(const gf32x4*)(XIN + ro + col); const u32x2 ob = *(const gu32x2*)(OUT + ro + col), eb = *(const gu32x2*)(ERAW + ro + col);
                        const f32x4 np = *(const gf32x4*)(npost + col), pn = *(const gf32x4*)(pnorm + col);
                        const f32x4 o = {bf_lo(ob.x), bf_hi(ob.x), bf_lo(ob.y), bf_hi(ob.y)}, e = {bf_lo(eb.x), bf_hi(eb.x), bf_lo(eb.y), bf_hi(eb.y)};
                        const f32x4 a = acc[ai][bj][m][n]; f32x4 r;
#pragma unroll
                        for (int j = 0; j < 4; ++j) { const float x1 = x[j] + o[j] * rso * np[j]; r[j] = x1 + fsigmoid(a[j]) * (e[j] * rse * pn[j]); q += r[j] * r[j]; }
                        *(gf32x4*)(XOUT + ro + col) = r;
                        if (!last) { u32x2 w; w.x = cvt_pk_bf16(r[0], r[1]); w.y = cvt_pk_bf16(r[2], r[3]); *(gu32x2*)(XB + ro + col) = w; }
                    }
                if (!last) { q += __shfl_xor(q, 16); q += __shfl_xor(q, 32); if (fq == 0) (void)__hip_atomic_fetch_add(SSQN + row, q, __ATOMIC_RELAXED, __HIP_MEMORY_SCOPE_AGENT); }
                if (m & 1) asm volatile("" ::: "memory");
            }
    }
};
}

constexpr int LDS_BYTES = 147456;
constexpr int MISC_OFF = LDS_BYTES - 128;
constexpr int ARGS_OFF = LDS_BYTES - 512;
constexpr int NWAVES = 8, NTHREADS = 512;

struct Ctx {
    LAS unsigned char* lds; int tid, lane, wave, vcu, G, bx;
};

struct TrTile { const gfloat* W; const gfloat* kscale; gbf16* WT; int ldw, K; };
constexpr int TR_PER_LAYER = 7808 + 1536 + 1024 + 1024 + 64;
__device__ __forceinline__ TrTile tr_decode(int it, const gfloat* w_in, const gfloat* norm_pre, const gfloat* w_branch, const gfloat* w_out, const gfloat* ple_gate, const gfloat* ple_proj, guchar* ws) {
    const int l = it / TR_PER_LAYER; int r = it - l * TR_PER_LAYER; TrTile t; int kt, ntile;
    if (r < 7808) { kt = r / 244; ntile = r - kt * 244; const int src = ntile < 116 ? ntile * 128 : ntile * 128 + 8;
        t.ldw = N_IN; t.K = DM; t.W = w_in + (size_t)l * DM * N_IN + (size_t)kt * 128 * N_IN + src; t.kscale = norm_pre + l * DM + kt * 128;
        t.WT = (gbf16*)(ws + WS_WIN + (size_t)l * SZ_WIN) + (size_t)ntile * 128 * DM + kt * 128; return t; }
    r -= 7808; t.kscale = nullptr; t.ldw = DM;
    if (r < 1536) { const int j = r / 512; const int rr = r - j * 512; kt = rr / 32; ntile = rr - kt * 32; t.K = BW;
        t.W = w_branch + ((size_t)(l * 3 + j) * BW + (size_t)kt * 128) * DM + ntile * 128;
        t.WT = (gbf16*)(ws + WS_WBR + (size_t)l * SZ_WBR) + (size_t)j * DM * BW + (size_t)ntile * 128 * BW + kt * 128; return t; }
    r -= 1536;
    if (r < 2048) { const int which = r / 1024; const int rr = r - which * 1024; kt = rr / 32; ntile = rr - kt * 32; t.K = DM;
        t.W = (which ? ple_gate : w_out) + ((size_t)l * DM + (size_t)kt * 128) * DM + ntile * 128;
        t.WT = (gbf16*)(ws + (which ? WS_WPG : WS_WOUT) + (size_t)l * SZ_WSQ) + (size_t)ntile * 128 * DM + kt * 128; return t; }
    r -= 2048; kt = r / 32; ntile = r - kt * 32; t.K = 256;
    t.W = ple_proj + ((size_t)l * 256 + (size_t)kt * 128) * DM + ntile * 128;
    t.WT = (gbf16*)(ws + WS_WPP + (size_t)l * SZ_WPP) + (size_t)ntile * 128 * 256 + kt * 128; return t;
}
__device__ __forceinline__ void tr_run(const Ctx& F, int it0, int it1, int sk0, int sk1, int me, int nw, const gfloat* w_in, const gfloat* norm_pre, const gfloat* w_branch,
                                       const gfloat* w_out, const gfloat* ple_gate, const gfloat* ple_proj, guchar* ws) {
    int tid = F.tid; LAUNDER_V(tid);
    {
        constexpr int RS = 264; const int NIT = it1 - it0 - (sk1 - sk0);
        const int c4 = tid & 31, kr = tid >> 5, kc = tid & 15;
        f32x4 va[8], vb[8]; float ka[8], kb[8]; TrTile ta, tb;
#define TR_LOAD(T_, V_, K_, IT_) do { T_ = tr_decode(it0 + (IT_) + (((it0 + (IT_)) >= sk0) ? (sk1 - sk0) : 0), w_in, norm_pre, w_branch, w_out, ple_gate, ple_proj, ws); \
        _Pragma("unroll") for (int i = 0; i < 8; ++i) { V_[i] = *(const gf32x4*)(T_.W + (size_t)(i * 16 + kr) * T_.ldw + 4 * c4); K_[i] = T_.kscale ? T_.kscale[i * 16 + kr] : 1.0f; } } while (0)
#define TR_PUT(V_, K_) do { _Pragma("unroll") for (int i = 0; i < 8; ++i) { const f32x4 a = V_[i] * K_[i]; u32x2 w; w.x = cvt_pk_bf16(a[0], a[1]); w.y = cvt_pk_bf16(a[2], a[3]); \
        *(LAS u32x2*)(F.lds + (i * 16 + kr) * RS + c4 * 8) = w; } } while (0)
#define TR_GET(WT_, K_) do { _Pragma("unroll") for (int q = 0; q < 4; ++q) { const int n = 32 * q + (tid >> 4); const LAS bf16_t* s = (const LAS bf16_t*)(F.lds + (8 * kc) * RS + 2 * n); unsigned e[8]; \
        _Pragma("unroll") for (int j = 0; j < 8; ++j) e[j] = s[j * (RS / 2)]; \
        u32x4 o; o.x = e[0] | (e[1] << 16); o.y = e[2] | (e[3] << 16); o.z = e[4] | (e[5] << 16); o.w = e[6] | (e[7] << 16); \
        *(gu32x4*)(WT_ + (size_t)n * K_ + 8 * kc) = o; } } while (0)
        int it = me;
        if (it < NIT) TR_LOAD(ta, va, ka, it);
        if (it + nw < NIT) TR_LOAD(tb, vb, kb, it + nw);
        while (it < NIT) {
            { TR_PUT(va, ka); __syncthreads(); gbf16* wt = ta.WT; const int kk = ta.K;
              if (it + 2 * nw < NIT) TR_LOAD(ta, va, ka, it + 2 * nw);
              TR_GET(wt, kk); __syncthreads(); }
            it += nw; if (it >= NIT) break;
            { TR_PUT(vb, kb); __syncthreads(); gbf16* wt = tb.WT; const int kk = tb.K;
              if (it + 2 * nw < NIT) TR_LOAD(tb, vb, kb, it + 2 * nw);
              TR_GET(wt, kk); __syncthreads(); }
            it += nw;
        }
#undef TR_LOAD
#undef TR_PUT
#undef TR_GET
    }
}
constexpr int TR_DEFER0 = TR_PER_LAYER + 7808 + 1536, TR_DEFER1 = TR_DEFER0 + 2048;
__device__ __forceinline__ void p0_prologue(const Ctx& F, const gfloat* x, const gfloat* p, const gint* positions, const gfloat* norm_pre, const gfloat* w_in, const gfloat* w_branch,
                                            const gfloat* w_out, const gfloat* ple_gate, const gfloat* ple_proj, guchar* ws) {
    int tid = F.tid; LAUNDER_V(tid);
    tr_run(F, 0, NLAYER * TR_PER_LAYER, TR_DEFER0, TR_DEFER1, F.vcu, F.G, w_in, norm_pre, w_branch, w_out, ple_gate, ple_proj, ws);
    const int gt = F.vcu * NTHREADS + tid, NGT = F.G * NTHREADS;
    for (int i = gt; i < NLAYER * 256 * DM; i += NGT) { const int l = i / (256 * DM), rr = (i / DM) & 255, k = i & (DM - 1);
        float val = 0.f; if (rr < 8) val = w_in[(size_t)l * DM * N_IN + (size_t)k * N_IN + IF_COL + rr] * norm_pre[l * DM + k];
        ((gbf16*)(ws + WS_WIN + (size_t)l * SZ_WIN))[(size_t)(122 * 256 + rr) * DM + k] = (bf16_t)(cvt_pk_bf16(val, 0.f) & 0xffffu); }
    for (int i = gt; i < NLAYER * M_ROWS * 256 / 4; i += NGT) { const f32x4 a = ((const gf32x4*)p)[i]; u32x2 w; w.x = cvt_pk_bf16(a[0], a[1]); w.y = cvt_pk_bf16(a[2], a[3]); ((gu32x2*)(ws + WS_PB))[i] = w; }
    for (int i = gt; i < M_ROWS * 8; i += NGT) { const int row = i >> 3, j = i & 7; const float inv = powf(500000.0f, -(float)j * 0.125f); const float ang = (float)positions[row] * inv;
        gfloat* cs = (gfloat*)(ws + WS_CS) + (size_t)row * 16; cs[j] = cosf(ang); cs[8 + j] = sinf(ang); }
    { const int gw = F.vcu * NWAVES + F.wave, NGW = F.G * NWAVES;
      for (int m = gw; m < M_ROWS; m += NGW) { const gf32x4* xr = (const gf32x4*)(x + (size_t)m * DM) + F.lane; gu32x2* o = (gu32x2*)(ws + WS_XB + (size_t)m * DM * 2) + F.lane; float s = 0.f;
#pragma unroll
          for (int j = 0; j < 16; ++j) { const f32x4 a = xr[64 * j]; s += (a[0] * a[0] + a[1] * a[1]) + (a[2] * a[2] + a[3] * a[3]); u32x2 w; w.x = cvt_pk_bf16(a[0], a[1]); w.y = cvt_pk_bf16(a[2], a[3]); o[64 * j] = w; }
          s = wave_sum(s); if (F.lane == 0) ((gfloat*)(ws + WS_SSQ0))[m] = s; } }
}

__device__ __forceinline__ u32x2 pack4(const f32x4 v) { u32x2 w; w.x = cvt_pk_bf16(v[0], v[1]); w.y = cvt_pk_bf16(v[2], v[3]); return w; }
__device__ __forceinline__ bf16x8 mk_frag(const u32x2 lo, const u32x2 hi) { const u32x4 t = {lo.x, lo.y, hi.x, hi.y}; return __builtin_bit_cast(bf16x8, t); }
__device__ __forceinline__ bf16x8 frag_const(unsigned w) { const u32x4 t = {w, w, w, w}; return __builtin_bit_cast(bf16x8, t); }

constexpr int GM_WL = 0, GM_VT = 34816, GM_ST = 104448, GM_RS = 272;
__device__ __forceinline__ void gmlp_unit(const Ctx& F, int b, int n, int g, guchar* ws, const gfloat* ln_g, const gfloat* ln_b, const gfloat* wsp, const gfloat* bsp) {
    int tid = F.tid; LAUNDER_V(tid); const int lane = tid & 63, w = F.wave, r16 = lane & 15, q4 = lane >> 4;
    const int row0 = b * SEQ + n * 128, c0 = g * 256;
    const gbf16* AU = (const gbf16*)(ws + WS_AU); const gbf16* AV = (const gbf16*)(ws + WS_AV); const gbf16* AZ = (const gbf16*)(ws + WS_AZ); gbf16* YA = (gbf16*)(ws + WS_YA);
    if (tid < 128) { const gf32x2* pp = (const gf32x2*)(ws + WS_LNP) + (size_t)(row0 + tid) * 32; float s = 0.f, q = 0.f;
#pragma unroll 8
        for (int j = 0; j < 32; ++j) { const f32x2 t = pp[j]; s += t.x; q += t.y; }
        const float mu = s * (1.0f / BW); const float var = fmaxf(q * (1.0f / BW) - mu * mu, 0.f);
        *(LAS f32x2*)(F.lds + GM_ST + tid * 8) = (f32x2){mu, rsqrtf(var + NORM_EPS)}; }
#pragma unroll
    for (int k = 0; k < 8; ++k) { const int item = tid + 512 * k, t = item >> 5, ch = item & 31;
        f32x4 a = *(const gf32x4*)(wsp + ((size_t)(g * 128 + t)) * 128 + 4 * ch);
#pragma unroll
        for (int e = 0; e < 4; ++e) if (4 * ch + e > t) a[e] = 0.f;
        *(LAS u32x2*)(F.lds + GM_WL + t * GM_RS + ch * 8) = pack4(a); }
    __syncthreads();
#pragma unroll
    for (int k = 0; k < 8; ++k) { const int item = tid + 512 * k, s = item & 127, ch = item >> 7;
        const u32x4 raw = *(const gu32x4*)(AV + (size_t)(row0 + s) * BW + c0 + 8 * ch);
        const f32x4 g0 = *(const gf32x4*)(ln_g + c0 + 8 * ch), g1 = *(const gf32x4*)(ln_g + c0 + 8 * ch + 4), b0 = *(const gf32x4*)(ln_b + c0 + 8 * ch), b1 = *(const gf32x4*)(ln_b + c0 + 8 * ch + 4);
        const f32x2 st = *(const LAS f32x2*)(F.lds + GM_ST + s * 8);
        const float xv[8] = {bf_lo(raw.x), bf_hi(raw.x), bf_lo(raw.y), bf_hi(raw.y), bf_lo(raw.z), bf_hi(raw.z), bf_lo(raw.w), bf_hi(raw.w)};
        const float gg[8] = {g0[0], g0[1], g0[2], g0[3], g1[0], g1[1], g1[2], g1[3]}, bb[8] = {b0[0], b0[1], b0[2], b0[3], b1[0], b1[1], b1[2], b1[3]};
#pragma unroll
        for (int i = 0; i < 8; ++i) { const float y = (xv[i] - st.x) * st.y * gg[i] + bb[i];
            *(LAS bf16_t*)(F.lds + GM_VT + (8 * ch + i) * GM_RS + 2 * s) = (bf16_t)(cvt_pk_bf16(y, 0.f) & 0xffffu); } }
    __syncthreads();
    f32x4 acc[2][8];
#pragma unroll
    for (int m = 0; m < 2; ++m)
#pragma unroll
        for (int n8 = 0; n8 < 8; ++n8) acc[m][n8] = (f32x4){0.f, 0.f, 0.f, 0.f};
    bf16x8 af[2][4];
#pragma unroll
    for (int m = 0; m < 2; ++m)
#pragma unroll
        for (int ks = 0; ks < 4; ++ks) af[m][ks] = *(const LAS bf16x8*)(F.lds + GM_VT + (32 * w + 16 * m + r16) * GM_RS + ks * 64 + q4 * 16);
#pragma unroll
    for (int n8 = 0; n8 < 8; ++n8)
#pragma unroll
        for (int ks = 0; ks < 4; ++ks) if (ks <= n8 / 2) {
            const bf16x8 bfr = *(const LAS bf16x8*)(F.lds + GM_WL + (16 * n8 + r16) * GM_RS + ks * 64 + q4 * 16);
#pragma unroll
            for (int m = 0; m < 2; ++m) acc[m][n8] = MFMA16(af[m][ks], bfr, acc[m][n8]); }
#pragma unroll
    for (int n8 = 0; n8 < 8; ++n8) { const int t = 16 * n8 + r16; const float bsv = bsp[g * 128 + t]; const size_t ro = (size_t)(row0 + t) * BW + c0 + 32 * w + 4 * q4;
#pragma unroll
        for (int m = 0; m < 2; ++m) { const u32x2 ub = *(const gu32x2*)(AU + ro + 16 * m), zb = *(const gu32x2*)(AZ + ro + 16 * m);
            const f32x4 a = acc[m][n8] + bsv; f32x4 y;
            y[0] = a[0] * bf_lo(ub.x) * bf_lo(zb.x); y[1] = a[1] * bf_hi(ub.x) * bf_hi(zb.x); y[2] = a[2] * bf_lo(ub.y) * bf_lo(zb.y); y[3] = a[3] * bf_hi(ub.y) * bf_hi(zb.y);
            *(gu32x2*)(YA + ro + 16 * m) = pack4(y); } }
    __syncthreads();
}

constexpr int SW_KL = 0, SW_VT = 36864, SW_QL = 70656, SW_RS = 144, SW_VS = 528;
__device__ __forceinline__ void rope8(const u32x4 a, const u32x4 bq, const gfloat* cs, float scale, u32x4& o1, u32x4& o2) {
    const f32x4 c0 = *(const gf32x4*)cs, c1 = *(const gf32x4*)(cs + 4), s0 = *(const gf32x4*)(cs + 8), s1 = *(const gf32x4*)(cs + 12);
    const float t1[8] = {bf_lo(a.x), bf_hi(a.x), bf_lo(a.y), bf_hi(a.y), bf_lo(a.z), bf_hi(a.z), bf_lo(a.w), bf_hi(a.w)};
    const float t2[8] = {bf_lo(bq.x), bf_hi(bq.x), bf_lo(bq.y), bf_hi(bq.y), bf_lo(bq.z), bf_hi(bq.z), bf_lo(bq.w), bf_hi(bq.w)};
    const float cc[8] = {c0[0], c0[1], c0[2], c0[3], c1[0], c1[1], c1[2], c1[3]}, ss[8] = {s0[0], s0[1], s0[2], s0[3], s1[0], s1[1], s1[2], s1[3]};
    float r1[8], r2[8];
#pragma unroll
    for (int i = 0; i < 8; ++i) { r1[i] = (t1[i] * cc[i] - t2[i] * ss[i]) * scale; r2[i] = (t2[i] * cc[i] + t1[i] * ss[i]) * scale; }
    o1 = (u32x4){cvt_pk_bf16(r1[0], r1[1]), cvt_pk_bf16(r1[2], r1[3]), cvt_pk_bf16(r1[4], r1[5]), cvt_pk_bf16(r1[6], r1[7])};
    o2 = (u32x4){cvt_pk_bf16(r2[0], r2[1]), cvt_pk_bf16(r2[2], r2[3]), cvt_pk_bf16(r2[4], r2[5]), cvt_pk_bf16(r2[6], r2[7])};
}
__device__ __forceinline__ u32x4 scale8(const u32x4 a, float sc) {
    return (u32x4){cvt_pk_bf16(bf_lo(a.x) * sc, bf_hi(a.x) * sc), cvt_pk_bf16(bf_lo(a.y) * sc, bf_hi(a.y) * sc), cvt_pk_bf16(bf_lo(a.z) * sc, bf_hi(a.z) * sc), cvt_pk_bf16(bf_lo(a.w) * sc, bf_hi(a.w) * sc)};
}
__device__ __forceinline__ void swa_unit(const Ctx& F, int b, int n, int hk, guchar* ws, const gfloat* sinks) {
    int tid = F.tid; LAUNDER_V(tid); const int lane = tid & 63, w = F.wave, r16 = lane & 15, q4 = lane >> 4;
    const int r0 = b * SEQ + n * 128, kr0 = r0 - 128;
    const gbf16* BQ = (const gbf16*)(ws + WS_BQ); const gbf16* BK = (const gbf16*)(ws + WS_BK); const gbf16* BV = (const gbf16*)(ws + WS_BV); const gbf16* BZ = (const gbf16*)(ws + WS_BZ);
    gbf16* YB = (gbf16*)(ws + WS_YA) + (size_t)M_ROWS * BW; const gfloat* CS = (const gfloat*)(ws + WS_CS);
#pragma unroll
    for (int k = 0; k < 4; ++k) { const int item = tid + 512 * k, key = item >> 3, ch = item & 7; const bool pad = (n == 0 && key < 128);
        if (ch == 1) continue;
        const gbf16* src = BK + (size_t)(kr0 + key) * 256 + hk * 64;
        LAS unsigned char* dst = F.lds + SW_KL + key * SW_RS;
        if (pad) { *(LAS u32x4*)(dst + ch * 16) = (u32x4){0u, 0u, 0u, 0u}; if (ch == 0) *(LAS u32x4*)(dst + 16) = (u32x4){0u, 0u, 0u, 0u}; }
        else if (ch == 0) { u32x4 o1, o2; rope8(*(const gu32x4*)src, *(const gu32x4*)(src + 8), CS + (size_t)(kr0 + key) * 16, 1.0f, o1, o2); *(LAS u32x4*)dst = o1; *(LAS u32x4*)(dst + 16) = o2; }
        else *(LAS u32x4*)(dst + ch * 16) = *(const gu32x4*)(src + 8 * ch); }
#pragma unroll
    for (int k = 0; k < 4; ++k) { const int item = tid + 512 * k, key = item & 255, ch = item >> 8; const bool pad = (n == 0 && key < 128);
        u32x4 raw = {0u, 0u, 0u, 0u}; if (!pad) raw = *(const gu32x4*)(BV + (size_t)(kr0 + key) * 256 + hk * 64 + 8 * ch);
        const unsigned e[4] = {raw.x, raw.y, raw.z, raw.w};
#pragma unroll
        for (int i = 0; i < 8; ++i) *(LAS bf16_t*)(F.lds + SW_VT + (8 * ch + i) * SW_VS + 2 * key) = (bf16_t)((e[i >> 1] >> ((i & 1) * 16)) & 0xffffu); }
    for (int hi = 0; hi < 8; ++hi) {
        const int hq = hk * 8 + hi;
#pragma unroll
        for (int k = 0; k < 2; ++k) { const int item = tid + 512 * k, qr = item >> 3, ch = item & 7;
            if (ch == 1) continue;
            const gbf16* src = BQ + (size_t)(r0 + qr) * BW + hq * 64; LAS unsigned char* dst = F.lds + SW_QL + qr * SW_RS;
            if (ch == 0) { u32x4 o1, o2; rope8(*(const gu32x4*)src, *(const gu32x4*)(src + 8), CS + (size_t)(r0 + qr) * 16, 0.125f, o1, o2); *(LAS u32x4*)dst = o1; *(LAS u32x4*)(dst + 16) = o2; }
            else *(LAS u32x4*)(dst + ch * 16) = scale8(*(const gu32x4*)(src + 8 * ch), 0.125f); }
        __syncthreads();
        bf16x8 bq[2];
#pragma unroll
        for (int ks = 0; ks < 2; ++ks) bq[ks] = *(const LAS bf16x8*)(F.lds + SW_QL + (16 * w + r16) * SW_RS + ks * 64 + q4 * 16);
        f32x4 s[16];
#pragma unroll
        for (int kt = 0; kt < 16; ++kt) { s[kt] = (f32x4){0.f, 0.f, 0.f, 0.f};
#pragma unroll
            for (int ks = 0; ks < 2; ++ks) { const bf16x8 a = *(const LAS bf16x8*)(F.lds + SW_KL + (16 * kt + r16) * SW_RS + ks * 64 + q4 * 16); s[kt] = MFMA16(a, bq[ks], s[kt]); } }
        const int qi = 16 * w + r16; const float sink = sinks[hq]; float mx = sink;
#pragma unroll
        for (int kt = 0; kt < 16; ++kt)
#pragma unroll
            for (int e = 0; e < 4; ++e) { const int kj = 16 * kt + 4 * q4 + e; const bool valid = (kj > qi) && (kj <= qi + 128) && (n > 0 || kj >= 128);
                s[kt][e] = valid ? s[kt][e] : -1e30f; mx = fmaxf(mx, s[kt][e]); }
        mx = fmaxf(mx, __shfl_xor(mx, 16)); mx = fmaxf(mx, __shfl_xor(mx, 32));
        float sum = 0.f;
#pragma unroll
        for (int kt = 0; kt < 16; ++kt)
#pragma unroll
            for (int e = 0; e < 4; ++e) { const float pv = (s[kt][e] > -1e29f) ? __expf(s[kt][e] - mx) : 0.f; s[kt][e] = pv; sum += pv; }
        sum += __shfl_xor(sum, 16); sum += __shfl_xor(sum, 32); sum += __expf(sink - mx);
        const float inv = 1.0f / sum;
        f32x4 o[4];
#pragma unroll
        for (int dt = 0; dt < 4; ++dt) o[dt] = (f32x4){0.f, 0.f, 0.f, 0.f};
#pragma unroll
        for (int kk = 0; kk < 8; ++kk) { const bf16x8 pf = mk_frag(pack4(s[2 * kk]), pack4(s[2 * kk + 1]));
#pragma unroll
            for (int dt = 0; dt < 4; ++dt) { const LAS unsigned char* vp = F.lds + SW_VT + (16 * dt + r16) * SW_VS + (32 * kk + 4 * q4) * 2;
                const bf16x8 a = mk_frag(*(const LAS u32x2*)vp, *(const LAS u32x2*)(vp + 32)); o[dt] = MFMA16(a, pf, o[dt]); } }
        const size_t ro = (size_t)(r0 + qi) * BW + hq * 64 + 4 * q4;
#pragma unroll
        for (int dt = 0; dt < 4; ++dt) { const u32x2 zb = *(const gu32x2*)(BZ + ro + 16 * dt); f32x4 y;
            y[0] = o[dt][0] * inv * bf_lo(zb.x); y[1] = o[dt][1] * inv * bf_hi(zb.x); y[2] = o[dt][2] * inv * bf_lo(zb.y); y[3] = o[dt][3] * inv * bf_hi(zb.y);
            *(gu32x2*)(YB + ro + 16 * dt) = pack4(y); }
        __syncthreads();
    }
}

#ifndef ML_R1A
#define ML_R1A 1
#endif
#ifndef ML_R1B
#define ML_R1B 1
#endif
#ifndef ML_RWR
#define ML_RWR 1
#endif
constexpr int ML_QL = 0, ML_KA = 33792, ML_KB = 67584, ML_VT = 101376, ML_VW = 105984, ML_VW2 = 110736, ML_CT = 115488, ML_X = 132912, ML_GATE = 142128, ML_GSZ = 1344, ML_RS = 528, ML_TS = 144;
static_assert(ML_GATE + 2 * ML_GSZ <= ARGS_OFF, "mLSTM LDS map");
typedef short s16x4 __attribute__((ext_vector_type(4)));
__device__ __forceinline__ bf16x8 tr_frag8(const LAS unsigned char* img, int rs, int row0, int col0, int r16) {
    const LAS unsigned char* p0 = img + (row0 + (r16 >> 2)) * rs + (col0 + 4 * (r16 & 3)) * 2;
    const s16x4 a = __builtin_amdgcn_ds_read_tr16_b64_v4i16((LAS s16x4*)p0);
    const s16x4 b = __builtin_amdgcn_ds_read_tr16_b64_v4i16((LAS s16x4*)(p0 + 4 * rs));
    return __builtin_shufflevector(a, b, 0, 1, 2, 3, 4, 5, 6, 7);
}
__device__ __forceinline__ float dpp_shr(float v, float ident, int n) {
    const int r = n == 1 ? __builtin_amdgcn_update_dpp(__float_as_int(ident), __float_as_int(v), 0x111, 0xf, 0xf, false)
                : n == 2 ? __builtin_amdgcn_update_dpp(__float_as_int(ident), __float_as_int(v), 0x112, 0xf, 0xf, false)
                : n == 4 ? __builtin_amdgcn_update_dpp(__float_as_int(ident), __float_as_int(v), 0x114, 0xf, 0xf, false)
                         : __builtin_amdgcn_update_dpp(__float_as_int(ident), __float_as_int(v), 0x118, 0xf, 0xf, false);
    return __int_as_float(r);
}
__device__ __forceinline__ float wave_scan_add(float v, int lane) {
    v += dpp_shr(v, 0.f, 1); v += dpp_shr(v, 0.f, 2); v += dpp_shr(v, 0.f, 4); v += dpp_shr(v, 0.f, 8);
    const float t0 = __int_as_float(__builtin_amdgcn_readlane(__float_as_int(v), 15)), t1 = __int_as_float(__builtin_amdgcn_readlane(__float_as_int(v), 31)), t2 = __int_as_float(__builtin_amdgcn_readlane(__float_as_int(v), 47));
    const int row = lane >> 4; const float add = row == 0 ? 0.f : (row == 1 ? t0 : (row == 2 ? t0 + t1 : (t0 + t1) + t2));
    return v + add;
}
__device__ __forceinline__ float wave_scan_max(float v, int lane) {
    const float NI = -3.0e38f;
    v = fmaxf(v, dpp_shr(v, NI, 1)); v = fmaxf(v, dpp_shr(v, NI, 2)); v = fmaxf(v, dpp_shr(v, NI, 4)); v = fmaxf(v, dpp_shr(v, NI, 8));
    const float t0 = __int_as_float(__builtin_amdgcn_readlane(__float_as_int(v), 15)), t1 = __int_as_float(__builtin_amdgcn_readlane(__float_as_int(v), 31)), t2 = __int_as_float(__builtin_amdgcn_readlane(__float_as_int(v), 47));
    const int row = lane >> 4; const float mx = row == 0 ? NI : (row == 1 ? t0 : (row == 2 ? fmaxf(t0, t1) : fmaxf(fmaxf(t0, t1), t2)));
    return fmaxf(v, mx);
}
__device__ __forceinline__ float softcap15(float z) { const float e = __expf(z * (2.0f / 15.0f)); return 15.0f * (1.0f - 2.0f * __builtin_amdgcn_rcpf(e + 1.0f)); }
__device__ __forceinline__ void mlstm_unit(const Ctx& F, int b, int h, int sl, guchar* ws, const gfloat* ibp, const gfloat* fbp, const gfloat* norm_g) {
    int tid = F.tid; LAUNDER_V(tid); const int lane = tid & 63, w = F.wave, r16 = lane & 15, q4 = lane >> 4;
    const gbf16* CQ = (const gbf16*)(ws + WS_CQ) + h * 256; const gbf16* CK = (const gbf16*)(ws + WS_CK) + h * 256; const gbf16* CV = (const gbf16*)(ws + WS_CV) + h * 512 + sl * 32;
    const gbf16* CO = (const gbf16*)(ws + WS_CO) + h * 512 + sl * 32; const gbf16* CZ = (const gbf16*)(ws + WS_CZ) + h * 512 + sl * 32;
    const gfloat* IFB = (const gfloat*)(ws + WS_IF);
    gbf16* NUM = (gbf16*)(ws + WS_NUM) + h * 512 + sl * 32; gfloat* SSQC = (gfloat*)(ws + WS_SSQC); gfloat* DNB = (gfloat*)(ws + WS_DN);
    const int rowb = b * SEQ;
    const bf16x8 ones = frag_const(0x3f803f80u), zeros = frag_const(0u);
    for (int i = tid; i < 33 * ML_RS / 16; i += NTHREADS) *(LAS u32x4*)(F.lds + ML_CT + i * 16) = (u32x4){0u, 0u, 0u, 0u};
    f32x4 st[2][3];
#pragma unroll
    for (int i = 0; i < 2; ++i)
#pragma unroll
        for (int dt = 0; dt < 3; ++dt) st[i][dt] = (f32x4){0.f, 0.f, 0.f, 0.f};
    float m_prev = 0.f;
    const float ibv = ibp[h], fbv = fbp[h];
    const f32x4 ng0 = *(const gf32x4*)(norm_g + h * 512 + sl * 32 + 4 * q4), ng1 = *(const gf32x4*)(norm_g + h * 512 + sl * 32 + 16 + 4 * q4);
    u32x4 qreg[4], kreg[4], vreg; float gi = 0.f, gf = 0.f;
#define ML_LOAD(c) do { const int rc_ = rowb + (c) * 64; _Pragma("unroll") for (int k_ = 0; k_ < 4; ++k_) { const int it_ = tid + 512 * k_, s_ = it_ >> 5, ch_ = it_ & 31; \
        qreg[k_] = *(const gu32x4*)(CQ + (size_t)(rc_ + s_) * 1024 + 8 * ch_); kreg[k_] = *(const gu32x4*)(CK + (size_t)(rc_ + s_) * 1024 + 8 * ch_); } \
        if (tid < 256) vreg = *(const gu32x4*)(CV + (size_t)(rc_ + (tid >> 2)) * BW + 8 * (tid & 3)); } while (0)
#define ML_GLOAD(c) do { if (w == 7) { const int r_ = rowb + (c) * 64 + lane; gi = IFB[(size_t)r_ * 8 + h]; gf = IFB[(size_t)r_ * 8 + 4 + h]; } } while (0)
#define ML_GPREP(par) do { if (w == 7) { const float ig_ = softcap15(gi + ibv); const float z_ = softcap15(gf + fbv); \
        const float lf_ = -(fmaxf(-z_, 0.f) + log1pf(__expf(-fabsf(z_)))); const float bc_ = wave_scan_add(lf_, lane); const float u_ = ig_ - bc_; const float pm_ = wave_scan_max(u_, lane); \
        const float Mv_ = fmaxf(m_prev, pm_); const float M63_ = __int_as_float(__builtin_amdgcn_readlane(__float_as_int(Mv_), 63)); const float g_ = __int_as_float(__builtin_amdgcn_readlane(__float_as_int(bc_), 63)); \
        LAS float* gp_ = (LAS float*)(F.lds + ML_GATE + (par) * ML_GSZ); gp_[lane] = u_; gp_[64 + lane] = Mv_; gp_[128 + lane] = __expf(m_prev - Mv_); gp_[192 + lane] = __expf(-(bc_ + Mv_)); \
        gp_[256 + lane] = __expf(u_ - M63_); if (lane == 0) gp_[320] = __expf(m_prev - M63_); m_prev = g_ + M63_; } } while (0)
#define ML_WRITE(kb_, vw_, gpn_) do { _Pragma("unroll") for (int k_ = 0; k_ < 4; ++k_) { const int it_ = tid + 512 * k_, s_ = it_ >> 5, ch_ = it_ & 31; \
        *(LAS u32x4*)(F.lds + ML_QL + s_ * ML_RS + ch_ * 16) = qreg[k_]; *(LAS u32x4*)(F.lds + (kb_) + s_ * ML_RS + ch_ * 16) = kreg[k_]; } \
        if (tid < 256) { const int s_ = tid >> 2, ch_ = tid & 3; const unsigned e_[4] = {vreg.x, vreg.y, vreg.z, vreg.w}; const float ws_ = (gpn_)[256 + s_]; \
            _Pragma("unroll") for (int i_ = 0; i_ < 8; ++i_) { const unsigned hv_ = (e_[i_ >> 1] >> ((i_ & 1) * 16)) & 0xffffu; \
                *(LAS bf16_t*)(F.lds + ML_VT + (8 * ch_ + i_) * ML_TS + 2 * s_) = (bf16_t)hv_; \
                *(LAS bf16_t*)(F.lds + (vw_) + (8 * ch_ + i_) * ML_TS + 2 * s_) = (bf16_t)(cvt_pk_bf16(__uint_as_float(hv_ << 16) * ws_, 0.f) & 0xffffu); } \
            if (ch_ == 0) *(LAS bf16_t*)(F.lds + (vw_) + 32 * ML_TS + 2 * s_) = (bf16_t)(cvt_pk_bf16(ws_, 0.f) & 0xffffu); } } while (0)
    ML_LOAD(0); ML_GLOAD(0);
    ML_GPREP(0);
    ML_GLOAD(1);
    __syncthreads();
    ML_WRITE(ML_KA, ML_VW, ((const LAS float*)(F.lds + ML_GATE)));
    __syncthreads();
    for (int c = 0; c < 32; ++c) {
        const int par = c & 1; const LAS float* gp = (const LAS float*)(F.lds + ML_GATE + par * ML_GSZ);
        const int vt = ML_VT, kb = par ? ML_KB : ML_KA, kbn = par ? ML_KA : ML_KB, vw = par ? ML_VW2 : ML_VW, vwn = par ? ML_VW : ML_VW2;
        const LAS float* gpn = (const LAS float*)(F.lds + ML_GATE + (par ^ 1) * ML_GSZ);
        const int rowc = rowb + c * 64;
        if (c + 1 < 32) { ML_LOAD(c + 1); ML_GPREP(par ^ 1); if (c + 2 < 32) ML_GLOAD(c + 2); }
        u32x2 ob0 = {0u, 0u}, ob1 = {0u, 0u}, zb0 = {0u, 0u}, zb1 = {0u, 0u};
        if (w < 4) { const size_t ro = (size_t)(rowc + 16 * w + r16) * BW + 4 * q4;
            ob0 = *(const gu32x2*)(CO + ro); ob1 = *(const gu32x2*)(CO + ro + 16); zb0 = *(const gu32x2*)(CZ + ro); zb1 = *(const gu32x2*)(CZ + ro + 16); }
        f32x4 oacc[3];
        for (int rp_ = 0; rp_ < ML_R1B; ++rp_) {
#pragma unroll
        for (int dt = 0; dt < 3; ++dt) oacc[dt] = (f32x4){0.f, 0.f, 0.f, 0.f};
        if (w < 4) {
            const int T = w;
            bf16x8 bq[8];
#pragma unroll
            for (int ks = 0; ks < 8; ++ks) bq[ks] = *(const LAS bf16x8*)(F.lds + ML_QL + (16 * T + r16) * ML_RS + ks * 64 + q4 * 16);
            f32x4 sa[4];
#pragma unroll
            for (int s4 = 0; s4 < 4; ++s4) { sa[s4] = (f32x4){0.f, 0.f, 0.f, 0.f};
                if (s4 <= T) {
#pragma unroll
                    for (int ks = 0; ks < 8; ++ks) { const bf16x8 a = *(const LAS bf16x8*)(F.lds + kb + (16 * s4 + r16) * ML_RS + ks * 64 + q4 * 16); sa[s4] = MFMA16(a, bq[ks], sa[s4]); } } }
            const int tl = 16 * T + r16; const float Mt = gp[64 + tl];
#pragma unroll
            for (int s4 = 0; s4 < 4; ++s4) { const f32x4 uu = *(const LAS f32x4*)(gp + 16 * s4 + 4 * q4);
#pragma unroll
                for (int e = 0; e < 4; ++e) { const int sl_ = 16 * s4 + 4 * q4 + e; sa[s4][e] = (sl_ <= tl) ? sa[s4][e] * __expf(uu[e] - Mt) : 0.f; } }
#pragma unroll
            for (int kk = 0; kk < 2; ++kk) { const bf16x8 pf = mk_frag(pack4(sa[2 * kk]), pack4(sa[2 * kk + 1]));
#pragma unroll
                for (int dt = 0; dt < 3; ++dt) { bf16x8 a;
                    if (dt < 2) { const LAS unsigned char* vp = F.lds + vt + (16 * dt + r16) * ML_TS + (32 * kk + 4 * q4) * 2; a = mk_frag(*(const LAS u32x2*)vp, *(const LAS u32x2*)(vp + 32)); }
                    else a = (r16 == 0) ? ones : zeros;
                    oacc[dt] = MFMA16(a, pf, oacc[dt]); } }
        } else {
            const int T = w - 4; f32x4 ia[3];
#pragma unroll
            for (int dt = 0; dt < 3; ++dt) ia[dt] = (f32x4){0.f, 0.f, 0.f, 0.f};
#pragma unroll
            for (int ks = 0; ks < 8; ++ks) { const bf16x8 bqv = *(const LAS bf16x8*)(F.lds + ML_QL + (16 * T + r16) * ML_RS + ks * 64 + q4 * 16);
#pragma unroll
                for (int dt = 0; dt < 3; ++dt) { bf16x8 a;
                    if (dt < 2) a = *(const LAS bf16x8*)(F.lds + ML_CT + (16 * dt + r16) * ML_RS + ks * 64 + q4 * 16);
                    else { a = *(const LAS bf16x8*)(F.lds + ML_CT + 32 * ML_RS + ks * 64 + q4 * 16); if (r16 != 0) a = zeros; }
                    ia[dt] = MFMA16(a, bqv, ia[dt]); } }
            const int tl = 16 * T + r16;
            *(LAS f32x4*)(F.lds + ML_X + tl * 144 + (4 * q4) * 4) = ia[0]; *(LAS f32x4*)(F.lds + ML_X + tl * 144 + (16 + 4 * q4) * 4) = ia[1];
            if (q4 == 0) *(LAS f32x4*)(F.lds + ML_X + tl * 144 + 32 * 4) = ia[2];
        }
        }
        __syncthreads();
        if (w < 4) {
            const int tl = 16 * w + r16; const float at = gp[128 + tl], en = gp[192 + tl];
            const f32x4 x0 = *(const LAS f32x4*)(F.lds + ML_X + tl * 144 + (4 * q4) * 4), x1 = *(const LAS f32x4*)(F.lds + ML_X + tl * 144 + (16 + 4 * q4) * 4);
            const float xd = *(const LAS float*)(F.lds + ML_X + tl * 144 + 32 * 4);
            const f32x4 n0 = oacc[0] + x0 * at, n1 = oacc[1] + x1 * at;
            float den = oacc[2][0] + xd * at; den = __shfl(den, r16);
            float sq = (n0[0] * n0[0] + n0[1] * n0[1]) + (n0[2] * n0[2] + n0[3] * n0[3]) + (n1[0] * n1[0] + n1[1] * n1[1]) + (n1[2] * n1[2] + n1[3] * n1[3]);
            sq += __shfl_xor(sq, 16); sq += __shfl_xor(sq, 32);
            const size_t ro = (size_t)(rowc + tl) * BW + 4 * q4;
            f32x4 t0, t1;
            t0[0] = n0[0] * ng0[0] * bf_lo(ob0.x) * bf_lo(zb0.x); t0[1] = n0[1] * ng0[1] * bf_hi(ob0.x) * bf_hi(zb0.x); t0[2] = n0[2] * ng0[2] * bf_lo(ob0.y) * bf_lo(zb0.y); t0[3] = n0[3] * ng0[3] * bf_hi(ob0.y) * bf_hi(zb0.y);
            t1[0] = n1[0] * ng1[0] * bf_lo(ob1.x) * bf_lo(zb1.x); t1[1] = n1[1] * ng1[1] * bf_hi(ob1.x) * bf_hi(zb1.x); t1[2] = n1[2] * ng1[2] * bf_lo(ob1.y) * bf_lo(zb1.y); t1[3] = n1[3] * ng1[3] * bf_hi(ob1.y) * bf_hi(zb1.y);
            *(gu32x2*)(NUM + ro) = pack4(t0); *(gu32x2*)(NUM + ro + 16) = pack4(t1);
            if (q4 == 0) { SSQC[(size_t)(rowc + tl) * 64 + h * 16 + sl] = sq; if (sl == 0) DNB[(size_t)(rowc + tl) * 4 + h] = fmaxf(fabsf(den), en); }
        }
        { const float dec = gp[320];
#pragma unroll
          for (int i = 0; i < 2; ++i)
#pragma unroll
              for (int dt = 0; dt < 3; ++dt) st[i][dt] = st[i][dt] * dec;
#pragma unroll
          for (int kk = 0; kk < 2; ++kk) { bf16x8 a[2], bv[3];
#pragma unroll
              for (int i = 0; i < 2; ++i) a[i] = tr_frag8(F.lds + kb, ML_RS, 32 * kk + 8 * q4, 32 * w + 16 * i, r16);
#pragma unroll
              for (int dt = 0; dt < 2; ++dt) bv[dt] = *(const LAS bf16x8*)(F.lds + vw + (16 * dt + r16) * ML_TS + kk * 64 + q4 * 16);
              bv[2] = *(const LAS bf16x8*)(F.lds + vw + 32 * ML_TS + kk * 64 + q4 * 16); if (r16 != 0) bv[2] = zeros;
#pragma unroll
              for (int i = 0; i < 2; ++i)
#pragma unroll
                  for (int dt = 0; dt < 3; ++dt) st[i][dt] = MFMA16(a[i], bv[dt], st[i][dt]); }
#pragma unroll
          for (int i = 0; i < 2; ++i) {
#pragma unroll
              for (int dt = 0; dt < 2; ++dt) *(LAS u32x2*)(F.lds + ML_CT + (16 * dt + r16) * ML_RS + (32 * w + 16 * i + 4 * q4) * 2) = pack4(st[i][dt]);
              if (r16 == 0) *(LAS u32x2*)(F.lds + ML_CT + 32 * ML_RS + (32 * w + 16 * i + 4 * q4) * 2) = pack4(st[i][2]); } }
        for (int rp_ = 0; rp_ < ML_RWR; ++rp_) if (c + 1 < 32) ML_WRITE(kbn, vwn, gpn);
        __syncthreads();
    }
#undef ML_LOAD
#undef ML_GLOAD
#undef ML_GPREP
#undef ML_WRITE
}

__device__ __forceinline__ void p2b_finalize(const Ctx& F, guchar* ws) {
    int lane = F.lane; LAUNDER_V(lane); const int gw = F.vcu * NWAVES + F.wave, NGW = F.G * NWAVES;
    const gbf16* NUM = (const gbf16*)(ws + WS_NUM); gbf16* YC = (gbf16*)(ws + WS_YA) + (size_t)2 * M_ROWS * BW;
    for (int m = gw; m < M_ROWS; m += NGW) {
        float s = ((const gfloat*)(ws + WS_SSQC))[(size_t)m * 64 + lane];
        s += __shfl_xor(s, 1); s += __shfl_xor(s, 2); s += __shfl_xor(s, 4); s += __shfl_xor(s, 8);
        const float dn = ((const gfloat*)(ws + WS_DN))[(size_t)m * 4 + (lane >> 4)];
        const float inv = 1.0f / dn; const float sc = inv * rsqrtf(s * (1.0f / 512.0f) * inv * inv + NORM_EPS);
#pragma unroll
        for (int it = 0; it < 4; ++it) { const float f = __shfl(sc, 16 * it); const size_t o = (size_t)m * BW + (size_t)(it * 64 + lane) * 8;
            const u32x4 nb = *(const gu32x4*)(NUM + o); u32x4 y;
            y.x = cvt_pk_bf16(bf_lo(nb.x) * f, bf_hi(nb.x) * f); y.y = cvt_pk_bf16(bf_lo(nb.y) * f, bf_hi(nb.y) * f);
            y.z = cvt_pk_bf16(bf_lo(nb.z) * f, bf_hi(nb.z) * f); y.w = cvt_pk_bf16(bf_lo(nb.w) * f, bf_hi(nb.w) * f);
            *(gu32x4*)(YC + o) = y; }
    }
}
__device__ __forceinline__ void p4b_x1(const Ctx& F, guchar* ws, const gfloat* npost) {
    int lane = F.lane; LAUNDER_V(lane); const int gw = F.vcu * NWAVES + F.wave, NGW = F.G * NWAVES;
    const gbf16* OUT = (const gbf16*)(ws + WS_OUT); const gbf16* XB = (const gbf16*)(ws + WS_XB); gbf16* X1B = (gbf16*)(ws + WS_X1B);
    for (int m = gw; m < M_ROWS; m += NGW) {
        const float so = wave_sum(((const gfloat*)(ws + WS_OUTP))[(size_t)m * 64 + lane]), se = wave_sum(((const gfloat*)(ws + WS_ERP))[(size_t)m * 64 + lane]);
        const float rso = rsqrtf(so * (1.0f / DM) + NORM_EPS), rse = rsqrtf(se * (1.0f / DM) + NORM_EPS);
        if (lane == 0) { ((gfloat*)(ws + WS_RSO))[m] = rso; ((gfloat*)(ws + WS_RSE))[m] = rse; }
#pragma unroll
        for (int it = 0; it < 8; ++it) { const int c = (it * 64 + lane) * 8; const size_t o = (size_t)m * DM + c;
            const u32x4 xb = *(const gu32x4*)(XB + o), ob = *(const gu32x4*)(OUT + o); const f32x4 n0 = *(const gf32x4*)(npost + c), n1 = *(const gf32x4*)(npost + c + 4); u32x4 y;
            y.x = cvt_pk_bf16(bf_lo(xb.x) + bf_lo(ob.x) * rso * n0[0], bf_hi(xb.x) + bf_hi(ob.x) * rso * n0[1]);
            y.y = cvt_pk_bf16(bf_lo(xb.y) + bf_lo(ob.y) * rso * n0[2], bf_hi(xb.y) + bf_hi(ob.y) * rso * n0[3]);
            y.z = cvt_pk_bf16(bf_lo(xb.z) + bf_lo(ob.z) * rso * n1[0], bf_hi(xb.z) + bf_hi(ob.z) * rso * n1[1]);
            y.w = cvt_pk_bf16(bf_lo(xb.w) + bf_lo(ob.w) * rso * n1[2], bf_hi(xb.w) + bf_hi(ob.w) * rso * n1[3]);
            *(gu32x4*)(X1B + o) = y; }
    }
}

#ifndef REP_P0
#define REP_P0 1
#endif
#ifndef REP_P1
#define REP_P1 1
#endif
#ifndef REP_ML
#define REP_ML 1
#endif
#ifndef REP_SW
#define REP_SW 1
#endif
#ifndef REP_GM
#define REP_GM 1
#endif
#ifndef REP_P3
#define REP_P3 1
#endif
#ifndef REP_THIN
#define REP_THIN 1
#endif
#ifndef REP_BAR
#define REP_BAR 1
#endif
#ifndef REP_P4
#define REP_P4 1
#endif
__device__ __forceinline__ unsigned long long arg_ld(LAS unsigned char* lds, int i) {
    unsigned a = (unsigned)(ARGS_OFF + 8 * i); asm volatile("" : "+v"(a));
    const volatile LAS unsigned* q = (const volatile LAS unsigned*)(lds + a);
    const unsigned lo = q[0], hi = q[1];
    return ((unsigned long long)(unsigned)__builtin_amdgcn_readfirstlane((int)hi) << 32) | (unsigned)__builtin_amdgcn_readfirstlane((int)lo);
}
struct Args { const void* in[19]; float* out; unsigned char* ws; };
static_assert(sizeof(Args) == 21 * 8, "no padding in Args");

__global__ void __launch_bounds__(NTHREADS, 2) fwd_kernel(Args args) {
    extern __shared__ __attribute__((aligned(16))) unsigned char lds_raw[];
    Ctx F; F.lds = (LAS unsigned char*)lds_raw; F.tid = threadIdx.x; F.lane = F.tid & 63; F.wave = __builtin_amdgcn_readfirstlane(F.tid >> 6);
    F.G = gridDim.x; F.bx = blockIdx.x; { const int bx = blockIdx.x; F.vcu = (F.G % 8 == 0) ? (bx % 8) * (F.G / 8) + bx / 8 : bx; }
    guchar* ws0 = (guchar*)args.ws;
#define WSL() ({ guchar* w_ = ws0; LAUNDER_S(w_); w_; })
    volatile LAS unsigned* MISC = (volatile LAS unsigned*)(F.lds + MISC_OFF);
    if (F.tid < 32) MISC[F.tid] = 0u;
    __syncthreads();
    const XcdBarrier bar = xcd_barrier_post((unsigned*)(ws0 + WS_CTL) + CW_BAR, MISC);

    if (F.tid < 19) ((LAS unsigned long long*)(F.lds + ARGS_OFF))[F.tid] = (unsigned long long)args.in[F.tid];
    if (F.tid == 19) ((LAS unsigned long long*)(F.lds + ARGS_OFF))[19] = (unsigned long long)args.out;
    __syncthreads();
#define ARGP(T, i) ((T)arg_ld(F.lds, (i)))

#define FL() ({ Ctx f_ = F; LAUNDER_S(f_.lds); LAUNDER_S(f_.wave); LAUNDER_S(f_.vcu); LAUNDER_S(f_.G); LAUNDER_S(f_.bx); f_; })
#ifndef SKIP_P0
    for (int rep_ = 0; rep_ < REP_P0; ++rep_) { const Ctx Fp = FL(); guchar* ws = WSL(); p0_prologue(FL(), ARGP(const gfloat*, 0), ARGP(const gfloat*, 1), ARGP(const gint*, 2), ARGP(const gfloat*, 3), ARGP(const gfloat*, 4), ARGP(const gfloat*, 13), ARGP(const gfloat*, 14), ARGP(const gfloat*, 18), ARGP(const gfloat*, 16), ws); }
#endif
    for (int rb_ = 0; rb_ < REP_BAR; ++rb_) xcd_barrier(bar);

    for (int l = 0; l < NLAYER; ++l) {
        const gfloat* xin = l == 0 ? ARGP(const gfloat*, 0) : (const gfloat*)ARGP(gfloat*, 19);
#ifndef SKIP_P1
        for (int rep_ = 0; rep_ < REP_P1; ++rep_) { const Ctx Fp = FL(); guchar* ws = WSL(); const gfloat* ssq = l == 0 ? (const gfloat*)(ws + WS_SSQ0) : (const gfloat*)(ws + WS_CTL + CTL_SSQ1); pg8::SchedPlain S; S.T.init(M_ROWS / 256, NT_IN, Fp.G, Fp.bx); S.A = (const gchar*)(ws + WS_XB); S.B = (const gchar*)(ws + WS_WIN + (size_t)l * SZ_WIN);
          S.astep = (size_t)256 * DM * 2; S.bstep = (size_t)256 * DM * 2;
          pg8::EpiIn E{ssq, ws};
          pg8::gemm_phase<pg8::EpiIn, pg8::SchedPlain>(FL().lds, DM, DM, DM, S, E); }
#ifdef PROBE_P1CHEAP
        { const Ctx Fp = FL(); guchar* ws = WSL(); pg8::SchedPlain S; S.T.init(M_ROWS / 256, NT_IN, Fp.G, Fp.bx); S.A = (const gchar*)(ws + WS_XB); S.B = (const gchar*)(ws + WS_WIN + (size_t)l * SZ_WIN);
          S.astep = (size_t)256 * DM * 2; S.bstep = (size_t)256 * DM * 2;
          pg8::EpiSq E{(gbf16*)(ws + WS_END), (gfloat*)(ws + WS_END + (size_t)M_ROWS * 31488 * 2)};
          pg8::gemm_phase<pg8::EpiSq, pg8::SchedPlain>(FL().lds, DM, DM, DM, S, E); }
#endif
        { const Ctx Fq = FL(); const int nwg_ = (M_ROWS / 256) * NT_IN, rem_ = nwg_ % Fq.G;
          if (rem_ == 0 || Fq.bx >= rem_) { const int me = rem_ ? Fq.bx - rem_ : Fq.bx, nw = rem_ ? Fq.G - rem_ : Fq.G;
            { const Ctx Fp = FL(); guchar* ws = WSL(); pg8::SchedPlain S; S.T.init(M_ROWS / 256, DM / 256, nw, me); S.A = (const gchar*)(ws + WS_PB + (size_t)l * M_ROWS * 256 * 2); S.B = (const gchar*)(ws + WS_WPP + (size_t)l * SZ_WPP);
              S.astep = (size_t)256 * 256 * 2; S.bstep = (size_t)256 * 256 * 2;
              pg8::EpiSq E{(gbf16*)(ws + WS_ERAW), (gfloat*)(ws + WS_ERP)};
              pg8::gemm_phase<pg8::EpiSq, pg8::SchedPlain>(FL().lds, 256, 256, 256, S, E); }
            if (l == 0) tr_run(FL(), TR_DEFER0, TR_DEFER1, 0x7fffffff, 0x7fffffff, me, nw, ARGP(const gfloat*, 4), ARGP(const gfloat*, 3), ARGP(const gfloat*, 13), ARGP(const gfloat*, 14), ARGP(const gfloat*, 18), ARGP(const gfloat*, 16), WSL()); } }
#endif
        for (int rb_ = 0; rb_ < REP_BAR; ++rb_) xcd_barrier(bar);
#ifndef SKIP_ML
        for (int rep_ = 0; rep_ < REP_ML; ++rep_) { const Ctx Fp = FL(); guchar* ws = WSL(); for (int u = Fp.vcu; u < 256; u += Fp.G) mlstm_unit(Fp, u >> 6, (u >> 4) & 3, u & 15, ws, ARGP(const gfloat*, 10) + l * 4, ARGP(const gfloat*, 11) + l * 4, ARGP(const gfloat*, 12) + l * BW); }
#endif
#ifndef SKIP_SW
        for (int rep_ = 0; rep_ < REP_SW; ++rep_) { const Ctx Fp = FL(); guchar* ws = WSL(); for (int u = Fp.vcu; u < 256; u += Fp.G) swa_unit(Fp, u >> 6, (u >> 2) & 15, u & 3, ws, ARGP(const gfloat*, 9) + l * 32); }
#endif
#ifndef SKIP_GM
        for (int rep_ = 0; rep_ < REP_GM; ++rep_) { const Ctx Fp = FL(); guchar* ws = WSL(); for (int u = Fp.vcu; u < 512; u += Fp.G) gmlp_unit(Fp, u >> 7, (u >> 3) & 15, u & 7, ws, ARGP(const gfloat*, 5) + l * BW, ARGP(const gfloat*, 6) + l * BW, ARGP(const gfloat*, 7) + (size_t)l * 8 * 128 * 128, ARGP(const gfloat*, 8) + l * 8 * 128); }
#endif
        for (int rb_ = 0; rb_ < REP_BAR; ++rb_) xcd_barrier(bar);
#ifndef SKIP_P2B
        for (int rep_ = 0; rep_ < REP_THIN; ++rep_) p2b_finalize(FL(), WSL());
#endif
        for (int rb_ = 0; rb_ < REP_BAR; ++rb_) xcd_barrier(bar);
#ifndef PROBE_NOSTORE
#define PROBE_NOSTORE 0
#endif
#ifdef PROBE_K1024
        for (int rep_ = 0; rep_ < 4; ++rep_) { const Ctx Fp = FL(); guchar* ws = WSL(); pg8::SchedPlain S; S.T.init(M_ROWS / 256, DM / 256, Fp.G, Fp.bx); S.A = (const gchar*)(ws + WS_YA); S.B = (const gchar*)(ws + WS_WOUT + (size_t)l * SZ_WSQ);
          S.astep = (size_t)256 * DM * 2; S.bstep = (size_t)256 * DM * 2;
          pg8::EpiSq E{PROBE_NOSTORE ? (gbf16*)nullptr : (gbf16*)(ws + WS_END), (gfloat*)(ws + WS_END + (size_t)M_ROWS * 31488 * 2)};
          pg8::gemm_phase<pg8::EpiSq, pg8::SchedPlain>(FL().lds, 1024, DM, DM, S, E); }
#endif
#ifdef PROBE_P3CHEAP
        { const Ctx Fp = FL(); guchar* ws = WSL(); pg8::SchedBranch S; S.T.init(M_ROWS / 256, DM / 256, Fp.G, Fp.bx); S.A = (const gchar*)(ws + WS_YA); S.B = (const gchar*)(ws + WS_WBR + (size_t)l * SZ_WBR);
          S.astep = (size_t)256 * BW * 2; S.bstep = (size_t)256 * BW * 2; S.aseg = SZ_ROWS_BW; S.bseg = (size_t)DM * BW * 2;
          pg8::EpiSq E{(gbf16*)(ws + WS_END), (gfloat*)(ws + WS_END + (size_t)M_ROWS * 31488 * 2)};
          pg8::gemm_phase<pg8::EpiSq, pg8::SchedBranch>(FL().lds, BW, BW, BW, S, E); }
#endif
#ifndef SKIP_P3
        for (int rep_ = 0; rep_ < REP_P3; ++rep_) { const Ctx Fp = FL(); guchar* ws = WSL(); pg8::SchedBranch S; S.T.init(M_ROWS / 256, DM / 256, Fp.G, Fp.bx); S.A = (const gchar*)(ws + WS_YA); S.B = (const gchar*)(ws + WS_WBR + (size_t)l * SZ_WBR);
          S.astep = (size_t)256 * BW * 2; S.bstep = (size_t)256 * BW * 2; S.aseg = SZ_ROWS_BW; S.bseg = (size_t)DM * BW * 2;
          pg8::EpiBranch E{(const gbf16*)(ws + WS_G), (gbf16*)(ws + WS_MIX)};
          pg8::gemm_phase<pg8::EpiBranch, pg8::SchedBranch>(FL().lds, BW, BW, BW, S, E); }
#endif
        for (int rb_ = 0; rb_ < REP_BAR; ++rb_) xcd_barrier(bar);
#ifndef SKIP_P4
        for (int rep_ = 0; rep_ < REP_P4; ++rep_) { const Ctx Fp = FL(); guchar* ws = WSL(); pg8::SchedPlain S; S.T.init(M_ROWS / 256, DM / 256, Fp.G, Fp.bx); S.A = (const gchar*)(ws + WS_MIX); S.B = (const gchar*)(ws + WS_WOUT + (size_t)l * SZ_WSQ);
          S.astep = (size_t)256 * DM * 2; S.bstep = (size_t)256 * DM * 2;
          pg8::EpiSq E{(gbf16*)(ws + WS_OUT), (gfloat*)(ws + WS_OUTP)};
          pg8::gemm_phase<pg8::EpiSq, pg8::SchedPlain>(FL().lds, DM, DM, DM, S, E); }
#endif
        for (int rb_ = 0; rb_ < REP_BAR; ++rb_) xcd_barrier(bar);
#ifndef SKIP_P4B
        for (int rep_ = 0; rep_ < REP_THIN; ++rep_) p4b_x1(FL(), WSL(), ARGP(const gfloat*, 15) + l * DM);
#endif
        for (int rb_ = 0; rb_ < REP_BAR; ++rb_) xcd_barrier(bar);
#ifndef SKIP_P5
        { const Ctx Fp = FL(); guchar* ws = WSL(); pg8::SchedPlain S; S.T.init(M_ROWS / 256, DM / 256, Fp.G, Fp.bx); S.A = (const gchar*)(ws + WS_X1B); S.B = (const gchar*)(ws + WS_WPG + (size_t)l * SZ_WSQ);
          S.astep = (size_t)256 * DM * 2; S.bstep = (size_t)256 * DM * 2;
          pg8::EpiPle E{xin, ARGP(gfloat*, 19), (gbf16*)(ws + WS_XB), (const gbf16*)(ws + WS_OUT), (const gbf16*)(ws + WS_ERAW), (const gfloat*)(ws + WS_RSO), (const gfloat*)(ws + WS_RSE),
                        ARGP(const gfloat*, 15) + l * DM, ARGP(const gfloat*, 17) + l * DM, (gfloat*)(ws + WS_CTL + CTL_SSQ1), l == NLAYER - 1 ? 1 : 0};
          pg8::gemm_phase<pg8::EpiPle, pg8::SchedPlain>(FL().lds, DM, DM, DM, S, E); }
#endif
        if (l + 1 < NLAYER) for (int rb_ = 0; rb_ < REP_BAR; ++rb_) xcd_barrier(bar);
    }
}

extern "C" void kernel_launch(void* const* d_in, const int* in_sizes, int n_in, void* d_out, int out_size, void* d_ws, size_t ws_size, hipStream_t stream) {
    static int grid = 0;
    if (grid == 0) {
        if (n_in != 19 || out_size != M_ROWS * DM || ws_size < WS_END) { fprintf(stderr, "kernel_launch: unexpected problem (n_in %d, out %d, ws %zu, need %zu)\n", n_in, out_size, ws_size, (size_t)WS_END); grid = -1; return; }
        int dev = 0, cus = 0;
        if (hipGetDevice(&dev) != hipSuccess || hipDeviceGetAttribute(&cus, hipDeviceAttributeMultiprocessorCount, dev) != hipSuccess) { grid = -1; return; }
        if (hipFuncSetAttribute((const void*)fwd_kernel, hipFuncAttributeMaxDynamicSharedMemorySize, LDS_BYTES) != hipSuccess) { fprintf(stderr, "kernel_launch: hipFuncSetAttribute failed\n"); grid = -1; return; }
        int per_cu = 0; (void)hipOccupancyMaxActiveBlocksPerMultiprocessor(&per_cu, (const void*)fwd_kernel, NTHREADS, LDS_BYTES); (void)hipGetLastError();
        if (per_cu < 1) fprintf(stderr, "kernel_launch: occupancy query reports %d blocks per CU\n", per_cu);
        grid = cus > 256 ? 256 : cus;
    }
    if (grid < 0) return;
    (void)hipMemsetAsync((char*)d_ws + WS_CTL, 0, CTL_ZERO_BYTES, stream);
    Args a{};
    for (int i = 0; i < 19; ++i) a.in[i] = d_in[i];
    a.out = (float*)d_out; a.ws = (unsigned char*)d_ws;
    hipLaunchKernelGGL(fwd_kernel, dim3(grid), dim3(NTHREADS), LDS_BYTES, stream, a);
    const hipError_t le = hipPeekAtLastError();
    if (le != hipSuccess) fprintf(stderr, "kernel_launch: launch failed: %s\n", hipGetErrorName(le));
}
```

```cpp
#include <hip/hip_runtime.h>
#include <cstdio>
#include <cstdint>

#define LAS __attribute__((address_space(3)))
#define GAS __attribute__((address_space(1)))
typedef unsigned short bf16_t;
typedef short bf16x8 __attribute__((ext_vector_type(8)));
typedef float f32x4 __attribute__((ext_vector_type(4)));
typedef float f32x2 __attribute__((ext_vector_type(2)));
typedef unsigned u32x4 __attribute__((ext_vector_type(4)));
typedef unsigned u32x2 __attribute__((ext_vector_type(2)));

typedef GAS float gfloat; typedef GAS bf16_t gbf16; typedef GAS int gint; typedef GAS char gchar; typedef GAS unsigned char guchar; typedef GAS unsigned gunsigned;
typedef GAS f32x4 gf32x4; typedef GAS f32x2 gf32x2; typedef GAS u32x4 gu32x4; typedef GAS u32x2 gu32x2;
constexpr int M_ROWS = 8192, SEQ = 2048, DM = 4096, BW = 2048, NLAYER = 2;
constexpr int N_IN = 31240, IF_COL = 14848;
constexpr int NT_IN = 123;
constexpr int N_IN_T = NT_IN * 256;
constexpr float NORM_EPS = 1e-6f;

__device__ __forceinline__ unsigned cvt_pk_bf16(float lo, float hi) { unsigned r; asm("v_cvt_pk_bf16_f32 %0, %1, %2" : "=v"(r) : "v"(lo), "v"(hi)); return r; }
__device__ __forceinline__ float bf_lo(unsigned w) { return __uint_as_float(w << 16); }
__device__ __forceinline__ float bf_hi(unsigned w) { return __uint_as_float(w & 0xffff0000u); }
__device__ __forceinline__ float bf1(bf16_t b) { return __uint_as_float(((unsigned)b) << 16); }
__device__ __forceinline__ float fsigmoid(float x) { return __builtin_amdgcn_rcpf(1.0f + __expf(-x)); }
__device__ __forceinline__ float wave_sum(float v) {
#pragma unroll
    for (int o = 1; o < 64; o <<= 1) v += __shfl_xor(v, o);
    return v;
}
__device__ __forceinline__ f32x2 gelu_pk(f32x2 v) {
    const f32x2 av = __builtin_elementwise_abs(v), d = av * 0.2316418882f + 1.0f;
    f32x2 t; t.x = __builtin_amdgcn_rcpf(d.x); t.y = __builtin_amdgcn_rcpf(d.y);
    f32x2 q = t * 0.5307027145f + (-0.7265760135f); q = q * t + 0.7107068705f; q = q * t + (-0.142248368f); q = q * t + 0.127414796f; q = q * t;
    const f32x2 s = (v * v) * (-0.72134752044f);
    f32x2 e; e.x = __builtin_amdgcn_exp2f(s.x); e.y = __builtin_amdgcn_exp2f(s.y);
    const f32x2 m = v * (q * e), r = v - m;
    f32x2 o; o.x = v.x < 0.f ? m.x : r.x; o.y = v.y < 0.f ? m.y : r.y; return o;
}
#define LAUNDER_V(x) asm volatile("" : "+v"(x))
#define LAUNDER_S(x) asm volatile("" : "+s"(x))
#define LDS_WAIT() asm volatile("s_waitcnt lgkmcnt(0)" ::: "memory")
#define VM_WAIT() asm volatile("s_waitcnt vmcnt(0)" ::: "memory")
#define MFMA16(a, b, c) __builtin_amdgcn_mfma_f32_16x16x32_bf16((a), (b), (c), 0, 0, 0)

#define XB_TMO      128
#define XB_XCNT(j)  (256  + 64 * (j))
#define XB_XSUB(j)  (1280 + 64 * (j))
#define XB_XGEN(j)  (2304 + 64 * (j))
#define XB_TOP      3328
#define XB_TOPGEN   3392
#define XCD_BAR_WORDS 3456
#define XB_SPIN_CAP (1u << 18)
__device__ __forceinline__ unsigned xb_ld(unsigned* p)              { return __hip_atomic_load(p, __ATOMIC_RELAXED, __HIP_MEMORY_SCOPE_AGENT); }
__device__ __forceinline__ unsigned xb_add(unsigned* p, unsigned v) { return __hip_atomic_fetch_add(p, v, __ATOMIC_RELAXED, __HIP_MEMORY_SCOPE_AGENT); }
__device__ __forceinline__ unsigned xb_xcc_id() { return (unsigned)__builtin_amdgcn_s_getreg((3 << 11) | 20) & 0xFu; }
#define XB_SPIN(cond, bar) do { unsigned _sp = 0; while (cond) { __builtin_amdgcn_s_sleep(1); \
    if ((++_sp & 255u) == 0u) { if (xb_ld(&(bar)[XB_TMO])) break; if (_sp > XB_SPIN_CAP) { atomicAdd(&(bar)[XB_TMO], 1u); break; } } } } while (0)
struct XcdBarrier { unsigned* bar; unsigned x; volatile LAS unsigned* st; };
__device__ __forceinline__ XcdBarrier xcd_barrier_post(unsigned* bar, volatile LAS unsigned* st) {
    XcdBarrier b; b.bar = bar; b.x = xb_xcc_id(); b.st = st;
    if (threadIdx.x == 0) (void)xb_add(&bar[XB_XCNT(b.x)], 1u);
    return b;
}
__device__ __forceinline__ void xcd_barrier_complete(unsigned* bar, unsigned x, unsigned& nloc, unsigned& nx) {
    const unsigned G = gridDim.x * gridDim.y * gridDim.z;
    unsigned sum, cnt, mine, sp = 0u;
    for (;;) {
        sum = 0u; cnt = 0u; mine = 0u;
#pragma unroll
        for (unsigned j = 0; j < 16; ++j) { const unsigned c = xb_ld(&bar[XB_XCNT(j)]); sum += c; cnt += (c > 0u) ? 1u : 0u; mine = (j == x) ? c : mine; }
        if (sum == G) break;
        __builtin_amdgcn_s_sleep(1);
        if ((++sp & 255u) == 0u) { if (xb_ld(&bar[XB_TMO])) break; if (sp > XB_SPIN_CAP) { atomicAdd(&bar[XB_TMO], 1u); break; } }
    }
    nloc = mine > 0u ? mine : 1u; nx = cnt > 0u ? cnt : 1u;
}
__device__ __forceinline__ void xcd_barrier(const XcdBarrier& b) {
    asm volatile("s_waitcnt vmcnt(0)" ::: "memory");
    __syncthreads();
    if (threadIdx.x == 0) {
        unsigned* bar = b.bar;
        __builtin_amdgcn_s_waitcnt(0);
        unsigned nloc = b.st[0], nx = b.st[1];
        if (nloc == 0u) { xcd_barrier_complete(bar, b.x, nloc, nx); b.st[0] = nloc; b.st[1] = nx; }
        const unsigned old = xb_add(&bar[XB_XSUB(b.x)], 1u);
        const unsigned gen = old / nloc;
        if (old + 1u == (gen + 1u) * nloc) {
            __builtin_amdgcn_fence(__ATOMIC_RELEASE, "agent");
            asm volatile("s_waitcnt vmcnt(0)" ::: "memory");
            const unsigned og = xb_add(&bar[XB_TOP], 1u);
            const unsigned tg = og / nx;
            if (og + 1u == (tg + 1u) * nx) xb_add(&bar[XB_TOPGEN], 1u);
            else XB_SPIN(xb_ld(&bar[XB_TOPGEN]) == tg, bar);
            __builtin_amdgcn_fence(__ATOMIC_ACQUIRE, "agent");
            xb_add(&bar[XB_XGEN(b.x)], 1u);
            asm volatile("s_waitcnt vmcnt(0)" ::: "memory");
        } else {
            XB_SPIN(xb_ld(&bar[XB_XGEN(b.x)]) == gen, bar);
            __builtin_amdgcn_fence(__ATOMIC_ACQUIRE, "agent");
            asm volatile("s_waitcnt vmcnt(0)" ::: "memory");
        }
    }
    __syncthreads();
}
#define EPIIN_NS 0
#define EPI_NS16 0
#define EPI_NS32 0

namespace pg8 {
constexpr int BM = 256, BK = 64, HALF = 128, HTB = HALF * BK * 2, STAGE_BYTES = 8 * HTB, NXCD = 8, WGM = 8;
__host__ __device__ __forceinline__ int lds_byte(int r, int c) { const int st = (r >> 4) * 2 + (c >> 5), rr = r & 15, cc = c & 31, ob = rr * 64 + cc * 2; return st * 1024 + (ob ^ (((ob >> 9) & 1) << 5)); }
__host__ __device__ __forceinline__ void stage_rc(int b, int& R, int& C) { const int st = b / 1024, sb = b % 1024, swz = sb ^ (((sb >> 9) & 1) << 5); R = (st >> 1) * 16 + swz / 64; C = (st & 1) * 32 + (swz % 64) / 2; }
__host__ __device__ __forceinline__ int perm32(int rho) { const int n = rho >> 4, i = rho & 15; return 8 * (i >> 2) + 4 * n + (i & 3); }

struct Unit { int pm, pn, seg; };

struct TileOrder {
    int nM, nN, nwg, G, c;
    __device__ __forceinline__ void init(int nM_, int nN_, int G_, int c_) { nM = nM_; nN = nN_; nwg = nM * nN; G = G_; c = c_; }
    __device__ __forceinline__ bool tile(int i, int& pm, int& pn) const {
        const long L = (long)i * G + c; if (L >= nwg) return false;
        int wgid = (int)L; { const int q = nwg / NXCD, r = nwg % NXCD, xcd = wgid % NXCD, off = wgid / NXCD; wgid = (xcd < r ? xcd * (q + 1) : r * (q + 1) + (xcd - r) * q) + off; }
        const int nig = WGM * nN, gid = wgid / nig, fm = gid * WGM, gsz = (nM - fm) < WGM ? (nM - fm) : WGM;
        pm = fm + ((wgid % nig) % gsz); pn = (wgid % nig) / gsz; return true;
    }
};
struct SchedPlain {
    TileOrder T; const gchar* A; const gchar* B; size_t astep, bstep;
    __device__ __forceinline__ bool next(int i, Unit& u) const { u.seg = 0; return T.tile(i, u.pm, u.pn); }
    __device__ __forceinline__ const gchar* a_ptr(const Unit& u) const { return A + (size_t)u.pm * astep; }
    __device__ __forceinline__ const gchar* b_ptr(const Unit& u) const { return B + (size_t)u.pn * bstep; }
};
struct SchedBranch {
    TileOrder T; const gchar* A; const gchar* B; size_t astep, bstep, aseg, bseg;
    __device__ __forceinline__ bool next(int i, Unit& u) const { const int t = i / 3; u.seg = i - 3 * t; return T.tile(t, u.pm, u.pn); }
    __device__ __forceinline__ const gchar* a_ptr(const Unit& u) const { return A + (size_t)u.seg * aseg + (size_t)u.pm * astep; }
    __device__ __forceinline__ const gchar* b_ptr(const Unit& u) const { return B + (size_t)u.seg * bseg + (size_t)u.pn * bstep; }
};

template <class Epi, class Sched>
__device__ __forceinline__ void gemm_phase(LAS unsigned char* lds, const int K, const int lda, const int ldb, const Sched& S, const Epi& E) {
    int tid = threadIdx.x; LAUNDER_V(tid);
    const int wid = __builtin_amdgcn_readfirstlane(tid >> 6), lane = tid & 63, wr = wid >> 2, wc = wid & 3, fr = lane & 15, fq = lane >> 4;
    const int nt = K / BK;
    unsigned voffA, voffB;
    { int R, C; stage_rc(tid * 16, R, C); const int Rb = Epi::PERM ? ((R & ~31) + perm32(R & 31)) : R;
      voffA = (unsigned)(R * lda + C) * 2u; voffB = (unsigned)(Rb * ldb + C) * 2u; }
    const unsigned qstepA = 64u * (unsigned)lda * 2u, qstepB = 64u * (unsigned)ldb * 2u;
    const size_t kstep = (size_t)(BK * 2);
    const size_t hstepA = (size_t)HALF * lda * 2, hstepB = (size_t)HALF * ldb * 2;
    const unsigned ldsw = (unsigned)wid * 1024u;
    const int aoff = lds_byte(wr * 64 + fr, fq * 8), boff = lds_byte(wc * 32 + fr, fq * 8);
#define PG8_SA(b, h) (((b) * 2 + (h)) * HTB)
#define PG8_SB(b, h) ((4 + (b) * 2 + (h)) * HTB)
#define PG8_STAGE(bufoff, gbase, voff) do { _Pragma("unroll") for (int _i = 0; _i < 2; ++_i) \
        __builtin_amdgcn_global_load_lds((const gunsigned*)((const gchar*)(gbase) + (size_t)_i * q##voff + (voff)), (LAS unsigned*)(lds + (bufoff) + ldsw + _i * 8192), 16, 0, 0); } while (0)
#define qvoffA qstepA
#define qvoffB qstepB
#define PG8_LDA(dst, b, h) do { _Pragma("unroll") for (int m = 0; m < 4; ++m) _Pragma("unroll") for (int k = 0; k < 2; ++k) dst[m][k] = *(const LAS bf16x8*)(lds + PG8_SA(b, h) + aoff + m * 2048 + k * 1024); } while (0)
#define PG8_LDB(dst, b, h) do { _Pragma("unroll") for (int n = 0; n < 2; ++n) _Pragma("unroll") for (int k = 0; k < 2; ++k) dst[n][k] = *(const LAS bf16x8*)(lds + PG8_SB(b, h) + boff + n * 2048 + k * 1024); } while (0)
#define PG8_MMA(ai, bj, At, Bt) do { __builtin_amdgcn_s_setprio(1); _Pragma("unroll") for (int m = 0; m < 4; ++m) _Pragma("unroll") for (int n = 0; n < 2; ++n) _Pragma("unroll") for (int k = 0; k < 2; ++k) \
        acc[ai][bj][m][n] = __builtin_amdgcn_mfma_f32_16x16x32_bf16(Bt[n][k], At[m][k], acc[ai][bj][m][n], 0, 0, 0); __builtin_amdgcn_s_setprio(0); } while (0)
#define PG8_WAIT_V(n) asm volatile("s_waitcnt vmcnt(" #n ")" ::: "memory")
#define PG8_WAIT_VR() do { if constexpr (Epi::NS == 16) asm volatile("s_waitcnt vmcnt(24)" ::: "memory"); else if constexpr (Epi::NS == 32) asm volatile("s_waitcnt vmcnt(40)" ::: "memory"); else asm volatile("s_waitcnt vmcnt(8)" ::: "memory"); } while (0)
#define PG8_WAIT_L(n) asm volatile("s_waitcnt lgkmcnt(" #n ")" ::: "memory")
#define PG8_BAR __builtin_amdgcn_s_barrier()
#define PG8_SCHED __builtin_amdgcn_sched_barrier(0)
    Unit cur, nxt; int ui = 0; bool relax_next = false;
    if (!S.next(0, cur)) return;
    f32x4 acc[2][2][4][2];
#pragma unroll
    for (int a = 0; a < 2; ++a)
#pragma unroll
        for (int b = 0; b < 2; ++b)
#pragma unroll
            for (int m = 0; m < 4; ++m)
#pragma unroll
                for (int n = 0; n < 2; ++n) acc[a][b][m][n] = (f32x4){0.f, 0.f, 0.f, 0.f};
    bf16x8 At[4][2], B0[2][2], B1[2][2];
    const gchar* cA = S.a_ptr(cur); const gchar* cB = S.b_ptr(cur);
    PG8_STAGE(PG8_SB(0, 0), cB, voffB); PG8_STAGE(PG8_SB(0, 1), cB + hstepB, voffB); PG8_STAGE(PG8_SA(0, 0), cA, voffA); PG8_STAGE(PG8_SA(0, 1), cA + hstepA, voffA);
    if (wr == 1) PG8_BAR;
    PG8_WAIT_V(2); PG8_BAR;
    PG8_STAGE(PG8_SB(1, 0), cB + kstep, voffB); PG8_STAGE(PG8_SA(1, 0), cA + kstep, voffA); PG8_STAGE(PG8_SB(1, 1), cB + hstepB + kstep, voffB);
    PG8_WAIT_V(6); PG8_BAR;
    for (;;) {
        const bool has_next = S.next(ui + 1, nxt);
        const gchar* nA = has_next ? S.a_ptr(nxt) : cA; const gchar* nB = has_next ? S.b_ptr(nxt) : cB;
        for (int t = 0; t < nt; t += 2) {
            const bool last = (t == nt - 2); const bool relax = Epi::NS > 0 && (t == 0) && relax_next;
            const gchar* a1 = cA + (size_t)(t + 1) * kstep;
            const gchar* a2 = last ? nA : cA + (size_t)(t + 2) * kstep; const gchar* b2 = last ? nB : cB + (size_t)(t + 2) * kstep;
            const gchar* a3 = a2 + kstep; const gchar* b3 = b2 + kstep;
            PG8_LDB(B0, 0, 0); PG8_LDB(B1, 0, 1); PG8_SCHED; PG8_LDA(At, 0, 0); PG8_STAGE(PG8_SA(1, 1), a1 + hstepA, voffA);
            if (relax) PG8_WAIT_VR(); else PG8_WAIT_V(8); PG8_WAIT_L(0); PG8_BAR; PG8_MMA(0, 0, At, B0); PG8_MMA(0, 1, At, B1); PG8_BAR; PG8_SCHED;
            PG8_LDA(At, 0, 1); PG8_STAGE(PG8_SB(0, 0), b2, voffB); PG8_STAGE(PG8_SB(0, 1), b2 + hstepB, voffB); PG8_STAGE(PG8_SA(0, 0), a2, voffA);
            if (relax) PG8_WAIT_VR(); else PG8_WAIT_V(8); PG8_WAIT_L(0); PG8_BAR; PG8_MMA(1, 0, At, B0); PG8_MMA(1, 1, At, B1); PG8_BAR; PG8_SCHED;
            PG8_LDB(B0, 1, 0); PG8_LDB(B1, 1, 1); PG8_SCHED; PG8_LDA(At, 1, 0); PG8_STAGE(PG8_SA(0, 1), a2 + hstepA, voffA);
            PG8_WAIT_V(8); PG8_WAIT_L(0); PG8_BAR; PG8_MMA(0, 0, At, B0); PG8_MMA(0, 1, At, B1); PG8_BAR; PG8_SCHED;
            PG8_LDA(At, 1, 1); PG8_STAGE(PG8_SB(1, 0), b3, voffB); PG8_STAGE(PG8_SB(1, 1), b3 + hstepB, voffB); PG8_STAGE(PG8_SA(1, 0), a3, voffA);
            PG8_WAIT_V(8); PG8_WAIT_L(0); PG8_BAR; PG8_MMA(1, 0, At, B0); PG8_MMA(1, 1, At, B1); PG8_BAR; PG8_SCHED;
        }
        if (wr == 0) PG8_BAR;
        { const int ln_ = (int)__builtin_amdgcn_mbcnt_hi(~0u, __builtin_amdgcn_mbcnt_lo(~0u, 0u)); E(acc, cur, wr, wc, ln_ & 15, ln_ >> 4); } relax_next = E.relax(cur);
        if (!has_next) break;
        if (!E.keep(cur)) {
#pragma unroll
            for (int a = 0; a < 2; ++a)
#pragma unroll
                for (int b = 0; b < 2; ++b)
#pragma unroll
                    for (int m = 0; m < 4; ++m)
#pragma unroll
                        for (int n = 0; n < 2; ++n) acc[a][b][m][n] = (f32x4){0.f, 0.f, 0.f, 0.f};
        }
        cur = nxt; cA = nA; cB = nB; ++ui;
        if (wr == 1) PG8_BAR;
    }
    PG8_WAIT_V(0);
    PG8_BAR;
#undef PG8_SA
#undef PG8_SB
#undef PG8_STAGE
#undef qvoffA
#undef qvoffB
#undef PG8_LDA
#undef PG8_LDB
#undef PG8_MMA
#undef PG8_WAIT_V
#undef PG8_WAIT_VR
#undef PG8_WAIT_L
#undef PG8_BAR
#undef PG8_SCHED
}
}

constexpr size_t MiB = 1u << 20;
constexpr size_t WS_CTL = 0, CTL_ZERO_BYTES = 1 * MiB;
constexpr int CW_BAR = 4096;
constexpr size_t CTL_SSQ1 = 256 * 1024;
constexpr size_t SZ_WIN = (size_t)N_IN_T * DM * 2, SZ_WBR = (size_t)3 * DM * BW * 2, SZ_WSQ = (size_t)DM * DM * 2, SZ_WPP = (size_t)DM * 256 * 2;
constexpr size_t WS_WIN = 2 * MiB;
constexpr size_t WS_WBR = WS_WIN + 2 * SZ_WIN;
constexpr size_t WS_WOUT = WS_WBR + 2 * SZ_WBR;
constexpr size_t WS_WPG = WS_WOUT + 2 * SZ_WSQ;
constexpr size_t WS_WPP = WS_WPG + 2 * SZ_WSQ;
constexpr size_t SZ_ROWS_BW = (size_t)M_ROWS * BW * 2, SZ_ROWS_D = (size_t)M_ROWS * DM * 2;
constexpr size_t WS_XB = WS_WPP + 2 * SZ_WPP;
constexpr size_t WS_PB = WS_XB + SZ_ROWS_D;
constexpr size_t WS_CS = WS_PB + (size_t)2 * M_ROWS * 256 * 2;
constexpr size_t WS_SSQ0 = WS_CS + (size_t)M_ROWS * 16 * 4;
constexpr size_t WS_AU = WS_SSQ0 + (size_t)M_ROWS * 4;
constexpr size_t WS_AV = WS_AU + SZ_ROWS_BW, WS_AZ = WS_AV + SZ_ROWS_BW, WS_BQ = WS_AZ + SZ_ROWS_BW;
constexpr size_t WS_BK = WS_BQ + SZ_ROWS_BW;
constexpr size_t WS_BV = WS_BK + (size_t)M_ROWS * 256 * 2;
constexpr size_t WS_BZ = WS_BV + (size_t)M_ROWS * 256 * 2;
constexpr size_t WS_CQ = WS_BZ + SZ_ROWS_BW;
constexpr size_t WS_CK = WS_CQ + (size_t)M_ROWS * 1024 * 2;
constexpr size_t WS_CV = WS_CK + (size_t)M_ROWS * 1024 * 2;
constexpr size_t WS_CO = WS_CV + SZ_ROWS_BW, WS_CZ = WS_CO + SZ_ROWS_BW;
constexpr size_t WS_G = WS_CZ + SZ_ROWS_BW;
constexpr size_t WS_IF = WS_G + (size_t)M_ROWS * 12288 * 2;
constexpr size_t WS_LNP = WS_IF + (size_t)M_ROWS * 8 * 4;
constexpr size_t WS_YA = WS_LNP + (size_t)M_ROWS * 32 * 8;
constexpr size_t WS_NUM = WS_YA + 3 * SZ_ROWS_BW;
constexpr size_t WS_SSQC = WS_NUM + SZ_ROWS_BW;
constexpr size_t WS_DN = WS_SSQC + (size_t)M_ROWS * 64 * 4;
constexpr size_t WS_MIX = WS_DN + (size_t)M_ROWS * 4 * 4;
constexpr size_t WS_OUT = WS_MIX + SZ_ROWS_D;
constexpr size_t WS_OUTP = WS_OUT + SZ_ROWS_D;
constexpr size_t WS_ERAW = WS_OUTP + (size_t)M_ROWS * 64 * 4;
constexpr size_t WS_ERP = WS_ERAW + SZ_ROWS_D;
constexpr size_t WS_RSO = WS_ERP + (size_t)M_ROWS * 64 * 4;
constexpr size_t WS_RSE = WS_RSO + (size_t)M_ROWS * 4;
constexpr size_t WS_X1B = WS_RSE + (size_t)M_ROWS * 4;
constexpr size_t WS_XSP = WS_X1B + SZ_ROWS_D;
constexpr size_t WS_END = WS_XSP + (size_t)M_ROWS * 64 * 4;
static_assert(WS_WIN % 256 == 0 && WS_XB % 256 == 0 && WS_AU % 256 == 0 && WS_G % 256 == 0 && WS_YA % 256 == 0 && WS_MIX % 256 == 0 && WS_X1B % 256 == 0, "alignment");

#ifndef EPIIN_NT
#define EPIIN_NT 0
#endif
#if EPIIN_NT
#define EPIIN_STORE(v, p) __builtin_nontemporal_store((v), (p))
#else
#define EPIIN_STORE(v, p) (*(p) = (v))
#endif
#ifndef EPI_NS16
#define EPI_NS16 16
#endif
#ifndef EPI_NS32
#define EPI_NS32 32
#endif
#ifndef EPIIN_NS
#define EPIIN_NS 16
#endif
namespace pg8 {
struct EpiIn {
    static constexpr bool PERM = true; static constexpr int NS = EPIIN_NS;
    __device__ __forceinline__ bool relax(const Unit& u) const { return u.pn < 122; }
    const gfloat* ssq; guchar* ws;
    __device__ __forceinline__ bool keep(const Unit&) const { return false; }
    __device__ __forceinline__ void operator()(f32x4 (&acc)[2][2][4][2], const Unit& u, int wr, int wc, int fr, int fq) const {
        const int pn = u.pn; const int row0 = u.pm * BM + wr * 64 + fr;
        size_t off; int ldc, t0, act; float sc = 1.f;
        if (pn < 16)       { off = WS_AU; ldc = 2048; t0 = 0; act = 6; }
        else if (pn < 24)  { off = WS_AV; ldc = 2048; t0 = 16; act = 5; }
        else if (pn < 32)  { off = WS_BQ; ldc = 2048; t0 = 24; act = 0; }
        else if (pn < 33)  { off = WS_BK; ldc = 256; t0 = 32; act = 0; }
        else if (pn < 34)  { off = WS_BV; ldc = 256; t0 = 33; act = 0; }
        else if (pn < 42)  { off = WS_BZ; ldc = 2048; t0 = 34; act = 2; }
        else if (pn < 46)  { off = WS_CQ; ldc = 1024; t0 = 42; act = 0; sc = 0.0625f; }
        else if (pn < 50)  { off = WS_CK; ldc = 1024; t0 = 46; act = 0; }
        else if (pn < 58)  { off = WS_CV; ldc = 2048; t0 = 50; act = 0; }
        else if (pn < 74)  { off = WS_CO; ldc = 2048; t0 = 58; act = 7; }
        else if (pn < 122) { off = WS_G; ldc = 12288; t0 = 74; act = 3; }
        else               { off = WS_IF; ldc = 8; t0 = 122; act = 4; }
        const int col0 = (pn - t0) * BM + wc * 32 + 8 * fq;
        if (act == 4) {
            if (wc == 0 && fq == 0) {
                gfloat* dst = (gfloat*)(ws + off);
#pragma unroll
                for (int ai = 0; ai < 2; ++ai)
#pragma unroll
                    for (int m = 0; m < 4; ++m) { const int row = row0 + ai * HALF + m * 16; const float rs = rsqrtf(ssq[row] * (1.0f / DM) + NORM_EPS);
                        *(gf32x4*)(dst + (size_t)row * 8) = acc[ai][0][m][0] * rs; *(gf32x4*)(dst + (size_t)row * 8 + 4) = acc[ai][0][m][1] * rs; }
            }
            return;
        }
        gbf16* base = (gbf16*)(ws + off);
        if (act == 6 || act == 7) {
            const int colp = (pn - t0) * HALF + wc * 32 + 8 * fq;
#pragma unroll
            for (int ai = 0; ai < 2; ++ai)
#pragma unroll
                for (int m = 0; m < 4; ++m) {
                    const int row = row0 + ai * HALF + m * 16; const float rs = rsqrtf(ssq[row] * (1.0f / DM) + NORM_EPS);
                    f32x4 a0 = acc[ai][0][m][0] * rs, a1 = acc[ai][0][m][1] * rs; const f32x4 z0 = acc[ai][1][m][0] * rs, z1 = acc[ai][1][m][1] * rs;
                    if (act == 6) { const f32x2 a = gelu_pk((f32x2){a0[0], a0[1]}), b = gelu_pk((f32x2){a0[2], a0[3]}), c = gelu_pk((f32x2){a1[0], a1[1]}), d = gelu_pk((f32x2){a1[2], a1[3]});
                        a0 = (f32x4){a.x, a.y, b.x, b.y}; a1 = (f32x4){c.x, c.y, d.x, d.y}; }
                    else {
#pragma unroll
                        for (int j = 0; j < 4; ++j) { a0[j] = fsigmoid(a0[j]); a1[j] = fsigmoid(a1[j]); } }
#pragma unroll
                    for (int j = 0; j < 4; ++j) { a0[j] *= z0[j] * fsigmoid(z0[j]); a1[j] *= z1[j] * fsigmoid(z1[j]); }
                    u32x4 w; w.x = cvt_pk_bf16(a0[0], a0[1]); w.y = cvt_pk_bf16(a0[2], a0[3]); w.z = cvt_pk_bf16(a1[0], a1[1]); w.w = cvt_pk_bf16(a1[2], a1[3]);
                    *(gu32x4*)(base + (size_t)row * ldc + colp) = w;
                }
            return;
        }
#pragma unroll
        for (int ai = 0; ai < 2; ++ai)
#pragma unroll
            for (int m = 0; m < 4; ++m) {
                const int row = row0 + ai * HALF + m * 16; const float rs = rsqrtf(ssq[row] * (1.0f / DM) + NORM_EPS) * sc;
                gbf16* rowp = base + (size_t)row * ldc + col0; float ls = 0.f, lq = 0.f;
#pragma unroll
                for (int bj = 0; bj < 2; ++bj) {
                    f32x4 v0 = acc[ai][bj][m][0] * rs, v1 = acc[ai][bj][m][1] * rs;
                    if (act == 5) {
                        f32x2 a = gelu_pk((f32x2){v0[0], v0[1]}), b = gelu_pk((f32x2){v0[2], v0[3]}), c = gelu_pk((f32x2){v1[0], v1[1]}), d = gelu_pk((f32x2){v1[2], v1[3]});
                        v0 = (f32x4){a.x, a.y, b.x, b.y}; v1 = (f32x4){c.x, c.y, d.x, d.y};
                        { ls += (v0[0] + v0[1]) + (v0[2] + v0[3]) + (v1[0] + v1[1]) + (v1[2] + v1[3]);
                            lq += (v0[0] * v0[0] + v0[1] * v0[1]) + (v0[2] * v0[2] + v0[3] * v0[3]) + (v1[0] * v1[0] + v1[1] * v1[1]) + (v1[2] * v1[2] + v1[3] * v1[3]); }
                    } else if (act == 2) {
#pragma unroll
                        for (int j = 0; j < 4; ++j) { v0[j] = v0[j] * fsigmoid(v0[j]); v1[j] = v1[j] * fsigmoid(v1[j]); }
                    } else if (act == 3) {
#pragma unroll
                        for (int j = 0; j < 4; ++j) { v0[j] = fsigmoid(v0[j]); v1[j] = fsigmoid(v1[j]); }
                    }
                    u32x4 w; w.x = cvt_pk_bf16(v0[0], v0[1]); w.y = cvt_pk_bf16(v0[2], v0[3]); w.z = cvt_pk_bf16(v1[0], v1[1]); w.w = cvt_pk_bf16(v1[2], v1[3]);
                    EPIIN_STORE(w, (gu32x4*)(rowp + bj * HALF));
                }
                if (act == 5) {
                    ls += __shfl_xor(ls, 16); ls += __shfl_xor(ls, 32); lq += __shfl_xor(lq, 16); lq += __shfl_xor(lq, 32);
                    if (fq == 0) *(gf32x2*)(ws + WS_LNP + ((size_t)row * 32 + (pn - 16) * 4 + wc) * 8) = (f32x2){ls, lq};
                }
            }
    }
};
struct EpiBranch {
    static constexpr bool PERM = true; static constexpr int NS = EPI_NS16;
    __device__ __forceinline__ bool relax(const Unit& u) const { return u.seg == 2; }
    const gbf16* G; gbf16* MIX;
    __device__ __forceinline__ bool keep(const Unit& u) const { return u.seg != 2; }
    __device__ __forceinline__ void operator()(f32x4 (&acc)[2][2][4][2], const Unit& u, int wr, int wc, int fr, int fq) const {
        const int row0 = u.pm * BM + wr * 64 + fr, col0 = u.pn * BM + wc * 32 + 8 * fq; const int seg = u.seg;
#pragma unroll
        for (int ai = 0; ai < 2; ++ai)
#pragma unroll
            for (int m = 0; m < 4; ++m) {
                const int row = row0 + ai * HALF + m * 16; const gbf16* gp = G + (size_t)row * 12288 + seg * DM + col0;
#pragma unroll
                for (int bj = 0; bj < 2; ++bj) {
                    const u32x4 ga = *(const gu32x4*)(gp + bj * HALF);
                    float f[8] = {bf_lo(ga.x), bf_hi(ga.x), bf_lo(ga.y), bf_hi(ga.y), bf_lo(ga.z), bf_hi(ga.z), bf_lo(ga.w), bf_hi(ga.w)};
#pragma unroll
                    for (int j = 0; j < 8; ++j) f[j] = fmaxf(f[j], 1e-20f);
                    if (seg != 2) {
                        const u32x4 gb = *(const gu32x4*)(gp + DM + bj * HALF);
                        const float h[8] = {bf_lo(gb.x), bf_hi(gb.x), bf_lo(gb.y), bf_hi(gb.y), bf_lo(gb.z), bf_hi(gb.z), bf_lo(gb.w), bf_hi(gb.w)};
#pragma unroll
                        for (int j = 0; j < 8; ++j) f[j] = f[j] * __builtin_amdgcn_rcpf(fmaxf(h[j], 1e-20f));
                    }
                    f32x4 v0 = acc[ai][bj][m][0], v1 = acc[ai][bj][m][1];
                    v0 = v0 * (f32x4){f[0], f[1], f[2], f[3]}; v1 = v1 * (f32x4){f[4], f[5], f[6], f[7]};
                    if (seg != 2) { acc[ai][bj][m][0] = v0; acc[ai][bj][m][1] = v1; }
                    else { u32x4 w; w.x = cvt_pk_bf16(v0[0], v0[1]); w.y = cvt_pk_bf16(v0[2], v0[3]); w.z = cvt_pk_bf16(v1[0], v1[1]); w.w = cvt_pk_bf16(v1[2], v1[3]);
                        *(gu32x4*)(MIX + (size_t)row * DM + col0 + bj * HALF) = w; }
                }
                if (m == 3) asm volatile("" ::: "memory");
            }
    }
};
struct EpiSq {
    static constexpr bool PERM = true; static constexpr int NS = EPI_NS16;
    __device__ __forceinline__ bool relax(const Unit&) const { return true; }
    gbf16* O; gfloat* P;
    __device__ __forceinline__ bool keep(const Unit&) const { return false; }
    __device__ __forceinline__ void operator()(f32x4 (&acc)[2][2][4][2], const Unit& u, int wr, int wc, int fr, int fq) const {
        const int row0 = u.pm * BM + wr * 64 + fr, col0 = u.pn * BM + wc * 32 + 8 * fq;
#pragma unroll
        for (int ai = 0; ai < 2; ++ai)
#pragma unroll
            for (int m = 0; m < 4; ++m) {
                const int row = row0 + ai * HALF + m * 16; float q = 0.f;
#pragma unroll
                for (int bj = 0; bj < 2; ++bj) {
                    const f32x4 v0 = acc[ai][bj][m][0], v1 = acc[ai][bj][m][1];
                    q += (v0[0] * v0[0] + v0[1] * v0[1]) + (v0[2] * v0[2] + v0[3] * v0[3]) + (v1[0] * v1[0] + v1[1] * v1[1]) + (v1[2] * v1[2] + v1[3] * v1[3]);
                    u32x4 w; w.x = cvt_pk_bf16(v0[0], v0[1]); w.y = cvt_pk_bf16(v0[2], v0[3]); w.z = cvt_pk_bf16(v1[0], v1[1]); w.w = cvt_pk_bf16(v1[2], v1[3]);
                    if (O) *(gu32x4*)(O + (size_t)row * DM + col0 + bj * HALF) = w; else asm volatile("" :: "v"(w));
                }
                q += __shfl_xor(q, 16); q += __shfl_xor(q, 32);
                if (fq == 0) P[(size_t)row * 64 + u.pn * 4 + wc] = q;
            }
    }
};
struct EpiPle {
    static constexpr bool PERM = false; static constexpr int NS = EPI_NS32;
    __device__ __forceinline__ bool relax(const Unit&) const { return true; }
    const gfloat* XIN; gfloat* XOUT; gbf16* XB; const gbf16* OUT; const gbf16* ERAW; const gfloat* RSO; const gfloat* RSE; const gfloat* npost; const gfloat* pnorm; gfloat* SSQN; int last;
    __device__ __forceinline__ bool keep(const Unit&) const { return false; }
    __device__ __forceinline__ void operator()(f32x4 (&acc)[2][2][4][2], const Unit& u, int wr, int wc, int fr, int fq) const {
        const int row0 = u.pm * BM + wr * 64 + fr, col0 = u.pn * BM + wc * 32 + 4 * fq;
#pragma unroll
        for (int ai = 0; ai < 2; ++ai)
#pragma unroll
            for (int m = 0; m < 4; ++m) {
                const int row = row0 + ai * HALF + m * 16; const float rso = RSO[row], rse = RSE[row]; float q = 0.f; const size_t ro = (size_t)row * DM;
#pragma unroll
                for (int bj = 0; bj < 2; ++bj)
#pragma unroll
                    for (int n = 0; n < 2; ++n) {
                        const int col = col0 + bj * HALF + n * 16;
                        const f32x4 x = *(const gf32x4*)(XIN + ro + col); const u32x2 ob = *(const gu32x2*)(OUT + ro + col), eb = *(const gu32x2*)(ERAW + ro + col);
                        const f32x4 np = *(const gf32x4*)(npost + col), pn = *(const gf32x4*)(pnorm + col);
                        const f32x4 o = {bf_lo(ob.x), bf_hi(ob.x), bf_lo(ob.y), bf_hi(ob.y)}, e = {bf_lo(eb.x), bf_hi(eb.x), bf_lo(eb.y), bf_hi(eb.y)};
                        const f32x4 a = acc[ai][bj][m][n]; f32x4 r;
#pragma unroll
                        for (int j = 0; j < 4; ++j) { const float x1 = x[j] + o[j] * rso * np[j]; r[j] = x1 + fsigmoid(a[j]) * (e[j] * rse * pn[j]); q += r[j] * r[j]; }
                        *(gf32x4*)(XOUT + ro + col) = r;
                        if (!last) { u32x2 w; w.x = cvt_pk_bf16(r[0], r[1]); w.y = cvt_pk_bf16(r[2], r[3]); *(gu32x2*)(XB + ro + col) = w; }
                    }
                if (!last) { q += __shfl_xor(q, 16); q += __shfl_xor(q, 32); if (fq == 0) SSQN[(size_t)row * 64 + u.pn * 4 + wc] = q; }
                if (m & 1) asm volatile("" ::: "memory");
            }
    }
};
}

constexpr int LDS_BYTES = 147456;
constexpr int MISC_OFF = LDS_BYTES - 128;
constexpr int ARGS_OFF = LDS_BYTES - 512;
constexpr int NWAVES = 8, NTHREADS = 512;

struct Ctx {
    LAS unsigned char* lds; int tid, lane, wave, vcu, G, bx;
};

struct TrTile { const gfloat* W; const gfloat* kscale; gbf16* WT; int ldw, K; };
constexpr int TR_PER_LAYER = 7808 + 1536 + 1024 + 1024 + 64;
__device__ __forceinline__ TrTile tr_decode(int it, const gfloat* w_in, const gfloat* norm_pre, const gfloat* w_branch, const gfloat* w_out, const gfloat* ple_gate, const gfloat* ple_proj, guchar* ws) {
    const int l = it / TR_PER_LAYER; int r = it - l * TR_PER_LAYER; TrTile t; int kt, ntile;
    if (r < 7808) { kt = r / 244; ntile = r - kt * 244; const int src = ntile < 116 ? ntile * 128 : ntile * 128 + 8;
        if (ntile < 16) ntile = 2 * ntile; else if (ntile < 32) ntile = ntile + 16; else if (ntile < 48) ntile = 2 * (ntile - 32) + 1;
        else if (ntile >= 116 && ntile < 132) ntile = 116 + 2 * (ntile - 116); else if (ntile >= 132 && ntile < 148) ntile = 116 + 2 * (ntile - 132) + 1;
        t.ldw = N_IN; t.K = DM; t.W = w_in + (size_t)l * DM * N_IN + (size_t)kt * 128 * N_IN + src; t.kscale = norm_pre + l * DM + kt * 128;
        t.WT = (gbf16*)(ws + WS_WIN + (size_t)l * SZ_WIN) + (size_t)ntile * 128 * DM + kt * 128; return t; }
    r -= 7808; t.kscale = nullptr; t.ldw = DM;
    if (r < 1536) { const int j = r / 512; const int rr = r - j * 512; kt = rr / 32; ntile = rr - kt * 32; t.K = BW;
        t.W = w_branch + ((size_t)(l * 3 + j) * BW + (size_t)kt * 128) * DM + ntile * 128;
        t.WT = (gbf16*)(ws + WS_WBR + (size_t)l * SZ_WBR) + (size_t)j * DM * BW + (size_t)ntile * 128 * BW + kt * 128; return t; }
    r -= 1536;
    if (r < 2048) { const int which = r / 1024; const int rr = r - which * 1024; kt = rr / 32; ntile = rr - kt * 32; t.K = DM;
        t.W = (which ? ple_gate : w_out) + ((size_t)l * DM + (size_t)kt * 128) * DM + ntile * 128;
        t.WT = (gbf16*)(ws + (which ? WS_WPG : WS_WOUT) + (size_t)l * SZ_WSQ) + (size_t)ntile * 128 * DM + kt * 128; return t; }
    r -= 2048; kt = r / 32; ntile = r - kt * 32; t.K = 256;
    t.W = ple_proj + ((size_t)l * 256 + (size_t)kt * 128) * DM + ntile * 128;
    t.WT = (gbf16*)(ws + WS_WPP + (size_t)l * SZ_WPP) + (size_t)ntile * 128 * 256 + kt * 128; return t;
}
__device__ __forceinline__ void tr_run(const Ctx& F, int it0, int it1, int sk0, int sk1, int me, int nw, const gfloat* w_in, const gfloat* norm_pre, const gfloat* w_branch,
                                       const gfloat* w_out, const gfloat* ple_gate, const gfloat* ple_proj, guchar* ws) {
    int tid = F.tid; LAUNDER_V(tid);
    {
        constexpr int RS = 264; const int NIT = it1 - it0 - (sk1 - sk0);
        const int c4 = tid & 31, kr = tid >> 5, kc = tid & 15;
        f32x4 va[8], vb[8]; float ka[8], kb[8]; TrTile ta, tb;
#define TR_LOAD(T_, V_, K_, IT_) do { T_ = tr_decode(it0 + (IT_) + (((it0 + (IT_)) >= sk0) ? (sk1 - sk0) : 0), w_in, norm_pre, w_branch, w_out, ple_gate, ple_proj, ws); \
        _Pragma("unroll") for (int i = 0; i < 8; ++i) { V_[i] = *(const gf32x4*)(T_.W + (size_t)(i * 16 + kr) * T_.ldw + 4 * c4); K_[i] = T_.kscale ? T_.kscale[i * 16 + kr] : 1.0f; } } while (0)
#define TR_PUT(V_, K_) do { _Pragma("unroll") for (int i = 0; i < 8; ++i) { const f32x4 a = V_[i] * K_[i]; u32x2 w; w.x = cvt_pk_bf16(a[0], a[1]); w.y = cvt_pk_bf16(a[2], a[3]); \
        *(LAS u32x2*)(F.lds + (i * 16 + kr) * RS + c4 * 8) = w; } } while (0)
#define TR_GET(WT_, K_) do { _Pragma("unroll") for (int q = 0; q < 4; ++q) { const int n = 32 * q + (tid >> 4); const LAS bf16_t* s = (const LAS bf16_t*)(F.lds + (8 * kc) * RS + 2 * n); unsigned e[8]; \
        _Pragma("unroll") for (int j = 0; j < 8; ++j) e[j] = s[j * (RS / 2)]; \
        u32x4 o; o.x = e[0] | (e[1] << 16); o.y = e[2] | (e[3] << 16); o.z = e[4] | (e[5] << 16); o.w = e[6] | (e[7] << 16); \
        *(gu32x4*)(WT_ + (size_t)n * K_ + 8 * kc) = o; } } while (0)
        int it = me;
        if (it < NIT) TR_LOAD(ta, va, ka, it);
        if (it + nw < NIT) TR_LOAD(tb, vb, kb, it + nw);
        while (it < NIT) {
            { TR_PUT(va, ka); __syncthreads(); gbf16* wt = ta.WT; const int kk = ta.K;
              if (it + 2 * nw < NIT) TR_LOAD(ta, va, ka, it + 2 * nw);
              TR_GET(wt, kk); __syncthreads(); }
            it += nw; if (it >= NIT) break;
            { TR_PUT(vb, kb); __syncthreads(); gbf16* wt = tb.WT; const int kk = tb.K;
              if (it + 2 * nw < NIT) TR_LOAD(tb, vb, kb, it + 2 * nw);
              TR_GET(wt, kk); __syncthreads(); }
            it += nw;
        }
#undef TR_LOAD
#undef TR_PUT
#undef TR_GET
    }
}
constexpr int TR_DEFER0 = TR_PER_LAYER + 7808 + 1536, TR_DEFER1 = TR_DEFER0 + 2048;
__device__ __forceinline__ void p0_prologue(const Ctx& F, const gfloat* x, const gfloat* p, const gint* positions, const gfloat* norm_pre, const gfloat* w_in, const gfloat* w_branch,
                                            const gfloat* w_out, const gfloat* ple_gate, const gfloat* ple_proj, guchar* ws) {
    int tid = F.tid; LAUNDER_V(tid);
    tr_run(F, 0, NLAYER * TR_PER_LAYER, TR_DEFER0, TR_DEFER1, F.vcu, F.G, w_in, norm_pre, w_branch, w_out, ple_gate, ple_proj, ws);
    const int gt = F.vcu * NTHREADS + tid, NGT = F.G * NTHREADS;
    for (int i = gt; i < NLAYER * 256 * DM; i += NGT) { const int l = i / (256 * DM), rr = (i / DM) & 255, k = i & (DM - 1);
        float val = 0.f; if (rr < 8) val = w_in[(size_t)l * DM * N_IN + (size_t)k * N_IN + IF_COL + rr] * norm_pre[l * DM + k];
        ((gbf16*)(ws + WS_WIN + (size_t)l * SZ_WIN))[(size_t)(122 * 256 + rr) * DM + k] = (bf16_t)(cvt_pk_bf16(val, 0.f) & 0xffffu); }
    for (int i = gt; i < NLAYER * M_ROWS * 256 / 4; i += NGT) { const f32x4 a = ((const gf32x4*)p)[i]; u32x2 w; w.x = cvt_pk_bf16(a[0], a[1]); w.y = cvt_pk_bf16(a[2], a[3]); ((gu32x2*)(ws + WS_PB))[i] = w; }
    for (int i = gt; i < M_ROWS * 8; i += NGT) { const int row = i >> 3, j = i & 7; const float inv = powf(500000.0f, -(float)j * 0.125f); const float ang = (float)positions[row] * inv;
        gfloat* cs = (gfloat*)(ws + WS_CS) + (size_t)row * 16; cs[j] = cosf(ang); cs[8 + j] = sinf(ang); }
    { const int gw = F.vcu * NWAVES + F.wave, NGW = F.G * NWAVES;
      for (int m = gw; m < M_ROWS; m += NGW) { const gf32x4* xr = (const gf32x4*)(x + (size_t)m * DM) + F.lane; gu32x2* o = (gu32x2*)(ws + WS_XB + (size_t)m * DM * 2) + F.lane; float s = 0.f;
#pragma unroll
          for (int j = 0; j < 16; ++j) { const f32x4 a = xr[64 * j]; s += (a[0] * a[0] + a[1] * a[1]) + (a[2] * a[2] + a[3] * a[3]); u32x2 w; w.x = cvt_pk_bf16(a[0], a[1]); w.y = cvt_pk_bf16(a[2], a[3]); o[64 * j] = w; }
          s = wave_sum(s); if (F.lane == 0) ((gfloat*)(ws + WS_SSQ0))[m] = s; } }
}

__device__ __forceinline__ u32x2 pack4(const f32x4 v) { u32x2 w; w.x = cvt_pk_bf16(v[0], v[1]); w.y = cvt_pk_bf16(v[2], v[3]); return w; }
__device__ __forceinline__ bf16x8 mk_frag(const u32x2 lo, const u32x2 hi) { const u32x4 t = {lo.x, lo.y, hi.x, hi.y}; return __builtin_bit_cast(bf16x8, t); }
__device__ __forceinline__ bf16x8 frag_const(unsigned w) { const u32x4 t = {w, w, w, w}; return __builtin_bit_cast(bf16x8, t); }

constexpr int GM_WL = 0, GM_VT = 34816, GM_ST = 104448, GM_RS = 272;
__device__ __forceinline__ void gmlp_unit(const Ctx& F, int b, int n, int g, guchar* ws, const gfloat* ln_g, const gfloat* ln_b, const gfloat* wsp, const gfloat* bsp) {
    int tid = F.tid; LAUNDER_V(tid); const int lane = tid & 63, w = F.wave, r16 = lane & 15, q4 = lane >> 4;
    const int row0 = b * SEQ + n * 128, c0 = g * 256;
    const gbf16* AU = (const gbf16*)(ws + WS_AU); const gbf16* AV = (const gbf16*)(ws + WS_AV); const gbf16* AZ = (const gbf16*)(ws + WS_AZ); gbf16* YA = (gbf16*)(ws + WS_YA);
    if (tid < 128) { const gf32x2* pp = (const gf32x2*)(ws + WS_LNP) + (size_t)(row0 + tid) * 32; float s = 0.f, q = 0.f;
#pragma unroll 8
        for (int j = 0; j < 32; ++j) { const f32x2 t = pp[j]; s += t.x; q += t.y; }
        const float mu = s * (1.0f / BW); const float var = fmaxf(q * (1.0f / BW) - mu * mu, 0.f);
        *(LAS f32x2*)(F.lds + GM_ST + tid * 8) = (f32x2){mu, rsqrtf(var + NORM_EPS)}; }
#pragma unroll
    for (int k = 0; k < 8; ++k) { const int item = tid + 512 * k, t = item >> 5, ch = item & 31;
        f32x4 a = *(const gf32x4*)(wsp + ((size_t)(g * 128 + t)) * 128 + 4 * ch);
#pragma unroll
        for (int e = 0; e < 4; ++e) if (4 * ch + e > t) a[e] = 0.f;
        *(LAS u32x2*)(F.lds + GM_WL + t * GM_RS + ch * 8) = pack4(a); }
    __syncthreads();
#pragma unroll
    for (int k = 0; k < 8; ++k) { const int item = tid + 512 * k, s = item & 127, ch = item >> 7;
        const u32x4 raw = *(const gu32x4*)(AV + (size_t)(row0 + s) * BW + c0 + 8 * ch);
        const f32x4 g0 = *(const gf32x4*)(ln_g + c0 + 8 * ch), g1 = *(const gf32x4*)(ln_g + c0 + 8 * ch + 4), b0 = *(const gf32x4*)(ln_b + c0 + 8 * ch), b1 = *(const gf32x4*)(ln_b + c0 + 8 * ch + 4);
        const f32x2 st = *(const LAS f32x2*)(F.lds + GM_ST + s * 8);
        const float xv[8] = {bf_lo(raw.x), bf_hi(raw.x), bf_lo(raw.y), bf_hi(raw.y), bf_lo(raw.z), bf_hi(raw.z), bf_lo(raw.w), bf_hi(raw.w)};
        const float gg[8] = {g0[0], g0[1], g0[2], g0[3], g1[0], g1[1], g1[2], g1[3]}, bb[8] = {b0[0], b0[1], b0[2], b0[3], b1[0], b1[1], b1[2], b1[3]};
#pragma unroll
        for (int i = 0; i < 8; ++i) { const float y = (xv[i] - st.x) * st.y * gg[i] + bb[i];
            *(LAS bf16_t*)(F.lds + GM_VT + (8 * ch + i) * GM_RS + 2 * s) = (bf16_t)(cvt_pk_bf16(y, 0.f) & 0xffffu); } }
    __syncthreads();
    f32x4 acc[2][8];
#pragma unroll
    for (int m = 0; m < 2; ++m)
#pragma unroll
        for (int n8 = 0; n8 < 8; ++n8) acc[m][n8] = (f32x4){0.f, 0.f, 0.f, 0.f};
    bf16x8 af[2][4];
#pragma unroll
    for (int m = 0; m < 2; ++m)
#pragma unroll
        for (int ks = 0; ks < 4; ++ks) af[m][ks] = *(const LAS bf16x8*)(F.lds + GM_VT + (32 * w + 16 * m + r16) * GM_RS + ks * 64 + q4 * 16);
#pragma unroll
    for (int n8 = 0; n8 < 8; ++n8)
#pragma unroll
        for (int ks = 0; ks < 4; ++ks) if (ks <= n8 / 2) {
            const bf16x8 bfr = *(const LAS bf16x8*)(F.lds + GM_WL + (16 * n8 + r16) * GM_RS + ks * 64 + q4 * 16);
#pragma unroll
            for (int m = 0; m < 2; ++m) acc[m][n8] = MFMA16(af[m][ks], bfr, acc[m][n8]); }
#pragma unroll
    for (int n8 = 0; n8 < 8; ++n8) { const int t = 16 * n8 + r16; const float bsv = bsp[g * 128 + t]; const size_t ro = (size_t)(row0 + t) * BW + c0 + 32 * w + 4 * q4;
#pragma unroll
        for (int m = 0; m < 2; ++m) { const u32x2 ub = *(const gu32x2*)(AU + ro + 16 * m);
            const f32x4 a = acc[m][n8] + bsv; f32x4 y;
            y[0] = a[0] * bf_lo(ub.x); y[1] = a[1] * bf_hi(ub.x); y[2] = a[2] * bf_lo(ub.y); y[3] = a[3] * bf_hi(ub.y);
            *(gu32x2*)(YA + ro + 16 * m) = pack4(y); } }
    __syncthreads();
}

constexpr int SW_KL = 0, SW_VT = 36864, SW_QL = 70656, SW_RS = 144, SW_VS = 528;
__device__ __forceinline__ void rope8(const u32x4 a, const u32x4 bq, const gfloat* cs, float scale, u32x4& o1, u32x4& o2) {
    const f32x4 c0 = *(const gf32x4*)cs, c1 = *(const gf32x4*)(cs + 4), s0 = *(const gf32x4*)(cs + 8), s1 = *(const gf32x4*)(cs + 12);
    const float t1[8] = {bf_lo(a.x), bf_hi(a.x), bf_lo(a.y), bf_hi(a.y), bf_lo(a.z), bf_hi(a.z), bf_lo(a.w), bf_hi(a.w)};
    const float t2[8] = {bf_lo(bq.x), bf_hi(bq.x), bf_lo(bq.y), bf_hi(bq.y), bf_lo(bq.z), bf_hi(bq.z), bf_lo(bq.w), bf_hi(bq.w)};
    const float cc[8] = {c0[0], c0[1], c0[2], c0[3], c1[0], c1[1], c1[2], c1[3]}, ss[8] = {s0[0], s0[1], s0[2], s0[3], s1[0], s1[1], s1[2], s1[3]};
    float r1[8], r2[8];
#pragma unroll
    for (int i = 0; i < 8; ++i) { r1[i] = (t1[i] * cc[i] - t2[i] * ss[i]) * scale; r2[i] = (t2[i] * cc[i] + t1[i] * ss[i]) * scale; }
    o1 = (u32x4){cvt_pk_bf16(r1[0], r1[1]), cvt_pk_bf16(r1[2], r1[3]), cvt_pk_bf16(r1[4], r1[5]), cvt_pk_bf16(r1[6], r1[7])};
    o2 = (u32x4){cvt_pk_bf16(r2[0], r2[1]), cvt_pk_bf16(r2[2], r2[3]), cvt_pk_bf16(r2[4], r2[5]), cvt_pk_bf16(r2[6], r2[7])};
}
__device__ __forceinline__ u32x4 scale8(const u32x4 a, float sc) {
    return (u32x4){cvt_pk_bf16(bf_lo(a.x) * sc, bf_hi(a.x) * sc), cvt_pk_bf16(bf_lo(a.y) * sc, bf_hi(a.y) * sc), cvt_pk_bf16(bf_lo(a.z) * sc, bf_hi(a.z) * sc), cvt_pk_bf16(bf_lo(a.w) * sc, bf_hi(a.w) * sc)};
}
__device__ __forceinline__ void swa_unit(const Ctx& F, int b, int n, int hk, guchar* ws, const gfloat* sinks) {
    int tid = F.tid; LAUNDER_V(tid); const int lane = tid & 63, w = F.wave, r16 = lane & 15, q4 = lane >> 4;
    const int r0 = b * SEQ + n * 128, kr0 = r0 - 128;
    const gbf16* BQ = (const gbf16*)(ws + WS_BQ); const gbf16* BK = (const gbf16*)(ws + WS_BK); const gbf16* BV = (const gbf16*)(ws + WS_BV); const gbf16* BZ = (const gbf16*)(ws + WS_BZ);
    gbf16* YB = (gbf16*)(ws + WS_YA) + (size_t)M_ROWS * BW; const gfloat* CS = (const gfloat*)(ws + WS_CS);
#pragma unroll
    for (int k = 0; k < 4; ++k) { const int item = tid + 512 * k, key = item >> 3, ch = item & 7; const bool pad = (n == 0 && key < 128);
        if (ch == 1) continue;
        const gbf16* src = BK + (size_t)(kr0 + key) * 256 + hk * 64;
        LAS unsigned char* dst = F.lds + SW_KL + key * SW_RS;
        if (pad) { *(LAS u32x4*)(dst + ch * 16) = (u32x4){0u, 0u, 0u, 0u}; if (ch == 0) *(LAS u32x4*)(dst + 16) = (u32x4){0u, 0u, 0u, 0u}; }
        else if (ch == 0) { u32x4 o1, o2; rope8(*(const gu32x4*)src, *(const gu32x4*)(src + 8), CS + (size_t)(kr0 + key) * 16, 1.0f, o1, o2); *(LAS u32x4*)dst = o1; *(LAS u32x4*)(dst + 16) = o2; }
        else *(LAS u32x4*)(dst + ch * 16) = *(const gu32x4*)(src + 8 * ch); }
#pragma unroll
    for (int k = 0; k < 4; ++k) { const int item = tid + 512 * k, key = item & 255, ch = item >> 8; const bool pad = (n == 0 && key < 128);
        u32x4 raw = {0u, 0u, 0u, 0u}; if (!pad) raw = *(const gu32x4*)(BV + (size_t)(kr0 + key) * 256 + hk * 64 + 8 * ch);
        const unsigned e[4] = {raw.x, raw.y, raw.z, raw.w};
#pragma unroll
        for (int i = 0; i < 8; ++i) *(LAS bf16_t*)(F.lds + SW_VT + (8 * ch + i) * SW_VS + 2 * key) = (bf16_t)((e[i >> 1] >> ((i & 1) * 16)) & 0xffffu); }
    for (int hi = 0; hi < 8; ++hi) {
        const int hq = hk * 8 + hi;
#pragma unroll
        for (int k = 0; k < 2; ++k) { const int item = tid + 512 * k, qr = item >> 3, ch = item & 7;
            if (ch == 1) continue;
            const gbf16* src = BQ + (size_t)(r0 + qr) * BW + hq * 64; LAS unsigned char* dst = F.lds + SW_QL + qr * SW_RS;
            if (ch == 0) { u32x4 o1, o2; rope8(*(const gu32x4*)src, *(const gu32x4*)(src + 8), CS + (size_t)(r0 + qr) * 16, 0.125f, o1, o2); *(LAS u32x4*)dst = o1; *(LAS u32x4*)(dst + 16) = o2; }
            else *(LAS u32x4*)(dst + ch * 16) = scale8(*(const gu32x4*)(src + 8 * ch), 0.125f); }
        __syncthreads();
        bf16x8 bq[2];
#pragma unroll
        for (int ks = 0; ks < 2; ++ks) bq[ks] = *(const LAS bf16x8*)(F.lds + SW_QL + (16 * w + r16) * SW_RS + ks * 64 + q4 * 16);
        f32x4 s[16];
#pragma unroll
        for (int kt = 0; kt < 16; ++kt) { s[kt] = (f32x4){0.f, 0.f, 0.f, 0.f};
#pragma unroll
            for (int ks = 0; ks < 2; ++ks) { const bf16x8 a = *(const LAS bf16x8*)(F.lds + SW_KL + (16 * kt + r16) * SW_RS + ks * 64 + q4 * 16); s[kt] = MFMA16(a, bq[ks], s[kt]); } }
        const int qi = 16 * w + r16; const float sink = sinks[hq]; float mx = sink;
#pragma unroll
        for (int kt = 0; kt < 16; ++kt)
#pragma unroll
            for (int e = 0; e < 4; ++e) { const int kj = 16 * kt + 4 * q4 + e; const bool valid = (kj > qi) && (kj <= qi + 128) && (n > 0 || kj >= 128);
                s[kt][e] = valid ? s[kt][e] : -1e30f; mx = fmaxf(mx, s[kt][e]); }
        mx = fmaxf(mx, __shfl_xor(mx, 16)); mx = fmaxf(mx, __shfl_xor(mx, 32));
        float sum = 0.f;
#pragma unroll
        for (int kt = 0; kt < 16; ++kt)
#pragma unroll
            for (int e = 0; e < 4; ++e) { const float pv = (s[kt][e] > -1e29f) ? __expf(s[kt][e] - mx) : 0.f; s[kt][e] = pv; sum += pv; }
        sum += __shfl_xor(sum, 16); sum += __shfl_xor(sum, 32); sum += __expf(sink - mx);
        const float inv = 1.0f / sum;
        f32x4 o[4];
#pragma unroll
        for (int dt = 0; dt < 4; ++dt) o[dt] = (f32x4){0.f, 0.f, 0.f, 0.f};
#pragma unroll
        for (int kk = 0; kk < 8; ++kk) { const bf16x8 pf = mk_frag(pack4(s[2 * kk]), pack4(s[2 * kk + 1]));
#pragma unroll
            for (int dt = 0; dt < 4; ++dt) { const LAS unsigned char* vp = F.lds + SW_VT + (16 * dt + r16) * SW_VS + (32 * kk + 4 * q4) * 2;
                const bf16x8 a = mk_frag(*(const LAS u32x2*)vp, *(const LAS u32x2*)(vp + 32)); o[dt] = MFMA16(a, pf, o[dt]); } }
        const size_t ro = (size_t)(r0 + qi) * BW + hq * 64 + 4 * q4;
#pragma unroll
        for (int dt = 0; dt < 4; ++dt) { const u32x2 zb = *(const gu32x2*)(BZ + ro + 16 * dt); f32x4 y;
            y[0] = o[dt][0] * inv * bf_lo(zb.x); y[1] = o[dt][1] * inv * bf_hi(zb.x); y[2] = o[dt][2] * inv * bf_lo(zb.y); y[3] = o[dt][3] * inv * bf_hi(zb.y);
            *(gu32x2*)(YB + ro + 16 * dt) = pack4(y); }
        __syncthreads();
    }
}

#ifndef ML_R1A
#define ML_R1A 1
#endif
#ifndef ML_R1B
#define ML_R1B 1
#endif
#ifndef ML_RWR
#define ML_RWR 1
#endif
constexpr int ML_QL = 0, ML_KA = 33792, ML_KB = 67584, ML_VT = 101376, ML_VW = 105984, ML_VW2 = 110736, ML_CT = 115488, ML_X = 132912, ML_GATE = 142128, ML_GSZ = 1344, ML_RS = 528, ML_TS = 144;
static_assert(ML_GATE + 2 * ML_GSZ <= ARGS_OFF, "mLSTM LDS map");
typedef short s16x4 __attribute__((ext_vector_type(4)));
__device__ __forceinline__ bf16x8 tr_frag8(const LAS unsigned char* img, int rs, int row0, int col0, int r16) {
    const LAS unsigned char* p0 = img + (row0 + (r16 >> 2)) * rs + (col0 + 4 * (r16 & 3)) * 2;
    const s16x4 a = __builtin_amdgcn_ds_read_tr16_b64_v4i16((LAS s16x4*)p0);
    const s16x4 b = __builtin_amdgcn_ds_read_tr16_b64_v4i16((LAS s16x4*)(p0 + 4 * rs));
    return __builtin_shufflevector(a, b, 0, 1, 2, 3, 4, 5, 6, 7);
}
__device__ __forceinline__ float dpp_shr(float v, float ident, int n) {
    const int r = n == 1 ? __builtin_amdgcn_update_dpp(__float_as_int(ident), __float_as_int(v), 0x111, 0xf, 0xf, false)
                : n == 2 ? __builtin_amdgcn_update_dpp(__float_as_int(ident), __float_as_int(v), 0x112, 0xf, 0xf, false)
                : n == 4 ? __builtin_amdgcn_update_dpp(__float_as_int(ident), __float_as_int(v), 0x114, 0xf, 0xf, false)
                         : __builtin_amdgcn_update_dpp(__float_as_int(ident), __float_as_int(v), 0x118, 0xf, 0xf, false);
    return __int_as_float(r);
}
__device__ __forceinline__ float wave_scan_add(float v, int lane) {
    v += dpp_shr(v, 0.f, 1); v += dpp_shr(v, 0.f, 2); v += dpp_shr(v, 0.f, 4); v += dpp_shr(v, 0.f, 8);
    const float t0 = __int_as_float(__builtin_amdgcn_readlane(__float_as_int(v), 15)), t1 = __int_as_float(__builtin_amdgcn_readlane(__float_as_int(v), 31)), t2 = __int_as_float(__builtin_amdgcn_readlane(__float_as_int(v), 47));
    const int row = lane >> 4; const float add = row == 0 ? 0.f : (row == 1 ? t0 : (row == 2 ? t0 + t1 : (t0 + t1) + t2));
    return v + add;
}
__device__ __forceinline__ float wave_scan_max(float v, int lane) {
    const float NI = -3.0e38f;
    v = fmaxf(v, dpp_shr(v, NI, 1)); v = fmaxf(v, dpp_shr(v, NI, 2)); v = fmaxf(v, dpp_shr(v, NI, 4)); v = fmaxf(v, dpp_shr(v, NI, 8));
    const float t0 = __int_as_float(__builtin_amdgcn_readlane(__float_as_int(v), 15)), t1 = __int_as_float(__builtin_amdgcn_readlane(__float_as_int(v), 31)), t2 = __int_as_float(__builtin_amdgcn_readlane(__float_as_int(v), 47));
    const int row = lane >> 4; const float mx = row == 0 ? NI : (row == 1 ? t0 : (row == 2 ? fmaxf(t0, t1) : fmaxf(fmaxf(t0, t1), t2)));
    return fmaxf(v, mx);
}
__device__ __forceinline__ float softcap15(float z) { const float e = __expf(z * (2.0f / 15.0f)); return 15.0f * (1.0f - 2.0f * __builtin_amdgcn_rcpf(e + 1.0f)); }
__device__ __forceinline__ void mlstm_unit(const Ctx& F, int b, int h, int sl, guchar* ws, const gfloat* ibp, const gfloat* fbp, const gfloat* norm_g) {
    int tid = F.tid; LAUNDER_V(tid); const int lane = tid & 63, w = F.wave, r16 = lane & 15, q4 = lane >> 4;
    const gbf16* CQ = (const gbf16*)(ws + WS_CQ) + h * 256; const gbf16* CK = (const gbf16*)(ws + WS_CK) + h * 256; const gbf16* CV = (const gbf16*)(ws + WS_CV) + h * 512 + sl * 32;
    const gbf16* CO = (const gbf16*)(ws + WS_CO) + h * 512 + sl * 32; const gbf16* CZ = (const gbf16*)(ws + WS_CZ) + h * 512 + sl * 32;
    const gfloat* IFB = (const gfloat*)(ws + WS_IF);
    gbf16* NUM = (gbf16*)(ws + WS_NUM) + h * 512 + sl * 32; gfloat* SSQC = (gfloat*)(ws + WS_SSQC); gfloat* DNB = (gfloat*)(ws + WS_DN);
    const int rowb = b * SEQ;
    const bf16x8 ones = frag_const(0x3f803f80u), zeros = frag_const(0u);
    for (int i = tid; i < 33 * ML_RS / 16; i += NTHREADS) *(LAS u32x4*)(F.lds + ML_CT + i * 16) = (u32x4){0u, 0u, 0u, 0u};
    f32x4 st[2][3];
#pragma unroll
    for (int i = 0; i < 2; ++i)
#pragma unroll
        for (int dt = 0; dt < 3; ++dt) st[i][dt] = (f32x4){0.f, 0.f, 0.f, 0.f};
    float m_prev = 0.f;
    const float ibv = ibp[h], fbv = fbp[h];
    u32x4 qra[4], kra[4], vra; float gi = 0.f, gf = 0.f;
#define ML_LOAD(c, Q_, K_, V_) do { const int rc_ = rowb + (c) * 64; _Pragma("unroll") for (int k_ = 0; k_ < 4; ++k_) { const int it_ = tid + 512 * k_, s_ = it_ >> 5, ch_ = it_ & 31; \
        Q_[k_] = *(const gu32x4*)(CQ + (size_t)(rc_ + s_) * 1024 + 8 * ch_); K_[k_] = *(const gu32x4*)(CK + (size_t)(rc_ + s_) * 1024 + 8 * ch_); } \
        if (tid < 256) V_ = *(const gu32x4*)(CV + (size_t)(rc_ + (tid >> 2)) * BW + 8 * (tid & 3)); } while (0)
#define ML_GLOAD(c) do { if (w == 7) { const int r_ = rowb + (c) * 64 + lane; gi = IFB[(size_t)r_ * 8 + h]; gf = IFB[(size_t)r_ * 8 + 4 + h]; } } while (0)
#define ML_GPREP(par) do { if (w == 7) { const float ig_ = softcap15(gi + ibv); const float z_ = softcap15(gf + fbv); \
        const float lf_ = -(fmaxf(-z_, 0.f) + log1pf(__expf(-fabsf(z_)))); const float bc_ = wave_scan_add(lf_, lane); const float u_ = ig_ - bc_; const float pm_ = wave_scan_max(u_, lane); \
        const float Mv_ = fmaxf(m_prev, pm_); const float M63_ = __int_as_float(__builtin_amdgcn_readlane(__float_as_int(Mv_), 63)); const float g_ = __int_as_float(__builtin_amdgcn_readlane(__float_as_int(bc_), 63)); \
        LAS float* gp_ = (LAS float*)(F.lds + ML_GATE + (par) * ML_GSZ); gp_[lane] = u_; gp_[64 + lane] = Mv_; gp_[128 + lane] = __expf(m_prev - Mv_); gp_[192 + lane] = __expf(-(bc_ + Mv_)); \
        gp_[256 + lane] = __expf(u_ - M63_); if (lane == 0) gp_[320] = __expf(m_prev - M63_); m_prev = g_ + M63_; } } while (0)
#define ML_WRITE(kb_, vw_, gpn_, Q_, K_, V_) do { _Pragma("unroll") for (int k_ = 0; k_ < 4; ++k_) { const int it_ = tid + 512 * k_, s_ = it_ >> 5, ch_ = it_ & 31; \
        *(LAS u32x4*)(F.lds + ML_QL + s_ * ML_RS + ch_ * 16) = Q_[k_]; *(LAS u32x4*)(F.lds + (kb_) + s_ * ML_RS + ch_ * 16) = K_[k_]; } \
        if (tid < 256) { const int s_ = tid >> 2, ch_ = tid & 3; const unsigned e_[4] = {V_.x, V_.y, V_.z, V_.w}; const float ws_ = (gpn_)[256 + s_]; \
            _Pragma("unroll") for (int i_ = 0; i_ < 8; ++i_) { const unsigned hv_ = (e_[i_ >> 1] >> ((i_ & 1) * 16)) & 0xffffu; \
                *(LAS bf16_t*)(F.lds + ML_VT + (8 * ch_ + i_) * ML_TS + 2 * s_) = (bf16_t)hv_; \
                *(LAS bf16_t*)(F.lds + (vw_) + (8 * ch_ + i_) * ML_TS + 2 * s_) = (bf16_t)(cvt_pk_bf16(__uint_as_float(hv_ << 16) * ws_, 0.f) & 0xffffu); } \
            if (ch_ == 0) *(LAS bf16_t*)(F.lds + (vw_) + 32 * ML_TS + 2 * s_) = (bf16_t)(cvt_pk_bf16(ws_, 0.f) & 0xffffu); } } while (0)
    ML_LOAD(0, qra, kra, vra); ML_GLOAD(0);
    ML_GPREP(0);
    ML_GLOAD(1);
    __syncthreads();
    ML_WRITE(ML_KA, ML_VW, ((const LAS float*)(F.lds + ML_GATE)), qra, kra, vra);
    __syncthreads();
#define ML_STEP(c, LQ_, LK_, LV_, WQ_, WK_, WV_) do { \
        const int par = c & 1; const LAS float* gp = (const LAS float*)(F.lds + ML_GATE + par * ML_GSZ); \
        const int vt = ML_VT, kb = par ? ML_KB : ML_KA, kbn = par ? ML_KA : ML_KB, vw = par ? ML_VW2 : ML_VW, vwn = par ? ML_VW : ML_VW2; \
        const LAS float* gpn = (const LAS float*)(F.lds + ML_GATE + (par ^ 1) * ML_GSZ); \
        const int rowc = rowb + c * 64; \
        if (c + 1 < 32) { ML_LOAD(c + 1, LQ_, LK_, LV_); ML_GPREP(par ^ 1); if (c + 2 < 32) ML_GLOAD(c + 2); } \
        u32x2 ob0 = {0u, 0u}, ob1 = {0u, 0u}; \
        if (w < 4) { const size_t ro = (size_t)(rowc + 16 * w + r16) * BW + 4 * q4; \
            ob0 = *(const gu32x2*)(CO + ro); ob1 = *(const gu32x2*)(CO + ro + 16); } \
        f32x4 oacc[3]; \
        for (int rp_ = 0; rp_ < ML_R1B; ++rp_) { \
        _Pragma("unroll") \
        for (int dt = 0; dt < 3; ++dt) oacc[dt] = (f32x4){0.f, 0.f, 0.f, 0.f}; \
        if (w < 4) { \
            const int T = w; \
            bf16x8 bq[8]; \
        _Pragma("unroll") \
            for (int ks = 0; ks < 8; ++ks) bq[ks] = *(const LAS bf16x8*)(F.lds + ML_QL + (16 * T + r16) * ML_RS + ks * 64 + q4 * 16); \
            f32x4 sa[4]; \
        _Pragma("unroll") \
            for (int s4 = 0; s4 < 4; ++s4) { sa[s4] = (f32x4){0.f, 0.f, 0.f, 0.f}; \
                if (s4 <= T) { \
        _Pragma("unroll") \
                    for (int ks = 0; ks < 8; ++ks) { const bf16x8 a = *(const LAS bf16x8*)(F.lds + kb + (16 * s4 + r16) * ML_RS + ks * 64 + q4 * 16); sa[s4] = MFMA16(a, bq[ks], sa[s4]); } } } \
            const int tl = 16 * T + r16; const float Mt = gp[64 + tl]; \
        _Pragma("unroll") \
            for (int s4 = 0; s4 < 4; ++s4) { const f32x4 uu = *(const LAS f32x4*)(gp + 16 * s4 + 4 * q4); \
        _Pragma("unroll") \
                for (int e = 0; e < 4; ++e) { const int sl_ = 16 * s4 + 4 * q4 + e; sa[s4][e] = (sl_ <= tl) ? sa[s4][e] * __expf(uu[e] - Mt) : 0.f; } } \
        _Pragma("unroll") \
            for (int kk = 0; kk < 2; ++kk) { const bf16x8 pf = mk_frag(pack4(sa[2 * kk]), pack4(sa[2 * kk + 1])); \
        _Pragma("unroll") \
                for (int dt = 0; dt < 3; ++dt) { bf16x8 a; \
                    if (dt < 2) { const LAS unsigned char* vp = F.lds + vt + (16 * dt + r16) * ML_TS + (32 * kk + 4 * q4) * 2; a = mk_frag(*(const LAS u32x2*)vp, *(const LAS u32x2*)(vp + 32)); } \
                    else a = (r16 == 0) ? ones : zeros; \
                    oacc[dt] = MFMA16(a, pf, oacc[dt]); } } \
        } else { \
            const int T = w - 4; f32x4 ia[3]; \
        _Pragma("unroll") \
            for (int dt = 0; dt < 3; ++dt) ia[dt] = (f32x4){0.f, 0.f, 0.f, 0.f}; \
        _Pragma("unroll") \
            for (int ks = 0; ks < 8; ++ks) { const bf16x8 bqv = *(const LAS bf16x8*)(F.lds + ML_QL + (16 * T + r16) * ML_RS + ks * 64 + q4 * 16); \
        _Pragma("unroll") \
                for (int dt = 0; dt < 3; ++dt) { bf16x8 a; \
                    if (dt < 2) a = *(const LAS bf16x8*)(F.lds + ML_CT + (16 * dt + r16) * ML_RS + ks * 64 + q4 * 16); \
                    else { a = *(const LAS bf16x8*)(F.lds + ML_CT + 32 * ML_RS + ks * 64 + q4 * 16); if (r16 != 0) a = zeros; } \
                    ia[dt] = MFMA16(a, bqv, ia[dt]); } } \
            const int tl = 16 * T + r16; \
            *(LAS f32x4*)(F.lds + ML_X + tl * 144 + (4 * q4) * 4) = ia[0]; *(LAS f32x4*)(F.lds + ML_X + tl * 144 + (16 + 4 * q4) * 4) = ia[1]; \
            if (q4 == 0) *(LAS f32x4*)(F.lds + ML_X + tl * 144 + 32 * 4) = ia[2]; \
        } \
        } \
        __syncthreads(); \
        if (w < 4) { \
            const int tl = 16 * w + r16; const float at = gp[128 + tl], en = gp[192 + tl]; \
            const f32x4 x0 = *(const LAS f32x4*)(F.lds + ML_X + tl * 144 + (4 * q4) * 4), x1 = *(const LAS f32x4*)(F.lds + ML_X + tl * 144 + (16 + 4 * q4) * 4); \
            const float xd = *(const LAS float*)(F.lds + ML_X + tl * 144 + 32 * 4); \
            const f32x4 n0 = oacc[0] + x0 * at, n1 = oacc[1] + x1 * at; \
            float den = oacc[2][0] + xd * at; den = __shfl(den, r16); \
            float sq = (n0[0] * n0[0] + n0[1] * n0[1]) + (n0[2] * n0[2] + n0[3] * n0[3]) + (n1[0] * n1[0] + n1[1] * n1[1]) + (n1[2] * n1[2] + n1[3] * n1[3]); \
            sq += __shfl_xor(sq, 16); sq += __shfl_xor(sq, 32); \
            const size_t ro = (size_t)(rowc + tl) * BW + 4 * q4; \
            const f32x4 ng0 = *(const gf32x4*)(norm_g + h * 512 + sl * 32 + 4 * q4), ng1 = *(const gf32x4*)(norm_g + h * 512 + sl * 32 + 16 + 4 * q4); \
            f32x4 t0, t1; \
            t0[0] = n0[0] * ng0[0] * bf_lo(ob0.x); t0[1] = n0[1] * ng0[1] * bf_hi(ob0.x); t0[2] = n0[2] * ng0[2] * bf_lo(ob0.y); t0[3] = n0[3] * ng0[3] * bf_hi(ob0.y); \
            t1[0] = n1[0] * ng1[0] * bf_lo(ob1.x); t1[1] = n1[1] * ng1[1] * bf_hi(ob1.x); t1[2] = n1[2] * ng1[2] * bf_lo(ob1.y); t1[3] = n1[3] * ng1[3] * bf_hi(ob1.y); \
            *(gu32x2*)(NUM + ro) = pack4(t0); *(gu32x2*)(NUM + ro + 16) = pack4(t1); \
            if (q4 == 0) { SSQC[(size_t)(rowc + tl) * 64 + h * 16 + sl] = sq; if (sl == 0) DNB[(size_t)(rowc + tl) * 4 + h] = fmaxf(fabsf(den), en); } \
        } \
        { const float dec = gp[320]; \
        _Pragma("unroll") \
          for (int i = 0; i < 2; ++i) \
        _Pragma("unroll") \
              for (int dt = 0; dt < 3; ++dt) st[i][dt] = st[i][dt] * dec; \
        _Pragma("unroll") \
          for (int kk = 0; kk < 2; ++kk) { bf16x8 a[2], bv[3]; \
        _Pragma("unroll") \
              for (int i = 0; i < 2; ++i) a[i] = tr_frag8(F.lds + kb, ML_RS, 32 * kk + 8 * q4, 32 * w + 16 * i, r16); \
        _Pragma("unroll") \
              for (int dt = 0; dt < 2; ++dt) bv[dt] = *(const LAS bf16x8*)(F.lds + vw + (16 * dt + r16) * ML_TS + kk * 64 + q4 * 16); \
              bv[2] = *(const LAS bf16x8*)(F.lds + vw + 32 * ML_TS + kk * 64 + q4 * 16); if (r16 != 0) bv[2] = zeros; \
        _Pragma("unroll") \
              for (int i = 0; i < 2; ++i) \
        _Pragma("unroll") \
                  for (int dt = 0; dt < 3; ++dt) st[i][dt] = MFMA16(a[i], bv[dt], st[i][dt]); } \
        _Pragma("unroll") \
          for (int i = 0; i < 2; ++i) { \
        _Pragma("unroll") \
              for (int dt = 0; dt < 2; ++dt) *(LAS u32x2*)(F.lds + ML_CT + (16 * dt + r16) * ML_RS + (32 * w + 16 * i + 4 * q4) * 2) = pack4(st[i][dt]); \
              if (r16 == 0) *(LAS u32x2*)(F.lds + ML_CT + 32 * ML_RS + (32 * w + 16 * i + 4 * q4) * 2) = pack4(st[i][2]); } } \
        for (int rp_ = 0; rp_ < ML_RWR; ++rp_) if (c + 1 < 32) ML_WRITE(kbn, vwn, gpn, WQ_, WK_, WV_); \
        __syncthreads(); \
    } while (0)
    for (int c2 = 0; c2 < 32; ++c2) { ML_STEP(c2, qra, kra, vra, qra, kra, vra); }
#undef ML_LOAD
#undef ML_GLOAD
#undef ML_GPREP
#undef ML_WRITE
#undef ML_STEP
}

__device__ __forceinline__ void p2b_finalize(const Ctx& F, guchar* ws) {
    int lane = F.lane; LAUNDER_V(lane); const int gw = F.vcu * NWAVES + F.wave, NGW = F.G * NWAVES;
    const gbf16* NUM = (const gbf16*)(ws + WS_NUM); gbf16* YC = (gbf16*)(ws + WS_YA) + (size_t)2 * M_ROWS * BW;
    for (int m = gw; m < M_ROWS; m += NGW) {
        float s = ((const gfloat*)(ws + WS_SSQC))[(size_t)m * 64 + lane];
        s += __shfl_xor(s, 1); s += __shfl_xor(s, 2); s += __shfl_xor(s, 4); s += __shfl_xor(s, 8);
        const float dn = ((const gfloat*)(ws + WS_DN))[(size_t)m * 4 + (lane >> 4)];
        const float inv = 1.0f / dn; const float sc = inv * rsqrtf(s * (1.0f / 512.0f) * inv * inv + NORM_EPS);
#pragma unroll
        for (int it = 0; it < 4; ++it) { const float f = __shfl(sc, 16 * it); const size_t o = (size_t)m * BW + (size_t)(it * 64 + lane) * 8;
            const u32x4 nb = *(const gu32x4*)(NUM + o); u32x4 y;
            y.x = cvt_pk_bf16(bf_lo(nb.x) * f, bf_hi(nb.x) * f); y.y = cvt_pk_bf16(bf_lo(nb.y) * f, bf_hi(nb.y) * f);
            y.z = cvt_pk_bf16(bf_lo(nb.z) * f, bf_hi(nb.z) * f); y.w = cvt_pk_bf16(bf_lo(nb.w) * f, bf_hi(nb.w) * f);
            *(gu32x4*)(YC + o) = y; }
    }
}
__device__ __forceinline__ void p5b_ssq(const Ctx& F, guchar* ws) {
    int lane = F.lane; LAUNDER_V(lane); const int gw = F.vcu * NWAVES + F.wave, NGW = F.G * NWAVES;
    for (int m = gw; m < M_ROWS; m += NGW) { const float s = wave_sum(((const gfloat*)(ws + WS_XSP))[(size_t)m * 64 + lane]); if (lane == 0) ((gfloat*)(ws + WS_CTL + CTL_SSQ1))[m] = s; }
}
__device__ __forceinline__ void p4b_x1(const Ctx& F, guchar* ws, const gfloat* npost) {
    int lane = F.lane; LAUNDER_V(lane); const int gw = F.vcu * NWAVES + F.wave, NGW = F.G * NWAVES;
    const gbf16* OUT = (const gbf16*)(ws + WS_OUT); const gbf16* XB = (const gbf16*)(ws + WS_XB); gbf16* X1B = (gbf16*)(ws + WS_X1B);
    for (int m = gw; m < M_ROWS; m += NGW) {
        const float so = wave_sum(((const gfloat*)(ws + WS_OUTP))[(size_t)m * 64 + lane]), se = wave_sum(((const gfloat*)(ws + WS_ERP))[(size_t)m * 64 + lane]);
        const float rso = rsqrtf(so * (1.0f / DM) + NORM_EPS), rse = rsqrtf(se * (1.0f / DM) + NORM_EPS);
        if (lane == 0) { ((gfloat*)(ws + WS_RSO))[m] = rso; ((gfloat*)(ws + WS_RSE))[m] = rse; }
#pragma unroll
        for (int it = 0; it < 8; ++it) { const int c = (it * 64 + lane) * 8; const size_t o = (size_t)m * DM + c;
            const u32x4 xb = *(const gu32x4*)(XB + o), ob = *(const gu32x4*)(OUT + o); const f32x4 n0 = *(const gf32x4*)(npost + c), n1 = *(const gf32x4*)(npost + c + 4); u32x4 y;
            y.x = cvt_pk_bf16(bf_lo(xb.x) + bf_lo(ob.x) * rso * n0[0], bf_hi(xb.x) + bf_hi(ob.x) * rso * n0[1]);
            y.y = cvt_pk_bf16(bf_lo(xb.y) + bf_lo(ob.y) * rso * n0[2], bf_hi(xb.y) + bf_hi(ob.y) * rso * n0[3]);
            y.z = cvt_pk_bf16(bf_lo(xb.z) + bf_lo(ob.z) * rso * n1[0], bf_hi(xb.z) + bf_hi(ob.z) * rso * n1[1]);
            y.w = cvt_pk_bf16(bf_lo(xb.w) + bf_lo(ob.w) * rso * n1[2], bf_hi(xb.w) + bf_hi(ob.w) * rso * n1[3]);
            *(gu32x4*)(X1B + o) = y; }
    }
}

#ifndef REP_P0
#define REP_P0 1
#endif
#ifndef REP_P1
#define REP_P1 1
#endif
#ifndef REP_ML
#define REP_ML 1
#endif
#ifndef REP_SW
#define REP_SW 1
#endif
#ifndef REP_GM
#define REP_GM 1
#endif
#ifndef REP_P3
#define REP_P3 1
#endif
#ifndef REP_THIN
#define REP_THIN 1
#endif
#ifndef REP_BAR
#define REP_BAR 1
#endif
#ifndef REP_P4
#define REP_P4 1
#endif
__device__ __forceinline__ unsigned long long arg_ld(LAS unsigned char* lds, int i) {
    unsigned a = (unsigned)(ARGS_OFF + 8 * i); asm volatile("" : "+v"(a));
    const volatile LAS unsigned* q = (const volatile LAS unsigned*)(lds + a);
    const unsigned lo = q[0], hi = q[1];
    return ((unsigned long long)(unsigned)__builtin_amdgcn_readfirstlane((int)hi) << 32) | (unsigned)__builtin_amdgcn_readfirstlane((int)lo);
}
struct Args { const void* in[19]; float* out; unsigned char* ws; };
static_assert(sizeof(Args) == 21 * 8, "no padding in Args");

__global__ void __launch_bounds__(NTHREADS, 2) fwd_kernel(Args args) {
    extern __shared__ __attribute__((aligned(16))) unsigned char lds_raw[];
    Ctx F; F.lds = (LAS unsigned char*)lds_raw; F.tid = threadIdx.x; F.lane = F.tid & 63; F.wave = __builtin_amdgcn_readfirstlane(F.tid >> 6);
    F.G = gridDim.x; F.bx = blockIdx.x; { const int bx = blockIdx.x; F.vcu = (F.G % 8 == 0) ? (bx % 8) * (F.G / 8) + bx / 8 : bx; }
    guchar* ws0 = (guchar*)args.ws;
#define WSL() ({ guchar* w_ = ws0; LAUNDER_S(w_); w_; })
    volatile LAS unsigned* MISC = (volatile LAS unsigned*)(F.lds + MISC_OFF);
    if (F.tid < 32) MISC[F.tid] = 0u;
    __syncthreads();
    const XcdBarrier bar = xcd_barrier_post((unsigned*)(ws0 + WS_CTL) + CW_BAR, MISC);

    if (F.tid < 19) ((LAS unsigned long long*)(F.lds + ARGS_OFF))[F.tid] = (unsigned long long)args.in[F.tid];
    if (F.tid == 19) ((LAS unsigned long long*)(F.lds + ARGS_OFF))[19] = (unsigned long long)args.out;
    __syncthreads();
#define ARGP(T, i) ((T)arg_ld(F.lds, (i)))

#define FL() ({ Ctx f_ = F; LAUNDER_S(f_.lds); LAUNDER_S(f_.wave); LAUNDER_S(f_.vcu); LAUNDER_S(f_.G); LAUNDER_S(f_.bx); f_; })
#ifndef SKIP_P0
    for (int rep_ = 0; rep_ < REP_P0; ++rep_) { const Ctx Fp = FL(); guchar* ws = WSL(); p0_prologue(FL(), ARGP(const gfloat*, 0), ARGP(const gfloat*, 1), ARGP(const gint*, 2), ARGP(const gfloat*, 3), ARGP(const gfloat*, 4), ARGP(const gfloat*, 13), ARGP(const gfloat*, 14), ARGP(const gfloat*, 18), ARGP(const gfloat*, 16), ws); }
#endif
    for (int rb_ = 0; rb_ < REP_BAR; ++rb_) xcd_barrier(bar);

    for (int l = 0; l < NLAYER; ++l) {
        const gfloat* xin = l == 0 ? ARGP(const gfloat*, 0) : (const gfloat*)ARGP(gfloat*, 19);
#ifndef SKIP_P1
        for (int rep_ = 0; rep_ < REP_P1; ++rep_) { const Ctx Fp = FL(); guchar* ws = WSL(); const gfloat* ssq = l == 0 ? (const gfloat*)(ws + WS_SSQ0) : (const gfloat*)(ws + WS_CTL + CTL_SSQ1); pg8::SchedPlain S; S.T.init(M_ROWS / 256, NT_IN, Fp.G, Fp.bx); S.A = (const gchar*)(ws + WS_XB); S.B = (const gchar*)(ws + WS_WIN + (size_t)l * SZ_WIN);
          S.astep = (size_t)256 * DM * 2; S.bstep = (size_t)256 * DM * 2;
          pg8::EpiIn E{ssq, ws};
          pg8::gemm_phase<pg8::EpiIn, pg8::SchedPlain>(Fp.lds, DM, DM, DM, S, E); }
#ifdef PROBE_P1CHEAP
        { const Ctx Fp = FL(); guchar* ws = WSL(); pg8::SchedPlain S; S.T.init(M_ROWS / 256, NT_IN, Fp.G, Fp.bx); S.A = (const gchar*)(ws + WS_XB); S.B = (const gchar*)(ws + WS_WIN + (size_t)l * SZ_WIN);
          S.astep = (size_t)256 * DM * 2; S.bstep = (size_t)256 * DM * 2;
          pg8::EpiSq E{(gbf16*)(ws + WS_END), (gfloat*)(ws + WS_END + (size_t)M_ROWS * 31488 * 2)};
          pg8::gemm_phase<pg8::EpiSq, pg8::SchedPlain>(Fp.lds, DM, DM, DM, S, E); }
#endif
        { const Ctx Fq = FL(); const int nwg_ = (M_ROWS / 256) * NT_IN, rem_ = nwg_ % Fq.G;
          if (rem_ == 0 || Fq.bx >= rem_) { const int me = rem_ ? Fq.bx - rem_ : Fq.bx, nw = rem_ ? Fq.G - rem_ : Fq.G;
            { const Ctx Fp = FL(); guchar* ws = WSL(); pg8::SchedPlain S; S.T.init(M_ROWS / 256, DM / 256, nw, me); S.A = (const gchar*)(ws + WS_PB + (size_t)l * M_ROWS * 256 * 2); S.B = (const gchar*)(ws + WS_WPP + (size_t)l * SZ_WPP);
              S.astep = (size_t)256 * 256 * 2; S.bstep = (size_t)256 * 256 * 2;
              pg8::EpiSq E{(gbf16*)(ws + WS_ERAW), (gfloat*)(ws + WS_ERP)};
              pg8::gemm_phase<pg8::EpiSq, pg8::SchedPlain>(Fp.lds, 256, 256, 256, S, E); }
            if (l == 0) tr_run(FL(), TR_DEFER0, TR_DEFER1, 0x7fffffff, 0x7fffffff, me, nw, ARGP(const gfloat*, 4), ARGP(const gfloat*, 3), ARGP(const gfloat*, 13), ARGP(const gfloat*, 14), ARGP(const gfloat*, 18), ARGP(const gfloat*, 16), WSL()); } }
#endif
        for (int rb_ = 0; rb_ < REP_BAR; ++rb_) xcd_barrier(bar);
#ifndef SKIP_ML
        for (int rep_ = 0; rep_ < REP_ML; ++rep_) { const Ctx Fp = FL(); guchar* ws = WSL(); for (int u = Fp.vcu; u < 256; u += Fp.G) mlstm_unit(Fp, u >> 6, (u >> 4) & 3, u & 15, ws, ARGP(const gfloat*, 10) + l * 4, ARGP(const gfloat*, 11) + l * 4, ARGP(const gfloat*, 12) + l * BW); }
#endif
#ifndef SKIP_SW
        for (int rep_ = 0; rep_ < REP_SW; ++rep_) { const Ctx Fp = FL(); guchar* ws = WSL(); for (int u = Fp.vcu; u < 256; u += Fp.G) swa_unit(Fp, u >> 6, (u >> 2) & 15, u & 3, ws, ARGP(const gfloat*, 9) + l * 32); }
#endif
#ifndef SKIP_GM
        for (int rep_ = 0; rep_ < REP_GM; ++rep_) { const Ctx Fp = FL(); guchar* ws = WSL(); for (int u = Fp.vcu; u < 512; u += Fp.G) gmlp_unit(Fp, u >> 7, (u >> 3) & 15, u & 7, ws, ARGP(const gfloat*, 5) + l * BW, ARGP(const gfloat*, 6) + l * BW, ARGP(const gfloat*, 7) + (size_t)l * 8 * 128 * 128, ARGP(const gfloat*, 8) + l * 8 * 128); }
#endif
        for (int rb_ = 0; rb_ < REP_BAR; ++rb_) xcd_barrier(bar);
#ifndef SKIP_P2B
        for (int rep_ = 0; rep_ < REP_THIN; ++rep_) p2b_finalize(FL(), WSL());
#endif
        for (int rb_ = 0; rb_ < REP_BAR; ++rb_) xcd_barrier(bar);
#ifndef PROBE_NOSTORE
#define PROBE_NOSTORE 0
#endif
#ifdef PROBE_K1024
        for (int rep_ = 0; rep_ < 4; ++rep_) { const Ctx Fp = FL(); guchar* ws = WSL(); pg8::SchedPlain S; S.T.init(M_ROWS / 256, DM / 256, Fp.G, Fp.bx); S.A = (const gchar*)(ws + WS_YA); S.B = (const gchar*)(ws + WS_WOUT + (size_t)l * SZ_WSQ);
          S.astep = (size_t)256 * DM * 2; S.bstep = (size_t)256 * DM * 2;
          pg8::EpiSq E{PROBE_NOSTORE ? (gbf16*)nullptr : (gbf16*)(ws + WS_END), (gfloat*)(ws + WS_END + (size_t)M_ROWS * 31488 * 2)};
          pg8::gemm_phase<pg8::EpiSq, pg8::SchedPlain>(Fp.lds, 1024, DM, DM, S, E); }
#endif
#ifdef PROBE_P3CHEAP
        { const Ctx Fp = FL(); guchar* ws = WSL(); pg8::SchedBranch S; S.T.init(M_ROWS / 256, DM / 256, Fp.G, Fp.bx); S.A = (const gchar*)(ws + WS_YA); S.B = (const gchar*)(ws + WS_WBR + (size_t)l * SZ_WBR);
          S.astep = (size_t)256 * BW * 2; S.bstep = (size_t)256 * BW * 2; S.aseg = SZ_ROWS_BW; S.bseg = (size_t)DM * BW * 2;
          pg8::EpiSq E{(gbf16*)(ws + WS_END), (gfloat*)(ws + WS_END + (size_t)M_ROWS * 31488 * 2)};
          pg8::gemm_phase<pg8::EpiSq, pg8::SchedBranch>(Fp.lds, BW, BW, BW, S, E); }
#endif
#ifndef SKIP_P3
        for (int rep_ = 0; rep_ < REP_P3; ++rep_) { const Ctx Fp = FL(); guchar* ws = WSL(); pg8::SchedBranch S; S.T.init(M_ROWS / 256, DM / 256, Fp.G, Fp.bx); S.A = (const gchar*)(ws + WS_YA); S.B = (const gchar*)(ws + WS_WBR + (size_t)l * SZ_WBR);
          S.astep = (size_t)256 * BW * 2; S.bstep = (size_t)256 * BW * 2; S.aseg = SZ_ROWS_BW; S.bseg = (size_t)DM * BW * 2;
          pg8::EpiBranch E{(const gbf16*)(ws + WS_G), (gbf16*)(ws + WS_MIX)};
          pg8::gemm_phase<pg8::EpiBranch, pg8::SchedBranch>(Fp.lds, BW, BW, BW, S, E); }
#endif
        for (int rb_ = 0; rb_ < REP_BAR; ++rb_) xcd_barrier(bar);
#ifndef SKIP_P4
        for (int rep_ = 0; rep_ < REP_P4; ++rep_) { const Ctx Fp = FL(); guchar* ws = WSL(); pg8::SchedPlain S; S.T.init(M_ROWS / 256, DM / 256, Fp.G, Fp.bx); S.A = (const gchar*)(ws + WS_MIX); S.B = (const gchar*)(ws + WS_WOUT + (size_t)l * SZ_WSQ);
          S.astep = (size_t)256 * DM * 2; S.bstep = (size_t)256 * DM * 2;
          pg8::EpiSq E{(gbf16*)(ws + WS_OUT), (gfloat*)(ws + WS_OUTP)};
          pg8::gemm_phase<pg8::EpiSq, pg8::SchedPlain>(Fp.lds, DM, DM, DM, S, E); }
#endif
        for (int rb_ = 0; rb_ < REP_BAR; ++rb_) xcd_barrier(bar);
#ifndef SKIP_P4B
        for (int rep_ = 0; rep_ < REP_THIN; ++rep_) p4b_x1(FL(), WSL(), ARGP(const gfloat*, 15) + l * DM);
#endif
        for (int rb_ = 0; rb_ < REP_BAR; ++rb_) xcd_barrier(bar);
#ifdef PROBE_P5
        { const Ctx Fp = FL(); guchar* ws = WSL(); pg8::SchedPlain S; S.T.init(M_ROWS / 256, DM / 256, Fp.G, Fp.bx); S.A = (const gchar*)(ws + WS_X1B); S.B = (const gchar*)(ws + WS_WPG + (size_t)l * SZ_WSQ);
          S.astep = (size_t)256 * DM * 2; S.bstep = (size_t)256 * DM * 2;
          pg8::EpiPle E{xin, (gfloat*)(ws + WS_END), (gbf16*)(ws + WS_END + (size_t)M_ROWS * DM * 4), (const gbf16*)(ws + WS_OUT), (const gbf16*)(ws + WS_ERAW), (const gfloat*)(ws + WS_RSO), (const gfloat*)(ws + WS_RSE),
                        ARGP(const gfloat*, 15) + l * DM, ARGP(const gfloat*, 17) + l * DM, (gfloat*)(ws + WS_END + (size_t)M_ROWS * DM * 6), 0};
          pg8::gemm_phase<pg8::EpiPle, pg8::SchedPlain>(Fp.lds, DM, DM, DM, S, E); }
#endif
#ifndef SKIP_P5
        { const Ctx Fp = FL(); guchar* ws = WSL(); pg8::SchedPlain S; S.T.init(M_ROWS / 256, DM / 256, Fp.G, Fp.bx); S.A = (const gchar*)(ws + WS_X1B); S.B = (const gchar*)(ws + WS_WPG + (size_t)l * SZ_WSQ);
          S.astep = (size_t)256 * DM * 2; S.bstep = (size_t)256 * DM * 2;
          pg8::EpiPle E{xin, ARGP(gfloat*, 19), (gbf16*)(ws + WS_XB), (const gbf16*)(ws + WS_OUT), (const gbf16*)(ws + WS_ERAW), (const gfloat*)(ws + WS_RSO), (const gfloat*)(ws + WS_RSE),
                        ARGP(const gfloat*, 15) + l * DM, ARGP(const gfloat*, 17) + l * DM, (gfloat*)(ws + WS_XSP), l == NLAYER - 1 ? 1 : 0};
          pg8::gemm_phase<pg8::EpiPle, pg8::SchedPlain>(Fp.lds, DM, DM, DM, S, E); }
#endif
        if (l + 1 < NLAYER) { for (int rb_ = 0; rb_ < REP_BAR; ++rb_) xcd_barrier(bar); p5b_ssq(FL(), WSL()); for (int rb_ = 0; rb_ < REP_BAR; ++rb_) xcd_barrier(bar); }
    }
}

extern "C" void kernel_launch(void* const* d_in, const int* in_sizes, int n_in, void* d_out, int out_size, void* d_ws, size_t ws_size, hipStream_t stream) {
    static int grid = 0;
    if (grid == 0) {
        if (n_in != 19 || out_size != M_ROWS * DM || ws_size < WS_END) { fprintf(stderr, "kernel_launch: unexpected problem (n_in %d, out %d, ws %zu, need %zu)\n", n_in, out_size, ws_size, (size_t)WS_END); grid = -1; return; }
        int dev = 0, cus = 0;
        if (hipGetDevice(&dev) != hipSuccess || hipDeviceGetAttribute(&cus, hipDeviceAttributeMultiprocessorCount, dev) != hipSuccess) { grid = -1; return; }
        if (hipFuncSetAttribute((const void*)fwd_kernel, hipFuncAttributeMaxDynamicSharedMemorySize, LDS_BYTES) != hipSuccess) { fprintf(stderr, "kernel_launch: hipFuncSetAttribute failed\n"); grid = -1; return; }
        int per_cu = 0; (void)hipOccupancyMaxActiveBlocksPerMultiprocessor(&per_cu, (const void*)fwd_kernel, NTHREADS, LDS_BYTES); (void)hipGetLastError();
        if (per_cu < 1) fprintf(stderr, "kernel_launch: occupancy query reports %d blocks per CU\n", per_cu);
        grid = cus > 256 ? 256 : cus;
    }
    if (grid < 0) return;
    (void)hipMemsetAsync((char*)d_ws + WS_CTL, 0, CTL_ZERO_BYTES, stream);
    Args a{};
    for (int i = 0; i < 19; ++i) a.in[i] = d_in[i];
    a.out = (float*)d_out; a.ws = (unsigned char*)d_ws;
    hipLaunchKernelGGL(fwd_kernel, dim3(grid), dim3(NTHREADS), LDS_BYTES, stream, a);
    const hipError_t le = hipPeekAtLastError();
    if (le != hipSuccess) fprintf(stderr, "kernel_launch: launch failed: %s\n", hipGetErrorName(le));
}
```

```cpp
#include <hip/hip_runtime.h>
#include <cstdio>
#include <cstdint>

#define LAS __attribute__((address_space(3)))
#define GAS __attribute__((address_space(1)))
typedef unsigned short bf16_t;
typedef short bf16x8 __attribute__((ext_vector_type(8)));
typedef float f32x4 __attribute__((ext_vector_type(4)));
typedef float f32x2 __attribute__((ext_vector_type(2)));
typedef unsigned u32x4 __attribute__((ext_vector_type(4)));
typedef unsigned u32x2 __attribute__((ext_vector_type(2)));

typedef GAS float gfloat; typedef GAS bf16_t gbf16; typedef GAS int gint; typedef GAS char gchar; typedef GAS unsigned char guchar; typedef GAS unsigned gunsigned;
typedef GAS f32x4 gf32x4; typedef GAS f32x2 gf32x2; typedef GAS u32x4 gu32x4; typedef GAS u32x2 gu32x2;
constexpr int M_ROWS = 8192, SEQ = 2048, DM = 4096, BW = 2048, NLAYER = 2;
constexpr int N_IN = 31240, IF_COL = 14848;
constexpr int NT_IN = 123;
constexpr int N_IN_T = NT_IN * 256;
constexpr float NORM_EPS = 1e-6f;

__device__ __forceinline__ unsigned cvt_pk_bf16(float lo, float hi) { unsigned r; asm("v_cvt_pk_bf16_f32 %0, %1, %2" : "=v"(r) : "v"(lo), "v"(hi)); return r; }
__device__ __forceinline__ float bf_lo(unsigned w) { return __uint_as_float(w << 16); }
__device__ __forceinline__ float bf_hi(unsigned w) { return __uint_as_float(w & 0xffff0000u); }
__device__ __forceinline__ float bf1(bf16_t b) { return __uint_as_float(((unsigned)b) << 16); }
__device__ __forceinline__ float fsigmoid(float x) { return __builtin_amdgcn_rcpf(1.0f + __expf(-x)); }
__device__ __forceinline__ float wave_sum(float v) {
#pragma unroll
    for (int o = 1; o < 64; o <<= 1) v += __shfl_xor(v, o);
    return v;
}
__device__ __forceinline__ f32x2 gelu_pk(f32x2 v) {
    const f32x2 av = __builtin_elementwise_abs(v), d = av * 0.2316418882f + 1.0f;
    f32x2 t; t.x = __builtin_amdgcn_rcpf(d.x); t.y = __builtin_amdgcn_rcpf(d.y);
    f32x2 q = t * 0.5307027145f + (-0.7265760135f); q = q * t + 0.7107068705f; q = q * t + (-0.142248368f); q = q * t + 0.127414796f; q = q * t;
    const f32x2 s = (v * v) * (-0.72134752044f);
    f32x2 e; e.x = __builtin_amdgcn_exp2f(s.x); e.y = __builtin_amdgcn_exp2f(s.y);
    const f32x2 m = v * (q * e), r = v - m;
    f32x2 o; o.x = v.x < 0.f ? m.x : r.x; o.y = v.y < 0.f ? m.y : r.y; return o;
}
#define LAUNDER_V(x) asm volatile("" : "+v"(x))
#define LAUNDER_S(x) asm volatile("" : "+s"(x))
#define LDS_WAIT() asm volatile("s_waitcnt lgkmcnt(0)" ::: "memory")
#define VM_WAIT() asm volatile("s_waitcnt vmcnt(0)" ::: "memory")
#define MFMA16(a, b, c) __builtin_amdgcn_mfma_f32_16x16x32_bf16((a), (b), (c), 0, 0, 0)

#define XB_TMO      128
#define XB_XCNT(j)  (256  + 64 * (j))
#define XB_XSUB(j)  (1280 + 64 * (j))
#define XB_XGEN(j)  (2304 + 64 * (j))
#define XB_TOP      3328
#define XB_TOPGEN   3392
#define XCD_BAR_WORDS 3456
#define XB_SPIN_CAP (1u << 18)
__device__ __forceinline__ unsigned xb_ld(unsigned* p)              { return __hip_atomic_load(p, __ATOMIC_RELAXED, __HIP_MEMORY_SCOPE_AGENT); }
__device__ __forceinline__ unsigned xb_add(unsigned* p, unsigned v) { return __hip_atomic_fetch_add(p, v, __ATOMIC_RELAXED, __HIP_MEMORY_SCOPE_AGENT); }
__device__ __forceinline__ unsigned xb_xcc_id() { return (unsigned)__builtin_amdgcn_s_getreg((3 << 11) | 20) & 0xFu; }
#define XB_SPIN(cond, bar) do { unsigned _sp = 0; while (cond) { __builtin_amdgcn_s_sleep(1); \
    if ((++_sp & 255u) == 0u) { if (xb_ld(&(bar)[XB_TMO])) break; if (_sp > XB_SPIN_CAP) { atomicAdd(&(bar)[XB_TMO], 1u); break; } } } } while (0)
struct XcdBarrier { unsigned* bar; unsigned x; volatile LAS unsigned* st; };
__device__ __forceinline__ XcdBarrier xcd_barrier_post(unsigned* bar, volatile LAS unsigned* st) {
    XcdBarrier b; b.bar = bar; b.x = xb_xcc_id(); b.st = st;
    if (threadIdx.x == 0) (void)xb_add(&bar[XB_XCNT(b.x)], 1u);
    return b;
}
__device__ __forceinline__ void xcd_barrier_complete(unsigned* bar, unsigned x, unsigned& nloc, unsigned& nx) {
    const unsigned G = gridDim.x * gridDim.y * gridDim.z;
    unsigned sum, cnt, mine, sp = 0u;
    for (;;) {
        sum = 0u; cnt = 0u; mine = 0u;
#pragma unroll
        for (unsigned j = 0; j < 16; ++j) { const unsigned c = xb_ld(&bar[XB_XCNT(j)]); sum += c; cnt += (c > 0u) ? 1u : 0u; mine = (j == x) ? c : mine; }
        if (sum == G) break;
        __builtin_amdgcn_s_sleep(1);
        if ((++sp & 255u) == 0u) { if (xb_ld(&bar[XB_TMO])) break; if (sp > XB_SPIN_CAP) { atomicAdd(&bar[XB_TMO], 1u); break; } }
    }
    nloc = mine > 0u ? mine : 1u; nx = cnt > 0u ? cnt : 1u;
}
__device__ __forceinline__ void xcd_barrier(const XcdBarrier& b) {
    asm volatile("s_waitcnt vmcnt(0)" ::: "memory");
    __syncthreads();
    if (threadIdx.x == 0) {
        unsigned* bar = b.bar;
        __builtin_amdgcn_s_waitcnt(0);
        unsigned nloc = b.st[0], nx = b.st[1];
        if (nloc == 0u) { xcd_barrier_complete(bar, b.x, nloc, nx); b.st[0] = nloc; b.st[1] = nx; }
        const unsigned old = xb_add(&bar[XB_XSUB(b.x)], 1u);
        const unsigned gen = old / nloc;
        if (old + 1u == (gen + 1u) * nloc) {
            __builtin_amdgcn_fence(__ATOMIC_RELEASE, "agent");
            asm volatile("s_waitcnt vmcnt(0)" ::: "memory");
            const unsigned og = xb_add(&bar[XB_TOP], 1u);
            const unsigned tg = og / nx;
            if (og + 1u == (tg + 1u) * nx) xb_add(&bar[XB_TOPGEN], 1u);
            else XB_SPIN(xb_ld(&bar[XB_TOPGEN]) == tg, bar);
            __builtin_amdgcn_fence(__ATOMIC_ACQUIRE, "agent");
            xb_add(&bar[XB_XGEN(b.x)], 1u);
            asm volatile("s_waitcnt vmcnt(0)" ::: "memory");
        } else {
            XB_SPIN(xb_ld(&bar[XB_XGEN(b.x)]) == gen, bar);
            __builtin_amdgcn_fence(__ATOMIC_ACQUIRE, "agent");
            asm volatile("s_waitcnt vmcnt(0)" ::: "memory");
        }
    }
    __syncthreads();
}

#ifndef WGM_DEFAULT
#define WGM_DEFAULT 4
#endif
namespace pg8 {
constexpr int BM = 256, BK = 64, HALF = 128, HTB = HALF * BK * 2, STAGE_BYTES = 8 * HTB, NXCD = 8, WGM = WGM_DEFAULT;
__host__ __device__ __forceinline__ int lds_byte(int r, int c) { const int st = (r >> 4) * 2 + (c >> 5), rr = r & 15, cc = c & 31, ob = rr * 64 + cc * 2; return st * 1024 + (ob ^ (((ob >> 9) & 1) << 5)); }
__host__ __device__ __forceinline__ void stage_rc(int b, int& R, int& C) { const int st = b / 1024, sb = b % 1024, swz = sb ^ (((sb >> 9) & 1) << 5); R = (st >> 1) * 16 + swz / 64; C = (st & 1) * 32 + (swz % 64) / 2; }
__host__ __device__ __forceinline__ int perm32(int rho) { const int n = rho >> 4, i = rho & 15; return 8 * (i >> 2) + 4 * n + (i & 3); }

struct Unit { int pm, pn, seg; };

struct TileOrder {
    int nM, nN, nwg, G, c, wgm;
    __device__ __forceinline__ void init(int nM_, int nN_, int G_, int c_, int wgm_ = WGM) { nM = nM_; nN = nN_; nwg = nM * nN; G = G_; c = c_; wgm = wgm_; }
    __device__ __forceinline__ bool tile(int i, int& pm, int& pn) const {
        const long L = (long)i * G + c; if (L >= nwg) return false;
        int wgid = (int)L; { const int q = nwg / NXCD, r = nwg % NXCD, xcd = wgid % NXCD, off = wgid / NXCD; wgid = (xcd < r ? xcd * (q + 1) : r * (q + 1) + (xcd - r) * q) + off; }
        const int nig = wgm * nN, gid = wgid / nig, fm = gid * wgm, gsz = (nM - fm) < wgm ? (nM - fm) : wgm;
        pm = fm + ((wgid % nig) % gsz); pn = (wgid % nig) / gsz; return true;
    }
};
struct SchedPlain {
    TileOrder T; const gchar* A; const gchar* B; size_t astep, bstep;
    __device__ __forceinline__ bool next(int i, Unit& u) const { u.seg = 0; return T.tile(i, u.pm, u.pn); }
    __device__ __forceinline__ const gchar* a_ptr(const Unit& u) const { return A + (size_t)u.pm * astep; }
    __device__ __forceinline__ const gchar* b_ptr(const Unit& u) const { return B + (size_t)u.pn * bstep; }
};
struct SchedBranch {
    TileOrder T; const gchar* A; const gchar* B; size_t astep, bstep, aseg, bseg;
    __device__ __forceinline__ bool next(int i, Unit& u) const { const int t = i / 3; u.seg = i - 3 * t; return T.tile(t, u.pm, u.pn); }
    __device__ __forceinline__ const gchar* a_ptr(const Unit& u) const { return A + (size_t)u.seg * aseg + (size_t)u.pm * astep; }
    __device__ __forceinline__ const gchar* b_ptr(const Unit& u) const { return B + (size_t)u.seg * bseg + (size_t)u.pn * bstep; }
};

template <class Epi, class Sched>
__device__ __forceinline__ void gemm_phase(LAS unsigned char* lds, const int K, const int lda, const int ldb, const Sched& S, const Epi& E) {
    int tid = threadIdx.x; LAUNDER_V(tid);
    const int wid = __builtin_amdgcn_readfirstlane(tid >> 6), lane = tid & 63, wr = wid >> 2, wc = wid & 3, fr = lane & 15, fq = lane >> 4;
    const int nt = K / BK;
    unsigned voffA, voffB;
    { int R, C; stage_rc(tid * 16, R, C); const int Rb = Epi::PERM ? ((R & ~31) + perm32(R & 31)) : R;
      voffA = (unsigned)(R * lda + C) * 2u; voffB = (unsigned)(Rb * ldb + C) * 2u; }
    const unsigned qstepA = 64u * (unsigned)lda * 2u, qstepB = 64u * (unsigned)ldb * 2u;
    const size_t kstep = (size_t)(BK * 2);
    const size_t hstepA = (size_t)HALF * lda * 2, hstepB = (size_t)HALF * ldb * 2;
    const unsigned ldsw = (unsigned)wid * 1024u;
    const int aoff = lds_byte(wr * 64 + fr, fq * 8), boff = lds_byte(wc * 32 + fr, fq * 8);
#define PG8_SA(b, h) (((b) * 2 + (h)) * HTB)
#define PG8_SB(b, h) ((4 + (b) * 2 + (h)) * HTB)
#define PG8_STAGE(bufoff, gbase, voff) do { _Pragma("unroll") for (int _i = 0; _i < 2; ++_i) \
        __builtin_amdgcn_global_load_lds((const gunsigned*)((const gchar*)(gbase) + (size_t)_i * q##voff + (voff)), (LAS unsigned*)(lds + (bufoff) + ldsw + _i * 8192), 16, 0, 0); } while (0)
#define qvoffA qstepA
#define qvoffB qstepB
#define PG8_LDA(dst, b, h) do { _Pragma("unroll") for (int m = 0; m < 4; ++m) _Pragma("unroll") for (int k = 0; k < 2; ++k) dst[m][k] = *(const LAS bf16x8*)(lds + PG8_SA(b, h) + aoff + m * 2048 + k * 1024); } while (0)
#define PG8_LDB(dst, b, h) do { _Pragma("unroll") for (int n = 0; n < 2; ++n) _Pragma("unroll") for (int k = 0; k < 2; ++k) dst[n][k] = *(const LAS bf16x8*)(lds + PG8_SB(b, h) + boff + n * 2048 + k * 1024); } while (0)
#define PG8_MMA(ai, bj, At, Bt) do { __builtin_amdgcn_s_setprio(1); _Pragma("unroll") for (int m = 0; m < 4; ++m) _Pragma("unroll") for (int n = 0; n < 2; ++n) _Pragma("unroll") for (int k = 0; k < 2; ++k) \
        acc[ai][bj][m][n] = __builtin_amdgcn_mfma_f32_16x16x32_bf16(Bt[n][k], At[m][k], acc[ai][bj][m][n], 0, 0, 0); __builtin_amdgcn_s_setprio(0); } while (0)
#define PG8_WAIT_V(n) asm volatile("s_waitcnt vmcnt(" #n ")" ::: "memory")
#define PG8_WAIT_VR() do { if constexpr (Epi::NS == 16) asm volatile("s_waitcnt vmcnt(24)" ::: "memory"); else if constexpr (Epi::NS == 32) asm volatile("s_waitcnt vmcnt(40)" ::: "memory"); else asm volatile("s_waitcnt vmcnt(8)" ::: "memory"); } while (0)
#define PG8_WAIT_L(n) asm volatile("s_waitcnt lgkmcnt(" #n ")" ::: "memory")
#define PG8_BAR __builtin_amdgcn_s_barrier()
#define PG8_SCHED __builtin_amdgcn_sched_barrier(0)
    Unit cur, nxt; int ui = 0; bool relax_next = false;
    if (!S.next(0, cur)) return;
    f32x4 acc[2][2][4][2];
#pragma unroll
    for (int a = 0; a < 2; ++a)
#pragma unroll
        for (int b = 0; b < 2; ++b)
#pragma unroll
            for (int m = 0; m < 4; ++m)
#pragma unroll
                for (int n = 0; n < 2; ++n) acc[a][b][m][n] = (f32x4){0.f, 0.f, 0.f, 0.f};
    bf16x8 At[4][2], B0[2][2], B1[2][2];
    const gchar* cA = S.a_ptr(cur); const gchar* cB = S.b_ptr(cur);
    PG8_STAGE(PG8_SB(0, 0), cB, voffB); PG8_STAGE(PG8_SB(0, 1), cB + hstepB, voffB); PG8_STAGE(PG8_SA(0, 0), cA, voffA); PG8_STAGE(PG8_SA(0, 1), cA + hstepA, voffA);
    if (wr == 1) PG8_BAR;
    PG8_WAIT_V(2); PG8_BAR;
    PG8_STAGE(PG8_SB(1, 0), cB + kstep, voffB); PG8_STAGE(PG8_SA(1, 0), cA + kstep, voffA); PG8_STAGE(PG8_SB(1, 1), cB + hstepB + kstep, voffB);
    PG8_WAIT_V(6); PG8_BAR;
    for (;;) {
        const bool has_next = S.next(ui + 1, nxt);
        const gchar* nA = has_next ? S.a_ptr(nxt) : cA; const gchar* nB = has_next ? S.b_ptr(nxt) : cB;
        for (int t = 0; t < nt; t += 2) {
            const bool last = (t == nt - 2); const bool relax = Epi::NS > 0 && (t == 0) && relax_next;
            const gchar* a1 = cA + (size_t)(t + 1) * kstep;
            const gchar* a2 = last ? nA : cA + (size_t)(t + 2) * kstep; const gchar* b2 = last ? nB : cB + (size_t)(t + 2) * kstep;
            const gchar* a3 = a2 + kstep; const gchar* b3 = b2 + kstep;
            PG8_LDB(B0, 0, 0); PG8_LDB(B1, 0, 1); PG8_SCHED; PG8_LDA(At, 0, 0); PG8_STAGE(PG8_SA(1, 1), a1 + hstepA, voffA);
            if (relax) PG8_WAIT_VR(); else PG8_WAIT_V(8); PG8_WAIT_L(0); PG8_BAR; PG8_MMA(0, 0, At, B0); PG8_MMA(0, 1, At, B1); PG8_BAR; PG8_SCHED;
            PG8_LDA(At, 0, 1); PG8_STAGE(PG8_SB(0, 0), b2, voffB); PG8_STAGE(PG8_SB(0, 1), b2 + hstepB, voffB); PG8_STAGE(PG8_SA(0, 0), a2, voffA);
            if (relax) PG8_WAIT_VR(); else PG8_WAIT_V(8); PG8_WAIT_L(0); PG8_BAR; PG8_MMA(1, 0, At, B0); PG8_MMA(1, 1, At, B1); PG8_BAR; PG8_SCHED;
            PG8_LDB(B0, 1, 0); PG8_LDB(B1, 1, 1); PG8_SCHED; PG8_LDA(At, 1, 0); PG8_STAGE(PG8_SA(0, 1), a2 + hstepA, voffA);
            PG8_WAIT_V(8); PG8_WAIT_L(0); PG8_BAR; PG8_MMA(0, 0, At, B0); PG8_MMA(0, 1, At, B1); PG8_BAR; PG8_SCHED;
            PG8_LDA(At, 1, 1); PG8_STAGE(PG8_SB(1, 0), b3, voffB); PG8_STAGE(PG8_SB(1, 1), b3 + hstepB, voffB); PG8_STAGE(PG8_SA(1, 0), a3, voffA);
            PG8_WAIT_V(8); PG8_WAIT_L(0); PG8_BAR; PG8_MMA(1, 0, At, B0); PG8_MMA(1, 1, At, B1); PG8_BAR; PG8_SCHED;
        }
        if (wr == 0) PG8_BAR;
        { const int ln_ = (int)__builtin_amdgcn_mbcnt_hi(~0u, __builtin_amdgcn_mbcnt_lo(~0u, 0u)); E(acc, cur, wr, wc, ln_ & 15, ln_ >> 4); } relax_next = E.relax(cur);
        if (!has_next) break;
        if (!E.keep(cur)) {
#pragma unroll
            for (int a = 0; a < 2; ++a)
#pragma unroll
                for (int b = 0; b < 2; ++b)
#pragma unroll
                    for (int m = 0; m < 4; ++m)
#pragma unroll
                        for (int n = 0; n < 2; ++n) acc[a][b][m][n] = (f32x4){0.f, 0.f, 0.f, 0.f};
        }
        cur = nxt; cA = nA; cB = nB; ++ui;
        if (wr == 1) PG8_BAR;
    }
    PG8_WAIT_V(0);
    PG8_BAR;
#undef PG8_SA
#undef PG8_SB
#undef PG8_STAGE
#undef qvoffA
#undef qvoffB
#undef PG8_LDA
#undef PG8_LDB
#undef PG8_MMA
#undef PG8_WAIT_V
#undef PG8_WAIT_VR
#undef PG8_WAIT_L
#undef PG8_BAR
#undef PG8_SCHED
}
}

constexpr size_t MiB = 1u << 20;
constexpr size_t WS_CTL = 0, CTL_ZERO_BYTES = 1 * MiB;
constexpr int CW_BAR = 4096;
constexpr size_t CTL_SSQ1 = 256 * 1024;
constexpr size_t SZ_WIN = (size_t)N_IN_T * DM * 2, SZ_WBR = (size_t)3 * DM * BW * 2, SZ_WSQ = (size_t)DM * DM * 2, SZ_WPP = (size_t)DM * 256 * 2;
constexpr size_t WS_WIN = 2 * MiB;
constexpr size_t WS_WBR = WS_WIN + 2 * SZ_WIN;
constexpr size_t WS_WOUT = WS_WBR + 2 * SZ_WBR;
constexpr size_t WS_WPG = WS_WOUT + 2 * SZ_WSQ;
constexpr size_t WS_WPP = WS_WPG + 2 * SZ_WSQ;
constexpr size_t SZ_ROWS_BW = (size_t)M_ROWS * BW * 2, SZ_ROWS_D = (size_t)M_ROWS * DM * 2;
constexpr size_t WS_XB = WS_WPP + 2 * SZ_WPP;
constexpr size_t WS_PB = WS_XB + SZ_ROWS_D;
constexpr size_t WS_CS = WS_PB + (size_t)2 * M_ROWS * 256 * 2;
constexpr size_t WS_SSQ0 = WS_CS + (size_t)M_ROWS * 16 * 4;
constexpr size_t WS_AU = WS_SSQ0 + (size_t)M_ROWS * 4;
constexpr size_t WS_AV = WS_AU + SZ_ROWS_BW, WS_AZ = WS_AV + SZ_ROWS_BW, WS_BQ = WS_AZ + SZ_ROWS_BW;
constexpr size_t WS_BK = WS_BQ + SZ_ROWS_BW;
constexpr size_t WS_BV = WS_BK + (size_t)M_ROWS * 256 * 2;
constexpr size_t WS_BZ = WS_BV + (size_t)M_ROWS * 256 * 2;
constexpr size_t WS_CQ = WS_BZ + SZ_ROWS_BW;
constexpr size_t WS_CK = WS_CQ + (size_t)M_ROWS * 1024 * 2;
constexpr size_t WS_CV = WS_CK + (size_t)M_ROWS * 1024 * 2;
constexpr size_t WS_CO = WS_CV + SZ_ROWS_BW, WS_CZ = WS_CO + SZ_ROWS_BW;
constexpr size_t WS_G = WS_CZ + SZ_ROWS_BW;
constexpr size_t WS_IF = WS_G + (size_t)M_ROWS * 12288 * 2;
constexpr size_t WS_LNP = WS_IF + (size_t)M_ROWS * 8 * 4;
constexpr size_t WS_YA = WS_LNP + (size_t)M_ROWS * 32 * 8;
constexpr size_t WS_NUM = WS_YA + 3 * SZ_ROWS_BW;
constexpr size_t WS_SSQC = WS_NUM + SZ_ROWS_BW;
constexpr size_t WS_DN = WS_SSQC + (size_t)M_ROWS * 64 * 4;
constexpr size_t WS_MIX = WS_DN + (size_t)M_ROWS * 4 * 4;
constexpr size_t WS_OUT = WS_MIX + SZ_ROWS_D;
constexpr size_t WS_OUTP = WS_OUT + SZ_ROWS_D;
constexpr size_t WS_ERAW = WS_OUTP + (size_t)M_ROWS * 64 * 4;
constexpr size_t WS_ERP = WS_ERAW + SZ_ROWS_D;
constexpr size_t WS_RSO = WS_ERP + (size_t)M_ROWS * 64 * 4;
constexpr size_t WS_RSE = WS_RSO + (size_t)M_ROWS * 4;
constexpr size_t WS_X1B = WS_RSE + (size_t)M_ROWS * 4;
constexpr size_t WS_XSP = WS_X1B + SZ_ROWS_D;
constexpr size_t WS_END = WS_XSP + (size_t)M_ROWS * 64 * 4;
static_assert(WS_WIN % 256 == 0 && WS_XB % 256 == 0 && WS_AU % 256 == 0 && WS_G % 256 == 0 && WS_YA % 256 == 0 && WS_MIX % 256 == 0 && WS_X1B % 256 == 0, "alignment");

#ifndef EPIIN_NT
#define EPIIN_NT 0
#endif
#if EPIIN_NT
#define EPIIN_STORE(v, p) __builtin_nontemporal_store((v), (p))
#else
#define EPIIN_STORE(v, p) (*(p) = (v))
#endif
#ifndef EPI_NS16
#define EPI_NS16 0
#endif
#ifndef EPI_NS32
#define EPI_NS32 0
#endif
#ifndef EPIIN_NS
#define EPIIN_NS 0
#endif
namespace pg8 {
struct EpiIn {
    static constexpr bool PERM = true; static constexpr int NS = EPIIN_NS;
    __device__ __forceinline__ bool relax(const Unit& u) const { return u.pn < 122; }
    const gfloat* ssq; guchar* ws;
    __device__ __forceinline__ bool keep(const Unit&) const { return false; }
    __device__ __forceinline__ void operator()(f32x4 (&acc)[2][2][4][2], const Unit& u, int wr, int wc, int fr, int fq) const {
        const int pn = u.pn; const int row0 = u.pm * BM + wr * 64 + fr;
        size_t off; int ldc, t0, act; float sc = 1.f;
        if (pn < 16)       { off = WS_AU; ldc = 2048; t0 = 0; act = 6; }
        else if (pn < 24)  { off = WS_AV; ldc = 2048; t0 = 16; act = 5; }
        else if (pn < 32)  { off = WS_BQ; ldc = 2048; t0 = 24; act = 0; }
        else if (pn < 33)  { off = WS_BK; ldc = 256; t0 = 32; act = 0; }
        else if (pn < 34)  { off = WS_BV; ldc = 256; t0 = 33; act = 0; }
        else if (pn < 42)  { off = WS_BZ; ldc = 2048; t0 = 34; act = 2; }
        else if (pn < 46)  { off = WS_CQ; ldc = 1024; t0 = 42; act = 0; sc = 0.0625f; }
        else if (pn < 50)  { off = WS_CK; ldc = 1024; t0 = 46; act = 0; }
        else if (pn < 58)  { off = WS_CV; ldc = 2048; t0 = 50; act = 0; }
        else if (pn < 74)  { off = WS_CO; ldc = 2048; t0 = 58; act = 7; }
        else if (pn < 122) { off = WS_G; ldc = 12288; t0 = 74; act = 3; }
        else               { off = WS_IF; ldc = 8; t0 = 122; act = 4; }
        const int col0 = (pn - t0) * BM + wc * 32 + 8 * fq;
        if (act == 4) {
            if (wc == 0 && fq == 0) {
                gfloat* dst = (gfloat*)(ws + off);
#pragma unroll
                for (int ai = 0; ai < 2; ++ai)
#pragma unroll
                    for (int m = 0; m < 4; ++m) { const int row = row0 + ai * HALF + m * 16; const float rs = rsqrtf(ssq[row] * (1.0f / DM) + NORM_EPS);
                        *(gf32x4*)(dst + (size_t)row * 8) = acc[ai][0][m][0] * rs; *(gf32x4*)(dst + (size_t)row * 8 + 4) = acc[ai][0][m][1] * rs; }
            }
            return;
        }
        gbf16* base = (gbf16*)(ws + off);
        if (act == 6 || act == 7) {
            const int colp = (pn - t0) * HALF + wc * 32 + 8 * fq;
#pragma unroll
            for (int ai = 0; ai < 2; ++ai)
#pragma unroll
                for (int m = 0; m < 4; ++m) {
                    const int row = row0 + ai * HALF + m * 16; const float rs = rsqrtf(ssq[row] * (1.0f / DM) + NORM_EPS);
                    f32x4 a0 = acc[ai][0][m][0] * rs, a1 = acc[ai][0][m][1] * rs; const f32x4 z0 = acc[ai][1][m][0] * rs, z1 = acc[ai][1][m][1] * rs;
                    if (act == 6) { const f32x2 a = gelu_pk((f32x2){a0[0], a0[1]}), b = gelu_pk((f32x2){a0[2], a0[3]}), c = gelu_pk((f32x2){a1[0], a1[1]}), d = gelu_pk((f32x2){a1[2], a1[3]});
                        a0 = (f32x4){a.x, a.y, b.x, b.y}; a1 = (f32x4){c.x, c.y, d.x, d.y}; }
                    else {
#pragma unroll
                        for (int j = 0; j < 4; ++j) { a0[j] = fsigmoid(a0[j]); a1[j] = fsigmoid(a1[j]); } }
#pragma unroll
                    for (int j = 0; j < 4; ++j) { a0[j] *= z0[j] * fsigmoid(z0[j]); a1[j] *= z1[j] * fsigmoid(z1[j]); }
                    u32x4 w; w.x = cvt_pk_bf16(a0[0], a0[1]); w.y = cvt_pk_bf16(a0[2], a0[3]); w.z = cvt_pk_bf16(a1[0], a1[1]); w.w = cvt_pk_bf16(a1[2], a1[3]);
                    *(gu32x4*)(base + (size_t)row * ldc + colp) = w;
                }
            return;
        }
#pragma unroll
        for (int ai = 0; ai < 2; ++ai)
#pragma unroll
            for (int m = 0; m < 4; ++m) {
                const int row = row0 + ai * HALF + m * 16; const float rs = rsqrtf(ssq[row] * (1.0f / DM) + NORM_EPS) * sc;
                gbf16* rowp = base + (size_t)row * ldc + col0; float ls = 0.f, lq = 0.f;
#pragma unroll
                for (int bj = 0; bj < 2; ++bj) {
                    f32x4 v0 = acc[ai][bj][m][0] * rs, v1 = acc[ai][bj][m][1] * rs;
                    if (act == 5) {
                        f32x2 a = gelu_pk((f32x2){v0[0], v0[1]}), b = gelu_pk((f32x2){v0[2], v0[3]}), c = gelu_pk((f32x2){v1[0], v1[1]}), d = gelu_pk((f32x2){v1[2], v1[3]});
                        v0 = (f32x4){a.x, a.y, b.x, b.y}; v1 = (f32x4){c.x, c.y, d.x, d.y};
                        { ls += (v0[0] + v0[1]) + (v0[2] + v0[3]) + (v1[0] + v1[1]) + (v1[2] + v1[3]);
                            lq += (v0[0] * v0[0] + v0[1] * v0[1]) + (v0[2] * v0[2] + v0[3] * v0[3]) + (v1[0] * v1[0] + v1[1] * v1[1]) + (v1[2] * v1[2] + v1[3] * v1[3]); }
                    } else if (act == 2) {
#pragma unroll
                        for (int j = 0; j < 4; ++j) { v0[j] = v0[j] * fsigmoid(v0[j]); v1[j] = v1[j] * fsigmoid(v1[j]); }
                    } else if (act == 3) {
#pragma unroll
                        for (int j = 0; j < 4; ++j) { v0[j] = fsigmoid(v0[j]); v1[j] = fsigmoid(v1[j]); }
                    }
                    u32x4 w; w.x = cvt_pk_bf16(v0[0], v0[1]); w.y = cvt_pk_bf16(v0[2], v0[3]); w.z = cvt_pk_bf16(v1[0], v1[1]); w.w = cvt_pk_bf16(v1[2], v1[3]);
                    EPIIN_STORE(w, (gu32x4*)(rowp + bj * HALF));
                }
                if (act == 5) {
                    ls += __shfl_xor(ls, 16); ls += __shfl_xor(ls, 32); lq += __shfl_xor(lq, 16); lq += __shfl_xor(lq, 32);
                    if (fq == 0) *(gf32x2*)(ws + WS_LNP + ((size_t)row * 32 + (pn - 16) * 4 + wc) * 8) = (f32x2){ls, lq};
                }
            }
    }
};
struct EpiBranch {
    static constexpr bool PERM = true; static constexpr int NS = EPI_NS16;
    __device__ __forceinline__ bool relax(const Unit& u) const { return u.seg == 2; }
    const gbf16* G; gbf16* MIX;
    __device__ __forceinline__ bool keep(const Unit& u) const { return u.seg != 2; }
    __device__ __forceinline__ void operator()(f32x4 (&acc)[2][2][4][2], const Unit& u, int wr, int wc, int fr, int fq) const {
        const int row0 = u.pm * BM + wr * 64 + fr, col0 = u.pn * BM + wc * 32 + 8 * fq; const int seg = u.seg;
#pragma unroll
        for (int ai = 0; ai < 2; ++ai)
#pragma unroll
            for (int m = 0; m < 4; ++m) {
                const int row = row0 + ai * HALF + m * 16; const gbf16* gp = G + (size_t)row * 12288 + seg * DM + col0;
#pragma unroll
                for (int bj = 0; bj < 2; ++bj) {
                    const u32x4 ga = *(const gu32x4*)(gp + bj * HALF);
                    float f[8] = {bf_lo(ga.x), bf_hi(ga.x), bf_lo(ga.y), bf_hi(ga.y), bf_lo(ga.z), bf_hi(ga.z), bf_lo(ga.w), bf_hi(ga.w)};
#pragma unroll
                    for (int j = 0; j < 8; ++j) f[j] = fmaxf(f[j], 1e-20f);
                    if (seg != 2) {
                        const u32x4 gb = *(const gu32x4*)(gp + DM + bj * HALF);
                        const float h[8] = {bf_lo(gb.x), bf_hi(gb.x), bf_lo(gb.y), bf_hi(gb.y), bf_lo(gb.z), bf_hi(gb.z), bf_lo(gb.w), bf_hi(gb.w)};
#pragma unroll
                        for (int j = 0; j < 8; ++j) f[j] = f[j] * __builtin_amdgcn_rcpf(fmaxf(h[j], 1e-20f));
                    }
                    f32x4 v0 = acc[ai][bj][m][0], v1 = acc[ai][bj][m][1];
                    v0 = v0 * (f32x4){f[0], f[1], f[2], f[3]}; v1 = v1 * (f32x4){f[4], f[5], f[6], f[7]};
                    if (seg != 2) { acc[ai][bj][m][0] = v0; acc[ai][bj][m][1] = v1; }
                    else { u32x4 w; w.x = cvt_pk_bf16(v0[0], v0[1]); w.y = cvt_pk_bf16(v0[2], v0[3]); w.z = cvt_pk_bf16(v1[0], v1[1]); w.w = cvt_pk_bf16(v1[2], v1[3]);
                        *(gu32x4*)(MIX + (size_t)row * DM + col0 + bj * HALF) = w; }
                }
                if (m == 3) asm volatile("" ::: "memory");
            }
    }
};
struct EpiSq {
    static constexpr bool PERM = true; static constexpr int NS = EPI_NS16;
    __device__ __forceinline__ bool relax(const Unit&) const { return true; }
    gbf16* O; gfloat* P;
    __device__ __forceinline__ bool keep(const Unit&) const { return false; }
    __device__ __forceinline__ void operator()(f32x4 (&acc)[2][2][4][2], const Unit& u, int wr, int wc, int fr, int fq) const {
        const int row0 = u.pm * BM + wr * 64 + fr, col0 = u.pn * BM + wc * 32 + 8 * fq;
#pragma unroll
        for (int ai = 0; ai < 2; ++ai)
#pragma unroll
            for (int m = 0; m < 4; ++m) {
                const int row = row0 + ai * HALF + m * 16; float q = 0.f;
#pragma unroll
                for (int bj = 0; bj < 2; ++bj) {
                    const f32x4 v0 = acc[ai][bj][m][0], v1 = acc[ai][bj][m][1];
                    q += (v0[0] * v0[0] + v0[1] * v0[1]) + (v0[2] * v0[2] + v0[3] * v0[3]) + (v1[0] * v1[0] + v1[1] * v1[1]) + (v1[2] * v1[2] + v1[3] * v1[3]);
                    u32x4 w; w.x = cvt_pk_bf16(v0[0], v0[1]); w.y = cvt_pk_bf16(v0[2], v0[3]); w.z = cvt_pk_bf16(v1[0], v1[1]); w.w = cvt_pk_bf16(v1[2], v1[3]);
                    if (O) *(gu32x4*)(O + (size_t)row * DM + col0 + bj * HALF) = w; else asm volatile("" :: "v"(w));
                }
                q += __shfl_xor(q, 16); q += __shfl_xor(q, 32);
                if (fq == 0) P[(size_t)row * 64 + u.pn * 4 + wc] = q;
            }
    }
};
struct EpiPle {
    static constexpr bool PERM = false; static constexpr int NS = EPI_NS32;
    __device__ __forceinline__ bool relax(const Unit&) const { return true; }
    const gfloat* XIN; gfloat* XOUT; gbf16* XB; const gbf16* OUT; const gbf16* ERAW; const gfloat* RSO; const gfloat* RSE; const gfloat* npost; const gfloat* pnorm; gfloat* SSQN; int last;
    __device__ __forceinline__ bool keep(const Unit&) const { return false; }
    __device__ __forceinline__ void operator()(f32x4 (&acc)[2][2][4][2], const Unit& u, int wr, int wc, int fr, int fq) const {
        const int row0 = u.pm * BM + wr * 64 + fr, col0 = u.pn * BM + wc * 32 + 4 * fq;
#pragma unroll
        for (int ai = 0; ai < 2; ++ai)
#pragma unroll
            for (int m = 0; m < 4; ++m) {
                const int row = row0 + ai * HALF + m * 16; const float rso = RSO[row], rse = RSE[row]; float q = 0.f; const size_t ro = (size_t)row * DM;
#pragma unroll
                for (int bj = 0; bj < 2; ++bj)
#pragma unroll
                    for (int n = 0; n < 2; ++n) {
                        const int col = col0 + bj * HALF + n * 16;
                        const f32x4 x = *(const gf32x4*)(XIN + ro + col); const u32x2 ob = *(const gu32x2*)(OUT + ro + col), eb = *(const gu32x2*)(ERAW + ro + col);
                        const f32x4 np = *(const gf32x4*)(npost + col), pn = *(const gf32x4*)(pnorm + col);
                        const f32x4 o = {bf_lo(ob.x), bf_hi(ob.x), bf_lo(ob.y), bf_hi(ob.y)}, e = {bf_lo(eb.x), bf_hi(eb.x), bf_lo(eb.y), bf_hi(eb.y)};
                        const f32x4 a = acc[ai][bj][m][n]; f32x4 r;
#pragma unroll
                        for (int j = 0; j < 4; ++j) { const float x1 = x[j] + o[j] * rso * np[j]; r[j] = x1 + fsigmoid(a[j]) * (e[j] * rse * pn[j]); q += r[j] * r[j]; }
                        *(gf32x4*)(XOUT + ro + col) = r;
                        if (!last) { u32x2 w; w.x = cvt_pk_bf16(r[0], r[1]); w.y = cvt_pk_bf16(r[2], r[3]); *(gu32x2*)(XB + ro + col) = w; }
                    }
                if (!last) { q += __shfl_xor(q, 16); q += __shfl_xor(q, 32); if (fq == 0) SSQN[(size_t)row * 64 + u.pn * 4 + wc] = q; }
                if (m & 1) asm volatile("" ::: "memory");
            }
    }
};
}

constexpr int LDS_BYTES = 147456;
constexpr int MISC_OFF = LDS_BYTES - 128;
constexpr int ARGS_OFF = LDS_BYTES - 512;
constexpr int NWAVES = 8, NTHREADS = 512;

struct Ctx {
    LAS unsigned char* lds; int tid, lane, wave, vcu, G, bx;
};

struct TrTile { const gfloat* W; const gfloat* kscale; gbf16* WT; int ldw, K; };
constexpr int TR_PER_LAYER = 3904 + 768 + 512 + 512 + 32;
__device__ __forceinline__ TrTile tr_decode(int it, const gfloat* w_in, const gfloat* norm_pre, const gfloat* w_branch, const gfloat* w_out, const gfloat* ple_gate, const gfloat* ple_proj, guchar* ws) {
    const int l = it / TR_PER_LAYER; int r = it - l * TR_PER_LAYER; TrTile t; int kt, ntile;
    if (r < 3904) { kt = r / 244; ntile = r - kt * 244; const int src = ntile < 116 ? ntile * 128 : ntile * 128 + 8;
        if (ntile < 16) ntile = 2 * ntile; else if (ntile < 32) ntile = ntile + 16; else if (ntile < 48) ntile = 2 * (ntile - 32) + 1;
        else if (ntile >= 116 && ntile < 132) ntile = 116 + 2 * (ntile - 116); else if (ntile >= 132 && ntile < 148) ntile = 116 + 2 * (ntile - 132) + 1;
        t.ldw = N_IN; t.K = DM; t.W = w_in + (size_t)l * DM * N_IN + (size_t)kt * 256 * N_IN + src; t.kscale = norm_pre + l * DM + kt * 256;
        t.WT = (gbf16*)(ws + WS_WIN + (size_t)l * SZ_WIN) + (size_t)ntile * 128 * DM + kt * 256; return t; }
    r -= 3904; t.kscale = nullptr; t.ldw = DM;
    if (r < 768) { const int j = r / 256; const int rr = r - j * 256; kt = rr / 32; ntile = rr - kt * 32; t.K = BW;
        t.W = w_branch + ((size_t)(l * 3 + j) * BW + (size_t)kt * 256) * DM + ntile * 128;
        t.WT = (gbf16*)(ws + WS_WBR + (size_t)l * SZ_WBR) + (size_t)j * DM * BW + (size_t)ntile * 128 * BW + kt * 256; return t; }
    r -= 768;
    if (r < 1024) { const int which = r / 512; const int rr = r - which * 512; kt = rr / 32; ntile = rr - kt * 32; t.K = DM;
        t.W = (which ? ple_gate : w_out) + ((size_t)l * DM + (size_t)kt * 256) * DM + ntile * 128;
        t.WT = (gbf16*)(ws + (which ? WS_WPG : WS_WOUT) + (size_t)l * SZ_WSQ) + (size_t)ntile * 128 * DM + kt * 256; return t; }
    r -= 1024; kt = r / 32; ntile = r - kt * 32; t.K = 256;
    t.W = ple_proj + ((size_t)l * 256 + (size_t)kt * 256) * DM + ntile * 128;
    t.WT = (gbf16*)(ws + WS_WPP + (size_t)l * SZ_WPP) + (size_t)ntile * 128 * 256 + kt * 256; return t;
}
__device__ __forceinline__ void tr_run(const Ctx& F, int it0, int it1, int sk0, int sk1, int me, int nw, const gfloat* w_in, const gfloat* norm_pre, const gfloat* w_branch,
                                       const gfloat* w_out, const gfloat* ple_gate, const gfloat* ple_proj, guchar* ws) {
    int tid = F.tid; LAUNDER_V(tid);
    {
        constexpr int RS = 264; const int NIT = it1 - it0 - (sk1 - sk0);
        const int c4 = tid & 31, kr = tid >> 5, kc = tid & 15;
        f32x4 va[16], vb[16]; float ka[16], kb[16]; TrTile ta, tb;
#define TR_LOAD(T_, V_, K_, IT_) do { T_ = tr_decode(it0 + (IT_) + (((it0 + (IT_)) >= sk0) ? (sk1 - sk0) : 0), w_in, norm_pre, w_branch, w_out, ple_gate, ple_proj, ws); \
        _Pragma("unroll") for (int i = 0; i < 16; ++i) { V_[i] = *(const gf32x4*)(T_.W + (size_t)(i * 16 + kr) * T_.ldw + 4 * c4); K_[i] = T_.kscale ? T_.kscale[i * 16 + kr] : 1.0f; } } while (0)
#define TR_PUT(V_, K_) do { _Pragma("unroll") for (int i = 0; i < 16; ++i) { const f32x4 a = V_[i] * K_[i]; u32x2 w; w.x = cvt_pk_bf16(a[0], a[1]); w.y = cvt_pk_bf16(a[2], a[3]); \
        *(LAS u32x2*)(F.lds + (i * 16 + kr) * RS + c4 * 8) = w; } } while (0)
#define TR_GET(WT_, K_) do { _Pragma("unroll") for (int q = 0; q < 4; ++q) _Pragma("unroll") for (int hh = 0; hh < 2; ++hh) { const int n = 32 * q + (tid >> 4), kq = kc + 16 * hh; \
        const LAS bf16_t* s = (const LAS bf16_t*)(F.lds + (8 * kq) * RS + 2 * n); unsigned e[8]; \
        _Pragma("unroll") for (int j = 0; j < 8; ++j) e[j] = s[j * (RS / 2)]; \
        u32x4 o; o.x = e[0] | (e[1] << 16); o.y = e[2] | (e[3] << 16); o.z = e[4] | (e[5] << 16); o.w = e[6] | (e[7] << 16); \
        *(gu32x4*)(WT_ + (size_t)n * K_ + 8 * kq) = o; } } while (0)
        int it = me;
        if (it < NIT) TR_LOAD(ta, va, ka, it);
        if (it + nw < NIT) TR_LOAD(tb, vb, kb, it + nw);
        while (it < NIT) {
            { TR_PUT(va, ka); __syncthreads(); gbf16* wt = ta.WT; const int kk = ta.K;
              if (it + 2 * nw < NIT) TR_LOAD(ta, va, ka, it + 2 * nw);
              TR_GET(wt, kk); __syncthreads(); }
            it += nw; if (it >= NIT) break;
            { TR_PUT(vb, kb); __syncthreads(); gbf16* wt = tb.WT; const int kk = tb.K;
              if (it + 2 * nw < NIT) TR_LOAD(tb, vb, kb, it + 2 * nw);
              TR_GET(wt, kk); __syncthreads(); }
            it += nw;
        }
#undef TR_LOAD
#undef TR_PUT
#undef TR_GET
    }
}
constexpr int TR_DEFER0 = TR_PER_LAYER + 3904 + 768, TR_DEFER1 = TR_DEFER0 + 1024;
__device__ __forceinline__ void p0_prologue(const Ctx& F, const gfloat* x, const gfloat* p, const gint* positions, const gfloat* norm_pre, const gfloat* w_in, const gfloat* w_branch,
                                            const gfloat* w_out, const gfloat* ple_gate, const gfloat* ple_proj, guchar* ws) {
    int tid = F.tid; LAUNDER_V(tid);
    tr_run(F, 0, NLAYER * TR_PER_LAYER, TR_DEFER0, TR_DEFER1, F.vcu, F.G, w_in, norm_pre, w_branch, w_out, ple_gate, ple_proj, ws);
    const int gt = F.vcu * NTHREADS + tid, NGT = F.G * NTHREADS;
    for (int i = gt; i < NLAYER * 256 * DM; i += NGT) { const int l = i / (256 * DM), rr = (i / DM) & 255, k = i & (DM - 1);
        float val = 0.f; if (rr < 8) val = w_in[(size_t)l * DM * N_IN + (size_t)k * N_IN + IF_COL + rr] * norm_pre[l * DM + k];
        ((gbf16*)(ws + WS_WIN + (size_t)l * SZ_WIN))[(size_t)(122 * 256 + rr) * DM + k] = (bf16_t)(cvt_pk_bf16(val, 0.f) & 0xffffu); }
    for (int i = gt; i < NLAYER * M_ROWS * 256 / 4; i += NGT) { const f32x4 a = ((const gf32x4*)p)[i]; u32x2 w; w.x = cvt_pk_bf16(a[0], a[1]); w.y = cvt_pk_bf16(a[2], a[3]); ((gu32x2*)(ws + WS_PB))[i] = w; }
    for (int i = gt; i < M_ROWS * 8; i += NGT) { const int row = i >> 3, j = i & 7; const float inv = powf(500000.0f, -(float)j * 0.125f); const float ang = (float)positions[row] * inv;
        gfloat* cs = (gfloat*)(ws + WS_CS) + (size_t)row * 16; cs[j] = cosf(ang); cs[8 + j] = sinf(ang); }
    { const int gw = F.vcu * NWAVES + F.wave, NGW = F.G * NWAVES;
      for (int m = gw; m < M_ROWS; m += NGW) { const gf32x4* xr = (const gf32x4*)(x + (size_t)m * DM) + F.lane; gu32x2* o = (gu32x2*)(ws + WS_XB + (size_t)m * DM * 2) + F.lane; float s = 0.f;
#pragma unroll
          for (int j = 0; j < 16; ++j) { const f32x4 a = xr[64 * j]; s += (a[0] * a[0] + a[1] * a[1]) + (a[2] * a[2] + a[3] * a[3]); u32x2 w; w.x = cvt_pk_bf16(a[0], a[1]); w.y = cvt_pk_bf16(a[2], a[3]); o[64 * j] = w; }
          s = wave_sum(s); if (F.lane == 0) ((gfloat*)(ws + WS_SSQ0))[m] = s; } }
}

__device__ __forceinline__ u32x2 pack4(const f32x4 v) { u32x2 w; w.x = cvt_pk_bf16(v[0], v[1]); w.y = cvt_pk_bf16(v[2], v[3]); return w; }
__device__ __forceinline__ bf16x8 mk_frag(const u32x2 lo, const u32x2 hi) { const u32x4 t = {lo.x, lo.y, hi.x, hi.y}; return __builtin_bit_cast(bf16x8, t); }
__device__ __forceinline__ bf16x8 frag_const(unsigned w) { const u32x4 t = {w, w, w, w}; return __builtin_bit_cast(bf16x8, t); }

constexpr int GM_WL = 0, GM_VT = 34816, GM_ST = 104448, GM_RS = 272;
__device__ __forceinline__ void gmlp_unit(const Ctx& F, int b, int n, int g, guchar* ws, const gfloat* ln_g, const gfloat* ln_b, const gfloat* wsp, const gfloat* bsp) {
    int tid = F.tid; LAUNDER_V(tid); const int lane = tid & 63, w = F.wave, r16 = lane & 15, q4 = lane >> 4;
    const int row0 = b * SEQ + n * 128, c0 = g * 256;
    const gbf16* AU = (const gbf16*)(ws + WS_AU); const gbf16* AV = (const gbf16*)(ws + WS_AV); const gbf16* AZ = (const gbf16*)(ws + WS_AZ); gbf16* YA = (gbf16*)(ws + WS_YA);
    if (tid < 128) { const gf32x2* pp = (const gf32x2*)(ws + WS_LNP) + (size_t)(row0 + tid) * 32; float s = 0.f, q = 0.f;
#pragma unroll 8
        for (int j = 0; j < 32; ++j) { const f32x2 t = pp[j]; s += t.x; q += t.y; }
        const float mu = s * (1.0f / BW); const float var = fmaxf(q * (1.0f / BW) - mu * mu, 0.f);
        *(LAS f32x2*)(F.lds + GM_ST + tid * 8) = (f32x2){mu, rsqrtf(var + NORM_EPS)}; }
#pragma unroll
    for (int k = 0; k < 8; ++k) { const int item = tid + 512 * k, t = item >> 5, ch = item & 31;
        f32x4 a = *(const gf32x4*)(wsp + ((size_t)(g * 128 + t)) * 128 + 4 * ch);
#pragma unroll
        for (int e = 0; e < 4; ++e) if (4 * ch + e > t) a[e] = 0.f;
        *(LAS u32x2*)(F.lds + GM_WL + t * GM_RS + ch * 8) = pack4(a); }
    __syncthreads();
#pragma unroll
    for (int k = 0; k < 8; ++k) { const int item = tid + 512 * k, s = item & 127, ch = item >> 7;
        const u32x4 raw = *(const gu32x4*)(AV + (size_t)(row0 + s) * BW + c0 + 8 * ch);
        const f32x4 g0 = *(const gf32x4*)(ln_g + c0 + 8 * ch), g1 = *(const gf32x4*)(ln_g + c0 + 8 * ch + 4), b0 = *(const gf32x4*)(ln_b + c0 + 8 * ch), b1 = *(const gf32x4*)(ln_b + c0 + 8 * ch + 4);
        const f32x2 st = *(const LAS f32x2*)(F.lds + GM_ST + s * 8);
        const float xv[8] = {bf_lo(raw.x), bf_hi(raw.x), bf_lo(raw.y), bf_hi(raw.y), bf_lo(raw.z), bf_hi(raw.z), bf_lo(raw.w), bf_hi(raw.w)};
        const float gg[8] = {g0[0], g0[1], g0[2], g0[3], g1[0], g1[1], g1[2], g1[3]}, bb[8] = {b0[0], b0[1], b0[2], b0[3], b1[0], b1[1], b1[2], b1[3]};
#pragma unroll
        for (int i = 0; i < 8; ++i) { const float y = (xv[i] - st.x) * st.y * gg[i] + bb[i];
            *(LAS bf16_t*)(F.lds + GM_VT + (8 * ch + i) * GM_RS + 2 * s) = (bf16_t)(cvt_pk_bf16(y, 0.f) & 0xffffu); } }
    __syncthreads();
    f32x4 acc[2][8];
#pragma unroll
    for (int m = 0; m < 2; ++m)
#pragma unroll
        for (int n8 = 0; n8 < 8; ++n8) acc[m][n8] = (f32x4){0.f, 0.f, 0.f, 0.f};
    bf16x8 af[2][4];
#pragma unroll
    for (int m = 0; m < 2; ++m)
#pragma unroll
        for (int ks = 0; ks < 4; ++ks) af[m][ks] = *(const LAS bf16x8*)(F.lds + GM_VT + (32 * w + 16 * m + r16) * GM_RS + ks * 64 + q4 * 16);
#pragma unroll
    for (int n8 = 0; n8 < 8; ++n8)
#pragma unroll
        for (int ks = 0; ks < 4; ++ks) if (ks <= n8 / 2) {
            const bf16x8 bfr = *(const LAS bf16x8*)(F.lds + GM_WL + (16 * n8 + r16) * GM_RS + ks * 64 + q4 * 16);
#pragma unroll
            for (int m = 0; m < 2; ++m) acc[m][n8] = MFMA16(af[m][ks], bfr, acc[m][n8]); }
#pragma unroll
    for (int n8 = 0; n8 < 8; ++n8) { const int t = 16 * n8 + r16; const float bsv = bsp[g * 128 + t]; const size_t ro = (size_t)(row0 + t) * BW + c0 + 32 * w + 4 * q4;
#pragma unroll
        for (int m = 0; m < 2; ++m) { const u32x2 ub = *(const gu32x2*)(AU + ro + 16 * m);
            const f32x4 a = acc[m][n8] + bsv; f32x4 y;
            y[0] = a[0] * bf_lo(ub.x); y[1] = a[1] * bf_hi(ub.x); y[2] = a[2] * bf_lo(ub.y); y[3] = a[3] * bf_hi(ub.y);
            *(gu32x2*)(YA + ro + 16 * m) = pack4(y); } }
    __syncthreads();
}

constexpr int SW_KL = 0, SW_VT = 36864, SW_QL = 70656, SW_QL2 = 89088, SW_RS = 144, SW_VS = 528;
__device__ __forceinline__ void rope8(const u32x4 a, const u32x4 bq, const gfloat* cs, float scale, u32x4& o1, u32x4& o2) {
    const f32x4 c0 = *(const gf32x4*)cs, c1 = *(const gf32x4*)(cs + 4), s0 = *(const gf32x4*)(cs + 8), s1 = *(const gf32x4*)(cs + 12);
    const float t1[8] = {bf_lo(a.x), bf_hi(a.x), bf_lo(a.y), bf_hi(a.y), bf_lo(a.z), bf_hi(a.z), bf_lo(a.w), bf_hi(a.w)};
    const float t2[8] = {bf_lo(bq.x), bf_hi(bq.x), bf_lo(bq.y), bf_hi(bq.y), bf_lo(bq.z), bf_hi(bq.z), bf_lo(bq.w), bf_hi(bq.w)};
    const float cc[8] = {c0[0], c0[1], c0[2], c0[3], c1[0], c1[1], c1[2], c1[3]}, ss[8] = {s0[0], s0[1], s0[2], s0[3], s1[0], s1[1], s1[2], s1[3]};
    float r1[8], r2[8];
#pragma unroll
    for (int i = 0; i < 8; ++i) { r1[i] = (t1[i] * cc[i] - t2[i] * ss[i]) * scale; r2[i] = (t2[i] * cc[i] + t1[i] * ss[i]) * scale; }
    o1 = (u32x4){cvt_pk_bf16(r1[0], r1[1]), cvt_pk_bf16(r1[2], r1[3]), cvt_pk_bf16(r1[4], r1[5]), cvt_pk_bf16(r1[6], r1[7])};
    o2 = (u32x4){cvt_pk_bf16(r2[0], r2[1]), cvt_pk_bf16(r2[2], r2[3]), cvt_pk_bf16(r2[4], r2[5]), cvt_pk_bf16(r2[6], r2[7])};
}
__device__ __forceinline__ u32x4 scale8(const u32x4 a, float sc) {
    return (u32x4){cvt_pk_bf16(bf_lo(a.x) * sc, bf_hi(a.x) * sc), cvt_pk_bf16(bf_lo(a.y) * sc, bf_hi(a.y) * sc), cvt_pk_bf16(bf_lo(a.z) * sc, bf_hi(a.z) * sc), cvt_pk_bf16(bf_lo(a.w) * sc, bf_hi(a.w) * sc)};
}
__device__ __forceinline__ void swa_unit(const Ctx& F, int b, int n, int hk, guchar* ws, const gfloat* sinks) {
    int tid = F.tid; LAUNDER_V(tid); const int lane = tid & 63, w = F.wave, r16 = lane & 15, q4 = lane >> 4;
    const int r0 = b * SEQ + n * 128, kr0 = r0 - 128;
    const gbf16* BQ = (const gbf16*)(ws + WS_BQ); const gbf16* BK = (const gbf16*)(ws + WS_BK); const gbf16* BV = (const gbf16*)(ws + WS_BV); const gbf16* BZ = (const gbf16*)(ws + WS_BZ);
    gbf16* YB = (gbf16*)(ws + WS_YA) + (size_t)M_ROWS * BW; const gfloat* CS = (const gfloat*)(ws + WS_CS);
#pragma unroll
    for (int k = 0; k < 4; ++k) { const int item = tid + 512 * k, key = item >> 3, ch = item & 7; const bool pad = (n == 0 && key < 128);
        if (ch == 1) continue;
        const gbf16* src = BK + (size_t)(kr0 + key) * 256 + hk * 64;
        LAS unsigned char* dst = F.lds + SW_KL + key * SW_RS;
        if (pad) { *(LAS u32x4*)(dst + ch * 16) = (u32x4){0u, 0u, 0u, 0u}; if (ch == 0) *(LAS u32x4*)(dst + 16) = (u32x4){0u, 0u, 0u, 0u}; }
        else if (ch == 0) { u32x4 o1, o2; rope8(*(const gu32x4*)src, *(const gu32x4*)(src + 8), CS + (size_t)(kr0 + key) * 16, 1.0f, o1, o2); *(LAS u32x4*)dst = o1; *(LAS u32x4*)(dst + 16) = o2; }
        else *(LAS u32x4*)(dst + ch * 16) = *(const gu32x4*)(src + 8 * ch); }
#pragma unroll
    for (int k = 0; k < 4; ++k) { const int item = tid + 512 * k, key = item & 255, ch = item >> 8; const bool pad = (n == 0 && key < 128);
        u32x4 raw = {0u, 0u, 0u, 0u}; if (!pad) raw = *(const gu32x4*)(BV + (size_t)(kr0 + key) * 256 + hk * 64 + 8 * ch);
        const unsigned e[4] = {raw.x, raw.y, raw.z, raw.w};
#pragma unroll
        for (int i = 0; i < 8; ++i) *(LAS bf16_t*)(F.lds + SW_VT + (8 * ch + i) * SW_VS + 2 * key) = (bf16_t)((e[i >> 1] >> ((i & 1) * 16)) & 0xffffu); }
    u32x4 qa[2], qb[2];
#define SW_QLOAD(hq_) do { _Pragma("unroll") for (int k_ = 0; k_ < 2; ++k_) { const int it_ = tid + 512 * k_, qr_ = it_ >> 3, ch_ = it_ & 7; const gbf16* src_ = BQ + (size_t)(r0 + qr_) * BW + (hq_) * 64; \
        qa[k_] = (u32x4){0u, 0u, 0u, 0u}; qb[k_] = (u32x4){0u, 0u, 0u, 0u}; \
        if (ch_ == 0) { qa[k_] = *(const gu32x4*)src_; qb[k_] = *(const gu32x4*)(src_ + 8); } else if (ch_ != 1) qa[k_] = *(const gu32x4*)(src_ + 8 * ch_); } } while (0)
#define SW_QWRITE(buf_) do { _Pragma("unroll") for (int k_ = 0; k_ < 2; ++k_) { const int it_ = tid + 512 * k_, qr_ = it_ >> 3, ch_ = it_ & 7; LAS unsigned char* dst_ = F.lds + (buf_) + qr_ * SW_RS; \
        if (ch_ == 0) { u32x4 o1_, o2_; rope8(qa[k_], qb[k_], CS + (size_t)(r0 + qr_) * 16, 0.125f, o1_, o2_); *(LAS u32x4*)dst_ = o1_; *(LAS u32x4*)(dst_ + 16) = o2_; } \
        else if (ch_ != 1) *(LAS u32x4*)(dst_ + ch_ * 16) = scale8(qa[k_], 0.125f); } } while (0)
    SW_QLOAD(hk * 8); SW_QWRITE(SW_QL);
    __syncthreads();
    for (int hi = 0; hi < 8; ++hi) {
        const int hq = hk * 8 + hi; const int qcur = (hi & 1) ? SW_QL2 : SW_QL, qnxt = (hi & 1) ? SW_QL : SW_QL2;
        if (hi < 7) SW_QLOAD(hq + 1);
        bf16x8 bq[2];
#pragma unroll
        for (int ks = 0; ks < 2; ++ks) bq[ks] = *(const LAS bf16x8*)(F.lds + qcur + (16 * w + r16) * SW_RS + ks * 64 + q4 * 16);
        f32x4 s[10];
#pragma unroll
        for (int j = 0; j < 9; ++j) { s[j] = (f32x4){0.f, 0.f, 0.f, 0.f};
#pragma unroll
            for (int ks = 0; ks < 2; ++ks) { const bf16x8 a = *(const LAS bf16x8*)(F.lds + SW_KL + (16 * (w + j) + r16) * SW_RS + ks * 64 + q4 * 16); s[j] = MFMA16(a, bq[ks], s[j]); } }
        s[9] = (f32x4){0.f, 0.f, 0.f, 0.f};
        const int qi = 16 * w + r16; const float sink = sinks[hq]; float mx = sink;
#pragma unroll
        for (int j = 0; j < 9; ++j)
#pragma unroll
            for (int e = 0; e < 4; ++e) { const int kj = 16 * (w + j) + 4 * q4 + e; const bool valid = (kj > qi) && (kj <= qi + 128) && (n > 0 || kj >= 128);
                s[j][e] = valid ? s[j][e] : -1e30f; mx = fmaxf(mx, s[j][e]); }
        mx = fmaxf(mx, __shfl_xor(mx, 16)); mx = fmaxf(mx, __shfl_xor(mx, 32));
        float sum = 0.f;
#pragma unroll
        for (int j = 0; j < 9; ++j)
#pragma unroll
            for (int e = 0; e < 4; ++e) { const float pv = (s[j][e] > -1e29f) ? __expf(s[j][e] - mx) : 0.f; s[j][e] = pv; sum += pv; }
        sum += __shfl_xor(sum, 16); sum += __shfl_xor(sum, 32); sum += __expf(sink - mx);
        const float inv = 1.0f / sum;
        f32x4 o[4];
#pragma unroll
        for (int dt = 0; dt < 4; ++dt) o[dt] = (f32x4){0.f, 0.f, 0.f, 0.f};
#pragma unroll
        for (int kk = 0; kk < 5; ++kk) { const bf16x8 pf = mk_frag(pack4(s[2 * kk]), pack4(s[2 * kk + 1]));
            const int t0 = w + 2 * kk, t1 = (w + 2 * kk + 1) > 15 ? 15 : (w + 2 * kk + 1);
#pragma unroll
            for (int dt = 0; dt < 4; ++dt) { const LAS unsigned char* vrow = F.lds + SW_VT + (16 * dt + r16) * SW_VS + (4 * q4) * 2;
                const bf16x8 a = mk_frag(*(const LAS u32x2*)(vrow + 32 * t0), *(const LAS u32x2*)(vrow + 32 * t1)); o[dt] = MFMA16(a, pf, o[dt]); } }
        const size_t ro = (size_t)(r0 + qi) * BW + hq * 64 + 4 * q4;
#pragma unroll
        for (int dt = 0; dt < 4; ++dt) { const u32x2 zb = *(const gu32x2*)(BZ + ro + 16 * dt); f32x4 y;
            y[0] = o[dt][0] * inv * bf_lo(zb.x); y[1] = o[dt][1] * inv * bf_hi(zb.x); y[2] = o[dt][2] * inv * bf_lo(zb.y); y[3] = o[dt][3] * inv * bf_hi(zb.y);
            *(gu32x2*)(YB + ro + 16 * dt) = pack4(y); }
        if (hi < 7) SW_QWRITE(qnxt);
        __syncthreads();
    }
#undef SW_QLOAD
#undef SW_QWRITE
}

#ifndef ML_R1A
#define ML_R1A 1
#endif
#ifndef ML_R1B
#define ML_R1B 1
#endif
#ifndef ML_RWR
#define ML_RWR 1
#endif
constexpr int ML_QL = 0, ML_KA = 33792, ML_KB = 67584, ML_VT = 101376, ML_VW = 105984, ML_VW2 = 110736, ML_CT = 115488, ML_X = 132912, ML_GATE = 142128, ML_GSZ = 1344, ML_RS = 528, ML_TS = 144;
static_assert(ML_GATE + 2 * ML_GSZ <= ARGS_OFF, "mLSTM LDS map");
typedef short s16x4 __attribute__((ext_vector_type(4)));
__device__ __forceinline__ bf16x8 tr_frag8(const LAS unsigned char* img, int rs, int row0, int col0, int r16) {
    const LAS unsigned char* p0 = img + (row0 + (r16 >> 2)) * rs + (col0 + 4 * (r16 & 3)) * 2;
    const s16x4 a = __builtin_amdgcn_ds_read_tr16_b64_v4i16((LAS s16x4*)p0);
    const s16x4 b = __builtin_amdgcn_ds_read_tr16_b64_v4i16((LAS s16x4*)(p0 + 4 * rs));
    return __builtin_shufflevector(a, b, 0, 1, 2, 3, 4, 5, 6, 7);
}
__device__ __forceinline__ float dpp_shr(float v, float ident, int n) {
    const int r = n == 1 ? __builtin_amdgcn_update_dpp(__float_as_int(ident), __float_as_int(v), 0x111, 0xf, 0xf, false)
                : n == 2 ? __builtin_amdgcn_update_dpp(__float_as_int(ident), __float_as_int(v), 0x112, 0xf, 0xf, false)
                : n == 4 ? __builtin_amdgcn_update_dpp(__float_as_int(ident), __float_as_int(v), 0x114, 0xf, 0xf, false)
                         : __builtin_amdgcn_update_dpp(__float_as_int(ident), __float_as_int(v), 0x118, 0xf, 0xf, false);
    return __int_as_float(r);
}
__device__ __forceinline__ float wave_scan_add(float v, int lane) {
    v += dpp_shr(v, 0.f, 1); v += dpp_shr(v, 0.f, 2); v += dpp_shr(v, 0.f, 4); v += dpp_shr(v, 0.f, 8);
    const float t0 = __int_as_float(__builtin_amdgcn_readlane(__float_as_int(v), 15)), t1 = __int_as_float(__builtin_amdgcn_readlane(__float_as_int(v), 31)), t2 = __int_as_float(__builtin_amdgcn_readlane(__float_as_int(v), 47));
    const int row = lane >> 4; const float add = row == 0 ? 0.f : (row == 1 ? t0 : (row == 2 ? t0 + t1 : (t0 + t1) + t2));
    return v + add;
}
__device__ __forceinline__ float wave_scan_max(float v, int lane) {
    const float NI = -3.0e38f;
    v = fmaxf(v, dpp_shr(v, NI, 1)); v = fmaxf(v, dpp_shr(v, NI, 2)); v = fmaxf(v, dpp_shr(v, NI, 4)); v = fmaxf(v, dpp_shr(v, NI, 8));
    const float t0 = __int_as_float(__builtin_amdgcn_readlane(__float_as_int(v), 15)), t1 = __int_as_float(__builtin_amdgcn_readlane(__float_as_int(v), 31)), t2 = __int_as_float(__builtin_amdgcn_readlane(__float_as_int(v), 47));
    const int row = lane >> 4; const float mx = row == 0 ? NI : (row == 1 ? t0 : (row == 2 ? fmaxf(t0, t1) : fmaxf(fmaxf(t0, t1), t2)));
    return fmaxf(v, mx);
}
__device__ __forceinline__ float softcap15(float z) { const float e = __expf(z * (2.0f / 15.0f)); return 15.0f * (1.0f - 2.0f * __builtin_amdgcn_rcpf(e + 1.0f)); }
__device__ __forceinline__ void mlstm_unit(const Ctx& F, int b, int h, int sl, guchar* ws, const gfloat* ibp, const gfloat* fbp, const gfloat* norm_g) {
    int tid = F.tid; LAUNDER_V(tid); const int lane = tid & 63, w = F.wave, r16 = lane & 15, q4 = lane >> 4;
    const gbf16* CQ = (const gbf16*)(ws + WS_CQ) + h * 256; const gbf16* CK = (const gbf16*)(ws + WS_CK) + h * 256; const gbf16* CV = (const gbf16*)(ws + WS_CV) + h * 512 + sl * 32;
    const gbf16* CO = (const gbf16*)(ws + WS_CO) + h * 512 + sl * 32; const gbf16* CZ = (const gbf16*)(ws + WS_CZ) + h * 512 + sl * 32;
    const gfloat* IFB = (const gfloat*)(ws + WS_IF);
    gbf16* NUM = (gbf16*)(ws + WS_NUM) + h * 512 + sl * 32; gfloat* SSQC = (gfloat*)(ws + WS_SSQC); gfloat* DNB = (gfloat*)(ws + WS_DN);
    const int rowb = b * SEQ;
    const bf16x8 ones = frag_const(0x3f803f80u), zeros = frag_const(0u);
    for (int i = tid; i < 33 * ML_RS / 16; i += NTHREADS) *(LAS u32x4*)(F.lds + ML_CT + i * 16) = (u32x4){0u, 0u, 0u, 0u};
    f32x4 st[2][3];
#pragma unroll
    for (int i = 0; i < 2; ++i)
#pragma unroll
        for (int dt = 0; dt < 3; ++dt) st[i][dt] = (f32x4){0.f, 0.f, 0.f, 0.f};
    float m_prev = 0.f;
    const float ibv = ibp[h], fbv = fbp[h];
    u32x4 qra[4], kra[4], vra; float gi = 0.f, gf = 0.f;
#define ML_LOAD(c, Q_, K_, V_) do { const int rc_ = rowb + (c) * 64; _Pragma("unroll") for (int k_ = 0; k_ < 4; ++k_) { const int it_ = tid + 512 * k_, s_ = it_ >> 5, ch_ = it_ & 31; \
        Q_[k_] = *(const gu32x4*)(CQ + (size_t)(rc_ + s_) * 1024 + 8 * ch_); K_[k_] = *(const gu32x4*)(CK + (size_t)(rc_ + s_) * 1024 + 8 * ch_); } \
        if (tid < 256) V_ = *(const gu32x4*)(CV + (size_t)(rc_ + (tid >> 2)) * BW + 8 * (tid & 3)); } while (0)
#define ML_GLOAD(c) do { if (w == 7) { const int r_ = rowb + (c) * 64 + lane; gi = IFB[(size_t)r_ * 8 + h]; gf = IFB[(size_t)r_ * 8 + 4 + h]; } } while (0)
#define ML_GPREP(par) do { if (w == 7) { const float ig_ = softcap15(gi + ibv); const float z_ = softcap15(gf + fbv); \
        const float lf_ = -(fmaxf(-z_, 0.f) + log1pf(__expf(-fabsf(z_)))); const float bc_ = wave_scan_add(lf_, lane); const float u_ = ig_ - bc_; const float pm_ = wave_scan_max(u_, lane); \
        const float Mv_ = fmaxf(m_prev, pm_); const float M63_ = __int_as_float(__builtin_amdgcn_readlane(__float_as_int(Mv_), 63)); const float g_ = __int_as_float(__builtin_amdgcn_readlane(__float_as_int(bc_), 63)); \
        LAS float* gp_ = (LAS float*)(F.lds + ML_GATE + (par) * ML_GSZ); gp_[lane] = u_; gp_[64 + lane] = Mv_; gp_[128 + lane] = __expf(m_prev - Mv_); gp_[192 + lane] = __expf(-(bc_ + Mv_)); \
        gp_[256 + lane] = __expf(u_ - M63_); if (lane == 0) gp_[320] = __expf(m_prev - M63_); m_prev = g_ + M63_; } } while (0)
#define ML_WRITE(kb_, vw_, gpn_, Q_, K_, V_) do { _Pragma("unroll") for (int k_ = 0; k_ < 4; ++k_) { const int it_ = tid + 512 * k_, s_ = it_ >> 5, ch_ = it_ & 31; \
        *(LAS u32x4*)(F.lds + ML_QL + s_ * ML_RS + ch_ * 16) = Q_[k_]; *(LAS u32x4*)(F.lds + (kb_) + s_ * ML_RS + ch_ * 16) = K_[k_]; } \
        if (tid < 256) { const int s_ = tid >> 2, ch_ = tid & 3; const unsigned e_[4] = {V_.x, V_.y, V_.z, V_.w}; const float ws_ = (gpn_)[256 + s_]; \
            _Pragma("unroll") for (int i_ = 0; i_ < 8; ++i_) { const unsigned hv_ = (e_[i_ >> 1] >> ((i_ & 1) * 16)) & 0xffffu; \
                *(LAS bf16_t*)(F.lds + ML_VT + (8 * ch_ + i_) * ML_TS + 2 * s_) = (bf16_t)hv_; \
                *(LAS bf16_t*)(F.lds + (vw_) + (8 * ch_ + i_) * ML_TS + 2 * s_) = (bf16_t)(cvt_pk_bf16(__uint_as_float(hv_ << 16) * ws_, 0.f) & 0xffffu); } \
            if (ch_ == 0) *(LAS bf16_t*)(F.lds + (vw_) + 32 * ML_TS + 2 * s_) = (bf16_t)(cvt_pk_bf16(ws_, 0.f) & 0xffffu); } } while (0)
    ML_LOAD(0, qra, kra, vra); ML_GLOAD(0);
    ML_GPREP(0);
    ML_GLOAD(1);
    __syncthreads();
    ML_WRITE(ML_KA, ML_VW, ((const LAS float*)(F.lds + ML_GATE)), qra, kra, vra);
    __syncthreads();
#define ML_STEP(c, LQ_, LK_, LV_, WQ_, WK_, WV_) do { \
        const int par = c & 1; const LAS float* gp = (const LAS float*)(F.lds + ML_GATE + par * ML_GSZ); \
        const int vt = ML_VT, kb = par ? ML_KB : ML_KA, kbn = par ? ML_KA : ML_KB, vw = par ? ML_VW2 : ML_VW, vwn = par ? ML_VW : ML_VW2; \
        const LAS float* gpn = (const LAS float*)(F.lds + ML_GATE + (par ^ 1) * ML_GSZ); \
        const int rowc = rowb + c * 64; \
        if (c + 1 < 32) { ML_LOAD(c + 1, LQ_, LK_, LV_); ML_GPREP(par ^ 1); if (c + 2 < 32) ML_GLOAD(c + 2); } \
        u32x2 ob0 = {0u, 0u}, ob1 = {0u, 0u}; \
        if (w < 4) { const size_t ro = (size_t)(rowc + 16 * w + r16) * BW + 4 * q4; \
            ob0 = *(const gu32x2*)(CO + ro); ob1 = *(const gu32x2*)(CO + ro + 16); } \
        f32x4 oacc[3]; \
        for (int rp_ = 0; rp_ < ML_R1B; ++rp_) { \
        _Pragma("unroll") \
        for (int dt = 0; dt < 3; ++dt) oacc[dt] = (f32x4){0.f, 0.f, 0.f, 0.f}; \
        if (w < 4) { \
            const int T = w; \
            bf16x8 bq[8]; \
        _Pragma("unroll") \
            for (int ks = 0; ks < 8; ++ks) bq[ks] = *(const LAS bf16x8*)(F.lds + ML_QL + (16 * T + r16) * ML_RS + ks * 64 + q4 * 16); \
            f32x4 sa[4]; \
        _Pragma("unroll") \
            for (int s4 = 0; s4 < 4; ++s4) { sa[s4] = (f32x4){0.f, 0.f, 0.f, 0.f}; \
                if (s4 <= T) { \
        _Pragma("unroll") \
                    for (int ks = 0; ks < 8; ++ks) { const bf16x8 a = *(const LAS bf16x8*)(F.lds + kb + (16 * s4 + r16) * ML_RS + ks * 64 + q4 * 16); sa[s4] = MFMA16(a, bq[ks], sa[s4]); } } } \
            const int tl = 16 * T + r16; const float Mt = gp[64 + tl]; \
        _Pragma("unroll") \
            for (int s4 = 0; s4 < 4; ++s4) { const f32x4 uu = *(const LAS f32x4*)(gp + 16 * s4 + 4 * q4); \
        _Pragma("unroll") \
                for (int e = 0; e < 4; ++e) { const int sl_ = 16 * s4 + 4 * q4 + e; sa[s4][e] = (sl_ <= tl) ? sa[s4][e] * __expf(uu[e] - Mt) : 0.f; } } \
        _Pragma("unroll") \
            for (int kk = 0; kk < 2; ++kk) { const bf16x8 pf = mk_frag(pack4(sa[2 * kk]), pack4(sa[2 * kk + 1])); \
        _Pragma("unroll") \
                for (int dt = 0; dt < 3; ++dt) { bf16x8 a; \
                    if (dt < 2) { const LAS unsigned char* vp = F.lds + vt + (16 * dt + r16) * ML_TS + (32 * kk + 4 * q4) * 2; a = mk_frag(*(const LAS u32x2*)vp, *(const LAS u32x2*)(vp + 32)); } \
                    else a = (r16 == 0) ? ones : zeros; \
                    oacc[dt] = MFMA16(a, pf, oacc[dt]); } } \
        } else { \
            const int T = w - 4; f32x4 ia[3]; \
        _Pragma("unroll") \
            for (int dt = 0; dt < 3; ++dt) ia[dt] = (f32x4){0.f, 0.f, 0.f, 0.f}; \
        _Pragma("unroll") \
            for (int ks = 0; ks < 8; ++ks) { const bf16x8 bqv = *(const LAS bf16x8*)(F.lds + ML_QL + (16 * T + r16) * ML_RS + ks * 64 + q4 * 16); \
        _Pragma("unroll") \
                for (int dt = 0; dt < 3; ++dt) { bf16x8 a; \
                    if (dt < 2) a = *(const LAS bf16x8*)(F.lds + ML_CT + (16 * dt + r16) * ML_RS + ks * 64 + q4 * 16); \
                    else { a = *(const LAS bf16x8*)(F.lds + ML_CT + 32 * ML_RS + ks * 64 + q4 * 16); if (r16 != 0) a = zeros; } \
                    ia[dt] = MFMA16(a, bqv, ia[dt]); } } \
            const int tl = 16 * T + r16; \
            *(LAS f32x4*)(F.lds + ML_X + tl * 144 + (4 * q4) * 4) = ia[0]; *(LAS f32x4*)(F.lds + ML_X + tl * 144 + (16 + 4 * q4) * 4) = ia[1]; \
            if (q4 == 0) *(LAS f32x4*)(F.lds + ML_X + tl * 144 + 32 * 4) = ia[2]; \
        } \
        } \
        __syncthreads(); \
        if (w < 4) { \
            const int tl = 16 * w + r16; const float at = gp[128 + tl], en = gp[192 + tl]; \
            const f32x4 x0 = *(const LAS f32x4*)(F.lds + ML_X + tl * 144 + (4 * q4) * 4), x1 = *(const LAS f32x4*)(F.lds + ML_X + tl * 144 + (16 + 4 * q4) * 4); \
            const float xd = *(const LAS float*)(F.lds + ML_X + tl * 144 + 32 * 4); \
            const f32x4 n0 = oacc[0] + x0 * at, n1 = oacc[1] + x1 * at; \
            float den = oacc[2][0] + xd * at; den = __shfl(den, r16); \
            float sq = (n0[0] * n0[0] + n0[1] * n0[1]) + (n0[2] * n0[2] + n0[3] * n0[3]) + (n1[0] * n1[0] + n1[1] * n1[1]) + (n1[2] * n1[2] + n1[3] * n1[3]); \
            sq += __shfl_xor(sq, 16); sq += __shfl_xor(sq, 32); \
            const size_t ro = (size_t)(rowc + tl) * BW + 4 * q4; \
            const f32x4 ng0 = *(const gf32x4*)(norm_g + h * 512 + sl * 32 + 4 * q4), ng1 = *(const gf32x4*)(norm_g + h * 512 + sl * 32 + 16 + 4 * q4); \
            f32x4 t0, t1; \
            t0[0] = n0[0] * ng0[0] * bf_lo(ob0.x); t0[1] = n0[1] * ng0[1] * bf_hi(ob0.x); t0[2] = n0[2] * ng0[2] * bf_lo(ob0.y); t0[3] = n0[3] * ng0[3] * bf_hi(ob0.y); \
            t1[0] = n1[0] * ng1[0] * bf_lo(ob1.x); t1[1] = n1[1] * ng1[1] * bf_hi(ob1.x); t1[2] = n1[2] * ng1[2] * bf_lo(ob1.y); t1[3] = n1[3] * ng1[3] * bf_hi(ob1.y); \
            *(gu32x2*)(NUM + ro) = pack4(t0); *(gu32x2*)(NUM + ro + 16) = pack4(t1); \
            if (q4 == 0) { SSQC[(size_t)(rowc + tl) * 64 + h * 16 + sl] = sq; if (sl == 0) DNB[(size_t)(rowc + tl) * 4 + h] = fmaxf(fabsf(den), en); } \
        } \
        { const float dec = gp[320]; \
        _Pragma("unroll") \
          for (int i = 0; i < 2; ++i) \
        _Pragma("unroll") \
              for (int dt = 0; dt < 3; ++dt) st[i][dt] = st[i][dt] * dec; \
        _Pragma("unroll") \
          for (int kk = 0; kk < 2; ++kk) { bf16x8 a[2], bv[3]; \
        _Pragma("unroll") \
              for (int i = 0; i < 2; ++i) a[i] = tr_frag8(F.lds + kb, ML_RS, 32 * kk + 8 * q4, 32 * w + 16 * i, r16); \
        _Pragma("unroll") \
              for (int dt = 0; dt < 2; ++dt) bv[dt] = *(const LAS bf16x8*)(F.lds + vw + (16 * dt + r16) * ML_TS + kk * 64 + q4 * 16); \
              bv[2] = *(const LAS bf16x8*)(F.lds + vw + 32 * ML_TS + kk * 64 + q4 * 16); if (r16 != 0) bv[2] = zeros; \
        _Pragma("unroll") \
              for (int i = 0; i < 2; ++i) \
        _Pragma("unroll") \
                  for (int dt = 0; dt < 3; ++dt) st[i][dt] = MFMA16(a[i], bv[dt], st[i][dt]); } \
        _Pragma("unroll") \
          for (int i = 0; i < 2; ++i) { \
        _Pragma("unroll") \
              for (int dt = 0; dt < 2; ++dt) *(LAS u32x2*)(F.lds + ML_CT + (16 * dt + r16) * ML_RS + (32 * w + 16 * i + 4 * q4) * 2) = pack4(st[i][dt]); \
              if (r16 == 0) *(LAS u32x2*)(F.lds + ML_CT + 32 * ML_RS + (32 * w + 16 * i + 4 * q4) * 2) = pack4(st[i][2]); } } \
        for (int rp_ = 0; rp_ < ML_RWR; ++rp_) if (c + 1 < 32) ML_WRITE(kbn, vwn, gpn, WQ_, WK_, WV_); \
        __syncthreads(); \
    } while (0)
    for (int c2 = 0; c2 < 32; ++c2) { ML_STEP(c2, qra, kra, vra, qra, kra, vra); }
#undef ML_LOAD
#undef ML_GLOAD
#undef ML_GPREP
#undef ML_WRITE
#undef ML_STEP
}

__device__ __forceinline__ void p2b_finalize(const Ctx& F, guchar* ws) {
    int lane = F.lane; LAUNDER_V(lane); const int gw = F.vcu * NWAVES + F.wave, NGW = F.G * NWAVES;
    const gbf16* NUM = (const gbf16*)(ws + WS_NUM); gbf16* YC = (gbf16*)(ws + WS_YA) + (size_t)2 * M_ROWS * BW;
    for (int m = gw; m < M_ROWS; m += NGW) {
        float s = ((const gfloat*)(ws + WS_SSQC))[(size_t)m * 64 + lane];
        s += __shfl_xor(s, 1); s += __shfl_xor(s, 2); s += __shfl_xor(s, 4); s += __shfl_xor(s, 8);
        const float dn = ((const gfloat*)(ws + WS_DN))[(size_t)m * 4 + (lane >> 4)];
        const float inv = 1.0f / dn; const float sc = inv * rsqrtf(s * (1.0f / 512.0f) * inv * inv + NORM_EPS);
#pragma unroll
        for (int it = 0; it < 4; ++it) { const float f = __shfl(sc, 16 * it); const size_t o = (size_t)m * BW + (size_t)(it * 64 + lane) * 8;
            const u32x4 nb = *(const gu32x4*)(NUM + o); u32x4 y;
            y.x = cvt_pk_bf16(bf_lo(nb.x) * f, bf_hi(nb.x) * f); y.y = cvt_pk_bf16(bf_lo(nb.y) * f, bf_hi(nb.y) * f);
            y.z = cvt_pk_bf16(bf_lo(nb.z) * f, bf_hi(nb.z) * f); y.w = cvt_pk_bf16(bf_lo(nb.w) * f, bf_hi(nb.w) * f);
            *(gu32x4*)(YC + o) = y; }
    }
}
__device__ __forceinline__ void p5b_ssq(const Ctx& F, guchar* ws) {
    int lane = F.lane; LAUNDER_V(lane); const int gw = F.vcu * NWAVES + F.wave, NGW = F.G * NWAVES;
    for (int m = gw; m < M_ROWS; m += NGW) { const float s = wave_sum(((const gfloat*)(ws + WS_XSP))[(size_t)m * 64 + lane]); if (lane == 0) ((gfloat*)(ws + WS_CTL + CTL_SSQ1))[m] = s; }
}
__device__ __forceinline__ void p4b_x1(const Ctx& F, guchar* ws, const gfloat* npost) {
    int lane = F.lane; LAUNDER_V(lane); const int gw = F.vcu * NWAVES + F.wave, NGW = F.G * NWAVES;
    const gbf16* OUT = (const gbf16*)(ws + WS_OUT); const gbf16* XB = (const gbf16*)(ws + WS_XB); gbf16* X1B = (gbf16*)(ws + WS_X1B);
    for (int m = gw; m < M_ROWS; m += NGW) {
        const float so = wave_sum(((const gfloat*)(ws + WS_OUTP))[(size_t)m * 64 + lane]), se = wave_sum(((const gfloat*)(ws + WS_ERP))[(size_t)m * 64 + lane]);
        const float rso = rsqrtf(so * (1.0f / DM) + NORM_EPS), rse = rsqrtf(se * (1.0f / DM) + NORM_EPS);
        if (lane == 0) { ((gfloat*)(ws + WS_RSO))[m] = rso; ((gfloat*)(ws + WS_RSE))[m] = rse; }
#pragma unroll
        for (int it = 0; it < 8; ++it) { const int c = (it * 64 + lane) * 8; const size_t o = (size_t)m * DM + c;
            const u32x4 xb = *(const gu32x4*)(XB + o), ob = *(const gu32x4*)(OUT + o); const f32x4 n0 = *(const gf32x4*)(npost + c), n1 = *(const gf32x4*)(npost + c + 4); u32x4 y;
            y.x = cvt_pk_bf16(bf_lo(xb.x) + bf_lo(ob.x) * rso * n0[0], bf_hi(xb.x) + bf_hi(ob.x) * rso * n0[1]);
            y.y = cvt_pk_bf16(bf_lo(xb.y) + bf_lo(ob.y) * rso * n0[2], bf_hi(xb.y) + bf_hi(ob.y) * rso * n0[3]);
            y.z = cvt_pk_bf16(bf_lo(xb.z) + bf_lo(ob.z) * rso * n1[0], bf_hi(xb.z) + bf_hi(ob.z) * rso * n1[1]);
            y.w = cvt_pk_bf16(bf_lo(xb.w) + bf_lo(ob.w) * rso * n1[2], bf_hi(xb.w) + bf_hi(ob.w) * rso * n1[3]);
            *(gu32x4*)(X1B + o) = y; }
    }
}

#ifndef P1_WGM
#define P1_WGM 4
#endif
#ifndef REP_P0
#define REP_P0 1
#endif
#ifndef REP_P1
#define REP_P1 1
#endif
#ifndef REP_ML
#define REP_ML 1
#endif
#ifndef REP_SW
#define REP_SW 1
#endif
#ifndef REP_GM
#define REP_GM 1
#endif
#ifndef REP_P3
#define REP_P3 1
#endif
#ifndef REP_THIN
#define REP_THIN 1
#endif
#ifndef REP_BAR
#define REP_BAR 1
#endif
#ifndef REP_P4
#define REP_P4 1
#endif
__device__ __forceinline__ unsigned long long arg_ld(LAS unsigned char* lds, int i) {
    unsigned a = (unsigned)(ARGS_OFF + 8 * i); asm volatile("" : "+v"(a));
    const volatile LAS unsigned* q = (const volatile LAS unsigned*)(lds + a);
    const unsigned lo = q[0], hi = q[1];
    return ((unsigned long long)(unsigned)__builtin_amdgcn_readfirstlane((int)hi) << 32) | (unsigned)__builtin_amdgcn_readfirstlane((int)lo);
}
struct Args { const void* in[19]; float* out; unsigned char* ws; };
static_assert(sizeof(Args) == 21 * 8, "no padding in Args");

__global__ void __launch_bounds__(NTHREADS, 2) fwd_kernel(Args args) {
    extern __shared__ __attribute__((aligned(16))) unsigned char lds_raw[];
    Ctx F; F.lds = (LAS unsigned char*)lds_raw; F.tid = threadIdx.x; F.lane = F.tid & 63; F.wave = __builtin_amdgcn_readfirstlane(F.tid >> 6);
    F.G = gridDim.x; F.bx = blockIdx.x; { const int bx = blockIdx.x; F.vcu = (F.G % 8 == 0) ? (bx % 8) * (F.G / 8) + bx / 8 : bx; }
    guchar* ws0 = (guchar*)args.ws;
#define WSL() ({ guchar* w_ = ws0; LAUNDER_S(w_); w_; })
    volatile LAS unsigned* MISC = (volatile LAS unsigned*)(F.lds + MISC_OFF);
    if (F.tid < 32) MISC[F.tid] = 0u;
    __syncthreads();
    const XcdBarrier bar = xcd_barrier_post((unsigned*)(ws0 + WS_CTL) + CW_BAR, MISC);

    if (F.tid < 19) ((LAS unsigned long long*)(F.lds + ARGS_OFF))[F.tid] = (unsigned long long)args.in[F.tid];
    if (F.tid == 19) ((LAS unsigned long long*)(F.lds + ARGS_OFF))[19] = (unsigned long long)args.out;
    __syncthreads();
#define ARGP(T, i) ((T)arg_ld(F.lds, (i)))

#define FL() ({ Ctx f_ = F; LAUNDER_S(f_.lds); LAUNDER_S(f_.wave); LAUNDER_S(f_.vcu); LAUNDER_S(f_.G); LAUNDER_S(f_.bx); f_; })
#ifndef SKIP_P0
    for (int rep_ = 0; rep_ < REP_P0; ++rep_) { const Ctx Fp = FL(); guchar* ws = WSL(); p0_prologue(FL(), ARGP(const gfloat*, 0), ARGP(const gfloat*, 1), ARGP(const gint*, 2), ARGP(const gfloat*, 3), ARGP(const gfloat*, 4), ARGP(const gfloat*, 13), ARGP(const gfloat*, 14), ARGP(const gfloat*, 18), ARGP(const gfloat*, 16), ws); }
#endif
    for (int rb_ = 0; rb_ < REP_BAR; ++rb_) xcd_barrier(bar);

    for (int l = 0; l < NLAYER; ++l) {
        const gfloat* xin = l == 0 ? ARGP(const gfloat*, 0) : (const gfloat*)ARGP(gfloat*, 19);
#ifndef SKIP_P1
        for (int rep_ = 0; rep_ < REP_P1; ++rep_) { const Ctx Fp = FL(); guchar* ws = WSL(); const gfloat* ssq = l == 0 ? (const gfloat*)(ws + WS_SSQ0) : (const gfloat*)(ws + WS_CTL + CTL_SSQ1); pg8::SchedPlain S; S.T.init(M_ROWS / 256, NT_IN, Fp.G, Fp.bx, P1_WGM); S.A = (const gchar*)(ws + WS_XB); S.B = (const gchar*)(ws + WS_WIN + (size_t)l * SZ_WIN);
          S.astep = (size_t)256 * DM * 2; S.bstep = (size_t)256 * DM * 2;
          pg8::EpiIn E{ssq, ws};
          pg8::gemm_phase<pg8::EpiIn, pg8::SchedPlain>(Fp.lds, DM, DM, DM, S, E); }
#ifdef PROBE_P1CHEAP
        { const Ctx Fp = FL(); guchar* ws = WSL(); pg8::SchedPlain S; S.T.init(M_ROWS / 256, NT_IN, Fp.G, Fp.bx); S.A = (const gchar*)(ws + WS_XB); S.B = (const gchar*)(ws + WS_WIN + (size_t)l * SZ_WIN);
          S.astep = (size_t)256 * DM * 2; S.bstep = (size_t)256 * DM * 2;
          pg8::EpiSq E{(gbf16*)(ws + WS_END), (gfloat*)(ws + WS_END + (size_t)M_ROWS * 31488 * 2)};
          pg8::gemm_phase<pg8::EpiSq, pg8::SchedPlain>(Fp.lds, DM, DM, DM, S, E); }
#endif
        { const Ctx Fq = FL(); const int nwg_ = (M_ROWS / 256) * NT_IN, rem_ = nwg_ % Fq.G;
          if (rem_ == 0 || Fq.bx >= rem_) { const int me = rem_ ? Fq.bx - rem_ : Fq.bx, nw = rem_ ? Fq.G - rem_ : Fq.G;
            { const Ctx Fp = FL(); guchar* ws = WSL(); pg8::SchedPlain S; S.T.init(M_ROWS / 256, DM / 256, nw, me); S.A = (const gchar*)(ws + WS_PB + (size_t)l * M_ROWS * 256 * 2); S.B = (const gchar*)(ws + WS_WPP + (size_t)l * SZ_WPP);
              S.astep = (size_t)256 * 256 * 2; S.bstep = (size_t)256 * 256 * 2;
              pg8::EpiSq E{(gbf16*)(ws + WS_ERAW), (gfloat*)(ws + WS_ERP)};
              pg8::gemm_phase<pg8::EpiSq, pg8::SchedPlain>(Fp.lds, 256, 256, 256, S, E); }
            if (l == 0) tr_run(FL(), TR_DEFER0, TR_DEFER1, 0x7fffffff, 0x7fffffff, me, nw, ARGP(const gfloat*, 4), ARGP(const gfloat*, 3), ARGP(const gfloat*, 13), ARGP(const gfloat*, 14), ARGP(const gfloat*, 18), ARGP(const gfloat*, 16), WSL()); } }
#endif
        for (int rb_ = 0; rb_ < REP_BAR; ++rb_) xcd_barrier(bar);
#ifndef SKIP_ML
        for (int rep_ = 0; rep_ < REP_ML; ++rep_) { const Ctx Fp = FL(); guchar* ws = WSL(); for (int u = Fp.vcu; u < 256; u += Fp.G) mlstm_unit(Fp, u >> 6, (u >> 4) & 3, u & 15, ws, ARGP(const gfloat*, 10) + l * 4, ARGP(const gfloat*, 11) + l * 4, ARGP(const gfloat*, 12) + l * BW); }
#endif
#ifndef SKIP_SW
        for (int rep_ = 0; rep_ < REP_SW; ++rep_) { const Ctx Fp = FL(); guchar* ws = WSL(); for (int u = Fp.vcu; u < 256; u += Fp.G) swa_unit(Fp, u >> 6, (u >> 2) & 15, u & 3, ws, ARGP(const gfloat*, 9) + l * 32); }
#endif
#ifndef SKIP_GM
        for (int rep_ = 0; rep_ < REP_GM; ++rep_) { const Ctx Fp = FL(); guchar* ws = WSL(); for (int u = Fp.vcu; u < 512; u += Fp.G) gmlp_unit(Fp, u >> 7, (u >> 3) & 15, u & 7, ws, ARGP(const gfloat*, 5) + l * BW, ARGP(const gfloat*, 6) + l * BW, ARGP(const gfloat*, 7) + (size_t)l * 8 * 128 * 128, ARGP(const gfloat*, 8) + l * 8 * 128); }
#endif
        for (int rb_ = 0; rb_ < REP_BAR; ++rb_) xcd_barrier(bar);
#ifndef SKIP_P2B
        for (int rep_ = 0; rep_ < REP_THIN; ++rep_) p2b_finalize(FL(), WSL());
#endif
        for (int rb_ = 0; rb_ < REP_BAR; ++rb_) xcd_barrier(bar);
#ifndef PROBE_NOSTORE
#define PROBE_NOSTORE 0
#endif
#ifdef PROBE_K1024
        for (int rep_ = 0; rep_ < 4; ++rep_) { const Ctx Fp = FL(); guchar* ws = WSL(); pg8::SchedPlain S; S.T.init(M_ROWS / 256, DM / 256, Fp.G, Fp.bx); S.A = (const gchar*)(ws + WS_YA); S.B = (const gchar*)(ws + WS_WOUT + (size_t)l * SZ_WSQ);
          S.astep = (size_t)256 * DM * 2; S.bstep = (size_t)256 * DM * 2;
          pg8::EpiSq E{PROBE_NOSTORE ? (gbf16*)nullptr : (gbf16*)(ws + WS_END), (gfloat*)(ws + WS_END + (size_t)M_ROWS * 31488 * 2)};
          pg8::gemm_phase<pg8::EpiSq, pg8::SchedPlain>(Fp.lds, 1024, DM, DM, S, E); }
#endif
#ifdef PROBE_P3CHEAP
        { const Ctx Fp = FL(); guchar* ws = WSL(); pg8::SchedBranch S; S.T.init(M_ROWS / 256, DM / 256, Fp.G, Fp.bx); S.A = (const gchar*)(ws + WS_YA); S.B = (const gchar*)(ws + WS_WBR + (size_t)l * SZ_WBR);
          S.astep = (size_t)256 * BW * 2; S.bstep = (size_t)256 * BW * 2; S.aseg = SZ_ROWS_BW; S.bseg = (size_t)DM * BW * 2;
          pg8::EpiSq E{(gbf16*)(ws + WS_END), (gfloat*)(ws + WS_END + (size_t)M_ROWS * 31488 * 2)};
          pg8::gemm_phase<pg8::EpiSq, pg8::SchedBranch>(Fp.lds, BW, BW, BW, S, E); }
#endif
#ifndef SKIP_P3
        for (int rep_ = 0; rep_ < REP_P3; ++rep_) { const Ctx Fp = FL(); guchar* ws = WSL(); pg8::SchedBranch S; S.T.init(M_ROWS / 256, DM / 256, Fp.G, Fp.bx); S.A = (const gchar*)(ws + WS_YA); S.B = (const gchar*)(ws + WS_WBR + (size_t)l * SZ_WBR);
          S.astep = (size_t)256 * BW * 2; S.bstep = (size_t)256 * BW * 2; S.aseg = SZ_ROWS_BW; S.bseg = (size_t)DM * BW * 2;
          pg8::EpiBranch E{(const gbf16*)(ws + WS_G), (gbf16*)(ws + WS_MIX)};
          pg8::gemm_phase<pg8::EpiBranch, pg8::SchedBranch>(Fp.lds, BW, BW, BW, S, E); }
#endif
        for (int rb_ = 0; rb_ < REP_BAR; ++rb_) xcd_barrier(bar);
#ifndef SKIP_P4
        for (int rep_ = 0; rep_ < REP_P4; ++rep_) { const Ctx Fp = FL(); guchar* ws = WSL(); pg8::SchedPlain S; S.T.init(M_ROWS / 256, DM / 256, Fp.G, Fp.bx); S.A = (const gchar*)(ws + WS_MIX); S.B = (const gchar*)(ws + WS_WOUT + (size_t)l * SZ_WSQ);
          S.astep = (size_t)256 * DM * 2; S.bstep = (size_t)256 * DM * 2;
          pg8::EpiSq E{(gbf16*)(ws + WS_OUT), (gfloat*)(ws + WS_OUTP)};
          pg8::gemm_phase<pg8::EpiSq, pg8::SchedPlain>(Fp.lds, DM, DM, DM, S, E); }
#endif
        for (int rb_ = 0; rb_ < REP_BAR; ++rb_) xcd_barrier(bar);
#ifndef SKIP_P4B
        for (int rep_ = 0; rep_ < REP_THIN; ++rep_) p4b_x1(FL(), WSL(), ARGP(const gfloat*, 15) + l * DM);
#endif
        for (int rb_ = 0; rb_ < REP_BAR; ++rb_) xcd_barrier(bar);
#ifdef PROBE_P5
        { const Ctx Fp = FL(); guchar* ws = WSL(); pg8::SchedPlain S; S.T.init(M_ROWS / 256, DM / 256, Fp.G, Fp.bx); S.A = (const gchar*)(ws + WS_X1B); S.B = (const gchar*)(ws + WS_WPG + (size_t)l * SZ_WSQ);
          S.astep = (size_t)256 * DM * 2; S.bstep = (size_t)256 * DM * 2;
          pg8::EpiPle E{xin, (gfloat*)(ws + WS_END), (gbf16*)(ws + WS_END + (size_t)M_ROWS * DM * 4), (const gbf16*)(ws + WS_OUT), (const gbf16*)(ws + WS_ERAW), (const gfloat*)(ws + WS_RSO), (const gfloat*)(ws + WS_RSE),
                        ARGP(const gfloat*, 15) + l * DM, ARGP(const gfloat*, 17) + l * DM, (gfloat*)(ws + WS_END + (size_t)M_ROWS * DM * 6), 0};
          pg8::gemm_phase<pg8::EpiPle, pg8::SchedPlain>(Fp.lds, DM, DM, DM, S, E); }
#endif
#ifndef SKIP_P5
        { const Ctx Fp = FL(); guchar* ws = WSL(); pg8::SchedPlain S; S.T.init(M_ROWS / 256, DM / 256, Fp.G, Fp.bx); S.A = (const gchar*)(ws + WS_X1B); S.B = (const gchar*)(ws + WS_WPG + (size_t)l * SZ_WSQ);
          S.astep = (size_t)256 * DM * 2; S.bstep = (size_t)256 * DM * 2;
          pg8::EpiPle E{xin, ARGP(gfloat*, 19), (gbf16*)(ws + WS_XB), (const gbf16*)(ws + WS_OUT), (const gbf16*)(ws + WS_ERAW), (const gfloat*)(ws + WS_RSO), (const gfloat*)(ws + WS_RSE),
                        ARGP(const gfloat*, 15) + l * DM, ARGP(const gfloat*, 17) + l * DM, (gfloat*)(ws + WS_XSP), l == NLAYER - 1 ? 1 : 0};
          pg8::gemm_phase<pg8::EpiPle, pg8::SchedPlain>(Fp.lds, DM, DM, DM, S, E); }
#endif
        if (l + 1 < NLAYER) { for (int rb_ = 0; rb_ < REP_BAR; ++rb_) xcd_barrier(bar); p5b_ssq(FL(), WSL()); for (int rb_ = 0; rb_ < REP_BAR; ++rb_) xcd_barrier(bar); }
    }
}

extern "C" void kernel_launch(void* const* d_in, const int* in_sizes, int n_in, void* d_out, int out_size, void* d_ws, size_t ws_size, hipStream_t stream) {
    static int grid = 0;
    if (grid == 0) {
        if (n_in != 19 || out_size != M_ROWS * DM || ws_size < WS_END) { fprintf(stderr, "kernel_launch: unexpected problem (n_in %d, out %d, ws %zu, need %zu)\n", n_in, out_size, ws_size, (size_t)WS_END); grid = -1; return; }
        int dev = 0, cus = 0;
        if (hipGetDevice(&dev) != hipSuccess || hipDeviceGetAttribute(&cus, hipDeviceAttributeMultiprocessorCount, dev) != hipSuccess) { grid = -1; return; }
        if (hipFuncSetAttribute((const void*)fwd_kernel, hipFuncAttributeMaxDynamicSharedMemorySize, LDS_BYTES) != hipSuccess) { fprintf(stderr, "kernel_launch: hipFuncSetAttribute failed\n"); grid = -1; return; }
        int per_cu = 0; (void)hipOccupancyMaxActiveBlocksPerMultiprocessor(&per_cu, (const void*)fwd_kernel, NTHREADS, LDS_BYTES); (void)hipGetLastError();
        if (per_cu < 1) fprintf(stderr, "kernel_launch: occupancy query reports %d blocks per CU\n", per_cu);
        grid = cus > 256 ? 256 : cus;
    }
    if (grid < 0) return;
    (void)hipMemsetAsync((char*)d_ws + WS_CTL, 0, CTL_ZERO_BYTES, stream);
    Args a{};
    for (int i = 0; i < 19; ++i) a.in[i] = d_in[i];
    a.out = (float*)d_out; a.ws = (unsigned char*)d_ws;
    hipLaunchKernelGGL(fwd_kernel, dim3(grid), dim3(NTHREADS), LDS_BYTES, stream, a);
    const hipError_t le = hipPeekAtLastError();
    if (le != hipSuccess) fprintf(stderr, "kernel_launch: launch failed: %s\n", hipGetErrorName(le));
}
```

```cpp
#include <hip/hip_runtime.h>
#include <cstdio>
#include <cstdint>

#define LAS __attribute__((address_space(3)))
#define GAS __attribute__((address_space(1)))
typedef unsigned short bf16_t;
typedef short bf16x8 __attribute__((ext_vector_type(8)));
typedef float f32x4 __attribute__((ext_vector_type(4)));
typedef float f32x2 __attribute__((ext_vector_type(2)));
typedef unsigned u32x4 __attribute__((ext_vector_type(4)));
typedef unsigned u32x2 __attribute__((ext_vector_type(2)));

typedef GAS float gfloat; typedef GAS bf16_t gbf16; typedef GAS int gint; typedef GAS char gchar; typedef GAS unsigned char guchar; typedef GAS unsigned gunsigned;
typedef GAS f32x4 gf32x4; typedef GAS f32x2 gf32x2; typedef GAS u32x4 gu32x4; typedef GAS u32x2 gu32x2;
constexpr int M_ROWS = 8192, SEQ = 2048, DM = 4096, BW = 2048, NLAYER = 2;
constexpr int N_IN = 31240, IF_COL = 14848;
constexpr int NT_IN = 123;
constexpr int N_IN_T = NT_IN * 256;
constexpr float NORM_EPS = 1e-6f;

__device__ __forceinline__ unsigned cvt_pk_bf16(float lo, float hi) { unsigned r; asm("v_cvt_pk_bf16_f32 %0, %1, %2" : "=v"(r) : "v"(lo), "v"(hi)); return r; }
__device__ __forceinline__ float bf_lo(unsigned w) { return __uint_as_float(w << 16); }
__device__ __forceinline__ float bf_hi(unsigned w) { return __uint_as_float(w & 0xffff0000u); }
__device__ __forceinline__ float bf1(bf16_t b) { return __uint_as_float(((unsigned)b) << 16); }
__device__ __forceinline__ float fsigmoid(float x) { return __builtin_amdgcn_rcpf(1.0f + __expf(-x)); }
__device__ __forceinline__ float wave_sum(float v) {
#pragma unroll
    for (int o = 1; o < 64; o <<= 1) v += __shfl_xor(v, o);
    return v;
}
__device__ __forceinline__ f32x2 gelu_pk(f32x2 v) {
    const f32x2 av = __builtin_elementwise_abs(v), d = av * 0.2316418882f + 1.0f;
    f32x2 t; t.x = __builtin_amdgcn_rcpf(d.x); t.y = __builtin_amdgcn_rcpf(d.y);
    f32x2 q = t * 0.5307027145f + (-0.7265760135f); q = q * t + 0.7107068705f; q = q * t + (-0.142248368f); q = q * t + 0.127414796f; q = q * t;
    const f32x2 s = (v * v) * (-0.72134752044f);
    f32x2 e; e.x = __builtin_amdgcn_exp2f(s.x); e.y = __builtin_amdgcn_exp2f(s.y);
    const f32x2 m = v * (q * e), r = v - m;
    f32x2 o; o.x = v.x < 0.f ? m.x : r.x; o.y = v.y < 0.f ? m.y : r.y; return o;
}
#define LAUNDER_V(x) asm volatile("" : "+v"(x))
#define LAUNDER_S(x) asm volatile("" : "+s"(x))
#define LDS_WAIT() asm volatile("s_waitcnt lgkmcnt(0)" ::: "memory")
#define VM_WAIT() asm volatile("s_waitcnt vmcnt(0)" ::: "memory")
#define MFMA16(a, b, c) __builtin_amdgcn_mfma_f32_16x16x32_bf16((a), (b), (c), 0, 0, 0)

#define XB_TMO      128
#define XB_XCNT(j)  (256  + 64 * (j))
#define XB_XSUB(j)  (1280 + 64 * (j))
#define XB_XGEN(j)  (2304 + 64 * (j))
#define XB_TOP      3328
#define XB_TOPGEN   3392
#define XCD_BAR_WORDS 3456
#define XB_SPIN_CAP (1u << 18)
__device__ __forceinline__ unsigned xb_ld(unsigned* p)              { return __hip_atomic_load(p, __ATOMIC_RELAXED, __HIP_MEMORY_SCOPE_AGENT); }
__device__ __forceinline__ unsigned xb_add(unsigned* p, unsigned v) { return __hip_atomic_fetch_add(p, v, __ATOMIC_RELAXED, __HIP_MEMORY_SCOPE_AGENT); }
__device__ __forceinline__ unsigned xb_xcc_id() { return (unsigned)__builtin_amdgcn_s_getreg((3 << 11) | 20) & 0xFu; }
#define XB_SPIN(cond, bar) do { unsigned _sp = 0; while (cond) { __builtin_amdgcn_s_sleep(1); \
    if ((++_sp & 255u) == 0u) { if (xb_ld(&(bar)[XB_TMO])) break; if (_sp > XB_SPIN_CAP) { atomicAdd(&(bar)[XB_TMO], 1u); break; } } } } while (0)
struct XcdBarrier { unsigned* bar; unsigned x; volatile LAS unsigned* st; };
__device__ __forceinline__ XcdBarrier xcd_barrier_post(unsigned* bar, volatile LAS unsigned* st) {
    XcdBarrier b; b.bar = bar; b.x = xb_xcc_id(); b.st = st;
    if (threadIdx.x == 0) (void)xb_add(&bar[XB_XCNT(b.x)], 1u);
    return b;
}
__device__ __forceinline__ void xcd_barrier_complete(unsigned* bar, unsigned x, unsigned& nloc, unsigned& nx) {
    const unsigned G = gridDim.x * gridDim.y * gridDim.z;
    unsigned sum, cnt, mine, sp = 0u;
    for (;;) {
        sum = 0u; cnt = 0u; mine = 0u;
#pragma unroll
        for (unsigned j = 0; j < 16; ++j) { const unsigned c = xb_ld(&bar[XB_XCNT(j)]); sum += c; cnt += (c > 0u) ? 1u : 0u; mine = (j == x) ? c : mine; }
        if (sum == G) break;
        __builtin_amdgcn_s_sleep(1);
        if ((++sp & 255u) == 0u) { if (xb_ld(&bar[XB_TMO])) break; if (sp > XB_SPIN_CAP) { atomicAdd(&bar[XB_TMO], 1u); break; } }
    }
    nloc = mine > 0u ? mine : 1u; nx = cnt > 0u ? cnt : 1u;
}
__device__ __forceinline__ void xcd_barrier(const XcdBarrier& b) {
    asm volatile("s_waitcnt vmcnt(0)" ::: "memory");
    __syncthreads();
    if (threadIdx.x == 0) {
        unsigned* bar = b.bar;
        __builtin_amdgcn_s_waitcnt(0);
        unsigned nloc = b.st[0], nx = b.st[1];
        if (nloc == 0u) { xcd_barrier_complete(bar, b.x, nloc, nx); b.st[0] = nloc; b.st[1] = nx; }
        const unsigned old = xb_add(&bar[XB_XSUB(b.x)], 1u);
        const unsigned gen = old / nloc;
        if (old + 1u == (gen + 1u) * nloc) {
            __builtin_amdgcn_fence(__ATOMIC_RELEASE, "agent");
            asm volatile("s_waitcnt vmcnt(0)" ::: "memory");
            const unsigned og = xb_add(&bar[XB_TOP], 1u);
            const unsigned tg = og / nx;
            if (og + 1u == (tg + 1u) * nx) xb_add(&bar[XB_TOPGEN], 1u);
            else XB_SPIN(xb_ld(&bar[XB_TOPGEN]) == tg, bar);
            __builtin_amdgcn_fence(__ATOMIC_ACQUIRE, "agent");
            xb_add(&bar[XB_XGEN(b.x)], 1u);
            asm volatile("s_waitcnt vmcnt(0)" ::: "memory");
        } else {
            XB_SPIN(xb_ld(&bar[XB_XGEN(b.x)]) == gen, bar);
            __builtin_amdgcn_fence(__ATOMIC_ACQUIRE, "agent");
            asm volatile("s_waitcnt vmcnt(0)" ::: "memory");
        }
    }
    __syncthreads();
}

#ifndef WGM_DEFAULT
#define WGM_DEFAULT 4
#endif
namespace pg8 {
constexpr int BM = 256, BK = 64, HALF = 128, HTB = HALF * BK * 2, STAGE_BYTES = 8 * HTB, NXCD = 8, WGM = WGM_DEFAULT;
__host__ __device__ __forceinline__ int lds_byte(int r, int c) { const int st = (r >> 4) * 2 + (c >> 5), rr = r & 15, cc = c & 31, ob = rr * 64 + cc * 2; return st * 1024 + (ob ^ (((ob >> 9) & 1) << 5)); }
__host__ __device__ __forceinline__ void stage_rc(int b, int& R, int& C) { const int st = b / 1024, sb = b % 1024, swz = sb ^ (((sb >> 9) & 1) << 5); R = (st >> 1) * 16 + swz / 64; C = (st & 1) * 32 + (swz % 64) / 2; }
__host__ __device__ __forceinline__ int perm32(int rho) { const int n = rho >> 4, i = rho & 15; return 8 * (i >> 2) + 4 * n + (i & 3); }

struct Unit { int pm, pn, seg; };

struct TileOrder {
    int nM, nN, nwg, G, c, wgm, rot;
    __device__ __forceinline__ void init(int nM_, int nN_, int G_, int c_, int wgm_ = WGM, int rot_ = 0) { nM = nM_; nN = nN_; nwg = nM * nN; G = G_; c = c_; wgm = wgm_; rot = rot_; }
    __device__ __forceinline__ bool tile(int i, int& pm, int& pn) const {
        const long L = (long)i * G + c; if (L >= nwg) return false;
        int wgid = (int)L; const int xcd = wgid % NXCD; { const int q = nwg / NXCD, r = nwg % NXCD, off = wgid / NXCD; wgid = (xcd < r ? xcd * (q + 1) : r * (q + 1) + (xcd - r) * q) + off; }
        const int nig = wgm * nN, gid = wgid / nig, fm = gid * wgm, gsz = (nM - fm) < wgm ? (nM - fm) : wgm;
        pm = fm + ((wgid % nig) % gsz); pn = (wgid % nig) / gsz; if (rot) { pn += rot * xcd; pn -= (pn / nN) * nN; } return true;
    }
};
struct SchedPlain {
    TileOrder T; const gchar* A; const gchar* B; size_t astep, bstep;
    __device__ __forceinline__ bool next(int i, Unit& u) const { u.seg = 0; return T.tile(i, u.pm, u.pn); }
    __device__ __forceinline__ const gchar* a_ptr(const Unit& u) const { return A + (size_t)u.pm * astep; }
    __device__ __forceinline__ const gchar* b_ptr(const Unit& u) const { return B + (size_t)u.pn * bstep; }
};
struct SchedBranch {
    TileOrder T; const gchar* A; const gchar* B; size_t astep, bstep, aseg, bseg;
    __device__ __forceinline__ bool next(int i, Unit& u) const { const int t = i / 3; u.seg = i - 3 * t; return T.tile(t, u.pm, u.pn); }
    __device__ __forceinline__ const gchar* a_ptr(const Unit& u) const { return A + (size_t)u.seg * aseg + (size_t)u.pm * astep; }
    __device__ __forceinline__ const gchar* b_ptr(const Unit& u) const { return B + (size_t)u.seg * bseg + (size_t)u.pn * bstep; }
};

template <class Epi, class Sched>
__device__ __forceinline__ void gemm_phase(LAS unsigned char* lds, const int K, const int lda, const int ldb, const Sched& S, const Epi& E) {
    int tid = threadIdx.x; LAUNDER_V(tid);
    const int wid = __builtin_amdgcn_readfirstlane(tid >> 6), lane = tid & 63, wr = wid >> 2, wc = wid & 3, fr = lane & 15, fq = lane >> 4;
    const int nt = K / BK;
    unsigned voffA, voffB;
    { int R, C; stage_rc(tid * 16, R, C); const int Rb = Epi::PERM ? ((R & ~31) + perm32(R & 31)) : R;
      voffA = (unsigned)(R * lda + C) * 2u; voffB = (unsigned)(Rb * ldb + C) * 2u; }
    const unsigned qstepA = 64u * (unsigned)lda * 2u, qstepB = 64u * (unsigned)ldb * 2u;
    const size_t kstep = (size_t)(BK * 2);
    const size_t hstepA = (size_t)HALF * lda * 2, hstepB = (size_t)HALF * ldb * 2;
    const unsigned ldsw = (unsigned)wid * 1024u;
    const int aoff = lds_byte(wr * 64 + fr, fq * 8), boff = lds_byte(wc * 32 + fr, fq * 8);
#define PG8_SA(b, h) (((b) * 2 + (h)) * HTB)
#define PG8_SB(b, h) ((4 + (b) * 2 + (h)) * HTB)
#define PG8_STAGE(bufoff, gbase, voff) do { _Pragma("unroll") for (int _i = 0; _i < 2; ++_i) \
        __builtin_amdgcn_global_load_lds((const gunsigned*)((const gchar*)(gbase) + (size_t)_i * q##voff + (voff)), (LAS unsigned*)(lds + (bufoff) + ldsw + _i * 8192), 16, 0, 0); } while (0)
#define qvoffA qstepA
#define qvoffB qstepB
#define PG8_LDA(dst, b, h) do { _Pragma("unroll") for (int m = 0; m < 4; ++m) _Pragma("unroll") for (int k = 0; k < 2; ++k) dst[m][k] = *(const LAS bf16x8*)(lds + PG8_SA(b, h) + aoff + m * 2048 + k * 1024); } while (0)
#define PG8_LDB(dst, b, h) do { _Pragma("unroll") for (int n = 0; n < 2; ++n) _Pragma("unroll") for (int k = 0; k < 2; ++k) dst[n][k] = *(const LAS bf16x8*)(lds + PG8_SB(b, h) + boff + n * 2048 + k * 1024); } while (0)
#define PG8_MMA(ai, bj, At, Bt) do { __builtin_amdgcn_s_setprio(1); _Pragma("unroll") for (int m = 0; m < 4; ++m) _Pragma("unroll") for (int n = 0; n < 2; ++n) _Pragma("unroll") for (int k = 0; k < 2; ++k) \
        acc[ai][bj][m][n] = __builtin_amdgcn_mfma_f32_16x16x32_bf16(Bt[n][k], At[m][k], acc[ai][bj][m][n], 0, 0, 0); __builtin_amdgcn_s_setprio(0); } while (0)
#define PG8_WAIT_V(n) asm volatile("s_waitcnt vmcnt(" #n ")" ::: "memory")
#define PG8_WAIT_VR() do { if constexpr (Epi::NS == 16) asm volatile("s_waitcnt vmcnt(24)" ::: "memory"); else if constexpr (Epi::NS == 32) asm volatile("s_waitcnt vmcnt(40)" ::: "memory"); else asm volatile("s_waitcnt vmcnt(8)" ::: "memory"); } while (0)
#define PG8_WAIT_L(n) asm volatile("s_waitcnt lgkmcnt(" #n ")" ::: "memory")
#define PG8_BAR __builtin_amdgcn_s_barrier()
#define PG8_SCHED __builtin_amdgcn_sched_barrier(0)
    Unit cur, nxt; int ui = 0; bool relax_next = false;
    if (!S.next(0, cur)) return;
    f32x4 acc[2][2][4][2];
#pragma unroll
    for (int a = 0; a < 2; ++a)
#pragma unroll
        for (int b = 0; b < 2; ++b)
#pragma unroll
            for (int m = 0; m < 4; ++m)
#pragma unroll
                for (int n = 0; n < 2; ++n) acc[a][b][m][n] = (f32x4){0.f, 0.f, 0.f, 0.f};
    bf16x8 At[4][2], B0[2][2], B1[2][2];
    const gchar* cA = S.a_ptr(cur); const gchar* cB = S.b_ptr(cur);
    PG8_STAGE(PG8_SB(0, 0), cB, voffB); PG8_STAGE(PG8_SB(0, 1), cB + hstepB, voffB); PG8_STAGE(PG8_SA(0, 0), cA, voffA); PG8_STAGE(PG8_SA(0, 1), cA + hstepA, voffA);
    if (wr == 1) PG8_BAR;
    PG8_WAIT_V(2); PG8_BAR;
    PG8_STAGE(PG8_SB(1, 0), cB + kstep, voffB); PG8_STAGE(PG8_SA(1, 0), cA + kstep, voffA); PG8_STAGE(PG8_SB(1, 1), cB + hstepB + kstep, voffB);
    PG8_WAIT_V(6); PG8_BAR;
    for (;;) {
        const bool has_next = S.next(ui + 1, nxt);
        const gchar* nA = has_next ? S.a_ptr(nxt) : cA; const gchar* nB = has_next ? S.b_ptr(nxt) : cB;
        for (int t = 0; t < nt; t += 2) {
            const bool last = (t == nt - 2); const bool relax = Epi::NS > 0 && (t == 0) && relax_next;
            const gchar* a1 = cA + (size_t)(t + 1) * kstep;
            const gchar* a2 = last ? nA : cA + (size_t)(t + 2) * kstep; const gchar* b2 = last ? nB : cB + (size_t)(t + 2) * kstep;
            const gchar* a3 = a2 + kstep; const gchar* b3 = b2 + kstep;
            PG8_LDB(B0, 0, 0); PG8_LDB(B1, 0, 1); PG8_SCHED; PG8_LDA(At, 0, 0); PG8_STAGE(PG8_SA(1, 1), a1 + hstepA, voffA);
            if (relax) PG8_WAIT_VR(); else PG8_WAIT_V(8); PG8_WAIT_L(0); PG8_BAR; PG8_MMA(0, 0, At, B0); PG8_MMA(0, 1, At, B1); PG8_BAR; PG8_SCHED;
            PG8_LDA(At, 0, 1); PG8_STAGE(PG8_SB(0, 0), b2, voffB); PG8_STAGE(PG8_SB(0, 1), b2 + hstepB, voffB); PG8_STAGE(PG8_SA(0, 0), a2, voffA);
            if (relax) PG8_WAIT_VR(); else PG8_WAIT_V(8); PG8_WAIT_L(0); PG8_BAR; PG8_MMA(1, 0, At, B0); PG8_MMA(1, 1, At, B1); PG8_BAR; PG8_SCHED;
            PG8_LDB(B0, 1, 0); PG8_LDB(B1, 1, 1); PG8_SCHED; PG8_LDA(At, 1, 0); PG8_STAGE(PG8_SA(0, 1), a2 + hstepA, voffA);
            PG8_WAIT_V(8); PG8_WAIT_L(0); PG8_BAR; PG8_MMA(0, 0, At, B0); PG8_MMA(0, 1, At, B1); PG8_BAR; PG8_SCHED;
            PG8_LDA(At, 1, 1); PG8_STAGE(PG8_SB(1, 0), b3, voffB); PG8_STAGE(PG8_SB(1, 1), b3 + hstepB, voffB); PG8_STAGE(PG8_SA(1, 0), a3, voffA);
            PG8_WAIT_V(8); PG8_WAIT_L(0); PG8_BAR; PG8_MMA(1, 0, At, B0); PG8_MMA(1, 1, At, B1); PG8_BAR; PG8_SCHED;
        }
        if (wr == 0) PG8_BAR;
        { const int ln_ = (int)__builtin_amdgcn_mbcnt_hi(~0u, __builtin_amdgcn_mbcnt_lo(~0u, 0u)); E(acc, cur, wr, wc, ln_ & 15, ln_ >> 4); } relax_next = E.relax(cur);
        if (!has_next) break;
        if (!E.keep(cur)) {
#pragma unroll
            for (int a = 0; a < 2; ++a)
#pragma unroll
                for (int b = 0; b < 2; ++b)
#pragma unroll
                    for (int m = 0; m < 4; ++m)
#pragma unroll
                        for (int n = 0; n < 2; ++n) acc[a][b][m][n] = (f32x4){0.f, 0.f, 0.f, 0.f};
        }
        cur = nxt; cA = nA; cB = nB; ++ui;
        if (wr == 1) PG8_BAR;
    }
    PG8_WAIT_V(0);
    PG8_BAR;
#undef PG8_SA
#undef PG8_SB
#undef PG8_STAGE
#undef qvoffA
#undef qvoffB
#undef PG8_LDA
#undef PG8_LDB
#undef PG8_MMA
#undef PG8_WAIT_V
#undef PG8_WAIT_VR
#undef PG8_WAIT_L
#undef PG8_BAR
#undef PG8_SCHED
}
}

constexpr size_t MiB = 1u << 20;
constexpr size_t WS_CTL = 0, CTL_ZERO_BYTES = 1 * MiB;
constexpr int CW_BAR = 4096;
constexpr size_t CTL_SSQ1 = 256 * 1024;
constexpr size_t SZ_WIN = (size_t)N_IN_T * DM * 2, SZ_WBR = (size_t)3 * DM * BW * 2, SZ_WSQ = (size_t)DM * DM * 2, SZ_WPP = (size_t)DM * 256 * 2;
constexpr size_t WS_WIN = 2 * MiB;
constexpr size_t WS_WBR = WS_WIN + 2 * SZ_WIN;
constexpr size_t WS_WOUT = WS_WBR + 2 * SZ_WBR;
constexpr size_t WS_WPG = WS_WOUT + 2 * SZ_WSQ;
constexpr size_t WS_WPP = WS_WPG + 2 * SZ_WSQ;
constexpr size_t SZ_ROWS_BW = (size_t)M_ROWS * BW * 2, SZ_ROWS_D = (size_t)M_ROWS * DM * 2;
constexpr size_t WS_XB = WS_WPP + 2 * SZ_WPP;
constexpr size_t WS_PB = WS_XB + SZ_ROWS_D;
constexpr size_t WS_CS = WS_PB + (size_t)2 * M_ROWS * 256 * 2;
constexpr size_t WS_SSQ0 = WS_CS + (size_t)M_ROWS * 16 * 4;
constexpr size_t WS_AU = WS_SSQ0 + (size_t)M_ROWS * 4;
constexpr size_t WS_AV = WS_AU + SZ_ROWS_BW, WS_AZ = WS_AV + SZ_ROWS_BW, WS_BQ = WS_AZ + SZ_ROWS_BW;
constexpr size_t WS_BK = WS_BQ + SZ_ROWS_BW;
constexpr size_t WS_BV = WS_BK + (size_t)M_ROWS * 256 * 2;
constexpr size_t WS_BZ = WS_BV + (size_t)M_ROWS * 256 * 2;
constexpr size_t WS_CQ = WS_BZ + SZ_ROWS_BW;
constexpr size_t WS_CK = WS_CQ + (size_t)M_ROWS * 1024 * 2;
constexpr size_t WS_CV = WS_CK + (size_t)M_ROWS * 1024 * 2;
constexpr size_t WS_CO = WS_CV + SZ_ROWS_BW, WS_CZ = WS_CO + SZ_ROWS_BW;
constexpr size_t WS_G = WS_CZ + SZ_ROWS_BW;
constexpr size_t WS_IF = WS_G + (size_t)M_ROWS * 12288 * 2;
constexpr size_t WS_LNP = WS_IF + (size_t)M_ROWS * 8 * 4;
constexpr size_t WS_YA = WS_LNP + (size_t)M_ROWS * 32 * 8;
constexpr size_t WS_NUM = WS_YA + 3 * SZ_ROWS_BW;
constexpr size_t WS_SSQC = WS_NUM + SZ_ROWS_BW;
constexpr size_t WS_DN = WS_SSQC + (size_t)M_ROWS * 64 * 4;
constexpr size_t WS_MIX = WS_DN + (size_t)M_ROWS * 4 * 4;
constexpr size_t WS_OUT = WS_MIX + SZ_ROWS_D;
constexpr size_t WS_OUTP = WS_OUT + SZ_ROWS_D;
constexpr size_t WS_ERAW = WS_OUTP + (size_t)M_ROWS * 64 * 4;
constexpr size_t WS_ERP = WS_ERAW + SZ_ROWS_D;
constexpr size_t WS_RSO = WS_ERP + (size_t)M_ROWS * 64 * 4;
constexpr size_t WS_RSE = WS_RSO + (size_t)M_ROWS * 4;
constexpr size_t WS_X1B = WS_RSE + (size_t)M_ROWS * 4;
constexpr size_t WS_XSP = WS_X1B + SZ_ROWS_D;
constexpr size_t WS_END = WS_XSP + (size_t)M_ROWS * 64 * 4;
static_assert(WS_WIN % 256 == 0 && WS_XB % 256 == 0 && WS_AU % 256 == 0 && WS_G % 256 == 0 && WS_YA % 256 == 0 && WS_MIX % 256 == 0 && WS_X1B % 256 == 0, "alignment");

#ifndef EPIIN_NT
#define EPIIN_NT 0
#endif
#if EPIIN_NT
#define EPIIN_STORE(v, p) __builtin_nontemporal_store((v), (p))
#else
#define EPIIN_STORE(v, p) (*(p) = (v))
#endif
#ifndef EPI_NS16
#define EPI_NS16 0
#endif
#ifndef EPI_NS32
#define EPI_NS32 0
#endif
#ifndef EPIIN_NS
#define EPIIN_NS 0
#endif
namespace pg8 {
struct EpiIn {
    static constexpr bool PERM = true; static constexpr int NS = EPIIN_NS;
    __device__ __forceinline__ bool relax(const Unit& u) const { return u.pn < 122; }
    const gfloat* ssq; guchar* ws;
    __device__ __forceinline__ bool keep(const Unit&) const { return false; }
    __device__ __forceinline__ void operator()(f32x4 (&acc)[2][2][4][2], const Unit& u, int wr, int wc, int fr, int fq) const {
        const int pn = u.pn; const int row0 = u.pm * BM + wr * 64 + fr;
        size_t off; int ldc, t0, act; float sc = 1.f;
        if (pn < 16)       { off = WS_AU; ldc = 2048; t0 = 0; act = 6; }
        else if (pn < 24)  { off = WS_AV; ldc = 2048; t0 = 16; act = 5; }
        else if (pn < 32)  { off = WS_BQ; ldc = 2048; t0 = 24; act = 0; }
        else if (pn < 33)  { off = WS_BK; ldc = 256; t0 = 32; act = 0; }
        else if (pn < 34)  { off = WS_BV; ldc = 256; t0 = 33; act = 0; }
        else if (pn < 42)  { off = WS_BZ; ldc = 2048; t0 = 34; act = 2; }
        else if (pn < 46)  { off = WS_CQ; ldc = 1024; t0 = 42; act = 0; sc = 0.0625f; }
        else if (pn < 50)  { off = WS_CK; ldc = 1024; t0 = 46; act = 0; }
        else if (pn < 58)  { off = WS_CV; ldc = 2048; t0 = 50; act = 0; }
        else if (pn < 74)  { off = WS_CO; ldc = 2048; t0 = 58; act = 7; }
        else if (pn < 122) { off = WS_G; ldc = 12288; t0 = 74; act = 3; }
        else               { off = WS_IF; ldc = 8; t0 = 122; act = 4; }
        const int col0 = (pn - t0) * BM + wc * 32 + 8 * fq;
        if (act == 4) {
            if (wc == 0 && fq == 0) {
                gfloat* dst = (gfloat*)(ws + off);
#pragma unroll
                for (int ai = 0; ai < 2; ++ai)
#pragma unroll
                    for (int m = 0; m < 4; ++m) { const int row = row0 + ai * HALF + m * 16; const float rs = rsqrtf(ssq[row] * (1.0f / DM) + NORM_EPS);
                        *(gf32x4*)(dst + (size_t)row * 8) = acc[ai][0][m][0] * rs; *(gf32x4*)(dst + (size_t)row * 8 + 4) = acc[ai][0][m][1] * rs; }
            }
            return;
        }
        gbf16* base = (gbf16*)(ws + off);
        if (act == 6 || act == 7) {
            const int colp = (pn - t0) * HALF + wc * 32 + 8 * fq;
#pragma unroll
            for (int ai = 0; ai < 2; ++ai)
#pragma unroll
                for (int m = 0; m < 4; ++m) {
                    const int row = row0 + ai * HALF + m * 16; const float rs = rsqrtf(ssq[row] * (1.0f / DM) + NORM_EPS);
                    f32x4 a0 = acc[ai][0][m][0] * rs, a1 = acc[ai][0][m][1] * rs; const f32x4 z0 = acc[ai][1][m][0] * rs, z1 = acc[ai][1][m][1] * rs;
                    if (act == 6) { const f32x2 a = gelu_pk((f32x2){a0[0], a0[1]}), b = gelu_pk((f32x2){a0[2], a0[3]}), c = gelu_pk((f32x2){a1[0], a1[1]}), d = gelu_pk((f32x2){a1[2], a1[3]});
                        a0 = (f32x4){a.x, a.y, b.x, b.y}; a1 = (f32x4){c.x, c.y, d.x, d.y}; }
                    else {
#pragma unroll
                        for (int j = 0; j < 4; ++j) { a0[j] = fsigmoid(a0[j]); a1[j] = fsigmoid(a1[j]); } }
#pragma unroll
                    for (int j = 0; j < 4; ++j) { a0[j] *= z0[j] * fsigmoid(z0[j]); a1[j] *= z1[j] * fsigmoid(z1[j]); }
                    u32x4 w; w.x = cvt_pk_bf16(a0[0], a0[1]); w.y = cvt_pk_bf16(a0[2], a0[3]); w.z = cvt_pk_bf16(a1[0], a1[1]); w.w = cvt_pk_bf16(a1[2], a1[3]);
                    *(gu32x4*)(base + (size_t)row * ldc + colp) = w;
                }
            return;
        }
#pragma unroll
        for (int ai = 0; ai < 2; ++ai)
#pragma unroll
            for (int m = 0; m < 4; ++m) {
                const int row = row0 + ai * HALF + m * 16; const float rs = rsqrtf(ssq[row] * (1.0f / DM) + NORM_EPS) * sc;
                gbf16* rowp = base + (size_t)row * ldc + col0; float ls = 0.f, lq = 0.f;
#pragma unroll
                for (int bj = 0; bj < 2; ++bj) {
                    f32x4 v0 = acc[ai][bj][m][0] * rs, v1 = acc[ai][bj][m][1] * rs;
                    if (act == 5) {
                        f32x2 a = gelu_pk((f32x2){v0[0], v0[1]}), b = gelu_pk((f32x2){v0[2], v0[3]}), c = gelu_pk((f32x2){v1[0], v1[1]}), d = gelu_pk((f32x2){v1[2], v1[3]});
                        v0 = (f32x4){a.x, a.y, b.x, b.y}; v1 = (f32x4){c.x, c.y, d.x, d.y};
                        { ls += (v0[0] + v0[1]) + (v0[2] + v0[3]) + (v1[0] + v1[1]) + (v1[2] + v1[3]);
                            lq += (v0[0] * v0[0] + v0[1] * v0[1]) + (v0[2] * v0[2] + v0[3] * v0[3]) + (v1[0] * v1[0] + v1[1] * v1[1]) + (v1[2] * v1[2] + v1[3] * v1[3]); }
                    } else if (act == 2) {
#pragma unroll
                        for (int j = 0; j < 4; ++j) { v0[j] = v0[j] * fsigmoid(v0[j]); v1[j] = v1[j] * fsigmoid(v1[j]); }
                    } else if (act == 3) {
#pragma unroll
                        for (int j = 0; j < 4; ++j) { v0[j] = fsigmoid(v0[j]); v1[j] = fsigmoid(v1[j]); }
                    }
                    u32x4 w; w.x = cvt_pk_bf16(v0[0], v0[1]); w.y = cvt_pk_bf16(v0[2], v0[3]); w.z = cvt_pk_bf16(v1[0], v1[1]); w.w = cvt_pk_bf16(v1[2], v1[3]);
                    EPIIN_STORE(w, (gu32x4*)(rowp + bj * HALF));
                }
                if (act == 5) {
                    ls += __shfl_xor(ls, 16); ls += __shfl_xor(ls, 32); lq += __shfl_xor(lq, 16); lq += __shfl_xor(lq, 32);
                    if (fq == 0) *(gf32x2*)(ws + WS_LNP + ((size_t)row * 32 + (pn - 16) * 4 + wc) * 8) = (f32x2){ls, lq};
                }
            }
    }
};
struct EpiBranch {
    static constexpr bool PERM = true; static constexpr int NS = EPI_NS16;
    __device__ __forceinline__ bool relax(const Unit& u) const { return u.seg == 2; }
    const gbf16* G; gbf16* MIX;
    __device__ __forceinline__ bool keep(const Unit& u) const { return u.seg != 2; }
    __device__ __forceinline__ void operator()(f32x4 (&acc)[2][2][4][2], const Unit& u, int wr, int wc, int fr, int fq) const {
        const int row0 = u.pm * BM + wr * 64 + fr, col0 = u.pn * BM + wc * 32 + 8 * fq; const int seg = u.seg;
#pragma unroll
        for (int ai = 0; ai < 2; ++ai)
#pragma unroll
            for (int m = 0; m < 4; ++m) {
                const int row = row0 + ai * HALF + m * 16; const gbf16* gp = G + (size_t)row * 12288 + seg * DM + col0;
#pragma unroll
                for (int bj = 0; bj < 2; ++bj) {
                    const u32x4 ga = *(const gu32x4*)(gp + bj * HALF);
                    float f[8] = {bf_lo(ga.x), bf_hi(ga.x), bf_lo(ga.y), bf_hi(ga.y), bf_lo(ga.z), bf_hi(ga.z), bf_lo(ga.w), bf_hi(ga.w)};
#pragma unroll
                    for (int j = 0; j < 8; ++j) f[j] = fmaxf(f[j], 1e-20f);
                    if (seg != 2) {
                        const u32x4 gb = *(const gu32x4*)(gp + DM + bj * HALF);
                        const float h[8] = {bf_lo(gb.x), bf_hi(gb.x), bf_lo(gb.y), bf_hi(gb.y), bf_lo(gb.z), bf_hi(gb.z), bf_lo(gb.w), bf_hi(gb.w)};
#pragma unroll
                        for (int j = 0; j < 8; ++j) f[j] = f[j] * __builtin_amdgcn_rcpf(fmaxf(h[j], 1e-20f));
                    }
                    f32x4 v0 = acc[ai][bj][m][0], v1 = acc[ai][bj][m][1];
                    v0 = v0 * (f32x4){f[0], f[1], f[2], f[3]}; v1 = v1 * (f32x4){f[4], f[5], f[6], f[7]};
                    if (seg != 2) { acc[ai][bj][m][0] = v0; acc[ai][bj][m][1] = v1; }
                    else { u32x4 w; w.x = cvt_pk_bf16(v0[0], v0[1]); w.y = cvt_pk_bf16(v0[2], v0[3]); w.z = cvt_pk_bf16(v1[0], v1[1]); w.w = cvt_pk_bf16(v1[2], v1[3]);
                        *(gu32x4*)(MIX + (size_t)row * DM + col0 + bj * HALF) = w; }
                }
                if (m == 3) asm volatile("" ::: "memory");
            }
    }
};
struct EpiSq {
    static constexpr bool PERM = true; static constexpr int NS = EPI_NS16;
    __device__ __forceinline__ bool relax(const Unit&) const { return true; }
    gbf16* O; gfloat* P;
    __device__ __forceinline__ bool keep(const Unit&) const { return false; }
    __device__ __forceinline__ void operator()(f32x4 (&acc)[2][2][4][2], const Unit& u, int wr, int wc, int fr, int fq) const {
        const int row0 = u.pm * BM + wr * 64 + fr, col0 = u.pn * BM + wc * 32 + 8 * fq;
#pragma unroll
        for (int ai = 0; ai < 2; ++ai)
#pragma unroll
            for (int m = 0; m < 4; ++m) {
                const int row = row0 + ai * HALF + m * 16; float q = 0.f;
#pragma unroll
                for (int bj = 0; bj < 2; ++bj) {
                    const f32x4 v0 = acc[ai][bj][m][0], v1 = acc[ai][bj][m][1];
                    q += (v0[0] * v0[0] + v0[1] * v0[1]) + (v0[2] * v0[2] + v0[3] * v0[3]) + (v1[0] * v1[0] + v1[1] * v1[1]) + (v1[2] * v1[2] + v1[3] * v1[3]);
                    u32x4 w; w.x = cvt_pk_bf16(v0[0], v0[1]); w.y = cvt_pk_bf16(v0[2], v0[3]); w.z = cvt_pk_bf16(v1[0], v1[1]); w.w = cvt_pk_bf16(v1[2], v1[3]);
                    if (O) *(gu32x4*)(O + (size_t)row * DM + col0 + bj * HALF) = w; else asm volatile("" :: "v"(w));
                }
                q += __shfl_xor(q, 16); q += __shfl_xor(q, 32);
                if (fq == 0) P[(size_t)row * 64 + u.pn * 4 + wc] = q;
            }
    }
};
struct EpiPle {
    static constexpr bool PERM = true; static constexpr int NS = EPI_NS32;
    __device__ __forceinline__ bool relax(const Unit&) const { return true; }
    const gfloat* XIN; gfloat* XOUT; gbf16* XB; const gbf16* OUT; const gbf16* ERAW; const gfloat* RSO; const gfloat* RSE; const gfloat* npost; const gfloat* pnorm; gfloat* SSQN; int last;
    __device__ __forceinline__ bool keep(const Unit&) const { return false; }
    __device__ __forceinline__ void operator()(f32x4 (&acc)[2][2][4][2], const Unit& u, int wr, int wc, int fr, int fq) const {
        const int row0 = u.pm * BM + wr * 64 + fr, col0 = u.pn * BM + wc * 32 + 8 * fq;
#pragma unroll
        for (int ai = 0; ai < 2; ++ai)
#pragma unroll
            for (int m = 0; m < 4; ++m) {
                const int row = row0 + ai * HALF + m * 16; const float rso = RSO[row], rse = RSE[row]; float q = 0.f; const size_t ro = (size_t)row * DM;
#pragma unroll
                for (int bj = 0; bj < 2; ++bj) {
                    const int col = col0 + bj * HALF;
                    const f32x4 xa = *(const gf32x4*)(XIN + ro + col), xb = *(const gf32x4*)(XIN + ro + col + 4); const u32x4 ob = *(const gu32x4*)(OUT + ro + col), eb = *(const gu32x4*)(ERAW + ro + col);
                    const f32x4 npa = *(const gf32x4*)(npost + col), npb = *(const gf32x4*)(npost + col + 4), pna = *(const gf32x4*)(pnorm + col), pnb = *(const gf32x4*)(pnorm + col + 4);
                    const float x[8] = {xa[0], xa[1], xa[2], xa[3], xb[0], xb[1], xb[2], xb[3]};
                    const float o[8] = {bf_lo(ob.x), bf_hi(ob.x), bf_lo(ob.y), bf_hi(ob.y), bf_lo(ob.z), bf_hi(ob.z), bf_lo(ob.w), bf_hi(ob.w)};
                    const float e8[8] = {bf_lo(eb.x), bf_hi(eb.x), bf_lo(eb.y), bf_hi(eb.y), bf_lo(eb.z), bf_hi(eb.z), bf_lo(eb.w), bf_hi(eb.w)};
                    const float np[8] = {npa[0], npa[1], npa[2], npa[3], npb[0], npb[1], npb[2], npb[3]}, pn[8] = {pna[0], pna[1], pna[2], pna[3], pnb[0], pnb[1], pnb[2], pnb[3]};
                    const f32x4 a0 = acc[ai][bj][m][0], a1 = acc[ai][bj][m][1]; const float a[8] = {a0[0], a0[1], a0[2], a0[3], a1[0], a1[1], a1[2], a1[3]};
                    float r[8];
#pragma unroll
                    for (int j = 0; j < 8; ++j) { const float x1 = x[j] + o[j] * rso * np[j]; r[j] = x1 + fsigmoid(a[j]) * (e8[j] * rse * pn[j]); q += r[j] * r[j]; }
                    *(gf32x4*)(XOUT + ro + col) = (f32x4){r[0], r[1], r[2], r[3]}; *(gf32x4*)(XOUT + ro + col + 4) = (f32x4){r[4], r[5], r[6], r[7]};
                    if (!last) { u32x4 w; w.x = cvt_pk_bf16(r[0], r[1]); w.y = cvt_pk_bf16(r[2], r[3]); w.z = cvt_pk_bf16(r[4], r[5]); w.w = cvt_pk_bf16(r[6], r[7]); *(gu32x4*)(XB + ro + col) = w; }
                }
                if (!last) { q += __shfl_xor(q, 16); q += __shfl_xor(q, 32); if (fq == 0) SSQN[(size_t)row * 64 + u.pn * 4 + wc] = q; }
                if (m & 1) asm volatile("" ::: "memory");
            }
    }
};
}

constexpr int LDS_BYTES = 147456;
constexpr int MISC_OFF = LDS_BYTES - 128;
constexpr int ARGS_OFF = LDS_BYTES - 512;
constexpr int NWAVES = 8, NTHREADS = 512;

struct Ctx {
    LAS unsigned char* lds; int tid, lane, wave, vcu, G, bx;
};

struct TrTile { const gfloat* W; const gfloat* kscale; gbf16* WT; int ldw, K; };
constexpr int TR_PER_LAYER = 3904 + 768 + 512 + 512 + 32;
__device__ __forceinline__ TrTile tr_decode(int it, const gfloat* w_in, const gfloat* norm_pre, const gfloat* w_branch, const gfloat* w_out, const gfloat* ple_gate, const gfloat* ple_proj, guchar* ws) {
    const int l = it / TR_PER_LAYER; int r = it - l * TR_PER_LAYER; TrTile t; int kt, ntile;
    if (r < 3904) { kt = r / 244; ntile = r - kt * 244; const int src = ntile < 116 ? ntile * 128 : ntile * 128 + 8;
        if (ntile < 16) ntile = 2 * ntile; else if (ntile < 32) ntile = ntile + 16; else if (ntile < 48) ntile = 2 * (ntile - 32) + 1;
        else if (ntile >= 116 && ntile < 132) ntile = 116 + 2 * (ntile - 116); else if (ntile >= 132 && ntile < 148) ntile = 116 + 2 * (ntile - 132) + 1;
        t.ldw = N_IN; t.K = DM; t.W = w_in + (size_t)l * DM * N_IN + (size_t)kt * 256 * N_IN + src; t.kscale = norm_pre + l * DM + kt * 256;
        t.WT = (gbf16*)(ws + WS_WIN + (size_t)l * SZ_WIN) + (size_t)ntile * 128 * DM + kt * 256; return t; }
    r -= 3904; t.kscale = nullptr; t.ldw = DM;
    if (r < 768) { const int j = r / 256; const int rr = r - j * 256; kt = rr / 32; ntile = rr - kt * 32; t.K = BW;
        t.W = w_branch + ((size_t)(l * 3 + j) * BW + (size_t)kt * 256) * DM + ntile * 128;
        t.WT = (gbf16*)(ws + WS_WBR + (size_t)l * SZ_WBR) + (size_t)j * DM * BW + (size_t)ntile * 128 * BW + kt * 256; return t; }
    r -= 768;
    if (r < 1024) { const int which = r / 512; const int rr = r - which * 512; kt = rr / 32; ntile = rr - kt * 32; t.K = DM;
        t.W = (which ? ple_gate : w_out) + ((size_t)l * DM + (size_t)kt * 256) * DM + ntile * 128;
        t.WT = (gbf16*)(ws + (which ? WS_WPG : WS_WOUT) + (size_t)l * SZ_WSQ) + (size_t)ntile * 128 * DM + kt * 256; return t; }
    r -= 1024; kt = r / 32; ntile = r - kt * 32; t.K = 256;
    t.W = ple_proj + ((size_t)l * 256 + (size_t)kt * 256) * DM + ntile * 128;
    t.WT = (gbf16*)(ws + WS_WPP + (size_t)l * SZ_WPP) + (size_t)ntile * 128 * 256 + kt * 256; return t;
}
#ifndef TR_REVERSE
#define TR_REVERSE 1
#endif
__device__ __forceinline__ void tr_run(const Ctx& F, int it0, int it1, int sk0, int sk1, int me, int nw, const gfloat* w_in, const gfloat* norm_pre, const gfloat* w_branch,
                                       const gfloat* w_out, const gfloat* ple_gate, const gfloat* ple_proj, guchar* ws) {
    int tid = F.tid; LAUNDER_V(tid);
    {
        constexpr int RS = 264; const int NIT = it1 - it0 - (sk1 - sk0);
        const int c4 = tid & 31, kr = tid >> 5, kc = tid & 15;
        f32x4 va[16], vb[16]; float ka[16], kb[16]; TrTile ta, tb;
#define TR_LOAD(T_, V_, K_, IT_) do { const int ir_ = TR_REVERSE ? (NIT - 1 - (IT_)) : (IT_); T_ = tr_decode(it0 + ir_ + (((it0 + ir_) >= sk0) ? (sk1 - sk0) : 0), w_in, norm_pre, w_branch, w_out, ple_gate, ple_proj, ws); \
        _Pragma("unroll") for (int i = 0; i < 16; ++i) { V_[i] = *(const gf32x4*)(T_.W + (size_t)(i * 16 + kr) * T_.ldw + 4 * c4); K_[i] = T_.kscale ? T_.kscale[i * 16 + kr] : 1.0f; } } while (0)
#define TR_PUT(V_, K_) do { _Pragma("unroll") for (int i = 0; i < 16; ++i) { const f32x4 a = V_[i] * K_[i]; u32x2 w; w.x = cvt_pk_bf16(a[0], a[1]); w.y = cvt_pk_bf16(a[2], a[3]); \
        *(LAS u32x2*)(F.lds + (i * 16 + kr) * RS + c4 * 8) = w; } } while (0)
#define TR_GET(WT_, K_) do { _Pragma("unroll") for (int q = 0; q < 4; ++q) _Pragma("unroll") for (int hh = 0; hh < 2; ++hh) { const int n = 32 * q + (tid >> 4), kq = kc + 16 * hh; \
        const LAS bf16_t* s = (const LAS bf16_t*)(F.lds + (8 * kq) * RS + 2 * n); unsigned e[8]; \
        _Pragma("unroll") for (int j = 0; j < 8; ++j) e[j] = s[j * (RS / 2)]; \
        u32x4 o; o.x = e[0] | (e[1] << 16); o.y = e[2] | (e[3] << 16); o.z = e[4] | (e[5] << 16); o.w = e[6] | (e[7] << 16); \
        *(gu32x4*)(WT_ + (size_t)n * K_ + 8 * kq) = o; } } while (0)
        int it = me;
        if (it < NIT) TR_LOAD(ta, va, ka, it);
        if (it + nw < NIT) TR_LOAD(tb, vb, kb, it + nw);
        while (it < NIT) {
            { TR_PUT(va, ka); __syncthreads(); gbf16* wt = ta.WT; const int kk = ta.K;
              if (it + 2 * nw < NIT) TR_LOAD(ta, va, ka, it + 2 * nw);
              TR_GET(wt, kk); __syncthreads(); }
            it += nw; if (it >= NIT) break;
            { TR_PUT(vb, kb); __syncthreads(); gbf16* wt = tb.WT; const int kk = tb.K;
              if (it + 2 * nw < NIT) TR_LOAD(tb, vb, kb, it + 2 * nw);
              TR_GET(wt, kk); __syncthreads(); }
            it += nw;
        }
#undef TR_LOAD
#undef TR_PUT
#undef TR_GET
    }
}
#ifndef TR_NODEFER
#define TR_NODEFER 0
#endif
constexpr int TR_DEFER0 = TR_PER_LAYER + 3904 + 768, TR_DEFER1 = TR_DEFER0 + (TR_NODEFER ? 0 : 1024);
__device__ __forceinline__ void p0_prologue(const Ctx& F, const gfloat* x, const gfloat* p, const gint* positions, const gfloat* norm_pre, const gfloat* w_in, const gfloat* w_branch,
                                            const gfloat* w_out, const gfloat* ple_gate, const gfloat* ple_proj, guchar* ws) {
    int tid = F.tid; LAUNDER_V(tid);
    tr_run(F, 0, NLAYER * TR_PER_LAYER, TR_DEFER0, TR_DEFER1, F.vcu, F.G, w_in, norm_pre, w_branch, w_out, ple_gate, ple_proj, ws);
    const int gt = F.vcu * NTHREADS + tid, NGT = F.G * NTHREADS;
    for (int i = gt; i < NLAYER * 256 * DM; i += NGT) { const int l = i / (256 * DM), rr = (i / DM) & 255, k = i & (DM - 1);
        float val = 0.f; if (rr < 8) val = w_in[(size_t)l * DM * N_IN + (size_t)k * N_IN + IF_COL + rr] * norm_pre[l * DM + k];
        ((gbf16*)(ws + WS_WIN + (size_t)l * SZ_WIN))[(size_t)(122 * 256 + rr) * DM + k] = (bf16_t)(cvt_pk_bf16(val, 0.f) & 0xffffu); }
    for (int i = gt; i < NLAYER * M_ROWS * 256 / 4; i += NGT) { const f32x4 a = ((const gf32x4*)p)[i]; u32x2 w; w.x = cvt_pk_bf16(a[0], a[1]); w.y = cvt_pk_bf16(a[2], a[3]); ((gu32x2*)(ws + WS_PB))[i] = w; }
    for (int i = gt; i < M_ROWS * 8; i += NGT) { const int row = i >> 3, j = i & 7; const float inv = powf(500000.0f, -(float)j * 0.125f); const float ang = (float)positions[row] * inv;
        gfloat* cs = (gfloat*)(ws + WS_CS) + (size_t)row * 16; cs[j] = cosf(ang); cs[8 + j] = sinf(ang); }
    { const int gw = F.vcu * NWAVES + F.wave, NGW = F.G * NWAVES;
      for (int m = gw; m < M_ROWS; m += NGW) { const gf32x4* xr = (const gf32x4*)(x + (size_t)m * DM) + F.lane; gu32x2* o = (gu32x2*)(ws + WS_XB + (size_t)m * DM * 2) + F.lane; float s = 0.f;
#pragma unroll
          for (int j = 0; j < 16; ++j) { const f32x4 a = xr[64 * j]; s += (a[0] * a[0] + a[1] * a[1]) + (a[2] * a[2] + a[3] * a[3]); u32x2 w; w.x = cvt_pk_bf16(a[0], a[1]); w.y = cvt_pk_bf16(a[2], a[3]); o[64 * j] = w; }
          s = wave_sum(s); if (F.lane == 0) ((gfloat*)(ws + WS_SSQ0))[m] = s; } }
}

__device__ __forceinline__ u32x2 pack4(const f32x4 v) { u32x2 w; w.x = cvt_pk_bf16(v[0], v[1]); w.y = cvt_pk_bf16(v[2], v[3]); return w; }
__device__ __forceinline__ bf16x8 mk_frag(const u32x2 lo, const u32x2 hi) { const u32x4 t = {lo.x, lo.y, hi.x, hi.y}; return __builtin_bit_cast(bf16x8, t); }
__device__ __forceinline__ bf16x8 frag_const(unsigned w) { const u32x4 t = {w, w, w, w}; return __builtin_bit_cast(bf16x8, t); }

constexpr int GM_WL = 0, GM_VT = 34816, GM_ST = 104448, GM_RS = 272;
__device__ __forceinline__ void gmlp_unit(const Ctx& F, int b, int n, int g, guchar* ws, const gfloat* ln_g, const gfloat* ln_b, const gfloat* wsp, const gfloat* bsp) {
    int tid = F.tid; LAUNDER_V(tid); const int lane = tid & 63, w = F.wave, r16 = lane & 15, q4 = lane >> 4;
    const int row0 = b * SEQ + n * 128, c0 = g * 256;
    const gbf16* AU = (const gbf16*)(ws + WS_AU); const gbf16* AV = (const gbf16*)(ws + WS_AV); const gbf16* AZ = (const gbf16*)(ws + WS_AZ); gbf16* YA = (gbf16*)(ws + WS_YA);
    if (tid < 128) { const gf32x2* pp = (const gf32x2*)(ws + WS_LNP) + (size_t)(row0 + tid) * 32; float s = 0.f, q = 0.f;
#pragma unroll 8
        for (int j = 0; j < 32; ++j) { const f32x2 t = pp[j]; s += t.x; q += t.y; }
        const float mu = s * (1.0f / BW); const float var = fmaxf(q * (1.0f / BW) - mu * mu, 0.f);
        *(LAS f32x2*)(F.lds + GM_ST + tid * 8) = (f32x2){mu, rsqrtf(var + NORM_EPS)}; }
#pragma unroll
    for (int k = 0; k < 8; ++k) { const int item = tid + 512 * k, t = item >> 5, ch = item & 31;
        f32x4 a = *(const gf32x4*)(wsp + ((size_t)(g * 128 + t)) * 128 + 4 * ch);
#pragma unroll
        for (int e = 0; e < 4; ++e) if (4 * ch + e > t) a[e] = 0.f;
        *(LAS u32x2*)(F.lds + GM_WL + t * GM_RS + ch * 8) = pack4(a); }
    __syncthreads();
#pragma unroll
    for (int k = 0; k < 8; ++k) { const int item = tid + 512 * k, s = item & 127, ch = item >> 7;
        const u32x4 raw = *(const gu32x4*)(AV + (size_t)(row0 + s) * BW + c0 + 8 * ch);
        const f32x4 g0 = *(const gf32x4*)(ln_g + c0 + 8 * ch), g1 = *(const gf32x4*)(ln_g + c0 + 8 * ch + 4), b0 = *(const gf32x4*)(ln_b + c0 + 8 * ch), b1 = *(const gf32x4*)(ln_b + c0 + 8 * ch + 4);
        const f32x2 st = *(const LAS f32x2*)(F.lds + GM_ST + s * 8);
        const float xv[8] = {bf_lo(raw.x), bf_hi(raw.x), bf_lo(raw.y), bf_hi(raw.y), bf_lo(raw.z), bf_hi(raw.z), bf_lo(raw.w), bf_hi(raw.w)};
        const float gg[8] = {g0[0], g0[1], g0[2], g0[3], g1[0], g1[1], g1[2], g1[3]}, bb[8] = {b0[0], b0[1], b0[2], b0[3], b1[0], b1[1], b1[2], b1[3]};
#pragma unroll
        for (int i = 0; i < 8; ++i) { const float y = (xv[i] - st.x) * st.y * gg[i] + bb[i];
            *(LAS bf16_t*)(F.lds + GM_VT + (8 * ch + i) * GM_RS + 2 * s) = (bf16_t)(cvt_pk_bf16(y, 0.f) & 0xffffu); } }
    __syncthreads();
    f32x4 acc[2][8];
#pragma unroll
    for (int m = 0; m < 2; ++m)
#pragma unroll
        for (int n8 = 0; n8 < 8; ++n8) acc[m][n8] = (f32x4){0.f, 0.f, 0.f, 0.f};
    bf16x8 af[2][4];
#pragma unroll
    for (int m = 0; m < 2; ++m)
#pragma unroll
        for (int ks = 0; ks < 4; ++ks) af[m][ks] = *(const LAS bf16x8*)(F.lds + GM_VT + (32 * w + 16 * m + r16) * GM_RS + ks * 64 + q4 * 16);
#pragma unroll
    for (int n8 = 0; n8 < 8; ++n8)
#pragma unroll
        for (int ks = 0; ks < 4; ++ks) if (ks <= n8 / 2) {
            const bf16x8 bfr = *(const LAS bf16x8*)(F.lds + GM_WL + (16 * n8 + r16) * GM_RS + ks * 64 + q4 * 16);
#pragma unroll
            for (int m = 0; m < 2; ++m) acc[m][n8] = MFMA16(af[m][ks], bfr, acc[m][n8]); }
#pragma unroll
    for (int n8 = 0; n8 < 8; ++n8) { const int t = 16 * n8 + r16; const float bsv = bsp[g * 128 + t]; const size_t ro = (size_t)(row0 + t) * BW + c0 + 32 * w + 4 * q4;
#pragma unroll
        for (int m = 0; m < 2; ++m) { const u32x2 ub = *(const gu32x2*)(AU + ro + 16 * m);
            const f32x4 a = acc[m][n8] + bsv; f32x4 y;
            y[0] = a[0] * bf_lo(ub.x); y[1] = a[1] * bf_hi(ub.x); y[2] = a[2] * bf_lo(ub.y); y[3] = a[3] * bf_hi(ub.y);
            *(gu32x2*)(YA + ro + 16 * m) = pack4(y); } }
    __syncthreads();
}

constexpr int SW_KL = 0, SW_VT = 36864, SW_QL = 70656, SW_QL2 = 89088, SW_RS = 144, SW_VS = 528;
__device__ __forceinline__ void rope8(const u32x4 a, const u32x4 bq, const gfloat* cs, float scale, u32x4& o1, u32x4& o2) {
    const f32x4 c0 = *(const gf32x4*)cs, c1 = *(const gf32x4*)(cs + 4), s0 = *(const gf32x4*)(cs + 8), s1 = *(const gf32x4*)(cs + 12);
    const float t1[8] = {bf_lo(a.x), bf_hi(a.x), bf_lo(a.y), bf_hi(a.y), bf_lo(a.z), bf_hi(a.z), bf_lo(a.w), bf_hi(a.w)};
    const float t2[8] = {bf_lo(bq.x), bf_hi(bq.x), bf_lo(bq.y), bf_hi(bq.y), bf_lo(bq.z), bf_hi(bq.z), bf_lo(bq.w), bf_hi(bq.w)};
    const float cc[8] = {c0[0], c0[1], c0[2], c0[3], c1[0], c1[1], c1[2], c1[3]}, ss[8] = {s0[0], s0[1], s0[2], s0[3], s1[0], s1[1], s1[2], s1[3]};
    float r1[8], r2[8];
#pragma unroll
    for (int i = 0; i < 8; ++i) { r1[i] = (t1[i] * cc[i] - t2[i] * ss[i]) * scale; r2[i] = (t2[i] * cc[i] + t1[i] * ss[i]) * scale; }
    o1 = (u32x4){cvt_pk_bf16(r1[0], r1[1]), cvt_pk_bf16(r1[2], r1[3]), cvt_pk_bf16(r1[4], r1[5]), cvt_pk_bf16(r1[6], r1[7])};
    o2 = (u32x4){cvt_pk_bf16(r2[0], r2[1]), cvt_pk_bf16(r2[2], r2[3]), cvt_pk_bf16(r2[4], r2[5]), cvt_pk_bf16(r2[6], r2[7])};
}
__device__ __forceinline__ u32x4 scale8(const u32x4 a, float sc) {
    return (u32x4){cvt_pk_bf16(bf_lo(a.x) * sc, bf_hi(a.x) * sc), cvt_pk_bf16(bf_lo(a.y) * sc, bf_hi(a.y) * sc), cvt_pk_bf16(bf_lo(a.z) * sc, bf_hi(a.z) * sc), cvt_pk_bf16(bf_lo(a.w) * sc, bf_hi(a.w) * sc)};
}
__device__ __forceinline__ void swa_unit(const Ctx& F, int b, int n, int hk, guchar* ws, const gfloat* sinks) {
    int tid = F.tid; LAUNDER_V(tid); const int lane = tid & 63, w = F.wave, r16 = lane & 15, q4 = lane >> 4;
    const int r0 = b * SEQ + n * 128, kr0 = r0 - 128;
    const gbf16* BQ = (const gbf16*)(ws + WS_BQ); const gbf16* BK = (const gbf16*)(ws + WS_BK); const gbf16* BV = (const gbf16*)(ws + WS_BV); const gbf16* BZ = (const gbf16*)(ws + WS_BZ);
    gbf16* YB = (gbf16*)(ws + WS_YA) + (size_t)M_ROWS * BW; const gfloat* CS = (const gfloat*)(ws + WS_CS);
#pragma unroll
    for (int k = 0; k < 4; ++k) { const int item = tid + 512 * k, key = item >> 3, ch = item & 7; const bool pad = (n == 0 && key < 128);
        if (ch == 1) continue;
        const gbf16* src = BK + (size_t)(kr0 + key) * 256 + hk * 64;
        LAS unsigned char* dst = F.lds + SW_KL + key * SW_RS;
        if (pad) { *(LAS u32x4*)(dst + ch * 16) = (u32x4){0u, 0u, 0u, 0u}; if (ch == 0) *(LAS u32x4*)(dst + 16) = (u32x4){0u, 0u, 0u, 0u}; }
        else if (ch == 0) { u32x4 o1, o2; rope8(*(const gu32x4*)src, *(const gu32x4*)(src + 8), CS + (size_t)(kr0 + key) * 16, 1.0f, o1, o2); *(LAS u32x4*)dst = o1; *(LAS u32x4*)(dst + 16) = o2; }
        else *(LAS u32x4*)(dst + ch * 16) = *(const gu32x4*)(src + 8 * ch); }
#pragma unroll
    for (int k = 0; k < 4; ++k) { const int item = tid + 512 * k, key = item & 255, ch = item >> 8; const bool pad = (n == 0 && key < 128);
        u32x4 raw = {0u, 0u, 0u, 0u}; if (!pad) raw = *(const gu32x4*)(BV + (size_t)(kr0 + key) * 256 + hk * 64 + 8 * ch);
        const unsigned e[4] = {raw.x, raw.y, raw.z, raw.w};
#pragma unroll
        for (int i = 0; i < 8; ++i) *(LAS bf16_t*)(F.lds + SW_VT + (8 * ch + i) * SW_VS + 2 * key) = (bf16_t)((e[i >> 1] >> ((i & 1) * 16)) & 0xffffu); }
    u32x4 qa[2], qb[2];
#define SW_QLOAD(hq_) do { _Pragma("unroll") for (int k_ = 0; k_ < 2; ++k_) { const int it_ = tid + 512 * k_, qr_ = it_ >> 3, ch_ = it_ & 7; const gbf16* src_ = BQ + (size_t)(r0 + qr_) * BW + (hq_) * 64; \
        qa[k_] = (u32x4){0u, 0u, 0u, 0u}; qb[k_] = (u32x4){0u, 0u, 0u, 0u}; \
        if (ch_ == 0) { qa[k_] = *(const gu32x4*)src_; qb[k_] = *(const gu32x4*)(src_ + 8); } else if (ch_ != 1) qa[k_] = *(const gu32x4*)(src_ + 8 * ch_); } } while (0)
#define SW_QWRITE(buf_) do { _Pragma("unroll") for (int k_ = 0; k_ < 2; ++k_) { const int it_ = tid + 512 * k_, qr_ = it_ >> 3, ch_ = it_ & 7; LAS unsigned char* dst_ = F.lds + (buf_) + qr_ * SW_RS; \
        if (ch_ == 0) { u32x4 o1_, o2_; rope8(qa[k_], qb[k_], CS + (size_t)(r0 + qr_) * 16, 0.125f, o1_, o2_); *(LAS u32x4*)dst_ = o1_; *(LAS u32x4*)(dst_ + 16) = o2_; } \
        else if (ch_ != 1) *(LAS u32x4*)(dst_ + ch_ * 16) = scale8(qa[k_], 0.125f); } } while (0)
    SW_QLOAD(hk * 8); SW_QWRITE(SW_QL);
    __syncthreads();
    for (int hi = 0; hi < 8; ++hi) {
        const int hq = hk * 8 + hi; const int qcur = (hi & 1) ? SW_QL2 : SW_QL, qnxt = (hi & 1) ? SW_QL : SW_QL2;
        if (hi < 7) SW_QLOAD(hq + 1);
        bf16x8 bq[2];
#pragma unroll
        for (int ks = 0; ks < 2; ++ks) bq[ks] = *(const LAS bf16x8*)(F.lds + qcur + (16 * w + r16) * SW_RS + ks * 64 + q4 * 16);
        f32x4 s[10];
#pragma unroll
        for (int j = 0; j < 9; ++j) { s[j] = (f32x4){0.f, 0.f, 0.f, 0.f};
#pragma unroll
            for (int ks = 0; ks < 2; ++ks) { const bf16x8 a = *(const LAS bf16x8*)(F.lds + SW_KL + (16 * (w + j) + r16) * SW_RS + ks * 64 + q4 * 16); s[j] = MFMA16(a, bq[ks], s[j]); } }
        s[9] = (f32x4){0.f, 0.f, 0.f, 0.f};
        const int qi = 16 * w + r16; const float sink = sinks[hq]; float mx = sink;
#pragma unroll
        for (int j = 0; j < 9; ++j)
#pragma unroll
            for (int e = 0; e < 4; ++e) { const int kj = 16 * (w + j) + 4 * q4 + e; const bool valid = (kj > qi) && (kj <= qi + 128) && (n > 0 || kj >= 128);
                s[j][e] = valid ? s[j][e] : -1e30f; mx = fmaxf(mx, s[j][e]); }
        mx = fmaxf(mx, __shfl_xor(mx, 16)); mx = fmaxf(mx, __shfl_xor(mx, 32));
        float sum = 0.f;
#pragma unroll
        for (int j = 0; j < 9; ++j)
#pragma unroll
            for (int e = 0; e < 4; ++e) { const float pv = (s[j][e] > -1e29f) ? __expf(s[j][e] - mx) : 0.f; s[j][e] = pv; sum += pv; }
        sum += __shfl_xor(sum, 16); sum += __shfl_xor(sum, 32); sum += __expf(sink - mx);
        const float inv = 1.0f / sum;
        f32x4 o[4];
#pragma unroll
        for (int dt = 0; dt < 4; ++dt) o[dt] = (f32x4){0.f, 0.f, 0.f, 0.f};
#pragma unroll
        for (int kk = 0; kk < 5; ++kk) { const bf16x8 pf = mk_frag(pack4(s[2 * kk]), pack4(s[2 * kk + 1]));
            const int t0 = w + 2 * kk, t1 = (w + 2 * kk + 1) > 15 ? 15 : (w + 2 * kk + 1);
#pragma unroll
            for (int dt = 0; dt < 4; ++dt) { const LAS unsigned char* vrow = F.lds + SW_VT + (16 * dt + r16) * SW_VS + (4 * q4) * 2;
                const bf16x8 a = mk_frag(*(const LAS u32x2*)(vrow + 32 * t0), *(const LAS u32x2*)(vrow + 32 * t1)); o[dt] = MFMA16(a, pf, o[dt]); } }
        const size_t ro = (size_t)(r0 + qi) * BW + hq * 64 + 4 * q4;
#pragma unroll
        for (int dt = 0; dt < 4; ++dt) { const u32x2 zb = *(const gu32x2*)(BZ + ro + 16 * dt); f32x4 y;
            y[0] = o[dt][0] * inv * bf_lo(zb.x); y[1] = o[dt][1] * inv * bf_hi(zb.x); y[2] = o[dt][2] * inv * bf_lo(zb.y); y[3] = o[dt][3] * inv * bf_hi(zb.y);
            *(gu32x2*)(YB + ro + 16 * dt) = pack4(y); }
        if (hi < 7) SW_QWRITE(qnxt);
        __syncthreads();
    }
#undef SW_QLOAD
#undef SW_QWRITE
}

#ifndef ML_R1A
#define ML_R1A 1
#endif
#ifndef ML_R1B
#define ML_R1B 1
#endif
#ifndef ML_RWR
#define ML_RWR 1
#endif
constexpr int ML_QL = 0, ML_KA = 33792, ML_KB = 67584, ML_VT = 101376, ML_VW = 105984, ML_VW2 = 110736, ML_CT = 115488, ML_X = 132912, ML_GATE = 142128, ML_GSZ = 1344, ML_RS = 528, ML_TS = 144;
static_assert(ML_GATE + 2 * ML_GSZ <= ARGS_OFF, "mLSTM LDS map");
typedef short s16x4 __attribute__((ext_vector_type(4)));
__device__ __forceinline__ bf16x8 tr_frag8(const LAS unsigned char* img, int rs, int row0, int col0, int r16) {
    const LAS unsigned char* p0 = img + (row0 + (r16 >> 2)) * rs + (col0 + 4 * (r16 & 3)) * 2;
    const s16x4 a = __builtin_amdgcn_ds_read_tr16_b64_v4i16((LAS s16x4*)p0);
    const s16x4 b = __builtin_amdgcn_ds_read_tr16_b64_v4i16((LAS s16x4*)(p0 + 4 * rs));
    return __builtin_shufflevector(a, b, 0, 1, 2, 3, 4, 5, 6, 7);
}
__device__ __forceinline__ float dpp_shr(float v, float ident, int n) {
    const int r = n == 1 ? __builtin_amdgcn_update_dpp(__float_as_int(ident), __float_as_int(v), 0x111, 0xf, 0xf, false)
                : n == 2 ? __builtin_amdgcn_update_dpp(__float_as_int(ident), __float_as_int(v), 0x112, 0xf, 0xf, false)
                : n == 4 ? __builtin_amdgcn_update_dpp(__float_as_int(ident), __float_as_int(v), 0x114, 0xf, 0xf, false)
                         : __builtin_amdgcn_update_dpp(__float_as_int(ident), __float_as_int(v), 0x118, 0xf, 0xf, false);
    return __int_as_float(r);
}
__device__ __forceinline__ float wave_scan_add(float v, int lane) {
    v += dpp_shr(v, 0.f, 1); v += dpp_shr(v, 0.f, 2); v += dpp_shr(v, 0.f, 4); v += dpp_shr(v, 0.f, 8);
    const float t0 = __int_as_float(__builtin_amdgcn_readlane(__float_as_int(v), 15)), t1 = __int_as_float(__builtin_amdgcn_readlane(__float_as_int(v), 31)), t2 = __int_as_float(__builtin_amdgcn_readlane(__float_as_int(v), 47));
    const int row = lane >> 4; const float add = row == 0 ? 0.f : (row == 1 ? t0 : (row == 2 ? t0 + t1 : (t0 + t1) + t2));
    return v + add;
}
__device__ __forceinline__ float wave_scan_max(float v, int lane) {
    const float NI = -3.0e38f;
    v = fmaxf(v, dpp_shr(v, NI, 1)); v = fmaxf(v, dpp_shr(v, NI, 2)); v = fmaxf(v, dpp_shr(v, NI, 4)); v = fmaxf(v, dpp_shr(v, NI, 8));
    const float t0 = __int_as_float(__builtin_amdgcn_readlane(__float_as_int(v), 15)), t1 = __int_as_float(__builtin_amdgcn_readlane(__float_as_int(v), 31)), t2 = __int_as_float(__builtin_amdgcn_readlane(__float_as_int(v), 47));
    const int row = lane >> 4; const float mx = row == 0 ? NI : (row == 1 ? t0 : (row == 2 ? fmaxf(t0, t1) : fmaxf(fmaxf(t0, t1), t2)));
    return fmaxf(v, mx);
}
__device__ __forceinline__ float softcap15(float z) { const float e = __expf(z * (2.0f / 15.0f)); return 15.0f * (1.0f - 2.0f * __builtin_amdgcn_rcpf(e + 1.0f)); }
__device__ __forceinline__ void mlstm_unit(const Ctx& F, int b, int h, int sl, guchar* ws, const gfloat* ibp, const gfloat* fbp, const gfloat* norm_g) {
    int tid = F.tid; LAUNDER_V(tid); const int lane = tid & 63, w = F.wave, r16 = lane & 15, q4 = lane >> 4;
    const gbf16* CQ = (const gbf16*)(ws + WS_CQ) + h * 256; const gbf16* CK = (const gbf16*)(ws + WS_CK) + h * 256; const gbf16* CV = (const gbf16*)(ws + WS_CV) + h * 512 + sl * 32;
    const gbf16* CO = (const gbf16*)(ws + WS_CO) + h * 512 + sl * 32; const gbf16* CZ = (const gbf16*)(ws + WS_CZ) + h * 512 + sl * 32;
    const gfloat* IFB = (const gfloat*)(ws + WS_IF);
    gbf16* NUM = (gbf16*)(ws + WS_NUM) + h * 512 + sl * 32; gfloat* SSQC = (gfloat*)(ws + WS_SSQC); gfloat* DNB = (gfloat*)(ws + WS_DN);
    const int rowb = b * SEQ;
    const bf16x8 ones = frag_const(0x3f803f80u), zeros = frag_const(0u);
    for (int i = tid; i < 33 * ML_RS / 16; i += NTHREADS) *(LAS u32x4*)(F.lds + ML_CT + i * 16) = (u32x4){0u, 0u, 0u, 0u};
    f32x4 st[2][3];
#pragma unroll
    for (int i = 0; i < 2; ++i)
#pragma unroll
        for (int dt = 0; dt < 3; ++dt) st[i][dt] = (f32x4){0.f, 0.f, 0.f, 0.f};
    float m_prev = 0.f;
    const float ibv = ibp[h], fbv = fbp[h];
    u32x4 qra[4], kra[4], vra; float gi = 0.f, gf = 0.f;
#define ML_LOAD(c, Q_, K_, V_) do { const int rc_ = rowb + (c) * 64; _Pragma("unroll") for (int k_ = 0; k_ < 4; ++k_) { const int it_ = tid + 512 * k_, s_ = it_ >> 5, ch_ = it_ & 31; \
        Q_[k_] = *(const gu32x4*)(CQ + (size_t)(rc_ + s_) * 1024 + 8 * ch_); K_[k_] = *(const gu32x4*)(CK + (size_t)(rc_ + s_) * 1024 + 8 * ch_); } \
        if (tid < 256) V_ = *(const gu32x4*)(CV + (size_t)(rc_ + (tid >> 2)) * BW + 8 * (tid & 3)); } while (0)
#define ML_GLOAD(c) do { if (w == 7) { const int r_ = rowb + (c) * 64 + lane; gi = IFB[(size_t)r_ * 8 + h]; gf = IFB[(size_t)r_ * 8 + 4 + h]; } } while (0)
#define ML_GPREP(par) do { if (w == 7) { const float ig_ = softcap15(gi + ibv); const float z_ = softcap15(gf + fbv); \
        const float lf_ = -(fmaxf(-z_, 0.f) + log1pf(__expf(-fabsf(z_)))); const float bc_ = wave_scan_add(lf_, lane); const float u_ = ig_ - bc_; const float pm_ = wave_scan_max(u_, lane); \
        const float Mv_ = fmaxf(m_prev, pm_); const float M63_ = __int_as_float(__builtin_amdgcn_readlane(__float_as_int(Mv_), 63)); const float g_ = __int_as_float(__builtin_amdgcn_readlane(__float_as_int(bc_), 63)); \
        LAS float* gp_ = (LAS float*)(F.lds + ML_GATE + (par) * ML_GSZ); gp_[lane] = u_; gp_[64 + lane] = Mv_; gp_[128 + lane] = __expf(m_prev - Mv_); gp_[192 + lane] = __expf(-(bc_ + Mv_)); \
        gp_[256 + lane] = __expf(u_ - M63_); if (lane == 0) gp_[320] = __expf(m_prev - M63_); m_prev = g_ + M63_; } } while (0)
#define ML_WRITE(kb_, vw_, gpn_, Q_, K_, V_) do { _Pragma("unroll") for (int k_ = 0; k_ < 4; ++k_) { const int it_ = tid + 512 * k_, s_ = it_ >> 5, ch_ = it_ & 31; \
        *(LAS u32x4*)(F.lds + ML_QL + s_ * ML_RS + ch_ * 16) = Q_[k_]; *(LAS u32x4*)(F.lds + (kb_) + s_ * ML_RS + ch_ * 16) = K_[k_]; } \
        if (tid < 256) { const int s_ = tid >> 2, ch_ = tid & 3; const unsigned e_[4] = {V_.x, V_.y, V_.z, V_.w}; const float ws_ = (gpn_)[256 + s_]; \
            _Pragma("unroll") for (int i_ = 0; i_ < 8; ++i_) { const unsigned hv_ = (e_[i_ >> 1] >> ((i_ & 1) * 16)) & 0xffffu; \
                *(LAS bf16_t*)(F.lds + ML_VT + (8 * ch_ + i_) * ML_TS + 2 * s_) = (bf16_t)hv_; \
                *(LAS bf16_t*)(F.lds + (vw_) + (8 * ch_ + i_) * ML_TS + 2 * s_) = (bf16_t)(cvt_pk_bf16(__uint_as_float(hv_ << 16) * ws_, 0.f) & 0xffffu); } \
            if (ch_ == 0) *(LAS bf16_t*)(F.lds + (vw_) + 32 * ML_TS + 2 * s_) = (bf16_t)(cvt_pk_bf16(ws_, 0.f) & 0xffffu); } } while (0)
    ML_LOAD(0, qra, kra, vra); ML_GLOAD(0);
    ML_GPREP(0);
    ML_GLOAD(1);
    __syncthreads();
    ML_WRITE(ML_KA, ML_VW, ((const LAS float*)(F.lds + ML_GATE)), qra, kra, vra);
    __syncthreads();
#define ML_STEP(c, LQ_, LK_, LV_, WQ_, WK_, WV_) do { \
        const int par = c & 1; const LAS float* gp = (const LAS float*)(F.lds + ML_GATE + par * ML_GSZ); \
        const int vt = ML_VT, kb = par ? ML_KB : ML_KA, kbn = par ? ML_KA : ML_KB, vw = par ? ML_VW2 : ML_VW, vwn = par ? ML_VW : ML_VW2; \
        const LAS float* gpn = (const LAS float*)(F.lds + ML_GATE + (par ^ 1) * ML_GSZ); \
        const int rowc = rowb + c * 64; \
        if (c + 1 < 32) { ML_LOAD(c + 1, LQ_, LK_, LV_); ML_GPREP(par ^ 1); if (c + 2 < 32) ML_GLOAD(c + 2); } \
        u32x2 ob0 = {0u, 0u}, ob1 = {0u, 0u}; \
        if (w < 4) { const size_t ro = (size_t)(rowc + 16 * w + r16) * BW + 4 * q4; \
            ob0 = *(const gu32x2*)(CO + ro); ob1 = *(const gu32x2*)(CO + ro + 16); } \
        f32x4 oacc[3]; \
        for (int rp_ = 0; rp_ < ML_R1B; ++rp_) { \
        _Pragma("unroll") \
        for (int dt = 0; dt < 3; ++dt) oacc[dt] = (f32x4){0.f, 0.f, 0.f, 0.f}; \
        if (w < 4) { \
            const int T = w; \
            bf16x8 bq[8]; \
        _Pragma("unroll") \
            for (int ks = 0; ks < 8; ++ks) bq[ks] = *(const LAS bf16x8*)(F.lds + ML_QL + (16 * T + r16) * ML_RS + ks * 64 + q4 * 16); \
            f32x4 sa[4]; \
        _Pragma("unroll") \
            for (int s4 = 0; s4 < 4; ++s4) { sa[s4] = (f32x4){0.f, 0.f, 0.f, 0.f}; \
                if (s4 <= T) { \
        _Pragma("unroll") \
                    for (int ks = 0; ks < 8; ++ks) { const bf16x8 a = *(const LAS bf16x8*)(F.lds + kb + (16 * s4 + r16) * ML_RS + ks * 64 + q4 * 16); sa[s4] = MFMA16(a, bq[ks], sa[s4]); } } } \
            const int tl = 16 * T + r16; const float Mt = gp[64 + tl]; \
        _Pragma("unroll") \
            for (int s4 = 0; s4 < 4; ++s4) { const f32x4 uu = *(const LAS f32x4*)(gp + 16 * s4 + 4 * q4); \
        _Pragma("unroll") \
                for (int e = 0; e < 4; ++e) { const int sl_ = 16 * s4 + 4 * q4 + e; sa[s4][e] = (sl_ <= tl) ? sa[s4][e] * __expf(uu[e] - Mt) : 0.f; } } \
        _Pragma("unroll") \
            for (int kk = 0; kk < 2; ++kk) { const bf16x8 pf = mk_frag(pack4(sa[2 * kk]), pack4(sa[2 * kk + 1])); \
        _Pragma("unroll") \
                for (int dt = 0; dt < 3; ++dt) { bf16x8 a; \
                    if (dt < 2) { const LAS unsigned char* vp = F.lds + vt + (16 * dt + r16) * ML_TS + (32 * kk + 4 * q4) * 2; a = mk_frag(*(const LAS u32x2*)vp, *(const LAS u32x2*)(vp + 32)); } \
                    else a = (r16 == 0) ? ones : zeros; \
                    oacc[dt] = MFMA16(a, pf, oacc[dt]); } } \
        } else { \
            const int T = w - 4; f32x4 ia[3]; \
        _Pragma("unroll") \
            for (int dt = 0; dt < 3; ++dt) ia[dt] = (f32x4){0.f, 0.f, 0.f, 0.f}; \
        _Pragma("unroll") \
            for (int ks = 0; ks < 8; ++ks) { const bf16x8 bqv = *(const LAS bf16x8*)(F.lds + ML_QL + (16 * T + r16) * ML_RS + ks * 64 + q4 * 16); \
        _Pragma("unroll") \
                for (int dt = 0; dt < 3; ++dt) { bf16x8 a; \
                    if (dt < 2) a = *(const LAS bf16x8*)(F.lds + ML_CT + (16 * dt + r16) * ML_RS + ks * 64 + q4 * 16); \
                    else { a = *(const LAS bf16x8*)(F.lds + ML_CT + 32 * ML_RS + ks * 64 + q4 * 16); if (r16 != 0) a = zeros; } \
                    ia[dt] = MFMA16(a, bqv, ia[dt]); } } \
            const int tl = 16 * T + r16; \
            *(LAS f32x4*)(F.lds + ML_X + tl * 144 + (4 * q4) * 4) = ia[0]; *(LAS f32x4*)(F.lds + ML_X + tl * 144 + (16 + 4 * q4) * 4) = ia[1]; \
            if (q4 == 0) *(LAS f32x4*)(F.lds + ML_X + tl * 144 + 32 * 4) = ia[2]; \
        } \
        } \
        __syncthreads(); \
        if (w < 4) { \
            const int tl = 16 * w + r16; const float at = gp[128 + tl], en = gp[192 + tl]; \
            const f32x4 x0 = *(const LAS f32x4*)(F.lds + ML_X + tl * 144 + (4 * q4) * 4), x1 = *(const LAS f32x4*)(F.lds + ML_X + tl * 144 + (16 + 4 * q4) * 4); \
            const float xd = *(const LAS float*)(F.lds + ML_X + tl * 144 + 32 * 4); \
            const f32x4 n0 = oacc[0] + x0 * at, n1 = oacc[1] + x1 * at; \
            float den = oacc[2][0] + xd * at; den = __shfl(den, r16); \
            float sq = (n0[0] * n0[0] + n0[1] * n0[1]) + (n0[2] * n0[2] + n0[3] * n0[3]) + (n1[0] * n1[0] + n1[1] * n1[1]) + (n1[2] * n1[2] + n1[3] * n1[3]); \
            sq += __shfl_xor(sq, 16); sq += __shfl_xor(sq, 32); \
            const size_t ro = (size_t)(rowc + tl) * BW + 4 * q4; \
            const f32x4 ng0 = *(const gf32x4*)(norm_g + h * 512 + sl * 32 + 4 * q4), ng1 = *(const gf32x4*)(norm_g + h * 512 + sl * 32 + 16 + 4 * q4); \
            f32x4 t0, t1; \
            t0[0] = n0[0] * ng0[0] * bf_lo(ob0.x); t0[1] = n0[1] * ng0[1] * bf_hi(ob0.x); t0[2] = n0[2] * ng0[2] * bf_lo(ob0.y); t0[3] = n0[3] * ng0[3] * bf_hi(ob0.y); \
            t1[0] = n1[0] * ng1[0] * bf_lo(ob1.x); t1[1] = n1[1] * ng1[1] * bf_hi(ob1.x); t1[2] = n1[2] * ng1[2] * bf_lo(ob1.y); t1[3] = n1[3] * ng1[3] * bf_hi(ob1.y); \
            *(gu32x2*)(NUM + ro) = pack4(t0); *(gu32x2*)(NUM + ro + 16) = pack4(t1); \
            if (q4 == 0) { SSQC[(size_t)(rowc + tl) * 64 + h * 16 + sl] = sq; if (sl == 0) DNB[(size_t)(rowc + tl) * 4 + h] = fmaxf(fabsf(den), en); } \
        } \
        { const float dec = gp[320]; \
        _Pragma("unroll") \
          for (int i = 0; i < 2; ++i) \
        _Pragma("unroll") \
              for (int dt = 0; dt < 3; ++dt) st[i][dt] = st[i][dt] * dec; \
        _Pragma("unroll") \
          for (int kk = 0; kk < 2; ++kk) { bf16x8 a[2], bv[3]; \
        _Pragma("unroll") \
              for (int i = 0; i < 2; ++i) a[i] = tr_frag8(F.lds + kb, ML_RS, 32 * kk + 8 * q4, 32 * w + 16 * i, r16); \
        _Pragma("unroll") \
              for (int dt = 0; dt < 2; ++dt) bv[dt] = *(const LAS bf16x8*)(F.lds + vw + (16 * dt + r16) * ML_TS + kk * 64 + q4 * 16); \
              bv[2] = *(const LAS bf16x8*)(F.lds + vw + 32 * ML_TS + kk * 64 + q4 * 16); if (r16 != 0) bv[2] = zeros; \
        _Pragma("unroll") \
              for (int i = 0; i < 2; ++i) \
        _Pragma("unroll") \
                  for (int dt = 0; dt < 3; ++dt) st[i][dt] = MFMA16(a[i], bv[dt], st[i][dt]); } \
        _Pragma("unroll") \
          for (int i = 0; i < 2; ++i) { \
        _Pragma("unroll") \
              for (int dt = 0; dt < 2; ++dt) *(LAS u32x2*)(F.lds + ML_CT + (16 * dt + r16) * ML_RS + (32 * w + 16 * i + 4 * q4) * 2) = pack4(st[i][dt]); \
              if (r16 == 0) *(LAS u32x2*)(F.lds + ML_CT + 32 * ML_RS + (32 * w + 16 * i + 4 * q4) * 2) = pack4(st[i][2]); } } \
        for (int rp_ = 0; rp_ < ML_RWR; ++rp_) if (c + 1 < 32) ML_WRITE(kbn, vwn, gpn, WQ_, WK_, WV_); \
        __syncthreads(); \
    } while (0)
    for (int c2 = 0; c2 < 32; ++c2) { ML_STEP(c2, qra, kra, vra, qra, kra, vra); }
#undef ML_LOAD
#undef ML_GLOAD
#undef ML_GPREP
#undef ML_WRITE
#undef ML_STEP
}

__device__ __forceinline__ void p2b_finalize(const Ctx& F, guchar* ws) {
    int lane = F.lane; LAUNDER_V(lane); const int gw = F.vcu * NWAVES + F.wave, NGW = F.G * NWAVES;
    const gbf16* NUM = (const gbf16*)(ws + WS_NUM); gbf16* YC = (gbf16*)(ws + WS_YA) + (size_t)2 * M_ROWS * BW;
    for (int m = gw; m < M_ROWS; m += NGW) {
        float s = ((const gfloat*)(ws + WS_SSQC))[(size_t)m * 64 + lane];
        s += __shfl_xor(s, 1); s += __shfl_xor(s, 2); s += __shfl_xor(s, 4); s += __shfl_xor(s, 8);
        const float dn = ((const gfloat*)(ws + WS_DN))[(size_t)m * 4 + (lane >> 4)];
        const float inv = 1.0f / dn; const float sc = inv * rsqrtf(s * (1.0f / 512.0f) * inv * inv + NORM_EPS);
#pragma unroll
        for (int it = 0; it < 4; ++it) { const float f = __shfl(sc, 16 * it); const size_t o = (size_t)m * BW + (size_t)(it * 64 + lane) * 8;
            const u32x4 nb = *(const gu32x4*)(NUM + o); u32x4 y;
            y.x = cvt_pk_bf16(bf_lo(nb.x) * f, bf_hi(nb.x) * f); y.y = cvt_pk_bf16(bf_lo(nb.y) * f, bf_hi(nb.y) * f);
            y.z = cvt_pk_bf16(bf_lo(nb.z) * f, bf_hi(nb.z) * f); y.w = cvt_pk_bf16(bf_lo(nb.w) * f, bf_hi(nb.w) * f);
            *(gu32x4*)(YC + o) = y; }
    }
}
__device__ __forceinline__ void p5b_ssq(const Ctx& F, guchar* ws) {
    int lane = F.lane; LAUNDER_V(lane); const int gw = F.vcu * NWAVES + F.wave, NGW = F.G * NWAVES;
    for (int m = gw; m < M_ROWS; m += NGW) { const float s = wave_sum(((const gfloat*)(ws + WS_XSP))[(size_t)m * 64 + lane]); if (lane == 0) ((gfloat*)(ws + WS_CTL + CTL_SSQ1))[m] = s; }
}
__device__ __forceinline__ void p4b_x1(const Ctx& F, guchar* ws, const gfloat* npost) {
    int lane = F.lane; LAUNDER_V(lane); const int gw = F.vcu * NWAVES + F.wave, NGW = F.G * NWAVES;
    const gbf16* OUT = (const gbf16*)(ws + WS_OUT); const gbf16* XB = (const gbf16*)(ws + WS_XB); gbf16* X1B = (gbf16*)(ws + WS_X1B);
    for (int m = gw; m < M_ROWS; m += NGW) {
        const float so = wave_sum(((const gfloat*)(ws + WS_OUTP))[(size_t)m * 64 + lane]), se = wave_sum(((const gfloat*)(ws + WS_ERP))[(size_t)m * 64 + lane]);
        const float rso = rsqrtf(so * (1.0f / DM) + NORM_EPS), rse = rsqrtf(se * (1.0f / DM) + NORM_EPS);
        if (lane == 0) { ((gfloat*)(ws + WS_RSO))[m] = rso; ((gfloat*)(ws + WS_RSE))[m] = rse; }
#pragma unroll
        for (int it = 0; it < 8; ++it) { const int c = (it * 64 + lane) * 8; const size_t o = (size_t)m * DM + c;
            const u32x4 xb = *(const gu32x4*)(XB + o), ob = *(const gu32x4*)(OUT + o); const f32x4 n0 = *(const gf32x4*)(npost + c), n1 = *(const gf32x4*)(npost + c + 4); u32x4 y;
            y.x = cvt_pk_bf16(bf_lo(xb.x) + bf_lo(ob.x) * rso * n0[0], bf_hi(xb.x) + bf_hi(ob.x) * rso * n0[1]);
            y.y = cvt_pk_bf16(bf_lo(xb.y) + bf_lo(ob.y) * rso * n0[2], bf_hi(xb.y) + bf_hi(ob.y) * rso * n0[3]);
            y.z = cvt_pk_bf16(bf_lo(xb.z) + bf_lo(ob.z) * rso * n1[0], bf_hi(xb.z) + bf_hi(ob.z) * rso * n1[1]);
            y.w = cvt_pk_bf16(bf_lo(xb.w) + bf_lo(ob.w) * rso * n1[2], bf_hi(xb.w) + bf_hi(ob.w) * rso * n1[3]);
            *(gu32x4*)(X1B + o) = y; }
    }
}

#ifndef P1_ROT
#define P1_ROT 0
#endif
#ifndef P1_WGM
#define P1_WGM 4
#endif
#ifndef REP_P0
#define REP_P0 1
#endif
#ifndef REP_P1
#define REP_P1 1
#endif
#ifndef REP_ML
#define REP_ML 1
#endif
#ifndef REP_SW
#define REP_SW 1
#endif
#ifndef REP_GM
#define REP_GM 1
#endif
#ifndef REP_P3
#define REP_P3 1
#endif
#ifndef REP_THIN
#define REP_THIN 1
#endif
#ifndef REP_BAR
#define REP_BAR 1
#endif
#ifndef REP_P4
#define REP_P4 1
#endif
__device__ __forceinline__ unsigned long long arg_ld(LAS unsigned char* lds, int i) {
    unsigned a = (unsigned)(ARGS_OFF + 8 * i); asm volatile("" : "+v"(a));
    const volatile LAS unsigned* q = (const volatile LAS unsigned*)(lds + a);
    const unsigned lo = q[0], hi = q[1];
    return ((unsigned long long)(unsigned)__builtin_amdgcn_readfirstlane((int)hi) << 32) | (unsigned)__builtin_amdgcn_readfirstlane((int)lo);
}
struct Args { const void* in[19]; float* out; unsigned char* ws; };
static_assert(sizeof(Args) == 21 * 8, "no padding in Args");

__global__ void __launch_bounds__(NTHREADS, 2) fwd_kernel(Args args) {
    extern __shared__ __attribute__((aligned(16))) unsigned char lds_raw[];
    Ctx F; F.lds = (LAS unsigned char*)lds_raw; F.tid = threadIdx.x; F.lane = F.tid & 63; F.wave = __builtin_amdgcn_readfirstlane(F.tid >> 6);
    F.G = gridDim.x; F.bx = blockIdx.x; { const int bx = blockIdx.x; F.vcu = (F.G % 8 == 0) ? (bx % 8) * (F.G / 8) + bx / 8 : bx; }
    guchar* ws0 = (guchar*)args.ws;
#define WSL() ({ guchar* w_ = ws0; LAUNDER_S(w_); w_; })
    volatile LAS unsigned* MISC = (volatile LAS unsigned*)(F.lds + MISC_OFF);
    if (F.tid < 32) MISC[F.tid] = 0u;
    __syncthreads();
    const XcdBarrier bar = xcd_barrier_post((unsigned*)(ws0 + WS_CTL) + CW_BAR, MISC);

    if (F.tid < 19) ((LAS unsigned long long*)(F.lds + ARGS_OFF))[F.tid] = (unsigned long long)args.in[F.tid];
    if (F.tid == 19) ((LAS unsigned long long*)(F.lds + ARGS_OFF))[19] = (unsigned long long)args.out;
    __syncthreads();
#define ARGP(T, i) ((T)arg_ld(F.lds, (i)))

#define FL() ({ Ctx f_ = F; LAUNDER_S(f_.lds); LAUNDER_S(f_.wave); LAUNDER_S(f_.vcu); LAUNDER_S(f_.G); LAUNDER_S(f_.bx); f_; })
#ifndef SKIP_P0
    for (int rep_ = 0; rep_ < REP_P0; ++rep_) { const Ctx Fp = FL(); guchar* ws = WSL(); p0_prologue(FL(), ARGP(const gfloat*, 0), ARGP(const gfloat*, 1), ARGP(const gint*, 2), ARGP(const gfloat*, 3), ARGP(const gfloat*, 4), ARGP(const gfloat*, 13), ARGP(const gfloat*, 14), ARGP(const gfloat*, 18), ARGP(const gfloat*, 16), ws); }
#endif
    for (int rb_ = 0; rb_ < REP_BAR; ++rb_) xcd_barrier(bar);

    for (int l = 0; l < NLAYER; ++l) {
        const gfloat* xin = l == 0 ? ARGP(const gfloat*, 0) : (const gfloat*)ARGP(gfloat*, 19);
#ifndef SKIP_P1
        for (int rep_ = 0; rep_ < REP_P1; ++rep_) { const Ctx Fp = FL(); guchar* ws = WSL(); const gfloat* ssq = l == 0 ? (const gfloat*)(ws + WS_SSQ0) : (const gfloat*)(ws + WS_CTL + CTL_SSQ1); pg8::SchedPlain S; S.T.init(M_ROWS / 256, NT_IN, Fp.G, Fp.bx, P1_WGM, P1_ROT); S.A = (const gchar*)(ws + WS_XB); S.B = (const gchar*)(ws + WS_WIN + (size_t)l * SZ_WIN);
          S.astep = (size_t)256 * DM * 2; S.bstep = (size_t)256 * DM * 2;
          pg8::EpiIn E{ssq, ws};
          pg8::gemm_phase<pg8::EpiIn, pg8::SchedPlain>(Fp.lds, DM, DM, DM, S, E); }
#ifdef PROBE_P1CHEAP
        { const Ctx Fp = FL(); guchar* ws = WSL(); pg8::SchedPlain S; S.T.init(M_ROWS / 256, NT_IN, Fp.G, Fp.bx); S.A = (const gchar*)(ws + WS_XB); S.B = (const gchar*)(ws + WS_WIN + (size_t)l * SZ_WIN);
          S.astep = (size_t)256 * DM * 2; S.bstep = (size_t)256 * DM * 2;
          pg8::EpiSq E{(gbf16*)(ws + WS_END), (gfloat*)(ws + WS_END + (size_t)M_ROWS * 31488 * 2)};
          pg8::gemm_phase<pg8::EpiSq, pg8::SchedPlain>(Fp.lds, DM, DM, DM, S, E); }
#endif
        { const Ctx Fq = FL(); const int nwg_ = (M_ROWS / 256) * NT_IN, rem_ = nwg_ % Fq.G;
          if (rem_ == 0 || Fq.bx >= rem_) { const int me = rem_ ? Fq.bx - rem_ : Fq.bx, nw = rem_ ? Fq.G - rem_ : Fq.G;
            { const Ctx Fp = FL(); guchar* ws = WSL(); pg8::SchedPlain S; S.T.init(M_ROWS / 256, DM / 256, nw, me); S.A = (const gchar*)(ws + WS_PB + (size_t)l * M_ROWS * 256 * 2); S.B = (const gchar*)(ws + WS_WPP + (size_t)l * SZ_WPP);
              S.astep = (size_t)256 * 256 * 2; S.bstep = (size_t)256 * 256 * 2;
              pg8::EpiSq E{(gbf16*)(ws + WS_ERAW), (gfloat*)(ws + WS_ERP)};
              pg8::gemm_phase<pg8::EpiSq, pg8::SchedPlain>(Fp.lds, 256, 256, 256, S, E); }
            if (l == 0) tr_run(FL(), TR_DEFER0, TR_DEFER1, 0x7fffffff, 0x7fffffff, me, nw, ARGP(const gfloat*, 4), ARGP(const gfloat*, 3), ARGP(const gfloat*, 13), ARGP(const gfloat*, 14), ARGP(const gfloat*, 18), ARGP(const gfloat*, 16), WSL()); } }
#endif
        for (int rb_ = 0; rb_ < REP_BAR; ++rb_) xcd_barrier(bar);
#ifndef SKIP_ML
        for (int rep_ = 0; rep_ < REP_ML; ++rep_) { const Ctx Fp = FL(); guchar* ws = WSL(); for (int u = Fp.vcu; u < 256; u += Fp.G) mlstm_unit(Fp, u >> 6, (u >> 4) & 3, u & 15, ws, ARGP(const gfloat*, 10) + l * 4, ARGP(const gfloat*, 11) + l * 4, ARGP(const gfloat*, 12) + l * BW); }
#endif
#ifndef SKIP_SW
        for (int rep_ = 0; rep_ < REP_SW; ++rep_) { const Ctx Fp = FL(); guchar* ws = WSL(); for (int u = Fp.vcu; u < 256; u += Fp.G) swa_unit(Fp, u >> 6, (u >> 2) & 15, u & 3, ws, ARGP(const gfloat*, 9) + l * 32); }
#endif
#ifndef SKIP_GM
        for (int rep_ = 0; rep_ < REP_GM; ++rep_) { const Ctx Fp = FL(); guchar* ws = WSL(); for (int u = Fp.vcu; u < 512; u += Fp.G) gmlp_unit(Fp, u >> 7, (u >> 3) & 15, u & 7, ws, ARGP(const gfloat*, 5) + l * BW, ARGP(const gfloat*, 6) + l * BW, ARGP(const gfloat*, 7) + (size_t)l * 8 * 128 * 128, ARGP(const gfloat*, 8) + l * 8 * 128); }
#endif
        for (int rb_ = 0; rb_ < REP_BAR; ++rb_) xcd_barrier(bar);
#ifndef SKIP_P2B
        for (int rep_ = 0; rep_ < REP_THIN; ++rep_) p2b_finalize(FL(), WSL());
#endif
        for (int rb_ = 0; rb_ < REP_BAR; ++rb_) xcd_barrier(bar);
#ifndef PROBE_NOSTORE
#define PROBE_NOSTORE 0
#endif
#ifdef PROBE_K1024
        for (int rep_ = 0; rep_ < 4; ++rep_) { const Ctx Fp = FL(); guchar* ws = WSL(); pg8::SchedPlain S; S.T.init(M_ROWS / 256, DM / 256, Fp.G, Fp.bx); S.A = (const gchar*)(ws + WS_YA); S.B = (const gchar*)(ws + WS_WOUT + (size_t)l * SZ_WSQ);
          S.astep = (size_t)256 * DM * 2; S.bstep = (size_t)256 * DM * 2;
          pg8::EpiSq E{PROBE_NOSTORE ? (gbf16*)nullptr : (gbf16*)(ws + WS_END), (gfloat*)(ws + WS_END + (size_t)M_ROWS * 31488 * 2)};
          pg8::gemm_phase<pg8::EpiSq, pg8::SchedPlain>(Fp.lds, 1024, DM, DM, S, E); }
#endif
#ifdef PROBE_P3CHEAP
        { const Ctx Fp = FL(); guchar* ws = WSL(); pg8::SchedBranch S; S.T.init(M_ROWS / 256, DM / 256, Fp.G, Fp.bx); S.A = (const gchar*)(ws + WS_YA); S.B = (const gchar*)(ws + WS_WBR + (size_t)l * SZ_WBR);
          S.astep = (size_t)256 * BW * 2; S.bstep = (size_t)256 * BW * 2; S.aseg = SZ_ROWS_BW; S.bseg = (size_t)DM * BW * 2;
          pg8::EpiSq E{(gbf16*)(ws + WS_END), (gfloat*)(ws + WS_END + (size_t)M_ROWS * 31488 * 2)};
          pg8::gemm_phase<pg8::EpiSq, pg8::SchedBranch>(Fp.lds, BW, BW, BW, S, E); }
#endif
#ifndef SKIP_P3
        for (int rep_ = 0; rep_ < REP_P3; ++rep_) { const Ctx Fp = FL(); guchar* ws = WSL(); pg8::SchedBranch S; S.T.init(M_ROWS / 256, DM / 256, Fp.G, Fp.bx); S.A = (const gchar*)(ws + WS_YA); S.B = (const gchar*)(ws + WS_WBR + (size_t)l * SZ_WBR);
          S.astep = (size_t)256 * BW * 2; S.bstep = (size_t)256 * BW * 2; S.aseg = SZ_ROWS_BW; S.bseg = (size_t)DM * BW * 2;
          pg8::EpiBranch E{(const gbf16*)(ws + WS_G), (gbf16*)(ws + WS_MIX)};
          pg8::gemm_phase<pg8::EpiBranch, pg8::SchedBranch>(Fp.lds, BW, BW, BW, S, E); }
#endif
        for (int rb_ = 0; rb_ < REP_BAR; ++rb_) xcd_barrier(bar);
#ifndef SKIP_P4
        for (int rep_ = 0; rep_ < REP_P4; ++rep_) { const Ctx Fp = FL(); guchar* ws = WSL(); pg8::SchedPlain S; S.T.init(M_ROWS / 256, DM / 256, Fp.G, Fp.bx); S.A = (const gchar*)(ws + WS_MIX); S.B = (const gchar*)(ws + WS_WOUT + (size_t)l * SZ_WSQ);
          S.astep = (size_t)256 * DM * 2; S.bstep = (size_t)256 * DM * 2;
          pg8::EpiSq E{(gbf16*)(ws + WS_OUT), (gfloat*)(ws + WS_OUTP)};
          pg8::gemm_phase<pg8::EpiSq, pg8::SchedPlain>(Fp.lds, DM, DM, DM, S, E); }
#endif
        for (int rb_ = 0; rb_ < REP_BAR; ++rb_) xcd_barrier(bar);
#ifndef SKIP_P4B
        for (int rep_ = 0; rep_ < REP_THIN; ++rep_) p4b_x1(FL(), WSL(), ARGP(const gfloat*, 15) + l * DM);
#endif
        for (int rb_ = 0; rb_ < REP_BAR; ++rb_) xcd_barrier(bar);
#ifdef PROBE_P5
        { const Ctx Fp = FL(); guchar* ws = WSL(); pg8::SchedPlain S; S.T.init(M_ROWS / 256, DM / 256, Fp.G, Fp.bx); S.A = (const gchar*)(ws + WS_X1B); S.B = (const gchar*)(ws + WS_WPG + (size_t)l * SZ_WSQ);
          S.astep = (size_t)256 * DM * 2; S.bstep = (size_t)256 * DM * 2;
          pg8::EpiPle E{xin, (gfloat*)(ws + WS_END), (gbf16*)(ws + WS_END + (size_t)M_ROWS * DM * 4), (const gbf16*)(ws + WS_OUT), (const gbf16*)(ws + WS_ERAW), (const gfloat*)(ws + WS_RSO), (const gfloat*)(ws + WS_RSE),
                        ARGP(const gfloat*, 15) + l * DM, ARGP(const gfloat*, 17) + l * DM, (gfloat*)(ws + WS_END + (size_t)M_ROWS * DM * 6), 0};
          pg8::gemm_phase<pg8::EpiPle, pg8::SchedPlain>(Fp.lds, DM, DM, DM, S, E); }
#endif
#ifndef SKIP_P5
        { const Ctx Fp = FL(); guchar* ws = WSL(); pg8::SchedPlain S; S.T.init(M_ROWS / 256, DM / 256, Fp.G, Fp.bx); S.A = (const gchar*)(ws + WS_X1B); S.B = (const gchar*)(ws + WS_WPG + (size_t)l * SZ_WSQ);
          S.astep = (size_t)256 * DM * 2; S.bstep = (size_t)256 * DM * 2;
          pg8::EpiPle E{xin, ARGP(gfloat*, 19), (gbf16*)(ws + WS_XB), (const gbf16*)(ws + WS_OUT), (const gbf16*)(ws + WS_ERAW), (const gfloat*)(ws + WS_RSO), (const gfloat*)(ws + WS_RSE),
                        ARGP(const gfloat*, 15) + l * DM, ARGP(const gfloat*, 17) + l * DM, (gfloat*)(ws + WS_XSP), l == NLAYER - 1 ? 1 : 0};
          pg8::gemm_phase<pg8::EpiPle, pg8::SchedPlain>(Fp.lds, DM, DM, DM, S, E); }
#endif
        if (l + 1 < NLAYER) { for (int rb_ = 0; rb_ < REP_BAR; ++rb_) xcd_barrier(bar); p5b_ssq(FL(), WSL()); for (int rb_ = 0; rb_ < REP_BAR; ++rb_) xcd_barrier(bar); }
    }
}

extern "C" void kernel_launch(void* const* d_in, const int* in_sizes, int n_in, void* d_out, int out_size, void* d_ws, size_t ws_size, hipStream_t stream) {
    static int grid = 0;
    if (grid == 0) {
        if (n_in != 19 || out_size != M_ROWS * DM || ws_size < WS_END) { fprintf(stderr, "kernel_launch: unexpected problem (n_in %d, out %d, ws %zu, need %zu)\n", n_in, out_size, ws_size, (size_t)WS_END); grid = -1; return; }
        int dev = 0, cus = 0;
        if (hipGetDevice(&dev) != hipSuccess || hipDeviceGetAttribute(&cus, hipDeviceAttributeMultiprocessorCount, dev) != hipSuccess) { grid = -1; return; }
        if (hipFuncSetAttribute((const void*)fwd_kernel, hipFuncAttributeMaxDynamicSharedMemorySize, LDS_BYTES) != hipSuccess) { fprintf(stderr, "kernel_launch: hipFuncSetAttribute failed\n"); grid = -1; return; }
        int per_cu = 0; (void)hipOccupancyMaxActiveBlocksPerMultiprocessor(&per_cu, (const void*)fwd_kernel, NTHREADS, LDS_BYTES); (void)hipGetLastError();
        if (per_cu < 1) fprintf(stderr, "kernel_launch: occupancy query reports %d blocks per CU\n", per_cu);
        grid = cus > 256 ? 256 : cus;
    }
    if (grid < 0) return;
    (void)hipMemsetAsync((char*)d_ws + WS_CTL, 0, CTL_ZERO_BYTES, stream);
    Args a{};
    for (int i = 0; i < 19; ++i) a.in[i] = d_in[i];
    a.out = (float*)d_out; a.ws = (unsigned char*)d_ws;
    hipLaunchKernelGGL(fwd_kernel, dim3(grid), dim3(NTHREADS), LDS_BYTES, stream, a);
    const hipError_t le = hipPeekAtLastError();
    if (le != hipSuccess) fprintf(stderr, "kernel_launch: launch failed: %s\n", hipGetErrorName(le));
}
```

```cpp
#include <hip/hip_runtime.h>
#include <cstdio>
#include <cstdint>

#define LAS __attribute__((address_space(3)))
#define GAS __attribute__((address_space(1)))
typedef unsigned short bf16_t;
typedef short bf16x8 __attribute__((ext_vector_type(8)));
typedef float f32x4 __attribute__((ext_vector_type(4)));
typedef float f32x2 __attribute__((ext_vector_type(2)));
typedef unsigned u32x4 __attribute__((ext_vector_type(4)));
typedef unsigned u32x2 __attribute__((ext_vector_type(2)));

typedef GAS float gfloat; typedef GAS bf16_t gbf16; typedef GAS int gint; typedef GAS char gchar; typedef GAS unsigned char guchar; typedef GAS unsigned gunsigned;
typedef GAS f32x4 gf32x4; typedef GAS f32x2 gf32x2; typedef GAS u32x4 gu32x4; typedef GAS u32x2 gu32x2;
constexpr int M_ROWS = 8192, SEQ = 2048, DM = 4096, BW = 2048, NLAYER = 2;
constexpr int N_IN = 31240, IF_COL = 14848;
constexpr int NT_IN = 123;
constexpr int N_IN_T = NT_IN * 256;
constexpr float NORM_EPS = 1e-6f;

__device__ __forceinline__ unsigned cvt_pk_bf16(float lo, float hi) { unsigned r; asm("v_cvt_pk_bf16_f32 %0, %1, %2" : "=v"(r) : "v"(lo), "v"(hi)); return r; }
__device__ __forceinline__ float bf_lo(unsigned w) { return __uint_as_float(w << 16); }
__device__ __forceinline__ float bf_hi(unsigned w) { return __uint_as_float(w & 0xffff0000u); }
__device__ __forceinline__ float bf1(bf16_t b) { return __uint_as_float(((unsigned)b) << 16); }
__device__ __forceinline__ float fsigmoid(float x) { return __builtin_amdgcn_rcpf(1.0f + __expf(-x)); }
__device__ __forceinline__ float wave_sum(float v) {
#pragma unroll
    for (int o = 1; o < 64; o <<= 1) v += __shfl_xor(v, o);
    return v;
}
__device__ __forceinline__ f32x2 gelu_pk(f32x2 v) {
    const f32x2 av = __builtin_elementwise_abs(v), d = av * 0.2316418882f + 1.0f;
    f32x2 t; t.x = __builtin_amdgcn_rcpf(d.x); t.y = __builtin_amdgcn_rcpf(d.y);
    f32x2 q = t * 0.5307027145f + (-0.7265760135f); q = q * t + 0.7107068705f; q = q * t + (-0.142248368f); q = q * t + 0.127414796f; q = q * t;
    const f32x2 s = (v * v) * (-0.72134752044f);
    f32x2 e; e.x = __builtin_amdgcn_exp2f(s.x); e.y = __builtin_amdgcn_exp2f(s.y);
    const f32x2 m = v * (q * e), r = v - m;
    f32x2 o; o.x = v.x < 0.f ? m.x : r.x; o.y = v.y < 0.f ? m.y : r.y; return o;
}
#define LAUNDER_V(x) asm volatile("" : "+v"(x))
#define LAUNDER_S(x) asm volatile("" : "+s"(x))
#define LDS_WAIT() asm volatile("s_waitcnt lgkmcnt(0)" ::: "memory")
#define VM_WAIT() asm volatile("s_waitcnt vmcnt(0)" ::: "memory")
#define MFMA16(a, b, c) __builtin_amdgcn_mfma_f32_16x16x32_bf16((a), (b), (c), 0, 0, 0)

#define XB_TMO      128
#define XB_XCNT(j)  (256  + 64 * (j))
#define XB_XSUB(j)  (1280 + 64 * (j))
#define XB_XGEN(j)  (2304 + 64 * (j))
#define XB_TOP      3328
#define XB_TOPGEN   3392
#define XCD_BAR_WORDS 3456
#define XB_SPIN_CAP (1u << 18)
__device__ __forceinline__ unsigned xb_ld(unsigned* p)              { return __hip_atomic_load(p, __ATOMIC_RELAXED, __HIP_MEMORY_SCOPE_AGENT); }
__device__ __forceinline__ unsigned xb_add(unsigned* p, unsigned v) { return __hip_atomic_fetch_add(p, v, __ATOMIC_RELAXED, __HIP_MEMORY_SCOPE_AGENT); }
__device__ __forceinline__ unsigned xb_xcc_id() { return (unsigned)__builtin_amdgcn_s_getreg((3 << 11) | 20) & 0xFu; }
#define XB_SPIN(cond, bar) do { unsigned _sp = 0; while (cond) { __builtin_amdgcn_s_sleep(1); \
    if ((++_sp & 255u) == 0u) { if (xb_ld(&(bar)[XB_TMO])) break; if (_sp > XB_SPIN_CAP) { atomicAdd(&(bar)[XB_TMO], 1u); break; } } } } while (0)
struct XcdBarrier { unsigned* bar; unsigned x; volatile LAS unsigned* st; };
__device__ __forceinline__ XcdBarrier xcd_barrier_post(unsigned* bar, volatile LAS unsigned* st) {
    XcdBarrier b; b.bar = bar; b.x = xb_xcc_id(); b.st = st;
    if (threadIdx.x == 0) (void)xb_add(&bar[XB_XCNT(b.x)], 1u);
    return b;
}
__device__ __forceinline__ void xcd_barrier_complete(unsigned* bar, unsigned x, unsigned& nloc, unsigned& nx) {
    const unsigned G = gridDim.x * gridDim.y * gridDim.z;
    unsigned sum, cnt, mine, sp = 0u;
    for (;;) {
        sum = 0u; cnt = 0u; mine = 0u;
#pragma unroll
        for (unsigned j = 0; j < 16; ++j) { const unsigned c = xb_ld(&bar[XB_XCNT(j)]); sum += c; cnt += (c > 0u) ? 1u : 0u; mine = (j == x) ? c : mine; }
        if (sum == G) break;
        __builtin_amdgcn_s_sleep(1);
        if ((++sp & 255u) == 0u) { if (xb_ld(&bar[XB_TMO])) break; if (sp > XB_SPIN_CAP) { atomicAdd(&bar[XB_TMO], 1u); break; } }
    }
    nloc = mine > 0u ? mine : 1u; nx = cnt > 0u ? cnt : 1u;
}
__device__ __forceinline__ void xcd_barrier(const XcdBarrier& b) {
    asm volatile("s_waitcnt vmcnt(0)" ::: "memory");
    __syncthreads();
    if (threadIdx.x == 0) {
        unsigned* bar = b.bar;
        __builtin_amdgcn_s_waitcnt(0);
        unsigned nloc = b.st[0], nx = b.st[1];
        if (nloc == 0u) { xcd_barrier_complete(bar, b.x, nloc, nx); b.st[0] = nloc; b.st[1] = nx; }
        const unsigned old = xb_add(&bar[XB_XSUB(b.x)], 1u);
        const unsigned gen = old / nloc;
        if (old + 1u == (gen + 1u) * nloc) {
            __builtin_amdgcn_fence(__ATOMIC_RELEASE, "agent");
            asm volatile("s_waitcnt vmcnt(0)" ::: "memory");
            const unsigned og = xb_add(&bar[XB_TOP], 1u);
            const unsigned tg = og / nx;
            if (og + 1u == (tg + 1u) * nx) xb_add(&bar[XB_TOPGEN], 1u);
            else XB_SPIN(xb_ld(&bar[XB_TOPGEN]) == tg, bar);
            __builtin_amdgcn_fence(__ATOMIC_ACQUIRE, "agent");
            xb_add(&bar[XB_XGEN(b.x)], 1u);
            asm volatile("s_waitcnt vmcnt(0)" ::: "memory");
        } else {
            XB_SPIN(xb_ld(&bar[XB_XGEN(b.x)]) == gen, bar);
            __builtin_amdgcn_fence(__ATOMIC_ACQUIRE, "agent");
            asm volatile("s_waitcnt vmcnt(0)" ::: "memory");
        }
    }
    __syncthreads();
}

#ifndef WGM_DEFAULT
#define WGM_DEFAULT 4
#endif
namespace pg8 {
constexpr int BM = 256, BK = 64, HALF = 128, HTB = HALF * BK * 2, STAGE_BYTES = 8 * HTB, NXCD = 8, WGM = WGM_DEFAULT;
__host__ __device__ __forceinline__ int lds_byte(int r, int c) { const int st = (r >> 4) * 2 + (c >> 5), rr = r & 15, cc = c & 31, ob = rr * 64 + cc * 2; return st * 1024 + (ob ^ (((ob >> 9) & 1) << 5)); }
__host__ __device__ __forceinline__ void stage_rc(int b, int& R, int& C) { const int st = b / 1024, sb = b % 1024, swz = sb ^ (((sb >> 9) & 1) << 5); R = (st >> 1) * 16 + swz / 64; C = (st & 1) * 32 + (swz % 64) / 2; }
__host__ __device__ __forceinline__ int perm32(int rho) { const int n = rho >> 4, i = rho & 15; return 8 * (i >> 2) + 4 * n + (i & 3); }

struct Unit { int pm, pn, seg; };

struct TileOrder {
    int nM, nN, nwg, G, c, wgm, rot;
    __device__ __forceinline__ void init(int nM_, int nN_, int G_, int c_, int wgm_ = WGM, int rot_ = 0) { nM = nM_; nN = nN_; nwg = nM * nN; G = G_; c = c_; wgm = wgm_; rot = rot_; }
    __device__ __forceinline__ bool tile(int i, int& pm, int& pn) const {
        const long L = (long)i * G + c; if (L >= nwg) return false;
        int wgid = (int)L; const int xcd = wgid % NXCD; { const int q = nwg / NXCD, r = nwg % NXCD, off = wgid / NXCD; wgid = (xcd < r ? xcd * (q + 1) : r * (q + 1) + (xcd - r) * q) + off; }
        const int nig = wgm * nN, gid = wgid / nig, fm = gid * wgm, gsz = (nM - fm) < wgm ? (nM - fm) : wgm;
        pm = fm + ((wgid % nig) % gsz); pn = (wgid % nig) / gsz; if (rot) { pn += rot * xcd; pn -= (pn / nN) * nN; } return true;
    }
};
struct SchedPlain {
    TileOrder T; const gchar* A; const gchar* B; size_t astep, bstep;
    __device__ __forceinline__ bool next(int i, Unit& u) const { u.seg = 0; return T.tile(i, u.pm, u.pn); }
    __device__ __forceinline__ const gchar* a_ptr(const Unit& u) const { return A + (size_t)u.pm * astep; }
    __device__ __forceinline__ const gchar* b_ptr(const Unit& u) const { return B + (size_t)u.pn * bstep; }
};
struct SchedBranch {
    TileOrder T; const gchar* A; const gchar* B; size_t astep, bstep, aseg, bseg;
    __device__ __forceinline__ bool next(int i, Unit& u) const { const int t = i / 3; u.seg = i - 3 * t; return T.tile(t, u.pm, u.pn); }
    __device__ __forceinline__ const gchar* a_ptr(const Unit& u) const { return A + (size_t)u.seg * aseg + (size_t)u.pm * astep; }
    __device__ __forceinline__ const gchar* b_ptr(const Unit& u) const { return B + (size_t)u.seg * bseg + (size_t)u.pn * bstep; }
};

template <class Epi, class Sched>
__device__ __forceinline__ void gemm_phase(LAS unsigned char* lds, const int K, const int lda, const int ldb, const Sched& S, const Epi& E) {
    int tid = threadIdx.x; LAUNDER_V(tid);
    const int wid = __builtin_amdgcn_readfirstlane(tid >> 6), lane = tid & 63, wr = wid >> 2, wc = wid & 3, fr = lane & 15, fq = lane >> 4;
    const int nt = K / BK;
    unsigned voffA, voffB;
    { int R, C; stage_rc(tid * 16, R, C); const int Rb = Epi::PERM ? ((R & ~31) + perm32(R & 31)) : R;
      voffA = (unsigned)(R * lda + C) * 2u; voffB = (unsigned)(Rb * ldb + C) * 2u; }
    const unsigned qstepA = 64u * (unsigned)lda * 2u, qstepB = 64u * (unsigned)ldb * 2u;
    const size_t kstep = (size_t)(BK * 2);
    const size_t hstepA = (size_t)HALF * lda * 2, hstepB = (size_t)HALF * ldb * 2;
    const unsigned ldsw = (unsigned)wid * 1024u;
    const int aoff = lds_byte(wr * 64 + fr, fq * 8), boff = lds_byte(wc * 32 + fr, fq * 8);
#define PG8_SA(b, h) (((b) * 2 + (h)) * HTB)
#define PG8_SB(b, h) ((4 + (b) * 2 + (h)) * HTB)
#define PG8_STAGE(bufoff, gbase, voff) do { _Pragma("unroll") for (int _i = 0; _i < 2; ++_i) \
        __builtin_amdgcn_global_load_lds((const gunsigned*)((const gchar*)(gbase) + (size_t)_i * q##voff + (voff)), (LAS unsigned*)(lds + (bufoff) + ldsw + _i * 8192), 16, 0, 0); } while (0)
#define qvoffA qstepA
#define qvoffB qstepB
#define PG8_LDA(dst, b, h) do { _Pragma("unroll") for (int m = 0; m < 4; ++m) _Pragma("unroll") for (int k = 0; k < 2; ++k) dst[m][k] = *(const LAS bf16x8*)(lds + PG8_SA(b, h) + aoff + m * 2048 + k * 1024); } while (0)
#define PG8_LDB(dst, b, h) do { _Pragma("unroll") for (int n = 0; n < 2; ++n) _Pragma("unroll") for (int k = 0; k < 2; ++k) dst[n][k] = *(const LAS bf16x8*)(lds + PG8_SB(b, h) + boff + n * 2048 + k * 1024); } while (0)
#define PG8_MMA(ai, bj, At, Bt) do { __builtin_amdgcn_s_setprio(1); _Pragma("unroll") for (int m = 0; m < 4; ++m) _Pragma("unroll") for (int n = 0; n < 2; ++n) _Pragma("unroll") for (int k = 0; k < 2; ++k) \
        acc[ai][bj][m][n] = __builtin_amdgcn_mfma_f32_16x16x32_bf16(Bt[n][k], At[m][k], acc[ai][bj][m][n], 0, 0, 0); __builtin_amdgcn_s_setprio(0); } while (0)
#define PG8_WAIT_V(n) asm volatile("s_waitcnt vmcnt(" #n ")" ::: "memory")
#define PG8_WAIT_VR() do { if constexpr (Epi::NS == 16) asm volatile("s_waitcnt vmcnt(24)" ::: "memory"); else if constexpr (Epi::NS == 32) asm volatile("s_waitcnt vmcnt(40)" ::: "memory"); else asm volatile("s_waitcnt vmcnt(8)" ::: "memory"); } while (0)
#define PG8_WAIT_L(n) asm volatile("s_waitcnt lgkmcnt(" #n ")" ::: "memory")
#define PG8_BAR __builtin_amdgcn_s_barrier()
#define PG8_SCHED __builtin_amdgcn_sched_barrier(0)
    Unit cur, nxt; int ui = 0; bool relax_next = false;
    if (!S.next(0, cur)) return;
    f32x4 acc[2][2][4][2];
#pragma unroll
    for (int a = 0; a < 2; ++a)
#pragma unroll
        for (int b = 0; b < 2; ++b)
#pragma unroll
            for (int m = 0; m < 4; ++m)
#pragma unroll
                for (int n = 0; n < 2; ++n) acc[a][b][m][n] = (f32x4){0.f, 0.f, 0.f, 0.f};
    bf16x8 At[4][2], B0[2][2], B1[2][2];
    const gchar* cA = S.a_ptr(cur); const gchar* cB = S.b_ptr(cur);
    PG8_STAGE(PG8_SB(0, 0), cB, voffB); PG8_STAGE(PG8_SB(0, 1), cB + hstepB, voffB); PG8_STAGE(PG8_SA(0, 0), cA, voffA); PG8_STAGE(PG8_SA(0, 1), cA + hstepA, voffA);
    if (wr == 1) PG8_BAR;
    PG8_WAIT_V(2); PG8_BAR;
    PG8_STAGE(PG8_SB(1, 0), cB + kstep, voffB); PG8_STAGE(PG8_SA(1, 0), cA + kstep, voffA); PG8_STAGE(PG8_SB(1, 1), cB + hstepB + kstep, voffB);
    PG8_WAIT_V(6); PG8_BAR;
    for (;;) {
        const bool has_next = S.next(ui + 1, nxt);
        const gchar* nA = has_next ? S.a_ptr(nxt) : cA; const gchar* nB = has_next ? S.b_ptr(nxt) : cB;
        for (int t = 0; t < nt; t += 2) {
            const bool last = (t == nt - 2); const bool relax = Epi::NS > 0 && (t == 0) && relax_next;
            const gchar* a1 = cA + (size_t)(t + 1) * kstep;
            const gchar* a2 = last ? nA : cA + (size_t)(t + 2) * kstep; const gchar* b2 = last ? nB : cB + (size_t)(t + 2) * kstep;
            const gchar* a3 = a2 + kstep; const gchar* b3 = b2 + kstep;
            PG8_LDB(B0, 0, 0); PG8_LDB(B1, 0, 1); PG8_SCHED; PG8_LDA(At, 0, 0); PG8_STAGE(PG8_SA(1, 1), a1 + hstepA, voffA);
            if (relax) PG8_WAIT_VR(); else PG8_WAIT_V(8); PG8_WAIT_L(0); PG8_BAR; PG8_MMA(0, 0, At, B0); PG8_MMA(0, 1, At, B1); PG8_BAR; PG8_SCHED;
            PG8_LDA(At, 0, 1); PG8_STAGE(PG8_SB(0, 0), b2, voffB); PG8_STAGE(PG8_SB(0, 1), b2 + hstepB, voffB); PG8_STAGE(PG8_SA(0, 0), a2, voffA);
            if (relax) PG8_WAIT_VR(); else PG8_WAIT_V(8); PG8_WAIT_L(0); PG8_BAR; PG8_MMA(1, 0, At, B0); PG8_MMA(1, 1, At, B1); PG8_BAR; PG8_SCHED;
            PG8_LDB(B0, 1, 0); PG8_LDB(B1, 1, 1); PG8_SCHED; PG8_LDA(At, 1, 0); PG8_STAGE(PG8_SA(0, 1), a2 + hstepA, voffA);
            PG8_WAIT_V(8); PG8_WAIT_L(0); PG8_BAR; PG8_MMA(0, 0, At, B0); PG8_MMA(0, 1, At, B1); PG8_BAR; PG8_SCHED;
            PG8_LDA(At, 1, 1); PG8_STAGE(PG8_SB(1, 0), b3, voffB); PG8_STAGE(PG8_SB(1, 1), b3 + hstepB, voffB); PG8_STAGE(PG8_SA(1, 0), a3, voffA);
            PG8_WAIT_V(8); PG8_WAIT_L(0); PG8_BAR; PG8_MMA(1, 0, At, B0); PG8_MMA(1, 1, At, B1); PG8_BAR; PG8_SCHED;
        }
        if (wr == 0) PG8_BAR;
        { const int ln_ = (int)__builtin_amdgcn_mbcnt_hi(~0u, __builtin_amdgcn_mbcnt_lo(~0u, 0u)); E(acc, cur, wr, wc, ln_ & 15, ln_ >> 4); } relax_next = E.relax(cur);
        if (!has_next) break;
        if (!E.keep(cur)) {
#pragma unroll
            for (int a = 0; a < 2; ++a)
#pragma unroll
                for (int b = 0; b < 2; ++b)
#pragma unroll
                    for (int m = 0; m < 4; ++m)
#pragma unroll
                        for (int n = 0; n < 2; ++n) acc[a][b][m][n] = (f32x4){0.f, 0.f, 0.f, 0.f};
        }
        cur = nxt; cA = nA; cB = nB; ++ui;
        if (wr == 1) PG8_BAR;
    }
    PG8_WAIT_V(0);
    PG8_BAR;
#undef PG8_SA
#undef PG8_SB
#undef PG8_STAGE
#undef qvoffA
#undef qvoffB
#undef PG8_LDA
#undef PG8_LDB
#undef PG8_MMA
#undef PG8_WAIT_V
#undef PG8_WAIT_VR
#undef PG8_WAIT_L
#undef PG8_BAR
#undef PG8_SCHED
}
}

constexpr size_t MiB = 1u << 20;
constexpr size_t WS_CTL = 0, CTL_ZERO_BYTES = 1 * MiB;
constexpr int CW_BAR = 4096;
constexpr size_t CTL_SSQ1 = 256 * 1024;
constexpr size_t SZ_WIN = (size_t)N_IN_T * DM * 2, SZ_WBR = (size_t)3 * DM * BW * 2, SZ_WSQ = (size_t)DM * DM * 2, SZ_WPP = (size_t)DM * 256 * 2;
constexpr size_t WS_WIN = 2 * MiB;
constexpr size_t WS_WBR = WS_WIN + 2 * SZ_WIN;
constexpr size_t WS_WOUT = WS_WBR + 2 * SZ_WBR;
constexpr size_t WS_WPG = WS_WOUT + 2 * SZ_WSQ;
constexpr size_t WS_WPP = WS_WPG + 2 * SZ_WSQ;
constexpr size_t SZ_ROWS_BW = (size_t)M_ROWS * BW * 2, SZ_ROWS_D = (size_t)M_ROWS * DM * 2;
constexpr size_t WS_XB = WS_WPP + 2 * SZ_WPP;
constexpr size_t WS_PB = WS_XB + SZ_ROWS_D;
constexpr size_t WS_CS = WS_PB + (size_t)2 * M_ROWS * 256 * 2;
constexpr size_t WS_SSQ0 = WS_CS + (size_t)M_ROWS * 16 * 4;
constexpr size_t WS_AU = WS_SSQ0 + (size_t)M_ROWS * 4;
constexpr size_t WS_AV = WS_AU + SZ_ROWS_BW, WS_AZ = WS_AV + SZ_ROWS_BW, WS_BQ = WS_AZ + SZ_ROWS_BW;
constexpr size_t WS_BK = WS_BQ + SZ_ROWS_BW;
constexpr size_t WS_BV = WS_BK + (size_t)M_ROWS * 256 * 2;
constexpr size_t WS_BZ = WS_BV + (size_t)M_ROWS * 256 * 2;
constexpr size_t WS_CQ = WS_BZ + SZ_ROWS_BW;
constexpr size_t WS_CK = WS_CQ + (size_t)M_ROWS * 1024 * 2;
constexpr size_t WS_CV = WS_CK + (size_t)M_ROWS * 1024 * 2;
constexpr size_t WS_CO = WS_CV + SZ_ROWS_BW, WS_CZ = WS_CO + SZ_ROWS_BW;
constexpr size_t WS_G = WS_CZ + SZ_ROWS_BW;
constexpr size_t WS_IF = WS_G + (size_t)M_ROWS * 12288 * 2;
constexpr size_t WS_LNP = WS_IF + (size_t)M_ROWS * 8 * 4;
constexpr size_t WS_YA = WS_LNP + (size_t)M_ROWS * 32 * 8;
constexpr size_t WS_NUM = WS_YA + 3 * SZ_ROWS_BW;
constexpr size_t WS_SSQC = WS_NUM + SZ_ROWS_BW;
constexpr size_t WS_DN = WS_SSQC + (size_t)M_ROWS * 64 * 4;
constexpr size_t WS_MIX = WS_DN + (size_t)M_ROWS * 4 * 4;
constexpr size_t WS_OUT = WS_MIX + SZ_ROWS_D;
constexpr size_t WS_OUTP = WS_OUT + SZ_ROWS_D;
constexpr size_t WS_ERAW = WS_OUTP + (size_t)M_ROWS * 64 * 4;
constexpr size_t WS_ERP = WS_ERAW + SZ_ROWS_D;
constexpr size_t WS_RSO = WS_ERP + (size_t)M_ROWS * 64 * 4;
constexpr size_t WS_RSE = WS_RSO + (size_t)M_ROWS * 4;
constexpr size_t WS_X1B = WS_RSE + (size_t)M_ROWS * 4;
constexpr size_t WS_XSP = WS_X1B + SZ_ROWS_D;
constexpr size_t WS_END = WS_XSP + (size_t)M_ROWS * 64 * 4;
static_assert(WS_WIN % 256 == 0 && WS_XB % 256 == 0 && WS_AU % 256 == 0 && WS_G % 256 == 0 && WS_YA % 256 == 0 && WS_MIX % 256 == 0 && WS_X1B % 256 == 0, "alignment");

#ifndef EPIIN_NT
#define EPIIN_NT 0
#endif
#if EPIIN_NT
#define EPIIN_STORE(v, p) __builtin_nontemporal_store((v), (p))
#else
#define EPIIN_STORE(v, p) (*(p) = (v))
#endif
#ifndef EPI_NS16
#define EPI_NS16 0
#endif
#ifndef EPI_NS32
#define EPI_NS32 0
#endif
#ifndef EPIIN_NS
#define EPIIN_NS 0
#endif
namespace pg8 {
struct EpiIn {
    static constexpr bool PERM = true; static constexpr int NS = EPIIN_NS;
    __device__ __forceinline__ bool relax(const Unit& u) const { return u.pn < 122; }
    const gfloat* ssq; guchar* ws;
    __device__ __forceinline__ bool keep(const Unit&) const { return false; }
    __device__ __forceinline__ void operator()(f32x4 (&acc)[2][2][4][2], const Unit& u, int wr, int wc, int fr, int fq) const {
        const int pn = u.pn; const int row0 = u.pm * BM + wr * 64 + fr;
        size_t off; int ldc, t0, act; float sc = 1.f;
        if (pn < 16)       { off = WS_AU; ldc = 2048; t0 = 0; act = 6; }
        else if (pn < 24)  { off = WS_AV; ldc = 2048; t0 = 16; act = 5; }
        else if (pn < 32)  { off = WS_BQ; ldc = 2048; t0 = 24; act = 0; }
        else if (pn < 33)  { off = WS_BK; ldc = 256; t0 = 32; act = 0; }
        else if (pn < 34)  { off = WS_BV; ldc = 256; t0 = 33; act = 0; }
        else if (pn < 42)  { off = WS_BZ; ldc = 2048; t0 = 34; act = 2; }
        else if (pn < 46)  { off = WS_CQ; ldc = 1024; t0 = 42; act = 0; sc = 0.0625f; }
        else if (pn < 50)  { off = WS_CK; ldc = 1024; t0 = 46; act = 0; }
        else if (pn < 58)  { off = WS_CV; ldc = 2048; t0 = 50; act = 0; }
        else if (pn < 74)  { off = WS_CO; ldc = 2048; t0 = 58; act = 7; }
        else if (pn < 122) { off = WS_G; ldc = 12288; t0 = 74; act = 3; }
        else               { off = WS_IF; ldc = 8; t0 = 122; act = 4; }
        const int col0 = (pn - t0) * BM + wc * 32 + 8 * fq;
        if (act == 4) {
            if (wc == 0 && fq == 0) {
                gfloat* dst = (gfloat*)(ws + off);
#pragma unroll
                for (int ai = 0; ai < 2; ++ai)
#pragma unroll
                    for (int m = 0; m < 4; ++m) { const int row = row0 + ai * HALF + m * 16; const float rs = rsqrtf(ssq[row] * (1.0f / DM) + NORM_EPS);
                        *(gf32x4*)(dst + (size_t)row * 8) = acc[ai][0][m][0] * rs; *(gf32x4*)(dst + (size_t)row * 8 + 4) = acc[ai][0][m][1] * rs; }
            }
            return;
        }
        gbf16* base = (gbf16*)(ws + off);
        if (act == 6 || act == 7) {
            const int colp = (pn - t0) * HALF + wc * 32 + 8 * fq;
#pragma unroll
            for (int ai = 0; ai < 2; ++ai)
#pragma unroll
                for (int m = 0; m < 4; ++m) {
                    const int row = row0 + ai * HALF + m * 16; const float rs = rsqrtf(ssq[row] * (1.0f / DM) + NORM_EPS);
                    f32x4 a0 = acc[ai][0][m][0] * rs, a1 = acc[ai][0][m][1] * rs; const f32x4 z0 = acc[ai][1][m][0] * rs, z1 = acc[ai][1][m][1] * rs;
                    if (act == 6) { const f32x2 a = gelu_pk((f32x2){a0[0], a0[1]}), b = gelu_pk((f32x2){a0[2], a0[3]}), c = gelu_pk((f32x2){a1[0], a1[1]}), d = gelu_pk((f32x2){a1[2], a1[3]});
                        a0 = (f32x4){a.x, a.y, b.x, b.y}; a1 = (f32x4){c.x, c.y, d.x, d.y}; }
                    else {
#pragma unroll
                        for (int j = 0; j < 4; ++j) { a0[j] = fsigmoid(a0[j]); a1[j] = fsigmoid(a1[j]); } }
#pragma unroll
                    for (int j = 0; j < 4; ++j) { a0[j] *= z0[j] * fsigmoid(z0[j]); a1[j] *= z1[j] * fsigmoid(z1[j]); }
                    u32x4 w; w.x = cvt_pk_bf16(a0[0], a0[1]); w.y = cvt_pk_bf16(a0[2], a0[3]); w.z = cvt_pk_bf16(a1[0], a1[1]); w.w = cvt_pk_bf16(a1[2], a1[3]);
                    *(gu32x4*)(base + (size_t)row * ldc + colp) = w;
                }
            return;
        }
#pragma unroll
        for (int ai = 0; ai < 2; ++ai)
#pragma unroll
            for (int m = 0; m < 4; ++m) {
                const int row = row0 + ai * HALF + m * 16; const float rs = rsqrtf(ssq[row] * (1.0f / DM) + NORM_EPS) * sc;
                gbf16* rowp = base + (size_t)row * ldc + col0; float ls = 0.f, lq = 0.f;
#pragma unroll
                for (int bj = 0; bj < 2; ++bj) {
                    f32x4 v0 = acc[ai][bj][m][0] * rs, v1 = acc[ai][bj][m][1] * rs;
                    if (act == 5) {
                        f32x2 a = gelu_pk((f32x2){v0[0], v0[1]}), b = gelu_pk((f32x2){v0[2], v0[3]}), c = gelu_pk((f32x2){v1[0], v1[1]}), d = gelu_pk((f32x2){v1[2], v1[3]});
                        v0 = (f32x4){a.x, a.y, b.x, b.y}; v1 = (f32x4){c.x, c.y, d.x, d.y};
                        { ls += (v0[0] + v0[1]) + (v0[2] + v0[3]) + (v1[0] + v1[1]) + (v1[2] + v1[3]);
                            lq += (v0[0] * v0[0] + v0[1] * v0[1]) + (v0[2] * v0[2] + v0[3] * v0[3]) + (v1[0] * v1[0] + v1[1] * v1[1]) + (v1[2] * v1[2] + v1[3] * v1[3]); }
                    } else if (act == 2) {
#pragma unroll
                        for (int j = 0; j < 4; ++j) { v0[j] = v0[j] * fsigmoid(v0[j]); v1[j] = v1[j] * fsigmoid(v1[j]); }
                    } else if (act == 3) {
#pragma unroll
                        for (int j = 0; j < 4; ++j) { v0[j] = fsigmoid(v0[j]); v1[j] = fsigmoid(v1[j]); }
                    }
                    u32x4 w; w.x = cvt_pk_bf16(v0[0], v0[1]); w.y = cvt_pk_bf16(v0[2], v0[3]); w.z = cvt_pk_bf16(v1[0], v1[1]); w.w = cvt_pk_bf16(v1[2], v1[3]);
                    EPIIN_STORE(w, (gu32x4*)(rowp + bj * HALF));
                }
                if (act == 5) {
                    ls += __shfl_xor(ls, 16); ls += __shfl_xor(ls, 32); lq += __shfl_xor(lq, 16); lq += __shfl_xor(lq, 32);
                    if (fq == 0) *(gf32x2*)(ws + WS_LNP + ((size_t)row * 32 + (pn - 16) * 4 + wc) * 8) = (f32x2){ls, lq};
                }
            }
    }
};
struct EpiBranch {
    static constexpr bool PERM = true; static constexpr int NS = EPI_NS16;
    __device__ __forceinline__ bool relax(const Unit& u) const { return u.seg == 2; }
    const gbf16* G; gbf16* MIX;
    __device__ __forceinline__ bool keep(const Unit& u) const { return u.seg != 2; }
    __device__ __forceinline__ void operator()(f32x4 (&acc)[2][2][4][2], const Unit& u, int wr, int wc, int fr, int fq) const {
        const int row0 = u.pm * BM + wr * 64 + fr, col0 = u.pn * BM + wc * 32 + 8 * fq; const int seg = u.seg;
#pragma unroll
        for (int ai = 0; ai < 2; ++ai)
#pragma unroll
            for (int m = 0; m < 4; ++m) {
                const int row = row0 + ai * HALF + m * 16; const gbf16* gp = G + (size_t)row * 12288 + seg * DM + col0;
#pragma unroll
                for (int bj = 0; bj < 2; ++bj) {
                    const u32x4 ga = *(const gu32x4*)(gp + bj * HALF);
                    float f[8] = {bf_lo(ga.x), bf_hi(ga.x), bf_lo(ga.y), bf_hi(ga.y), bf_lo(ga.z), bf_hi(ga.z), bf_lo(ga.w), bf_hi(ga.w)};
#pragma unroll
                    for (int j = 0; j < 8; ++j) f[j] = fmaxf(f[j], 1e-20f);
                    if (seg != 2) {
                        const u32x4 gb = *(const gu32x4*)(gp + DM + bj * HALF);
                        const float h[8] = {bf_lo(gb.x), bf_hi(gb.x), bf_lo(gb.y), bf_hi(gb.y), bf_lo(gb.z), bf_hi(gb.z), bf_lo(gb.w), bf_hi(gb.w)};
#pragma unroll
                        for (int j = 0; j < 8; ++j) f[j] = f[j] * __builtin_amdgcn_rcpf(fmaxf(h[j], 1e-20f));
                    }
                    f32x4 v0 = acc[ai][bj][m][0], v1 = acc[ai][bj][m][1];
                    v0 = v0 * (f32x4){f[0], f[1], f[2], f[3]}; v1 = v1 * (f32x4){f[4], f[5], f[6], f[7]};
                    if (seg != 2) { acc[ai][bj][m][0] = v0; acc[ai][bj][m][1] = v1; }
                    else { u32x4 w; w.x = cvt_pk_bf16(v0[0], v0[1]); w.y = cvt_pk_bf16(v0[2], v0[3]); w.z = cvt_pk_bf16(v1[0], v1[1]); w.w = cvt_pk_bf16(v1[2], v1[3]);
                        *(gu32x4*)(MIX + (size_t)row * DM + col0 + bj * HALF) = w; }
                }
                if (m == 3) asm volatile("" ::: "memory");
            }
    }
};
struct EpiSq {
    static constexpr bool PERM = true; static constexpr int NS = EPI_NS16;
    __device__ __forceinline__ bool relax(const Unit&) const { return true; }
    gbf16* O; gfloat* P;
    __device__ __forceinline__ bool keep(const Unit&) const { return false; }
    __device__ __forceinline__ void operator()(f32x4 (&acc)[2][2][4][2], const Unit& u, int wr, int wc, int fr, int fq) const {
        const int row0 = u.pm * BM + wr * 64 + fr, col0 = u.pn * BM + wc * 32 + 8 * fq;
#pragma unroll
        for (int ai = 0; ai < 2; ++ai)
#pragma unroll
            for (int m = 0; m < 4; ++m) {
                const int row = row0 + ai * HALF + m * 16; float q = 0.f;
#pragma unroll
                for (int bj = 0; bj < 2; ++bj) {
                    const f32x4 v0 = acc[ai][bj][m][0], v1 = acc[ai][bj][m][1];
                    q += (v0[0] * v0[0] + v0[1] * v0[1]) + (v0[2] * v0[2] + v0[3] * v0[3]) + (v1[0] * v1[0] + v1[1] * v1[1]) + (v1[2] * v1[2] + v1[3] * v1[3]);
                    u32x4 w; w.x = cvt_pk_bf16(v0[0], v0[1]); w.y = cvt_pk_bf16(v0[2], v0[3]); w.z = cvt_pk_bf16(v1[0], v1[1]); w.w = cvt_pk_bf16(v1[2], v1[3]);
                    if (O) *(gu32x4*)(O + (size_t)row * DM + col0 + bj * HALF) = w; else asm volatile("" :: "v"(w));
                }
                q += __shfl_xor(q, 16); q += __shfl_xor(q, 32);
                if (fq == 0) P[(size_t)row * 64 + u.pn * 4 + wc] = q;
            }
    }
};
struct EpiPle {
    static constexpr bool PERM = true; static constexpr int NS = EPI_NS32;
    __device__ __forceinline__ bool relax(const Unit&) const { return true; }
    const gfloat* XIN; gfloat* XOUT; gbf16* XB; const gbf16* OUT; const gbf16* ERAW; const gfloat* RSO; const gfloat* RSE; const gfloat* npost; const gfloat* pnorm; gfloat* SSQN; int last;
    __device__ __forceinline__ bool keep(const Unit&) const { return false; }
    __device__ __forceinline__ void operator()(f32x4 (&acc)[2][2][4][2], const Unit& u, int wr, int wc, int fr, int fq) const {
        const int row0 = u.pm * BM + wr * 64 + fr, col0 = u.pn * BM + wc * 32 + 8 * fq;
#pragma unroll
        for (int ai = 0; ai < 2; ++ai)
#pragma unroll
            for (int m = 0; m < 4; ++m) {
                const int row = row0 + ai * HALF + m * 16; const float rso = RSO[row], rse = RSE[row]; float q = 0.f; const size_t ro = (size_t)row * DM;
#pragma unroll
                for (int bj = 0; bj < 2; ++bj) {
                    const int col = col0 + bj * HALF;
                    const f32x4 xa = *(const gf32x4*)(XIN + ro + col), xb = *(const gf32x4*)(XIN + ro + col + 4); const u32x4 ob = *(const gu32x4*)(OUT + ro + col), eb = *(const gu32x4*)(ERAW + ro + col);
                    const f32x4 npa = *(const gf32x4*)(npost + col), npb = *(const gf32x4*)(npost + col + 4), pna = *(const gf32x4*)(pnorm + col), pnb = *(const gf32x4*)(pnorm + col + 4);
                    const float x[8] = {xa[0], xa[1], xa[2], xa[3], xb[0], xb[1], xb[2], xb[3]};
                    const float o[8] = {bf_lo(ob.x), bf_hi(ob.x), bf_lo(ob.y), bf_hi(ob.y), bf_lo(ob.z), bf_hi(ob.z), bf_lo(ob.w), bf_hi(ob.w)};
                    const float e8[8] = {bf_lo(eb.x), bf_hi(eb.x), bf_lo(eb.y), bf_hi(eb.y), bf_lo(eb.z), bf_hi(eb.z), bf_lo(eb.w), bf_hi(eb.w)};
                    const float np[8] = {npa[0], npa[1], npa[2], npa[3], npb[0], npb[1], npb[2], npb[3]}, pn[8] = {pna[0], pna[1], pna[2], pna[3], pnb[0], pnb[1], pnb[2], pnb[3]};
                    const f32x4 a0 = acc[ai][bj][m][0], a1 = acc[ai][bj][m][1]; const float a[8] = {a0[0], a0[1], a0[2], a0[3], a1[0], a1[1], a1[2], a1[3]};
                    float r[8];
#pragma unroll
                    for (int j = 0; j < 8; ++j) { const float x1 = x[j] + o[j] * rso * np[j]; r[j] = x1 + fsigmoid(a[j]) * (e8[j] * rse * pn[j]); q += r[j] * r[j]; }
                    *(gf32x4*)(XOUT + ro + col) = (f32x4){r[0], r[1], r[2], r[3]}; *(gf32x4*)(XOUT + ro + col + 4) = (f32x4){r[4], r[5], r[6], r[7]};
                    if (!last) { u32x4 w; w.x = cvt_pk_bf16(r[0], r[1]); w.y = cvt_pk_bf16(r[2], r[3]); w.z = cvt_pk_bf16(r[4], r[5]); w.w = cvt_pk_bf16(r[6], r[7]); *(gu32x4*)(XB + ro + col) = w; }
                }
                if (!last) { q += __shfl_xor(q, 16); q += __shfl_xor(q, 32); if (fq == 0) SSQN[(size_t)row * 64 + u.pn * 4 + wc] = q; }
                if (m & 1) asm volatile("" ::: "memory");
            }
    }
};
}

constexpr int LDS_BYTES = 147456;
constexpr int MISC_OFF = LDS_BYTES - 128;
constexpr int ARGS_OFF = LDS_BYTES - 512;
constexpr int NWAVES = 8, NTHREADS = 512;

struct Ctx {
    LAS unsigned char* lds; int tid, lane, wave, vcu, G, bx;
};

struct TrTile { const gfloat* W; const gfloat* kscale; gbf16* WT; int ldw, K; };
constexpr int TR_PER_LAYER = 3904 + 768 + 512 + 512 + 32;
__device__ __forceinline__ TrTile tr_decode(int it, const gfloat* w_in, const gfloat* norm_pre, const gfloat* w_branch, const gfloat* w_out, const gfloat* ple_gate, const gfloat* ple_proj, guchar* ws) {
    const int l = it / TR_PER_LAYER; int r = it - l * TR_PER_LAYER; TrTile t; int kt, ntile;
    if (r < 3904) { kt = r / 244; ntile = r - kt * 244; const int src = ntile < 116 ? ntile * 128 : ntile * 128 + 8;
        if (ntile < 16) ntile = 2 * ntile; else if (ntile < 32) ntile = ntile + 16; else if (ntile < 48) ntile = 2 * (ntile - 32) + 1;
        else if (ntile >= 116 && ntile < 132) ntile = 116 + 2 * (ntile - 116); else if (ntile >= 132 && ntile < 148) ntile = 116 + 2 * (ntile - 132) + 1;
        t.ldw = N_IN; t.K = DM; t.W = w_in + (size_t)l * DM * N_IN + (size_t)kt * 256 * N_IN + src; t.kscale = norm_pre + l * DM + kt * 256;
        t.WT = (gbf16*)(ws + WS_WIN + (size_t)l * SZ_WIN) + (size_t)ntile * 128 * DM + kt * 256; return t; }
    r -= 3904; t.kscale = nullptr; t.ldw = DM;
    if (r < 768) { const int j = r / 256; const int rr = r - j * 256; kt = rr / 32; ntile = rr - kt * 32; t.K = BW;
        t.W = w_branch + ((size_t)(l * 3 + j) * BW + (size_t)kt * 256) * DM + ntile * 128;
        t.WT = (gbf16*)(ws + WS_WBR + (size_t)l * SZ_WBR) + (size_t)j * DM * BW + (size_t)ntile * 128 * BW + kt * 256; return t; }
    r -= 768;
    if (r < 1024) { const int which = r / 512; const int rr = r - which * 512; kt = rr / 32; ntile = rr - kt * 32; t.K = DM;
        t.W = (which ? ple_gate : w_out) + ((size_t)l * DM + (size_t)kt * 256) * DM + ntile * 128;
        t.WT = (gbf16*)(ws + (which ? WS_WPG : WS_WOUT) + (size_t)l * SZ_WSQ) + (size_t)ntile * 128 * DM + kt * 256; return t; }
    r -= 1024; kt = r / 32; ntile = r - kt * 32; t.K = 256;
    t.W = ple_proj + ((size_t)l * 256 + (size_t)kt * 256) * DM + ntile * 128;
    t.WT = (gbf16*)(ws + WS_WPP + (size_t)l * SZ_WPP) + (size_t)ntile * 128 * 256 + kt * 256; return t;
}
#ifndef TR_REVERSE
#define TR_REVERSE 1
#endif
__device__ __forceinline__ void tr_run(const Ctx& F, int it0, int it1, int sk0, int sk1, int me, int nw, const gfloat* w_in, const gfloat* norm_pre, const gfloat* w_branch,
                                       const gfloat* w_out, const gfloat* ple_gate, const gfloat* ple_proj, guchar* ws) {
    int tid = F.tid; LAUNDER_V(tid);
    {
        constexpr int RS = 264; const int NIT = it1 - it0 - (sk1 - sk0);
        const int c4 = tid & 31, kr = tid >> 5, kc = tid & 15;
        f32x4 va[16], vb[16]; float ka[16], kb[16]; TrTile ta, tb;
#define TR_LOAD(T_, V_, K_, IT_) do { const int ir_ = TR_REVERSE ? (NIT - 1 - (IT_)) : (IT_); T_ = tr_decode(it0 + ir_ + (((it0 + ir_) >= sk0) ? (sk1 - sk0) : 0), w_in, norm_pre, w_branch, w_out, ple_gate, ple_proj, ws); \
        _Pragma("unroll") for (int i = 0; i < 16; ++i) { V_[i] = *(const gf32x4*)(T_.W + (size_t)(i * 16 + kr) * T_.ldw + 4 * c4); K_[i] = T_.kscale ? T_.kscale[i * 16 + kr] : 1.0f; } } while (0)
#define TR_PUT(V_, K_) do { _Pragma("unroll") for (int i = 0; i < 16; ++i) { const f32x4 a = V_[i] * K_[i]; u32x2 w; w.x = cvt_pk_bf16(a[0], a[1]); w.y = cvt_pk_bf16(a[2], a[3]); \
        *(LAS u32x2*)(F.lds + (i * 16 + kr) * RS + c4 * 8) = w; } } while (0)
#define TR_GET(WT_, K_) do { _Pragma("unroll") for (int q = 0; q < 4; ++q) _Pragma("unroll") for (int hh = 0; hh < 2; ++hh) { const int n = 32 * q + (tid >> 4), kq = kc + 16 * hh; \
        const LAS bf16_t* s = (const LAS bf16_t*)(F.lds + (8 * kq) * RS + 2 * n); unsigned e[8]; \
        _Pragma("unroll") for (int j = 0; j < 8; ++j) e[j] = s[j * (RS / 2)]; \
        u32x4 o; o.x = e[0] | (e[1] << 16); o.y = e[2] | (e[3] << 16); o.z = e[4] | (e[5] << 16); o.w = e[6] | (e[7] << 16); \
        *(gu32x4*)(WT_ + (size_t)n * K_ + 8 * kq) = o; } } while (0)
        int it = me;
        if (it < NIT) TR_LOAD(ta, va, ka, it);
        if (it + nw < NIT) TR_LOAD(tb, vb, kb, it + nw);
        while (it < NIT) {
            { TR_PUT(va, ka); __syncthreads(); gbf16* wt = ta.WT; const int kk = ta.K;
              if (it + 2 * nw < NIT) TR_LOAD(ta, va, ka, it + 2 * nw);
              TR_GET(wt, kk); __syncthreads(); }
            it += nw; if (it >= NIT) break;
            { TR_PUT(vb, kb); __syncthreads(); gbf16* wt = tb.WT; const int kk = tb.K;
              if (it + 2 * nw < NIT) TR_LOAD(tb, vb, kb, it + 2 * nw);
              TR_GET(wt, kk); __syncthreads(); }
            it += nw;
        }
#undef TR_LOAD
#undef TR_PUT
#undef TR_GET
    }
}
#ifndef TR_NODEFER
#define TR_NODEFER 0
#endif
constexpr int TR_DEFER0 = TR_PER_LAYER + 3904 + 768, TR_DEFER1 = TR_DEFER0 + (TR_NODEFER ? 0 : 1024);
__device__ __forceinline__ void p0_prologue(const Ctx& F, const gfloat* x, const gfloat* p, const gint* positions, const gfloat* norm_pre, const gfloat* w_in, const gfloat* w_branch,
                                            const gfloat* w_out, const gfloat* ple_gate, const gfloat* ple_proj, guchar* ws) {
    int tid = F.tid; LAUNDER_V(tid);
    tr_run(F, 0, NLAYER * TR_PER_LAYER, TR_DEFER0, TR_DEFER1, F.vcu, F.G, w_in, norm_pre, w_branch, w_out, ple_gate, ple_proj, ws);
    const int gt = F.vcu * NTHREADS + tid, NGT = F.G * NTHREADS;
    for (int i = gt; i < NLAYER * 256 * DM; i += NGT) { const int l = i / (256 * DM), rr = (i / DM) & 255, k = i & (DM - 1);
        float val = 0.f; if (rr < 8) val = w_in[(size_t)l * DM * N_IN + (size_t)k * N_IN + IF_COL + rr] * norm_pre[l * DM + k];
        ((gbf16*)(ws + WS_WIN + (size_t)l * SZ_WIN))[(size_t)(122 * 256 + rr) * DM + k] = (bf16_t)(cvt_pk_bf16(val, 0.f) & 0xffffu); }
    for (int i = gt; i < NLAYER * M_ROWS * 256 / 4; i += NGT) { const f32x4 a = ((const gf32x4*)p)[i]; u32x2 w; w.x = cvt_pk_bf16(a[0], a[1]); w.y = cvt_pk_bf16(a[2], a[3]); ((gu32x2*)(ws + WS_PB))[i] = w; }
    for (int i = gt; i < M_ROWS * 8; i += NGT) { const int row = i >> 3, j = i & 7; const float inv = powf(500000.0f, -(float)j * 0.125f); const float ang = (float)positions[row] * inv;
        gfloat* cs = (gfloat*)(ws + WS_CS) + (size_t)row * 16; cs[j] = cosf(ang); cs[8 + j] = sinf(ang); }
    { const int gw = F.vcu * NWAVES + F.wave, NGW = F.G * NWAVES;
      for (int m = gw; m < M_ROWS; m += NGW) { const gf32x4* xr = (const gf32x4*)(x + (size_t)m * DM) + F.lane; gu32x2* o = (gu32x2*)(ws + WS_XB + (size_t)m * DM * 2) + F.lane; float s = 0.f;
#pragma unroll
          for (int j = 0; j < 16; ++j) { const f32x4 a = xr[64 * j]; s += (a[0] * a[0] + a[1] * a[1]) + (a[2] * a[2] + a[3] * a[3]); u32x2 w; w.x = cvt_pk_bf16(a[0], a[1]); w.y = cvt_pk_bf16(a[2], a[3]); o[64 * j] = w; }
          s = wave_sum(s); if (F.lane == 0) ((gfloat*)(ws + WS_SSQ0))[m] = s; } }
}

__device__ __forceinline__ u32x2 pack4(const f32x4 v) { u32x2 w; w.x = cvt_pk_bf16(v[0], v[1]); w.y = cvt_pk_bf16(v[2], v[3]); return w; }
__device__ __forceinline__ bf16x8 mk_frag(const u32x2 lo, const u32x2 hi) { const u32x4 t = {lo.x, lo.y, hi.x, hi.y}; return __builtin_bit_cast(bf16x8, t); }
__device__ __forceinline__ bf16x8 frag_const(unsigned w) { const u32x4 t = {w, w, w, w}; return __builtin_bit_cast(bf16x8, t); }

constexpr int GM_WL = 0, GM_VT = 34816, GM_ST = 104448, GM_RS = 272;
__device__ __forceinline__ void gmlp_unit(const Ctx& F, int b, int n, int g, guchar* ws, const gfloat* ln_g, const gfloat* ln_b, const gfloat* wsp, const gfloat* bsp) {
    int tid = F.tid; LAUNDER_V(tid); const int lane = tid & 63, w = F.wave, r16 = lane & 15, q4 = lane >> 4;
    const int row0 = b * SEQ + n * 128, c0 = g * 256;
    const gbf16* AU = (const gbf16*)(ws + WS_AU); const gbf16* AV = (const gbf16*)(ws + WS_AV); const gbf16* AZ = (const gbf16*)(ws + WS_AZ); gbf16* YA = (gbf16*)(ws + WS_YA);
    if (tid < 128) { const gf32x2* pp = (const gf32x2*)(ws + WS_LNP) + (size_t)(row0 + tid) * 32; float s = 0.f, q = 0.f;
#pragma unroll 8
        for (int j = 0; j < 32; ++j) { const f32x2 t = pp[j]; s += t.x; q += t.y; }
        const float mu = s * (1.0f / BW); const float var = fmaxf(q * (1.0f / BW) - mu * mu, 0.f);
        *(LAS f32x2*)(F.lds + GM_ST + tid * 8) = (f32x2){mu, rsqrtf(var + NORM_EPS)}; }
#pragma unroll
    for (int k = 0; k < 8; ++k) { const int item = tid + 512 * k, t = item >> 5, ch = item & 31;
        f32x4 a = *(const gf32x4*)(wsp + ((size_t)(g * 128 + t)) * 128 + 4 * ch);
#pragma unroll
        for (int e = 0; e < 4; ++e) if (4 * ch + e > t) a[e] = 0.f;
        *(LAS u32x2*)(F.lds + GM_WL + t * GM_RS + ch * 8) = pack4(a); }
    __syncthreads();
#pragma unroll
    for (int k = 0; k < 8; ++k) { const int item = tid + 512 * k, s = item & 127, ch = item >> 7;
        const u32x4 raw = *(const gu32x4*)(AV + (size_t)(row0 + s) * BW + c0 + 8 * ch);
        const f32x4 g0 = *(const gf32x4*)(ln_g + c0 + 8 * ch), g1 = *(const gf32x4*)(ln_g + c0 + 8 * ch + 4), b0 = *(const gf32x4*)(ln_b + c0 + 8 * ch), b1 = *(const gf32x4*)(ln_b + c0 + 8 * ch + 4);
        const f32x2 st = *(const LAS f32x2*)(F.lds + GM_ST + s * 8);
        const float xv[8] = {bf_lo(raw.x), bf_hi(raw.x), bf_lo(raw.y), bf_hi(raw.y), bf_lo(raw.z), bf_hi(raw.z), bf_lo(raw.w), bf_hi(raw.w)};
        const float gg[8] = {g0[0], g0[1], g0[2], g0[3], g1[0], g1[1], g1[2], g1[3]}, bb[8] = {b0[0], b0[1], b0[2], b0[3], b1[0], b1[1], b1[2], b1[3]};
#pragma unroll
        for (int i = 0; i < 8; ++i) { const float y = (xv[i] - st.x) * st.y * gg[i] + bb[i];
            *(LAS bf16_t*)(F.lds + GM_VT + (8 * ch + i) * GM_RS + 2 * s) = (bf16_t)(cvt_pk_bf16(y, 0.f) & 0xffffu); } }
    __syncthreads();
    f32x4 acc[2][8];
#pragma unroll
    for (int m = 0; m < 2; ++m)
#pragma unroll
        for (int n8 = 0; n8 < 8; ++n8) acc[m][n8] = (f32x4){0.f, 0.f, 0.f, 0.f};
    bf16x8 af[2][4];
#pragma unroll
    for (int m = 0; m < 2; ++m)
#pragma unroll
        for (int ks = 0; ks < 4; ++ks) af[m][ks] = *(const LAS bf16x8*)(F.lds + GM_VT + (32 * w + 8 * (r16 >> 2) + 4 * m + (r16 & 3)) * GM_RS + ks * 64 + q4 * 16);
#pragma unroll
    for (int n8 = 0; n8 < 8; ++n8)
#pragma unroll
        for (int ks = 0; ks < 4; ++ks) if (ks <= n8 / 2) {
            const bf16x8 bfr = *(const LAS bf16x8*)(F.lds + GM_WL + (16 * n8 + r16) * GM_RS + ks * 64 + q4 * 16);
#pragma unroll
            for (int m = 0; m < 2; ++m) acc[m][n8] = MFMA16(af[m][ks], bfr, acc[m][n8]); }
#pragma unroll
    for (int n8 = 0; n8 < 8; ++n8) { const int t = 16 * n8 + r16; const float bsv = bsp[g * 128 + t]; const size_t ro = (size_t)(row0 + t) * BW + c0 + 32 * w + 8 * q4;
        const u32x4 ub = *(const gu32x4*)(AU + ro); const f32x4 a0 = acc[0][n8] + bsv, a1 = acc[1][n8] + bsv; u32x4 y;
        y.x = cvt_pk_bf16(a0[0] * bf_lo(ub.x), a0[1] * bf_hi(ub.x)); y.y = cvt_pk_bf16(a0[2] * bf_lo(ub.y), a0[3] * bf_hi(ub.y));
        y.z = cvt_pk_bf16(a1[0] * bf_lo(ub.z), a1[1] * bf_hi(ub.z)); y.w = cvt_pk_bf16(a1[2] * bf_lo(ub.w), a1[3] * bf_hi(ub.w));
        *(gu32x4*)(YA + ro) = y; }
    __syncthreads();
}

constexpr int SW_KL = 0, SW_VT = 36864, SW_QL = 70656, SW_QL2 = 89088, SW_RS = 144, SW_VS = 528;
__device__ __forceinline__ void rope8(const u32x4 a, const u32x4 bq, const gfloat* cs, float scale, u32x4& o1, u32x4& o2) {
    const f32x4 c0 = *(const gf32x4*)cs, c1 = *(const gf32x4*)(cs + 4), s0 = *(const gf32x4*)(cs + 8), s1 = *(const gf32x4*)(cs + 12);
    const float t1[8] = {bf_lo(a.x), bf_hi(a.x), bf_lo(a.y), bf_hi(a.y), bf_lo(a.z), bf_hi(a.z), bf_lo(a.w), bf_hi(a.w)};
    const float t2[8] = {bf_lo(bq.x), bf_hi(bq.x), bf_lo(bq.y), bf_hi(bq.y), bf_lo(bq.z), bf_hi(bq.z), bf_lo(bq.w), bf_hi(bq.w)};
    const float cc[8] = {c0[0], c0[1], c0[2], c0[3], c1[0], c1[1], c1[2], c1[3]}, ss[8] = {s0[0], s0[1], s0[2], s0[3], s1[0], s1[1], s1[2], s1[3]};
    float r1[8], r2[8];
#pragma unroll
    for (int i = 0; i < 8; ++i) { r1[i] = (t1[i] * cc[i] - t2[i] * ss[i]) * scale; r2[i] = (t2[i] * cc[i] + t1[i] * ss[i]) * scale; }
    o1 = (u32x4){cvt_pk_bf16(r1[0], r1[1]), cvt_pk_bf16(r1[2], r1[3]), cvt_pk_bf16(r1[4], r1[5]), cvt_pk_bf16(r1[6], r1[7])};
    o2 = (u32x4){cvt_pk_bf16(r2[0], r2[1]), cvt_pk_bf16(r2[2], r2[3]), cvt_pk_bf16(r2[4], r2[5]), cvt_pk_bf16(r2[6], r2[7])};
}
__device__ __forceinline__ u32x4 scale8(const u32x4 a, float sc) {
    return (u32x4){cvt_pk_bf16(bf_lo(a.x) * sc, bf_hi(a.x) * sc), cvt_pk_bf16(bf_lo(a.y) * sc, bf_hi(a.y) * sc), cvt_pk_bf16(bf_lo(a.z) * sc, bf_hi(a.z) * sc), cvt_pk_bf16(bf_lo(a.w) * sc, bf_hi(a.w) * sc)};
}
__device__ __forceinline__ void swa_unit(const Ctx& F, int b, int n, int hk, guchar* ws, const gfloat* sinks) {
    int tid = F.tid; LAUNDER_V(tid); const int lane = tid & 63, w = F.wave, r16 = lane & 15, q4 = lane >> 4;
    const int r0 = b * SEQ + n * 128, kr0 = r0 - 128;
    const gbf16* BQ = (const gbf16*)(ws + WS_BQ); const gbf16* BK = (const gbf16*)(ws + WS_BK); const gbf16* BV = (const gbf16*)(ws + WS_BV); const gbf16* BZ = (const gbf16*)(ws + WS_BZ);
    gbf16* YB = (gbf16*)(ws + WS_YA) + (size_t)M_ROWS * BW; const gfloat* CS = (const gfloat*)(ws + WS_CS);
#pragma unroll
    for (int k = 0; k < 4; ++k) { const int item = tid + 512 * k, key = item >> 3, ch = item & 7; const bool pad = (n == 0 && key < 128);
        if (ch == 1) continue;
        const gbf16* src = BK + (size_t)(kr0 + key) * 256 + hk * 64;
        LAS unsigned char* dst = F.lds + SW_KL + key * SW_RS;
        if (pad) { *(LAS u32x4*)(dst + ch * 16) = (u32x4){0u, 0u, 0u, 0u}; if (ch == 0) *(LAS u32x4*)(dst + 16) = (u32x4){0u, 0u, 0u, 0u}; }
        else if (ch == 0) { u32x4 o1, o2; rope8(*(const gu32x4*)src, *(const gu32x4*)(src + 8), CS + (size_t)(kr0 + key) * 16, 1.0f, o1, o2); *(LAS u32x4*)dst = o1; *(LAS u32x4*)(dst + 16) = o2; }
        else *(LAS u32x4*)(dst + ch * 16) = *(const gu32x4*)(src + 8 * ch); }
#pragma unroll
    for (int k = 0; k < 4; ++k) { const int item = tid + 512 * k, key = item & 255, ch = item >> 8; const bool pad = (n == 0 && key < 128);
        u32x4 raw = {0u, 0u, 0u, 0u}; if (!pad) raw = *(const gu32x4*)(BV + (size_t)(kr0 + key) * 256 + hk * 64 + 8 * ch);
        const unsigned e[4] = {raw.x, raw.y, raw.z, raw.w};
#pragma unroll
        for (int i = 0; i < 8; ++i) *(LAS bf16_t*)(F.lds + SW_VT + (8 * ch + i) * SW_VS + 2 * key) = (bf16_t)((e[i >> 1] >> ((i & 1) * 16)) & 0xffffu); }
    u32x4 qa[2], qb[2];
#define SW_QLOAD(hq_) do { _Pragma("unroll") for (int k_ = 0; k_ < 2; ++k_) { const int it_ = tid + 512 * k_, qr_ = it_ >> 3, ch_ = it_ & 7; const gbf16* src_ = BQ + (size_t)(r0 + qr_) * BW + (hq_) * 64; \
        qa[k_] = (u32x4){0u, 0u, 0u, 0u}; qb[k_] = (u32x4){0u, 0u, 0u, 0u}; \
        if (ch_ == 0) { qa[k_] = *(const gu32x4*)src_; qb[k_] = *(const gu32x4*)(src_ + 8); } else if (ch_ != 1) qa[k_] = *(const gu32x4*)(src_ + 8 * ch_); } } while (0)
#define SW_QWRITE(buf_) do { _Pragma("unroll") for (int k_ = 0; k_ < 2; ++k_) { const int it_ = tid + 512 * k_, qr_ = it_ >> 3, ch_ = it_ & 7; LAS unsigned char* dst_ = F.lds + (buf_) + qr_ * SW_RS; \
        if (ch_ == 0) { u32x4 o1_, o2_; rope8(qa[k_], qb[k_], CS + (size_t)(r0 + qr_) * 16, 0.125f, o1_, o2_); *(LAS u32x4*)dst_ = o1_; *(LAS u32x4*)(dst_ + 16) = o2_; } \
        else if (ch_ != 1) *(LAS u32x4*)(dst_ + ch_ * 16) = scale8(qa[k_], 0.125f); } } while (0)
    SW_QLOAD(hk * 8); SW_QWRITE(SW_QL);
    __syncthreads();
    for (int hi = 0; hi < 8; ++hi) {
        const int hq = hk * 8 + hi; const int qcur = (hi & 1) ? SW_QL2 : SW_QL, qnxt = (hi & 1) ? SW_QL : SW_QL2;
        if (hi < 7) SW_QLOAD(hq + 1);
        bf16x8 bq[2];
#pragma unroll
        for (int ks = 0; ks < 2; ++ks) bq[ks] = *(const LAS bf16x8*)(F.lds + qcur + (16 * w + r16) * SW_RS + ks * 64 + q4 * 16);
        f32x4 s[10];
#pragma unroll
        for (int j = 0; j < 9; ++j) { s[j] = (f32x4){0.f, 0.f, 0.f, 0.f};
#pragma unroll
            for (int ks = 0; ks < 2; ++ks) { const bf16x8 a = *(const LAS bf16x8*)(F.lds + SW_KL + (16 * (w + j) + r16) * SW_RS + ks * 64 + q4 * 16); s[j] = MFMA16(a, bq[ks], s[j]); } }
        s[9] = (f32x4){0.f, 0.f, 0.f, 0.f};
        const int qi = 16 * w + r16; const float sink = sinks[hq]; float mx = sink;
#pragma unroll
        for (int j = 0; j < 9; ++j)
#pragma unroll
            for (int e = 0; e < 4; ++e) { const int kj = 16 * (w + j) + 4 * q4 + e; const bool valid = (kj > qi) && (kj <= qi + 128) && (n > 0 || kj >= 128);
                s[j][e] = valid ? s[j][e] : -1e30f; mx = fmaxf(mx, s[j][e]); }
        mx = fmaxf(mx, __shfl_xor(mx, 16)); mx = fmaxf(mx, __shfl_xor(mx, 32));
        float sum = 0.f;
#pragma unroll
        for (int j = 0; j < 9; ++j)
#pragma unroll
            for (int e = 0; e < 4; ++e) { const float pv = (s[j][e] > -1e29f) ? __expf(s[j][e] - mx) : 0.f; s[j][e] = pv; sum += pv; }
        sum += __shfl_xor(sum, 16); sum += __shfl_xor(sum, 32); sum += __expf(sink - mx);
        const float inv = 1.0f / sum;
        f32x4 o[4];
#pragma unroll
        for (int dt = 0; dt < 4; ++dt) o[dt] = (f32x4){0.f, 0.f, 0.f, 0.f};
#pragma unroll
        for (int kk = 0; kk < 5; ++kk) { const bf16x8 pf = mk_frag(pack4(s[2 * kk]), pack4(s[2 * kk + 1]));
            const int t0 = w + 2 * kk, t1 = (w + 2 * kk + 1) > 15 ? 15 : (w + 2 * kk + 1);
#pragma unroll
            for (int dt = 0; dt < 4; ++dt) { const LAS unsigned char* vrow = F.lds + SW_VT + (32 * (dt >> 1) + 8 * (r16 >> 2) + 4 * (dt & 1) + (r16 & 3)) * SW_VS + (4 * q4) * 2;
                const bf16x8 a = mk_frag(*(const LAS u32x2*)(vrow + 32 * t0), *(const LAS u32x2*)(vrow + 32 * t1)); o[dt] = MFMA16(a, pf, o[dt]); } }
        const size_t ro = (size_t)(r0 + qi) * BW + hq * 64 + 8 * q4;
#pragma unroll
        for (int pp = 0; pp < 2; ++pp) { const u32x4 zb = *(const gu32x4*)(BZ + ro + 32 * pp); const f32x4 oa = o[2 * pp] * inv, ob2 = o[2 * pp + 1] * inv; u32x4 y;
            y.x = cvt_pk_bf16(oa[0] * bf_lo(zb.x), oa[1] * bf_hi(zb.x)); y.y = cvt_pk_bf16(oa[2] * bf_lo(zb.y), oa[3] * bf_hi(zb.y));
            y.z = cvt_pk_bf16(ob2[0] * bf_lo(zb.z), ob2[1] * bf_hi(zb.z)); y.w = cvt_pk_bf16(ob2[2] * bf_lo(zb.w), ob2[3] * bf_hi(zb.w));
            *(gu32x4*)(YB + ro + 32 * pp) = y; }
        if (hi < 7) SW_QWRITE(qnxt);
        __syncthreads();
    }
#undef SW_QLOAD
#undef SW_QWRITE
}

#ifndef ML_R1A
#define ML_R1A 1
#endif
#ifndef ML_R1B
#define ML_R1B 1
#endif
#ifndef ML_RWR
#define ML_RWR 1
#endif
constexpr int ML_QL = 0, ML_KA = 33792, ML_KB = 67584, ML_VT = 101376, ML_VW = 105984, ML_VW2 = 110736, ML_CT = 115488, ML_X = 132912, ML_GATE = 142128, ML_GSZ = 1344, ML_RS = 528, ML_TS = 144;
static_assert(ML_GATE + 2 * ML_GSZ <= ARGS_OFF, "mLSTM LDS map");
typedef short s16x4 __attribute__((ext_vector_type(4)));
__device__ __forceinline__ bf16x8 tr_frag8(const LAS unsigned char* img, int rs, int row0, int col0, int r16) {
    const LAS unsigned char* p0 = img + (row0 + (r16 >> 2)) * rs + (col0 + 4 * (r16 & 3)) * 2;
    const s16x4 a = __builtin_amdgcn_ds_read_tr16_b64_v4i16((LAS s16x4*)p0);
    const s16x4 b = __builtin_amdgcn_ds_read_tr16_b64_v4i16((LAS s16x4*)(p0 + 4 * rs));
    return __builtin_shufflevector(a, b, 0, 1, 2, 3, 4, 5, 6, 7);
}
__device__ __forceinline__ float dpp_shr(float v, float ident, int n) {
    const int r = n == 1 ? __builtin_amdgcn_update_dpp(__float_as_int(ident), __float_as_int(v), 0x111, 0xf, 0xf, false)
                : n == 2 ? __builtin_amdgcn_update_dpp(__float_as_int(ident), __float_as_int(v), 0x112, 0xf, 0xf, false)
                : n == 4 ? __builtin_amdgcn_update_dpp(__float_as_int(ident), __float_as_int(v), 0x114, 0xf, 0xf, false)
                         : __builtin_amdgcn_update_dpp(__float_as_int(ident), __float_as_int(v), 0x118, 0xf, 0xf, false);
    return __int_as_float(r);
}
__device__ __forceinline__ float wave_scan_add(float v, int lane) {
    v += dpp_shr(v, 0.f, 1); v += dpp_shr(v, 0.f, 2); v += dpp_shr(v, 0.f, 4); v += dpp_shr(v, 0.f, 8);
    const float t0 = __int_as_float(__builtin_amdgcn_readlane(__float_as_int(v), 15)), t1 = __int_as_float(__builtin_amdgcn_readlane(__float_as_int(v), 31)), t2 = __int_as_float(__builtin_amdgcn_readlane(__float_as_int(v), 47));
    const int row = lane >> 4; const float add = row == 0 ? 0.f : (row == 1 ? t0 : (row == 2 ? t0 + t1 : (t0 + t1) + t2));
    return v + add;
}
__device__ __forceinline__ float wave_scan_max(float v, int lane) {
    const float NI = -3.0e38f;
    v = fmaxf(v, dpp_shr(v, NI, 1)); v = fmaxf(v, dpp_shr(v, NI, 2)); v = fmaxf(v, dpp_shr(v, NI, 4)); v = fmaxf(v, dpp_shr(v, NI, 8));
    const float t0 = __int_as_float(__builtin_amdgcn_readlane(__float_as_int(v), 15)), t1 = __int_as_float(__builtin_amdgcn_readlane(__float_as_int(v), 31)), t2 = __int_as_float(__builtin_amdgcn_readlane(__float_as_int(v), 47));
    const int row = lane >> 4; const float mx = row == 0 ? NI : (row == 1 ? t0 : (row == 2 ? fmaxf(t0, t1) : fmaxf(fmaxf(t0, t1), t2)));
    return fmaxf(v, mx);
}
__device__ __forceinline__ float softcap15(float z) { const float e = __expf(z * (2.0f / 15.0f)); return 15.0f * (1.0f - 2.0f * __builtin_amdgcn_rcpf(e + 1.0f)); }
__device__ __forceinline__ void mlstm_unit(const Ctx& F, int b, int h, int sl, guchar* ws, const gfloat* ibp, const gfloat* fbp, const gfloat* norm_g) {
    int tid = F.tid; LAUNDER_V(tid); const int lane = tid & 63, w = F.wave, r16 = lane & 15, q4 = lane >> 4;
    const gbf16* CQ = (const gbf16*)(ws + WS_CQ) + h * 256; const gbf16* CK = (const gbf16*)(ws + WS_CK) + h * 256; const gbf16* CV = (const gbf16*)(ws + WS_CV) + h * 512 + sl * 32;
    const gbf16* CO = (const gbf16*)(ws + WS_CO) + h * 512 + sl * 32; const gbf16* CZ = (const gbf16*)(ws + WS_CZ) + h * 512 + sl * 32;
    const gfloat* IFB = (const gfloat*)(ws + WS_IF);
    gbf16* NUM = (gbf16*)(ws + WS_NUM) + h * 512 + sl * 32; gfloat* SSQC = (gfloat*)(ws + WS_SSQC); gfloat* DNB = (gfloat*)(ws + WS_DN);
    const int rowb = b * SEQ;
    const bf16x8 ones = frag_const(0x3f803f80u), zeros = frag_const(0u);
    for (int i = tid; i < 33 * ML_RS / 16; i += NTHREADS) *(LAS u32x4*)(F.lds + ML_CT + i * 16) = (u32x4){0u, 0u, 0u, 0u};
    f32x4 st[2][3];
#pragma unroll
    for (int i = 0; i < 2; ++i)
#pragma unroll
        for (int dt = 0; dt < 3; ++dt) st[i][dt] = (f32x4){0.f, 0.f, 0.f, 0.f};
    float m_prev = 0.f;
    const float ibv = ibp[h], fbv = fbp[h];
    const f32x4 ng0 = *(const gf32x4*)(norm_g + h * 512 + sl * 32 + 4 * q4), ng1 = *(const gf32x4*)(norm_g + h * 512 + sl * 32 + 16 + 4 * q4);
    u32x4 qra[4], kra[4], vra; float gi = 0.f, gf = 0.f;
#define ML_LOAD(c, Q_, K_, V_) do { const int rc_ = rowb + (c) * 64; _Pragma("unroll") for (int k_ = 0; k_ < 4; ++k_) { const int it_ = tid + 512 * k_, s_ = it_ >> 5, ch_ = it_ & 31; \
        Q_[k_] = *(const gu32x4*)(CQ + (size_t)(rc_ + s_) * 1024 + 8 * ch_); K_[k_] = *(const gu32x4*)(CK + (size_t)(rc_ + s_) * 1024 + 8 * ch_); } \
        V_ = *(const gu32x4*)(CV + (size_t)(rc_ + ((tid & 255) >> 2)) * BW + 8 * (tid & 3)); } while (0)
#define ML_GLOAD(c) do { const int r_ = rowb + (c) * 64 + lane; gi = IFB[(size_t)r_ * 8 + h]; gf = IFB[(size_t)r_ * 8 + 4 + h]; } while (0)
#define ML_GPREP(par) do { if (w == 7) { const float ig_ = softcap15(gi + ibv); const float z_ = softcap15(gf + fbv); \
        const float lf_ = -(fmaxf(-z_, 0.f) + log1pf(__expf(-fabsf(z_)))); const float bc_ = wave_scan_add(lf_, lane); const float u_ = ig_ - bc_; const float pm_ = wave_scan_max(u_, lane); \
        const float Mv_ = fmaxf(m_prev, pm_); const float M63_ = __int_as_float(__builtin_amdgcn_readlane(__float_as_int(Mv_), 63)); const float g_ = __int_as_float(__builtin_amdgcn_readlane(__float_as_int(bc_), 63)); \
        LAS float* gp_ = (LAS float*)(F.lds + ML_GATE + (par) * ML_GSZ); gp_[lane] = u_; gp_[64 + lane] = Mv_; gp_[128 + lane] = __expf(m_prev - Mv_); gp_[192 + lane] = __expf(-(bc_ + Mv_)); \
        gp_[256 + lane] = __expf(u_ - M63_); if (lane == 0) gp_[320] = __expf(m_prev - M63_); m_prev = g_ + M63_; } } while (0)
#define ML_WRITE(kb_, vw_, gpn_, Q_, K_, V_) do { _Pragma("unroll") for (int k_ = 0; k_ < 4; ++k_) { const int it_ = tid + 512 * k_, s_ = it_ >> 5, ch_ = it_ & 31; \
        *(LAS u32x4*)(F.lds + ML_QL + s_ * ML_RS + ch_ * 16) = Q_[k_]; *(LAS u32x4*)(F.lds + (kb_) + s_ * ML_RS + ch_ * 16) = K_[k_]; } \
        if (tid < 256) { const int s_ = tid >> 2, ch_ = tid & 3; const unsigned e_[4] = {V_.x, V_.y, V_.z, V_.w}; const float ws_ = (gpn_)[256 + s_]; \
            _Pragma("unroll") for (int i_ = 0; i_ < 8; ++i_) { const unsigned hv_ = (e_[i_ >> 1] >> ((i_ & 1) * 16)) & 0xffffu; \
                *(LAS bf16_t*)(F.lds + ML_VT + (8 * ch_ + i_) * ML_TS + 2 * s_) = (bf16_t)hv_; \
                *(LAS bf16_t*)(F.lds + (vw_) + (8 * ch_ + i_) * ML_TS + 2 * s_) = (bf16_t)(cvt_pk_bf16(__uint_as_float(hv_ << 16) * ws_, 0.f) & 0xffffu); } \
            if (ch_ == 0) *(LAS bf16_t*)(F.lds + (vw_) + 32 * ML_TS + 2 * s_) = (bf16_t)(cvt_pk_bf16(ws_, 0.f) & 0xffffu); } } while (0)
    ML_LOAD(0, qra, kra, vra); ML_GLOAD(0);
    ML_GPREP(0);
    ML_GLOAD(1);
    __syncthreads();
    ML_WRITE(ML_KA, ML_VW, ((const LAS float*)(F.lds + ML_GATE)), qra, kra, vra);
    __syncthreads();
#define ML_STEP(c, LQ_, LK_, LV_, WQ_, WK_, WV_) do { \
        const int par = c & 1; const LAS float* gp = (const LAS float*)(F.lds + ML_GATE + par * ML_GSZ); \
        const int vt = ML_VT, kb = par ? ML_KB : ML_KA, kbn = par ? ML_KA : ML_KB, vw = par ? ML_VW2 : ML_VW, vwn = par ? ML_VW : ML_VW2; \
        const LAS float* gpn = (const LAS float*)(F.lds + ML_GATE + (par ^ 1) * ML_GSZ); \
        const int rowc = rowb + c * 64; \
        const size_t rog_ = (size_t)(rowc + 16 * (w & 3) + r16) * BW + 4 * q4; \
        const u32x2 ob0 = *(const gu32x2*)(CO + rog_), ob1 = *(const gu32x2*)(CO + rog_ + 16); \
        ML_LOAD((c + 1 < 32 ? c + 1 : 31), LQ_, LK_, LV_); if (c + 1 < 32) ML_GPREP(par ^ 1); ML_GLOAD((c + 2 < 32 ? c + 2 : 31)); \
        f32x4 oacc[3]; \
        for (int rp_ = 0; rp_ < ML_R1B; ++rp_) { \
        _Pragma("unroll") \
        for (int dt = 0; dt < 3; ++dt) oacc[dt] = (f32x4){0.f, 0.f, 0.f, 0.f}; \
        if (w < 4) { \
            const int T = w; \
            bf16x8 bq[8]; \
        _Pragma("unroll") \
            for (int ks = 0; ks < 8; ++ks) bq[ks] = *(const LAS bf16x8*)(F.lds + ML_QL + (16 * T + r16) * ML_RS + ks * 64 + q4 * 16); \
            f32x4 sa[4]; \
        _Pragma("unroll") \
            for (int s4 = 0; s4 < 4; ++s4) { sa[s4] = (f32x4){0.f, 0.f, 0.f, 0.f}; \
                if (s4 <= T) { \
        _Pragma("unroll") \
                    for (int ks = 0; ks < 8; ++ks) { const bf16x8 a = *(const LAS bf16x8*)(F.lds + kb + (16 * s4 + r16) * ML_RS + ks * 64 + q4 * 16); sa[s4] = MFMA16(a, bq[ks], sa[s4]); } } } \
            const int tl = 16 * T + r16; const float Mt = gp[64 + tl]; \
        _Pragma("unroll") \
            for (int s4 = 0; s4 < 4; ++s4) { const f32x4 uu = *(const LAS f32x4*)(gp + 16 * s4 + 4 * q4); \
        _Pragma("unroll") \
                for (int e = 0; e < 4; ++e) { const int sl_ = 16 * s4 + 4 * q4 + e; sa[s4][e] = (sl_ <= tl) ? sa[s4][e] * __expf(uu[e] - Mt) : 0.f; } } \
        _Pragma("unroll") \
            for (int kk = 0; kk < 2; ++kk) { const bf16x8 pf = mk_frag(pack4(sa[2 * kk]), pack4(sa[2 * kk + 1])); \
        _Pragma("unroll") \
                for (int dt = 0; dt < 3; ++dt) { bf16x8 a; \
                    if (dt < 2) { const LAS unsigned char* vp = F.lds + vt + (16 * dt + r16) * ML_TS + (32 * kk + 4 * q4) * 2; a = mk_frag(*(const LAS u32x2*)vp, *(const LAS u32x2*)(vp + 32)); } \
                    else a = (r16 == 0) ? ones : zeros; \
                    oacc[dt] = MFMA16(a, pf, oacc[dt]); } } \
        } else { \
            const int T = w - 4; f32x4 ia[3]; \
        _Pragma("unroll") \
            for (int dt = 0; dt < 3; ++dt) ia[dt] = (f32x4){0.f, 0.f, 0.f, 0.f}; \
        _Pragma("unroll") \
            for (int ks = 0; ks < 8; ++ks) { const bf16x8 bqv = *(const LAS bf16x8*)(F.lds + ML_QL + (16 * T + r16) * ML_RS + ks * 64 + q4 * 16); \
        _Pragma("unroll") \
                for (int dt = 0; dt < 3; ++dt) { bf16x8 a; \
                    if (dt < 2) a = *(const LAS bf16x8*)(F.lds + ML_CT + (16 * dt + r16) * ML_RS + ks * 64 + q4 * 16); \
                    else { a = *(const LAS bf16x8*)(F.lds + ML_CT + 32 * ML_RS + ks * 64 + q4 * 16); if (r16 != 0) a = zeros; } \
                    ia[dt] = MFMA16(a, bqv, ia[dt]); } } \
            const int tl = 16 * T + r16; \
            *(LAS f32x4*)(F.lds + ML_X + tl * 144 + (4 * q4) * 4) = ia[0]; *(LAS f32x4*)(F.lds + ML_X + tl * 144 + (16 + 4 * q4) * 4) = ia[1]; \
            if (q4 == 0) *(LAS f32x4*)(F.lds + ML_X + tl * 144 + 32 * 4) = ia[2]; \
        } \
        } \
        __syncthreads(); \
        if (w < 4) { \
            const int tl = 16 * w + r16; const float at = gp[128 + tl], en = gp[192 + tl]; \
            const f32x4 x0 = *(const LAS f32x4*)(F.lds + ML_X + tl * 144 + (4 * q4) * 4), x1 = *(const LAS f32x4*)(F.lds + ML_X + tl * 144 + (16 + 4 * q4) * 4); \
            const float xd = *(const LAS float*)(F.lds + ML_X + tl * 144 + 32 * 4); \
            const f32x4 n0 = oacc[0] + x0 * at, n1 = oacc[1] + x1 * at; \
            float den = oacc[2][0] + xd * at; den = __shfl(den, r16); \
            float sq = (n0[0] * n0[0] + n0[1] * n0[1]) + (n0[2] * n0[2] + n0[3] * n0[3]) + (n1[0] * n1[0] + n1[1] * n1[1]) + (n1[2] * n1[2] + n1[3] * n1[3]); \
            sq += __shfl_xor(sq, 16); sq += __shfl_xor(sq, 32); \
            const size_t ro = (size_t)(rowc + tl) * BW + 4 * q4; \
            f32x4 t0, t1; \
            t0[0] = n0[0] * ng0[0] * bf_lo(ob0.x); t0[1] = n0[1] * ng0[1] * bf_hi(ob0.x); t0[2] = n0[2] * ng0[2] * bf_lo(ob0.y); t0[3] = n0[3] * ng0[3] * bf_hi(ob0.y); \
            t1[0] = n1[0] * ng1[0] * bf_lo(ob1.x); t1[1] = n1[1] * ng1[1] * bf_hi(ob1.x); t1[2] = n1[2] * ng1[2] * bf_lo(ob1.y); t1[3] = n1[3] * ng1[3] * bf_hi(ob1.y); \
            *(gu32x2*)(NUM + ro) = pack4(t0); *(gu32x2*)(NUM + ro + 16) = pack4(t1); \
            if (q4 == 0) { SSQC[(size_t)(rowc + tl) * 64 + h * 16 + sl] = sq; if (sl == 0) DNB[(size_t)(rowc + tl) * 4 + h] = fmaxf(fabsf(den), en); } \
        } \
        { const float dec = gp[320]; \
        _Pragma("unroll") \
          for (int i = 0; i < 2; ++i) \
        _Pragma("unroll") \
              for (int dt = 0; dt < 3; ++dt) st[i][dt] = st[i][dt] * dec; \
        _Pragma("unroll") \
          for (int kk = 0; kk < 2; ++kk) { bf16x8 a[2], bv[3]; \
        _Pragma("unroll") \
              for (int i = 0; i < 2; ++i) a[i] = tr_frag8(F.lds + kb, ML_RS, 32 * kk + 8 * q4, 32 * w + 16 * i, r16); \
        _Pragma("unroll") \
              for (int dt = 0; dt < 2; ++dt) bv[dt] = *(const LAS bf16x8*)(F.lds + vw + (16 * dt + r16) * ML_TS + kk * 64 + q4 * 16); \
              bv[2] = *(const LAS bf16x8*)(F.lds + vw + 32 * ML_TS + kk * 64 + q4 * 16); if (r16 != 0) bv[2] = zeros; \
        _Pragma("unroll") \
              for (int i = 0; i < 2; ++i) \
        _Pragma("unroll") \
                  for (int dt = 0; dt < 3; ++dt) st[i][dt] = MFMA16(a[i], bv[dt], st[i][dt]); } \
        _Pragma("unroll") \
          for (int i = 0; i < 2; ++i) { \
        _Pragma("unroll") \
              for (int dt = 0; dt < 2; ++dt) *(LAS u32x2*)(F.lds + ML_CT + (16 * dt + r16) * ML_RS + (32 * w + 16 * i + 4 * q4) * 2) = pack4(st[i][dt]); \
              if (r16 == 0) *(LAS u32x2*)(F.lds + ML_CT + 32 * ML_RS + (32 * w + 16 * i + 4 * q4) * 2) = pack4(st[i][2]); } } \
        for (int rp_ = 0; rp_ < ML_RWR; ++rp_) if (c + 1 < 32) ML_WRITE(kbn, vwn, gpn, WQ_, WK_, WV_); \
        __syncthreads(); \
    } while (0)
    for (int c2 = 0; c2 < 32; ++c2) { ML_STEP(c2, qra, kra, vra, qra, kra, vra); }
#undef ML_LOAD
#undef ML_GLOAD
#undef ML_GPREP
#undef ML_WRITE
#undef ML_STEP
}

__device__ __forceinline__ void p2b_finalize(const Ctx& F, guchar* ws) {
    int lane = F.lane; LAUNDER_V(lane); const int gw = F.vcu * NWAVES + F.wave, NGW = F.G * NWAVES;
    const gbf16* NUM = (const gbf16*)(ws + WS_NUM); gbf16* YC = (gbf16*)(ws + WS_YA) + (size_t)2 * M_ROWS * BW;
    for (int m = gw; m < M_ROWS; m += NGW) {
        float s = ((const gfloat*)(ws + WS_SSQC))[(size_t)m * 64 + lane];
        s += __shfl_xor(s, 1); s += __shfl_xor(s, 2); s += __shfl_xor(s, 4); s += __shfl_xor(s, 8);
        const float dn = ((const gfloat*)(ws + WS_DN))[(size_t)m * 4 + (lane >> 4)];
        const float inv = 1.0f / dn; const float sc = inv * rsqrtf(s * (1.0f / 512.0f) * inv * inv + NORM_EPS);
#pragma unroll
        for (int it = 0; it < 4; ++it) { const float f = __shfl(sc, 16 * it); const size_t o = (size_t)m * BW + (size_t)(it * 64 + lane) * 8;
            const u32x4 nb = *(const gu32x4*)(NUM + o); u32x4 y;
            y.x = cvt_pk_bf16(bf_lo(nb.x) * f, bf_hi(nb.x) * f); y.y = cvt_pk_bf16(bf_lo(nb.y) * f, bf_hi(nb.y) * f);
            y.z = cvt_pk_bf16(bf_lo(nb.z) * f, bf_hi(nb.z) * f); y.w = cvt_pk_bf16(bf_lo(nb.w) * f, bf_hi(nb.w) * f);
            *(gu32x4*)(YC + o) = y; }
    }
}
__device__ __forceinline__ void p5b_ssq(const Ctx& F, guchar* ws) {
    int lane = F.lane; LAUNDER_V(lane); const int gw = F.vcu * NWAVES + F.wave, NGW = F.G * NWAVES;
    for (int m = gw; m < M_ROWS; m += NGW) { const float s = wave_sum(((const gfloat*)(ws + WS_XSP))[(size_t)m * 64 + lane]); if (lane == 0) ((gfloat*)(ws + WS_CTL + CTL_SSQ1))[m] = s; }
}
__device__ __forceinline__ void p4b_x1(const Ctx& F, guchar* ws, const gfloat* npost) {
    int lane = F.lane; LAUNDER_V(lane); const int gw = F.vcu * NWAVES + F.wave, NGW = F.G * NWAVES;
    const gbf16* OUT = (const gbf16*)(ws + WS_OUT); const gbf16* XB = (const gbf16*)(ws + WS_XB); gbf16* X1B = (gbf16*)(ws + WS_X1B);
    for (int m = gw; m < M_ROWS; m += NGW) {
        const float so = wave_sum(((const gfloat*)(ws + WS_OUTP))[(size_t)m * 64 + lane]), se = wave_sum(((const gfloat*)(ws + WS_ERP))[(size_t)m * 64 + lane]);
        const float rso = rsqrtf(so * (1.0f / DM) + NORM_EPS), rse = rsqrtf(se * (1.0f / DM) + NORM_EPS);
        if (lane == 0) { ((gfloat*)(ws + WS_RSO))[m] = rso; ((gfloat*)(ws + WS_RSE))[m] = rse; }
#pragma unroll
        for (int it = 0; it < 8; ++it) { const int c = (it * 64 + lane) * 8; const size_t o = (size_t)m * DM + c;
            const u32x4 xb = *(const gu32x4*)(XB + o), ob = *(const gu32x4*)(OUT + o); const f32x4 n0 = *(const gf32x4*)(npost + c), n1 = *(const gf32x4*)(npost + c + 4); u32x4 y;
            y.x = cvt_pk_bf16(bf_lo(xb.x) + bf_lo(ob.x) * rso * n0[0], bf_hi(xb.x) + bf_hi(ob.x) * rso * n0[1]);
            y.y = cvt_pk_bf16(bf_lo(xb.y) + bf_lo(ob.y) * rso * n0[2], bf_hi(xb.y) + bf_hi(ob.y) * rso * n0[3]);
            y.z = cvt_pk_bf16(bf_lo(xb.z) + bf_lo(ob.z) * rso * n1[0], bf_hi(xb.z) + bf_hi(ob.z) * rso * n1[1]);
            y.w = cvt_pk_bf16(bf_lo(xb.w) + bf_lo(ob.w) * rso * n1[2], bf_hi(xb.w) + bf_hi(ob.w) * rso * n1[3]);
            *(gu32x4*)(X1B + o) = y; }
    }
}

#ifndef P1_ROT
#define P1_ROT 0
#endif
#ifndef P1_WGM
#define P1_WGM 4
#endif
#ifndef REP_P0
#define REP_P0 1
#endif
#ifndef REP_P1
#define REP_P1 1
#endif
#ifndef REP_ML
#define REP_ML 1
#endif
#ifndef REP_SW
#define REP_SW 1
#endif
#ifndef REP_GM
#define REP_GM 1
#endif
#ifndef REP_P3
#define REP_P3 1
#endif
#ifndef REP_THIN
#define REP_THIN 1
#endif
#ifndef REP_BAR
#define REP_BAR 1
#endif
#ifndef REP_P4
#define REP_P4 1
#endif
__device__ __forceinline__ unsigned long long arg_ld(LAS unsigned char* lds, int i) {
    unsigned a = (unsigned)(ARGS_OFF + 8 * i); asm volatile("" : "+v"(a));
    const volatile LAS unsigned* q = (const volatile LAS unsigned*)(lds + a);
    const unsigned lo = q[0], hi = q[1];
    return ((unsigned long long)(unsigned)__builtin_amdgcn_readfirstlane((int)hi) << 32) | (unsigned)__builtin_amdgcn_readfirstlane((int)lo);
}
struct Args { const void* in[19]; float* out; unsigned char* ws; };
static_assert(sizeof(Args) == 21 * 8, "no padding in Args");

__global__ void __launch_bounds__(NTHREADS, 2) fwd_kernel(Args args) {
    extern __shared__ __attribute__((aligned(16))) unsigned char lds_raw[];
    Ctx F; F.lds = (LAS unsigned char*)lds_raw; F.tid = threadIdx.x; F.lane = F.tid & 63; F.wave = __builtin_amdgcn_readfirstlane(F.tid >> 6);
    F.G = gridDim.x; F.bx = blockIdx.x; { const int bx = blockIdx.x; F.vcu = (F.G % 8 == 0) ? (bx % 8) * (F.G / 8) + bx / 8 : bx; }
    guchar* ws0 = (guchar*)args.ws;
#define WSL() ({ guchar* w_ = ws0; LAUNDER_S(w_); w_; })
    volatile LAS unsigned* MISC = (volatile LAS unsigned*)(F.lds + MISC_OFF);
    if (F.tid < 32) MISC[F.tid] = 0u;
    __syncthreads();
    const XcdBarrier bar = xcd_barrier_post((unsigned*)(ws0 + WS_CTL) + CW_BAR, MISC);

    if (F.tid < 19) ((LAS unsigned long long*)(F.lds + ARGS_OFF))[F.tid] = (unsigned long long)args.in[F.tid];
    if (F.tid == 19) ((LAS unsigned long long*)(F.lds + ARGS_OFF))[19] = (unsigned long long)args.out;
    __syncthreads();
#define ARGP(T, i) ((T)arg_ld(F.lds, (i)))

#define FL() ({ Ctx f_ = F; LAUNDER_S(f_.lds); LAUNDER_S(f_.wave); LAUNDER_S(f_.vcu); LAUNDER_S(f_.G); LAUNDER_S(f_.bx); f_; })
#ifndef SKIP_P0
    for (int rep_ = 0; rep_ < REP_P0; ++rep_) { const Ctx Fp = FL(); guchar* ws = WSL(); p0_prologue(FL(), ARGP(const gfloat*, 0), ARGP(const gfloat*, 1), ARGP(const gint*, 2), ARGP(const gfloat*, 3), ARGP(const gfloat*, 4), ARGP(const gfloat*, 13), ARGP(const gfloat*, 14), ARGP(const gfloat*, 18), ARGP(const gfloat*, 16), ws); }
#endif
    for (int rb_ = 0; rb_ < REP_BAR; ++rb_) xcd_barrier(bar);

    for (int l = 0; l < NLAYER; ++l) {
        const gfloat* xin = l == 0 ? ARGP(const gfloat*, 0) : (const gfloat*)ARGP(gfloat*, 19);
#ifndef SKIP_P1
        for (int rep_ = 0; rep_ < REP_P1; ++rep_) { const Ctx Fp = FL(); guchar* ws = WSL(); const gfloat* ssq = l == 0 ? (const gfloat*)(ws + WS_SSQ0) : (const gfloat*)(ws + WS_CTL + CTL_SSQ1); pg8::SchedPlain S; S.T.init(M_ROWS / 256, NT_IN, Fp.G, Fp.bx, P1_WGM, P1_ROT); S.A = (const gchar*)(ws + WS_XB); S.B = (const gchar*)(ws + WS_WIN + (size_t)l * SZ_WIN);
          S.astep = (size_t)256 * DM * 2; S.bstep = (size_t)256 * DM * 2;
          pg8::EpiIn E{ssq, ws};
          pg8::gemm_phase<pg8::EpiIn, pg8::SchedPlain>(Fp.lds, DM, DM, DM, S, E); }
#ifdef PROBE_P1CHEAP
        { const Ctx Fp = FL(); guchar* ws = WSL(); pg8::SchedPlain S; S.T.init(M_ROWS / 256, NT_IN, Fp.G, Fp.bx); S.A = (const gchar*)(ws + WS_XB); S.B = (const gchar*)(ws + WS_WIN + (size_t)l * SZ_WIN);
          S.astep = (size_t)256 * DM * 2; S.bstep = (size_t)256 * DM * 2;
          pg8::EpiSq E{(gbf16*)(ws + WS_END), (gfloat*)(ws + WS_END + (size_t)M_ROWS * 31488 * 2)};
          pg8::gemm_phase<pg8::EpiSq, pg8::SchedPlain>(Fp.lds, DM, DM, DM, S, E); }
#endif
        { const Ctx Fq = FL(); const int nwg_ = (M_ROWS / 256) * NT_IN, rem_ = nwg_ % Fq.G;
          if (rem_ == 0 || Fq.bx >= rem_) { const int me = rem_ ? Fq.bx - rem_ : Fq.bx, nw = rem_ ? Fq.G - rem_ : Fq.G;
            { const Ctx Fp = FL(); guchar* ws = WSL(); pg8::SchedPlain S; S.T.init(M_ROWS / 256, DM / 256, nw, me); S.A = (const gchar*)(ws + WS_PB + (size_t)l * M_ROWS * 256 * 2); S.B = (const gchar*)(ws + WS_WPP + (size_t)l * SZ_WPP);
              S.astep = (size_t)256 * 256 * 2; S.bstep = (size_t)256 * 256 * 2;
              pg8::EpiSq E{(gbf16*)(ws + WS_ERAW), (gfloat*)(ws + WS_ERP)};
              pg8::gemm_phase<pg8::EpiSq, pg8::SchedPlain>(Fp.lds, 256, 256, 256, S, E); }
            if (l == 0) tr_run(FL(), TR_DEFER0, TR_DEFER1, 0x7fffffff, 0x7fffffff, me, nw, ARGP(const gfloat*, 4), ARGP(const gfloat*, 3), ARGP(const gfloat*, 13), ARGP(const gfloat*, 14), ARGP(const gfloat*, 18), ARGP(const gfloat*, 16), WSL()); } }
#endif
        for (int rb_ = 0; rb_ < REP_BAR; ++rb_) xcd_barrier(bar);
#ifndef SKIP_ML
        for (int rep_ = 0; rep_ < REP_ML; ++rep_) { const Ctx Fp = FL(); guchar* ws = WSL(); for (int u = Fp.vcu; u < 256; u += Fp.G) mlstm_unit(Fp, u >> 6, (u >> 4) & 3, u & 15, ws, ARGP(const gfloat*, 10) + l * 4, ARGP(const gfloat*, 11) + l * 4, ARGP(const gfloat*, 12) + l * BW); }
#endif
#ifndef SKIP_SW
        for (int rep_ = 0; rep_ < REP_SW; ++rep_) { const Ctx Fp = FL(); guchar* ws = WSL(); for (int u = Fp.vcu; u < 256; u += Fp.G) swa_unit(Fp, u >> 6, (u >> 2) & 15, u & 3, ws, ARGP(const gfloat*, 9) + l * 32); }
#endif
#ifndef SKIP_GM
        for (int rep_ = 0; rep_ < REP_GM; ++rep_) { const Ctx Fp = FL(); guchar* ws = WSL(); for (int u = Fp.vcu; u < 512; u += Fp.G) gmlp_unit(Fp, u >> 7, (u >> 3) & 15, u & 7, ws, ARGP(const gfloat*, 5) + l * BW, ARGP(const gfloat*, 6) + l * BW, ARGP(const gfloat*, 7) + (size_t)l * 8 * 128 * 128, ARGP(const gfloat*, 8) + l * 8 * 128); }
#endif
        for (int rb_ = 0; rb_ < REP_BAR; ++rb_) xcd_barrier(bar);
#ifndef SKIP_P2B
        for (int rep_ = 0; rep_ < REP_THIN; ++rep_) p2b_finalize(FL(), WSL());
#endif
        for (int rb_ = 0; rb_ < REP_BAR; ++rb_) xcd_barrier(bar);
#ifndef PROBE_NOSTORE
#define PROBE_NOSTORE 0
#endif
#ifdef PROBE_K1024
        for (int rep_ = 0; rep_ < 4; ++rep_) { const Ctx Fp = FL(); guchar* ws = WSL(); pg8::SchedPlain S; S.T.init(M_ROWS / 256, DM / 256, Fp.G, Fp.bx); S.A = (const gchar*)(ws + WS_YA); S.B = (const gchar*)(ws + WS_WOUT + (size_t)l * SZ_WSQ);
          S.astep = (size_t)256 * DM * 2; S.bstep = (size_t)256 * DM * 2;
          pg8::EpiSq E{PROBE_NOSTORE ? (gbf16*)nullptr : (gbf16*)(ws + WS_END), (gfloat*)(ws + WS_END + (size_t)M_ROWS * 31488 * 2)};
          pg8::gemm_phase<pg8::EpiSq, pg8::SchedPlain>(Fp.lds, 1024, DM, DM, S, E); }
#endif
#ifdef PROBE_P3CHEAP
        { const Ctx Fp = FL(); guchar* ws = WSL(); pg8::SchedBranch S; S.T.init(M_ROWS / 256, DM / 256, Fp.G, Fp.bx); S.A = (const gchar*)(ws + WS_YA); S.B = (const gchar*)(ws + WS_WBR + (size_t)l * SZ_WBR);
          S.astep = (size_t)256 * BW * 2; S.bstep = (size_t)256 * BW * 2; S.aseg = SZ_ROWS_BW; S.bseg = (size_t)DM * BW * 2;
          pg8::EpiSq E{(gbf16*)(ws + WS_END), (gfloat*)(ws + WS_END + (size_t)M_ROWS * 31488 * 2)};
          pg8::gemm_phase<pg8::EpiSq, pg8::SchedBranch>(Fp.lds, BW, BW, BW, S, E); }
#endif
#ifndef SKIP_P3
        for (int rep_ = 0; rep_ < REP_P3; ++rep_) { const Ctx Fp = FL(); guchar* ws = WSL(); pg8::SchedBranch S; S.T.init(M_ROWS / 256, DM / 256, Fp.G, Fp.bx); S.A = (const gchar*)(ws + WS_YA); S.B = (const gchar*)(ws + WS_WBR + (size_t)l * SZ_WBR);
          S.astep = (size_t)256 * BW * 2; S.bstep = (size_t)256 * BW * 2; S.aseg = SZ_ROWS_BW; S.bseg = (size_t)DM * BW * 2;
          pg8::EpiBranch E{(const gbf16*)(ws + WS_G), (gbf16*)(ws + WS_MIX)};
          pg8::gemm_phase<pg8::EpiBranch, pg8::SchedBranch>(Fp.lds, BW, BW, BW, S, E); }
#endif
        for (int rb_ = 0; rb_ < REP_BAR; ++rb_) xcd_barrier(bar);
#ifndef SKIP_P4
        for (int rep_ = 0; rep_ < REP_P4; ++rep_) { const Ctx Fp = FL(); guchar* ws = WSL(); pg8::SchedPlain S; S.T.init(M_ROWS / 256, DM / 256, Fp.G, Fp.bx); S.A = (const gchar*)(ws + WS_MIX); S.B = (const gchar*)(ws + WS_WOUT + (size_t)l * SZ_WSQ);
          S.astep = (size_t)256 * DM * 2; S.bstep = (size_t)256 * DM * 2;
          pg8::EpiSq E{(gbf16*)(ws + WS_OUT), (gfloat*)(ws + WS_OUTP)};
          pg8::gemm_phase<pg8::EpiSq, pg8::SchedPlain>(Fp.lds, DM, DM, DM, S, E); }
#endif
        for (int rb_ = 0; rb_ < REP_BAR; ++rb_) xcd_barrier(bar);
#ifndef SKIP_P4B
        for (int rep_ = 0; rep_ < REP_THIN; ++rep_) p4b_x1(FL(), WSL(), ARGP(const gfloat*, 15) + l * DM);
#endif
        for (int rb_ = 0; rb_ < REP_BAR; ++rb_) xcd_barrier(bar);
#ifdef PROBE_P5
        { const Ctx Fp = FL(); guchar* ws = WSL(); pg8::SchedPlain S; S.T.init(M_ROWS / 256, DM / 256, Fp.G, Fp.bx); S.A = (const gchar*)(ws + WS_X1B); S.B = (const gchar*)(ws + WS_WPG + (size_t)l * SZ_WSQ);
          S.astep = (size_t)256 * DM * 2; S.bstep = (size_t)256 * DM * 2;
          pg8::EpiPle E{xin, (gfloat*)(ws + WS_END), (gbf16*)(ws + WS_END + (size_t)M_ROWS * DM * 4), (const gbf16*)(ws + WS_OUT), (const gbf16*)(ws + WS_ERAW), (const gfloat*)(ws + WS_RSO), (const gfloat*)(ws + WS_RSE),
                        ARGP(const gfloat*, 15) + l * DM, ARGP(const gfloat*, 17) + l * DM, (gfloat*)(ws + WS_END + (size_t)M_ROWS * DM * 6), 0};
          pg8::gemm_phase<pg8::EpiPle, pg8::SchedPlain>(Fp.lds, DM, DM, DM, S, E); }
#endif
#ifndef SKIP_P5
        { const Ctx Fp = FL(); guchar* ws = WSL(); pg8::SchedPlain S; S.T.init(M_ROWS / 256, DM / 256, Fp.G, Fp.bx); S.A = (const gchar*)(ws + WS_X1B); S.B = (const gchar*)(ws + WS_WPG + (size_t)l * SZ_WSQ);
          S.astep = (size_t)256 * DM * 2; S.bstep = (size_t)256 * DM * 2;
          pg8::EpiPle E{xin, ARGP(gfloat*, 19), (gbf16*)(ws + WS_XB), (const gbf16*)(ws + WS_OUT), (const gbf16*)(ws + WS_ERAW), (const gfloat*)(ws + WS_RSO), (const gfloat*)(ws + WS_RSE),
                        ARGP(const gfloat*, 15) + l * DM, ARGP(const gfloat*, 17) + l * DM, (gfloat*)(ws + WS_XSP), l == NLAYER - 1 ? 1 : 0};
          pg8::gemm_phase<pg8::EpiPle, pg8::SchedPlain>(Fp.lds, DM, DM, DM, S, E); }
#endif
        if (l + 1 < NLAYER) { for (int rb_ = 0; rb_ < REP_BAR; ++rb_) xcd_barrier(bar); p5b_ssq(FL(), WSL()); for (int rb_ = 0; rb_ < REP_BAR; ++rb_) xcd_barrier(bar); }
    }
}

extern "C" void kernel_launch(void* const* d_in, const int* in_sizes, int n_in, void* d_out, int out_size, void* d_ws, size_t ws_size, hipStream_t stream) {
    static int grid = 0;
    if (grid == 0) {
        if (n_in != 19 || out_size != M_ROWS * DM || ws_size < WS_END) { fprintf(stderr, "kernel_launch: unexpected problem (n_in %d, out %d, ws %zu, need %zu)\n", n_in, out_size, ws_size, (size_t)WS_END); grid = -1; return; }
        int dev = 0, cus = 0;
        if (hipGetDevice(&dev) != hipSuccess || hipDeviceGetAttribute(&cus, hipDeviceAttributeMultiprocessorCount, dev) != hipSuccess) { grid = -1; return; }
        if (hipFuncSetAttribute((const void*)fwd_kernel, hipFuncAttributeMaxDynamicSharedMemorySize, LDS_BYTES) != hipSuccess) { fprintf(stderr, "kernel_launch: hipFuncSetAttribute failed\n"); grid = -1; return; }
        int per_cu = 0; (void)hipOccupancyMaxActiveBlocksPerMultiprocessor(&per_cu, (const void*)fwd_kernel, NTHREADS, LDS_BYTES); (void)hipGetLastError();
        if (per_cu < 1) fprintf(stderr, "kernel_launch: occupancy query reports %d blocks per CU\n", per_cu);
        grid = cus > 256 ? 256 : cus;
    }
    if (grid < 0) return;
    (void)hipMemsetAsync((char*)d_ws + WS_CTL, 0, CTL_ZERO_BYTES, stream);
    Args a{};
    for (int i = 0; i < 19; ++i) a.in[i] = d_in[i];
    a.out = (float*)d_out; a.ws = (unsigned char*)d_ws;
    hipLaunchKernelGGL(fwd_kernel, dim3(grid), dim3(NTHREADS), LDS_BYTES, stream, a);
    const hipError_t le = hipPeekAtLastError();
    if (le != hipSuccess) fprintf(stderr, "kernel_launch: launch failed: %s\n", hipGetErrorName(le));
}
```

```cpp
#include <hip/hip_runtime.h>
#include <cstdio>
#include <cstdint>

#define LAS __attribute__((address_space(3)))
#define GAS __attribute__((address_space(1)))
typedef unsigned short bf16_t;
typedef short bf16x8 __attribute__((ext_vector_type(8)));
typedef float f32x4 __attribute__((ext_vector_type(4)));
typedef float f32x2 __attribute__((ext_vector_type(2)));
typedef unsigned u32x4 __attribute__((ext_vector_type(4)));
typedef unsigned u32x2 __attribute__((ext_vector_type(2)));

typedef GAS float gfloat; typedef GAS bf16_t gbf16; typedef GAS int gint; typedef GAS char gchar; typedef GAS unsigned char guchar; typedef GAS unsigned gunsigned;
typedef GAS f32x4 gf32x4; typedef GAS f32x2 gf32x2; typedef GAS u32x4 gu32x4; typedef GAS u32x2 gu32x2;
constexpr int M_ROWS = 8192, SEQ = 2048, DM = 4096, BW = 2048, NLAYER = 2;
constexpr int N_IN = 31240, IF_COL = 14848;
constexpr int NT_IN = 123;
constexpr int N_IN_T = NT_IN * 256;
constexpr float NORM_EPS = 1e-6f;

__device__ __forceinline__ unsigned cvt_pk_bf16(float lo, float hi) { unsigned r; asm("v_cvt_pk_bf16_f32 %0, %1, %2" : "=v"(r) : "v"(lo), "v"(hi)); return r; }
__device__ __forceinline__ float bf_lo(unsigned w) { return __uint_as_float(w << 16); }
__device__ __forceinline__ float bf_hi(unsigned w) { return __uint_as_float(w & 0xffff0000u); }
__device__ __forceinline__ float bf1(bf16_t b) { return __uint_as_float(((unsigned)b) << 16); }
__device__ __forceinline__ float fsigmoid(float x) { return __builtin_amdgcn_rcpf(1.0f + __expf(-x)); }
__device__ __forceinline__ float wave_sum(float v) {
#pragma unroll
    for (int o = 1; o < 64; o <<= 1) v += __shfl_xor(v, o);
    return v;
}
__device__ __forceinline__ f32x2 gelu_pk(f32x2 v) {
    const f32x2 av = __builtin_elementwise_abs(v), d = av * 0.2316418882f + 1.0f;
    f32x2 t; t.x = __builtin_amdgcn_rcpf(d.x); t.y = __builtin_amdgcn_rcpf(d.y);
    f32x2 q = t * 0.5307027145f + (-0.7265760135f); q = q * t + 0.7107068705f; q = q * t + (-0.142248368f); q = q * t + 0.127414796f; q = q * t;
    const f32x2 s = (v * v) * (-0.72134752044f);
    f32x2 e; e.x = __builtin_amdgcn_exp2f(s.x); e.y = __builtin_amdgcn_exp2f(s.y);
    const f32x2 m = v * (q * e), r = v - m;
    f32x2 o; o.x = v.x < 0.f ? m.x : r.x; o.y = v.y < 0.f ? m.y : r.y; return o;
}
typedef int i32x8 __attribute__((ext_vector_type(8)));
typedef short s16x16 __attribute__((ext_vector_type(16)));
__host__ __device__ __forceinline__ size_t ablk8(int row, int col, int K) { return ((size_t)(row >> 8) * (K >> 7) + (col >> 7)) * 32768 + (size_t)(row & 255) * 128 + (col & 127); }
__device__ __forceinline__ unsigned pack_fp8x4(float a, float b, float c, float d) { int w = 0; w = __builtin_amdgcn_cvt_pk_fp8_f32(a, b, w, false); w = __builtin_amdgcn_cvt_pk_fp8_f32(c, d, w, true); return (unsigned)w; }
__device__ __forceinline__ unsigned pack_i8x4(float a, float b, float c, float d) {
    const int q0 = min(max(__float2int_rn(a), -127), 127), q1 = min(max(__float2int_rn(b), -127), 127), q2 = min(max(__float2int_rn(c), -127), 127), q3 = min(max(__float2int_rn(d), -127), 127);
    return ((unsigned)q0 & 0xffu) | (((unsigned)q1 & 0xffu) << 8) | (((unsigned)q2 & 0xffu) << 16) | ((unsigned)q3 << 24);
}
__host__ __device__ __forceinline__ size_t ablk(int row, int col, int K) { return ((size_t)(row >> 8) * (K >> 6) + (col >> 6)) * 16384 + (size_t)(row & 255) * 64 + (col & 63); }
__host__ __device__ __forceinline__ size_t tb256(int row, int col, int nt) { return ((size_t)(row >> 8) * nt + (col >> 8)) * 65536 + (size_t)(row & 255) * 256 + (col & 255); }
__host__ __device__ __forceinline__ size_t tb128(int row, int col, int nt) { return ((size_t)(row >> 8) * nt + (col >> 7)) * 32768 + (size_t)(row & 255) * 128 + (col & 127); }
#define LAUNDER_V(x) asm volatile("" : "+v"(x))
#define LAUNDER_S(x) asm volatile("" : "+s"(x))
#define LDS_WAIT() asm volatile("s_waitcnt lgkmcnt(0)" ::: "memory")
#define VM_WAIT() asm volatile("s_waitcnt vmcnt(0)" ::: "memory")
#define MFMA16(a, b, c) __builtin_amdgcn_mfma_f32_16x16x32_bf16((a), (b), (c), 0, 0, 0)

#define XB_TMO      128
#define XB_XCNT(j)  (256  + 64 * (j))
#define XB_XSUB(j)  (1280 + 64 * (j))
#define XB_XGEN(j)  (2304 + 64 * (j))
#define XB_TOP      3328
#define XB_TOPGEN   3392
#define XCD_BAR_WORDS 3456
#define XB_SPIN_CAP (1u << 18)
__device__ __forceinline__ unsigned xb_ld(unsigned* p)              { return __hip_atomic_load(p, __ATOMIC_RELAXED, __HIP_MEMORY_SCOPE_AGENT); }
__device__ __forceinline__ unsigned xb_add(unsigned* p, unsigned v) { return __hip_atomic_fetch_add(p, v, __ATOMIC_RELAXED, __HIP_MEMORY_SCOPE_AGENT); }
__device__ __forceinline__ unsigned xb_xcc_id() { return (unsigned)__builtin_amdgcn_s_getreg((3 << 11) | 20) & 0xFu; }
#define XB_SPIN(cond, bar) do { unsigned _sp = 0; while (cond) { __builtin_amdgcn_s_sleep(1); \
    if ((++_sp & 255u) == 0u) { if (xb_ld(&(bar)[XB_TMO])) break; if (_sp > XB_SPIN_CAP) { atomicAdd(&(bar)[XB_TMO], 1u); break; } } } } while (0)
struct XcdBarrier { unsigned* bar; unsigned x; volatile LAS unsigned* st; };
__device__ __forceinline__ XcdBarrier xcd_barrier_post(unsigned* bar, volatile LAS unsigned* st) {
    XcdBarrier b; b.bar = bar; b.x = xb_xcc_id(); b.st = st;
    if (threadIdx.x == 0) (void)xb_add(&bar[XB_XCNT(b.x)], 1u);
    return b;
}
__device__ __forceinline__ void xcd_barrier_complete(unsigned* bar, unsigned x, unsigned& nloc, unsigned& nx) {
    const unsigned G = gridDim.x * gridDim.y * gridDim.z;
    unsigned sum, cnt, mine, sp = 0u;
    for (;;) {
        sum = 0u; cnt = 0u; mine = 0u;
#pragma unroll
        for (unsigned j = 0; j < 16; ++j) { const unsigned c = xb_ld(&bar[XB_XCNT(j)]); sum += c; cnt += (c > 0u) ? 1u : 0u; mine = (j == x) ? c : mine; }
        if (sum == G) break;
        __builtin_amdgcn_s_sleep(1);
        if ((++sp & 255u) == 0u) { if (xb_ld(&bar[XB_TMO])) break; if (sp > XB_SPIN_CAP) { atomicAdd(&bar[XB_TMO], 1u); break; } }
    }
    nloc = mine > 0u ? mine : 1u; nx = cnt > 0u ? cnt : 1u;
}
__device__ __forceinline__ void xcd_barrier(const XcdBarrier& b) {
    asm volatile("s_waitcnt vmcnt(0)" ::: "memory");
    __syncthreads();
    if (threadIdx.x == 0) {
        unsigned* bar = b.bar;
        __builtin_amdgcn_s_waitcnt(0);
        unsigned nloc = b.st[0], nx = b.st[1];
        if (nloc == 0u) { xcd_barrier_complete(bar, b.x, nloc, nx); b.st[0] = nloc; b.st[1] = nx; }
        const unsigned old = xb_add(&bar[XB_XSUB(b.x)], 1u);
        const unsigned gen = old / nloc;
        if (old + 1u == (gen + 1u) * nloc) {
            __builtin_amdgcn_fence(__ATOMIC_RELEASE, "agent");
            asm volatile("s_waitcnt vmcnt(0)" ::: "memory");
            const unsigned og = xb_add(&bar[XB_TOP], 1u);
            const unsigned tg = og / nx;
            if (og + 1u == (tg + 1u) * nx) xb_add(&bar[XB_TOPGEN], 1u);
            else XB_SPIN(xb_ld(&bar[XB_TOPGEN]) == tg, bar);
            __builtin_amdgcn_fence(__ATOMIC_ACQUIRE, "agent");
            xb_add(&bar[XB_XGEN(b.x)], 1u);
            asm volatile("s_waitcnt vmcnt(0)" ::: "memory");
        } else {
            XB_SPIN(xb_ld(&bar[XB_XGEN(b.x)]) == gen, bar);
            __builtin_amdgcn_fence(__ATOMIC_ACQUIRE, "agent");
            asm volatile("s_waitcnt vmcnt(0)" ::: "memory");
        }
    }
    __syncthreads();
}

#ifndef WGM_DEFAULT
#define WGM_DEFAULT 4
#endif
#ifndef PG8_SADDR
#define PG8_SADDR 1
#endif
namespace pg8 {
constexpr int BM = 256, BK = 64, HALF = 128, HTB = HALF * BK * 2, STAGE_BYTES = 8 * HTB, NXCD = 8, WGM = WGM_DEFAULT;
__host__ __device__ __forceinline__ int lds_byte(int r, int c) { const int st = (r >> 4) * 2 + (c >> 5), rr = r & 15, cc = c & 31, ob = rr * 64 + cc * 2; return st * 1024 + (ob ^ (((ob >> 9) & 1) << 5)); }
__host__ __device__ __forceinline__ void stage_rc(int b, int& R, int& C) { const int st = b / 1024, sb = b % 1024, swz = sb ^ (((sb >> 9) & 1) << 5); R = (st >> 1) * 16 + swz / 64; C = (st & 1) * 32 + (swz % 64) / 2; }
__host__ __device__ __forceinline__ int perm32(int rho) { const int n = rho >> 4, i = rho & 15; return 8 * (i >> 2) + 4 * n + (i & 3); }

struct Unit { int pm, pn, seg; };

struct TileOrder {
    int nM, nN, nwg, G, c, wgm, rot, tailtile, pnoff;
    __device__ __forceinline__ void init(int nM_, int nN_, int G_, int c_, int wgm_ = WGM, int rot_ = 0, int tailtile_ = -1, int pnoff_ = 0) { nM = nM_; nN = nN_; nwg = nM * nN; G = G_; c = c_; wgm = wgm_; rot = rot_; tailtile = tailtile_; pnoff = pnoff_; }
    __device__ __forceinline__ bool tile(int i, int& pm, int& pn) const {
        const long L = (long)i * G + c; if (L >= nwg) return false;
        int wgid = (int)L; const int xcd = wgid % NXCD; { const int q = nwg / NXCD, r = nwg % NXCD, off = wgid / NXCD; wgid = (xcd < r ? xcd * (q + 1) : r * (q + 1) + (xcd - r) * q) + off; }
        const int nig = wgm * nN, gid = wgid / nig, fm = gid * wgm, gsz = (nM - fm) < wgm ? (nM - fm) : wgm;
        pm = fm + ((wgid % nig) % gsz); pn = (wgid % nig) / gsz; if (rot) { pn += rot * xcd; pn -= (pn / nN) * nN; } if (tailtile >= 0 && pn == nN - 1) pn = tailtile; pn += pnoff; return true;
    }
};
struct SchedPlain {
    TileOrder T; const gchar* A; const gchar* B; size_t astep, bstep;
    __device__ __forceinline__ bool next(int i, Unit& u) const { u.seg = 0; return T.tile(i, u.pm, u.pn); }
    __device__ __forceinline__ const gchar* a_ptr(const Unit& u) const { return A + (size_t)u.pm * astep; }
    int pn0 = 0;
    __device__ __forceinline__ const gchar* b_ptr(const Unit& u) const { return B + (size_t)(u.pn - pn0) * bstep; }
};
struct SchedBranch {
    TileOrder T; const gchar* A; const gchar* B; size_t astep, bstep, aseg, bseg;
    __device__ __forceinline__ bool next(int i, Unit& u) const { const int t = i / 3; u.seg = i - 3 * t; return T.tile(t, u.pm, u.pn); }
    __device__ __forceinline__ const gchar* a_ptr(const Unit& u) const { return A + (size_t)u.seg * aseg + (size_t)u.pm * astep; }
    __device__ __forceinline__ const gchar* b_ptr(const Unit& u) const { return B + (size_t)u.seg * bseg + (size_t)u.pn * bstep; }
};

template <class Epi, class Sched>
__device__ __forceinline__ void gemm_phase(LAS unsigned char* lds, const int K, const int lda, const int ldb, const Sched& S, const Epi& E, unsigned* lockctr = nullptr, const int nlock = 0) {
    int tid = threadIdx.x; LAUNDER_V(tid);
    const int wid = __builtin_amdgcn_readfirstlane(tid >> 6), lane = tid & 63, wr = wid >> 2, wc = wid & 3, fr = lane & 15, fq = lane >> 4;
    const int nt = K / BK;
    unsigned voffA, voffB;
    { int R, C; stage_rc(tid * 16, R, C); const int Rb = Epi::PERM ? ((R & ~31) + perm32(R & 31)) : R;
      voffA = (unsigned)(R * BK + C) * 2u; voffB = (unsigned)(Rb * BK + C) * 2u; }
    const unsigned qstepA = 64u * (unsigned)BK * 2u, qstepB = 64u * (unsigned)BK * 2u;
    const size_t kstep = (size_t)BM * BK * 2, kstepB = (size_t)BM * BK * 2;
    const size_t hstepA = (size_t)HALF * BK * 2, hstepB = (size_t)HALF * BK * 2;
    const unsigned ldsw = (unsigned)wid * 1024u;
    const int aoff = lds_byte(wr * 64 + fr, fq * 8), boff = lds_byte(wc * 32 + fr, fq * 8);
#define PG8_SA(b, h) (((b) * 2 + (h)) * HTB)
#define PG8_SB(b, h) ((4 + (b) * 2 + (h)) * HTB)
#if PG8_SADDR
#define PG8_STAGE(bufoff, gbase, voff) do { _Pragma("unroll") for (int _i = 0; _i < 2; ++_i) { const gchar* p_ = (const gchar*)(gbase) + (size_t)_i * q##voff; asm volatile("" : "+s"(p_)); \
        __builtin_amdgcn_global_load_lds((const gunsigned*)(p_ + (voff)), (LAS unsigned*)(lds + (bufoff) + ldsw + _i * 8192), 16, 0, 0); } } while (0)
#else
#define PG8_STAGE(bufoff, gbase, voff) do { _Pragma("unroll") for (int _i = 0; _i < 2; ++_i) \
        __builtin_amdgcn_global_load_lds((const gunsigned*)((const gchar*)(gbase) + (size_t)_i * q##voff + (voff)), (LAS unsigned*)(lds + (bufoff) + ldsw + _i * 8192), 16, 0, 0); } while (0)
#endif
#define qvoffA qstepA
#define qvoffB qstepB
#define PG8_LDA(dst, b, h) do { _Pragma("unroll") for (int m = 0; m < 4; ++m) _Pragma("unroll") for (int k = 0; k < 2; ++k) dst[m][k] = *(const LAS bf16x8*)(lds + PG8_SA(b, h) + aoff + m * 2048 + k * 1024); } while (0)
#define PG8_LDB(dst, b, h) do { _Pragma("unroll") for (int n = 0; n < 2; ++n) _Pragma("unroll") for (int k = 0; k < 2; ++k) dst[n][k] = *(const LAS bf16x8*)(lds + PG8_SB(b, h) + boff + n * 2048 + k * 1024); } while (0)
#define PG8_CAT(x_, y_) __builtin_bit_cast(i32x8, __builtin_shufflevector((x_), (y_), 0, 1, 2, 3, 4, 5, 6, 7, 8, 9, 10, 11, 12, 13, 14, 15))
#define PG8_MMA(ai, bj, At, Bt) do { __builtin_amdgcn_s_setprio(1); _Pragma("unroll") for (int m = 0; m < 4; ++m) _Pragma("unroll") for (int n = 0; n < 2; ++n) { \
        if constexpr (Epi::FP8) { const i32x8 b8_ = PG8_CAT(Bt[n][0], Bt[n][1]), a8_ = PG8_CAT(At[m][0], At[m][1]); \
            asm volatile("s_nop 1\n\tv_mfma_scale_f32_16x16x128_f8f6f4 %0, %1, %2, %0, %3, %3 op_sel_hi:[0,0,0]" : "+v"(acc[ai][bj][m][n]) : "v"(b8_), "v"(a8_), "v"(sc8)); } \
        else if constexpr (Epi::I8) { _Pragma("unroll") for (int k = 0; k < 2; ++k) asm volatile("s_nop 1\n\tv_mfma_i32_16x16x64_i8 %0, %1, %2, %0" : "+v"(acc[ai][bj][m][n]) : "v"(Bt[n][k]), "v"(At[m][k])); } \
        else { _Pragma("unroll") for (int k = 0; k < 2; ++k) acc[ai][bj][m][n] = __builtin_amdgcn_mfma_f32_16x16x32_bf16(Bt[n][k], At[m][k], acc[ai][bj][m][n], 0, 0, 0); } } __builtin_amdgcn_s_setprio(0); } while (0)
#define PG8_WAIT_V(n) asm volatile("s_waitcnt vmcnt(" #n ")" ::: "memory")
#define PG8_WAIT_VR() do { if constexpr (Epi::NS == 16) asm volatile("s_waitcnt vmcnt(24)" ::: "memory"); else if constexpr (Epi::NS == 32) asm volatile("s_waitcnt vmcnt(40)" ::: "memory"); else asm volatile("s_waitcnt vmcnt(8)" ::: "memory"); } while (0)
#define PG8_WAIT_L(n) asm volatile("s_waitcnt lgkmcnt(" #n ")" ::: "memory")
#define PG8_BAR __builtin_amdgcn_s_barrier()
#define PG8_SCHED __builtin_amdgcn_sched_barrier(0)
    Unit cur, nxt; int ui = 0; bool relax_next = false;
    int sc8 = 0x7f7f7f7f; asm volatile("" : "+v"(sc8));
    if (!S.next(0, cur)) return;
    f32x4 acc[2][2][4][2];
#pragma unroll
    for (int a = 0; a < 2; ++a)
#pragma unroll
        for (int b = 0; b < 2; ++b)
#pragma unroll
            for (int m = 0; m < 4; ++m)
#pragma unroll
                for (int n = 0; n < 2; ++n) acc[a][b][m][n] = (f32x4){0.f, 0.f, 0.f, 0.f};
    bf16x8 At[4][2], B0[2][2], B1[2][2];
    const gchar* cA = S.a_ptr(cur); const gchar* cB = S.b_ptr(cur);
    PG8_STAGE(PG8_SB(0, 0), cB, voffB); PG8_STAGE(PG8_SB(0, 1), cB + hstepB, voffB); PG8_STAGE(PG8_SA(0, 0), cA, voffA); PG8_STAGE(PG8_SA(0, 1), cA + hstepA, voffA);
    if (wr == 1) PG8_BAR;
    PG8_WAIT_V(2); PG8_BAR;
    PG8_STAGE(PG8_SB(1, 0), cB + kstepB, voffB); PG8_STAGE(PG8_SA(1, 0), cA + kstep, voffA); PG8_STAGE(PG8_SB(1, 1), cB + hstepB + kstepB, voffB);
    PG8_WAIT_V(6); PG8_BAR;
    for (;;) {
        const bool has_next = S.next(ui + 1, nxt);
        const gchar* nA = has_next ? S.a_ptr(nxt) : cA; const gchar* nB = has_next ? S.b_ptr(nxt) : cB;
        for (int t = 0; t < nt; t += 2) {
            const bool last = (t == nt - 2); const bool relax = Epi::NS > 0 && (t == 0) && relax_next;
#if PG8_SADDR
            asm volatile("" : "+v"(voffA), "+v"(voffB));
#endif
            const gchar* a1 = cA + (size_t)(t + 1) * kstep;
            const gchar* a2 = last ? nA : cA + (size_t)(t + 2) * kstep; const gchar* b2 = last ? nB : cB + (size_t)(t + 2) * kstepB;
            const gchar* a3 = a2 + kstep; const gchar* b3 = b2 + kstepB;
            PG8_LDB(B0, 0, 0); PG8_LDB(B1, 0, 1); PG8_SCHED; PG8_LDA(At, 0, 0); PG8_STAGE(PG8_SA(1, 1), a1 + hstepA, voffA);
            if (relax) PG8_WAIT_VR(); else PG8_WAIT_V(8); PG8_WAIT_L(0); PG8_BAR; PG8_MMA(0, 0, At, B0); PG8_MMA(0, 1, At, B1); PG8_BAR; PG8_SCHED;
            PG8_LDA(At, 0, 1); PG8_STAGE(PG8_SB(0, 0), b2, voffB); PG8_STAGE(PG8_SB(0, 1), b2 + hstepB, voffB); PG8_STAGE(PG8_SA(0, 0), a2, voffA);
            if (relax) PG8_WAIT_VR(); else PG8_WAIT_V(8); PG8_WAIT_L(0); PG8_BAR; PG8_MMA(1, 0, At, B0); PG8_MMA(1, 1, At, B1); PG8_BAR; PG8_SCHED;
            PG8_LDB(B0, 1, 0); PG8_LDB(B1, 1, 1); PG8_SCHED; PG8_LDA(At, 1, 0); PG8_STAGE(PG8_SA(0, 1), a2 + hstepA, voffA);
            PG8_WAIT_V(8); PG8_WAIT_L(0); PG8_BAR; PG8_MMA(0, 0, At, B0); PG8_MMA(0, 1, At, B1); PG8_BAR; PG8_SCHED;
            PG8_LDA(At, 1, 1); PG8_STAGE(PG8_SB(1, 0), b3, voffB); PG8_STAGE(PG8_SB(1, 1), b3 + hstepB, voffB); PG8_STAGE(PG8_SA(1, 0), a3, voffA);
            PG8_WAIT_V(8); PG8_WAIT_L(0); PG8_BAR; PG8_MMA(1, 0, At, B0); PG8_MMA(1, 1, At, B1); PG8_BAR; PG8_SCHED;
        }
        if constexpr (Epi::FP8 || Epi::I8) asm volatile("s_nop 15\n\ts_nop 15\n\ts_nop 15\n\ts_nop 15" ::: "memory");
        if (wr == 0) PG8_BAR;
        { const int ln_ = (int)__builtin_amdgcn_mbcnt_hi(~0u, __builtin_amdgcn_mbcnt_lo(~0u, 0u)); E(acc, cur, wr, wc, ln_ & 15, ln_ >> 4); } relax_next = E.relax(cur);
        if (ui < nlock) {
            if (tid == 0) { (void)xb_add(lockctr, 1u); const unsigned tgt_ = (unsigned)(ui + 1) * (unsigned)S.T.G; unsigned sp_ = 0u; while (xb_ld(lockctr) < tgt_) { __builtin_amdgcn_s_sleep(1); if (++sp_ > (1u << 20)) break; } }
            PG8_BAR; }
        if (!has_next) break;
        if (!E.keep(cur)) {
#pragma unroll
            for (int a = 0; a < 2; ++a)
#pragma unroll
                for (int b = 0; b < 2; ++b)
#pragma unroll
                    for (int m = 0; m < 4; ++m)
#pragma unroll
                        for (int n = 0; n < 2; ++n) acc[a][b][m][n] = (f32x4){0.f, 0.f, 0.f, 0.f};
        }
        cur = nxt; cA = nA; cB = nB; ++ui;
        if (wr == 1) PG8_BAR;
    }
    PG8_WAIT_V(0);
    PG8_BAR;
#undef PG8_SA
#undef PG8_SB
#undef PG8_STAGE
#undef qvoffA
#undef qvoffB
#undef PG8_LDA
#undef PG8_LDB
#undef PG8_MMA
#undef PG8_CAT
#undef PG8_WAIT_V
#undef PG8_WAIT_VR
#undef PG8_WAIT_L
#undef PG8_BAR
#undef PG8_SCHED
}
}

constexpr size_t MiB = 1u << 20;
constexpr size_t WS_CTL = 0, CTL_ZERO_BYTES = 1 * MiB;
constexpr int CW_BAR = 4096;
constexpr size_t CTL_SSQ1 = 256 * 1024;
constexpr size_t SZ_WIN = (size_t)N_IN_T * DM * 2, SZ_WBR = (size_t)3 * DM * BW * 2, SZ_WSQ = (size_t)DM * DM * 2, SZ_WPP = (size_t)DM * 256 * 2;
constexpr size_t WS_WIN = 2 * MiB;
constexpr size_t WS_WBR = WS_WIN + 2 * SZ_WIN;
constexpr size_t WS_WOUT = WS_WBR + 2 * SZ_WBR;
constexpr size_t WS_WPG = WS_WOUT + 2 * SZ_WSQ;
constexpr size_t WS_WPP = WS_WPG + 2 * SZ_WSQ;
constexpr size_t SZ_ROWS_BW = (size_t)M_ROWS * BW * 2, SZ_ROWS_D = (size_t)M_ROWS * DM * 2;
constexpr size_t WS_XB = WS_WPP + 2 * SZ_WPP;
constexpr size_t WS_PB = WS_XB + SZ_ROWS_D;
constexpr size_t WS_CS = WS_PB + (size_t)2 * M_ROWS * 256 * 2;
constexpr size_t WS_SSQ0 = WS_CS + (size_t)M_ROWS * 16 * 4;
constexpr size_t WS_AU = WS_SSQ0 + (size_t)M_ROWS * 4;
constexpr size_t WS_AV = WS_AU + SZ_ROWS_BW, WS_AZ = WS_AV + SZ_ROWS_BW, WS_BQ = WS_AZ + SZ_ROWS_BW;
constexpr size_t WS_BK = WS_BQ + SZ_ROWS_BW;
constexpr size_t WS_BV = WS_BK + (size_t)M_ROWS * 256 * 2;
constexpr size_t WS_BZ = WS_BV + (size_t)M_ROWS * 256 * 2;
constexpr size_t WS_CQ = WS_BZ + SZ_ROWS_BW;
constexpr size_t WS_CK = WS_CQ + (size_t)M_ROWS * 1024 * 2;
constexpr size_t WS_CV = WS_CK + (size_t)M_ROWS * 1024 * 2;
constexpr size_t WS_CO = WS_CV + SZ_ROWS_BW, WS_CZ = WS_CO + SZ_ROWS_BW;
constexpr size_t WS_G = WS_CZ + SZ_ROWS_BW;
constexpr size_t WS_IF = WS_G + (size_t)M_ROWS * 12288 * 2;
constexpr size_t WS_LNP = WS_IF + (size_t)M_ROWS * 8 * 4;
constexpr size_t WS_YA = WS_LNP + (size_t)M_ROWS * 32 * 8;
constexpr size_t WS_NUM = WS_YA + 3 * SZ_ROWS_BW;
constexpr size_t WS_SSQC = WS_NUM + SZ_ROWS_BW;
constexpr size_t WS_DN = WS_SSQC + (size_t)M_ROWS * 64 * 4;
constexpr size_t WS_MIX = WS_DN + (size_t)M_ROWS * 4 * 4;
constexpr size_t WS_OUT = WS_MIX + SZ_ROWS_D;
constexpr size_t WS_OUTP = WS_OUT + SZ_ROWS_D;
constexpr size_t WS_ERAW = WS_OUTP + (size_t)M_ROWS * 64 * 4;
constexpr size_t WS_ERP = WS_ERAW + SZ_ROWS_D;
constexpr size_t WS_RSO = WS_ERP + (size_t)M_ROWS * 64 * 4;
constexpr size_t WS_RSE = WS_RSO + (size_t)M_ROWS * 4;
constexpr size_t WS_X1B = WS_RSE + (size_t)M_ROWS * 4;
constexpr size_t WS_XSP = WS_X1B + SZ_ROWS_D;
constexpr size_t WS_X1B8 = WS_XSP + (size_t)M_ROWS * 64 * 4;
constexpr size_t WS_RSX = WS_X1B8 + (size_t)M_ROWS * DM;
constexpr size_t WS_XB8 = WS_RSX + (size_t)M_ROWS * 4;
constexpr size_t SZ_WG8 = (size_t)56 * 256 * DM;
constexpr size_t WS_WG8 = WS_XB8 + (size_t)M_ROWS * DM;
constexpr size_t WS_END = WS_WG8 + 2 * SZ_WG8;
static_assert(WS_WIN % 256 == 0 && WS_XB % 256 == 0 && WS_AU % 256 == 0 && WS_G % 256 == 0 && WS_YA % 256 == 0 && WS_MIX % 256 == 0 && WS_X1B % 256 == 0, "alignment");

#ifndef EPIIN_NT
#define EPIIN_NT 0
#endif
#if EPIIN_NT
#define EPIIN_STORE(v, p) __builtin_nontemporal_store((v), (p))
#else
#define EPIIN_STORE(v, p) (*(p) = (v))
#endif
#ifndef DBG_ZERO_ASC
#define DBG_ZERO_ASC 0
#endif
#ifndef P1G_FP8
#define P1G_FP8 1
#endif
#ifndef P5_I8
#define P5_I8 1
#endif
constexpr int CW_WMAX = 512;
#ifndef P5_FP8
#define P5_FP8 0
#endif
constexpr float W8_SCALE = 256.0f;
#ifndef EPI_NS16
#define EPI_NS16 0
#endif
#ifndef EPI_NS32
#define EPI_NS32 0
#endif
#ifndef EPIIN_NS
#define EPIIN_NS 0
#endif
namespace pg8 {
__device__ __forceinline__ unsigned pack_u8x4(float a, float b, float c, float d) {
    const unsigned q0 = (unsigned)(a * 255.0f + 0.5f), q1 = (unsigned)(b * 255.0f + 0.5f), q2 = (unsigned)(c * 255.0f + 0.5f), q3 = (unsigned)(d * 255.0f + 0.5f);
    return q0 | (q1 << 8) | (q2 << 16) | (q3 << 24);
}
template <bool F8> struct EpiInT {
    static constexpr bool PERM = true; static constexpr int NS = EPIIN_NS; static constexpr bool FP8 = F8; static constexpr bool I8 = false;
    __device__ __forceinline__ bool relax(const Unit& u) const { return u.pn < 122; }
    const gfloat* ssq; guchar* ws; const LAS float* rtab; int rowbase;
    __device__ __forceinline__ float rstd_of(int row) const { return rowbase >= 0 ? rtab[row - rowbase] : rsqrtf(ssq[row] * (1.0f / DM) + NORM_EPS); }
    __device__ __forceinline__ bool keep(const Unit&) const { return false; }
    __device__ __forceinline__ void operator()(f32x4 (&acc)[2][2][4][2], const Unit& u, int wr, int wc, int fr, int fq) const {
        const int pn = u.pn; const int row0 = u.pm * BM + wr * 64 + fr;
        size_t off; int ldc, t0, act; float sc = 1.f;
        if (pn < 16)       { off = WS_AU; ldc = 2048; t0 = 0; act = 6; }
        else if (pn < 24)  { off = WS_AV; ldc = 2048; t0 = 16; act = 5; }
        else if (pn < 32)  { off = WS_BQ; ldc = 2048; t0 = 24; act = 0; }
        else if (pn < 33)  { off = WS_BK; ldc = 256; t0 = 32; act = 0; }
        else if (pn < 34)  { off = WS_BV; ldc = 256; t0 = 33; act = 0; }
        else if (pn < 42)  { off = WS_BZ; ldc = 2048; t0 = 34; act = 2; }
        else if (pn < 46)  { off = WS_CQ; ldc = 1024; t0 = 42; act = 0; sc = 0.0625f; }
        else if (pn < 50)  { off = WS_CK; ldc = 1024; t0 = 46; act = 0; }
        else if (pn < 58)  { off = WS_CV; ldc = 2048; t0 = 50; act = 0; }
        else if (pn < 66)  { off = WS_CZ; ldc = 2048; t0 = 58; act = 2; }
        else if (pn < 122) { off = WS_G; ldc = 12288; t0 = 74; act = 3; if (F8) sc = 1.0f / W8_SCALE; }
        else if (F8)       { off = WS_CO; ldc = 2048; t0 = 122; act = 8; sc = 1.0f / W8_SCALE; }
        else               { off = WS_IF; ldc = 8; t0 = 122; act = 4; }
        const int col0 = (pn - t0) * BM + wc * 32 + 8 * fq;
        if (act == 4) {
            if (wc == 0 && fq == 0) {
                gfloat* dst = (gfloat*)(ws + off);
#pragma unroll
                for (int ai = 0; ai < 2; ++ai)
#pragma unroll
                    for (int m = 0; m < 4; ++m) { const int row = row0 + ai * HALF + m * 16; const float rs = rstd_of(row);
                        *(gf32x4*)(dst + (size_t)row * 8) = acc[ai][0][m][0] * rs; *(gf32x4*)(dst + (size_t)row * 8 + 4) = acc[ai][0][m][1] * rs; }
            }
            return;
        }
        gbf16* base = (gbf16*)(ws + off);
        if (act == 6 || act == 7) {
            const int colp = (pn - t0) * HALF + wc * 32 + 8 * fq;
#pragma unroll
            for (int ai = 0; ai < 2; ++ai)
#pragma unroll
                for (int m = 0; m < 4; ++m) {
                    const int row = row0 + ai * HALF + m * 16; const float rs = rstd_of(row);
                    f32x4 a0 = acc[ai][0][m][0] * rs, a1 = acc[ai][0][m][1] * rs; const f32x4 z0 = acc[ai][1][m][0] * rs, z1 = acc[ai][1][m][1] * rs;
                    if (act == 6) { const f32x2 a = gelu_pk((f32x2){a0[0], a0[1]}), b = gelu_pk((f32x2){a0[2], a0[3]}), c = gelu_pk((f32x2){a1[0], a1[1]}), d = gelu_pk((f32x2){a1[2], a1[3]});
                        a0 = (f32x4){a.x, a.y, b.x, b.y}; a1 = (f32x4){c.x, c.y, d.x, d.y}; }
                    else {
#pragma unroll
                        for (int j = 0; j < 4; ++j) { a0[j] = fsigmoid(a0[j]); a1[j] = fsigmoid(a1[j]); } }
#pragma unroll
                    for (int j = 0; j < 4; ++j) { a0[j] *= z0[j] * fsigmoid(z0[j]); a1[j] *= z1[j] * fsigmoid(z1[j]); }
                    u32x4 w; w.x = cvt_pk_bf16(a0[0], a0[1]); w.y = cvt_pk_bf16(a0[2], a0[3]); w.z = cvt_pk_bf16(a1[0], a1[1]); w.w = cvt_pk_bf16(a1[2], a1[3]);
                    *(gu32x4*)(base + tb128(row, colp, 16)) = w;
                }
            return;
        }
#pragma unroll
        for (int ai = 0; ai < 2; ++ai)
#pragma unroll
            for (int m = 0; m < 4; ++m) {
                const int row = row0 + ai * HALF + m * 16; const float rs = rstd_of(row) * sc;
                gbf16* rowp = base + tb256(row, col0, ldc >> 8); float ls = 0.f, lq = 0.f;
#pragma unroll
                for (int bj = 0; bj < 2; ++bj) {
                    f32x4 v0 = acc[ai][bj][m][0] * rs, v1 = acc[ai][bj][m][1] * rs;
                    if (act == 5) {
                        f32x2 a = gelu_pk((f32x2){v0[0], v0[1]}), b = gelu_pk((f32x2){v0[2], v0[3]}), c = gelu_pk((f32x2){v1[0], v1[1]}), d = gelu_pk((f32x2){v1[2], v1[3]});
                        v0 = (f32x4){a.x, a.y, b.x, b.y}; v1 = (f32x4){c.x, c.y, d.x, d.y};
                        { ls += (v0[0] + v0[1]) + (v0[2] + v0[3]) + (v1[0] + v1[1]) + (v1[2] + v1[3]);
                            lq += (v0[0] * v0[0] + v0[1] * v0[1]) + (v0[2] * v0[2] + v0[3] * v0[3]) + (v1[0] * v1[0] + v1[1] * v1[1]) + (v1[2] * v1[2] + v1[3] * v1[3]); }
                    } else if (act == 2) {
#pragma unroll
                        for (int j = 0; j < 4; ++j) { v0[j] = v0[j] * fsigmoid(v0[j]); v1[j] = v1[j] * fsigmoid(v1[j]); }
                    } else if (act == 3 || act == 8) {
#pragma unroll
                        for (int j = 0; j < 4; ++j) { v0[j] = fsigmoid(v0[j]); v1[j] = fsigmoid(v1[j]); }
                    }
                    if (act == 3) {
                        u32x2 w8; w8.x = pack_u8x4(v0[0], v0[1], v0[2], v0[3]); w8.y = pack_u8x4(v1[0], v1[1], v1[2], v1[3]);
                        *(gu32x2*)(ws + WS_G + ((size_t)(u.pm * 48 + (pn - 74)) * 256 + (row & 255)) * 256 + (wc * 32 + 8 * fq) + bj * HALF) = w8;
                    } else {
                    u32x4 w; w.x = cvt_pk_bf16(v0[0], v0[1]); w.y = cvt_pk_bf16(v0[2], v0[3]); w.z = cvt_pk_bf16(v1[0], v1[1]); w.w = cvt_pk_bf16(v1[2], v1[3]);
                    EPIIN_STORE(w, (gu32x4*)(rowp + bj * HALF)); }
                }
                if (act == 5) {
                    ls += __shfl_xor(ls, 16); ls += __shfl_xor(ls, 32); lq += __shfl_xor(lq, 16); lq += __shfl_xor(lq, 32);
                    if (fq == 0) *(gf32x2*)(ws + WS_LNP + ((size_t)row * 32 + (pn - 16) * 4 + wc) * 8) = (f32x2){ls, lq};
                }
            }
    }
};
using EpiIn = EpiInT<false>;
struct EpiBranch {
    static constexpr bool PERM = true; static constexpr int NS = EPI_NS16; static constexpr bool FP8 = false; static constexpr bool I8 = false;
    __device__ __forceinline__ bool relax(const Unit& u) const { return u.seg == 2; }
    const guchar* G; gbf16* MIX;
    __device__ __forceinline__ bool keep(const Unit& u) const { return u.seg != 2; }
    __device__ __forceinline__ void operator()(f32x4 (&acc)[2][2][4][2], const Unit& u, int wr, int wc, int fr, int fq) const {
        const int row0 = u.pm * BM + wr * 64 + fr, col0 = u.pn * BM + wc * 32 + 8 * fq; const int seg = u.seg;
        u32x2 ga[2][4][2], gb[2][4][2];
#pragma unroll
        for (int ai = 0; ai < 2; ++ai)
#pragma unroll
            for (int m = 0; m < 4; ++m) {
                const int row = row0 + ai * HALF + m * 16; const guchar* gp = G + ((size_t)(u.pm * 48 + seg * 16 + u.pn) * 256 + (row & 255)) * 256 + (wc * 32 + 8 * fq);
#pragma unroll
                for (int bj = 0; bj < 2; ++bj) { ga[ai][m][bj] = *(const gu32x2*)(gp + bj * HALF); gb[ai][m][bj] = (seg != 2) ? *(const gu32x2*)(gp + (size_t)16 * 65536 + bj * HALF) : (u32x2){255u * 0x01010101u, 255u * 0x01010101u}; }
            }
#pragma unroll
        for (int ai = 0; ai < 2; ++ai)
#pragma unroll
            for (int m = 0; m < 4; ++m) {
                const int row = row0 + ai * HALF + m * 16;
#pragma unroll
                for (int bj = 0; bj < 2; ++bj) {
                    const u32x2 a_ = ga[ai][m][bj], b_ = gb[ai][m][bj];
                    float f[8] = {(float)((a_.x >> (8 * 0)) & 0xffu), (float)((a_.x >> (8 * 1)) & 0xffu), (float)((a_.x >> (8 * 2)) & 0xffu), (float)((a_.x >> (8 * 3)) & 0xffu),
                                  (float)((a_.y >> (8 * 0)) & 0xffu), (float)((a_.y >> (8 * 1)) & 0xffu), (float)((a_.y >> (8 * 2)) & 0xffu), (float)((a_.y >> (8 * 3)) & 0xffu)};
                    const float h[8] = {(float)((b_.x >> (8 * 0)) & 0xffu), (float)((b_.x >> (8 * 1)) & 0xffu), (float)((b_.x >> (8 * 2)) & 0xffu), (float)((b_.x >> (8 * 3)) & 0xffu),
                                        (float)((b_.y >> (8 * 0)) & 0xffu), (float)((b_.y >> (8 * 1)) & 0xffu), (float)((b_.y >> (8 * 2)) & 0xffu), (float)((b_.y >> (8 * 3)) & 0xffu)};
#pragma unroll
                    for (int j = 0; j < 8; ++j) f[j] = fmaxf(f[j], 1e-18f) * __builtin_amdgcn_rcpf(fmaxf(h[j], 1e-18f));
                    f32x4 v0 = acc[ai][bj][m][0], v1 = acc[ai][bj][m][1];
                    v0 = v0 * (f32x4){f[0], f[1], f[2], f[3]}; v1 = v1 * (f32x4){f[4], f[5], f[6], f[7]};
                    if (seg != 2) { acc[ai][bj][m][0] = v0; acc[ai][bj][m][1] = v1; }
                    else { u32x4 w; w.x = cvt_pk_bf16(v0[0], v0[1]); w.y = cvt_pk_bf16(v0[2], v0[3]); w.z = cvt_pk_bf16(v1[0], v1[1]); w.w = cvt_pk_bf16(v1[2], v1[3]);
                        *(gu32x4*)(MIX + ablk(row, col0 + bj * HALF, DM)) = w; }
                }
            }
    }
};
struct EpiSq {
    static constexpr bool PERM = true; static constexpr int NS = EPI_NS16; static constexpr bool FP8 = false; static constexpr bool I8 = false;
    __device__ __forceinline__ bool relax(const Unit&) const { return true; }
    gbf16* O; gfloat* P;
    __device__ __forceinline__ bool keep(const Unit&) const { return false; }
    __device__ __forceinline__ void operator()(f32x4 (&acc)[2][2][4][2], const Unit& u, int wr, int wc, int fr, int fq) const {
        const int row0 = u.pm * BM + wr * 64 + fr, col0 = u.pn * BM + wc * 32 + 8 * fq;
#pragma unroll
        for (int ai = 0; ai < 2; ++ai)
#pragma unroll
            for (int m = 0; m < 4; ++m) {
                const int row = row0 + ai * HALF + m * 16; float q = 0.f;
#pragma unroll
                for (int bj = 0; bj < 2; ++bj) {
                    const f32x4 v0 = acc[ai][bj][m][0], v1 = acc[ai][bj][m][1];
                    q += (v0[0] * v0[0] + v0[1] * v0[1]) + (v0[2] * v0[2] + v0[3] * v0[3]) + (v1[0] * v1[0] + v1[1] * v1[1]) + (v1[2] * v1[2] + v1[3] * v1[3]);
                    u32x4 w; w.x = cvt_pk_bf16(v0[0], v0[1]); w.y = cvt_pk_bf16(v0[2], v0[3]); w.z = cvt_pk_bf16(v1[0], v1[1]); w.w = cvt_pk_bf16(v1[2], v1[3]);
                    if (O) *(gu32x4*)(O + (size_t)row * DM + col0 + bj * HALF) = w; else asm volatile("" :: "v"(w));
                }
                q += __shfl_xor(q, 16); q += __shfl_xor(q, 32);
                if (fq == 0) P[(size_t)row * 64 + u.pn * 4 + wc] = q;
            }
    }
};
struct EpiPle {
    static constexpr bool PERM = true; static constexpr int NS = EPI_NS32; static constexpr bool FP8 = P5_FP8 != 0; static constexpr bool I8 = P5_I8 != 0;
    __device__ __forceinline__ bool relax(const Unit&) const { return true; }
    const gbf16* X1B; gfloat* XOUT; gbf16* XB; const gbf16* ERAW; const gfloat* RSE; const gfloat* pnorm; gfloat* SSQN; int last; guchar* XB8; const gfloat* RSX; float swq;
    __device__ __forceinline__ bool keep(const Unit&) const { return false; }
    __device__ __forceinline__ void operator()(f32x4 (&acc)[2][2][4][2], const Unit& u, int wr, int wc, int fr, int fq) const {
        const int row0 = u.pm * BM + wr * 64 + fr, col0 = u.pn * BM + wc * 32 + 8 * fq; constexpr float ASC = FP8 ? (DBG_ZERO_ASC ? 0.0f : 1.0f / W8_SCALE) : 1.0f;
#pragma unroll
        for (int ai = 0; ai < 2; ++ai)
#pragma unroll
            for (int m = 0; m < 4; ++m) {
                const int row = row0 + ai * HALF + m * 16; const float rse = RSE[row]; float q = 0.f; const size_t ro = (size_t)row * DM; const float zsc = I8 ? RSX[row] * swq : ASC;
#pragma unroll
                for (int bj = 0; bj < 2; ++bj) {
                    const int col = col0 + bj * HALF;
                    const u32x4 xb = *(const gu32x4*)(X1B + ablk(row, col, DM)), eb = *(const gu32x4*)(ERAW + ro + col);
                    const f32x4 pna = *(const gf32x4*)(pnorm + col), pnb = *(const gf32x4*)(pnorm + col + 4);
                    const float x[8] = {bf_lo(xb.x), bf_hi(xb.x), bf_lo(xb.y), bf_hi(xb.y), bf_lo(xb.z), bf_hi(xb.z), bf_lo(xb.w), bf_hi(xb.w)};
                    const float e8[8] = {bf_lo(eb.x), bf_hi(eb.x), bf_lo(eb.y), bf_hi(eb.y), bf_lo(eb.z), bf_hi(eb.z), bf_lo(eb.w), bf_hi(eb.w)};
                    const float pn[8] = {pna[0], pna[1], pna[2], pna[3], pnb[0], pnb[1], pnb[2], pnb[3]};
                    const f32x4 a0 = acc[ai][bj][m][0], a1 = acc[ai][bj][m][1];
                    const float a[8] = {I8 ? (float)__float_as_int(a0[0]) : a0[0], I8 ? (float)__float_as_int(a0[1]) : a0[1], I8 ? (float)__float_as_int(a0[2]) : a0[2], I8 ? (float)__float_as_int(a0[3]) : a0[3],
                                        I8 ? (float)__float_as_int(a1[0]) : a1[0], I8 ? (float)__float_as_int(a1[1]) : a1[1], I8 ? (float)__float_as_int(a1[2]) : a1[2], I8 ? (float)__float_as_int(a1[3]) : a1[3]};
                    float r[8];
#pragma unroll
                    for (int j = 0; j < 8; ++j) { r[j] = x[j] + fsigmoid(a[j] * zsc) * (e8[j] * rse * pn[j]); q += r[j] * r[j]; }
                    if (last) { *(gf32x4*)(XOUT + ro + col) = (f32x4){r[0], r[1], r[2], r[3]}; *(gf32x4*)(XOUT + ro + col + 4) = (f32x4){r[4], r[5], r[6], r[7]}; }
                    else { u32x4 w; w.x = cvt_pk_bf16(r[0], r[1]); w.y = cvt_pk_bf16(r[2], r[3]); w.z = cvt_pk_bf16(r[4], r[5]); w.w = cvt_pk_bf16(r[6], r[7]); *(gu32x4*)(XB + ablk(row, col, DM)) = w;
                        if (P1G_FP8) { u32x2 w8; w8.x = pack_fp8x4(r[0], r[1], r[2], r[3]); w8.y = pack_fp8x4(r[4], r[5], r[6], r[7]); *(gu32x2*)(XB8 + ablk8(row, col, DM)) = w8; } }
                }
                if (!last) { q += __shfl_xor(q, 16); q += __shfl_xor(q, 32); if (fq == 0) SSQN[(size_t)row * 64 + u.pn * 4 + wc] = q; }
                if (m & 1) asm volatile("" ::: "memory");
            }
    }
};
}

constexpr int LDS_BYTES = 163840;
constexpr int MISC_OFF = LDS_BYTES - 128;
constexpr int ARGS_OFF = LDS_BYTES - 512;
constexpr int NWAVES = 8, NTHREADS = 512;

struct Ctx {
    LAS unsigned char* lds; int tid, lane, wave, vcu, G, bx;
};

struct TrTile { const gfloat* W; const gfloat* kscale; gbf16* WT; int ldw, K; guchar* W8; const gunsigned* QS; };
constexpr int TR_PER_LAYER = 7808 + 1536 + 1024 + 1024 + 64;
__device__ __forceinline__ TrTile tr_decode(int it, const gfloat* w_in, const gfloat* norm_pre, const gfloat* w_branch, const gfloat* w_out, const gfloat* ple_gate, const gfloat* ple_proj, guchar* ws) {
    const int l = it / TR_PER_LAYER; int r = it - l * TR_PER_LAYER; TrTile t; int kt, ntile; t.W8 = nullptr; t.QS = nullptr;
    if (r < 7808) { kt = r / 244; ntile = r - kt * 244; const int src = ntile < 116 ? ntile * 128 : ntile * 128 + 8;
        if (ntile < 16) ntile = 2 * ntile; else if (ntile < 32) ntile = ntile + 16; else if (ntile < 48) ntile = 2 * (ntile - 32) + 1;
        const int oblk = (ntile >= 116 && ntile < 132) ? ntile - 116 : -1; if (ntile >= 132 && ntile < 148) ntile -= 16;
        t.ldw = N_IN; t.K = DM; t.W = w_in + (size_t)l * DM * N_IN + (size_t)kt * 128 * N_IN + src; t.kscale = norm_pre + l * DM + kt * 128;
        t.WT = (gbf16*)(ws + WS_WIN + (size_t)l * SZ_WIN) + ((size_t)(ntile >> 1) * (DM / 64) + (size_t)kt * 2) * 16384 + (size_t)(ntile & 1) * 128 * 64;
        if (ntile >= 148) t.W8 = ws + WS_WG8 + (size_t)l * SZ_WG8 + ((size_t)((ntile - 148) >> 1) * (DM / 128) + (size_t)kt) * 32768 + (size_t)(ntile & 1) * 128 * 128;
        if (oblk >= 0) t.W8 = ws + WS_WG8 + (size_t)l * SZ_WG8 + ((size_t)(48 + (oblk >> 1)) * (DM / 128) + (size_t)kt) * 32768 + (size_t)(oblk & 1) * 128 * 128;
        return t; }
    r -= 7808; t.kscale = nullptr; t.ldw = DM;
    if (r < 1536) { const int j = r / 512; const int rr = r - j * 512; kt = rr / 32; ntile = rr - kt * 32; t.K = BW;
        t.W = w_branch + ((size_t)(l * 3 + j) * BW + (size_t)kt * 128) * DM + ntile * 128;
        t.WT = (gbf16*)(ws + WS_WBR + (size_t)l * SZ_WBR) + (size_t)j * DM * BW + ((size_t)(ntile >> 1) * (BW / 64) + (size_t)kt * 2) * 16384 + (size_t)(ntile & 1) * 128 * 64; return t; }
    r -= 1536;
    if (r < 2048) { const int which = r / 1024; const int rr = r - which * 1024; kt = rr / 32; ntile = rr - kt * 32; t.K = DM;
        t.W = (which ? ple_gate : w_out) + ((size_t)l * DM + (size_t)kt * 128) * DM + ntile * 128;
        t.WT = (gbf16*)(ws + (which ? WS_WPG : WS_WOUT) + (size_t)l * SZ_WSQ) + ((size_t)(ntile >> 1) * (DM / 64) + (size_t)kt * 2) * 16384 + (size_t)(ntile & 1) * 128 * 64;
        if (P5_I8 && which) t.QS = (const gunsigned*)(ws + WS_CTL) + CW_WMAX + l;
        if ((P5_FP8 || P5_I8) && which) t.W8 = ws + WS_WPG + (size_t)l * SZ_WSQ + ((size_t)(ntile >> 1) * (DM / 128) + (size_t)kt) * 32768 + (size_t)(ntile & 1) * 128 * 128;
        return t; }
    r -= 2048; kt = r / 32; ntile = r - kt * 32; t.K = 256;
    t.W = ple_proj + ((size_t)l * 256 + (size_t)kt * 128) * DM + ntile * 128;
    t.WT = (gbf16*)(ws + WS_WPP + (size_t)l * SZ_WPP) + ((size_t)(ntile >> 1) * (256 / 64) + (size_t)kt * 2) * 16384 + (size_t)(ntile & 1) * 128 * 64; return t;
}
#ifndef TR_NTLOAD
#define TR_NTLOAD 0
#endif
#ifndef TR_REVERSE
#define TR_REVERSE 1
#endif
__device__ __forceinline__ void tr_run(const Ctx& F, int it0, int it1, int sk0, int sk1, int me, int nw, const gfloat* w_in, const gfloat* norm_pre, const gfloat* w_branch,
                                       const gfloat* w_out, const gfloat* ple_gate, const gfloat* ple_proj, guchar* ws) {
    int tid = F.tid; LAUNDER_V(tid);
    {
        constexpr int RS = 264; const int NIT = it1 - it0 - (sk1 - sk0);
        const int c4 = tid & 31, kr = tid >> 5, kc = tid & 15;
        f32x4 va[8], vb[8]; float ka[8], kb[8]; TrTile ta, tb;
#define TR_LOAD(T_, V_, K_, IT_) do { const int ir_ = TR_REVERSE ? (NIT - 1 - (IT_)) : (IT_); T_ = tr_decode(it0 + ir_ + (((it0 + ir_) >= sk0) ? (sk1 - sk0) : 0), w_in, norm_pre, w_branch, w_out, ple_gate, ple_proj, ws); \
        _Pragma("unroll") for (int i = 0; i < 8; ++i) { V_[i] = TR_NTLOAD ? __builtin_nontemporal_load((const gf32x4*)(T_.W + (size_t)(i * 16 + kr) * T_.ldw + 4 * c4)) : *(const gf32x4*)(T_.W + (size_t)(i * 16 + kr) * T_.ldw + 4 * c4); K_[i] = T_.kscale ? T_.kscale[i * 16 + kr] : 1.0f; } } while (0)
#define TR_PUT(V_, K_) do { _Pragma("unroll") for (int i = 0; i < 8; ++i) { const f32x4 a = V_[i] * K_[i]; u32x2 w; w.x = cvt_pk_bf16(a[0], a[1]); w.y = cvt_pk_bf16(a[2], a[3]); \
        *(LAS u32x2*)(F.lds + (i * 16 + kr) * RS + c4 * 8) = w; } } while (0)
#define TR_GET(WT_, W8_, QS_) do { _Pragma("unroll") for (int q = 0; q < 4; ++q) { const int n = 32 * q + (tid >> 4), kq = kc; \
        const LAS bf16_t* s = (const LAS bf16_t*)(F.lds + (8 * kq) * RS + 2 * n); unsigned e[8]; \
        _Pragma("unroll") for (int j = 0; j < 8; ++j) e[j] = s[j * (RS / 2)]; \
        if (QS_) { const float qs_ = 127.0f / fmaxf(__uint_as_float(*(QS_)), 1e-30f); u32x2 o8; \
            o8.x = pack_i8x4(__uint_as_float(e[0] << 16) * qs_, __uint_as_float(e[1] << 16) * qs_, __uint_as_float(e[2] << 16) * qs_, __uint_as_float(e[3] << 16) * qs_); \
            o8.y = pack_i8x4(__uint_as_float(e[4] << 16) * qs_, __uint_as_float(e[5] << 16) * qs_, __uint_as_float(e[6] << 16) * qs_, __uint_as_float(e[7] << 16) * qs_); \
            *(gu32x2*)((W8_) + n * 128 + 8 * kq) = o8; } \
        else if (W8_) { u32x2 o8; o8.x = pack_fp8x4(__uint_as_float(e[0] << 16) * W8_SCALE, __uint_as_float(e[1] << 16) * W8_SCALE, __uint_as_float(e[2] << 16) * W8_SCALE, __uint_as_float(e[3] << 16) * W8_SCALE); \
            o8.y = pack_fp8x4(__uint_as_float(e[4] << 16) * W8_SCALE, __uint_as_float(e[5] << 16) * W8_SCALE, __uint_as_float(e[6] << 16) * W8_SCALE, __uint_as_float(e[7] << 16) * W8_SCALE); \
            *(gu32x2*)((W8_) + n * 128 + 8 * kq) = o8; } \
        else { u32x4 o; o.x = e[0] | (e[1] << 16); o.y = e[2] | (e[3] << 16); o.z = e[4] | (e[5] << 16); o.w = e[6] | (e[7] << 16); \
        *(gu32x4*)(WT_ + (size_t)(kq >> 3) * 16384 + n * 64 + 8 * (kq & 7)) = o; } } } while (0)
        int it = me;
        if (it < NIT) TR_LOAD(ta, va, ka, it);
        if (it + nw < NIT) TR_LOAD(tb, vb, kb, it + nw);
        while (it < NIT) {
            { TR_PUT(va, ka); __syncthreads(); gbf16* wt = ta.WT; guchar* kk = ta.W8; const gunsigned* qp = ta.QS;
              if (it + 2 * nw < NIT) TR_LOAD(ta, va, ka, it + 2 * nw);
              TR_GET(wt, kk, qp); __syncthreads(); }
            it += nw; if (it >= NIT) break;
            { TR_PUT(vb, kb); __syncthreads(); gbf16* wt = tb.WT; guchar* kk = tb.W8; const gunsigned* qp = tb.QS;
              if (it + 2 * nw < NIT) TR_LOAD(tb, vb, kb, it + 2 * nw);
              TR_GET(wt, kk, qp); __syncthreads(); }
            it += nw;
        }
#undef TR_LOAD
#undef TR_PUT
#undef TR_GET
    }
}
#ifndef TR_NODEFER
#define TR_NODEFER 0
#endif
constexpr int TR_PG0 = 7808 + 1536 + 1024, TR_PG1 = TR_PER_LAYER + TR_PG0;
constexpr int TR_DEFER0 = TR_PER_LAYER + 7808 + 1536, TR_DEFER1 = TR_DEFER0 + (TR_NODEFER ? 0 : 2048);
__device__ __forceinline__ void p0_prologue(const Ctx& F, const gfloat* x, const gfloat* p, const gint* positions, const gfloat* norm_pre, const gfloat* w_in, const gfloat* w_branch,
                                            const gfloat* w_out, const gfloat* ple_gate, const gfloat* ple_proj, guchar* ws) {
    int tid = F.tid; LAUNDER_V(tid);
#if P5_I8
    tr_run(F, 0, TR_PG1, TR_PG0, TR_PG0 + 1024, F.vcu, F.G, w_in, norm_pre, w_branch, w_out, ple_gate, ple_proj, ws);
    tr_run(F, TR_PG1 + 1024, NLAYER * TR_PER_LAYER, 0x7fffffff, 0x7fffffff, F.vcu, F.G, w_in, norm_pre, w_branch, w_out, ple_gate, ple_proj, ws);
    { const int gt_ = F.vcu * NTHREADS + tid, NGT_ = F.G * NTHREADS;
      for (int l = 0; l < NLAYER; ++l) { const gf32x4* wp = (const gf32x4*)(ple_gate + (size_t)l * DM * DM); float mx = 0.f;
          for (int i0 = gt_; i0 < DM * DM / 4; i0 += 8 * NGT_) { f32x4 a[8];
#pragma unroll
              for (int j = 0; j < 8; ++j) { const int i = i0 + j * NGT_; a[j] = wp[i < DM * DM / 4 ? i : i0]; }
#pragma unroll
              for (int j = 0; j < 8; ++j) mx = fmaxf(mx, fmaxf(fmaxf(fabsf(a[j][0]), fabsf(a[j][1])), fmaxf(fabsf(a[j][2]), fabsf(a[j][3])))); }
#pragma unroll
          for (int s = 32; s >= 1; s >>= 1) mx = fmaxf(mx, __shfl_xor(mx, s));
          if (F.lane == 0) atomicMax((unsigned*)((gunsigned*)(ws + WS_CTL) + CW_WMAX + l), __float_as_uint(mx)); } }
#else
    tr_run(F, 0, NLAYER * TR_PER_LAYER, TR_DEFER0, TR_DEFER1, F.vcu, F.G, w_in, norm_pre, w_branch, w_out, ple_gate, ple_proj, ws);
#endif
    const int gt = F.vcu * NTHREADS + tid, NGT = F.G * NTHREADS;
    for (int i = gt; i < NLAYER * 256 * DM; i += NGT) { const int l = i / (256 * DM), rr = (i / DM) & 255, k = i & (DM - 1);
        float val = 0.f; if (rr < 8) val = w_in[(size_t)l * DM * N_IN + (size_t)k * N_IN + IF_COL + rr] * norm_pre[l * DM + k];
        ((gbf16*)(ws + WS_WIN + (size_t)l * SZ_WIN))[((size_t)122 * (DM / 64) + (k >> 6)) * 16384 + rr * 64 + (k & 63)] = (bf16_t)(cvt_pk_bf16(val, 0.f) & 0xffffu); }
    for (int i = gt; i < NLAYER * M_ROWS * 256 / 4; i += NGT) { const f32x4 a = ((const gf32x4*)p)[i]; u32x2 w; w.x = cvt_pk_bf16(a[0], a[1]); w.y = cvt_pk_bf16(a[2], a[3]);
        const int l = i / (M_ROWS * 64), r = (i >> 6) & (M_ROWS - 1), c = (i & 63) * 4; *(gu32x2*)((gbf16*)(ws + WS_PB) + (size_t)l * M_ROWS * 256 + ablk(r, c, 256)) = w; }
    for (int i = gt; i < M_ROWS * 8; i += NGT) { const int row = i >> 3, j = i & 7; const float inv = powf(500000.0f, -(float)j * 0.125f); const float ang = (float)positions[row] * inv;
        gfloat* cs = (gfloat*)(ws + WS_CS) + (size_t)row * 16; cs[j] = cosf(ang); cs[8 + j] = sinf(ang); }
    { const int gw = F.vcu * NWAVES + F.wave, NGW = F.G * NWAVES;
      for (int m = gw; m < M_ROWS; m += NGW) { const gf32x4* xr = (const gf32x4*)(x + (size_t)m * DM) + F.lane; gbf16* o = (gbf16*)(ws + WS_XB); float s = 0.f;
#pragma unroll
          for (int j = 0; j < 16; ++j) { const f32x4 a = xr[64 * j]; s += (a[0] * a[0] + a[1] * a[1]) + (a[2] * a[2] + a[3] * a[3]); u32x2 w; w.x = cvt_pk_bf16(a[0], a[1]); w.y = cvt_pk_bf16(a[2], a[3]); *(gu32x2*)(o + ablk(m, (F.lane + 64 * j) * 4, DM)) = w;
              if (P1G_FP8) *(gunsigned*)(ws + WS_XB8 + ablk8(m, (F.lane + 64 * j) * 4, DM)) = pack_fp8x4(a[0], a[1], a[2], a[3]); }
          s = wave_sum(s); if (F.lane == 0) ((gfloat*)(ws + WS_SSQ0))[m] = s; } }
}

__device__ __forceinline__ u32x2 pack4(const f32x4 v) { u32x2 w; w.x = cvt_pk_bf16(v[0], v[1]); w.y = cvt_pk_bf16(v[2], v[3]); return w; }
__device__ __forceinline__ bf16x8 mk_frag(const u32x2 lo, const u32x2 hi) { const u32x4 t = {lo.x, lo.y, hi.x, hi.y}; return __builtin_bit_cast(bf16x8, t); }
__device__ __forceinline__ bf16x8 frag_const(unsigned w) { const u32x4 t = {w, w, w, w}; return __builtin_bit_cast(bf16x8, t); }

constexpr int GM_RS = 288, GM_WL = 0, GM_VT = 128 * GM_RS, GM_ST = GM_VT + 256 * GM_RS;
__device__ __forceinline__ void gmlp_unit(const Ctx& F, int b, int n, int g, guchar* ws, const gfloat* ln_g, const gfloat* ln_b, const gfloat* wsp, const gfloat* bsp) {
    int tid = F.tid; LAUNDER_V(tid); const int lane = tid & 63, w = F.wave, r16 = lane & 15, q4 = lane >> 4;
    const int row0 = b * SEQ + n * 128, c0 = g * 256;
    const gbf16* AU = (const gbf16*)(ws + WS_AU); const gbf16* AV = (const gbf16*)(ws + WS_AV); gbf16* YA = (gbf16*)(ws + WS_YA);
    u32x4 raw[8];
#pragma unroll
    for (int k = 0; k < 8; ++k) { const int item = tid + 512 * k, s = item & 127, ch = item >> 7; raw[k] = *(const gu32x4*)(AV + tb256(row0 + s, c0 + 8 * ch, 8)); }
    f32x4 wt[8];
#pragma unroll
    for (int k = 0; k < 8; ++k) { const int item = tid + 512 * k, t = item >> 5, ch = item & 31; wt[k] = *(const gf32x4*)(wsp + ((size_t)(g * 128 + t)) * 128 + 4 * ch); }
    { const gf32x4* pp = (const gf32x4*)(ws + WS_LNP) + (size_t)(row0 + (tid & 127)) * 16 + (tid >> 7) * 4; float s = 0.f, q = 0.f;
#pragma unroll
        for (int j = 0; j < 4; ++j) { const f32x4 t = pp[j]; s += t[0] + t[2]; q += t[1] + t[3]; }
        *(LAS f32x2*)(F.lds + GM_ST + 1024 + ((tid >> 7) * 128 + (tid & 127)) * 8) = (f32x2){s, q}; }
#pragma unroll
    for (int k = 0; k < 8; ++k) { const int item = tid + 512 * k, t = item >> 5, ch = item & 31; f32x4 a = wt[k];
#pragma unroll
        for (int e = 0; e < 4; ++e) if (4 * ch + e > t) a[e] = 0.f;
        *(LAS u32x2*)(F.lds + GM_WL + t * GM_RS + ch * 8) = pack4(a); }
    __syncthreads();
    if (tid < 128) { float s = 0.f, q = 0.f;
#pragma unroll
        for (int j = 0; j < 4; ++j) { const f32x2 t = *(const LAS f32x2*)(F.lds + GM_ST + 1024 + (j * 128 + tid) * 8); s += t.x; q += t.y; }
        const float mu = s * (1.0f / BW); const float var = fmaxf(q * (1.0f / BW) - mu * mu, 0.f);
        *(LAS f32x2*)(F.lds + GM_ST + tid * 8) = (f32x2){mu, rsqrtf(var + NORM_EPS)}; }
    __syncthreads();
#pragma unroll
    for (int k = 0; k < 8; ++k) { const int item = tid + 512 * k, s = item & 127, ch = item >> 7;
        const f32x4 g0 = *(const gf32x4*)(ln_g + c0 + 8 * ch), g1 = *(const gf32x4*)(ln_g + c0 + 8 * ch + 4), b0 = *(const gf32x4*)(ln_b + c0 + 8 * ch), b1 = *(const gf32x4*)(ln_b + c0 + 8 * ch + 4);
        const f32x2 st = *(const LAS f32x2*)(F.lds + GM_ST + s * 8);
        const float xv[8] = {bf_lo(raw[k].x), bf_hi(raw[k].x), bf_lo(raw[k].y), bf_hi(raw[k].y), bf_lo(raw[k].z), bf_hi(raw[k].z), bf_lo(raw[k].w), bf_hi(raw[k].w)};
        const float gg[8] = {g0[0], g0[1], g0[2], g0[3], g1[0], g1[1], g1[2], g1[3]}, bb[8] = {b0[0], b0[1], b0[2], b0[3], b1[0], b1[1], b1[2], b1[3]};
#pragma unroll
        for (int i = 0; i < 8; ++i) { const float y = (xv[i] - st.x) * st.y * gg[i] + bb[i];
            *(LAS bf16_t*)(F.lds + GM_VT + (8 * ch + i) * GM_RS + 2 * s) = (bf16_t)(cvt_pk_bf16(y, 0.f) & 0xffffu); } }
    u32x4 ub[8]; float bsv[8];
#pragma unroll
    for (int n8 = 0; n8 < 8; ++n8) { const int t = 16 * n8 + r16; ub[n8] = *(const gu32x4*)(AU + tb128(row0 + t, c0 + 32 * w + 8 * q4, 16)); bsv[n8] = bsp[g * 128 + t]; }
    __syncthreads();
    f32x4 acc[2][8];
#pragma unroll
    for (int m = 0; m < 2; ++m)
#pragma unroll
        for (int n8 = 0; n8 < 8; ++n8) acc[m][n8] = (f32x4){0.f, 0.f, 0.f, 0.f};
    bf16x8 af[2][4];
#pragma unroll
    for (int m = 0; m < 2; ++m)
#pragma unroll
        for (int ks = 0; ks < 4; ++ks) af[m][ks] = *(const LAS bf16x8*)(F.lds + GM_VT + (32 * w + 8 * (r16 >> 2) + 4 * m + (r16 & 3)) * GM_RS + ks * 64 + q4 * 16);
#pragma unroll
    for (int n8 = 0; n8 < 8; ++n8)
#pragma unroll
        for (int ks = 0; ks < 4; ++ks) if (ks <= n8 / 2) {
            const bf16x8 bfr = *(const LAS bf16x8*)(F.lds + GM_WL + (16 * n8 + r16) * GM_RS + ks * 64 + q4 * 16);
#pragma unroll
            for (int m = 0; m < 2; ++m) acc[m][n8] = MFMA16(af[m][ks], bfr, acc[m][n8]); }
#pragma unroll
    for (int n8 = 0; n8 < 8; ++n8) { const int t = 16 * n8 + r16; const size_t roy = ablk(row0 + t, c0 + 32 * w + 8 * q4, BW);
        const f32x4 a0 = acc[0][n8] + bsv[n8], a1 = acc[1][n8] + bsv[n8]; u32x4 y;
        y.x = cvt_pk_bf16(a0[0] * bf_lo(ub[n8].x), a0[1] * bf_hi(ub[n8].x)); y.y = cvt_pk_bf16(a0[2] * bf_lo(ub[n8].y), a0[3] * bf_hi(ub[n8].y));
        y.z = cvt_pk_bf16(a1[0] * bf_lo(ub[n8].z), a1[1] * bf_hi(ub[n8].z)); y.w = cvt_pk_bf16(a1[2] * bf_lo(ub[n8].w), a1[3] * bf_hi(ub[n8].w));
        *(gu32x4*)(YA + roy) = y; }
    __syncthreads();
}

constexpr int SW_RS = 160, SW_VS = 528, SW_KL = 0, SW_VT = 256 * SW_RS, SW_QL = SW_VT + 64 * SW_VS, SW_QL2 = SW_QL + 128 * SW_RS, SW_CS = SW_QL2 + 128 * SW_RS;
static_assert(SW_CS + 384 * 64 <= ARGS_OFF, "SWA LDS map");
__device__ __forceinline__ void rope8(const u32x4 a, const u32x4 bq, const gfloat* cs, float scale, u32x4& o1, u32x4& o2) {
    const f32x4 c0 = *(const gf32x4*)cs, c1 = *(const gf32x4*)(cs + 4), s0 = *(const gf32x4*)(cs + 8), s1 = *(const gf32x4*)(cs + 12);
    const float t1[8] = {bf_lo(a.x), bf_hi(a.x), bf_lo(a.y), bf_hi(a.y), bf_lo(a.z), bf_hi(a.z), bf_lo(a.w), bf_hi(a.w)};
    const float t2[8] = {bf_lo(bq.x), bf_hi(bq.x), bf_lo(bq.y), bf_hi(bq.y), bf_lo(bq.z), bf_hi(bq.z), bf_lo(bq.w), bf_hi(bq.w)};
    const float cc[8] = {c0[0], c0[1], c0[2], c0[3], c1[0], c1[1], c1[2], c1[3]}, ss[8] = {s0[0], s0[1], s0[2], s0[3], s1[0], s1[1], s1[2], s1[3]};
    float r1[8], r2[8];
#pragma unroll
    for (int i = 0; i < 8; ++i) { r1[i] = (t1[i] * cc[i] - t2[i] * ss[i]) * scale; r2[i] = (t2[i] * cc[i] + t1[i] * ss[i]) * scale; }
    o1 = (u32x4){cvt_pk_bf16(r1[0], r1[1]), cvt_pk_bf16(r1[2], r1[3]), cvt_pk_bf16(r1[4], r1[5]), cvt_pk_bf16(r1[6], r1[7])};
    o2 = (u32x4){cvt_pk_bf16(r2[0], r2[1]), cvt_pk_bf16(r2[2], r2[3]), cvt_pk_bf16(r2[4], r2[5]), cvt_pk_bf16(r2[6], r2[7])};
}
__device__ __forceinline__ u32x4 scale8(const u32x4 a, float sc) {
    return (u32x4){cvt_pk_bf16(bf_lo(a.x) * sc, bf_hi(a.x) * sc), cvt_pk_bf16(bf_lo(a.y) * sc, bf_hi(a.y) * sc), cvt_pk_bf16(bf_lo(a.z) * sc, bf_hi(a.z) * sc), cvt_pk_bf16(bf_lo(a.w) * sc, bf_hi(a.w) * sc)};
}
__device__ __forceinline__ void swa_unit(const Ctx& F, int b, int n, int hk, guchar* ws, const gfloat* sinks) {
    int tid = F.tid; LAUNDER_V(tid); const int lane = tid & 63, w = F.wave, r16 = lane & 15, q4 = lane >> 4;
    const int r0 = b * SEQ + n * 128, kr0 = r0 - 128;
    const gbf16* BQ = (const gbf16*)(ws + WS_BQ); const gbf16* BK = (const gbf16*)(ws + WS_BK); const gbf16* BV = (const gbf16*)(ws + WS_BV); const gbf16* BZ = (const gbf16*)(ws + WS_BZ);
    gbf16* YB = (gbf16*)(ws + WS_YA) + (size_t)M_ROWS * BW; const gfloat* CS = (const gfloat*)(ws + WS_CS);
    const int kch = tid & 7;
    u32x4 kraw[4], vraw[4]; f32x4 csr[3]; u32x4 qa[2];
#pragma unroll
    for (int k = 0; k < 4; ++k) { const int key = (tid + 512 * k) >> 3; const bool pad = (n == 0 && key < 128);
        kraw[k] = *(const gu32x4*)(BK + (size_t)(pad ? r0 : kr0 + key) * 256 + hk * 64 + 8 * kch); }
#pragma unroll
    for (int k = 0; k < 4; ++k) { const int item = tid + 512 * k, key = item & 255, ch = item >> 8; const bool pad = (n == 0 && key < 128);
        vraw[k] = *(const gu32x4*)(BV + (size_t)(pad ? r0 : kr0 + key) * 256 + hk * 64 + 8 * ch); }
#pragma unroll
    for (int k = 0; k < 3; ++k) { const int item = tid + 512 * k, r = item >> 2, part = item & 3; const int row = r < 256 ? ((n == 0 && r < 128) ? r0 : kr0 + r) : r0 + r - 256;
        csr[k] = *(const gf32x4*)(CS + (size_t)row * 16 + part * 4); }
#define SW_QLOAD(hq_) do { _Pragma("unroll") for (int k_ = 0; k_ < 2; ++k_) { const int qr_ = (tid + 512 * k_) >> 3; qa[k_] = *(const gu32x4*)(BQ + tb256(r0 + qr_, (hq_) * 64, 8) + 8 * kch); } } while (0)
    SW_QLOAD(hk * 8);
#pragma unroll
    for (int k = 0; k < 3; ++k) { const int item = tid + 512 * k; *(LAS f32x4*)(F.lds + SW_CS + item * 16) = csr[k]; }
#pragma unroll
    for (int k = 0; k < 4; ++k) { const int item = tid + 512 * k, key = item & 255, ch = item >> 8; const bool pad = (n == 0 && key < 128);
        const u32x4 raw = pad ? (u32x4){0u, 0u, 0u, 0u} : vraw[k]; const unsigned e[4] = {raw.x, raw.y, raw.z, raw.w};
#pragma unroll
        for (int i = 0; i < 8; ++i) *(LAS bf16_t*)(F.lds + SW_VT + (8 * ch + i) * SW_VS + 2 * key) = (bf16_t)((e[i >> 1] >> ((i & 1) * 16)) & 0xffffu); }
    __syncthreads();
#define SW_PUT(raw_, csrow_, dst_, scale_) do { const u32x4 own_ = (raw_); u32x4 par_; \
        par_.x = (unsigned)__builtin_amdgcn_update_dpp(0, (int)own_.x, 0xB1, 0xf, 0xf, false); par_.y = (unsigned)__builtin_amdgcn_update_dpp(0, (int)own_.y, 0xB1, 0xf, 0xf, false); \
        par_.z = (unsigned)__builtin_amdgcn_update_dpp(0, (int)own_.z, 0xB1, 0xf, 0xf, false); par_.w = (unsigned)__builtin_amdgcn_update_dpp(0, (int)own_.w, 0xB1, 0xf, 0xf, false); \
        u32x4 o_; \
        if (kch < 2) { const LAS float* cs_ = (const LAS float*)(F.lds + SW_CS + (csrow_) * 64); \
            const f32x4 c0_ = *(const LAS f32x4*)cs_, c1_ = *(const LAS f32x4*)(cs_ + 4), s0_ = *(const LAS f32x4*)(cs_ + 8), s1_ = *(const LAS f32x4*)(cs_ + 12); \
            const float sg_ = kch == 0 ? -(scale_) : (scale_); \
            const float t_[8] = {bf_lo(own_.x), bf_hi(own_.x), bf_lo(own_.y), bf_hi(own_.y), bf_lo(own_.z), bf_hi(own_.z), bf_lo(own_.w), bf_hi(own_.w)}; \
            const float u_[8] = {bf_lo(par_.x), bf_hi(par_.x), bf_lo(par_.y), bf_hi(par_.y), bf_lo(par_.z), bf_hi(par_.z), bf_lo(par_.w), bf_hi(par_.w)}; \
            const float cc_[8] = {c0_[0], c0_[1], c0_[2], c0_[3], c1_[0], c1_[1], c1_[2], c1_[3]}, ss_[8] = {s0_[0], s0_[1], s0_[2], s0_[3], s1_[0], s1_[1], s1_[2], s1_[3]}; \
            float r_[8]; _Pragma("unroll") for (int i_ = 0; i_ < 8; ++i_) r_[i_] = (t_[i_] * cc_[i_]) * (scale_) + (u_[i_] * ss_[i_]) * sg_; \
            o_ = (u32x4){cvt_pk_bf16(r_[0], r_[1]), cvt_pk_bf16(r_[2], r_[3]), cvt_pk_bf16(r_[4], r_[5]), cvt_pk_bf16(r_[6], r_[7])}; } \
        else o_ = ((scale_) == 1.0f) ? own_ : scale8(own_, (scale_)); \
        *(LAS u32x4*)((dst_) + kch * 16) = o_; } while (0)
#pragma unroll
    for (int k = 0; k < 4; ++k) { const int key = (tid + 512 * k) >> 3; const bool pad = (n == 0 && key < 128);
        const u32x4 kz = pad ? (u32x4){0u, 0u, 0u, 0u} : kraw[k]; SW_PUT(kz, key, F.lds + SW_KL + key * SW_RS, 1.0f); }
#define SW_QWRITE(buf_) do { _Pragma("unroll") for (int k_ = 0; k_ < 2; ++k_) { const int qr_ = (tid + 512 * k_) >> 3; SW_PUT(qa[k_], 256 + qr_, F.lds + (buf_) + qr_ * SW_RS, 0.125f); } } while (0)
    SW_QWRITE(SW_QL);
    __syncthreads();
    for (int hi = 0; hi < 8; ++hi) {
        const int hq = hk * 8 + hi; const int qcur = (hi & 1) ? SW_QL2 : SW_QL, qnxt = (hi & 1) ? SW_QL : SW_QL2;
        SW_QLOAD((hi < 7 ? hq + 1 : hq));
        const u32x4 zb0 = *(const gu32x4*)(BZ + tb256(r0 + 16 * w + r16, hq * 64 + 8 * q4, 8)), zb1 = *(const gu32x4*)(BZ + tb256(r0 + 16 * w + r16, hq * 64 + 8 * q4 + 32, 8));
        bf16x8 bq[2];
#pragma unroll
        for (int ks = 0; ks < 2; ++ks) bq[ks] = *(const LAS bf16x8*)(F.lds + qcur + (16 * w + r16) * SW_RS + ks * 64 + q4 * 16);
        f32x4 s[10];
#pragma unroll
        for (int j = 0; j < 9; ++j) { s[j] = (f32x4){0.f, 0.f, 0.f, 0.f};
#pragma unroll
            for (int ks = 0; ks < 2; ++ks) { const bf16x8 a = *(const LAS bf16x8*)(F.lds + SW_KL + (16 * (w + j) + r16) * SW_RS + ks * 64 + q4 * 16); s[j] = MFMA16(a, bq[ks], s[j]); } }
        s[9] = (f32x4){0.f, 0.f, 0.f, 0.f};
        const int qi = 16 * w + r16; const float sink = sinks[hq]; float mx = sink;
#pragma unroll
        for (int j = 0; j < 9; ++j)
#pragma unroll
            for (int e = 0; e < 4; ++e) { const int kj = 16 * (w + j) + 4 * q4 + e; const bool valid = (kj > qi) && (kj <= qi + 128) && (n > 0 || kj >= 128);
                s[j][e] = valid ? s[j][e] : -1e30f; mx = fmaxf(mx, s[j][e]); }
        mx = fmaxf(mx, __shfl_xor(mx, 16)); mx = fmaxf(mx, __shfl_xor(mx, 32));
        float sum = 0.f;
#pragma unroll
        for (int j = 0; j < 9; ++j)
#pragma unroll
            for (int e = 0; e < 4; ++e) { const float pv = (s[j][e] > -1e29f) ? __expf(s[j][e] - mx) : 0.f; s[j][e] = pv; sum += pv; }
        sum += __shfl_xor(sum, 16); sum += __shfl_xor(sum, 32); sum += __expf(sink - mx);
        const float inv = 1.0f / sum;
        f32x4 o[4];
#pragma unroll
        for (int dt = 0; dt < 4; ++dt) o[dt] = (f32x4){0.f, 0.f, 0.f, 0.f};
#pragma unroll
        for (int kk = 0; kk < 5; ++kk) { const bf16x8 pf = mk_frag(pack4(s[2 * kk]), pack4(s[2 * kk + 1]));
            const int t0 = w + 2 * kk, t1 = (w + 2 * kk + 1) > 15 ? 15 : (w + 2 * kk + 1);
#pragma unroll
            for (int dt = 0; dt < 4; ++dt) { const LAS unsigned char* vrow = F.lds + SW_VT + (32 * (dt >> 1) + 8 * (r16 >> 2) + 4 * (dt & 1) + (r16 & 3)) * SW_VS + (4 * q4) * 2;
                const bf16x8 a = mk_frag(*(const LAS u32x2*)(vrow + 32 * t0), *(const LAS u32x2*)(vrow + 32 * t1)); o[dt] = MFMA16(a, pf, o[dt]); } }
        const size_t ro = (size_t)(r0 + qi) * BW + hq * 64 + 8 * q4;
#pragma unroll
        for (int pp = 0; pp < 2; ++pp) { const u32x4 zb = pp ? zb1 : zb0; const f32x4 oa = o[2 * pp] * inv, ob2 = o[2 * pp + 1] * inv; u32x4 y;
            y.x = cvt_pk_bf16(oa[0] * bf_lo(zb.x), oa[1] * bf_hi(zb.x)); y.y = cvt_pk_bf16(oa[2] * bf_lo(zb.y), oa[3] * bf_hi(zb.y));
            y.z = cvt_pk_bf16(ob2[0] * bf_lo(zb.z), ob2[1] * bf_hi(zb.z)); y.w = cvt_pk_bf16(ob2[2] * bf_lo(zb.w), ob2[3] * bf_hi(zb.w));
            *(gu32x4*)(YB + ablk(r0 + qi, hq * 64 + 8 * q4 + 32 * pp, BW)) = y; }
        SW_QWRITE(qnxt);
        __syncthreads();
    }
#undef SW_QLOAD
#undef SW_QWRITE
#undef SW_PUT
}

#ifndef ML_R1A
#define ML_R1A 1
#endif
#ifndef ML_R1B
#define ML_R1B 1
#endif
#ifndef ML_RWR
#define ML_RWR 1
#endif
constexpr int ML_RS = 544, ML_TS = 144, ML_WS = 160, ML_GSZ = 1344;
constexpr int ML_QL = 0, ML_KA = 64 * ML_RS, ML_KB = 2 * 64 * ML_RS, ML_VT = 3 * 64 * ML_RS, ML_VW = ML_VT + 32 * ML_TS, ML_VW2 = ML_VW + 33 * ML_WS, ML_CT = ML_VW2 + 33 * ML_WS, ML_X = ML_CT + 33 * ML_RS, ML_GATE = ML_X + 64 * 144;
static_assert(ML_GATE + 2 * ML_GSZ <= ARGS_OFF, "mLSTM LDS map");
typedef short s16x4 __attribute__((ext_vector_type(4)));
__device__ __forceinline__ bf16x8 tr_frag8(const LAS unsigned char* img, int rs, int row0, int col0, int r16) {
    const LAS unsigned char* p0 = img + (row0 + (r16 >> 2)) * rs + (col0 + 4 * (r16 & 3)) * 2;
    const s16x4 a = __builtin_amdgcn_ds_read_tr16_b64_v4i16((LAS s16x4*)p0);
    const s16x4 b = __builtin_amdgcn_ds_read_tr16_b64_v4i16((LAS s16x4*)(p0 + 4 * rs));
    return __builtin_shufflevector(a, b, 0, 1, 2, 3, 4, 5, 6, 7);
}
__device__ __forceinline__ float dpp_shr(float v, float ident, int n) {
    const int r = n == 1 ? __builtin_amdgcn_update_dpp(__float_as_int(ident), __float_as_int(v), 0x111, 0xf, 0xf, false)
                : n == 2 ? __builtin_amdgcn_update_dpp(__float_as_int(ident), __float_as_int(v), 0x112, 0xf, 0xf, false)
                : n == 4 ? __builtin_amdgcn_update_dpp(__float_as_int(ident), __float_as_int(v), 0x114, 0xf, 0xf, false)
                         : __builtin_amdgcn_update_dpp(__float_as_int(ident), __float_as_int(v), 0x118, 0xf, 0xf, false);
    return __int_as_float(r);
}
__device__ __forceinline__ float wave_scan_add(float v, int lane) {
    v += dpp_shr(v, 0.f, 1); v += dpp_shr(v, 0.f, 2); v += dpp_shr(v, 0.f, 4); v += dpp_shr(v, 0.f, 8);
    const float t0 = __int_as_float(__builtin_amdgcn_readlane(__float_as_int(v), 15)), t1 = __int_as_float(__builtin_amdgcn_readlane(__float_as_int(v), 31)), t2 = __int_as_float(__builtin_amdgcn_readlane(__float_as_int(v), 47));
    const int row = lane >> 4; const float add = row == 0 ? 0.f : (row == 1 ? t0 : (row == 2 ? t0 + t1 : (t0 + t1) + t2));
    return v + add;
}
__device__ __forceinline__ float wave_scan_max(float v, int lane) {
    const float NI = -3.0e38f;
    v = fmaxf(v, dpp_shr(v, NI, 1)); v = fmaxf(v, dpp_shr(v, NI, 2)); v = fmaxf(v, dpp_shr(v, NI, 4)); v = fmaxf(v, dpp_shr(v, NI, 8));
    const float t0 = __int_as_float(__builtin_amdgcn_readlane(__float_as_int(v), 15)), t1 = __int_as_float(__builtin_amdgcn_readlane(__float_as_int(v), 31)), t2 = __int_as_float(__builtin_amdgcn_readlane(__float_as_int(v), 47));
    const int row = lane >> 4; const float mx = row == 0 ? NI : (row == 1 ? t0 : (row == 2 ? fmaxf(t0, t1) : fmaxf(fmaxf(t0, t1), t2)));
    return fmaxf(v, mx);
}
__device__ __forceinline__ float softcap15(float z) { const float e = __expf(z * (2.0f / 15.0f)); return 15.0f * (1.0f - 2.0f * __builtin_amdgcn_rcpf(e + 1.0f)); }
__device__ __forceinline__ void mlstm_unit(const Ctx& F, int b, int h, int sl, guchar* ws, const gfloat* ibp, const gfloat* fbp, const gfloat* norm_g) {
    int tid = F.tid; LAUNDER_V(tid); const int lane = tid & 63, w = F.wave, r16 = lane & 15, q4 = lane >> 4;
    const gbf16* CQ = (const gbf16*)(ws + WS_CQ); const gbf16* CK = (const gbf16*)(ws + WS_CK); const gbf16* CV = (const gbf16*)(ws + WS_CV);
    const gbf16* CO = (const gbf16*)(ws + WS_CO); const gbf16* CZs = (const gbf16*)(ws + WS_CZ);
    const gfloat* IFB = (const gfloat*)(ws + WS_IF);
    gbf16* NUM = (gbf16*)(ws + WS_NUM) + h * 512 + sl * 32; gfloat* SSQC = (gfloat*)(ws + WS_SSQC); gfloat* DNB = (gfloat*)(ws + WS_DN);
    const int rowb = b * SEQ;
    const bf16x8 ones = frag_const(0x3f803f80u), zeros = frag_const(0u);
    for (int i = tid; i < 33 * ML_RS / 16; i += NTHREADS) *(LAS u32x4*)(F.lds + ML_CT + i * 16) = (u32x4){0u, 0u, 0u, 0u};
    f32x4 st[2][3];
#pragma unroll
    for (int i = 0; i < 2; ++i)
#pragma unroll
        for (int dt = 0; dt < 3; ++dt) st[i][dt] = (f32x4){0.f, 0.f, 0.f, 0.f};
    float m_prev = 0.f;
    const float ibv = ibp[h], fbv = fbp[h];
    const f32x4 ng0 = *(const gf32x4*)(norm_g + h * 512 + sl * 32 + 4 * q4), ng1 = *(const gf32x4*)(norm_g + h * 512 + sl * 32 + 16 + 4 * q4);
    u32x4 qra[4], kra[4], vra; float gi = 0.f, gf = 0.f;
#define ML_LOAD(c, Q_, K_, V_) do { const int rc_ = rowb + (c) * 64; _Pragma("unroll") for (int k_ = 0; k_ < 4; ++k_) { const int it_ = tid + 512 * k_, s_ = it_ >> 5, ch_ = it_ & 31; \
        Q_[k_] = *(const gu32x4*)(CQ + tb256(rc_ + s_, h * 256 + 8 * ch_, 4)); K_[k_] = *(const gu32x4*)(CK + tb256(rc_ + s_, h * 256 + 8 * ch_, 4)); } \
        V_ = *(const gu32x4*)(CV + tb256(rc_ + ((tid & 255) >> 2), h * 512 + sl * 32 + 8 * (tid & 3), 8)); } while (0)
#define ML_GLOAD(c) do { const int r_ = rowb + (c) * 64 + lane; gi = IFB[(size_t)r_ * 8 + h]; gf = IFB[(size_t)r_ * 8 + 4 + h]; } while (0)
#define ML_GPREP(par) do { if (w == 7) { const float ig_ = softcap15(gi + ibv); const float z_ = softcap15(gf + fbv); \
        const float lf_ = -(fmaxf(-z_, 0.f) + log1pf(__expf(-fabsf(z_)))); const float bc_ = wave_scan_add(lf_, lane); const float u_ = ig_ - bc_; const float pm_ = wave_scan_max(u_, lane); \
        const float Mv_ = fmaxf(m_prev, pm_); const float M63_ = __int_as_float(__builtin_amdgcn_readlane(__float_as_int(Mv_), 63)); const float g_ = __int_as_float(__builtin_amdgcn_readlane(__float_as_int(bc_), 63)); \
        LAS float* gp_ = (LAS float*)(F.lds + ML_GATE + (par) * ML_GSZ); gp_[lane] = u_; gp_[64 + lane] = Mv_; gp_[128 + lane] = __expf(m_prev - Mv_); gp_[192 + lane] = __expf(-(bc_ + Mv_)); \
        gp_[256 + lane] = __expf(u_ - M63_); if (lane == 0) gp_[320] = __expf(m_prev - M63_); m_prev = g_ + M63_; } } while (0)
#define ML_WRITE(kb_, vw_, gpn_, Q_, K_, V_) do { _Pragma("unroll") for (int k_ = 0; k_ < 4; ++k_) { const int it_ = tid + 512 * k_, s_ = it_ >> 5, ch_ = it_ & 31; \
        *(LAS u32x4*)(F.lds + ML_QL + s_ * ML_RS + ch_ * 16) = Q_[k_]; *(LAS u32x4*)(F.lds + (kb_) + s_ * ML_RS + ch_ * 16) = K_[k_]; } \
        if (tid < 256) { const int s_ = tid >> 2, ch_ = tid & 3; const unsigned e_[4] = {V_.x, V_.y, V_.z, V_.w}; const float ws_ = (gpn_)[256 + s_]; \
            _Pragma("unroll") for (int i_ = 0; i_ < 8; ++i_) { const unsigned hv_ = (e_[i_ >> 1] >> ((i_ & 1) * 16)) & 0xffffu; \
                *(LAS bf16_t*)(F.lds + ML_VT + (8 * ch_ + i_) * ML_TS + 2 * s_) = (bf16_t)hv_; \
                *(LAS bf16_t*)(F.lds + (vw_) + (8 * ch_ + i_) * ML_WS + 2 * s_) = (bf16_t)(cvt_pk_bf16(__uint_as_float(hv_ << 16) * ws_, 0.f) & 0xffffu); } \
            if (ch_ == 0) *(LAS bf16_t*)(F.lds + (vw_) + 32 * ML_WS + 2 * s_) = (bf16_t)(cvt_pk_bf16(ws_, 0.f) & 0xffffu); } } while (0)
    ML_LOAD(0, qra, kra, vra); ML_GLOAD(0);
    ML_GPREP(0);
    ML_GLOAD(1);
    __syncthreads();
    ML_WRITE(ML_KA, ML_VW, ((const LAS float*)(F.lds + ML_GATE)), qra, kra, vra);
    __syncthreads();
#define ML_STEP(c, LQ_, LK_, LV_, WQ_, WK_, WV_) do { \
        const int par = c & 1; const LAS float* gp = (const LAS float*)(F.lds + ML_GATE + par * ML_GSZ); \
        const int vt = ML_VT, kb = par ? ML_KB : ML_KA, kbn = par ? ML_KA : ML_KB, vw = par ? ML_VW2 : ML_VW, vwn = par ? ML_VW : ML_VW2; \
        const LAS float* gpn = (const LAS float*)(F.lds + ML_GATE + (par ^ 1) * ML_GSZ); \
        const int rowc = rowb + c * 64; \
        const size_t rog_ = tb256(rowc + 16 * (w & 3) + r16, h * 512 + sl * 32 + 4 * q4, 8); \
        const u32x2 ob0 = *(const gu32x2*)(CO + rog_), ob1 = *(const gu32x2*)(CO + rog_ + 16), zb0 = *(const gu32x2*)(CZs + rog_), zb1 = *(const gu32x2*)(CZs + rog_ + 16); \
        ML_LOAD((c + 1 < 32 ? c + 1 : 31), LQ_, LK_, LV_); if (c + 1 < 32) ML_GPREP(par ^ 1); ML_GLOAD((c + 2 < 32 ? c + 2 : 31)); \
        f32x4 oacc[3]; \
        for (int rp_ = 0; rp_ < ML_R1B; ++rp_) { \
        _Pragma("unroll") \
        for (int dt = 0; dt < 3; ++dt) oacc[dt] = (f32x4){0.f, 0.f, 0.f, 0.f}; \
        if (w < 4) { \
            const int T = w; \
            bf16x8 bq[8]; \
        _Pragma("unroll") \
            for (int ks = 0; ks < 8; ++ks) bq[ks] = *(const LAS bf16x8*)(F.lds + ML_QL + (16 * T + r16) * ML_RS + ks * 64 + q4 * 16); \
            f32x4 sa[4]; \
        _Pragma("unroll") \
            for (int s4 = 0; s4 < 4; ++s4) { sa[s4] = (f32x4){0.f, 0.f, 0.f, 0.f}; \
                if (s4 <= T) { \
        _Pragma("unroll") \
                    for (int ks = 0; ks < 8; ++ks) { const bf16x8 a = *(const LAS bf16x8*)(F.lds + kb + (16 * s4 + r16) * ML_RS + ks * 64 + q4 * 16); sa[s4] = MFMA16(a, bq[ks], sa[s4]); } } } \
            const int tl = 16 * T + r16; const float Mt = gp[64 + tl]; \
        _Pragma("unroll") \
            for (int s4 = 0; s4 < 4; ++s4) { const f32x4 uu = *(const LAS f32x4*)(gp + 16 * s4 + 4 * q4); \
        _Pragma("unroll") \
                for (int e = 0; e < 4; ++e) { const int sl_ = 16 * s4 + 4 * q4 + e; sa[s4][e] = (sl_ <= tl) ? sa[s4][e] * __expf(uu[e] - Mt) : 0.f; } } \
        _Pragma("unroll") \
            for (int kk = 0; kk < 2; ++kk) { const bf16x8 pf = mk_frag(pack4(sa[2 * kk]), pack4(sa[2 * kk + 1])); \
        _Pragma("unroll") \
                for (int dt = 0; dt < 3; ++dt) { bf16x8 a; \
                    if (dt < 2) { const LAS unsigned char* vp = F.lds + vt + (16 * dt + r16) * ML_TS + (32 * kk + 4 * q4) * 2; a = mk_frag(*(const LAS u32x2*)vp, *(const LAS u32x2*)(vp + 32)); } \
                    else a = (r16 == 0) ? ones : zeros; \
                    oacc[dt] = MFMA16(a, pf, oacc[dt]); } } \
        } else { \
            const int T = w - 4; f32x4 ia[3]; \
        _Pragma("unroll") \
            for (int dt = 0; dt < 3; ++dt) ia[dt] = (f32x4){0.f, 0.f, 0.f, 0.f}; \
        _Pragma("unroll") \
            for (int ks = 0; ks < 8; ++ks) { const bf16x8 bqv = *(const LAS bf16x8*)(F.lds + ML_QL + (16 * T + r16) * ML_RS + ks * 64 + q4 * 16); \
        _Pragma("unroll") \
                for (int dt = 0; dt < 3; ++dt) { bf16x8 a; \
                    if (dt < 2) a = *(const LAS bf16x8*)(F.lds + ML_CT + (16 * dt + r16) * ML_RS + ks * 64 + q4 * 16); \
                    else { a = *(const LAS bf16x8*)(F.lds + ML_CT + 32 * ML_RS + ks * 64 + q4 * 16); if (r16 != 0) a = zeros; } \
                    ia[dt] = MFMA16(a, bqv, ia[dt]); } } \
            const int tl = 16 * T + r16; \
            *(LAS f32x4*)(F.lds + ML_X + tl * 144 + (4 * q4) * 4) = ia[0]; *(LAS f32x4*)(F.lds + ML_X + tl * 144 + (16 + 4 * q4) * 4) = ia[1]; \
            if (q4 == 0) *(LAS f32x4*)(F.lds + ML_X + tl * 144 + 32 * 4) = ia[2]; \
        } \
        } \
        __syncthreads(); \
        if (w < 4) { \
            const int tl = 16 * w + r16; const float at = gp[128 + tl], en = gp[192 + tl]; \
            const f32x4 x0 = *(const LAS f32x4*)(F.lds + ML_X + tl * 144 + (4 * q4) * 4), x1 = *(const LAS f32x4*)(F.lds + ML_X + tl * 144 + (16 + 4 * q4) * 4); \
            const float xd = *(const LAS float*)(F.lds + ML_X + tl * 144 + 32 * 4); \
            const f32x4 n0 = oacc[0] + x0 * at, n1 = oacc[1] + x1 * at; \
            float den = oacc[2][0] + xd * at; den = __shfl(den, r16); \
            float sq = (n0[0] * n0[0] + n0[1] * n0[1]) + (n0[2] * n0[2] + n0[3] * n0[3]) + (n1[0] * n1[0] + n1[1] * n1[1]) + (n1[2] * n1[2] + n1[3] * n1[3]); \
            sq += __shfl_xor(sq, 16); sq += __shfl_xor(sq, 32); \
            const size_t ro = (size_t)(rowc + tl) * BW + 4 * q4; \
            f32x4 t0, t1; \
            t0[0] = n0[0] * ng0[0] * (bf_lo(ob0.x) * bf_lo(zb0.x)); t0[1] = n0[1] * ng0[1] * (bf_hi(ob0.x) * bf_hi(zb0.x)); t0[2] = n0[2] * ng0[2] * (bf_lo(ob0.y) * bf_lo(zb0.y)); t0[3] = n0[3] * ng0[3] * (bf_hi(ob0.y) * bf_hi(zb0.y)); \
            t1[0] = n1[0] * ng1[0] * (bf_lo(ob1.x) * bf_lo(zb1.x)); t1[1] = n1[1] * ng1[1] * (bf_hi(ob1.x) * bf_hi(zb1.x)); t1[2] = n1[2] * ng1[2] * (bf_lo(ob1.y) * bf_lo(zb1.y)); t1[3] = n1[3] * ng1[3] * (bf_hi(ob1.y) * bf_hi(zb1.y)); \
            *(gu32x2*)(NUM + ro) = pack4(t0); *(gu32x2*)(NUM + ro + 16) = pack4(t1); \
            if (q4 == 0) { SSQC[(size_t)(rowc + tl) * 64 + h * 16 + sl] = sq; if (sl == 0) DNB[(size_t)(rowc + tl) * 4 + h] = fmaxf(fabsf(den), en); } \
        } \
        { const float dec = gp[320]; \
        _Pragma("unroll") \
          for (int i = 0; i < 2; ++i) \
        _Pragma("unroll") \
              for (int dt = 0; dt < 3; ++dt) st[i][dt] = st[i][dt] * dec; \
        _Pragma("unroll") \
          for (int kk = 0; kk < 2; ++kk) { bf16x8 a[2], bv[3]; \
        _Pragma("unroll") \
              for (int i = 0; i < 2; ++i) a[i] = tr_frag8(F.lds + kb, ML_RS, 32 * kk + 8 * q4, 32 * w + 16 * i, r16); \
        _Pragma("unroll") \
              for (int dt = 0; dt < 2; ++dt) bv[dt] = *(const LAS bf16x8*)(F.lds + vw + (16 * dt + r16) * ML_WS + kk * 64 + q4 * 16); \
              bv[2] = *(const LAS bf16x8*)(F.lds + vw + 32 * ML_WS + kk * 64 + q4 * 16); if (r16 != 0) bv[2] = zeros; \
        _Pragma("unroll") \
              for (int i = 0; i < 2; ++i) \
        _Pragma("unroll") \
                  for (int dt = 0; dt < 3; ++dt) st[i][dt] = MFMA16(a[i], bv[dt], st[i][dt]); } \
        _Pragma("unroll") \
          for (int i = 0; i < 2; ++i) { \
        _Pragma("unroll") \
              for (int dt = 0; dt < 2; ++dt) *(LAS u32x2*)(F.lds + ML_CT + (16 * dt + r16) * ML_RS + (32 * w + 16 * i + 4 * q4) * 2) = pack4(st[i][dt]); \
              if (r16 == 0) *(LAS u32x2*)(F.lds + ML_CT + 32 * ML_RS + (32 * w + 16 * i + 4 * q4) * 2) = pack4(st[i][2]); } } \
        for (int rp_ = 0; rp_ < ML_RWR; ++rp_) if (c + 1 < 32) ML_WRITE(kbn, vwn, gpn, WQ_, WK_, WV_); \
        __syncthreads(); \
    } while (0)
    for (int c2 = 0; c2 < 32; ++c2) { ML_STEP(c2, qra, kra, vra, qra, kra, vra); }
#undef ML_LOAD
#undef ML_GLOAD
#undef ML_GPREP
#undef ML_WRITE
#undef ML_STEP
}

__device__ __forceinline__ void p2b_finalize(const Ctx& F, guchar* ws) {
    int lane = F.lane; LAUNDER_V(lane); const int gw = F.vcu * NWAVES + F.wave, NGW = F.G * NWAVES;
    const gbf16* NUM = (const gbf16*)(ws + WS_NUM); gbf16* YC = (gbf16*)(ws + WS_YA) + (size_t)2 * M_ROWS * BW;
    for (int m = gw; m < M_ROWS; m += NGW) {
        float s = ((const gfloat*)(ws + WS_SSQC))[(size_t)m * 64 + lane];
        s += __shfl_xor(s, 1); s += __shfl_xor(s, 2); s += __shfl_xor(s, 4); s += __shfl_xor(s, 8);
        const float dn = ((const gfloat*)(ws + WS_DN))[(size_t)m * 4 + (lane >> 4)];
        const float inv = 1.0f / dn; const float sc = inv * rsqrtf(s * (1.0f / 512.0f) * inv * inv + NORM_EPS);
#pragma unroll
        for (int it = 0; it < 4; ++it) { const float f = __shfl(sc, 16 * it); const size_t o = (size_t)m * BW + (size_t)(it * 64 + lane) * 8;
            const u32x4 nb = *(const gu32x4*)(NUM + o); u32x4 y;
            y.x = cvt_pk_bf16(bf_lo(nb.x) * f, bf_hi(nb.x) * f); y.y = cvt_pk_bf16(bf_lo(nb.y) * f, bf_hi(nb.y) * f);
            y.z = cvt_pk_bf16(bf_lo(nb.z) * f, bf_hi(nb.z) * f); y.w = cvt_pk_bf16(bf_lo(nb.w) * f, bf_hi(nb.w) * f);
            *(gu32x4*)(YC + ablk(m, (it * 64 + lane) * 8, BW)) = y; }
    }
}
__device__ __forceinline__ void p5b_ssq(const Ctx& F, guchar* ws) {
    int lane = F.lane; LAUNDER_V(lane); const int gw = F.vcu * NWAVES + F.wave, NGW = F.G * NWAVES;
    for (int m = gw; m < M_ROWS; m += NGW) { const float s = wave_sum(((const gfloat*)(ws + WS_XSP))[(size_t)m * 64 + lane]); if (lane == 0) ((gfloat*)(ws + WS_CTL + CTL_SSQ1))[m] = s; }
}
__device__ __forceinline__ void p4b_x1(const Ctx& F, guchar* ws, const gfloat* npost) {
    int lane = F.lane; LAUNDER_V(lane); const int gw = F.vcu * NWAVES + F.wave, NGW = F.G * NWAVES;
    const gbf16* OUT = (const gbf16*)(ws + WS_OUT); const gbf16* XB = (const gbf16*)(ws + WS_XB); gbf16* X1B = (gbf16*)(ws + WS_X1B);
    for (int m = gw; m < M_ROWS; m += NGW) {
        const float so = wave_sum(((const gfloat*)(ws + WS_OUTP))[(size_t)m * 64 + lane]), se = wave_sum(((const gfloat*)(ws + WS_ERP))[(size_t)m * 64 + lane]);
        const float rso = rsqrtf(so * (1.0f / DM) + NORM_EPS), rse = rsqrtf(se * (1.0f / DM) + NORM_EPS);
        if (lane == 0) { ((gfloat*)(ws + WS_RSO))[m] = rso; ((gfloat*)(ws + WS_RSE))[m] = rse; }
        u32x4 yv[8]; float mx = 0.f;
#pragma unroll
        for (int it = 0; it < 8; ++it) { const int c = (it * 64 + lane) * 8; const size_t o = (size_t)m * DM + c;
            const u32x4 xb = *(const gu32x4*)(XB + ablk(m, c, DM)), ob = *(const gu32x4*)(OUT + o); const f32x4 n0 = *(const gf32x4*)(npost + c), n1 = *(const gf32x4*)(npost + c + 4); u32x4 y;
            y.x = cvt_pk_bf16(bf_lo(xb.x) + bf_lo(ob.x) * rso * n0[0], bf_hi(xb.x) + bf_hi(ob.x) * rso * n0[1]);
            y.y = cvt_pk_bf16(bf_lo(xb.y) + bf_lo(ob.y) * rso * n0[2], bf_hi(xb.y) + bf_hi(ob.y) * rso * n0[3]);
            y.z = cvt_pk_bf16(bf_lo(xb.z) + bf_lo(ob.z) * rso * n1[0], bf_hi(xb.z) + bf_hi(ob.z) * rso * n1[1]);
            y.w = cvt_pk_bf16(bf_lo(xb.w) + bf_lo(ob.w) * rso * n1[2], bf_hi(xb.w) + bf_hi(ob.w) * rso * n1[3]);
            *(gu32x4*)(X1B + ablk(m, c, DM)) = y; yv[it] = y;
            mx = fmaxf(mx, fmaxf(fmaxf(fmaxf(fabsf(bf_lo(y.x)), fabsf(bf_hi(y.x))), fmaxf(fabsf(bf_lo(y.y)), fabsf(bf_hi(y.y)))), fmaxf(fmaxf(fabsf(bf_lo(y.z)), fabsf(bf_hi(y.z))), fmaxf(fabsf(bf_lo(y.w)), fabsf(bf_hi(y.w))))));
#if P5_FP8
            { u32x2 y8; y8.x = pack_fp8x4(bf_lo(y.x), bf_hi(y.x), bf_lo(y.y), bf_hi(y.y)); y8.y = pack_fp8x4(bf_lo(y.z), bf_hi(y.z), bf_lo(y.w), bf_hi(y.w)); *(gu32x2*)(ws + WS_X1B8 + ablk8(m, c, DM)) = y8; }
#endif
            }
#if P5_I8
#pragma unroll
        for (int s = 32; s >= 1; s >>= 1) mx = fmaxf(mx, __shfl_xor(mx, s));
        mx = fmaxf(mx, 1e-30f); const float qs = 127.0f / mx;
        if (lane == 0) ((gfloat*)(ws + WS_RSX))[m] = mx * (1.0f / 127.0f);
#pragma unroll
        for (int it = 0; it < 8; ++it) { const int c = (it * 64 + lane) * 8; const u32x4 y = yv[it]; u32x2 y8;
            y8.x = pack_i8x4(bf_lo(y.x) * qs, bf_hi(y.x) * qs, bf_lo(y.y) * qs, bf_hi(y.y) * qs); y8.y = pack_i8x4(bf_lo(y.z) * qs, bf_hi(y.z) * qs, bf_lo(y.w) * qs, bf_hi(y.w) * qs);
            *(gu32x2*)(ws + WS_X1B8 + ablk8(m, c, DM)) = y8; }
#endif
    }
}

#ifndef P1_ROT
#define P1_ROT 0
#endif
#ifndef P1_WGM
#define P1_WGM 4
#endif
#ifndef REP_P0
#define REP_P0 1
#endif
#ifndef REP_P1
#define REP_P1 1
#endif
#ifndef REP_ML
#define REP_ML 1
#endif
#ifndef REP_SW
#define REP_SW 1
#endif
#ifndef REP_GM
#define REP_GM 1
#endif
#ifndef REP_P3
#define REP_P3 1
#endif
#ifndef REP_THIN
#define REP_THIN 1
#endif
#ifndef REP_BAR
#define REP_BAR 1
#endif
#ifndef REP_P4
#define REP_P4 1
#endif
__device__ __forceinline__ unsigned long long arg_ld(LAS unsigned char* lds, int i) {
    unsigned a = (unsigned)(ARGS_OFF + 8 * i); asm volatile("" : "+v"(a));
    const volatile LAS unsigned* q = (const volatile LAS unsigned*)(lds + a);
    const unsigned lo = q[0], hi = q[1];
    return ((unsigned long long)(unsigned)__builtin_amdgcn_readfirstlane((int)hi) << 32) | (unsigned)__builtin_amdgcn_readfirstlane((int)lo);
}
struct Args { const void* in[19]; float* out; unsigned char* ws; };
static_assert(sizeof(Args) == 21 * 8, "no padding in Args");

__global__ void __launch_bounds__(NTHREADS, 2) fwd_kernel(Args args) {
    extern __shared__ __attribute__((aligned(16))) unsigned char lds_raw[];
    Ctx F; F.lds = (LAS unsigned char*)lds_raw; F.tid = threadIdx.x; F.lane = F.tid & 63; F.wave = __builtin_amdgcn_readfirstlane(F.tid >> 6);
    F.G = gridDim.x; F.bx = blockIdx.x; { const int bx = blockIdx.x; F.vcu = (F.G % 8 == 0) ? (bx % 8) * (F.G / 8) + bx / 8 : bx; }
    guchar* ws0 = (guchar*)args.ws;
#define WSL() ({ guchar* w_ = ws0; LAUNDER_S(w_); w_; })
    volatile LAS unsigned* MISC = (volatile LAS unsigned*)(F.lds + MISC_OFF);
    if (F.tid < 32) MISC[F.tid] = 0u;
    __syncthreads();
    const XcdBarrier bar = xcd_barrier_post((unsigned*)(ws0 + WS_CTL) + CW_BAR, MISC);

    if (F.tid < 19) ((LAS unsigned long long*)(F.lds + ARGS_OFF))[F.tid] = (unsigned long long)args.in[F.tid];
    if (F.tid == 19) ((LAS unsigned long long*)(F.lds + ARGS_OFF))[19] = (unsigned long long)args.out;
    __syncthreads();
#define ARGP(T, i) ((T)arg_ld(F.lds, (i)))

#define FL() ({ Ctx f_ = F; LAUNDER_S(f_.lds); LAUNDER_S(f_.wave); LAUNDER_S(f_.vcu); LAUNDER_S(f_.G); LAUNDER_S(f_.bx); f_; })
#ifndef SKIP_P0
    for (int rep_ = 0; rep_ < REP_P0; ++rep_) { const Ctx Fp = FL(); guchar* ws = WSL(); p0_prologue(FL(), ARGP(const gfloat*, 0), ARGP(const gfloat*, 1), ARGP(const gint*, 2), ARGP(const gfloat*, 3), ARGP(const gfloat*, 4), ARGP(const gfloat*, 13), ARGP(const gfloat*, 14), ARGP(const gfloat*, 18), ARGP(const gfloat*, 16), ws); }
#endif
    for (int rb_ = 0; rb_ < REP_BAR; ++rb_) xcd_barrier(bar);

    auto layer_body = [&](const int l) __attribute__((always_inline)) {
#ifndef NT_BF
#define NT_BF (P1G_FP8 ? 67 : NT_IN)
#endif
#ifndef P1_LOCK
#define P1_LOCK 0
#endif
#ifndef SKIP_P1
        for (int rep_ = 0; rep_ < REP_P1; ++rep_) { const Ctx Fp = FL(); guchar* ws = WSL(); const gfloat* ssq = l == 0 ? (const gfloat*)(ws + WS_SSQ0) : (const gfloat*)(ws + WS_CTL + CTL_SSQ1);
          const int rowbase = (Fp.G == 256 && P1_WGM == 4 && P1_ROT == 0) ? (Fp.bx & 7) * 1024 : -1; LAS float* rtab = (LAS float*)(Fp.lds + 132096);
          if (rowbase >= 0) { int ti_ = threadIdx.x; LAUNDER_V(ti_); const float s0_ = ssq[rowbase + ti_], s1_ = ssq[rowbase + 512 + ti_]; rtab[ti_] = rsqrtf(s0_ * (1.0f / DM) + NORM_EPS); rtab[512 + ti_] = rsqrtf(s1_ * (1.0f / DM) + NORM_EPS); __syncthreads(); }
#if P1G_FP8
          { pg8::SchedPlain S; S.T.init(M_ROWS / 256, 56, Fp.G, Fp.bx, P1_WGM, P1_ROT, -1, 74); S.pn0 = 74; S.A = (const gchar*)(ws + WS_XB8); S.B = (const gchar*)(ws + WS_WG8 + (size_t)l * SZ_WG8);
            S.astep = (size_t)256 * DM; S.bstep = (size_t)256 * DM;
            pg8::EpiInT<true> E{ssq, ws, rtab, rowbase};
            pg8::gemm_phase<pg8::EpiInT<true>, pg8::SchedPlain>(Fp.lds, DM / 2, DM, DM, S, E); }
          { pg8::SchedPlain S; S.T.init(M_ROWS / 256, NT_BF, Fp.G, Fp.bx, P1_WGM, P1_ROT, 122, 0); S.A = (const gchar*)(ws + WS_XB); S.B = (const gchar*)(ws + WS_WIN + (size_t)l * SZ_WIN);
            S.astep = (size_t)256 * DM * 2; S.bstep = (size_t)256 * DM * 2;
            pg8::EpiIn E{ssq, ws, rtab, rowbase};
            pg8::gemm_phase<pg8::EpiIn, pg8::SchedPlain>(Fp.lds, DM, DM, DM, S, E, (unsigned*)(ws + WS_CTL) + 256 + 64 * l, P1_LOCK); }
#else
          { pg8::SchedPlain S; S.T.init(M_ROWS / 256, NT_IN, Fp.G, Fp.bx, P1_WGM, P1_ROT); S.A = (const gchar*)(ws + WS_XB); S.B = (const gchar*)(ws + WS_WIN + (size_t)l * SZ_WIN);
            S.astep = (size_t)256 * DM * 2; S.bstep = (size_t)256 * DM * 2;
            pg8::EpiIn E{ssq, ws, rtab, rowbase};
            pg8::gemm_phase<pg8::EpiIn, pg8::SchedPlain>(Fp.lds, DM, DM, DM, S, E, (unsigned*)(ws + WS_CTL) + 256 + 64 * l, P1_LOCK); }
#endif
        }
#ifdef PROBE_P1CHEAP
        { const Ctx Fp = FL(); guchar* ws = WSL(); pg8::SchedPlain S; S.T.init(M_ROWS / 256, NT_IN, Fp.G, Fp.bx); S.A = (const gchar*)(ws + WS_XB); S.B = (const gchar*)(ws + WS_WIN + (size_t)l * SZ_WIN);
          S.astep = (size_t)256 * DM * 2; S.bstep = (size_t)256 * DM * 2;
          pg8::EpiSq E{(gbf16*)(ws + WS_END), (gfloat*)(ws + WS_END + (size_t)M_ROWS * 31488 * 2)};
          pg8::gemm_phase<pg8::EpiSq, pg8::SchedPlain>(Fp.lds, DM, DM, DM, S, E); }
#endif
        { const Ctx Fq = FL(); const int nwg_ = (M_ROWS / 256) * NT_BF, rem_ = nwg_ % Fq.G;
          if (rem_ == 0 || Fq.bx >= rem_) { const int me = rem_ ? Fq.bx - rem_ : Fq.bx, nw = rem_ ? Fq.G - rem_ : Fq.G;
            { const Ctx Fp = FL(); guchar* ws = WSL(); pg8::SchedPlain S; S.T.init(M_ROWS / 256, DM / 256, nw, me); S.A = (const gchar*)(ws + WS_PB + (size_t)l * M_ROWS * 256 * 2); S.B = (const gchar*)(ws + WS_WPP + (size_t)l * SZ_WPP);
              S.astep = (size_t)256 * 256 * 2; S.bstep = (size_t)256 * 256 * 2;
              pg8::EpiSq E{(gbf16*)(ws + WS_ERAW), (gfloat*)(ws + WS_ERP)};
              pg8::gemm_phase<pg8::EpiSq, pg8::SchedPlain>(Fp.lds, 256, 256, 256, S, E); }
            if (l == 0) tr_run(FL(), P5_I8 ? TR_PG0 : TR_DEFER0, P5_I8 ? TR_PG1 + 1024 : TR_DEFER1, P5_I8 ? TR_PG0 + 1024 : 0x7fffffff, P5_I8 ? TR_PG1 : 0x7fffffff, me, nw, ARGP(const gfloat*, 4), ARGP(const gfloat*, 3), ARGP(const gfloat*, 13), ARGP(const gfloat*, 14), ARGP(const gfloat*, 18), ARGP(const gfloat*, 16), WSL()); } }
#endif
#ifdef PROBE_DELAY
        if (((F.bx & 7) < 4) == (PROBE_DELAY == 1)) { const unsigned long long t0_ = __builtin_amdgcn_s_memrealtime(); while (__builtin_amdgcn_s_memrealtime() - t0_ < 3000ull) __builtin_amdgcn_s_sleep(8); }
#endif
        for (int rb_ = 0; rb_ < REP_BAR; ++rb_) xcd_barrier(bar);
#ifndef SKIP_ML
        for (int rep_ = 0; rep_ < REP_ML; ++rep_) { const Ctx Fp = FL(); guchar* ws = WSL(); for (int u = Fp.vcu; u < 256; u += Fp.G) mlstm_unit(Fp, u >> 6, (u >> 4) & 3, u & 15, ws, ARGP(const gfloat*, 10) + l * 4, ARGP(const gfloat*, 11) + l * 4, ARGP(const gfloat*, 12) + l * BW); }
#endif
#ifndef SKIP_SW
        for (int rep_ = 0; rep_ < REP_SW; ++rep_) { const Ctx Fp = FL(); guchar* ws = WSL(); for (int u = Fp.vcu; u < 256; u += Fp.G) swa_unit(Fp, u >> 6, (u >> 2) & 15, u & 3, ws, ARGP(const gfloat*, 9) + l * 32); }
#endif
#ifndef SKIP_GM
        for (int rep_ = 0; rep_ < REP_GM; ++rep_) { const Ctx Fp = FL(); guchar* ws = WSL(); for (int u = Fp.vcu; u < 512; u += Fp.G) gmlp_unit(Fp, u >> 7, (u >> 3) & 15, u & 7, ws, ARGP(const gfloat*, 5) + l * BW, ARGP(const gfloat*, 6) + l * BW, ARGP(const gfloat*, 7) + (size_t)l * 8 * 128 * 128, ARGP(const gfloat*, 8) + l * 8 * 128); }
#endif
        for (int rb_ = 0; rb_ < REP_BAR; ++rb_) xcd_barrier(bar);
#ifndef SKIP_P2B
        for (int rep_ = 0; rep_ < REP_THIN; ++rep_) p2b_finalize(FL(), WSL());
#endif
        for (int rb_ = 0; rb_ < REP_BAR; ++rb_) xcd_barrier(bar);
#ifndef PROBE_NOSTORE
#define PROBE_NOSTORE 0
#endif
#ifdef PROBE_K1024
        for (int rep_ = 0; rep_ < 4; ++rep_) { const Ctx Fp = FL(); guchar* ws = WSL(); pg8::SchedPlain S; S.T.init(M_ROWS / 256, DM / 256, Fp.G, Fp.bx); S.A = (const gchar*)(ws + WS_YA); S.B = (const gchar*)(ws + WS_WOUT + (size_t)l * SZ_WSQ);
          S.astep = (size_t)256 * DM * 2; S.bstep = (size_t)256 * DM * 2;
          pg8::EpiSq E{PROBE_NOSTORE ? (gbf16*)nullptr : (gbf16*)(ws + WS_END), (gfloat*)(ws + WS_END + (size_t)M_ROWS * 31488 * 2)};
          pg8::gemm_phase<pg8::EpiSq, pg8::SchedPlain>(Fp.lds, 1024, DM, DM, S, E); }
#endif
#ifdef PROBE_P3CHEAP
        { const Ctx Fp = FL(); guchar* ws = WSL(); pg8::SchedBranch S; S.T.init(M_ROWS / 256, DM / 256, Fp.G, Fp.bx); S.A = (const gchar*)(ws + WS_YA); S.B = (const gchar*)(ws + WS_WBR + (size_t)l * SZ_WBR);
          S.astep = (size_t)256 * BW * 2; S.bstep = (size_t)256 * BW * 2; S.aseg = SZ_ROWS_BW; S.bseg = (size_t)DM * BW * 2;
          pg8::EpiSq E{(gbf16*)(ws + WS_END), (gfloat*)(ws + WS_END + (size_t)M_ROWS * 31488 * 2)};
          pg8::gemm_phase<pg8::EpiSq, pg8::SchedBranch>(Fp.lds, BW, BW, BW, S, E); }
#endif
#ifndef SKIP_P3
        for (int rep_ = 0; rep_ < REP_P3; ++rep_) { const Ctx Fp = FL(); guchar* ws = WSL(); pg8::SchedBranch S; S.T.init(M_ROWS / 256, DM / 256, Fp.G, Fp.bx); S.A = (const gchar*)(ws + WS_YA); S.B = (const gchar*)(ws + WS_WBR + (size_t)l * SZ_WBR);
          S.astep = (size_t)256 * BW * 2; S.bstep = (size_t)256 * BW * 2; S.aseg = SZ_ROWS_BW; S.bseg = (size_t)DM * BW * 2;
          pg8::EpiBranch E{(const guchar*)(ws + WS_G), (gbf16*)(ws + WS_MIX)};
          pg8::gemm_phase<pg8::EpiBranch, pg8::SchedBranch>(Fp.lds, BW, BW, BW, S, E); }
#endif
        for (int rb_ = 0; rb_ < REP_BAR; ++rb_) xcd_barrier(bar);
#ifndef SKIP_P4
        for (int rep_ = 0; rep_ < REP_P4; ++rep_) { const Ctx Fp = FL(); guchar* ws = WSL(); pg8::SchedPlain S; S.T.init(M_ROWS / 256, DM / 256, Fp.G, Fp.bx); S.A = (const gchar*)(ws + WS_MIX); S.B = (const gchar*)(ws + WS_WOUT + (size_t)l * SZ_WSQ);
          S.astep = (size_t)256 * DM * 2; S.bstep = (size_t)256 * DM * 2;
          pg8::EpiSq E{(gbf16*)(ws + WS_OUT), (gfloat*)(ws + WS_OUTP)};
          pg8::gemm_phase<pg8::EpiSq, pg8::SchedPlain>(Fp.lds, DM, DM, DM, S, E); }
#endif
        for (int rb_ = 0; rb_ < REP_BAR; ++rb_) xcd_barrier(bar);
#ifndef SKIP_P4B
        for (int rep_ = 0; rep_ < REP_THIN; ++rep_) p4b_x1(FL(), WSL(), ARGP(const gfloat*, 15) + l * DM);
#endif
        for (int rb_ = 0; rb_ < REP_BAR; ++rb_) xcd_barrier(bar);
#ifndef SKIP_P5
        { const Ctx Fp = FL(); guchar* ws = WSL(); pg8::SchedPlain S; S.T.init(M_ROWS / 256, DM / 256, Fp.G, Fp.bx); S.A = (const gchar*)(ws + ((P5_FP8 || P5_I8) ? WS_X1B8 : WS_X1B)); S.B = (const gchar*)(ws + WS_WPG + (size_t)l * SZ_WSQ);
          S.astep = (size_t)256 * DM * ((P5_FP8 || P5_I8) ? 1 : 2); S.bstep = (size_t)256 * DM * ((P5_FP8 || P5_I8) ? 1 : 2);
          pg8::EpiPle E{(const gbf16*)(ws + WS_X1B), ARGP(gfloat*, 19), (gbf16*)(ws + WS_XB), (const gbf16*)(ws + WS_ERAW), (const gfloat*)(ws + WS_RSE), ARGP(const gfloat*, 17) + l * DM, (gfloat*)(ws + WS_XSP), l == NLAYER - 1 ? 1 : 0, ws + WS_XB8, (const gfloat*)(ws + WS_RSX), __uint_as_float(((const gunsigned*)(ws + WS_CTL))[CW_WMAX + l]) * (1.0f / 127.0f)};
          pg8::gemm_phase<pg8::EpiPle, pg8::SchedPlain>(Fp.lds, (P5_FP8 || P5_I8) ? DM / 2 : DM, DM, DM, S, E); }
#endif
        if (l + 1 < NLAYER) { for (int rb_ = 0; rb_ < REP_BAR; ++rb_) xcd_barrier(bar); p5b_ssq(FL(), WSL()); for (int rb_ = 0; rb_ < REP_BAR; ++rb_) xcd_barrier(bar); }
    };
    static_assert(NLAYER == 2, "two layer bodies");
    layer_body(0); layer_body(1);
}

extern "C" void kernel_launch(void* const* d_in, const int* in_sizes, int n_in, void* d_out, int out_size, void* d_ws, size_t ws_size, hipStream_t stream) {
    static int grid = 0;
    if (grid == 0) {
        if (n_in != 19 || out_size != M_ROWS * DM || ws_size < WS_END) { fprintf(stderr, "kernel_launch: unexpected problem (n_in %d, out %d, ws %zu, need %zu)\n", n_in, out_size, ws_size, (size_t)WS_END); grid = -1; return; }
        int dev = 0, cus = 0;
        if (hipGetDevice(&dev) != hipSuccess || hipDeviceGetAttribute(&cus, hipDeviceAttributeMultiprocessorCount, dev) != hipSuccess) { grid = -1; return; }
        if (hipFuncSetAttribute((const void*)fwd_kernel, hipFuncAttributeMaxDynamicSharedMemorySize, LDS_BYTES) != hipSuccess) { fprintf(stderr, "kernel_launch: hipFuncSetAttribute failed\n"); grid = -1; return; }
        int per_cu = 0; (void)hipOccupancyMaxActiveBlocksPerMultiprocessor(&per_cu, (const void*)fwd_kernel, NTHREADS, LDS_BYTES); (void)hipGetLastError();
        if (per_cu < 1) fprintf(stderr, "kernel_launch: occupancy query reports %d blocks per CU\n", per_cu);
        grid = cus > 256 ? 256 : cus;
    }
    if (grid < 0) return;
    (void)hipMemsetAsync((char*)d_ws + WS_CTL, 0, CTL_ZERO_BYTES, stream);
    Args a{};
    for (int i = 0; i < 19; ++i) a.in[i] = d_in[i];
    a.out = (float*)d_out; a.ws = (unsigned char*)d_ws;
    hipLaunchKernelGGL(fwd_kernel, dim3(grid), dim3(NTHREADS), LDS_BYTES, stream, a);
    const hipError_t le = hipPeekAtLastError();
    if (le != hipSuccess) fprintf(stderr, "kernel_launch: launch failed: %s\n", hipGetErrorName(le));
}
```

```cpp
#include <hip/hip_runtime.h>
#include <cstdio>
#include <cstdint>

#define LAS __attribute__((address_space(3)))
#define GAS __attribute__((address_space(1)))
typedef unsigned short bf16_t;
typedef short bf16x8 __attribute__((ext_vector_type(8)));
typedef float f32x4 __attribute__((ext_vector_type(4)));
typedef float f32x2 __attribute__((ext_vector_type(2)));
typedef unsigned u32x4 __attribute__((ext_vector_type(4)));
typedef unsigned u32x2 __attribute__((ext_vector_type(2)));

typedef GAS float gfloat; typedef GAS bf16_t gbf16; typedef GAS int gint; typedef GAS char gchar; typedef GAS unsigned char guchar; typedef GAS unsigned gunsigned;
typedef GAS f32x4 gf32x4; typedef GAS f32x2 gf32x2; typedef GAS u32x4 gu32x4; typedef GAS u32x2 gu32x2;
constexpr int M_ROWS = 8192, SEQ = 2048, DM = 4096, BW = 2048, NLAYER = 2;
constexpr int N_IN = 31240, IF_COL = 14848;
constexpr int NT_IN = 123;
constexpr int N_IN_T = NT_IN * 256;
constexpr float NORM_EPS = 1e-6f;

__device__ __forceinline__ unsigned cvt_pk_bf16(float lo, float hi) { unsigned r; asm("v_cvt_pk_bf16_f32 %0, %1, %2" : "=v"(r) : "v"(lo), "v"(hi)); return r; }
__device__ __forceinline__ float bf_lo(unsigned w) { return __uint_as_float(w << 16); }
__device__ __forceinline__ float bf_hi(unsigned w) { return __uint_as_float(w & 0xffff0000u); }
__device__ __forceinline__ float bf1(bf16_t b) { return __uint_as_float(((unsigned)b) << 16); }
__device__ __forceinline__ float fsigmoid(float x) { return __builtin_amdgcn_rcpf(1.0f + __expf(-x)); }
__device__ __forceinline__ float wave_sum(float v) {
#pragma unroll
    for (int o = 1; o < 64; o <<= 1) v += __shfl_xor(v, o);
    return v;
}
__device__ __forceinline__ f32x2 gelu_pk(f32x2 v) {
    const f32x2 av = __builtin_elementwise_abs(v), d = av * 0.2316418882f + 1.0f;
    f32x2 t; t.x = __builtin_amdgcn_rcpf(d.x); t.y = __builtin_amdgcn_rcpf(d.y);
    f32x2 q = t * 0.5307027145f + (-0.7265760135f); q = q * t + 0.7107068705f; q = q * t + (-0.142248368f); q = q * t + 0.127414796f; q = q * t;
    const f32x2 s = (v * v) * (-0.72134752044f);
    f32x2 e; e.x = __builtin_amdgcn_exp2f(s.x); e.y = __builtin_amdgcn_exp2f(s.y);
    const f32x2 m = v * (q * e), r = v - m;
    f32x2 o; o.x = v.x < 0.f ? m.x : r.x; o.y = v.y < 0.f ? m.y : r.y; return o;
}
typedef int i32x8 __attribute__((ext_vector_type(8)));
typedef short s16x16 __attribute__((ext_vector_type(16)));
__host__ __device__ __forceinline__ size_t ablk8(int row, int col, int K) { return ((size_t)(row >> 8) * (K >> 7) + (col >> 7)) * 32768 + (size_t)(row & 255) * 128 + (col & 127); }
__device__ __forceinline__ unsigned pack_fp8x4(float a, float b, float c, float d) { int w = 0; w = __builtin_amdgcn_cvt_pk_fp8_f32(a, b, w, false); w = __builtin_amdgcn_cvt_pk_fp8_f32(c, d, w, true); return (unsigned)w; }
__device__ __forceinline__ unsigned pack_i8x4(float a, float b, float c, float d) {
    const int q0 = min(max(__float2int_rn(a), -127), 127), q1 = min(max(__float2int_rn(b), -127), 127), q2 = min(max(__float2int_rn(c), -127), 127), q3 = min(max(__float2int_rn(d), -127), 127);
    return ((unsigned)q0 & 0xffu) | (((unsigned)q1 & 0xffu) << 8) | (((unsigned)q2 & 0xffu) << 16) | ((unsigned)q3 << 24);
}
__host__ __device__ __forceinline__ size_t ablk(int row, int col, int K) { return ((size_t)(row >> 8) * (K >> 6) + (col >> 6)) * 16384 + (size_t)(row & 255) * 64 + (col & 63); }
__host__ __device__ __forceinline__ size_t tb256(int row, int col, int nt) { return ((size_t)(row >> 8) * nt + (col >> 8)) * 65536 + (size_t)(row & 255) * 256 + (col & 255); }
__host__ __device__ __forceinline__ size_t tb128(int row, int col, int nt) { return ((size_t)(row >> 8) * nt + (col >> 7)) * 32768 + (size_t)(row & 255) * 128 + (col & 127); }
#define LAUNDER_V(x) asm volatile("" : "+v"(x))
#define LAUNDER_S(x) asm volatile("" : "+s"(x))
#define LDS_WAIT() asm volatile("s_waitcnt lgkmcnt(0)" ::: "memory")
#define VM_WAIT() asm volatile("s_waitcnt vmcnt(0)" ::: "memory")
#define MFMA16(a, b, c) __builtin_amdgcn_mfma_f32_16x16x32_bf16((a), (b), (c), 0, 0, 0)

#define XB_TMO      128
#define XB_XCNT(j)  (256  + 64 * (j))
#define XB_XSUB(j)  (1280 + 64 * (j))
#define XB_XGEN(j)  (2304 + 64 * (j))
#define XB_TOP      3328
#define XB_TOPGEN   3392
#define XCD_BAR_WORDS 3456
#define XB_SPIN_CAP (1u << 18)
__device__ __forceinline__ unsigned xb_ld(unsigned* p)              { return __hip_atomic_load(p, __ATOMIC_RELAXED, __HIP_MEMORY_SCOPE_AGENT); }
__device__ __forceinline__ unsigned xb_add(unsigned* p, unsigned v) { return __hip_atomic_fetch_add(p, v, __ATOMIC_RELAXED, __HIP_MEMORY_SCOPE_AGENT); }
__device__ __forceinline__ unsigned xb_xcc_id() { return (unsigned)__builtin_amdgcn_s_getreg((3 << 11) | 20) & 0xFu; }
#define XB_SPIN(cond, bar) do { unsigned _sp = 0; while (cond) { __builtin_amdgcn_s_sleep(1); \
    if ((++_sp & 255u) == 0u) { if (xb_ld(&(bar)[XB_TMO])) break; if (_sp > XB_SPIN_CAP) { atomicAdd(&(bar)[XB_TMO], 1u); break; } } } } while (0)
struct XcdBarrier { unsigned* bar; unsigned x; volatile LAS unsigned* st; };
__device__ __forceinline__ XcdBarrier xcd_barrier_post(unsigned* bar, volatile LAS unsigned* st) {
    XcdBarrier b; b.bar = bar; b.x = xb_xcc_id(); b.st = st;
    if (threadIdx.x == 0) (void)xb_add(&bar[XB_XCNT(b.x)], 1u);
    return b;
}
__device__ __forceinline__ void xcd_barrier_complete(unsigned* bar, unsigned x, unsigned& nloc, unsigned& nx) {
    const unsigned G = gridDim.x * gridDim.y * gridDim.z;
    unsigned sum, cnt, mine, sp = 0u;
    for (;;) {
        sum = 0u; cnt = 0u; mine = 0u;
#pragma unroll
        for (unsigned j = 0; j < 16; ++j) { const unsigned c = xb_ld(&bar[XB_XCNT(j)]); sum += c; cnt += (c > 0u) ? 1u : 0u; mine = (j == x) ? c : mine; }
        if (sum == G) break;
        __builtin_amdgcn_s_sleep(1);
        if ((++sp & 255u) == 0u) { if (xb_ld(&bar[XB_TMO])) break; if (sp > XB_SPIN_CAP) { atomicAdd(&bar[XB_TMO], 1u); break; } }
    }
    nloc = mine > 0u ? mine : 1u; nx = cnt > 0u ? cnt : 1u;
}
__device__ __forceinline__ void xcd_barrier(const XcdBarrier& b) {
    asm volatile("s_waitcnt vmcnt(0)" ::: "memory");
    __syncthreads();
    if (threadIdx.x == 0) {
        unsigned* bar = b.bar;
        __builtin_amdgcn_s_waitcnt(0);
        unsigned nloc = b.st[0], nx = b.st[1];
        if (nloc == 0u) { xcd_barrier_complete(bar, b.x, nloc, nx); b.st[0] = nloc; b.st[1] = nx; }
        const unsigned old = xb_add(&bar[XB_XSUB(b.x)], 1u);
        const unsigned gen = old / nloc;
        if (old + 1u == (gen + 1u) * nloc) {
            __builtin_amdgcn_fence(__ATOMIC_RELEASE, "agent");
            asm volatile("s_waitcnt vmcnt(0)" ::: "memory");
            const unsigned og = xb_add(&bar[XB_TOP], 1u);
            const unsigned tg = og / nx;
            if (og + 1u == (tg + 1u) * nx) xb_add(&bar[XB_TOPGEN], 1u);
            else XB_SPIN(xb_ld(&bar[XB_TOPGEN]) == tg, bar);
            __builtin_amdgcn_fence(__ATOMIC_ACQUIRE, "agent");
            xb_add(&bar[XB_XGEN(b.x)], 1u);
            asm volatile("s_waitcnt vmcnt(0)" ::: "memory");
        } else {
            XB_SPIN(xb_ld(&bar[XB_XGEN(b.x)]) == gen, bar);
            __builtin_amdgcn_fence(__ATOMIC_ACQUIRE, "agent");
            asm volatile("s_waitcnt vmcnt(0)" ::: "memory");
        }
    }
    __syncthreads();
}

#ifndef WGM_DEFAULT
#define WGM_DEFAULT 4
#endif
#ifndef PG8_SADDR
#define PG8_SADDR 1
#endif
namespace pg8 {
constexpr int BM = 256, BK = 64, HALF = 128, HTB = HALF * BK * 2, STAGE_BYTES = 8 * HTB, NXCD = 8, WGM = WGM_DEFAULT;
__host__ __device__ __forceinline__ int lds_byte(int r, int c) { const int st = (r >> 4) * 2 + (c >> 5), rr = r & 15, cc = c & 31, ob = rr * 64 + cc * 2; return st * 1024 + (ob ^ (((ob >> 9) & 1) << 5)); }
__host__ __device__ __forceinline__ void stage_rc(int b, int& R, int& C) { const int st = b / 1024, sb = b % 1024, swz = sb ^ (((sb >> 9) & 1) << 5); R = (st >> 1) * 16 + swz / 64; C = (st & 1) * 32 + (swz % 64) / 2; }
__host__ __device__ __forceinline__ int perm32(int rho) { const int n = rho >> 4, i = rho & 15; return 8 * (i >> 2) + 4 * n + (i & 3); }

struct Unit { int pm, pn, seg; };

struct TileOrder {
    int nM, nN, nwg, G, c, wgm, rot, tailtile, pnoff;
    __device__ __forceinline__ void init(int nM_, int nN_, int G_, int c_, int wgm_ = WGM, int rot_ = 0, int tailtile_ = -1, int pnoff_ = 0) { nM = nM_; nN = nN_; nwg = nM * nN; G = G_; c = c_; wgm = wgm_; rot = rot_; tailtile = tailtile_; pnoff = pnoff_; }
    __device__ __forceinline__ bool tile(int i, int& pm, int& pn) const {
        const long L = (long)i * G + c; if (L >= nwg) return false;
        int wgid = (int)L; const int xcd = wgid % NXCD; { const int q = nwg / NXCD, r = nwg % NXCD, off = wgid / NXCD; wgid = (xcd < r ? xcd * (q + 1) : r * (q + 1) + (xcd - r) * q) + off; }
        const int nig = wgm * nN, gid = wgid / nig, fm = gid * wgm, gsz = (nM - fm) < wgm ? (nM - fm) : wgm;
        pm = fm + ((wgid % nig) % gsz); pn = (wgid % nig) / gsz; if (rot) { pn += rot * xcd; pn -= (pn / nN) * nN; } if (tailtile >= 0 && pn == nN - 1) pn = tailtile; pn += pnoff; return true;
    }
};
struct SchedPlain {
    TileOrder T; const gchar* A; const gchar* B; size_t astep, bstep;
    __device__ __forceinline__ bool next(int i, Unit& u) const { u.seg = 0; return T.tile(i, u.pm, u.pn); }
    __device__ __forceinline__ const gchar* a_ptr(const Unit& u) const { return A + (size_t)u.pm * astep; }
    int pn0 = 0;
    __device__ __forceinline__ const gchar* b_ptr(const Unit& u) const { return B + (size_t)(u.pn - pn0) * bstep; }
};
struct SchedBranch {
    TileOrder T; const gchar* A; const gchar* B; size_t astep, bstep, aseg, bseg;
    __device__ __forceinline__ bool next(int i, Unit& u) const { const int t = i / 3; u.seg = i - 3 * t; return T.tile(t, u.pm, u.pn); }
    __device__ __forceinline__ const gchar* a_ptr(const Unit& u) const { return A + (size_t)u.seg * aseg + (size_t)u.pm * astep; }
    __device__ __forceinline__ const gchar* b_ptr(const Unit& u) const { return B + (size_t)u.seg * bseg + (size_t)u.pn * bstep; }
};

template <class Epi, class Sched>
__device__ __forceinline__ void gemm_phase(LAS unsigned char* lds, const int K, const int lda, const int ldb, const Sched& S, const Epi& E, unsigned* lockctr = nullptr, const int nlock = 0) {
    int tid = threadIdx.x; LAUNDER_V(tid);
    const int wid = __builtin_amdgcn_readfirstlane(tid >> 6), lane = tid & 63, wr = wid >> 2, wc = wid & 3, fr = lane & 15, fq = lane >> 4;
    const int nt = K / BK;
    unsigned voffA, voffB;
    { int R, C; stage_rc(tid * 16, R, C); const int Rb = Epi::PERM ? ((R & ~31) + perm32(R & 31)) : R;
      voffA = (unsigned)(R * BK + C) * 2u; voffB = (unsigned)(Rb * BK + C) * 2u; }
    const unsigned qstepA = 64u * (unsigned)BK * 2u, qstepB = 64u * (unsigned)BK * 2u;
    const size_t kstep = (size_t)BM * BK * 2, kstepB = (size_t)BM * BK * 2;
    const size_t hstepA = (size_t)HALF * BK * 2, hstepB = (size_t)HALF * BK * 2;
    const unsigned ldsw = (unsigned)wid * 1024u;
    const int aoff = lds_byte(wr * 64 + fr, fq * 8), boff = lds_byte(wc * 32 + fr, fq * 8);
#define PG8_SA(b, h) (((b) * 2 + (h)) * HTB)
#define PG8_SB(b, h) ((4 + (b) * 2 + (h)) * HTB)
#if PG8_SADDR
#define PG8_STAGE(bufoff, gbase, voff) do { _Pragma("unroll") for (int _i = 0; _i < 2; ++_i) { const gchar* p_ = (const gchar*)(gbase) + (size_t)_i * q##voff; asm volatile("" : "+s"(p_)); \
        __builtin_amdgcn_global_load_lds((const gunsigned*)(p_ + (voff)), (LAS unsigned*)(lds + (bufoff) + ldsw + _i * 8192), 16, 0, 0); } } while (0)
#else
#define PG8_STAGE(bufoff, gbase, voff) do { _Pragma("unroll") for (int _i = 0; _i < 2; ++_i) \
        __builtin_amdgcn_global_load_lds((const gunsigned*)((const gchar*)(gbase) + (size_t)_i * q##voff + (voff)), (LAS unsigned*)(lds + (bufoff) + ldsw + _i * 8192), 16, 0, 0); } while (0)
#endif
#define qvoffA qstepA
#define qvoffB qstepB
#define PG8_LDA(dst, b, h) do { _Pragma("unroll") for (int m = 0; m < 4; ++m) _Pragma("unroll") for (int k = 0; k < 2; ++k) dst[m][k] = *(const LAS bf16x8*)(lds + PG8_SA(b, h) + aoff + m * 2048 + k * 1024); } while (0)
#define PG8_LDB(dst, b, h) do { _Pragma("unroll") for (int n = 0; n < 2; ++n) _Pragma("unroll") for (int k = 0; k < 2; ++k) dst[n][k] = *(const LAS bf16x8*)(lds + PG8_SB(b, h) + boff + n * 2048 + k * 1024); } while (0)
#define PG8_CAT(x_, y_) __builtin_bit_cast(i32x8, __builtin_shufflevector((x_), (y_), 0, 1, 2, 3, 4, 5, 6, 7, 8, 9, 10, 11, 12, 13, 14, 15))
#define PG8_MMA(ai, bj, At, Bt) do { __builtin_amdgcn_s_setprio(1); _Pragma("unroll") for (int m = 0; m < 4; ++m) _Pragma("unroll") for (int n = 0; n < 2; ++n) { \
        if constexpr (Epi::FP8) { const i32x8 b8_ = PG8_CAT(Bt[n][0], Bt[n][1]), a8_ = PG8_CAT(At[m][0], At[m][1]); \
            asm volatile("s_nop 1\n\tv_mfma_scale_f32_16x16x128_f8f6f4 %0, %1, %2, %0, %3, %3 op_sel_hi:[0,0,0]" : "+v"(acc[ai][bj][m][n]) : "v"(b8_), "v"(a8_), "v"(sc8)); } \
        else if constexpr (Epi::I8) { _Pragma("unroll") for (int k = 0; k < 2; ++k) asm volatile("s_nop 1\n\tv_mfma_i32_16x16x64_i8 %0, %1, %2, %0" : "+v"(acc[ai][bj][m][n]) : "v"(Bt[n][k]), "v"(At[m][k])); } \
        else { _Pragma("unroll") for (int k = 0; k < 2; ++k) acc[ai][bj][m][n] = __builtin_amdgcn_mfma_f32_16x16x32_bf16(Bt[n][k], At[m][k], acc[ai][bj][m][n], 0, 0, 0); } } __builtin_amdgcn_s_setprio(0); } while (0)
#define PG8_WAIT_V(n) asm volatile("s_waitcnt vmcnt(" #n ")" ::: "memory")
#define PG8_WAIT_VR() do { if constexpr (Epi::NS == 16) asm volatile("s_waitcnt vmcnt(24)" ::: "memory"); else if constexpr (Epi::NS == 32) asm volatile("s_waitcnt vmcnt(40)" ::: "memory"); else asm volatile("s_waitcnt vmcnt(8)" ::: "memory"); } while (0)
#define PG8_WAIT_L(n) asm volatile("s_waitcnt lgkmcnt(" #n ")" ::: "memory")
#define PG8_BAR __builtin_amdgcn_s_barrier()
#define PG8_SCHED __builtin_amdgcn_sched_barrier(0)
    Unit cur, nxt; int ui = 0; bool relax_next = false;
    int sc8 = 0x7f7f7f7f; asm volatile("" : "+v"(sc8));
    if (!S.next(0, cur)) return;
    f32x4 acc[2][2][4][2];
#pragma unroll
    for (int a = 0; a < 2; ++a)
#pragma unroll
        for (int b = 0; b < 2; ++b)
#pragma unroll
            for (int m = 0; m < 4; ++m)
#pragma unroll
                for (int n = 0; n < 2; ++n) acc[a][b][m][n] = (f32x4){0.f, 0.f, 0.f, 0.f};
    bf16x8 At[4][2], B0[2][2], B1[2][2];
    const gchar* cA = S.a_ptr(cur); const gchar* cB = S.b_ptr(cur);
    PG8_STAGE(PG8_SB(0, 0), cB, voffB); PG8_STAGE(PG8_SB(0, 1), cB + hstepB, voffB); PG8_STAGE(PG8_SA(0, 0), cA, voffA); PG8_STAGE(PG8_SA(0, 1), cA + hstepA, voffA);
    if (wr == 1) PG8_BAR;
    PG8_WAIT_V(2); PG8_BAR;
    PG8_STAGE(PG8_SB(1, 0), cB + kstepB, voffB); PG8_STAGE(PG8_SA(1, 0), cA + kstep, voffA); PG8_STAGE(PG8_SB(1, 1), cB + hstepB + kstepB, voffB);
    PG8_WAIT_V(6); PG8_BAR;
    for (;;) {
        const bool has_next = S.next(ui + 1, nxt);
        const gchar* nA = has_next ? S.a_ptr(nxt) : cA; const gchar* nB = has_next ? S.b_ptr(nxt) : cB;
        for (int t = 0; t < nt; t += 2) {
            const bool last = (t == nt - 2); const bool relax = Epi::NS > 0 && (t == 0) && relax_next;
#if PG8_SADDR
            asm volatile("" : "+v"(voffA), "+v"(voffB));
#endif
            const gchar* a1 = cA + (size_t)(t + 1) * kstep;
            const gchar* a2 = last ? nA : cA + (size_t)(t + 2) * kstep; const gchar* b2 = last ? nB : cB + (size_t)(t + 2) * kstepB;
            const gchar* a3 = a2 + kstep; const gchar* b3 = b2 + kstepB;
            PG8_LDB(B0, 0, 0); PG8_LDB(B1, 0, 1); PG8_SCHED; PG8_LDA(At, 0, 0); PG8_STAGE(PG8_SA(1, 1), a1 + hstepA, voffA);
            if (relax) PG8_WAIT_VR(); else PG8_WAIT_V(8); PG8_WAIT_L(0); PG8_BAR; PG8_MMA(0, 0, At, B0); PG8_MMA(0, 1, At, B1); PG8_BAR; PG8_SCHED;
            PG8_LDA(At, 0, 1); PG8_STAGE(PG8_SB(0, 0), b2, voffB); PG8_STAGE(PG8_SB(0, 1), b2 + hstepB, voffB); PG8_STAGE(PG8_SA(0, 0), a2, voffA);
            if (relax) PG8_WAIT_VR(); else PG8_WAIT_V(8); PG8_WAIT_L(0); PG8_BAR; PG8_MMA(1, 0, At, B0); PG8_MMA(1, 1, At, B1); PG8_BAR; PG8_SCHED;
            PG8_LDB(B0, 1, 0); PG8_LDB(B1, 1, 1); PG8_SCHED; PG8_LDA(At, 1, 0); PG8_STAGE(PG8_SA(0, 1), a2 + hstepA, voffA);
            PG8_WAIT_V(8); PG8_WAIT_L(0); PG8_BAR; PG8_MMA(0, 0, At, B0); PG8_MMA(0, 1, At, B1); PG8_BAR; PG8_SCHED;
            PG8_LDA(At, 1, 1); PG8_STAGE(PG8_SB(1, 0), b3, voffB); PG8_STAGE(PG8_SB(1, 1), b3 + hstepB, voffB); PG8_STAGE(PG8_SA(1, 0), a3, voffA);
            PG8_WAIT_V(8); PG8_WAIT_L(0); PG8_BAR; PG8_MMA(1, 0, At, B0); PG8_MMA(1, 1, At, B1); PG8_BAR; PG8_SCHED;
        }
        if constexpr (Epi::FP8 || Epi::I8) asm volatile("s_nop 15\n\ts_nop 15\n\ts_nop 15\n\ts_nop 15" ::: "memory");
        if (wr == 0) PG8_BAR;
        { const int ln_ = (int)__builtin_amdgcn_mbcnt_hi(~0u, __builtin_amdgcn_mbcnt_lo(~0u, 0u)); E(acc, cur, wr, wc, ln_ & 15, ln_ >> 4); } relax_next = E.relax(cur);
        if (ui < nlock) {
            if (tid == 0) { (void)xb_add(lockctr, 1u); const unsigned tgt_ = (unsigned)(ui + 1) * (unsigned)S.T.G; unsigned sp_ = 0u; while (xb_ld(lockctr) < tgt_) { __builtin_amdgcn_s_sleep(1); if (++sp_ > (1u << 20)) break; } }
            PG8_BAR; }
        if (!has_next) break;
        if (!E.keep(cur)) {
#pragma unroll
            for (int a = 0; a < 2; ++a)
#pragma unroll
                for (int b = 0; b < 2; ++b)
#pragma unroll
                    for (int m = 0; m < 4; ++m)
#pragma unroll
                        for (int n = 0; n < 2; ++n) acc[a][b][m][n] = (f32x4){0.f, 0.f, 0.f, 0.f};
        }
        cur = nxt; cA = nA; cB = nB; ++ui;
        if (wr == 1) PG8_BAR;
    }
    PG8_WAIT_V(0);
    PG8_BAR;
#undef PG8_SA
#undef PG8_SB
#undef PG8_STAGE
#undef qvoffA
#undef qvoffB
#undef PG8_LDA
#undef PG8_LDB
#undef PG8_MMA
#undef PG8_CAT
#undef PG8_WAIT_V
#undef PG8_WAIT_VR
#undef PG8_WAIT_L
#undef PG8_BAR
#undef PG8_SCHED
}
}

constexpr size_t MiB = 1u << 20;
constexpr size_t WS_CTL = 0, CTL_ZERO_BYTES = 1 * MiB;
constexpr int CW_BAR = 4096;
constexpr size_t CTL_SSQ1 = 256 * 1024;
constexpr size_t SZ_WIN = (size_t)N_IN_T * DM * 2, SZ_WBR = (size_t)3 * DM * BW * 2, SZ_WSQ = (size_t)DM * DM * 2, SZ_WPP = (size_t)DM * 256 * 2;
constexpr size_t WS_WIN = 2 * MiB;
constexpr size_t WS_WBR = WS_WIN + 2 * SZ_WIN;
constexpr size_t WS_WOUT = WS_WBR + 2 * SZ_WBR;
constexpr size_t WS_WPG = WS_WOUT + 2 * SZ_WSQ;
constexpr size_t WS_WPP = WS_WPG + 2 * SZ_WSQ;
constexpr size_t SZ_ROWS_BW = (size_t)M_ROWS * BW * 2, SZ_ROWS_D = (size_t)M_ROWS * DM * 2;
constexpr size_t WS_XB = WS_WPP + 2 * SZ_WPP;
constexpr size_t WS_PB = WS_XB + SZ_ROWS_D;
constexpr size_t WS_CS = WS_PB + (size_t)2 * M_ROWS * 256 * 2;
constexpr size_t WS_SSQ0 = WS_CS + (size_t)M_ROWS * 16 * 4;
constexpr size_t WS_AU = WS_SSQ0 + (size_t)M_ROWS * 4;
constexpr size_t WS_AV = WS_AU + SZ_ROWS_BW, WS_AZ = WS_AV + SZ_ROWS_BW, WS_BQ = WS_AZ + SZ_ROWS_BW;
constexpr size_t WS_BK = WS_BQ + SZ_ROWS_BW;
constexpr size_t WS_BV = WS_BK + (size_t)M_ROWS * 256 * 2;
constexpr size_t WS_BZ = WS_BV + (size_t)M_ROWS * 256 * 2;
constexpr size_t WS_CQ = WS_BZ + SZ_ROWS_BW;
constexpr size_t WS_CK = WS_CQ + (size_t)M_ROWS * 1024 * 2;
constexpr size_t WS_CV = WS_CK + (size_t)M_ROWS * 1024 * 2;
constexpr size_t WS_CO = WS_CV + SZ_ROWS_BW, WS_CZ = WS_CO + SZ_ROWS_BW;
constexpr size_t WS_G = WS_CZ + SZ_ROWS_BW;
constexpr size_t WS_IF = WS_G + (size_t)M_ROWS * 12288 * 2;
constexpr size_t WS_LNP = WS_IF + (size_t)M_ROWS * 8 * 4;
constexpr size_t WS_YA = WS_LNP + (size_t)M_ROWS * 32 * 8;
constexpr size_t WS_NUM = WS_YA + 3 * SZ_ROWS_BW;
constexpr size_t WS_SSQC = WS_NUM + SZ_ROWS_BW;
constexpr size_t WS_DN = WS_SSQC + (size_t)M_ROWS * 64 * 4;
constexpr size_t WS_MIX = WS_DN + (size_t)M_ROWS * 4 * 4;
constexpr size_t WS_OUT = WS_MIX + SZ_ROWS_D;
constexpr size_t WS_OUTP = WS_OUT + SZ_ROWS_D;
constexpr size_t WS_ERAW = WS_OUTP + (size_t)M_ROWS * 64 * 4;
constexpr size_t WS_ERP = WS_ERAW + SZ_ROWS_D;
constexpr size_t WS_RSO = WS_ERP + (size_t)M_ROWS * 64 * 4;
constexpr size_t WS_RSE = WS_RSO + (size_t)M_ROWS * 4;
constexpr size_t WS_X1B = WS_RSE + (size_t)M_ROWS * 4;
constexpr size_t WS_XSP = WS_X1B + SZ_ROWS_D;
constexpr size_t WS_X1B8 = WS_XSP + (size_t)M_ROWS * 64 * 4;
constexpr size_t WS_RSX = WS_X1B8 + (size_t)M_ROWS * DM;
constexpr size_t WS_XB8 = WS_RSX + (size_t)M_ROWS * 4;
constexpr size_t SZ_WG8 = (size_t)56 * 256 * DM;
constexpr size_t WS_WG8 = WS_XB8 + (size_t)M_ROWS * DM;
constexpr size_t WS_END = WS_WG8 + 2 * SZ_WG8;
static_assert(WS_WIN % 256 == 0 && WS_XB % 256 == 0 && WS_AU % 256 == 0 && WS_G % 256 == 0 && WS_YA % 256 == 0 && WS_MIX % 256 == 0 && WS_X1B % 256 == 0, "alignment");

#ifndef EPIIN_NT
#define EPIIN_NT 0
#endif
#if EPIIN_NT
#define EPIIN_STORE(v, p) __builtin_nontemporal_store((v), (p))
#else
#define EPIIN_STORE(v, p) (*(p) = (v))
#endif
#ifndef DBG_ZERO_ASC
#define DBG_ZERO_ASC 0
#endif
#ifndef P1G_FP8
#define P1G_FP8 1
#endif
#ifndef P5_I8
#define P5_I8 1
#endif
constexpr int CW_WMAX = 512;
#ifndef P5_FP8
#define P5_FP8 0
#endif
constexpr float W8_SCALE = 256.0f;
#ifndef EPI_NS16
#define EPI_NS16 0
#endif
#ifndef EPI_NS32
#define EPI_NS32 0
#endif
#ifndef EPIIN_NS
#define EPIIN_NS 0
#endif
namespace pg8 {
__device__ __forceinline__ unsigned pack_u8x4(float a, float b, float c, float d) {
    const unsigned q0 = (unsigned)(a * 255.0f + 0.5f), q1 = (unsigned)(b * 255.0f + 0.5f), q2 = (unsigned)(c * 255.0f + 0.5f), q3 = (unsigned)(d * 255.0f + 0.5f);
    return q0 | (q1 << 8) | (q2 << 16) | (q3 << 24);
}
template <bool F8> struct EpiInT {
    static constexpr bool PERM = true; static constexpr int NS = EPIIN_NS; static constexpr bool FP8 = F8; static constexpr bool I8 = false;
    __device__ __forceinline__ bool relax(const Unit& u) const { return u.pn < 122; }
    const gfloat* ssq; guchar* ws; const LAS float* rtab; int rowbase;
    __device__ __forceinline__ float rstd_of(int row) const { return rowbase >= 0 ? rtab[row - rowbase] : rsqrtf(ssq[row] * (1.0f / DM) + NORM_EPS); }
    __device__ __forceinline__ bool keep(const Unit&) const { return false; }
    __device__ __forceinline__ void operator()(f32x4 (&acc)[2][2][4][2], const Unit& u, int wr, int wc, int fr, int fq) const {
        const int pn = u.pn; const int row0 = u.pm * BM + wr * 64 + fr;
        size_t off; int ldc, t0, act; float sc = 1.f;
        if (pn < 16)       { off = WS_AU; ldc = 2048; t0 = 0; act = 6; }
        else if (pn < 24)  { off = WS_AV; ldc = 2048; t0 = 16; act = 5; }
        else if (pn < 32)  { off = WS_BQ; ldc = 2048; t0 = 24; act = 0; }
        else if (pn < 33)  { off = WS_BK; ldc = 256; t0 = 32; act = 0; }
        else if (pn < 34)  { off = WS_BV; ldc = 256; t0 = 33; act = 0; }
        else if (pn < 42)  { off = WS_BZ; ldc = 2048; t0 = 34; act = 2; }
        else if (pn < 46)  { off = WS_CQ; ldc = 1024; t0 = 42; act = 0; sc = 0.0625f; }
        else if (pn < 50)  { off = WS_CK; ldc = 1024; t0 = 46; act = 0; }
        else if (pn < 58)  { off = WS_CV; ldc = 2048; t0 = 50; act = 0; }
        else if (pn < 66)  { off = WS_CZ; ldc = 2048; t0 = 58; act = 2; }
        else if (pn < 122) { off = WS_G; ldc = 12288; t0 = 74; act = 3; if (F8) sc = 1.0f / W8_SCALE; }
        else if (F8)       { off = WS_CO; ldc = 2048; t0 = 122; act = 8; sc = 1.0f / W8_SCALE; }
        else               { off = WS_IF; ldc = 8; t0 = 122; act = 4; }
        const int col0 = (pn - t0) * BM + wc * 32 + 8 * fq;
        if (act == 4) {
            if (wc == 0 && fq == 0) {
                gfloat* dst = (gfloat*)(ws + off);
#pragma unroll
                for (int ai = 0; ai < 2; ++ai)
#pragma unroll
                    for (int m = 0; m < 4; ++m) { const int row = row0 + ai * HALF + m * 16; const float rs = rstd_of(row);
                        *(gf32x4*)(dst + (size_t)row * 8) = acc[ai][0][m][0] * rs; *(gf32x4*)(dst + (size_t)row * 8 + 4) = acc[ai][0][m][1] * rs; }
            }
            return;
        }
        gbf16* base = (gbf16*)(ws + off);
        if (act == 6 || act == 7) {
            const int colp = (pn - t0) * HALF + wc * 32 + 8 * fq;
#pragma unroll
            for (int ai = 0; ai < 2; ++ai)
#pragma unroll
                for (int m = 0; m < 4; ++m) {
                    const int row = row0 + ai * HALF + m * 16; const float rs = rstd_of(row);
                    f32x4 a0 = acc[ai][0][m][0] * rs, a1 = acc[ai][0][m][1] * rs; const f32x4 z0 = acc[ai][1][m][0] * rs, z1 = acc[ai][1][m][1] * rs;
                    if (act == 6) { const f32x2 a = gelu_pk((f32x2){a0[0], a0[1]}), b = gelu_pk((f32x2){a0[2], a0[3]}), c = gelu_pk((f32x2){a1[0], a1[1]}), d = gelu_pk((f32x2){a1[2], a1[3]});
                        a0 = (f32x4){a.x, a.y, b.x, b.y}; a1 = (f32x4){c.x, c.y, d.x, d.y}; }
                    else {
#pragma unroll
                        for (int j = 0; j < 4; ++j) { a0[j] = fsigmoid(a0[j]); a1[j] = fsigmoid(a1[j]); } }
#pragma unroll
                    for (int j = 0; j < 4; ++j) { a0[j] *= z0[j] * fsigmoid(z0[j]); a1[j] *= z1[j] * fsigmoid(z1[j]); }
                    u32x4 w; w.x = cvt_pk_bf16(a0[0], a0[1]); w.y = cvt_pk_bf16(a0[2], a0[3]); w.z = cvt_pk_bf16(a1[0], a1[1]); w.w = cvt_pk_bf16(a1[2], a1[3]);
                    *(gu32x4*)(base + tb128(row, colp, 16)) = w;
                }
            return;
        }
#pragma unroll
        for (int ai = 0; ai < 2; ++ai)
#pragma unroll
            for (int m = 0; m < 4; ++m) {
                const int row = row0 + ai * HALF + m * 16; const float rs = rstd_of(row) * sc;
                gbf16* rowp = base + tb256(row, col0, ldc >> 8); float ls = 0.f, lq = 0.f;
#pragma unroll
                for (int bj = 0; bj < 2; ++bj) {
                    f32x4 v0 = acc[ai][bj][m][0] * rs, v1 = acc[ai][bj][m][1] * rs;
                    if (act == 5) {
                        f32x2 a = gelu_pk((f32x2){v0[0], v0[1]}), b = gelu_pk((f32x2){v0[2], v0[3]}), c = gelu_pk((f32x2){v1[0], v1[1]}), d = gelu_pk((f32x2){v1[2], v1[3]});
                        v0 = (f32x4){a.x, a.y, b.x, b.y}; v1 = (f32x4){c.x, c.y, d.x, d.y};
                        { ls += (v0[0] + v0[1]) + (v0[2] + v0[3]) + (v1[0] + v1[1]) + (v1[2] + v1[3]);
                            lq += (v0[0] * v0[0] + v0[1] * v0[1]) + (v0[2] * v0[2] + v0[3] * v0[3]) + (v1[0] * v1[0] + v1[1] * v1[1]) + (v1[2] * v1[2] + v1[3] * v1[3]); }
                    } else if (act == 2) {
#pragma unroll
                        for (int j = 0; j < 4; ++j) { v0[j] = v0[j] * fsigmoid(v0[j]); v1[j] = v1[j] * fsigmoid(v1[j]); }
                    } else if (act == 3 || act == 8) {
#pragma unroll
                        for (int j = 0; j < 4; ++j) { v0[j] = fsigmoid(v0[j]); v1[j] = fsigmoid(v1[j]); }
                    }
                    if (act == 3) {
                        u32x2 w8; w8.x = pack_u8x4(v0[0], v0[1], v0[2], v0[3]); w8.y = pack_u8x4(v1[0], v1[1], v1[2], v1[3]);
                        *(gu32x2*)(ws + WS_G + ((size_t)(u.pm * 48 + (pn - 74)) * 256 + (row & 255)) * 256 + (wc * 32 + 8 * fq) + bj * HALF) = w8;
                    } else {
                    u32x4 w; w.x = cvt_pk_bf16(v0[0], v0[1]); w.y = cvt_pk_bf16(v0[2], v0[3]); w.z = cvt_pk_bf16(v1[0], v1[1]); w.w = cvt_pk_bf16(v1[2], v1[3]);
                    EPIIN_STORE(w, (gu32x4*)(rowp + bj * HALF)); }
                }
                if (act == 5) {
                    ls += __shfl_xor(ls, 16); ls += __shfl_xor(ls, 32); lq += __shfl_xor(lq, 16); lq += __shfl_xor(lq, 32);
                    if (fq == 0) *(gf32x2*)(ws + WS_LNP + ((size_t)row * 32 + (pn - 16) * 4 + wc) * 8) = (f32x2){ls, lq};
                }
            }
    }
};
using EpiIn = EpiInT<false>;
struct EpiBranch {
    static constexpr bool PERM = true; static constexpr int NS = EPI_NS16; static constexpr bool FP8 = false; static constexpr bool I8 = false;
    __device__ __forceinline__ bool relax(const Unit& u) const { return u.seg == 2; }
    const guchar* G; gbf16* MIX;
    __device__ __forceinline__ bool keep(const Unit& u) const { return u.seg != 2; }
    __device__ __forceinline__ void operator()(f32x4 (&acc)[2][2][4][2], const Unit& u, int wr, int wc, int fr, int fq) const {
        const int row0 = u.pm * BM + wr * 64 + fr, col0 = u.pn * BM + wc * 32 + 8 * fq; const int seg = u.seg;
        u32x2 ga[2][4][2], gb[2][4][2];
#pragma unroll
        for (int ai = 0; ai < 2; ++ai)
#pragma unroll
            for (int m = 0; m < 4; ++m) {
                const int row = row0 + ai * HALF + m * 16; const guchar* gp = G + ((size_t)(u.pm * 48 + seg * 16 + u.pn) * 256 + (row & 255)) * 256 + (wc * 32 + 8 * fq);
#pragma unroll
                for (int bj = 0; bj < 2; ++bj) { ga[ai][m][bj] = *(const gu32x2*)(gp + bj * HALF); gb[ai][m][bj] = (seg != 2) ? *(const gu32x2*)(gp + (size_t)16 * 65536 + bj * HALF) : (u32x2){255u * 0x01010101u, 255u * 0x01010101u}; }
            }
#pragma unroll
        for (int ai = 0; ai < 2; ++ai)
#pragma unroll
            for (int m = 0; m < 4; ++m) {
                const int row = row0 + ai * HALF + m * 16;
#pragma unroll
                for (int bj = 0; bj < 2; ++bj) {
                    const u32x2 a_ = ga[ai][m][bj], b_ = gb[ai][m][bj];
                    float f[8] = {(float)((a_.x >> (8 * 0)) & 0xffu), (float)((a_.x >> (8 * 1)) & 0xffu), (float)((a_.x >> (8 * 2)) & 0xffu), (float)((a_.x >> (8 * 3)) & 0xffu),
                                  (float)((a_.y >> (8 * 0)) & 0xffu), (float)((a_.y >> (8 * 1)) & 0xffu), (float)((a_.y >> (8 * 2)) & 0xffu), (float)((a_.y >> (8 * 3)) & 0xffu)};
                    const float h[8] = {(float)((b_.x >> (8 * 0)) & 0xffu), (float)((b_.x >> (8 * 1)) & 0xffu), (float)((b_.x >> (8 * 2)) & 0xffu), (float)((b_.x >> (8 * 3)) & 0xffu),
                                        (float)((b_.y >> (8 * 0)) & 0xffu), (float)((b_.y >> (8 * 1)) & 0xffu), (float)((b_.y >> (8 * 2)) & 0xffu), (float)((b_.y >> (8 * 3)) & 0xffu)};
#pragma unroll
                    for (int j = 0; j < 8; ++j) f[j] = fmaxf(f[j], 1e-18f) * __builtin_amdgcn_rcpf(fmaxf(h[j], 1e-18f));
                    f32x4 v0 = acc[ai][bj][m][0], v1 = acc[ai][bj][m][1];
                    v0 = v0 * (f32x4){f[0], f[1], f[2], f[3]}; v1 = v1 * (f32x4){f[4], f[5], f[6], f[7]};
                    if (seg != 2) { acc[ai][bj][m][0] = v0; acc[ai][bj][m][1] = v1; }
                    else { u32x4 w; w.x = cvt_pk_bf16(v0[0], v0[1]); w.y = cvt_pk_bf16(v0[2], v0[3]); w.z = cvt_pk_bf16(v1[0], v1[1]); w.w = cvt_pk_bf16(v1[2], v1[3]);
                        *(gu32x4*)(MIX + ablk(row, col0 + bj * HALF, DM)) = w; }
                }
            }
    }
};
struct EpiSq {
    static constexpr bool PERM = true; static constexpr int NS = EPI_NS16; static constexpr bool FP8 = false; static constexpr bool I8 = false;
    __device__ __forceinline__ bool relax(const Unit&) const { return true; }
    gbf16* O; gfloat* P;
    __device__ __forceinline__ bool keep(const Unit&) const { return false; }
    __device__ __forceinline__ void operator()(f32x4 (&acc)[2][2][4][2], const Unit& u, int wr, int wc, int fr, int fq) const {
        const int row0 = u.pm * BM + wr * 64 + fr, col0 = u.pn * BM + wc * 32 + 8 * fq;
#pragma unroll
        for (int ai = 0; ai < 2; ++ai)
#pragma unroll
            for (int m = 0; m < 4; ++m) {
                const int row = row0 + ai * HALF + m * 16; float q = 0.f;
#pragma unroll
                for (int bj = 0; bj < 2; ++bj) {
                    const f32x4 v0 = acc[ai][bj][m][0], v1 = acc[ai][bj][m][1];
                    q += (v0[0] * v0[0] + v0[1] * v0[1]) + (v0[2] * v0[2] + v0[3] * v0[3]) + (v1[0] * v1[0] + v1[1] * v1[1]) + (v1[2] * v1[2] + v1[3] * v1[3]);
                    u32x4 w; w.x = cvt_pk_bf16(v0[0], v0[1]); w.y = cvt_pk_bf16(v0[2], v0[3]); w.z = cvt_pk_bf16(v1[0], v1[1]); w.w = cvt_pk_bf16(v1[2], v1[3]);
                    if (O) *(gu32x4*)(O + (size_t)row * DM + col0 + bj * HALF) = w; else asm volatile("" :: "v"(w));
                }
                q += __shfl_xor(q, 16); q += __shfl_xor(q, 32);
                if (fq == 0) P[(size_t)row * 64 + u.pn * 4 + wc] = q;
            }
    }
};
struct EpiPle {
    static constexpr bool PERM = true; static constexpr int NS = EPI_NS32; static constexpr bool FP8 = P5_FP8 != 0; static constexpr bool I8 = P5_I8 != 0;
    __device__ __forceinline__ bool relax(const Unit&) const { return true; }
    const gbf16* X1B; gfloat* XOUT; gbf16* XB; const gbf16* ERAW; const gfloat* RSE; const gfloat* pnorm; gfloat* SSQN; int last; guchar* XB8; const gfloat* RSX; float swq;
    __device__ __forceinline__ bool keep(const Unit&) const { return false; }
    __device__ __forceinline__ void operator()(f32x4 (&acc)[2][2][4][2], const Unit& u, int wr, int wc, int fr, int fq) const {
        const int row0 = u.pm * BM + wr * 64 + fr, col0 = u.pn * BM + wc * 32 + 8 * fq; constexpr float ASC = FP8 ? (DBG_ZERO_ASC ? 0.0f : 1.0f / W8_SCALE) : 1.0f;
#pragma unroll
        for (int ai = 0; ai < 2; ++ai)
#pragma unroll
            for (int m = 0; m < 4; ++m) {
                const int row = row0 + ai * HALF + m * 16; const float rse = RSE[row]; float q = 0.f; const size_t ro = (size_t)row * DM; const float zsc = I8 ? RSX[row] * swq : ASC;
#pragma unroll
                for (int bj = 0; bj < 2; ++bj) {
                    const int col = col0 + bj * HALF;
                    const u32x4 xb = *(const gu32x4*)(X1B + ablk(row, col, DM)), eb = *(const gu32x4*)(ERAW + ro + col);
                    const f32x4 pna = *(const gf32x4*)(pnorm + col), pnb = *(const gf32x4*)(pnorm + col + 4);
                    const float x[8] = {bf_lo(xb.x), bf_hi(xb.x), bf_lo(xb.y), bf_hi(xb.y), bf_lo(xb.z), bf_hi(xb.z), bf_lo(xb.w), bf_hi(xb.w)};
                    const float e8[8] = {bf_lo(eb.x), bf_hi(eb.x), bf_lo(eb.y), bf_hi(eb.y), bf_lo(eb.z), bf_hi(eb.z), bf_lo(eb.w), bf_hi(eb.w)};
                    const float pn[8] = {pna[0], pna[1], pna[2], pna[3], pnb[0], pnb[1], pnb[2], pnb[3]};
                    const f32x4 a0 = acc[ai][bj][m][0], a1 = acc[ai][bj][m][1];
                    const float a[8] = {I8 ? (float)__float_as_int(a0[0]) : a0[0], I8 ? (float)__float_as_int(a0[1]) : a0[1], I8 ? (float)__float_as_int(a0[2]) : a0[2], I8 ? (float)__float_as_int(a0[3]) : a0[3],
                                        I8 ? (float)__float_as_int(a1[0]) : a1[0], I8 ? (float)__float_as_int(a1[1]) : a1[1], I8 ? (float)__float_as_int(a1[2]) : a1[2], I8 ? (float)__float_as_int(a1[3]) : a1[3]};
                    float r[8];
#pragma unroll
                    for (int j = 0; j < 8; ++j) { r[j] = x[j] + fsigmoid(a[j] * zsc) * (e8[j] * rse * pn[j]); q += r[j] * r[j]; }
                    if (last) { *(gf32x4*)(XOUT + ro + col) = (f32x4){r[0], r[1], r[2], r[3]}; *(gf32x4*)(XOUT + ro + col + 4) = (f32x4){r[4], r[5], r[6], r[7]}; }
                    else { u32x4 w; w.x = cvt_pk_bf16(r[0], r[1]); w.y = cvt_pk_bf16(r[2], r[3]); w.z = cvt_pk_bf16(r[4], r[5]); w.w = cvt_pk_bf16(r[6], r[7]); *(gu32x4*)(XB + ablk(row, col, DM)) = w;
                        if (P1G_FP8) { u32x2 w8; w8.x = pack_fp8x4(r[0], r[1], r[2], r[3]); w8.y = pack_fp8x4(r[4], r[5], r[6], r[7]); *(gu32x2*)(XB8 + ablk8(row, col, DM)) = w8; } }
                }
                if (!last) { q += __shfl_xor(q, 16); q += __shfl_xor(q, 32); if (fq == 0) SSQN[(size_t)row * 64 + u.pn * 4 + wc] = q; }
                if (m & 1) asm volatile("" ::: "memory");
            }
    }
};
}

constexpr int LDS_BYTES = 163840;
constexpr int MISC_OFF = LDS_BYTES - 128;
constexpr int ARGS_OFF = LDS_BYTES - 512;
constexpr int NWAVES = 8, NTHREADS = 512;

struct Ctx {
    LAS unsigned char* lds; int tid, lane, wave, vcu, G, bx;
};

struct TrTile { const gfloat* W; const gfloat* kscale; gbf16* WT; int ldw, K; guchar* W8; const gunsigned* QS; };
constexpr int TR_PER_LAYER = 7808 + 1536 + 1024 + 1024 + 64;
__device__ __forceinline__ TrTile tr_decode(int it, const gfloat* w_in, const gfloat* norm_pre, const gfloat* w_branch, const gfloat* w_out, const gfloat* ple_gate, const gfloat* ple_proj, guchar* ws) {
    const int l = it / TR_PER_LAYER; int r = it - l * TR_PER_LAYER; TrTile t; int kt, ntile; t.W8 = nullptr; t.QS = nullptr;
    if (r < 7808) { kt = r / 244; ntile = r - kt * 244; const int src = ntile < 116 ? ntile * 128 : ntile * 128 + 8;
        if (ntile < 16) ntile = 2 * ntile; else if (ntile < 32) ntile = ntile + 16; else if (ntile < 48) ntile = 2 * (ntile - 32) + 1;
        const int oblk = (ntile >= 116 && ntile < 132) ? ntile - 116 : -1; if (ntile >= 132 && ntile < 148) ntile -= 16;
        t.ldw = N_IN; t.K = DM; t.W = w_in + (size_t)l * DM * N_IN + (size_t)kt * 128 * N_IN + src; t.kscale = norm_pre + l * DM + kt * 128;
        t.WT = (gbf16*)(ws + WS_WIN + (size_t)l * SZ_WIN) + ((size_t)(ntile >> 1) * (DM / 64) + (size_t)kt * 2) * 16384 + (size_t)(ntile & 1) * 128 * 64;
        if (ntile >= 148) t.W8 = ws + WS_WG8 + (size_t)l * SZ_WG8 + ((size_t)((ntile - 148) >> 1) * (DM / 128) + (size_t)kt) * 32768 + (size_t)(ntile & 1) * 128 * 128;
        if (oblk >= 0) t.W8 = ws + WS_WG8 + (size_t)l * SZ_WG8 + ((size_t)(48 + (oblk >> 1)) * (DM / 128) + (size_t)kt) * 32768 + (size_t)(oblk & 1) * 128 * 128;
        return t; }
    r -= 7808; t.kscale = nullptr; t.ldw = DM;
    if (r < 1536) { const int j = r / 512; const int rr = r - j * 512; kt = rr / 32; ntile = rr - kt * 32; t.K = BW;
        t.W = w_branch + ((size_t)(l * 3 + j) * BW + (size_t)kt * 128) * DM + ntile * 128;
        t.WT = (gbf16*)(ws + WS_WBR + (size_t)l * SZ_WBR) + (size_t)j * DM * BW + ((size_t)(ntile >> 1) * (BW / 64) + (size_t)kt * 2) * 16384 + (size_t)(ntile & 1) * 128 * 64; return t; }
    r -= 1536;
    if (r < 2048) { const int which = r / 1024; const int rr = r - which * 1024; kt = rr / 32; ntile = rr - kt * 32; t.K = DM;
        t.W = (which ? ple_gate : w_out) + ((size_t)l * DM + (size_t)kt * 128) * DM + ntile * 128;
        t.WT = (gbf16*)(ws + (which ? WS_WPG : WS_WOUT) + (size_t)l * SZ_WSQ) + ((size_t)(ntile >> 1) * (DM / 64) + (size_t)kt * 2) * 16384 + (size_t)(ntile & 1) * 128 * 64;
        if (P5_I8 && which) t.QS = (const gunsigned*)(ws + WS_CTL) + CW_WMAX + l;
        if ((P5_FP8 || P5_I8) && which) t.W8 = ws + WS_WPG + (size_t)l * SZ_WSQ + ((size_t)(ntile >> 1) * (DM / 128) + (size_t)kt) * 32768 + (size_t)(ntile & 1) * 128 * 128;
        return t; }
    r -= 2048; kt = r / 32; ntile = r - kt * 32; t.K = 256;
    t.W = ple_proj + ((size_t)l * 256 + (size_t)kt * 128) * DM + ntile * 128;
    t.WT = (gbf16*)(ws + WS_WPP + (size_t)l * SZ_WPP) + ((size_t)(ntile >> 1) * (256 / 64) + (size_t)kt * 2) * 16384 + (size_t)(ntile & 1) * 128 * 64; return t;
}
#ifndef TR_NTLOAD
#define TR_NTLOAD 0
#endif
#ifndef TR_REVERSE
#define TR_REVERSE 1
#endif
__device__ __forceinline__ void tr_run(const Ctx& F, int it0, int it1, int sk0, int sk1, int me, int nw, const gfloat* w_in, const gfloat* norm_pre, const gfloat* w_branch,
                                       const gfloat* w_out, const gfloat* ple_gate, const gfloat* ple_proj, guchar* ws) {
    int tid = F.tid; LAUNDER_V(tid);
    {
        constexpr int RS = 264; const int NIT = it1 - it0 - (sk1 - sk0);
        const int c4 = tid & 31, kr = tid >> 5, kc = tid & 15;
        f32x4 va[8], vb[8]; float ka[8], kb[8]; TrTile ta, tb;
#define TR_LOAD(T_, V_, K_, IT_) do { const int ir_ = TR_REVERSE ? (NIT - 1 - (IT_)) : (IT_); T_ = tr_decode(it0 + ir_ + (((it0 + ir_) >= sk0) ? (sk1 - sk0) : 0), w_in, norm_pre, w_branch, w_out, ple_gate, ple_proj, ws); \
        _Pragma("unroll") for (int i = 0; i < 8; ++i) { V_[i] = TR_NTLOAD ? __builtin_nontemporal_load((const gf32x4*)(T_.W + (size_t)(i * 16 + kr) * T_.ldw + 4 * c4)) : *(const gf32x4*)(T_.W + (size_t)(i * 16 + kr) * T_.ldw + 4 * c4); K_[i] = T_.kscale ? T_.kscale[i * 16 + kr] : 1.0f; } } while (0)
#define TR_PUT(V_, K_) do { _Pragma("unroll") for (int i = 0; i < 8; ++i) { const f32x4 a = V_[i] * K_[i]; u32x2 w; w.x = cvt_pk_bf16(a[0], a[1]); w.y = cvt_pk_bf16(a[2], a[3]); \
        *(LAS u32x2*)(F.lds + (i * 16 + kr) * RS + c4 * 8) = w; } } while (0)
#define TR_GET(WT_, W8_, QS_) do { _Pragma("unroll") for (int q = 0; q < 4; ++q) { const int n = 32 * q + (tid >> 4), kq = kc; \
        const LAS bf16_t* s = (const LAS bf16_t*)(F.lds + (8 * kq) * RS + 2 * n); unsigned e[8]; \
        _Pragma("unroll") for (int j = 0; j < 8; ++j) e[j] = s[j * (RS / 2)]; \
        if (QS_) { const float qs_ = 127.0f / fmaxf(__uint_as_float(*(QS_)), 1e-30f); u32x2 o8; \
            o8.x = pack_i8x4(__uint_as_float(e[0] << 16) * qs_, __uint_as_float(e[1] << 16) * qs_, __uint_as_float(e[2] << 16) * qs_, __uint_as_float(e[3] << 16) * qs_); \
            o8.y = pack_i8x4(__uint_as_float(e[4] << 16) * qs_, __uint_as_float(e[5] << 16) * qs_, __uint_as_float(e[6] << 16) * qs_, __uint_as_float(e[7] << 16) * qs_); \
            *(gu32x2*)((W8_) + n * 128 + 8 * kq) = o8; } \
        else if (W8_) { u32x2 o8; o8.x = pack_fp8x4(__uint_as_float(e[0] << 16) * W8_SCALE, __uint_as_float(e[1] << 16) * W8_SCALE, __uint_as_float(e[2] << 16) * W8_SCALE, __uint_as_float(e[3] << 16) * W8_SCALE); \
            o8.y = pack_fp8x4(__uint_as_float(e[4] << 16) * W8_SCALE, __uint_as_float(e[5] << 16) * W8_SCALE, __uint_as_float(e[6] << 16) * W8_SCALE, __uint_as_float(e[7] << 16) * W8_SCALE); \
            *(gu32x2*)((W8_) + n * 128 + 8 * kq) = o8; } \
        else { u32x4 o; o.x = e[0] | (e[1] << 16); o.y = e[2] | (e[3] << 16); o.z = e[4] | (e[5] << 16); o.w = e[6] | (e[7] << 16); \
        *(gu32x4*)(WT_ + (size_t)(kq >> 3) * 16384 + n * 64 + 8 * (kq & 7)) = o; } } } while (0)
        int it = me;
        if (it < NIT) TR_LOAD(ta, va, ka, it);
        if (it + nw < NIT) TR_LOAD(tb, vb, kb, it + nw);
        while (it < NIT) {
            { TR_PUT(va, ka); __syncthreads(); gbf16* wt = ta.WT; guchar* kk = ta.W8; const gunsigned* qp = ta.QS;
              if (it + 2 * nw < NIT) TR_LOAD(ta, va, ka, it + 2 * nw);
              TR_GET(wt, kk, qp); __syncthreads(); }
            it += nw; if (it >= NIT) break;
            { TR_PUT(vb, kb); __syncthreads(); gbf16* wt = tb.WT; guchar* kk = tb.W8; const gunsigned* qp = tb.QS;
              if (it + 2 * nw < NIT) TR_LOAD(tb, vb, kb, it + 2 * nw);
              TR_GET(wt, kk, qp); __syncthreads(); }
            it += nw;
        }
#undef TR_LOAD
#undef TR_PUT
#undef TR_GET
    }
}
#ifndef TR_NODEFER
#define TR_NODEFER 0
#endif
#ifndef TR_WOUT1_TAIL
#define TR_WOUT1_TAIL 1
#endif
constexpr int TR_PG0 = 7808 + 1536 + 1024, TR_PG1 = TR_PER_LAYER + TR_PG0;
constexpr int TR_DEFER0 = TR_PER_LAYER + 7808 + 1536, TR_DEFER1 = TR_DEFER0 + (TR_NODEFER ? 0 : 2048);
__device__ __forceinline__ void p0_prologue(const Ctx& F, const gfloat* x, const gfloat* p, const gint* positions, const gfloat* norm_pre, const gfloat* w_in, const gfloat* w_branch,
                                            const gfloat* w_out, const gfloat* ple_gate, const gfloat* ple_proj, guchar* ws) {
    int tid = F.tid; LAUNDER_V(tid);
#if P5_I8
    tr_run(F, 0, TR_PG1 - (TR_WOUT1_TAIL ? 1024 : 0), TR_PG0, TR_PG0 + 1024, F.vcu, F.G, w_in, norm_pre, w_branch, w_out, ple_gate, ple_proj, ws);
    tr_run(F, TR_PG1 + 1024, NLAYER * TR_PER_LAYER, 0x7fffffff, 0x7fffffff, F.vcu, F.G, w_in, norm_pre, w_branch, w_out, ple_gate, ple_proj, ws);
    { const int gt_ = F.vcu * NTHREADS + tid, NGT_ = F.G * NTHREADS;
      for (int l = 0; l < NLAYER; ++l) { const gf32x4* wp = (const gf32x4*)(ple_gate + (size_t)l * DM * DM); float mx = 0.f;
          for (int i0 = gt_; i0 < DM * DM / 4; i0 += 8 * NGT_) { f32x4 a[8];
#pragma unroll
              for (int j = 0; j < 8; ++j) { const int i = i0 + j * NGT_; a[j] = wp[i < DM * DM / 4 ? i : i0]; }
#pragma unroll
              for (int j = 0; j < 8; ++j) mx = fmaxf(mx, fmaxf(fmaxf(fabsf(a[j][0]), fabsf(a[j][1])), fmaxf(fabsf(a[j][2]), fabsf(a[j][3])))); }
#pragma unroll
          for (int s = 32; s >= 1; s >>= 1) mx = fmaxf(mx, __shfl_xor(mx, s));
          if (F.lane == 0) atomicMax((unsigned*)((gunsigned*)(ws + WS_CTL) + CW_WMAX + l), __float_as_uint(mx)); } }
#else
    tr_run(F, 0, NLAYER * TR_PER_LAYER, TR_DEFER0, TR_DEFER1, F.vcu, F.G, w_in, norm_pre, w_branch, w_out, ple_gate, ple_proj, ws);
#endif
    const int gt = F.vcu * NTHREADS + tid, NGT = F.G * NTHREADS;
    for (int i = gt; i < NLAYER * 256 * DM; i += NGT) { const int l = i / (256 * DM), rr = (i / DM) & 255, k = i & (DM - 1);
        float val = 0.f; if (rr < 8) val = w_in[(size_t)l * DM * N_IN + (size_t)k * N_IN + IF_COL + rr] * norm_pre[l * DM + k];
        ((gbf16*)(ws + WS_WIN + (size_t)l * SZ_WIN))[((size_t)122 * (DM / 64) + (k >> 6)) * 16384 + rr * 64 + (k & 63)] = (bf16_t)(cvt_pk_bf16(val, 0.f) & 0xffffu); }
    for (int i = gt; i < NLAYER * M_ROWS * 256 / 4; i += NGT) { const f32x4 a = ((const gf32x4*)p)[i]; u32x2 w; w.x = cvt_pk_bf16(a[0], a[1]); w.y = cvt_pk_bf16(a[2], a[3]);
        const int l = i / (M_ROWS * 64), r = (i >> 6) & (M_ROWS - 1), c = (i & 63) * 4; *(gu32x2*)((gbf16*)(ws + WS_PB) + (size_t)l * M_ROWS * 256 + ablk(r, c, 256)) = w; }
    for (int i = gt; i < M_ROWS * 8; i += NGT) { const int row = i >> 3, j = i & 7; const float inv = powf(500000.0f, -(float)j * 0.125f); const float ang = (float)positions[row] * inv;
        gfloat* cs = (gfloat*)(ws + WS_CS) + (size_t)row * 16; cs[j] = cosf(ang); cs[8 + j] = sinf(ang); }
    { const int gw = F.vcu * NWAVES + F.wave, NGW = F.G * NWAVES;
      for (int m = gw; m < M_ROWS; m += NGW) { const gf32x4* xr = (const gf32x4*)(x + (size_t)m * DM) + F.lane; gbf16* o = (gbf16*)(ws + WS_XB); float s = 0.f;
#pragma unroll
          for (int j = 0; j < 16; ++j) { const f32x4 a = xr[64 * j]; s += (a[0] * a[0] + a[1] * a[1]) + (a[2] * a[2] + a[3] * a[3]); u32x2 w; w.x = cvt_pk_bf16(a[0], a[1]); w.y = cvt_pk_bf16(a[2], a[3]); *(gu32x2*)(o + ablk(m, (F.lane + 64 * j) * 4, DM)) = w;
              if (P1G_FP8) *(gunsigned*)(ws + WS_XB8 + ablk8(m, (F.lane + 64 * j) * 4, DM)) = pack_fp8x4(a[0], a[1], a[2], a[3]); }
          s = wave_sum(s); if (F.lane == 0) ((gfloat*)(ws + WS_SSQ0))[m] = s; } }
}

__device__ __forceinline__ u32x2 pack4(const f32x4 v) { u32x2 w; w.x = cvt_pk_bf16(v[0], v[1]); w.y = cvt_pk_bf16(v[2], v[3]); return w; }
__device__ __forceinline__ bf16x8 mk_frag(const u32x2 lo, const u32x2 hi) { const u32x4 t = {lo.x, lo.y, hi.x, hi.y}; return __builtin_bit_cast(bf16x8, t); }
__device__ __forceinline__ bf16x8 frag_const(unsigned w) { const u32x4 t = {w, w, w, w}; return __builtin_bit_cast(bf16x8, t); }

constexpr int GM_RS = 288, GM_WL = 0, GM_VT = 128 * GM_RS, GM_ST = GM_VT + 256 * GM_RS;
__device__ __forceinline__ void gmlp_unit(const Ctx& F, int b, int n, int g, guchar* ws, const gfloat* ln_g, const gfloat* ln_b, const gfloat* wsp, const gfloat* bsp) {
    int tid = F.tid; LAUNDER_V(tid); const int lane = tid & 63, w = F.wave, r16 = lane & 15, q4 = lane >> 4;
    const int row0 = b * SEQ + n * 128, c0 = g * 256;
    const gbf16* AU = (const gbf16*)(ws + WS_AU); const gbf16* AV = (const gbf16*)(ws + WS_AV); gbf16* YA = (gbf16*)(ws + WS_YA);
    u32x4 raw[8];
#pragma unroll
    for (int k = 0; k < 8; ++k) { const int item = tid + 512 * k, s = item & 127, ch = item >> 7; raw[k] = *(const gu32x4*)(AV + tb256(row0 + s, c0 + 8 * ch, 8)); }
    f32x4 wt[8];
#pragma unroll
    for (int k = 0; k < 8; ++k) { const int item = tid + 512 * k, t = item >> 5, ch = item & 31; wt[k] = *(const gf32x4*)(wsp + ((size_t)(g * 128 + t)) * 128 + 4 * ch); }
    { const gf32x4* pp = (const gf32x4*)(ws + WS_LNP) + (size_t)(row0 + (tid & 127)) * 16 + (tid >> 7) * 4; float s = 0.f, q = 0.f;
#pragma unroll
        for (int j = 0; j < 4; ++j) { const f32x4 t = pp[j]; s += t[0] + t[2]; q += t[1] + t[3]; }
        *(LAS f32x2*)(F.lds + GM_ST + 1024 + ((tid >> 7) * 128 + (tid & 127)) * 8) = (f32x2){s, q}; }
#pragma unroll
    for (int k = 0; k < 8; ++k) { const int item = tid + 512 * k, t = item >> 5, ch = item & 31; f32x4 a = wt[k];
#pragma unroll
        for (int e = 0; e < 4; ++e) if (4 * ch + e > t) a[e] = 0.f;
        *(LAS u32x2*)(F.lds + GM_WL + t * GM_RS + ch * 8) = pack4(a); }
    __syncthreads();
    if (tid < 128) { float s = 0.f, q = 0.f;
#pragma unroll
        for (int j = 0; j < 4; ++j) { const f32x2 t = *(const LAS f32x2*)(F.lds + GM_ST + 1024 + (j * 128 + tid) * 8); s += t.x; q += t.y; }
        const float mu = s * (1.0f / BW); const float var = fmaxf(q * (1.0f / BW) - mu * mu, 0.f);
        *(LAS f32x2*)(F.lds + GM_ST + tid * 8) = (f32x2){mu, rsqrtf(var + NORM_EPS)}; }
    __syncthreads();
#pragma unroll
    for (int k = 0; k < 8; ++k) { const int item = tid + 512 * k, s = item & 127, ch = item >> 7;
        const f32x4 g0 = *(const gf32x4*)(ln_g + c0 + 8 * ch), g1 = *(const gf32x4*)(ln_g + c0 + 8 * ch + 4), b0 = *(const gf32x4*)(ln_b + c0 + 8 * ch), b1 = *(const gf32x4*)(ln_b + c0 + 8 * ch + 4);
        const f32x2 st = *(const LAS f32x2*)(F.lds + GM_ST + s * 8);
        const float xv[8] = {bf_lo(raw[k].x), bf_hi(raw[k].x), bf_lo(raw[k].y), bf_hi(raw[k].y), bf_lo(raw[k].z), bf_hi(raw[k].z), bf_lo(raw[k].w), bf_hi(raw[k].w)};
        const float gg[8] = {g0[0], g0[1], g0[2], g0[3], g1[0], g1[1], g1[2], g1[3]}, bb[8] = {b0[0], b0[1], b0[2], b0[3], b1[0], b1[1], b1[2], b1[3]};
#pragma unroll
        for (int i = 0; i < 8; ++i) { const float y = (xv[i] - st.x) * st.y * gg[i] + bb[i];
            *(LAS bf16_t*)(F.lds + GM_VT + (8 * ch + i) * GM_RS + 2 * s) = (bf16_t)(cvt_pk_bf16(y, 0.f) & 0xffffu); } }
    u32x4 ub[8]; float bsv[8];
#pragma unroll
    for (int n8 = 0; n8 < 8; ++n8) { const int t = 16 * n8 + r16; ub[n8] = *(const gu32x4*)(AU + tb128(row0 + t, c0 + 32 * w + 8 * q4, 16)); bsv[n8] = bsp[g * 128 + t]; }
    __syncthreads();
    f32x4 acc[2][8];
#pragma unroll
    for (int m = 0; m < 2; ++m)
#pragma unroll
        for (int n8 = 0; n8 < 8; ++n8) acc[m][n8] = (f32x4){0.f, 0.f, 0.f, 0.f};
    bf16x8 af[2][4];
#pragma unroll
    for (int m = 0; m < 2; ++m)
#pragma unroll
        for (int ks = 0; ks < 4; ++ks) af[m][ks] = *(const LAS bf16x8*)(F.lds + GM_VT + (32 * w + 8 * (r16 >> 2) + 4 * m + (r16 & 3)) * GM_RS + ks * 64 + q4 * 16);
#pragma unroll
    for (int n8 = 0; n8 < 8; ++n8)
#pragma unroll
        for (int ks = 0; ks < 4; ++ks) if (ks <= n8 / 2) {
            const bf16x8 bfr = *(const LAS bf16x8*)(F.lds + GM_WL + (16 * n8 + r16) * GM_RS + ks * 64 + q4 * 16);
#pragma unroll
            for (int m = 0; m < 2; ++m) acc[m][n8] = MFMA16(af[m][ks], bfr, acc[m][n8]); }
#pragma unroll
    for (int n8 = 0; n8 < 8; ++n8) { const int t = 16 * n8 + r16; const size_t roy = ablk(row0 + t, c0 + 32 * w + 8 * q4, BW);
        const f32x4 a0 = acc[0][n8] + bsv[n8], a1 = acc[1][n8] + bsv[n8]; u32x4 y;
        y.x = cvt_pk_bf16(a0[0] * bf_lo(ub[n8].x), a0[1] * bf_hi(ub[n8].x)); y.y = cvt_pk_bf16(a0[2] * bf_lo(ub[n8].y), a0[3] * bf_hi(ub[n8].y));
        y.z = cvt_pk_bf16(a1[0] * bf_lo(ub[n8].z), a1[1] * bf_hi(ub[n8].z)); y.w = cvt_pk_bf16(a1[2] * bf_lo(ub[n8].w), a1[3] * bf_hi(ub[n8].w));
        *(gu32x4*)(YA + roy) = y; }
    __syncthreads();
}

constexpr int SW_RS = 160, SW_VS = 528, SW_KL = 0, SW_VT = 256 * SW_RS, SW_QL = SW_VT + 64 * SW_VS, SW_QL2 = SW_QL + 128 * SW_RS, SW_CS = SW_QL2 + 128 * SW_RS;
static_assert(SW_CS + 384 * 64 <= ARGS_OFF, "SWA LDS map");
__device__ __forceinline__ void rope8(const u32x4 a, const u32x4 bq, const gfloat* cs, float scale, u32x4& o1, u32x4& o2) {
    const f32x4 c0 = *(const gf32x4*)cs, c1 = *(const gf32x4*)(cs + 4), s0 = *(const gf32x4*)(cs + 8), s1 = *(const gf32x4*)(cs + 12);
    const float t1[8] = {bf_lo(a.x), bf_hi(a.x), bf_lo(a.y), bf_hi(a.y), bf_lo(a.z), bf_hi(a.z), bf_lo(a.w), bf_hi(a.w)};
    const float t2[8] = {bf_lo(bq.x), bf_hi(bq.x), bf_lo(bq.y), bf_hi(bq.y), bf_lo(bq.z), bf_hi(bq.z), bf_lo(bq.w), bf_hi(bq.w)};
    const float cc[8] = {c0[0], c0[1], c0[2], c0[3], c1[0], c1[1], c1[2], c1[3]}, ss[8] = {s0[0], s0[1], s0[2], s0[3], s1[0], s1[1], s1[2], s1[3]};
    float r1[8], r2[8];
#pragma unroll
    for (int i = 0; i < 8; ++i) { r1[i] = (t1[i] * cc[i] - t2[i] * ss[i]) * scale; r2[i] = (t2[i] * cc[i] + t1[i] * ss[i]) * scale; }
    o1 = (u32x4){cvt_pk_bf16(r1[0], r1[1]), cvt_pk_bf16(r1[2], r1[3]), cvt_pk_bf16(r1[4], r1[5]), cvt_pk_bf16(r1[6], r1[7])};
    o2 = (u32x4){cvt_pk_bf16(r2[0], r2[1]), cvt_pk_bf16(r2[2], r2[3]), cvt_pk_bf16(r2[4], r2[5]), cvt_pk_bf16(r2[6], r2[7])};
}
__device__ __forceinline__ u32x4 scale8(const u32x4 a, float sc) {
    return (u32x4){cvt_pk_bf16(bf_lo(a.x) * sc, bf_hi(a.x) * sc), cvt_pk_bf16(bf_lo(a.y) * sc, bf_hi(a.y) * sc), cvt_pk_bf16(bf_lo(a.z) * sc, bf_hi(a.z) * sc), cvt_pk_bf16(bf_lo(a.w) * sc, bf_hi(a.w) * sc)};
}
__device__ __forceinline__ void swa_unit(const Ctx& F, int b, int n, int hk, guchar* ws, const gfloat* sinks) {
    int tid = F.tid; LAUNDER_V(tid); const int lane = tid & 63, w = F.wave, r16 = lane & 15, q4 = lane >> 4;
    const int r0 = b * SEQ + n * 128, kr0 = r0 - 128;
    const gbf16* BQ = (const gbf16*)(ws + WS_BQ); const gbf16* BK = (const gbf16*)(ws + WS_BK); const gbf16* BV = (const gbf16*)(ws + WS_BV); const gbf16* BZ = (const gbf16*)(ws + WS_BZ);
    gbf16* YB = (gbf16*)(ws + WS_YA) + (size_t)M_ROWS * BW; const gfloat* CS = (const gfloat*)(ws + WS_CS);
    const int kch = tid & 7;
    u32x4 kraw[4], vraw[4]; f32x4 csr[3]; u32x4 qa[2];
#pragma unroll
    for (int k = 0; k < 4; ++k) { const int key = (tid + 512 * k) >> 3; const bool pad = (n == 0 && key < 128);
        kraw[k] = *(const gu32x4*)(BK + (size_t)(pad ? r0 : kr0 + key) * 256 + hk * 64 + 8 * kch); }
#pragma unroll
    for (int k = 0; k < 4; ++k) { const int item = tid + 512 * k, key = item & 255, ch = item >> 8; const bool pad = (n == 0 && key < 128);
        vraw[k] = *(const gu32x4*)(BV + (size_t)(pad ? r0 : kr0 + key) * 256 + hk * 64 + 8 * ch); }
#pragma unroll
    for (int k = 0; k < 3; ++k) { const int item = tid + 512 * k, r = item >> 2, part = item & 3; const int row = r < 256 ? ((n == 0 && r < 128) ? r0 : kr0 + r) : r0 + r - 256;
        csr[k] = *(const gf32x4*)(CS + (size_t)row * 16 + part * 4); }
#define SW_QLOAD(hq_) do { _Pragma("unroll") for (int k_ = 0; k_ < 2; ++k_) { const int qr_ = (tid + 512 * k_) >> 3; qa[k_] = *(const gu32x4*)(BQ + tb256(r0 + qr_, (hq_) * 64, 8) + 8 * kch); } } while (0)
    SW_QLOAD(hk * 8);
#pragma unroll
    for (int k = 0; k < 3; ++k) { const int item = tid + 512 * k; *(LAS f32x4*)(F.lds + SW_CS + item * 16) = csr[k]; }
#pragma unroll
    for (int k = 0; k < 4; ++k) { const int item = tid + 512 * k, key = item & 255, ch = item >> 8; const bool pad = (n == 0 && key < 128);
        const u32x4 raw = pad ? (u32x4){0u, 0u, 0u, 0u} : vraw[k]; const unsigned e[4] = {raw.x, raw.y, raw.z, raw.w};
#pragma unroll
        for (int i = 0; i < 8; ++i) *(LAS bf16_t*)(F.lds + SW_VT + (8 * ch + i) * SW_VS + 2 * key) = (bf16_t)((e[i >> 1] >> ((i & 1) * 16)) & 0xffffu); }
    __syncthreads();
#define SW_PUT(raw_, csrow_, dst_, scale_) do { const u32x4 own_ = (raw_); u32x4 par_; \
        par_.x = (unsigned)__builtin_amdgcn_update_dpp(0, (int)own_.x, 0xB1, 0xf, 0xf, false); par_.y = (unsigned)__builtin_amdgcn_update_dpp(0, (int)own_.y, 0xB1, 0xf, 0xf, false); \
        par_.z = (unsigned)__builtin_amdgcn_update_dpp(0, (int)own_.z, 0xB1, 0xf, 0xf, false); par_.w = (unsigned)__builtin_amdgcn_update_dpp(0, (int)own_.w, 0xB1, 0xf, 0xf, false); \
        u32x4 o_; \
        if (kch < 2) { const LAS float* cs_ = (const LAS float*)(F.lds + SW_CS + (csrow_) * 64); \
            const f32x4 c0_ = *(const LAS f32x4*)cs_, c1_ = *(const LAS f32x4*)(cs_ + 4), s0_ = *(const LAS f32x4*)(cs_ + 8), s1_ = *(const LAS f32x4*)(cs_ + 12); \
            const float sg_ = kch == 0 ? -(scale_) : (scale_); \
            const float t_[8] = {bf_lo(own_.x), bf_hi(own_.x), bf_lo(own_.y), bf_hi(own_.y), bf_lo(own_.z), bf_hi(own_.z), bf_lo(own_.w), bf_hi(own_.w)}; \
            const float u_[8] = {bf_lo(par_.x), bf_hi(par_.x), bf_lo(par_.y), bf_hi(par_.y), bf_lo(par_.z), bf_hi(par_.z), bf_lo(par_.w), bf_hi(par_.w)}; \
            const float cc_[8] = {c0_[0], c0_[1], c0_[2], c0_[3], c1_[0], c1_[1], c1_[2], c1_[3]}, ss_[8] = {s0_[0], s0_[1], s0_[2], s0_[3], s1_[0], s1_[1], s1_[2], s1_[3]}; \
            float r_[8]; _Pragma("unroll") for (int i_ = 0; i_ < 8; ++i_) r_[i_] = (t_[i_] * cc_[i_]) * (scale_) + (u_[i_] * ss_[i_]) * sg_; \
            o_ = (u32x4){cvt_pk_bf16(r_[0], r_[1]), cvt_pk_bf16(r_[2], r_[3]), cvt_pk_bf16(r_[4], r_[5]), cvt_pk_bf16(r_[6], r_[7])}; } \
        else o_ = ((scale_) == 1.0f) ? own_ : scale8(own_, (scale_)); \
        *(LAS u32x4*)((dst_) + kch * 16) = o_; } while (0)
#pragma unroll
    for (int k = 0; k < 4; ++k) { const int key = (tid + 512 * k) >> 3; const bool pad = (n == 0 && key < 128);
        const u32x4 kz = pad ? (u32x4){0u, 0u, 0u, 0u} : kraw[k]; SW_PUT(kz, key, F.lds + SW_KL + key * SW_RS, 1.0f); }
#define SW_QWRITE(buf_) do { _Pragma("unroll") for (int k_ = 0; k_ < 2; ++k_) { const int qr_ = (tid + 512 * k_) >> 3; SW_PUT(qa[k_], 256 + qr_, F.lds + (buf_) + qr_ * SW_RS, 0.125f); } } while (0)
    SW_QWRITE(SW_QL);
    __syncthreads();
    for (int hi = 0; hi < 8; ++hi) {
        const int hq = hk * 8 + hi; const int qcur = (hi & 1) ? SW_QL2 : SW_QL, qnxt = (hi & 1) ? SW_QL : SW_QL2;
        SW_QLOAD((hi < 7 ? hq + 1 : hq));
        const u32x4 zb0 = *(const gu32x4*)(BZ + tb256(r0 + 16 * w + r16, hq * 64 + 8 * q4, 8)), zb1 = *(const gu32x4*)(BZ + tb256(r0 + 16 * w + r16, hq * 64 + 8 * q4 + 32, 8));
        bf16x8 bq[2];
#pragma unroll
        for (int ks = 0; ks < 2; ++ks) bq[ks] = *(const LAS bf16x8*)(F.lds + qcur + (16 * w + r16) * SW_RS + ks * 64 + q4 * 16);
        f32x4 s[10];
#pragma unroll
        for (int j = 0; j < 9; ++j) { s[j] = (f32x4){0.f, 0.f, 0.f, 0.f};
#pragma unroll
            for (int ks = 0; ks < 2; ++ks) { const bf16x8 a = *(const LAS bf16x8*)(F.lds + SW_KL + (16 * (w + j) + r16) * SW_RS + ks * 64 + q4 * 16); s[j] = MFMA16(a, bq[ks], s[j]); } }
        s[9] = (f32x4){0.f, 0.f, 0.f, 0.f};
        const int qi = 16 * w + r16; const float sink = sinks[hq]; float mx = sink;
#pragma unroll
        for (int j = 0; j < 9; ++j)
#pragma unroll
            for (int e = 0; e < 4; ++e) { const int kj = 16 * (w + j) + 4 * q4 + e; const bool valid = (kj > qi) && (kj <= qi + 128) && (n > 0 || kj >= 128);
                s[j][e] = valid ? s[j][e] : -1e30f; mx = fmaxf(mx, s[j][e]); }
        mx = fmaxf(mx, __shfl_xor(mx, 16)); mx = fmaxf(mx, __shfl_xor(mx, 32));
        float sum = 0.f;
#pragma unroll
        for (int j = 0; j < 9; ++j)
#pragma unroll
            for (int e = 0; e < 4; ++e) { const float pv = (s[j][e] > -1e29f) ? __expf(s[j][e] - mx) : 0.f; s[j][e] = pv; sum += pv; }
        sum += __shfl_xor(sum, 16); sum += __shfl_xor(sum, 32); sum += __expf(sink - mx);
        const float inv = 1.0f / sum;
        f32x4 o[4];
#pragma unroll
        for (int dt = 0; dt < 4; ++dt) o[dt] = (f32x4){0.f, 0.f, 0.f, 0.f};
#pragma unroll
        for (int kk = 0; kk < 5; ++kk) { const bf16x8 pf = mk_frag(pack4(s[2 * kk]), pack4(s[2 * kk + 1]));
            const int t0 = w + 2 * kk, t1 = (w + 2 * kk + 1) > 15 ? 15 : (w + 2 * kk + 1);
#pragma unroll
            for (int dt = 0; dt < 4; ++dt) { const LAS unsigned char* vrow = F.lds + SW_VT + (32 * (dt >> 1) + 8 * (r16 >> 2) + 4 * (dt & 1) + (r16 & 3)) * SW_VS + (4 * q4) * 2;
                const bf16x8 a = mk_frag(*(const LAS u32x2*)(vrow + 32 * t0), *(const LAS u32x2*)(vrow + 32 * t1)); o[dt] = MFMA16(a, pf, o[dt]); } }
        const size_t ro = (size_t)(r0 + qi) * BW + hq * 64 + 8 * q4;
#pragma unroll
        for (int pp = 0; pp < 2; ++pp) { const u32x4 zb = pp ? zb1 : zb0; const f32x4 oa = o[2 * pp] * inv, ob2 = o[2 * pp + 1] * inv; u32x4 y;
            y.x = cvt_pk_bf16(oa[0] * bf_lo(zb.x), oa[1] * bf_hi(zb.x)); y.y = cvt_pk_bf16(oa[2] * bf_lo(zb.y), oa[3] * bf_hi(zb.y));
            y.z = cvt_pk_bf16(ob2[0] * bf_lo(zb.z), ob2[1] * bf_hi(zb.z)); y.w = cvt_pk_bf16(ob2[2] * bf_lo(zb.w), ob2[3] * bf_hi(zb.w));
            *(gu32x4*)(YB + ablk(r0 + qi, hq * 64 + 8 * q4 + 32 * pp, BW)) = y; }
        SW_QWRITE(qnxt);
        __syncthreads();
    }
#undef SW_QLOAD
#undef SW_QWRITE
#undef SW_PUT
}

#ifndef ML_R1A
#define ML_R1A 1
#endif
#ifndef ML_R1B
#define ML_R1B 1
#endif
#ifndef ML_RWR
#define ML_RWR 1
#endif
constexpr int ML_RS = 544, ML_TS = 144, ML_WS = 160, ML_GSZ = 1344;
constexpr int ML_QL = 0, ML_KA = 64 * ML_RS, ML_KB = 2 * 64 * ML_RS, ML_VT = 3 * 64 * ML_RS, ML_VW = ML_VT + 32 * ML_TS, ML_VW2 = ML_VW + 33 * ML_WS, ML_CT = ML_VW2 + 33 * ML_WS, ML_X = ML_CT + 33 * ML_RS, ML_GATE = ML_X + 64 * 144;
static_assert(ML_GATE + 2 * ML_GSZ <= ARGS_OFF, "mLSTM LDS map");
typedef short s16x4 __attribute__((ext_vector_type(4)));
__device__ __forceinline__ bf16x8 tr_frag8(const LAS unsigned char* img, int rs, int row0, int col0, int r16) {
    const LAS unsigned char* p0 = img + (row0 + (r16 >> 2)) * rs + (col0 + 4 * (r16 & 3)) * 2;
    const s16x4 a = __builtin_amdgcn_ds_read_tr16_b64_v4i16((LAS s16x4*)p0);
    const s16x4 b = __builtin_amdgcn_ds_read_tr16_b64_v4i16((LAS s16x4*)(p0 + 4 * rs));
    return __builtin_shufflevector(a, b, 0, 1, 2, 3, 4, 5, 6, 7);
}
__device__ __forceinline__ float dpp_shr(float v, float ident, int n) {
    const int r = n == 1 ? __builtin_amdgcn_update_dpp(__float_as_int(ident), __float_as_int(v), 0x111, 0xf, 0xf, false)
                : n == 2 ? __builtin_amdgcn_update_dpp(__float_as_int(ident), __float_as_int(v), 0x112, 0xf, 0xf, false)
                : n == 4 ? __builtin_amdgcn_update_dpp(__float_as_int(ident), __float_as_int(v), 0x114, 0xf, 0xf, false)
                         : __builtin_amdgcn_update_dpp(__float_as_int(ident), __float_as_int(v), 0x118, 0xf, 0xf, false);
    return __int_as_float(r);
}
__device__ __forceinline__ float wave_scan_add(float v, int lane) {
    v += dpp_shr(v, 0.f, 1); v += dpp_shr(v, 0.f, 2); v += dpp_shr(v, 0.f, 4); v += dpp_shr(v, 0.f, 8);
    const float t0 = __int_as_float(__builtin_amdgcn_readlane(__float_as_int(v), 15)), t1 = __int_as_float(__builtin_amdgcn_readlane(__float_as_int(v), 31)), t2 = __int_as_float(__builtin_amdgcn_readlane(__float_as_int(v), 47));
    const int row = lane >> 4; const float add = row == 0 ? 0.f : (row == 1 ? t0 : (row == 2 ? t0 + t1 : (t0 + t1) + t2));
    return v + add;
}
__device__ __forceinline__ float wave_scan_max(float v, int lane) {
    const float NI = -3.0e38f;
    v = fmaxf(v, dpp_shr(v, NI, 1)); v = fmaxf(v, dpp_shr(v, NI, 2)); v = fmaxf(v, dpp_shr(v, NI, 4)); v = fmaxf(v, dpp_shr(v, NI, 8));
    const float t0 = __int_as_float(__builtin_amdgcn_readlane(__float_as_int(v), 15)), t1 = __int_as_float(__builtin_amdgcn_readlane(__float_as_int(v), 31)), t2 = __int_as_float(__builtin_amdgcn_readlane(__float_as_int(v), 47));
    const int row = lane >> 4; const float mx = row == 0 ? NI : (row == 1 ? t0 : (row == 2 ? fmaxf(t0, t1) : fmaxf(fmaxf(t0, t1), t2)));
    return fmaxf(v, mx);
}
__device__ __forceinline__ float softcap15(float z) { const float e = __expf(z * (2.0f / 15.0f)); return 15.0f * (1.0f - 2.0f * __builtin_amdgcn_rcpf(e + 1.0f)); }
__device__ __forceinline__ void mlstm_unit(const Ctx& F, int b, int h, int sl, guchar* ws, const gfloat* ibp, const gfloat* fbp, const gfloat* norm_g) {
    int tid = F.tid; LAUNDER_V(tid); const int lane = tid & 63, w = F.wave, r16 = lane & 15, q4 = lane >> 4;
    const gbf16* CQ = (const gbf16*)(ws + WS_CQ); const gbf16* CK = (const gbf16*)(ws + WS_CK); const gbf16* CV = (const gbf16*)(ws + WS_CV);
    const gbf16* CO = (const gbf16*)(ws + WS_CO); const gbf16* CZs = (const gbf16*)(ws + WS_CZ);
    const gfloat* IFB = (const gfloat*)(ws + WS_IF);
    gbf16* NUM = (gbf16*)(ws + WS_NUM) + h * 512 + sl * 32; gfloat* SSQC = (gfloat*)(ws + WS_SSQC); gfloat* DNB = (gfloat*)(ws + WS_DN);
    const int rowb = b * SEQ;
    const bf16x8 ones = frag_const(0x3f803f80u), zeros = frag_const(0u);
    for (int i = tid; i < 33 * ML_RS / 16; i += NTHREADS) *(LAS u32x4*)(F.lds + ML_CT + i * 16) = (u32x4){0u, 0u, 0u, 0u};
    f32x4 st[2][3];
#pragma unroll
    for (int i = 0; i < 2; ++i)
#pragma unroll
        for (int dt = 0; dt < 3; ++dt) st[i][dt] = (f32x4){0.f, 0.f, 0.f, 0.f};
    float m_prev = 0.f;
    const float ibv = ibp[h], fbv = fbp[h];
    const f32x4 ng0 = *(const gf32x4*)(norm_g + h * 512 + sl * 32 + 4 * q4), ng1 = *(const gf32x4*)(norm_g + h * 512 + sl * 32 + 16 + 4 * q4);
    u32x4 qra[4], kra[4], vra; float gi = 0.f, gf = 0.f;
#define ML_LOAD(c, Q_, K_, V_) do { const int rc_ = rowb + (c) * 64; _Pragma("unroll") for (int k_ = 0; k_ < 4; ++k_) { const int it_ = tid + 512 * k_, s_ = it_ >> 5, ch_ = it_ & 31; \
        Q_[k_] = *(const gu32x4*)(CQ + tb256(rc_ + s_, h * 256 + 8 * ch_, 4)); K_[k_] = *(const gu32x4*)(CK + tb256(rc_ + s_, h * 256 + 8 * ch_, 4)); } \
        V_ = *(const gu32x4*)(CV + tb256(rc_ + ((tid & 255) >> 2), h * 512 + sl * 32 + 8 * (tid & 3), 8)); } while (0)
#define ML_GLOAD(c) do { const int r_ = rowb + (c) * 64 + lane; gi = IFB[(size_t)r_ * 8 + h]; gf = IFB[(size_t)r_ * 8 + 4 + h]; } while (0)
#define ML_GPREP(par) do { if (w == 7) { const float ig_ = softcap15(gi + ibv); const float z_ = softcap15(gf + fbv); \
        const float lf_ = -(fmaxf(-z_, 0.f) + log1pf(__expf(-fabsf(z_)))); const float bc_ = wave_scan_add(lf_, lane); const float u_ = ig_ - bc_; const float pm_ = wave_scan_max(u_, lane); \
        const float Mv_ = fmaxf(m_prev, pm_); const float M63_ = __int_as_float(__builtin_amdgcn_readlane(__float_as_int(Mv_), 63)); const float g_ = __int_as_float(__builtin_amdgcn_readlane(__float_as_int(bc_), 63)); \
        LAS float* gp_ = (LAS float*)(F.lds + ML_GATE + (par) * ML_GSZ); gp_[lane] = u_; gp_[64 + lane] = Mv_; gp_[128 + lane] = __expf(m_prev - Mv_); gp_[192 + lane] = __expf(-(bc_ + Mv_)); \
        gp_[256 + lane] = __expf(u_ - M63_); if (lane == 0) gp_[320] = __expf(m_prev - M63_); m_prev = g_ + M63_; } } while (0)
#define ML_WRITE(kb_, vw_, gpn_, Q_, K_, V_) do { _Pragma("unroll") for (int k_ = 0; k_ < 4; ++k_) { const int it_ = tid + 512 * k_, s_ = it_ >> 5, ch_ = it_ & 31; \
        *(LAS u32x4*)(F.lds + ML_QL + s_ * ML_RS + ch_ * 16) = Q_[k_]; *(LAS u32x4*)(F.lds + (kb_) + s_ * ML_RS + ch_ * 16) = K_[k_]; } \
        if (tid < 256) { const int s_ = tid >> 2, ch_ = tid & 3; const unsigned e_[4] = {V_.x, V_.y, V_.z, V_.w}; const float ws_ = (gpn_)[256 + s_]; \
            _Pragma("unroll") for (int i_ = 0; i_ < 8; ++i_) { const unsigned hv_ = (e_[i_ >> 1] >> ((i_ & 1) * 16)) & 0xffffu; \
                *(LAS bf16_t*)(F.lds + ML_VT + (8 * ch_ + i_) * ML_TS + 2 * s_) = (bf16_t)hv_; \
                *(LAS bf16_t*)(F.lds + (vw_) + (8 * ch_ + i_) * ML_WS + 2 * s_) = (bf16_t)(cvt_pk_bf16(__uint_as_float(hv_ << 16) * ws_, 0.f) & 0xffffu); } \
            if (ch_ == 0) *(LAS bf16_t*)(F.lds + (vw_) + 32 * ML_WS + 2 * s_) = (bf16_t)(cvt_pk_bf16(ws_, 0.f) & 0xffffu); } } while (0)
    ML_LOAD(0, qra, kra, vra); ML_GLOAD(0);
    ML_GPREP(0);
    ML_GLOAD(1);
    __syncthreads();
    ML_WRITE(ML_KA, ML_VW, ((const LAS float*)(F.lds + ML_GATE)), qra, kra, vra);
    __syncthreads();
#define ML_STEP(c, LQ_, LK_, LV_, WQ_, WK_, WV_) do { \
        const int par = c & 1; const LAS float* gp = (const LAS float*)(F.lds + ML_GATE + par * ML_GSZ); \
        const int vt = ML_VT, kb = par ? ML_KB : ML_KA, kbn = par ? ML_KA : ML_KB, vw = par ? ML_VW2 : ML_VW, vwn = par ? ML_VW : ML_VW2; \
        const LAS float* gpn = (const LAS float*)(F.lds + ML_GATE + (par ^ 1) * ML_GSZ); \
        const int rowc = rowb + c * 64; \
        const size_t rog_ = tb256(rowc + 16 * (w & 3) + r16, h * 512 + sl * 32 + 4 * q4, 8); \
        const u32x2 ob0 = *(const gu32x2*)(CO + rog_), ob1 = *(const gu32x2*)(CO + rog_ + 16), zb0 = *(const gu32x2*)(CZs + rog_), zb1 = *(const gu32x2*)(CZs + rog_ + 16); \
        ML_LOAD((c + 1 < 32 ? c + 1 : 31), LQ_, LK_, LV_); if (c + 1 < 32) ML_GPREP(par ^ 1); ML_GLOAD((c + 2 < 32 ? c + 2 : 31)); \
        f32x4 oacc[3]; \
        for (int rp_ = 0; rp_ < ML_R1B; ++rp_) { \
        _Pragma("unroll") \
        for (int dt = 0; dt < 3; ++dt) oacc[dt] = (f32x4){0.f, 0.f, 0.f, 0.f}; \
        if (w < 4) { \
            const int T = w; \
            bf16x8 bq[8]; \
        _Pragma("unroll") \
            for (int ks = 0; ks < 8; ++ks) bq[ks] = *(const LAS bf16x8*)(F.lds + ML_QL + (16 * T + r16) * ML_RS + ks * 64 + q4 * 16); \
            f32x4 sa[4]; \
        _Pragma("unroll") \
            for (int s4 = 0; s4 < 4; ++s4) { sa[s4] = (f32x4){0.f, 0.f, 0.f, 0.f}; \
                if (s4 <= T) { \
        _Pragma("unroll") \
                    for (int ks = 0; ks < 8; ++ks) { const bf16x8 a = *(const LAS bf16x8*)(F.lds + kb + (16 * s4 + r16) * ML_RS + ks * 64 + q4 * 16); sa[s4] = MFMA16(a, bq[ks], sa[s4]); } } } \
            const int tl = 16 * T + r16; const float Mt = gp[64 + tl]; \
        _Pragma("unroll") \
            for (int s4 = 0; s4 < 4; ++s4) { const f32x4 uu = *(const LAS f32x4*)(gp + 16 * s4 + 4 * q4); \
        _Pragma("unroll") \
                for (int e = 0; e < 4; ++e) { const int sl_ = 16 * s4 + 4 * q4 + e; sa[s4][e] = (sl_ <= tl) ? sa[s4][e] * __expf(uu[e] - Mt) : 0.f; } } \
        _Pragma("unroll") \
            for (int kk = 0; kk < 2; ++kk) { const bf16x8 pf = mk_frag(pack4(sa[2 * kk]), pack4(sa[2 * kk + 1])); \
        _Pragma("unroll") \
                for (int dt = 0; dt < 3; ++dt) { bf16x8 a; \
                    if (dt < 2) { const LAS unsigned char* vp = F.lds + vt + (16 * dt + r16) * ML_TS + (32 * kk + 4 * q4) * 2; a = mk_frag(*(const LAS u32x2*)vp, *(const LAS u32x2*)(vp + 32)); } \
                    else a = (r16 == 0) ? ones : zeros; \
                    oacc[dt] = MFMA16(a, pf, oacc[dt]); } } \
        } else { \
            const int T = w - 4; f32x4 ia[3]; \
        _Pragma("unroll") \
            for (int dt = 0; dt < 3; ++dt) ia[dt] = (f32x4){0.f, 0.f, 0.f, 0.f}; \
        _Pragma("unroll") \
            for (int ks = 0; ks < 8; ++ks) { const bf16x8 bqv = *(const LAS bf16x8*)(F.lds + ML_QL + (16 * T + r16) * ML_RS + ks * 64 + q4 * 16); \
        _Pragma("unroll") \
                for (int dt = 0; dt < 3; ++dt) { bf16x8 a; \
                    if (dt < 2) a = *(const LAS bf16x8*)(F.lds + ML_CT + (16 * dt + r16) * ML_RS + ks * 64 + q4 * 16); \
                    else { a = *(const LAS bf16x8*)(F.lds + ML_CT + 32 * ML_RS + ks * 64 + q4 * 16); if (r16 != 0) a = zeros; } \
                    ia[dt] = MFMA16(a, bqv, ia[dt]); } } \
            const int tl = 16 * T + r16; \
            *(LAS f32x4*)(F.lds + ML_X + tl * 144 + (4 * q4) * 4) = ia[0]; *(LAS f32x4*)(F.lds + ML_X + tl * 144 + (16 + 4 * q4) * 4) = ia[1]; \
            if (q4 == 0) *(LAS f32x4*)(F.lds + ML_X + tl * 144 + 32 * 4) = ia[2]; \
        } \
        } \
        __syncthreads(); \
        if (w < 4) { \
            const int tl = 16 * w + r16; const float at = gp[128 + tl], en = gp[192 + tl]; \
            const f32x4 x0 = *(const LAS f32x4*)(F.lds + ML_X + tl * 144 + (4 * q4) * 4), x1 = *(const LAS f32x4*)(F.lds + ML_X + tl * 144 + (16 + 4 * q4) * 4); \
            const float xd = *(const LAS float*)(F.lds + ML_X + tl * 144 + 32 * 4); \
            const f32x4 n0 = oacc[0] + x0 * at, n1 = oacc[1] + x1 * at; \
            float den = oacc[2][0] + xd * at; den = __shfl(den, r16); \
            float sq = (n0[0] * n0[0] + n0[1] * n0[1]) + (n0[2] * n0[2] + n0[3] * n0[3]) + (n1[0] * n1[0] + n1[1] * n1[1]) + (n1[2] * n1[2] + n1[3] * n1[3]); \
            sq += __shfl_xor(sq, 16); sq += __shfl_xor(sq, 32); \
            const size_t ro = (size_t)(rowc + tl) * BW + 4 * q4; \
            f32x4 t0, t1; \
            t0[0] = n0[0] * ng0[0] * (bf_lo(ob0.x) * bf_lo(zb0.x)); t0[1] = n0[1] * ng0[1] * (bf_hi(ob0.x) * bf_hi(zb0.x)); t0[2] = n0[2] * ng0[2] * (bf_lo(ob0.y) * bf_lo(zb0.y)); t0[3] = n0[3] * ng0[3] * (bf_hi(ob0.y) * bf_hi(zb0.y)); \
            t1[0] = n1[0] * ng1[0] * (bf_lo(ob1.x) * bf_lo(zb1.x)); t1[1] = n1[1] * ng1[1] * (bf_hi(ob1.x) * bf_hi(zb1.x)); t1[2] = n1[2] * ng1[2] * (bf_lo(ob1.y) * bf_lo(zb1.y)); t1[3] = n1[3] * ng1[3] * (bf_hi(ob1.y) * bf_hi(zb1.y)); \
            *(gu32x2*)(NUM + ro) = pack4(t0); *(gu32x2*)(NUM + ro + 16) = pack4(t1); \
            if (q4 == 0) { SSQC[(size_t)(rowc + tl) * 64 + h * 16 + sl] = sq; if (sl == 0) DNB[(size_t)(rowc + tl) * 4 + h] = fmaxf(fabsf(den), en); } \
        } \
        { const float dec = gp[320]; \
        _Pragma("unroll") \
          for (int i = 0; i < 2; ++i) \
        _Pragma("unroll") \
              for (int dt = 0; dt < 3; ++dt) st[i][dt] = st[i][dt] * dec; \
        _Pragma("unroll") \
          for (int kk = 0; kk < 2; ++kk) { bf16x8 a[2], bv[3]; \
        _Pragma("unroll") \
              for (int i = 0; i < 2; ++i) a[i] = tr_frag8(F.lds + kb, ML_RS, 32 * kk + 8 * q4, 32 * w + 16 * i, r16); \
        _Pragma("unroll") \
              for (int dt = 0; dt < 2; ++dt) bv[dt] = *(const LAS bf16x8*)(F.lds + vw + (16 * dt + r16) * ML_WS + kk * 64 + q4 * 16); \
              bv[2] = *(const LAS bf16x8*)(F.lds + vw + 32 * ML_WS + kk * 64 + q4 * 16); if (r16 != 0) bv[2] = zeros; \
        _Pragma("unroll") \
              for (int i = 0; i < 2; ++i) \
        _Pragma("unroll") \
                  for (int dt = 0; dt < 3; ++dt) st[i][dt] = MFMA16(a[i], bv[dt], st[i][dt]); } \
        _Pragma("unroll") \
          for (int i = 0; i < 2; ++i) { \
        _Pragma("unroll") \
              for (int dt = 0; dt < 2; ++dt) *(LAS u32x2*)(F.lds + ML_CT + (16 * dt + r16) * ML_RS + (32 * w + 16 * i + 4 * q4) * 2) = pack4(st[i][dt]); \
              if (r16 == 0) *(LAS u32x2*)(F.lds + ML_CT + 32 * ML_RS + (32 * w + 16 * i + 4 * q4) * 2) = pack4(st[i][2]); } } \
        for (int rp_ = 0; rp_ < ML_RWR; ++rp_) if (c + 1 < 32) ML_WRITE(kbn, vwn, gpn, WQ_, WK_, WV_); \
        __syncthreads(); \
    } while (0)
    for (int c2 = 0; c2 < 32; ++c2) { ML_STEP(c2, qra, kra, vra, qra, kra, vra); }
#undef ML_LOAD
#undef ML_GLOAD
#undef ML_GPREP
#undef ML_WRITE
#undef ML_STEP
}

__device__ __forceinline__ void p2b_finalize(const Ctx& F, guchar* ws) {
    int lane = F.lane; LAUNDER_V(lane); const int gw = F.vcu * NWAVES + F.wave, NGW = F.G * NWAVES;
    const gbf16* NUM = (const gbf16*)(ws + WS_NUM); gbf16* YC = (gbf16*)(ws + WS_YA) + (size_t)2 * M_ROWS * BW;
    for (int m = gw; m < M_ROWS; m += NGW) {
        float s = ((const gfloat*)(ws + WS_SSQC))[(size_t)m * 64 + lane];
        s += __shfl_xor(s, 1); s += __shfl_xor(s, 2); s += __shfl_xor(s, 4); s += __shfl_xor(s, 8);
        const float dn = ((const gfloat*)(ws + WS_DN))[(size_t)m * 4 + (lane >> 4)];
        const float inv = 1.0f / dn; const float sc = inv * rsqrtf(s * (1.0f / 512.0f) * inv * inv + NORM_EPS);
#pragma unroll
        for (int it = 0; it < 4; ++it) { const float f = __shfl(sc, 16 * it); const size_t o = (size_t)m * BW + (size_t)(it * 64 + lane) * 8;
            const u32x4 nb = *(const gu32x4*)(NUM + o); u32x4 y;
            y.x = cvt_pk_bf16(bf_lo(nb.x) * f, bf_hi(nb.x) * f); y.y = cvt_pk_bf16(bf_lo(nb.y) * f, bf_hi(nb.y) * f);
            y.z = cvt_pk_bf16(bf_lo(nb.z) * f, bf_hi(nb.z) * f); y.w = cvt_pk_bf16(bf_lo(nb.w) * f, bf_hi(nb.w) * f);
            *(gu32x4*)(YC + ablk(m, (it * 64 + lane) * 8, BW)) = y; }
    }
}
__device__ __forceinline__ void p5b_ssq(const Ctx& F, guchar* ws) {
    int lane = F.lane; LAUNDER_V(lane); const int gw = F.vcu * NWAVES + F.wave, NGW = F.G * NWAVES;
    for (int m = gw; m < M_ROWS; m += NGW) { const float s = wave_sum(((const gfloat*)(ws + WS_XSP))[(size_t)m * 64 + lane]); if (lane == 0) ((gfloat*)(ws + WS_CTL + CTL_SSQ1))[m] = s; }
}
__device__ __forceinline__ void p4b_x1(const Ctx& F, guchar* ws, const gfloat* npost) {
    int lane = F.lane; LAUNDER_V(lane); const int gw = F.vcu * NWAVES + F.wave, NGW = F.G * NWAVES;
    const gbf16* OUT = (const gbf16*)(ws + WS_OUT); const gbf16* XB = (const gbf16*)(ws + WS_XB); gbf16* X1B = (gbf16*)(ws + WS_X1B);
    for (int m = gw; m < M_ROWS; m += NGW) {
        const float so = wave_sum(((const gfloat*)(ws + WS_OUTP))[(size_t)m * 64 + lane]), se = wave_sum(((const gfloat*)(ws + WS_ERP))[(size_t)m * 64 + lane]);
        const float rso = rsqrtf(so * (1.0f / DM) + NORM_EPS), rse = rsqrtf(se * (1.0f / DM) + NORM_EPS);
        if (lane == 0) { ((gfloat*)(ws + WS_RSO))[m] = rso; ((gfloat*)(ws + WS_RSE))[m] = rse; }
        u32x4 yv[8]; float mx = 0.f;
#pragma unroll
        for (int it = 0; it < 8; ++it) { const int c = (it * 64 + lane) * 8; const size_t o = (size_t)m * DM + c;
            const u32x4 xb = *(const gu32x4*)(XB + ablk(m, c, DM)), ob = *(const gu32x4*)(OUT + o); const f32x4 n0 = *(const gf32x4*)(npost + c), n1 = *(const gf32x4*)(npost + c + 4); u32x4 y;
            y.x = cvt_pk_bf16(bf_lo(xb.x) + bf_lo(ob.x) * rso * n0[0], bf_hi(xb.x) + bf_hi(ob.x) * rso * n0[1]);
            y.y = cvt_pk_bf16(bf_lo(xb.y) + bf_lo(ob.y) * rso * n0[2], bf_hi(xb.y) + bf_hi(ob.y) * rso * n0[3]);
            y.z = cvt_pk_bf16(bf_lo(xb.z) + bf_lo(ob.z) * rso * n1[0], bf_hi(xb.z) + bf_hi(ob.z) * rso * n1[1]);
            y.w = cvt_pk_bf16(bf_lo(xb.w) + bf_lo(ob.w) * rso * n1[2], bf_hi(xb.w) + bf_hi(ob.w) * rso * n1[3]);
            *(gu32x4*)(X1B + ablk(m, c, DM)) = y; yv[it] = y;
            mx = fmaxf(mx, fmaxf(fmaxf(fmaxf(fabsf(bf_lo(y.x)), fabsf(bf_hi(y.x))), fmaxf(fabsf(bf_lo(y.y)), fabsf(bf_hi(y.y)))), fmaxf(fmaxf(fabsf(bf_lo(y.z)), fabsf(bf_hi(y.z))), fmaxf(fabsf(bf_lo(y.w)), fabsf(bf_hi(y.w))))));
#if P5_FP8
            { u32x2 y8; y8.x = pack_fp8x4(bf_lo(y.x), bf_hi(y.x), bf_lo(y.y), bf_hi(y.y)); y8.y = pack_fp8x4(bf_lo(y.z), bf_hi(y.z), bf_lo(y.w), bf_hi(y.w)); *(gu32x2*)(ws + WS_X1B8 + ablk8(m, c, DM)) = y8; }
#endif
            }
#if P5_I8
#pragma unroll
        for (int s = 32; s >= 1; s >>= 1) mx = fmaxf(mx, __shfl_xor(mx, s));
        mx = fmaxf(mx, 1e-30f); const float qs = 127.0f / mx;
        if (lane == 0) ((gfloat*)(ws + WS_RSX))[m] = mx * (1.0f / 127.0f);
#pragma unroll
        for (int it = 0; it < 8; ++it) { const int c = (it * 64 + lane) * 8; const u32x4 y = yv[it]; u32x2 y8;
            y8.x = pack_i8x4(bf_lo(y.x) * qs, bf_hi(y.x) * qs, bf_lo(y.y) * qs, bf_hi(y.y) * qs); y8.y = pack_i8x4(bf_lo(y.z) * qs, bf_hi(y.z) * qs, bf_lo(y.w) * qs, bf_hi(y.w) * qs);
            *(gu32x2*)(ws + WS_X1B8 + ablk8(m, c, DM)) = y8; }
#endif
    }
}

#ifndef P1_ROT
#define P1_ROT 0
#endif
#ifndef P1_WGM
#define P1_WGM 4
#endif
#ifndef REP_P0
#define REP_P0 1
#endif
#ifndef REP_P1
#define REP_P1 1
#endif
#ifndef REP_ML
#define REP_ML 1
#endif
#ifndef REP_SW
#define REP_SW 1
#endif
#ifndef REP_GM
#define REP_GM 1
#endif
#ifndef REP_P3
#define REP_P3 1
#endif
#ifndef REP_THIN
#define REP_THIN 1
#endif
#ifndef REP_BAR
#define REP_BAR 1
#endif
#ifndef REP_P4
#define REP_P4 1
#endif
__device__ __forceinline__ unsigned long long arg_ld(LAS unsigned char* lds, int i) {
    unsigned a = (unsigned)(ARGS_OFF + 8 * i); asm volatile("" : "+v"(a));
    const volatile LAS unsigned* q = (const volatile LAS unsigned*)(lds + a);
    const unsigned lo = q[0], hi = q[1];
    return ((unsigned long long)(unsigned)__builtin_amdgcn_readfirstlane((int)hi) << 32) | (unsigned)__builtin_amdgcn_readfirstlane((int)lo);
}
struct Args { const void* in[19]; float* out; unsigned char* ws; };
static_assert(sizeof(Args) == 21 * 8, "no padding in Args");

__global__ void __launch_bounds__(NTHREADS, 2) fwd_kernel(Args args) {
    extern __shared__ __attribute__((aligned(16))) unsigned char lds_raw[];
    Ctx F; F.lds = (LAS unsigned char*)lds_raw; F.tid = threadIdx.x; F.lane = F.tid & 63; F.wave = __builtin_amdgcn_readfirstlane(F.tid >> 6);
    F.G = gridDim.x; F.bx = blockIdx.x; { const int bx = blockIdx.x; F.vcu = (F.G % 8 == 0) ? (bx % 8) * (F.G / 8) + bx / 8 : bx; }
    guchar* ws0 = (guchar*)args.ws;
#define WSL() ({ guchar* w_ = ws0; LAUNDER_S(w_); w_; })
    volatile LAS unsigned* MISC = (volatile LAS unsigned*)(F.lds + MISC_OFF);
    if (F.tid < 32) MISC[F.tid] = 0u;
    __syncthreads();
    const XcdBarrier bar = xcd_barrier_post((unsigned*)(ws0 + WS_CTL) + CW_BAR, MISC);

    if (F.tid < 19) ((LAS unsigned long long*)(F.lds + ARGS_OFF))[F.tid] = (unsigned long long)args.in[F.tid];
    if (F.tid == 19) ((LAS unsigned long long*)(F.lds + ARGS_OFF))[19] = (unsigned long long)args.out;
    __syncthreads();
#define ARGP(T, i) ((T)arg_ld(F.lds, (i)))

#define FL() ({ Ctx f_ = F; LAUNDER_S(f_.lds); LAUNDER_S(f_.wave); LAUNDER_S(f_.vcu); LAUNDER_S(f_.G); LAUNDER_S(f_.bx); f_; })
#ifndef SKIP_P0
    for (int rep_ = 0; rep_ < REP_P0; ++rep_) { const Ctx Fp = FL(); guchar* ws = WSL(); p0_prologue(FL(), ARGP(const gfloat*, 0), ARGP(const gfloat*, 1), ARGP(const gint*, 2), ARGP(const gfloat*, 3), ARGP(const gfloat*, 4), ARGP(const gfloat*, 13), ARGP(const gfloat*, 14), ARGP(const gfloat*, 18), ARGP(const gfloat*, 16), ws); }
#endif
    for (int rb_ = 0; rb_ < REP_BAR; ++rb_) xcd_barrier(bar);

    auto layer_body = [&](const int l) __attribute__((always_inline)) {
#ifndef NT_BF
#define NT_BF (P1G_FP8 ? 67 : NT_IN)
#endif
#ifndef P1_LOCK
#define P1_LOCK 0
#endif
#ifndef SKIP_P1
        for (int rep_ = 0; rep_ < REP_P1; ++rep_) { const Ctx Fp = FL(); guchar* ws = WSL(); const gfloat* ssq = l == 0 ? (const gfloat*)(ws + WS_SSQ0) : (const gfloat*)(ws + WS_CTL + CTL_SSQ1);
          const int rowbase = (Fp.G == 256 && P1_WGM == 4 && P1_ROT == 0) ? (Fp.bx & 7) * 1024 : -1; LAS float* rtab = (LAS float*)(Fp.lds + 132096);
          if (rowbase >= 0) { int ti_ = threadIdx.x; LAUNDER_V(ti_); const float s0_ = ssq[rowbase + ti_], s1_ = ssq[rowbase + 512 + ti_]; rtab[ti_] = rsqrtf(s0_ * (1.0f / DM) + NORM_EPS); rtab[512 + ti_] = rsqrtf(s1_ * (1.0f / DM) + NORM_EPS); __syncthreads(); }
#if P1G_FP8
          { pg8::SchedPlain S; S.T.init(M_ROWS / 256, 56, Fp.G, Fp.bx, P1_WGM, P1_ROT, -1, 74); S.pn0 = 74; S.A = (const gchar*)(ws + WS_XB8); S.B = (const gchar*)(ws + WS_WG8 + (size_t)l * SZ_WG8);
            S.astep = (size_t)256 * DM; S.bstep = (size_t)256 * DM;
            pg8::EpiInT<true> E{ssq, ws, rtab, rowbase};
            pg8::gemm_phase<pg8::EpiInT<true>, pg8::SchedPlain>(Fp.lds, DM / 2, DM, DM, S, E); }
          { pg8::SchedPlain S; S.T.init(M_ROWS / 256, NT_BF, Fp.G, Fp.bx, P1_WGM, P1_ROT, 122, 0); S.A = (const gchar*)(ws + WS_XB); S.B = (const gchar*)(ws + WS_WIN + (size_t)l * SZ_WIN);
            S.astep = (size_t)256 * DM * 2; S.bstep = (size_t)256 * DM * 2;
            pg8::EpiIn E{ssq, ws, rtab, rowbase};
            pg8::gemm_phase<pg8::EpiIn, pg8::SchedPlain>(Fp.lds, DM, DM, DM, S, E, (unsigned*)(ws + WS_CTL) + 256 + 64 * l, P1_LOCK); }
#else
          { pg8::SchedPlain S; S.T.init(M_ROWS / 256, NT_IN, Fp.G, Fp.bx, P1_WGM, P1_ROT); S.A = (const gchar*)(ws + WS_XB); S.B = (const gchar*)(ws + WS_WIN + (size_t)l * SZ_WIN);
            S.astep = (size_t)256 * DM * 2; S.bstep = (size_t)256 * DM * 2;
            pg8::EpiIn E{ssq, ws, rtab, rowbase};
            pg8::gemm_phase<pg8::EpiIn, pg8::SchedPlain>(Fp.lds, DM, DM, DM, S, E, (unsigned*)(ws + WS_CTL) + 256 + 64 * l, P1_LOCK); }
#endif
        }
#ifdef PROBE_P1CHEAP
        { const Ctx Fp = FL(); guchar* ws = WSL(); pg8::SchedPlain S; S.T.init(M_ROWS / 256, NT_IN, Fp.G, Fp.bx); S.A = (const gchar*)(ws + WS_XB); S.B = (const gchar*)(ws + WS_WIN + (size_t)l * SZ_WIN);
          S.astep = (size_t)256 * DM * 2; S.bstep = (size_t)256 * DM * 2;
          pg8::EpiSq E{(gbf16*)(ws + WS_END), (gfloat*)(ws + WS_END + (size_t)M_ROWS * 31488 * 2)};
          pg8::gemm_phase<pg8::EpiSq, pg8::SchedPlain>(Fp.lds, DM, DM, DM, S, E); }
#endif
        { const Ctx Fq = FL(); const int nwg_ = (M_ROWS / 256) * NT_BF, rem_ = nwg_ % Fq.G;
          if (rem_ == 0 || Fq.bx >= rem_) { const int me = rem_ ? Fq.bx - rem_ : Fq.bx, nw = rem_ ? Fq.G - rem_ : Fq.G;
            { const Ctx Fp = FL(); guchar* ws = WSL(); pg8::SchedPlain S; S.T.init(M_ROWS / 256, DM / 256, nw, me); S.A = (const gchar*)(ws + WS_PB + (size_t)l * M_ROWS * 256 * 2); S.B = (const gchar*)(ws + WS_WPP + (size_t)l * SZ_WPP);
              S.astep = (size_t)256 * 256 * 2; S.bstep = (size_t)256 * 256 * 2;
              pg8::EpiSq E{(gbf16*)(ws + WS_ERAW), (gfloat*)(ws + WS_ERP)};
              pg8::gemm_phase<pg8::EpiSq, pg8::SchedPlain>(Fp.lds, 256, 256, 256, S, E); }
            if (l == 1 && P5_I8 && TR_WOUT1_TAIL) tr_run(FL(), TR_PG1 - 1024, TR_PG1, 0x7fffffff, 0x7fffffff, me, nw, ARGP(const gfloat*, 4), ARGP(const gfloat*, 3), ARGP(const gfloat*, 13), ARGP(const gfloat*, 14), ARGP(const gfloat*, 18), ARGP(const gfloat*, 16), WSL());
            if (l == 0) tr_run(FL(), P5_I8 ? TR_PG0 : TR_DEFER0, P5_I8 ? TR_PG1 + 1024 : TR_DEFER1, P5_I8 ? TR_PG0 + 1024 : 0x7fffffff, P5_I8 ? TR_PG1 : 0x7fffffff, me, nw, ARGP(const gfloat*, 4), ARGP(const gfloat*, 3), ARGP(const gfloat*, 13), ARGP(const gfloat*, 14), ARGP(const gfloat*, 18), ARGP(const gfloat*, 16), WSL()); } }
#endif
#ifdef PROBE_DELAY
        if (((F.bx & 7) < 4) == (PROBE_DELAY == 1)) { const unsigned long long t0_ = __builtin_amdgcn_s_memrealtime(); while (__builtin_amdgcn_s_memrealtime() - t0_ < 3000ull) __builtin_amdgcn_s_sleep(8); }
#endif
        for (int rb_ = 0; rb_ < REP_BAR; ++rb_) xcd_barrier(bar);
#ifndef SKIP_ML
        for (int rep_ = 0; rep_ < REP_ML; ++rep_) { const Ctx Fp = FL(); guchar* ws = WSL(); for (int u = Fp.vcu; u < 256; u += Fp.G) mlstm_unit(Fp, u >> 6, (u >> 4) & 3, u & 15, ws, ARGP(const gfloat*, 10) + l * 4, ARGP(const gfloat*, 11) + l * 4, ARGP(const gfloat*, 12) + l * BW); }
#endif
#ifndef SKIP_SW
        for (int rep_ = 0; rep_ < REP_SW; ++rep_) { const Ctx Fp = FL(); guchar* ws = WSL(); for (int u = Fp.vcu; u < 256; u += Fp.G) swa_unit(Fp, u >> 6, (u >> 2) & 15, u & 3, ws, ARGP(const gfloat*, 9) + l * 32); }
#endif
#ifndef SKIP_GM
        for (int rep_ = 0; rep_ < REP_GM; ++rep_) { const Ctx Fp = FL(); guchar* ws = WSL(); for (int u = Fp.vcu; u < 512; u += Fp.G) gmlp_unit(Fp, u >> 7, (u >> 3) & 15, u & 7, ws, ARGP(const gfloat*, 5) + l * BW, ARGP(const gfloat*, 6) + l * BW, ARGP(const gfloat*, 7) + (size_t)l * 8 * 128 * 128, ARGP(const gfloat*, 8) + l * 8 * 128); }
#endif
        for (int rb_ = 0; rb_ < REP_BAR; ++rb_) xcd_barrier(bar);
#ifndef SKIP_P2B
        for (int rep_ = 0; rep_ < REP_THIN; ++rep_) p2b_finalize(FL(), WSL());
#endif
        for (int rb_ = 0; rb_ < REP_BAR; ++rb_) xcd_barrier(bar);
#ifndef PROBE_NOSTORE
#define PROBE_NOSTORE 0
#endif
#ifdef PROBE_K1024
        for (int rep_ = 0; rep_ < 4; ++rep_) { const Ctx Fp = FL(); guchar* ws = WSL(); pg8::SchedPlain S; S.T.init(M_ROWS / 256, DM / 256, Fp.G, Fp.bx); S.A = (const gchar*)(ws + WS_YA); S.B = (const gchar*)(ws + WS_WOUT + (size_t)l * SZ_WSQ);
          S.astep = (size_t)256 * DM * 2; S.bstep = (size_t)256 * DM * 2;
          pg8::EpiSq E{PROBE_NOSTORE ? (gbf16*)nullptr : (gbf16*)(ws + WS_END), (gfloat*)(ws + WS_END + (size_t)M_ROWS * 31488 * 2)};
          pg8::gemm_phase<pg8::EpiSq, pg8::SchedPlain>(Fp.lds, 1024, DM, DM, S, E); }
#endif
#ifdef PROBE_P3CHEAP
        { const Ctx Fp = FL(); guchar* ws = WSL(); pg8::SchedBranch S; S.T.init(M_ROWS / 256, DM / 256, Fp.G, Fp.bx); S.A = (const gchar*)(ws + WS_YA); S.B = (const gchar*)(ws + WS_WBR + (size_t)l * SZ_WBR);
          S.astep = (size_t)256 * BW * 2; S.bstep = (size_t)256 * BW * 2; S.aseg = SZ_ROWS_BW; S.bseg = (size_t)DM * BW * 2;
          pg8::EpiSq E{(gbf16*)(ws + WS_END), (gfloat*)(ws + WS_END + (size_t)M_ROWS * 31488 * 2)};
          pg8::gemm_phase<pg8::EpiSq, pg8::SchedBranch>(Fp.lds, BW, BW, BW, S, E); }
#endif
#ifndef SKIP_P3
        for (int rep_ = 0; rep_ < REP_P3; ++rep_) { const Ctx Fp = FL(); guchar* ws = WSL(); pg8::SchedBranch S; S.T.init(M_ROWS / 256, DM / 256, Fp.G, Fp.bx); S.A = (const gchar*)(ws + WS_YA); S.B = (const gchar*)(ws + WS_WBR + (size_t)l * SZ_WBR);
          S.astep = (size_t)256 * BW * 2; S.bstep = (size_t)256 * BW * 2; S.aseg = SZ_ROWS_BW; S.bseg = (size_t)DM * BW * 2;
          pg8::EpiBranch E{(const guchar*)(ws + WS_G), (gbf16*)(ws + WS_MIX)};
          pg8::gemm_phase<pg8::EpiBranch, pg8::SchedBranch>(Fp.lds, BW, BW, BW, S, E); }
#endif
        for (int rb_ = 0; rb_ < REP_BAR; ++rb_) xcd_barrier(bar);
#ifndef SKIP_P4
        for (int rep_ = 0; rep_ < REP_P4; ++rep_) { const Ctx Fp = FL(); guchar* ws = WSL(); pg8::SchedPlain S; S.T.init(M_ROWS / 256, DM / 256, Fp.G, Fp.bx); S.A = (const gchar*)(ws + WS_MIX); S.B = (const gchar*)(ws + WS_WOUT + (size_t)l * SZ_WSQ);
          S.astep = (size_t)256 * DM * 2; S.bstep = (size_t)256 * DM * 2;
          pg8::EpiSq E{(gbf16*)(ws + WS_OUT), (gfloat*)(ws + WS_OUTP)};
          pg8::gemm_phase<pg8::EpiSq, pg8::SchedPlain>(Fp.lds, DM, DM, DM, S, E); }
#endif
        for (int rb_ = 0; rb_ < REP_BAR; ++rb_) xcd_barrier(bar);
#ifndef SKIP_P4B
        for (int rep_ = 0; rep_ < REP_THIN; ++rep_) p4b_x1(FL(), WSL(), ARGP(const gfloat*, 15) + l * DM);
#endif
        for (int rb_ = 0; rb_ < REP_BAR; ++rb_) xcd_barrier(bar);
#ifndef SKIP_P5
        { const Ctx Fp = FL(); guchar* ws = WSL(); pg8::SchedPlain S; S.T.init(M_ROWS / 256, DM / 256, Fp.G, Fp.bx); S.A = (const gchar*)(ws + ((P5_FP8 || P5_I8) ? WS_X1B8 : WS_X1B)); S.B = (const gchar*)(ws + WS_WPG + (size_t)l * SZ_WSQ);
          S.astep = (size_t)256 * DM * ((P5_FP8 || P5_I8) ? 1 : 2); S.bstep = (size_t)256 * DM * ((P5_FP8 || P5_I8) ? 1 : 2);
          pg8::EpiPle E{(const gbf16*)(ws + WS_X1B), ARGP(gfloat*, 19), (gbf16*)(ws + WS_XB), (const gbf16*)(ws + WS_ERAW), (const gfloat*)(ws + WS_RSE), ARGP(const gfloat*, 17) + l * DM, (gfloat*)(ws + WS_XSP), l == NLAYER - 1 ? 1 : 0, ws + WS_XB8, (const gfloat*)(ws + WS_RSX), __uint_as_float(((const gunsigned*)(ws + WS_CTL))[CW_WMAX + l]) * (1.0f / 127.0f)};
          pg8::gemm_phase<pg8::EpiPle, pg8::SchedPlain>(Fp.lds, (P5_FP8 || P5_I8) ? DM / 2 : DM, DM, DM, S, E); }
#endif
        if (l + 1 < NLAYER) { for (int rb_ = 0; rb_ < REP_BAR; ++rb_) xcd_barrier(bar); p5b_ssq(FL(), WSL()); for (int rb_ = 0; rb_ < REP_BAR; ++rb_) xcd_barrier(bar); }
    };
    static_assert(NLAYER == 2, "two layer bodies");
    layer_body(0); layer_body(1);
}

extern "C" void kernel_launch(void* const* d_in, const int* in_sizes, int n_in, void* d_out, int out_size, void* d_ws, size_t ws_size, hipStream_t stream) {
    static int grid = 0;
    if (grid == 0) {
        if (n_in != 19 || out_size != M_ROWS * DM || ws_size < WS_END) { fprintf(stderr, "kernel_launch: unexpected problem (n_in %d, out %d, ws %zu, need %zu)\n", n_in, out_size, ws_size, (size_t)WS_END); grid = -1; return; }
        int dev = 0, cus = 0;
        if (hipGetDevice(&dev) != hipSuccess || hipDeviceGetAttribute(&cus, hipDeviceAttributeMultiprocessorCount, dev) != hipSuccess) { grid = -1; return; }
        if (hipFuncSetAttribute((const void*)fwd_kernel, hipFuncAttributeMaxDynamicSharedMemorySize, LDS_BYTES) != hipSuccess) { fprintf(stderr, "kernel_launch: hipFuncSetAttribute failed\n"); grid = -1; return; }
        int per_cu = 0; (void)hipOccupancyMaxActiveBlocksPerMultiprocessor(&per_cu, (const void*)fwd_kernel, NTHREADS, LDS_BYTES); (void)hipGetLastError();
        if (per_cu < 1) fprintf(stderr, "kernel_launch: occupancy query reports %d blocks per CU\n", per_cu);
        grid = cus > 256 ? 256 : cus;
    }
    if (grid < 0) return;
    (void)hipMemsetAsync((char*)d_ws + WS_CTL, 0, CTL_ZERO_BYTES, stream);
    Args a{};
    for (int i = 0; i < 19; ++i) a.in[i] = d_in[i];
    a.out = (float*)d_out; a.ws = (unsigned char*)d_ws;
    hipLaunchKernelGGL(fwd_kernel, dim3(grid), dim3(NTHREADS), LDS_BYTES, stream, a);
    const hipError_t le = hipPeekAtLastError();
    if (le != hipSuccess) fprintf(stderr, "kernel_launch: launch failed: %s\n", hipGetErrorName(le));
}
```

```cpp
#include <hip/hip_runtime.h>
#include <cstdio>
#include <cstdint>

#define LAS __attribute__((address_space(3)))
#define GAS __attribute__((address_space(1)))
typedef unsigned short bf16_t;
typedef short bf16x8 __attribute__((ext_vector_type(8)));
typedef float f32x4 __attribute__((ext_vector_type(4)));
typedef float f32x2 __attribute__((ext_vector_type(2)));
typedef unsigned u32x4 __attribute__((ext_vector_type(4)));
typedef unsigned u32x2 __attribute__((ext_vector_type(2)));

typedef GAS float gfloat; typedef GAS bf16_t gbf16; typedef GAS int gint; typedef GAS char gchar; typedef GAS unsigned char guchar; typedef GAS unsigned gunsigned;
typedef GAS f32x4 gf32x4; typedef GAS f32x2 gf32x2; typedef GAS u32x4 gu32x4; typedef GAS u32x2 gu32x2;
constexpr int M_ROWS = 8192, SEQ = 2048, DM = 4096, BW = 2048, NLAYER = 2;
constexpr int N_IN = 31240, IF_COL = 14848;
constexpr int NT_IN = 123;
constexpr int N_IN_T = NT_IN * 256;
constexpr float NORM_EPS = 1e-6f;

__device__ __forceinline__ unsigned cvt_pk_bf16(float lo, float hi) { unsigned r; asm("v_cvt_pk_bf16_f32 %0, %1, %2" : "=v"(r) : "v"(lo), "v"(hi)); return r; }
__device__ __forceinline__ float bf_lo(unsigned w) { return __uint_as_float(w << 16); }
__device__ __forceinline__ float bf_hi(unsigned w) { return __uint_as_float(w & 0xffff0000u); }
__device__ __forceinline__ float bf1(bf16_t b) { return __uint_as_float(((unsigned)b) << 16); }
__device__ __forceinline__ float fsigmoid(float x) { return __builtin_amdgcn_rcpf(1.0f + __expf(-x)); }
__device__ __forceinline__ float wave_sum(float v) {
#pragma unroll
    for (int o = 1; o < 64; o <<= 1) v += __shfl_xor(v, o);
    return v;
}
__device__ __forceinline__ f32x2 gelu_pk(f32x2 v) {
    const f32x2 av = __builtin_elementwise_abs(v), d = av * 0.2316418882f + 1.0f;
    f32x2 t; t.x = __builtin_amdgcn_rcpf(d.x); t.y = __builtin_amdgcn_rcpf(d.y);
    f32x2 q = t * 0.5307027145f + (-0.7265760135f); q = q * t + 0.7107068705f; q = q * t + (-0.142248368f); q = q * t + 0.127414796f; q = q * t;
    const f32x2 s = (v * v) * (-0.72134752044f);
    f32x2 e; e.x = __builtin_amdgcn_exp2f(s.x); e.y = __builtin_amdgcn_exp2f(s.y);
    const f32x2 m = v * (q * e), r = v - m;
    f32x2 o; o.x = v.x < 0.f ? m.x : r.x; o.y = v.y < 0.f ? m.y : r.y; return o;
}
typedef int i32x8 __attribute__((ext_vector_type(8)));
typedef short s16x16 __attribute__((ext_vector_type(16)));
__host__ __device__ __forceinline__ size_t ablk8(int row, int col, int K) { return ((size_t)(row >> 8) * (K >> 7) + (col >> 7)) * 32768 + (size_t)(row & 255) * 128 + (col & 127); }
__device__ __forceinline__ unsigned pack_fp8x4(float a, float b, float c, float d) { int w = 0; w = __builtin_amdgcn_cvt_pk_fp8_f32(a, b, w, false); w = __builtin_amdgcn_cvt_pk_fp8_f32(c, d, w, true); return (unsigned)w; }
__device__ __forceinline__ unsigned pack_i8x4(float a, float b, float c, float d) {
    const int q0 = min(max(__float2int_rn(a), -127), 127), q1 = min(max(__float2int_rn(b), -127), 127), q2 = min(max(__float2int_rn(c), -127), 127), q3 = min(max(__float2int_rn(d), -127), 127);
    return ((unsigned)q0 & 0xffu) | (((unsigned)q1 & 0xffu) << 8) | (((unsigned)q2 & 0xffu) << 16) | ((unsigned)q3 << 24);
}
__host__ __device__ __forceinline__ size_t ablk(int row, int col, int K) { return ((size_t)(row >> 8) * (K >> 6) + (col >> 6)) * 16384 + (size_t)(row & 255) * 64 + (col & 63); }
__host__ __device__ __forceinline__ size_t tb256(int row, int col, int nt) { return ((size_t)(row >> 8) * nt + (col >> 8)) * 65536 + (size_t)(row & 255) * 256 + (col & 255); }
__host__ __device__ __forceinline__ size_t tb128(int row, int col, int nt) { return ((size_t)(row >> 8) * nt + (col >> 7)) * 32768 + (size_t)(row & 255) * 128 + (col & 127); }
#define LAUNDER_V(x) asm volatile("" : "+v"(x))
#define LAUNDER_S(x) asm volatile("" : "+s"(x))
#define LDS_WAIT() asm volatile("s_waitcnt lgkmcnt(0)" ::: "memory")
#define VM_WAIT() asm volatile("s_waitcnt vmcnt(0)" ::: "memory")
#define MFMA16(a, b, c) __builtin_amdgcn_mfma_f32_16x16x32_bf16((a), (b), (c), 0, 0, 0)

#define XB_TMO      128
#define XB_XCNT(j)  (256  + 64 * (j))
#define XB_XSUB(j)  (1280 + 64 * (j))
#define XB_XGEN(j)  (2304 + 64 * (j))
#define XB_TOP      3328
#define XB_TOPGEN   3392
#define XCD_BAR_WORDS 3456
#define XB_SPIN_CAP (1u << 18)
__device__ __forceinline__ unsigned xb_ld(unsigned* p)              { return __hip_atomic_load(p, __ATOMIC_RELAXED, __HIP_MEMORY_SCOPE_AGENT); }
__device__ __forceinline__ unsigned xb_add(unsigned* p, unsigned v) { return __hip_atomic_fetch_add(p, v, __ATOMIC_RELAXED, __HIP_MEMORY_SCOPE_AGENT); }
__device__ __forceinline__ unsigned xb_xcc_id() { return (unsigned)__builtin_amdgcn_s_getreg((3 << 11) | 20) & 0xFu; }
#define XB_SPIN(cond, bar) do { unsigned _sp = 0; while (cond) { __builtin_amdgcn_s_sleep(1); \
    if ((++_sp & 255u) == 0u) { if (xb_ld(&(bar)[XB_TMO])) break; if (_sp > XB_SPIN_CAP) { atomicAdd(&(bar)[XB_TMO], 1u); break; } } } } while (0)
struct XcdBarrier { unsigned* bar; unsigned x; volatile LAS unsigned* st; };
__device__ __forceinline__ XcdBarrier xcd_barrier_post(unsigned* bar, volatile LAS unsigned* st) {
    XcdBarrier b; b.bar = bar; b.x = xb_xcc_id(); b.st = st;
    if (threadIdx.x == 0) (void)xb_add(&bar[XB_XCNT(b.x)], 1u);
    return b;
}
__device__ __forceinline__ void xcd_barrier_complete(unsigned* bar, unsigned x, unsigned& nloc, unsigned& nx) {
    const unsigned G = gridDim.x * gridDim.y * gridDim.z;
    unsigned sum, cnt, mine, sp = 0u;
    for (;;) {
        sum = 0u; cnt = 0u; mine = 0u;
#pragma unroll
        for (unsigned j = 0; j < 16; ++j) { const unsigned c = xb_ld(&bar[XB_XCNT(j)]); sum += c; cnt += (c > 0u) ? 1u : 0u; mine = (j == x) ? c : mine; }
        if (sum == G) break;
        __builtin_amdgcn_s_sleep(1);
        if ((++sp & 255u) == 0u) { if (xb_ld(&bar[XB_TMO])) break; if (sp > XB_SPIN_CAP) { atomicAdd(&bar[XB_TMO], 1u); break; } }
    }
    nloc = mine > 0u ? mine : 1u; nx = cnt > 0u ? cnt : 1u;
}
__device__ __forceinline__ void xcd_barrier(const XcdBarrier& b) {
    asm volatile("s_waitcnt vmcnt(0)" ::: "memory");
    __syncthreads();
    if (threadIdx.x == 0) {
        unsigned* bar = b.bar;
        __builtin_amdgcn_s_waitcnt(0);
        unsigned nloc = b.st[0], nx = b.st[1];
        if (nloc == 0u) { xcd_barrier_complete(bar, b.x, nloc, nx); b.st[0] = nloc; b.st[1] = nx; }
        const unsigned old = xb_add(&bar[XB_XSUB(b.x)], 1u);
        const unsigned gen = old / nloc;
        if (old + 1u == (gen + 1u) * nloc) {
            __builtin_amdgcn_fence(__ATOMIC_RELEASE, "agent");
            asm volatile("s_waitcnt vmcnt(0)" ::: "memory");
            const unsigned og = xb_add(&bar[XB_TOP], 1u);
            const unsigned tg = og / nx;
            if (og + 1u == (tg + 1u) * nx) xb_add(&bar[XB_TOPGEN], 1u);
            else XB_SPIN(xb_ld(&bar[XB_TOPGEN]) == tg, bar);
            __builtin_amdgcn_fence(__ATOMIC_ACQUIRE, "agent");
            xb_add(&bar[XB_XGEN(b.x)], 1u);
            asm volatile("s_waitcnt vmcnt(0)" ::: "memory");
        } else {
            XB_SPIN(xb_ld(&bar[XB_XGEN(b.x)]) == gen, bar);
            __builtin_amdgcn_fence(__ATOMIC_ACQUIRE, "agent");
            asm volatile("s_waitcnt vmcnt(0)" ::: "memory");
        }
    }
    __syncthreads();
}

#ifndef WGM_DEFAULT
#define WGM_DEFAULT 4
#endif
#ifndef PG8_SADDR
#define PG8_SADDR 1
#endif
namespace pg8 {
constexpr int BM = 256, BK = 64, HALF = 128, HTB = HALF * BK * 2, STAGE_BYTES = 8 * HTB, NXCD = 8, WGM = WGM_DEFAULT;
__host__ __device__ __forceinline__ int lds_byte(int r, int c) { const int st = (r >> 4) * 2 + (c >> 5), rr = r & 15, cc = c & 31, ob = rr * 64 + cc * 2; return st * 1024 + (ob ^ (((ob >> 9) & 1) << 5)); }
__host__ __device__ __forceinline__ void stage_rc(int b, int& R, int& C) { const int st = b / 1024, sb = b % 1024, swz = sb ^ (((sb >> 9) & 1) << 5); R = (st >> 1) * 16 + swz / 64; C = (st & 1) * 32 + (swz % 64) / 2; }
__host__ __device__ __forceinline__ int perm32(int rho) { const int n = rho >> 4, i = rho & 15; return 8 * (i >> 2) + 4 * n + (i & 3); }

struct Unit { int pm, pn, seg; };

struct TileOrder {
    int nM, nN, nwg, G, c, wgm, rot, tailtile, pnoff;
    __device__ __forceinline__ void init(int nM_, int nN_, int G_, int c_, int wgm_ = WGM, int rot_ = 0, int tailtile_ = -1, int pnoff_ = 0) { nM = nM_; nN = nN_; nwg = nM * nN; G = G_; c = c_; wgm = wgm_; rot = rot_; tailtile = tailtile_; pnoff = pnoff_; }
    __device__ __forceinline__ bool tile(int i, int& pm, int& pn) const {
        const long L = (long)i * G + c; if (L >= nwg) return false;
        int wgid = (int)L; const int xcd = wgid % NXCD; { const int q = nwg / NXCD, r = nwg % NXCD, off = wgid / NXCD; wgid = (xcd < r ? xcd * (q + 1) : r * (q + 1) + (xcd - r) * q) + off; }
        const int nig = wgm * nN, gid = wgid / nig, fm = gid * wgm, gsz = (nM - fm) < wgm ? (nM - fm) : wgm;
        pm = fm + ((wgid % nig) % gsz); pn = (wgid % nig) / gsz; if (rot) { pn += rot * xcd; pn -= (pn / nN) * nN; } if (tailtile >= 0 && pn == nN - 1) pn = tailtile; pn += pnoff; return true;
    }
};
struct SchedPlain {
    TileOrder T; const gchar* A; const gchar* B; size_t astep, bstep;
    __device__ __forceinline__ bool next(int i, Unit& u) const { u.seg = 0; return T.tile(i, u.pm, u.pn); }
    __device__ __forceinline__ const gchar* a_ptr(const Unit& u) const { return A + (size_t)u.pm * astep; }
    int pn0 = 0;
    __device__ __forceinline__ const gchar* b_ptr(const Unit& u) const { return B + (size_t)(u.pn - pn0) * bstep; }
};
struct SchedBranch {
    TileOrder T; const gchar* A; const gchar* B; size_t astep, bstep, aseg, bseg;
    __device__ __forceinline__ bool next(int i, Unit& u) const { const int t = i / 3; u.seg = i - 3 * t; return T.tile(t, u.pm, u.pn); }
    __device__ __forceinline__ const gchar* a_ptr(const Unit& u) const { return A + (size_t)u.seg * aseg + (size_t)u.pm * astep; }
    __device__ __forceinline__ const gchar* b_ptr(const Unit& u) const { return B + (size_t)u.seg * bseg + (size_t)u.pn * bstep; }
};

template <class Epi, class Sched>
__device__ __forceinline__ void gemm_phase(LAS unsigned char* lds, const int K, const int lda, const int ldb, const Sched& S, const Epi& E, unsigned* lockctr = nullptr, const int nlock = 0) {
    int tid = threadIdx.x; LAUNDER_V(tid);
    const int wid = __builtin_amdgcn_readfirstlane(tid >> 6), lane = tid & 63, wr = wid >> 2, wc = wid & 3, fr = lane & 15, fq = lane >> 4;
    const int nt = K / BK;
    unsigned voffA, voffB;
    { int R, C; stage_rc(tid * 16, R, C); const int Rb = Epi::PERM ? ((R & ~31) + perm32(R & 31)) : R;
      voffA = (unsigned)(R * BK + C) * 2u; voffB = (unsigned)(Rb * BK + C) * 2u; }
    const unsigned qstepA = 64u * (unsigned)BK * 2u, qstepB = 64u * (unsigned)BK * 2u;
    const size_t kstep = (size_t)BM * BK * 2, kstepB = (size_t)BM * BK * 2;
    const size_t hstepA = (size_t)HALF * BK * 2, hstepB = (size_t)HALF * BK * 2;
    const unsigned ldsw = (unsigned)wid * 1024u;
    const int aoff = lds_byte(wr * 64 + fr, fq * 8), boff = lds_byte(wc * 32 + fr, fq * 8);
#define PG8_SA(b, h) (((b) * 2 + (h)) * HTB)
#define PG8_SB(b, h) ((4 + (b) * 2 + (h)) * HTB)
#if PG8_SADDR
#define PG8_STAGE(bufoff, gbase, voff) do { _Pragma("unroll") for (int _i = 0; _i < 2; ++_i) { const gchar* p_ = (const gchar*)(gbase) + (size_t)_i * q##voff; asm volatile("" : "+s"(p_)); \
        __builtin_amdgcn_global_load_lds((const gunsigned*)(p_ + (voff)), (LAS unsigned*)(lds + (bufoff) + ldsw + _i * 8192), 16, 0, 0); } } while (0)
#else
#define PG8_STAGE(bufoff, gbase, voff) do { _Pragma("unroll") for (int _i = 0; _i < 2; ++_i) \
        __builtin_amdgcn_global_load_lds((const gunsigned*)((const gchar*)(gbase) + (size_t)_i * q##voff + (voff)), (LAS unsigned*)(lds + (bufoff) + ldsw + _i * 8192), 16, 0, 0); } while (0)
#endif
#define qvoffA qstepA
#define qvoffB qstepB
#define PG8_LDA(dst, b, h) do { _Pragma("unroll") for (int m = 0; m < 4; ++m) _Pragma("unroll") for (int k = 0; k < 2; ++k) dst[m][k] = *(const LAS bf16x8*)(lds + PG8_SA(b, h) + aoff + m * 2048 + k * 1024); } while (0)
#define PG8_LDB(dst, b, h) do { _Pragma("unroll") for (int n = 0; n < 2; ++n) _Pragma("unroll") for (int k = 0; k < 2; ++k) dst[n][k] = *(const LAS bf16x8*)(lds + PG8_SB(b, h) + boff + n * 2048 + k * 1024); } while (0)
#define PG8_CAT(x_, y_) __builtin_bit_cast(i32x8, __builtin_shufflevector((x_), (y_), 0, 1, 2, 3, 4, 5, 6, 7, 8, 9, 10, 11, 12, 13, 14, 15))
#define PG8_MMA(ai, bj, At, Bt) do { __builtin_amdgcn_s_setprio(1); _Pragma("unroll") for (int m = 0; m < 4; ++m) _Pragma("unroll") for (int n = 0; n < 2; ++n) { \
        if constexpr (Epi::FP8) { const i32x8 b8_ = PG8_CAT(Bt[n][0], Bt[n][1]), a8_ = PG8_CAT(At[m][0], At[m][1]); \
            asm volatile("s_nop 1\n\tv_mfma_scale_f32_16x16x128_f8f6f4 %0, %1, %2, %0, %3, %3 op_sel_hi:[0,0,0]" : "+v"(acc[ai][bj][m][n]) : "v"(b8_), "v"(a8_), "v"(sc8)); } \
        else if constexpr (Epi::I8) { _Pragma("unroll") for (int k = 0; k < 2; ++k) asm volatile("s_nop 1\n\tv_mfma_i32_16x16x64_i8 %0, %1, %2, %0" : "+v"(acc[ai][bj][m][n]) : "v"(Bt[n][k]), "v"(At[m][k])); } \
        else { _Pragma("unroll") for (int k = 0; k < 2; ++k) acc[ai][bj][m][n] = __builtin_amdgcn_mfma_f32_16x16x32_bf16(Bt[n][k], At[m][k], acc[ai][bj][m][n], 0, 0, 0); } } __builtin_amdgcn_s_setprio(0); } while (0)
#define PG8_WAIT_V(n) asm volatile("s_waitcnt vmcnt(" #n ")" ::: "memory")
#define PG8_WAIT_VR() do { if constexpr (Epi::NS == 16) asm volatile("s_waitcnt vmcnt(24)" ::: "memory"); else if constexpr (Epi::NS == 32) asm volatile("s_waitcnt vmcnt(40)" ::: "memory"); else asm volatile("s_waitcnt vmcnt(8)" ::: "memory"); } while (0)
#define PG8_WAIT_L(n) asm volatile("s_waitcnt lgkmcnt(" #n ")" ::: "memory")
#define PG8_BAR __builtin_amdgcn_s_barrier()
#define PG8_SCHED __builtin_amdgcn_sched_barrier(0)
    Unit cur, nxt; int ui = 0; bool relax_next = false;
    int sc8 = 0x7f7f7f7f; asm volatile("" : "+v"(sc8));
    if (!S.next(0, cur)) return;
    f32x4 acc[2][2][4][2];
#pragma unroll
    for (int a = 0; a < 2; ++a)
#pragma unroll
        for (int b = 0; b < 2; ++b)
#pragma unroll
            for (int m = 0; m < 4; ++m)
#pragma unroll
                for (int n = 0; n < 2; ++n) acc[a][b][m][n] = (f32x4){0.f, 0.f, 0.f, 0.f};
    bf16x8 At[4][2], B0[2][2], B1[2][2];
    const gchar* cA = S.a_ptr(cur); const gchar* cB = S.b_ptr(cur);
    PG8_STAGE(PG8_SB(0, 0), cB, voffB); PG8_STAGE(PG8_SB(0, 1), cB + hstepB, voffB); PG8_STAGE(PG8_SA(0, 0), cA, voffA); PG8_STAGE(PG8_SA(0, 1), cA + hstepA, voffA);
    if (wr == 1) PG8_BAR;
    PG8_WAIT_V(2); PG8_BAR;
    PG8_STAGE(PG8_SB(1, 0), cB + kstepB, voffB); PG8_STAGE(PG8_SA(1, 0), cA + kstep, voffA); PG8_STAGE(PG8_SB(1, 1), cB + hstepB + kstepB, voffB);
    PG8_WAIT_V(6); PG8_BAR;
    for (;;) {
        const bool has_next = S.next(ui + 1, nxt);
        const gchar* nA = has_next ? S.a_ptr(nxt) : cA; const gchar* nB = has_next ? S.b_ptr(nxt) : cB;
        for (int t = 0; t < nt; t += 2) {
            const bool last = (t == nt - 2); const bool relax = Epi::NS > 0 && (t == 0) && relax_next;
#if PG8_SADDR
            asm volatile("" : "+v"(voffA), "+v"(voffB));
#endif
            const gchar* a1 = cA + (size_t)(t + 1) * kstep;
            const gchar* a2 = last ? nA : cA + (size_t)(t + 2) * kstep; const gchar* b2 = last ? nB : cB + (size_t)(t + 2) * kstepB;
            const gchar* a3 = a2 + kstep; const gchar* b3 = b2 + kstepB;
            PG8_LDB(B0, 0, 0); PG8_LDB(B1, 0, 1); PG8_SCHED; PG8_LDA(At, 0, 0); PG8_STAGE(PG8_SA(1, 1), a1 + hstepA, voffA);
            if (relax) PG8_WAIT_VR(); else PG8_WAIT_V(8); PG8_WAIT_L(0); PG8_BAR; PG8_MMA(0, 0, At, B0); PG8_MMA(0, 1, At, B1); PG8_BAR; PG8_SCHED;
            PG8_LDA(At, 0, 1); PG8_STAGE(PG8_SB(0, 0), b2, voffB); PG8_STAGE(PG8_SB(0, 1), b2 + hstepB, voffB); PG8_STAGE(PG8_SA(0, 0), a2, voffA);
            if (relax) PG8_WAIT_VR(); else PG8_WAIT_V(8); PG8_WAIT_L(0); PG8_BAR; PG8_MMA(1, 0, At, B0); PG8_MMA(1, 1, At, B1); PG8_BAR; PG8_SCHED;
            PG8_LDB(B0, 1, 0); PG8_LDB(B1, 1, 1); PG8_SCHED; PG8_LDA(At, 1, 0); PG8_STAGE(PG8_SA(0, 1), a2 + hstepA, voffA);
            PG8_WAIT_V(8); PG8_WAIT_L(0); PG8_BAR; PG8_MMA(0, 0, At, B0); PG8_MMA(0, 1, At, B1); PG8_BAR; PG8_SCHED;
            PG8_LDA(At, 1, 1); PG8_STAGE(PG8_SB(1, 0), b3, voffB); PG8_STAGE(PG8_SB(1, 1), b3 + hstepB, voffB); PG8_STAGE(PG8_SA(1, 0), a3, voffA);
            PG8_WAIT_V(8); PG8_WAIT_L(0); PG8_BAR; PG8_MMA(1, 0, At, B0); PG8_MMA(1, 1, At, B1); PG8_BAR; PG8_SCHED;
        }
        if constexpr (Epi::FP8 || Epi::I8) asm volatile("s_nop 15\n\ts_nop 15\n\ts_nop 15\n\ts_nop 15" ::: "memory");
        if (wr == 0) PG8_BAR;
        { const int ln_ = (int)__builtin_amdgcn_mbcnt_hi(~0u, __builtin_amdgcn_mbcnt_lo(~0u, 0u)); E(acc, cur, wr, wc, ln_ & 15, ln_ >> 4); } relax_next = E.relax(cur);
        if (ui < nlock) {
            if (tid == 0) { (void)xb_add(lockctr, 1u); const unsigned tgt_ = (unsigned)(ui + 1) * (unsigned)S.T.G; unsigned sp_ = 0u; while (xb_ld(lockctr) < tgt_) { __builtin_amdgcn_s_sleep(1); if (++sp_ > (1u << 20)) break; } }
            PG8_BAR; }
        if (!has_next) break;
        if (!E.keep(cur)) {
#pragma unroll
            for (int a = 0; a < 2; ++a)
#pragma unroll
                for (int b = 0; b < 2; ++b)
#pragma unroll
                    for (int m = 0; m < 4; ++m)
#pragma unroll
                        for (int n = 0; n < 2; ++n) acc[a][b][m][n] = (f32x4){0.f, 0.f, 0.f, 0.f};
        }
        cur = nxt; cA = nA; cB = nB; ++ui;
        if (wr == 1) PG8_BAR;
    }
    PG8_WAIT_V(0);
    PG8_BAR;
#undef PG8_SA
#undef PG8_SB
#undef PG8_STAGE
#undef qvoffA
#undef qvoffB
#undef PG8_LDA
#undef PG8_LDB
#undef PG8_MMA
#undef PG8_CAT
#undef PG8_WAIT_V
#undef PG8_WAIT_VR
#undef PG8_WAIT_L
#undef PG8_BAR
#undef PG8_SCHED
}
}

constexpr size_t MiB = 1u << 20;
constexpr size_t WS_CTL = 0, CTL_ZERO_BYTES = 1 * MiB;
constexpr int CW_BAR = 4096;
constexpr size_t CTL_SSQ1 = 256 * 1024;
constexpr size_t SZ_WIN = (size_t)N_IN_T * DM * 2, SZ_WBR = (size_t)3 * DM * BW * 2, SZ_WSQ = (size_t)DM * DM * 2, SZ_WPP = (size_t)DM * 256 * 2;
constexpr size_t WS_WIN = 2 * MiB;
constexpr size_t WS_WBR = WS_WIN + 2 * SZ_WIN;
constexpr size_t WS_WOUT = WS_WBR + 2 * SZ_WBR;
constexpr size_t WS_WPG = WS_WOUT + 2 * SZ_WSQ;
constexpr size_t WS_WPP = WS_WPG + 2 * SZ_WSQ;
constexpr size_t SZ_ROWS_BW = (size_t)M_ROWS * BW * 2, SZ_ROWS_D = (size_t)M_ROWS * DM * 2;
constexpr size_t WS_XB = WS_WPP + 2 * SZ_WPP;
constexpr size_t WS_PB = WS_XB + SZ_ROWS_D;
constexpr size_t WS_CS = WS_PB + (size_t)2 * M_ROWS * 256 * 2;
constexpr size_t WS_SSQ0 = WS_CS + (size_t)M_ROWS * 16 * 4;
constexpr size_t WS_AU = WS_SSQ0 + (size_t)M_ROWS * 4;
constexpr size_t WS_AV = WS_AU + SZ_ROWS_BW, WS_AZ = WS_AV + SZ_ROWS_BW, WS_BQ = WS_AZ + SZ_ROWS_BW;
constexpr size_t WS_BK = WS_BQ + SZ_ROWS_BW;
constexpr size_t WS_BV = WS_BK + (size_t)M_ROWS * 256 * 2;
constexpr size_t WS_BZ = WS_BV + (size_t)M_ROWS * 256 * 2;
constexpr size_t WS_CQ = WS_BZ + SZ_ROWS_BW;
constexpr size_t WS_CK = WS_CQ + (size_t)M_ROWS * 1024 * 2;
constexpr size_t WS_CV = WS_CK + (size_t)M_ROWS * 1024 * 2;
constexpr size_t WS_CO = WS_CV + SZ_ROWS_BW, WS_CZ = WS_CO + SZ_ROWS_BW;
constexpr size_t WS_G = WS_CZ + SZ_ROWS_BW;
constexpr size_t WS_IF = WS_G + (size_t)M_ROWS * 12288 * 2;
constexpr size_t WS_LNP = WS_IF + (size_t)M_ROWS * 8 * 4;
constexpr size_t WS_YA = WS_LNP + (size_t)M_ROWS * 32 * 8;
constexpr size_t WS_NUM = WS_YA + 3 * SZ_ROWS_BW;
constexpr size_t WS_SSQC = WS_NUM + SZ_ROWS_BW;
constexpr size_t WS_DN = WS_SSQC + (size_t)M_ROWS * 64 * 4;
constexpr size_t WS_MIX = WS_DN + (size_t)M_ROWS * 4 * 4;
constexpr size_t WS_OUT = WS_MIX + SZ_ROWS_D;
constexpr size_t WS_OUTP = WS_OUT + SZ_ROWS_D;
constexpr size_t WS_ERAW = WS_OUTP + (size_t)M_ROWS * 64 * 4;
constexpr size_t WS_ERP = WS_ERAW + SZ_ROWS_D;
constexpr size_t WS_RSO = WS_ERP + (size_t)M_ROWS * 64 * 4;
constexpr size_t WS_RSE = WS_RSO + (size_t)M_ROWS * 4;
constexpr size_t WS_X1B = WS_RSE + (size_t)M_ROWS * 4;
constexpr size_t WS_XSP = WS_X1B + SZ_ROWS_D;
constexpr size_t WS_X1B8 = WS_XSP + (size_t)M_ROWS * 64 * 4;
constexpr size_t WS_RSX = WS_X1B8 + (size_t)M_ROWS * DM;
constexpr size_t WS_XB8 = WS_RSX + (size_t)M_ROWS * 4;
constexpr size_t SZ_WG8 = (size_t)56 * 256 * DM;
constexpr size_t WS_WG8 = WS_XB8 + (size_t)M_ROWS * DM;
constexpr size_t WS_END = WS_WG8 + 2 * SZ_WG8;
static_assert(WS_WIN % 256 == 0 && WS_XB % 256 == 0 && WS_AU % 256 == 0 && WS_G % 256 == 0 && WS_YA % 256 == 0 && WS_MIX % 256 == 0 && WS_X1B % 256 == 0, "alignment");

#ifndef EPIIN_NT
#define EPIIN_NT 0
#endif
#if EPIIN_NT
#define EPIIN_STORE(v, p) __builtin_nontemporal_store((v), (p))
#else
#define EPIIN_STORE(v, p) (*(p) = (v))
#endif
#ifndef DBG_ZERO_ASC
#define DBG_ZERO_ASC 0
#endif
#ifndef P1G_FP8
#define P1G_FP8 1
#endif
#ifndef P5_I8
#define P5_I8 1
#endif
constexpr int CW_WMAX = 512;
#ifndef P5_FP8
#define P5_FP8 0
#endif
constexpr float W8_SCALE = 256.0f;
#ifndef EPI_NS16
#define EPI_NS16 0
#endif
#ifndef EPI_NS32
#define EPI_NS32 0
#endif
#ifndef EPIIN_NS
#define EPIIN_NS 0
#endif
namespace pg8 {
__device__ __forceinline__ unsigned pack_u8x4(float a, float b, float c, float d) {
    const unsigned q0 = (unsigned)(a * 255.0f + 0.5f), q1 = (unsigned)(b * 255.0f + 0.5f), q2 = (unsigned)(c * 255.0f + 0.5f), q3 = (unsigned)(d * 255.0f + 0.5f);
    return q0 | (q1 << 8) | (q2 << 16) | (q3 << 24);
}
template <bool F8> struct EpiInT {
    static constexpr bool PERM = true; static constexpr int NS = EPIIN_NS; static constexpr bool FP8 = F8; static constexpr bool I8 = false;
    __device__ __forceinline__ bool relax(const Unit& u) const { return u.pn < 122; }
    const gfloat* ssq; guchar* ws; const LAS float* rtab; int rowbase;
    __device__ __forceinline__ float rstd_of(int row) const { return rowbase >= 0 ? rtab[row - rowbase] : rsqrtf(ssq[row] * (1.0f / DM) + NORM_EPS); }
    __device__ __forceinline__ bool keep(const Unit&) const { return false; }
    __device__ __forceinline__ void operator()(f32x4 (&acc)[2][2][4][2], const Unit& u, int wr, int wc, int fr, int fq) const {
        const int pn = u.pn; const int row0 = u.pm * BM + wr * 64 + fr;
        size_t off; int ldc, t0, act; float sc = 1.f;
        if (pn < 16)       { off = WS_AU; ldc = 2048; t0 = 0; act = 6; }
        else if (pn < 24)  { off = WS_AV; ldc = 2048; t0 = 16; act = 5; }
        else if (pn < 32)  { off = WS_BQ; ldc = 2048; t0 = 24; act = 0; }
        else if (pn < 33)  { off = WS_BK; ldc = 256; t0 = 32; act = 0; }
        else if (pn < 34)  { off = WS_BV; ldc = 256; t0 = 33; act = 0; }
        else if (pn < 42)  { off = WS_BZ; ldc = 2048; t0 = 34; act = 2; }
        else if (pn < 46)  { off = WS_CQ; ldc = 1024; t0 = 42; act = 0; sc = 0.0625f; }
        else if (pn < 50)  { off = WS_CK; ldc = 1024; t0 = 46; act = 0; }
        else if (pn < 58)  { off = WS_CV; ldc = 2048; t0 = 50; act = 0; }
        else if (pn < 66)  { off = WS_CZ; ldc = 2048; t0 = 58; act = 2; }
        else if (pn < 122) { off = WS_G; ldc = 12288; t0 = 74; act = 3; if (F8) sc = 1.0f / W8_SCALE; }
        else if (F8)       { off = WS_CO; ldc = 2048; t0 = 122; act = 8; sc = 1.0f / W8_SCALE; }
        else               { off = WS_IF; ldc = 8; t0 = 122; act = 4; }
        const int col0 = (pn - t0) * BM + wc * 32 + 8 * fq;
        if (act == 4) {
            if (wc == 0 && fq == 0) {
                gfloat* dst = (gfloat*)(ws + off);
#pragma unroll
                for (int ai = 0; ai < 2; ++ai)
#pragma unroll
                    for (int m = 0; m < 4; ++m) { const int row = row0 + ai * HALF + m * 16; const float rs = rstd_of(row);
                        *(gf32x4*)(dst + (size_t)row * 8) = acc[ai][0][m][0] * rs; *(gf32x4*)(dst + (size_t)row * 8 + 4) = acc[ai][0][m][1] * rs; }
            }
            return;
        }
        gbf16* base = (gbf16*)(ws + off);
        if (act == 6 || act == 7) {
            const int colp = (pn - t0) * HALF + wc * 32 + 8 * fq;
#pragma unroll
            for (int ai = 0; ai < 2; ++ai)
#pragma unroll
                for (int m = 0; m < 4; ++m) {
                    const int row = row0 + ai * HALF + m * 16; const float rs = rstd_of(row);
                    f32x4 a0 = acc[ai][0][m][0] * rs, a1 = acc[ai][0][m][1] * rs; const f32x4 z0 = acc[ai][1][m][0] * rs, z1 = acc[ai][1][m][1] * rs;
                    if (act == 6) { const f32x2 a = gelu_pk((f32x2){a0[0], a0[1]}), b = gelu_pk((f32x2){a0[2], a0[3]}), c = gelu_pk((f32x2){a1[0], a1[1]}), d = gelu_pk((f32x2){a1[2], a1[3]});
                        a0 = (f32x4){a.x, a.y, b.x, b.y}; a1 = (f32x4){c.x, c.y, d.x, d.y}; }
                    else {
#pragma unroll
                        for (int j = 0; j < 4; ++j) { a0[j] = fsigmoid(a0[j]); a1[j] = fsigmoid(a1[j]); } }
#pragma unroll
                    for (int j = 0; j < 4; ++j) { a0[j] *= z0[j] * fsigmoid(z0[j]); a1[j] *= z1[j] * fsigmoid(z1[j]); }
                    u32x4 w; w.x = cvt_pk_bf16(a0[0], a0[1]); w.y = cvt_pk_bf16(a0[2], a0[3]); w.z = cvt_pk_bf16(a1[0], a1[1]); w.w = cvt_pk_bf16(a1[2], a1[3]);
                    *(gu32x4*)(base + tb128(row, colp, 16)) = w;
                }
            return;
        }
#pragma unroll
        for (int ai = 0; ai < 2; ++ai)
#pragma unroll
            for (int m = 0; m < 4; ++m) {
                const int row = row0 + ai * HALF + m * 16; const float rs = rstd_of(row) * sc;
                gbf16* rowp = base + tb256(row, col0, ldc >> 8); float ls = 0.f, lq = 0.f;
#pragma unroll
                for (int bj = 0; bj < 2; ++bj) {
                    f32x4 v0 = acc[ai][bj][m][0] * rs, v1 = acc[ai][bj][m][1] * rs;
                    if (act == 5) {
                        f32x2 a = gelu_pk((f32x2){v0[0], v0[1]}), b = gelu_pk((f32x2){v0[2], v0[3]}), c = gelu_pk((f32x2){v1[0], v1[1]}), d = gelu_pk((f32x2){v1[2], v1[3]});
                        v0 = (f32x4){a.x, a.y, b.x, b.y}; v1 = (f32x4){c.x, c.y, d.x, d.y};
                        { ls += (v0[0] + v0[1]) + (v0[2] + v0[3]) + (v1[0] + v1[1]) + (v1[2] + v1[3]);
                            lq += (v0[0] * v0[0] + v0[1] * v0[1]) + (v0[2] * v0[2] + v0[3] * v0[3]) + (v1[0] * v1[0] + v1[1] * v1[1]) + (v1[2] * v1[2] + v1[3] * v1[3]); }
                    } else if (act == 2) {
#pragma unroll
                        for (int j = 0; j < 4; ++j) { v0[j] = v0[j] * fsigmoid(v0[j]); v1[j] = v1[j] * fsigmoid(v1[j]); }
                    } else if (act == 3 || act == 8) {
#pragma unroll
                        for (int j = 0; j < 4; ++j) { v0[j] = fsigmoid(v0[j]); v1[j] = fsigmoid(v1[j]); }
                    }
                    if (act == 3) {
                        u32x2 w8; w8.x = pack_u8x4(v0[0], v0[1], v0[2], v0[3]); w8.y = pack_u8x4(v1[0], v1[1], v1[2], v1[3]);
                        *(gu32x2*)(ws + WS_G + ((size_t)(u.pm * 48 + (pn - 74)) * 256 + (row & 255)) * 256 + (wc * 32 + 8 * fq) + bj * HALF) = w8;
                    } else {
                    u32x4 w; w.x = cvt_pk_bf16(v0[0], v0[1]); w.y = cvt_pk_bf16(v0[2], v0[3]); w.z = cvt_pk_bf16(v1[0], v1[1]); w.w = cvt_pk_bf16(v1[2], v1[3]);
                    EPIIN_STORE(w, (gu32x4*)(rowp + bj * HALF)); }
                }
                if (act == 5) {
                    ls += __shfl_xor(ls, 16); ls += __shfl_xor(ls, 32); lq += __shfl_xor(lq, 16); lq += __shfl_xor(lq, 32);
                    if (fq == 0) *(gf32x2*)(ws + WS_LNP + ((size_t)row * 32 + (pn - 16) * 4 + wc) * 8) = (f32x2){ls, lq};
                }
            }
    }
};
using EpiIn = EpiInT<false>;
struct EpiBranch {
    static constexpr bool PERM = true; static constexpr int NS = EPI_NS16; static constexpr bool FP8 = false; static constexpr bool I8 = false;
    __device__ __forceinline__ bool relax(const Unit& u) const { return u.seg == 2; }
    const guchar* G; gbf16* MIX;
    __device__ __forceinline__ bool keep(const Unit& u) const { return u.seg != 2; }
    __device__ __forceinline__ void operator()(f32x4 (&acc)[2][2][4][2], const Unit& u, int wr, int wc, int fr, int fq) const {
        const int row0 = u.pm * BM + wr * 64 + fr, col0 = u.pn * BM + wc * 32 + 8 * fq; const int seg = u.seg;
        u32x2 ga[2][4][2], gb[2][4][2];
#pragma unroll
        for (int ai = 0; ai < 2; ++ai)
#pragma unroll
            for (int m = 0; m < 4; ++m) {
                const int row = row0 + ai * HALF + m * 16; const guchar* gp = G + ((size_t)(u.pm * 48 + seg * 16 + u.pn) * 256 + (row & 255)) * 256 + (wc * 32 + 8 * fq);
#pragma unroll
                for (int bj = 0; bj < 2; ++bj) { ga[ai][m][bj] = *(const gu32x2*)(gp + bj * HALF); gb[ai][m][bj] = (seg != 2) ? *(const gu32x2*)(gp + (size_t)16 * 65536 + bj * HALF) : (u32x2){255u * 0x01010101u, 255u * 0x01010101u}; }
            }
#pragma unroll
        for (int ai = 0; ai < 2; ++ai)
#pragma unroll
            for (int m = 0; m < 4; ++m) {
                const int row = row0 + ai * HALF + m * 16;
#pragma unroll
                for (int bj = 0; bj < 2; ++bj) {
                    const u32x2 a_ = ga[ai][m][bj], b_ = gb[ai][m][bj];
                    float f[8] = {(float)((a_.x >> (8 * 0)) & 0xffu), (float)((a_.x >> (8 * 1)) & 0xffu), (float)((a_.x >> (8 * 2)) & 0xffu), (float)((a_.x >> (8 * 3)) & 0xffu),
                                  (float)((a_.y >> (8 * 0)) & 0xffu), (float)((a_.y >> (8 * 1)) & 0xffu), (float)((a_.y >> (8 * 2)) & 0xffu), (float)((a_.y >> (8 * 3)) & 0xffu)};
                    const float h[8] = {(float)((b_.x >> (8 * 0)) & 0xffu), (float)((b_.x >> (8 * 1)) & 0xffu), (float)((b_.x >> (8 * 2)) & 0xffu), (float)((b_.x >> (8 * 3)) & 0xffu),
                                        (float)((b_.y >> (8 * 0)) & 0xffu), (float)((b_.y >> (8 * 1)) & 0xffu), (float)((b_.y >> (8 * 2)) & 0xffu), (float)((b_.y >> (8 * 3)) & 0xffu)};
#pragma unroll
                    for (int j = 0; j < 8; ++j) f[j] = fmaxf(f[j], 1e-18f) * __builtin_amdgcn_rcpf(fmaxf(h[j], 1e-18f));
                    f32x4 v0 = acc[ai][bj][m][0], v1 = acc[ai][bj][m][1];
                    v0 = v0 * (f32x4){f[0], f[1], f[2], f[3]}; v1 = v1 * (f32x4){f[4], f[5], f[6], f[7]};
                    if (seg != 2) { acc[ai][bj][m][0] = v0; acc[ai][bj][m][1] = v1; }
                    else { u32x4 w; w.x = cvt_pk_bf16(v0[0], v0[1]); w.y = cvt_pk_bf16(v0[2], v0[3]); w.z = cvt_pk_bf16(v1[0], v1[1]); w.w = cvt_pk_bf16(v1[2], v1[3]);
                        *(gu32x4*)(MIX + ablk(row, col0 + bj * HALF, DM)) = w; }
                }
            }
    }
};
struct EpiSq {
    static constexpr bool PERM = true; static constexpr int NS = EPI_NS16; static constexpr bool FP8 = false; static constexpr bool I8 = false;
    __device__ __forceinline__ bool relax(const Unit&) const { return true; }
    gbf16* O; gfloat* P;
    __device__ __forceinline__ bool keep(const Unit&) const { return false; }
    __device__ __forceinline__ void operator()(f32x4 (&acc)[2][2][4][2], const Unit& u, int wr, int wc, int fr, int fq) const {
        const int row0 = u.pm * BM + wr * 64 + fr, col0 = u.pn * BM + wc * 32 + 8 * fq;
#pragma unroll
        for (int ai = 0; ai < 2; ++ai)
#pragma unroll
            for (int m = 0; m < 4; ++m) {
                const int row = row0 + ai * HALF + m * 16; float q = 0.f;
#pragma unroll
                for (int bj = 0; bj < 2; ++bj) {
                    const f32x4 v0 = acc[ai][bj][m][0], v1 = acc[ai][bj][m][1];
                    q += (v0[0] * v0[0] + v0[1] * v0[1]) + (v0[2] * v0[2] + v0[3] * v0[3]) + (v1[0] * v1[0] + v1[1] * v1[1]) + (v1[2] * v1[2] + v1[3] * v1[3]);
                    u32x4 w; w.x = cvt_pk_bf16(v0[0], v0[1]); w.y = cvt_pk_bf16(v0[2], v0[3]); w.z = cvt_pk_bf16(v1[0], v1[1]); w.w = cvt_pk_bf16(v1[2], v1[3]);
                    if (O) *(gu32x4*)(O + (size_t)row * DM + col0 + bj * HALF) = w; else asm volatile("" :: "v"(w));
                }
                q += __shfl_xor(q, 16); q += __shfl_xor(q, 32);
                if (fq == 0) P[(size_t)row * 64 + u.pn * 4 + wc] = q;
            }
    }
};
struct EpiPle {
    static constexpr bool PERM = true; static constexpr int NS = EPI_NS32; static constexpr bool FP8 = P5_FP8 != 0; static constexpr bool I8 = P5_I8 != 0;
    __device__ __forceinline__ bool relax(const Unit&) const { return true; }
    const gbf16* X1B; gfloat* XOUT; gbf16* XB; const gbf16* ERAW; const gfloat* RSE; const gfloat* pnorm; gfloat* SSQN; int last; guchar* XB8; const gfloat* RSX; float swq;
    __device__ __forceinline__ bool keep(const Unit&) const { return false; }
    __device__ __forceinline__ void operator()(f32x4 (&acc)[2][2][4][2], const Unit& u, int wr, int wc, int fr, int fq) const {
        const int row0 = u.pm * BM + wr * 64 + fr, col0 = u.pn * BM + wc * 32 + 8 * fq; constexpr float ASC = FP8 ? (DBG_ZERO_ASC ? 0.0f : 1.0f / W8_SCALE) : 1.0f;
#pragma unroll
        for (int ai = 0; ai < 2; ++ai)
#pragma unroll
            for (int m = 0; m < 4; ++m) {
                const int row = row0 + ai * HALF + m * 16; const float rse = RSE[row]; float q = 0.f; const size_t ro = (size_t)row * DM; const float zsc = I8 ? RSX[row] * swq : ASC;
#pragma unroll
                for (int bj = 0; bj < 2; ++bj) {
                    const int col = col0 + bj * HALF;
                    const u32x4 xb = *(const gu32x4*)(X1B + ablk(row, col, DM)), eb = *(const gu32x4*)(ERAW + ro + col);
                    const f32x4 pna = *(const gf32x4*)(pnorm + col), pnb = *(const gf32x4*)(pnorm + col + 4);
                    const float x[8] = {bf_lo(xb.x), bf_hi(xb.x), bf_lo(xb.y), bf_hi(xb.y), bf_lo(xb.z), bf_hi(xb.z), bf_lo(xb.w), bf_hi(xb.w)};
                    const float e8[8] = {bf_lo(eb.x), bf_hi(eb.x), bf_lo(eb.y), bf_hi(eb.y), bf_lo(eb.z), bf_hi(eb.z), bf_lo(eb.w), bf_hi(eb.w)};
                    const float pn[8] = {pna[0], pna[1], pna[2], pna[3], pnb[0], pnb[1], pnb[2], pnb[3]};
                    const f32x4 a0 = acc[ai][bj][m][0], a1 = acc[ai][bj][m][1];
                    const float a[8] = {I8 ? (float)__float_as_int(a0[0]) : a0[0], I8 ? (float)__float_as_int(a0[1]) : a0[1], I8 ? (float)__float_as_int(a0[2]) : a0[2], I8 ? (float)__float_as_int(a0[3]) : a0[3],
                                        I8 ? (float)__float_as_int(a1[0]) : a1[0], I8 ? (float)__float_as_int(a1[1]) : a1[1], I8 ? (float)__float_as_int(a1[2]) : a1[2], I8 ? (float)__float_as_int(a1[3]) : a1[3]};
                    float r[8];
#pragma unroll
                    for (int j = 0; j < 8; ++j) { r[j] = x[j] + fsigmoid(a[j] * zsc) * (e8[j] * rse * pn[j]); q += r[j] * r[j]; }
                    if (last) { *(gf32x4*)(XOUT + ro + col) = (f32x4){r[0], r[1], r[2], r[3]}; *(gf32x4*)(XOUT + ro + col + 4) = (f32x4){r[4], r[5], r[6], r[7]}; }
                    else { u32x4 w; w.x = cvt_pk_bf16(r[0], r[1]); w.y = cvt_pk_bf16(r[2], r[3]); w.z = cvt_pk_bf16(r[4], r[5]); w.w = cvt_pk_bf16(r[6], r[7]); *(gu32x4*)(XB + ablk(row, col, DM)) = w;
                        if (P1G_FP8) { u32x2 w8; w8.x = pack_fp8x4(r[0], r[1], r[2], r[3]); w8.y = pack_fp8x4(r[4], r[5], r[6], r[7]); *(gu32x2*)(XB8 + ablk8(row, col, DM)) = w8; } }
                }
                if (!last) { q += __shfl_xor(q, 16); q += __shfl_xor(q, 32); if (fq == 0) SSQN[(size_t)row * 64 + u.pn * 4 + wc] = q; }
                if (m & 1) asm volatile("" ::: "memory");
            }
    }
};
}

constexpr int LDS_BYTES = 163840;
constexpr int MISC_OFF = LDS_BYTES - 128;
constexpr int ARGS_OFF = LDS_BYTES - 512;
constexpr int NWAVES = 8, NTHREADS = 512;

struct Ctx {
    LAS unsigned char* lds; int tid, lane, wave, vcu, G, bx;
};

struct TrTile { const gfloat* W; const gfloat* kscale; gbf16* WT; int ldw, K; guchar* W8; const gunsigned* QS; };
constexpr int TR_PER_LAYER = 7808 + 1536 + 1024 + 1024 + 64;
__device__ __forceinline__ TrTile tr_decode(int it, const gfloat* w_in, const gfloat* norm_pre, const gfloat* w_branch, const gfloat* w_out, const gfloat* ple_gate, const gfloat* ple_proj, guchar* ws) {
    const int l = it / TR_PER_LAYER; int r = it - l * TR_PER_LAYER; TrTile t; int kt, ntile; t.W8 = nullptr; t.QS = nullptr;
    if (r < 7808) { kt = r / 244; ntile = r - kt * 244; const int src = ntile < 116 ? ntile * 128 : ntile * 128 + 8;
        if (ntile < 16) ntile = 2 * ntile; else if (ntile < 32) ntile = ntile + 16; else if (ntile < 48) ntile = 2 * (ntile - 32) + 1;
        const int oblk = (ntile >= 116 && ntile < 132) ? ntile - 116 : -1; if (ntile >= 132 && ntile < 148) ntile -= 16;
        t.ldw = N_IN; t.K = DM; t.W = w_in + (size_t)l * DM * N_IN + (size_t)kt * 128 * N_IN + src; t.kscale = norm_pre + l * DM + kt * 128;
        t.WT = (gbf16*)(ws + WS_WIN + (size_t)l * SZ_WIN) + ((size_t)(ntile >> 1) * (DM / 64) + (size_t)kt * 2) * 16384 + (size_t)(ntile & 1) * 128 * 64;
        if (ntile >= 148) t.W8 = ws + WS_WG8 + (size_t)l * SZ_WG8 + ((size_t)((ntile - 148) >> 1) * (DM / 128) + (size_t)kt) * 32768 + (size_t)(ntile & 1) * 128 * 128;
        if (oblk >= 0) t.W8 = ws + WS_WG8 + (size_t)l * SZ_WG8 + ((size_t)(48 + (oblk >> 1)) * (DM / 128) + (size_t)kt) * 32768 + (size_t)(oblk & 1) * 128 * 128;
        return t; }
    r -= 7808; t.kscale = nullptr; t.ldw = DM;
    if (r < 1536) { const int j = r / 512; const int rr = r - j * 512; kt = rr / 32; ntile = rr - kt * 32; t.K = BW;
        t.W = w_branch + ((size_t)(l * 3 + j) * BW + (size_t)kt * 128) * DM + ntile * 128;
        t.WT = (gbf16*)(ws + WS_WBR + (size_t)l * SZ_WBR) + (size_t)j * DM * BW + ((size_t)(ntile >> 1) * (BW / 64) + (size_t)kt * 2) * 16384 + (size_t)(ntile & 1) * 128 * 64; return t; }
    r -= 1536;
    if (r < 2048) { const int which = r / 1024; const int rr = r - which * 1024; kt = rr / 32; ntile = rr - kt * 32; t.K = DM;
        t.W = (which ? ple_gate : w_out) + ((size_t)l * DM + (size_t)kt * 128) * DM + ntile * 128;
        t.WT = (gbf16*)(ws + (which ? WS_WPG : WS_WOUT) + (size_t)l * SZ_WSQ) + ((size_t)(ntile >> 1) * (DM / 64) + (size_t)kt * 2) * 16384 + (size_t)(ntile & 1) * 128 * 64;
        if (P5_I8 && which) t.QS = (const gunsigned*)(ws + WS_CTL) + CW_WMAX + l;
        if ((P5_FP8 || P5_I8) && which) t.W8 = ws + WS_WPG + (size_t)l * SZ_WSQ + ((size_t)(ntile >> 1) * (DM / 128) + (size_t)kt) * 32768 + (size_t)(ntile & 1) * 128 * 128;
        return t; }
    r -= 2048; kt = r / 32; ntile = r - kt * 32; t.K = 256;
    t.W = ple_proj + ((size_t)l * 256 + (size_t)kt * 128) * DM + ntile * 128;
    t.WT = (gbf16*)(ws + WS_WPP + (size_t)l * SZ_WPP) + ((size_t)(ntile >> 1) * (256 / 64) + (size_t)kt * 2) * 16384 + (size_t)(ntile & 1) * 128 * 64; return t;
}
#ifndef TR_NTLOAD
#define TR_NTLOAD 0
#endif
#ifndef TR_REVERSE
#define TR_REVERSE 1
#endif
__device__ __forceinline__ void tr_run(const Ctx& F, int it0, int it1, int sk0, int sk1, int me, int nw, const gfloat* w_in, const gfloat* norm_pre, const gfloat* w_branch,
                                       const gfloat* w_out, const gfloat* ple_gate, const gfloat* ple_proj, guchar* ws) {
    int tid = F.tid; LAUNDER_V(tid);
    {
        constexpr int RS = 264; const int NIT = it1 - it0 - (sk1 - sk0);
        const int c4 = tid & 31, kr = tid >> 5, kc = tid & 15;
        f32x4 va[8], vb[8]; float ka[8], kb[8]; TrTile ta, tb;
#define TR_LOAD(T_, V_, K_, IT_) do { const int ir_ = TR_REVERSE ? (NIT - 1 - (IT_)) : (IT_); T_ = tr_decode(it0 + ir_ + (((it0 + ir_) >= sk0) ? (sk1 - sk0) : 0), w_in, norm_pre, w_branch, w_out, ple_gate, ple_proj, ws); \
        _Pragma("unroll") for (int i = 0; i < 8; ++i) { V_[i] = TR_NTLOAD ? __builtin_nontemporal_load((const gf32x4*)(T_.W + (size_t)(i * 16 + kr) * T_.ldw + 4 * c4)) : *(const gf32x4*)(T_.W + (size_t)(i * 16 + kr) * T_.ldw + 4 * c4); K_[i] = T_.kscale ? T_.kscale[i * 16 + kr] : 1.0f; } } while (0)
#define TR_PUT(V_, K_) do { _Pragma("unroll") for (int i = 0; i < 8; ++i) { const f32x4 a = V_[i] * K_[i]; u32x2 w; w.x = cvt_pk_bf16(a[0], a[1]); w.y = cvt_pk_bf16(a[2], a[3]); \
        *(LAS u32x2*)(F.lds + (i * 16 + kr) * RS + c4 * 8) = w; } } while (0)
#define TR_GET(WT_, W8_, QS_) do { _Pragma("unroll") for (int q = 0; q < 4; ++q) { const int n = 32 * q + (tid >> 4), kq = kc; \
        const LAS bf16_t* s = (const LAS bf16_t*)(F.lds + (8 * kq) * RS + 2 * n); unsigned e[8]; \
        _Pragma("unroll") for (int j = 0; j < 8; ++j) e[j] = s[j * (RS / 2)]; \
        if (QS_) { const float qs_ = 127.0f / fmaxf(__uint_as_float(*(QS_)), 1e-30f); u32x2 o8; \
            o8.x = pack_i8x4(__uint_as_float(e[0] << 16) * qs_, __uint_as_float(e[1] << 16) * qs_, __uint_as_float(e[2] << 16) * qs_, __uint_as_float(e[3] << 16) * qs_); \
            o8.y = pack_i8x4(__uint_as_float(e[4] << 16) * qs_, __uint_as_float(e[5] << 16) * qs_, __uint_as_float(e[6] << 16) * qs_, __uint_as_float(e[7] << 16) * qs_); \
            *(gu32x2*)((W8_) + n * 128 + 8 * kq) = o8; } \
        else if (W8_) { u32x2 o8; o8.x = pack_fp8x4(__uint_as_float(e[0] << 16) * W8_SCALE, __uint_as_float(e[1] << 16) * W8_SCALE, __uint_as_float(e[2] << 16) * W8_SCALE, __uint_as_float(e[3] << 16) * W8_SCALE); \
            o8.y = pack_fp8x4(__uint_as_float(e[4] << 16) * W8_SCALE, __uint_as_float(e[5] << 16) * W8_SCALE, __uint_as_float(e[6] << 16) * W8_SCALE, __uint_as_float(e[7] << 16) * W8_SCALE); \
            *(gu32x2*)((W8_) + n * 128 + 8 * kq) = o8; } \
        else { u32x4 o; o.x = e[0] | (e[1] << 16); o.y = e[2] | (e[3] << 16); o.z = e[4] | (e[5] << 16); o.w = e[6] | (e[7] << 16); \
        *(gu32x4*)(WT_ + (size_t)(kq >> 3) * 16384 + n * 64 + 8 * (kq & 7)) = o; } } } while (0)
        int it = me;
        if (it < NIT) TR_LOAD(ta, va, ka, it);
        if (it + nw < NIT) TR_LOAD(tb, vb, kb, it + nw);
        while (it < NIT) {
            { TR_PUT(va, ka); __syncthreads(); gbf16* wt = ta.WT; guchar* kk = ta.W8; const gunsigned* qp = ta.QS;
              if (it + 2 * nw < NIT) TR_LOAD(ta, va, ka, it + 2 * nw);
              TR_GET(wt, kk, qp); __syncthreads(); }
            it += nw; if (it >= NIT) break;
            { TR_PUT(vb, kb); __syncthreads(); gbf16* wt = tb.WT; guchar* kk = tb.W8; const gunsigned* qp = tb.QS;
              if (it + 2 * nw < NIT) TR_LOAD(tb, vb, kb, it + 2 * nw);
              TR_GET(wt, kk, qp); __syncthreads(); }
            it += nw;
        }
#undef TR_LOAD
#undef TR_PUT
#undef TR_GET
    }
}
#ifndef TR_NODEFER
#define TR_NODEFER 0
#endif
#ifndef TR_L1TAIL
#define TR_L1TAIL (1024 + 1536)
#endif
constexpr int TR_PG0 = 7808 + 1536 + 1024, TR_PG1 = TR_PER_LAYER + TR_PG0;
constexpr int TR_DEFER0 = TR_PER_LAYER + 7808 + 1536, TR_DEFER1 = TR_DEFER0 + (TR_NODEFER ? 0 : 2048);
__device__ __forceinline__ void p0_prologue(const Ctx& F, const gfloat* x, const gfloat* p, const gint* positions, const gfloat* norm_pre, const gfloat* w_in, const gfloat* w_branch,
                                            const gfloat* w_out, const gfloat* ple_gate, const gfloat* ple_proj, guchar* ws) {
    int tid = F.tid; LAUNDER_V(tid);
#if P5_I8
    tr_run(F, 0, TR_PG1 - TR_L1TAIL, TR_PG0, TR_PG0 + 1024, F.vcu, F.G, w_in, norm_pre, w_branch, w_out, ple_gate, ple_proj, ws);
    tr_run(F, TR_PG1 + 1024, NLAYER * TR_PER_LAYER, 0x7fffffff, 0x7fffffff, F.vcu, F.G, w_in, norm_pre, w_branch, w_out, ple_gate, ple_proj, ws);
    { const int gt_ = F.vcu * NTHREADS + tid, NGT_ = F.G * NTHREADS;
      for (int l = 0; l < NLAYER; ++l) { const gf32x4* wp = (const gf32x4*)(ple_gate + (size_t)l * DM * DM); float mx = 0.f;
          for (int i0 = gt_; i0 < DM * DM / 4; i0 += 8 * NGT_) { f32x4 a[8];
#pragma unroll
              for (int j = 0; j < 8; ++j) { const int i = i0 + j * NGT_; a[j] = wp[i < DM * DM / 4 ? i : i0]; }
#pragma unroll
              for (int j = 0; j < 8; ++j) mx = fmaxf(mx, fmaxf(fmaxf(fabsf(a[j][0]), fabsf(a[j][1])), fmaxf(fabsf(a[j][2]), fabsf(a[j][3])))); }
#pragma unroll
          for (int s = 32; s >= 1; s >>= 1) mx = fmaxf(mx, __shfl_xor(mx, s));
          if (F.lane == 0) atomicMax((unsigned*)((gunsigned*)(ws + WS_CTL) + CW_WMAX + l), __float_as_uint(mx)); } }
#else
    tr_run(F, 0, NLAYER * TR_PER_LAYER, TR_DEFER0, TR_DEFER1, F.vcu, F.G, w_in, norm_pre, w_branch, w_out, ple_gate, ple_proj, ws);
#endif
    const int gt = F.vcu * NTHREADS + tid, NGT = F.G * NTHREADS;
    for (int i = gt; i < NLAYER * 256 * DM; i += NGT) { const int l = i / (256 * DM), rr = (i / DM) & 255, k = i & (DM - 1);
        float val = 0.f; if (rr < 8) val = w_in[(size_t)l * DM * N_IN + (size_t)k * N_IN + IF_COL + rr] * norm_pre[l * DM + k];
        ((gbf16*)(ws + WS_WIN + (size_t)l * SZ_WIN))[((size_t)122 * (DM / 64) + (k >> 6)) * 16384 + rr * 64 + (k & 63)] = (bf16_t)(cvt_pk_bf16(val, 0.f) & 0xffffu); }
    for (int i = gt; i < NLAYER * M_ROWS * 256 / 4; i += NGT) { const f32x4 a = ((const gf32x4*)p)[i]; u32x2 w; w.x = cvt_pk_bf16(a[0], a[1]); w.y = cvt_pk_bf16(a[2], a[3]);
        const int l = i / (M_ROWS * 64), r = (i >> 6) & (M_ROWS - 1), c = (i & 63) * 4; *(gu32x2*)((gbf16*)(ws + WS_PB) + (size_t)l * M_ROWS * 256 + ablk(r, c, 256)) = w; }
    for (int i = gt; i < M_ROWS * 8; i += NGT) { const int row = i >> 3, j = i & 7; const float inv = powf(500000.0f, -(float)j * 0.125f); const float ang = (float)positions[row] * inv;
        gfloat* cs = (gfloat*)(ws + WS_CS) + (size_t)row * 16; cs[j] = cosf(ang); cs[8 + j] = sinf(ang); }
    { const int gw = F.vcu * NWAVES + F.wave, NGW = F.G * NWAVES;
      for (int m = gw; m < M_ROWS; m += NGW) { const gf32x4* xr = (const gf32x4*)(x + (size_t)m * DM) + F.lane; gbf16* o = (gbf16*)(ws + WS_XB); float s = 0.f;
#pragma unroll
          for (int j = 0; j < 16; ++j) { const f32x4 a = xr[64 * j]; s += (a[0] * a[0] + a[1] * a[1]) + (a[2] * a[2] + a[3] * a[3]); u32x2 w; w.x = cvt_pk_bf16(a[0], a[1]); w.y = cvt_pk_bf16(a[2], a[3]); *(gu32x2*)(o + ablk(m, (F.lane + 64 * j) * 4, DM)) = w;
              if (P1G_FP8) *(gunsigned*)(ws + WS_XB8 + ablk8(m, (F.lane + 64 * j) * 4, DM)) = pack_fp8x4(a[0], a[1], a[2], a[3]); }
          s = wave_sum(s); if (F.lane == 0) ((gfloat*)(ws + WS_SSQ0))[m] = s; } }
}

__device__ __forceinline__ u32x2 pack4(const f32x4 v) { u32x2 w; w.x = cvt_pk_bf16(v[0], v[1]); w.y = cvt_pk_bf16(v[2], v[3]); return w; }
__device__ __forceinline__ bf16x8 mk_frag(const u32x2 lo, const u32x2 hi) { const u32x4 t = {lo.x, lo.y, hi.x, hi.y}; return __builtin_bit_cast(bf16x8, t); }
__device__ __forceinline__ bf16x8 frag_const(unsigned w) { const u32x4 t = {w, w, w, w}; return __builtin_bit_cast(bf16x8, t); }

constexpr int GM_RS = 288, GM_WL = 0, GM_VT = 128 * GM_RS, GM_ST = GM_VT + 256 * GM_RS;
__device__ __forceinline__ void gmlp_unit(const Ctx& F, int b, int n, int g, guchar* ws, const gfloat* ln_g, const gfloat* ln_b, const gfloat* wsp, const gfloat* bsp) {
    int tid = F.tid; LAUNDER_V(tid); const int lane = tid & 63, w = F.wave, r16 = lane & 15, q4 = lane >> 4;
    const int row0 = b * SEQ + n * 128, c0 = g * 256;
    const gbf16* AU = (const gbf16*)(ws + WS_AU); const gbf16* AV = (const gbf16*)(ws + WS_AV); gbf16* YA = (gbf16*)(ws + WS_YA);
    u32x4 raw[8];
#pragma unroll
    for (int k = 0; k < 8; ++k) { const int item = tid + 512 * k, s = item & 127, ch = item >> 7; raw[k] = *(const gu32x4*)(AV + tb256(row0 + s, c0 + 8 * ch, 8)); }
    f32x4 wt[8];
#pragma unroll
    for (int k = 0; k < 8; ++k) { const int item = tid + 512 * k, t = item >> 5, ch = item & 31; wt[k] = *(const gf32x4*)(wsp + ((size_t)(g * 128 + t)) * 128 + 4 * ch); }
    { const gf32x4* pp = (const gf32x4*)(ws + WS_LNP) + (size_t)(row0 + (tid & 127)) * 16 + (tid >> 7) * 4; float s = 0.f, q = 0.f;
#pragma unroll
        for (int j = 0; j < 4; ++j) { const f32x4 t = pp[j]; s += t[0] + t[2]; q += t[1] + t[3]; }
        *(LAS f32x2*)(F.lds + GM_ST + 1024 + ((tid >> 7) * 128 + (tid & 127)) * 8) = (f32x2){s, q}; }
#pragma unroll
    for (int k = 0; k < 8; ++k) { const int item = tid + 512 * k, t = item >> 5, ch = item & 31; f32x4 a = wt[k];
#pragma unroll
        for (int e = 0; e < 4; ++e) if (4 * ch + e > t) a[e] = 0.f;
        *(LAS u32x2*)(F.lds + GM_WL + t * GM_RS + ch * 8) = pack4(a); }
    __syncthreads();
    if (tid < 128) { float s = 0.f, q = 0.f;
#pragma unroll
        for (int j = 0; j < 4; ++j) { const f32x2 t = *(const LAS f32x2*)(F.lds + GM_ST + 1024 + (j * 128 + tid) * 8); s += t.x; q += t.y; }
        const float mu = s * (1.0f / BW); const float var = fmaxf(q * (1.0f / BW) - mu * mu, 0.f);
        *(LAS f32x2*)(F.lds + GM_ST + tid * 8) = (f32x2){mu, rsqrtf(var + NORM_EPS)}; }
    __syncthreads();
#pragma unroll
    for (int k = 0; k < 8; ++k) { const int item = tid + 512 * k, s = item & 127, ch = item >> 7;
        const f32x4 g0 = *(const gf32x4*)(ln_g + c0 + 8 * ch), g1 = *(const gf32x4*)(ln_g + c0 + 8 * ch + 4), b0 = *(const gf32x4*)(ln_b + c0 + 8 * ch), b1 = *(const gf32x4*)(ln_b + c0 + 8 * ch + 4);
        const f32x2 st = *(const LAS f32x2*)(F.lds + GM_ST + s * 8);
        const float xv[8] = {bf_lo(raw[k].x), bf_hi(raw[k].x), bf_lo(raw[k].y), bf_hi(raw[k].y), bf_lo(raw[k].z), bf_hi(raw[k].z), bf_lo(raw[k].w), bf_hi(raw[k].w)};
        const float gg[8] = {g0[0], g0[1], g0[2], g0[3], g1[0], g1[1], g1[2], g1[3]}, bb[8] = {b0[0], b0[1], b0[2], b0[3], b1[0], b1[1], b1[2], b1[3]};
#pragma unroll
        for (int i = 0; i < 8; ++i) { const float y = (xv[i] - st.x) * st.y * gg[i] + bb[i];
            *(LAS bf16_t*)(F.lds + GM_VT + (8 * ch + i) * GM_RS + 2 * s) = (bf16_t)(cvt_pk_bf16(y, 0.f) & 0xffffu); } }
    u32x4 ub[8]; float bsv[8];
#pragma unroll
    for (int n8 = 0; n8 < 8; ++n8) { const int t = 16 * n8 + r16; ub[n8] = *(const gu32x4*)(AU + tb128(row0 + t, c0 + 32 * w + 8 * q4, 16)); bsv[n8] = bsp[g * 128 + t]; }
    __syncthreads();
    f32x4 acc[2][8];
#pragma unroll
    for (int m = 0; m < 2; ++m)
#pragma unroll
        for (int n8 = 0; n8 < 8; ++n8) acc[m][n8] = (f32x4){0.f, 0.f, 0.f, 0.f};
    bf16x8 af[2][4];
#pragma unroll
    for (int m = 0; m < 2; ++m)
#pragma unroll
        for (int ks = 0; ks < 4; ++ks) af[m][ks] = *(const LAS bf16x8*)(F.lds + GM_VT + (32 * w + 8 * (r16 >> 2) + 4 * m + (r16 & 3)) * GM_RS + ks * 64 + q4 * 16);
#pragma unroll
    for (int n8 = 0; n8 < 8; ++n8)
#pragma unroll
        for (int ks = 0; ks < 4; ++ks) if (ks <= n8 / 2) {
            const bf16x8 bfr = *(const LAS bf16x8*)(F.lds + GM_WL + (16 * n8 + r16) * GM_RS + ks * 64 + q4 * 16);
#pragma unroll
            for (int m = 0; m < 2; ++m) acc[m][n8] = MFMA16(af[m][ks], bfr, acc[m][n8]); }
#pragma unroll
    for (int n8 = 0; n8 < 8; ++n8) { const int t = 16 * n8 + r16; const size_t roy = ablk(row0 + t, c0 + 32 * w + 8 * q4, BW);
        const f32x4 a0 = acc[0][n8] + bsv[n8], a1 = acc[1][n8] + bsv[n8]; u32x4 y;
        y.x = cvt_pk_bf16(a0[0] * bf_lo(ub[n8].x), a0[1] * bf_hi(ub[n8].x)); y.y = cvt_pk_bf16(a0[2] * bf_lo(ub[n8].y), a0[3] * bf_hi(ub[n8].y));
        y.z = cvt_pk_bf16(a1[0] * bf_lo(ub[n8].z), a1[1] * bf_hi(ub[n8].z)); y.w = cvt_pk_bf16(a1[2] * bf_lo(ub[n8].w), a1[3] * bf_hi(ub[n8].w));
        *(gu32x4*)(YA + roy) = y; }
    __syncthreads();
}

constexpr int SW_RS = 160, SW_VS = 528, SW_KL = 0, SW_VT = 256 * SW_RS, SW_QL = SW_VT + 64 * SW_VS, SW_QL2 = SW_QL + 128 * SW_RS, SW_CS = SW_QL2 + 128 * SW_RS;
static_assert(SW_CS + 384 * 64 <= ARGS_OFF, "SWA LDS map");
__device__ __forceinline__ void rope8(const u32x4 a, const u32x4 bq, const gfloat* cs, float scale, u32x4& o1, u32x4& o2) {
    const f32x4 c0 = *(const gf32x4*)cs, c1 = *(const gf32x4*)(cs + 4), s0 = *(const gf32x4*)(cs + 8), s1 = *(const gf32x4*)(cs + 12);
    const float t1[8] = {bf_lo(a.x), bf_hi(a.x), bf_lo(a.y), bf_hi(a.y), bf_lo(a.z), bf_hi(a.z), bf_lo(a.w), bf_hi(a.w)};
    const float t2[8] = {bf_lo(bq.x), bf_hi(bq.x), bf_lo(bq.y), bf_hi(bq.y), bf_lo(bq.z), bf_hi(bq.z), bf_lo(bq.w), bf_hi(bq.w)};
    const float cc[8] = {c0[0], c0[1], c0[2], c0[3], c1[0], c1[1], c1[2], c1[3]}, ss[8] = {s0[0], s0[1], s0[2], s0[3], s1[0], s1[1], s1[2], s1[3]};
    float r1[8], r2[8];
#pragma unroll
    for (int i = 0; i < 8; ++i) { r1[i] = (t1[i] * cc[i] - t2[i] * ss[i]) * scale; r2[i] = (t2[i] * cc[i] + t1[i] * ss[i]) * scale; }
    o1 = (u32x4){cvt_pk_bf16(r1[0], r1[1]), cvt_pk_bf16(r1[2], r1[3]), cvt_pk_bf16(r1[4], r1[5]), cvt_pk_bf16(r1[6], r1[7])};
    o2 = (u32x4){cvt_pk_bf16(r2[0], r2[1]), cvt_pk_bf16(r2[2], r2[3]), cvt_pk_bf16(r2[4], r2[5]), cvt_pk_bf16(r2[6], r2[7])};
}
__device__ __forceinline__ u32x4 scale8(const u32x4 a, float sc) {
    return (u32x4){cvt_pk_bf16(bf_lo(a.x) * sc, bf_hi(a.x) * sc), cvt_pk_bf16(bf_lo(a.y) * sc, bf_hi(a.y) * sc), cvt_pk_bf16(bf_lo(a.z) * sc, bf_hi(a.z) * sc), cvt_pk_bf16(bf_lo(a.w) * sc, bf_hi(a.w) * sc)};
}
__device__ __forceinline__ void swa_unit(const Ctx& F, int b, int n, int hk, guchar* ws, const gfloat* sinks) {
    int tid = F.tid; LAUNDER_V(tid); const int lane = tid & 63, w = F.wave, r16 = lane & 15, q4 = lane >> 4;
    const int r0 = b * SEQ + n * 128, kr0 = r0 - 128;
    const gbf16* BQ = (const gbf16*)(ws + WS_BQ); const gbf16* BK = (const gbf16*)(ws + WS_BK); const gbf16* BV = (const gbf16*)(ws + WS_BV); const gbf16* BZ = (const gbf16*)(ws + WS_BZ);
    gbf16* YB = (gbf16*)(ws + WS_YA) + (size_t)M_ROWS * BW; const gfloat* CS = (const gfloat*)(ws + WS_CS);
    const int kch = tid & 7;
    u32x4 kraw[4], vraw[4]; f32x4 csr[3]; u32x4 qa[2];
#pragma unroll
    for (int k = 0; k < 4; ++k) { const int key = (tid + 512 * k) >> 3; const bool pad = (n == 0 && key < 128);
        kraw[k] = *(const gu32x4*)(BK + (size_t)(pad ? r0 : kr0 + key) * 256 + hk * 64 + 8 * kch); }
#pragma unroll
    for (int k = 0; k < 4; ++k) { const int item = tid + 512 * k, key = item & 255, ch = item >> 8; const bool pad = (n == 0 && key < 128);
        vraw[k] = *(const gu32x4*)(BV + (size_t)(pad ? r0 : kr0 + key) * 256 + hk * 64 + 8 * ch); }
#pragma unroll
    for (int k = 0; k < 3; ++k) { const int item = tid + 512 * k, r = item >> 2, part = item & 3; const int row = r < 256 ? ((n == 0 && r < 128) ? r0 : kr0 + r) : r0 + r - 256;
        csr[k] = *(const gf32x4*)(CS + (size_t)row * 16 + part * 4); }
#define SW_QLOAD(hq_) do { _Pragma("unroll") for (int k_ = 0; k_ < 2; ++k_) { const int qr_ = (tid + 512 * k_) >> 3; qa[k_] = *(const gu32x4*)(BQ + tb256(r0 + qr_, (hq_) * 64, 8) + 8 * kch); } } while (0)
    SW_QLOAD(hk * 8);
#pragma unroll
    for (int k = 0; k < 3; ++k) { const int item = tid + 512 * k; *(LAS f32x4*)(F.lds + SW_CS + item * 16) = csr[k]; }
#pragma unroll
    for (int k = 0; k < 4; ++k) { const int item = tid + 512 * k, key = item & 255, ch = item >> 8; const bool pad = (n == 0 && key < 128);
        const u32x4 raw = pad ? (u32x4){0u, 0u, 0u, 0u} : vraw[k]; const unsigned e[4] = {raw.x, raw.y, raw.z, raw.w};
#pragma unroll
        for (int i = 0; i < 8; ++i) *(LAS bf16_t*)(F.lds + SW_VT + (8 * ch + i) * SW_VS + 2 * key) = (bf16_t)((e[i >> 1] >> ((i & 1) * 16)) & 0xffffu); }
    __syncthreads();
#define SW_PUT(raw_, csrow_, dst_, scale_) do { const u32x4 own_ = (raw_); u32x4 par_; \
        par_.x = (unsigned)__builtin_amdgcn_update_dpp(0, (int)own_.x, 0xB1, 0xf, 0xf, false); par_.y = (unsigned)__builtin_amdgcn_update_dpp(0, (int)own_.y, 0xB1, 0xf, 0xf, false); \
        par_.z = (unsigned)__builtin_amdgcn_update_dpp(0, (int)own_.z, 0xB1, 0xf, 0xf, false); par_.w = (unsigned)__builtin_amdgcn_update_dpp(0, (int)own_.w, 0xB1, 0xf, 0xf, false); \
        u32x4 o_; \
        if (kch < 2) { const LAS float* cs_ = (const LAS float*)(F.lds + SW_CS + (csrow_) * 64); \
            const f32x4 c0_ = *(const LAS f32x4*)cs_, c1_ = *(const LAS f32x4*)(cs_ + 4), s0_ = *(const LAS f32x4*)(cs_ + 8), s1_ = *(const LAS f32x4*)(cs_ + 12); \
            const float sg_ = kch == 0 ? -(scale_) : (scale_); \
            const float t_[8] = {bf_lo(own_.x), bf_hi(own_.x), bf_lo(own_.y), bf_hi(own_.y), bf_lo(own_.z), bf_hi(own_.z), bf_lo(own_.w), bf_hi(own_.w)}; \
            const float u_[8] = {bf_lo(par_.x), bf_hi(par_.x), bf_lo(par_.y), bf_hi(par_.y), bf_lo(par_.z), bf_hi(par_.z), bf_lo(par_.w), bf_hi(par_.w)}; \
            const float cc_[8] = {c0_[0], c0_[1], c0_[2], c0_[3], c1_[0], c1_[1], c1_[2], c1_[3]}, ss_[8] = {s0_[0], s0_[1], s0_[2], s0_[3], s1_[0], s1_[1], s1_[2], s1_[3]}; \
            float r_[8]; _Pragma("unroll") for (int i_ = 0; i_ < 8; ++i_) r_[i_] = (t_[i_] * cc_[i_]) * (scale_) + (u_[i_] * ss_[i_]) * sg_; \
            o_ = (u32x4){cvt_pk_bf16(r_[0], r_[1]), cvt_pk_bf16(r_[2], r_[3]), cvt_pk_bf16(r_[4], r_[5]), cvt_pk_bf16(r_[6], r_[7])}; } \
        else o_ = ((scale_) == 1.0f) ? own_ : scale8(own_, (scale_)); \
        *(LAS u32x4*)((dst_) + kch * 16) = o_; } while (0)
#pragma unroll
    for (int k = 0; k < 4; ++k) { const int key = (tid + 512 * k) >> 3; const bool pad = (n == 0 && key < 128);
        const u32x4 kz = pad ? (u32x4){0u, 0u, 0u, 0u} : kraw[k]; SW_PUT(kz, key, F.lds + SW_KL + key * SW_RS, 1.0f); }
#define SW_QWRITE(buf_) do { _Pragma("unroll") for (int k_ = 0; k_ < 2; ++k_) { const int qr_ = (tid + 512 * k_) >> 3; SW_PUT(qa[k_], 256 + qr_, F.lds + (buf_) + qr_ * SW_RS, 0.125f); } } while (0)
    SW_QWRITE(SW_QL);
    __syncthreads();
    for (int hi = 0; hi < 8; ++hi) {
        const int hq = hk * 8 + hi; const int qcur = (hi & 1) ? SW_QL2 : SW_QL, qnxt = (hi & 1) ? SW_QL : SW_QL2;
        SW_QLOAD((hi < 7 ? hq + 1 : hq));
        const u32x4 zb0 = *(const gu32x4*)(BZ + tb256(r0 + 16 * w + r16, hq * 64 + 8 * q4, 8)), zb1 = *(const gu32x4*)(BZ + tb256(r0 + 16 * w + r16, hq * 64 + 8 * q4 + 32, 8));
        bf16x8 bq[2];
#pragma unroll
        for (int ks = 0; ks < 2; ++ks) bq[ks] = *(const LAS bf16x8*)(F.lds + qcur + (16 * w + r16) * SW_RS + ks * 64 + q4 * 16);
        f32x4 s[10];
#pragma unroll
        for (int j = 0; j < 9; ++j) { s[j] = (f32x4){0.f, 0.f, 0.f, 0.f};
#pragma unroll
            for (int ks = 0; ks < 2; ++ks) { const bf16x8 a = *(const LAS bf16x8*)(F.lds + SW_KL + (16 * (w + j) + r16) * SW_RS + ks * 64 + q4 * 16); s[j] = MFMA16(a, bq[ks], s[j]); } }
        s[9] = (f32x4){0.f, 0.f, 0.f, 0.f};
        const int qi = 16 * w + r16; const float sink = sinks[hq]; float mx = sink;
#pragma unroll
        for (int j = 0; j < 9; ++j)
#pragma unroll
            for (int e = 0; e < 4; ++e) { const int kj = 16 * (w + j) + 4 * q4 + e; const bool valid = (kj > qi) && (kj <= qi + 128) && (n > 0 || kj >= 128);
                s[j][e] = valid ? s[j][e] : -1e30f; mx = fmaxf(mx, s[j][e]); }
        mx = fmaxf(mx, __shfl_xor(mx, 16)); mx = fmaxf(mx, __shfl_xor(mx, 32));
        float sum = 0.f;
#pragma unroll
        for (int j = 0; j < 9; ++j)
#pragma unroll
            for (int e = 0; e < 4; ++e) { const float pv = (s[j][e] > -1e29f) ? __expf(s[j][e] - mx) : 0.f; s[j][e] = pv; sum += pv; }
        sum += __shfl_xor(sum, 16); sum += __shfl_xor(sum, 32); sum += __expf(sink - mx);
        const float inv = 1.0f / sum;
        f32x4 o[4];
#pragma unroll
        for (int dt = 0; dt < 4; ++dt) o[dt] = (f32x4){0.f, 0.f, 0.f, 0.f};
#pragma unroll
        for (int kk = 0; kk < 5; ++kk) { const bf16x8 pf = mk_frag(pack4(s[2 * kk]), pack4(s[2 * kk + 1]));
            const int t0 = w + 2 * kk, t1 = (w + 2 * kk + 1) > 15 ? 15 : (w + 2 * kk + 1);
#pragma unroll
            for (int dt = 0; dt < 4; ++dt) { const LAS unsigned char* vrow = F.lds + SW_VT + (32 * (dt >> 1) + 8 * (r16 >> 2) + 4 * (dt & 1) + (r16 & 3)) * SW_VS + (4 * q4) * 2;
                const bf16x8 a = mk_frag(*(const LAS u32x2*)(vrow + 32 * t0), *(const LAS u32x2*)(vrow + 32 * t1)); o[dt] = MFMA16(a, pf, o[dt]); } }
        const size_t ro = (size_t)(r0 + qi) * BW + hq * 64 + 8 * q4;
#pragma unroll
        for (int pp = 0; pp < 2; ++pp) { const u32x4 zb = pp ? zb1 : zb0; const f32x4 oa = o[2 * pp] * inv, ob2 = o[2 * pp + 1] * inv; u32x4 y;
            y.x = cvt_pk_bf16(oa[0] * bf_lo(zb.x), oa[1] * bf_hi(zb.x)); y.y = cvt_pk_bf16(oa[2] * bf_lo(zb.y), oa[3] * bf_hi(zb.y));
            y.z = cvt_pk_bf16(ob2[0] * bf_lo(zb.z), ob2[1] * bf_hi(zb.z)); y.w = cvt_pk_bf16(ob2[2] * bf_lo(zb.w), ob2[3] * bf_hi(zb.w));
            *(gu32x4*)(YB + ablk(r0 + qi, hq * 64 + 8 * q4 + 32 * pp, BW)) = y; }
        SW_QWRITE(qnxt);
        __syncthreads();
    }
#undef SW_QLOAD
#undef SW_QWRITE
#undef SW_PUT
}

#ifndef ML_R1A
#define ML_R1A 1
#endif
#ifndef ML_R1B
#define ML_R1B 1
#endif
#ifndef ML_RWR
#define ML_RWR 1
#endif
constexpr int ML_RS = 544, ML_TS = 144, ML_WS = 160, ML_GSZ = 1344;
constexpr int ML_QL = 0, ML_KA = 64 * ML_RS, ML_KB = 2 * 64 * ML_RS, ML_VT = 3 * 64 * ML_RS, ML_VW = ML_VT + 32 * ML_TS, ML_VW2 = ML_VW + 33 * ML_WS, ML_CT = ML_VW2 + 33 * ML_WS, ML_X = ML_CT + 33 * ML_RS, ML_GATE = ML_X + 64 * 144;
static_assert(ML_GATE + 2 * ML_GSZ <= ARGS_OFF, "mLSTM LDS map");
typedef short s16x4 __attribute__((ext_vector_type(4)));
__device__ __forceinline__ bf16x8 tr_frag8(const LAS unsigned char* img, int rs, int row0, int col0, int r16) {
    const LAS unsigned char* p0 = img + (row0 + (r16 >> 2)) * rs + (col0 + 4 * (r16 & 3)) * 2;
    const s16x4 a = __builtin_amdgcn_ds_read_tr16_b64_v4i16((LAS s16x4*)p0);
    const s16x4 b = __builtin_amdgcn_ds_read_tr16_b64_v4i16((LAS s16x4*)(p0 + 4 * rs));
    return __builtin_shufflevector(a, b, 0, 1, 2, 3, 4, 5, 6, 7);
}
__device__ __forceinline__ float dpp_shr(float v, float ident, int n) {
    const int r = n == 1 ? __builtin_amdgcn_update_dpp(__float_as_int(ident), __float_as_int(v), 0x111, 0xf, 0xf, false)
                : n == 2 ? __builtin_amdgcn_update_dpp(__float_as_int(ident), __float_as_int(v), 0x112, 0xf, 0xf, false)
                : n == 4 ? __builtin_amdgcn_update_dpp(__float_as_int(ident), __float_as_int(v), 0x114, 0xf, 0xf, false)
                         : __builtin_amdgcn_update_dpp(__float_as_int(ident), __float_as_int(v), 0x118, 0xf, 0xf, false);
    return __int_as_float(r);
}
__device__ __forceinline__ float wave_scan_add(float v, int lane) {
    v += dpp_shr(v, 0.f, 1); v += dpp_shr(v, 0.f, 2); v += dpp_shr(v, 0.f, 4); v += dpp_shr(v, 0.f, 8);
    const float t0 = __int_as_float(__builtin_amdgcn_readlane(__float_as_int(v), 15)), t1 = __int_as_float(__builtin_amdgcn_readlane(__float_as_int(v), 31)), t2 = __int_as_float(__builtin_amdgcn_readlane(__float_as_int(v), 47));
    const int row = lane >> 4; const float add = row == 0 ? 0.f : (row == 1 ? t0 : (row == 2 ? t0 + t1 : (t0 + t1) + t2));
    return v + add;
}
__device__ __forceinline__ float wave_scan_max(float v, int lane) {
    const float NI = -3.0e38f;
    v = fmaxf(v, dpp_shr(v, NI, 1)); v = fmaxf(v, dpp_shr(v, NI, 2)); v = fmaxf(v, dpp_shr(v, NI, 4)); v = fmaxf(v, dpp_shr(v, NI, 8));
    const float t0 = __int_as_float(__builtin_amdgcn_readlane(__float_as_int(v), 15)), t1 = __int_as_float(__builtin_amdgcn_readlane(__float_as_int(v), 31)), t2 = __int_as_float(__builtin_amdgcn_readlane(__float_as_int(v), 47));
    const int row = lane >> 4; const float mx = row == 0 ? NI : (row == 1 ? t0 : (row == 2 ? fmaxf(t0, t1) : fmaxf(fmaxf(t0, t1), t2)));
    return fmaxf(v, mx);
}
__device__ __forceinline__ float softcap15(float z) { const float e = __expf(z * (2.0f / 15.0f)); return 15.0f * (1.0f - 2.0f * __builtin_amdgcn_rcpf(e + 1.0f)); }
__device__ __forceinline__ void mlstm_unit(const Ctx& F, int b, int h, int sl, guchar* ws, const gfloat* ibp, const gfloat* fbp, const gfloat* norm_g) {
    int tid = F.tid; LAUNDER_V(tid); const int lane = tid & 63, w = F.wave, r16 = lane & 15, q4 = lane >> 4;
    const gbf16* CQ = (const gbf16*)(ws + WS_CQ); const gbf16* CK = (const gbf16*)(ws + WS_CK); const gbf16* CV = (const gbf16*)(ws + WS_CV);
    const gbf16* CO = (const gbf16*)(ws + WS_CO); const gbf16* CZs = (const gbf16*)(ws + WS_CZ);
    const gfloat* IFB = (const gfloat*)(ws + WS_IF);
    gbf16* NUM = (gbf16*)(ws + WS_NUM) + h * 512 + sl * 32; gfloat* SSQC = (gfloat*)(ws + WS_SSQC); gfloat* DNB = (gfloat*)(ws + WS_DN);
    const int rowb = b * SEQ;
    const bf16x8 ones = frag_const(0x3f803f80u), zeros = frag_const(0u);
    for (int i = tid; i < 33 * ML_RS / 16; i += NTHREADS) *(LAS u32x4*)(F.lds + ML_CT + i * 16) = (u32x4){0u, 0u, 0u, 0u};
    f32x4 st[2][3];
#pragma unroll
    for (int i = 0; i < 2; ++i)
#pragma unroll
        for (int dt = 0; dt < 3; ++dt) st[i][dt] = (f32x4){0.f, 0.f, 0.f, 0.f};
    float m_prev = 0.f;
    const float ibv = ibp[h], fbv = fbp[h];
    const f32x4 ng0 = *(const gf32x4*)(norm_g + h * 512 + sl * 32 + 4 * q4), ng1 = *(const gf32x4*)(norm_g + h * 512 + sl * 32 + 16 + 4 * q4);
    u32x4 qra[4], kra[4], vra; float gi = 0.f, gf = 0.f;
#define ML_LOAD(c, Q_, K_, V_) do { const int rc_ = rowb + (c) * 64; _Pragma("unroll") for (int k_ = 0; k_ < 4; ++k_) { const int it_ = tid + 512 * k_, s_ = it_ >> 5, ch_ = it_ & 31; \
        Q_[k_] = *(const gu32x4*)(CQ + tb256(rc_ + s_, h * 256 + 8 * ch_, 4)); K_[k_] = *(const gu32x4*)(CK + tb256(rc_ + s_, h * 256 + 8 * ch_, 4)); } \
        V_ = *(const gu32x4*)(CV + tb256(rc_ + ((tid & 255) >> 2), h * 512 + sl * 32 + 8 * (tid & 3), 8)); } while (0)
#define ML_GLOAD(c) do { const int r_ = rowb + (c) * 64 + lane; gi = IFB[(size_t)r_ * 8 + h]; gf = IFB[(size_t)r_ * 8 + 4 + h]; } while (0)
#define ML_GPREP(par) do { if (w == 7) { const float ig_ = softcap15(gi + ibv); const float z_ = softcap15(gf + fbv); \
        const float lf_ = -(fmaxf(-z_, 0.f) + log1pf(__expf(-fabsf(z_)))); const float bc_ = wave_scan_add(lf_, lane); const float u_ = ig_ - bc_; const float pm_ = wave_scan_max(u_, lane); \
        const float Mv_ = fmaxf(m_prev, pm_); const float M63_ = __int_as_float(__builtin_amdgcn_readlane(__float_as_int(Mv_), 63)); const float g_ = __int_as_float(__builtin_amdgcn_readlane(__float_as_int(bc_), 63)); \
        LAS float* gp_ = (LAS float*)(F.lds + ML_GATE + (par) * ML_GSZ); gp_[lane] = u_; gp_[64 + lane] = Mv_; gp_[128 + lane] = __expf(m_prev - Mv_); gp_[192 + lane] = __expf(-(bc_ + Mv_)); \
        gp_[256 + lane] = __expf(u_ - M63_); if (lane == 0) gp_[320] = __expf(m_prev - M63_); m_prev = g_ + M63_; } } while (0)
#define ML_WRITE(kb_, vw_, gpn_, Q_, K_, V_) do { _Pragma("unroll") for (int k_ = 0; k_ < 4; ++k_) { const int it_ = tid + 512 * k_, s_ = it_ >> 5, ch_ = it_ & 31; \
        *(LAS u32x4*)(F.lds + ML_QL + s_ * ML_RS + ch_ * 16) = Q_[k_]; *(LAS u32x4*)(F.lds + (kb_) + s_ * ML_RS + ch_ * 16) = K_[k_]; } \
        if (tid < 256) { const int s_ = tid >> 2, ch_ = tid & 3; const unsigned e_[4] = {V_.x, V_.y, V_.z, V_.w}; const float ws_ = (gpn_)[256 + s_]; \
            _Pragma("unroll") for (int i_ = 0; i_ < 8; ++i_) { const unsigned hv_ = (e_[i_ >> 1] >> ((i_ & 1) * 16)) & 0xffffu; \
                *(LAS bf16_t*)(F.lds + ML_VT + (8 * ch_ + i_) * ML_TS + 2 * s_) = (bf16_t)hv_; \
                *(LAS bf16_t*)(F.lds + (vw_) + (8 * ch_ + i_) * ML_WS + 2 * s_) = (bf16_t)(cvt_pk_bf16(__uint_as_float(hv_ << 16) * ws_, 0.f) & 0xffffu); } \
            if (ch_ == 0) *(LAS bf16_t*)(F.lds + (vw_) + 32 * ML_WS + 2 * s_) = (bf16_t)(cvt_pk_bf16(ws_, 0.f) & 0xffffu); } } while (0)
    ML_LOAD(0, qra, kra, vra); ML_GLOAD(0);
    ML_GPREP(0);
    ML_GLOAD(1);
    __syncthreads();
    ML_WRITE(ML_KA, ML_VW, ((const LAS float*)(F.lds + ML_GATE)), qra, kra, vra);
    __syncthreads();
#define ML_STEP(c, LQ_, LK_, LV_, WQ_, WK_, WV_) do { \
        const int par = c & 1; const LAS float* gp = (const LAS float*)(F.lds + ML_GATE + par * ML_GSZ); \
        const int vt = ML_VT, kb = par ? ML_KB : ML_KA, kbn = par ? ML_KA : ML_KB, vw = par ? ML_VW2 : ML_VW, vwn = par ? ML_VW : ML_VW2; \
        const LAS float* gpn = (const LAS float*)(F.lds + ML_GATE + (par ^ 1) * ML_GSZ); \
        const int rowc = rowb + c * 64; \
        const size_t rog_ = tb256(rowc + 16 * (w & 3) + r16, h * 512 + sl * 32 + 4 * q4, 8); \
        const u32x2 ob0 = *(const gu32x2*)(CO + rog_), ob1 = *(const gu32x2*)(CO + rog_ + 16), zb0 = *(const gu32x2*)(CZs + rog_), zb1 = *(const gu32x2*)(CZs + rog_ + 16); \
        ML_LOAD((c + 1 < 32 ? c + 1 : 31), LQ_, LK_, LV_); if (c + 1 < 32) ML_GPREP(par ^ 1); ML_GLOAD((c + 2 < 32 ? c + 2 : 31)); \
        f32x4 oacc[3]; \
        for (int rp_ = 0; rp_ < ML_R1B; ++rp_) { \
        _Pragma("unroll") \
        for (int dt = 0; dt < 3; ++dt) oacc[dt] = (f32x4){0.f, 0.f, 0.f, 0.f}; \
        if (w < 4) { \
            const int T = w; \
            bf16x8 bq[8]; \
        _Pragma("unroll") \
            for (int ks = 0; ks < 8; ++ks) bq[ks] = *(const LAS bf16x8*)(F.lds + ML_QL + (16 * T + r16) * ML_RS + ks * 64 + q4 * 16); \
            f32x4 sa[4]; \
        _Pragma("unroll") \
            for (int s4 = 0; s4 < 4; ++s4) { sa[s4] = (f32x4){0.f, 0.f, 0.f, 0.f}; \
                if (s4 <= T) { \
        _Pragma("unroll") \
                    for (int ks = 0; ks < 8; ++ks) { const bf16x8 a = *(const LAS bf16x8*)(F.lds + kb + (16 * s4 + r16) * ML_RS + ks * 64 + q4 * 16); sa[s4] = MFMA16(a, bq[ks], sa[s4]); } } } \
            const int tl = 16 * T + r16; const float Mt = gp[64 + tl]; \
        _Pragma("unroll") \
            for (int s4 = 0; s4 < 4; ++s4) { const f32x4 uu = *(const LAS f32x4*)(gp + 16 * s4 + 4 * q4); \
        _Pragma("unroll") \
                for (int e = 0; e < 4; ++e) { const int sl_ = 16 * s4 + 4 * q4 + e; sa[s4][e] = (sl_ <= tl) ? sa[s4][e] * __expf(uu[e] - Mt) : 0.f; } } \
        _Pragma("unroll") \
            for (int kk = 0; kk < 2; ++kk) { const bf16x8 pf = mk_frag(pack4(sa[2 * kk]), pack4(sa[2 * kk + 1])); \
        _Pragma("unroll") \
                for (int dt = 0; dt < 3; ++dt) { bf16x8 a; \
                    if (dt < 2) { const LAS unsigned char* vp = F.lds + vt + (16 * dt + r16) * ML_TS + (32 * kk + 4 * q4) * 2; a = mk_frag(*(const LAS u32x2*)vp, *(const LAS u32x2*)(vp + 32)); } \
                    else a = (r16 == 0) ? ones : zeros; \
                    oacc[dt] = MFMA16(a, pf, oacc[dt]); } } \
        } else { \
            const int T = w - 4; f32x4 ia[3]; \
        _Pragma("unroll") \
            for (int dt = 0; dt < 3; ++dt) ia[dt] = (f32x4){0.f, 0.f, 0.f, 0.f}; \
        _Pragma("unroll") \
            for (int ks = 0; ks < 8; ++ks) { const bf16x8 bqv = *(const LAS bf16x8*)(F.lds + ML_QL + (16 * T + r16) * ML_RS + ks * 64 + q4 * 16); \
        _Pragma("unroll") \
                for (int dt = 0; dt < 3; ++dt) { bf16x8 a; \
                    if (dt < 2) a = *(const LAS bf16x8*)(F.lds + ML_CT + (16 * dt + r16) * ML_RS + ks * 64 + q4 * 16); \
                    else { a = *(const LAS bf16x8*)(F.lds + ML_CT + 32 * ML_RS + ks * 64 + q4 * 16); if (r16 != 0) a = zeros; } \
                    ia[dt] = MFMA16(a, bqv, ia[dt]); } } \
            const int tl = 16 * T + r16; \
            *(LAS f32x4*)(F.lds + ML_X + tl * 144 + (4 * q4) * 4) = ia[0]; *(LAS f32x4*)(F.lds + ML_X + tl * 144 + (16 + 4 * q4) * 4) = ia[1]; \
            if (q4 == 0) *(LAS f32x4*)(F.lds + ML_X + tl * 144 + 32 * 4) = ia[2]; \
        } \
        } \
        __syncthreads(); \
        if (w < 4) { \
            const int tl = 16 * w + r16; const float at = gp[128 + tl], en = gp[192 + tl]; \
            const f32x4 x0 = *(const LAS f32x4*)(F.lds + ML_X + tl * 144 + (4 * q4) * 4), x1 = *(const LAS f32x4*)(F.lds + ML_X + tl * 144 + (16 + 4 * q4) * 4); \
            const float xd = *(const LAS float*)(F.lds + ML_X + tl * 144 + 32 * 4); \
            const f32x4 n0 = oacc[0] + x0 * at, n1 = oacc[1] + x1 * at; \
            float den = oacc[2][0] + xd * at; den = __shfl(den, r16); \
            float sq = (n0[0] * n0[0] + n0[1] * n0[1]) + (n0[2] * n0[2] + n0[3] * n0[3]) + (n1[0] * n1[0] + n1[1] * n1[1]) + (n1[2] * n1[2] + n1[3] * n1[3]); \
            sq += __shfl_xor(sq, 16); sq += __shfl_xor(sq, 32); \
            const size_t ro = (size_t)(rowc + tl) * BW + 4 * q4; \
            f32x4 t0, t1; \
            t0[0] = n0[0] * ng0[0] * (bf_lo(ob0.x) * bf_lo(zb0.x)); t0[1] = n0[1] * ng0[1] * (bf_hi(ob0.x) * bf_hi(zb0.x)); t0[2] = n0[2] * ng0[2] * (bf_lo(ob0.y) * bf_lo(zb0.y)); t0[3] = n0[3] * ng0[3] * (bf_hi(ob0.y) * bf_hi(zb0.y)); \
            t1[0] = n1[0] * ng1[0] * (bf_lo(ob1.x) * bf_lo(zb1.x)); t1[1] = n1[1] * ng1[1] * (bf_hi(ob1.x) * bf_hi(zb1.x)); t1[2] = n1[2] * ng1[2] * (bf_lo(ob1.y) * bf_lo(zb1.y)); t1[3] = n1[3] * ng1[3] * (bf_hi(ob1.y) * bf_hi(zb1.y)); \
            *(gu32x2*)(NUM + ro) = pack4(t0); *(gu32x2*)(NUM + ro + 16) = pack4(t1); \
            if (q4 == 0) { SSQC[(size_t)(rowc + tl) * 64 + h * 16 + sl] = sq; if (sl == 0) DNB[(size_t)(rowc + tl) * 4 + h] = fmaxf(fabsf(den), en); } \
        } \
        { const float dec = gp[320]; \
        _Pragma("unroll") \
          for (int i = 0; i < 2; ++i) \
        _Pragma("unroll") \
              for (int dt = 0; dt < 3; ++dt) st[i][dt] = st[i][dt] * dec; \
        _Pragma("unroll") \
          for (int kk = 0; kk < 2; ++kk) { bf16x8 a[2], bv[3]; \
        _Pragma("unroll") \
              for (int i = 0; i < 2; ++i) a[i] = tr_frag8(F.lds + kb, ML_RS, 32 * kk + 8 * q4, 32 * w + 16 * i, r16); \
        _Pragma("unroll") \
              for (int dt = 0; dt < 2; ++dt) bv[dt] = *(const LAS bf16x8*)(F.lds + vw + (16 * dt + r16) * ML_WS + kk * 64 + q4 * 16); \
              bv[2] = *(const LAS bf16x8*)(F.lds + vw + 32 * ML_WS + kk * 64 + q4 * 16); if (r16 != 0) bv[2] = zeros; \
        _Pragma("unroll") \
              for (int i = 0; i < 2; ++i) \
        _Pragma("unroll") \
                  for (int dt = 0; dt < 3; ++dt) st[i][dt] = MFMA16(a[i], bv[dt], st[i][dt]); } \
        _Pragma("unroll") \
          for (int i = 0; i < 2; ++i) { \
        _Pragma("unroll") \
              for (int dt = 0; dt < 2; ++dt) *(LAS u32x2*)(F.lds + ML_CT + (16 * dt + r16) * ML_RS + (32 * w + 16 * i + 4 * q4) * 2) = pack4(st[i][dt]); \
              if (r16 == 0) *(LAS u32x2*)(F.lds + ML_CT + 32 * ML_RS + (32 * w + 16 * i + 4 * q4) * 2) = pack4(st[i][2]); } } \
        for (int rp_ = 0; rp_ < ML_RWR; ++rp_) if (c + 1 < 32) ML_WRITE(kbn, vwn, gpn, WQ_, WK_, WV_); \
        __syncthreads(); \
    } while (0)
    for (int c2 = 0; c2 < 32; ++c2) { ML_STEP(c2, qra, kra, vra, qra, kra, vra); }
#undef ML_LOAD
#undef ML_GLOAD
#undef ML_GPREP
#undef ML_WRITE
#undef ML_STEP
}

__device__ __forceinline__ void p2b_finalize(const Ctx& F, guchar* ws) {
    int lane = F.lane; LAUNDER_V(lane); const int gw = F.vcu * NWAVES + F.wave, NGW = F.G * NWAVES;
    const gbf16* NUM = (const gbf16*)(ws + WS_NUM); gbf16* YC = (gbf16*)(ws + WS_YA) + (size_t)2 * M_ROWS * BW;
    for (int m = gw; m < M_ROWS; m += NGW) {
        float s = ((const gfloat*)(ws + WS_SSQC))[(size_t)m * 64 + lane];
        s += __shfl_xor(s, 1); s += __shfl_xor(s, 2); s += __shfl_xor(s, 4); s += __shfl_xor(s, 8);
        const float dn = ((const gfloat*)(ws + WS_DN))[(size_t)m * 4 + (lane >> 4)];
        const float inv = 1.0f / dn; const float sc = inv * rsqrtf(s * (1.0f / 512.0f) * inv * inv + NORM_EPS);
#pragma unroll
        for (int it = 0; it < 4; ++it) { const float f = __shfl(sc, 16 * it); const size_t o = (size_t)m * BW + (size_t)(it * 64 + lane) * 8;
            const u32x4 nb = *(const gu32x4*)(NUM + o); u32x4 y;
            y.x = cvt_pk_bf16(bf_lo(nb.x) * f, bf_hi(nb.x) * f); y.y = cvt_pk_bf16(bf_lo(nb.y) * f, bf_hi(nb.y) * f);
            y.z = cvt_pk_bf16(bf_lo(nb.z) * f, bf_hi(nb.z) * f); y.w = cvt_pk_bf16(bf_lo(nb.w) * f, bf_hi(nb.w) * f);
            *(gu32x4*)(YC + ablk(m, (it * 64 + lane) * 8, BW)) = y; }
    }
}
__device__ __forceinline__ void p5b_ssq(const Ctx& F, guchar* ws) {
    int lane = F.lane; LAUNDER_V(lane); const int gw = F.vcu * NWAVES + F.wave, NGW = F.G * NWAVES;
    for (int m = gw; m < M_ROWS; m += NGW) { const float s = wave_sum(((const gfloat*)(ws + WS_XSP))[(size_t)m * 64 + lane]); if (lane == 0) ((gfloat*)(ws + WS_CTL + CTL_SSQ1))[m] = s; }
}
__device__ __forceinline__ void p4b_x1(const Ctx& F, guchar* ws, const gfloat* npost) {
    int lane = F.lane; LAUNDER_V(lane); const int gw = F.vcu * NWAVES + F.wave, NGW = F.G * NWAVES;
    const gbf16* OUT = (const gbf16*)(ws + WS_OUT); const gbf16* XB = (const gbf16*)(ws + WS_XB); gbf16* X1B = (gbf16*)(ws + WS_X1B);
    for (int m = gw; m < M_ROWS; m += NGW) {
        const float so = wave_sum(((const gfloat*)(ws + WS_OUTP))[(size_t)m * 64 + lane]), se = wave_sum(((const gfloat*)(ws + WS_ERP))[(size_t)m * 64 + lane]);
        const float rso = rsqrtf(so * (1.0f / DM) + NORM_EPS), rse = rsqrtf(se * (1.0f / DM) + NORM_EPS);
        if (lane == 0) { ((gfloat*)(ws + WS_RSO))[m] = rso; ((gfloat*)(ws + WS_RSE))[m] = rse; }
        u32x4 yv[8]; float mx = 0.f;
#pragma unroll
        for (int it = 0; it < 8; ++it) { const int c = (it * 64 + lane) * 8; const size_t o = (size_t)m * DM + c;
            const u32x4 xb = *(const gu32x4*)(XB + ablk(m, c, DM)), ob = *(const gu32x4*)(OUT + o); const f32x4 n0 = *(const gf32x4*)(npost + c), n1 = *(const gf32x4*)(npost + c + 4); u32x4 y;
            y.x = cvt_pk_bf16(bf_lo(xb.x) + bf_lo(ob.x) * rso * n0[0], bf_hi(xb.x) + bf_hi(ob.x) * rso * n0[1]);
            y.y = cvt_pk_bf16(bf_lo(xb.y) + bf_lo(ob.y) * rso * n0[2], bf_hi(xb.y) + bf_hi(ob.y) * rso * n0[3]);
            y.z = cvt_pk_bf16(bf_lo(xb.z) + bf_lo(ob.z) * rso * n1[0], bf_hi(xb.z) + bf_hi(ob.z) * rso * n1[1]);
            y.w = cvt_pk_bf16(bf_lo(xb.w) + bf_lo(ob.w) * rso * n1[2], bf_hi(xb.w) + bf_hi(ob.w) * rso * n1[3]);
            *(gu32x4*)(X1B + ablk(m, c, DM)) = y; yv[it] = y;
            mx = fmaxf(mx, fmaxf(fmaxf(fmaxf(fabsf(bf_lo(y.x)), fabsf(bf_hi(y.x))), fmaxf(fabsf(bf_lo(y.y)), fabsf(bf_hi(y.y)))), fmaxf(fmaxf(fabsf(bf_lo(y.z)), fabsf(bf_hi(y.z))), fmaxf(fabsf(bf_lo(y.w)), fabsf(bf_hi(y.w))))));
#if P5_FP8
            { u32x2 y8; y8.x = pack_fp8x4(bf_lo(y.x), bf_hi(y.x), bf_lo(y.y), bf_hi(y.y)); y8.y = pack_fp8x4(bf_lo(y.z), bf_hi(y.z), bf_lo(y.w), bf_hi(y.w)); *(gu32x2*)(ws + WS_X1B8 + ablk8(m, c, DM)) = y8; }
#endif
            }
#if P5_I8
#pragma unroll
        for (int s = 32; s >= 1; s >>= 1) mx = fmaxf(mx, __shfl_xor(mx, s));
        mx = fmaxf(mx, 1e-30f); const float qs = 127.0f / mx;
        if (lane == 0) ((gfloat*)(ws + WS_RSX))[m] = mx * (1.0f / 127.0f);
#pragma unroll
        for (int it = 0; it < 8; ++it) { const int c = (it * 64 + lane) * 8; const u32x4 y = yv[it]; u32x2 y8;
            y8.x = pack_i8x4(bf_lo(y.x) * qs, bf_hi(y.x) * qs, bf_lo(y.y) * qs, bf_hi(y.y) * qs); y8.y = pack_i8x4(bf_lo(y.z) * qs, bf_hi(y.z) * qs, bf_lo(y.w) * qs, bf_hi(y.w) * qs);
            *(gu32x2*)(ws + WS_X1B8 + ablk8(m, c, DM)) = y8; }
#endif
    }
}

#ifndef P1_ROT
#define P1_ROT 0
#endif
#ifndef P1_WGM
#define P1_WGM 4
#endif
#ifndef REP_P0
#define REP_P0 1
#endif
#ifndef REP_P1
#define REP_P1 1
#endif
#ifndef REP_ML
#define REP_ML 1
#endif
#ifndef REP_SW
#define REP_SW 1
#endif
#ifndef REP_GM
#define REP_GM 1
#endif
#ifndef REP_P3
#define REP_P3 1
#endif
#ifndef REP_THIN
#define REP_THIN 1
#endif
#ifndef REP_BAR
#define REP_BAR 1
#endif
#ifndef REP_P4
#define REP_P4 1
#endif
__device__ __forceinline__ unsigned long long arg_ld(LAS unsigned char* lds, int i) {
    unsigned a = (unsigned)(ARGS_OFF + 8 * i); asm volatile("" : "+v"(a));
    const volatile LAS unsigned* q = (const volatile LAS unsigned*)(lds + a);
    const unsigned lo = q[0], hi = q[1];
    return ((unsigned long long)(unsigned)__builtin_amdgcn_readfirstlane((int)hi) << 32) | (unsigned)__builtin_amdgcn_readfirstlane((int)lo);
}
struct Args { const void* in[19]; float* out; unsigned char* ws; };
static_assert(sizeof(Args) == 21 * 8, "no padding in Args");

__global__ void __launch_bounds__(NTHREADS, 2) fwd_kernel(Args args) {
    extern __shared__ __attribute__((aligned(16))) unsigned char lds_raw[];
    Ctx F; F.lds = (LAS unsigned char*)lds_raw; F.tid = threadIdx.x; F.lane = F.tid & 63; F.wave = __builtin_amdgcn_readfirstlane(F.tid >> 6);
    F.G = gridDim.x; F.bx = blockIdx.x; { const int bx = blockIdx.x; F.vcu = (F.G % 8 == 0) ? (bx % 8) * (F.G / 8) + bx / 8 : bx; }
    guchar* ws0 = (guchar*)args.ws;
#define WSL() ({ guchar* w_ = ws0; LAUNDER_S(w_); w_; })
    volatile LAS unsigned* MISC = (volatile LAS unsigned*)(F.lds + MISC_OFF);
    if (F.tid < 32) MISC[F.tid] = 0u;
    __syncthreads();
    const XcdBarrier bar = xcd_barrier_post((unsigned*)(ws0 + WS_CTL) + CW_BAR, MISC);

    if (F.tid < 19) ((LAS unsigned long long*)(F.lds + ARGS_OFF))[F.tid] = (unsigned long long)args.in[F.tid];
    if (F.tid == 19) ((LAS unsigned long long*)(F.lds + ARGS_OFF))[19] = (unsigned long long)args.out;
    __syncthreads();
#define ARGP(T, i) ((T)arg_ld(F.lds, (i)))

#define FL() ({ Ctx f_ = F; LAUNDER_S(f_.lds); LAUNDER_S(f_.wave); LAUNDER_S(f_.vcu); LAUNDER_S(f_.G); LAUNDER_S(f_.bx); f_; })
#ifndef SKIP_P0
    for (int rep_ = 0; rep_ < REP_P0; ++rep_) { const Ctx Fp = FL(); guchar* ws = WSL(); p0_prologue(FL(), ARGP(const gfloat*, 0), ARGP(const gfloat*, 1), ARGP(const gint*, 2), ARGP(const gfloat*, 3), ARGP(const gfloat*, 4), ARGP(const gfloat*, 13), ARGP(const gfloat*, 14), ARGP(const gfloat*, 18), ARGP(const gfloat*, 16), ws); }
#endif
    for (int rb_ = 0; rb_ < REP_BAR; ++rb_) xcd_barrier(bar);

    auto layer_body = [&](const int l) __attribute__((always_inline)) {
#ifndef NT_BF
#define NT_BF (P1G_FP8 ? 67 : NT_IN)
#endif
#ifndef P1_LOCK
#define P1_LOCK 0
#endif
#ifndef SKIP_P1
        for (int rep_ = 0; rep_ < REP_P1; ++rep_) { const Ctx Fp = FL(); guchar* ws = WSL(); const gfloat* ssq = l == 0 ? (const gfloat*)(ws + WS_SSQ0) : (const gfloat*)(ws + WS_CTL + CTL_SSQ1);
          const int rowbase = (Fp.G == 256 && P1_WGM == 4 && P1_ROT == 0) ? (Fp.bx & 7) * 1024 : -1; LAS float* rtab = (LAS float*)(Fp.lds + 132096);
          if (rowbase >= 0) { int ti_ = threadIdx.x; LAUNDER_V(ti_); const float s0_ = ssq[rowbase + ti_], s1_ = ssq[rowbase + 512 + ti_]; rtab[ti_] = rsqrtf(s0_ * (1.0f / DM) + NORM_EPS); rtab[512 + ti_] = rsqrtf(s1_ * (1.0f / DM) + NORM_EPS); __syncthreads(); }
#if P1G_FP8
          { pg8::SchedPlain S; S.T.init(M_ROWS / 256, 56, Fp.G, Fp.bx, P1_WGM, P1_ROT, -1, 74); S.pn0 = 74; S.A = (const gchar*)(ws + WS_XB8); S.B = (const gchar*)(ws + WS_WG8 + (size_t)l * SZ_WG8);
            S.astep = (size_t)256 * DM; S.bstep = (size_t)256 * DM;
            pg8::EpiInT<true> E{ssq, ws, rtab, rowbase};
            pg8::gemm_phase<pg8::EpiInT<true>, pg8::SchedPlain>(Fp.lds, DM / 2, DM, DM, S, E); }
          { pg8::SchedPlain S; S.T.init(M_ROWS / 256, NT_BF, Fp.G, Fp.bx, P1_WGM, P1_ROT, 122, 0); S.A = (const gchar*)(ws + WS_XB); S.B = (const gchar*)(ws + WS_WIN + (size_t)l * SZ_WIN);
            S.astep = (size_t)256 * DM * 2; S.bstep = (size_t)256 * DM * 2;
            pg8::EpiIn E{ssq, ws, rtab, rowbase};
            pg8::gemm_phase<pg8::EpiIn, pg8::SchedPlain>(Fp.lds, DM, DM, DM, S, E, (unsigned*)(ws + WS_CTL) + 256 + 64 * l, P1_LOCK); }
#else
          { pg8::SchedPlain S; S.T.init(M_ROWS / 256, NT_IN, Fp.G, Fp.bx, P1_WGM, P1_ROT); S.A = (const gchar*)(ws + WS_XB); S.B = (const gchar*)(ws + WS_WIN + (size_t)l * SZ_WIN);
            S.astep = (size_t)256 * DM * 2; S.bstep = (size_t)256 * DM * 2;
            pg8::EpiIn E{ssq, ws, rtab, rowbase};
            pg8::gemm_phase<pg8::EpiIn, pg8::SchedPlain>(Fp.lds, DM, DM, DM, S, E, (unsigned*)(ws + WS_CTL) + 256 + 64 * l, P1_LOCK); }
#endif
        }
#ifdef PROBE_P1CHEAP
        { const Ctx Fp = FL(); guchar* ws = WSL(); pg8::SchedPlain S; S.T.init(M_ROWS / 256, NT_IN, Fp.G, Fp.bx); S.A = (const gchar*)(ws + WS_XB); S.B = (const gchar*)(ws + WS_WIN + (size_t)l * SZ_WIN);
          S.astep = (size_t)256 * DM * 2; S.bstep = (size_t)256 * DM * 2;
          pg8::EpiSq E{(gbf16*)(ws + WS_END), (gfloat*)(ws + WS_END + (size_t)M_ROWS * 31488 * 2)};
          pg8::gemm_phase<pg8::EpiSq, pg8::SchedPlain>(Fp.lds, DM, DM, DM, S, E); }
#endif
        { const Ctx Fq = FL(); const int nwg_ = (M_ROWS / 256) * NT_BF, rem_ = nwg_ % Fq.G;
          if (rem_ == 0 || Fq.bx >= rem_) { const int me = rem_ ? Fq.bx - rem_ : Fq.bx, nw = rem_ ? Fq.G - rem_ : Fq.G;
            { const Ctx Fp = FL(); guchar* ws = WSL(); pg8::SchedPlain S; S.T.init(M_ROWS / 256, DM / 256, nw, me); S.A = (const gchar*)(ws + WS_PB + (size_t)l * M_ROWS * 256 * 2); S.B = (const gchar*)(ws + WS_WPP + (size_t)l * SZ_WPP);
              S.astep = (size_t)256 * 256 * 2; S.bstep = (size_t)256 * 256 * 2;
              pg8::EpiSq E{(gbf16*)(ws + WS_ERAW), (gfloat*)(ws + WS_ERP)};
              pg8::gemm_phase<pg8::EpiSq, pg8::SchedPlain>(Fp.lds, 256, 256, 256, S, E); }
            if (l == 1 && P5_I8 && TR_L1TAIL) tr_run(FL(), TR_PG1 - TR_L1TAIL, TR_PG1, 0x7fffffff, 0x7fffffff, me, nw, ARGP(const gfloat*, 4), ARGP(const gfloat*, 3), ARGP(const gfloat*, 13), ARGP(const gfloat*, 14), ARGP(const gfloat*, 18), ARGP(const gfloat*, 16), WSL());
            if (l == 0) tr_run(FL(), P5_I8 ? TR_PG0 : TR_DEFER0, P5_I8 ? TR_PG1 + 1024 : TR_DEFER1, P5_I8 ? TR_PG0 + 1024 : 0x7fffffff, P5_I8 ? TR_PG1 : 0x7fffffff, me, nw, ARGP(const gfloat*, 4), ARGP(const gfloat*, 3), ARGP(const gfloat*, 13), ARGP(const gfloat*, 14), ARGP(const gfloat*, 18), ARGP(const gfloat*, 16), WSL()); } }
#endif
#ifdef PROBE_DELAY
        if (((F.bx & 7) < 4) == (PROBE_DELAY == 1)) { const unsigned long long t0_ = __builtin_amdgcn_s_memrealtime(); while (__builtin_amdgcn_s_memrealtime() - t0_ < 3000ull) __builtin_amdgcn_s_sleep(8); }
#endif
        for (int rb_ = 0; rb_ < REP_BAR; ++rb_) xcd_barrier(bar);
#ifndef SKIP_ML
        for (int rep_ = 0; rep_ < REP_ML; ++rep_) { const Ctx Fp = FL(); guchar* ws = WSL(); for (int u = Fp.vcu; u < 256; u += Fp.G) mlstm_unit(Fp, u >> 6, (u >> 4) & 3, u & 15, ws, ARGP(const gfloat*, 10) + l * 4, ARGP(const gfloat*, 11) + l * 4, ARGP(const gfloat*, 12) + l * BW); }
#endif
#ifndef SKIP_SW
        for (int rep_ = 0; rep_ < REP_SW; ++rep_) { const Ctx Fp = FL(); guchar* ws = WSL(); for (int u = Fp.vcu; u < 256; u += Fp.G) swa_unit(Fp, u >> 6, (u >> 2) & 15, u & 3, ws, ARGP(const gfloat*, 9) + l * 32); }
#endif
#ifndef SKIP_GM
        for (int rep_ = 0; rep_ < REP_GM; ++rep_) { const Ctx Fp = FL(); guchar* ws = WSL(); for (int u = Fp.vcu; u < 512; u += Fp.G) gmlp_unit(Fp, u >> 7, (u >> 3) & 15, u & 7, ws, ARGP(const gfloat*, 5) + l * BW, ARGP(const gfloat*, 6) + l * BW, ARGP(const gfloat*, 7) + (size_t)l * 8 * 128 * 128, ARGP(const gfloat*, 8) + l * 8 * 128); }
#endif
        for (int rb_ = 0; rb_ < REP_BAR; ++rb_) xcd_barrier(bar);
#ifndef SKIP_P2B
        for (int rep_ = 0; rep_ < REP_THIN; ++rep_) p2b_finalize(FL(), WSL());
#endif
        for (int rb_ = 0; rb_ < REP_BAR; ++rb_) xcd_barrier(bar);
#ifndef PROBE_NOSTORE
#define PROBE_NOSTORE 0
#endif
#ifdef PROBE_K1024
        for (int rep_ = 0; rep_ < 4; ++rep_) { const Ctx Fp = FL(); guchar* ws = WSL(); pg8::SchedPlain S; S.T.init(M_ROWS / 256, DM / 256, Fp.G, Fp.bx); S.A = (const gchar*)(ws + WS_YA); S.B = (const gchar*)(ws + WS_WOUT + (size_t)l * SZ_WSQ);
          S.astep = (size_t)256 * DM * 2; S.bstep = (size_t)256 * DM * 2;
          pg8::EpiSq E{PROBE_NOSTORE ? (gbf16*)nullptr : (gbf16*)(ws + WS_END), (gfloat*)(ws + WS_END + (size_t)M_ROWS * 31488 * 2)};
          pg8::gemm_phase<pg8::EpiSq, pg8::SchedPlain>(Fp.lds, 1024, DM, DM, S, E); }
#endif
#ifdef PROBE_P3CHEAP
        { const Ctx Fp = FL(); guchar* ws = WSL(); pg8::SchedBranch S; S.T.init(M_ROWS / 256, DM / 256, Fp.G, Fp.bx); S.A = (const gchar*)(ws + WS_YA); S.B = (const gchar*)(ws + WS_WBR + (size_t)l * SZ_WBR);
          S.astep = (size_t)256 * BW * 2; S.bstep = (size_t)256 * BW * 2; S.aseg = SZ_ROWS_BW; S.bseg = (size_t)DM * BW * 2;
          pg8::EpiSq E{(gbf16*)(ws + WS_END), (gfloat*)(ws + WS_END + (size_t)M_ROWS * 31488 * 2)};
          pg8::gemm_phase<pg8::EpiSq, pg8::SchedBranch>(Fp.lds, BW, BW, BW, S, E); }
#endif
#ifndef SKIP_P3
        for (int rep_ = 0; rep_ < REP_P3; ++rep_) { const Ctx Fp = FL(); guchar* ws = WSL(); pg8::SchedBranch S; S.T.init(M_ROWS / 256, DM / 256, Fp.G, Fp.bx); S.A = (const gchar*)(ws + WS_YA); S.B = (const gchar*)(ws + WS_WBR + (size_t)l * SZ_WBR);
          S.astep = (size_t)256 * BW * 2; S.bstep = (size_t)256 * BW * 2; S.aseg = SZ_ROWS_BW; S.bseg = (size_t)DM * BW * 2;
          pg8::EpiBranch E{(const guchar*)(ws + WS_G), (gbf16*)(ws + WS_MIX)};
          pg8::gemm_phase<pg8::EpiBranch, pg8::SchedBranch>(Fp.lds, BW, BW, BW, S, E); }
#endif
        for (int rb_ = 0; rb_ < REP_BAR; ++rb_) xcd_barrier(bar);
#ifndef SKIP_P4
        for (int rep_ = 0; rep_ < REP_P4; ++rep_) { const Ctx Fp = FL(); guchar* ws = WSL(); pg8::SchedPlain S; S.T.init(M_ROWS / 256, DM / 256, Fp.G, Fp.bx); S.A = (const gchar*)(ws + WS_MIX); S.B = (const gchar*)(ws + WS_WOUT + (size_t)l * SZ_WSQ);
          S.astep = (size_t)256 * DM * 2; S.bstep = (size_t)256 * DM * 2;
          pg8::EpiSq E{(gbf16*)(ws + WS_OUT), (gfloat*)(ws + WS_OUTP)};
          pg8::gemm_phase<pg8::EpiSq, pg8::SchedPlain>(Fp.lds, DM, DM, DM, S, E); }
#endif
        for (int rb_ = 0; rb_ < REP_BAR; ++rb_) xcd_barrier(bar);
#ifndef SKIP_P4B
        for (int rep_ = 0; rep_ < REP_THIN; ++rep_) p4b_x1(FL(), WSL(), ARGP(const gfloat*, 15) + l * DM);
#endif
        for (int rb_ = 0; rb_ < REP_BAR; ++rb_) xcd_barrier(bar);
#ifndef SKIP_P5
        { const Ctx Fp = FL(); guchar* ws = WSL(); pg8::SchedPlain S; S.T.init(M_ROWS / 256, DM / 256, Fp.G, Fp.bx); S.A = (const gchar*)(ws + ((P5_FP8 || P5_I8) ? WS_X1B8 : WS_X1B)); S.B = (const gchar*)(ws + WS_WPG + (size_t)l * SZ_WSQ);
          S.astep = (size_t)256 * DM * ((P5_FP8 || P5_I8) ? 1 : 2); S.bstep = (size_t)256 * DM * ((P5_FP8 || P5_I8) ? 1 : 2);
          pg8::EpiPle E{(const gbf16*)(ws + WS_X1B), ARGP(gfloat*, 19), (gbf16*)(ws + WS_XB), (const gbf16*)(ws + WS_ERAW), (const gfloat*)(ws + WS_RSE), ARGP(const gfloat*, 17) + l * DM, (gfloat*)(ws + WS_XSP), l == NLAYER - 1 ? 1 : 0, ws + WS_XB8, (const gfloat*)(ws + WS_RSX), __uint_as_float(((const gunsigned*)(ws + WS_CTL))[CW_WMAX + l]) * (1.0f / 127.0f)};
          pg8::gemm_phase<pg8::EpiPle, pg8::SchedPlain>(Fp.lds, (P5_FP8 || P5_I8) ? DM / 2 : DM, DM, DM, S, E); }
#endif
        if (l + 1 < NLAYER) { for (int rb_ = 0; rb_ < REP_BAR; ++rb_) xcd_barrier(bar); p5b_ssq(FL(), WSL()); for (int rb_ = 0; rb_ < REP_BAR; ++rb_) xcd_barrier(bar); }
    };
    static_assert(NLAYER == 2, "two layer bodies");
    layer_body(0); layer_body(1);
}

extern "C" void kernel_launch(void* const* d_in, const int* in_sizes, int n_in, void* d_out, int out_size, void* d_ws, size_t ws_size, hipStream_t stream) {
    static int grid = 0;
    if (grid == 0) {
        if (n_in != 19 || out_size != M_ROWS * DM || ws_size < WS_END) { fprintf(stderr, "kernel_launch: unexpected problem (n_in %d, out %d, ws %zu, need %zu)\n", n_in, out_size, ws_size, (size_t)WS_END); grid = -1; return; }
        int dev = 0, cus = 0;
        if (hipGetDevice(&dev) != hipSuccess || hipDeviceGetAttribute(&cus, hipDeviceAttributeMultiprocessorCount, dev) != hipSuccess) { grid = -1; return; }
        if (hipFuncSetAttribute((const void*)fwd_kernel, hipFuncAttributeMaxDynamicSharedMemorySize, LDS_BYTES) != hipSuccess) { fprintf(stderr, "kernel_launch: hipFuncSetAttribute failed\n"); grid = -1; return; }
        int per_cu = 0; (void)hipOccupancyMaxActiveBlocksPerMultiprocessor(&per_cu, (const void*)fwd_kernel, NTHREADS, LDS_BYTES); (void)hipGetLastError();
        if (per_cu < 1) fprintf(stderr, "kernel_launch: occupancy query reports %d blocks per CU\n", per_cu);
        grid = cus > 256 ? 256 : cus;
    }
    if (grid < 0) return;
    (void)hipMemsetAsync((char*)d_ws + WS_CTL, 0, CTL_ZERO_BYTES, stream);
    Args a{};
    for (int i = 0; i < 19; ++i) a.in[i] = d_in[i];
    a.out = (float*)d_out; a.ws = (unsigned char*)d_ws;
    hipLaunchKernelGGL(fwd_kernel, dim3(grid), dim3(NTHREADS), LDS_BYTES, stream, a);
    const hipError_t le = hipPeekAtLastError();
    if (le != hipSuccess) fprintf(stderr, "kernel_launch: launch failed: %s\n", hipGetErrorName(le));
}
```

```cpp
#include <hip/hip_runtime.h>
#include <cstdio>
#include <cstdint>

#define LAS __attribute__((address_space(3)))
#define GAS __attribute__((address_space(1)))
typedef unsigned short bf16_t;
typedef short bf16x8 __attribute__((ext_vector_type(8)));
typedef float f32x4 __attribute__((ext_vector_type(4)));
typedef float f32x2 __attribute__((ext_vector_type(2)));
typedef unsigned u32x4 __attribute__((ext_vector_type(4)));
typedef unsigned u32x2 __attribute__((ext_vector_type(2)));

typedef GAS float gfloat; typedef GAS bf16_t gbf16; typedef GAS int gint; typedef GAS char gchar; typedef GAS unsigned char guchar; typedef GAS unsigned gunsigned;
typedef GAS f32x4 gf32x4; typedef GAS f32x2 gf32x2; typedef GAS u32x4 gu32x4; typedef GAS u32x2 gu32x2;
constexpr int M_ROWS = 8192, SEQ = 2048, DM = 4096, BW = 2048, NLAYER = 2;
constexpr int N_IN = 31240, IF_COL = 14848;
constexpr int NT_IN = 123;
constexpr int N_IN_T = NT_IN * 256;
constexpr float NORM_EPS = 1e-6f;

__device__ __forceinline__ unsigned cvt_pk_bf16(float lo, float hi) { unsigned r; asm("v_cvt_pk_bf16_f32 %0, %1, %2" : "=v"(r) : "v"(lo), "v"(hi)); return r; }
__device__ __forceinline__ float bf_lo(unsigned w) { return __uint_as_float(w << 16); }
__device__ __forceinline__ float bf_hi(unsigned w) { return __uint_as_float(w & 0xffff0000u); }
__device__ __forceinline__ float bf1(bf16_t b) { return __uint_as_float(((unsigned)b) << 16); }
__device__ __forceinline__ float fsigmoid(float x) { return __builtin_amdgcn_rcpf(1.0f + __expf(-x)); }
__device__ __forceinline__ float wave_sum(float v) {
#pragma unroll
    for (int o = 1; o < 64; o <<= 1) v += __shfl_xor(v, o);
    return v;
}
__device__ __forceinline__ f32x2 gelu_pk(f32x2 v) {
    const f32x2 av = __builtin_elementwise_abs(v), d = av * 0.2316418882f + 1.0f;
    f32x2 t; t.x = __builtin_amdgcn_rcpf(d.x); t.y = __builtin_amdgcn_rcpf(d.y);
    f32x2 q = t * 0.5307027145f + (-0.7265760135f); q = q * t + 0.7107068705f; q = q * t + (-0.142248368f); q = q * t + 0.127414796f; q = q * t;
    const f32x2 s = (v * v) * (-0.72134752044f);
    f32x2 e; e.x = __builtin_amdgcn_exp2f(s.x); e.y = __builtin_amdgcn_exp2f(s.y);
    const f32x2 m = v * (q * e), r = v - m;
    f32x2 o; o.x = v.x < 0.f ? m.x : r.x; o.y = v.y < 0.f ? m.y : r.y; return o;
}
typedef int i32x8 __attribute__((ext_vector_type(8)));
typedef short s16x16 __attribute__((ext_vector_type(16)));
__host__ __device__ __forceinline__ size_t ablk8(int row, int col, int K) { return ((size_t)(row >> 8) * (K >> 7) + (col >> 7)) * 32768 + (size_t)(row & 255) * 128 + (col & 127); }
__device__ __forceinline__ unsigned pack_fp8x4(float a, float b, float c, float d) { int w = 0; w = __builtin_amdgcn_cvt_pk_fp8_f32(a, b, w, false); w = __builtin_amdgcn_cvt_pk_fp8_f32(c, d, w, true); return (unsigned)w; }
__device__ __forceinline__ unsigned pack_i8x4(float a, float b, float c, float d) {
    const int q0 = min(max(__float2int_rn(a), -127), 127), q1 = min(max(__float2int_rn(b), -127), 127), q2 = min(max(__float2int_rn(c), -127), 127), q3 = min(max(__float2int_rn(d), -127), 127);
    return ((unsigned)q0 & 0xffu) | (((unsigned)q1 & 0xffu) << 8) | (((unsigned)q2 & 0xffu) << 16) | ((unsigned)q3 << 24);
}
__host__ __device__ __forceinline__ size_t ablk(int row, int col, int K) { return ((size_t)(row >> 8) * (K >> 6) + (col >> 6)) * 16384 + (size_t)(row & 255) * 64 + (col & 63); }
__host__ __device__ __forceinline__ size_t tb256(int row, int col, int nt) { return ((size_t)(row >> 8) * nt + (col >> 8)) * 65536 + (size_t)(row & 255) * 256 + (col & 255); }
__host__ __device__ __forceinline__ size_t tb128(int row, int col, int nt) { return ((size_t)(row >> 8) * nt + (col >> 7)) * 32768 + (size_t)(row & 255) * 128 + (col & 127); }
#define LAUNDER_V(x) asm volatile("" : "+v"(x))
#define LAUNDER_S(x) asm volatile("" : "+s"(x))
#define LDS_WAIT() asm volatile("s_waitcnt lgkmcnt(0)" ::: "memory")
#define VM_WAIT() asm volatile("s_waitcnt vmcnt(0)" ::: "memory")
#define MFMA16(a, b, c) __builtin_amdgcn_mfma_f32_16x16x32_bf16((a), (b), (c), 0, 0, 0)

#define XB_TMO      128
#define XB_XCNT(j)  (256  + 64 * (j))
#define XB_XSUB(j)  (1280 + 64 * (j))
#define XB_XGEN(j)  (2304 + 64 * (j))
#define XB_TOP      3328
#define XB_TOPGEN   3392
#define XCD_BAR_WORDS 3456
#define XB_SPIN_CAP (1u << 18)
__device__ __forceinline__ unsigned xb_ld(unsigned* p)              { return __hip_atomic_load(p, __ATOMIC_RELAXED, __HIP_MEMORY_SCOPE_AGENT); }
__device__ __forceinline__ unsigned xb_add(unsigned* p, unsigned v) { return __hip_atomic_fetch_add(p, v, __ATOMIC_RELAXED, __HIP_MEMORY_SCOPE_AGENT); }
__device__ __forceinline__ unsigned xb_xcc_id() { return (unsigned)__builtin_amdgcn_s_getreg((3 << 11) | 20) & 0xFu; }
#define XB_SPIN(cond, bar) do { unsigned _sp = 0; while (cond) { __builtin_amdgcn_s_sleep(1); \
    if ((++_sp & 255u) == 0u) { if (xb_ld(&(bar)[XB_TMO])) break; if (_sp > XB_SPIN_CAP) { atomicAdd(&(bar)[XB_TMO], 1u); break; } } } } while (0)
struct XcdBarrier { unsigned* bar; unsigned x; volatile LAS unsigned* st; };
__device__ __forceinline__ XcdBarrier xcd_barrier_post(unsigned* bar, volatile LAS unsigned* st) {
    XcdBarrier b; b.bar = bar; b.x = xb_xcc_id(); b.st = st;
    if (threadIdx.x == 0) (void)xb_add(&bar[XB_XCNT(b.x)], 1u);
    return b;
}
__device__ __forceinline__ void xcd_barrier_complete(unsigned* bar, unsigned x, unsigned& nloc, unsigned& nx) {
    const unsigned G = gridDim.x * gridDim.y * gridDim.z;
    unsigned sum, cnt, mine, sp = 0u;
    for (;;) {
        sum = 0u; cnt = 0u; mine = 0u;
#pragma unroll
        for (unsigned j = 0; j < 16; ++j) { const unsigned c = xb_ld(&bar[XB_XCNT(j)]); sum += c; cnt += (c > 0u) ? 1u : 0u; mine = (j == x) ? c : mine; }
        if (sum == G) break;
        __builtin_amdgcn_s_sleep(1);
        if ((++sp & 255u) == 0u) { if (xb_ld(&bar[XB_TMO])) break; if (sp > XB_SPIN_CAP) { atomicAdd(&bar[XB_TMO], 1u); break; } }
    }
    nloc = mine > 0u ? mine : 1u; nx = cnt > 0u ? cnt : 1u;
}
__device__ __forceinline__ void xcd_barrier(const XcdBarrier& b) {
    asm volatile("s_waitcnt vmcnt(0)" ::: "memory");
    __syncthreads();
    if (threadIdx.x == 0) {
        unsigned* bar = b.bar;
        __builtin_amdgcn_s_waitcnt(0);
        unsigned nloc = b.st[0], nx = b.st[1];
        if (nloc == 0u) { xcd_barrier_complete(bar, b.x, nloc, nx); b.st[0] = nloc; b.st[1] = nx; }
        const unsigned old = xb_add(&bar[XB_XSUB(b.x)], 1u);
        const unsigned gen = old / nloc;
        if (old + 1u == (gen + 1u) * nloc) {
            __builtin_amdgcn_fence(__ATOMIC_RELEASE, "agent");
            asm volatile("s_waitcnt vmcnt(0)" ::: "memory");
            const unsigned og = xb_add(&bar[XB_TOP], 1u);
            const unsigned tg = og / nx;
            if (og + 1u == (tg + 1u) * nx) xb_add(&bar[XB_TOPGEN], 1u);
            else XB_SPIN(xb_ld(&bar[XB_TOPGEN]) == tg, bar);
            __builtin_amdgcn_fence(__ATOMIC_ACQUIRE, "agent");
            xb_add(&bar[XB_XGEN(b.x)], 1u);
            asm volatile("s_waitcnt vmcnt(0)" ::: "memory");
        } else {
            XB_SPIN(xb_ld(&bar[XB_XGEN(b.x)]) == gen, bar);
            __builtin_amdgcn_fence(__ATOMIC_ACQUIRE, "agent");
            asm volatile("s_waitcnt vmcnt(0)" ::: "memory");
        }
    }
    __syncthreads();
}

#ifndef WGM_DEFAULT
#define WGM_DEFAULT 4
#endif
#ifndef PG8_SADDR
#define PG8_SADDR 1
#endif
namespace pg8 {
constexpr int BM = 256, BK = 64, HALF = 128, HTB = HALF * BK * 2, STAGE_BYTES = 8 * HTB, NXCD = 8, WGM = WGM_DEFAULT;
__host__ __device__ __forceinline__ int lds_byte(int r, int c) { const int st = (r >> 4) * 2 + (c >> 5), rr = r & 15, cc = c & 31, ob = rr * 64 + cc * 2; return st * 1024 + (ob ^ (((ob >> 9) & 1) << 5)); }
__host__ __device__ __forceinline__ void stage_rc(int b, int& R, int& C) { const int st = b / 1024, sb = b % 1024, swz = sb ^ (((sb >> 9) & 1) << 5); R = (st >> 1) * 16 + swz / 64; C = (st & 1) * 32 + (swz % 64) / 2; }
__host__ __device__ __forceinline__ int perm32(int rho) { const int n = rho >> 4, i = rho & 15; return 8 * (i >> 2) + 4 * n + (i & 3); }

struct Unit { int pm, pn, seg; };

struct TileOrder {
    int nM, nN, nwg, G, c, wgm, rot, tailtile, pnoff;
    __device__ __forceinline__ void init(int nM_, int nN_, int G_, int c_, int wgm_ = WGM, int rot_ = 0, int tailtile_ = -1, int pnoff_ = 0) { nM = nM_; nN = nN_; nwg = nM * nN; G = G_; c = c_; wgm = wgm_; rot = rot_; tailtile = tailtile_; pnoff = pnoff_; }
    __device__ __forceinline__ bool tile(int i, int& pm, int& pn) const {
        const long L = (long)i * G + c; if (L >= nwg) return false;
        int wgid = (int)L; const int xcd = wgid % NXCD; { const int q = nwg / NXCD, r = nwg % NXCD, off = wgid / NXCD; wgid = (xcd < r ? xcd * (q + 1) : r * (q + 1) + (xcd - r) * q) + off; }
        const int nig = wgm * nN, gid = wgid / nig, fm = gid * wgm, gsz = (nM - fm) < wgm ? (nM - fm) : wgm;
        pm = fm + ((wgid % nig) % gsz); pn = (wgid % nig) / gsz; if (rot) { pn += rot * xcd; pn -= (pn / nN) * nN; } if (tailtile >= 0 && pn == nN - 1) pn = tailtile; pn += pnoff; return true;
    }
};
struct SchedPlain {
    TileOrder T; const gchar* A; const gchar* B; size_t astep, bstep;
    __device__ __forceinline__ bool next(int i, Unit& u) const { u.seg = 0; return T.tile(i, u.pm, u.pn); }
    __device__ __forceinline__ const gchar* a_ptr(const Unit& u) const { return A + (size_t)u.pm * astep; }
    int pn0 = 0;
    __device__ __forceinline__ const gchar* b_ptr(const Unit& u) const { return B + (size_t)(u.pn - pn0) * bstep; }
};
struct SchedBranch {
    TileOrder T; const gchar* A; const gchar* B; size_t astep, bstep, aseg, bseg;
    __device__ __forceinline__ bool next(int i, Unit& u) const { const int t = i / 3; u.seg = i - 3 * t; return T.tile(t, u.pm, u.pn); }
    __device__ __forceinline__ const gchar* a_ptr(const Unit& u) const { return A + (size_t)u.seg * aseg + (size_t)u.pm * astep; }
    __device__ __forceinline__ const gchar* b_ptr(const Unit& u) const { return B + (size_t)u.seg * bseg + (size_t)u.pn * bstep; }
};

template <class Epi, class Sched>
__device__ __forceinline__ void gemm_phase(LAS unsigned char* lds, const int K, const int lda, const int ldb, const Sched& S, const Epi& E, unsigned* lockctr = nullptr, const int nlock = 0) {
    int tid = threadIdx.x; LAUNDER_V(tid);
    const int wid = __builtin_amdgcn_readfirstlane(tid >> 6), lane = tid & 63, wr = wid >> 2, wc = wid & 3, fr = lane & 15, fq = lane >> 4;
    const int nt = K / BK;
    unsigned voffA, voffB;
    { int R, C; stage_rc(tid * 16, R, C); const int Rb = Epi::PERM ? ((R & ~31) + perm32(R & 31)) : R;
      voffA = (unsigned)(R * BK + C) * 2u; voffB = (unsigned)(Rb * BK + C) * 2u; }
    const unsigned qstepA = 64u * (unsigned)BK * 2u, qstepB = 64u * (unsigned)BK * 2u;
    const size_t kstep = (size_t)BM * BK * 2, kstepB = (size_t)BM * BK * 2;
    const size_t hstepA = (size_t)HALF * BK * 2, hstepB = (size_t)HALF * BK * 2;
    const unsigned ldsw = (unsigned)wid * 1024u;
    const int aoff = lds_byte(wr * 64 + fr, fq * 8), boff = lds_byte(wc * 32 + fr, fq * 8);
#define PG8_SA(b, h) (((b) * 2 + (h)) * HTB)
#define PG8_SB(b, h) ((4 + (b) * 2 + (h)) * HTB)
#if PG8_SADDR
#define PG8_STAGE(bufoff, gbase, voff) do { _Pragma("unroll") for (int _i = 0; _i < 2; ++_i) { const gchar* p_ = (const gchar*)(gbase) + (size_t)_i * q##voff; asm volatile("" : "+s"(p_)); \
        __builtin_amdgcn_global_load_lds((const gunsigned*)(p_ + (voff)), (LAS unsigned*)(lds + (bufoff) + ldsw + _i * 8192), 16, 0, 0); } } while (0)
#else
#define PG8_STAGE(bufoff, gbase, voff) do { _Pragma("unroll") for (int _i = 0; _i < 2; ++_i) \
        __builtin_amdgcn_global_load_lds((const gunsigned*)((const gchar*)(gbase) + (size_t)_i * q##voff + (voff)), (LAS unsigned*)(lds + (bufoff) + ldsw + _i * 8192), 16, 0, 0); } while (0)
#endif
#define qvoffA qstepA
#define qvoffB qstepB
#define PG8_LDA(dst, b, h) do { _Pragma("unroll") for (int m = 0; m < 4; ++m) _Pragma("unroll") for (int k = 0; k < 2; ++k) dst[m][k] = *(const LAS bf16x8*)(lds + PG8_SA(b, h) + aoff + m * 2048 + k * 1024); } while (0)
#define PG8_LDB(dst, b, h) do { _Pragma("unroll") for (int n = 0; n < 2; ++n) _Pragma("unroll") for (int k = 0; k < 2; ++k) dst[n][k] = *(const LAS bf16x8*)(lds + PG8_SB(b, h) + boff + n * 2048 + k * 1024); } while (0)
#define PG8_CAT(x_, y_) __builtin_bit_cast(i32x8, __builtin_shufflevector((x_), (y_), 0, 1, 2, 3, 4, 5, 6, 7, 8, 9, 10, 11, 12, 13, 14, 15))
#define PG8_MMA(ai, bj, At, Bt) do { __builtin_amdgcn_s_setprio(1); _Pragma("unroll") for (int m = 0; m < 4; ++m) _Pragma("unroll") for (int n = 0; n < 2; ++n) { \
        if constexpr (Epi::FP8) { const i32x8 b8_ = PG8_CAT(Bt[n][0], Bt[n][1]), a8_ = PG8_CAT(At[m][0], At[m][1]); \
            asm volatile("s_nop 1\n\tv_mfma_scale_f32_16x16x128_f8f6f4 %0, %1, %2, %0, %3, %3 op_sel_hi:[0,0,0]" : "+v"(acc[ai][bj][m][n]) : "v"(b8_), "v"(a8_), "v"(sc8)); } \
        else if constexpr (Epi::I8) { _Pragma("unroll") for (int k = 0; k < 2; ++k) asm volatile("s_nop 1\n\tv_mfma_i32_16x16x64_i8 %0, %1, %2, %0" : "+v"(acc[ai][bj][m][n]) : "v"(Bt[n][k]), "v"(At[m][k])); } \
        else { _Pragma("unroll") for (int k = 0; k < 2; ++k) acc[ai][bj][m][n] = __builtin_amdgcn_mfma_f32_16x16x32_bf16(Bt[n][k], At[m][k], acc[ai][bj][m][n], 0, 0, 0); } } __builtin_amdgcn_s_setprio(0); } while (0)
#define PG8_WAIT_V(n) asm volatile("s_waitcnt vmcnt(" #n ")" ::: "memory")
#define PG8_WAIT_VR() do { if constexpr (Epi::NS == 16) asm volatile("s_waitcnt vmcnt(24)" ::: "memory"); else if constexpr (Epi::NS == 32) asm volatile("s_waitcnt vmcnt(40)" ::: "memory"); else asm volatile("s_waitcnt vmcnt(8)" ::: "memory"); } while (0)
#define PG8_WAIT_L(n) asm volatile("s_waitcnt lgkmcnt(" #n ")" ::: "memory")
#define PG8_BAR __builtin_amdgcn_s_barrier()
#define PG8_SCHED __builtin_amdgcn_sched_barrier(0)
    Unit cur, nxt; int ui = 0; bool relax_next = false;
    int sc8 = 0x7f7f7f7f; asm volatile("" : "+v"(sc8));
    if (!S.next(0, cur)) return;
    f32x4 acc[2][2][4][2];
#pragma unroll
    for (int a = 0; a < 2; ++a)
#pragma unroll
        for (int b = 0; b < 2; ++b)
#pragma unroll
            for (int m = 0; m < 4; ++m)
#pragma unroll
                for (int n = 0; n < 2; ++n) acc[a][b][m][n] = (f32x4){0.f, 0.f, 0.f, 0.f};
    bf16x8 At[4][2], B0[2][2], B1[2][2];
    const gchar* cA = S.a_ptr(cur); const gchar* cB = S.b_ptr(cur);
    PG8_STAGE(PG8_SB(0, 0), cB, voffB); PG8_STAGE(PG8_SB(0, 1), cB + hstepB, voffB); PG8_STAGE(PG8_SA(0, 0), cA, voffA); PG8_STAGE(PG8_SA(0, 1), cA + hstepA, voffA);
    if (wr == 1) PG8_BAR;
    PG8_WAIT_V(2); PG8_BAR;
    PG8_STAGE(PG8_SB(1, 0), cB + kstepB, voffB); PG8_STAGE(PG8_SA(1, 0), cA + kstep, voffA); PG8_STAGE(PG8_SB(1, 1), cB + hstepB + kstepB, voffB);
    PG8_WAIT_V(6); PG8_BAR;
    for (;;) {
        const bool has_next = S.next(ui + 1, nxt);
        const gchar* nA = has_next ? S.a_ptr(nxt) : cA; const gchar* nB = has_next ? S.b_ptr(nxt) : cB;
        for (int t = 0; t < nt; t += 2) {
            const bool last = (t == nt - 2); const bool relax = Epi::NS > 0 && (t == 0) && relax_next;
#if PG8_SADDR
            asm volatile("" : "+v"(voffA), "+v"(voffB));
#endif
            const gchar* a1 = cA + (size_t)(t + 1) * kstep;
            const gchar* a2 = last ? nA : cA + (size_t)(t + 2) * kstep; const gchar* b2 = last ? nB : cB + (size_t)(t + 2) * kstepB;
            const gchar* a3 = a2 + kstep; const gchar* b3 = b2 + kstepB;
            PG8_LDB(B0, 0, 0); PG8_LDB(B1, 0, 1); PG8_SCHED; PG8_LDA(At, 0, 0); PG8_STAGE(PG8_SA(1, 1), a1 + hstepA, voffA);
            if (relax) PG8_WAIT_VR(); else PG8_WAIT_V(8); PG8_WAIT_L(0); PG8_BAR; PG8_MMA(0, 0, At, B0); PG8_MMA(0, 1, At, B1); PG8_BAR; PG8_SCHED;
            PG8_LDA(At, 0, 1); PG8_STAGE(PG8_SB(0, 0), b2, voffB); PG8_STAGE(PG8_SB(0, 1), b2 + hstepB, voffB); PG8_STAGE(PG8_SA(0, 0), a2, voffA);
            if (relax) PG8_WAIT_VR(); else PG8_WAIT_V(8); PG8_WAIT_L(0); PG8_BAR; PG8_MMA(1, 0, At, B0); PG8_MMA(1, 1, At, B1); PG8_BAR; PG8_SCHED;
            PG8_LDB(B0, 1, 0); PG8_LDB(B1, 1, 1); PG8_SCHED; PG8_LDA(At, 1, 0); PG8_STAGE(PG8_SA(0, 1), a2 + hstepA, voffA);
            PG8_WAIT_V(8); PG8_WAIT_L(0); PG8_BAR; PG8_MMA(0, 0, At, B0); PG8_MMA(0, 1, At, B1); PG8_BAR; PG8_SCHED;
            PG8_LDA(At, 1, 1); PG8_STAGE(PG8_SB(1, 0), b3, voffB); PG8_STAGE(PG8_SB(1, 1), b3 + hstepB, voffB); PG8_STAGE(PG8_SA(1, 0), a3, voffA);
            PG8_WAIT_V(8); PG8_WAIT_L(0); PG8_BAR; PG8_MMA(1, 0, At, B0); PG8_MMA(1, 1, At, B1); PG8_BAR; PG8_SCHED;
        }
        if constexpr (Epi::FP8 || Epi::I8) asm volatile("s_nop 15\n\ts_nop 15\n\ts_nop 15\n\ts_nop 15" ::: "memory");
        if (wr == 0) PG8_BAR;
        { const int ln_ = (int)__builtin_amdgcn_mbcnt_hi(~0u, __builtin_amdgcn_mbcnt_lo(~0u, 0u)); E(acc, cur, wr, wc, ln_ & 15, ln_ >> 4); } relax_next = E.relax(cur);
        if (ui < nlock) {
            if (tid == 0) { (void)xb_add(lockctr, 1u); const unsigned tgt_ = (unsigned)(ui + 1) * (unsigned)S.T.G; unsigned sp_ = 0u; while (xb_ld(lockctr) < tgt_) { __builtin_amdgcn_s_sleep(1); if (++sp_ > (1u << 20)) break; } }
            PG8_BAR; }
        if (!has_next) break;
        if (!E.keep(cur)) {
#pragma unroll
            for (int a = 0; a < 2; ++a)
#pragma unroll
                for (int b = 0; b < 2; ++b)
#pragma unroll
                    for (int m = 0; m < 4; ++m)
#pragma unroll
                        for (int n = 0; n < 2; ++n) acc[a][b][m][n] = (f32x4){0.f, 0.f, 0.f, 0.f};
        }
        cur = nxt; cA = nA; cB = nB; ++ui;
        if (wr == 1) PG8_BAR;
    }
    PG8_WAIT_V(0);
    PG8_BAR;
#undef PG8_SA
#undef PG8_SB
#undef PG8_STAGE
#undef qvoffA
#undef qvoffB
#undef PG8_LDA
#undef PG8_LDB
#undef PG8_MMA
#undef PG8_CAT
#undef PG8_WAIT_V
#undef PG8_WAIT_VR
#undef PG8_WAIT_L
#undef PG8_BAR
#undef PG8_SCHED
}
}

constexpr size_t MiB = 1u << 20;
constexpr size_t WS_CTL = 0, CTL_ZERO_BYTES = 1 * MiB;
constexpr int CW_BAR = 4096;
constexpr size_t CTL_SSQ1 = 256 * 1024;
constexpr size_t SZ_WIN = (size_t)N_IN_T * DM * 2, SZ_WBR = (size_t)3 * DM * BW * 2, SZ_WSQ = (size_t)DM * DM * 2, SZ_WPP = (size_t)DM * 256 * 2;
constexpr size_t WS_WIN = 2 * MiB;
constexpr size_t WS_WBR = WS_WIN + 2 * SZ_WIN;
constexpr size_t WS_WOUT = WS_WBR + 2 * SZ_WBR;
constexpr size_t WS_WPG = WS_WOUT + 2 * SZ_WSQ;
constexpr size_t WS_WPP = WS_WPG + 2 * SZ_WSQ;
constexpr size_t SZ_ROWS_BW = (size_t)M_ROWS * BW * 2, SZ_ROWS_D = (size_t)M_ROWS * DM * 2;
constexpr size_t WS_XB = WS_WPP + 2 * SZ_WPP;
constexpr size_t WS_PB = WS_XB + SZ_ROWS_D;
constexpr size_t WS_CS = WS_PB + (size_t)2 * M_ROWS * 256 * 2;
constexpr size_t WS_SSQ0 = WS_CS + (size_t)M_ROWS * 16 * 4;
constexpr size_t WS_AU = WS_SSQ0 + (size_t)M_ROWS * 4;
constexpr size_t WS_AV = WS_AU + SZ_ROWS_BW, WS_AZ = WS_AV + SZ_ROWS_BW, WS_BQ = WS_AZ + SZ_ROWS_BW;
constexpr size_t WS_BK = WS_BQ + SZ_ROWS_BW;
constexpr size_t WS_BV = WS_BK + (size_t)M_ROWS * 256 * 2;
constexpr size_t WS_BZ = WS_BV + (size_t)M_ROWS * 256 * 2;
constexpr size_t WS_CQ = WS_BZ + SZ_ROWS_BW;
constexpr size_t WS_CK = WS_CQ + (size_t)M_ROWS * 1024 * 2;
constexpr size_t WS_CV = WS_CK + (size_t)M_ROWS * 1024 * 2;
constexpr size_t WS_CO = WS_CV + SZ_ROWS_BW, WS_CZ = WS_CO + SZ_ROWS_BW;
constexpr size_t WS_G = WS_CZ + SZ_ROWS_BW;
constexpr size_t WS_IF = WS_G + (size_t)M_ROWS * 12288 * 2;
constexpr size_t WS_LNP = WS_IF + (size_t)M_ROWS * 8 * 4;
constexpr size_t WS_YA = WS_LNP + (size_t)M_ROWS * 32 * 8;
constexpr size_t WS_NUM = WS_YA + 3 * SZ_ROWS_BW;
constexpr size_t WS_SSQC = WS_NUM + SZ_ROWS_BW;
constexpr size_t WS_DN = WS_SSQC + (size_t)M_ROWS * 64 * 4;
constexpr size_t WS_MIX = WS_DN + (size_t)M_ROWS * 4 * 4;
constexpr size_t WS_OUT = WS_MIX + SZ_ROWS_D;
constexpr size_t WS_OUTP = WS_OUT + SZ_ROWS_D;
constexpr size_t WS_ERAW = WS_OUTP + (size_t)M_ROWS * 64 * 4;
constexpr size_t WS_ERP = WS_ERAW + SZ_ROWS_D;
constexpr size_t WS_RSO = WS_ERP + (size_t)M_ROWS * 64 * 4;
constexpr size_t WS_RSE = WS_RSO + (size_t)M_ROWS * 4;
constexpr size_t WS_X1B = WS_RSE + (size_t)M_ROWS * 4;
constexpr size_t WS_XSP = WS_X1B + SZ_ROWS_D;
constexpr size_t WS_X1B8 = WS_XSP + (size_t)M_ROWS * 64 * 4;
constexpr size_t WS_RSX = WS_X1B8 + (size_t)M_ROWS * DM;
constexpr size_t WS_XB8 = WS_RSX + (size_t)M_ROWS * 4;
constexpr size_t SZ_WG8 = (size_t)56 * 256 * DM;
constexpr size_t WS_WG8 = WS_XB8 + (size_t)M_ROWS * DM;
constexpr size_t WS_END = WS_WG8 + 2 * SZ_WG8;
static_assert(WS_WIN % 256 == 0 && WS_XB % 256 == 0 && WS_AU % 256 == 0 && WS_G % 256 == 0 && WS_YA % 256 == 0 && WS_MIX % 256 == 0 && WS_X1B % 256 == 0, "alignment");

#ifndef EPIIN_NT
#define EPIIN_NT 0
#endif
#if EPIIN_NT
#define EPIIN_STORE(v, p) __builtin_nontemporal_store((v), (p))
#else
#define EPIIN_STORE(v, p) (*(p) = (v))
#endif
#ifndef DBG_ZERO_ASC
#define DBG_ZERO_ASC 0
#endif
#ifndef P1G_FP8
#define P1G_FP8 1
#endif
#ifndef P5_I8
#define P5_I8 1
#endif
constexpr int CW_WMAX = 512;
#ifndef P5_FP8
#define P5_FP8 0
#endif
constexpr float W8_SCALE = 256.0f;
#ifndef EPI_NS16
#define EPI_NS16 0
#endif
#ifndef EPI_NS32
#define EPI_NS32 0
#endif
#ifndef EPIIN_NS
#define EPIIN_NS 0
#endif
namespace pg8 {
__device__ __forceinline__ unsigned pack_u8x4(float a, float b, float c, float d) {
    const unsigned q0 = (unsigned)(a * 255.0f + 0.5f), q1 = (unsigned)(b * 255.0f + 0.5f), q2 = (unsigned)(c * 255.0f + 0.5f), q3 = (unsigned)(d * 255.0f + 0.5f);
    return q0 | (q1 << 8) | (q2 << 16) | (q3 << 24);
}
template <bool F8> struct EpiInT {
    static constexpr bool PERM = true; static constexpr int NS = EPIIN_NS; static constexpr bool FP8 = F8; static constexpr bool I8 = false;
    __device__ __forceinline__ bool relax(const Unit& u) const { return u.pn < 122; }
    const gfloat* ssq; guchar* ws; const LAS float* rtab; int rowbase;
    __device__ __forceinline__ float rstd_of(int row) const { return rowbase >= 0 ? rtab[row - rowbase] : rsqrtf(ssq[row] * (1.0f / DM) + NORM_EPS); }
    __device__ __forceinline__ bool keep(const Unit&) const { return false; }
    __device__ __forceinline__ void operator()(f32x4 (&acc)[2][2][4][2], const Unit& u, int wr, int wc, int fr, int fq) const {
        const int pn = u.pn; const int row0 = u.pm * BM + wr * 64 + fr;
        size_t off; int ldc, t0, act; float sc = 1.f;
        if (pn < 16)       { off = WS_AU; ldc = 2048; t0 = 0; act = 6; }
        else if (pn < 24)  { off = WS_AV; ldc = 2048; t0 = 16; act = 5; }
        else if (pn < 32)  { off = WS_BQ; ldc = 2048; t0 = 24; act = 0; }
        else if (pn < 33)  { off = WS_BK; ldc = 256; t0 = 32; act = 0; }
        else if (pn < 34)  { off = WS_BV; ldc = 256; t0 = 33; act = 0; }
        else if (pn < 42)  { off = WS_BZ; ldc = 2048; t0 = 34; act = 2; }
        else if (pn < 46)  { off = WS_CQ; ldc = 1024; t0 = 42; act = 0; sc = 0.0625f; }
        else if (pn < 50)  { off = WS_CK; ldc = 1024; t0 = 46; act = 0; }
        else if (pn < 58)  { off = WS_CV; ldc = 2048; t0 = 50; act = 0; }
        else if (pn < 66)  { off = WS_CZ; ldc = 2048; t0 = 58; act = 2; }
        else if (pn < 122) { off = WS_G; ldc = 12288; t0 = 74; act = 3; if (F8) sc = 1.0f / W8_SCALE; }
        else if (F8)       { off = WS_CO; ldc = 2048; t0 = 122; act = 8; sc = 1.0f / W8_SCALE; }
        else               { off = WS_IF; ldc = 8; t0 = 122; act = 4; }
        const int col0 = (pn - t0) * BM + wc * 32 + 8 * fq;
        if (act == 4) {
            if (wc == 0 && fq == 0) {
                gfloat* dst = (gfloat*)(ws + off);
#pragma unroll
                for (int ai = 0; ai < 2; ++ai)
#pragma unroll
                    for (int m = 0; m < 4; ++m) { const int row = row0 + ai * HALF + m * 16; const float rs = rstd_of(row);
                        *(gf32x4*)(dst + (size_t)row * 8) = acc[ai][0][m][0] * rs; *(gf32x4*)(dst + (size_t)row * 8 + 4) = acc[ai][0][m][1] * rs; }
            }
            return;
        }
        gbf16* base = (gbf16*)(ws + off);
        if (act == 6 || act == 7) {
            const int colp = (pn - t0) * HALF + wc * 32 + 8 * fq;
#pragma unroll
            for (int ai = 0; ai < 2; ++ai)
#pragma unroll
                for (int m = 0; m < 4; ++m) {
                    const int row = row0 + ai * HALF + m * 16; const float rs = rstd_of(row);
                    f32x4 a0 = acc[ai][0][m][0] * rs, a1 = acc[ai][0][m][1] * rs; const f32x4 z0 = acc[ai][1][m][0] * rs, z1 = acc[ai][1][m][1] * rs;
                    if (act == 6) { const f32x2 a = gelu_pk((f32x2){a0[0], a0[1]}), b = gelu_pk((f32x2){a0[2], a0[3]}), c = gelu_pk((f32x2){a1[0], a1[1]}), d = gelu_pk((f32x2){a1[2], a1[3]});
                        a0 = (f32x4){a.x, a.y, b.x, b.y}; a1 = (f32x4){c.x, c.y, d.x, d.y}; }
                    else {
#pragma unroll
                        for (int j = 0; j < 4; ++j) { a0[j] = fsigmoid(a0[j]); a1[j] = fsigmoid(a1[j]); } }
#pragma unroll
                    for (int j = 0; j < 4; ++j) { a0[j] *= z0[j] * fsigmoid(z0[j]); a1[j] *= z1[j] * fsigmoid(z1[j]); }
                    u32x4 w; w.x = cvt_pk_bf16(a0[0], a0[1]); w.y = cvt_pk_bf16(a0[2], a0[3]); w.z = cvt_pk_bf16(a1[0], a1[1]); w.w = cvt_pk_bf16(a1[2], a1[3]);
                    *(gu32x4*)(base + tb128(row, colp, 16)) = w;
                }
            return;
        }
#pragma unroll
        for (int ai = 0; ai < 2; ++ai)
#pragma unroll
            for (int m = 0; m < 4; ++m) {
                const int row = row0 + ai * HALF + m * 16; const float rs = rstd_of(row) * sc;
                gbf16* rowp = base + tb256(row, col0, ldc >> 8); float ls = 0.f, lq = 0.f; u32x2 g8[2] = {{0u, 0u}, {0u, 0u}};
#pragma unroll
                for (int bj = 0; bj < 2; ++bj) {
                    f32x4 v0 = acc[ai][bj][m][0] * rs, v1 = acc[ai][bj][m][1] * rs;
                    if (act == 5) {
                        f32x2 a = gelu_pk((f32x2){v0[0], v0[1]}), b = gelu_pk((f32x2){v0[2], v0[3]}), c = gelu_pk((f32x2){v1[0], v1[1]}), d = gelu_pk((f32x2){v1[2], v1[3]});
                        v0 = (f32x4){a.x, a.y, b.x, b.y}; v1 = (f32x4){c.x, c.y, d.x, d.y};
                        { ls += (v0[0] + v0[1]) + (v0[2] + v0[3]) + (v1[0] + v1[1]) + (v1[2] + v1[3]);
                            lq += (v0[0] * v0[0] + v0[1] * v0[1]) + (v0[2] * v0[2] + v0[3] * v0[3]) + (v1[0] * v1[0] + v1[1] * v1[1]) + (v1[2] * v1[2] + v1[3] * v1[3]); }
                    } else if (act == 2) {
#pragma unroll
                        for (int j = 0; j < 4; ++j) { v0[j] = v0[j] * fsigmoid(v0[j]); v1[j] = v1[j] * fsigmoid(v1[j]); }
                    } else if (act == 3 || act == 8) {
#pragma unroll
                        for (int j = 0; j < 4; ++j) { v0[j] = fsigmoid(v0[j]); v1[j] = fsigmoid(v1[j]); }
                    }
                    if (act == 3) {
                        g8[bj].x = pack_u8x4(v0[0], v0[1], v0[2], v0[3]); g8[bj].y = pack_u8x4(v1[0], v1[1], v1[2], v1[3]);
                    } else {
                    u32x4 w; w.x = cvt_pk_bf16(v0[0], v0[1]); w.y = cvt_pk_bf16(v0[2], v0[3]); w.z = cvt_pk_bf16(v1[0], v1[1]); w.w = cvt_pk_bf16(v1[2], v1[3]);
                    EPIIN_STORE(w, (gu32x4*)(rowp + bj * HALF)); }
                }
                if (act == 3) {
                    typedef unsigned u32x2v_ __attribute__((ext_vector_type(2)));
                    const u32x2v_ r0 = __builtin_amdgcn_permlane16_swap(g8[0].x, g8[1].x, false, false), r1 = __builtin_amdgcn_permlane16_swap(g8[0].y, g8[1].y, false, false);
                    const u32x4 w16 = {r0.x, r1.x, r0.y, r1.y};
                    *(gu32x4*)(ws + WS_G + ((size_t)(u.pm * 48 + (pn - 74)) * 256 + (row & 255)) * 256 + (wc * 32 + 8 * (fq & ~1)) + (fq & 1) * HALF) = w16;
                }
                if (act == 5) {
                    ls += __shfl_xor(ls, 16); ls += __shfl_xor(ls, 32); lq += __shfl_xor(lq, 16); lq += __shfl_xor(lq, 32);
                    if (fq == 0) *(gf32x2*)(ws + WS_LNP + ((size_t)row * 32 + (pn - 16) * 4 + wc) * 8) = (f32x2){ls, lq};
                }
            }
    }
};
using EpiIn = EpiInT<false>;
struct EpiBranch {
    static constexpr bool PERM = true; static constexpr int NS = EPI_NS16; static constexpr bool FP8 = false; static constexpr bool I8 = false;
    __device__ __forceinline__ bool relax(const Unit& u) const { return u.seg == 2; }
    const guchar* G; gbf16* MIX;
    __device__ __forceinline__ bool keep(const Unit& u) const { return u.seg != 2; }
    __device__ __forceinline__ void operator()(f32x4 (&acc)[2][2][4][2], const Unit& u, int wr, int wc, int fr, int fq) const {
        const int row0 = u.pm * BM + wr * 64 + fr, col0 = u.pn * BM + wc * 32 + 8 * fq; const int seg = u.seg;
        u32x2 ga[2][4][2], gb[2][4][2];
#pragma unroll
        for (int ai = 0; ai < 2; ++ai)
#pragma unroll
            for (int m = 0; m < 4; ++m) {
                const int row = row0 + ai * HALF + m * 16; const guchar* gp = G + ((size_t)(u.pm * 48 + seg * 16 + u.pn) * 256 + (row & 255)) * 256 + (wc * 32 + 8 * fq);
#pragma unroll
                for (int bj = 0; bj < 2; ++bj) { ga[ai][m][bj] = *(const gu32x2*)(gp + bj * HALF); gb[ai][m][bj] = (seg != 2) ? *(const gu32x2*)(gp + (size_t)16 * 65536 + bj * HALF) : (u32x2){255u * 0x01010101u, 255u * 0x01010101u}; }
            }
#pragma unroll
        for (int ai = 0; ai < 2; ++ai)
#pragma unroll
            for (int m = 0; m < 4; ++m) {
                const int row = row0 + ai * HALF + m * 16;
#pragma unroll
                for (int bj = 0; bj < 2; ++bj) {
                    const u32x2 a_ = ga[ai][m][bj], b_ = gb[ai][m][bj];
                    float f[8] = {(float)((a_.x >> (8 * 0)) & 0xffu), (float)((a_.x >> (8 * 1)) & 0xffu), (float)((a_.x >> (8 * 2)) & 0xffu), (float)((a_.x >> (8 * 3)) & 0xffu),
                                  (float)((a_.y >> (8 * 0)) & 0xffu), (float)((a_.y >> (8 * 1)) & 0xffu), (float)((a_.y >> (8 * 2)) & 0xffu), (float)((a_.y >> (8 * 3)) & 0xffu)};
                    const float h[8] = {(float)((b_.x >> (8 * 0)) & 0xffu), (float)((b_.x >> (8 * 1)) & 0xffu), (float)((b_.x >> (8 * 2)) & 0xffu), (float)((b_.x >> (8 * 3)) & 0xffu),
                                        (float)((b_.y >> (8 * 0)) & 0xffu), (float)((b_.y >> (8 * 1)) & 0xffu), (float)((b_.y >> (8 * 2)) & 0xffu), (float)((b_.y >> (8 * 3)) & 0xffu)};
#pragma unroll
                    for (int j = 0; j < 8; ++j) f[j] = fmaxf(f[j], 1e-18f) * __builtin_amdgcn_rcpf(fmaxf(h[j], 1e-18f));
                    f32x4 v0 = acc[ai][bj][m][0], v1 = acc[ai][bj][m][1];
                    v0 = v0 * (f32x4){f[0], f[1], f[2], f[3]}; v1 = v1 * (f32x4){f[4], f[5], f[6], f[7]};
                    if (seg != 2) { acc[ai][bj][m][0] = v0; acc[ai][bj][m][1] = v1; }
                    else { u32x4 w; w.x = cvt_pk_bf16(v0[0], v0[1]); w.y = cvt_pk_bf16(v0[2], v0[3]); w.z = cvt_pk_bf16(v1[0], v1[1]); w.w = cvt_pk_bf16(v1[2], v1[3]);
                        *(gu32x4*)(MIX + ablk(row, col0 + bj * HALF, DM)) = w; }
                }
            }
    }
};
struct EpiSq {
    static constexpr bool PERM = true; static constexpr int NS = EPI_NS16; static constexpr bool FP8 = false; static constexpr bool I8 = false;
    __device__ __forceinline__ bool relax(const Unit&) const { return true; }
    gbf16* O; gfloat* P;
    __device__ __forceinline__ bool keep(const Unit&) const { return false; }
    __device__ __forceinline__ void operator()(f32x4 (&acc)[2][2][4][2], const Unit& u, int wr, int wc, int fr, int fq) const {
        const int row0 = u.pm * BM + wr * 64 + fr, col0 = u.pn * BM + wc * 32 + 8 * fq;
#pragma unroll
        for (int ai = 0; ai < 2; ++ai)
#pragma unroll
            for (int m = 0; m < 4; ++m) {
                const int row = row0 + ai * HALF + m * 16; float q = 0.f;
#pragma unroll
                for (int bj = 0; bj < 2; ++bj) {
                    const f32x4 v0 = acc[ai][bj][m][0], v1 = acc[ai][bj][m][1];
                    q += (v0[0] * v0[0] + v0[1] * v0[1]) + (v0[2] * v0[2] + v0[3] * v0[3]) + (v1[0] * v1[0] + v1[1] * v1[1]) + (v1[2] * v1[2] + v1[3] * v1[3]);
                    u32x4 w; w.x = cvt_pk_bf16(v0[0], v0[1]); w.y = cvt_pk_bf16(v0[2], v0[3]); w.z = cvt_pk_bf16(v1[0], v1[1]); w.w = cvt_pk_bf16(v1[2], v1[3]);
                    if (O) *(gu32x4*)(O + (size_t)row * DM + col0 + bj * HALF) = w; else asm volatile("" :: "v"(w));
                }
                q += __shfl_xor(q, 16); q += __shfl_xor(q, 32);
                if (fq == 0) P[(size_t)row * 64 + u.pn * 4 + wc] = q;
            }
    }
};
struct EpiPle {
    static constexpr bool PERM = true; static constexpr int NS = EPI_NS32; static constexpr bool FP8 = P5_FP8 != 0; static constexpr bool I8 = P5_I8 != 0;
    __device__ __forceinline__ bool relax(const Unit&) const { return true; }
    const gbf16* X1B; gfloat* XOUT; gbf16* XB; const gbf16* ERAW; const gfloat* RSE; const gfloat* pnorm; gfloat* SSQN; int last; guchar* XB8; const gfloat* RSX; float swq;
    __device__ __forceinline__ bool keep(const Unit&) const { return false; }
    __device__ __forceinline__ void operator()(f32x4 (&acc)[2][2][4][2], const Unit& u, int wr, int wc, int fr, int fq) const {
        const int row0 = u.pm * BM + wr * 64 + fr, col0 = u.pn * BM + wc * 32 + 8 * fq; constexpr float ASC = FP8 ? (DBG_ZERO_ASC ? 0.0f : 1.0f / W8_SCALE) : 1.0f;
#pragma unroll
        for (int ai = 0; ai < 2; ++ai)
#pragma unroll
            for (int m = 0; m < 4; ++m) {
                const int row = row0 + ai * HALF + m * 16; const float rse = RSE[row]; float q = 0.f; const size_t ro = (size_t)row * DM; const float zsc = I8 ? RSX[row] * swq : ASC;
#pragma unroll
                for (int bj = 0; bj < 2; ++bj) {
                    const int col = col0 + bj * HALF;
                    const u32x4 xb = *(const gu32x4*)(X1B + ablk(row, col, DM)), eb = *(const gu32x4*)(ERAW + ro + col);
                    const f32x4 pna = *(const gf32x4*)(pnorm + col), pnb = *(const gf32x4*)(pnorm + col + 4);
                    const float x[8] = {bf_lo(xb.x), bf_hi(xb.x), bf_lo(xb.y), bf_hi(xb.y), bf_lo(xb.z), bf_hi(xb.z), bf_lo(xb.w), bf_hi(xb.w)};
                    const float e8[8] = {bf_lo(eb.x), bf_hi(eb.x), bf_lo(eb.y), bf_hi(eb.y), bf_lo(eb.z), bf_hi(eb.z), bf_lo(eb.w), bf_hi(eb.w)};
                    const float pn[8] = {pna[0], pna[1], pna[2], pna[3], pnb[0], pnb[1], pnb[2], pnb[3]};
                    const f32x4 a0 = acc[ai][bj][m][0], a1 = acc[ai][bj][m][1];
                    const float a[8] = {I8 ? (float)__float_as_int(a0[0]) : a0[0], I8 ? (float)__float_as_int(a0[1]) : a0[1], I8 ? (float)__float_as_int(a0[2]) : a0[2], I8 ? (float)__float_as_int(a0[3]) : a0[3],
                                        I8 ? (float)__float_as_int(a1[0]) : a1[0], I8 ? (float)__float_as_int(a1[1]) : a1[1], I8 ? (float)__float_as_int(a1[2]) : a1[2], I8 ? (float)__float_as_int(a1[3]) : a1[3]};
                    float r[8];
#pragma unroll
                    for (int j = 0; j < 8; ++j) { r[j] = x[j] + fsigmoid(a[j] * zsc) * (e8[j] * rse * pn[j]); q += r[j] * r[j]; }
                    if (last) { *(gf32x4*)(XOUT + ro + col) = (f32x4){r[0], r[1], r[2], r[3]}; *(gf32x4*)(XOUT + ro + col + 4) = (f32x4){r[4], r[5], r[6], r[7]}; }
                    else { u32x4 w; w.x = cvt_pk_bf16(r[0], r[1]); w.y = cvt_pk_bf16(r[2], r[3]); w.z = cvt_pk_bf16(r[4], r[5]); w.w = cvt_pk_bf16(r[6], r[7]); *(gu32x4*)(XB + ablk(row, col, DM)) = w;
                        if (P1G_FP8) { u32x2 w8; w8.x = pack_fp8x4(r[0], r[1], r[2], r[3]); w8.y = pack_fp8x4(r[4], r[5], r[6], r[7]); *(gu32x2*)(XB8 + ablk8(row, col, DM)) = w8; } }
                }
                if (!last) { q += __shfl_xor(q, 16); q += __shfl_xor(q, 32); if (fq == 0) SSQN[(size_t)row * 64 + u.pn * 4 + wc] = q; }
                if (m & 1) asm volatile("" ::: "memory");
            }
    }
};
}

constexpr int LDS_BYTES = 163840;
constexpr int MISC_OFF = LDS_BYTES - 128;
constexpr int ARGS_OFF = LDS_BYTES - 512;
constexpr int NWAVES = 8, NTHREADS = 512;

struct Ctx {
    LAS unsigned char* lds; int tid, lane, wave, vcu, G, bx;
};

struct TrTile { const gfloat* W; const gfloat* kscale; gbf16* WT; int ldw, K; guchar* W8; const gunsigned* QS; };
constexpr int TR_PER_LAYER = 7808 + 1536 + 1024 + 1024 + 64;
__device__ __forceinline__ TrTile tr_decode(int it, const gfloat* w_in, const gfloat* norm_pre, const gfloat* w_branch, const gfloat* w_out, const gfloat* ple_gate, const gfloat* ple_proj, guchar* ws) {
    const int l = it / TR_PER_LAYER; int r = it - l * TR_PER_LAYER; TrTile t; int kt, ntile; t.W8 = nullptr; t.QS = nullptr;
    if (r < 7808) { kt = r / 244; ntile = r - kt * 244; const int src = ntile < 116 ? ntile * 128 : ntile * 128 + 8;
        if (ntile < 16) ntile = 2 * ntile; else if (ntile < 32) ntile = ntile + 16; else if (ntile < 48) ntile = 2 * (ntile - 32) + 1;
        const int oblk = (ntile >= 116 && ntile < 132) ? ntile - 116 : -1; if (ntile >= 132 && ntile < 148) ntile -= 16;
        t.ldw = N_IN; t.K = DM; t.W = w_in + (size_t)l * DM * N_IN + (size_t)kt * 128 * N_IN + src; t.kscale = norm_pre + l * DM + kt * 128;
        t.WT = (gbf16*)(ws + WS_WIN + (size_t)l * SZ_WIN) + ((size_t)(ntile >> 1) * (DM / 64) + (size_t)kt * 2) * 16384 + (size_t)(ntile & 1) * 128 * 64;
        if (ntile >= 148) t.W8 = ws + WS_WG8 + (size_t)l * SZ_WG8 + ((size_t)((ntile - 148) >> 1) * (DM / 128) + (size_t)kt) * 32768 + (size_t)(ntile & 1) * 128 * 128;
        if (oblk >= 0) t.W8 = ws + WS_WG8 + (size_t)l * SZ_WG8 + ((size_t)(48 + (oblk >> 1)) * (DM / 128) + (size_t)kt) * 32768 + (size_t)(oblk & 1) * 128 * 128;
        return t; }
    r -= 7808; t.kscale = nullptr; t.ldw = DM;
    if (r < 1536) { const int j = r / 512; const int rr = r - j * 512; kt = rr / 32; ntile = rr - kt * 32; t.K = BW;
        t.W = w_branch + ((size_t)(l * 3 + j) * BW + (size_t)kt * 128) * DM + ntile * 128;
        t.WT = (gbf16*)(ws + WS_WBR + (size_t)l * SZ_WBR) + (size_t)j * DM * BW + ((size_t)(ntile >> 1) * (BW / 64) + (size_t)kt * 2) * 16384 + (size_t)(ntile & 1) * 128 * 64; return t; }
    r -= 1536;
    if (r < 2048) { const int which = r / 1024; const int rr = r - which * 1024; kt = rr / 32; ntile = rr - kt * 32; t.K = DM;
        t.W = (which ? ple_gate : w_out) + ((size_t)l * DM + (size_t)kt * 128) * DM + ntile * 128;
        t.WT = (gbf16*)(ws + (which ? WS_WPG : WS_WOUT) + (size_t)l * SZ_WSQ) + ((size_t)(ntile >> 1) * (DM / 64) + (size_t)kt * 2) * 16384 + (size_t)(ntile & 1) * 128 * 64;
        if (P5_I8 && which) t.QS = (const gunsigned*)(ws + WS_CTL) + CW_WMAX + l;
        if ((P5_FP8 || P5_I8) && which) t.W8 = ws + WS_WPG + (size_t)l * SZ_WSQ + ((size_t)(ntile >> 1) * (DM / 128) + (size_t)kt) * 32768 + (size_t)(ntile & 1) * 128 * 128;
        return t; }
    r -= 2048; kt = r / 32; ntile = r - kt * 32; t.K = 256;
    t.W = ple_proj + ((size_t)l * 256 + (size_t)kt * 128) * DM + ntile * 128;
    t.WT = (gbf16*)(ws + WS_WPP + (size_t)l * SZ_WPP) + ((size_t)(ntile >> 1) * (256 / 64) + (size_t)kt * 2) * 16384 + (size_t)(ntile & 1) * 128 * 64; return t;
}
#ifndef TR_NTLOAD
#define TR_NTLOAD 0
#endif
#ifndef TR_REVERSE
#define TR_REVERSE 1
#endif
__device__ __forceinline__ void tr_run(const Ctx& F, int it0, int it1, int sk0, int sk1, int me, int nw, const gfloat* w_in, const gfloat* norm_pre, const gfloat* w_branch,
                                       const gfloat* w_out, const gfloat* ple_gate, const gfloat* ple_proj, guchar* ws) {
    int tid = F.tid; LAUNDER_V(tid);
    {
        constexpr int RS = 264; const int NIT = it1 - it0 - (sk1 - sk0);
        const int c4 = tid & 31, kr = tid >> 5, kc = tid & 15;
        f32x4 va[8], vb[8]; float ka[8], kb[8]; TrTile ta, tb;
#define TR_LOAD(T_, V_, K_, IT_) do { const int ir_ = TR_REVERSE ? (NIT - 1 - (IT_)) : (IT_); T_ = tr_decode(it0 + ir_ + (((it0 + ir_) >= sk0) ? (sk1 - sk0) : 0), w_in, norm_pre, w_branch, w_out, ple_gate, ple_proj, ws); \
        _Pragma("unroll") for (int i = 0; i < 8; ++i) { V_[i] = TR_NTLOAD ? __builtin_nontemporal_load((const gf32x4*)(T_.W + (size_t)(i * 16 + kr) * T_.ldw + 4 * c4)) : *(const gf32x4*)(T_.W + (size_t)(i * 16 + kr) * T_.ldw + 4 * c4); K_[i] = T_.kscale ? T_.kscale[i * 16 + kr] : 1.0f; } } while (0)
#define TR_PUT(V_, K_) do { _Pragma("unroll") for (int i = 0; i < 8; ++i) { const f32x4 a = V_[i] * K_[i]; u32x2 w; w.x = cvt_pk_bf16(a[0], a[1]); w.y = cvt_pk_bf16(a[2], a[3]); \
        *(LAS u32x2*)(F.lds + (i * 16 + kr) * RS + c4 * 8) = w; } } while (0)
#define TR_GET(WT_, W8_, QS_) do { _Pragma("unroll") for (int q = 0; q < 4; ++q) { const int n = 32 * q + (tid >> 4), kq = kc; \
        const LAS bf16_t* s = (const LAS bf16_t*)(F.lds + (8 * kq) * RS + 2 * n); unsigned e[8]; \
        _Pragma("unroll") for (int j = 0; j < 8; ++j) e[j] = s[j * (RS / 2)]; \
        if (QS_) { const float qs_ = 127.0f / fmaxf(__uint_as_float(*(QS_)), 1e-30f); u32x2 o8; \
            o8.x = pack_i8x4(__uint_as_float(e[0] << 16) * qs_, __uint_as_float(e[1] << 16) * qs_, __uint_as_float(e[2] << 16) * qs_, __uint_as_float(e[3] << 16) * qs_); \
            o8.y = pack_i8x4(__uint_as_float(e[4] << 16) * qs_, __uint_as_float(e[5] << 16) * qs_, __uint_as_float(e[6] << 16) * qs_, __uint_as_float(e[7] << 16) * qs_); \
            *(gu32x2*)((W8_) + n * 128 + 8 * kq) = o8; } \
        else if (W8_) { u32x2 o8; o8.x = pack_fp8x4(__uint_as_float(e[0] << 16) * W8_SCALE, __uint_as_float(e[1] << 16) * W8_SCALE, __uint_as_float(e[2] << 16) * W8_SCALE, __uint_as_float(e[3] << 16) * W8_SCALE); \
            o8.y = pack_fp8x4(__uint_as_float(e[4] << 16) * W8_SCALE, __uint_as_float(e[5] << 16) * W8_SCALE, __uint_as_float(e[6] << 16) * W8_SCALE, __uint_as_float(e[7] << 16) * W8_SCALE); \
            *(gu32x2*)((W8_) + n * 128 + 8 * kq) = o8; } \
        else { u32x4 o; o.x = e[0] | (e[1] << 16); o.y = e[2] | (e[3] << 16); o.z = e[4] | (e[5] << 16); o.w = e[6] | (e[7] << 16); \
        *(gu32x4*)(WT_ + (size_t)(kq >> 3) * 16384 + n * 64 + 8 * (kq & 7)) = o; } } } while (0)
        int it = me;
        if (it < NIT) TR_LOAD(ta, va, ka, it);
        if (it + nw < NIT) TR_LOAD(tb, vb, kb, it + nw);
        while (it < NIT) {
            { TR_PUT(va, ka); __syncthreads(); gbf16* wt = ta.WT; guchar* kk = ta.W8; const gunsigned* qp = ta.QS;
              if (it + 2 * nw < NIT) TR_LOAD(ta, va, ka, it + 2 * nw);
              TR_GET(wt, kk, qp); __syncthreads(); }
            it += nw; if (it >= NIT) break;
            { TR_PUT(vb, kb); __syncthreads(); gbf16* wt = tb.WT; guchar* kk = tb.W8; const gunsigned* qp = tb.QS;
              if (it + 2 * nw < NIT) TR_LOAD(tb, vb, kb, it + 2 * nw);
              TR_GET(wt, kk, qp); __syncthreads(); }
            it += nw;
        }
#undef TR_LOAD
#undef TR_PUT
#undef TR_GET
    }
}
#ifndef TR_NODEFER
#define TR_NODEFER 0
#endif
#ifndef TR_L1TAIL
#define TR_L1TAIL (1024 + 1536)
#endif
constexpr int TR_PG0 = 7808 + 1536 + 1024, TR_PG1 = TR_PER_LAYER + TR_PG0;
constexpr int TR_DEFER0 = TR_PER_LAYER + 7808 + 1536, TR_DEFER1 = TR_DEFER0 + (TR_NODEFER ? 0 : 2048);
__device__ __forceinline__ void p0_prologue(const Ctx& F, const gfloat* x, const gfloat* p, const gint* positions, const gfloat* norm_pre, const gfloat* w_in, const gfloat* w_branch,
                                            const gfloat* w_out, const gfloat* ple_gate, const gfloat* ple_proj, guchar* ws) {
    int tid = F.tid; LAUNDER_V(tid);
#if P5_I8
    tr_run(F, 0, TR_PG1 - TR_L1TAIL, TR_PG0, TR_PG0 + 1024, F.vcu, F.G, w_in, norm_pre, w_branch, w_out, ple_gate, ple_proj, ws);
    tr_run(F, TR_PG1 + 1024, NLAYER * TR_PER_LAYER, 0x7fffffff, 0x7fffffff, F.vcu, F.G, w_in, norm_pre, w_branch, w_out, ple_gate, ple_proj, ws);
    { const int gt_ = F.vcu * NTHREADS + tid, NGT_ = F.G * NTHREADS;
      for (int l = 0; l < NLAYER; ++l) { const gf32x4* wp = (const gf32x4*)(ple_gate + (size_t)l * DM * DM); float mx = 0.f;
          for (int i0 = gt_; i0 < DM * DM / 4; i0 += 8 * NGT_) { f32x4 a[8];
#pragma unroll
              for (int j = 0; j < 8; ++j) { const int i = i0 + j * NGT_; a[j] = wp[i < DM * DM / 4 ? i : i0]; }
#pragma unroll
              for (int j = 0; j < 8; ++j) mx = fmaxf(mx, fmaxf(fmaxf(fabsf(a[j][0]), fabsf(a[j][1])), fmaxf(fabsf(a[j][2]), fabsf(a[j][3])))); }
#pragma unroll
          for (int s = 32; s >= 1; s >>= 1) mx = fmaxf(mx, __shfl_xor(mx, s));
          if (F.lane == 0) atomicMax((unsigned*)((gunsigned*)(ws + WS_CTL) + CW_WMAX + l), __float_as_uint(mx)); } }
#else
    tr_run(F, 0, NLAYER * TR_PER_LAYER, TR_DEFER0, TR_DEFER1, F.vcu, F.G, w_in, norm_pre, w_branch, w_out, ple_gate, ple_proj, ws);
#endif
    const int gt = F.vcu * NTHREADS + tid, NGT = F.G * NTHREADS;
    for (int i = gt; i < NLAYER * 256 * DM; i += NGT) { const int l = i / (256 * DM), rr = (i / DM) & 255, k = i & (DM - 1);
        float val = 0.f; if (rr < 8) val = w_in[(size_t)l * DM * N_IN + (size_t)k * N_IN + IF_COL + rr] * norm_pre[l * DM + k];
        ((gbf16*)(ws + WS_WIN + (size_t)l * SZ_WIN))[((size_t)122 * (DM / 64) + (k >> 6)) * 16384 + rr * 64 + (k & 63)] = (bf16_t)(cvt_pk_bf16(val, 0.f) & 0xffffu); }
    for (int i = gt; i < NLAYER * M_ROWS * 256 / 4; i += NGT) { const f32x4 a = ((const gf32x4*)p)[i]; u32x2 w; w.x = cvt_pk_bf16(a[0], a[1]); w.y = cvt_pk_bf16(a[2], a[3]);
        const int l = i / (M_ROWS * 64), r = (i >> 6) & (M_ROWS - 1), c = (i & 63) * 4; *(gu32x2*)((gbf16*)(ws + WS_PB) + (size_t)l * M_ROWS * 256 + ablk(r, c, 256)) = w; }
    for (int i = gt; i < M_ROWS * 8; i += NGT) { const int row = i >> 3, j = i & 7; const float inv = powf(500000.0f, -(float)j * 0.125f); const float ang = (float)positions[row] * inv;
        gfloat* cs = (gfloat*)(ws + WS_CS) + (size_t)row * 16; cs[j] = cosf(ang); cs[8 + j] = sinf(ang); }
    { const int gw = F.vcu * NWAVES + F.wave, NGW = F.G * NWAVES;
      for (int m = gw; m < M_ROWS; m += NGW) { const gf32x4* xr = (const gf32x4*)(x + (size_t)m * DM) + F.lane; gbf16* o = (gbf16*)(ws + WS_XB); float s = 0.f;
#pragma unroll
          for (int j = 0; j < 16; ++j) { const f32x4 a = xr[64 * j]; s += (a[0] * a[0] + a[1] * a[1]) + (a[2] * a[2] + a[3] * a[3]); u32x2 w; w.x = cvt_pk_bf16(a[0], a[1]); w.y = cvt_pk_bf16(a[2], a[3]); *(gu32x2*)(o + ablk(m, (F.lane + 64 * j) * 4, DM)) = w;
              if (P1G_FP8) *(gunsigned*)(ws + WS_XB8 + ablk8(m, (F.lane + 64 * j) * 4, DM)) = pack_fp8x4(a[0], a[1], a[2], a[3]); }
          s = wave_sum(s); if (F.lane == 0) ((gfloat*)(ws + WS_SSQ0))[m] = s; } }
}

__device__ __forceinline__ u32x2 pack4(const f32x4 v) { u32x2 w; w.x = cvt_pk_bf16(v[0], v[1]); w.y = cvt_pk_bf16(v[2], v[3]); return w; }
__device__ __forceinline__ bf16x8 mk_frag(const u32x2 lo, const u32x2 hi) { const u32x4 t = {lo.x, lo.y, hi.x, hi.y}; return __builtin_bit_cast(bf16x8, t); }
__device__ __forceinline__ bf16x8 frag_const(unsigned w) { const u32x4 t = {w, w, w, w}; return __builtin_bit_cast(bf16x8, t); }

constexpr int GM_RS = 288, GM_WL = 0, GM_VT = 128 * GM_RS, GM_ST = GM_VT + 256 * GM_RS;
__device__ __forceinline__ void gmlp_unit(const Ctx& F, int b, int n, int g, guchar* ws, const gfloat* ln_g, const gfloat* ln_b, const gfloat* wsp, const gfloat* bsp) {
    int tid = F.tid; LAUNDER_V(tid); const int lane = tid & 63, w = F.wave, r16 = lane & 15, q4 = lane >> 4;
    const int row0 = b * SEQ + n * 128, c0 = g * 256;
    const gbf16* AU = (const gbf16*)(ws + WS_AU); const gbf16* AV = (const gbf16*)(ws + WS_AV); gbf16* YA = (gbf16*)(ws + WS_YA);
    u32x4 raw[8];
#pragma unroll
    for (int k = 0; k < 8; ++k) { const int item = tid + 512 * k, s = item & 127, ch = item >> 7; raw[k] = *(const gu32x4*)(AV + tb256(row0 + s, c0 + 8 * ch, 8)); }
    f32x4 wt[8];
#pragma unroll
    for (int k = 0; k < 8; ++k) { const int item = tid + 512 * k, t = item >> 5, ch = item & 31; wt[k] = *(const gf32x4*)(wsp + ((size_t)(g * 128 + t)) * 128 + 4 * ch); }
    { const gf32x4* pp = (const gf32x4*)(ws + WS_LNP) + (size_t)(row0 + (tid & 127)) * 16 + (tid >> 7) * 4; float s = 0.f, q = 0.f;
#pragma unroll
        for (int j = 0; j < 4; ++j) { const f32x4 t = pp[j]; s += t[0] + t[2]; q += t[1] + t[3]; }
        *(LAS f32x2*)(F.lds + GM_ST + 1024 + ((tid >> 7) * 128 + (tid & 127)) * 8) = (f32x2){s, q}; }
#pragma unroll
    for (int k = 0; k < 8; ++k) { const int item = tid + 512 * k, t = item >> 5, ch = item & 31; f32x4 a = wt[k];
#pragma unroll
        for (int e = 0; e < 4; ++e) if (4 * ch + e > t) a[e] = 0.f;
        *(LAS u32x2*)(F.lds + GM_WL + t * GM_RS + ch * 8) = pack4(a); }
    __syncthreads();
    if (tid < 128) { float s = 0.f, q = 0.f;
#pragma unroll
        for (int j = 0; j < 4; ++j) { const f32x2 t = *(const LAS f32x2*)(F.lds + GM_ST + 1024 + (j * 128 + tid) * 8); s += t.x; q += t.y; }
        const float mu = s * (1.0f / BW); const float var = fmaxf(q * (1.0f / BW) - mu * mu, 0.f);
        *(LAS f32x2*)(F.lds + GM_ST + tid * 8) = (f32x2){mu, rsqrtf(var + NORM_EPS)}; }
    __syncthreads();
#pragma unroll
    for (int k = 0; k < 8; ++k) { const int item = tid + 512 * k, s = item & 127, ch = item >> 7;
        const f32x4 g0 = *(const gf32x4*)(ln_g + c0 + 8 * ch), g1 = *(const gf32x4*)(ln_g + c0 + 8 * ch + 4), b0 = *(const gf32x4*)(ln_b + c0 + 8 * ch), b1 = *(const gf32x4*)(ln_b + c0 + 8 * ch + 4);
        const f32x2 st = *(const LAS f32x2*)(F.lds + GM_ST + s * 8);
        const float xv[8] = {bf_lo(raw[k].x), bf_hi(raw[k].x), bf_lo(raw[k].y), bf_hi(raw[k].y), bf_lo(raw[k].z), bf_hi(raw[k].z), bf_lo(raw[k].w), bf_hi(raw[k].w)};
        const float gg[8] = {g0[0], g0[1], g0[2], g0[3], g1[0], g1[1], g1[2], g1[3]}, bb[8] = {b0[0], b0[1], b0[2], b0[3], b1[0], b1[1], b1[2], b1[3]};
#pragma unroll
        for (int i = 0; i < 8; ++i) { const float y = (xv[i] - st.x) * st.y * gg[i] + bb[i];
            *(LAS bf16_t*)(F.lds + GM_VT + (8 * ch + i) * GM_RS + 2 * s) = (bf16_t)(cvt_pk_bf16(y, 0.f) & 0xffffu); } }
    u32x4 ub[8]; float bsv[8];
#pragma unroll
    for (int n8 = 0; n8 < 8; ++n8) { const int t = 16 * n8 + r16; ub[n8] = *(const gu32x4*)(AU + tb128(row0 + t, c0 + 32 * w + 8 * q4, 16)); bsv[n8] = bsp[g * 128 + t]; }
    __syncthreads();
    f32x4 acc[2][8];
#pragma unroll
    for (int m = 0; m < 2; ++m)
#pragma unroll
        for (int n8 = 0; n8 < 8; ++n8) acc[m][n8] = (f32x4){0.f, 0.f, 0.f, 0.f};
    bf16x8 af[2][4];
#pragma unroll
    for (int m = 0; m < 2; ++m)
#pragma unroll
        for (int ks = 0; ks < 4; ++ks) af[m][ks] = *(const LAS bf16x8*)(F.lds + GM_VT + (32 * w + 8 * (r16 >> 2) + 4 * m + (r16 & 3)) * GM_RS + ks * 64 + q4 * 16);
#pragma unroll
    for (int n8 = 0; n8 < 8; ++n8)
#pragma unroll
        for (int ks = 0; ks < 4; ++ks) if (ks <= n8 / 2) {
            const bf16x8 bfr = *(const LAS bf16x8*)(F.lds + GM_WL + (16 * n8 + r16) * GM_RS + ks * 64 + q4 * 16);
#pragma unroll
            for (int m = 0; m < 2; ++m) acc[m][n8] = MFMA16(af[m][ks], bfr, acc[m][n8]); }
#pragma unroll
    for (int n8 = 0; n8 < 8; ++n8) { const int t = 16 * n8 + r16; const size_t roy = ablk(row0 + t, c0 + 32 * w + 8 * q4, BW);
        const f32x4 a0 = acc[0][n8] + bsv[n8], a1 = acc[1][n8] + bsv[n8]; u32x4 y;
        y.x = cvt_pk_bf16(a0[0] * bf_lo(ub[n8].x), a0[1] * bf_hi(ub[n8].x)); y.y = cvt_pk_bf16(a0[2] * bf_lo(ub[n8].y), a0[3] * bf_hi(ub[n8].y));
        y.z = cvt_pk_bf16(a1[0] * bf_lo(ub[n8].z), a1[1] * bf_hi(ub[n8].z)); y.w = cvt_pk_bf16(a1[2] * bf_lo(ub[n8].w), a1[3] * bf_hi(ub[n8].w));
        *(gu32x4*)(YA + roy) = y; }
    __syncthreads();
}

constexpr int SW_RS = 160, SW_VS = 528, SW_KL = 0, SW_VT = 256 * SW_RS, SW_QL = SW_VT + 64 * SW_VS, SW_QL2 = SW_QL + 128 * SW_RS, SW_CS = SW_QL2 + 128 * SW_RS;
static_assert(SW_CS + 384 * 64 <= ARGS_OFF, "SWA LDS map");
__device__ __forceinline__ void rope8(const u32x4 a, const u32x4 bq, const gfloat* cs, float scale, u32x4& o1, u32x4& o2) {
    const f32x4 c0 = *(const gf32x4*)cs, c1 = *(const gf32x4*)(cs + 4), s0 = *(const gf32x4*)(cs + 8), s1 = *(const gf32x4*)(cs + 12);
    const float t1[8] = {bf_lo(a.x), bf_hi(a.x), bf_lo(a.y), bf_hi(a.y), bf_lo(a.z), bf_hi(a.z), bf_lo(a.w), bf_hi(a.w)};
    const float t2[8] = {bf_lo(bq.x), bf_hi(bq.x), bf_lo(bq.y), bf_hi(bq.y), bf_lo(bq.z), bf_hi(bq.z), bf_lo(bq.w), bf_hi(bq.w)};
    const float cc[8] = {c0[0], c0[1], c0[2], c0[3], c1[0], c1[1], c1[2], c1[3]}, ss[8] = {s0[0], s0[1], s0[2], s0[3], s1[0], s1[1], s1[2], s1[3]};
    float r1[8], r2[8];
#pragma unroll
    for (int i = 0; i < 8; ++i) { r1[i] = (t1[i] * cc[i] - t2[i] * ss[i]) * scale; r2[i] = (t2[i] * cc[i] + t1[i] * ss[i]) * scale; }
    o1 = (u32x4){cvt_pk_bf16(r1[0], r1[1]), cvt_pk_bf16(r1[2], r1[3]), cvt_pk_bf16(r1[4], r1[5]), cvt_pk_bf16(r1[6], r1[7])};
    o2 = (u32x4){cvt_pk_bf16(r2[0], r2[1]), cvt_pk_bf16(r2[2], r2[3]), cvt_pk_bf16(r2[4], r2[5]), cvt_pk_bf16(r2[6], r2[7])};
}
__device__ __forceinline__ u32x4 scale8(const u32x4 a, float sc) {
    return (u32x4){cvt_pk_bf16(bf_lo(a.x) * sc, bf_hi(a.x) * sc), cvt_pk_bf16(bf_lo(a.y) * sc, bf_hi(a.y) * sc), cvt_pk_bf16(bf_lo(a.z) * sc, bf_hi(a.z) * sc), cvt_pk_bf16(bf_lo(a.w) * sc, bf_hi(a.w) * sc)};
}
__device__ __forceinline__ void swa_unit(const Ctx& F, int b, int n, int hk, guchar* ws, const gfloat* sinks) {
    int tid = F.tid; LAUNDER_V(tid); const int lane = tid & 63, w = F.wave, r16 = lane & 15, q4 = lane >> 4;
    const int r0 = b * SEQ + n * 128, kr0 = r0 - 128;
    const gbf16* BQ = (const gbf16*)(ws + WS_BQ); const gbf16* BK = (const gbf16*)(ws + WS_BK); const gbf16* BV = (const gbf16*)(ws + WS_BV); const gbf16* BZ = (const gbf16*)(ws + WS_BZ);
    gbf16* YB = (gbf16*)(ws + WS_YA) + (size_t)M_ROWS * BW; const gfloat* CS = (const gfloat*)(ws + WS_CS);
    const int kch = tid & 7;
    u32x4 kraw[4], vraw[4]; f32x4 csr[3]; u32x4 qa[2];
#pragma unroll
    for (int k = 0; k < 4; ++k) { const int key = (tid + 512 * k) >> 3; const bool pad = (n == 0 && key < 128);
        kraw[k] = *(const gu32x4*)(BK + (size_t)(pad ? r0 : kr0 + key) * 256 + hk * 64 + 8 * kch); }
#pragma unroll
    for (int k = 0; k < 4; ++k) { const int item = tid + 512 * k, key = item & 255, ch = item >> 8; const bool pad = (n == 0 && key < 128);
        vraw[k] = *(const gu32x4*)(BV + (size_t)(pad ? r0 : kr0 + key) * 256 + hk * 64 + 8 * ch); }
#pragma unroll
    for (int k = 0; k < 3; ++k) { const int item = tid + 512 * k, r = item >> 2, part = item & 3; const int row = r < 256 ? ((n == 0 && r < 128) ? r0 : kr0 + r) : r0 + r - 256;
        csr[k] = *(const gf32x4*)(CS + (size_t)row * 16 + part * 4); }
#define SW_QLOAD(hq_) do { _Pragma("unroll") for (int k_ = 0; k_ < 2; ++k_) { const int qr_ = (tid + 512 * k_) >> 3; qa[k_] = *(const gu32x4*)(BQ + tb256(r0 + qr_, (hq_) * 64, 8) + 8 * kch); } } while (0)
    SW_QLOAD(hk * 8);
#pragma unroll
    for (int k = 0; k < 3; ++k) { const int item = tid + 512 * k; *(LAS f32x4*)(F.lds + SW_CS + item * 16) = csr[k]; }
#pragma unroll
    for (int k = 0; k < 4; ++k) { const int item = tid + 512 * k, key = item & 255, ch = item >> 8; const bool pad = (n == 0 && key < 128);
        const u32x4 raw = pad ? (u32x4){0u, 0u, 0u, 0u} : vraw[k]; const unsigned e[4] = {raw.x, raw.y, raw.z, raw.w};
#pragma unroll
        for (int i = 0; i < 8; ++i) *(LAS bf16_t*)(F.lds + SW_VT + (8 * ch + i) * SW_VS + 2 * key) = (bf16_t)((e[i >> 1] >> ((i & 1) * 16)) & 0xffffu); }
    __syncthreads();
#define SW_PUT(raw_, csrow_, dst_, scale_) do { const u32x4 own_ = (raw_); u32x4 par_; \
        par_.x = (unsigned)__builtin_amdgcn_update_dpp(0, (int)own_.x, 0xB1, 0xf, 0xf, false); par_.y = (unsigned)__builtin_amdgcn_update_dpp(0, (int)own_.y, 0xB1, 0xf, 0xf, false); \
        par_.z = (unsigned)__builtin_amdgcn_update_dpp(0, (int)own_.z, 0xB1, 0xf, 0xf, false); par_.w = (unsigned)__builtin_amdgcn_update_dpp(0, (int)own_.w, 0xB1, 0xf, 0xf, false); \
        u32x4 o_; \
        if (kch < 2) { const LAS float* cs_ = (const LAS float*)(F.lds + SW_CS + (csrow_) * 64); \
            const f32x4 c0_ = *(const LAS f32x4*)cs_, c1_ = *(const LAS f32x4*)(cs_ + 4), s0_ = *(const LAS f32x4*)(cs_ + 8), s1_ = *(const LAS f32x4*)(cs_ + 12); \
            const float sg_ = kch == 0 ? -(scale_) : (scale_); \
            const float t_[8] = {bf_lo(own_.x), bf_hi(own_.x), bf_lo(own_.y), bf_hi(own_.y), bf_lo(own_.z), bf_hi(own_.z), bf_lo(own_.w), bf_hi(own_.w)}; \
            const float u_[8] = {bf_lo(par_.x), bf_hi(par_.x), bf_lo(par_.y), bf_hi(par_.y), bf_lo(par_.z), bf_hi(par_.z), bf_lo(par_.w), bf_hi(par_.w)}; \
            const float cc_[8] = {c0_[0], c0_[1], c0_[2], c0_[3], c1_[0], c1_[1], c1_[2], c1_[3]}, ss_[8] = {s0_[0], s0_[1], s0_[2], s0_[3], s1_[0], s1_[1], s1_[2], s1_[3]}; \
            float r_[8]; _Pragma("unroll") for (int i_ = 0; i_ < 8; ++i_) r_[i_] = (t_[i_] * cc_[i_]) * (scale_) + (u_[i_] * ss_[i_]) * sg_; \
            o_ = (u32x4){cvt_pk_bf16(r_[0], r_[1]), cvt_pk_bf16(r_[2], r_[3]), cvt_pk_bf16(r_[4], r_[5]), cvt_pk_bf16(r_[6], r_[7])}; } \
        else o_ = ((scale_) == 1.0f) ? own_ : scale8(own_, (scale_)); \
        *(LAS u32x4*)((dst_) + kch * 16) = o_; } while (0)
#pragma unroll
    for (int k = 0; k < 4; ++k) { const int key = (tid + 512 * k) >> 3; const bool pad = (n == 0 && key < 128);
        const u32x4 kz = pad ? (u32x4){0u, 0u, 0u, 0u} : kraw[k]; SW_PUT(kz, key, F.lds + SW_KL + key * SW_RS, 1.0f); }
#define SW_QWRITE(buf_) do { _Pragma("unroll") for (int k_ = 0; k_ < 2; ++k_) { const int qr_ = (tid + 512 * k_) >> 3; SW_PUT(qa[k_], 256 + qr_, F.lds + (buf_) + qr_ * SW_RS, 0.125f); } } while (0)
    SW_QWRITE(SW_QL);
    __syncthreads();
    for (int hi = 0; hi < 8; ++hi) {
        const int hq = hk * 8 + hi; const int qcur = (hi & 1) ? SW_QL2 : SW_QL, qnxt = (hi & 1) ? SW_QL : SW_QL2;
        SW_QLOAD((hi < 7 ? hq + 1 : hq));
        const u32x4 zb0 = *(const gu32x4*)(BZ + tb256(r0 + 16 * w + r16, hq * 64 + 8 * q4, 8)), zb1 = *(const gu32x4*)(BZ + tb256(r0 + 16 * w + r16, hq * 64 + 8 * q4 + 32, 8));
        bf16x8 bq[2];
#pragma unroll
        for (int ks = 0; ks < 2; ++ks) bq[ks] = *(const LAS bf16x8*)(F.lds + qcur + (16 * w + r16) * SW_RS + ks * 64 + q4 * 16);
        f32x4 s[10];
#pragma unroll
        for (int j = 0; j < 9; ++j) { s[j] = (f32x4){0.f, 0.f, 0.f, 0.f};
#pragma unroll
            for (int ks = 0; ks < 2; ++ks) { const bf16x8 a = *(const LAS bf16x8*)(F.lds + SW_KL + (16 * (w + j) + r16) * SW_RS + ks * 64 + q4 * 16); s[j] = MFMA16(a, bq[ks], s[j]); } }
        s[9] = (f32x4){0.f, 0.f, 0.f, 0.f};
        const int qi = 16 * w + r16; const float sink = sinks[hq]; float mx = sink;
#pragma unroll
        for (int j = 0; j < 9; ++j)
#pragma unroll
            for (int e = 0; e < 4; ++e) { const int kj = 16 * (w + j) + 4 * q4 + e; const bool valid = (kj > qi) && (kj <= qi + 128) && (n > 0 || kj >= 128);
                s[j][e] = valid ? s[j][e] : -1e30f; mx = fmaxf(mx, s[j][e]); }
        mx = fmaxf(mx, __shfl_xor(mx, 16)); mx = fmaxf(mx, __shfl_xor(mx, 32));
        float sum = 0.f;
#pragma unroll
        for (int j = 0; j < 9; ++j)
#pragma unroll
            for (int e = 0; e < 4; ++e) { const float pv = (s[j][e] > -1e29f) ? __expf(s[j][e] - mx) : 0.f; s[j][e] = pv; sum += pv; }
        sum += __shfl_xor(sum, 16); sum += __shfl_xor(sum, 32); sum += __expf(sink - mx);
        const float inv = 1.0f / sum;
        f32x4 o[4];
#pragma unroll
        for (int dt = 0; dt < 4; ++dt) o[dt] = (f32x4){0.f, 0.f, 0.f, 0.f};
#pragma unroll
        for (int kk = 0; kk < 5; ++kk) { const bf16x8 pf = mk_frag(pack4(s[2 * kk]), pack4(s[2 * kk + 1]));
            const int t0 = w + 2 * kk, t1 = (w + 2 * kk + 1) > 15 ? 15 : (w + 2 * kk + 1);
#pragma unroll
            for (int dt = 0; dt < 4; ++dt) { const LAS unsigned char* vrow = F.lds + SW_VT + (32 * (dt >> 1) + 8 * (r16 >> 2) + 4 * (dt & 1) + (r16 & 3)) * SW_VS + (4 * q4) * 2;
                const bf16x8 a = mk_frag(*(const LAS u32x2*)(vrow + 32 * t0), *(const LAS u32x2*)(vrow + 32 * t1)); o[dt] = MFMA16(a, pf, o[dt]); } }
        const size_t ro = (size_t)(r0 + qi) * BW + hq * 64 + 8 * q4;
#pragma unroll
        for (int pp = 0; pp < 2; ++pp) { const u32x4 zb = pp ? zb1 : zb0; const f32x4 oa = o[2 * pp] * inv, ob2 = o[2 * pp + 1] * inv; u32x4 y;
            y.x = cvt_pk_bf16(oa[0] * bf_lo(zb.x), oa[1] * bf_hi(zb.x)); y.y = cvt_pk_bf16(oa[2] * bf_lo(zb.y), oa[3] * bf_hi(zb.y));
            y.z = cvt_pk_bf16(ob2[0] * bf_lo(zb.z), ob2[1] * bf_hi(zb.z)); y.w = cvt_pk_bf16(ob2[2] * bf_lo(zb.w), ob2[3] * bf_hi(zb.w));
            *(gu32x4*)(YB + ablk(r0 + qi, hq * 64 + 8 * q4 + 32 * pp, BW)) = y; }
        SW_QWRITE(qnxt);
        __syncthreads();
    }
#undef SW_QLOAD
#undef SW_QWRITE
#undef SW_PUT
}

#ifndef ML_R1A
#define ML_R1A 1
#endif
#ifndef ML_R1B
#define ML_R1B 1
#endif
#ifndef ML_RWR
#define ML_RWR 1
#endif
constexpr int ML_RS = 544, ML_TS = 144, ML_WS = 160, ML_GSZ = 1344;
constexpr int ML_QL = 0, ML_KA = 64 * ML_RS, ML_KB = 2 * 64 * ML_RS, ML_VT = 3 * 64 * ML_RS, ML_VW = ML_VT + 32 * ML_TS, ML_VW2 = ML_VW + 33 * ML_WS, ML_CT = ML_VW2 + 33 * ML_WS, ML_X = ML_CT + 33 * ML_RS, ML_GATE = ML_X + 64 * 144;
static_assert(ML_GATE + 2 * ML_GSZ <= ARGS_OFF, "mLSTM LDS map");
typedef short s16x4 __attribute__((ext_vector_type(4)));
__device__ __forceinline__ bf16x8 tr_frag8(const LAS unsigned char* img, int rs, int row0, int col0, int r16) {
    const LAS unsigned char* p0 = img + (row0 + (r16 >> 2)) * rs + (col0 + 4 * (r16 & 3)) * 2;
    const s16x4 a = __builtin_amdgcn_ds_read_tr16_b64_v4i16((LAS s16x4*)p0);
    const s16x4 b = __builtin_amdgcn_ds_read_tr16_b64_v4i16((LAS s16x4*)(p0 + 4 * rs));
    return __builtin_shufflevector(a, b, 0, 1, 2, 3, 4, 5, 6, 7);
}
__device__ __forceinline__ float dpp_shr(float v, float ident, int n) {
    const int r = n == 1 ? __builtin_amdgcn_update_dpp(__float_as_int(ident), __float_as_int(v), 0x111, 0xf, 0xf, false)
                : n == 2 ? __builtin_amdgcn_update_dpp(__float_as_int(ident), __float_as_int(v), 0x112, 0xf, 0xf, false)
                : n == 4 ? __builtin_amdgcn_update_dpp(__float_as_int(ident), __float_as_int(v), 0x114, 0xf, 0xf, false)
                         : __builtin_amdgcn_update_dpp(__float_as_int(ident), __float_as_int(v), 0x118, 0xf, 0xf, false);
    return __int_as_float(r);
}
__device__ __forceinline__ float wave_scan_add(float v, int lane) {
    v += dpp_shr(v, 0.f, 1); v += dpp_shr(v, 0.f, 2); v += dpp_shr(v, 0.f, 4); v += dpp_shr(v, 0.f, 8);
    const float t0 = __int_as_float(__builtin_amdgcn_readlane(__float_as_int(v), 15)), t1 = __int_as_float(__builtin_amdgcn_readlane(__float_as_int(v), 31)), t2 = __int_as_float(__builtin_amdgcn_readlane(__float_as_int(v), 47));
    const int row = lane >> 4; const float add = row == 0 ? 0.f : (row == 1 ? t0 : (row == 2 ? t0 + t1 : (t0 + t1) + t2));
    return v + add;
}
__device__ __forceinline__ float wave_scan_max(float v, int lane) {
    const float NI = -3.0e38f;
    v = fmaxf(v, dpp_shr(v, NI, 1)); v = fmaxf(v, dpp_shr(v, NI, 2)); v = fmaxf(v, dpp_shr(v, NI, 4)); v = fmaxf(v, dpp_shr(v, NI, 8));
    const float t0 = __int_as_float(__builtin_amdgcn_readlane(__float_as_int(v), 15)), t1 = __int_as_float(__builtin_amdgcn_readlane(__float_as_int(v), 31)), t2 = __int_as_float(__builtin_amdgcn_readlane(__float_as_int(v), 47));
    const int row = lane >> 4; const float mx = row == 0 ? NI : (row == 1 ? t0 : (row == 2 ? fmaxf(t0, t1) : fmaxf(fmaxf(t0, t1), t2)));
    return fmaxf(v, mx);
}
__device__ __forceinline__ float softcap15(float z) { const float e = __expf(z * (2.0f / 15.0f)); return 15.0f * (1.0f - 2.0f * __builtin_amdgcn_rcpf(e + 1.0f)); }
__device__ __forceinline__ void mlstm_unit(const Ctx& F, int b, int h, int sl, guchar* ws, const gfloat* ibp, const gfloat* fbp, const gfloat* norm_g) {
    int tid = F.tid; LAUNDER_V(tid); const int lane = tid & 63, w = F.wave, r16 = lane & 15, q4 = lane >> 4;
    const gbf16* CQ = (const gbf16*)(ws + WS_CQ); const gbf16* CK = (const gbf16*)(ws + WS_CK); const gbf16* CV = (const gbf16*)(ws + WS_CV);
    const gbf16* CO = (const gbf16*)(ws + WS_CO); const gbf16* CZs = (const gbf16*)(ws + WS_CZ);
    const gfloat* IFB = (const gfloat*)(ws + WS_IF);
    gbf16* NUM = (gbf16*)(ws + WS_NUM) + h * 512 + sl * 32; gfloat* SSQC = (gfloat*)(ws + WS_SSQC); gfloat* DNB = (gfloat*)(ws + WS_DN);
    const int rowb = b * SEQ;
    const bf16x8 ones = frag_const(0x3f803f80u), zeros = frag_const(0u);
    for (int i = tid; i < 33 * ML_RS / 16; i += NTHREADS) *(LAS u32x4*)(F.lds + ML_CT + i * 16) = (u32x4){0u, 0u, 0u, 0u};
    f32x4 st[2][3];
#pragma unroll
    for (int i = 0; i < 2; ++i)
#pragma unroll
        for (int dt = 0; dt < 3; ++dt) st[i][dt] = (f32x4){0.f, 0.f, 0.f, 0.f};
    float m_prev = 0.f;
    const float ibv = ibp[h], fbv = fbp[h];
    const f32x4 ng0 = *(const gf32x4*)(norm_g + h * 512 + sl * 32 + 4 * q4), ng1 = *(const gf32x4*)(norm_g + h * 512 + sl * 32 + 16 + 4 * q4);
    u32x4 qra[4], kra[4], vra; float gi = 0.f, gf = 0.f;
#define ML_LOAD(c, Q_, K_, V_) do { const int rc_ = rowb + (c) * 64; _Pragma("unroll") for (int k_ = 0; k_ < 4; ++k_) { const int it_ = tid + 512 * k_, s_ = it_ >> 5, ch_ = it_ & 31; \
        Q_[k_] = *(const gu32x4*)(CQ + tb256(rc_ + s_, h * 256 + 8 * ch_, 4)); K_[k_] = *(const gu32x4*)(CK + tb256(rc_ + s_, h * 256 + 8 * ch_, 4)); } \
        V_ = *(const gu32x4*)(CV + tb256(rc_ + ((tid & 255) >> 2), h * 512 + sl * 32 + 8 * (tid & 3), 8)); } while (0)
#define ML_GLOAD(c) do { const int r_ = rowb + (c) * 64 + lane; gi = IFB[(size_t)r_ * 8 + h]; gf = IFB[(size_t)r_ * 8 + 4 + h]; } while (0)
#define ML_GPREP(par) do { if (w == 7) { const float ig_ = softcap15(gi + ibv); const float z_ = softcap15(gf + fbv); \
        const float lf_ = -(fmaxf(-z_, 0.f) + log1pf(__expf(-fabsf(z_)))); const float bc_ = wave_scan_add(lf_, lane); const float u_ = ig_ - bc_; const float pm_ = wave_scan_max(u_, lane); \
        const float Mv_ = fmaxf(m_prev, pm_); const float M63_ = __int_as_float(__builtin_amdgcn_readlane(__float_as_int(Mv_), 63)); const float g_ = __int_as_float(__builtin_amdgcn_readlane(__float_as_int(bc_), 63)); \
        LAS float* gp_ = (LAS float*)(F.lds + ML_GATE + (par) * ML_GSZ); gp_[lane] = u_; gp_[64 + lane] = Mv_; gp_[128 + lane] = __expf(m_prev - Mv_); gp_[192 + lane] = __expf(-(bc_ + Mv_)); \
        gp_[256 + lane] = __expf(u_ - M63_); if (lane == 0) gp_[320] = __expf(m_prev - M63_); m_prev = g_ + M63_; } } while (0)
#define ML_WRITE(kb_, vw_, gpn_, Q_, K_, V_) do { _Pragma("unroll") for (int k_ = 0; k_ < 4; ++k_) { const int it_ = tid + 512 * k_, s_ = it_ >> 5, ch_ = it_ & 31; \
        *(LAS u32x4*)(F.lds + ML_QL + s_ * ML_RS + ch_ * 16) = Q_[k_]; *(LAS u32x4*)(F.lds + (kb_) + s_ * ML_RS + ch_ * 16) = K_[k_]; } \
        if (tid < 256) { const int s_ = tid >> 2, ch_ = tid & 3; const unsigned e_[4] = {V_.x, V_.y, V_.z, V_.w}; const float ws_ = (gpn_)[256 + s_]; \
            _Pragma("unroll") for (int i_ = 0; i_ < 8; ++i_) { const unsigned hv_ = (e_[i_ >> 1] >> ((i_ & 1) * 16)) & 0xffffu; \
                *(LAS bf16_t*)(F.lds + ML_VT + (8 * ch_ + i_) * ML_TS + 2 * s_) = (bf16_t)hv_; \
                *(LAS bf16_t*)(F.lds + (vw_) + (8 * ch_ + i_) * ML_WS + 2 * s_) = (bf16_t)(cvt_pk_bf16(__uint_as_float(hv_ << 16) * ws_, 0.f) & 0xffffu); } \
            if (ch_ == 0) *(LAS bf16_t*)(F.lds + (vw_) + 32 * ML_WS + 2 * s_) = (bf16_t)(cvt_pk_bf16(ws_, 0.f) & 0xffffu); } } while (0)
    ML_LOAD(0, qra, kra, vra); ML_GLOAD(0);
    ML_GPREP(0);
    ML_GLOAD(1);
    __syncthreads();
    ML_WRITE(ML_KA, ML_VW, ((const LAS float*)(F.lds + ML_GATE)), qra, kra, vra);
    __syncthreads();
#define ML_STEP(c, LQ_, LK_, LV_, WQ_, WK_, WV_) do { \
        const int par = c & 1; const LAS float* gp = (const LAS float*)(F.lds + ML_GATE + par * ML_GSZ); \
        const int vt = ML_VT, kb = par ? ML_KB : ML_KA, kbn = par ? ML_KA : ML_KB, vw = par ? ML_VW2 : ML_VW, vwn = par ? ML_VW : ML_VW2; \
        const LAS float* gpn = (const LAS float*)(F.lds + ML_GATE + (par ^ 1) * ML_GSZ); \
        const int rowc = rowb + c * 64; \
        const size_t rog_ = tb256(rowc + 16 * (w & 3) + r16, h * 512 + sl * 32 + 4 * q4, 8); \
        const u32x2 ob0 = *(const gu32x2*)(CO + rog_), ob1 = *(const gu32x2*)(CO + rog_ + 16), zb0 = *(const gu32x2*)(CZs + rog_), zb1 = *(const gu32x2*)(CZs + rog_ + 16); \
        ML_LOAD((c + 1 < 32 ? c + 1 : 31), LQ_, LK_, LV_); if (c + 1 < 32) ML_GPREP(par ^ 1); ML_GLOAD((c + 2 < 32 ? c + 2 : 31)); \
        f32x4 oacc[3]; \
        for (int rp_ = 0; rp_ < ML_R1B; ++rp_) { \
        _Pragma("unroll") \
        for (int dt = 0; dt < 3; ++dt) oacc[dt] = (f32x4){0.f, 0.f, 0.f, 0.f}; \
        if (w < 4) { \
            const int T = w; \
            bf16x8 bq[8]; \
        _Pragma("unroll") \
            for (int ks = 0; ks < 8; ++ks) bq[ks] = *(const LAS bf16x8*)(F.lds + ML_QL + (16 * T + r16) * ML_RS + ks * 64 + q4 * 16); \
            f32x4 sa[4]; \
        _Pragma("unroll") \
            for (int s4 = 0; s4 < 4; ++s4) { sa[s4] = (f32x4){0.f, 0.f, 0.f, 0.f}; \
                if (s4 <= T) { \
        _Pragma("unroll") \
                    for (int ks = 0; ks < 8; ++ks) { const bf16x8 a = *(const LAS bf16x8*)(F.lds + kb + (16 * s4 + r16) * ML_RS + ks * 64 + q4 * 16); sa[s4] = MFMA16(a, bq[ks], sa[s4]); } } } \
            const int tl = 16 * T + r16; const float Mt = gp[64 + tl]; \
        _Pragma("unroll") \
            for (int s4 = 0; s4 < 4; ++s4) { const f32x4 uu = *(const LAS f32x4*)(gp + 16 * s4 + 4 * q4); \
        _Pragma("unroll") \
                for (int e = 0; e < 4; ++e) { const int sl_ = 16 * s4 + 4 * q4 + e; sa[s4][e] = (sl_ <= tl) ? sa[s4][e] * __expf(uu[e] - Mt) : 0.f; } } \
        _Pragma("unroll") \
            for (int kk = 0; kk < 2; ++kk) { const bf16x8 pf = mk_frag(pack4(sa[2 * kk]), pack4(sa[2 * kk + 1])); \
        _Pragma("unroll") \
                for (int dt = 0; dt < 3; ++dt) { bf16x8 a; \
                    if (dt < 2) { const LAS unsigned char* vp = F.lds + vt + (16 * dt + r16) * ML_TS + (32 * kk + 4 * q4) * 2; a = mk_frag(*(const LAS u32x2*)vp, *(const LAS u32x2*)(vp + 32)); } \
                    else a = (r16 == 0) ? ones : zeros; \
                    oacc[dt] = MFMA16(a, pf, oacc[dt]); } } \
        } else { \
            const int T = w - 4; f32x4 ia[3]; \
        _Pragma("unroll") \
            for (int dt = 0; dt < 3; ++dt) ia[dt] = (f32x4){0.f, 0.f, 0.f, 0.f}; \
        _Pragma("unroll") \
            for (int ks = 0; ks < 8; ++ks) { const bf16x8 bqv = *(const LAS bf16x8*)(F.lds + ML_QL + (16 * T + r16) * ML_RS + ks * 64 + q4 * 16); \
        _Pragma("unroll") \
                for (int dt = 0; dt < 3; ++dt) { bf16x8 a; \
                    if (dt < 2) a = *(const LAS bf16x8*)(F.lds + ML_CT + (16 * dt + r16) * ML_RS + ks * 64 + q4 * 16); \
                    else { a = *(const LAS bf16x8*)(F.lds + ML_CT + 32 * ML_RS + ks * 64 + q4 * 16); if (r16 != 0) a = zeros; } \
                    ia[dt] = MFMA16(a, bqv, ia[dt]); } } \
            const int tl = 16 * T + r16; \
            *(LAS f32x4*)(F.lds + ML_X + tl * 144 + (4 * q4) * 4) = ia[0]; *(LAS f32x4*)(F.lds + ML_X + tl * 144 + (16 + 4 * q4) * 4) = ia[1]; \
            if (q4 == 0) *(LAS f32x4*)(F.lds + ML_X + tl * 144 + 32 * 4) = ia[2]; \
        } \
        } \
        __syncthreads(); \
        if (w < 4) { \
            const int tl = 16 * w + r16; const float at = gp[128 + tl], en = gp[192 + tl]; \
            const f32x4 x0 = *(const LAS f32x4*)(F.lds + ML_X + tl * 144 + (4 * q4) * 4), x1 = *(const LAS f32x4*)(F.lds + ML_X + tl * 144 + (16 + 4 * q4) * 4); \
            const float xd = *(const LAS float*)(F.lds + ML_X + tl * 144 + 32 * 4); \
            const f32x4 n0 = oacc[0] + x0 * at, n1 = oacc[1] + x1 * at; \
            float den = oacc[2][0] + xd * at; den = __shfl(den, r16); \
            float sq = (n0[0] * n0[0] + n0[1] * n0[1]) + (n0[2] * n0[2] + n0[3] * n0[3]) + (n1[0] * n1[0] + n1[1] * n1[1]) + (n1[2] * n1[2] + n1[3] * n1[3]); \
            sq += __shfl_xor(sq, 16); sq += __shfl_xor(sq, 32); \
            const size_t ro = (size_t)(rowc + tl) * BW + 4 * q4; \
            f32x4 t0, t1; \
            t0[0] = n0[0] * ng0[0] * (bf_lo(ob0.x) * bf_lo(zb0.x)); t0[1] = n0[1] * ng0[1] * (bf_hi(ob0.x) * bf_hi(zb0.x)); t0[2] = n0[2] * ng0[2] * (bf_lo(ob0.y) * bf_lo(zb0.y)); t0[3] = n0[3] * ng0[3] * (bf_hi(ob0.y) * bf_hi(zb0.y)); \
            t1[0] = n1[0] * ng1[0] * (bf_lo(ob1.x) * bf_lo(zb1.x)); t1[1] = n1[1] * ng1[1] * (bf_hi(ob1.x) * bf_hi(zb1.x)); t1[2] = n1[2] * ng1[2] * (bf_lo(ob1.y) * bf_lo(zb1.y)); t1[3] = n1[3] * ng1[3] * (bf_hi(ob1.y) * bf_hi(zb1.y)); \
            *(gu32x2*)(NUM + ro) = pack4(t0); *(gu32x2*)(NUM + ro + 16) = pack4(t1); \
            if (q4 == 0) { SSQC[(size_t)(rowc + tl) * 64 + h * 16 + sl] = sq; if (sl == 0) DNB[(size_t)(rowc + tl) * 4 + h] = fmaxf(fabsf(den), en); } \
        } \
        { const float dec = gp[320]; \
        _Pragma("unroll") \
          for (int i = 0; i < 2; ++i) \
        _Pragma("unroll") \
              for (int dt = 0; dt < 3; ++dt) st[i][dt] = st[i][dt] * dec; \
        _Pragma("unroll") \
          for (int kk = 0; kk < 2; ++kk) { bf16x8 a[2], bv[3]; \
        _Pragma("unroll") \
              for (int i = 0; i < 2; ++i) a[i] = tr_frag8(F.lds + kb, ML_RS, 32 * kk + 8 * q4, 32 * w + 16 * i, r16); \
        _Pragma("unroll") \
              for (int dt = 0; dt < 2; ++dt) bv[dt] = *(const LAS bf16x8*)(F.lds + vw + (16 * dt + r16) * ML_WS + kk * 64 + q4 * 16); \
              bv[2] = *(const LAS bf16x8*)(F.lds + vw + 32 * ML_WS + kk * 64 + q4 * 16); if (r16 != 0) bv[2] = zeros; \
        _Pragma("unroll") \
              for (int i = 0; i < 2; ++i) \
        _Pragma("unroll") \
                  for (int dt = 0; dt < 3; ++dt) st[i][dt] = MFMA16(a[i], bv[dt], st[i][dt]); } \
        _Pragma("unroll") \
          for (int i = 0; i < 2; ++i) { \
        _Pragma("unroll") \
              for (int dt = 0; dt < 2; ++dt) *(LAS u32x2*)(F.lds + ML_CT + (16 * dt + r16) * ML_RS + (32 * w + 16 * i + 4 * q4) * 2) = pack4(st[i][dt]); \
              if (r16 == 0) *(LAS u32x2*)(F.lds + ML_CT + 32 * ML_RS + (32 * w + 16 * i + 4 * q4) * 2) = pack4(st[i][2]); } } \
        for (int rp_ = 0; rp_ < ML_RWR; ++rp_) if (c + 1 < 32) ML_WRITE(kbn, vwn, gpn, WQ_, WK_, WV_); \
        __syncthreads(); \
    } while (0)
    for (int c2 = 0; c2 < 32; ++c2) { ML_STEP(c2, qra, kra, vra, qra, kra, vra); }
#undef ML_LOAD
#undef ML_GLOAD
#undef ML_GPREP
#undef ML_WRITE
#undef ML_STEP
}

__device__ __forceinline__ void p2b_finalize(const Ctx& F, guchar* ws) {
    int lane = F.lane; LAUNDER_V(lane); const int gw = F.vcu * NWAVES + F.wave, NGW = F.G * NWAVES;
    const gbf16* NUM = (const gbf16*)(ws + WS_NUM); gbf16* YC = (gbf16*)(ws + WS_YA) + (size_t)2 * M_ROWS * BW;
    for (int m = gw; m < M_ROWS; m += NGW) {
        float s = ((const gfloat*)(ws + WS_SSQC))[(size_t)m * 64 + lane];
        s += __shfl_xor(s, 1); s += __shfl_xor(s, 2); s += __shfl_xor(s, 4); s += __shfl_xor(s, 8);
        const float dn = ((const gfloat*)(ws + WS_DN))[(size_t)m * 4 + (lane >> 4)];
        const float inv = 1.0f / dn; const float sc = inv * rsqrtf(s * (1.0f / 512.0f) * inv * inv + NORM_EPS);
#pragma unroll
        for (int it = 0; it < 4; ++it) { const float f = __shfl(sc, 16 * it); const size_t o = (size_t)m * BW + (size_t)(it * 64 + lane) * 8;
            const u32x4 nb = *(const gu32x4*)(NUM + o); u32x4 y;
            y.x = cvt_pk_bf16(bf_lo(nb.x) * f, bf_hi(nb.x) * f); y.y = cvt_pk_bf16(bf_lo(nb.y) * f, bf_hi(nb.y) * f);
            y.z = cvt_pk_bf16(bf_lo(nb.z) * f, bf_hi(nb.z) * f); y.w = cvt_pk_bf16(bf_lo(nb.w) * f, bf_hi(nb.w) * f);
            *(gu32x4*)(YC + ablk(m, (it * 64 + lane) * 8, BW)) = y; }
    }
}
__device__ __forceinline__ void p5b_ssq(const Ctx& F, guchar* ws) {
    int lane = F.lane; LAUNDER_V(lane); const int gw = F.vcu * NWAVES + F.wave, NGW = F.G * NWAVES;
    for (int m = gw; m < M_ROWS; m += NGW) { const float s = wave_sum(((const gfloat*)(ws + WS_XSP))[(size_t)m * 64 + lane]); if (lane == 0) ((gfloat*)(ws + WS_CTL + CTL_SSQ1))[m] = s; }
}
__device__ __forceinline__ void p4b_x1(const Ctx& F, guchar* ws, const gfloat* npost) {
    int lane = F.lane; LAUNDER_V(lane); const int gw = F.vcu * NWAVES + F.wave, NGW = F.G * NWAVES;
    const gbf16* OUT = (const gbf16*)(ws + WS_OUT); const gbf16* XB = (const gbf16*)(ws + WS_XB); gbf16* X1B = (gbf16*)(ws + WS_X1B);
    for (int m = gw; m < M_ROWS; m += NGW) {
        const float so = wave_sum(((const gfloat*)(ws + WS_OUTP))[(size_t)m * 64 + lane]), se = wave_sum(((const gfloat*)(ws + WS_ERP))[(size_t)m * 64 + lane]);
        const float rso = rsqrtf(so * (1.0f / DM) + NORM_EPS), rse = rsqrtf(se * (1.0f / DM) + NORM_EPS);
        if (lane == 0) { ((gfloat*)(ws + WS_RSO))[m] = rso; ((gfloat*)(ws + WS_RSE))[m] = rse; }
        u32x4 yv[8]; float mx = 0.f;
#pragma unroll
        for (int it = 0; it < 8; ++it) { const int c = (it * 64 + lane) * 8; const size_t o = (size_t)m * DM + c;
            const u32x4 xb = *(const gu32x4*)(XB + ablk(m, c, DM)), ob = *(const gu32x4*)(OUT + o); const f32x4 n0 = *(const gf32x4*)(npost + c), n1 = *(const gf32x4*)(npost + c + 4); u32x4 y;
            y.x = cvt_pk_bf16(bf_lo(xb.x) + bf_lo(ob.x) * rso * n0[0], bf_hi(xb.x) + bf_hi(ob.x) * rso * n0[1]);
            y.y = cvt_pk_bf16(bf_lo(xb.y) + bf_lo(ob.y) * rso * n0[2], bf_hi(xb.y) + bf_hi(ob.y) * rso * n0[3]);
            y.z = cvt_pk_bf16(bf_lo(xb.z) + bf_lo(ob.z) * rso * n1[0], bf_hi(xb.z) + bf_hi(ob.z) * rso * n1[1]);
            y.w = cvt_pk_bf16(bf_lo(xb.w) + bf_lo(ob.w) * rso * n1[2], bf_hi(xb.w) + bf_hi(ob.w) * rso * n1[3]);
            *(gu32x4*)(X1B + ablk(m, c, DM)) = y; yv[it] = y;
            mx = fmaxf(mx, fmaxf(fmaxf(fmaxf(fabsf(bf_lo(y.x)), fabsf(bf_hi(y.x))), fmaxf(fabsf(bf_lo(y.y)), fabsf(bf_hi(y.y)))), fmaxf(fmaxf(fabsf(bf_lo(y.z)), fabsf(bf_hi(y.z))), fmaxf(fabsf(bf_lo(y.w)), fabsf(bf_hi(y.w))))));
#if P5_FP8
            { u32x2 y8; y8.x = pack_fp8x4(bf_lo(y.x), bf_hi(y.x), bf_lo(y.y), bf_hi(y.y)); y8.y = pack_fp8x4(bf_lo(y.z), bf_hi(y.z), bf_lo(y.w), bf_hi(y.w)); *(gu32x2*)(ws + WS_X1B8 + ablk8(m, c, DM)) = y8; }
#endif
            }
#if P5_I8
#pragma unroll
        for (int s = 32; s >= 1; s >>= 1) mx = fmaxf(mx, __shfl_xor(mx, s));
        mx = fmaxf(mx, 1e-30f); const float qs = 127.0f / mx;
        if (lane == 0) ((gfloat*)(ws + WS_RSX))[m] = mx * (1.0f / 127.0f);
#pragma unroll
        for (int it = 0; it < 8; ++it) { const int c = (it * 64 + lane) * 8; const u32x4 y = yv[it]; u32x2 y8;
            y8.x = pack_i8x4(bf_lo(y.x) * qs, bf_hi(y.x) * qs, bf_lo(y.y) * qs, bf_hi(y.y) * qs); y8.y = pack_i8x4(bf_lo(y.z) * qs, bf_hi(y.z) * qs, bf_lo(y.w) * qs, bf_hi(y.w) * qs);
            *(gu32x2*)(ws + WS_X1B8 + ablk8(m, c, DM)) = y8; }
#endif
    }
}

#ifndef P1_ROT
#define P1_ROT 0
#endif
#ifndef P1_WGM
#define P1_WGM 4
#endif
#ifndef REP_P0
#define REP_P0 1
#endif
#ifndef REP_P1
#define REP_P1 1
#endif
#ifndef REP_ML
#define REP_ML 1
#endif
#ifndef REP_SW
#define REP_SW 1
#endif
#ifndef REP_GM
#define REP_GM 1
#endif
#ifndef REP_P3
#define REP_P3 1
#endif
#ifndef REP_THIN
#define REP_THIN 1
#endif
#ifndef REP_BAR
#define REP_BAR 1
#endif
#ifndef REP_P4
#define REP_P4 1
#endif
__device__ __forceinline__ unsigned long long arg_ld(LAS unsigned char* lds, int i) {
    unsigned a = (unsigned)(ARGS_OFF + 8 * i); asm volatile("" : "+v"(a));
    const volatile LAS unsigned* q = (const volatile LAS unsigned*)(lds + a);
    const unsigned lo = q[0], hi = q[1];
    return ((unsigned long long)(unsigned)__builtin_amdgcn_readfirstlane((int)hi) << 32) | (unsigned)__builtin_amdgcn_readfirstlane((int)lo);
}
struct Args { const void* in[19]; float* out; unsigned char* ws; };
static_assert(sizeof(Args) == 21 * 8, "no padding in Args");

__global__ void __launch_bounds__(NTHREADS, 2) fwd_kernel(Args args) {
    extern __shared__ __attribute__((aligned(16))) unsigned char lds_raw[];
    Ctx F; F.lds = (LAS unsigned char*)lds_raw; F.tid = threadIdx.x; F.lane = F.tid & 63; F.wave = __builtin_amdgcn_readfirstlane(F.tid >> 6);
    F.G = gridDim.x; F.bx = blockIdx.x; { const int bx = blockIdx.x; F.vcu = (F.G % 8 == 0) ? (bx % 8) * (F.G / 8) + bx / 8 : bx; }
    guchar* ws0 = (guchar*)args.ws;
#define WSL() ({ guchar* w_ = ws0; LAUNDER_S(w_); w_; })
    volatile LAS unsigned* MISC = (volatile LAS unsigned*)(F.lds + MISC_OFF);
    if (F.tid < 32) MISC[F.tid] = 0u;
    __syncthreads();
    const XcdBarrier bar = xcd_barrier_post((unsigned*)(ws0 + WS_CTL) + CW_BAR, MISC);

    if (F.tid < 19) ((LAS unsigned long long*)(F.lds + ARGS_OFF))[F.tid] = (unsigned long long)args.in[F.tid];
    if (F.tid == 19) ((LAS unsigned long long*)(F.lds + ARGS_OFF))[19] = (unsigned long long)args.out;
    __syncthreads();
#define ARGP(T, i) ((T)arg_ld(F.lds, (i)))

#define FL() ({ Ctx f_ = F; LAUNDER_S(f_.lds); LAUNDER_S(f_.wave); LAUNDER_S(f_.vcu); LAUNDER_S(f_.G); LAUNDER_S(f_.bx); f_; })
#ifndef SKIP_P0
    for (int rep_ = 0; rep_ < REP_P0; ++rep_) { const Ctx Fp = FL(); guchar* ws = WSL(); p0_prologue(FL(), ARGP(const gfloat*, 0), ARGP(const gfloat*, 1), ARGP(const gint*, 2), ARGP(const gfloat*, 3), ARGP(const gfloat*, 4), ARGP(const gfloat*, 13), ARGP(const gfloat*, 14), ARGP(const gfloat*, 18), ARGP(const gfloat*, 16), ws); }
#endif
    for (int rb_ = 0; rb_ < REP_BAR; ++rb_) xcd_barrier(bar);

    auto layer_body = [&](const int l) __attribute__((always_inline)) {
#ifndef NT_BF
#define NT_BF (P1G_FP8 ? 67 : NT_IN)
#endif
#ifndef P1_LOCK
#define P1_LOCK 0
#endif
#ifndef SKIP_P1
        for (int rep_ = 0; rep_ < REP_P1; ++rep_) { const Ctx Fp = FL(); guchar* ws = WSL(); const gfloat* ssq = l == 0 ? (const gfloat*)(ws + WS_SSQ0) : (const gfloat*)(ws + WS_CTL + CTL_SSQ1);
          const int rowbase = (Fp.G == 256 && P1_WGM == 4 && P1_ROT == 0) ? (Fp.bx & 7) * 1024 : -1; LAS float* rtab = (LAS float*)(Fp.lds + 132096);
          if (rowbase >= 0) { int ti_ = threadIdx.x; LAUNDER_V(ti_); const float s0_ = ssq[rowbase + ti_], s1_ = ssq[rowbase + 512 + ti_]; rtab[ti_] = rsqrtf(s0_ * (1.0f / DM) + NORM_EPS); rtab[512 + ti_] = rsqrtf(s1_ * (1.0f / DM) + NORM_EPS); __syncthreads(); }
#if P1G_FP8
          { pg8::SchedPlain S; S.T.init(M_ROWS / 256, 56, Fp.G, Fp.bx, P1_WGM, P1_ROT, -1, 74); S.pn0 = 74; S.A = (const gchar*)(ws + WS_XB8); S.B = (const gchar*)(ws + WS_WG8 + (size_t)l * SZ_WG8);
            S.astep = (size_t)256 * DM; S.bstep = (size_t)256 * DM;
            pg8::EpiInT<true> E{ssq, ws, rtab, rowbase};
            pg8::gemm_phase<pg8::EpiInT<true>, pg8::SchedPlain>(Fp.lds, DM / 2, DM, DM, S, E); }
          { pg8::SchedPlain S; S.T.init(M_ROWS / 256, NT_BF, Fp.G, Fp.bx, P1_WGM, P1_ROT, 122, 0); S.A = (const gchar*)(ws + WS_XB); S.B = (const gchar*)(ws + WS_WIN + (size_t)l * SZ_WIN);
            S.astep = (size_t)256 * DM * 2; S.bstep = (size_t)256 * DM * 2;
            pg8::EpiIn E{ssq, ws, rtab, rowbase};
            pg8::gemm_phase<pg8::EpiIn, pg8::SchedPlain>(Fp.lds, DM, DM, DM, S, E, (unsigned*)(ws + WS_CTL) + 256 + 64 * l, P1_LOCK); }
#else
          { pg8::SchedPlain S; S.T.init(M_ROWS / 256, NT_IN, Fp.G, Fp.bx, P1_WGM, P1_ROT); S.A = (const gchar*)(ws + WS_XB); S.B = (const gchar*)(ws + WS_WIN + (size_t)l * SZ_WIN);
            S.astep = (size_t)256 * DM * 2; S.bstep = (size_t)256 * DM * 2;
            pg8::EpiIn E{ssq, ws, rtab, rowbase};
            pg8::gemm_phase<pg8::EpiIn, pg8::SchedPlain>(Fp.lds, DM, DM, DM, S, E, (unsigned*)(ws + WS_CTL) + 256 + 64 * l, P1_LOCK); }
#endif
        }
#ifdef PROBE_P1CHEAP
        { const Ctx Fp = FL(); guchar* ws = WSL(); pg8::SchedPlain S; S.T.init(M_ROWS / 256, NT_IN, Fp.G, Fp.bx); S.A = (const gchar*)(ws + WS_XB); S.B = (const gchar*)(ws + WS_WIN + (size_t)l * SZ_WIN);
          S.astep = (size_t)256 * DM * 2; S.bstep = (size_t)256 * DM * 2;
          pg8::EpiSq E{(gbf16*)(ws + WS_END), (gfloat*)(ws + WS_END + (size_t)M_ROWS * 31488 * 2)};
          pg8::gemm_phase<pg8::EpiSq, pg8::SchedPlain>(Fp.lds, DM, DM, DM, S, E); }
#endif
        { const Ctx Fq = FL(); const int nwg_ = (M_ROWS / 256) * NT_BF, rem_ = nwg_ % Fq.G;
          if (rem_ == 0 || Fq.bx >= rem_) { const int me = rem_ ? Fq.bx - rem_ : Fq.bx, nw = rem_ ? Fq.G - rem_ : Fq.G;
            { const Ctx Fp = FL(); guchar* ws = WSL(); pg8::SchedPlain S; S.T.init(M_ROWS / 256, DM / 256, nw, me); S.A = (const gchar*)(ws + WS_PB + (size_t)l * M_ROWS * 256 * 2); S.B = (const gchar*)(ws + WS_WPP + (size_t)l * SZ_WPP);
              S.astep = (size_t)256 * 256 * 2; S.bstep = (size_t)256 * 256 * 2;
              pg8::EpiSq E{(gbf16*)(ws + WS_ERAW), (gfloat*)(ws + WS_ERP)};
              pg8::gemm_phase<pg8::EpiSq, pg8::SchedPlain>(Fp.lds, 256, 256, 256, S, E); }
            if (l == 1 && P5_I8 && TR_L1TAIL) tr_run(FL(), TR_PG1 - TR_L1TAIL, TR_PG1, 0x7fffffff, 0x7fffffff, me, nw, ARGP(const gfloat*, 4), ARGP(const gfloat*, 3), ARGP(const gfloat*, 13), ARGP(const gfloat*, 14), ARGP(const gfloat*, 18), ARGP(const gfloat*, 16), WSL());
            if (l == 0) tr_run(FL(), P5_I8 ? TR_PG0 : TR_DEFER0, P5_I8 ? TR_PG1 + 1024 : TR_DEFER1, P5_I8 ? TR_PG0 + 1024 : 0x7fffffff, P5_I8 ? TR_PG1 : 0x7fffffff, me, nw, ARGP(const gfloat*, 4), ARGP(const gfloat*, 3), ARGP(const gfloat*, 13), ARGP(const gfloat*, 14), ARGP(const gfloat*, 18), ARGP(const gfloat*, 16), WSL()); } }
#endif
#ifdef PROBE_DELAY
        if (((F.bx & 7) < 4) == (PROBE_DELAY == 1)) { const unsigned long long t0_ = __builtin_amdgcn_s_memrealtime(); while (__builtin_amdgcn_s_memrealtime() - t0_ < 3000ull) __builtin_amdgcn_s_sleep(8); }
#endif
        for (int rb_ = 0; rb_ < REP_BAR; ++rb_) xcd_barrier(bar);
#ifndef SKIP_ML
        for (int rep_ = 0; rep_ < REP_ML; ++rep_) { const Ctx Fp = FL(); guchar* ws = WSL(); for (int u = Fp.vcu; u < 256; u += Fp.G) mlstm_unit(Fp, u >> 6, (u >> 4) & 3, u & 15, ws, ARGP(const gfloat*, 10) + l * 4, ARGP(const gfloat*, 11) + l * 4, ARGP(const gfloat*, 12) + l * BW); }
#endif
#ifndef SKIP_SW
        for (int rep_ = 0; rep_ < REP_SW; ++rep_) { const Ctx Fp = FL(); guchar* ws = WSL(); for (int u = Fp.vcu; u < 256; u += Fp.G) swa_unit(Fp, u >> 6, (u >> 2) & 15, u & 3, ws, ARGP(const gfloat*, 9) + l * 32); }
#endif
#ifndef SKIP_GM
        for (int rep_ = 0; rep_ < REP_GM; ++rep_) { const Ctx Fp = FL(); guchar* ws = WSL(); for (int u = Fp.vcu; u < 512; u += Fp.G) gmlp_unit(Fp, u >> 7, (u >> 3) & 15, u & 7, ws, ARGP(const gfloat*, 5) + l * BW, ARGP(const gfloat*, 6) + l * BW, ARGP(const gfloat*, 7) + (size_t)l * 8 * 128 * 128, ARGP(const gfloat*, 8) + l * 8 * 128); }
#endif
        for (int rb_ = 0; rb_ < REP_BAR; ++rb_) xcd_barrier(bar);
#ifndef SKIP_P2B
        for (int rep_ = 0; rep_ < REP_THIN; ++rep_) p2b_finalize(FL(), WSL());
#endif
        for (int rb_ = 0; rb_ < REP_BAR; ++rb_) xcd_barrier(bar);
#ifndef PROBE_NOSTORE
#define PROBE_NOSTORE 0
#endif
#ifdef PROBE_K1024
        for (int rep_ = 0; rep_ < 4; ++rep_) { const Ctx Fp = FL(); guchar* ws = WSL(); pg8::SchedPlain S; S.T.init(M_ROWS / 256, DM / 256, Fp.G, Fp.bx); S.A = (const gchar*)(ws + WS_YA); S.B = (const gchar*)(ws + WS_WOUT + (size_t)l * SZ_WSQ);
          S.astep = (size_t)256 * DM * 2; S.bstep = (size_t)256 * DM * 2;
          pg8::EpiSq E{PROBE_NOSTORE ? (gbf16*)nullptr : (gbf16*)(ws + WS_END), (gfloat*)(ws + WS_END + (size_t)M_ROWS * 31488 * 2)};
          pg8::gemm_phase<pg8::EpiSq, pg8::SchedPlain>(Fp.lds, 1024, DM, DM, S, E); }
#endif
#ifdef PROBE_P3CHEAP
        { const Ctx Fp = FL(); guchar* ws = WSL(); pg8::SchedBranch S; S.T.init(M_ROWS / 256, DM / 256, Fp.G, Fp.bx); S.A = (const gchar*)(ws + WS_YA); S.B = (const gchar*)(ws + WS_WBR + (size_t)l * SZ_WBR);
          S.astep = (size_t)256 * BW * 2; S.bstep = (size_t)256 * BW * 2; S.aseg = SZ_ROWS_BW; S.bseg = (size_t)DM * BW * 2;
          pg8::EpiSq E{(gbf16*)(ws + WS_END), (gfloat*)(ws + WS_END + (size_t)M_ROWS * 31488 * 2)};
          pg8::gemm_phase<pg8::EpiSq, pg8::SchedBranch>(Fp.lds, BW, BW, BW, S, E); }
#endif
#ifndef SKIP_P3
        for (int rep_ = 0; rep_ < REP_P3; ++rep_) { const Ctx Fp = FL(); guchar* ws = WSL(); pg8::SchedBranch S; S.T.init(M_ROWS / 256, DM / 256, Fp.G, Fp.bx); S.A = (const gchar*)(ws + WS_YA); S.B = (const gchar*)(ws + WS_WBR + (size_t)l * SZ_WBR);
          S.astep = (size_t)256 * BW * 2; S.bstep = (size_t)256 * BW * 2; S.aseg = SZ_ROWS_BW; S.bseg = (size_t)DM * BW * 2;
          pg8::EpiBranch E{(const guchar*)(ws + WS_G), (gbf16*)(ws + WS_MIX)};
          pg8::gemm_phase<pg8::EpiBranch, pg8::SchedBranch>(Fp.lds, BW, BW, BW, S, E); }
#endif
        for (int rb_ = 0; rb_ < REP_BAR; ++rb_) xcd_barrier(bar);
#ifndef SKIP_P4
        for (int rep_ = 0; rep_ < REP_P4; ++rep_) { const Ctx Fp = FL(); guchar* ws = WSL(); pg8::SchedPlain S; S.T.init(M_ROWS / 256, DM / 256, Fp.G, Fp.bx); S.A = (const gchar*)(ws + WS_MIX); S.B = (const gchar*)(ws + WS_WOUT + (size_t)l * SZ_WSQ);
          S.astep = (size_t)256 * DM * 2; S.bstep = (size_t)256 * DM * 2;
          pg8::EpiSq E{(gbf16*)(ws + WS_OUT), (gfloat*)(ws + WS_OUTP)};
          pg8::gemm_phase<pg8::EpiSq, pg8::SchedPlain>(Fp.lds, DM, DM, DM, S, E); }
#endif
        for (int rb_ = 0; rb_ < REP_BAR; ++rb_) xcd_barrier(bar);
#ifndef SKIP_P4B
        for (int rep_ = 0; rep_ < REP_THIN; ++rep_) p4b_x1(FL(), WSL(), ARGP(const gfloat*, 15) + l * DM);
#endif
        for (int rb_ = 0; rb_ < REP_BAR; ++rb_) xcd_barrier(bar);
#ifndef SKIP_P5
        { const Ctx Fp = FL(); guchar* ws = WSL(); pg8::SchedPlain S; S.T.init(M_ROWS / 256, DM / 256, Fp.G, Fp.bx); S.A = (const gchar*)(ws + ((P5_FP8 || P5_I8) ? WS_X1B8 : WS_X1B)); S.B = (const gchar*)(ws + WS_WPG + (size_t)l * SZ_WSQ);
          S.astep = (size_t)256 * DM * ((P5_FP8 || P5_I8) ? 1 : 2); S.bstep = (size_t)256 * DM * ((P5_FP8 || P5_I8) ? 1 : 2);
          pg8::EpiPle E{(const gbf16*)(ws + WS_X1B), ARGP(gfloat*, 19), (gbf16*)(ws + WS_XB), (const gbf16*)(ws + WS_ERAW), (const gfloat*)(ws + WS_RSE), ARGP(const gfloat*, 17) + l * DM, (gfloat*)(ws + WS_XSP), l == NLAYER - 1 ? 1 : 0, ws + WS_XB8, (const gfloat*)(ws + WS_RSX), __uint_as_float(((const gunsigned*)(ws + WS_CTL))[CW_WMAX + l]) * (1.0f / 127.0f)};
          pg8::gemm_phase<pg8::EpiPle, pg8::SchedPlain>(Fp.lds, (P5_FP8 || P5_I8) ? DM / 2 : DM, DM, DM, S, E); }
#endif
        if (l + 1 < NLAYER) { for (int rb_ = 0; rb_ < REP_BAR; ++rb_) xcd_barrier(bar); p5b_ssq(FL(), WSL()); for (int rb_ = 0; rb_ < REP_BAR; ++rb_) xcd_barrier(bar); }
    };
    static_assert(NLAYER == 2, "two layer bodies");
    layer_body(0); layer_body(1);
}

extern "C" void kernel_launch(void* const* d_in, const int* in_sizes, int n_in, void* d_out, int out_size, void* d_ws, size_t ws_size, hipStream_t stream) {
    static int grid = 0;
    if (grid == 0) {
        if (n_in != 19 || out_size != M_ROWS * DM || ws_size < WS_END) { fprintf(stderr, "kernel_launch: unexpected problem (n_in %d, out %d, ws %zu, need %zu)\n", n_in, out_size, ws_size, (size_t)WS_END); grid = -1; return; }
        int dev = 0, cus = 0;
        if (hipGetDevice(&dev) != hipSuccess || hipDeviceGetAttribute(&cus, hipDeviceAttributeMultiprocessorCount, dev) != hipSuccess) { grid = -1; return; }
        if (hipFuncSetAttribute((const void*)fwd_kernel, hipFuncAttributeMaxDynamicSharedMemorySize, LDS_BYTES) != hipSuccess) { fprintf(stderr, "kernel_launch: hipFuncSetAttribute failed\n"); grid = -1; return; }
        int per_cu = 0; (void)hipOccupancyMaxActiveBlocksPerMultiprocessor(&per_cu, (const void*)fwd_kernel, NTHREADS, LDS_BYTES); (void)hipGetLastError();
        if (per_cu < 1) fprintf(stderr, "kernel_launch: occupancy query reports %d blocks per CU\n", per_cu);
        grid = cus > 256 ? 256 : cus;
    }
    if (grid < 0) return;
    (void)hipMemsetAsync((char*)d_ws + WS_CTL, 0, CTL_ZERO_BYTES, stream);
    Args a{};
    for (int i = 0; i < 19; ++i) a.in[i] = d_in[i];
    a.out = (float*)d_out; a.ws = (unsigned char*)d_ws;
    hipLaunchKernelGGL(fwd_kernel, dim3(grid), dim3(NTHREADS), LDS_BYTES, stream, a);
    const hipError_t le = hipPeekAtLastError();
    if (le != hipSuccess) fprintf(stderr, "kernel_launch: launch failed: %s\n", hipGetErrorName(le));
}
```

```cpp
#include <hip/hip_runtime.h>
#include <cstdio>
#include <cstdint>

#define LAS __attribute__((address_space(3)))
#define GAS __attribute__((address_space(1)))
typedef unsigned short bf16_t;
typedef short bf16x8 __attribute__((ext_vector_type(8)));
typedef float f32x4 __attribute__((ext_vector_type(4)));
typedef float f32x2 __attribute__((ext_vector_type(2)));
typedef unsigned u32x4 __attribute__((ext_vector_type(4)));
typedef unsigned u32x2 __attribute__((ext_vector_type(2)));

typedef GAS float gfloat; typedef GAS bf16_t gbf16; typedef GAS int gint; typedef GAS char gchar; typedef GAS unsigned char guchar; typedef GAS unsigned gunsigned;
typedef GAS f32x4 gf32x4; typedef GAS f32x2 gf32x2; typedef GAS u32x4 gu32x4; typedef GAS u32x2 gu32x2;
constexpr int M_ROWS = 8192, SEQ = 2048, DM = 4096, BW = 2048, NLAYER = 2;
constexpr int N_IN = 31240, IF_COL = 14848;
constexpr int NT_IN = 123;
constexpr int N_IN_T = NT_IN * 256;
constexpr float NORM_EPS = 1e-6f;

__device__ __forceinline__ unsigned cvt_pk_bf16(float lo, float hi) { unsigned r; asm("v_cvt_pk_bf16_f32 %0, %1, %2" : "=v"(r) : "v"(lo), "v"(hi)); return r; }
__device__ __forceinline__ float bf_lo(unsigned w) { return __uint_as_float(w << 16); }
__device__ __forceinline__ float bf_hi(unsigned w) { return __uint_as_float(w & 0xffff0000u); }
__device__ __forceinline__ float bf1(bf16_t b) { return __uint_as_float(((unsigned)b) << 16); }
__device__ __forceinline__ float fsigmoid(float x) { return __builtin_amdgcn_rcpf(1.0f + __expf(-x)); }
__device__ __forceinline__ float wave_sum(float v) {
#pragma unroll
    for (int o = 1; o < 64; o <<= 1) v += __shfl_xor(v, o);
    return v;
}
__device__ __forceinline__ f32x2 gelu_pk(f32x2 v) {
    const f32x2 av = __builtin_elementwise_abs(v), d = av * 0.2316418882f + 1.0f;
    f32x2 t; t.x = __builtin_amdgcn_rcpf(d.x); t.y = __builtin_amdgcn_rcpf(d.y);
    f32x2 q = t * 0.5307027145f + (-0.7265760135f); q = q * t + 0.7107068705f; q = q * t + (-0.142248368f); q = q * t + 0.127414796f; q = q * t;
    const f32x2 s = (v * v) * (-0.72134752044f);
    f32x2 e; e.x = __builtin_amdgcn_exp2f(s.x); e.y = __builtin_amdgcn_exp2f(s.y);
    const f32x2 m = v * (q * e), r = v - m;
    f32x2 o; o.x = v.x < 0.f ? m.x : r.x; o.y = v.y < 0.f ? m.y : r.y; return o;
}
typedef int i32x8 __attribute__((ext_vector_type(8)));
typedef short s16x16 __attribute__((ext_vector_type(16)));
__host__ __device__ __forceinline__ size_t ablk8(int row, int col, int K) { return ((size_t)(row >> 8) * (K >> 7) + (col >> 7)) * 32768 + (size_t)(row & 255) * 128 + (col & 127); }
__device__ __forceinline__ unsigned pack_fp8x4(float a, float b, float c, float d) { int w = 0; w = __builtin_amdgcn_cvt_pk_fp8_f32(a, b, w, false); w = __builtin_amdgcn_cvt_pk_fp8_f32(c, d, w, true); return (unsigned)w; }
__device__ __forceinline__ unsigned pack_i8x4(float a, float b, float c, float d) {
    const int q0 = min(max(__float2int_rn(a), -127), 127), q1 = min(max(__float2int_rn(b), -127), 127), q2 = min(max(__float2int_rn(c), -127), 127), q3 = min(max(__float2int_rn(d), -127), 127);
    return ((unsigned)q0 & 0xffu) | (((unsigned)q1 & 0xffu) << 8) | (((unsigned)q2 & 0xffu) << 16) | ((unsigned)q3 << 24);
}
__host__ __device__ __forceinline__ size_t ablk(int row, int col, int K) { return ((size_t)(row >> 8) * (K >> 6) + (col >> 6)) * 16384 + (size_t)(row & 255) * 64 + (col & 63); }
__host__ __device__ __forceinline__ size_t tb256(int row, int col, int nt) { return ((size_t)(row >> 8) * nt + (col >> 8)) * 65536 + (size_t)(row & 255) * 256 + (col & 255); }
__host__ __device__ __forceinline__ size_t tb128(int row, int col, int nt) { return ((size_t)(row >> 8) * nt + (col >> 7)) * 32768 + (size_t)(row & 255) * 128 + (col & 127); }
#define LAUNDER_V(x) asm volatile("" : "+v"(x))
#define LAUNDER_S(x) asm volatile("" : "+s"(x))
#define LDS_WAIT() asm volatile("s_waitcnt lgkmcnt(0)" ::: "memory")
#define VM_WAIT() asm volatile("s_waitcnt vmcnt(0)" ::: "memory")
#define MFMA16(a, b, c) __builtin_amdgcn_mfma_f32_16x16x32_bf16((a), (b), (c), 0, 0, 0)

#define XB_TMO      128
#define XB_XCNT(j)  (256  + 64 * (j))
#define XB_XSUB(j)  (1280 + 64 * (j))
#define XB_XGEN(j)  (2304 + 64 * (j))
#define XB_TOP      3328
#define XB_TOPGEN   3392
#define XCD_BAR_WORDS 3456
#define XB_SPIN_CAP (1u << 18)
__device__ __forceinline__ unsigned xb_ld(unsigned* p)              { return __hip_atomic_load(p, __ATOMIC_RELAXED, __HIP_MEMORY_SCOPE_AGENT); }
__device__ __forceinline__ unsigned xb_add(unsigned* p, unsigned v) { return __hip_atomic_fetch_add(p, v, __ATOMIC_RELAXED, __HIP_MEMORY_SCOPE_AGENT); }
__device__ __forceinline__ unsigned xb_xcc_id() { return (unsigned)__builtin_amdgcn_s_getreg((3 << 11) | 20) & 0xFu; }
#define XB_SPIN(cond, bar) do { unsigned _sp = 0; while (cond) { __builtin_amdgcn_s_sleep(1); \
    if ((++_sp & 255u) == 0u) { if (xb_ld(&(bar)[XB_TMO])) break; if (_sp > XB_SPIN_CAP) { atomicAdd(&(bar)[XB_TMO], 1u); break; } } } } while (0)
struct XcdBarrier { unsigned* bar; unsigned x; volatile LAS unsigned* st; };
__device__ __forceinline__ XcdBarrier xcd_barrier_post(unsigned* bar, volatile LAS unsigned* st) {
    XcdBarrier b; b.bar = bar; b.x = xb_xcc_id(); b.st = st;
    if (threadIdx.x == 0) (void)xb_add(&bar[XB_XCNT(b.x)], 1u);
    return b;
}
__device__ __forceinline__ void xcd_barrier_complete(unsigned* bar, unsigned x, unsigned& nloc, unsigned& nx) {
    const unsigned G = gridDim.x * gridDim.y * gridDim.z;
    unsigned sum, cnt, mine, sp = 0u;
    for (;;) {
        sum = 0u; cnt = 0u; mine = 0u;
#pragma unroll
        for (unsigned j = 0; j < 16; ++j) { const unsigned c = xb_ld(&bar[XB_XCNT(j)]); sum += c; cnt += (c > 0u) ? 1u : 0u; mine = (j == x) ? c : mine; }
        if (sum == G) break;
        __builtin_amdgcn_s_sleep(1);
        if ((++sp & 255u) == 0u) { if (xb_ld(&bar[XB_TMO])) break; if (sp > XB_SPIN_CAP) { atomicAdd(&bar[XB_TMO], 1u); break; } }
    }
    nloc = mine > 0u ? mine : 1u; nx = cnt > 0u ? cnt : 1u;
}
__device__ __forceinline__ void xcd_barrier(const XcdBarrier& b) {
    asm volatile("s_waitcnt vmcnt(0)" ::: "memory");
    __syncthreads();
    if (threadIdx.x == 0) {
        unsigned* bar = b.bar;
        __builtin_amdgcn_s_waitcnt(0);
        unsigned nloc = b.st[0], nx = b.st[1];
        if (nloc == 0u) { xcd_barrier_complete(bar, b.x, nloc, nx); b.st[0] = nloc; b.st[1] = nx; }
        const unsigned old = xb_add(&bar[XB_XSUB(b.x)], 1u);
        const unsigned gen = old / nloc;
        if (old + 1u == (gen + 1u) * nloc) {
            __builtin_amdgcn_fence(__ATOMIC_RELEASE, "agent");
            asm volatile("s_waitcnt vmcnt(0)" ::: "memory");
            const unsigned og = xb_add(&bar[XB_TOP], 1u);
            const unsigned tg = og / nx;
            if (og + 1u == (tg + 1u) * nx) xb_add(&bar[XB_TOPGEN], 1u);
            else XB_SPIN(xb_ld(&bar[XB_TOPGEN]) == tg, bar);
            __builtin_amdgcn_fence(__ATOMIC_ACQUIRE, "agent");
            xb_add(&bar[XB_XGEN(b.x)], 1u);
            asm volatile("s_waitcnt vmcnt(0)" ::: "memory");
        } else {
            XB_SPIN(xb_ld(&bar[XB_XGEN(b.x)]) == gen, bar);
            __builtin_amdgcn_fence(__ATOMIC_ACQUIRE, "agent");
            asm volatile("s_waitcnt vmcnt(0)" ::: "memory");
        }
    }
    __syncthreads();
}

#ifndef WGM_DEFAULT
#define WGM_DEFAULT 4
#endif
#ifndef PG8_SADDR
#define PG8_SADDR 1
#endif
namespace pg8 {
constexpr int BM = 256, BK = 64, HALF = 128, HTB = HALF * BK * 2, STAGE_BYTES = 8 * HTB, NXCD = 8, WGM = WGM_DEFAULT;
__host__ __device__ __forceinline__ int lds_byte(int r, int c) { const int st = (r >> 4) * 2 + (c >> 5), rr = r & 15, cc = c & 31, ob = rr * 64 + cc * 2; return st * 1024 + (ob ^ (((ob >> 9) & 1) << 5)); }
__host__ __device__ __forceinline__ void stage_rc(int b, int& R, int& C) { const int st = b / 1024, sb = b % 1024, swz = sb ^ (((sb >> 9) & 1) << 5); R = (st >> 1) * 16 + swz / 64; C = (st & 1) * 32 + (swz % 64) / 2; }
__host__ __device__ __forceinline__ int perm32(int rho) { const int n = rho >> 4, i = rho & 15; return 8 * (i >> 2) + 4 * n + (i & 3); }

struct Unit { int pm, pn, seg; };

struct TileOrder {
    int nM, nN, nwg, G, c, wgm, rot, tailtile, pnoff;
    __device__ __forceinline__ void init(int nM_, int nN_, int G_, int c_, int wgm_ = WGM, int rot_ = 0, int tailtile_ = -1, int pnoff_ = 0) { nM = nM_; nN = nN_; nwg = nM * nN; G = G_; c = c_; wgm = wgm_; rot = rot_; tailtile = tailtile_; pnoff = pnoff_; }
    __device__ __forceinline__ bool tile(int i, int& pm, int& pn) const {
        const long L = (long)i * G + c; if (L >= nwg) return false;
        int wgid = (int)L; const int xcd = wgid % NXCD; { const int q = nwg / NXCD, r = nwg % NXCD, off = wgid / NXCD; wgid = (xcd < r ? xcd * (q + 1) : r * (q + 1) + (xcd - r) * q) + off; }
        const int nig = wgm * nN, gid = wgid / nig, fm = gid * wgm, gsz = (nM - fm) < wgm ? (nM - fm) : wgm;
        pm = fm + ((wgid % nig) % gsz); pn = (wgid % nig) / gsz; if (rot) { pn += rot * xcd; pn -= (pn / nN) * nN; } if (tailtile >= 0 && pn == nN - 1) pn = tailtile; pn += pnoff; return true;
    }
};
struct SchedPlain {
    TileOrder T; const gchar* A; const gchar* B; size_t astep, bstep;
    __device__ __forceinline__ bool next(int i, Unit& u) const { u.seg = 0; return T.tile(i, u.pm, u.pn); }
    __device__ __forceinline__ const gchar* a_ptr(const Unit& u) const { return A + (size_t)u.pm * astep; }
    int pn0 = 0;
    __device__ __forceinline__ const gchar* b_ptr(const Unit& u) const { return B + (size_t)(u.pn - pn0) * bstep; }
};
struct SchedBranch {
    TileOrder T; const gchar* A; const gchar* B; size_t astep, bstep, aseg, bseg;
    __device__ __forceinline__ bool next(int i, Unit& u) const { const int t = i / 3; u.seg = i - 3 * t; return T.tile(t, u.pm, u.pn); }
    __device__ __forceinline__ const gchar* a_ptr(const Unit& u) const { return A + (size_t)u.seg * aseg + (size_t)u.pm * astep; }
    __device__ __forceinline__ const gchar* b_ptr(const Unit& u) const { return B + (size_t)u.seg * bseg + (size_t)u.pn * bstep; }
};

template <class Epi, class Sched>
__device__ __forceinline__ void gemm_phase(LAS unsigned char* lds, const int K, const int lda, const int ldb, const Sched& S, const Epi& E, unsigned* lockctr = nullptr, const int nlock = 0) {
    int tid = threadIdx.x; LAUNDER_V(tid);
    const int wid = __builtin_amdgcn_readfirstlane(tid >> 6), lane = tid & 63, wr = wid >> 2, wc = wid & 3, fr = lane & 15, fq = lane >> 4;
    const int nt = K / BK;
    unsigned voffA, voffB;
    { int R, C; stage_rc(tid * 16, R, C); const int Rb = Epi::PERM ? ((R & ~31) + perm32(R & 31)) : R;
      voffA = (unsigned)(R * BK + C) * 2u; voffB = (unsigned)(Rb * BK + C) * 2u; }
    const unsigned qstepA = 64u * (unsigned)BK * 2u, qstepB = 64u * (unsigned)BK * 2u;
    const size_t kstep = (size_t)BM * BK * 2, kstepB = (size_t)BM * BK * 2;
    const size_t hstepA = (size_t)HALF * BK * 2, hstepB = (size_t)HALF * BK * 2;
    const unsigned ldsw = (unsigned)wid * 1024u;
    const int aoff = lds_byte(wr * 64 + fr, fq * 8), boff = lds_byte(wc * 32 + fr, fq * 8);
#define PG8_SA(b, h) (((b) * 2 + (h)) * HTB)
#define PG8_SB(b, h) ((4 + (b) * 2 + (h)) * HTB)
#if PG8_SADDR
#define PG8_STAGE(bufoff, gbase, voff) do { _Pragma("unroll") for (int _i = 0; _i < 2; ++_i) { const gchar* p_ = (const gchar*)(gbase) + (size_t)_i * q##voff; asm volatile("" : "+s"(p_)); \
        __builtin_amdgcn_global_load_lds((const gunsigned*)(p_ + (voff)), (LAS unsigned*)(lds + (bufoff) + ldsw + _i * 8192), 16, 0, 0); } } while (0)
#else
#define PG8_STAGE(bufoff, gbase, voff) do { _Pragma("unroll") for (int _i = 0; _i < 2; ++_i) \
        __builtin_amdgcn_global_load_lds((const gunsigned*)((const gchar*)(gbase) + (size_t)_i * q##voff + (voff)), (LAS unsigned*)(lds + (bufoff) + ldsw + _i * 8192), 16, 0, 0); } while (0)
#endif
#define qvoffA qstepA
#define qvoffB qstepB
#define PG8_LDA(dst, b, h) do { _Pragma("unroll") for (int m = 0; m < 4; ++m) _Pragma("unroll") for (int k = 0; k < 2; ++k) dst[m][k] = *(const LAS bf16x8*)(lds + PG8_SA(b, h) + aoff + m * 2048 + k * 1024); } while (0)
#define PG8_LDB(dst, b, h) do { _Pragma("unroll") for (int n = 0; n < 2; ++n) _Pragma("unroll") for (int k = 0; k < 2; ++k) dst[n][k] = *(const LAS bf16x8*)(lds + PG8_SB(b, h) + boff + n * 2048 + k * 1024); } while (0)
#define PG8_CAT(x_, y_) __builtin_bit_cast(i32x8, __builtin_shufflevector((x_), (y_), 0, 1, 2, 3, 4, 5, 6, 7, 8, 9, 10, 11, 12, 13, 14, 15))
#define PG8_MMA(ai, bj, At, Bt) do { __builtin_amdgcn_s_setprio(1); _Pragma("unroll") for (int m = 0; m < 4; ++m) _Pragma("unroll") for (int n = 0; n < 2; ++n) { \
        if constexpr (Epi::FP8) { const i32x8 b8_ = PG8_CAT(Bt[n][0], Bt[n][1]), a8_ = PG8_CAT(At[m][0], At[m][1]); \
            asm volatile("s_nop 1\n\tv_mfma_scale_f32_16x16x128_f8f6f4 %0, %1, %2, %0, %3, %3 op_sel_hi:[0,0,0]" : "+v"(acc[ai][bj][m][n]) : "v"(b8_), "v"(a8_), "v"(sc8)); } \
        else if constexpr (Epi::I8) { _Pragma("unroll") for (int k = 0; k < 2; ++k) asm volatile("s_nop 1\n\tv_mfma_i32_16x16x64_i8 %0, %1, %2, %0" : "+v"(acc[ai][bj][m][n]) : "v"(Bt[n][k]), "v"(At[m][k])); } \
        else { _Pragma("unroll") for (int k = 0; k < 2; ++k) acc[ai][bj][m][n] = __builtin_amdgcn_mfma_f32_16x16x32_bf16(Bt[n][k], At[m][k], acc[ai][bj][m][n], 0, 0, 0); } } __builtin_amdgcn_s_setprio(0); } while (0)
#define PG8_WAIT_V(n) asm volatile("s_waitcnt vmcnt(" #n ")" ::: "memory")
#define PG8_WAIT_VR() do { if constexpr (Epi::NS == 16) asm volatile("s_waitcnt vmcnt(24)" ::: "memory"); else if constexpr (Epi::NS == 32) asm volatile("s_waitcnt vmcnt(40)" ::: "memory"); else asm volatile("s_waitcnt vmcnt(8)" ::: "memory"); } while (0)
#define PG8_WAIT_L(n) asm volatile("s_waitcnt lgkmcnt(" #n ")" ::: "memory")
#define PG8_BAR __builtin_amdgcn_s_barrier()
#define PG8_SCHED __builtin_amdgcn_sched_barrier(0)
    Unit cur, nxt; int ui = 0; bool relax_next = false;
    int sc8 = 0x7f7f7f7f; asm volatile("" : "+v"(sc8));
    if (!S.next(0, cur)) return;
    f32x4 acc[2][2][4][2];
#pragma unroll
    for (int a = 0; a < 2; ++a)
#pragma unroll
        for (int b = 0; b < 2; ++b)
#pragma unroll
            for (int m = 0; m < 4; ++m)
#pragma unroll
                for (int n = 0; n < 2; ++n) acc[a][b][m][n] = (f32x4){0.f, 0.f, 0.f, 0.f};
    bf16x8 At[4][2], B0[2][2], B1[2][2];
    const gchar* cA = S.a_ptr(cur); const gchar* cB = S.b_ptr(cur);
    PG8_STAGE(PG8_SB(0, 0), cB, voffB); PG8_STAGE(PG8_SB(0, 1), cB + hstepB, voffB); PG8_STAGE(PG8_SA(0, 0), cA, voffA); PG8_STAGE(PG8_SA(0, 1), cA + hstepA, voffA);
    if (wr == 1) PG8_BAR;
    PG8_WAIT_V(2); PG8_BAR;
    PG8_STAGE(PG8_SB(1, 0), cB + kstepB, voffB); PG8_STAGE(PG8_SA(1, 0), cA + kstep, voffA); PG8_STAGE(PG8_SB(1, 1), cB + hstepB + kstepB, voffB);
    PG8_WAIT_V(6); PG8_BAR;
    for (;;) {
        const bool has_next = S.next(ui + 1, nxt);
        const gchar* nA = has_next ? S.a_ptr(nxt) : cA; const gchar* nB = has_next ? S.b_ptr(nxt) : cB;
        for (int t = 0; t < nt; t += 2) {
            const bool last = (t == nt - 2); const bool relax = Epi::NS > 0 && (t == 0) && relax_next;
#if PG8_SADDR
            asm volatile("" : "+v"(voffA), "+v"(voffB));
#endif
            const gchar* a1 = cA + (size_t)(t + 1) * kstep;
            const gchar* a2 = last ? nA : cA + (size_t)(t + 2) * kstep; const gchar* b2 = last ? nB : cB + (size_t)(t + 2) * kstepB;
            const gchar* a3 = a2 + kstep; const gchar* b3 = b2 + kstepB;
            PG8_LDB(B0, 0, 0); PG8_LDB(B1, 0, 1); PG8_SCHED; PG8_LDA(At, 0, 0); PG8_STAGE(PG8_SA(1, 1), a1 + hstepA, voffA);
            if (relax) PG8_WAIT_VR(); else PG8_WAIT_V(8); PG8_WAIT_L(0); PG8_BAR; PG8_MMA(0, 0, At, B0); PG8_MMA(0, 1, At, B1); PG8_BAR; PG8_SCHED;
            PG8_LDA(At, 0, 1); PG8_STAGE(PG8_SB(0, 0), b2, voffB); PG8_STAGE(PG8_SB(0, 1), b2 + hstepB, voffB); PG8_STAGE(PG8_SA(0, 0), a2, voffA);
            if (relax) PG8_WAIT_VR(); else PG8_WAIT_V(8); PG8_WAIT_L(0); PG8_BAR; PG8_MMA(1, 0, At, B0); PG8_MMA(1, 1, At, B1); PG8_BAR; PG8_SCHED;
            PG8_LDB(B0, 1, 0); PG8_LDB(B1, 1, 1); PG8_SCHED; PG8_LDA(At, 1, 0); PG8_STAGE(PG8_SA(0, 1), a2 + hstepA, voffA);
            PG8_WAIT_V(8); PG8_WAIT_L(0); PG8_BAR; PG8_MMA(0, 0, At, B0); PG8_MMA(0, 1, At, B1); PG8_BAR; PG8_SCHED;
            PG8_LDA(At, 1, 1); PG8_STAGE(PG8_SB(1, 0), b3, voffB); PG8_STAGE(PG8_SB(1, 1), b3 + hstepB, voffB); PG8_STAGE(PG8_SA(1, 0), a3, voffA);
            PG8_WAIT_V(8); PG8_WAIT_L(0); PG8_BAR; PG8_MMA(1, 0, At, B0); PG8_MMA(1, 1, At, B1); PG8_BAR; PG8_SCHED;
        }
        if constexpr (Epi::FP8 || Epi::I8) asm volatile("s_nop 15\n\ts_nop 15\n\ts_nop 15\n\ts_nop 15" ::: "memory");
        if (wr == 0) PG8_BAR;
        { const int ln_ = (int)__builtin_amdgcn_mbcnt_hi(~0u, __builtin_amdgcn_mbcnt_lo(~0u, 0u)); E(acc, cur, wr, wc, ln_ & 15, ln_ >> 4); } relax_next = E.relax(cur);
        if (ui < nlock) {
            if (tid == 0) { (void)xb_add(lockctr, 1u); const unsigned tgt_ = (unsigned)(ui + 1) * (unsigned)S.T.G; unsigned sp_ = 0u; while (xb_ld(lockctr) < tgt_) { __builtin_amdgcn_s_sleep(1); if (++sp_ > (1u << 20)) break; } }
            PG8_BAR; }
        if (!has_next) break;
        if (!E.keep(cur)) {
#pragma unroll
            for (int a = 0; a < 2; ++a)
#pragma unroll
                for (int b = 0; b < 2; ++b)
#pragma unroll
                    for (int m = 0; m < 4; ++m)
#pragma unroll
                        for (int n = 0; n < 2; ++n) acc[a][b][m][n] = (f32x4){0.f, 0.f, 0.f, 0.f};
        }
        cur = nxt; cA = nA; cB = nB; ++ui;
        if (wr == 1) PG8_BAR;
    }
    PG8_WAIT_V(0);
    PG8_BAR;
#undef PG8_SA
#undef PG8_SB
#undef PG8_STAGE
#undef qvoffA
#undef qvoffB
#undef PG8_LDA
#undef PG8_LDB
#undef PG8_MMA
#undef PG8_CAT
#undef PG8_WAIT_V
#undef PG8_WAIT_VR
#undef PG8_WAIT_L
#undef PG8_BAR
#undef PG8_SCHED
}
}

constexpr size_t MiB = 1u << 20;
constexpr size_t WS_CTL = 0, CTL_ZERO_BYTES = 1 * MiB;
constexpr int CW_BAR = 4096;
constexpr size_t CTL_SSQ1 = 256 * 1024;
constexpr size_t SZ_WIN = (size_t)N_IN_T * DM * 2, SZ_WBR = (size_t)3 * DM * BW * 2, SZ_WSQ = (size_t)DM * DM * 2, SZ_WPP = (size_t)DM * 256 * 2;
constexpr size_t WS_WIN = 2 * MiB;
constexpr size_t WS_WBR = WS_WIN + 2 * SZ_WIN;
constexpr size_t WS_WOUT = WS_WBR + 2 * SZ_WBR;
constexpr size_t WS_WPG = WS_WOUT + 2 * SZ_WSQ;
constexpr size_t WS_WPP = WS_WPG + 2 * SZ_WSQ;
constexpr size_t SZ_ROWS_BW = (size_t)M_ROWS * BW * 2, SZ_ROWS_D = (size_t)M_ROWS * DM * 2;
constexpr size_t WS_XB = WS_WPP + 2 * SZ_WPP;
constexpr size_t WS_PB = WS_XB + SZ_ROWS_D;
constexpr size_t WS_CS = WS_PB + (size_t)2 * M_ROWS * 256 * 2;
constexpr size_t WS_SSQ0 = WS_CS + (size_t)M_ROWS * 16 * 4;
constexpr size_t WS_AU = WS_SSQ0 + (size_t)M_ROWS * 4;
constexpr size_t WS_AV = WS_AU + SZ_ROWS_BW, WS_AZ = WS_AV + SZ_ROWS_BW, WS_BQ = WS_AZ + SZ_ROWS_BW;
constexpr size_t WS_BK = WS_BQ + SZ_ROWS_BW;
constexpr size_t WS_BV = WS_BK + (size_t)M_ROWS * 256 * 2;
constexpr size_t WS_BZ = WS_BV + (size_t)M_ROWS * 256 * 2;
constexpr size_t WS_CQ = WS_BZ + SZ_ROWS_BW;
constexpr size_t WS_CK = WS_CQ + (size_t)M_ROWS * 1024 * 2;
constexpr size_t WS_CV = WS_CK + (size_t)M_ROWS * 1024 * 2;
constexpr size_t WS_CO = WS_CV + SZ_ROWS_BW, WS_CZ = WS_CO + SZ_ROWS_BW;
constexpr size_t WS_G = WS_CZ + SZ_ROWS_BW;
constexpr size_t WS_IF = WS_G + (size_t)M_ROWS * 12288 * 2;
constexpr size_t WS_LNP = WS_IF + (size_t)M_ROWS * 8 * 4;
constexpr size_t WS_YA = WS_LNP + (size_t)M_ROWS * 32 * 8;
constexpr size_t WS_NUM = WS_YA + 3 * SZ_ROWS_BW;
constexpr size_t WS_SSQC = WS_NUM + SZ_ROWS_BW;
constexpr size_t WS_DN = WS_SSQC + (size_t)M_ROWS * 64 * 4;
constexpr size_t WS_MIX = WS_DN + (size_t)M_ROWS * 4 * 4;
constexpr size_t WS_OUT = WS_MIX + SZ_ROWS_D;
constexpr size_t WS_OUTP = WS_OUT + SZ_ROWS_D;
constexpr size_t WS_ERAW = WS_OUTP + (size_t)M_ROWS * 64 * 4;
constexpr size_t WS_ERP = WS_ERAW + SZ_ROWS_D;
constexpr size_t WS_RSO = WS_ERP + (size_t)M_ROWS * 64 * 4;
constexpr size_t WS_RSE = WS_RSO + (size_t)M_ROWS * 4;
constexpr size_t WS_X1B = WS_RSE + (size_t)M_ROWS * 4;
constexpr size_t WS_XSP = WS_X1B + SZ_ROWS_D;
constexpr size_t WS_X1B8 = WS_XSP + (size_t)M_ROWS * 64 * 4;
constexpr size_t WS_RSX = WS_X1B8 + (size_t)M_ROWS * DM;
constexpr size_t WS_XB8 = WS_RSX + (size_t)M_ROWS * 4;
constexpr size_t SZ_WG8 = (size_t)56 * 256 * DM;
constexpr size_t WS_WG8 = WS_XB8 + (size_t)M_ROWS * DM;
constexpr size_t WS_END = WS_WG8 + 2 * SZ_WG8;
static_assert(WS_WIN % 256 == 0 && WS_XB % 256 == 0 && WS_AU % 256 == 0 && WS_G % 256 == 0 && WS_YA % 256 == 0 && WS_MIX % 256 == 0 && WS_X1B % 256 == 0, "alignment");

#ifndef EPIIN_NT
#define EPIIN_NT 0
#endif
#if EPIIN_NT
#define EPIIN_STORE(v, p) __builtin_nontemporal_store((v), (p))
#else
#define EPIIN_STORE(v, p) (*(p) = (v))
#endif
#ifndef DBG_ZERO_ASC
#define DBG_ZERO_ASC 0
#endif
#ifndef P1G_FP8
#define P1G_FP8 1
#endif
#ifndef P5_I8
#define P5_I8 1
#endif
constexpr int CW_WMAX = 512;
#ifndef P5_FP8
#define P5_FP8 0
#endif
constexpr float W8_SCALE = 256.0f;
#ifndef EPI_NS16
#define EPI_NS16 0
#endif
#ifndef EPI_NS32
#define EPI_NS32 0
#endif
#ifndef EPIIN_NS
#define EPIIN_NS 0
#endif
namespace pg8 {
__device__ __forceinline__ unsigned pack_u8x4(float a, float b, float c, float d) {
    const unsigned q0 = (unsigned)(a * 255.0f + 0.5f), q1 = (unsigned)(b * 255.0f + 0.5f), q2 = (unsigned)(c * 255.0f + 0.5f), q3 = (unsigned)(d * 255.0f + 0.5f);
    return q0 | (q1 << 8) | (q2 << 16) | (q3 << 24);
}
template <bool F8> struct EpiInT {
    static constexpr bool PERM = true; static constexpr int NS = EPIIN_NS; static constexpr bool FP8 = F8; static constexpr bool I8 = false;
    __device__ __forceinline__ bool relax(const Unit& u) const { return u.pn < 122; }
    const gfloat* ssq; guchar* ws; const LAS float* rtab; int rowbase;
    __device__ __forceinline__ float rstd_of(int row) const { return rowbase >= 0 ? rtab[row - rowbase] : rsqrtf(ssq[row] * (1.0f / DM) + NORM_EPS); }
    __device__ __forceinline__ bool keep(const Unit&) const { return false; }
    __device__ __forceinline__ void operator()(f32x4 (&acc)[2][2][4][2], const Unit& u, int wr, int wc, int fr, int fq) const {
        const int pn = u.pn; const int row0 = u.pm * BM + wr * 64 + fr;
        size_t off; int ldc, t0, act; float sc = 1.f;
        if (F8)            { if (pn < 122) { off = WS_G; ldc = 12288; t0 = 74; act = 3; } else { off = WS_CO; ldc = 2048; t0 = 122; act = 8; } sc = 1.0f / W8_SCALE; }
        else if (pn < 16)  { off = WS_AU; ldc = 2048; t0 = 0; act = 6; }
        else if (pn < 24)  { off = WS_AV; ldc = 2048; t0 = 16; act = 5; }
        else if (pn < 32)  { off = WS_BQ; ldc = 2048; t0 = 24; act = 0; }
        else if (pn < 33)  { off = WS_BK; ldc = 256; t0 = 32; act = 0; }
        else if (pn < 34)  { off = WS_BV; ldc = 256; t0 = 33; act = 0; }
        else if (pn < 42)  { off = WS_BZ; ldc = 2048; t0 = 34; act = 2; }
        else if (pn < 46)  { off = WS_CQ; ldc = 1024; t0 = 42; act = 0; sc = 0.0625f; }
        else if (pn < 50)  { off = WS_CK; ldc = 1024; t0 = 46; act = 0; }
        else if (pn < 58)  { off = WS_CV; ldc = 2048; t0 = 50; act = 0; }
        else if (pn < 66)  { off = WS_CZ; ldc = 2048; t0 = 58; act = 2; }
        else               { off = WS_IF; ldc = 8; t0 = 122; act = 4; }
        const int col0 = (pn - t0) * BM + wc * 32 + 8 * fq;
        if (!F8 && act == 4) {
            if (wc == 0 && fq == 0) {
                gfloat* dst = (gfloat*)(ws + off);
#pragma unroll
                for (int ai = 0; ai < 2; ++ai)
#pragma unroll
                    for (int m = 0; m < 4; ++m) { const int row = row0 + ai * HALF + m * 16; const float rs = rstd_of(row);
                        *(gf32x4*)(dst + (size_t)row * 8) = acc[ai][0][m][0] * rs; *(gf32x4*)(dst + (size_t)row * 8 + 4) = acc[ai][0][m][1] * rs; }
            }
            return;
        }
        gbf16* base = (gbf16*)(ws + off);
        if (!F8 && (act == 6 || act == 7)) {
            const int colp = (pn - t0) * HALF + wc * 32 + 8 * fq;
#pragma unroll
            for (int ai = 0; ai < 2; ++ai)
#pragma unroll
                for (int m = 0; m < 4; ++m) {
                    const int row = row0 + ai * HALF + m * 16; const float rs = rstd_of(row);
                    f32x4 a0 = acc[ai][0][m][0] * rs, a1 = acc[ai][0][m][1] * rs; const f32x4 z0 = acc[ai][1][m][0] * rs, z1 = acc[ai][1][m][1] * rs;
                    if (act == 6) { const f32x2 a = gelu_pk((f32x2){a0[0], a0[1]}), b = gelu_pk((f32x2){a0[2], a0[3]}), c = gelu_pk((f32x2){a1[0], a1[1]}), d = gelu_pk((f32x2){a1[2], a1[3]});
                        a0 = (f32x4){a.x, a.y, b.x, b.y}; a1 = (f32x4){c.x, c.y, d.x, d.y}; }
                    else {
#pragma unroll
                        for (int j = 0; j < 4; ++j) { a0[j] = fsigmoid(a0[j]); a1[j] = fsigmoid(a1[j]); } }
#pragma unroll
                    for (int j = 0; j < 4; ++j) { a0[j] *= z0[j] * fsigmoid(z0[j]); a1[j] *= z1[j] * fsigmoid(z1[j]); }
                    u32x4 w; w.x = cvt_pk_bf16(a0[0], a0[1]); w.y = cvt_pk_bf16(a0[2], a0[3]); w.z = cvt_pk_bf16(a1[0], a1[1]); w.w = cvt_pk_bf16(a1[2], a1[3]);
                    *(gu32x4*)(base + tb128(row, colp, 16)) = w;
                }
            return;
        }
#pragma unroll
        for (int ai = 0; ai < 2; ++ai)
#pragma unroll
            for (int m = 0; m < 4; ++m) {
                const int row = row0 + ai * HALF + m * 16; const float rs = rstd_of(row) * sc;
                gbf16* rowp = base + tb256(row, col0, ldc >> 8); float ls = 0.f, lq = 0.f; u32x2 g8[2] = {{0u, 0u}, {0u, 0u}};
#pragma unroll
                for (int bj = 0; bj < 2; ++bj) {
                    f32x4 v0 = acc[ai][bj][m][0] * rs, v1 = acc[ai][bj][m][1] * rs;
                    if (!F8 && act == 5) {
                        f32x2 a = gelu_pk((f32x2){v0[0], v0[1]}), b = gelu_pk((f32x2){v0[2], v0[3]}), c = gelu_pk((f32x2){v1[0], v1[1]}), d = gelu_pk((f32x2){v1[2], v1[3]});
                        v0 = (f32x4){a.x, a.y, b.x, b.y}; v1 = (f32x4){c.x, c.y, d.x, d.y};
                        { ls += (v0[0] + v0[1]) + (v0[2] + v0[3]) + (v1[0] + v1[1]) + (v1[2] + v1[3]);
                            lq += (v0[0] * v0[0] + v0[1] * v0[1]) + (v0[2] * v0[2] + v0[3] * v0[3]) + (v1[0] * v1[0] + v1[1] * v1[1]) + (v1[2] * v1[2] + v1[3] * v1[3]); }
                    } else if (!F8 && act == 2) {
#pragma unroll
                        for (int j = 0; j < 4; ++j) { v0[j] = v0[j] * fsigmoid(v0[j]); v1[j] = v1[j] * fsigmoid(v1[j]); }
                    } else if (F8 && (act == 3 || act == 8)) {
#pragma unroll
                        for (int j = 0; j < 4; ++j) { v0[j] = fsigmoid(v0[j]); v1[j] = fsigmoid(v1[j]); }
                    }
                    if (F8 && act == 3) {
                        g8[bj].x = pack_u8x4(v0[0], v0[1], v0[2], v0[3]); g8[bj].y = pack_u8x4(v1[0], v1[1], v1[2], v1[3]);
                    } else {
                    u32x4 w; w.x = cvt_pk_bf16(v0[0], v0[1]); w.y = cvt_pk_bf16(v0[2], v0[3]); w.z = cvt_pk_bf16(v1[0], v1[1]); w.w = cvt_pk_bf16(v1[2], v1[3]);
                    EPIIN_STORE(w, (gu32x4*)(rowp + bj * HALF)); }
                }
                if (F8 && act == 3) {
                    typedef unsigned u32x2v_ __attribute__((ext_vector_type(2)));
                    const u32x2v_ r0 = __builtin_amdgcn_permlane16_swap(g8[0].x, g8[1].x, false, false), r1 = __builtin_amdgcn_permlane16_swap(g8[0].y, g8[1].y, false, false);
                    const u32x4 w16 = {r0.x, r1.x, r0.y, r1.y};
                    *(gu32x4*)(ws + WS_G + ((size_t)(u.pm * 48 + (pn - 74)) * 256 + (row & 255)) * 256 + (wc * 32 + 8 * (fq & ~1)) + (fq & 1) * HALF) = w16;
                }
                if (!F8 && act == 5) {
                    ls += __shfl_xor(ls, 16); ls += __shfl_xor(ls, 32); lq += __shfl_xor(lq, 16); lq += __shfl_xor(lq, 32);
                    if (fq == 0) *(gf32x2*)(ws + WS_LNP + ((size_t)row * 32 + (pn - 16) * 4 + wc) * 8) = (f32x2){ls, lq};
                }
            }
    }
};
using EpiIn = EpiInT<false>;
struct EpiBranch {
    static constexpr bool PERM = true; static constexpr int NS = EPI_NS16; static constexpr bool FP8 = false; static constexpr bool I8 = false;
    __device__ __forceinline__ bool relax(const Unit& u) const { return u.seg == 2; }
    const guchar* G; gbf16* MIX;
    __device__ __forceinline__ bool keep(const Unit& u) const { return u.seg != 2; }
    __device__ __forceinline__ void operator()(f32x4 (&acc)[2][2][4][2], const Unit& u, int wr, int wc, int fr, int fq) const {
        const int row0 = u.pm * BM + wr * 64 + fr, col0 = u.pn * BM + wc * 32 + 8 * fq; const int seg = u.seg;
        u32x2 ga[2][4][2], gb[2][4][2];
#pragma unroll
        for (int ai = 0; ai < 2; ++ai)
#pragma unroll
            for (int m = 0; m < 4; ++m) {
                const int row = row0 + ai * HALF + m * 16; const guchar* gp = G + ((size_t)(u.pm * 48 + seg * 16 + u.pn) * 256 + (row & 255)) * 256 + (wc * 32 + 8 * fq);
#pragma unroll
                for (int bj = 0; bj < 2; ++bj) { ga[ai][m][bj] = *(const gu32x2*)(gp + bj * HALF); gb[ai][m][bj] = (seg != 2) ? *(const gu32x2*)(gp + (size_t)16 * 65536 + bj * HALF) : (u32x2){255u * 0x01010101u, 255u * 0x01010101u}; }
            }
#pragma unroll
        for (int ai = 0; ai < 2; ++ai)
#pragma unroll
            for (int m = 0; m < 4; ++m) {
                const int row = row0 + ai * HALF + m * 16;
#pragma unroll
                for (int bj = 0; bj < 2; ++bj) {
                    const u32x2 a_ = ga[ai][m][bj], b_ = gb[ai][m][bj];
                    float f[8] = {(float)((a_.x >> (8 * 0)) & 0xffu), (float)((a_.x >> (8 * 1)) & 0xffu), (float)((a_.x >> (8 * 2)) & 0xffu), (float)((a_.x >> (8 * 3)) & 0xffu),
                                  (float)((a_.y >> (8 * 0)) & 0xffu), (float)((a_.y >> (8 * 1)) & 0xffu), (float)((a_.y >> (8 * 2)) & 0xffu), (float)((a_.y >> (8 * 3)) & 0xffu)};
                    const float h[8] = {(float)((b_.x >> (8 * 0)) & 0xffu), (float)((b_.x >> (8 * 1)) & 0xffu), (float)((b_.x >> (8 * 2)) & 0xffu), (float)((b_.x >> (8 * 3)) & 0xffu),
                                        (float)((b_.y >> (8 * 0)) & 0xffu), (float)((b_.y >> (8 * 1)) & 0xffu), (float)((b_.y >> (8 * 2)) & 0xffu), (float)((b_.y >> (8 * 3)) & 0xffu)};
#pragma unroll
                    for (int j = 0; j < 8; ++j) f[j] = fmaxf(f[j], 1e-18f) * __builtin_amdgcn_rcpf(fmaxf(h[j], 1e-18f));
                    f32x4 v0 = acc[ai][bj][m][0], v1 = acc[ai][bj][m][1];
                    v0 = v0 * (f32x4){f[0], f[1], f[2], f[3]}; v1 = v1 * (f32x4){f[4], f[5], f[6], f[7]};
                    if (seg != 2) { acc[ai][bj][m][0] = v0; acc[ai][bj][m][1] = v1; }
                    else { u32x4 w; w.x = cvt_pk_bf16(v0[0], v0[1]); w.y = cvt_pk_bf16(v0[2], v0[3]); w.z = cvt_pk_bf16(v1[0], v1[1]); w.w = cvt_pk_bf16(v1[2], v1[3]);
                        *(gu32x4*)(MIX + ablk(row, col0 + bj * HALF, DM)) = w; }
                }
            }
    }
};
struct EpiSq {
    static constexpr bool PERM = true; static constexpr int NS = EPI_NS16; static constexpr bool FP8 = false; static constexpr bool I8 = false;
    __device__ __forceinline__ bool relax(const Unit&) const { return true; }
    gbf16* O; gfloat* P;
    __device__ __forceinline__ bool keep(const Unit&) const { return false; }
    __device__ __forceinline__ void operator()(f32x4 (&acc)[2][2][4][2], const Unit& u, int wr, int wc, int fr, int fq) const {
        const int row0 = u.pm * BM + wr * 64 + fr, col0 = u.pn * BM + wc * 32 + 8 * fq;
#pragma unroll
        for (int ai = 0; ai < 2; ++ai)
#pragma unroll
            for (int m = 0; m < 4; ++m) {
                const int row = row0 + ai * HALF + m * 16; float q = 0.f;
#pragma unroll
                for (int bj = 0; bj < 2; ++bj) {
                    const f32x4 v0 = acc[ai][bj][m][0], v1 = acc[ai][bj][m][1];
                    q += (v0[0] * v0[0] + v0[1] * v0[1]) + (v0[2] * v0[2] + v0[3] * v0[3]) + (v1[0] * v1[0] + v1[1] * v1[1]) + (v1[2] * v1[2] + v1[3] * v1[3]);
                    u32x4 w; w.x = cvt_pk_bf16(v0[0], v0[1]); w.y = cvt_pk_bf16(v0[2], v0[3]); w.z = cvt_pk_bf16(v1[0], v1[1]); w.w = cvt_pk_bf16(v1[2], v1[3]);
                    if (O) *(gu32x4*)(O + (size_t)row * DM + col0 + bj * HALF) = w; else asm volatile("" :: "v"(w));
                }
                q += __shfl_xor(q, 16); q += __shfl_xor(q, 32);
                if (fq == 0) P[(size_t)row * 64 + u.pn * 4 + wc] = q;
            }
    }
};
struct EpiPle {
    static constexpr bool PERM = true; static constexpr int NS = EPI_NS32; static constexpr bool FP8 = P5_FP8 != 0; static constexpr bool I8 = P5_I8 != 0;
    __device__ __forceinline__ bool relax(const Unit&) const { return true; }
    const gbf16* X1B; gfloat* XOUT; gbf16* XB; const gbf16* ERAW; const gfloat* RSE; const gfloat* pnorm; gfloat* SSQN; int last; guchar* XB8; const gfloat* RSX; float swq;
    __device__ __forceinline__ bool keep(const Unit&) const { return false; }
    __device__ __forceinline__ void operator()(f32x4 (&acc)[2][2][4][2], const Unit& u, int wr, int wc, int fr, int fq) const {
        const int row0 = u.pm * BM + wr * 64 + fr, col0 = u.pn * BM + wc * 32 + 8 * fq; constexpr float ASC = FP8 ? (DBG_ZERO_ASC ? 0.0f : 1.0f / W8_SCALE) : 1.0f;
#pragma unroll
        for (int ai = 0; ai < 2; ++ai)
#pragma unroll
            for (int m = 0; m < 4; ++m) {
                const int row = row0 + ai * HALF + m * 16; const float rse = RSE[row]; float q = 0.f; const size_t ro = (size_t)row * DM; const float zsc = I8 ? RSX[row] * swq : ASC;
#pragma unroll
                for (int bj = 0; bj < 2; ++bj) {
                    const int col = col0 + bj * HALF;
                    const u32x4 xb = *(const gu32x4*)(X1B + ablk(row, col, DM)), eb = *(const gu32x4*)(ERAW + ro + col);
                    const f32x4 pna = *(const gf32x4*)(pnorm + col), pnb = *(const gf32x4*)(pnorm + col + 4);
                    const float x[8] = {bf_lo(xb.x), bf_hi(xb.x), bf_lo(xb.y), bf_hi(xb.y), bf_lo(xb.z), bf_hi(xb.z), bf_lo(xb.w), bf_hi(xb.w)};
                    const float e8[8] = {bf_lo(eb.x), bf_hi(eb.x), bf_lo(eb.y), bf_hi(eb.y), bf_lo(eb.z), bf_hi(eb.z), bf_lo(eb.w), bf_hi(eb.w)};
                    const float pn[8] = {pna[0], pna[1], pna[2], pna[3], pnb[0], pnb[1], pnb[2], pnb[3]};
                    const f32x4 a0 = acc[ai][bj][m][0], a1 = acc[ai][bj][m][1];
                    const float a[8] = {I8 ? (float)__float_as_int(a0[0]) : a0[0], I8 ? (float)__float_as_int(a0[1]) : a0[1], I8 ? (float)__float_as_int(a0[2]) : a0[2], I8 ? (float)__float_as_int(a0[3]) : a0[3],
                                        I8 ? (float)__float_as_int(a1[0]) : a1[0], I8 ? (float)__float_as_int(a1[1]) : a1[1], I8 ? (float)__float_as_int(a1[2]) : a1[2], I8 ? (float)__float_as_int(a1[3]) : a1[3]};
                    float r[8];
#pragma unroll
                    for (int j = 0; j < 8; ++j) { r[j] = x[j] + fsigmoid(a[j] * zsc) * (e8[j] * rse * pn[j]); q += r[j] * r[j]; }
                    if (last) { *(gf32x4*)(XOUT + ro + col) = (f32x4){r[0], r[1], r[2], r[3]}; *(gf32x4*)(XOUT + ro + col + 4) = (f32x4){r[4], r[5], r[6], r[7]}; }
                    else { u32x4 w; w.x = cvt_pk_bf16(r[0], r[1]); w.y = cvt_pk_bf16(r[2], r[3]); w.z = cvt_pk_bf16(r[4], r[5]); w.w = cvt_pk_bf16(r[6], r[7]); *(gu32x4*)(XB + ablk(row, col, DM)) = w;
                        if (P1G_FP8) { u32x2 w8; w8.x = pack_fp8x4(r[0], r[1], r[2], r[3]); w8.y = pack_fp8x4(r[4], r[5], r[6], r[7]); *(gu32x2*)(XB8 + ablk8(row, col, DM)) = w8; } }
                }
                if (!last) { q += __shfl_xor(q, 16); q += __shfl_xor(q, 32); if (fq == 0) SSQN[(size_t)row * 64 + u.pn * 4 + wc] = q; }
                if (m & 1) asm volatile("" ::: "memory");
            }
    }
};
}

constexpr int LDS_BYTES = 163840;
constexpr int MISC_OFF = LDS_BYTES - 128;
constexpr int ARGS_OFF = LDS_BYTES - 512;
constexpr int NWAVES = 8, NTHREADS = 512;

struct Ctx {
    LAS unsigned char* lds; int tid, lane, wave, vcu, G, bx;
};

struct TrTile { const gfloat* W; const gfloat* kscale; gbf16* WT; int ldw, K; guchar* W8; const gunsigned* QS; };
constexpr int TR_PER_LAYER = 7808 + 1536 + 1024 + 1024 + 64;
__device__ __forceinline__ TrTile tr_decode(int it, const gfloat* w_in, const gfloat* norm_pre, const gfloat* w_branch, const gfloat* w_out, const gfloat* ple_gate, const gfloat* ple_proj, guchar* ws) {
    const int l = it / TR_PER_LAYER; int r = it - l * TR_PER_LAYER; TrTile t; int kt, ntile; t.W8 = nullptr; t.QS = nullptr;
    if (r < 7808) { kt = r / 244; ntile = r - kt * 244; const int src = ntile < 116 ? ntile * 128 : ntile * 128 + 8;
        if (ntile < 16) ntile = 2 * ntile; else if (ntile < 32) ntile = ntile + 16; else if (ntile < 48) ntile = 2 * (ntile - 32) + 1;
        const int oblk = (ntile >= 116 && ntile < 132) ? ntile - 116 : -1; if (ntile >= 132 && ntile < 148) ntile -= 16;
        t.ldw = N_IN; t.K = DM; t.W = w_in + (size_t)l * DM * N_IN + (size_t)kt * 128 * N_IN + src; t.kscale = norm_pre + l * DM + kt * 128;
        t.WT = (gbf16*)(ws + WS_WIN + (size_t)l * SZ_WIN) + ((size_t)(ntile >> 1) * (DM / 64) + (size_t)kt * 2) * 16384 + (size_t)(ntile & 1) * 128 * 64;
        if (ntile >= 148) t.W8 = ws + WS_WG8 + (size_t)l * SZ_WG8 + ((size_t)((ntile - 148) >> 1) * (DM / 128) + (size_t)kt) * 32768 + (size_t)(ntile & 1) * 128 * 128;
        if (oblk >= 0) t.W8 = ws + WS_WG8 + (size_t)l * SZ_WG8 + ((size_t)(48 + (oblk >> 1)) * (DM / 128) + (size_t)kt) * 32768 + (size_t)(oblk & 1) * 128 * 128;
        return t; }
    r -= 7808; t.kscale = nullptr; t.ldw = DM;
    if (r < 1536) { const int j = r / 512; const int rr = r - j * 512; kt = rr / 32; ntile = rr - kt * 32; t.K = BW;
        t.W = w_branch + ((size_t)(l * 3 + j) * BW + (size_t)kt * 128) * DM + ntile * 128;
        t.WT = (gbf16*)(ws + WS_WBR + (size_t)l * SZ_WBR) + (size_t)j * DM * BW + ((size_t)(ntile >> 1) * (BW / 64) + (size_t)kt * 2) * 16384 + (size_t)(ntile & 1) * 128 * 64; return t; }
    r -= 1536;
    if (r < 2048) { const int which = r / 1024; const int rr = r - which * 1024; kt = rr / 32; ntile = rr - kt * 32; t.K = DM;
        t.W = (which ? ple_gate : w_out) + ((size_t)l * DM + (size_t)kt * 128) * DM + ntile * 128;
        t.WT = (gbf16*)(ws + (which ? WS_WPG : WS_WOUT) + (size_t)l * SZ_WSQ) + ((size_t)(ntile >> 1) * (DM / 64) + (size_t)kt * 2) * 16384 + (size_t)(ntile & 1) * 128 * 64;
        if (P5_I8 && which) t.QS = (const gunsigned*)(ws + WS_CTL) + CW_WMAX + l;
        if ((P5_FP8 || P5_I8) && which) t.W8 = ws + WS_WPG + (size_t)l * SZ_WSQ + ((size_t)(ntile >> 1) * (DM / 128) + (size_t)kt) * 32768 + (size_t)(ntile & 1) * 128 * 128;
        return t; }
    r -= 2048; kt = r / 32; ntile = r - kt * 32; t.K = 256;
    t.W = ple_proj + ((size_t)l * 256 + (size_t)kt * 128) * DM + ntile * 128;
    t.WT = (gbf16*)(ws + WS_WPP + (size_t)l * SZ_WPP) + ((size_t)(ntile >> 1) * (256 / 64) + (size_t)kt * 2) * 16384 + (size_t)(ntile & 1) * 128 * 64; return t;
}
#ifndef TR_NTLOAD
#define TR_NTLOAD 0
#endif
#ifndef TR_REVERSE
#define TR_REVERSE 1
#endif
__device__ __forceinline__ void tr_run(const Ctx& F, int it0, int it1, int sk0, int sk1, int me, int nw, const gfloat* w_in, const gfloat* norm_pre, const gfloat* w_branch,
                                       const gfloat* w_out, const gfloat* ple_gate, const gfloat* ple_proj, guchar* ws) {
    int tid = F.tid; LAUNDER_V(tid);
    {
        constexpr int RS = 264; const int NIT = it1 - it0 - (sk1 - sk0);
        const int c4 = tid & 31, kr = tid >> 5, kc = tid & 15;
        f32x4 va[8], vb[8]; float ka[8], kb[8]; TrTile ta, tb;
#define TR_LOAD(T_, V_, K_, IT_) do { const int ir_ = TR_REVERSE ? (NIT - 1 - (IT_)) : (IT_); T_ = tr_decode(it0 + ir_ + (((it0 + ir_) >= sk0) ? (sk1 - sk0) : 0), w_in, norm_pre, w_branch, w_out, ple_gate, ple_proj, ws); \
        _Pragma("unroll") for (int i = 0; i < 8; ++i) { V_[i] = TR_NTLOAD ? __builtin_nontemporal_load((const gf32x4*)(T_.W + (size_t)(i * 16 + kr) * T_.ldw + 4 * c4)) : *(const gf32x4*)(T_.W + (size_t)(i * 16 + kr) * T_.ldw + 4 * c4); K_[i] = T_.kscale ? T_.kscale[i * 16 + kr] : 1.0f; } } while (0)
#define TR_PUT(V_, K_) do { _Pragma("unroll") for (int i = 0; i < 8; ++i) { const f32x4 a = V_[i] * K_[i]; u32x2 w; w.x = cvt_pk_bf16(a[0], a[1]); w.y = cvt_pk_bf16(a[2], a[3]); \
        *(LAS u32x2*)(F.lds + (i * 16 + kr) * RS + c4 * 8) = w; } } while (0)
#define TR_GET(WT_, W8_, QS_) do { _Pragma("unroll") for (int q = 0; q < 4; ++q) { const int n = 32 * q + (tid >> 4), kq = kc; \
        const LAS bf16_t* s = (const LAS bf16_t*)(F.lds + (8 * kq) * RS + 2 * n); unsigned e[8]; \
        _Pragma("unroll") for (int j = 0; j < 8; ++j) e[j] = s[j * (RS / 2)]; \
        if (QS_) { const float qs_ = 127.0f / fmaxf(__uint_as_float(*(QS_)), 1e-30f); u32x2 o8; \
            o8.x = pack_i8x4(__uint_as_float(e[0] << 16) * qs_, __uint_as_float(e[1] << 16) * qs_, __uint_as_float(e[2] << 16) * qs_, __uint_as_float(e[3] << 16) * qs_); \
            o8.y = pack_i8x4(__uint_as_float(e[4] << 16) * qs_, __uint_as_float(e[5] << 16) * qs_, __uint_as_float(e[6] << 16) * qs_, __uint_as_float(e[7] << 16) * qs_); \
            *(gu32x2*)((W8_) + n * 128 + 8 * kq) = o8; } \
        else if (W8_) { u32x2 o8; o8.x = pack_fp8x4(__uint_as_float(e[0] << 16) * W8_SCALE, __uint_as_float(e[1] << 16) * W8_SCALE, __uint_as_float(e[2] << 16) * W8_SCALE, __uint_as_float(e[3] << 16) * W8_SCALE); \
            o8.y = pack_fp8x4(__uint_as_float(e[4] << 16) * W8_SCALE, __uint_as_float(e[5] << 16) * W8_SCALE, __uint_as_float(e[6] << 16) * W8_SCALE, __uint_as_float(e[7] << 16) * W8_SCALE); \
            *(gu32x2*)((W8_) + n * 128 + 8 * kq) = o8; } \
        else { u32x4 o; o.x = e[0] | (e[1] << 16); o.y = e[2] | (e[3] << 16); o.z = e[4] | (e[5] << 16); o.w = e[6] | (e[7] << 16); \
        *(gu32x4*)(WT_ + (size_t)(kq >> 3) * 16384 + n * 64 + 8 * (kq & 7)) = o; } } } while (0)
        int it = me;
        if (it < NIT) TR_LOAD(ta, va, ka, it);
        if (it + nw < NIT) TR_LOAD(tb, vb, kb, it + nw);
        while (it < NIT) {
            { TR_PUT(va, ka); __syncthreads(); gbf16* wt = ta.WT; guchar* kk = ta.W8; const gunsigned* qp = ta.QS;
              if (it + 2 * nw < NIT) TR_LOAD(ta, va, ka, it + 2 * nw);
              TR_GET(wt, kk, qp); __syncthreads(); }
            it += nw; if (it >= NIT) break;
            { TR_PUT(vb, kb); __syncthreads(); gbf16* wt = tb.WT; guchar* kk = tb.W8; const gunsigned* qp = tb.QS;
              if (it + 2 * nw < NIT) TR_LOAD(tb, vb, kb, it + 2 * nw);
              TR_GET(wt, kk, qp); __syncthreads(); }
            it += nw;
        }
#undef TR_LOAD
#undef TR_PUT
#undef TR_GET
    }
}
#ifndef TR_NODEFER
#define TR_NODEFER 0
#endif
#ifndef TR_L1TAIL
#define TR_L1TAIL (1024 + 1536)
#endif
constexpr int TR_PG0 = 7808 + 1536 + 1024, TR_PG1 = TR_PER_LAYER + TR_PG0;
constexpr int TR_DEFER0 = TR_PER_LAYER + 7808 + 1536, TR_DEFER1 = TR_DEFER0 + (TR_NODEFER ? 0 : 2048);
__device__ __forceinline__ void p0_prologue(const Ctx& F, const gfloat* x, const gfloat* p, const gint* positions, const gfloat* norm_pre, const gfloat* w_in, const gfloat* w_branch,
                                            const gfloat* w_out, const gfloat* ple_gate, const gfloat* ple_proj, guchar* ws) {
    int tid = F.tid; LAUNDER_V(tid);
#if P5_I8
    tr_run(F, 0, TR_PG1 - TR_L1TAIL, TR_PG0, TR_PG0 + 1024, F.vcu, F.G, w_in, norm_pre, w_branch, w_out, ple_gate, ple_proj, ws);
    tr_run(F, TR_PG1 + 1024, NLAYER * TR_PER_LAYER, 0x7fffffff, 0x7fffffff, F.vcu, F.G, w_in, norm_pre, w_branch, w_out, ple_gate, ple_proj, ws);
    { const int gt_ = F.vcu * NTHREADS + tid, NGT_ = F.G * NTHREADS;
      for (int l = 0; l < NLAYER; ++l) { const gf32x4* wp = (const gf32x4*)(ple_gate + (size_t)l * DM * DM); float mx = 0.f;
          for (int i0 = gt_; i0 < DM * DM / 4; i0 += 8 * NGT_) { f32x4 a[8];
#pragma unroll
              for (int j = 0; j < 8; ++j) { const int i = i0 + j * NGT_; a[j] = wp[i < DM * DM / 4 ? i : i0]; }
#pragma unroll
              for (int j = 0; j < 8; ++j) mx = fmaxf(mx, fmaxf(fmaxf(fabsf(a[j][0]), fabsf(a[j][1])), fmaxf(fabsf(a[j][2]), fabsf(a[j][3])))); }
#pragma unroll
          for (int s = 32; s >= 1; s >>= 1) mx = fmaxf(mx, __shfl_xor(mx, s));
          if (F.lane == 0) atomicMax((unsigned*)((gunsigned*)(ws + WS_CTL) + CW_WMAX + l), __float_as_uint(mx)); } }
#else
    tr_run(F, 0, NLAYER * TR_PER_LAYER, TR_DEFER0, TR_DEFER1, F.vcu, F.G, w_in, norm_pre, w_branch, w_out, ple_gate, ple_proj, ws);
#endif
    const int gt = F.vcu * NTHREADS + tid, NGT = F.G * NTHREADS;
    for (int i = gt; i < NLAYER * 256 * DM; i += NGT) { const int l = i / (256 * DM), rr = (i / DM) & 255, k = i & (DM - 1);
        float val = 0.f; if (rr < 8) val = w_in[(size_t)l * DM * N_IN + (size_t)k * N_IN + IF_COL + rr] * norm_pre[l * DM + k];
        ((gbf16*)(ws + WS_WIN + (size_t)l * SZ_WIN))[((size_t)122 * (DM / 64) + (k >> 6)) * 16384 + rr * 64 + (k & 63)] = (bf16_t)(cvt_pk_bf16(val, 0.f) & 0xffffu); }
    for (int i = gt; i < NLAYER * M_ROWS * 256 / 4; i += NGT) { const f32x4 a = ((const gf32x4*)p)[i]; u32x2 w; w.x = cvt_pk_bf16(a[0], a[1]); w.y = cvt_pk_bf16(a[2], a[3]);
        const int l = i / (M_ROWS * 64), r = (i >> 6) & (M_ROWS - 1), c = (i & 63) * 4; *(gu32x2*)((gbf16*)(ws + WS_PB) + (size_t)l * M_ROWS * 256 + ablk(r, c, 256)) = w; }
    for (int i = gt; i < M_ROWS * 8; i += NGT) { const int row = i >> 3, j = i & 7; const float inv = powf(500000.0f, -(float)j * 0.125f); const float ang = (float)positions[row] * inv;
        gfloat* cs = (gfloat*)(ws + WS_CS) + (size_t)row * 16; cs[j] = cosf(ang); cs[8 + j] = sinf(ang); }
    { const int gw = F.vcu * NWAVES + F.wave, NGW = F.G * NWAVES;
      for (int m = gw; m < M_ROWS; m += NGW) { const gf32x4* xr = (const gf32x4*)(x + (size_t)m * DM) + F.lane; gbf16* o = (gbf16*)(ws + WS_XB); float s = 0.f;
#pragma unroll
          for (int j = 0; j < 16; ++j) { const f32x4 a = xr[64 * j]; s += (a[0] * a[0] + a[1] * a[1]) + (a[2] * a[2] + a[3] * a[3]); u32x2 w; w.x = cvt_pk_bf16(a[0], a[1]); w.y = cvt_pk_bf16(a[2], a[3]); *(gu32x2*)(o + ablk(m, (F.lane + 64 * j) * 4, DM)) = w;
              if (P1G_FP8) *(gunsigned*)(ws + WS_XB8 + ablk8(m, (F.lane + 64 * j) * 4, DM)) = pack_fp8x4(a[0], a[1], a[2], a[3]); }
          s = wave_sum(s); if (F.lane == 0) ((gfloat*)(ws + WS_SSQ0))[m] = s; } }
}

__device__ __forceinline__ u32x2 pack4(const f32x4 v) { u32x2 w; w.x = cvt_pk_bf16(v[0], v[1]); w.y = cvt_pk_bf16(v[2], v[3]); return w; }
__device__ __forceinline__ bf16x8 mk_frag(const u32x2 lo, const u32x2 hi) { const u32x4 t = {lo.x, lo.y, hi.x, hi.y}; return __builtin_bit_cast(bf16x8, t); }
__device__ __forceinline__ bf16x8 frag_const(unsigned w) { const u32x4 t = {w, w, w, w}; return __builtin_bit_cast(bf16x8, t); }

constexpr int GM_RS = 288, GM_WL = 0, GM_VT = 128 * GM_RS, GM_ST = GM_VT + 256 * GM_RS;
__device__ __forceinline__ void gmlp_unit(const Ctx& F, int b, int n, int g, guchar* ws, const gfloat* ln_g, const gfloat* ln_b, const gfloat* wsp, const gfloat* bsp) {
    int tid = F.tid; LAUNDER_V(tid); const int lane = tid & 63, w = F.wave, r16 = lane & 15, q4 = lane >> 4;
    const int row0 = b * SEQ + n * 128, c0 = g * 256;
    const gbf16* AU = (const gbf16*)(ws + WS_AU); const gbf16* AV = (const gbf16*)(ws + WS_AV); gbf16* YA = (gbf16*)(ws + WS_YA);
    u32x4 raw[8];
#pragma unroll
    for (int k = 0; k < 8; ++k) { const int item = tid + 512 * k, s = item & 127, ch = item >> 7; raw[k] = *(const gu32x4*)(AV + tb256(row0 + s, c0 + 8 * ch, 8)); }
    f32x4 wt[8];
#pragma unroll
    for (int k = 0; k < 8; ++k) { const int item = tid + 512 * k, t = item >> 5, ch = item & 31; wt[k] = *(const gf32x4*)(wsp + ((size_t)(g * 128 + t)) * 128 + 4 * ch); }
    { const gf32x4* pp = (const gf32x4*)(ws + WS_LNP) + (size_t)(row0 + (tid & 127)) * 16 + (tid >> 7) * 4; float s = 0.f, q = 0.f;
#pragma unroll
        for (int j = 0; j < 4; ++j) { const f32x4 t = pp[j]; s += t[0] + t[2]; q += t[1] + t[3]; }
        *(LAS f32x2*)(F.lds + GM_ST + 1024 + ((tid >> 7) * 128 + (tid & 127)) * 8) = (f32x2){s, q}; }
#pragma unroll
    for (int k = 0; k < 8; ++k) { const int item = tid + 512 * k, t = item >> 5, ch = item & 31; f32x4 a = wt[k];
#pragma unroll
        for (int e = 0; e < 4; ++e) if (4 * ch + e > t) a[e] = 0.f;
        *(LAS u32x2*)(F.lds + GM_WL + t * GM_RS + ch * 8) = pack4(a); }
    __syncthreads();
    if (tid < 128) { float s = 0.f, q = 0.f;
#pragma unroll
        for (int j = 0; j < 4; ++j) { const f32x2 t = *(const LAS f32x2*)(F.lds + GM_ST + 1024 + (j * 128 + tid) * 8); s += t.x; q += t.y; }
        const float mu = s * (1.0f / BW); const float var = fmaxf(q * (1.0f / BW) - mu * mu, 0.f);
        *(LAS f32x2*)(F.lds + GM_ST + tid * 8) = (f32x2){mu, rsqrtf(var + NORM_EPS)}; }
    __syncthreads();
#pragma unroll
    for (int k = 0; k < 8; ++k) { const int item = tid + 512 * k, s = item & 127, ch = item >> 7;
        const f32x4 g0 = *(const gf32x4*)(ln_g + c0 + 8 * ch), g1 = *(const gf32x4*)(ln_g + c0 + 8 * ch + 4), b0 = *(const gf32x4*)(ln_b + c0 + 8 * ch), b1 = *(const gf32x4*)(ln_b + c0 + 8 * ch + 4);
        const f32x2 st = *(const LAS f32x2*)(F.lds + GM_ST + s * 8);
        const float xv[8] = {bf_lo(raw[k].x), bf_hi(raw[k].x), bf_lo(raw[k].y), bf_hi(raw[k].y), bf_lo(raw[k].z), bf_hi(raw[k].z), bf_lo(raw[k].w), bf_hi(raw[k].w)};
        const float gg[8] = {g0[0], g0[1], g0[2], g0[3], g1[0], g1[1], g1[2], g1[3]}, bb[8] = {b0[0], b0[1], b0[2], b0[3], b1[0], b1[1], b1[2], b1[3]};
#pragma unroll
        for (int i = 0; i < 8; ++i) { const float y = (xv[i] - st.x) * st.y * gg[i] + bb[i];
            *(LAS bf16_t*)(F.lds + GM_VT + (8 * ch + i) * GM_RS + 2 * s) = (bf16_t)(cvt_pk_bf16(y, 0.f) & 0xffffu); } }
    u32x4 ub[8]; float bsv[8];
#pragma unroll
    for (int n8 = 0; n8 < 8; ++n8) { const int t = 16 * n8 + r16; ub[n8] = *(const gu32x4*)(AU + tb128(row0 + t, c0 + 32 * w + 8 * q4, 16)); bsv[n8] = bsp[g * 128 + t]; }
    __syncthreads();
    f32x4 acc[2][8];
#pragma unroll
    for (int m = 0; m < 2; ++m)
#pragma unroll
        for (int n8 = 0; n8 < 8; ++n8) acc[m][n8] = (f32x4){0.f, 0.f, 0.f, 0.f};
    bf16x8 af[2][4];
#pragma unroll
    for (int m = 0; m < 2; ++m)
#pragma unroll
        for (int ks = 0; ks < 4; ++ks) af[m][ks] = *(const LAS bf16x8*)(F.lds + GM_VT + (32 * w + 8 * (r16 >> 2) + 4 * m + (r16 & 3)) * GM_RS + ks * 64 + q4 * 16);
#pragma unroll
    for (int n8 = 0; n8 < 8; ++n8)
#pragma unroll
        for (int ks = 0; ks < 4; ++ks) if (ks <= n8 / 2) {
            const bf16x8 bfr = *(const LAS bf16x8*)(F.lds + GM_WL + (16 * n8 + r16) * GM_RS + ks * 64 + q4 * 16);
#pragma unroll
            for (int m = 0; m < 2; ++m) acc[m][n8] = MFMA16(af[m][ks], bfr, acc[m][n8]); }
#pragma unroll
    for (int n8 = 0; n8 < 8; ++n8) { const int t = 16 * n8 + r16; const size_t roy = ablk(row0 + t, c0 + 32 * w + 8 * q4, BW);
        const f32x4 a0 = acc[0][n8] + bsv[n8], a1 = acc[1][n8] + bsv[n8]; u32x4 y;
        y.x = cvt_pk_bf16(a0[0] * bf_lo(ub[n8].x), a0[1] * bf_hi(ub[n8].x)); y.y = cvt_pk_bf16(a0[2] * bf_lo(ub[n8].y), a0[3] * bf_hi(ub[n8].y));
        y.z = cvt_pk_bf16(a1[0] * bf_lo(ub[n8].z), a1[1] * bf_hi(ub[n8].z)); y.w = cvt_pk_bf16(a1[2] * bf_lo(ub[n8].w), a1[3] * bf_hi(ub[n8].w));
        *(gu32x4*)(YA + roy) = y; }
    __syncthreads();
}

constexpr int SW_RS = 160, SW_VS = 528, SW_KL = 0, SW_VT = 256 * SW_RS, SW_QL = SW_VT + 64 * SW_VS, SW_QL2 = SW_QL + 128 * SW_RS, SW_CS = SW_QL2 + 128 * SW_RS;
static_assert(SW_CS + 384 * 64 <= ARGS_OFF, "SWA LDS map");
__device__ __forceinline__ void rope8(const u32x4 a, const u32x4 bq, const gfloat* cs, float scale, u32x4& o1, u32x4& o2) {
    const f32x4 c0 = *(const gf32x4*)cs, c1 = *(const gf32x4*)(cs + 4), s0 = *(const gf32x4*)(cs + 8), s1 = *(const gf32x4*)(cs + 12);
    const float t1[8] = {bf_lo(a.x), bf_hi(a.x), bf_lo(a.y), bf_hi(a.y), bf_lo(a.z), bf_hi(a.z), bf_lo(a.w), bf_hi(a.w)};
    const float t2[8] = {bf_lo(bq.x), bf_hi(bq.x), bf_lo(bq.y), bf_hi(bq.y), bf_lo(bq.z), bf_hi(bq.z), bf_lo(bq.w), bf_hi(bq.w)};
    const float cc[8] = {c0[0], c0[1], c0[2], c0[3], c1[0], c1[1], c1[2], c1[3]}, ss[8] = {s0[0], s0[1], s0[2], s0[3], s1[0], s1[1], s1[2], s1[3]};
    float r1[8], r2[8];
#pragma unroll
    for (int i = 0; i < 8; ++i) { r1[i] = (t1[i] * cc[i] - t2[i] * ss[i]) * scale; r2[i] = (t2[i] * cc[i] + t1[i] * ss[i]) * scale; }
    o1 = (u32x4){cvt_pk_bf16(r1[0], r1[1]), cvt_pk_bf16(r1[2], r1[3]), cvt_pk_bf16(r1[4], r1[5]), cvt_pk_bf16(r1[6], r1[7])};
    o2 = (u32x4){cvt_pk_bf16(r2[0], r2[1]), cvt_pk_bf16(r2[2], r2[3]), cvt_pk_bf16(r2[4], r2[5]), cvt_pk_bf16(r2[6], r2[7])};
}
__device__ __forceinline__ u32x4 scale8(const u32x4 a, float sc) {
    return (u32x4){cvt_pk_bf16(bf_lo(a.x) * sc, bf_hi(a.x) * sc), cvt_pk_bf16(bf_lo(a.y) * sc, bf_hi(a.y) * sc), cvt_pk_bf16(bf_lo(a.z) * sc, bf_hi(a.z) * sc), cvt_pk_bf16(bf_lo(a.w) * sc, bf_hi(a.w) * sc)};
}
__device__ __forceinline__ void swa_unit(const Ctx& F, int b, int n, int hk, guchar* ws, const gfloat* sinks) {
    int tid = F.tid; LAUNDER_V(tid); const int lane = tid & 63, w = F.wave, r16 = lane & 15, q4 = lane >> 4;
    const int r0 = b * SEQ + n * 128, kr0 = r0 - 128;
    const gbf16* BQ = (const gbf16*)(ws + WS_BQ); const gbf16* BK = (const gbf16*)(ws + WS_BK); const gbf16* BV = (const gbf16*)(ws + WS_BV); const gbf16* BZ = (const gbf16*)(ws + WS_BZ);
    gbf16* YB = (gbf16*)(ws + WS_YA) + (size_t)M_ROWS * BW; const gfloat* CS = (const gfloat*)(ws + WS_CS);
    const int kch = tid & 7;
    u32x4 kraw[4], vraw[4]; f32x4 csr[3]; u32x4 qa[2];
#pragma unroll
    for (int k = 0; k < 4; ++k) { const int key = (tid + 512 * k) >> 3; const bool pad = (n == 0 && key < 128);
        kraw[k] = *(const gu32x4*)(BK + (size_t)(pad ? r0 : kr0 + key) * 256 + hk * 64 + 8 * kch); }
#pragma unroll
    for (int k = 0; k < 4; ++k) { const int item = tid + 512 * k, key = item & 255, ch = item >> 8; const bool pad = (n == 0 && key < 128);
        vraw[k] = *(const gu32x4*)(BV + (size_t)(pad ? r0 : kr0 + key) * 256 + hk * 64 + 8 * ch); }
#pragma unroll
    for (int k = 0; k < 3; ++k) { const int item = tid + 512 * k, r = item >> 2, part = item & 3; const int row = r < 256 ? ((n == 0 && r < 128) ? r0 : kr0 + r) : r0 + r - 256;
        csr[k] = *(const gf32x4*)(CS + (size_t)row * 16 + part * 4); }
#define SW_QLOAD(hq_) do { _Pragma("unroll") for (int k_ = 0; k_ < 2; ++k_) { const int qr_ = (tid + 512 * k_) >> 3; qa[k_] = *(const gu32x4*)(BQ + tb256(r0 + qr_, (hq_) * 64, 8) + 8 * kch); } } while (0)
    SW_QLOAD(hk * 8);
#pragma unroll
    for (int k = 0; k < 3; ++k) { const int item = tid + 512 * k; *(LAS f32x4*)(F.lds + SW_CS + item * 16) = csr[k]; }
#pragma unroll
    for (int k = 0; k < 4; ++k) { const int item = tid + 512 * k, key = item & 255, ch = item >> 8; const bool pad = (n == 0 && key < 128);
        const u32x4 raw = pad ? (u32x4){0u, 0u, 0u, 0u} : vraw[k]; const unsigned e[4] = {raw.x, raw.y, raw.z, raw.w};
#pragma unroll
        for (int i = 0; i < 8; ++i) *(LAS bf16_t*)(F.lds + SW_VT + (8 * ch + i) * SW_VS + 2 * key) = (bf16_t)((e[i >> 1] >> ((i & 1) * 16)) & 0xffffu); }
    __syncthreads();
#define SW_PUT(raw_, csrow_, dst_, scale_) do { const u32x4 own_ = (raw_); u32x4 par_; \
        par_.x = (unsigned)__builtin_amdgcn_update_dpp(0, (int)own_.x, 0xB1, 0xf, 0xf, false); par_.y = (unsigned)__builtin_amdgcn_update_dpp(0, (int)own_.y, 0xB1, 0xf, 0xf, false); \
        par_.z = (unsigned)__builtin_amdgcn_update_dpp(0, (int)own_.z, 0xB1, 0xf, 0xf, false); par_.w = (unsigned)__builtin_amdgcn_update_dpp(0, (int)own_.w, 0xB1, 0xf, 0xf, false); \
        u32x4 o_; \
        if (kch < 2) { const LAS float* cs_ = (const LAS float*)(F.lds + SW_CS + (csrow_) * 64); \
            const f32x4 c0_ = *(const LAS f32x4*)cs_, c1_ = *(const LAS f32x4*)(cs_ + 4), s0_ = *(const LAS f32x4*)(cs_ + 8), s1_ = *(const LAS f32x4*)(cs_ + 12); \
            const float sg_ = kch == 0 ? -(scale_) : (scale_); \
            const float t_[8] = {bf_lo(own_.x), bf_hi(own_.x), bf_lo(own_.y), bf_hi(own_.y), bf_lo(own_.z), bf_hi(own_.z), bf_lo(own_.w), bf_hi(own_.w)}; \
            const float u_[8] = {bf_lo(par_.x), bf_hi(par_.x), bf_lo(par_.y), bf_hi(par_.y), bf_lo(par_.z), bf_hi(par_.z), bf_lo(par_.w), bf_hi(par_.w)}; \
            const float cc_[8] = {c0_[0], c0_[1], c0_[2], c0_[3], c1_[0], c1_[1], c1_[2], c1_[3]}, ss_[8] = {s0_[0], s0_[1], s0_[2], s0_[3], s1_[0], s1_[1], s1_[2], s1_[3]}; \
            float r_[8]; _Pragma("unroll") for (int i_ = 0; i_ < 8; ++i_) r_[i_] = (t_[i_] * cc_[i_]) * (scale_) + (u_[i_] * ss_[i_]) * sg_; \
            o_ = (u32x4){cvt_pk_bf16(r_[0], r_[1]), cvt_pk_bf16(r_[2], r_[3]), cvt_pk_bf16(r_[4], r_[5]), cvt_pk_bf16(r_[6], r_[7])}; } \
        else o_ = ((scale_) == 1.0f) ? own_ : scale8(own_, (scale_)); \
        *(LAS u32x4*)((dst_) + kch * 16) = o_; } while (0)
#pragma unroll
    for (int k = 0; k < 4; ++k) { const int key = (tid + 512 * k) >> 3; const bool pad = (n == 0 && key < 128);
        const u32x4 kz = pad ? (u32x4){0u, 0u, 0u, 0u} : kraw[k]; SW_PUT(kz, key, F.lds + SW_KL + key * SW_RS, 1.0f); }
#define SW_QWRITE(buf_) do { _Pragma("unroll") for (int k_ = 0; k_ < 2; ++k_) { const int qr_ = (tid + 512 * k_) >> 3; SW_PUT(qa[k_], 256 + qr_, F.lds + (buf_) + qr_ * SW_RS, 0.125f); } } while (0)
    SW_QWRITE(SW_QL);
    __syncthreads();
    for (int hi = 0; hi < 8; ++hi) {
        const int hq = hk * 8 + hi; const int qcur = (hi & 1) ? SW_QL2 : SW_QL, qnxt = (hi & 1) ? SW_QL : SW_QL2;
        SW_QLOAD((hi < 7 ? hq + 1 : hq));
        const u32x4 zb0 = *(const gu32x4*)(BZ + tb256(r0 + 16 * w + r16, hq * 64 + 8 * q4, 8)), zb1 = *(const gu32x4*)(BZ + tb256(r0 + 16 * w + r16, hq * 64 + 8 * q4 + 32, 8));
        bf16x8 bq[2];
#pragma unroll
        for (int ks = 0; ks < 2; ++ks) bq[ks] = *(const LAS bf16x8*)(F.lds + qcur + (16 * w + r16) * SW_RS + ks * 64 + q4 * 16);
        f32x4 s[10];
#pragma unroll
        for (int j = 0; j < 9; ++j) { s[j] = (f32x4){0.f, 0.f, 0.f, 0.f};
#pragma unroll
            for (int ks = 0; ks < 2; ++ks) { const bf16x8 a = *(const LAS bf16x8*)(F.lds + SW_KL + (16 * (w + j) + r16) * SW_RS + ks * 64 + q4 * 16); s[j] = MFMA16(a, bq[ks], s[j]); } }
        s[9] = (f32x4){0.f, 0.f, 0.f, 0.f};
        const int qi = 16 * w + r16; const float sink = sinks[hq]; float mx = sink;
#pragma unroll
        for (int j = 0; j < 9; ++j)
#pragma unroll
            for (int e = 0; e < 4; ++e) { const int kj = 16 * (w + j) + 4 * q4 + e; const bool valid = (kj > qi) && (kj <= qi + 128) && (n > 0 || kj >= 128);
                s[j][e] = valid ? s[j][e] : -1e30f; mx = fmaxf(mx, s[j][e]); }
        mx = fmaxf(mx, __shfl_xor(mx, 16)); mx = fmaxf(mx, __shfl_xor(mx, 32));
        float sum = 0.f;
#pragma unroll
        for (int j = 0; j < 9; ++j)
#pragma unroll
            for (int e = 0; e < 4; ++e) { const float pv = (s[j][e] > -1e29f) ? __expf(s[j][e] - mx) : 0.f; s[j][e] = pv; sum += pv; }
        sum += __shfl_xor(sum, 16); sum += __shfl_xor(sum, 32); sum += __expf(sink - mx);
        const float inv = 1.0f / sum;
        f32x4 o[4];
#pragma unroll
        for (int dt = 0; dt < 4; ++dt) o[dt] = (f32x4){0.f, 0.f, 0.f, 0.f};
#pragma unroll
        for (int kk = 0; kk < 5; ++kk) { const bf16x8 pf = mk_frag(pack4(s[2 * kk]), pack4(s[2 * kk + 1]));
            const int t0 = w + 2 * kk, t1 = (w + 2 * kk + 1) > 15 ? 15 : (w + 2 * kk + 1);
#pragma unroll
            for (int dt = 0; dt < 4; ++dt) { const LAS unsigned char* vrow = F.lds + SW_VT + (32 * (dt >> 1) + 8 * (r16 >> 2) + 4 * (dt & 1) + (r16 & 3)) * SW_VS + (4 * q4) * 2;
                const bf16x8 a = mk_frag(*(const LAS u32x2*)(vrow + 32 * t0), *(const LAS u32x2*)(vrow + 32 * t1)); o[dt] = MFMA16(a, pf, o[dt]); } }
        const size_t ro = (size_t)(r0 + qi) * BW + hq * 64 + 8 * q4;
#pragma unroll
        for (int pp = 0; pp < 2; ++pp) { const u32x4 zb = pp ? zb1 : zb0; const f32x4 oa = o[2 * pp] * inv, ob2 = o[2 * pp + 1] * inv; u32x4 y;
            y.x = cvt_pk_bf16(oa[0] * bf_lo(zb.x), oa[1] * bf_hi(zb.x)); y.y = cvt_pk_bf16(oa[2] * bf_lo(zb.y), oa[3] * bf_hi(zb.y));
            y.z = cvt_pk_bf16(ob2[0] * bf_lo(zb.z), ob2[1] * bf_hi(zb.z)); y.w = cvt_pk_bf16(ob2[2] * bf_lo(zb.w), ob2[3] * bf_hi(zb.w));
            *(gu32x4*)(YB + ablk(r0 + qi, hq * 64 + 8 * q4 + 32 * pp, BW)) = y; }
        SW_QWRITE(qnxt);
        __syncthreads();
    }
#undef SW_QLOAD
#undef SW_QWRITE
#undef SW_PUT
}

#ifndef ML_R1A
#define ML_R1A 1
#endif
#ifndef ML_R1B
#define ML_R1B 1
#endif
#ifndef ML_RWR
#define ML_RWR 1
#endif
constexpr int ML_RS = 544, ML_TS = 144, ML_WS = 160, ML_GSZ = 1344;
constexpr int ML_QL = 0, ML_KA = 64 * ML_RS, ML_KB = 2 * 64 * ML_RS, ML_VT = 3 * 64 * ML_RS, ML_VW = ML_VT + 32 * ML_TS, ML_VW2 = ML_VW + 33 * ML_WS, ML_CT = ML_VW2 + 33 * ML_WS, ML_X = ML_CT + 33 * ML_RS, ML_GATE = ML_X + 64 * 144;
static_assert(ML_GATE + 2 * ML_GSZ <= ARGS_OFF, "mLSTM LDS map");
typedef short s16x4 __attribute__((ext_vector_type(4)));
__device__ __forceinline__ bf16x8 tr_frag8(const LAS unsigned char* img, int rs, int row0, int col0, int r16) {
    const LAS unsigned char* p0 = img + (row0 + (r16 >> 2)) * rs + (col0 + 4 * (r16 & 3)) * 2;
    const s16x4 a = __builtin_amdgcn_ds_read_tr16_b64_v4i16((LAS s16x4*)p0);
    const s16x4 b = __builtin_amdgcn_ds_read_tr16_b64_v4i16((LAS s16x4*)(p0 + 4 * rs));
    return __builtin_shufflevector(a, b, 0, 1, 2, 3, 4, 5, 6, 7);
}
__device__ __forceinline__ float dpp_shr(float v, float ident, int n) {
    const int r = n == 1 ? __builtin_amdgcn_update_dpp(__float_as_int(ident), __float_as_int(v), 0x111, 0xf, 0xf, false)
                : n == 2 ? __builtin_amdgcn_update_dpp(__float_as_int(ident), __float_as_int(v), 0x112, 0xf, 0xf, false)
                : n == 4 ? __builtin_amdgcn_update_dpp(__float_as_int(ident), __float_as_int(v), 0x114, 0xf, 0xf, false)
                         : __builtin_amdgcn_update_dpp(__float_as_int(ident), __float_as_int(v), 0x118, 0xf, 0xf, false);
    return __int_as_float(r);
}
__device__ __forceinline__ float wave_scan_add(float v, int lane) {
    v += dpp_shr(v, 0.f, 1); v += dpp_shr(v, 0.f, 2); v += dpp_shr(v, 0.f, 4); v += dpp_shr(v, 0.f, 8);
    const float t0 = __int_as_float(__builtin_amdgcn_readlane(__float_as_int(v), 15)), t1 = __int_as_float(__builtin_amdgcn_readlane(__float_as_int(v), 31)), t2 = __int_as_float(__builtin_amdgcn_readlane(__float_as_int(v), 47));
    const int row = lane >> 4; const float add = row == 0 ? 0.f : (row == 1 ? t0 : (row == 2 ? t0 + t1 : (t0 + t1) + t2));
    return v + add;
}
__device__ __forceinline__ float wave_scan_max(float v, int lane) {
    const float NI = -3.0e38f;
    v = fmaxf(v, dpp_shr(v, NI, 1)); v = fmaxf(v, dpp_shr(v, NI, 2)); v = fmaxf(v, dpp_shr(v, NI, 4)); v = fmaxf(v, dpp_shr(v, NI, 8));
    const float t0 = __int_as_float(__builtin_amdgcn_readlane(__float_as_int(v), 15)), t1 = __int_as_float(__builtin_amdgcn_readlane(__float_as_int(v), 31)), t2 = __int_as_float(__builtin_amdgcn_readlane(__float_as_int(v), 47));
    const int row = lane >> 4; const float mx = row == 0 ? NI : (row == 1 ? t0 : (row == 2 ? fmaxf(t0, t1) : fmaxf(fmaxf(t0, t1), t2)));
    return fmaxf(v, mx);
}
__device__ __forceinline__ float softcap15(float z) { const float e = __expf(z * (2.0f / 15.0f)); return 15.0f * (1.0f - 2.0f * __builtin_amdgcn_rcpf(e + 1.0f)); }
__device__ __forceinline__ void mlstm_unit(const Ctx& F, int b, int h, int sl, guchar* ws, const gfloat* ibp, const gfloat* fbp, const gfloat* norm_g) {
    int tid = F.tid; LAUNDER_V(tid); const int lane = tid & 63, w = F.wave, r16 = lane & 15, q4 = lane >> 4;
    const gbf16* CQ = (const gbf16*)(ws + WS_CQ); const gbf16* CK = (const gbf16*)(ws + WS_CK); const gbf16* CV = (const gbf16*)(ws + WS_CV);
    const gbf16* CO = (const gbf16*)(ws + WS_CO); const gbf16* CZs = (const gbf16*)(ws + WS_CZ);
    const gfloat* IFB = (const gfloat*)(ws + WS_IF);
    gbf16* NUM = (gbf16*)(ws + WS_NUM) + h * 512 + sl * 32; gfloat* SSQC = (gfloat*)(ws + WS_SSQC); gfloat* DNB = (gfloat*)(ws + WS_DN);
    const int rowb = b * SEQ;
    const bf16x8 ones = frag_const(0x3f803f80u), zeros = frag_const(0u);
    for (int i = tid; i < 33 * ML_RS / 16; i += NTHREADS) *(LAS u32x4*)(F.lds + ML_CT + i * 16) = (u32x4){0u, 0u, 0u, 0u};
    f32x4 st[2][3];
#pragma unroll
    for (int i = 0; i < 2; ++i)
#pragma unroll
        for (int dt = 0; dt < 3; ++dt) st[i][dt] = (f32x4){0.f, 0.f, 0.f, 0.f};
    float m_prev = 0.f;
    const float ibv = ibp[h], fbv = fbp[h];
    const f32x4 ng0 = *(const gf32x4*)(norm_g + h * 512 + sl * 32 + 4 * q4), ng1 = *(const gf32x4*)(norm_g + h * 512 + sl * 32 + 16 + 4 * q4);
    u32x4 qra[4], kra[4], vra; float gi = 0.f, gf = 0.f;
#define ML_LOAD(c, Q_, K_, V_) do { const int rc_ = rowb + (c) * 64; _Pragma("unroll") for (int k_ = 0; k_ < 4; ++k_) { const int it_ = tid + 512 * k_, s_ = it_ >> 5, ch_ = it_ & 31; \
        Q_[k_] = *(const gu32x4*)(CQ + tb256(rc_ + s_, h * 256 + 8 * ch_, 4)); K_[k_] = *(const gu32x4*)(CK + tb256(rc_ + s_, h * 256 + 8 * ch_, 4)); } \
        V_ = *(const gu32x4*)(CV + tb256(rc_ + ((tid & 255) >> 2), h * 512 + sl * 32 + 8 * (tid & 3), 8)); } while (0)
#define ML_GLOAD(c) do { const int r_ = rowb + (c) * 64 + lane; gi = IFB[(size_t)r_ * 8 + h]; gf = IFB[(size_t)r_ * 8 + 4 + h]; } while (0)
#define ML_GPREP(par) do { if (w == 7) { const float ig_ = softcap15(gi + ibv); const float z_ = softcap15(gf + fbv); \
        const float lf_ = -(fmaxf(-z_, 0.f) + log1pf(__expf(-fabsf(z_)))); const float bc_ = wave_scan_add(lf_, lane); const float u_ = ig_ - bc_; const float pm_ = wave_scan_max(u_, lane); \
        const float Mv_ = fmaxf(m_prev, pm_); const float M63_ = __int_as_float(__builtin_amdgcn_readlane(__float_as_int(Mv_), 63)); const float g_ = __int_as_float(__builtin_amdgcn_readlane(__float_as_int(bc_), 63)); \
        LAS float* gp_ = (LAS float*)(F.lds + ML_GATE + (par) * ML_GSZ); gp_[lane] = u_; gp_[64 + lane] = Mv_; gp_[128 + lane] = __expf(m_prev - Mv_); gp_[192 + lane] = __expf(-(bc_ + Mv_)); \
        gp_[256 + lane] = __expf(u_ - M63_); if (lane == 0) gp_[320] = __expf(m_prev - M63_); m_prev = g_ + M63_; } } while (0)
#define ML_WRITE(kb_, vw_, gpn_, Q_, K_, V_) do { _Pragma("unroll") for (int k_ = 0; k_ < 4; ++k_) { const int it_ = tid + 512 * k_, s_ = it_ >> 5, ch_ = it_ & 31; \
        *(LAS u32x4*)(F.lds + ML_QL + s_ * ML_RS + ch_ * 16) = Q_[k_]; *(LAS u32x4*)(F.lds + (kb_) + s_ * ML_RS + ch_ * 16) = K_[k_]; } \
        if (tid < 256) { const int s_ = tid >> 2, ch_ = tid & 3; const unsigned e_[4] = {V_.x, V_.y, V_.z, V_.w}; const float ws_ = (gpn_)[256 + s_]; \
            _Pragma("unroll") for (int i_ = 0; i_ < 8; ++i_) { const unsigned hv_ = (e_[i_ >> 1] >> ((i_ & 1) * 16)) & 0xffffu; \
                *(LAS bf16_t*)(F.lds + ML_VT + (8 * ch_ + i_) * ML_TS + 2 * s_) = (bf16_t)hv_; \
                *(LAS bf16_t*)(F.lds + (vw_) + (8 * ch_ + i_) * ML_WS + 2 * s_) = (bf16_t)(cvt_pk_bf16(__uint_as_float(hv_ << 16) * ws_, 0.f) & 0xffffu); } \
            if (ch_ == 0) *(LAS bf16_t*)(F.lds + (vw_) + 32 * ML_WS + 2 * s_) = (bf16_t)(cvt_pk_bf16(ws_, 0.f) & 0xffffu); } } while (0)
    ML_LOAD(0, qra, kra, vra); ML_GLOAD(0);
    ML_GPREP(0);
    ML_GLOAD(1);
    __syncthreads();
    ML_WRITE(ML_KA, ML_VW, ((const LAS float*)(F.lds + ML_GATE)), qra, kra, vra);
    __syncthreads();
#define ML_STEP(c, LQ_, LK_, LV_, WQ_, WK_, WV_) do { \
        const int par = c & 1; const LAS float* gp = (const LAS float*)(F.lds + ML_GATE + par * ML_GSZ); \
        const int vt = ML_VT, kb = par ? ML_KB : ML_KA, kbn = par ? ML_KA : ML_KB, vw = par ? ML_VW2 : ML_VW, vwn = par ? ML_VW : ML_VW2; \
        const LAS float* gpn = (const LAS float*)(F.lds + ML_GATE + (par ^ 1) * ML_GSZ); \
        const int rowc = rowb + c * 64; \
        const size_t rog_ = tb256(rowc + 16 * (w & 3) + r16, h * 512 + sl * 32 + 4 * q4, 8); \
        const u32x2 ob0 = *(const gu32x2*)(CO + rog_), ob1 = *(const gu32x2*)(CO + rog_ + 16), zb0 = *(const gu32x2*)(CZs + rog_), zb1 = *(const gu32x2*)(CZs + rog_ + 16); \
        ML_LOAD((c + 1 < 32 ? c + 1 : 31), LQ_, LK_, LV_); if (c + 1 < 32) ML_GPREP(par ^ 1); ML_GLOAD((c + 2 < 32 ? c + 2 : 31)); \
        f32x4 oacc[3]; \
        for (int rp_ = 0; rp_ < ML_R1B; ++rp_) { \
        _Pragma("unroll") \
        for (int dt = 0; dt < 3; ++dt) oacc[dt] = (f32x4){0.f, 0.f, 0.f, 0.f}; \
        if (w < 4) { \
            const int T = w; \
            bf16x8 bq[8]; \
        _Pragma("unroll") \
            for (int ks = 0; ks < 8; ++ks) bq[ks] = *(const LAS bf16x8*)(F.lds + ML_QL + (16 * T + r16) * ML_RS + ks * 64 + q4 * 16); \
            f32x4 sa[4]; \
        _Pragma("unroll") \
            for (int s4 = 0; s4 < 4; ++s4) { sa[s4] = (f32x4){0.f, 0.f, 0.f, 0.f}; \
                if (s4 <= T) { \
        _Pragma("unroll") \
                    for (int ks = 0; ks < 8; ++ks) { const bf16x8 a = *(const LAS bf16x8*)(F.lds + kb + (16 * s4 + r16) * ML_RS + ks * 64 + q4 * 16); sa[s4] = MFMA16(a, bq[ks], sa[s4]); } } } \
            const int tl = 16 * T + r16; const float Mt = gp[64 + tl]; \
        _Pragma("unroll") \
            for (int s4 = 0; s4 < 4; ++s4) { const f32x4 uu = *(const LAS f32x4*)(gp + 16 * s4 + 4 * q4); \
        _Pragma("unroll") \
                for (int e = 0; e < 4; ++e) { const int sl_ = 16 * s4 + 4 * q4 + e; sa[s4][e] = (sl_ <= tl) ? sa[s4][e] * __expf(uu[e] - Mt) : 0.f; } } \
        _Pragma("unroll") \
            for (int kk = 0; kk < 2; ++kk) { const bf16x8 pf = mk_frag(pack4(sa[2 * kk]), pack4(sa[2 * kk + 1])); \
        _Pragma("unroll") \
                for (int dt = 0; dt < 3; ++dt) { bf16x8 a; \
                    if (dt < 2) { const LAS unsigned char* vp = F.lds + vt + (16 * dt + r16) * ML_TS + (32 * kk + 4 * q4) * 2; a = mk_frag(*(const LAS u32x2*)vp, *(const LAS u32x2*)(vp + 32)); } \
                    else a = (r16 == 0) ? ones : zeros; \
                    oacc[dt] = MFMA16(a, pf, oacc[dt]); } } \
        } else { \
            const int T = w - 4; f32x4 ia[3]; \
        _Pragma("unroll") \
            for (int dt = 0; dt < 3; ++dt) ia[dt] = (f32x4){0.f, 0.f, 0.f, 0.f}; \
        _Pragma("unroll") \
            for (int ks = 0; ks < 8; ++ks) { const bf16x8 bqv = *(const LAS bf16x8*)(F.lds + ML_QL + (16 * T + r16) * ML_RS + ks * 64 + q4 * 16); \
        _Pragma("unroll") \
                for (int dt = 0; dt < 3; ++dt) { bf16x8 a; \
                    if (dt < 2) a = *(const LAS bf16x8*)(F.lds + ML_CT + (16 * dt + r16) * ML_RS + ks * 64 + q4 * 16); \
                    else { a = *(const LAS bf16x8*)(F.lds + ML_CT + 32 * ML_RS + ks * 64 + q4 * 16); if (r16 != 0) a = zeros; } \
                    ia[dt] = MFMA16(a, bqv, ia[dt]); } } \
            const int tl = 16 * T + r16; \
            *(LAS f32x4*)(F.lds + ML_X + tl * 144 + (4 * q4) * 4) = ia[0]; *(LAS f32x4*)(F.lds + ML_X + tl * 144 + (16 + 4 * q4) * 4) = ia[1]; \
            if (q4 == 0) *(LAS f32x4*)(F.lds + ML_X + tl * 144 + 32 * 4) = ia[2]; \
        } \
        } \
        __syncthreads(); \
        if (w < 4) { \
            const int tl = 16 * w + r16; const float at = gp[128 + tl], en = gp[192 + tl]; \
            const f32x4 x0 = *(const LAS f32x4*)(F.lds + ML_X + tl * 144 + (4 * q4) * 4), x1 = *(const LAS f32x4*)(F.lds + ML_X + tl * 144 + (16 + 4 * q4) * 4); \
            const float xd = *(const LAS float*)(F.lds + ML_X + tl * 144 + 32 * 4); \
            const f32x4 n0 = oacc[0] + x0 * at, n1 = oacc[1] + x1 * at; \
            float den = oacc[2][0] + xd * at; den = __shfl(den, r16); \
            float sq = (n0[0] * n0[0] + n0[1] * n0[1]) + (n0[2] * n0[2] + n0[3] * n0[3]) + (n1[0] * n1[0] + n1[1] * n1[1]) + (n1[2] * n1[2] + n1[3] * n1[3]); \
            sq += __shfl_xor(sq, 16); sq += __shfl_xor(sq, 32); \
            const size_t ro = (size_t)(rowc + tl) * BW + 4 * q4; \
            f32x4 t0, t1; \
            t0[0] = n0[0] * ng0[0] * (bf_lo(ob0.x) * bf_lo(zb0.x)); t0[1] = n0[1] * ng0[1] * (bf_hi(ob0.x) * bf_hi(zb0.x)); t0[2] = n0[2] * ng0[2] * (bf_lo(ob0.y) * bf_lo(zb0.y)); t0[3] = n0[3] * ng0[3] * (bf_hi(ob0.y) * bf_hi(zb0.y)); \
            t1[0] = n1[0] * ng1[0] * (bf_lo(ob1.x) * bf_lo(zb1.x)); t1[1] = n1[1] * ng1[1] * (bf_hi(ob1.x) * bf_hi(zb1.x)); t1[2] = n1[2] * ng1[2] * (bf_lo(ob1.y) * bf_lo(zb1.y)); t1[3] = n1[3] * ng1[3] * (bf_hi(ob1.y) * bf_hi(zb1.y)); \
            *(gu32x2*)(NUM + ro) = pack4(t0); *(gu32x2*)(NUM + ro + 16) = pack4(t1); \
            if (q4 == 0) { SSQC[(size_t)(rowc + tl) * 64 + h * 16 + sl] = sq; if (sl == 0) DNB[(size_t)(rowc + tl) * 4 + h] = fmaxf(fabsf(den), en); } \
        } \
        { const float dec = gp[320]; \
        _Pragma("unroll") \
          for (int i = 0; i < 2; ++i) \
        _Pragma("unroll") \
              for (int dt = 0; dt < 3; ++dt) st[i][dt] = st[i][dt] * dec; \
        _Pragma("unroll") \
          for (int kk = 0; kk < 2; ++kk) { bf16x8 a[2], bv[3]; \
        _Pragma("unroll") \
              for (int i = 0; i < 2; ++i) a[i] = tr_frag8(F.lds + kb, ML_RS, 32 * kk + 8 * q4, 32 * w + 16 * i, r16); \
        _Pragma("unroll") \
              for (int dt = 0; dt < 2; ++dt) bv[dt] = *(const LAS bf16x8*)(F.lds + vw + (16 * dt + r16) * ML_WS + kk * 64 + q4 * 16); \
              bv[2] = *(const LAS bf16x8*)(F.lds + vw + 32 * ML_WS + kk * 64 + q4 * 16); if (r16 != 0) bv[2] = zeros; \
        _Pragma("unroll") \
              for (int i = 0; i < 2; ++i) \
        _Pragma("unroll") \
                  for (int dt = 0; dt < 3; ++dt) st[i][dt] = MFMA16(a[i], bv[dt], st[i][dt]); } \
        _Pragma("unroll") \
          for (int i = 0; i < 2; ++i) { \
        _Pragma("unroll") \
              for (int dt = 0; dt < 2; ++dt) *(LAS u32x2*)(F.lds + ML_CT + (16 * dt + r16) * ML_RS + (32 * w + 16 * i + 4 * q4) * 2) = pack4(st[i][dt]); \
              if (r16 == 0) *(LAS u32x2*)(F.lds + ML_CT + 32 * ML_RS + (32 * w + 16 * i + 4 * q4) * 2) = pack4(st[i][2]); } } \
        for (int rp_ = 0; rp_ < ML_RWR; ++rp_) if (c + 1 < 32) ML_WRITE(kbn, vwn, gpn, WQ_, WK_, WV_); \
        __syncthreads(); \
    } while (0)
    for (int c2 = 0; c2 < 32; ++c2) { ML_STEP(c2, qra, kra, vra, qra, kra, vra); }
#undef ML_LOAD
#undef ML_GLOAD
#undef ML_GPREP
#undef ML_WRITE
#undef ML_STEP
}

__device__ __forceinline__ void p2b_finalize(const Ctx& F, guchar* ws) {
    int lane = F.lane; LAUNDER_V(lane); const int gw = F.vcu * NWAVES + F.wave, NGW = F.G * NWAVES;
    const gbf16* NUM = (const gbf16*)(ws + WS_NUM); gbf16* YC = (gbf16*)(ws + WS_YA) + (size_t)2 * M_ROWS * BW;
    for (int m = gw; m < M_ROWS; m += NGW) {
        float s = ((const gfloat*)(ws + WS_SSQC))[(size_t)m * 64 + lane];
        s += __shfl_xor(s, 1); s += __shfl_xor(s, 2); s += __shfl_xor(s, 4); s += __shfl_xor(s, 8);
        const float dn = ((const gfloat*)(ws + WS_DN))[(size_t)m * 4 + (lane >> 4)];
        const float inv = 1.0f / dn; const float sc = inv * rsqrtf(s * (1.0f / 512.0f) * inv * inv + NORM_EPS);
#pragma unroll
        for (int it = 0; it < 4; ++it) { const float f = __shfl(sc, 16 * it); const size_t o = (size_t)m * BW + (size_t)(it * 64 + lane) * 8;
            const u32x4 nb = *(const gu32x4*)(NUM + o); u32x4 y;
            y.x = cvt_pk_bf16(bf_lo(nb.x) * f, bf_hi(nb.x) * f); y.y = cvt_pk_bf16(bf_lo(nb.y) * f, bf_hi(nb.y) * f);
            y.z = cvt_pk_bf16(bf_lo(nb.z) * f, bf_hi(nb.z) * f); y.w = cvt_pk_bf16(bf_lo(nb.w) * f, bf_hi(nb.w) * f);
            *(gu32x4*)(YC + ablk(m, (it * 64 + lane) * 8, BW)) = y; }
    }
}
__device__ __forceinline__ void p5b_ssq(const Ctx& F, guchar* ws) {
    int lane = F.lane; LAUNDER_V(lane); const int gw = F.vcu * NWAVES + F.wave, NGW = F.G * NWAVES;
    for (int m = gw; m < M_ROWS; m += NGW) { const float s = wave_sum(((const gfloat*)(ws + WS_XSP))[(size_t)m * 64 + lane]); if (lane == 0) ((gfloat*)(ws + WS_CTL + CTL_SSQ1))[m] = s; }
}
__device__ __forceinline__ void p4b_x1(const Ctx& F, guchar* ws, const gfloat* npost) {
    int lane = F.lane; LAUNDER_V(lane); const int gw = F.vcu * NWAVES + F.wave, NGW = F.G * NWAVES;
    const gbf16* OUT = (const gbf16*)(ws + WS_OUT); const gbf16* XB = (const gbf16*)(ws + WS_XB); gbf16* X1B = (gbf16*)(ws + WS_X1B);
    for (int m = gw; m < M_ROWS; m += NGW) {
        const float so = wave_sum(((const gfloat*)(ws + WS_OUTP))[(size_t)m * 64 + lane]), se = wave_sum(((const gfloat*)(ws + WS_ERP))[(size_t)m * 64 + lane]);
        const float rso = rsqrtf(so * (1.0f / DM) + NORM_EPS), rse = rsqrtf(se * (1.0f / DM) + NORM_EPS);
        if (lane == 0) { ((gfloat*)(ws + WS_RSO))[m] = rso; ((gfloat*)(ws + WS_RSE))[m] = rse; }
        u32x4 yv[8]; float mx = 0.f;
#pragma unroll
        for (int it = 0; it < 8; ++it) { const int c = (it * 64 + lane) * 8; const size_t o = (size_t)m * DM + c;
            const u32x4 xb = *(const gu32x4*)(XB + ablk(m, c, DM)), ob = *(const gu32x4*)(OUT + o); const f32x4 n0 = *(const gf32x4*)(npost + c), n1 = *(const gf32x4*)(npost + c + 4); u32x4 y;
            y.x = cvt_pk_bf16(bf_lo(xb.x) + bf_lo(ob.x) * rso * n0[0], bf_hi(xb.x) + bf_hi(ob.x) * rso * n0[1]);
            y.y = cvt_pk_bf16(bf_lo(xb.y) + bf_lo(ob.y) * rso * n0[2], bf_hi(xb.y) + bf_hi(ob.y) * rso * n0[3]);
            y.z = cvt_pk_bf16(bf_lo(xb.z) + bf_lo(ob.z) * rso * n1[0], bf_hi(xb.z) + bf_hi(ob.z) * rso * n1[1]);
            y.w = cvt_pk_bf16(bf_lo(xb.w) + bf_lo(ob.w) * rso * n1[2], bf_hi(xb.w) + bf_hi(ob.w) * rso * n1[3]);
            *(gu32x4*)(X1B + ablk(m, c, DM)) = y; yv[it] = y;
            mx = fmaxf(mx, fmaxf(fmaxf(fmaxf(fabsf(bf_lo(y.x)), fabsf(bf_hi(y.x))), fmaxf(fabsf(bf_lo(y.y)), fabsf(bf_hi(y.y)))), fmaxf(fmaxf(fabsf(bf_lo(y.z)), fabsf(bf_hi(y.z))), fmaxf(fabsf(bf_lo(y.w)), fabsf(bf_hi(y.w))))));
#if P5_FP8
            { u32x2 y8; y8.x = pack_fp8x4(bf_lo(y.x), bf_hi(y.x), bf_lo(y.y), bf_hi(y.y)); y8.y = pack_fp8x4(bf_lo(y.z), bf_hi(y.z), bf_lo(y.w), bf_hi(y.w)); *(gu32x2*)(ws + WS_X1B8 + ablk8(m, c, DM)) = y8; }
#endif
            }
#if P5_I8
#pragma unroll
        for (int s = 32; s >= 1; s >>= 1) mx = fmaxf(mx, __shfl_xor(mx, s));
        mx = fmaxf(mx, 1e-30f); const float qs = 127.0f / mx;
        if (lane == 0) ((gfloat*)(ws + WS_RSX))[m] = mx * (1.0f / 127.0f);
#pragma unroll
        for (int it = 0; it < 8; ++it) { const int c = (it * 64 + lane) * 8; const u32x4 y = yv[it]; u32x2 y8;
            y8.x = pack_i8x4(bf_lo(y.x) * qs, bf_hi(y.x) * qs, bf_lo(y.y) * qs, bf_hi(y.y) * qs); y8.y = pack_i8x4(bf_lo(y.z) * qs, bf_hi(y.z) * qs, bf_lo(y.w) * qs, bf_hi(y.w) * qs);
            *(gu32x2*)(ws + WS_X1B8 + ablk8(m, c, DM)) = y8; }
#endif
    }
}

#ifndef P1_ROT
#define P1_ROT 0
#endif
#ifndef P1_WGM
#define P1_WGM 4
#endif
#ifndef REP_P0
#define REP_P0 1
#endif
#ifndef REP_P1
#define REP_P1 1
#endif
#ifndef REP_ML
#define REP_ML 1
#endif
#ifndef REP_SW
#define REP_SW 1
#endif
#ifndef REP_GM
#define REP_GM 1
#endif
#ifndef REP_P3
#define REP_P3 1
#endif
#ifndef REP_THIN
#define REP_THIN 1
#endif
#ifndef REP_BAR
#define REP_BAR 1
#endif
#ifndef REP_P4
#define REP_P4 1
#endif
__device__ __forceinline__ unsigned long long arg_ld(LAS unsigned char* lds, int i) {
    unsigned a = (unsigned)(ARGS_OFF + 8 * i); asm volatile("" : "+v"(a));
    const volatile LAS unsigned* q = (const volatile LAS unsigned*)(lds + a);
    const unsigned lo = q[0], hi = q[1];
    return ((unsigned long long)(unsigned)__builtin_amdgcn_readfirstlane((int)hi) << 32) | (unsigned)__builtin_amdgcn_readfirstlane((int)lo);
}
struct Args { const void* in[19]; float* out; unsigned char* ws; };
static_assert(sizeof(Args) == 21 * 8, "no padding in Args");

__global__ void __launch_bounds__(NTHREADS, 2) fwd_kernel(Args args) {
    extern __shared__ __attribute__((aligned(16))) unsigned char lds_raw[];
    Ctx F; F.lds = (LAS unsigned char*)lds_raw; F.tid = threadIdx.x; F.lane = F.tid & 63; F.wave = __builtin_amdgcn_readfirstlane(F.tid >> 6);
    F.G = gridDim.x; F.bx = blockIdx.x; { const int bx = blockIdx.x; F.vcu = (F.G % 8 == 0) ? (bx % 8) * (F.G / 8) + bx / 8 : bx; }
    guchar* ws0 = (guchar*)args.ws;
#define WSL() ({ guchar* w_ = ws0; LAUNDER_S(w_); w_; })
    volatile LAS unsigned* MISC = (volatile LAS unsigned*)(F.lds + MISC_OFF);
    if (F.tid < 32) MISC[F.tid] = 0u;
    __syncthreads();
    const XcdBarrier bar = xcd_barrier_post((unsigned*)(ws0 + WS_CTL) + CW_BAR, MISC);

    if (F.tid < 19) ((LAS unsigned long long*)(F.lds + ARGS_OFF))[F.tid] = (unsigned long long)args.in[F.tid];
    if (F.tid == 19) ((LAS unsigned long long*)(F.lds + ARGS_OFF))[19] = (unsigned long long)args.out;
    __syncthreads();
#define ARGP(T, i) ((T)arg_ld(F.lds, (i)))

#define FL() ({ Ctx f_ = F; LAUNDER_S(f_.lds); LAUNDER_S(f_.wave); LAUNDER_S(f_.vcu); LAUNDER_S(f_.G); LAUNDER_S(f_.bx); f_; })
#ifndef SKIP_P0
    for (int rep_ = 0; rep_ < REP_P0; ++rep_) { const Ctx Fp = FL(); guchar* ws = WSL(); p0_prologue(FL(), ARGP(const gfloat*, 0), ARGP(const gfloat*, 1), ARGP(const gint*, 2), ARGP(const gfloat*, 3), ARGP(const gfloat*, 4), ARGP(const gfloat*, 13), ARGP(const gfloat*, 14), ARGP(const gfloat*, 18), ARGP(const gfloat*, 16), ws); }
#endif
    for (int rb_ = 0; rb_ < REP_BAR; ++rb_) xcd_barrier(bar);

    auto layer_body = [&](const int l) __attribute__((always_inline)) {
#ifndef NT_BF
#define NT_BF (P1G_FP8 ? 67 : NT_IN)
#endif
#ifndef P1_LOCK
#define P1_LOCK 0
#endif
#ifndef SKIP_P1
        for (int rep_ = 0; rep_ < REP_P1; ++rep_) { const Ctx Fp = FL(); guchar* ws = WSL(); const gfloat* ssq = l == 0 ? (const gfloat*)(ws + WS_SSQ0) : (const gfloat*)(ws + WS_CTL + CTL_SSQ1);
          const int rowbase = (Fp.G == 256 && P1_WGM == 4 && P1_ROT == 0) ? (Fp.bx & 7) * 1024 : -1; LAS float* rtab = (LAS float*)(Fp.lds + 132096);
          if (rowbase >= 0) { int ti_ = threadIdx.x; LAUNDER_V(ti_); const float s0_ = ssq[rowbase + ti_], s1_ = ssq[rowbase + 512 + ti_]; rtab[ti_] = rsqrtf(s0_ * (1.0f / DM) + NORM_EPS); rtab[512 + ti_] = rsqrtf(s1_ * (1.0f / DM) + NORM_EPS); __syncthreads(); }
#if P1G_FP8
          { pg8::SchedPlain S; S.T.init(M_ROWS / 256, 56, Fp.G, Fp.bx, P1_WGM, P1_ROT, -1, 74); S.pn0 = 74; S.A = (const gchar*)(ws + WS_XB8); S.B = (const gchar*)(ws + WS_WG8 + (size_t)l * SZ_WG8);
            S.astep = (size_t)256 * DM; S.bstep = (size_t)256 * DM;
            pg8::EpiInT<true> E{ssq, ws, rtab, rowbase};
            pg8::gemm_phase<pg8::EpiInT<true>, pg8::SchedPlain>(Fp.lds, DM / 2, DM, DM, S, E); }
          { pg8::SchedPlain S; S.T.init(M_ROWS / 256, NT_BF, Fp.G, Fp.bx, P1_WGM, P1_ROT, 122, 0); S.A = (const gchar*)(ws + WS_XB); S.B = (const gchar*)(ws + WS_WIN + (size_t)l * SZ_WIN);
            S.astep = (size_t)256 * DM * 2; S.bstep = (size_t)256 * DM * 2;
            pg8::EpiIn E{ssq, ws, rtab, rowbase};
            pg8::gemm_phase<pg8::EpiIn, pg8::SchedPlain>(Fp.lds, DM, DM, DM, S, E, (unsigned*)(ws + WS_CTL) + 256 + 64 * l, P1_LOCK); }
#else
          { pg8::SchedPlain S; S.T.init(M_ROWS / 256, NT_IN, Fp.G, Fp.bx, P1_WGM, P1_ROT); S.A = (const gchar*)(ws + WS_XB); S.B = (const gchar*)(ws + WS_WIN + (size_t)l * SZ_WIN);
            S.astep = (size_t)256 * DM * 2; S.bstep = (size_t)256 * DM * 2;
            pg8::EpiIn E{ssq, ws, rtab, rowbase};
            pg8::gemm_phase<pg8::EpiIn, pg8::SchedPlain>(Fp.lds, DM, DM, DM, S, E, (unsigned*)(ws + WS_CTL) + 256 + 64 * l, P1_LOCK); }
#endif
        }
#ifdef PROBE_P1CHEAP
        { const Ctx Fp = FL(); guchar* ws = WSL(); pg8::SchedPlain S; S.T.init(M_ROWS / 256, NT_IN, Fp.G, Fp.bx); S.A = (const gchar*)(ws + WS_XB); S.B = (const gchar*)(ws + WS_WIN + (size_t)l * SZ_WIN);
          S.astep = (size_t)256 * DM * 2; S.bstep = (size_t)256 * DM * 2;
          pg8::EpiSq E{(gbf16*)(ws + WS_END), (gfloat*)(ws + WS_END + (size_t)M_ROWS * 31488 * 2)};
          pg8::gemm_phase<pg8::EpiSq, pg8::SchedPlain>(Fp.lds, DM, DM, DM, S, E); }
#endif
        { const Ctx Fq = FL(); const int nwg_ = (M_ROWS / 256) * NT_BF, rem_ = nwg_ % Fq.G;
          if (rem_ == 0 || Fq.bx >= rem_) { const int me = rem_ ? Fq.bx - rem_ : Fq.bx, nw = rem_ ? Fq.G - rem_ : Fq.G;
            { const Ctx Fp = FL(); guchar* ws = WSL(); pg8::SchedPlain S; S.T.init(M_ROWS / 256, DM / 256, nw, me); S.A = (const gchar*)(ws + WS_PB + (size_t)l * M_ROWS * 256 * 2); S.B = (const gchar*)(ws + WS_WPP + (size_t)l * SZ_WPP);
              S.astep = (size_t)256 * 256 * 2; S.bstep = (size_t)256 * 256 * 2;
              pg8::EpiSq E{(gbf16*)(ws + WS_ERAW), (gfloat*)(ws + WS_ERP)};
              pg8::gemm_phase<pg8::EpiSq, pg8::SchedPlain>(Fp.lds, 256, 256, 256, S, E); }
            if (l == 1 && P5_I8 && TR_L1TAIL) tr_run(FL(), TR_PG1 - TR_L1TAIL, TR_PG1, 0x7fffffff, 0x7fffffff, me, nw, ARGP(const gfloat*, 4), ARGP(const gfloat*, 3), ARGP(const gfloat*, 13), ARGP(const gfloat*, 14), ARGP(const gfloat*, 18), ARGP(const gfloat*, 16), WSL());
            if (l == 0) tr_run(FL(), P5_I8 ? TR_PG0 : TR_DEFER0, P5_I8 ? TR_PG1 + 1024 : TR_DEFER1, P5_I8 ? TR_PG0 + 1024 : 0x7fffffff, P5_I8 ? TR_PG1 : 0x7fffffff, me, nw, ARGP(const gfloat*, 4), ARGP(const gfloat*, 3), ARGP(const gfloat*, 13), ARGP(const gfloat*, 14), ARGP(const gfloat*, 18), ARGP(const gfloat*, 16), WSL()); } }
#endif
#ifdef PROBE_DELAY
        if (((F.bx & 7) < 4) == (PROBE_DELAY == 1)) { const unsigned long long t0_ = __builtin_amdgcn_s_memrealtime(); while (__builtin_amdgcn_s_memrealtime() - t0_ < 3000ull) __builtin_amdgcn_s_sleep(8); }
#endif
        for (int rb_ = 0; rb_ < REP_BAR; ++rb_) xcd_barrier(bar);
#ifndef SKIP_ML
        for (int rep_ = 0; rep_ < REP_ML; ++rep_) { const Ctx Fp = FL(); guchar* ws = WSL(); for (int u = Fp.vcu; u < 256; u += Fp.G) mlstm_unit(Fp, u >> 6, (u >> 4) & 3, u & 15, ws, ARGP(const gfloat*, 10) + l * 4, ARGP(const gfloat*, 11) + l * 4, ARGP(const gfloat*, 12) + l * BW); }
#endif
#ifndef SKIP_SW
        for (int rep_ = 0; rep_ < REP_SW; ++rep_) { const Ctx Fp = FL(); guchar* ws = WSL(); for (int u = Fp.vcu; u < 256; u += Fp.G) swa_unit(Fp, u >> 6, (u >> 2) & 15, u & 3, ws, ARGP(const gfloat*, 9) + l * 32); }
#endif
#ifndef SKIP_GM
        for (int rep_ = 0; rep_ < REP_GM; ++rep_) { const Ctx Fp = FL(); guchar* ws = WSL(); for (int u = Fp.vcu; u < 512; u += Fp.G) gmlp_unit(Fp, u >> 7, (u >> 3) & 15, u & 7, ws, ARGP(const gfloat*, 5) + l * BW, ARGP(const gfloat*, 6) + l * BW, ARGP(const gfloat*, 7) + (size_t)l * 8 * 128 * 128, ARGP(const gfloat*, 8) + l * 8 * 128); }
#endif
        for (int rb_ = 0; rb_ < REP_BAR; ++rb_) xcd_barrier(bar);
#ifndef SKIP_P2B
        for (int rep_ = 0; rep_ < REP_THIN; ++rep_) p2b_finalize(FL(), WSL());
#endif
        for (int rb_ = 0; rb_ < REP_BAR; ++rb_) xcd_barrier(bar);
#ifndef PROBE_NOSTORE
#define PROBE_NOSTORE 0
#endif
#ifdef PROBE_K1024
        for (int rep_ = 0; rep_ < 4; ++rep_) { const Ctx Fp = FL(); guchar* ws = WSL(); pg8::SchedPlain S; S.T.init(M_ROWS / 256, DM / 256, Fp.G, Fp.bx); S.A = (const gchar*)(ws + WS_YA); S.B = (const gchar*)(ws + WS_WOUT + (size_t)l * SZ_WSQ);
          S.astep = (size_t)256 * DM * 2; S.bstep = (size_t)256 * DM * 2;
          pg8::EpiSq E{PROBE_NOSTORE ? (gbf16*)nullptr : (gbf16*)(ws + WS_END), (gfloat*)(ws + WS_END + (size_t)M_ROWS * 31488 * 2)};
          pg8::gemm_phase<pg8::EpiSq, pg8::SchedPlain>(Fp.lds, 1024, DM, DM, S, E); }
#endif
#ifdef PROBE_P3CHEAP
        { const Ctx Fp = FL(); guchar* ws = WSL(); pg8::SchedBranch S; S.T.init(M_ROWS / 256, DM / 256, Fp.G, Fp.bx); S.A = (const gchar*)(ws + WS_YA); S.B = (const gchar*)(ws + WS_WBR + (size_t)l * SZ_WBR);
          S.astep = (size_t)256 * BW * 2; S.bstep = (size_t)256 * BW * 2; S.aseg = SZ_ROWS_BW; S.bseg = (size_t)DM * BW * 2;
          pg8::EpiSq E{(gbf16*)(ws + WS_END), (gfloat*)(ws + WS_END + (size_t)M_ROWS * 31488 * 2)};
          pg8::gemm_phase<pg8::EpiSq, pg8::SchedBranch>(Fp.lds, BW, BW, BW, S, E); }
#endif
#ifndef SKIP_P3
        for (int rep_ = 0; rep_ < REP_P3; ++rep_) { const Ctx Fp = FL(); guchar* ws = WSL(); pg8::SchedBranch S; S.T.init(M_ROWS / 256, DM / 256, Fp.G, Fp.bx); S.A = (const gchar*)(ws + WS_YA); S.B = (const gchar*)(ws + WS_WBR + (size_t)l * SZ_WBR);
          S.astep = (size_t)256 * BW * 2; S.bstep = (size_t)256 * BW * 2; S.aseg = SZ_ROWS_BW; S.bseg = (size_t)DM * BW * 2;
          pg8::EpiBranch E{(const guchar*)(ws + WS_G), (gbf16*)(ws + WS_MIX)};
          pg8::gemm_phase<pg8::EpiBranch, pg8::SchedBranch>(Fp.lds, BW, BW, BW, S, E); }
#endif
        for (int rb_ = 0; rb_ < REP_BAR; ++rb_) xcd_barrier(bar);
#ifndef SKIP_P4
        for (int rep_ = 0; rep_ < REP_P4; ++rep_) { const Ctx Fp = FL(); guchar* ws = WSL(); pg8::SchedPlain S; S.T.init(M_ROWS / 256, DM / 256, Fp.G, Fp.bx); S.A = (const gchar*)(ws + WS_MIX); S.B = (const gchar*)(ws + WS_WOUT + (size_t)l * SZ_WSQ);
          S.astep = (size_t)256 * DM * 2; S.bstep = (size_t)256 * DM * 2;
          pg8::EpiSq E{(gbf16*)(ws + WS_OUT), (gfloat*)(ws + WS_OUTP)};
          pg8::gemm_phase<pg8::EpiSq, pg8::SchedPlain>(Fp.lds, DM, DM, DM, S, E); }
#endif
        for (int rb_ = 0; rb_ < REP_BAR; ++rb_) xcd_barrier(bar);
#ifndef SKIP_P4B
        for (int rep_ = 0; rep_ < REP_THIN; ++rep_) p4b_x1(FL(), WSL(), ARGP(const gfloat*, 15) + l * DM);
#endif
        for (int rb_ = 0; rb_ < REP_BAR; ++rb_) xcd_barrier(bar);
#ifndef SKIP_P5
        { const Ctx Fp = FL(); guchar* ws = WSL(); pg8::SchedPlain S; S.T.init(M_ROWS / 256, DM / 256, Fp.G, Fp.bx); S.A = (const gchar*)(ws + ((P5_FP8 || P5_I8) ? WS_X1B8 : WS_X1B)); S.B = (const gchar*)(ws + WS_WPG + (size_t)l * SZ_WSQ);
          S.astep = (size_t)256 * DM * ((P5_FP8 || P5_I8) ? 1 : 2); S.bstep = (size_t)256 * DM * ((P5_FP8 || P5_I8) ? 1 : 2);
          pg8::EpiPle E{(const gbf16*)(ws + WS_X1B), ARGP(gfloat*, 19), (gbf16*)(ws + WS_XB), (const gbf16*)(ws + WS_ERAW), (const gfloat*)(ws + WS_RSE), ARGP(const gfloat*, 17) + l * DM, (gfloat*)(ws + WS_XSP), l == NLAYER - 1 ? 1 : 0, ws + WS_XB8, (const gfloat*)(ws + WS_RSX), __uint_as_float(((const gunsigned*)(ws + WS_CTL))[CW_WMAX + l]) * (1.0f / 127.0f)};
          pg8::gemm_phase<pg8::EpiPle, pg8::SchedPlain>(Fp.lds, (P5_FP8 || P5_I8) ? DM / 2 : DM, DM, DM, S, E); }
#endif
        if (l + 1 < NLAYER) { for (int rb_ = 0; rb_ < REP_BAR; ++rb_) xcd_barrier(bar); p5b_ssq(FL(), WSL()); for (int rb_ = 0; rb_ < REP_BAR; ++rb_) xcd_barrier(bar); }
    };
    static_assert(NLAYER == 2, "two layer bodies");
    layer_body(0); layer_body(1);
}

extern "C" void kernel_launch(void* const* d_in, const int* in_sizes, int n_in, void* d_out, int out_size, void* d_ws, size_t ws_size, hipStream_t stream) {
    static int grid = 0;
    if (grid == 0) {
        if (n_in != 19 || out_size != M_ROWS * DM || ws_size < WS_END) { fprintf(stderr, "kernel_launch: unexpected problem (n_in %d, out %d, ws %zu, need %zu)\n", n_in, out_size, ws_size, (size_t)WS_END); grid = -1; return; }
        int dev = 0, cus = 0;
        if (hipGetDevice(&dev) != hipSuccess || hipDeviceGetAttribute(&cus, hipDeviceAttributeMultiprocessorCount, dev) != hipSuccess) { grid = -1; return; }
        if (hipFuncSetAttribute((const void*)fwd_kernel, hipFuncAttributeMaxDynamicSharedMemorySize, LDS_BYTES) != hipSuccess) { fprintf(stderr, "kernel_launch: hipFuncSetAttribute failed\n"); grid = -1; return; }
        int per_cu = 0; (void)hipOccupancyMaxActiveBlocksPerMultiprocessor(&per_cu, (const void*)fwd_kernel, NTHREADS, LDS_BYTES); (void)hipGetLastError();
        if (per_cu < 1) fprintf(stderr, "kernel_launch: occupancy query reports %d blocks per CU\n", per_cu);
        grid = cus > 256 ? 256 : cus;
    }
    if (grid < 0) return;
    (void)hipMemsetAsync((char*)d_ws + WS_CTL, 0, CTL_ZERO_BYTES, stream);
    Args a{};
    for (int i = 0; i < 19; ++i) a.in[i] = d_in[i];
    a.out = (float*)d_out; a.ws = (unsigned char*)d_ws;
    hipLaunchKernelGGL(fwd_kernel, dim3(grid), dim3(NTHREADS), LDS_BYTES, stream, a);
    const hipError_t le = hipPeekAtLastError();
    if (le != hipSuccess) fprintf(stderr, "kernel_launch: launch failed: %s\n", hipGetErrorName(le));
}
```

```cpp
#include <hip/hip_runtime.h>
#include <cstdio>
#include <cstdint>

#define LAS __attribute__((address_space(3)))
#define GAS __attribute__((address_space(1)))
typedef unsigned short bf16_t;
typedef short bf16x8 __attribute__((ext_vector_type(8)));
typedef float f32x4 __attribute__((ext_vector_type(4)));
typedef float f32x2 __attribute__((ext_vector_type(2)));
typedef unsigned u32x4 __attribute__((ext_vector_type(4)));
typedef unsigned u32x2 __attribute__((ext_vector_type(2)));

typedef GAS float gfloat; typedef GAS bf16_t gbf16; typedef GAS int gint; typedef GAS char gchar; typedef GAS unsigned char guchar; typedef GAS unsigned gunsigned;
typedef GAS f32x4 gf32x4; typedef GAS f32x2 gf32x2; typedef GAS u32x4 gu32x4; typedef GAS u32x2 gu32x2;
constexpr int M_ROWS = 8192, SEQ = 2048, DM = 4096, BW = 2048, NLAYER = 2;
constexpr int N_IN = 31240, IF_COL = 14848;
constexpr int NT_IN = 123;
constexpr int N_IN_T = NT_IN * 256;
constexpr float NORM_EPS = 1e-6f;

__device__ __forceinline__ unsigned cvt_pk_bf16(float lo, float hi) { unsigned r; asm("v_cvt_pk_bf16_f32 %0, %1, %2" : "=v"(r) : "v"(lo), "v"(hi)); return r; }
__device__ __forceinline__ float bf_lo(unsigned w) { return __uint_as_float(w << 16); }
__device__ __forceinline__ float bf_hi(unsigned w) { return __uint_as_float(w & 0xffff0000u); }
__device__ __forceinline__ float bf1(bf16_t b) { return __uint_as_float(((unsigned)b) << 16); }
__device__ __forceinline__ float fsigmoid(float x) { return __builtin_amdgcn_rcpf(1.0f + __expf(-x)); }
__device__ __forceinline__ float wave_sum(float v) {
#pragma unroll
    for (int o = 1; o < 64; o <<= 1) v += __shfl_xor(v, o);
    return v;
}
__device__ __forceinline__ f32x2 gelu_pk(f32x2 v) {
    const f32x2 av = __builtin_elementwise_abs(v), d = av * 0.2316418882f + 1.0f;
    f32x2 t; t.x = __builtin_amdgcn_rcpf(d.x); t.y = __builtin_amdgcn_rcpf(d.y);
    f32x2 q = t * 0.5307027145f + (-0.7265760135f); q = q * t + 0.7107068705f; q = q * t + (-0.142248368f); q = q * t + 0.127414796f; q = q * t;
    const f32x2 s = (v * v) * (-0.72134752044f);
    f32x2 e; e.x = __builtin_amdgcn_exp2f(s.x); e.y = __builtin_amdgcn_exp2f(s.y);
    const f32x2 m = v * (q * e), r = v - m;
    f32x2 o; o.x = v.x < 0.f ? m.x : r.x; o.y = v.y < 0.f ? m.y : r.y; return o;
}
typedef int i32x8 __attribute__((ext_vector_type(8)));
typedef short s16x16 __attribute__((ext_vector_type(16)));
__host__ __device__ __forceinline__ size_t ablk8(int row, int col, int K) { return ((size_t)(row >> 8) * (K >> 7) + (col >> 7)) * 32768 + (size_t)(row & 255) * 128 + (col & 127); }
__device__ __forceinline__ unsigned pack_fp8x4(float a, float b, float c, float d) { int w = 0; w = __builtin_amdgcn_cvt_pk_fp8_f32(a, b, w, false); w = __builtin_amdgcn_cvt_pk_fp8_f32(c, d, w, true); return (unsigned)w; }
typedef float f32x16 __attribute__((ext_vector_type(16)));
typedef unsigned u32x6 __attribute__((ext_vector_type(6)));
__device__ __forceinline__ u32x6 mx6_pack(const float (&v)[32], unsigned& E) {
    float mx = 0.f;
#pragma unroll
    for (int i = 0; i < 32; ++i) mx = fmaxf(mx, fabsf(v[i]));
    const unsigned b = __float_as_uint(mx * (1.0f / 7.5f)); unsigned eb = (b >> 23) & 0xffu; if (b & 0x7fffffu) eb += 1u; eb = eb < 1u ? 1u : (eb > 254u ? 254u : eb);
    E = eb; const float s = __uint_as_float(eb << 23); f32x16 a, c;
#pragma unroll
    for (int i = 0; i < 16; ++i) { a[i] = v[i]; c[i] = v[16 + i]; }
    u32x6 d;
    asm volatile("s_nop 7\n\tv_cvt_scalef32_2xpk16_fp6_f32 %0, %1, %2, %3\n\ts_nop 7\n\ts_nop 7" : "=&v"(d) : "v"(a), "v"(c), "v"(s));
    return d;
}
__device__ __forceinline__ unsigned pack_i8x4(float a, float b, float c, float d) {
    const int q0 = min(max(__float2int_rn(a), -127), 127), q1 = min(max(__float2int_rn(b), -127), 127), q2 = min(max(__float2int_rn(c), -127), 127), q3 = min(max(__float2int_rn(d), -127), 127);
    return ((unsigned)q0 & 0xffu) | (((unsigned)q1 & 0xffu) << 8) | (((unsigned)q2 & 0xffu) << 16) | ((unsigned)q3 << 24);
}
__host__ __device__ __forceinline__ size_t ablk(int row, int col, int K) { return ((size_t)(row >> 8) * (K >> 6) + (col >> 6)) * 16384 + (size_t)(row & 255) * 64 + (col & 63); }
__host__ __device__ __forceinline__ size_t tb256(int row, int col, int nt) { return ((size_t)(row >> 8) * nt + (col >> 8)) * 65536 + (size_t)(row & 255) * 256 + (col & 255); }
__host__ __device__ __forceinline__ size_t tb128(int row, int col, int nt) { return ((size_t)(row >> 8) * nt + (col >> 7)) * 32768 + (size_t)(row & 255) * 128 + (col & 127); }
#define LAUNDER_V(x) asm volatile("" : "+v"(x))
#define LAUNDER_S(x) asm volatile("" : "+s"(x))
#define LDS_WAIT() asm volatile("s_waitcnt lgkmcnt(0)" ::: "memory")
#define VM_WAIT() asm volatile("s_waitcnt vmcnt(0)" ::: "memory")
#define MFMA16(a, b, c) __builtin_amdgcn_mfma_f32_16x16x32_bf16((a), (b), (c), 0, 0, 0)

#define XB_TMO      128
#define XB_XCNT(j)  (256  + 64 * (j))
#define XB_XSUB(j)  (1280 + 64 * (j))
#define XB_XGEN(j)  (2304 + 64 * (j))
#define XB_TOP      3328
#define XB_TOPGEN   3392
#define XCD_BAR_WORDS 3456
#define XB_SPIN_CAP (1u << 18)
__device__ __forceinline__ unsigned xb_ld(unsigned* p)              { return __hip_atomic_load(p, __ATOMIC_RELAXED, __HIP_MEMORY_SCOPE_AGENT); }
__device__ __forceinline__ unsigned xb_add(unsigned* p, unsigned v) { return __hip_atomic_fetch_add(p, v, __ATOMIC_RELAXED, __HIP_MEMORY_SCOPE_AGENT); }
__device__ __forceinline__ unsigned xb_xcc_id() { return (unsigned)__builtin_amdgcn_s_getreg((3 << 11) | 20) & 0xFu; }
#define XB_SPIN(cond, bar) do { unsigned _sp = 0; while (cond) { __builtin_amdgcn_s_sleep(1); \
    if ((++_sp & 255u) == 0u) { if (xb_ld(&(bar)[XB_TMO])) break; if (_sp > XB_SPIN_CAP) { atomicAdd(&(bar)[XB_TMO], 1u); break; } } } } while (0)
struct XcdBarrier { unsigned* bar; unsigned x; volatile LAS unsigned* st; };
__device__ __forceinline__ XcdBarrier xcd_barrier_post(unsigned* bar, volatile LAS unsigned* st) {
    XcdBarrier b; b.bar = bar; b.x = xb_xcc_id(); b.st = st;
    if (threadIdx.x == 0) (void)xb_add(&bar[XB_XCNT(b.x)], 1u);
    return b;
}
__device__ __forceinline__ void xcd_barrier_complete(unsigned* bar, unsigned x, unsigned& nloc, unsigned& nx) {
    const unsigned G = gridDim.x * gridDim.y * gridDim.z;
    unsigned sum, cnt, mine, sp = 0u;
    for (;;) {
        sum = 0u; cnt = 0u; mine = 0u;
#pragma unroll
        for (unsigned j = 0; j < 16; ++j) { const unsigned c = xb_ld(&bar[XB_XCNT(j)]); sum += c; cnt += (c > 0u) ? 1u : 0u; mine = (j == x) ? c : mine; }
        if (sum == G) break;
        __builtin_amdgcn_s_sleep(1);
        if ((++sp & 255u) == 0u) { if (xb_ld(&bar[XB_TMO])) break; if (sp > XB_SPIN_CAP) { atomicAdd(&bar[XB_TMO], 1u); break; } }
    }
    nloc = mine > 0u ? mine : 1u; nx = cnt > 0u ? cnt : 1u;
}
__device__ __forceinline__ void xcd_barrier(const XcdBarrier& b) {
    asm volatile("s_waitcnt vmcnt(0)" ::: "memory");
    __syncthreads();
    if (threadIdx.x == 0) {
        unsigned* bar = b.bar;
        __builtin_amdgcn_s_waitcnt(0);
        unsigned nloc = b.st[0], nx = b.st[1];
        if (nloc == 0u) { xcd_barrier_complete(bar, b.x, nloc, nx); b.st[0] = nloc; b.st[1] = nx; }
        const unsigned old = xb_add(&bar[XB_XSUB(b.x)], 1u);
        const unsigned gen = old / nloc;
        if (old + 1u == (gen + 1u) * nloc) {
            __builtin_amdgcn_fence(__ATOMIC_RELEASE, "agent");
            asm volatile("s_waitcnt vmcnt(0)" ::: "memory");
            const unsigned og = xb_add(&bar[XB_TOP], 1u);
            const unsigned tg = og / nx;
            if (og + 1u == (tg + 1u) * nx) xb_add(&bar[XB_TOPGEN], 1u);
            else XB_SPIN(xb_ld(&bar[XB_TOPGEN]) == tg, bar);
            __builtin_amdgcn_fence(__ATOMIC_ACQUIRE, "agent");
            xb_add(&bar[XB_XGEN(b.x)], 1u);
            asm volatile("s_waitcnt vmcnt(0)" ::: "memory");
        } else {
            XB_SPIN(xb_ld(&bar[XB_XGEN(b.x)]) == gen, bar);
            __builtin_amdgcn_fence(__ATOMIC_ACQUIRE, "agent");
            asm volatile("s_waitcnt vmcnt(0)" ::: "memory");
        }
    }
    __syncthreads();
}

#ifndef WGM_DEFAULT
#define WGM_DEFAULT 4
#endif
#ifndef DBG_F6_CONSTSCALE
#define DBG_F6_CONSTSCALE 0
#endif
#ifndef PG8_SADDR
#define PG8_SADDR 1
#endif
namespace pg8 {
constexpr int BM = 256, BK = 64, HALF = 128, HTB = HALF * BK * 2, STAGE_BYTES = 8 * HTB, NXCD = 8, WGM = WGM_DEFAULT;
__host__ __device__ __forceinline__ int lds_byte(int r, int c) { const int st = (r >> 4) * 2 + (c >> 5), rr = r & 15, cc = c & 31, ob = rr * 64 + cc * 2; return st * 1024 + (ob ^ (((ob >> 9) & 1) << 5)); }
__host__ __device__ __forceinline__ void stage_rc(int b, int& R, int& C) { const int st = b / 1024, sb = b % 1024, swz = sb ^ (((sb >> 9) & 1) << 5); R = (st >> 1) * 16 + swz / 64; C = (st & 1) * 32 + (swz % 64) / 2; }
__host__ __device__ __forceinline__ int perm32(int rho) { const int n = rho >> 4, i = rho & 15; return 8 * (i >> 2) + 4 * n + (i & 3); }

struct Unit { int pm, pn, seg; };

struct TileOrder {
    int nM, nN, nwg, G, c, wgm, rot, tailtile, pnoff;
    __device__ __forceinline__ void init(int nM_, int nN_, int G_, int c_, int wgm_ = WGM, int rot_ = 0, int tailtile_ = -1, int pnoff_ = 0) { nM = nM_; nN = nN_; nwg = nM * nN; G = G_; c = c_; wgm = wgm_; rot = rot_; tailtile = tailtile_; pnoff = pnoff_; }
    __device__ __forceinline__ bool tile(int i, int& pm, int& pn) const {
        const long L = (long)i * G + c; if (L >= nwg) return false;
        int wgid = (int)L; const int xcd = wgid % NXCD; { const int q = nwg / NXCD, r = nwg % NXCD, off = wgid / NXCD; wgid = (xcd < r ? xcd * (q + 1) : r * (q + 1) + (xcd - r) * q) + off; }
        const int nig = wgm * nN, gid = wgid / nig, fm = gid * wgm, gsz = (nM - fm) < wgm ? (nM - fm) : wgm;
        pm = fm + ((wgid % nig) % gsz); pn = (wgid % nig) / gsz; if (rot) { pn += rot * xcd; pn -= (pn / nN) * nN; } if (tailtile >= 0 && pn == nN - 1) pn = tailtile; pn += pnoff; return true;
    }
};
struct SchedPlain {
    TileOrder T; const gchar* A; const gchar* B; size_t astep, bstep;
    __device__ __forceinline__ bool next(int i, Unit& u) const { u.seg = 0; return T.tile(i, u.pm, u.pn); }
    __device__ __forceinline__ const gchar* a_ptr(const Unit& u) const { return A + (size_t)u.pm * astep; }
    int pn0 = 0;
    __device__ __forceinline__ const gchar* b_ptr(const Unit& u) const { return B + (size_t)(u.pn - pn0) * bstep; }
};
struct SchedBranch {
    TileOrder T; const gchar* A; const gchar* B; size_t astep, bstep, aseg, bseg;
    __device__ __forceinline__ bool next(int i, Unit& u) const { const int t = i / 3; u.seg = i - 3 * t; return T.tile(t, u.pm, u.pn); }
    __device__ __forceinline__ const gchar* a_ptr(const Unit& u) const { return A + (size_t)u.seg * aseg + (size_t)u.pm * astep; }
    __device__ __forceinline__ const gchar* b_ptr(const Unit& u) const { return B + (size_t)u.seg * bseg + (size_t)u.pn * bstep; }
};

template <class Epi, class Sched>
__device__ __forceinline__ void gemm_phase(LAS unsigned char* lds, const int K, const int lda, const int ldb, const Sched& S, const Epi& E, unsigned* lockctr = nullptr, const int nlock = 0) {
    int tid = threadIdx.x; LAUNDER_V(tid);
    const int wid = __builtin_amdgcn_readfirstlane(tid >> 6), lane = tid & 63, wr = wid >> 2, wc = wid & 3, fr = lane & 15, fq = lane >> 4;
    const int nt = K / BK;
    unsigned voffA, voffB;
    { int R, C; stage_rc(tid * 16, R, C); const int Rb = Epi::PERM ? ((R & ~31) + perm32(R & 31)) : R;
      voffA = (unsigned)(R * BK + C) * 2u; voffB = (unsigned)(Rb * BK + C) * 2u; }
    const unsigned qstepA = 64u * (unsigned)BK * 2u, qstepB = 64u * (unsigned)BK * 2u;
    const size_t kstep = (size_t)BM * BK * 2, kstepB = (size_t)BM * BK * 2;
    const size_t hstepA = (size_t)HALF * BK * 2, hstepB = (size_t)HALF * BK * 2;
    const unsigned ldsw = (unsigned)wid * 1024u;
    const int aoff = lds_byte(wr * 64 + fr, fq * 8), boff = lds_byte(wc * 32 + fr, fq * 8);
#define PG8_SA(b, h) (((b) * 2 + (h)) * HTB)
#define PG8_SB(b, h) ((4 + (b) * 2 + (h)) * HTB)
#if PG8_SADDR
#define PG8_STAGE(bufoff, gbase, voff) do { _Pragma("unroll") for (int _i = 0; _i < 2; ++_i) { const gchar* p_ = (const gchar*)(gbase) + (size_t)_i * q##voff; asm volatile("" : "+s"(p_)); \
        __builtin_amdgcn_global_load_lds((const gunsigned*)(p_ + (voff)), (LAS unsigned*)(lds + (bufoff) + ldsw + _i * 8192), 16, 0, 0); } } while (0)
#else
#define PG8_STAGE(bufoff, gbase, voff) do { _Pragma("unroll") for (int _i = 0; _i < 2; ++_i) \
        __builtin_amdgcn_global_load_lds((const gunsigned*)((const gchar*)(gbase) + (size_t)_i * q##voff + (voff)), (LAS unsigned*)(lds + (bufoff) + ldsw + _i * 8192), 16, 0, 0); } while (0)
#endif
#define qvoffA qstepA
#define qvoffB qstepB
#define PG8_LDA(dst, b, h) do { _Pragma("unroll") for (int m = 0; m < 4; ++m) _Pragma("unroll") for (int k = 0; k < 2; ++k) dst[m][k] = *(const LAS bf16x8*)(lds + PG8_SA(b, h) + aoff + m * 2048 + k * 1024); } while (0)
#define PG8_LDB(dst, b, h) do { _Pragma("unroll") for (int n = 0; n < 2; ++n) _Pragma("unroll") for (int k = 0; k < 2; ++k) dst[n][k] = *(const LAS bf16x8*)(lds + PG8_SB(b, h) + boff + n * 2048 + k * 1024); } while (0)
#define PG8_CAT(x_, y_) __builtin_bit_cast(i32x8, __builtin_shufflevector((x_), (y_), 0, 1, 2, 3, 4, 5, 6, 7, 8, 9, 10, 11, 12, 13, 14, 15))
#define PG8_MMA(ai, bj, At, Bt) do { __builtin_amdgcn_s_setprio(1); _Pragma("unroll") for (int m = 0; m < 4; ++m) _Pragma("unroll") for (int n = 0; n < 2; ++n) { \
        if constexpr (Epi::FP8) { const i32x8 b8_ = PG8_CAT(Bt[n][0], Bt[n][1]), a8_ = PG8_CAT(At[m][0], At[m][1]); \
            asm volatile("s_nop 1\n\tv_mfma_scale_f32_16x16x128_f8f6f4 %0, %1, %2, %0, %3, %3 op_sel_hi:[0,0,0]" : "+v"(acc[ai][bj][m][n]) : "v"(b8_), "v"(a8_), "v"(sc8)); } \
        else if constexpr (Epi::F6) { const i32x8 b8_ = PG8_CAT(Bt[n][0], Bt[n][1]), a8_ = PG8_CAT(At[m][0], At[m][1]); const int sb_ = DBG_F6_CONSTSCALE ? sc8 : b8_[6], sa_ = DBG_F6_CONSTSCALE ? sc8 : a8_[6]; typedef int i32x6_ __attribute__((ext_vector_type(6))); \
            const i32x6_ b6_ = __builtin_shufflevector(b8_, b8_, 0, 1, 2, 3, 4, 5), a6_ = __builtin_shufflevector(a8_, a8_, 0, 1, 2, 3, 4, 5); \
            asm volatile("s_nop 1\n\tv_mfma_scale_f32_16x16x128_f8f6f4 %0, %1, %2, %0, %3, %4 op_sel_hi:[0,0,0] cbsz:2 blgp:2" : "+v"(acc[ai][bj][m][n]) : "v"(b6_), "v"(a6_), "v"(sb_), "v"(sa_)); } \
        else if constexpr (Epi::I8) { _Pragma("unroll") for (int k = 0; k < 2; ++k) asm volatile("s_nop 1\n\tv_mfma_i32_16x16x64_i8 %0, %1, %2, %0" : "+v"(acc[ai][bj][m][n]) : "v"(Bt[n][k]), "v"(At[m][k])); } \
        else { _Pragma("unroll") for (int k = 0; k < 2; ++k) acc[ai][bj][m][n] = __builtin_amdgcn_mfma_f32_16x16x32_bf16(Bt[n][k], At[m][k], acc[ai][bj][m][n], 0, 0, 0); } } __builtin_amdgcn_s_setprio(0); } while (0)
#define PG8_WAIT_V(n) asm volatile("s_waitcnt vmcnt(" #n ")" ::: "memory")
#define PG8_WAIT_VR() do { if constexpr (Epi::NS == 16) asm volatile("s_waitcnt vmcnt(24)" ::: "memory"); else if constexpr (Epi::NS == 32) asm volatile("s_waitcnt vmcnt(40)" ::: "memory"); else asm volatile("s_waitcnt vmcnt(8)" ::: "memory"); } while (0)
#define PG8_WAIT_L(n) asm volatile("s_waitcnt lgkmcnt(" #n ")" ::: "memory")
#define PG8_BAR __builtin_amdgcn_s_barrier()
#define PG8_SCHED __builtin_amdgcn_sched_barrier(0)
    Unit cur, nxt; int ui = 0; bool relax_next = false;
    int sc8 = 0x7f7f7f7f; asm volatile("" : "+v"(sc8));
    if (!S.next(0, cur)) return;
    f32x4 acc[2][2][4][2];
#pragma unroll
    for (int a = 0; a < 2; ++a)
#pragma unroll
        for (int b = 0; b < 2; ++b)
#pragma unroll
            for (int m = 0; m < 4; ++m)
#pragma unroll
                for (int n = 0; n < 2; ++n) acc[a][b][m][n] = (f32x4){0.f, 0.f, 0.f, 0.f};
    bf16x8 At[4][2], B0[2][2], B1[2][2];
    const gchar* cA = S.a_ptr(cur); const gchar* cB = S.b_ptr(cur);
    PG8_STAGE(PG8_SB(0, 0), cB, voffB); PG8_STAGE(PG8_SB(0, 1), cB + hstepB, voffB); PG8_STAGE(PG8_SA(0, 0), cA, voffA); PG8_STAGE(PG8_SA(0, 1), cA + hstepA, voffA);
    if (wr == 1) PG8_BAR;
    PG8_WAIT_V(2); PG8_BAR;
    PG8_STAGE(PG8_SB(1, 0), cB + kstepB, voffB); PG8_STAGE(PG8_SA(1, 0), cA + kstep, voffA); PG8_STAGE(PG8_SB(1, 1), cB + hstepB + kstepB, voffB);
    PG8_WAIT_V(6); PG8_BAR;
    for (;;) {
        const bool has_next = S.next(ui + 1, nxt);
        const gchar* nA = has_next ? S.a_ptr(nxt) : cA; const gchar* nB = has_next ? S.b_ptr(nxt) : cB;
        for (int t = 0; t < nt; t += 2) {
            const bool last = (t == nt - 2); const bool relax = Epi::NS > 0 && (t == 0) && relax_next;
#if PG8_SADDR
            asm volatile("" : "+v"(voffA), "+v"(voffB));
#endif
            const gchar* a1 = cA + (size_t)(t + 1) * kstep;
            const gchar* a2 = last ? nA : cA + (size_t)(t + 2) * kstep; const gchar* b2 = last ? nB : cB + (size_t)(t + 2) * kstepB;
            const gchar* a3 = a2 + kstep; const gchar* b3 = b2 + kstepB;
            PG8_LDB(B0, 0, 0); PG8_LDB(B1, 0, 1); PG8_SCHED; PG8_LDA(At, 0, 0); PG8_STAGE(PG8_SA(1, 1), a1 + hstepA, voffA);
            if (relax) PG8_WAIT_VR(); else PG8_WAIT_V(8); PG8_WAIT_L(0); PG8_BAR; PG8_MMA(0, 0, At, B0); PG8_MMA(0, 1, At, B1); PG8_BAR; PG8_SCHED;
            PG8_LDA(At, 0, 1); PG8_STAGE(PG8_SB(0, 0), b2, voffB); PG8_STAGE(PG8_SB(0, 1), b2 + hstepB, voffB); PG8_STAGE(PG8_SA(0, 0), a2, voffA);
            if (relax) PG8_WAIT_VR(); else PG8_WAIT_V(8); PG8_WAIT_L(0); PG8_BAR; PG8_MMA(1, 0, At, B0); PG8_MMA(1, 1, At, B1); PG8_BAR; PG8_SCHED;
            PG8_LDB(B0, 1, 0); PG8_LDB(B1, 1, 1); PG8_SCHED; PG8_LDA(At, 1, 0); PG8_STAGE(PG8_SA(0, 1), a2 + hstepA, voffA);
            PG8_WAIT_V(8); PG8_WAIT_L(0); PG8_BAR; PG8_MMA(0, 0, At, B0); PG8_MMA(0, 1, At, B1); PG8_BAR; PG8_SCHED;
            PG8_LDA(At, 1, 1); PG8_STAGE(PG8_SB(1, 0), b3, voffB); PG8_STAGE(PG8_SB(1, 1), b3 + hstepB, voffB); PG8_STAGE(PG8_SA(1, 0), a3, voffA);
            PG8_WAIT_V(8); PG8_WAIT_L(0); PG8_BAR; PG8_MMA(1, 0, At, B0); PG8_MMA(1, 1, At, B1); PG8_BAR; PG8_SCHED;
        }
        if constexpr (Epi::FP8 || Epi::I8 || Epi::F6) asm volatile("s_nop 15\n\ts_nop 15\n\ts_nop 15\n\ts_nop 15" ::: "memory");
        if (wr == 0) PG8_BAR;
        { const int ln_ = (int)__builtin_amdgcn_mbcnt_hi(~0u, __builtin_amdgcn_mbcnt_lo(~0u, 0u)); E(acc, cur, wr, wc, ln_ & 15, ln_ >> 4); } relax_next = E.relax(cur);
        if (ui < nlock) {
            if (tid == 0) { (void)xb_add(lockctr, 1u); const unsigned tgt_ = (unsigned)(ui + 1) * (unsigned)S.T.G; unsigned sp_ = 0u; while (xb_ld(lockctr) < tgt_) { __builtin_amdgcn_s_sleep(1); if (++sp_ > (1u << 20)) break; } }
            PG8_BAR; }
        if (!has_next) break;
        if (!E.keep(cur)) {
#pragma unroll
            for (int a = 0; a < 2; ++a)
#pragma unroll
                for (int b = 0; b < 2; ++b)
#pragma unroll
                    for (int m = 0; m < 4; ++m)
#pragma unroll
                        for (int n = 0; n < 2; ++n) acc[a][b][m][n] = (f32x4){0.f, 0.f, 0.f, 0.f};
        }
        cur = nxt; cA = nA; cB = nB; ++ui;
        if (wr == 1) PG8_BAR;
    }
    PG8_WAIT_V(0);
    PG8_BAR;
#undef PG8_SA
#undef PG8_SB
#undef PG8_STAGE
#undef qvoffA
#undef qvoffB
#undef PG8_LDA
#undef PG8_LDB
#undef PG8_MMA
#undef PG8_CAT
#undef PG8_WAIT_V
#undef PG8_WAIT_VR
#undef PG8_WAIT_L
#undef PG8_BAR
#undef PG8_SCHED
}
}

constexpr size_t MiB = 1u << 20;
constexpr size_t WS_CTL = 0, CTL_ZERO_BYTES = 1 * MiB;
constexpr int CW_BAR = 4096;
constexpr size_t CTL_SSQ1 = 256 * 1024;
constexpr size_t SZ_WIN = (size_t)N_IN_T * DM * 2, SZ_WBR = (size_t)3 * DM * BW * 2, SZ_WSQ = (size_t)DM * DM * 2, SZ_WPP = (size_t)DM * 256 * 2;
constexpr size_t WS_WIN = 2 * MiB;
constexpr size_t WS_WBR = WS_WIN + 2 * SZ_WIN;
constexpr size_t WS_WOUT = WS_WBR + 2 * SZ_WBR;
constexpr size_t WS_WPG = WS_WOUT + 2 * SZ_WSQ;
constexpr size_t WS_WPP = WS_WPG + 2 * SZ_WSQ;
constexpr size_t SZ_ROWS_BW = (size_t)M_ROWS * BW * 2, SZ_ROWS_D = (size_t)M_ROWS * DM * 2;
constexpr size_t WS_XB = WS_WPP + 2 * SZ_WPP;
constexpr size_t WS_PB = WS_XB + SZ_ROWS_D;
constexpr size_t WS_CS = WS_PB + (size_t)2 * M_ROWS * 256 * 2;
constexpr size_t WS_SSQ0 = WS_CS + (size_t)M_ROWS * 16 * 4;
constexpr size_t WS_AU = WS_SSQ0 + (size_t)M_ROWS * 4;
constexpr size_t WS_AV = WS_AU + SZ_ROWS_BW, WS_AZ = WS_AV + SZ_ROWS_BW, WS_BQ = WS_AZ + SZ_ROWS_BW;
constexpr size_t WS_BK = WS_BQ + SZ_ROWS_BW;
constexpr size_t WS_BV = WS_BK + (size_t)M_ROWS * 256 * 2;
constexpr size_t WS_BZ = WS_BV + (size_t)M_ROWS * 256 * 2;
constexpr size_t WS_CQ = WS_BZ + SZ_ROWS_BW;
constexpr size_t WS_CK = WS_CQ + (size_t)M_ROWS * 1024 * 2;
constexpr size_t WS_CV = WS_CK + (size_t)M_ROWS * 1024 * 2;
constexpr size_t WS_CO = WS_CV + SZ_ROWS_BW, WS_CZ = WS_CO + SZ_ROWS_BW;
constexpr size_t WS_G = WS_CZ + SZ_ROWS_BW;
constexpr size_t WS_IF = WS_G + (size_t)M_ROWS * 12288 * 2;
constexpr size_t WS_LNP = WS_IF + (size_t)M_ROWS * 8 * 4;
constexpr size_t WS_YA = WS_LNP + (size_t)M_ROWS * 32 * 8;
constexpr size_t WS_NUM = WS_YA + 3 * SZ_ROWS_BW;
constexpr size_t WS_SSQC = WS_NUM + SZ_ROWS_BW;
constexpr size_t WS_DN = WS_SSQC + (size_t)M_ROWS * 64 * 4;
constexpr size_t WS_MIX = WS_DN + (size_t)M_ROWS * 4 * 4;
constexpr size_t WS_OUT = WS_MIX + SZ_ROWS_D;
constexpr size_t WS_OUTP = WS_OUT + SZ_ROWS_D;
constexpr size_t WS_ERAW = WS_OUTP + (size_t)M_ROWS * 64 * 4;
constexpr size_t WS_ERP = WS_ERAW + SZ_ROWS_D;
constexpr size_t WS_RSO = WS_ERP + (size_t)M_ROWS * 64 * 4;
constexpr size_t WS_RSE = WS_RSO + (size_t)M_ROWS * 4;
constexpr size_t WS_X1B = WS_RSE + (size_t)M_ROWS * 4;
constexpr size_t WS_XSP = WS_X1B + SZ_ROWS_D;
constexpr size_t WS_X1B8 = WS_XSP + (size_t)M_ROWS * 64 * 4;
constexpr size_t WS_RSX = WS_X1B8 + (size_t)M_ROWS * DM;
constexpr size_t WS_XB8 = WS_RSX + (size_t)M_ROWS * 4;
constexpr size_t SZ_WG8 = (size_t)56 * 256 * DM;
constexpr size_t WS_WG8 = WS_XB8 + (size_t)M_ROWS * DM;
constexpr size_t WS_END = WS_WG8 + 2 * SZ_WG8;
static_assert(WS_WIN % 256 == 0 && WS_XB % 256 == 0 && WS_AU % 256 == 0 && WS_G % 256 == 0 && WS_YA % 256 == 0 && WS_MIX % 256 == 0 && WS_X1B % 256 == 0, "alignment");

#ifndef EPIIN_NT
#define EPIIN_NT 0
#endif
#if EPIIN_NT
#define EPIIN_STORE(v, p) __builtin_nontemporal_store((v), (p))
#else
#define EPIIN_STORE(v, p) (*(p) = (v))
#endif
#ifndef DBG_ZERO_ASC
#define DBG_ZERO_ASC 0
#endif
#ifndef DBG_F6_AS_FP8
#define DBG_F6_AS_FP8 0
#endif
#ifndef P1G_F6
#define P1G_F6 1
#endif
#ifndef P1G_FP8
#define P1G_FP8 1
#endif
#ifndef P5_I8
#define P5_I8 1
#endif
constexpr int CW_WMAX = 512;
#ifndef P5_FP8
#define P5_FP8 0
#endif
constexpr float W8_SCALE = 256.0f;
#ifndef EPI_NS16
#define EPI_NS16 0
#endif
#ifndef EPI_NS32
#define EPI_NS32 0
#endif
#ifndef EPIIN_NS
#define EPIIN_NS 0
#endif
namespace pg8 {
__device__ __forceinline__ unsigned pack_u8x4(float a, float b, float c, float d) {
    const unsigned q0 = (unsigned)(a * 255.0f + 0.5f), q1 = (unsigned)(b * 255.0f + 0.5f), q2 = (unsigned)(c * 255.0f + 0.5f), q3 = (unsigned)(d * 255.0f + 0.5f);
    return q0 | (q1 << 8) | (q2 << 16) | (q3 << 24);
}
template <bool F8> struct EpiInT {
    static constexpr bool PERM = true; static constexpr int NS = EPIIN_NS; static constexpr bool FP8 = F8 && (!P1G_F6 || DBG_F6_AS_FP8); static constexpr bool I8 = false; static constexpr bool F6 = F8 && P1G_F6 && !DBG_F6_AS_FP8;
    __device__ __forceinline__ bool relax(const Unit& u) const { return u.pn < 122; }
    const gfloat* ssq; guchar* ws; const LAS float* rtab; int rowbase;
    __device__ __forceinline__ float rstd_of(int row) const { return rowbase >= 0 ? rtab[row - rowbase] : rsqrtf(ssq[row] * (1.0f / DM) + NORM_EPS); }
    __device__ __forceinline__ bool keep(const Unit&) const { return false; }
    __device__ __forceinline__ void operator()(f32x4 (&acc)[2][2][4][2], const Unit& u, int wr, int wc, int fr, int fq) const {
        const int pn = u.pn; const int row0 = u.pm * BM + wr * 64 + fr;
        size_t off; int ldc, t0, act; float sc = 1.f;
        if (F8)            { if (pn < 122) { off = WS_G; ldc = 12288; t0 = 74; act = 3; } else { off = WS_CO; ldc = 2048; t0 = 122; act = 8; } sc = P1G_F6 ? 1.0f : 1.0f / W8_SCALE; }
        else if (pn < 16)  { off = WS_AU; ldc = 2048; t0 = 0; act = 6; }
        else if (pn < 24)  { off = WS_AV; ldc = 2048; t0 = 16; act = 5; }
        else if (pn < 32)  { off = WS_BQ; ldc = 2048; t0 = 24; act = 0; }
        else if (pn < 33)  { off = WS_BK; ldc = 256; t0 = 32; act = 0; }
        else if (pn < 34)  { off = WS_BV; ldc = 256; t0 = 33; act = 0; }
        else if (pn < 42)  { off = WS_BZ; ldc = 2048; t0 = 34; act = 2; }
        else if (pn < 46)  { off = WS_CQ; ldc = 1024; t0 = 42; act = 0; sc = 0.0625f; }
        else if (pn < 50)  { off = WS_CK; ldc = 1024; t0 = 46; act = 0; }
        else if (pn < 58)  { off = WS_CV; ldc = 2048; t0 = 50; act = 0; }
        else if (pn < 66)  { off = WS_CZ; ldc = 2048; t0 = 58; act = 2; }
        else               { off = WS_IF; ldc = 8; t0 = 122; act = 4; }
        const int col0 = (pn - t0) * BM + wc * 32 + 8 * fq;
        if (!F8 && act == 4) {
            if (wc == 0 && fq == 0) {
                gfloat* dst = (gfloat*)(ws + off);
#pragma unroll
                for (int ai = 0; ai < 2; ++ai)
#pragma unroll
                    for (int m = 0; m < 4; ++m) { const int row = row0 + ai * HALF + m * 16; const float rs = rstd_of(row);
                        *(gf32x4*)(dst + (size_t)row * 8) = acc[ai][0][m][0] * rs; *(gf32x4*)(dst + (size_t)row * 8 + 4) = acc[ai][0][m][1] * rs; }
            }
            return;
        }
        gbf16* base = (gbf16*)(ws + off);
        if (!F8 && (act == 6 || act == 7)) {
            const int colp = (pn - t0) * HALF + wc * 32 + 8 * fq;
#pragma unroll
            for (int ai = 0; ai < 2; ++ai)
#pragma unroll
                for (int m = 0; m < 4; ++m) {
                    const int row = row0 + ai * HALF + m * 16; const float rs = rstd_of(row);
                    f32x4 a0 = acc[ai][0][m][0] * rs, a1 = acc[ai][0][m][1] * rs; const f32x4 z0 = acc[ai][1][m][0] * rs, z1 = acc[ai][1][m][1] * rs;
                    if (act == 6) { const f32x2 a = gelu_pk((f32x2){a0[0], a0[1]}), b = gelu_pk((f32x2){a0[2], a0[3]}), c = gelu_pk((f32x2){a1[0], a1[1]}), d = gelu_pk((f32x2){a1[2], a1[3]});
                        a0 = (f32x4){a.x, a.y, b.x, b.y}; a1 = (f32x4){c.x, c.y, d.x, d.y}; }
                    else {
#pragma unroll
                        for (int j = 0; j < 4; ++j) { a0[j] = fsigmoid(a0[j]); a1[j] = fsigmoid(a1[j]); } }
#pragma unroll
                    for (int j = 0; j < 4; ++j) { a0[j] *= z0[j] * fsigmoid(z0[j]); a1[j] *= z1[j] * fsigmoid(z1[j]); }
                    u32x4 w; w.x = cvt_pk_bf16(a0[0], a0[1]); w.y = cvt_pk_bf16(a0[2], a0[3]); w.z = cvt_pk_bf16(a1[0], a1[1]); w.w = cvt_pk_bf16(a1[2], a1[3]);
                    *(gu32x4*)(base + tb128(row, colp, 16)) = w;
                }
            return;
        }
#pragma unroll
        for (int ai = 0; ai < 2; ++ai)
#pragma unroll
            for (int m = 0; m < 4; ++m) {
                const int row = row0 + ai * HALF + m * 16; const float rs = rstd_of(row) * sc;
                gbf16* rowp = base + tb256(row, col0, ldc >> 8); float ls = 0.f, lq = 0.f; u32x2 g8[2] = {{0u, 0u}, {0u, 0u}};
#pragma unroll
                for (int bj = 0; bj < 2; ++bj) {
                    f32x4 v0 = acc[ai][bj][m][0] * rs, v1 = acc[ai][bj][m][1] * rs;
                    if (!F8 && act == 5) {
                        f32x2 a = gelu_pk((f32x2){v0[0], v0[1]}), b = gelu_pk((f32x2){v0[2], v0[3]}), c = gelu_pk((f32x2){v1[0], v1[1]}), d = gelu_pk((f32x2){v1[2], v1[3]});
                        v0 = (f32x4){a.x, a.y, b.x, b.y}; v1 = (f32x4){c.x, c.y, d.x, d.y};
                        { ls += (v0[0] + v0[1]) + (v0[2] + v0[3]) + (v1[0] + v1[1]) + (v1[2] + v1[3]);
                            lq += (v0[0] * v0[0] + v0[1] * v0[1]) + (v0[2] * v0[2] + v0[3] * v0[3]) + (v1[0] * v1[0] + v1[1] * v1[1]) + (v1[2] * v1[2] + v1[3] * v1[3]); }
                    } else if (!F8 && act == 2) {
#pragma unroll
                        for (int j = 0; j < 4; ++j) { v0[j] = v0[j] * fsigmoid(v0[j]); v1[j] = v1[j] * fsigmoid(v1[j]); }
                    } else if (F8 && (act == 3 || act == 8)) {
#pragma unroll
                        for (int j = 0; j < 4; ++j) { v0[j] = fsigmoid(v0[j]); v1[j] = fsigmoid(v1[j]); }
                    }
                    if (F8 && act == 3) {
                        g8[bj].x = pack_u8x4(v0[0], v0[1], v0[2], v0[3]); g8[bj].y = pack_u8x4(v1[0], v1[1], v1[2], v1[3]);
                    } else {
                    u32x4 w; w.x = cvt_pk_bf16(v0[0], v0[1]); w.y = cvt_pk_bf16(v0[2], v0[3]); w.z = cvt_pk_bf16(v1[0], v1[1]); w.w = cvt_pk_bf16(v1[2], v1[3]);
                    EPIIN_STORE(w, (gu32x4*)(rowp + bj * HALF)); }
                }
                if (F8 && act == 3) {
                    typedef unsigned u32x2v_ __attribute__((ext_vector_type(2)));
                    const u32x2v_ r0 = __builtin_amdgcn_permlane16_swap(g8[0].x, g8[1].x, false, false), r1 = __builtin_amdgcn_permlane16_swap(g8[0].y, g8[1].y, false, false);
                    const u32x4 w16 = {r0.x, r1.x, r0.y, r1.y};
                    *(gu32x4*)(ws + WS_G + ((size_t)(u.pm * 48 + (pn - 74)) * 256 + (row & 255)) * 256 + (wc * 32 + 8 * (fq & ~1)) + (fq & 1) * HALF) = w16;
                }
                if (!F8 && act == 5) {
                    ls += __shfl_xor(ls, 16); ls += __shfl_xor(ls, 32); lq += __shfl_xor(lq, 16); lq += __shfl_xor(lq, 32);
                    if (fq == 0) *(gf32x2*)(ws + WS_LNP + ((size_t)row * 32 + (pn - 16) * 4 + wc) * 8) = (f32x2){ls, lq};
                }
            }
    }
};
using EpiIn = EpiInT<false>;
struct EpiBranch {
    static constexpr bool PERM = true; static constexpr int NS = EPI_NS16; static constexpr bool FP8 = false; static constexpr bool I8 = false; static constexpr bool F6 = false;
    __device__ __forceinline__ bool relax(const Unit& u) const { return u.seg == 2; }
    const guchar* G; gbf16* MIX;
    __device__ __forceinline__ bool keep(const Unit& u) const { return u.seg != 2; }
    __device__ __forceinline__ void operator()(f32x4 (&acc)[2][2][4][2], const Unit& u, int wr, int wc, int fr, int fq) const {
        const int row0 = u.pm * BM + wr * 64 + fr, col0 = u.pn * BM + wc * 32 + 8 * fq; const int seg = u.seg;
        u32x2 ga[2][4][2], gb[2][4][2];
#pragma unroll
        for (int ai = 0; ai < 2; ++ai)
#pragma unroll
            for (int m = 0; m < 4; ++m) {
                const int row = row0 + ai * HALF + m * 16; const guchar* gp = G + ((size_t)(u.pm * 48 + seg * 16 + u.pn) * 256 + (row & 255)) * 256 + (wc * 32 + 8 * fq);
#pragma unroll
                for (int bj = 0; bj < 2; ++bj) { ga[ai][m][bj] = *(const gu32x2*)(gp + bj * HALF); gb[ai][m][bj] = (seg != 2) ? *(const gu32x2*)(gp + (size_t)16 * 65536 + bj * HALF) : (u32x2){255u * 0x01010101u, 255u * 0x01010101u}; }
            }
#pragma unroll
        for (int ai = 0; ai < 2; ++ai)
#pragma unroll
            for (int m = 0; m < 4; ++m) {
                const int row = row0 + ai * HALF + m * 16;
#pragma unroll
                for (int bj = 0; bj < 2; ++bj) {
                    const u32x2 a_ = ga[ai][m][bj], b_ = gb[ai][m][bj];
                    float f[8] = {(float)((a_.x >> (8 * 0)) & 0xffu), (float)((a_.x >> (8 * 1)) & 0xffu), (float)((a_.x >> (8 * 2)) & 0xffu), (float)((a_.x >> (8 * 3)) & 0xffu),
                                  (float)((a_.y >> (8 * 0)) & 0xffu), (float)((a_.y >> (8 * 1)) & 0xffu), (float)((a_.y >> (8 * 2)) & 0xffu), (float)((a_.y >> (8 * 3)) & 0xffu)};
                    const float h[8] = {(float)((b_.x >> (8 * 0)) & 0xffu), (float)((b_.x >> (8 * 1)) & 0xffu), (float)((b_.x >> (8 * 2)) & 0xffu), (float)((b_.x >> (8 * 3)) & 0xffu),
                                        (float)((b_.y >> (8 * 0)) & 0xffu), (float)((b_.y >> (8 * 1)) & 0xffu), (float)((b_.y >> (8 * 2)) & 0xffu), (float)((b_.y >> (8 * 3)) & 0xffu)};
#pragma unroll
                    for (int j = 0; j < 8; ++j) f[j] = fmaxf(f[j], 1e-18f) * __builtin_amdgcn_rcpf(fmaxf(h[j], 1e-18f));
                    f32x4 v0 = acc[ai][bj][m][0], v1 = acc[ai][bj][m][1];
                    v0 = v0 * (f32x4){f[0], f[1], f[2], f[3]}; v1 = v1 * (f32x4){f[4], f[5], f[6], f[7]};
                    if (seg != 2) { acc[ai][bj][m][0] = v0; acc[ai][bj][m][1] = v1; }
                    else { u32x4 w; w.x = cvt_pk_bf16(v0[0], v0[1]); w.y = cvt_pk_bf16(v0[2], v0[3]); w.z = cvt_pk_bf16(v1[0], v1[1]); w.w = cvt_pk_bf16(v1[2], v1[3]);
                        *(gu32x4*)(MIX + ablk(row, col0 + bj * HALF, DM)) = w; }
                }
            }
    }
};
struct EpiSq {
    static constexpr bool PERM = true; static constexpr int NS = EPI_NS16; static constexpr bool FP8 = false; static constexpr bool I8 = false; static constexpr bool F6 = false;
    __device__ __forceinline__ bool relax(const Unit&) const { return true; }
    gbf16* O; gfloat* P;
    __device__ __forceinline__ bool keep(const Unit&) const { return false; }
    __device__ __forceinline__ void operator()(f32x4 (&acc)[2][2][4][2], const Unit& u, int wr, int wc, int fr, int fq) const {
        const int row0 = u.pm * BM + wr * 64 + fr, col0 = u.pn * BM + wc * 32 + 8 * fq;
#pragma unroll
        for (int ai = 0; ai < 2; ++ai)
#pragma unroll
            for (int m = 0; m < 4; ++m) {
                const int row = row0 + ai * HALF + m * 16; float q = 0.f;
#pragma unroll
                for (int bj = 0; bj < 2; ++bj) {
                    const f32x4 v0 = acc[ai][bj][m][0], v1 = acc[ai][bj][m][1];
                    q += (v0[0] * v0[0] + v0[1] * v0[1]) + (v0[2] * v0[2] + v0[3] * v0[3]) + (v1[0] * v1[0] + v1[1] * v1[1]) + (v1[2] * v1[2] + v1[3] * v1[3]);
                    u32x4 w; w.x = cvt_pk_bf16(v0[0], v0[1]); w.y = cvt_pk_bf16(v0[2], v0[3]); w.z = cvt_pk_bf16(v1[0], v1[1]); w.w = cvt_pk_bf16(v1[2], v1[3]);
                    if (O) *(gu32x4*)(O + (size_t)row * DM + col0 + bj * HALF) = w; else asm volatile("" :: "v"(w));
                }
                q += __shfl_xor(q, 16); q += __shfl_xor(q, 32);
                if (fq == 0) P[(size_t)row * 64 + u.pn * 4 + wc] = q;
            }
    }
};
struct EpiPle {
    static constexpr bool PERM = true; static constexpr int NS = EPI_NS32; static constexpr bool FP8 = P5_FP8 != 0; static constexpr bool I8 = P5_I8 != 0; static constexpr bool F6 = false;
    __device__ __forceinline__ bool relax(const Unit&) const { return true; }
    const gbf16* X1B; gfloat* XOUT; gbf16* XB; const gbf16* ERAW; const gfloat* RSE; const gfloat* pnorm; gfloat* SSQN; int last; guchar* XB8; const gfloat* RSX; float swq;
    __device__ __forceinline__ bool keep(const Unit&) const { return false; }
    __device__ __forceinline__ void operator()(f32x4 (&acc)[2][2][4][2], const Unit& u, int wr, int wc, int fr, int fq) const {
        const int row0 = u.pm * BM + wr * 64 + fr, col0 = u.pn * BM + wc * 32 + 8 * fq; constexpr float ASC = FP8 ? (DBG_ZERO_ASC ? 0.0f : 1.0f / W8_SCALE) : 1.0f;
#pragma unroll
        for (int ai = 0; ai < 2; ++ai)
#pragma unroll
            for (int m = 0; m < 4; ++m) {
                const int row = row0 + ai * HALF + m * 16; const float rse = RSE[row]; float q = 0.f; const size_t ro = (size_t)row * DM; const float zsc = I8 ? RSX[row] * swq : ASC;
#pragma unroll
                for (int bj = 0; bj < 2; ++bj) {
                    const int col = col0 + bj * HALF;
                    const u32x4 xb = *(const gu32x4*)(X1B + ablk(row, col, DM)), eb = *(const gu32x4*)(ERAW + ro + col);
                    const f32x4 pna = *(const gf32x4*)(pnorm + col), pnb = *(const gf32x4*)(pnorm + col + 4);
                    const float x[8] = {bf_lo(xb.x), bf_hi(xb.x), bf_lo(xb.y), bf_hi(xb.y), bf_lo(xb.z), bf_hi(xb.z), bf_lo(xb.w), bf_hi(xb.w)};
                    const float e8[8] = {bf_lo(eb.x), bf_hi(eb.x), bf_lo(eb.y), bf_hi(eb.y), bf_lo(eb.z), bf_hi(eb.z), bf_lo(eb.w), bf_hi(eb.w)};
                    const float pn[8] = {pna[0], pna[1], pna[2], pna[3], pnb[0], pnb[1], pnb[2], pnb[3]};
                    const f32x4 a0 = acc[ai][bj][m][0], a1 = acc[ai][bj][m][1];
                    const float a[8] = {I8 ? (float)__float_as_int(a0[0]) : a0[0], I8 ? (float)__float_as_int(a0[1]) : a0[1], I8 ? (float)__float_as_int(a0[2]) : a0[2], I8 ? (float)__float_as_int(a0[3]) : a0[3],
                                        I8 ? (float)__float_as_int(a1[0]) : a1[0], I8 ? (float)__float_as_int(a1[1]) : a1[1], I8 ? (float)__float_as_int(a1[2]) : a1[2], I8 ? (float)__float_as_int(a1[3]) : a1[3]};
                    float r[8];
#pragma unroll
                    for (int j = 0; j < 8; ++j) { r[j] = x[j] + fsigmoid(a[j] * zsc) * (e8[j] * rse * pn[j]); q += r[j] * r[j]; }
                    if (last) { *(gf32x4*)(XOUT + ro + col) = (f32x4){r[0], r[1], r[2], r[3]}; *(gf32x4*)(XOUT + ro + col + 4) = (f32x4){r[4], r[5], r[6], r[7]}; }
                    else { u32x4 w; w.x = cvt_pk_bf16(r[0], r[1]); w.y = cvt_pk_bf16(r[2], r[3]); w.z = cvt_pk_bf16(r[4], r[5]); w.w = cvt_pk_bf16(r[6], r[7]); *(gu32x4*)(XB + ablk(row, col, DM)) = w;
                        if (P1G_FP8 && !P1G_F6) { u32x2 w8; w8.x = pack_fp8x4(r[0], r[1], r[2], r[3]); w8.y = pack_fp8x4(r[4], r[5], r[6], r[7]); *(gu32x2*)(XB8 + ablk8(row, col, DM)) = w8; } }
                }
                if (!last) { q += __shfl_xor(q, 16); q += __shfl_xor(q, 32); if (fq == 0) SSQN[(size_t)row * 64 + u.pn * 4 + wc] = q; }
                if (m & 1) asm volatile("" ::: "memory");
            }
    }
};
}

constexpr int LDS_BYTES = 163840;
constexpr int MISC_OFF = LDS_BYTES - 128;
constexpr int ARGS_OFF = LDS_BYTES - 512;
constexpr int NWAVES = 8, NTHREADS = 512;

struct Ctx {
    LAS unsigned char* lds; int tid, lane, wave, vcu, G, bx;
};

struct TrTile { const gfloat* W; const gfloat* kscale; gbf16* WT; int ldw, K; guchar* W8; const gunsigned* QS; };
constexpr int TR_PER_LAYER = 7808 + 1536 + 1024 + 1024 + 64;
__device__ __forceinline__ TrTile tr_decode(int it, const gfloat* w_in, const gfloat* norm_pre, const gfloat* w_branch, const gfloat* w_out, const gfloat* ple_gate, const gfloat* ple_proj, guchar* ws) {
    const int l = it / TR_PER_LAYER; int r = it - l * TR_PER_LAYER; TrTile t; int kt, ntile; t.W8 = nullptr; t.QS = nullptr;
    if (r < 7808) { kt = r / 244; ntile = r - kt * 244; const int src = ntile < 116 ? ntile * 128 : ntile * 128 + 8;
        if (ntile < 16) ntile = 2 * ntile; else if (ntile < 32) ntile = ntile + 16; else if (ntile < 48) ntile = 2 * (ntile - 32) + 1;
        const int oblk = (ntile >= 116 && ntile < 132) ? ntile - 116 : -1; if (ntile >= 132 && ntile < 148) ntile -= 16;
        t.ldw = N_IN; t.K = DM; t.W = w_in + (size_t)l * DM * N_IN + (size_t)kt * 128 * N_IN + src; t.kscale = norm_pre + l * DM + kt * 128;
        t.WT = (gbf16*)(ws + WS_WIN + (size_t)l * SZ_WIN) + ((size_t)(ntile >> 1) * (DM / 64) + (size_t)kt * 2) * 16384 + (size_t)(ntile & 1) * 128 * 64;
        if (ntile >= 148) t.W8 = ws + WS_WG8 + (size_t)l * SZ_WG8 + ((size_t)((ntile - 148) >> 1) * (DM / 128) + (size_t)kt) * 32768 + (size_t)(ntile & 1) * 128 * 128;
        if (oblk >= 0) t.W8 = ws + WS_WG8 + (size_t)l * SZ_WG8 + ((size_t)(48 + (oblk >> 1)) * (DM / 128) + (size_t)kt) * 32768 + (size_t)(oblk & 1) * 128 * 128;
        return t; }
    r -= 7808; t.kscale = nullptr; t.ldw = DM;
    if (r < 1536) { const int j = r / 512; const int rr = r - j * 512; kt = rr / 32; ntile = rr - kt * 32; t.K = BW;
        t.W = w_branch + ((size_t)(l * 3 + j) * BW + (size_t)kt * 128) * DM + ntile * 128;
        t.WT = (gbf16*)(ws + WS_WBR + (size_t)l * SZ_WBR) + (size_t)j * DM * BW + ((size_t)(ntile >> 1) * (BW / 64) + (size_t)kt * 2) * 16384 + (size_t)(ntile & 1) * 128 * 64; return t; }
    r -= 1536;
    if (r < 2048) { const int which = r / 1024; const int rr = r - which * 1024; kt = rr / 32; ntile = rr - kt * 32; t.K = DM;
        t.W = (which ? ple_gate : w_out) + ((size_t)l * DM + (size_t)kt * 128) * DM + ntile * 128;
        t.WT = (gbf16*)(ws + (which ? WS_WPG : WS_WOUT) + (size_t)l * SZ_WSQ) + ((size_t)(ntile >> 1) * (DM / 64) + (size_t)kt * 2) * 16384 + (size_t)(ntile & 1) * 128 * 64;
        if (P5_I8 && which) t.QS = (const gunsigned*)(ws + WS_CTL) + CW_WMAX + l;
        if ((P5_FP8 || P5_I8) && which) t.W8 = ws + WS_WPG + (size_t)l * SZ_WSQ + ((size_t)(ntile >> 1) * (DM / 128) + (size_t)kt) * 32768 + (size_t)(ntile & 1) * 128 * 128;
        return t; }
    r -= 2048; kt = r / 32; ntile = r - kt * 32; t.K = 256;
    t.W = ple_proj + ((size_t)l * 256 + (size_t)kt * 128) * DM + ntile * 128;
    t.WT = (gbf16*)(ws + WS_WPP + (size_t)l * SZ_WPP) + ((size_t)(ntile >> 1) * (256 / 64) + (size_t)kt * 2) * 16384 + (size_t)(ntile & 1) * 128 * 64; return t;
}
#ifndef TR_NTLOAD
#define TR_NTLOAD 0
#endif
#ifndef TR_REVERSE
#define TR_REVERSE 1
#endif
__device__ __forceinline__ void tr_run(const Ctx& F, int it0, int it1, int sk0, int sk1, int me, int nw, const gfloat* w_in, const gfloat* norm_pre, const gfloat* w_branch,
                                       const gfloat* w_out, const gfloat* ple_gate, const gfloat* ple_proj, guchar* ws) {
    int tid = F.tid; LAUNDER_V(tid);
    {
        constexpr int RS = 264; const int NIT = it1 - it0 - (sk1 - sk0);
        const int c4 = tid & 31, kr = tid >> 5, kc = tid & 15;
        f32x4 va[8], vb[8]; float ka[8], kb[8]; TrTile ta, tb;
#define TR_LOAD(T_, V_, K_, IT_) do { const int ir_ = TR_REVERSE ? (NIT - 1 - (IT_)) : (IT_); T_ = tr_decode(it0 + ir_ + (((it0 + ir_) >= sk0) ? (sk1 - sk0) : 0), w_in, norm_pre, w_branch, w_out, ple_gate, ple_proj, ws); \
        _Pragma("unroll") for (int i = 0; i < 8; ++i) { V_[i] = TR_NTLOAD ? __builtin_nontemporal_load((const gf32x4*)(T_.W + (size_t)(i * 16 + kr) * T_.ldw + 4 * c4)) : *(const gf32x4*)(T_.W + (size_t)(i * 16 + kr) * T_.ldw + 4 * c4); K_[i] = T_.kscale ? T_.kscale[i * 16 + kr] : 1.0f; } } while (0)
#define TR_PUT(V_, K_) do { _Pragma("unroll") for (int i = 0; i < 8; ++i) { const f32x4 a = V_[i] * K_[i]; u32x2 w; w.x = cvt_pk_bf16(a[0], a[1]); w.y = cvt_pk_bf16(a[2], a[3]); \
        *(LAS u32x2*)(F.lds + (i * 16 + kr) * RS + c4 * 8) = w; } } while (0)
#define TR_GET(WT_, W8_, QS_) do { if (P1G_F6 && (W8_) && !(QS_)) { const int n_ = tid >> 2, kb_ = tid & 3; float v_[32]; \
        const LAS bf16_t* s_ = (const LAS bf16_t*)(F.lds + (32 * kb_) * RS + 2 * n_); \
        _Pragma("unroll") for (int j = 0; j < 32; ++j) v_[j] = __uint_as_float((unsigned)s_[j * (RS / 2)] << 16); \
        unsigned E_; const u32x6 d_ = mx6_pack(v_, E_); \
        *(gu32x4*)((W8_) + n_ * 128 + 16 * kb_) = (u32x4){d_[0], d_[1], d_[2], d_[3]}; *(gu32x4*)((W8_) + n_ * 128 + 64 + 16 * kb_) = (u32x4){d_[4], d_[5], E_, 0u}; } \
      else { _Pragma("unroll") for (int q = 0; q < 4; ++q) { const int n = 32 * q + (tid >> 4), kq = kc; \
        const LAS bf16_t* s = (const LAS bf16_t*)(F.lds + (8 * kq) * RS + 2 * n); unsigned e[8]; \
        _Pragma("unroll") for (int j = 0; j < 8; ++j) e[j] = s[j * (RS / 2)]; \
        if (QS_) { const float qs_ = 127.0f / fmaxf(__uint_as_float(*(QS_)), 1e-30f); u32x2 o8; \
            o8.x = pack_i8x4(__uint_as_float(e[0] << 16) * qs_, __uint_as_float(e[1] << 16) * qs_, __uint_as_float(e[2] << 16) * qs_, __uint_as_float(e[3] << 16) * qs_); \
            o8.y = pack_i8x4(__uint_as_float(e[4] << 16) * qs_, __uint_as_float(e[5] << 16) * qs_, __uint_as_float(e[6] << 16) * qs_, __uint_as_float(e[7] << 16) * qs_); \
            *(gu32x2*)((W8_) + n * 128 + 8 * kq) = o8; } \
        else if (W8_) { u32x2 o8; o8.x = pack_fp8x4(__uint_as_float(e[0] << 16) * W8_SCALE, __uint_as_float(e[1] << 16) * W8_SCALE, __uint_as_float(e[2] << 16) * W8_SCALE, __uint_as_float(e[3] << 16) * W8_SCALE); \
            o8.y = pack_fp8x4(__uint_as_float(e[4] << 16) * W8_SCALE, __uint_as_float(e[5] << 16) * W8_SCALE, __uint_as_float(e[6] << 16) * W8_SCALE, __uint_as_float(e[7] << 16) * W8_SCALE); \
            *(gu32x2*)((W8_) + n * 128 + 8 * kq) = o8; } \
        else { u32x4 o; o.x = e[0] | (e[1] << 16); o.y = e[2] | (e[3] << 16); o.z = e[4] | (e[5] << 16); o.w = e[6] | (e[7] << 16); \
        *(gu32x4*)(WT_ + (size_t)(kq >> 3) * 16384 + n * 64 + 8 * (kq & 7)) = o; } } } } while (0)
        int it = me;
        if (it < NIT) TR_LOAD(ta, va, ka, it);
        if (it + nw < NIT) TR_LOAD(tb, vb, kb, it + nw);
        while (it < NIT) {
            { TR_PUT(va, ka); __syncthreads(); gbf16* wt = ta.WT; guchar* kk = ta.W8; const gunsigned* qp = ta.QS;
              if (it + 2 * nw < NIT) TR_LOAD(ta, va, ka, it + 2 * nw);
              TR_GET(wt, kk, qp); __syncthreads(); }
            it += nw; if (it >= NIT) break;
            { TR_PUT(vb, kb); __syncthreads(); gbf16* wt = tb.WT; guchar* kk = tb.W8; const gunsigned* qp = tb.QS;
              if (it + 2 * nw < NIT) TR_LOAD(tb, vb, kb, it + 2 * nw);
              TR_GET(wt, kk, qp); __syncthreads(); }
            it += nw;
        }
#undef TR_LOAD
#undef TR_PUT
#undef TR_GET
    }
}
#ifndef TR_NODEFER
#define TR_NODEFER 0
#endif
#ifndef TR_L1TAIL
#define TR_L1TAIL (1024 + 1536)
#endif
constexpr int TR_PG0 = 7808 + 1536 + 1024, TR_PG1 = TR_PER_LAYER + TR_PG0;
constexpr int TR_DEFER0 = TR_PER_LAYER + 7808 + 1536, TR_DEFER1 = TR_DEFER0 + (TR_NODEFER ? 0 : 2048);
__device__ __forceinline__ void p0_prologue(const Ctx& F, const gfloat* x, const gfloat* p, const gint* positions, const gfloat* norm_pre, const gfloat* w_in, const gfloat* w_branch,
                                            const gfloat* w_out, const gfloat* ple_gate, const gfloat* ple_proj, guchar* ws) {
    int tid = F.tid; LAUNDER_V(tid);
#if P5_I8
    tr_run(F, 0, TR_PG1 - TR_L1TAIL, TR_PG0, TR_PG0 + 1024, F.vcu, F.G, w_in, norm_pre, w_branch, w_out, ple_gate, ple_proj, ws);
    tr_run(F, TR_PG1 + 1024, NLAYER * TR_PER_LAYER, 0x7fffffff, 0x7fffffff, F.vcu, F.G, w_in, norm_pre, w_branch, w_out, ple_gate, ple_proj, ws);
    { const int gt_ = F.vcu * NTHREADS + tid, NGT_ = F.G * NTHREADS;
      for (int l = 0; l < NLAYER; ++l) { const gf32x4* wp = (const gf32x4*)(ple_gate + (size_t)l * DM * DM); float mx = 0.f;
          for (int i0 = gt_; i0 < DM * DM / 4; i0 += 8 * NGT_) { f32x4 a[8];
#pragma unroll
              for (int j = 0; j < 8; ++j) { const int i = i0 + j * NGT_; a[j] = wp[i < DM * DM / 4 ? i : i0]; }
#pragma unroll
              for (int j = 0; j < 8; ++j) mx = fmaxf(mx, fmaxf(fmaxf(fabsf(a[j][0]), fabsf(a[j][1])), fmaxf(fabsf(a[j][2]), fabsf(a[j][3])))); }
#pragma unroll
          for (int s = 32; s >= 1; s >>= 1) mx = fmaxf(mx, __shfl_xor(mx, s));
          if (F.lane == 0) atomicMax((unsigned*)((gunsigned*)(ws + WS_CTL) + CW_WMAX + l), __float_as_uint(mx)); } }
#else
    tr_run(F, 0, NLAYER * TR_PER_LAYER, TR_DEFER0, TR_DEFER1, F.vcu, F.G, w_in, norm_pre, w_branch, w_out, ple_gate, ple_proj, ws);
#endif
    const int gt = F.vcu * NTHREADS + tid, NGT = F.G * NTHREADS;
    for (int i = gt; i < NLAYER * 256 * DM; i += NGT) { const int l = i / (256 * DM), rr = (i / DM) & 255, k = i & (DM - 1);
        float val = 0.f; if (rr < 8) val = w_in[(size_t)l * DM * N_IN + (size_t)k * N_IN + IF_COL + rr] * norm_pre[l * DM + k];
        ((gbf16*)(ws + WS_WIN + (size_t)l * SZ_WIN))[((size_t)122 * (DM / 64) + (k >> 6)) * 16384 + rr * 64 + (k & 63)] = (bf16_t)(cvt_pk_bf16(val, 0.f) & 0xffffu); }
    for (int i = gt; i < NLAYER * M_ROWS * 256 / 4; i += NGT) { const f32x4 a = ((const gf32x4*)p)[i]; u32x2 w; w.x = cvt_pk_bf16(a[0], a[1]); w.y = cvt_pk_bf16(a[2], a[3]);
        const int l = i / (M_ROWS * 64), r = (i >> 6) & (M_ROWS - 1), c = (i & 63) * 4; *(gu32x2*)((gbf16*)(ws + WS_PB) + (size_t)l * M_ROWS * 256 + ablk(r, c, 256)) = w; }
    for (int i = gt; i < M_ROWS * 8; i += NGT) { const int row = i >> 3, j = i & 7; const float inv = powf(500000.0f, -(float)j * 0.125f); const float ang = (float)positions[row] * inv;
        gfloat* cs = (gfloat*)(ws + WS_CS) + (size_t)row * 16; cs[j] = cosf(ang); cs[8 + j] = sinf(ang); }
    { const int gw = F.vcu * NWAVES + F.wave, NGW = F.G * NWAVES;
#if P1G_F6
      for (int m = gw; m < M_ROWS; m += NGW) { gbf16* o = (gbf16*)(ws + WS_XB); float s = 0.f;
#pragma unroll
          for (int hb = 0; hb < 2; ++hb) { const int c0 = 32 * (F.lane + 64 * hb); const gf32x4* xr = (const gf32x4*)(x + (size_t)m * DM + c0); float v[32];
#pragma unroll
              for (int i = 0; i < 8; ++i) { const f32x4 a = xr[i]; v[4 * i] = a[0]; v[4 * i + 1] = a[1]; v[4 * i + 2] = a[2]; v[4 * i + 3] = a[3]; s += (a[0] * a[0] + a[1] * a[1]) + (a[2] * a[2] + a[3] * a[3]); }
#pragma unroll
              for (int i = 0; i < 4; ++i) { u32x4 w; w.x = cvt_pk_bf16(v[8 * i], v[8 * i + 1]); w.y = cvt_pk_bf16(v[8 * i + 2], v[8 * i + 3]); w.z = cvt_pk_bf16(v[8 * i + 4], v[8 * i + 5]); w.w = cvt_pk_bf16(v[8 * i + 6], v[8 * i + 7]); *(gu32x4*)(o + ablk(m, c0 + 8 * i, DM)) = w; }
              unsigned E; const u32x6 d = mx6_pack(v, E); guchar* rp = ws + WS_XB8 + ((size_t)(m >> 8) * (DM / 128) + (c0 >> 7)) * 32768 + (size_t)(m & 255) * 128 + 16 * ((c0 >> 5) & 3);
              *(gu32x4*)rp = (u32x4){d[0], d[1], d[2], d[3]}; *(gu32x4*)(rp + 64) = (u32x4){d[4], d[5], E, 0u}; }
          s = wave_sum(s); if (F.lane == 0) ((gfloat*)(ws + WS_SSQ0))[m] = s; }
#else
      for (int m = gw; m < M_ROWS; m += NGW) { const gf32x4* xr = (const gf32x4*)(x + (size_t)m * DM) + F.lane; gbf16* o = (gbf16*)(ws + WS_XB); float s = 0.f;
#pragma unroll
          for (int j = 0; j < 16; ++j) { const f32x4 a = xr[64 * j]; s += (a[0] * a[0] + a[1] * a[1]) + (a[2] * a[2] + a[3] * a[3]); u32x2 w; w.x = cvt_pk_bf16(a[0], a[1]); w.y = cvt_pk_bf16(a[2], a[3]); *(gu32x2*)(o + ablk(m, (F.lane + 64 * j) * 4, DM)) = w;
              if (P1G_FP8) *(gunsigned*)(ws + WS_XB8 + ablk8(m, (F.lane + 64 * j) * 4, DM)) = pack_fp8x4(a[0], a[1], a[2], a[3]); }
          s = wave_sum(s); if (F.lane == 0) ((gfloat*)(ws + WS_SSQ0))[m] = s; }
#endif
    }
}

__device__ __forceinline__ u32x2 pack4(const f32x4 v) { u32x2 w; w.x = cvt_pk_bf16(v[0], v[1]); w.y = cvt_pk_bf16(v[2], v[3]); return w; }
__device__ __forceinline__ bf16x8 mk_frag(const u32x2 lo, const u32x2 hi) { const u32x4 t = {lo.x, lo.y, hi.x, hi.y}; return __builtin_bit_cast(bf16x8, t); }
__device__ __forceinline__ bf16x8 frag_const(unsigned w) { const u32x4 t = {w, w, w, w}; return __builtin_bit_cast(bf16x8, t); }

constexpr int GM_RS = 288, GM_WL = 0, GM_VT = 128 * GM_RS, GM_ST = GM_VT + 256 * GM_RS;
__device__ __forceinline__ void gmlp_unit(const Ctx& F, int b, int n, int g, guchar* ws, const gfloat* ln_g, const gfloat* ln_b, const gfloat* wsp, const gfloat* bsp) {
    int tid = F.tid; LAUNDER_V(tid); const int lane = tid & 63, w = F.wave, r16 = lane & 15, q4 = lane >> 4;
    const int row0 = b * SEQ + n * 128, c0 = g * 256;
    const gbf16* AU = (const gbf16*)(ws + WS_AU); const gbf16* AV = (const gbf16*)(ws + WS_AV); gbf16* YA = (gbf16*)(ws + WS_YA);
    u32x4 raw[8];
#pragma unroll
    for (int k = 0; k < 8; ++k) { const int item = tid + 512 * k, s = item & 127, ch = item >> 7; raw[k] = *(const gu32x4*)(AV + tb256(row0 + s, c0 + 8 * ch, 8)); }
    f32x4 wt[8];
#pragma unroll
    for (int k = 0; k < 8; ++k) { const int item = tid + 512 * k, t = item >> 5, ch = item & 31; wt[k] = *(const gf32x4*)(wsp + ((size_t)(g * 128 + t)) * 128 + 4 * ch); }
    { const gf32x4* pp = (const gf32x4*)(ws + WS_LNP) + (size_t)(row0 + (tid & 127)) * 16 + (tid >> 7) * 4; float s = 0.f, q = 0.f;
#pragma unroll
        for (int j = 0; j < 4; ++j) { const f32x4 t = pp[j]; s += t[0] + t[2]; q += t[1] + t[3]; }
        *(LAS f32x2*)(F.lds + GM_ST + 1024 + ((tid >> 7) * 128 + (tid & 127)) * 8) = (f32x2){s, q}; }
#pragma unroll
    for (int k = 0; k < 8; ++k) { const int item = tid + 512 * k, t = item >> 5, ch = item & 31; f32x4 a = wt[k];
#pragma unroll
        for (int e = 0; e < 4; ++e) if (4 * ch + e > t) a[e] = 0.f;
        *(LAS u32x2*)(F.lds + GM_WL + t * GM_RS + ch * 8) = pack4(a); }
    __syncthreads();
    if (tid < 128) { float s = 0.f, q = 0.f;
#pragma unroll
        for (int j = 0; j < 4; ++j) { const f32x2 t = *(const LAS f32x2*)(F.lds + GM_ST + 1024 + (j * 128 + tid) * 8); s += t.x; q += t.y; }
        const float mu = s * (1.0f / BW); const float var = fmaxf(q * (1.0f / BW) - mu * mu, 0.f);
        *(LAS f32x2*)(F.lds + GM_ST + tid * 8) = (f32x2){mu, rsqrtf(var + NORM_EPS)}; }
    __syncthreads();
#pragma unroll
    for (int k = 0; k < 8; ++k) { const int item = tid + 512 * k, s = item & 127, ch = item >> 7;
        const f32x4 g0 = *(const gf32x4*)(ln_g + c0 + 8 * ch), g1 = *(const gf32x4*)(ln_g + c0 + 8 * ch + 4), b0 = *(const gf32x4*)(ln_b + c0 + 8 * ch), b1 = *(const gf32x4*)(ln_b + c0 + 8 * ch + 4);
        const f32x2 st = *(const LAS f32x2*)(F.lds + GM_ST + s * 8);
        const float xv[8] = {bf_lo(raw[k].x), bf_hi(raw[k].x), bf_lo(raw[k].y), bf_hi(raw[k].y), bf_lo(raw[k].z), bf_hi(raw[k].z), bf_lo(raw[k].w), bf_hi(raw[k].w)};
        const float gg[8] = {g0[0], g0[1], g0[2], g0[3], g1[0], g1[1], g1[2], g1[3]}, bb[8] = {b0[0], b0[1], b0[2], b0[3], b1[0], b1[1], b1[2], b1[3]};
#pragma unroll
        for (int i = 0; i < 8; ++i) { const float y = (xv[i] - st.x) * st.y * gg[i] + bb[i];
            *(LAS bf16_t*)(F.lds + GM_VT + (8 * ch + i) * GM_RS + 2 * s) = (bf16_t)(cvt_pk_bf16(y, 0.f) & 0xffffu); } }
    u32x4 ub[8]; float bsv[8];
#pragma unroll
    for (int n8 = 0; n8 < 8; ++n8) { const int t = 16 * n8 + r16; ub[n8] = *(const gu32x4*)(AU + tb128(row0 + t, c0 + 32 * w + 8 * q4, 16)); bsv[n8] = bsp[g * 128 + t]; }
    __syncthreads();
    f32x4 acc[2][8];
#pragma unroll
    for (int m = 0; m < 2; ++m)
#pragma unroll
        for (int n8 = 0; n8 < 8; ++n8) acc[m][n8] = (f32x4){0.f, 0.f, 0.f, 0.f};
    bf16x8 af[2][4];
#pragma unroll
    for (int m = 0; m < 2; ++m)
#pragma unroll
        for (int ks = 0; ks < 4; ++ks) af[m][ks] = *(const LAS bf16x8*)(F.lds + GM_VT + (32 * w + 8 * (r16 >> 2) + 4 * m + (r16 & 3)) * GM_RS + ks * 64 + q4 * 16);
#pragma unroll
    for (int n8 = 0; n8 < 8; ++n8)
#pragma unroll
        for (int ks = 0; ks < 4; ++ks) if (ks <= n8 / 2) {
            const bf16x8 bfr = *(const LAS bf16x8*)(F.lds + GM_WL + (16 * n8 + r16) * GM_RS + ks * 64 + q4 * 16);
#pragma unroll
            for (int m = 0; m < 2; ++m) acc[m][n8] = MFMA16(af[m][ks], bfr, acc[m][n8]); }
#pragma unroll
    for (int n8 = 0; n8 < 8; ++n8) { const int t = 16 * n8 + r16; const size_t roy = ablk(row0 + t, c0 + 32 * w + 8 * q4, BW);
        const f32x4 a0 = acc[0][n8] + bsv[n8], a1 = acc[1][n8] + bsv[n8]; u32x4 y;
        y.x = cvt_pk_bf16(a0[0] * bf_lo(ub[n8].x), a0[1] * bf_hi(ub[n8].x)); y.y = cvt_pk_bf16(a0[2] * bf_lo(ub[n8].y), a0[3] * bf_hi(ub[n8].y));
        y.z = cvt_pk_bf16(a1[0] * bf_lo(ub[n8].z), a1[1] * bf_hi(ub[n8].z)); y.w = cvt_pk_bf16(a1[2] * bf_lo(ub[n8].w), a1[3] * bf_hi(ub[n8].w));
        *(gu32x4*)(YA + roy) = y; }
    __syncthreads();
}

constexpr int SW_RS = 160, SW_VS = 528, SW_KL = 0, SW_VT = 256 * SW_RS, SW_QL = SW_VT + 64 * SW_VS, SW_QL2 = SW_QL + 128 * SW_RS, SW_CS = SW_QL2 + 128 * SW_RS;
static_assert(SW_CS + 384 * 64 <= ARGS_OFF, "SWA LDS map");
__device__ __forceinline__ void rope8(const u32x4 a, const u32x4 bq, const gfloat* cs, float scale, u32x4& o1, u32x4& o2) {
    const f32x4 c0 = *(const gf32x4*)cs, c1 = *(const gf32x4*)(cs + 4), s0 = *(const gf32x4*)(cs + 8), s1 = *(const gf32x4*)(cs + 12);
    const float t1[8] = {bf_lo(a.x), bf_hi(a.x), bf_lo(a.y), bf_hi(a.y), bf_lo(a.z), bf_hi(a.z), bf_lo(a.w), bf_hi(a.w)};
    const float t2[8] = {bf_lo(bq.x), bf_hi(bq.x), bf_lo(bq.y), bf_hi(bq.y), bf_lo(bq.z), bf_hi(bq.z), bf_lo(bq.w), bf_hi(bq.w)};
    const float cc[8] = {c0[0], c0[1], c0[2], c0[3], c1[0], c1[1], c1[2], c1[3]}, ss[8] = {s0[0], s0[1], s0[2], s0[3], s1[0], s1[1], s1[2], s1[3]};
    float r1[8], r2[8];
#pragma unroll
    for (int i = 0; i < 8; ++i) { r1[i] = (t1[i] * cc[i] - t2[i] * ss[i]) * scale; r2[i] = (t2[i] * cc[i] + t1[i] * ss[i]) * scale; }
    o1 = (u32x4){cvt_pk_bf16(r1[0], r1[1]), cvt_pk_bf16(r1[2], r1[3]), cvt_pk_bf16(r1[4], r1[5]), cvt_pk_bf16(r1[6], r1[7])};
    o2 = (u32x4){cvt_pk_bf16(r2[0], r2[1]), cvt_pk_bf16(r2[2], r2[3]), cvt_pk_bf16(r2[4], r2[5]), cvt_pk_bf16(r2[6], r2[7])};
}
__device__ __forceinline__ u32x4 scale8(const u32x4 a, float sc) {
    return (u32x4){cvt_pk_bf16(bf_lo(a.x) * sc, bf_hi(a.x) * sc), cvt_pk_bf16(bf_lo(a.y) * sc, bf_hi(a.y) * sc), cvt_pk_bf16(bf_lo(a.z) * sc, bf_hi(a.z) * sc), cvt_pk_bf16(bf_lo(a.w) * sc, bf_hi(a.w) * sc)};
}
__device__ __forceinline__ void swa_unit(const Ctx& F, int b, int n, int hk, guchar* ws, const gfloat* sinks) {
    int tid = F.tid; LAUNDER_V(tid); const int lane = tid & 63, w = F.wave, r16 = lane & 15, q4 = lane >> 4;
    const int r0 = b * SEQ + n * 128, kr0 = r0 - 128;
    const gbf16* BQ = (const gbf16*)(ws + WS_BQ); const gbf16* BK = (const gbf16*)(ws + WS_BK); const gbf16* BV = (const gbf16*)(ws + WS_BV); const gbf16* BZ = (const gbf16*)(ws + WS_BZ);
    gbf16* YB = (gbf16*)(ws + WS_YA) + (size_t)M_ROWS * BW; const gfloat* CS = (const gfloat*)(ws + WS_CS);
    const int kch = tid & 7;
    u32x4 kraw[4], vraw[4]; f32x4 csr[3]; u32x4 qa[2];
#pragma unroll
    for (int k = 0; k < 4; ++k) { const int key = (tid + 512 * k) >> 3; const bool pad = (n == 0 && key < 128);
        kraw[k] = *(const gu32x4*)(BK + (size_t)(pad ? r0 : kr0 + key) * 256 + hk * 64 + 8 * kch); }
#pragma unroll
    for (int k = 0; k < 4; ++k) { const int item = tid + 512 * k, key = item & 255, ch = item >> 8; const bool pad = (n == 0 && key < 128);
        vraw[k] = *(const gu32x4*)(BV + (size_t)(pad ? r0 : kr0 + key) * 256 + hk * 64 + 8 * ch); }
#pragma unroll
    for (int k = 0; k < 3; ++k) { const int item = tid + 512 * k, r = item >> 2, part = item & 3; const int row = r < 256 ? ((n == 0 && r < 128) ? r0 : kr0 + r) : r0 + r - 256;
        csr[k] = *(const gf32x4*)(CS + (size_t)row * 16 + part * 4); }
#define SW_QLOAD(hq_) do { _Pragma("unroll") for (int k_ = 0; k_ < 2; ++k_) { const int qr_ = (tid + 512 * k_) >> 3; qa[k_] = *(const gu32x4*)(BQ + tb256(r0 + qr_, (hq_) * 64, 8) + 8 * kch); } } while (0)
    SW_QLOAD(hk * 8);
#pragma unroll
    for (int k = 0; k < 3; ++k) { const int item = tid + 512 * k; *(LAS f32x4*)(F.lds + SW_CS + item * 16) = csr[k]; }
#pragma unroll
    for (int k = 0; k < 4; ++k) { const int item = tid + 512 * k, key = item & 255, ch = item >> 8; const bool pad = (n == 0 && key < 128);
        const u32x4 raw = pad ? (u32x4){0u, 0u, 0u, 0u} : vraw[k]; const unsigned e[4] = {raw.x, raw.y, raw.z, raw.w};
#pragma unroll
        for (int i = 0; i < 8; ++i) *(LAS bf16_t*)(F.lds + SW_VT + (8 * ch + i) * SW_VS + 2 * key) = (bf16_t)((e[i >> 1] >> ((i & 1) * 16)) & 0xffffu); }
    __syncthreads();
#define SW_PUT(raw_, csrow_, dst_, scale_) do { const u32x4 own_ = (raw_); u32x4 par_; \
        par_.x = (unsigned)__builtin_amdgcn_update_dpp(0, (int)own_.x, 0xB1, 0xf, 0xf, false); par_.y = (unsigned)__builtin_amdgcn_update_dpp(0, (int)own_.y, 0xB1, 0xf, 0xf, false); \
        par_.z = (unsigned)__builtin_amdgcn_update_dpp(0, (int)own_.z, 0xB1, 0xf, 0xf, false); par_.w = (unsigned)__builtin_amdgcn_update_dpp(0, (int)own_.w, 0xB1, 0xf, 0xf, false); \
        u32x4 o_; \
        if (kch < 2) { const LAS float* cs_ = (const LAS float*)(F.lds + SW_CS + (csrow_) * 64); \
            const f32x4 c0_ = *(const LAS f32x4*)cs_, c1_ = *(const LAS f32x4*)(cs_ + 4), s0_ = *(const LAS f32x4*)(cs_ + 8), s1_ = *(const LAS f32x4*)(cs_ + 12); \
            const float sg_ = kch == 0 ? -(scale_) : (scale_); \
            const float t_[8] = {bf_lo(own_.x), bf_hi(own_.x), bf_lo(own_.y), bf_hi(own_.y), bf_lo(own_.z), bf_hi(own_.z), bf_lo(own_.w), bf_hi(own_.w)}; \
            const float u_[8] = {bf_lo(par_.x), bf_hi(par_.x), bf_lo(par_.y), bf_hi(par_.y), bf_lo(par_.z), bf_hi(par_.z), bf_lo(par_.w), bf_hi(par_.w)}; \
            const float cc_[8] = {c0_[0], c0_[1], c0_[2], c0_[3], c1_[0], c1_[1], c1_[2], c1_[3]}, ss_[8] = {s0_[0], s0_[1], s0_[2], s0_[3], s1_[0], s1_[1], s1_[2], s1_[3]}; \
            float r_[8]; _Pragma("unroll") for (int i_ = 0; i_ < 8; ++i_) r_[i_] = (t_[i_] * cc_[i_]) * (scale_) + (u_[i_] * ss_[i_]) * sg_; \
            o_ = (u32x4){cvt_pk_bf16(r_[0], r_[1]), cvt_pk_bf16(r_[2], r_[3]), cvt_pk_bf16(r_[4], r_[5]), cvt_pk_bf16(r_[6], r_[7])}; } \
        else o_ = ((scale_) == 1.0f) ? own_ : scale8(own_, (scale_)); \
        *(LAS u32x4*)((dst_) + kch * 16) = o_; } while (0)
#pragma unroll
    for (int k = 0; k < 4; ++k) { const int key = (tid + 512 * k) >> 3; const bool pad = (n == 0 && key < 128);
        const u32x4 kz = pad ? (u32x4){0u, 0u, 0u, 0u} : kraw[k]; SW_PUT(kz, key, F.lds + SW_KL + key * SW_RS, 1.0f); }
#define SW_QWRITE(buf_) do { _Pragma("unroll") for (int k_ = 0; k_ < 2; ++k_) { const int qr_ = (tid + 512 * k_) >> 3; SW_PUT(qa[k_], 256 + qr_, F.lds + (buf_) + qr_ * SW_RS, 0.125f); } } while (0)
    SW_QWRITE(SW_QL);
    __syncthreads();
    for (int hi = 0; hi < 8; ++hi) {
        const int hq = hk * 8 + hi; const int qcur = (hi & 1) ? SW_QL2 : SW_QL, qnxt = (hi & 1) ? SW_QL : SW_QL2;
        SW_QLOAD((hi < 7 ? hq + 1 : hq));
        const u32x4 zb0 = *(const gu32x4*)(BZ + tb256(r0 + 16 * w + r16, hq * 64 + 8 * q4, 8)), zb1 = *(const gu32x4*)(BZ + tb256(r0 + 16 * w + r16, hq * 64 + 8 * q4 + 32, 8));
        bf16x8 bq[2];
#pragma unroll
        for (int ks = 0; ks < 2; ++ks) bq[ks] = *(const LAS bf16x8*)(F.lds + qcur + (16 * w + r16) * SW_RS + ks * 64 + q4 * 16);
        f32x4 s[10];
#pragma unroll
        for (int j = 0; j < 9; ++j) { s[j] = (f32x4){0.f, 0.f, 0.f, 0.f};
#pragma unroll
            for (int ks = 0; ks < 2; ++ks) { const bf16x8 a = *(const LAS bf16x8*)(F.lds + SW_KL + (16 * (w + j) + r16) * SW_RS + ks * 64 + q4 * 16); s[j] = MFMA16(a, bq[ks], s[j]); } }
        s[9] = (f32x4){0.f, 0.f, 0.f, 0.f};
        const int qi = 16 * w + r16; const float sink = sinks[hq]; float mx = sink;
#pragma unroll
        for (int j = 0; j < 9; ++j)
#pragma unroll
            for (int e = 0; e < 4; ++e) { const int kj = 16 * (w + j) + 4 * q4 + e; const bool valid = (kj > qi) && (kj <= qi + 128) && (n > 0 || kj >= 128);
                s[j][e] = valid ? s[j][e] : -1e30f; mx = fmaxf(mx, s[j][e]); }
        mx = fmaxf(mx, __shfl_xor(mx, 16)); mx = fmaxf(mx, __shfl_xor(mx, 32));
        float sum = 0.f;
#pragma unroll
        for (int j = 0; j < 9; ++j)
#pragma unroll
            for (int e = 0; e < 4; ++e) { const float pv = (s[j][e] > -1e29f) ? __expf(s[j][e] - mx) : 0.f; s[j][e] = pv; sum += pv; }
        sum += __shfl_xor(sum, 16); sum += __shfl_xor(sum, 32); sum += __expf(sink - mx);
        const float inv = 1.0f / sum;
        f32x4 o[4];
#pragma unroll
        for (int dt = 0; dt < 4; ++dt) o[dt] = (f32x4){0.f, 0.f, 0.f, 0.f};
#pragma unroll
        for (int kk = 0; kk < 5; ++kk) { const bf16x8 pf = mk_frag(pack4(s[2 * kk]), pack4(s[2 * kk + 1]));
            const int t0 = w + 2 * kk, t1 = (w + 2 * kk + 1) > 15 ? 15 : (w + 2 * kk + 1);
#pragma unroll
            for (int dt = 0; dt < 4; ++dt) { const LAS unsigned char* vrow = F.lds + SW_VT + (32 * (dt >> 1) + 8 * (r16 >> 2) + 4 * (dt & 1) + (r16 & 3)) * SW_VS + (4 * q4) * 2;
                const bf16x8 a = mk_frag(*(const LAS u32x2*)(vrow + 32 * t0), *(const LAS u32x2*)(vrow + 32 * t1)); o[dt] = MFMA16(a, pf, o[dt]); } }
        const size_t ro = (size_t)(r0 + qi) * BW + hq * 64 + 8 * q4;
#pragma unroll
        for (int pp = 0; pp < 2; ++pp) { const u32x4 zb = pp ? zb1 : zb0; const f32x4 oa = o[2 * pp] * inv, ob2 = o[2 * pp + 1] * inv; u32x4 y;
            y.x = cvt_pk_bf16(oa[0] * bf_lo(zb.x), oa[1] * bf_hi(zb.x)); y.y = cvt_pk_bf16(oa[2] * bf_lo(zb.y), oa[3] * bf_hi(zb.y));
            y.z = cvt_pk_bf16(ob2[0] * bf_lo(zb.z), ob2[1] * bf_hi(zb.z)); y.w = cvt_pk_bf16(ob2[2] * bf_lo(zb.w), ob2[3] * bf_hi(zb.w));
            *(gu32x4*)(YB + ablk(r0 + qi, hq * 64 + 8 * q4 + 32 * pp, BW)) = y; }
        SW_QWRITE(qnxt);
        __syncthreads();
    }
#undef SW_QLOAD
#undef SW_QWRITE
#undef SW_PUT
}

#ifndef ML_R1A
#define ML_R1A 1
#endif
#ifndef ML_R1B
#define ML_R1B 1
#endif
#ifndef ML_RWR
#define ML_RWR 1
#endif
constexpr int ML_RS = 544, ML_TS = 144, ML_WS = 160, ML_GSZ = 1344;
constexpr int ML_QL = 0, ML_KA = 64 * ML_RS, ML_KB = 2 * 64 * ML_RS, ML_VT = 3 * 64 * ML_RS, ML_VW = ML_VT + 32 * ML_TS, ML_VW2 = ML_VW + 33 * ML_WS, ML_CT = ML_VW2 + 33 * ML_WS, ML_X = ML_CT + 33 * ML_RS, ML_GATE = ML_X + 64 * 144;
static_assert(ML_GATE + 2 * ML_GSZ <= ARGS_OFF, "mLSTM LDS map");
typedef short s16x4 __attribute__((ext_vector_type(4)));
__device__ __forceinline__ bf16x8 tr_frag8(const LAS unsigned char* img, int rs, int row0, int col0, int r16) {
    const LAS unsigned char* p0 = img + (row0 + (r16 >> 2)) * rs + (col0 + 4 * (r16 & 3)) * 2;
    const s16x4 a = __builtin_amdgcn_ds_read_tr16_b64_v4i16((LAS s16x4*)p0);
    const s16x4 b = __builtin_amdgcn_ds_read_tr16_b64_v4i16((LAS s16x4*)(p0 + 4 * rs));
    return __builtin_shufflevector(a, b, 0, 1, 2, 3, 4, 5, 6, 7);
}
__device__ __forceinline__ float dpp_shr(float v, float ident, int n) {
    const int r = n == 1 ? __builtin_amdgcn_update_dpp(__float_as_int(ident), __float_as_int(v), 0x111, 0xf, 0xf, false)
                : n == 2 ? __builtin_amdgcn_update_dpp(__float_as_int(ident), __float_as_int(v), 0x112, 0xf, 0xf, false)
                : n == 4 ? __builtin_amdgcn_update_dpp(__float_as_int(ident), __float_as_int(v), 0x114, 0xf, 0xf, false)
                         : __builtin_amdgcn_update_dpp(__float_as_int(ident), __float_as_int(v), 0x118, 0xf, 0xf, false);
    return __int_as_float(r);
}
__device__ __forceinline__ float wave_scan_add(float v, int lane) {
    v += dpp_shr(v, 0.f, 1); v += dpp_shr(v, 0.f, 2); v += dpp_shr(v, 0.f, 4); v += dpp_shr(v, 0.f, 8);
    const float t0 = __int_as_float(__builtin_amdgcn_readlane(__float_as_int(v), 15)), t1 = __int_as_float(__builtin_amdgcn_readlane(__float_as_int(v), 31)), t2 = __int_as_float(__builtin_amdgcn_readlane(__float_as_int(v), 47));
    const int row = lane >> 4; const float add = row == 0 ? 0.f : (row == 1 ? t0 : (row == 2 ? t0 + t1 : (t0 + t1) + t2));
    return v + add;
}
__device__ __forceinline__ float wave_scan_max(float v, int lane) {
    const float NI = -3.0e38f;
    v = fmaxf(v, dpp_shr(v, NI, 1)); v = fmaxf(v, dpp_shr(v, NI, 2)); v = fmaxf(v, dpp_shr(v, NI, 4)); v = fmaxf(v, dpp_shr(v, NI, 8));
    const float t0 = __int_as_float(__builtin_amdgcn_readlane(__float_as_int(v), 15)), t1 = __int_as_float(__builtin_amdgcn_readlane(__float_as_int(v), 31)), t2 = __int_as_float(__builtin_amdgcn_readlane(__float_as_int(v), 47));
    const int row = lane >> 4; const float mx = row == 0 ? NI : (row == 1 ? t0 : (row == 2 ? fmaxf(t0, t1) : fmaxf(fmaxf(t0, t1), t2)));
    return fmaxf(v, mx);
}
__device__ __forceinline__ float softcap15(float z) { const float e = __expf(z * (2.0f / 15.0f)); return 15.0f * (1.0f - 2.0f * __builtin_amdgcn_rcpf(e + 1.0f)); }
__device__ __forceinline__ void mlstm_unit(const Ctx& F, int b, int h, int sl, guchar* ws, const gfloat* ibp, const gfloat* fbp, const gfloat* norm_g) {
    int tid = F.tid; LAUNDER_V(tid); const int lane = tid & 63, w = F.wave, r16 = lane & 15, q4 = lane >> 4;
    const gbf16* CQ = (const gbf16*)(ws + WS_CQ); const gbf16* CK = (const gbf16*)(ws + WS_CK); const gbf16* CV = (const gbf16*)(ws + WS_CV);
    const gbf16* CO = (const gbf16*)(ws + WS_CO); const gbf16* CZs = (const gbf16*)(ws + WS_CZ);
    const gfloat* IFB = (const gfloat*)(ws + WS_IF);
    gbf16* NUM = (gbf16*)(ws + WS_NUM) + h * 512 + sl * 32; gfloat* SSQC = (gfloat*)(ws + WS_SSQC); gfloat* DNB = (gfloat*)(ws + WS_DN);
    const int rowb = b * SEQ;
    const bf16x8 ones = frag_const(0x3f803f80u), zeros = frag_const(0u);
    for (int i = tid; i < 33 * ML_RS / 16; i += NTHREADS) *(LAS u32x4*)(F.lds + ML_CT + i * 16) = (u32x4){0u, 0u, 0u, 0u};
    f32x4 st[2][3];
#pragma unroll
    for (int i = 0; i < 2; ++i)
#pragma unroll
        for (int dt = 0; dt < 3; ++dt) st[i][dt] = (f32x4){0.f, 0.f, 0.f, 0.f};
    float m_prev = 0.f;
    const float ibv = ibp[h], fbv = fbp[h];
    const f32x4 ng0 = *(const gf32x4*)(norm_g + h * 512 + sl * 32 + 4 * q4), ng1 = *(const gf32x4*)(norm_g + h * 512 + sl * 32 + 16 + 4 * q4);
    u32x4 qra[4], kra[4], vra; float gi = 0.f, gf = 0.f;
#define ML_LOAD(c, Q_, K_, V_) do { const int rc_ = rowb + (c) * 64; _Pragma("unroll") for (int k_ = 0; k_ < 4; ++k_) { const int it_ = tid + 512 * k_, s_ = it_ >> 5, ch_ = it_ & 31; \
        Q_[k_] = *(const gu32x4*)(CQ + tb256(rc_ + s_, h * 256 + 8 * ch_, 4)); K_[k_] = *(const gu32x4*)(CK + tb256(rc_ + s_, h * 256 + 8 * ch_, 4)); } \
        V_ = *(const gu32x4*)(CV + tb256(rc_ + ((tid & 255) >> 2), h * 512 + sl * 32 + 8 * (tid & 3), 8)); } while (0)
#define ML_GLOAD(c) do { const int r_ = rowb + (c) * 64 + lane; gi = IFB[(size_t)r_ * 8 + h]; gf = IFB[(size_t)r_ * 8 + 4 + h]; } while (0)
#define ML_GPREP(par) do { if (w == 7) { const float ig_ = softcap15(gi + ibv); const float z_ = softcap15(gf + fbv); \
        const float lf_ = -(fmaxf(-z_, 0.f) + log1pf(__expf(-fabsf(z_)))); const float bc_ = wave_scan_add(lf_, lane); const float u_ = ig_ - bc_; const float pm_ = wave_scan_max(u_, lane); \
        const float Mv_ = fmaxf(m_prev, pm_); const float M63_ = __int_as_float(__builtin_amdgcn_readlane(__float_as_int(Mv_), 63)); const float g_ = __int_as_float(__builtin_amdgcn_readlane(__float_as_int(bc_), 63)); \
        LAS float* gp_ = (LAS float*)(F.lds + ML_GATE + (par) * ML_GSZ); gp_[lane] = u_; gp_[64 + lane] = Mv_; gp_[128 + lane] = __expf(m_prev - Mv_); gp_[192 + lane] = __expf(-(bc_ + Mv_)); \
        gp_[256 + lane] = __expf(u_ - M63_); if (lane == 0) gp_[320] = __expf(m_prev - M63_); m_prev = g_ + M63_; } } while (0)
#define ML_WRITE(kb_, vw_, gpn_, Q_, K_, V_) do { _Pragma("unroll") for (int k_ = 0; k_ < 4; ++k_) { const int it_ = tid + 512 * k_, s_ = it_ >> 5, ch_ = it_ & 31; \
        *(LAS u32x4*)(F.lds + ML_QL + s_ * ML_RS + ch_ * 16) = Q_[k_]; *(LAS u32x4*)(F.lds + (kb_) + s_ * ML_RS + ch_ * 16) = K_[k_]; } \
        if (tid < 256) { const int s_ = tid >> 2, ch_ = tid & 3; const unsigned e_[4] = {V_.x, V_.y, V_.z, V_.w}; const float ws_ = (gpn_)[256 + s_]; \
            _Pragma("unroll") for (int i_ = 0; i_ < 8; ++i_) { const unsigned hv_ = (e_[i_ >> 1] >> ((i_ & 1) * 16)) & 0xffffu; \
                *(LAS bf16_t*)(F.lds + ML_VT + (8 * ch_ + i_) * ML_TS + 2 * s_) = (bf16_t)hv_; \
                *(LAS bf16_t*)(F.lds + (vw_) + (8 * ch_ + i_) * ML_WS + 2 * s_) = (bf16_t)(cvt_pk_bf16(__uint_as_float(hv_ << 16) * ws_, 0.f) & 0xffffu); } \
            if (ch_ == 0) *(LAS bf16_t*)(F.lds + (vw_) + 32 * ML_WS + 2 * s_) = (bf16_t)(cvt_pk_bf16(ws_, 0.f) & 0xffffu); } } while (0)
    ML_LOAD(0, qra, kra, vra); ML_GLOAD(0);
    ML_GPREP(0);
    ML_GLOAD(1);
    __syncthreads();
    ML_WRITE(ML_KA, ML_VW, ((const LAS float*)(F.lds + ML_GATE)), qra, kra, vra);
    __syncthreads();
#define ML_STEP(c, LQ_, LK_, LV_, WQ_, WK_, WV_) do { \
        const int par = c & 1; const LAS float* gp = (const LAS float*)(F.lds + ML_GATE + par * ML_GSZ); \
        const int vt = ML_VT, kb = par ? ML_KB : ML_KA, kbn = par ? ML_KA : ML_KB, vw = par ? ML_VW2 : ML_VW, vwn = par ? ML_VW : ML_VW2; \
        const LAS float* gpn = (const LAS float*)(F.lds + ML_GATE + (par ^ 1) * ML_GSZ); \
        const int rowc = rowb + c * 64; \
        const size_t rog_ = tb256(rowc + 16 * (w & 3) + r16, h * 512 + sl * 32 + 4 * q4, 8); \
        const u32x2 ob0 = *(const gu32x2*)(CO + rog_), ob1 = *(const gu32x2*)(CO + rog_ + 16), zb0 = *(const gu32x2*)(CZs + rog_), zb1 = *(const gu32x2*)(CZs + rog_ + 16); \
        ML_LOAD((c + 1 < 32 ? c + 1 : 31), LQ_, LK_, LV_); if (c + 1 < 32) ML_GPREP(par ^ 1); ML_GLOAD((c + 2 < 32 ? c + 2 : 31)); \
        f32x4 oacc[3]; \
        for (int rp_ = 0; rp_ < ML_R1B; ++rp_) { \
        _Pragma("unroll") \
        for (int dt = 0; dt < 3; ++dt) oacc[dt] = (f32x4){0.f, 0.f, 0.f, 0.f}; \
        if (w < 4) { \
            const int T = w; \
            bf16x8 bq[8]; \
        _Pragma("unroll") \
            for (int ks = 0; ks < 8; ++ks) bq[ks] = *(const LAS bf16x8*)(F.lds + ML_QL + (16 * T + r16) * ML_RS + ks * 64 + q4 * 16); \
            f32x4 sa[4]; \
        _Pragma("unroll") \
            for (int s4 = 0; s4 < 4; ++s4) { sa[s4] = (f32x4){0.f, 0.f, 0.f, 0.f}; \
                if (s4 <= T) { \
        _Pragma("unroll") \
                    for (int ks = 0; ks < 8; ++ks) { const bf16x8 a = *(const LAS bf16x8*)(F.lds + kb + (16 * s4 + r16) * ML_RS + ks * 64 + q4 * 16); sa[s4] = MFMA16(a, bq[ks], sa[s4]); } } } \
            const int tl = 16 * T + r16; const float Mt = gp[64 + tl]; \
        _Pragma("unroll") \
            for (int s4 = 0; s4 < 4; ++s4) { const f32x4 uu = *(const LAS f32x4*)(gp + 16 * s4 + 4 * q4); \
        _Pragma("unroll") \
                for (int e = 0; e < 4; ++e) { const int sl_ = 16 * s4 + 4 * q4 + e; sa[s4][e] = (sl_ <= tl) ? sa[s4][e] * __expf(uu[e] - Mt) : 0.f; } } \
        _Pragma("unroll") \
            for (int kk = 0; kk < 2; ++kk) { const bf16x8 pf = mk_frag(pack4(sa[2 * kk]), pack4(sa[2 * kk + 1])); \
        _Pragma("unroll") \
                for (int dt = 0; dt < 3; ++dt) { bf16x8 a; \
                    if (dt < 2) { const LAS unsigned char* vp = F.lds + vt + (16 * dt + r16) * ML_TS + (32 * kk + 4 * q4) * 2; a = mk_frag(*(const LAS u32x2*)vp, *(const LAS u32x2*)(vp + 32)); } \
                    else a = (r16 == 0) ? ones : zeros; \
                    oacc[dt] = MFMA16(a, pf, oacc[dt]); } } \
        } else { \
            const int T = w - 4; f32x4 ia[3]; \
        _Pragma("unroll") \
            for (int dt = 0; dt < 3; ++dt) ia[dt] = (f32x4){0.f, 0.f, 0.f, 0.f}; \
        _Pragma("unroll") \
            for (int ks = 0; ks < 8; ++ks) { const bf16x8 bqv = *(const LAS bf16x8*)(F.lds + ML_QL + (16 * T + r16) * ML_RS + ks * 64 + q4 * 16); \
        _Pragma("unroll") \
                for (int dt = 0; dt < 3; ++dt) { bf16x8 a; \
                    if (dt < 2) a = *(const LAS bf16x8*)(F.lds + ML_CT + (16 * dt + r16) * ML_RS + ks * 64 + q4 * 16); \
                    else { a = *(const LAS bf16x8*)(F.lds + ML_CT + 32 * ML_RS + ks * 64 + q4 * 16); if (r16 != 0) a = zeros; } \
                    ia[dt] = MFMA16(a, bqv, ia[dt]); } } \
            const int tl = 16 * T + r16; \
            *(LAS f32x4*)(F.lds + ML_X + tl * 144 + (4 * q4) * 4) = ia[0]; *(LAS f32x4*)(F.lds + ML_X + tl * 144 + (16 + 4 * q4) * 4) = ia[1]; \
            if (q4 == 0) *(LAS f32x4*)(F.lds + ML_X + tl * 144 + 32 * 4) = ia[2]; \
        } \
        } \
        __syncthreads(); \
        if (w < 4) { \
            const int tl = 16 * w + r16; const float at = gp[128 + tl], en = gp[192 + tl]; \
            const f32x4 x0 = *(const LAS f32x4*)(F.lds + ML_X + tl * 144 + (4 * q4) * 4), x1 = *(const LAS f32x4*)(F.lds + ML_X + tl * 144 + (16 + 4 * q4) * 4); \
            const float xd = *(const LAS float*)(F.lds + ML_X + tl * 144 + 32 * 4); \
            const f32x4 n0 = oacc[0] + x0 * at, n1 = oacc[1] + x1 * at; \
            float den = oacc[2][0] + xd * at; den = __shfl(den, r16); \
            float sq = (n0[0] * n0[0] + n0[1] * n0[1]) + (n0[2] * n0[2] + n0[3] * n0[3]) + (n1[0] * n1[0] + n1[1] * n1[1]) + (n1[2] * n1[2] + n1[3] * n1[3]); \
            sq += __shfl_xor(sq, 16); sq += __shfl_xor(sq, 32); \
            const size_t ro = (size_t)(rowc + tl) * BW + 4 * q4; \
            f32x4 t0, t1; \
            t0[0] = n0[0] * ng0[0] * (bf_lo(ob0.x) * bf_lo(zb0.x)); t0[1] = n0[1] * ng0[1] * (bf_hi(ob0.x) * bf_hi(zb0.x)); t0[2] = n0[2] * ng0[2] * (bf_lo(ob0.y) * bf_lo(zb0.y)); t0[3] = n0[3] * ng0[3] * (bf_hi(ob0.y) * bf_hi(zb0.y)); \
            t1[0] = n1[0] * ng1[0] * (bf_lo(ob1.x) * bf_lo(zb1.x)); t1[1] = n1[1] * ng1[1] * (bf_hi(ob1.x) * bf_hi(zb1.x)); t1[2] = n1[2] * ng1[2] * (bf_lo(ob1.y) * bf_lo(zb1.y)); t1[3] = n1[3] * ng1[3] * (bf_hi(ob1.y) * bf_hi(zb1.y)); \
            *(gu32x2*)(NUM + ro) = pack4(t0); *(gu32x2*)(NUM + ro + 16) = pack4(t1); \
            if (q4 == 0) { SSQC[(size_t)(rowc + tl) * 64 + h * 16 + sl] = sq; if (sl == 0) DNB[(size_t)(rowc + tl) * 4 + h] = fmaxf(fabsf(den), en); } \
        } \
        { const float dec = gp[320]; \
        _Pragma("unroll") \
          for (int i = 0; i < 2; ++i) \
        _Pragma("unroll") \
              for (int dt = 0; dt < 3; ++dt) st[i][dt] = st[i][dt] * dec; \
        _Pragma("unroll") \
          for (int kk = 0; kk < 2; ++kk) { bf16x8 a[2], bv[3]; \
        _Pragma("unroll") \
              for (int i = 0; i < 2; ++i) a[i] = tr_frag8(F.lds + kb, ML_RS, 32 * kk + 8 * q4, 32 * w + 16 * i, r16); \
        _Pragma("unroll") \
              for (int dt = 0; dt < 2; ++dt) bv[dt] = *(const LAS bf16x8*)(F.lds + vw + (16 * dt + r16) * ML_WS + kk * 64 + q4 * 16); \
              bv[2] = *(const LAS bf16x8*)(F.lds + vw + 32 * ML_WS + kk * 64 + q4 * 16); if (r16 != 0) bv[2] = zeros; \
        _Pragma("unroll") \
              for (int i = 0; i < 2; ++i) \
        _Pragma("unroll") \
                  for (int dt = 0; dt < 3; ++dt) st[i][dt] = MFMA16(a[i], bv[dt], st[i][dt]); } \
        _Pragma("unroll") \
          for (int i = 0; i < 2; ++i) { \
        _Pragma("unroll") \
              for (int dt = 0; dt < 2; ++dt) *(LAS u32x2*)(F.lds + ML_CT + (16 * dt + r16) * ML_RS + (32 * w + 16 * i + 4 * q4) * 2) = pack4(st[i][dt]); \
              if (r16 == 0) *(LAS u32x2*)(F.lds + ML_CT + 32 * ML_RS + (32 * w + 16 * i + 4 * q4) * 2) = pack4(st[i][2]); } } \
        for (int rp_ = 0; rp_ < ML_RWR; ++rp_) if (c + 1 < 32) ML_WRITE(kbn, vwn, gpn, WQ_, WK_, WV_); \
        __syncthreads(); \
    } while (0)
    for (int c2 = 0; c2 < 32; ++c2) { ML_STEP(c2, qra, kra, vra, qra, kra, vra); }
#undef ML_LOAD
#undef ML_GLOAD
#undef ML_GPREP
#undef ML_WRITE
#undef ML_STEP
}

__device__ __forceinline__ void p2b_finalize(const Ctx& F, guchar* ws) {
    int lane = F.lane; LAUNDER_V(lane); const int gw = F.vcu * NWAVES + F.wave, NGW = F.G * NWAVES;
    const gbf16* NUM = (const gbf16*)(ws + WS_NUM); gbf16* YC = (gbf16*)(ws + WS_YA) + (size_t)2 * M_ROWS * BW;
    for (int m = gw; m < M_ROWS; m += NGW) {
        float s = ((const gfloat*)(ws + WS_SSQC))[(size_t)m * 64 + lane];
        s += __shfl_xor(s, 1); s += __shfl_xor(s, 2); s += __shfl_xor(s, 4); s += __shfl_xor(s, 8);
        const float dn = ((const gfloat*)(ws + WS_DN))[(size_t)m * 4 + (lane >> 4)];
        const float inv = 1.0f / dn; const float sc = inv * rsqrtf(s * (1.0f / 512.0f) * inv * inv + NORM_EPS);
#pragma unroll
        for (int it = 0; it < 4; ++it) { const float f = __shfl(sc, 16 * it); const size_t o = (size_t)m * BW + (size_t)(it * 64 + lane) * 8;
            const u32x4 nb = *(const gu32x4*)(NUM + o); u32x4 y;
            y.x = cvt_pk_bf16(bf_lo(nb.x) * f, bf_hi(nb.x) * f); y.y = cvt_pk_bf16(bf_lo(nb.y) * f, bf_hi(nb.y) * f);
            y.z = cvt_pk_bf16(bf_lo(nb.z) * f, bf_hi(nb.z) * f); y.w = cvt_pk_bf16(bf_lo(nb.w) * f, bf_hi(nb.w) * f);
            *(gu32x4*)(YC + ablk(m, (it * 64 + lane) * 8, BW)) = y; }
    }
}
__device__ __forceinline__ void p5b_ssq(const Ctx& F, guchar* ws) {
    int lane = F.lane; LAUNDER_V(lane); const int gw = F.vcu * NWAVES + F.wave, NGW = F.G * NWAVES;
    for (int m = gw; m < M_ROWS; m += NGW) { const float s = wave_sum(((const gfloat*)(ws + WS_XSP))[(size_t)m * 64 + lane]); if (lane == 0) ((gfloat*)(ws + WS_CTL + CTL_SSQ1))[m] = s;
#if P1G_F6
#pragma unroll
        for (int hb = 0; hb < 2; ++hb) { const int c0 = 32 * (lane + 64 * hb); float v[32];
#pragma unroll
            for (int i = 0; i < 4; ++i) { const u32x4 w = *(const gu32x4*)((const gbf16*)(ws + WS_XB) + ablk(m, c0 + 8 * i, DM));
                v[8 * i] = bf_lo(w.x); v[8 * i + 1] = bf_hi(w.x); v[8 * i + 2] = bf_lo(w.y); v[8 * i + 3] = bf_hi(w.y); v[8 * i + 4] = bf_lo(w.z); v[8 * i + 5] = bf_hi(w.z); v[8 * i + 6] = bf_lo(w.w); v[8 * i + 7] = bf_hi(w.w); }
            unsigned E; const u32x6 d = mx6_pack(v, E); guchar* rp = ws + WS_XB8 + ((size_t)(m >> 8) * (DM / 128) + (c0 >> 7)) * 32768 + (size_t)(m & 255) * 128 + 16 * ((c0 >> 5) & 3);
            *(gu32x4*)rp = (u32x4){d[0], d[1], d[2], d[3]}; *(gu32x4*)(rp + 64) = (u32x4){d[4], d[5], E, 0u}; }
#endif
    }
}
__device__ __forceinline__ void p4b_x1(const Ctx& F, guchar* ws, const gfloat* npost) {
    int lane = F.lane; LAUNDER_V(lane); const int gw = F.vcu * NWAVES + F.wave, NGW = F.G * NWAVES;
    const gbf16* OUT = (const gbf16*)(ws + WS_OUT); const gbf16* XB = (const gbf16*)(ws + WS_XB); gbf16* X1B = (gbf16*)(ws + WS_X1B);
    for (int m = gw; m < M_ROWS; m += NGW) {
        const float so = wave_sum(((const gfloat*)(ws + WS_OUTP))[(size_t)m * 64 + lane]), se = wave_sum(((const gfloat*)(ws + WS_ERP))[(size_t)m * 64 + lane]);
        const float rso = rsqrtf(so * (1.0f / DM) + NORM_EPS), rse = rsqrtf(se * (1.0f / DM) + NORM_EPS);
        if (lane == 0) { ((gfloat*)(ws + WS_RSO))[m] = rso; ((gfloat*)(ws + WS_RSE))[m] = rse; }
        u32x4 yv[8]; float mx = 0.f;
#pragma unroll
        for (int it = 0; it < 8; ++it) { const int c = (it * 64 + lane) * 8; const size_t o = (size_t)m * DM + c;
            const u32x4 xb = *(const gu32x4*)(XB + ablk(m, c, DM)), ob = *(const gu32x4*)(OUT + o); const f32x4 n0 = *(const gf32x4*)(npost + c), n1 = *(const gf32x4*)(npost + c + 4); u32x4 y;
            y.x = cvt_pk_bf16(bf_lo(xb.x) + bf_lo(ob.x) * rso * n0[0], bf_hi(xb.x) + bf_hi(ob.x) * rso * n0[1]);
            y.y = cvt_pk_bf16(bf_lo(xb.y) + bf_lo(ob.y) * rso * n0[2], bf_hi(xb.y) + bf_hi(ob.y) * rso * n0[3]);
            y.z = cvt_pk_bf16(bf_lo(xb.z) + bf_lo(ob.z) * rso * n1[0], bf_hi(xb.z) + bf_hi(ob.z) * rso * n1[1]);
            y.w = cvt_pk_bf16(bf_lo(xb.w) + bf_lo(ob.w) * rso * n1[2], bf_hi(xb.w) + bf_hi(ob.w) * rso * n1[3]);
            *(gu32x4*)(X1B + ablk(m, c, DM)) = y; yv[it] = y;
            mx = fmaxf(mx, fmaxf(fmaxf(fmaxf(fabsf(bf_lo(y.x)), fabsf(bf_hi(y.x))), fmaxf(fabsf(bf_lo(y.y)), fabsf(bf_hi(y.y)))), fmaxf(fmaxf(fabsf(bf_lo(y.z)), fabsf(bf_hi(y.z))), fmaxf(fabsf(bf_lo(y.w)), fabsf(bf_hi(y.w))))));
#if P5_FP8
            { u32x2 y8; y8.x = pack_fp8x4(bf_lo(y.x), bf_hi(y.x), bf_lo(y.y), bf_hi(y.y)); y8.y = pack_fp8x4(bf_lo(y.z), bf_hi(y.z), bf_lo(y.w), bf_hi(y.w)); *(gu32x2*)(ws + WS_X1B8 + ablk8(m, c, DM)) = y8; }
#endif
            }
#if P5_I8
#pragma unroll
        for (int s = 32; s >= 1; s >>= 1) mx = fmaxf(mx, __shfl_xor(mx, s));
        mx = fmaxf(mx, 1e-30f); const float qs = 127.0f / mx;
        if (lane == 0) ((gfloat*)(ws + WS_RSX))[m] = mx * (1.0f / 127.0f);
#pragma unroll
        for (int it = 0; it < 8; ++it) { const int c = (it * 64 + lane) * 8; const u32x4 y = yv[it]; u32x2 y8;
            y8.x = pack_i8x4(bf_lo(y.x) * qs, bf_hi(y.x) * qs, bf_lo(y.y) * qs, bf_hi(y.y) * qs); y8.y = pack_i8x4(bf_lo(y.z) * qs, bf_hi(y.z) * qs, bf_lo(y.w) * qs, bf_hi(y.w) * qs);
            *(gu32x2*)(ws + WS_X1B8 + ablk8(m, c, DM)) = y8; }
#endif
    }
}

#ifndef P1_ROT
#define P1_ROT 0
#endif
#ifndef P1_WGM
#define P1_WGM 4
#endif
#ifndef REP_P0
#define REP_P0 1
#endif
#ifndef REP_P1
#define REP_P1 1
#endif
#ifndef REP_ML
#define REP_ML 1
#endif
#ifndef REP_SW
#define REP_SW 1
#endif
#ifndef REP_GM
#define REP_GM 1
#endif
#ifndef REP_P3
#define REP_P3 1
#endif
#ifndef REP_THIN
#define REP_THIN 1
#endif
#ifndef REP_BAR
#define REP_BAR 1
#endif
#ifndef REP_P4
#define REP_P4 1
#endif
__device__ __forceinline__ unsigned long long arg_ld(LAS unsigned char* lds, int i) {
    unsigned a = (unsigned)(ARGS_OFF + 8 * i); asm volatile("" : "+v"(a));
    const volatile LAS unsigned* q = (const volatile LAS unsigned*)(lds + a);
    const unsigned lo = q[0], hi = q[1];
    return ((unsigned long long)(unsigned)__builtin_amdgcn_readfirstlane((int)hi) << 32) | (unsigned)__builtin_amdgcn_readfirstlane((int)lo);
}
struct Args { const void* in[19]; float* out; unsigned char* ws; };
static_assert(sizeof(Args) == 21 * 8, "no padding in Args");

__global__ void __launch_bounds__(NTHREADS, 2) fwd_kernel(Args args) {
    extern __shared__ __attribute__((aligned(16))) unsigned char lds_raw[];
    Ctx F; F.lds = (LAS unsigned char*)lds_raw; F.tid = threadIdx.x; F.lane = F.tid & 63; F.wave = __builtin_amdgcn_readfirstlane(F.tid >> 6);
    F.G = gridDim.x; F.bx = blockIdx.x; { const int bx = blockIdx.x; F.vcu = (F.G % 8 == 0) ? (bx % 8) * (F.G / 8) + bx / 8 : bx; }
    guchar* ws0 = (guchar*)args.ws;
#define WSL() ({ guchar* w_ = ws0; LAUNDER_S(w_); w_; })
    volatile LAS unsigned* MISC = (volatile LAS unsigned*)(F.lds + MISC_OFF);
    if (F.tid < 32) MISC[F.tid] = 0u;
    __syncthreads();
    const XcdBarrier bar = xcd_barrier_post((unsigned*)(ws0 + WS_CTL) + CW_BAR, MISC);

    if (F.tid < 19) ((LAS unsigned long long*)(F.lds + ARGS_OFF))[F.tid] = (unsigned long long)args.in[F.tid];
    if (F.tid == 19) ((LAS unsigned long long*)(F.lds + ARGS_OFF))[19] = (unsigned long long)args.out;
    __syncthreads();
#define ARGP(T, i) ((T)arg_ld(F.lds, (i)))

#define FL() ({ Ctx f_ = F; LAUNDER_S(f_.lds); LAUNDER_S(f_.wave); LAUNDER_S(f_.vcu); LAUNDER_S(f_.G); LAUNDER_S(f_.bx); f_; })
#ifndef SKIP_P0
    for (int rep_ = 0; rep_ < REP_P0; ++rep_) { const Ctx Fp = FL(); guchar* ws = WSL(); p0_prologue(FL(), ARGP(const gfloat*, 0), ARGP(const gfloat*, 1), ARGP(const gint*, 2), ARGP(const gfloat*, 3), ARGP(const gfloat*, 4), ARGP(const gfloat*, 13), ARGP(const gfloat*, 14), ARGP(const gfloat*, 18), ARGP(const gfloat*, 16), ws); }
#endif
    for (int rb_ = 0; rb_ < REP_BAR; ++rb_) xcd_barrier(bar);

    auto layer_body = [&](const int l) __attribute__((always_inline)) {
#ifndef NT_BF
#define NT_BF (P1G_FP8 ? 67 : NT_IN)
#endif
#ifndef P1_LOCK
#define P1_LOCK 0
#endif
#ifndef SKIP_P1
        for (int rep_ = 0; rep_ < REP_P1; ++rep_) { const Ctx Fp = FL(); guchar* ws = WSL(); const gfloat* ssq = l == 0 ? (const gfloat*)(ws + WS_SSQ0) : (const gfloat*)(ws + WS_CTL + CTL_SSQ1);
          const int rowbase = (Fp.G == 256 && P1_WGM == 4 && P1_ROT == 0) ? (Fp.bx & 7) * 1024 : -1; LAS float* rtab = (LAS float*)(Fp.lds + 132096);
          if (rowbase >= 0) { int ti_ = threadIdx.x; LAUNDER_V(ti_); const float s0_ = ssq[rowbase + ti_], s1_ = ssq[rowbase + 512 + ti_]; rtab[ti_] = rsqrtf(s0_ * (1.0f / DM) + NORM_EPS); rtab[512 + ti_] = rsqrtf(s1_ * (1.0f / DM) + NORM_EPS); __syncthreads(); }
#if P1G_FP8
          { pg8::SchedPlain S; S.T.init(M_ROWS / 256, 56, Fp.G, Fp.bx, P1_WGM, P1_ROT, -1, 74); S.pn0 = 74; S.A = (const gchar*)(ws + WS_XB8); S.B = (const gchar*)(ws + WS_WG8 + (size_t)l * SZ_WG8);
            S.astep = (size_t)256 * DM; S.bstep = (size_t)256 * DM;
            pg8::EpiInT<true> E{ssq, ws, rtab, rowbase};
            pg8::gemm_phase<pg8::EpiInT<true>, pg8::SchedPlain>(Fp.lds, DM / 2, DM, DM, S, E); }
          { pg8::SchedPlain S; S.T.init(M_ROWS / 256, NT_BF, Fp.G, Fp.bx, P1_WGM, P1_ROT, 122, 0); S.A = (const gchar*)(ws + WS_XB); S.B = (const gchar*)(ws + WS_WIN + (size_t)l * SZ_WIN);
            S.astep = (size_t)256 * DM * 2; S.bstep = (size_t)256 * DM * 2;
            pg8::EpiIn E{ssq, ws, rtab, rowbase};
            pg8::gemm_phase<pg8::EpiIn, pg8::SchedPlain>(Fp.lds, DM, DM, DM, S, E, (unsigned*)(ws + WS_CTL) + 256 + 64 * l, P1_LOCK); }
#else
          { pg8::SchedPlain S; S.T.init(M_ROWS / 256, NT_IN, Fp.G, Fp.bx, P1_WGM, P1_ROT); S.A = (const gchar*)(ws + WS_XB); S.B = (const gchar*)(ws + WS_WIN + (size_t)l * SZ_WIN);
            S.astep = (size_t)256 * DM * 2; S.bstep = (size_t)256 * DM * 2;
            pg8::EpiIn E{ssq, ws, rtab, rowbase};
            pg8::gemm_phase<pg8::EpiIn, pg8::SchedPlain>(Fp.lds, DM, DM, DM, S, E, (unsigned*)(ws + WS_CTL) + 256 + 64 * l, P1_LOCK); }
#endif
        }
#ifdef PROBE_P1CHEAP
        { const Ctx Fp = FL(); guchar* ws = WSL(); pg8::SchedPlain S; S.T.init(M_ROWS / 256, NT_IN, Fp.G, Fp.bx); S.A = (const gchar*)(ws + WS_XB); S.B = (const gchar*)(ws + WS_WIN + (size_t)l * SZ_WIN);
          S.astep = (size_t)256 * DM * 2; S.bstep = (size_t)256 * DM * 2;
          pg8::EpiSq E{(gbf16*)(ws + WS_END), (gfloat*)(ws + WS_END + (size_t)M_ROWS * 31488 * 2)};
          pg8::gemm_phase<pg8::EpiSq, pg8::SchedPlain>(Fp.lds, DM, DM, DM, S, E); }
#endif
        { const Ctx Fq = FL(); const int nwg_ = (M_ROWS / 256) * NT_BF, rem_ = nwg_ % Fq.G;
          if (rem_ == 0 || Fq.bx >= rem_) { const int me = rem_ ? Fq.bx - rem_ : Fq.bx, nw = rem_ ? Fq.G - rem_ : Fq.G;
            { const Ctx Fp = FL(); guchar* ws = WSL(); pg8::SchedPlain S; S.T.init(M_ROWS / 256, DM / 256, nw, me); S.A = (const gchar*)(ws + WS_PB + (size_t)l * M_ROWS * 256 * 2); S.B = (const gchar*)(ws + WS_WPP + (size_t)l * SZ_WPP);
              S.astep = (size_t)256 * 256 * 2; S.bstep = (size_t)256 * 256 * 2;
              pg8::EpiSq E{(gbf16*)(ws + WS_ERAW), (gfloat*)(ws + WS_ERP)};
              pg8::gemm_phase<pg8::EpiSq, pg8::SchedPlain>(Fp.lds, 256, 256, 256, S, E); }
            if (l == 1 && P5_I8 && TR_L1TAIL) tr_run(FL(), TR_PG1 - TR_L1TAIL, TR_PG1, 0x7fffffff, 0x7fffffff, me, nw, ARGP(const gfloat*, 4), ARGP(const gfloat*, 3), ARGP(const gfloat*, 13), ARGP(const gfloat*, 14), ARGP(const gfloat*, 18), ARGP(const gfloat*, 16), WSL());
            if (l == 0) tr_run(FL(), P5_I8 ? TR_PG0 : TR_DEFER0, P5_I8 ? TR_PG1 + 1024 : TR_DEFER1, P5_I8 ? TR_PG0 + 1024 : 0x7fffffff, P5_I8 ? TR_PG1 : 0x7fffffff, me, nw, ARGP(const gfloat*, 4), ARGP(const gfloat*, 3), ARGP(const gfloat*, 13), ARGP(const gfloat*, 14), ARGP(const gfloat*, 18), ARGP(const gfloat*, 16), WSL()); } }
#endif
#ifdef PROBE_DELAY
        if (((F.bx & 7) < 4) == (PROBE_DELAY == 1)) { const unsigned long long t0_ = __builtin_amdgcn_s_memrealtime(); while (__builtin_amdgcn_s_memrealtime() - t0_ < 3000ull) __builtin_amdgcn_s_sleep(8); }
#endif
        for (int rb_ = 0; rb_ < REP_BAR; ++rb_) xcd_barrier(bar);
#ifndef SKIP_ML
        for (int rep_ = 0; rep_ < REP_ML; ++rep_) { const Ctx Fp = FL(); guchar* ws = WSL(); for (int u = Fp.vcu; u < 256; u += Fp.G) mlstm_unit(Fp, u >> 6, (u >> 4) & 3, u & 15, ws, ARGP(const gfloat*, 10) + l * 4, ARGP(const gfloat*, 11) + l * 4, ARGP(const gfloat*, 12) + l * BW); }
#endif
#ifndef SKIP_SW
        for (int rep_ = 0; rep_ < REP_SW; ++rep_) { const Ctx Fp = FL(); guchar* ws = WSL(); for (int u = Fp.vcu; u < 256; u += Fp.G) swa_unit(Fp, u >> 6, (u >> 2) & 15, u & 3, ws, ARGP(const gfloat*, 9) + l * 32); }
#endif
#ifndef SKIP_GM
        for (int rep_ = 0; rep_ < REP_GM; ++rep_) { const Ctx Fp = FL(); guchar* ws = WSL(); for (int u = Fp.vcu; u < 512; u += Fp.G) gmlp_unit(Fp, u >> 7, (u >> 3) & 15, u & 7, ws, ARGP(const gfloat*, 5) + l * BW, ARGP(const gfloat*, 6) + l * BW, ARGP(const gfloat*, 7) + (size_t)l * 8 * 128 * 128, ARGP(const gfloat*, 8) + l * 8 * 128); }
#endif
        for (int rb_ = 0; rb_ < REP_BAR; ++rb_) xcd_barrier(bar);
#ifndef SKIP_P2B
        for (int rep_ = 0; rep_ < REP_THIN; ++rep_) p2b_finalize(FL(), WSL());
#endif
        for (int rb_ = 0; rb_ < REP_BAR; ++rb_) xcd_barrier(bar);
#ifndef PROBE_NOSTORE
#define PROBE_NOSTORE 0
#endif
#ifdef PROBE_K1024
        for (int rep_ = 0; rep_ < 4; ++rep_) { const Ctx Fp = FL(); guchar* ws = WSL(); pg8::SchedPlain S; S.T.init(M_ROWS / 256, DM / 256, Fp.G, Fp.bx); S.A = (const gchar*)(ws + WS_YA); S.B = (const gchar*)(ws + WS_WOUT + (size_t)l * SZ_WSQ);
          S.astep = (size_t)256 * DM * 2; S.bstep = (size_t)256 * DM * 2;
          pg8::EpiSq E{PROBE_NOSTORE ? (gbf16*)nullptr : (gbf16*)(ws + WS_END), (gfloat*)(ws + WS_END + (size_t)M_ROWS * 31488 * 2)};
          pg8::gemm_phase<pg8::EpiSq, pg8::SchedPlain>(Fp.lds, 1024, DM, DM, S, E); }
#endif
#ifdef PROBE_P3CHEAP
        { const Ctx Fp = FL(); guchar* ws = WSL(); pg8::SchedBranch S; S.T.init(M_ROWS / 256, DM / 256, Fp.G, Fp.bx); S.A = (const gchar*)(ws + WS_YA); S.B = (const gchar*)(ws + WS_WBR + (size_t)l * SZ_WBR);
          S.astep = (size_t)256 * BW * 2; S.bstep = (size_t)256 * BW * 2; S.aseg = SZ_ROWS_BW; S.bseg = (size_t)DM * BW * 2;
          pg8::EpiSq E{(gbf16*)(ws + WS_END), (gfloat*)(ws + WS_END + (size_t)M_ROWS * 31488 * 2)};
          pg8::gemm_phase<pg8::EpiSq, pg8::SchedBranch>(Fp.lds, BW, BW, BW, S, E); }
#endif
#ifndef SKIP_P3
        for (int rep_ = 0; rep_ < REP_P3; ++rep_) { const Ctx Fp = FL(); guchar* ws = WSL(); pg8::SchedBranch S; S.T.init(M_ROWS / 256, DM / 256, Fp.G, Fp.bx); S.A = (const gchar*)(ws + WS_YA); S.B = (const gchar*)(ws + WS_WBR + (size_t)l * SZ_WBR);
          S.astep = (size_t)256 * BW * 2; S.bstep = (size_t)256 * BW * 2; S.aseg = SZ_ROWS_BW; S.bseg = (size_t)DM * BW * 2;
          pg8::EpiBranch E{(const guchar*)(ws + WS_G), (gbf16*)(ws + WS_MIX)};
          pg8::gemm_phase<pg8::EpiBranch, pg8::SchedBranch>(Fp.lds, BW, BW, BW, S, E); }
#endif
        for (int rb_ = 0; rb_ < REP_BAR; ++rb_) xcd_barrier(bar);
#ifndef SKIP_P4
        for (int rep_ = 0; rep_ < REP_P4; ++rep_) { const Ctx Fp = FL(); guchar* ws = WSL(); pg8::SchedPlain S; S.T.init(M_ROWS / 256, DM / 256, Fp.G, Fp.bx); S.A = (const gchar*)(ws + WS_MIX); S.B = (const gchar*)(ws + WS_WOUT + (size_t)l * SZ_WSQ);
          S.astep = (size_t)256 * DM * 2; S.bstep = (size_t)256 * DM * 2;
          pg8::EpiSq E{(gbf16*)(ws + WS_OUT), (gfloat*)(ws + WS_OUTP)};
          pg8::gemm_phase<pg8::EpiSq, pg8::SchedPlain>(Fp.lds, DM, DM, DM, S, E); }
#endif
        for (int rb_ = 0; rb_ < REP_BAR; ++rb_) xcd_barrier(bar);
#ifndef SKIP_P4B
        for (int rep_ = 0; rep_ < REP_THIN; ++rep_) p4b_x1(FL(), WSL(), ARGP(const gfloat*, 15) + l * DM);
#endif
        for (int rb_ = 0; rb_ < REP_BAR; ++rb_) xcd_barrier(bar);
#ifndef SKIP_P5
        { const Ctx Fp = FL(); guchar* ws = WSL(); pg8::SchedPlain S; S.T.init(M_ROWS / 256, DM / 256, Fp.G, Fp.bx); S.A = (const gchar*)(ws + ((P5_FP8 || P5_I8) ? WS_X1B8 : WS_X1B)); S.B = (const gchar*)(ws + WS_WPG + (size_t)l * SZ_WSQ);
          S.astep = (size_t)256 * DM * ((P5_FP8 || P5_I8) ? 1 : 2); S.bstep = (size_t)256 * DM * ((P5_FP8 || P5_I8) ? 1 : 2);
          pg8::EpiPle E{(const gbf16*)(ws + WS_X1B), ARGP(gfloat*, 19), (gbf16*)(ws + WS_XB), (const gbf16*)(ws + WS_ERAW), (const gfloat*)(ws + WS_RSE), ARGP(const gfloat*, 17) + l * DM, (gfloat*)(ws + WS_XSP), l == NLAYER - 1 ? 1 : 0, ws + WS_XB8, (const gfloat*)(ws + WS_RSX), __uint_as_float(((const gunsigned*)(ws + WS_CTL))[CW_WMAX + l]) * (1.0f / 127.0f)};
          pg8::gemm_phase<pg8::EpiPle, pg8::SchedPlain>(Fp.lds, (P5_FP8 || P5_I8) ? DM / 2 : DM, DM, DM, S, E); }
#endif
        if (l + 1 < NLAYER) { for (int rb_ = 0; rb_ < REP_BAR; ++rb_) xcd_barrier(bar); p5b_ssq(FL(), WSL()); for (int rb_ = 0; rb_ < REP_BAR; ++rb_) xcd_barrier(bar); }
    };
    static_assert(NLAYER == 2, "two layer bodies");
    layer_body(0); layer_body(1);
}

extern "C" void kernel_launch(void* const* d_in, const int* in_sizes, int n_in, void* d_out, int out_size, void* d_ws, size_t ws_size, hipStream_t stream) {
    static int grid = 0;
    if (grid == 0) {
        if (n_in != 19 || out_size != M_ROWS * DM || ws_size < WS_END) { fprintf(stderr, "kernel_launch: unexpected problem (n_in %d, out %d, ws %zu, need %zu)\n", n_in, out_size, ws_size, (size_t)WS_END); grid = -1; return; }
        int dev = 0, cus = 0;
        if (hipGetDevice(&dev) != hipSuccess || hipDeviceGetAttribute(&cus, hipDeviceAttributeMultiprocessorCount, dev) != hipSuccess) { grid = -1; return; }
        if (hipFuncSetAttribute((const void*)fwd_kernel, hipFuncAttributeMaxDynamicSharedMemorySize, LDS_BYTES) != hipSuccess) { fprintf(stderr, "kernel_launch: hipFuncSetAttribute failed\n"); grid = -1; return; }
        int per_cu = 0; (void)hipOccupancyMaxActiveBlocksPerMultiprocessor(&per_cu, (const void*)fwd_kernel, NTHREADS, LDS_BYTES); (void)hipGetLastError();
        if (per_cu < 1) fprintf(stderr, "kernel_launch: occupancy query reports %d blocks per CU\n", per_cu);
        grid = cus > 256 ? 256 : cus;
    }
    if (grid < 0) return;
    (void)hipMemsetAsync((char*)d_ws + WS_CTL, 0, CTL_ZERO_BYTES, stream);
    Args a{};
    for (int i = 0; i < 19; ++i) a.in[i] = d_in[i];
    a.out = (float*)d_out; a.ws = (unsigned char*)d_ws;
    hipLaunchKernelGGL(fwd_kernel, dim3(grid), dim3(NTHREADS), LDS_BYTES, stream, a);
    const hipError_t le = hipPeekAtLastError();
    if (le != hipSuccess) fprintf(stderr, "kernel_launch: launch failed: %s\n", hipGetErrorName(le));
}
```

```cpp
#include <hip/hip_runtime.h>
#include <cstdio>
#include <cstdint>

#define LAS __attribute__((address_space(3)))
#define GAS __attribute__((address_space(1)))
typedef unsigned short bf16_t;
typedef short bf16x8 __attribute__((ext_vector_type(8)));
typedef float f32x4 __attribute__((ext_vector_type(4)));
typedef float f32x2 __attribute__((ext_vector_type(2)));
typedef unsigned u32x4 __attribute__((ext_vector_type(4)));
typedef unsigned u32x2 __attribute__((ext_vector_type(2)));

typedef GAS float gfloat; typedef GAS bf16_t gbf16; typedef GAS int gint; typedef GAS char gchar; typedef GAS unsigned char guchar; typedef GAS unsigned gunsigned;
typedef GAS f32x4 gf32x4; typedef GAS f32x2 gf32x2; typedef GAS u32x4 gu32x4; typedef GAS u32x2 gu32x2;
constexpr int M_ROWS = 8192, SEQ = 2048, DM = 4096, BW = 2048, NLAYER = 2;
constexpr int N_IN = 31240, IF_COL = 14848;
constexpr int NT_IN = 123;
constexpr int N_IN_T = NT_IN * 256;
constexpr float NORM_EPS = 1e-6f;

__device__ __forceinline__ unsigned cvt_pk_bf16(float lo, float hi) { unsigned r; asm("v_cvt_pk_bf16_f32 %0, %1, %2" : "=v"(r) : "v"(lo), "v"(hi)); return r; }
__device__ __forceinline__ float bf_lo(unsigned w) { return __uint_as_float(w << 16); }
__device__ __forceinline__ float bf_hi(unsigned w) { return __uint_as_float(w & 0xffff0000u); }
__device__ __forceinline__ float bf1(bf16_t b) { return __uint_as_float(((unsigned)b) << 16); }
__device__ __forceinline__ float fsigmoid(float x) { return __builtin_amdgcn_rcpf(1.0f + __expf(-x)); }
__device__ __forceinline__ float wave_sum(float v) {
#pragma unroll
    for (int o = 1; o < 64; o <<= 1) v += __shfl_xor(v, o);
    return v;
}
__device__ __forceinline__ f32x2 gelu_pk(f32x2 v) {
    const f32x2 av = __builtin_elementwise_abs(v), d = av * 0.2316418882f + 1.0f;
    f32x2 t; t.x = __builtin_amdgcn_rcpf(d.x); t.y = __builtin_amdgcn_rcpf(d.y);
    f32x2 q = t * 0.5307027145f + (-0.7265760135f); q = q * t + 0.7107068705f; q = q * t + (-0.142248368f); q = q * t + 0.127414796f; q = q * t;
    const f32x2 s = (v * v) * (-0.72134752044f);
    f32x2 e; e.x = __builtin_amdgcn_exp2f(s.x); e.y = __builtin_amdgcn_exp2f(s.y);
    const f32x2 m = v * (q * e), r = v - m;
    f32x2 o; o.x = v.x < 0.f ? m.x : r.x; o.y = v.y < 0.f ? m.y : r.y; return o;
}
typedef int i32x8 __attribute__((ext_vector_type(8)));
typedef short s16x16 __attribute__((ext_vector_type(16)));
__host__ __device__ __forceinline__ size_t ablk8(int row, int col, int K) { return ((size_t)(row >> 8) * (K >> 7) + (col >> 7)) * 32768 + (size_t)(row & 255) * 128 + (col & 127); }
__device__ __forceinline__ unsigned pack_fp8x4(float a, float b, float c, float d) { int w = 0; w = __builtin_amdgcn_cvt_pk_fp8_f32(a, b, w, false); w = __builtin_amdgcn_cvt_pk_fp8_f32(c, d, w, true); return (unsigned)w; }
typedef float f32x16 __attribute__((ext_vector_type(16)));
typedef unsigned u32x6 __attribute__((ext_vector_type(6)));
__device__ __forceinline__ u32x6 mx6_pack(const float (&v)[32], unsigned& E) {
    float mx = 0.f;
#pragma unroll
    for (int i = 0; i < 32; ++i) mx = fmaxf(mx, fabsf(v[i]));
    const unsigned b = __float_as_uint(mx * (1.0f / 7.5f)); unsigned eb = (b >> 23) & 0xffu; if (b & 0x7fffffu) eb += 1u; eb = eb < 1u ? 1u : (eb > 254u ? 254u : eb);
    E = eb; const float s = __uint_as_float(eb << 23); f32x16 a, c;
#pragma unroll
    for (int i = 0; i < 16; ++i) { a[i] = v[i]; c[i] = v[16 + i]; }
    u32x6 d;
    asm volatile("s_nop 7\n\tv_cvt_scalef32_2xpk16_fp6_f32 %0, %1, %2, %3\n\ts_nop 7\n\ts_nop 7" : "=&v"(d) : "v"(a), "v"(c), "v"(s));
    return d;
}
__device__ __forceinline__ unsigned pack_i8x4(float a, float b, float c, float d) {
    const int q0 = min(max(__float2int_rn(a), -127), 127), q1 = min(max(__float2int_rn(b), -127), 127), q2 = min(max(__float2int_rn(c), -127), 127), q3 = min(max(__float2int_rn(d), -127), 127);
    return ((unsigned)q0 & 0xffu) | (((unsigned)q1 & 0xffu) << 8) | (((unsigned)q2 & 0xffu) << 16) | ((unsigned)q3 << 24);
}
__host__ __device__ __forceinline__ size_t ablk(int row, int col, int K) { return ((size_t)(row >> 8) * (K >> 6) + (col >> 6)) * 16384 + (size_t)(row & 255) * 64 + (col & 63); }
__host__ __device__ __forceinline__ size_t tb256(int row, int col, int nt) { return ((size_t)(row >> 8) * nt + (col >> 8)) * 65536 + (size_t)(row & 255) * 256 + (col & 255); }
__host__ __device__ __forceinline__ size_t tb128(int row, int col, int nt) { return ((size_t)(row >> 8) * nt + (col >> 7)) * 32768 + (size_t)(row & 255) * 128 + (col & 127); }
#define LAUNDER_V(x) asm volatile("" : "+v"(x))
#define LAUNDER_S(x) asm volatile("" : "+s"(x))
#define LDS_WAIT() asm volatile("s_waitcnt lgkmcnt(0)" ::: "memory")
#define VM_WAIT() asm volatile("s_waitcnt vmcnt(0)" ::: "memory")
#define MFMA16(a, b, c) __builtin_amdgcn_mfma_f32_16x16x32_bf16((a), (b), (c), 0, 0, 0)

#define XB_TMO      128
#define XB_XCNT(j)  (256  + 64 * (j))
#define XB_XSUB(j)  (1280 + 64 * (j))
#define XB_XGEN(j)  (2304 + 64 * (j))
#define XB_TOP      3328
#define XB_TOPGEN   3392
#define XCD_BAR_WORDS 3456
#define XB_SPIN_CAP (1u << 18)
__device__ __forceinline__ unsigned xb_ld(unsigned* p)              { return __hip_atomic_load(p, __ATOMIC_RELAXED, __HIP_MEMORY_SCOPE_AGENT); }
__device__ __forceinline__ unsigned xb_add(unsigned* p, unsigned v) { return __hip_atomic_fetch_add(p, v, __ATOMIC_RELAXED, __HIP_MEMORY_SCOPE_AGENT); }
__device__ __forceinline__ unsigned xb_xcc_id() { return (unsigned)__builtin_amdgcn_s_getreg((3 << 11) | 20) & 0xFu; }
#define XB_SPIN(cond, bar) do { unsigned _sp = 0; while (cond) { __builtin_amdgcn_s_sleep(1); \
    if ((++_sp & 255u) == 0u) { if (xb_ld(&(bar)[XB_TMO])) break; if (_sp > XB_SPIN_CAP) { atomicAdd(&(bar)[XB_TMO], 1u); break; } } } } while (0)
struct XcdBarrier { unsigned* bar; unsigned x; volatile LAS unsigned* st; };
__device__ __forceinline__ XcdBarrier xcd_barrier_post(unsigned* bar, volatile LAS unsigned* st) {
    XcdBarrier b; b.bar = bar; b.x = xb_xcc_id(); b.st = st;
    if (threadIdx.x == 0) (void)xb_add(&bar[XB_XCNT(b.x)], 1u);
    return b;
}
__device__ __forceinline__ void xcd_barrier_complete(unsigned* bar, unsigned x, unsigned& nloc, unsigned& nx) {
    const unsigned G = gridDim.x * gridDim.y * gridDim.z;
    unsigned sum, cnt, mine, sp = 0u;
    for (;;) {
        sum = 0u; cnt = 0u; mine = 0u;
#pragma unroll
        for (unsigned j = 0; j < 16; ++j) { const unsigned c = xb_ld(&bar[XB_XCNT(j)]); sum += c; cnt += (c > 0u) ? 1u : 0u; mine = (j == x) ? c : mine; }
        if (sum == G) break;
        __builtin_amdgcn_s_sleep(1);
        if ((++sp & 255u) == 0u) { if (xb_ld(&bar[XB_TMO])) break; if (sp > XB_SPIN_CAP) { atomicAdd(&bar[XB_TMO], 1u); break; } }
    }
    nloc = mine > 0u ? mine : 1u; nx = cnt > 0u ? cnt : 1u;
}
__device__ __forceinline__ void xcd_barrier(const XcdBarrier& b) {
    asm volatile("s_waitcnt vmcnt(0)" ::: "memory");
    __syncthreads();
    if (threadIdx.x == 0) {
        unsigned* bar = b.bar;
        __builtin_amdgcn_s_waitcnt(0);
        unsigned nloc = b.st[0], nx = b.st[1];
        if (nloc == 0u) { xcd_barrier_complete(bar, b.x, nloc, nx); b.st[0] = nloc; b.st[1] = nx; }
        const unsigned old = xb_add(&bar[XB_XSUB(b.x)], 1u);
        const unsigned gen = old / nloc;
        if (old + 1u == (gen + 1u) * nloc) {
            __builtin_amdgcn_fence(__ATOMIC_RELEASE, "agent");
            asm volatile("s_waitcnt vmcnt(0)" ::: "memory");
            const unsigned og = xb_add(&bar[XB_TOP], 1u);
            const unsigned tg = og / nx;
            if (og + 1u == (tg + 1u) * nx) xb_add(&bar[XB_TOPGEN], 1u);
            else XB_SPIN(xb_ld(&bar[XB_TOPGEN]) == tg, bar);
            __builtin_amdgcn_fence(__ATOMIC_ACQUIRE, "agent");
            xb_add(&bar[XB_XGEN(b.x)], 1u);
            asm volatile("s_waitcnt vmcnt(0)" ::: "memory");
        } else {
            XB_SPIN(xb_ld(&bar[XB_XGEN(b.x)]) == gen, bar);
            __builtin_amdgcn_fence(__ATOMIC_ACQUIRE, "agent");
            asm volatile("s_waitcnt vmcnt(0)" ::: "memory");
        }
    }
    __syncthreads();
}

#ifndef WGM_DEFAULT
#define WGM_DEFAULT 4
#endif
#ifndef DBG_F6_CONSTSCALE
#define DBG_F6_CONSTSCALE 0
#endif
#ifndef PG8_SADDR
#define PG8_SADDR 1
#endif
namespace pg8 {
constexpr int BM = 256, BK = 64, HALF = 128, HTB = HALF * BK * 2, STAGE_BYTES = 8 * HTB, NXCD = 8, WGM = WGM_DEFAULT;
__host__ __device__ __forceinline__ int lds_byte(int r, int c) { const int st = (r >> 4) * 2 + (c >> 5), rr = r & 15, cc = c & 31, ob = rr * 64 + cc * 2; return st * 1024 + (ob ^ (((ob >> 9) & 1) << 5)); }
__host__ __device__ __forceinline__ void stage_rc(int b, int& R, int& C) { const int st = b / 1024, sb = b % 1024, swz = sb ^ (((sb >> 9) & 1) << 5); R = (st >> 1) * 16 + swz / 64; C = (st & 1) * 32 + (swz % 64) / 2; }
__host__ __device__ __forceinline__ int perm32(int rho) { const int n = rho >> 4, i = rho & 15; return 8 * (i >> 2) + 4 * n + (i & 3); }

struct Unit { int pm, pn, seg; };

struct TileOrder {
    int nM, nN, nwg, G, c, wgm, rot, tailtile, pnoff;
    __device__ __forceinline__ void init(int nM_, int nN_, int G_, int c_, int wgm_ = WGM, int rot_ = 0, int tailtile_ = -1, int pnoff_ = 0) { nM = nM_; nN = nN_; nwg = nM * nN; G = G_; c = c_; wgm = wgm_; rot = rot_; tailtile = tailtile_; pnoff = pnoff_; }
    __device__ __forceinline__ bool tile(int i, int& pm, int& pn) const {
        const long L = (long)i * G + c; if (L >= nwg) return false;
        int wgid = (int)L; const int xcd = wgid % NXCD; { const int q = nwg / NXCD, r = nwg % NXCD, off = wgid / NXCD; wgid = (xcd < r ? xcd * (q + 1) : r * (q + 1) + (xcd - r) * q) + off; }
        const int nig = wgm * nN, gid = wgid / nig, fm = gid * wgm, gsz = (nM - fm) < wgm ? (nM - fm) : wgm;
        pm = fm + ((wgid % nig) % gsz); pn = (wgid % nig) / gsz; if (rot) { pn += rot * xcd; pn -= (pn / nN) * nN; } if (tailtile >= 0 && pn == nN - 1) pn = tailtile; pn += pnoff; return true;
    }
};
struct SchedPlain {
    TileOrder T; const gchar* A; const gchar* B; size_t astep, bstep;
    __device__ __forceinline__ bool next(int i, Unit& u) const { u.seg = 0; return T.tile(i, u.pm, u.pn); }
    __device__ __forceinline__ const gchar* a_ptr(const Unit& u) const { return A + (size_t)u.pm * astep; }
    int pn0 = 0;
    __device__ __forceinline__ const gchar* b_ptr(const Unit& u) const { return B + (size_t)(u.pn - pn0) * bstep; }
};
struct SchedBranch {
    TileOrder T; const gchar* A; const gchar* B; size_t astep, bstep, aseg, bseg;
    __device__ __forceinline__ bool next(int i, Unit& u) const { const int t = i / 3; u.seg = i - 3 * t; return T.tile(t, u.pm, u.pn); }
    __device__ __forceinline__ const gchar* a_ptr(const Unit& u) const { return A + (size_t)u.seg * aseg + (size_t)u.pm * astep; }
    __device__ __forceinline__ const gchar* b_ptr(const Unit& u) const { return B + (size_t)u.seg * bseg + (size_t)u.pn * bstep; }
};

template <class Epi, class Sched>
__device__ __forceinline__ void gemm_phase(LAS unsigned char* lds, const int K, const int lda, const int ldb, const Sched& S, const Epi& E, unsigned* lockctr = nullptr, const int nlock = 0) {
    int tid = threadIdx.x; LAUNDER_V(tid);
    const int wid = __builtin_amdgcn_readfirstlane(tid >> 6), lane = tid & 63, wr = wid >> 2, wc = wid & 3, fr = lane & 15, fq = lane >> 4;
    const int nt = K / BK;
    unsigned voffA, voffB;
    { int R, C; stage_rc(tid * 16, R, C); const int Rb = Epi::PERM ? ((R & ~31) + perm32(R & 31)) : R;
      voffA = (unsigned)(R * BK + C) * 2u; voffB = (unsigned)(Rb * BK + C) * 2u; }
    const unsigned qstepA = 64u * (unsigned)BK * 2u, qstepB = 64u * (unsigned)BK * 2u;
    const size_t kstep = (size_t)BM * BK * 2, kstepB = (size_t)BM * BK * 2;
    const size_t hstepA = (size_t)HALF * BK * 2, hstepB = (size_t)HALF * BK * 2;
    const unsigned ldsw = (unsigned)wid * 1024u;
    const int aoff = lds_byte(wr * 64 + fr, fq * 8), boff = lds_byte(wc * 32 + fr, fq * 8);
#define PG8_SA(b, h) (((b) * 2 + (h)) * HTB)
#define PG8_SB(b, h) ((4 + (b) * 2 + (h)) * HTB)
#if PG8_SADDR
#define PG8_STAGE(bufoff, gbase, voff) do { _Pragma("unroll") for (int _i = 0; _i < 2; ++_i) { const gchar* p_ = (const gchar*)(gbase) + (size_t)_i * q##voff; asm volatile("" : "+s"(p_)); \
        __builtin_amdgcn_global_load_lds((const gunsigned*)(p_ + (voff)), (LAS unsigned*)(lds + (bufoff) + ldsw + _i * 8192), 16, 0, 0); } } while (0)
#else
#define PG8_STAGE(bufoff, gbase, voff) do { _Pragma("unroll") for (int _i = 0; _i < 2; ++_i) \
        __builtin_amdgcn_global_load_lds((const gunsigned*)((const gchar*)(gbase) + (size_t)_i * q##voff + (voff)), (LAS unsigned*)(lds + (bufoff) + ldsw + _i * 8192), 16, 0, 0); } while (0)
#endif
#define qvoffA qstepA
#define qvoffB qstepB
#define PG8_LDA(dst, b, h) do { _Pragma("unroll") for (int m = 0; m < 4; ++m) _Pragma("unroll") for (int k = 0; k < 2; ++k) dst[m][k] = *(const LAS bf16x8*)(lds + PG8_SA(b, h) + aoff + m * 2048 + k * 1024); } while (0)
#define PG8_LDB(dst, b, h) do { _Pragma("unroll") for (int n = 0; n < 2; ++n) _Pragma("unroll") for (int k = 0; k < 2; ++k) dst[n][k] = *(const LAS bf16x8*)(lds + PG8_SB(b, h) + boff + n * 2048 + k * 1024); } while (0)
#define PG8_CAT(x_, y_) __builtin_bit_cast(i32x8, __builtin_shufflevector((x_), (y_), 0, 1, 2, 3, 4, 5, 6, 7, 8, 9, 10, 11, 12, 13, 14, 15))
#define PG8_MMA(ai, bj, At, Bt) do { __builtin_amdgcn_s_setprio(1); _Pragma("unroll") for (int m = 0; m < 4; ++m) _Pragma("unroll") for (int n = 0; n < 2; ++n) { \
        if constexpr (Epi::FP8) { const i32x8 b8_ = PG8_CAT(Bt[n][0], Bt[n][1]), a8_ = PG8_CAT(At[m][0], At[m][1]); \
            asm volatile("s_nop 1\n\tv_mfma_scale_f32_16x16x128_f8f6f4 %0, %1, %2, %0, %3, %3 op_sel_hi:[0,0,0]" : "+v"(acc[ai][bj][m][n]) : "v"(b8_), "v"(a8_), "v"(sc8)); } \
        else if constexpr (Epi::F6) { const i32x8 b8_ = PG8_CAT(Bt[n][0], Bt[n][1]), a8_ = PG8_CAT(At[m][0], At[m][1]); const int sb_ = DBG_F6_CONSTSCALE ? sc8 : b8_[6], sa_ = DBG_F6_CONSTSCALE ? sc8 : a8_[6]; typedef int i32x6_ __attribute__((ext_vector_type(6))); \
            const i32x6_ b6_ = __builtin_shufflevector(b8_, b8_, 0, 1, 2, 3, 4, 5), a6_ = __builtin_shufflevector(a8_, a8_, 0, 1, 2, 3, 4, 5); \
            asm volatile("s_nop 3\n\tv_mfma_scale_f32_16x16x128_f8f6f4 %0, %1, %2, %0, %3, %4 op_sel_hi:[0,0,0] cbsz:2 blgp:2" : "+v"(acc[ai][bj][m][n]) : "v"(b6_), "v"(a6_), "v"(sb_), "v"(sa_)); } \
        else if constexpr (Epi::I8) { _Pragma("unroll") for (int k = 0; k < 2; ++k) asm volatile("s_nop 1\n\tv_mfma_i32_16x16x64_i8 %0, %1, %2, %0" : "+v"(acc[ai][bj][m][n]) : "v"(Bt[n][k]), "v"(At[m][k])); } \
        else { _Pragma("unroll") for (int k = 0; k < 2; ++k) acc[ai][bj][m][n] = __builtin_amdgcn_mfma_f32_16x16x32_bf16(Bt[n][k], At[m][k], acc[ai][bj][m][n], 0, 0, 0); } } __builtin_amdgcn_s_setprio(0); } while (0)
#define PG8_WAIT_V(n) asm volatile("s_waitcnt vmcnt(" #n ")" ::: "memory")
#define PG8_WAIT_VR() do { if constexpr (Epi::NS == 16) asm volatile("s_waitcnt vmcnt(24)" ::: "memory"); else if constexpr (Epi::NS == 32) asm volatile("s_waitcnt vmcnt(40)" ::: "memory"); else asm volatile("s_waitcnt vmcnt(8)" ::: "memory"); } while (0)
#define PG8_WAIT_L(n) asm volatile("s_waitcnt lgkmcnt(" #n ")" ::: "memory")
#define PG8_BAR __builtin_amdgcn_s_barrier()
#define PG8_SCHED __builtin_amdgcn_sched_barrier(0)
    Unit cur, nxt; int ui = 0; bool relax_next = false;
    int sc8 = 0x7f7f7f7f; asm volatile("" : "+v"(sc8));
    if (!S.next(0, cur)) return;
    f32x4 acc[2][2][4][2];
#pragma unroll
    for (int a = 0; a < 2; ++a)
#pragma unroll
        for (int b = 0; b < 2; ++b)
#pragma unroll
            for (int m = 0; m < 4; ++m)
#pragma unroll
                for (int n = 0; n < 2; ++n) acc[a][b][m][n] = (f32x4){0.f, 0.f, 0.f, 0.f};
    bf16x8 At[4][2], B0[2][2], B1[2][2];
    const gchar* cA = S.a_ptr(cur); const gchar* cB = S.b_ptr(cur);
    PG8_STAGE(PG8_SB(0, 0), cB, voffB); PG8_STAGE(PG8_SB(0, 1), cB + hstepB, voffB); PG8_STAGE(PG8_SA(0, 0), cA, voffA); PG8_STAGE(PG8_SA(0, 1), cA + hstepA, voffA);
    if (wr == 1) PG8_BAR;
    PG8_WAIT_V(2); PG8_BAR;
    PG8_STAGE(PG8_SB(1, 0), cB + kstepB, voffB); PG8_STAGE(PG8_SA(1, 0), cA + kstep, voffA); PG8_STAGE(PG8_SB(1, 1), cB + hstepB + kstepB, voffB);
    PG8_WAIT_V(6); PG8_BAR;
    for (;;) {
        const bool has_next = S.next(ui + 1, nxt);
        const gchar* nA = has_next ? S.a_ptr(nxt) : cA; const gchar* nB = has_next ? S.b_ptr(nxt) : cB;
        for (int t = 0; t < nt; t += 2) {
            const bool last = (t == nt - 2); const bool relax = Epi::NS > 0 && (t == 0) && relax_next;
#if PG8_SADDR
            asm volatile("" : "+v"(voffA), "+v"(voffB));
#endif
            const gchar* a1 = cA + (size_t)(t + 1) * kstep;
            const gchar* a2 = last ? nA : cA + (size_t)(t + 2) * kstep; const gchar* b2 = last ? nB : cB + (size_t)(t + 2) * kstepB;
            const gchar* a3 = a2 + kstep; const gchar* b3 = b2 + kstepB;
            PG8_LDB(B0, 0, 0); PG8_LDB(B1, 0, 1); PG8_SCHED; PG8_LDA(At, 0, 0); PG8_STAGE(PG8_SA(1, 1), a1 + hstepA, voffA);
            if (relax) PG8_WAIT_VR(); else PG8_WAIT_V(8); PG8_WAIT_L(0); PG8_BAR; PG8_MMA(0, 0, At, B0); PG8_MMA(0, 1, At, B1); PG8_BAR; PG8_SCHED;
            PG8_LDA(At, 0, 1); PG8_STAGE(PG8_SB(0, 0), b2, voffB); PG8_STAGE(PG8_SB(0, 1), b2 + hstepB, voffB); PG8_STAGE(PG8_SA(0, 0), a2, voffA);
            if (relax) PG8_WAIT_VR(); else PG8_WAIT_V(8); PG8_WAIT_L(0); PG8_BAR; PG8_MMA(1, 0, At, B0); PG8_MMA(1, 1, At, B1); PG8_BAR; PG8_SCHED;
            PG8_LDB(B0, 1, 0); PG8_LDB(B1, 1, 1); PG8_SCHED; PG8_LDA(At, 1, 0); PG8_STAGE(PG8_SA(0, 1), a2 + hstepA, voffA);
            PG8_WAIT_V(8); PG8_WAIT_L(0); PG8_BAR; PG8_MMA(0, 0, At, B0); PG8_MMA(0, 1, At, B1); PG8_BAR; PG8_SCHED;
            PG8_LDA(At, 1, 1); PG8_STAGE(PG8_SB(1, 0), b3, voffB); PG8_STAGE(PG8_SB(1, 1), b3 + hstepB, voffB); PG8_STAGE(PG8_SA(1, 0), a3, voffA);
            PG8_WAIT_V(8); PG8_WAIT_L(0); PG8_BAR; PG8_MMA(1, 0, At, B0); PG8_MMA(1, 1, At, B1); PG8_BAR; PG8_SCHED;
        }
        if constexpr (Epi::FP8 || Epi::I8 || Epi::F6) asm volatile("s_nop 15\n\ts_nop 15\n\ts_nop 15\n\ts_nop 15" ::: "memory");
        if (wr == 0) PG8_BAR;
        { const int ln_ = (int)__builtin_amdgcn_mbcnt_hi(~0u, __builtin_amdgcn_mbcnt_lo(~0u, 0u)); E(acc, cur, wr, wc, ln_ & 15, ln_ >> 4); } relax_next = E.relax(cur);
        if (ui < nlock) {
            if (tid == 0) { (void)xb_add(lockctr, 1u); const unsigned tgt_ = (unsigned)(ui + 1) * (unsigned)S.T.G; unsigned sp_ = 0u; while (xb_ld(lockctr) < tgt_) { __builtin_amdgcn_s_sleep(1); if (++sp_ > (1u << 20)) break; } }
            PG8_BAR; }
        if (!has_next) break;
        if (!E.keep(cur)) {
#pragma unroll
            for (int a = 0; a < 2; ++a)
#pragma unroll
                for (int b = 0; b < 2; ++b)
#pragma unroll
                    for (int m = 0; m < 4; ++m)
#pragma unroll
                        for (int n = 0; n < 2; ++n) acc[a][b][m][n] = (f32x4){0.f, 0.f, 0.f, 0.f};
        }
        cur = nxt; cA = nA; cB = nB; ++ui;
        if (wr == 1) PG8_BAR;
    }
    PG8_WAIT_V(0);
    PG8_BAR;
#undef PG8_SA
#undef PG8_SB
#undef PG8_STAGE
#undef qvoffA
#undef qvoffB
#undef PG8_LDA
#undef PG8_LDB
#undef PG8_MMA
#undef PG8_CAT
#undef PG8_WAIT_V
#undef PG8_WAIT_VR
#undef PG8_WAIT_L
#undef PG8_BAR
#undef PG8_SCHED
}
}

constexpr size_t MiB = 1u << 20;
constexpr size_t WS_CTL = 0, CTL_ZERO_BYTES = 1 * MiB;
constexpr int CW_BAR = 4096;
constexpr size_t CTL_SSQ1 = 256 * 1024;
constexpr size_t SZ_WIN = (size_t)N_IN_T * DM * 2, SZ_WBR = (size_t)3 * DM * BW * 2, SZ_WSQ = (size_t)DM * DM * 2, SZ_WPP = (size_t)DM * 256 * 2;
constexpr size_t WS_WIN = 2 * MiB;
constexpr size_t WS_WBR = WS_WIN + 2 * SZ_WIN;
constexpr size_t WS_WOUT = WS_WBR + 2 * SZ_WBR;
constexpr size_t WS_WPG = WS_WOUT + 2 * SZ_WSQ;
constexpr size_t WS_WPP = WS_WPG + 2 * SZ_WSQ;
constexpr size_t SZ_ROWS_BW = (size_t)M_ROWS * BW * 2, SZ_ROWS_D = (size_t)M_ROWS * DM * 2;
constexpr size_t WS_XB = WS_WPP + 2 * SZ_WPP;
constexpr size_t WS_PB = WS_XB + SZ_ROWS_D;
constexpr size_t WS_CS = WS_PB + (size_t)2 * M_ROWS * 256 * 2;
constexpr size_t WS_SSQ0 = WS_CS + (size_t)M_ROWS * 16 * 4;
constexpr size_t WS_AU = WS_SSQ0 + (size_t)M_ROWS * 4;
constexpr size_t WS_AV = WS_AU + SZ_ROWS_BW, WS_AZ = WS_AV + SZ_ROWS_BW, WS_BQ = WS_AZ + SZ_ROWS_BW;
constexpr size_t WS_BK = WS_BQ + SZ_ROWS_BW;
constexpr size_t WS_BV = WS_BK + (size_t)M_ROWS * 256 * 2;
constexpr size_t WS_BZ = WS_BV + (size_t)M_ROWS * 256 * 2;
constexpr size_t WS_CQ = WS_BZ + SZ_ROWS_BW;
constexpr size_t WS_CK = WS_CQ + (size_t)M_ROWS * 1024 * 2;
constexpr size_t WS_CV = WS_CK + (size_t)M_ROWS * 1024 * 2;
constexpr size_t WS_CO = WS_CV + SZ_ROWS_BW, WS_CZ = WS_CO + SZ_ROWS_BW;
constexpr size_t WS_G = WS_CZ + SZ_ROWS_BW;
constexpr size_t WS_IF = WS_G + (size_t)M_ROWS * 12288 * 2;
constexpr size_t WS_LNP = WS_IF + (size_t)M_ROWS * 8 * 4;
constexpr size_t WS_YA = WS_LNP + (size_t)M_ROWS * 32 * 8;
constexpr size_t WS_NUM = WS_YA + 3 * SZ_ROWS_BW;
constexpr size_t WS_SSQC = WS_NUM + SZ_ROWS_BW;
constexpr size_t WS_DN = WS_SSQC + (size_t)M_ROWS * 64 * 4;
constexpr size_t WS_MIX = WS_DN + (size_t)M_ROWS * 4 * 4;
constexpr size_t WS_OUT = WS_MIX + SZ_ROWS_D;
constexpr size_t WS_OUTP = WS_OUT + SZ_ROWS_D;
constexpr size_t WS_ERAW = WS_OUTP + (size_t)M_ROWS * 64 * 4;
constexpr size_t WS_ERP = WS_ERAW + SZ_ROWS_D;
constexpr size_t WS_RSO = WS_ERP + (size_t)M_ROWS * 64 * 4;
constexpr size_t WS_RSE = WS_RSO + (size_t)M_ROWS * 4;
constexpr size_t WS_X1B = WS_RSE + (size_t)M_ROWS * 4;
constexpr size_t WS_XSP = WS_X1B + SZ_ROWS_D;
constexpr size_t WS_X1B8 = WS_XSP + (size_t)M_ROWS * 64 * 4;
constexpr size_t WS_RSX = WS_X1B8 + (size_t)M_ROWS * DM;
constexpr size_t WS_XB8 = WS_RSX + (size_t)M_ROWS * 4;
constexpr size_t SZ_WG8 = (size_t)56 * 256 * DM;
constexpr size_t WS_WG8 = WS_XB8 + (size_t)M_ROWS * DM;
constexpr size_t WS_END = WS_WG8 + 2 * SZ_WG8;
static_assert(WS_WIN % 256 == 0 && WS_XB % 256 == 0 && WS_AU % 256 == 0 && WS_G % 256 == 0 && WS_YA % 256 == 0 && WS_MIX % 256 == 0 && WS_X1B % 256 == 0, "alignment");

#ifndef EPIIN_NT
#define EPIIN_NT 0
#endif
#if EPIIN_NT
#define EPIIN_STORE(v, p) __builtin_nontemporal_store((v), (p))
#else
#define EPIIN_STORE(v, p) (*(p) = (v))
#endif
#ifndef DBG_ZERO_ASC
#define DBG_ZERO_ASC 0
#endif
#ifndef DBG_F6_AS_FP8
#define DBG_F6_AS_FP8 0
#endif
#ifndef P1G_F6
#define P1G_F6 1
#endif
#ifndef P1G_FP8
#define P1G_FP8 1
#endif
#ifndef P5_I8
#define P5_I8 1
#endif
constexpr int CW_WMAX = 512;
#ifndef P5_FP8
#define P5_FP8 0
#endif
constexpr float W8_SCALE = 256.0f;
#ifndef EPI_NS16
#define EPI_NS16 0
#endif
#ifndef EPI_NS32
#define EPI_NS32 0
#endif
#ifndef EPIIN_NS
#define EPIIN_NS 0
#endif
namespace pg8 {
__device__ __forceinline__ unsigned pack_u8x4(float a, float b, float c, float d) {
    const unsigned q0 = (unsigned)(a * 255.0f + 0.5f), q1 = (unsigned)(b * 255.0f + 0.5f), q2 = (unsigned)(c * 255.0f + 0.5f), q3 = (unsigned)(d * 255.0f + 0.5f);
    return q0 | (q1 << 8) | (q2 << 16) | (q3 << 24);
}
template <bool F8> struct EpiInT {
    static constexpr bool PERM = true; static constexpr int NS = EPIIN_NS; static constexpr bool FP8 = F8 && (!P1G_F6 || DBG_F6_AS_FP8); static constexpr bool I8 = false; static constexpr bool F6 = F8 && P1G_F6 && !DBG_F6_AS_FP8;
    __device__ __forceinline__ bool relax(const Unit& u) const { return u.pn < 122; }
    const gfloat* ssq; guchar* ws; const LAS float* rtab; int rowbase;
    __device__ __forceinline__ float rstd_of(int row) const { return rowbase >= 0 ? rtab[row - rowbase] : rsqrtf(ssq[row] * (1.0f / DM) + NORM_EPS); }
    __device__ __forceinline__ bool keep(const Unit&) const { return false; }
    __device__ __forceinline__ void operator()(f32x4 (&acc)[2][2][4][2], const Unit& u, int wr, int wc, int fr, int fq) const {
        const int pn = u.pn; const int row0 = u.pm * BM + wr * 64 + fr;
        size_t off; int ldc, t0, act; float sc = 1.f;
        if (F8)            { if (pn < 122) { off = WS_G; ldc = 12288; t0 = 74; act = 3; } else { off = WS_CO; ldc = 2048; t0 = 122; act = 8; } sc = P1G_F6 ? 1.0f : 1.0f / W8_SCALE; }
        else if (pn < 16)  { off = WS_AU; ldc = 2048; t0 = 0; act = 6; }
        else if (pn < 24)  { off = WS_AV; ldc = 2048; t0 = 16; act = 5; }
        else if (pn < 32)  { off = WS_BQ; ldc = 2048; t0 = 24; act = 0; }
        else if (pn < 33)  { off = WS_BK; ldc = 256; t0 = 32; act = 0; }
        else if (pn < 34)  { off = WS_BV; ldc = 256; t0 = 33; act = 0; }
        else if (pn < 42)  { off = WS_BZ; ldc = 2048; t0 = 34; act = 2; }
        else if (pn < 46)  { off = WS_CQ; ldc = 1024; t0 = 42; act = 0; sc = 0.0625f; }
        else if (pn < 50)  { off = WS_CK; ldc = 1024; t0 = 46; act = 0; }
        else if (pn < 58)  { off = WS_CV; ldc = 2048; t0 = 50; act = 0; }
        else if (pn < 66)  { off = WS_CZ; ldc = 2048; t0 = 58; act = 2; }
        else               { off = WS_IF; ldc = 8; t0 = 122; act = 4; }
        const int col0 = (pn - t0) * BM + wc * 32 + 8 * fq;
        if (!F8 && act == 4) {
            if (wc == 0 && fq == 0) {
                gfloat* dst = (gfloat*)(ws + off);
#pragma unroll
                for (int ai = 0; ai < 2; ++ai)
#pragma unroll
                    for (int m = 0; m < 4; ++m) { const int row = row0 + ai * HALF + m * 16; const float rs = rstd_of(row);
                        *(gf32x4*)(dst + (size_t)row * 8) = acc[ai][0][m][0] * rs; *(gf32x4*)(dst + (size_t)row * 8 + 4) = acc[ai][0][m][1] * rs; }
            }
            return;
        }
        gbf16* base = (gbf16*)(ws + off);
        if (!F8 && (act == 6 || act == 7)) {
            const int colp = (pn - t0) * HALF + wc * 32 + 8 * fq;
#pragma unroll
            for (int ai = 0; ai < 2; ++ai)
#pragma unroll
                for (int m = 0; m < 4; ++m) {
                    const int row = row0 + ai * HALF + m * 16; const float rs = rstd_of(row);
                    f32x4 a0 = acc[ai][0][m][0] * rs, a1 = acc[ai][0][m][1] * rs; const f32x4 z0 = acc[ai][1][m][0] * rs, z1 = acc[ai][1][m][1] * rs;
                    if (act == 6) { const f32x2 a = gelu_pk((f32x2){a0[0], a0[1]}), b = gelu_pk((f32x2){a0[2], a0[3]}), c = gelu_pk((f32x2){a1[0], a1[1]}), d = gelu_pk((f32x2){a1[2], a1[3]});
                        a0 = (f32x4){a.x, a.y, b.x, b.y}; a1 = (f32x4){c.x, c.y, d.x, d.y}; }
                    else {
#pragma unroll
                        for (int j = 0; j < 4; ++j) { a0[j] = fsigmoid(a0[j]); a1[j] = fsigmoid(a1[j]); } }
#pragma unroll
                    for (int j = 0; j < 4; ++j) { a0[j] *= z0[j] * fsigmoid(z0[j]); a1[j] *= z1[j] * fsigmoid(z1[j]); }
                    u32x4 w; w.x = cvt_pk_bf16(a0[0], a0[1]); w.y = cvt_pk_bf16(a0[2], a0[3]); w.z = cvt_pk_bf16(a1[0], a1[1]); w.w = cvt_pk_bf16(a1[2], a1[3]);
                    *(gu32x4*)(base + tb128(row, colp, 16)) = w;
                }
            return;
        }
#pragma unroll
        for (int ai = 0; ai < 2; ++ai)
#pragma unroll
            for (int m = 0; m < 4; ++m) {
                const int row = row0 + ai * HALF + m * 16; const float rs = rstd_of(row) * sc;
                gbf16* rowp = base + tb256(row, col0, ldc >> 8); float ls = 0.f, lq = 0.f; u32x2 g8[2] = {{0u, 0u}, {0u, 0u}};
#pragma unroll
                for (int bj = 0; bj < 2; ++bj) {
                    f32x4 v0 = acc[ai][bj][m][0] * rs, v1 = acc[ai][bj][m][1] * rs;
                    if (!F8 && act == 5) {
                        f32x2 a = gelu_pk((f32x2){v0[0], v0[1]}), b = gelu_pk((f32x2){v0[2], v0[3]}), c = gelu_pk((f32x2){v1[0], v1[1]}), d = gelu_pk((f32x2){v1[2], v1[3]});
                        v0 = (f32x4){a.x, a.y, b.x, b.y}; v1 = (f32x4){c.x, c.y, d.x, d.y};
                        { ls += (v0[0] + v0[1]) + (v0[2] + v0[3]) + (v1[0] + v1[1]) + (v1[2] + v1[3]);
                            lq += (v0[0] * v0[0] + v0[1] * v0[1]) + (v0[2] * v0[2] + v0[3] * v0[3]) + (v1[0] * v1[0] + v1[1] * v1[1]) + (v1[2] * v1[2] + v1[3] * v1[3]); }
                    } else if (!F8 && act == 2) {
#pragma unroll
                        for (int j = 0; j < 4; ++j) { v0[j] = v0[j] * fsigmoid(v0[j]); v1[j] = v1[j] * fsigmoid(v1[j]); }
                    } else if (F8 && (act == 3 || act == 8)) {
#pragma unroll
                        for (int j = 0; j < 4; ++j) { v0[j] = fsigmoid(v0[j]); v1[j] = fsigmoid(v1[j]); }
                    }
                    if (F8 && act == 3) {
                        g8[bj].x = pack_u8x4(v0[0], v0[1], v0[2], v0[3]); g8[bj].y = pack_u8x4(v1[0], v1[1], v1[2], v1[3]);
                    } else {
                    u32x4 w; w.x = cvt_pk_bf16(v0[0], v0[1]); w.y = cvt_pk_bf16(v0[2], v0[3]); w.z = cvt_pk_bf16(v1[0], v1[1]); w.w = cvt_pk_bf16(v1[2], v1[3]);
                    EPIIN_STORE(w, (gu32x4*)(rowp + bj * HALF)); }
                }
                if (F8 && act == 3) {
                    typedef unsigned u32x2v_ __attribute__((ext_vector_type(2)));
                    const u32x2v_ r0 = __builtin_amdgcn_permlane16_swap(g8[0].x, g8[1].x, false, false), r1 = __builtin_amdgcn_permlane16_swap(g8[0].y, g8[1].y, false, false);
                    const u32x4 w16 = {r0.x, r1.x, r0.y, r1.y};
                    *(gu32x4*)(ws + WS_G + ((size_t)(u.pm * 48 + (pn - 74)) * 256 + (row & 255)) * 256 + (wc * 32 + 8 * (fq & ~1)) + (fq & 1) * HALF) = w16;
                }
                if (!F8 && act == 5) {
                    ls += __shfl_xor(ls, 16); ls += __shfl_xor(ls, 32); lq += __shfl_xor(lq, 16); lq += __shfl_xor(lq, 32);
                    if (fq == 0) *(gf32x2*)(ws + WS_LNP + ((size_t)row * 32 + (pn - 16) * 4 + wc) * 8) = (f32x2){ls, lq};
                }
            }
    }
};
using EpiIn = EpiInT<false>;
struct EpiBranch {
    static constexpr bool PERM = true; static constexpr int NS = EPI_NS16; static constexpr bool FP8 = false; static constexpr bool I8 = false; static constexpr bool F6 = false;
    __device__ __forceinline__ bool relax(const Unit& u) const { return u.seg == 2; }
    const guchar* G; gbf16* MIX;
    __device__ __forceinline__ bool keep(const Unit& u) const { return u.seg != 2; }
    __device__ __forceinline__ void operator()(f32x4 (&acc)[2][2][4][2], const Unit& u, int wr, int wc, int fr, int fq) const {
        const int row0 = u.pm * BM + wr * 64 + fr, col0 = u.pn * BM + wc * 32 + 8 * fq; const int seg = u.seg;
        u32x2 ga[2][4][2], gb[2][4][2];
#pragma unroll
        for (int ai = 0; ai < 2; ++ai)
#pragma unroll
            for (int m = 0; m < 4; ++m) {
                const int row = row0 + ai * HALF + m * 16; const guchar* gp = G + ((size_t)(u.pm * 48 + seg * 16 + u.pn) * 256 + (row & 255)) * 256 + (wc * 32 + 8 * fq);
#pragma unroll
                for (int bj = 0; bj < 2; ++bj) { ga[ai][m][bj] = *(const gu32x2*)(gp + bj * HALF); gb[ai][m][bj] = (seg != 2) ? *(const gu32x2*)(gp + (size_t)16 * 65536 + bj * HALF) : (u32x2){255u * 0x01010101u, 255u * 0x01010101u}; }
            }
#pragma unroll
        for (int ai = 0; ai < 2; ++ai)
#pragma unroll
            for (int m = 0; m < 4; ++m) {
                const int row = row0 + ai * HALF + m * 16;
#pragma unroll
                for (int bj = 0; bj < 2; ++bj) {
                    const u32x2 a_ = ga[ai][m][bj], b_ = gb[ai][m][bj];
                    float f[8] = {(float)((a_.x >> (8 * 0)) & 0xffu), (float)((a_.x >> (8 * 1)) & 0xffu), (float)((a_.x >> (8 * 2)) & 0xffu), (float)((a_.x >> (8 * 3)) & 0xffu),
                                  (float)((a_.y >> (8 * 0)) & 0xffu), (float)((a_.y >> (8 * 1)) & 0xffu), (float)((a_.y >> (8 * 2)) & 0xffu), (float)((a_.y >> (8 * 3)) & 0xffu)};
                    const float h[8] = {(float)((b_.x >> (8 * 0)) & 0xffu), (float)((b_.x >> (8 * 1)) & 0xffu), (float)((b_.x >> (8 * 2)) & 0xffu), (float)((b_.x >> (8 * 3)) & 0xffu),
                                        (float)((b_.y >> (8 * 0)) & 0xffu), (float)((b_.y >> (8 * 1)) & 0xffu), (float)((b_.y >> (8 * 2)) & 0xffu), (float)((b_.y >> (8 * 3)) & 0xffu)};
#pragma unroll
                    for (int j = 0; j < 8; ++j) f[j] = fmaxf(f[j], 1e-18f) * __builtin_amdgcn_rcpf(fmaxf(h[j], 1e-18f));
                    f32x4 v0 = acc[ai][bj][m][0], v1 = acc[ai][bj][m][1];
                    v0 = v0 * (f32x4){f[0], f[1], f[2], f[3]}; v1 = v1 * (f32x4){f[4], f[5], f[6], f[7]};
                    if (seg != 2) { acc[ai][bj][m][0] = v0; acc[ai][bj][m][1] = v1; }
                    else { u32x4 w; w.x = cvt_pk_bf16(v0[0], v0[1]); w.y = cvt_pk_bf16(v0[2], v0[3]); w.z = cvt_pk_bf16(v1[0], v1[1]); w.w = cvt_pk_bf16(v1[2], v1[3]);
                        *(gu32x4*)(MIX + ablk(row, col0 + bj * HALF, DM)) = w; }
                }
            }
    }
};
struct EpiSq {
    static constexpr bool PERM = true; static constexpr int NS = EPI_NS16; static constexpr bool FP8 = false; static constexpr bool I8 = false; static constexpr bool F6 = false;
    __device__ __forceinline__ bool relax(const Unit&) const { return true; }
    gbf16* O; gfloat* P;
    __device__ __forceinline__ bool keep(const Unit&) const { return false; }
    __device__ __forceinline__ void operator()(f32x4 (&acc)[2][2][4][2], const Unit& u, int wr, int wc, int fr, int fq) const {
        const int row0 = u.pm * BM + wr * 64 + fr, col0 = u.pn * BM + wc * 32 + 8 * fq;
#pragma unroll
        for (int ai = 0; ai < 2; ++ai)
#pragma unroll
            for (int m = 0; m < 4; ++m) {
                const int row = row0 + ai * HALF + m * 16; float q = 0.f;
#pragma unroll
                for (int bj = 0; bj < 2; ++bj) {
                    const f32x4 v0 = acc[ai][bj][m][0], v1 = acc[ai][bj][m][1];
                    q += (v0[0] * v0[0] + v0[1] * v0[1]) + (v0[2] * v0[2] + v0[3] * v0[3]) + (v1[0] * v1[0] + v1[1] * v1[1]) + (v1[2] * v1[2] + v1[3] * v1[3]);
                    u32x4 w; w.x = cvt_pk_bf16(v0[0], v0[1]); w.y = cvt_pk_bf16(v0[2], v0[3]); w.z = cvt_pk_bf16(v1[0], v1[1]); w.w = cvt_pk_bf16(v1[2], v1[3]);
                    if (O) *(gu32x4*)(O + (size_t)row * DM + col0 + bj * HALF) = w; else asm volatile("" :: "v"(w));
                }
                q += __shfl_xor(q, 16); q += __shfl_xor(q, 32);
                if (fq == 0) P[(size_t)row * 64 + u.pn * 4 + wc] = q;
            }
    }
};
struct EpiPle {
    static constexpr bool PERM = true; static constexpr int NS = EPI_NS32; static constexpr bool FP8 = P5_FP8 != 0; static constexpr bool I8 = P5_I8 != 0; static constexpr bool F6 = false;
    __device__ __forceinline__ bool relax(const Unit&) const { return true; }
    const gbf16* X1B; gfloat* XOUT; gbf16* XB; const gbf16* ERAW; const gfloat* RSE; const gfloat* pnorm; gfloat* SSQN; int last; guchar* XB8; const gfloat* RSX; float swq;
    __device__ __forceinline__ bool keep(const Unit&) const { return false; }
    __device__ __forceinline__ void operator()(f32x4 (&acc)[2][2][4][2], const Unit& u, int wr, int wc, int fr, int fq) const {
        const int row0 = u.pm * BM + wr * 64 + fr, col0 = u.pn * BM + wc * 32 + 8 * fq; constexpr float ASC = FP8 ? (DBG_ZERO_ASC ? 0.0f : 1.0f / W8_SCALE) : 1.0f;
#pragma unroll
        for (int ai = 0; ai < 2; ++ai)
#pragma unroll
            for (int m = 0; m < 4; ++m) {
                const int row = row0 + ai * HALF + m * 16; const float rse = RSE[row]; float q = 0.f; const size_t ro = (size_t)row * DM; const float zsc = I8 ? RSX[row] * swq : ASC;
#pragma unroll
                for (int bj = 0; bj < 2; ++bj) {
                    const int col = col0 + bj * HALF;
                    const u32x4 xb = *(const gu32x4*)(X1B + ablk(row, col, DM)), eb = *(const gu32x4*)(ERAW + ro + col);
                    const f32x4 pna = *(const gf32x4*)(pnorm + col), pnb = *(const gf32x4*)(pnorm + col + 4);
                    const float x[8] = {bf_lo(xb.x), bf_hi(xb.x), bf_lo(xb.y), bf_hi(xb.y), bf_lo(xb.z), bf_hi(xb.z), bf_lo(xb.w), bf_hi(xb.w)};
                    const float e8[8] = {bf_lo(eb.x), bf_hi(eb.x), bf_lo(eb.y), bf_hi(eb.y), bf_lo(eb.z), bf_hi(eb.z), bf_lo(eb.w), bf_hi(eb.w)};
                    const float pn[8] = {pna[0], pna[1], pna[2], pna[3], pnb[0], pnb[1], pnb[2], pnb[3]};
                    const f32x4 a0 = acc[ai][bj][m][0], a1 = acc[ai][bj][m][1];
                    const float a[8] = {I8 ? (float)__float_as_int(a0[0]) : a0[0], I8 ? (float)__float_as_int(a0[1]) : a0[1], I8 ? (float)__float_as_int(a0[2]) : a0[2], I8 ? (float)__float_as_int(a0[3]) : a0[3],
                                        I8 ? (float)__float_as_int(a1[0]) : a1[0], I8 ? (float)__float_as_int(a1[1]) : a1[1], I8 ? (float)__float_as_int(a1[2]) : a1[2], I8 ? (float)__float_as_int(a1[3]) : a1[3]};
                    float r[8];
#pragma unroll
                    for (int j = 0; j < 8; ++j) { r[j] = x[j] + fsigmoid(a[j] * zsc) * (e8[j] * rse * pn[j]); q += r[j] * r[j]; }
                    if (last) { *(gf32x4*)(XOUT + ro + col) = (f32x4){r[0], r[1], r[2], r[3]}; *(gf32x4*)(XOUT + ro + col + 4) = (f32x4){r[4], r[5], r[6], r[7]}; }
                    else { u32x4 w; w.x = cvt_pk_bf16(r[0], r[1]); w.y = cvt_pk_bf16(r[2], r[3]); w.z = cvt_pk_bf16(r[4], r[5]); w.w = cvt_pk_bf16(r[6], r[7]); *(gu32x4*)(XB + ablk(row, col, DM)) = w;
                        if (P1G_FP8 && !P1G_F6) { u32x2 w8; w8.x = pack_fp8x4(r[0], r[1], r[2], r[3]); w8.y = pack_fp8x4(r[4], r[5], r[6], r[7]); *(gu32x2*)(XB8 + ablk8(row, col, DM)) = w8; } }
                }
                if (!last) { q += __shfl_xor(q, 16); q += __shfl_xor(q, 32); if (fq == 0) SSQN[(size_t)row * 64 + u.pn * 4 + wc] = q; }
                if (m & 1) asm volatile("" ::: "memory");
            }
    }
};
}

constexpr int LDS_BYTES = 163840;
constexpr int MISC_OFF = LDS_BYTES - 128;
constexpr int ARGS_OFF = LDS_BYTES - 512;
constexpr int NWAVES = 8, NTHREADS = 512;

struct Ctx {
    LAS unsigned char* lds; int tid, lane, wave, vcu, G, bx;
};

struct TrTile { const gfloat* W; const gfloat* kscale; gbf16* WT; int ldw, K; guchar* W8; const gunsigned* QS; };
constexpr int TR_PER_LAYER = 7808 + 1536 + 1024 + 1024 + 64;
__device__ __forceinline__ TrTile tr_decode(int it, const gfloat* w_in, const gfloat* norm_pre, const gfloat* w_branch, const gfloat* w_out, const gfloat* ple_gate, const gfloat* ple_proj, guchar* ws) {
    const int l = it / TR_PER_LAYER; int r = it - l * TR_PER_LAYER; TrTile t; int kt, ntile; t.W8 = nullptr; t.QS = nullptr;
    if (r < 7808) { kt = r / 244; ntile = r - kt * 244; const int src = ntile < 116 ? ntile * 128 : ntile * 128 + 8;
        if (ntile < 16) ntile = 2 * ntile; else if (ntile < 32) ntile = ntile + 16; else if (ntile < 48) ntile = 2 * (ntile - 32) + 1;
        const int oblk = (ntile >= 116 && ntile < 132) ? ntile - 116 : -1; if (ntile >= 132 && ntile < 148) ntile -= 16;
        t.ldw = N_IN; t.K = DM; t.W = w_in + (size_t)l * DM * N_IN + (size_t)kt * 128 * N_IN + src; t.kscale = norm_pre + l * DM + kt * 128;
        t.WT = (gbf16*)(ws + WS_WIN + (size_t)l * SZ_WIN) + ((size_t)(ntile >> 1) * (DM / 64) + (size_t)kt * 2) * 16384 + (size_t)(ntile & 1) * 128 * 64;
        if (ntile >= 148) t.W8 = ws + WS_WG8 + (size_t)l * SZ_WG8 + ((size_t)((ntile - 148) >> 1) * (DM / 128) + (size_t)kt) * 32768 + (size_t)(ntile & 1) * 128 * 128;
        if (oblk >= 0) t.W8 = ws + WS_WG8 + (size_t)l * SZ_WG8 + ((size_t)(48 + (oblk >> 1)) * (DM / 128) + (size_t)kt) * 32768 + (size_t)(oblk & 1) * 128 * 128;
        return t; }
    r -= 7808; t.kscale = nullptr; t.ldw = DM;
    if (r < 1536) { const int j = r / 512; const int rr = r - j * 512; kt = rr / 32; ntile = rr - kt * 32; t.K = BW;
        t.W = w_branch + ((size_t)(l * 3 + j) * BW + (size_t)kt * 128) * DM + ntile * 128;
        t.WT = (gbf16*)(ws + WS_WBR + (size_t)l * SZ_WBR) + (size_t)j * DM * BW + ((size_t)(ntile >> 1) * (BW / 64) + (size_t)kt * 2) * 16384 + (size_t)(ntile & 1) * 128 * 64; return t; }
    r -= 1536;
    if (r < 2048) { const int which = r / 1024; const int rr = r - which * 1024; kt = rr / 32; ntile = rr - kt * 32; t.K = DM;
        t.W = (which ? ple_gate : w_out) + ((size_t)l * DM + (size_t)kt * 128) * DM + ntile * 128;
        t.WT = (gbf16*)(ws + (which ? WS_WPG : WS_WOUT) + (size_t)l * SZ_WSQ) + ((size_t)(ntile >> 1) * (DM / 64) + (size_t)kt * 2) * 16384 + (size_t)(ntile & 1) * 128 * 64;
        if (P5_I8 && which) t.QS = (const gunsigned*)(ws + WS_CTL) + CW_WMAX + l;
        if ((P5_FP8 || P5_I8) && which) t.W8 = ws + WS_WPG + (size_t)l * SZ_WSQ + ((size_t)(ntile >> 1) * (DM / 128) + (size_t)kt) * 32768 + (size_t)(ntile & 1) * 128 * 128;
        return t; }
    r -= 2048; kt = r / 32; ntile = r - kt * 32; t.K = 256;
    t.W = ple_proj + ((size_t)l * 256 + (size_t)kt * 128) * DM + ntile * 128;
    t.WT = (gbf16*)(ws + WS_WPP + (size_t)l * SZ_WPP) + ((size_t)(ntile >> 1) * (256 / 64) + (size_t)kt * 2) * 16384 + (size_t)(ntile & 1) * 128 * 64; return t;
}
#ifndef TR_NTLOAD
#define TR_NTLOAD 0
#endif
#ifndef TR_REVERSE
#define TR_REVERSE 1
#endif
__device__ __forceinline__ void tr_run(const Ctx& F, int it0, int it1, int sk0, int sk1, int me, int nw, const gfloat* w_in, const gfloat* norm_pre, const gfloat* w_branch,
                                       const gfloat* w_out, const gfloat* ple_gate, const gfloat* ple_proj, guchar* ws) {
    int tid = F.tid; LAUNDER_V(tid);
    {
        constexpr int RS = 264; const int NIT = it1 - it0 - (sk1 - sk0);
        const int c4 = tid & 31, kr = tid >> 5, kc = tid & 15;
        f32x4 va[8], vb[8]; float ka[8], kb[8]; TrTile ta, tb;
#define TR_LOAD(T_, V_, K_, IT_) do { const int ir_ = TR_REVERSE ? (NIT - 1 - (IT_)) : (IT_); T_ = tr_decode(it0 + ir_ + (((it0 + ir_) >= sk0) ? (sk1 - sk0) : 0), w_in, norm_pre, w_branch, w_out, ple_gate, ple_proj, ws); \
        _Pragma("unroll") for (int i = 0; i < 8; ++i) { V_[i] = TR_NTLOAD ? __builtin_nontemporal_load((const gf32x4*)(T_.W + (size_t)(i * 16 + kr) * T_.ldw + 4 * c4)) : *(const gf32x4*)(T_.W + (size_t)(i * 16 + kr) * T_.ldw + 4 * c4); K_[i] = T_.kscale ? T_.kscale[i * 16 + kr] : 1.0f; } } while (0)
#define TR_PUT(V_, K_) do { _Pragma("unroll") for (int i = 0; i < 8; ++i) { const f32x4 a = V_[i] * K_[i]; u32x2 w; w.x = cvt_pk_bf16(a[0], a[1]); w.y = cvt_pk_bf16(a[2], a[3]); \
        *(LAS u32x2*)(F.lds + (i * 16 + kr) * RS + c4 * 8) = w; } } while (0)
#define TR_GET(WT_, W8_, QS_) do { if (P1G_F6 && (W8_) && !(QS_)) { const int n_ = tid >> 2, kb_ = tid & 3; float v_[32]; \
        const LAS bf16_t* s_ = (const LAS bf16_t*)(F.lds + (32 * kb_) * RS + 2 * n_); \
        _Pragma("unroll") for (int j = 0; j < 32; ++j) v_[j] = __uint_as_float((unsigned)s_[j * (RS / 2)] << 16); \
        unsigned E_; const u32x6 d_ = mx6_pack(v_, E_); \
        *(gu32x4*)((W8_) + n_ * 128 + 16 * kb_) = (u32x4){d_[0], d_[1], d_[2], d_[3]}; *(gu32x4*)((W8_) + n_ * 128 + 64 + 16 * kb_) = (u32x4){d_[4], d_[5], E_, 0u}; } \
      else { _Pragma("unroll") for (int q = 0; q < 4; ++q) { const int n = 32 * q + (tid >> 4), kq = kc; \
        const LAS bf16_t* s = (const LAS bf16_t*)(F.lds + (8 * kq) * RS + 2 * n); unsigned e[8]; \
        _Pragma("unroll") for (int j = 0; j < 8; ++j) e[j] = s[j * (RS / 2)]; \
        if (QS_) { const float qs_ = 127.0f / fmaxf(__uint_as_float(*(QS_)), 1e-30f); u32x2 o8; \
            o8.x = pack_i8x4(__uint_as_float(e[0] << 16) * qs_, __uint_as_float(e[1] << 16) * qs_, __uint_as_float(e[2] << 16) * qs_, __uint_as_float(e[3] << 16) * qs_); \
            o8.y = pack_i8x4(__uint_as_float(e[4] << 16) * qs_, __uint_as_float(e[5] << 16) * qs_, __uint_as_float(e[6] << 16) * qs_, __uint_as_float(e[7] << 16) * qs_); \
            *(gu32x2*)((W8_) + n * 128 + 8 * kq) = o8; } \
        else if (W8_) { u32x2 o8; o8.x = pack_fp8x4(__uint_as_float(e[0] << 16) * W8_SCALE, __uint_as_float(e[1] << 16) * W8_SCALE, __uint_as_float(e[2] << 16) * W8_SCALE, __uint_as_float(e[3] << 16) * W8_SCALE); \
            o8.y = pack_fp8x4(__uint_as_float(e[4] << 16) * W8_SCALE, __uint_as_float(e[5] << 16) * W8_SCALE, __uint_as_float(e[6] << 16) * W8_SCALE, __uint_as_float(e[7] << 16) * W8_SCALE); \
            *(gu32x2*)((W8_) + n * 128 + 8 * kq) = o8; } \
        else { u32x4 o; o.x = e[0] | (e[1] << 16); o.y = e[2] | (e[3] << 16); o.z = e[4] | (e[5] << 16); o.w = e[6] | (e[7] << 16); \
        *(gu32x4*)(WT_ + (size_t)(kq >> 3) * 16384 + n * 64 + 8 * (kq & 7)) = o; } } } } while (0)
        int it = me;
        if (it < NIT) TR_LOAD(ta, va, ka, it);
        if (it + nw < NIT) TR_LOAD(tb, vb, kb, it + nw);
        while (it < NIT) {
            { TR_PUT(va, ka); __syncthreads(); gbf16* wt = ta.WT; guchar* kk = ta.W8; const gunsigned* qp = ta.QS;
              if (it + 2 * nw < NIT) TR_LOAD(ta, va, ka, it + 2 * nw);
              TR_GET(wt, kk, qp); __syncthreads(); }
            it += nw; if (it >= NIT) break;
            { TR_PUT(vb, kb); __syncthreads(); gbf16* wt = tb.WT; guchar* kk = tb.W8; const gunsigned* qp = tb.QS;
              if (it + 2 * nw < NIT) TR_LOAD(tb, vb, kb, it + 2 * nw);
              TR_GET(wt, kk, qp); __syncthreads(); }
            it += nw;
        }
#undef TR_LOAD
#undef TR_PUT
#undef TR_GET
    }
}
#ifndef TR_NODEFER
#define TR_NODEFER 0
#endif
#ifndef TR_L1TAIL
#define TR_L1TAIL (1024 + 1536)
#endif
constexpr int TR_PG0 = 7808 + 1536 + 1024, TR_PG1 = TR_PER_LAYER + TR_PG0;
constexpr int TR_DEFER0 = TR_PER_LAYER + 7808 + 1536, TR_DEFER1 = TR_DEFER0 + (TR_NODEFER ? 0 : 2048);
__device__ __forceinline__ void p0_prologue(const Ctx& F, const gfloat* x, const gfloat* p, const gint* positions, const gfloat* norm_pre, const gfloat* w_in, const gfloat* w_branch,
                                            const gfloat* w_out, const gfloat* ple_gate, const gfloat* ple_proj, guchar* ws) {
    int tid = F.tid; LAUNDER_V(tid);
#if P5_I8
    tr_run(F, 0, TR_PG1 - TR_L1TAIL, TR_PG0, TR_PG0 + 1024, F.vcu, F.G, w_in, norm_pre, w_branch, w_out, ple_gate, ple_proj, ws);
    tr_run(F, TR_PG1 + 1024, NLAYER * TR_PER_LAYER, 0x7fffffff, 0x7fffffff, F.vcu, F.G, w_in, norm_pre, w_branch, w_out, ple_gate, ple_proj, ws);
    { const int gt_ = F.vcu * NTHREADS + tid, NGT_ = F.G * NTHREADS;
      for (int l = 0; l < NLAYER; ++l) { const gf32x4* wp = (const gf32x4*)(ple_gate + (size_t)l * DM * DM); float mx = 0.f;
          for (int i0 = gt_; i0 < DM * DM / 4; i0 += 8 * NGT_) { f32x4 a[8];
#pragma unroll
              for (int j = 0; j < 8; ++j) { const int i = i0 + j * NGT_; a[j] = wp[i < DM * DM / 4 ? i : i0]; }
#pragma unroll
              for (int j = 0; j < 8; ++j) mx = fmaxf(mx, fmaxf(fmaxf(fabsf(a[j][0]), fabsf(a[j][1])), fmaxf(fabsf(a[j][2]), fabsf(a[j][3])))); }
#pragma unroll
          for (int s = 32; s >= 1; s >>= 1) mx = fmaxf(mx, __shfl_xor(mx, s));
          if (F.lane == 0) atomicMax((unsigned*)((gunsigned*)(ws + WS_CTL) + CW_WMAX + l), __float_as_uint(mx)); } }
#else
    tr_run(F, 0, NLAYER * TR_PER_LAYER, TR_DEFER0, TR_DEFER1, F.vcu, F.G, w_in, norm_pre, w_branch, w_out, ple_gate, ple_proj, ws);
#endif
    const int gt = F.vcu * NTHREADS + tid, NGT = F.G * NTHREADS;
    for (int i = gt; i < NLAYER * 256 * DM; i += NGT) { const int l = i / (256 * DM), rr = (i / DM) & 255, k = i & (DM - 1);
        float val = 0.f; if (rr < 8) val = w_in[(size_t)l * DM * N_IN + (size_t)k * N_IN + IF_COL + rr] * norm_pre[l * DM + k];
        ((gbf16*)(ws + WS_WIN + (size_t)l * SZ_WIN))[((size_t)122 * (DM / 64) + (k >> 6)) * 16384 + rr * 64 + (k & 63)] = (bf16_t)(cvt_pk_bf16(val, 0.f) & 0xffffu); }
    for (int i = gt; i < NLAYER * M_ROWS * 256 / 4; i += NGT) { const f32x4 a = ((const gf32x4*)p)[i]; u32x2 w; w.x = cvt_pk_bf16(a[0], a[1]); w.y = cvt_pk_bf16(a[2], a[3]);
        const int l = i / (M_ROWS * 64), r = (i >> 6) & (M_ROWS - 1), c = (i & 63) * 4; *(gu32x2*)((gbf16*)(ws + WS_PB) + (size_t)l * M_ROWS * 256 + ablk(r, c, 256)) = w; }
    for (int i = gt; i < M_ROWS * 8; i += NGT) { const int row = i >> 3, j = i & 7; const float inv = powf(500000.0f, -(float)j * 0.125f); const float ang = (float)positions[row] * inv;
        gfloat* cs = (gfloat*)(ws + WS_CS) + (size_t)row * 16; cs[j] = cosf(ang); cs[8 + j] = sinf(ang); }
    { const int gw = F.vcu * NWAVES + F.wave, NGW = F.G * NWAVES;
#if P1G_F6
      for (int m = gw; m < M_ROWS; m += NGW) { gbf16* o = (gbf16*)(ws + WS_XB); float s = 0.f;
#pragma unroll
          for (int hb = 0; hb < 2; ++hb) { const int c0 = 32 * (F.lane + 64 * hb); const gf32x4* xr = (const gf32x4*)(x + (size_t)m * DM + c0); float v[32];
#pragma unroll
              for (int i = 0; i < 8; ++i) { const f32x4 a = xr[i]; v[4 * i] = a[0]; v[4 * i + 1] = a[1]; v[4 * i + 2] = a[2]; v[4 * i + 3] = a[3]; s += (a[0] * a[0] + a[1] * a[1]) + (a[2] * a[2] + a[3] * a[3]); }
#pragma unroll
              for (int i = 0; i < 4; ++i) { u32x4 w; w.x = cvt_pk_bf16(v[8 * i], v[8 * i + 1]); w.y = cvt_pk_bf16(v[8 * i + 2], v[8 * i + 3]); w.z = cvt_pk_bf16(v[8 * i + 4], v[8 * i + 5]); w.w = cvt_pk_bf16(v[8 * i + 6], v[8 * i + 7]); *(gu32x4*)(o + ablk(m, c0 + 8 * i, DM)) = w; }
              unsigned E; const u32x6 d = mx6_pack(v, E); guchar* rp = ws + WS_XB8 + ((size_t)(m >> 8) * (DM / 128) + (c0 >> 7)) * 32768 + (size_t)(m & 255) * 128 + 16 * ((c0 >> 5) & 3);
              *(gu32x4*)rp = (u32x4){d[0], d[1], d[2], d[3]}; *(gu32x4*)(rp + 64) = (u32x4){d[4], d[5], E, 0u}; }
          s = wave_sum(s); if (F.lane == 0) ((gfloat*)(ws + WS_SSQ0))[m] = s; }
#else
      for (int m = gw; m < M_ROWS; m += NGW) { const gf32x4* xr = (const gf32x4*)(x + (size_t)m * DM) + F.lane; gbf16* o = (gbf16*)(ws + WS_XB); float s = 0.f;
#pragma unroll
          for (int j = 0; j < 16; ++j) { const f32x4 a = xr[64 * j]; s += (a[0] * a[0] + a[1] * a[1]) + (a[2] * a[2] + a[3] * a[3]); u32x2 w; w.x = cvt_pk_bf16(a[0], a[1]); w.y = cvt_pk_bf16(a[2], a[3]); *(gu32x2*)(o + ablk(m, (F.lane + 64 * j) * 4, DM)) = w;
              if (P1G_FP8) *(gunsigned*)(ws + WS_XB8 + ablk8(m, (F.lane + 64 * j) * 4, DM)) = pack_fp8x4(a[0], a[1], a[2], a[3]); }
          s = wave_sum(s); if (F.lane == 0) ((gfloat*)(ws + WS_SSQ0))[m] = s; }
#endif
    }
}

__device__ __forceinline__ u32x2 pack4(const f32x4 v) { u32x2 w; w.x = cvt_pk_bf16(v[0], v[1]); w.y = cvt_pk_bf16(v[2], v[3]); return w; }
__device__ __forceinline__ bf16x8 mk_frag(const u32x2 lo, const u32x2 hi) { const u32x4 t = {lo.x, lo.y, hi.x, hi.y}; return __builtin_bit_cast(bf16x8, t); }
__device__ __forceinline__ bf16x8 frag_const(unsigned w) { const u32x4 t = {w, w, w, w}; return __builtin_bit_cast(bf16x8, t); }

constexpr int GM_RS = 288, GM_WL = 0, GM_VT = 128 * GM_RS, GM_ST = GM_VT + 256 * GM_RS;
__device__ __forceinline__ void gmlp_unit(const Ctx& F, int b, int n, int g, guchar* ws, const gfloat* ln_g, const gfloat* ln_b, const gfloat* wsp, const gfloat* bsp) {
    int tid = F.tid; LAUNDER_V(tid); const int lane = tid & 63, w = F.wave, r16 = lane & 15, q4 = lane >> 4;
    const int row0 = b * SEQ + n * 128, c0 = g * 256;
    const gbf16* AU = (const gbf16*)(ws + WS_AU); const gbf16* AV = (const gbf16*)(ws + WS_AV); gbf16* YA = (gbf16*)(ws + WS_YA);
    u32x4 raw[8];
#pragma unroll
    for (int k = 0; k < 8; ++k) { const int item = tid + 512 * k, s = item & 127, ch = item >> 7; raw[k] = *(const gu32x4*)(AV + tb256(row0 + s, c0 + 8 * ch, 8)); }
    f32x4 wt[8];
#pragma unroll
    for (int k = 0; k < 8; ++k) { const int item = tid + 512 * k, t = item >> 5, ch = item & 31; wt[k] = *(const gf32x4*)(wsp + ((size_t)(g * 128 + t)) * 128 + 4 * ch); }
    { const gf32x4* pp = (const gf32x4*)(ws + WS_LNP) + (size_t)(row0 + (tid & 127)) * 16 + (tid >> 7) * 4; float s = 0.f, q = 0.f;
#pragma unroll
        for (int j = 0; j < 4; ++j) { const f32x4 t = pp[j]; s += t[0] + t[2]; q += t[1] + t[3]; }
        *(LAS f32x2*)(F.lds + GM_ST + 1024 + ((tid >> 7) * 128 + (tid & 127)) * 8) = (f32x2){s, q}; }
#pragma unroll
    for (int k = 0; k < 8; ++k) { const int item = tid + 512 * k, t = item >> 5, ch = item & 31; f32x4 a = wt[k];
#pragma unroll
        for (int e = 0; e < 4; ++e) if (4 * ch + e > t) a[e] = 0.f;
        *(LAS u32x2*)(F.lds + GM_WL + t * GM_RS + ch * 8) = pack4(a); }
    __syncthreads();
    if (tid < 128) { float s = 0.f, q = 0.f;
#pragma unroll
        for (int j = 0; j < 4; ++j) { const f32x2 t = *(const LAS f32x2*)(F.lds + GM_ST + 1024 + (j * 128 + tid) * 8); s += t.x; q += t.y; }
        const float mu = s * (1.0f / BW); const float var = fmaxf(q * (1.0f / BW) - mu * mu, 0.f);
        *(LAS f32x2*)(F.lds + GM_ST + tid * 8) = (f32x2){mu, rsqrtf(var + NORM_EPS)}; }
    __syncthreads();
#pragma unroll
    for (int k = 0; k < 8; ++k) { const int item = tid + 512 * k, s = item & 127, ch = item >> 7;
        const f32x4 g0 = *(const gf32x4*)(ln_g + c0 + 8 * ch), g1 = *(const gf32x4*)(ln_g + c0 + 8 * ch + 4), b0 = *(const gf32x4*)(ln_b + c0 + 8 * ch), b1 = *(const gf32x4*)(ln_b + c0 + 8 * ch + 4);
        const f32x2 st = *(const LAS f32x2*)(F.lds + GM_ST + s * 8);
        const float xv[8] = {bf_lo(raw[k].x), bf_hi(raw[k].x), bf_lo(raw[k].y), bf_hi(raw[k].y), bf_lo(raw[k].z), bf_hi(raw[k].z), bf_lo(raw[k].w), bf_hi(raw[k].w)};
        const float gg[8] = {g0[0], g0[1], g0[2], g0[3], g1[0], g1[1], g1[2], g1[3]}, bb[8] = {b0[0], b0[1], b0[2], b0[3], b1[0], b1[1], b1[2], b1[3]};
#pragma unroll
        for (int i = 0; i < 8; ++i) { const float y = (xv[i] - st.x) * st.y * gg[i] + bb[i];
            *(LAS bf16_t*)(F.lds + GM_VT + (8 * ch + i) * GM_RS + 2 * s) = (bf16_t)(cvt_pk_bf16(y, 0.f) & 0xffffu); } }
    u32x4 ub[8]; float bsv[8];
#pragma unroll
    for (int n8 = 0; n8 < 8; ++n8) { const int t = 16 * n8 + r16; ub[n8] = *(const gu32x4*)(AU + tb128(row0 + t, c0 + 32 * w + 8 * q4, 16)); bsv[n8] = bsp[g * 128 + t]; }
    __syncthreads();
    f32x4 acc[2][8];
#pragma unroll
    for (int m = 0; m < 2; ++m)
#pragma unroll
        for (int n8 = 0; n8 < 8; ++n8) acc[m][n8] = (f32x4){0.f, 0.f, 0.f, 0.f};
    bf16x8 af[2][4];
#pragma unroll
    for (int m = 0; m < 2; ++m)
#pragma unroll
        for (int ks = 0; ks < 4; ++ks) af[m][ks] = *(const LAS bf16x8*)(F.lds + GM_VT + (32 * w + 8 * (r16 >> 2) + 4 * m + (r16 & 3)) * GM_RS + ks * 64 + q4 * 16);
#pragma unroll
    for (int n8 = 0; n8 < 8; ++n8)
#pragma unroll
        for (int ks = 0; ks < 4; ++ks) if (ks <= n8 / 2) {
            const bf16x8 bfr = *(const LAS bf16x8*)(F.lds + GM_WL + (16 * n8 + r16) * GM_RS + ks * 64 + q4 * 16);
#pragma unroll
            for (int m = 0; m < 2; ++m) acc[m][n8] = MFMA16(af[m][ks], bfr, acc[m][n8]); }
#pragma unroll
    for (int n8 = 0; n8 < 8; ++n8) { const int t = 16 * n8 + r16; const size_t roy = ablk(row0 + t, c0 + 32 * w + 8 * q4, BW);
        const f32x4 a0 = acc[0][n8] + bsv[n8], a1 = acc[1][n8] + bsv[n8]; u32x4 y;
        y.x = cvt_pk_bf16(a0[0] * bf_lo(ub[n8].x), a0[1] * bf_hi(ub[n8].x)); y.y = cvt_pk_bf16(a0[2] * bf_lo(ub[n8].y), a0[3] * bf_hi(ub[n8].y));
        y.z = cvt_pk_bf16(a1[0] * bf_lo(ub[n8].z), a1[1] * bf_hi(ub[n8].z)); y.w = cvt_pk_bf16(a1[2] * bf_lo(ub[n8].w), a1[3] * bf_hi(ub[n8].w));
        *(gu32x4*)(YA + roy) = y; }
    __syncthreads();
}

constexpr int SW_RS = 160, SW_VS = 528, SW_KL = 0, SW_VT = 256 * SW_RS, SW_QL = SW_VT + 64 * SW_VS, SW_QL2 = SW_QL + 128 * SW_RS, SW_CS = SW_QL2 + 128 * SW_RS;
static_assert(SW_CS + 384 * 64 <= ARGS_OFF, "SWA LDS map");
__device__ __forceinline__ void rope8(const u32x4 a, const u32x4 bq, const gfloat* cs, float scale, u32x4& o1, u32x4& o2) {
    const f32x4 c0 = *(const gf32x4*)cs, c1 = *(const gf32x4*)(cs + 4), s0 = *(const gf32x4*)(cs + 8), s1 = *(const gf32x4*)(cs + 12);
    const float t1[8] = {bf_lo(a.x), bf_hi(a.x), bf_lo(a.y), bf_hi(a.y), bf_lo(a.z), bf_hi(a.z), bf_lo(a.w), bf_hi(a.w)};
    const float t2[8] = {bf_lo(bq.x), bf_hi(bq.x), bf_lo(bq.y), bf_hi(bq.y), bf_lo(bq.z), bf_hi(bq.z), bf_lo(bq.w), bf_hi(bq.w)};
    const float cc[8] = {c0[0], c0[1], c0[2], c0[3], c1[0], c1[1], c1[2], c1[3]}, ss[8] = {s0[0], s0[1], s0[2], s0[3], s1[0], s1[1], s1[2], s1[3]};
    float r1[8], r2[8];
#pragma unroll
    for (int i = 0; i < 8; ++i) { r1[i] = (t1[i] * cc[i] - t2[i] * ss[i]) * scale; r2[i] = (t2[i] * cc[i] + t1[i] * ss[i]) * scale; }
    o1 = (u32x4){cvt_pk_bf16(r1[0], r1[1]), cvt_pk_bf16(r1[2], r1[3]), cvt_pk_bf16(r1[4], r1[5]), cvt_pk_bf16(r1[6], r1[7])};
    o2 = (u32x4){cvt_pk_bf16(r2[0], r2[1]), cvt_pk_bf16(r2[2], r2[3]), cvt_pk_bf16(r2[4], r2[5]), cvt_pk_bf16(r2[6], r2[7])};
}
__device__ __forceinline__ u32x4 scale8(const u32x4 a, float sc) {
    return (u32x4){cvt_pk_bf16(bf_lo(a.x) * sc, bf_hi(a.x) * sc), cvt_pk_bf16(bf_lo(a.y) * sc, bf_hi(a.y) * sc), cvt_pk_bf16(bf_lo(a.z) * sc, bf_hi(a.z) * sc), cvt_pk_bf16(bf_lo(a.w) * sc, bf_hi(a.w) * sc)};
}
__device__ __forceinline__ void swa_unit(const Ctx& F, int b, int n, int hk, guchar* ws, const gfloat* sinks) {
    int tid = F.tid; LAUNDER_V(tid); const int lane = tid & 63, w = F.wave, r16 = lane & 15, q4 = lane >> 4;
    const int r0 = b * SEQ + n * 128, kr0 = r0 - 128;
    const gbf16* BQ = (const gbf16*)(ws + WS_BQ); const gbf16* BK = (const gbf16*)(ws + WS_BK); const gbf16* BV = (const gbf16*)(ws + WS_BV); const gbf16* BZ = (const gbf16*)(ws + WS_BZ);
    gbf16* YB = (gbf16*)(ws + WS_YA) + (size_t)M_ROWS * BW; const gfloat* CS = (const gfloat*)(ws + WS_CS);
    const int kch = tid & 7;
    u32x4 kraw[4], vraw[4]; f32x4 csr[3]; u32x4 qa[2];
#pragma unroll
    for (int k = 0; k < 4; ++k) { const int key = (tid + 512 * k) >> 3; const bool pad = (n == 0 && key < 128);
        kraw[k] = *(const gu32x4*)(BK + (size_t)(pad ? r0 : kr0 + key) * 256 + hk * 64 + 8 * kch); }
#pragma unroll
    for (int k = 0; k < 4; ++k) { const int item = tid + 512 * k, key = item & 255, ch = item >> 8; const bool pad = (n == 0 && key < 128);
        vraw[k] = *(const gu32x4*)(BV + (size_t)(pad ? r0 : kr0 + key) * 256 + hk * 64 + 8 * ch); }
#pragma unroll
    for (int k = 0; k < 3; ++k) { const int item = tid + 512 * k, r = item >> 2, part = item & 3; const int row = r < 256 ? ((n == 0 && r < 128) ? r0 : kr0 + r) : r0 + r - 256;
        csr[k] = *(const gf32x4*)(CS + (size_t)row * 16 + part * 4); }
#define SW_QLOAD(hq_) do { _Pragma("unroll") for (int k_ = 0; k_ < 2; ++k_) { const int qr_ = (tid + 512 * k_) >> 3; qa[k_] = *(const gu32x4*)(BQ + tb256(r0 + qr_, (hq_) * 64, 8) + 8 * kch); } } while (0)
    SW_QLOAD(hk * 8);
#pragma unroll
    for (int k = 0; k < 3; ++k) { const int item = tid + 512 * k; *(LAS f32x4*)(F.lds + SW_CS + item * 16) = csr[k]; }
#pragma unroll
    for (int k = 0; k < 4; ++k) { const int item = tid + 512 * k, key = item & 255, ch = item >> 8; const bool pad = (n == 0 && key < 128);
        const u32x4 raw = pad ? (u32x4){0u, 0u, 0u, 0u} : vraw[k]; const unsigned e[4] = {raw.x, raw.y, raw.z, raw.w};
#pragma unroll
        for (int i = 0; i < 8; ++i) *(LAS bf16_t*)(F.lds + SW_VT + (8 * ch + i) * SW_VS + 2 * key) = (bf16_t)((e[i >> 1] >> ((i & 1) * 16)) & 0xffffu); }
    __syncthreads();
#define SW_PUT(raw_, csrow_, dst_, scale_) do { const u32x4 own_ = (raw_); u32x4 par_; \
        par_.x = (unsigned)__builtin_amdgcn_update_dpp(0, (int)own_.x, 0xB1, 0xf, 0xf, false); par_.y = (unsigned)__builtin_amdgcn_update_dpp(0, (int)own_.y, 0xB1, 0xf, 0xf, false); \
        par_.z = (unsigned)__builtin_amdgcn_update_dpp(0, (int)own_.z, 0xB1, 0xf, 0xf, false); par_.w = (unsigned)__builtin_amdgcn_update_dpp(0, (int)own_.w, 0xB1, 0xf, 0xf, false); \
        u32x4 o_; \
        if (kch < 2) { const LAS float* cs_ = (const LAS float*)(F.lds + SW_CS + (csrow_) * 64); \
            const f32x4 c0_ = *(const LAS f32x4*)cs_, c1_ = *(const LAS f32x4*)(cs_ + 4), s0_ = *(const LAS f32x4*)(cs_ + 8), s1_ = *(const LAS f32x4*)(cs_ + 12); \
            const float sg_ = kch == 0 ? -(scale_) : (scale_); \
            const float t_[8] = {bf_lo(own_.x), bf_hi(own_.x), bf_lo(own_.y), bf_hi(own_.y), bf_lo(own_.z), bf_hi(own_.z), bf_lo(own_.w), bf_hi(own_.w)}; \
            const float u_[8] = {bf_lo(par_.x), bf_hi(par_.x), bf_lo(par_.y), bf_hi(par_.y), bf_lo(par_.z), bf_hi(par_.z), bf_lo(par_.w), bf_hi(par_.w)}; \
            const float cc_[8] = {c0_[0], c0_[1], c0_[2], c0_[3], c1_[0], c1_[1], c1_[2], c1_[3]}, ss_[8] = {s0_[0], s0_[1], s0_[2], s0_[3], s1_[0], s1_[1], s1_[2], s1_[3]}; \
            float r_[8]; _Pragma("unroll") for (int i_ = 0; i_ < 8; ++i_) r_[i_] = (t_[i_] * cc_[i_]) * (scale_) + (u_[i_] * ss_[i_]) * sg_; \
            o_ = (u32x4){cvt_pk_bf16(r_[0], r_[1]), cvt_pk_bf16(r_[2], r_[3]), cvt_pk_bf16(r_[4], r_[5]), cvt_pk_bf16(r_[6], r_[7])}; } \
        else o_ = ((scale_) == 1.0f) ? own_ : scale8(own_, (scale_)); \
        *(LAS u32x4*)((dst_) + kch * 16) = o_; } while (0)
#pragma unroll
    for (int k = 0; k < 4; ++k) { const int key = (tid + 512 * k) >> 3; const bool pad = (n == 0 && key < 128);
        const u32x4 kz = pad ? (u32x4){0u, 0u, 0u, 0u} : kraw[k]; SW_PUT(kz, key, F.lds + SW_KL + key * SW_RS, 1.0f); }
#define SW_QWRITE(buf_) do { _Pragma("unroll") for (int k_ = 0; k_ < 2; ++k_) { const int qr_ = (tid + 512 * k_) >> 3; SW_PUT(qa[k_], 256 + qr_, F.lds + (buf_) + qr_ * SW_RS, 0.125f); } } while (0)
    SW_QWRITE(SW_QL);
    __syncthreads();
    for (int hi = 0; hi < 8; ++hi) {
        const int hq = hk * 8 + hi; const int qcur = (hi & 1) ? SW_QL2 : SW_QL, qnxt = (hi & 1) ? SW_QL : SW_QL2;
        SW_QLOAD((hi < 7 ? hq + 1 : hq));
        const u32x4 zb0 = *(const gu32x4*)(BZ + tb256(r0 + 16 * w + r16, hq * 64 + 8 * q4, 8)), zb1 = *(const gu32x4*)(BZ + tb256(r0 + 16 * w + r16, hq * 64 + 8 * q4 + 32, 8));
        bf16x8 bq[2];
#pragma unroll
        for (int ks = 0; ks < 2; ++ks) bq[ks] = *(const LAS bf16x8*)(F.lds + qcur + (16 * w + r16) * SW_RS + ks * 64 + q4 * 16);
        f32x4 s[10];
#pragma unroll
        for (int j = 0; j < 9; ++j) { s[j] = (f32x4){0.f, 0.f, 0.f, 0.f};
#pragma unroll
            for (int ks = 0; ks < 2; ++ks) { const bf16x8 a = *(const LAS bf16x8*)(F.lds + SW_KL + (16 * (w + j) + r16) * SW_RS + ks * 64 + q4 * 16); s[j] = MFMA16(a, bq[ks], s[j]); } }
        s[9] = (f32x4){0.f, 0.f, 0.f, 0.f};
        const int qi = 16 * w + r16; const float sink = sinks[hq]; float mx = sink;
#pragma unroll
        for (int j = 0; j < 9; ++j)
#pragma unroll
            for (int e = 0; e < 4; ++e) { const int kj = 16 * (w + j) + 4 * q4 + e; const bool valid = (kj > qi) && (kj <= qi + 128) && (n > 0 || kj >= 128);
                s[j][e] = valid ? s[j][e] : -1e30f; mx = fmaxf(mx, s[j][e]); }
        mx = fmaxf(mx, __shfl_xor(mx, 16)); mx = fmaxf(mx, __shfl_xor(mx, 32));
        float sum = 0.f;
#pragma unroll
        for (int j = 0; j < 9; ++j)
#pragma unroll
            for (int e = 0; e < 4; ++e) { const float pv = (s[j][e] > -1e29f) ? __expf(s[j][e] - mx) : 0.f; s[j][e] = pv; sum += pv; }
        sum += __shfl_xor(sum, 16); sum += __shfl_xor(sum, 32); sum += __expf(sink - mx);
        const float inv = 1.0f / sum;
        f32x4 o[4];
#pragma unroll
        for (int dt = 0; dt < 4; ++dt) o[dt] = (f32x4){0.f, 0.f, 0.f, 0.f};
#pragma unroll
        for (int kk = 0; kk < 5; ++kk) { const bf16x8 pf = mk_frag(pack4(s[2 * kk]), pack4(s[2 * kk + 1]));
            const int t0 = w + 2 * kk, t1 = (w + 2 * kk + 1) > 15 ? 15 : (w + 2 * kk + 1);
#pragma unroll
            for (int dt = 0; dt < 4; ++dt) { const LAS unsigned char* vrow = F.lds + SW_VT + (32 * (dt >> 1) + 8 * (r16 >> 2) + 4 * (dt & 1) + (r16 & 3)) * SW_VS + (4 * q4) * 2;
                const bf16x8 a = mk_frag(*(const LAS u32x2*)(vrow + 32 * t0), *(const LAS u32x2*)(vrow + 32 * t1)); o[dt] = MFMA16(a, pf, o[dt]); } }
        const size_t ro = (size_t)(r0 + qi) * BW + hq * 64 + 8 * q4;
#pragma unroll
        for (int pp = 0; pp < 2; ++pp) { const u32x4 zb = pp ? zb1 : zb0; const f32x4 oa = o[2 * pp] * inv, ob2 = o[2 * pp + 1] * inv; u32x4 y;
            y.x = cvt_pk_bf16(oa[0] * bf_lo(zb.x), oa[1] * bf_hi(zb.x)); y.y = cvt_pk_bf16(oa[2] * bf_lo(zb.y), oa[3] * bf_hi(zb.y));
            y.z = cvt_pk_bf16(ob2[0] * bf_lo(zb.z), ob2[1] * bf_hi(zb.z)); y.w = cvt_pk_bf16(ob2[2] * bf_lo(zb.w), ob2[3] * bf_hi(zb.w));
            *(gu32x4*)(YB + ablk(r0 + qi, hq * 64 + 8 * q4 + 32 * pp, BW)) = y; }
        SW_QWRITE(qnxt);
        __syncthreads();
    }
#undef SW_QLOAD
#undef SW_QWRITE
#undef SW_PUT
}

#ifndef ML_R1A
#define ML_R1A 1
#endif
#ifndef ML_R1B
#define ML_R1B 1
#endif
#ifndef ML_RWR
#define ML_RWR 1
#endif
constexpr int ML_RS = 544, ML_TS = 144, ML_WS = 160, ML_GSZ = 1344;
constexpr int ML_QL = 0, ML_KA = 64 * ML_RS, ML_KB = 2 * 64 * ML_RS, ML_VT = 3 * 64 * ML_RS, ML_VW = ML_VT + 32 * ML_TS, ML_VW2 = ML_VW + 33 * ML_WS, ML_CT = ML_VW2 + 33 * ML_WS, ML_X = ML_CT + 33 * ML_RS, ML_GATE = ML_X + 64 * 144;
static_assert(ML_GATE + 2 * ML_GSZ <= ARGS_OFF, "mLSTM LDS map");
typedef short s16x4 __attribute__((ext_vector_type(4)));
__device__ __forceinline__ bf16x8 tr_frag8(const LAS unsigned char* img, int rs, int row0, int col0, int r16) {
    const LAS unsigned char* p0 = img + (row0 + (r16 >> 2)) * rs + (col0 + 4 * (r16 & 3)) * 2;
    const s16x4 a = __builtin_amdgcn_ds_read_tr16_b64_v4i16((LAS s16x4*)p0);
    const s16x4 b = __builtin_amdgcn_ds_read_tr16_b64_v4i16((LAS s16x4*)(p0 + 4 * rs));
    return __builtin_shufflevector(a, b, 0, 1, 2, 3, 4, 5, 6, 7);
}
__device__ __forceinline__ float dpp_shr(float v, float ident, int n) {
    const int r = n == 1 ? __builtin_amdgcn_update_dpp(__float_as_int(ident), __float_as_int(v), 0x111, 0xf, 0xf, false)
                : n == 2 ? __builtin_amdgcn_update_dpp(__float_as_int(ident), __float_as_int(v), 0x112, 0xf, 0xf, false)
                : n == 4 ? __builtin_amdgcn_update_dpp(__float_as_int(ident), __float_as_int(v), 0x114, 0xf, 0xf, false)
                         : __builtin_amdgcn_update_dpp(__float_as_int(ident), __float_as_int(v), 0x118, 0xf, 0xf, false);
    return __int_as_float(r);
}
__device__ __forceinline__ float wave_scan_add(float v, int lane) {
    v += dpp_shr(v, 0.f, 1); v += dpp_shr(v, 0.f, 2); v += dpp_shr(v, 0.f, 4); v += dpp_shr(v, 0.f, 8);
    const float t0 = __int_as_float(__builtin_amdgcn_readlane(__float_as_int(v), 15)), t1 = __int_as_float(__builtin_amdgcn_readlane(__float_as_int(v), 31)), t2 = __int_as_float(__builtin_amdgcn_readlane(__float_as_int(v), 47));
    const int row = lane >> 4; const float add = row == 0 ? 0.f : (row == 1 ? t0 : (row == 2 ? t0 + t1 : (t0 + t1) + t2));
    return v + add;
}
__device__ __forceinline__ float wave_scan_max(float v, int lane) {
    const float NI = -3.0e38f;
    v = fmaxf(v, dpp_shr(v, NI, 1)); v = fmaxf(v, dpp_shr(v, NI, 2)); v = fmaxf(v, dpp_shr(v, NI, 4)); v = fmaxf(v, dpp_shr(v, NI, 8));
    const float t0 = __int_as_float(__builtin_amdgcn_readlane(__float_as_int(v), 15)), t1 = __int_as_float(__builtin_amdgcn_readlane(__float_as_int(v), 31)), t2 = __int_as_float(__builtin_amdgcn_readlane(__float_as_int(v), 47));
    const int row = lane >> 4; const float mx = row == 0 ? NI : (row == 1 ? t0 : (row == 2 ? fmaxf(t0, t1) : fmaxf(fmaxf(t0, t1), t2)));
    return fmaxf(v, mx);
}
__device__ __forceinline__ float softcap15(float z) { const float e = __expf(z * (2.0f / 15.0f)); return 15.0f * (1.0f - 2.0f * __builtin_amdgcn_rcpf(e + 1.0f)); }
__device__ __forceinline__ void mlstm_unit(const Ctx& F, int b, int h, int sl, guchar* ws, const gfloat* ibp, const gfloat* fbp, const gfloat* norm_g) {
    int tid = F.tid; LAUNDER_V(tid); const int lane = tid & 63, w = F.wave, r16 = lane & 15, q4 = lane >> 4;
    const gbf16* CQ = (const gbf16*)(ws + WS_CQ); const gbf16* CK = (const gbf16*)(ws + WS_CK); const gbf16* CV = (const gbf16*)(ws + WS_CV);
    const gbf16* CO = (const gbf16*)(ws + WS_CO); const gbf16* CZs = (const gbf16*)(ws + WS_CZ);
    const gfloat* IFB = (const gfloat*)(ws + WS_IF);
    gbf16* NUM = (gbf16*)(ws + WS_NUM) + h * 512 + sl * 32; gfloat* SSQC = (gfloat*)(ws + WS_SSQC); gfloat* DNB = (gfloat*)(ws + WS_DN);
    const int rowb = b * SEQ;
    const bf16x8 ones = frag_const(0x3f803f80u), zeros = frag_const(0u);
    for (int i = tid; i < 33 * ML_RS / 16; i += NTHREADS) *(LAS u32x4*)(F.lds + ML_CT + i * 16) = (u32x4){0u, 0u, 0u, 0u};
    f32x4 st[2][3];
#pragma unroll
    for (int i = 0; i < 2; ++i)
#pragma unroll
        for (int dt = 0; dt < 3; ++dt) st[i][dt] = (f32x4){0.f, 0.f, 0.f, 0.f};
    float m_prev = 0.f;
    const float ibv = ibp[h], fbv = fbp[h];
    const f32x4 ng0 = *(const gf32x4*)(norm_g + h * 512 + sl * 32 + 4 * q4), ng1 = *(const gf32x4*)(norm_g + h * 512 + sl * 32 + 16 + 4 * q4);
    u32x4 qra[4], kra[4], vra; float gi = 0.f, gf = 0.f;
#define ML_LOAD(c, Q_, K_, V_) do { const int rc_ = rowb + (c) * 64; _Pragma("unroll") for (int k_ = 0; k_ < 4; ++k_) { const int it_ = tid + 512 * k_, s_ = it_ >> 5, ch_ = it_ & 31; \
        Q_[k_] = *(const gu32x4*)(CQ + tb256(rc_ + s_, h * 256 + 8 * ch_, 4)); K_[k_] = *(const gu32x4*)(CK + tb256(rc_ + s_, h * 256 + 8 * ch_, 4)); } \
        V_ = *(const gu32x4*)(CV + tb256(rc_ + ((tid & 255) >> 2), h * 512 + sl * 32 + 8 * (tid & 3), 8)); } while (0)
#define ML_GLOAD(c) do { const int r_ = rowb + (c) * 64 + lane; gi = IFB[(size_t)r_ * 8 + h]; gf = IFB[(size_t)r_ * 8 + 4 + h]; } while (0)
#define ML_GPREP(par) do { if (w == 7) { const float ig_ = softcap15(gi + ibv); const float z_ = softcap15(gf + fbv); \
        const float lf_ = -(fmaxf(-z_, 0.f) + log1pf(__expf(-fabsf(z_)))); const float bc_ = wave_scan_add(lf_, lane); const float u_ = ig_ - bc_; const float pm_ = wave_scan_max(u_, lane); \
        const float Mv_ = fmaxf(m_prev, pm_); const float M63_ = __int_as_float(__builtin_amdgcn_readlane(__float_as_int(Mv_), 63)); const float g_ = __int_as_float(__builtin_amdgcn_readlane(__float_as_int(bc_), 63)); \
        LAS float* gp_ = (LAS float*)(F.lds + ML_GATE + (par) * ML_GSZ); gp_[lane] = u_; gp_[64 + lane] = Mv_; gp_[128 + lane] = __expf(m_prev - Mv_); gp_[192 + lane] = __expf(-(bc_ + Mv_)); \
        gp_[256 + lane] = __expf(u_ - M63_); if (lane == 0) gp_[320] = __expf(m_prev - M63_); m_prev = g_ + M63_; } } while (0)
#define ML_WRITE(kb_, vw_, gpn_, Q_, K_, V_) do { _Pragma("unroll") for (int k_ = 0; k_ < 4; ++k_) { const int it_ = tid + 512 * k_, s_ = it_ >> 5, ch_ = it_ & 31; \
        *(LAS u32x4*)(F.lds + ML_QL + s_ * ML_RS + ch_ * 16) = Q_[k_]; *(LAS u32x4*)(F.lds + (kb_) + s_ * ML_RS + ch_ * 16) = K_[k_]; } \
        if (tid < 256) { const int s_ = tid >> 2, ch_ = tid & 3; const unsigned e_[4] = {V_.x, V_.y, V_.z, V_.w}; const float ws_ = (gpn_)[256 + s_]; \
            _Pragma("unroll") for (int i_ = 0; i_ < 8; ++i_) { const unsigned hv_ = (e_[i_ >> 1] >> ((i_ & 1) * 16)) & 0xffffu; \
                *(LAS bf16_t*)(F.lds + ML_VT + (8 * ch_ + i_) * ML_TS + 2 * s_) = (bf16_t)hv_; \
                *(LAS bf16_t*)(F.lds + (vw_) + (8 * ch_ + i_) * ML_WS + 2 * s_) = (bf16_t)(cvt_pk_bf16(__uint_as_float(hv_ << 16) * ws_, 0.f) & 0xffffu); } \
            if (ch_ == 0) *(LAS bf16_t*)(F.lds + (vw_) + 32 * ML_WS + 2 * s_) = (bf16_t)(cvt_pk_bf16(ws_, 0.f) & 0xffffu); } } while (0)
    ML_LOAD(0, qra, kra, vra); ML_GLOAD(0);
    ML_GPREP(0);
    ML_GLOAD(1);
    __syncthreads();
    ML_WRITE(ML_KA, ML_VW, ((const LAS float*)(F.lds + ML_GATE)), qra, kra, vra);
    __syncthreads();
#define ML_STEP(c, LQ_, LK_, LV_, WQ_, WK_, WV_) do { \
        const int par = c & 1; const LAS float* gp = (const LAS float*)(F.lds + ML_GATE + par * ML_GSZ); \
        const int vt = ML_VT, kb = par ? ML_KB : ML_KA, kbn = par ? ML_KA : ML_KB, vw = par ? ML_VW2 : ML_VW, vwn = par ? ML_VW : ML_VW2; \
        const LAS float* gpn = (const LAS float*)(F.lds + ML_GATE + (par ^ 1) * ML_GSZ); \
        const int rowc = rowb + c * 64; \
        const size_t rog_ = tb256(rowc + 16 * (w & 3) + r16, h * 512 + sl * 32 + 4 * q4, 8); \
        const u32x2 ob0 = *(const gu32x2*)(CO + rog_), ob1 = *(const gu32x2*)(CO + rog_ + 16), zb0 = *(const gu32x2*)(CZs + rog_), zb1 = *(const gu32x2*)(CZs + rog_ + 16); \
        ML_LOAD((c + 1 < 32 ? c + 1 : 31), LQ_, LK_, LV_); if (c + 1 < 32) ML_GPREP(par ^ 1); ML_GLOAD((c + 2 < 32 ? c + 2 : 31)); \
        f32x4 oacc[3]; \
        for (int rp_ = 0; rp_ < ML_R1B; ++rp_) { \
        _Pragma("unroll") \
        for (int dt = 0; dt < 3; ++dt) oacc[dt] = (f32x4){0.f, 0.f, 0.f, 0.f}; \
        if (w < 4) { \
            const int T = w; \
            bf16x8 bq[8]; \
        _Pragma("unroll") \
            for (int ks = 0; ks < 8; ++ks) bq[ks] = *(const LAS bf16x8*)(F.lds + ML_QL + (16 * T + r16) * ML_RS + ks * 64 + q4 * 16); \
            f32x4 sa[4]; \
        _Pragma("unroll") \
            for (int s4 = 0; s4 < 4; ++s4) { sa[s4] = (f32x4){0.f, 0.f, 0.f, 0.f}; \
                if (s4 <= T) { \
        _Pragma("unroll") \
                    for (int ks = 0; ks < 8; ++ks) { const bf16x8 a = *(const LAS bf16x8*)(F.lds + kb + (16 * s4 + r16) * ML_RS + ks * 64 + q4 * 16); sa[s4] = MFMA16(a, bq[ks], sa[s4]); } } } \
            const int tl = 16 * T + r16; const float Mt = gp[64 + tl]; \
        _Pragma("unroll") \
            for (int s4 = 0; s4 < 4; ++s4) { const f32x4 uu = *(const LAS f32x4*)(gp + 16 * s4 + 4 * q4); \
        _Pragma("unroll") \
                for (int e = 0; e < 4; ++e) { const int sl_ = 16 * s4 + 4 * q4 + e; sa[s4][e] = (sl_ <= tl) ? sa[s4][e] * __expf(uu[e] - Mt) : 0.f; } } \
        _Pragma("unroll") \
            for (int kk = 0; kk < 2; ++kk) { const bf16x8 pf = mk_frag(pack4(sa[2 * kk]), pack4(sa[2 * kk + 1])); \
        _Pragma("unroll") \
                for (int dt = 0; dt < 3; ++dt) { bf16x8 a; \
                    if (dt < 2) { const LAS unsigned char* vp = F.lds + vt + (16 * dt + r16) * ML_TS + (32 * kk + 4 * q4) * 2; a = mk_frag(*(const LAS u32x2*)vp, *(const LAS u32x2*)(vp + 32)); } \
                    else a = (r16 == 0) ? ones : zeros; \
                    oacc[dt] = MFMA16(a, pf, oacc[dt]); } } \
        } else { \
            const int T = w - 4; f32x4 ia[3]; \
        _Pragma("unroll") \
            for (int dt = 0; dt < 3; ++dt) ia[dt] = (f32x4){0.f, 0.f, 0.f, 0.f}; \
        _Pragma("unroll") \
            for (int ks = 0; ks < 8; ++ks) { const bf16x8 bqv = *(const LAS bf16x8*)(F.lds + ML_QL + (16 * T + r16) * ML_RS + ks * 64 + q4 * 16); \
        _Pragma("unroll") \
                for (int dt = 0; dt < 3; ++dt) { bf16x8 a; \
                    if (dt < 2) a = *(const LAS bf16x8*)(F.lds + ML_CT + (16 * dt + r16) * ML_RS + ks * 64 + q4 * 16); \
                    else { a = *(const LAS bf16x8*)(F.lds + ML_CT + 32 * ML_RS + ks * 64 + q4 * 16); if (r16 != 0) a = zeros; } \
                    ia[dt] = MFMA16(a, bqv, ia[dt]); } } \
            const int tl = 16 * T + r16; \
            *(LAS f32x4*)(F.lds + ML_X + tl * 144 + (4 * q4) * 4) = ia[0]; *(LAS f32x4*)(F.lds + ML_X + tl * 144 + (16 + 4 * q4) * 4) = ia[1]; \
            if (q4 == 0) *(LAS f32x4*)(F.lds + ML_X + tl * 144 + 32 * 4) = ia[2]; \
        } \
        } \
        __syncthreads(); \
        if (w < 4) { \
            const int tl = 16 * w + r16; const float at = gp[128 + tl], en = gp[192 + tl]; \
            const f32x4 x0 = *(const LAS f32x4*)(F.lds + ML_X + tl * 144 + (4 * q4) * 4), x1 = *(const LAS f32x4*)(F.lds + ML_X + tl * 144 + (16 + 4 * q4) * 4); \
            const float xd = *(const LAS float*)(F.lds + ML_X + tl * 144 + 32 * 4); \
            const f32x4 n0 = oacc[0] + x0 * at, n1 = oacc[1] + x1 * at; \
            float den = oacc[2][0] + xd * at; den = __shfl(den, r16); \
            float sq = (n0[0] * n0[0] + n0[1] * n0[1]) + (n0[2] * n0[2] + n0[3] * n0[3]) + (n1[0] * n1[0] + n1[1] * n1[1]) + (n1[2] * n1[2] + n1[3] * n1[3]); \
            sq += __shfl_xor(sq, 16); sq += __shfl_xor(sq, 32); \
            const size_t ro = (size_t)(rowc + tl) * BW + 4 * q4; \
            f32x4 t0, t1; \
            t0[0] = n0[0] * ng0[0] * (bf_lo(ob0.x) * bf_lo(zb0.x)); t0[1] = n0[1] * ng0[1] * (bf_hi(ob0.x) * bf_hi(zb0.x)); t0[2] = n0[2] * ng0[2] * (bf_lo(ob0.y) * bf_lo(zb0.y)); t0[3] = n0[3] * ng0[3] * (bf_hi(ob0.y) * bf_hi(zb0.y)); \
            t1[0] = n1[0] * ng1[0] * (bf_lo(ob1.x) * bf_lo(zb1.x)); t1[1] = n1[1] * ng1[1] * (bf_hi(ob1.x) * bf_hi(zb1.x)); t1[2] = n1[2] * ng1[2] * (bf_lo(ob1.y) * bf_lo(zb1.y)); t1[3] = n1[3] * ng1[3] * (bf_hi(ob1.y) * bf_hi(zb1.y)); \
            *(gu32x2*)(NUM + ro) = pack4(t0); *(gu32x2*)(NUM + ro + 16) = pack4(t1); \
            if (q4 == 0) { SSQC[(size_t)(rowc + tl) * 64 + h * 16 + sl] = sq; if (sl == 0) DNB[(size_t)(rowc + tl) * 4 + h] = fmaxf(fabsf(den), en); } \
        } \
        { const float dec = gp[320]; \
        _Pragma("unroll") \
          for (int i = 0; i < 2; ++i) \
        _Pragma("unroll") \
              for (int dt = 0; dt < 3; ++dt) st[i][dt] = st[i][dt] * dec; \
        _Pragma("unroll") \
          for (int kk = 0; kk < 2; ++kk) { bf16x8 a[2], bv[3]; \
        _Pragma("unroll") \
              for (int i = 0; i < 2; ++i) a[i] = tr_frag8(F.lds + kb, ML_RS, 32 * kk + 8 * q4, 32 * w + 16 * i, r16); \
        _Pragma("unroll") \
              for (int dt = 0; dt < 2; ++dt) bv[dt] = *(const LAS bf16x8*)(F.lds + vw + (16 * dt + r16) * ML_WS + kk * 64 + q4 * 16); \
              bv[2] = *(const LAS bf16x8*)(F.lds + vw + 32 * ML_WS + kk * 64 + q4 * 16); if (r16 != 0) bv[2] = zeros; \
        _Pragma("unroll") \
              for (int i = 0; i < 2; ++i) \
        _Pragma("unroll") \
                  for (int dt = 0; dt < 3; ++dt) st[i][dt] = MFMA16(a[i], bv[dt], st[i][dt]); } \
        _Pragma("unroll") \
          for (int i = 0; i < 2; ++i) { \
        _Pragma("unroll") \
              for (int dt = 0; dt < 2; ++dt) *(LAS u32x2*)(F.lds + ML_CT + (16 * dt + r16) * ML_RS + (32 * w + 16 * i + 4 * q4) * 2) = pack4(st[i][dt]); \
              if (r16 == 0) *(LAS u32x2*)(F.lds + ML_CT + 32 * ML_RS + (32 * w + 16 * i + 4 * q4) * 2) = pack4(st[i][2]); } } \
        for (int rp_ = 0; rp_ < ML_RWR; ++rp_) if (c + 1 < 32) ML_WRITE(kbn, vwn, gpn, WQ_, WK_, WV_); \
        __syncthreads(); \
    } while (0)
    for (int c2 = 0; c2 < 32; ++c2) { ML_STEP(c2, qra, kra, vra, qra, kra, vra); }
#undef ML_LOAD
#undef ML_GLOAD
#undef ML_GPREP
#undef ML_WRITE
#undef ML_STEP
}

__device__ __forceinline__ void p2b_finalize(const Ctx& F, guchar* ws) {
    int lane = F.lane; LAUNDER_V(lane); const int gw = F.vcu * NWAVES + F.wave, NGW = F.G * NWAVES;
    const gbf16* NUM = (const gbf16*)(ws + WS_NUM); gbf16* YC = (gbf16*)(ws + WS_YA) + (size_t)2 * M_ROWS * BW;
    for (int m = gw; m < M_ROWS; m += NGW) {
        float s = ((const gfloat*)(ws + WS_SSQC))[(size_t)m * 64 + lane];
        s += __shfl_xor(s, 1); s += __shfl_xor(s, 2); s += __shfl_xor(s, 4); s += __shfl_xor(s, 8);
        const float dn = ((const gfloat*)(ws + WS_DN))[(size_t)m * 4 + (lane >> 4)];
        const float inv = 1.0f / dn; const float sc = inv * rsqrtf(s * (1.0f / 512.0f) * inv * inv + NORM_EPS);
#pragma unroll
        for (int it = 0; it < 4; ++it) { const float f = __shfl(sc, 16 * it); const size_t o = (size_t)m * BW + (size_t)(it * 64 + lane) * 8;
            const u32x4 nb = *(const gu32x4*)(NUM + o); u32x4 y;
            y.x = cvt_pk_bf16(bf_lo(nb.x) * f, bf_hi(nb.x) * f); y.y = cvt_pk_bf16(bf_lo(nb.y) * f, bf_hi(nb.y) * f);
            y.z = cvt_pk_bf16(bf_lo(nb.z) * f, bf_hi(nb.z) * f); y.w = cvt_pk_bf16(bf_lo(nb.w) * f, bf_hi(nb.w) * f);
            *(gu32x4*)(YC + ablk(m, (it * 64 + lane) * 8, BW)) = y; }
    }
}
__device__ __forceinline__ void p5b_ssq(const Ctx& F, guchar* ws) {
    int lane = F.lane; LAUNDER_V(lane); const int gw = F.vcu * NWAVES + F.wave, NGW = F.G * NWAVES;
    for (int m = gw; m < M_ROWS; m += NGW) { const float s = wave_sum(((const gfloat*)(ws + WS_XSP))[(size_t)m * 64 + lane]); if (lane == 0) ((gfloat*)(ws + WS_CTL + CTL_SSQ1))[m] = s;
#if P1G_F6
#pragma unroll
        for (int hb = 0; hb < 2; ++hb) { const int c0 = 32 * (lane + 64 * hb); float v[32];
#pragma unroll
            for (int i = 0; i < 4; ++i) { const u32x4 w = *(const gu32x4*)((const gbf16*)(ws + WS_XB) + ablk(m, c0 + 8 * i, DM));
                v[8 * i] = bf_lo(w.x); v[8 * i + 1] = bf_hi(w.x); v[8 * i + 2] = bf_lo(w.y); v[8 * i + 3] = bf_hi(w.y); v[8 * i + 4] = bf_lo(w.z); v[8 * i + 5] = bf_hi(w.z); v[8 * i + 6] = bf_lo(w.w); v[8 * i + 7] = bf_hi(w.w); }
            unsigned E; const u32x6 d = mx6_pack(v, E); guchar* rp = ws + WS_XB8 + ((size_t)(m >> 8) * (DM / 128) + (c0 >> 7)) * 32768 + (size_t)(m & 255) * 128 + 16 * ((c0 >> 5) & 3);
            *(gu32x4*)rp = (u32x4){d[0], d[1], d[2], d[3]}; *(gu32x4*)(rp + 64) = (u32x4){d[4], d[5], E, 0u}; }
#endif
    }
}
__device__ __forceinline__ void p4b_x1(const Ctx& F, guchar* ws, const gfloat* npost) {
    int lane = F.lane; LAUNDER_V(lane); const int gw = F.vcu * NWAVES + F.wave, NGW = F.G * NWAVES;
    const gbf16* OUT = (const gbf16*)(ws + WS_OUT); const gbf16* XB = (const gbf16*)(ws + WS_XB); gbf16* X1B = (gbf16*)(ws + WS_X1B);
    for (int m = gw; m < M_ROWS; m += NGW) {
        const float so = wave_sum(((const gfloat*)(ws + WS_OUTP))[(size_t)m * 64 + lane]), se = wave_sum(((const gfloat*)(ws + WS_ERP))[(size_t)m * 64 + lane]);
        const float rso = rsqrtf(so * (1.0f / DM) + NORM_EPS), rse = rsqrtf(se * (1.0f / DM) + NORM_EPS);
        if (lane == 0) { ((gfloat*)(ws + WS_RSO))[m] = rso; ((gfloat*)(ws + WS_RSE))[m] = rse; }
        u32x4 yv[8]; float mx = 0.f;
#pragma unroll
        for (int it = 0; it < 8; ++it) { const int c = (it * 64 + lane) * 8; const size_t o = (size_t)m * DM + c;
            const u32x4 xb = *(const gu32x4*)(XB + ablk(m, c, DM)), ob = *(const gu32x4*)(OUT + o); const f32x4 n0 = *(const gf32x4*)(npost + c), n1 = *(const gf32x4*)(npost + c + 4); u32x4 y;
            y.x = cvt_pk_bf16(bf_lo(xb.x) + bf_lo(ob.x) * rso * n0[0], bf_hi(xb.x) + bf_hi(ob.x) * rso * n0[1]);
            y.y = cvt_pk_bf16(bf_lo(xb.y) + bf_lo(ob.y) * rso * n0[2], bf_hi(xb.y) + bf_hi(ob.y) * rso * n0[3]);
            y.z = cvt_pk_bf16(bf_lo(xb.z) + bf_lo(ob.z) * rso * n1[0], bf_hi(xb.z) + bf_hi(ob.z) * rso * n1[1]);
            y.w = cvt_pk_bf16(bf_lo(xb.w) + bf_lo(ob.w) * rso * n1[2], bf_hi(xb.w) + bf_hi(ob.w) * rso * n1[3]);
            *(gu32x4*)(X1B + ablk(m, c, DM)) = y; yv[it] = y;
            mx = fmaxf(mx, fmaxf(fmaxf(fmaxf(fabsf(bf_lo(y.x)), fabsf(bf_hi(y.x))), fmaxf(fabsf(bf_lo(y.y)), fabsf(bf_hi(y.y)))), fmaxf(fmaxf(fabsf(bf_lo(y.z)), fabsf(bf_hi(y.z))), fmaxf(fabsf(bf_lo(y.w)), fabsf(bf_hi(y.w))))));
#if P5_FP8
            { u32x2 y8; y8.x = pack_fp8x4(bf_lo(y.x), bf_hi(y.x), bf_lo(y.y), bf_hi(y.y)); y8.y = pack_fp8x4(bf_lo(y.z), bf_hi(y.z), bf_lo(y.w), bf_hi(y.w)); *(gu32x2*)(ws + WS_X1B8 + ablk8(m, c, DM)) = y8; }
#endif
            }
#if P5_I8
#pragma unroll
        for (int s = 32; s >= 1; s >>= 1) mx = fmaxf(mx, __shfl_xor(mx, s));
        mx = fmaxf(mx, 1e-30f); const float qs = 127.0f / mx;
        if (lane == 0) ((gfloat*)(ws + WS_RSX))[m] = mx * (1.0f / 127.0f);
#pragma unroll
        for (int it = 0; it < 8; ++it) { const int c = (it * 64 + lane) * 8; const u32x4 y = yv[it]; u32x2 y8;
            y8.x = pack_i8x4(bf_lo(y.x) * qs, bf_hi(y.x) * qs, bf_lo(y.y) * qs, bf_hi(y.y) * qs); y8.y = pack_i8x4(bf_lo(y.z) * qs, bf_hi(y.z) * qs, bf_lo(y.w) * qs, bf_hi(y.w) * qs);
            *(gu32x2*)(ws + WS_X1B8 + ablk8(m, c, DM)) = y8; }
#endif
    }
}

#ifndef P1_ROT
#define P1_ROT 0
#endif
#ifndef P1_WGM
#define P1_WGM 4
#endif
#ifndef REP_P0
#define REP_P0 1
#endif
#ifndef REP_P1
#define REP_P1 1
#endif
#ifndef REP_ML
#define REP_ML 1
#endif
#ifndef REP_SW
#define REP_SW 1
#endif
#ifndef REP_GM
#define REP_GM 1
#endif
#ifndef REP_P3
#define REP_P3 1
#endif
#ifndef REP_THIN
#define REP_THIN 1
#endif
#ifndef REP_BAR
#define REP_BAR 1
#endif
#ifndef REP_P4
#define REP_P4 1
#endif
__device__ __forceinline__ unsigned long long arg_ld(LAS unsigned char* lds, int i) {
    unsigned a = (unsigned)(ARGS_OFF + 8 * i); asm volatile("" : "+v"(a));
    const volatile LAS unsigned* q = (const volatile LAS unsigned*)(lds + a);
    const unsigned lo = q[0], hi = q[1];
    return ((unsigned long long)(unsigned)__builtin_amdgcn_readfirstlane((int)hi) << 32) | (unsigned)__builtin_amdgcn_readfirstlane((int)lo);
}
struct Args { const void* in[19]; float* out; unsigned char* ws; };
static_assert(sizeof(Args) == 21 * 8, "no padding in Args");

__global__ void __launch_bounds__(NTHREADS, 2) fwd_kernel(Args args) {
    extern __shared__ __attribute__((aligned(16))) unsigned char lds_raw[];
    Ctx F; F.lds = (LAS unsigned char*)lds_raw; F.tid = threadIdx.x; F.lane = F.tid & 63; F.wave = __builtin_amdgcn_readfirstlane(F.tid >> 6);
    F.G = gridDim.x; F.bx = blockIdx.x; { const int bx = blockIdx.x; F.vcu = (F.G % 8 == 0) ? (bx % 8) * (F.G / 8) + bx / 8 : bx; }
    guchar* ws0 = (guchar*)args.ws;
#define WSL() ({ guchar* w_ = ws0; LAUNDER_S(w_); w_; })
    volatile LAS unsigned* MISC = (volatile LAS unsigned*)(F.lds + MISC_OFF);
    if (F.tid < 32) MISC[F.tid] = 0u;
    __syncthreads();
    const XcdBarrier bar = xcd_barrier_post((unsigned*)(ws0 + WS_CTL) + CW_BAR, MISC);

    if (F.tid < 19) ((LAS unsigned long long*)(F.lds + ARGS_OFF))[F.tid] = (unsigned long long)args.in[F.tid];
    if (F.tid == 19) ((LAS unsigned long long*)(F.lds + ARGS_OFF))[19] = (unsigned long long)args.out;
    __syncthreads();
#define ARGP(T, i) ((T)arg_ld(F.lds, (i)))

#define FL() ({ Ctx f_ = F; LAUNDER_S(f_.lds); LAUNDER_S(f_.wave); LAUNDER_S(f_.vcu); LAUNDER_S(f_.G); LAUNDER_S(f_.bx); f_; })
#ifndef SKIP_P0
    for (int rep_ = 0; rep_ < REP_P0; ++rep_) { const Ctx Fp = FL(); guchar* ws = WSL(); p0_prologue(FL(), ARGP(const gfloat*, 0), ARGP(const gfloat*, 1), ARGP(const gint*, 2), ARGP(const gfloat*, 3), ARGP(const gfloat*, 4), ARGP(const gfloat*, 13), ARGP(const gfloat*, 14), ARGP(const gfloat*, 18), ARGP(const gfloat*, 16), ws); }
#endif
    for (int rb_ = 0; rb_ < REP_BAR; ++rb_) xcd_barrier(bar);

    auto layer_body = [&](const int l) __attribute__((always_inline)) {
#ifndef NT_BF
#define NT_BF (P1G_FP8 ? 67 : NT_IN)
#endif
#ifndef P1_LOCK
#define P1_LOCK 0
#endif
#ifndef SKIP_P1
        for (int rep_ = 0; rep_ < REP_P1; ++rep_) { const Ctx Fp = FL(); guchar* ws = WSL(); const gfloat* ssq = l == 0 ? (const gfloat*)(ws + WS_SSQ0) : (const gfloat*)(ws + WS_CTL + CTL_SSQ1);
          const int rowbase = (Fp.G == 256 && P1_WGM == 4 && P1_ROT == 0) ? (Fp.bx & 7) * 1024 : -1; LAS float* rtab = (LAS float*)(Fp.lds + 132096);
          if (rowbase >= 0) { int ti_ = threadIdx.x; LAUNDER_V(ti_); const float s0_ = ssq[rowbase + ti_], s1_ = ssq[rowbase + 512 + ti_]; rtab[ti_] = rsqrtf(s0_ * (1.0f / DM) + NORM_EPS); rtab[512 + ti_] = rsqrtf(s1_ * (1.0f / DM) + NORM_EPS); __syncthreads(); }
#if P1G_FP8
          { pg8::SchedPlain S; S.T.init(M_ROWS / 256, 56, Fp.G, Fp.bx, P1_WGM, P1_ROT, -1, 74); S.pn0 = 74; S.A = (const gchar*)(ws + WS_XB8); S.B = (const gchar*)(ws + WS_WG8 + (size_t)l * SZ_WG8);
            S.astep = (size_t)256 * DM; S.bstep = (size_t)256 * DM;
            pg8::EpiInT<true> E{ssq, ws, rtab, rowbase};
            pg8::gemm_phase<pg8::EpiInT<true>, pg8::SchedPlain>(Fp.lds, DM / 2, DM, DM, S, E); }
          { pg8::SchedPlain S; S.T.init(M_ROWS / 256, NT_BF, Fp.G, Fp.bx, P1_WGM, P1_ROT, 122, 0); S.A = (const gchar*)(ws + WS_XB); S.B = (const gchar*)(ws + WS_WIN + (size_t)l * SZ_WIN);
            S.astep = (size_t)256 * DM * 2; S.bstep = (size_t)256 * DM * 2;
            pg8::EpiIn E{ssq, ws, rtab, rowbase};
            pg8::gemm_phase<pg8::EpiIn, pg8::SchedPlain>(Fp.lds, DM, DM, DM, S, E, (unsigned*)(ws + WS_CTL) + 256 + 64 * l, P1_LOCK); }
#else
          { pg8::SchedPlain S; S.T.init(M_ROWS / 256, NT_IN, Fp.G, Fp.bx, P1_WGM, P1_ROT); S.A = (const gchar*)(ws + WS_XB); S.B = (const gchar*)(ws + WS_WIN + (size_t)l * SZ_WIN);
            S.astep = (size_t)256 * DM * 2; S.bstep = (size_t)256 * DM * 2;
            pg8::EpiIn E{ssq, ws, rtab, rowbase};
            pg8::gemm_phase<pg8::EpiIn, pg8::SchedPlain>(Fp.lds, DM, DM, DM, S, E, (unsigned*)(ws + WS_CTL) + 256 + 64 * l, P1_LOCK); }
#endif
        }
#ifdef PROBE_P1CHEAP
        { const Ctx Fp = FL(); guchar* ws = WSL(); pg8::SchedPlain S; S.T.init(M_ROWS / 256, NT_IN, Fp.G, Fp.bx); S.A = (const gchar*)(ws + WS_XB); S.B = (const gchar*)(ws + WS_WIN + (size_t)l * SZ_WIN);
          S.astep = (size_t)256 * DM * 2; S.bstep = (size_t)256 * DM * 2;
          pg8::EpiSq E{(gbf16*)(ws + WS_END), (gfloat*)(ws + WS_END + (size_t)M_ROWS * 31488 * 2)};
          pg8::gemm_phase<pg8::EpiSq, pg8::SchedPlain>(Fp.lds, DM, DM, DM, S, E); }
#endif
        { const Ctx Fq = FL(); const int nwg_ = (M_ROWS / 256) * NT_BF, rem_ = nwg_ % Fq.G;
          if (rem_ == 0 || Fq.bx >= rem_) { const int me = rem_ ? Fq.bx - rem_ : Fq.bx, nw = rem_ ? Fq.G - rem_ : Fq.G;
            { const Ctx Fp = FL(); guchar* ws = WSL(); pg8::SchedPlain S; S.T.init(M_ROWS / 256, DM / 256, nw, me); S.A = (const gchar*)(ws + WS_PB + (size_t)l * M_ROWS * 256 * 2); S.B = (const gchar*)(ws + WS_WPP + (size_t)l * SZ_WPP);
              S.astep = (size_t)256 * 256 * 2; S.bstep = (size_t)256 * 256 * 2;
              pg8::EpiSq E{(gbf16*)(ws + WS_ERAW), (gfloat*)(ws + WS_ERP)};
              pg8::gemm_phase<pg8::EpiSq, pg8::SchedPlain>(Fp.lds, 256, 256, 256, S, E); }
            if (l == 1 && P5_I8 && TR_L1TAIL) tr_run(FL(), TR_PG1 - TR_L1TAIL, TR_PG1, 0x7fffffff, 0x7fffffff, me, nw, ARGP(const gfloat*, 4), ARGP(const gfloat*, 3), ARGP(const gfloat*, 13), ARGP(const gfloat*, 14), ARGP(const gfloat*, 18), ARGP(const gfloat*, 16), WSL());
            if (l == 0) tr_run(FL(), P5_I8 ? TR_PG0 : TR_DEFER0, P5_I8 ? TR_PG1 + 1024 : TR_DEFER1, P5_I8 ? TR_PG0 + 1024 : 0x7fffffff, P5_I8 ? TR_PG1 : 0x7fffffff, me, nw, ARGP(const gfloat*, 4), ARGP(const gfloat*, 3), ARGP(const gfloat*, 13), ARGP(const gfloat*, 14), ARGP(const gfloat*, 18), ARGP(const gfloat*, 16), WSL()); } }
#endif
#ifdef PROBE_DELAY
        if (((F.bx & 7) < 4) == (PROBE_DELAY == 1)) { const unsigned long long t0_ = __builtin_amdgcn_s_memrealtime(); while (__builtin_amdgcn_s_memrealtime() - t0_ < 3000ull) __builtin_amdgcn_s_sleep(8); }
#endif
        for (int rb_ = 0; rb_ < REP_BAR; ++rb_) xcd_barrier(bar);
#ifndef SKIP_ML
        for (int rep_ = 0; rep_ < REP_ML; ++rep_) { const Ctx Fp = FL(); guchar* ws = WSL(); for (int u = Fp.vcu; u < 256; u += Fp.G) mlstm_unit(Fp, u >> 6, (u >> 4) & 3, u & 15, ws, ARGP(const gfloat*, 10) + l * 4, ARGP(const gfloat*, 11) + l * 4, ARGP(const gfloat*, 12) + l * BW); }
#endif
#ifndef SKIP_SW
        for (int rep_ = 0; rep_ < REP_SW; ++rep_) { const Ctx Fp = FL(); guchar* ws = WSL(); for (int u = Fp.vcu; u < 256; u += Fp.G) swa_unit(Fp, u >> 6, (u >> 2) & 15, u & 3, ws, ARGP(const gfloat*, 9) + l * 32); }
#endif
#ifndef SKIP_GM
        for (int rep_ = 0; rep_ < REP_GM; ++rep_) { const Ctx Fp = FL(); guchar* ws = WSL(); for (int u = Fp.vcu; u < 512; u += Fp.G) gmlp_unit(Fp, u >> 7, (u >> 3) & 15, u & 7, ws, ARGP(const gfloat*, 5) + l * BW, ARGP(const gfloat*, 6) + l * BW, ARGP(const gfloat*, 7) + (size_t)l * 8 * 128 * 128, ARGP(const gfloat*, 8) + l * 8 * 128); }
#endif
        for (int rb_ = 0; rb_ < REP_BAR; ++rb_) xcd_barrier(bar);
#ifndef SKIP_P2B
        for (int rep_ = 0; rep_ < REP_THIN; ++rep_) p2b_finalize(FL(), WSL());
#endif
        for (int rb_ = 0; rb_ < REP_BAR; ++rb_) xcd_barrier(bar);
#ifndef PROBE_NOSTORE
#define PROBE_NOSTORE 0
#endif
#ifdef PROBE_K1024
        for (int rep_ = 0; rep_ < 4; ++rep_) { const Ctx Fp = FL(); guchar* ws = WSL(); pg8::SchedPlain S; S.T.init(M_ROWS / 256, DM / 256, Fp.G, Fp.bx); S.A = (const gchar*)(ws + WS_YA); S.B = (const gchar*)(ws + WS_WOUT + (size_t)l * SZ_WSQ);
          S.astep = (size_t)256 * DM * 2; S.bstep = (size_t)256 * DM * 2;
          pg8::EpiSq E{PROBE_NOSTORE ? (gbf16*)nullptr : (gbf16*)(ws + WS_END), (gfloat*)(ws + WS_END + (size_t)M_ROWS * 31488 * 2)};
          pg8::gemm_phase<pg8::EpiSq, pg8::SchedPlain>(Fp.lds, 1024, DM, DM, S, E); }
#endif
#ifdef PROBE_P3CHEAP
        { const Ctx Fp = FL(); guchar* ws = WSL(); pg8::SchedBranch S; S.T.init(M_ROWS / 256, DM / 256, Fp.G, Fp.bx); S.A = (const gchar*)(ws + WS_YA); S.B = (const gchar*)(ws + WS_WBR + (size_t)l * SZ_WBR);
          S.astep = (size_t)256 * BW * 2; S.bstep = (size_t)256 * BW * 2; S.aseg = SZ_ROWS_BW; S.bseg = (size_t)DM * BW * 2;
          pg8::EpiSq E{(gbf16*)(ws + WS_END), (gfloat*)(ws + WS_END + (size_t)M_ROWS * 31488 * 2)};
          pg8::gemm_phase<pg8::EpiSq, pg8::SchedBranch>(Fp.lds, BW, BW, BW, S, E); }
#endif
#ifndef SKIP_P3
        for (int rep_ = 0; rep_ < REP_P3; ++rep_) { const Ctx Fp = FL(); guchar* ws = WSL(); pg8::SchedBranch S; S.T.init(M_ROWS / 256, DM / 256, Fp.G, Fp.bx); S.A = (const gchar*)(ws + WS_YA); S.B = (const gchar*)(ws + WS_WBR + (size_t)l * SZ_WBR);
          S.astep = (size_t)256 * BW * 2; S.bstep = (size_t)256 * BW * 2; S.aseg = SZ_ROWS_BW; S.bseg = (size_t)DM * BW * 2;
          pg8::EpiBranch E{(const guchar*)(ws + WS_G), (gbf16*)(ws + WS_MIX)};
          pg8::gemm_phase<pg8::EpiBranch, pg8::SchedBranch>(Fp.lds, BW, BW, BW, S, E); }
#endif
        for (int rb_ = 0; rb_ < REP_BAR; ++rb_) xcd_barrier(bar);
#ifndef SKIP_P4
        for (int rep_ = 0; rep_ < REP_P4; ++rep_) { const Ctx Fp = FL(); guchar* ws = WSL(); pg8::SchedPlain S; S.T.init(M_ROWS / 256, DM / 256, Fp.G, Fp.bx); S.A = (const gchar*)(ws + WS_MIX); S.B = (const gchar*)(ws + WS_WOUT + (size_t)l * SZ_WSQ);
          S.astep = (size_t)256 * DM * 2; S.bstep = (size_t)256 * DM * 2;
          pg8::EpiSq E{(gbf16*)(ws + WS_OUT), (gfloat*)(ws + WS_OUTP)};
          pg8::gemm_phase<pg8::EpiSq, pg8::SchedPlain>(Fp.lds, DM, DM, DM, S, E); }
#endif
        for (int rb_ = 0; rb_ < REP_BAR; ++rb_) xcd_barrier(bar);
#ifndef SKIP_P4B
        for (int rep_ = 0; rep_ < REP_THIN; ++rep_) p4b_x1(FL(), WSL(), ARGP(const gfloat*, 15) + l * DM);
#endif
        for (int rb_ = 0; rb_ < REP_BAR; ++rb_) xcd_barrier(bar);
#ifndef SKIP_P5
        { const Ctx Fp = FL(); guchar* ws = WSL(); pg8::SchedPlain S; S.T.init(M_ROWS / 256, DM / 256, Fp.G, Fp.bx); S.A = (const gchar*)(ws + ((P5_FP8 || P5_I8) ? WS_X1B8 : WS_X1B)); S.B = (const gchar*)(ws + WS_WPG + (size_t)l * SZ_WSQ);
          S.astep = (size_t)256 * DM * ((P5_FP8 || P5_I8) ? 1 : 2); S.bstep = (size_t)256 * DM * ((P5_FP8 || P5_I8) ? 1 : 2);
          pg8::EpiPle E{(const gbf16*)(ws + WS_X1B), ARGP(gfloat*, 19), (gbf16*)(ws + WS_XB), (const gbf16*)(ws + WS_ERAW), (const gfloat*)(ws + WS_RSE), ARGP(const gfloat*, 17) + l * DM, (gfloat*)(ws + WS_XSP), l == NLAYER - 1 ? 1 : 0, ws + WS_XB8, (const gfloat*)(ws + WS_RSX), __uint_as_float(((const gunsigned*)(ws + WS_CTL))[CW_WMAX + l]) * (1.0f / 127.0f)};
          pg8::gemm_phase<pg8::EpiPle, pg8::SchedPlain>(Fp.lds, (P5_FP8 || P5_I8) ? DM / 2 : DM, DM, DM, S, E); }
#endif
        if (l + 1 < NLAYER) { for (int rb_ = 0; rb_ < REP_BAR; ++rb_) xcd_barrier(bar); p5b_ssq(FL(), WSL()); for (int rb_ = 0; rb_ < REP_BAR; ++rb_) xcd_barrier(bar); }
    };
    static_assert(NLAYER == 2, "two layer bodies");
    layer_body(0); layer_body(1);
}

extern "C" void kernel_launch(void* const* d_in, const int* in_sizes, int n_in, void* d_out, int out_size, void* d_ws, size_t ws_size, hipStream_t stream) {
    static int grid = 0;
    if (grid == 0) {
        if (n_in != 19 || out_size != M_ROWS * DM || ws_size < WS_END) { fprintf(stderr, "kernel_launch: unexpected problem (n_in %d, out %d, ws %zu, need %zu)\n", n_in, out_size, ws_size, (size_t)WS_END); grid = -1; return; }
        int dev = 0, cus = 0;
        if (hipGetDevice(&dev) != hipSuccess || hipDeviceGetAttribute(&cus, hipDeviceAttributeMultiprocessorCount, dev) != hipSuccess) { grid = -1; return; }
        if (hipFuncSetAttribute((const void*)fwd_kernel, hipFuncAttributeMaxDynamicSharedMemorySize, LDS_BYTES) != hipSuccess) { fprintf(stderr, "kernel_launch: hipFuncSetAttribute failed\n"); grid = -1; return; }
        int per_cu = 0; (void)hipOccupancyMaxActiveBlocksPerMultiprocessor(&per_cu, (const void*)fwd_kernel, NTHREADS, LDS_BYTES); (void)hipGetLastError();
        if (per_cu < 1) fprintf(stderr, "kernel_launch: occupancy query reports %d blocks per CU\n", per_cu);
        grid = cus > 256 ? 256 : cus;
    }
    if (grid < 0) return;
    (void)hipMemsetAsync((char*)d_ws + WS_CTL, 0, CTL_ZERO_BYTES, stream);
    Args a{};
    for (int i = 0; i < 19; ++i) a.in[i] = d_in[i];
    a.out = (float*)d_out; a.ws = (unsigned char*)d_ws;
    hipLaunchKernelGGL(fwd_kernel, dim3(grid), dim3(NTHREADS), LDS_BYTES, stream, a);
    const hipError_t le = hipPeekAtLastError();
    if (le != hipSuccess) fprintf(stderr, "kernel_launch: launch failed: %s\n", hipGetErrorName(le));
}
```
